# Optimizing an MI355X kernel written in HIP

```python
import jax, jax.numpy as jnp
from jax import lax
import numpy as np

D_MODEL = 1024
BATCH = 8
SEQ = 4096
DEPTH = 1

MEM_LEN = 256
EPS = 1e-6
MIX_WIDTH = D_MODEL
RNN_WIDTH = MIX_WIDTH // 2
RNN_HEADS = 8
RNN_HEAD_DIM = RNN_WIDTH // RNN_HEADS
CONV_WIDTH = 4
LRU_C = 8.0
SB_WIDTH = MIX_WIDTH - RNN_WIDTH
SB_HEADS = 8
SB_HEAD_DIM = SB_WIDTH // SB_HEADS
Q_BLOCK = 128
PROJ_WIDTH = 2 * RNN_WIDTH + 3 * SB_WIDTH
XA_HEADS = 4
XA_HEAD_DIM = D_MODEL // XA_HEADS
N_GROUPS = 4
EXPERTS_PER_GROUP = 4
TOP_K = 2
D_EXPERT = D_MODEL // 4

kernel_name = "hymba_rglru_stickbreak_hmoe_block"


def rms_norm(x, gain):
    xf = x.astype(jnp.float32)
    var = jnp.mean(xf * xf, axis=-1, keepdims=True)
    return (xf * lax.rsqrt(var + EPS) * gain.astype(jnp.float32)).astype(x.dtype)


def causal_depthwise_conv(x, w, b):
    c = x.shape[-1]
    y = lax.conv_general_dilated(
        x, w[:, None, :].astype(x.dtype), window_strides=(1,),
        padding=[(CONV_WIDTH - 1, 0)], dimension_numbers=('NWC', 'WIO', 'NWC'),
        feature_group_count=c)
    return y + b.astype(x.dtype)


def rg_lru(x, w_a, b_a, w_x, b_x, lam):
    bsz, s, _ = x.shape
    xh = x.reshape(bsz, s, RNN_HEADS, RNN_HEAD_DIM)
    r = jax.nn.sigmoid(jnp.einsum('bshi,hij->bshj', xh, w_a) + b_a).reshape(bsz, s, RNN_WIDTH)
    i = jax.nn.sigmoid(jnp.einsum('bshi,hij->bshj', xh, w_x) + b_x).reshape(bsz, s, RNN_WIDTH)
    log_a = -LRU_C * r.astype(jnp.float32) * jax.nn.softplus(-lam.astype(jnp.float32))
    a = jnp.exp(log_a)
    b = jnp.sqrt(-jnp.expm1(2.0 * log_a)) * (i * x).astype(jnp.float32)

    def combine(left, right):
        a_l, b_l = left
        a_r, b_r = right
        return a_l * a_r, a_r * b_l + b_r

    _, h = lax.associative_scan(combine, (a, b), axis=1)
    return h.astype(x.dtype)


def stick_breaking_attention(q, k, v):
    bsz, s, nh, dh = q.shape
    n_blocks = s // Q_BLOCK
    scale = dh ** -0.5
    q_blocks = q.reshape(bsz, n_blocks, Q_BLOCK, nh, dh).transpose(1, 0, 3, 2, 4)
    key_pos = jnp.arange(s)

    def one_block(args):
        q_blk, blk = args
        query_pos = blk * Q_BLOCK + jnp.arange(Q_BLOCK)
        z = jnp.einsum('bhqd,bkhd->bhqk', q_blk, k).astype(jnp.float32) * scale
        mask = key_pos[None, :] < query_pos[:, None]
        log_not = jnp.where(mask, jax.nn.log_sigmoid(-z), 0.0)
        later = lax.cumsum(log_not, axis=3, reverse=True) - log_not
        w = jnp.where(mask, jnp.exp(jax.nn.log_sigmoid(z) + later), 0.0)
        return jnp.einsum('bhqk,bkhd->bqhd', w.astype(v.dtype), v)

    out = lax.map(one_block, (q_blocks, jnp.arange(n_blocks)))
    return out.transpose(1, 0, 2, 3, 4).reshape(bsz, s, nh * dh)


def hybrid_mixer(h, w_in, conv_w, conv_b, w_a, b_a, w_x, b_x, lam, g_rnn, g_sb, w_out):
    bsz, s, _ = h.shape
    proj = h @ w_in
    x_rnn, gate_rnn, q, k, v = jnp.split(
        proj, [RNN_WIDTH, 2 * RNN_WIDTH, 2 * RNN_WIDTH + SB_WIDTH, 2 * RNN_WIDTH + 2 * SB_WIDTH], axis=-1)
    x_rnn = causal_depthwise_conv(x_rnn, conv_w, conv_b)
    y_rnn = rg_lru(x_rnn, w_a, b_a, w_x, b_x, lam) * jax.nn.gelu(gate_rnn)
    hd = (bsz, s, SB_HEADS, SB_HEAD_DIM)
    y_sb = stick_breaking_attention(q.reshape(hd), k.reshape(hd), v.reshape(hd))
    y = jnp.concatenate([rms_norm(y_rnn, g_rnn), rms_norm(y_sb, g_sb)], axis=-1)
    return y @ w_out


def memory_cross_attention(h, m, w_q, w_k, w_v, w_o):
    bsz, s, d = h.shape
    n_mem = m.shape[1]
    q = (h @ w_q).reshape(bsz, s, XA_HEADS, XA_HEAD_DIM)
    k = (m @ w_k).reshape(bsz, n_mem, XA_HEADS, XA_HEAD_DIM)
    v = (m @ w_v).reshape(bsz, n_mem, XA_HEADS, XA_HEAD_DIM)
    scores = jnp.einsum('bshd,bmhd->bhsm', q, k).astype(jnp.float32) * (XA_HEAD_DIM ** -0.5)
    p = jax.nn.softmax(scores, axis=-1).astype(v.dtype)
    o = jnp.einsum('bhsm,bmhd->bshd', p, v).reshape(bsz, s, d)
    return o @ w_o


def hierarchical_moe(h, w_group_router, b_group_router, w_expert_router, b_expert_router,
                     w_gate, w_up, w_down):
    bsz, s, d = h.shape
    t = h.reshape(-1, d)
    group_prob = jax.nn.softmax((t @ w_group_router).astype(jnp.float32) + b_group_router, axis=-1)
    group_p, group_idx = lax.top_k(group_prob, 1)
    expert_logits = jnp.einsum('nd,gde->nge', t, w_expert_router).astype(jnp.float32) + b_expert_router
    chosen = jnp.take_along_axis(expert_logits, group_idx[:, :, None], axis=1)[:, 0]
    top_logit, top_idx = lax.top_k(chosen, TOP_K)
    top_w = jax.nn.softmax(top_logit, axis=-1) * group_p
    expert_w = jnp.sum(jax.nn.one_hot(top_idx, EXPERTS_PER_GROUP, dtype=jnp.float32) * top_w[..., None], axis=1)
    combine = jax.nn.one_hot(group_idx[:, 0], N_GROUPS, dtype=jnp.float32)[:, :, None] * expert_w[:, None, :]
    out = jnp.zeros_like(t)
    for g in range(N_GROUPS):
        hid = jax.nn.silu(jnp.einsum('nd,edf->nef', t, w_gate[g])) * jnp.einsum('nd,edf->nef', t, w_up[g])
        hid = hid * combine[:, g, :, None].astype(hid.dtype)
        out = out + jnp.einsum('nef,efd->nd', hid, w_down[g])
    return out.reshape(bsz, s, d)


def setup_inputs(seed: int = 0) -> dict:
    key = jax.random.key(seed)
    ks = jax.random.split(key, 32)
    f32 = jnp.float32
    L = DEPTH

    def nrm(k, shape, fan_in):
        return jax.random.normal(k, shape, f32) * (fan_in ** -0.5)

    def gain(k, shape):
        return 1.0 + 0.02 * jax.random.normal(k, shape, f32)

    u = jax.random.uniform(ks[9], (L, RNN_WIDTH), f32, 0.9, 0.999)
    a0 = u ** (1.0 / LRU_C)
    lam = jnp.log(a0) - jnp.log1p(-a0)
    return {
        "x": jax.random.normal(ks[0], (BATCH, SEQ, D_MODEL), f32),
        "mem": jax.random.normal(ks[1], (BATCH, MEM_LEN, D_MODEL), f32),
        "norm_mix": gain(ks[2], (L, D_MODEL)),
        "w_in": nrm(ks[3], (L, D_MODEL, PROJ_WIDTH), D_MODEL),
        "conv_w": nrm(ks[4], (L, CONV_WIDTH, RNN_WIDTH), CONV_WIDTH),
        "conv_b": 0.01 * jax.random.normal(ks[5], (L, RNN_WIDTH), f32),
        "lru_w_a": nrm(ks[6], (L, RNN_HEADS, RNN_HEAD_DIM, RNN_HEAD_DIM), RNN_HEAD_DIM),
        "lru_b_a": 0.01 * jax.random.normal(ks[7], (L, RNN_HEADS, RNN_HEAD_DIM), f32),
        "lru_w_x": nrm(ks[8], (L, RNN_HEADS, RNN_HEAD_DIM, RNN_HEAD_DIM), RNN_HEAD_DIM),
        "lru_b_x": 0.01 * jax.random.normal(ks[10], (L, RNN_HEADS, RNN_HEAD_DIM), f32),
        "lru_lambda": lam,
        "norm_rnn_out": gain(ks[11], (L, RNN_WIDTH)),
        "norm_sb_out": gain(ks[12], (L, SB_WIDTH)),
        "w_out": nrm(ks[13], (L, MIX_WIDTH, D_MODEL), MIX_WIDTH),
        "norm_xattn": gain(ks[14], (L, D_MODEL)),
        "norm_mem": gain(ks[15], (L, D_MODEL)),
        "xa_w_q": nrm(ks[16], (L, D_MODEL, D_MODEL), D_MODEL),
        "xa_w_k": nrm(ks[17], (L, D_MODEL, D_MODEL), D_MODEL),
        "xa_w_v": nrm(ks[18], (L, D_MODEL, D_MODEL), D_MODEL),
        "xa_w_o": nrm(ks[19], (L, D_MODEL, D_MODEL), D_MODEL),
        "norm_moe": gain(ks[20], (L, D_MODEL)),
        "w_group_router": nrm(ks[21], (L, D_MODEL, N_GROUPS), D_MODEL),
        "b_group_router": 0.01 * jax.random.normal(ks[22], (L, N_GROUPS), f32),
        "w_expert_router": nrm(ks[23], (L, N_GROUPS, D_MODEL, EXPERTS_PER_GROUP), D_MODEL),
        "b_expert_router": 0.01 * jax.random.normal(ks[24], (L, N_GROUPS, EXPERTS_PER_GROUP), f32),
        "w_gate": nrm(ks[25], (L, N_GROUPS, EXPERTS_PER_GROUP, D_MODEL, D_EXPERT), D_MODEL),
        "w_up": nrm(ks[26], (L, N_GROUPS, EXPERTS_PER_GROUP, D_MODEL, D_EXPERT), D_MODEL),
        "w_down": nrm(ks[27], (L, N_GROUPS, EXPERTS_PER_GROUP, D_EXPERT, D_MODEL), D_EXPERT),
        "norm_final": gain(ks[28], (D_MODEL,)),
    }


def reference(x, mem, norm_mix, w_in, conv_w, conv_b, lru_w_a, lru_b_a, lru_w_x, lru_b_x,
              lru_lambda, norm_rnn_out, norm_sb_out, w_out, norm_xattn, norm_mem,
              xa_w_q, xa_w_k, xa_w_v, xa_w_o, norm_moe, w_group_router, b_group_router,
              w_expert_router, b_expert_router, w_gate, w_up, w_down, norm_final):
    for l in range(DEPTH):
        x = x + hybrid_mixer(rms_norm(x, norm_mix[l]), w_in[l], conv_w[l], conv_b[l],
                             lru_w_a[l], lru_b_a[l], lru_w_x[l], lru_b_x[l], lru_lambda[l],
                             norm_rnn_out[l], norm_sb_out[l], w_out[l])
        x = x + memory_cross_attention(rms_norm(x, norm_xattn[l]), rms_norm(mem, norm_mem[l]),
                                       xa_w_q[l], xa_w_k[l], xa_w_v[l], xa_w_o[l])
        x = x + hierarchical_moe(rms_norm(x, norm_moe[l]), w_group_router[l], b_group_router[l],
                                 w_expert_router[l], b_expert_router[l],
                                 w_gate[l], w_up[l], w_down[l])
    return rms_norm(x, norm_final)
```

```cpp
#include <hip/hip_runtime.h>
#include <cstdio>
#include <cstdint>

typedef unsigned short bf16_t;
typedef short bf16x8 __attribute__((ext_vector_type(8)));
typedef float f32x4 __attribute__((ext_vector_type(4)));
typedef unsigned u32x4 __attribute__((ext_vector_type(4)));

constexpr int D = 1024, BATCH = 8, SEQ = 4096, NTOK = BATCH * SEQ, MEM = 256, NMEM = BATCH * MEM;
constexpr int RW = 512, SBW = 512, PROJ = 2560, NH = 8, HD = 64;
constexpr int XH = 4, XD = 256, NG = 4, EPG = 4, NEXP = 16, DE = 256;
constexpr float EPS = 1e-6f, LOG2E = 1.4426950408889634f;

constexpr size_t MiB = 1u << 20;
constexpr size_t WS_CTL = 0;
constexpr size_t WS_SMALL = 1 * MiB;
constexpr size_t WS_WIN = 16 * MiB;
constexpr size_t WS_WOUT = 21 * MiB;
constexpr size_t WS_WQ = 23 * MiB;
constexpr size_t WS_WKV = 25 * MiB;
constexpr size_t WS_WO = 29 * MiB;
constexpr size_t WS_MEMN = 31 * MiB;
constexpr size_t WS_KVM = 35 * MiB;
constexpr size_t WS_WG = 43 * MiB;
constexpr size_t WS_WU = 51 * MiB;
constexpr size_t WS_WD2 = 59 * MiB;
constexpr size_t WS_R0 = 96 * MiB;
constexpr size_t WS_R1 = 160 * MiB;
constexpr size_t WS_R2 = 224 * MiB;
constexpr size_t WS_R3 = 288 * MiB;
constexpr size_t WS_R4 = 320 * MiB;
constexpr size_t WS_R5 = 384 * MiB;
constexpr size_t WS_END = 448 * MiB;

constexpr size_t SM_RSTD0 = 0;
constexpr size_t SM_SSQR = 1 * 32768;
constexpr size_t SM_SSQS = 2 * 32768;
constexpr size_t SM_SSQ1 = 10 * 32768;
constexpr size_t SM_SSQ2 = 26 * 32768;
constexpr size_t SM_SSQ3 = 42 * 32768;
constexpr size_t SM_SELW = 58 * 32768;
constexpr size_t SM_SELE = 60 * 32768;
constexpr size_t SM_END = 62 * 32768;

__device__ __forceinline__ unsigned f2bf(float f) { unsigned u = __builtin_bit_cast(unsigned, f); return (u + 0x7fffu + ((u >> 16) & 1u)) >> 16; }
__device__ __forceinline__ float bf2f(unsigned short h) { return __builtin_bit_cast(float, (unsigned)h << 16); }
__device__ __forceinline__ float wave_sum(float v) {
#pragma unroll
    for (int o = 1; o < 64; o <<= 1) v += __shfl_xor(v, o);
    return v;
}
__device__ __forceinline__ float gelu_tanh(float x) { const float u = 0.7978845608028654f * (x + 0.044715f * x * x * x); return x / (1.f + __expf(-2.f * u)); }
__device__ __forceinline__ float sigmoidf_(float x) { return 1.f / (1.f + __expf(-x)); }

__global__ void k_prep_x(const float* __restrict__ x, bf16_t* __restrict__ xb, float* __restrict__ rstd0) {
    const int row = blockIdx.x * 4 + (threadIdx.x >> 6), lane = threadIdx.x & 63;
    const f32x4* xr = (const f32x4*)(x + (size_t)row * D) + lane;
    float s = 0.f; f32x4 v[4];
#pragma unroll
    for (int j = 0; j < 4; ++j) { v[j] = xr[64 * j]; s += v[j].x * v[j].x + v[j].y * v[j].y + v[j].z * v[j].z + v[j].w * v[j].w; }
    s = wave_sum(s);
    if (lane == 0) rstd0[row] = 1.0f / sqrtf(s * (1.f / D) + EPS);
    unsigned long long* o8 = (unsigned long long*)(xb + (size_t)row * D) + lane;
#pragma unroll
    for (int j = 0; j < 4; ++j) o8[64 * j] = (unsigned long long)(f2bf(v[j].x) | (f2bf(v[j].y) << 16)) | ((unsigned long long)(f2bf(v[j].z) | (f2bf(v[j].w) << 16)) << 32);
}
__global__ void k_prep_mem(const float* __restrict__ m, const float* __restrict__ g, bf16_t* __restrict__ o) {
    const int row = blockIdx.x * 4 + (threadIdx.x >> 6), lane = threadIdx.x & 63;
    const f32x4* xr = (const f32x4*)(m + (size_t)row * D) + lane;
    float s = 0.f; f32x4 v[4];
#pragma unroll
    for (int j = 0; j < 4; ++j) { v[j] = xr[64 * j]; s += v[j].x * v[j].x + v[j].y * v[j].y + v[j].z * v[j].z + v[j].w * v[j].w; }
    s = wave_sum(s);
    const float r = 1.0f / sqrtf(s * (1.f / D) + EPS);
    unsigned long long* o8 = (unsigned long long*)(o + (size_t)row * D) + lane;
#pragma unroll
    for (int j = 0; j < 4; ++j) { const f32x4 gg = ((const f32x4*)g)[64 * j + lane];
        o8[64 * j] = (unsigned long long)(f2bf(v[j].x * r * gg.x) | (f2bf(v[j].y * r * gg.y) << 16)) | ((unsigned long long)(f2bf(v[j].z * r * gg.z) | (f2bf(v[j].w * r * gg.w) << 16)) << 32); }
}
__global__ void k_transpose_w(const float* __restrict__ W, int K, int N, bf16_t* __restrict__ Wt, const float* __restrict__ g0, const float* __restrict__ g1, int ksplit) {
    __shared__ float t[32][33];
    const int b = blockIdx.z; W += (size_t)b * K * N; Wt += (size_t)b * K * N;
    const int k0 = blockIdx.y * 32, n0 = blockIdx.x * 32, tx = threadIdx.x & 31, ty = threadIdx.x >> 5;
    for (int i = ty; i < 32; i += 8) { const int k = k0 + i; float gv = 1.f; if (g0) gv = (k < ksplit) ? g0[k] : g1[k - ksplit]; t[i][tx] = W[(size_t)k * N + n0 + tx] * gv; }
    __syncthreads();
    for (int i = ty; i < 32; i += 8) Wt[(size_t)(n0 + i) * K + k0 + tx] = (bf16_t)f2bf(t[tx][i]);
}

struct MidScale { const float* f; int k; int pad; };
template <class Epi>
__global__ void __launch_bounds__(256) k_gemm(const bf16_t* __restrict__ A, int lda, const bf16_t* __restrict__ Bt, int ldb, int K, MidScale ms, Epi E) {
    const int wid = threadIdx.x >> 6, lane = threadIdx.x & 63, fr = lane & 15, fq = lane >> 4;
    const int row0 = blockIdx.y * 64 + wid * 16, col0 = blockIdx.x * 64;
    const bf16_t* ap = A + (size_t)(row0 + fr) * lda + fq * 8;
    const bf16_t* bp = Bt + (size_t)(col0 + fr) * ldb + fq * 8;
    f32x4 acc[4];
#pragma unroll
    for (int n = 0; n < 4; ++n) acc[n] = (f32x4){0.f, 0.f, 0.f, 0.f};
    for (int k0 = 0; k0 < K; k0 += 32) {
        if (ms.f && k0 == ms.k) {
#pragma unroll
            for (int j = 0; j < 4; ++j) { const float f = ms.f[row0 + fq * 4 + j];
#pragma unroll
                for (int n = 0; n < 4; ++n) acc[n][j] *= f; }
        }
        const bf16x8 a = *(const bf16x8*)(ap + k0);
#pragma unroll
        for (int n = 0; n < 4; ++n) { const bf16x8 b = *(const bf16x8*)(bp + (size_t)n * 16 * ldb + k0); acc[n] = __builtin_amdgcn_mfma_f32_16x16x32_bf16(a, b, acc[n], 0, 0, 0); }
    }
#pragma unroll
    for (int n = 0; n < 4; ++n)
#pragma unroll
        for (int j = 0; j < 4; ++j) E(row0 + fq * 4 + j, col0 + n * 16 + fr, acc[n][j]);
}
struct EpiInProj { const float* rstd0; bf16_t *XR, *GG, *Qs, *Ks, *Vs;
    __device__ void operator()(int r, int c, float v) const { v *= rstd0[r]; const int t = c >> 9, cc = c & 511;
        if (t == 0) XR[(size_t)r * RW + cc] = (bf16_t)f2bf(v);
        else if (t == 1) GG[(size_t)r * RW + cc] = (bf16_t)f2bf(gelu_tanh(v));
        else if (t == 2) Qs[(size_t)r * SBW + cc] = (bf16_t)f2bf(v * (0.125f * LOG2E));
        else if (t == 3) Ks[(size_t)r * SBW + cc] = (bf16_t)f2bf(v);
        else Vs[(size_t)r * SBW + cc] = (bf16_t)f2bf(v); } };
struct EpiStoreBf16 { bf16_t* O; const float* rowscale; int ldo; float scale;
    __device__ void operator()(int r, int c, float v) const { O[(size_t)r * ldo + c] = (bf16_t)f2bf(v * (rowscale ? rowscale[r] : 1.f) * scale); } };
struct EpiResF32 { const float* base; const float* rowscale; bf16_t* O;
    __device__ void operator()(int r, int c, float v) const { O[(size_t)r * D + c] = (bf16_t)f2bf(base[(size_t)r * D + c] + v * rowscale[r]); } };
struct EpiResBf16 { const bf16_t* base; bf16_t* O;
    __device__ void operator()(int r, int c, float v) const { O[(size_t)r * D + c] = (bf16_t)f2bf(bf2f(base[(size_t)r * D + c]) + v); } };

__global__ void k_rowssq(const bf16_t* __restrict__ X, int ld, int c0, int ncols, float* __restrict__ out, int ostride) {
    const int row = blockIdx.x * 4 + (threadIdx.x >> 6), lane = threadIdx.x & 63;
    float s = 0.f;
    for (int c = lane; c < ncols; c += 64) { const float v = bf2f(X[(size_t)row * ld + c0 + c]); s += v * v; }
    s = wave_sum(s);
    for (int i = lane; i < ostride; i += 64) out[(size_t)row * ostride + i] = (i == 0) ? s : 0.f;
}
__global__ void k_mixscales(const float* __restrict__ ssq_r, const float* __restrict__ ssq_s8, float* __restrict__ fmid, float* __restrict__ fend) {
    const int r = blockIdx.x * 256 + threadIdx.x;
    float s = 0.f;
#pragma unroll
    for (int i = 0; i < 8; ++i) s += ssq_s8[(size_t)r * 8 + i];
    const float rr = 1.0f / sqrtf(ssq_r[r] * (1.f / RW) + EPS), rs = 1.0f / sqrtf(s * (1.f / SBW) + EPS);
    fmid[r] = rr / rs; fend[r] = rs;
}
__global__ void k_rstd16(const float* __restrict__ p16, float* __restrict__ rstd) {
    const int r = blockIdx.x * 256 + threadIdx.x; float s = 0.f;
#pragma unroll
    for (int i = 0; i < 16; ++i) s += p16[(size_t)r * 16 + i];
    rstd[r] = 1.0f / sqrtf(s * (1.f / D) + EPS);
}

__global__ void __launch_bounds__(64) k_lru_naive(const bf16_t* __restrict__ XR, const bf16_t* __restrict__ GG, const float* __restrict__ conv_w, const float* __restrict__ conv_b,
                                                  const float* __restrict__ w_a, const float* __restrict__ b_a, const float* __restrict__ w_x, const float* __restrict__ b_x,
                                                  const float* __restrict__ lam, bf16_t* __restrict__ YY) {
    __shared__ float xs[64];
    const int b = blockIdx.x >> 3, h = blockIdx.x & 7, j = threadIdx.x, c = h * 64 + j;
    float wa[64], wx[64];
#pragma unroll
    for (int i = 0; i < 64; ++i) { wa[i] = w_a[(size_t)(h * 64 + i) * 64 + j]; wx[i] = w_x[(size_t)(h * 64 + i) * 64 + j]; }
    const float ba = b_a[c], bx = b_x[c], cw0 = conv_w[c], cw1 = conv_w[RW + c], cw2 = conv_w[2 * RW + c], cw3 = conv_w[3 * RW + c], cb = conv_b[c];
    const float l = lam[c], spl = (l > 15.f) ? __expf(-l) : log1pf(__expf(-l));
    float x0 = 0.f, x1 = 0.f, x2 = 0.f, hst = 0.f;
    for (int t = 0; t < SEQ; ++t) {
        const size_t row = (size_t)b * SEQ + t;
        const float x3 = bf2f(XR[row * RW + c]);
        const float xc = cw0 * x0 + cw1 * x1 + cw2 * x2 + cw3 * x3 + cb;
        x0 = x1; x1 = x2; x2 = x3;
        __syncthreads(); xs[j] = xc; __syncthreads();
        float ra = ba, ri = bx;
#pragma unroll
        for (int i = 0; i < 64; ++i) { const float xv = xs[i]; ra += xv * wa[i]; ri += xv * wx[i]; }
        const float r = sigmoidf_(ra), ig = sigmoidf_(ri);
        const float log_a = -8.0f * r * spl, a = __expf(log_a), bb = sqrtf(fmaxf(0.f, -expm1f(2.f * log_a))) * (ig * xc);
        hst = a * hst + bb;
        YY[row * D + c] = (bf16_t)f2bf(hst * bf2f(GG[row * RW + c]));
    }
}

__global__ void __launch_bounds__(64) k_sb_naive(const bf16_t* __restrict__ Qs, const bf16_t* __restrict__ Ks, const bf16_t* __restrict__ Vs, bf16_t* __restrict__ YY, float* __restrict__ ssq_s8) {
    const int qb = blockIdx.x & 63, h = (blockIdx.x >> 6) & 7, b = blockIdx.x >> 9, lane = threadIdx.x;
    const int t = qb * 64 + lane; const size_t row = (size_t)b * SEQ + t;
    float q[64], o[64];
#pragma unroll
    for (int d = 0; d < 64; ++d) { q[d] = bf2f(Qs[row * SBW + h * 64 + d]); o[d] = 0.f; }
    float R = 0.f;
    for (int s = qb * 64 + 62; s >= 0; --s) {
        const bf16_t* kr = Ks + ((size_t)b * SEQ + s) * SBW + h * 64; const bf16_t* vr = Vs + ((size_t)b * SEQ + s) * SBW + h * 64;
        float z = 0.f;
#pragma unroll
        for (int d = 0; d < 64; ++d) z += q[d] * bf2f(kr[d]);
        const bool valid = s < t;
        const float sp = valid ? (fmaxf(z, 0.f) + __log2f(1.f + exp2f(-fabsf(z)))) : 0.f;
        const float w = valid ? exp2f(z - (R + sp)) : 0.f;
        R += sp;
        const float wb = bf2f((bf16_t)f2bf(w));
#pragma unroll
        for (int d = 0; d < 64; ++d) o[d] += wb * bf2f(vr[d]);
    }
    float ss = 0.f;
#pragma unroll
    for (int d = 0; d < 64; ++d) { ss += o[d] * o[d]; YY[row * D + RW + h * 64 + d] = (bf16_t)f2bf(o[d]); }
    ssq_s8[row * 8 + h] = ss;
}

__global__ void __launch_bounds__(256) k_xattn_naive(const bf16_t* __restrict__ QX, const bf16_t* __restrict__ KVM, bf16_t* __restrict__ OX) {
    __shared__ float qs[8][256]; __shared__ float ps[8][256];
    const int tg = blockIdx.x & 511, h = (blockIdx.x >> 9) & 3, b = blockIdx.x >> 11, j = threadIdx.x, lane = j & 63, wid = j >> 6;
    const size_t row0 = (size_t)b * SEQ + tg * 8;
    for (int i = 0; i < 8; ++i) qs[i][j] = bf2f(QX[(row0 + i) * D + h * XD + j]);
    __syncthreads();
    const bf16_t* kr = KVM + ((size_t)b * MEM + j) * 2048 + h * XD;
    float sc[8];
#pragma unroll
    for (int i = 0; i < 8; ++i) sc[i] = 0.f;
    for (int d = 0; d < XD; ++d) { const float kv = bf2f(kr[d]);
#pragma unroll
        for (int i = 0; i < 8; ++i) sc[i] += qs[i][d] * kv; }
#pragma unroll
    for (int i = 0; i < 8; ++i) ps[i][j] = sc[i];
    __syncthreads();
    for (int i = wid * 2; i < wid * 2 + 2; ++i) {
        float v0 = ps[i][lane], v1 = ps[i][lane + 64], v2 = ps[i][lane + 128], v3 = ps[i][lane + 192];
        float m = fmaxf(fmaxf(v0, v1), fmaxf(v2, v3));
#pragma unroll
        for (int o = 1; o < 64; o <<= 1) m = fmaxf(m, __shfl_xor(m, o));
        v0 = exp2f(v0 - m); v1 = exp2f(v1 - m); v2 = exp2f(v2 - m); v3 = exp2f(v3 - m);
        const float s = wave_sum(v0 + v1 + v2 + v3), inv = 1.f / s;
        ps[i][lane] = v0 * inv; ps[i][lane + 64] = v1 * inv; ps[i][lane + 128] = v2 * inv; ps[i][lane + 192] = v3 * inv;
    }
    __syncthreads();
    float o[8];
#pragma unroll
    for (int i = 0; i < 8; ++i) o[i] = 0.f;
    for (int m = 0; m < MEM; ++m) { const float vv = bf2f(KVM[((size_t)b * MEM + m) * 2048 + 1024 + h * XD + j]);
#pragma unroll
        for (int i = 0; i < 8; ++i) o[i] += ps[i][m] * vv; }
#pragma unroll
    for (int i = 0; i < 8; ++i) OX[(row0 + i) * D + h * XD + j] = (bf16_t)f2bf(o[i]);
}

__global__ void __launch_bounds__(256) k_router(const bf16_t* __restrict__ X2b, const float* __restrict__ rstd2, const float* __restrict__ g, const float* __restrict__ wgr, const float* __restrict__ bgr,
                                                const float* __restrict__ wer, const float* __restrict__ ber, float* __restrict__ selw, int* __restrict__ sele) {
    const int row = blockIdx.x * 4 + (threadIdx.x >> 6), lane = threadIdx.x & 63;
    float acc[20];
#pragma unroll
    for (int i = 0; i < 20; ++i) acc[i] = 0.f;
    const float rs = rstd2[row];
    for (int kk = 0; kk < 16; ++kk) { const int k = kk * 64 + lane; const float t = bf2f(X2b[(size_t)row * D + k]) * rs * g[k];
#pragma unroll
        for (int i = 0; i < 4; ++i) acc[i] += t * wgr[k * 4 + i];
#pragma unroll
        for (int gi = 0; gi < 4; ++gi)
#pragma unroll
            for (int e = 0; e < 4; ++e) acc[4 + gi * 4 + e] += t * wer[((size_t)gi * D + k) * 4 + e]; }
#pragma unroll
    for (int i = 0; i < 20; ++i) acc[i] = wave_sum(acc[i]);
    if (lane == 0) {
        float gl[4]; float gm = -INFINITY; int gi = 0;
#pragma unroll
        for (int i = 0; i < 4; ++i) { gl[i] = acc[i] + bgr[i]; if (gl[i] > gm) { gm = gl[i]; gi = i; } }
        float gs = 0.f;
#pragma unroll
        for (int i = 0; i < 4; ++i) gs += __expf(gl[i] - gm);
        const float gp = 1.f / gs;
        float el[4];
#pragma unroll
        for (int e = 0; e < 4; ++e) { float v = 0.f;
#pragma unroll
            for (int q = 0; q < 4; ++q) if (q == gi) v = acc[4 + q * 4 + e] + ber[q * 4 + e];
            el[e] = v; }
        int e1 = 0; float m1 = el[0];
#pragma unroll
        for (int e = 1; e < 4; ++e) if (el[e] > m1) { m1 = el[e]; e1 = e; }
        int e2 = -1; float m2 = -INFINITY;
#pragma unroll
        for (int e = 0; e < 4; ++e) if (e != e1 && el[e] > m2) { m2 = el[e]; e2 = e; }
        const float p2 = __expf(m2 - m1), w1 = gp / (1.f + p2), w2 = gp * p2 / (1.f + p2);
        selw[(size_t)row * 2] = w1; selw[(size_t)row * 2 + 1] = w2; sele[(size_t)row * 2] = gi * 4 + e1; sele[(size_t)row * 2 + 1] = gi * 4 + e2;
    }
}
__global__ void __launch_bounds__(256) k_moe_up_naive(const bf16_t* __restrict__ X2b, const float* __restrict__ rstd2, const float* __restrict__ g, const float* __restrict__ Wg, const float* __restrict__ Wu,
                                                      const float* __restrict__ selw, const int* __restrict__ sele, float* __restrict__ HIDn) {
    __shared__ float t[D];
    const int row = blockIdx.x >> 1, slot = blockIdx.x & 1, f = threadIdx.x;
    const float rs = rstd2[row];
    for (int k = f; k < D; k += 256) t[k] = bf2f(X2b[(size_t)row * D + k]) * rs * g[k];
    __syncthreads();
    const int e = sele[(size_t)row * 2 + slot]; const float w = selw[(size_t)row * 2 + slot];
    const float* wg = Wg + (size_t)e * D * DE + f; const float* wu = Wu + (size_t)e * D * DE + f;
    float ga = 0.f, ua = 0.f;
    for (int k = 0; k < D; ++k) { ga += t[k] * wg[(size_t)k * DE]; ua += t[k] * wu[(size_t)k * DE]; }
    HIDn[((size_t)row * 2 + slot) * DE + f] = ga * sigmoidf_(ga) * ua * w;
}
__global__ void __launch_bounds__(256) k_moe_down_naive(const float* __restrict__ HIDn, const float* __restrict__ Wd, const int* __restrict__ sele, const bf16_t* __restrict__ X2b, bf16_t* __restrict__ X3b) {
    __shared__ float hs[2 * DE];
    const int row = blockIdx.x, tid = threadIdx.x;
    hs[tid] = HIDn[(size_t)row * 2 * DE + tid]; hs[256 + tid] = HIDn[(size_t)row * 2 * DE + 256 + tid];
    __syncthreads();
    float o[4] = {0.f, 0.f, 0.f, 0.f};
    for (int s = 0; s < 2; ++s) { const float* wd = Wd + (size_t)sele[(size_t)row * 2 + s] * DE * D;
        for (int f = 0; f < DE; ++f) { const float hv = hs[s * DE + f];
#pragma unroll
            for (int i = 0; i < 4; ++i) o[i] += hv * wd[(size_t)f * D + i * 256 + tid]; } }
#pragma unroll
    for (int i = 0; i < 4; ++i) { const int c = i * 256 + tid; X3b[(size_t)row * D + c] = (bf16_t)f2bf(bf2f(X2b[(size_t)row * D + c]) + o[i]); }
}
__global__ void __launch_bounds__(256) k_final(const bf16_t* __restrict__ X3b, const float* __restrict__ g, float* __restrict__ out) {
    const int row = blockIdx.x * 4 + (threadIdx.x >> 6), lane = threadIdx.x & 63;
    float v[16]; float s = 0.f;
#pragma unroll
    for (int j = 0; j < 16; ++j) { v[j] = bf2f(X3b[(size_t)row * D + j * 64 + lane]); s += v[j] * v[j]; }
    s = wave_sum(s); const float r = 1.0f / sqrtf(s * (1.f / D) + EPS);
#pragma unroll
    for (int j = 0; j < 16; ++j) out[(size_t)row * D + j * 64 + lane] = v[j] * r * g[j * 64 + lane];
}

extern "C" void kernel_launch(void* const* d_in, const int* in_sizes, int n_in, void* d_out, int out_size, void* d_ws, size_t ws_size, hipStream_t stream) {
    if (n_in != 29 || ws_size < WS_END) { fprintf(stderr, "kernel_launch: unexpected inputs (%d) or workspace (%zu)\n", n_in, ws_size); return; }
    const float* x = (const float*)d_in[0]; const float* mem = (const float*)d_in[1]; const float* norm_mix = (const float*)d_in[2]; const float* w_in = (const float*)d_in[3];
    const float* conv_w = (const float*)d_in[4]; const float* conv_b = (const float*)d_in[5]; const float* lru_w_a = (const float*)d_in[6]; const float* lru_b_a = (const float*)d_in[7];
    const float* lru_w_x = (const float*)d_in[8]; const float* lru_b_x = (const float*)d_in[9]; const float* lru_lambda = (const float*)d_in[10];
    const float* norm_rnn = (const float*)d_in[11]; const float* norm_sb = (const float*)d_in[12]; const float* w_out = (const float*)d_in[13];
    const float* norm_xattn = (const float*)d_in[14]; const float* norm_mem = (const float*)d_in[15];
    const float* xa_w_q = (const float*)d_in[16]; const float* xa_w_k = (const float*)d_in[17]; const float* xa_w_v = (const float*)d_in[18]; const float* xa_w_o = (const float*)d_in[19];
    const float* norm_moe = (const float*)d_in[20]; const float* w_gr = (const float*)d_in[21]; const float* b_gr = (const float*)d_in[22]; const float* w_er = (const float*)d_in[23]; const float* b_er = (const float*)d_in[24];
    const float* w_gate = (const float*)d_in[25]; const float* w_up = (const float*)d_in[26]; const float* w_down = (const float*)d_in[27]; const float* norm_final = (const float*)d_in[28];
    unsigned char* ws = (unsigned char*)d_ws; float* out = (float*)d_out;
    float* sm = (float*)(ws + WS_SMALL);
    float* rstd0 = sm + SM_RSTD0; float* ssq_r = sm + SM_SSQR; float* ssq_s = sm + SM_SSQS; float* ssq1 = sm + SM_SSQ1; float* ssq2 = sm + SM_SSQ2;
    float* selw = sm + SM_SELW; int* sele = (int*)(sm + SM_SELE);
    float* fmid = sm + SM_END; float* fend = fmid + 32768; float* rstd1 = fend + 32768; float* rstd2 = rstd1 + 32768;
    bf16_t* Win_t = (bf16_t*)(ws + WS_WIN); bf16_t* Wout_t = (bf16_t*)(ws + WS_WOUT); bf16_t* Wq_t = (bf16_t*)(ws + WS_WQ); bf16_t* Wkv_t = (bf16_t*)(ws + WS_WKV); bf16_t* Wo_t = (bf16_t*)(ws + WS_WO);
    bf16_t* memn = (bf16_t*)(ws + WS_MEMN); bf16_t* KVM = (bf16_t*)(ws + WS_KVM);
    bf16_t* xb = (bf16_t*)(ws + WS_R0); bf16_t* X1b = xb; bf16_t* X3b = xb;
    bf16_t* XR = (bf16_t*)(ws + WS_R1); bf16_t* GG = XR + (size_t)NTOK * RW; bf16_t* QX = XR;
    bf16_t* Qs = (bf16_t*)(ws + WS_R2); bf16_t* Ks = Qs + (size_t)NTOK * SBW; bf16_t* OX = Qs;
    bf16_t* Vs = (bf16_t*)(ws + WS_R3);
    bf16_t* YY = (bf16_t*)(ws + WS_R4); bf16_t* X2b = YY;
    float* HIDn = (float*)(ws + WS_R5);

    k_prep_x<<<NTOK / 4, 256, 0, stream>>>(x, xb, rstd0);
    k_prep_mem<<<NMEM / 4, 256, 0, stream>>>(mem, norm_mem, memn);
    k_transpose_w<<<dim3(PROJ / 32, D / 32, 1), 256, 0, stream>>>(w_in, D, PROJ, Win_t, norm_mix, norm_mix, D);
    k_transpose_w<<<dim3(D / 32, D / 32, 1), 256, 0, stream>>>(w_out, D, D, Wout_t, norm_rnn, norm_sb, RW);
    k_transpose_w<<<dim3(D / 32, D / 32, 1), 256, 0, stream>>>(xa_w_q, D, D, Wq_t, norm_xattn, norm_xattn, D);
    k_transpose_w<<<dim3(D / 32, D / 32, 1), 256, 0, stream>>>(xa_w_k, D, D, Wkv_t, nullptr, nullptr, 0);
    k_transpose_w<<<dim3(D / 32, D / 32, 1), 256, 0, stream>>>(xa_w_v, D, D, Wkv_t + (size_t)D * D, nullptr, nullptr, 0);
    k_transpose_w<<<dim3(D / 32, D / 32, 1), 256, 0, stream>>>(xa_w_o, D, D, Wo_t, nullptr, nullptr, 0);
    k_gemm<EpiInProj><<<dim3(PROJ / 64, NTOK / 64), 256, 0, stream>>>(xb, D, Win_t, D, D, MidScale{nullptr, 0, 0}, EpiInProj{rstd0, XR, GG, Qs, Ks, Vs});
    k_gemm<EpiStoreBf16><<<dim3(2048 / 64, NMEM / 64), 256, 0, stream>>>(memn, D, Wkv_t, D, D, MidScale{nullptr, 0, 0}, EpiStoreBf16{KVM, nullptr, 2048, 1.f});
    k_sb_naive<<<BATCH * NH * 64, 64, 0, stream>>>(Qs, Ks, Vs, YY, ssq_s);
    k_lru_naive<<<BATCH * NH, 64, 0, stream>>>(XR, GG, conv_w, conv_b, lru_w_a, lru_b_a, lru_w_x, lru_b_x, lru_lambda, YY);
    k_rowssq<<<NTOK / 4, 256, 0, stream>>>(YY, D, 0, RW, ssq_r, 1);
    k_mixscales<<<NTOK / 256, 256, 0, stream>>>(ssq_r, ssq_s, fmid, fend);
    k_gemm<EpiResF32><<<dim3(D / 64, NTOK / 64), 256, 0, stream>>>(YY, D, Wout_t, D, D, MidScale{fmid, RW, 0}, EpiResF32{x, fend, X1b});
    k_rowssq<<<NTOK / 4, 256, 0, stream>>>(X1b, D, 0, D, ssq1, 16);
    k_rstd16<<<NTOK / 256, 256, 0, stream>>>(ssq1, rstd1);
    k_gemm<EpiStoreBf16><<<dim3(D / 64, NTOK / 64), 256, 0, stream>>>(X1b, D, Wq_t, D, D, MidScale{nullptr, 0, 0}, EpiStoreBf16{QX, rstd1, D, 0.0625f * LOG2E});
    k_xattn_naive<<<BATCH * XH * 512, 256, 0, stream>>>(QX, KVM, OX);
    k_gemm<EpiResBf16><<<dim3(D / 64, NTOK / 64), 256, 0, stream>>>(OX, D, Wo_t, D, D, MidScale{nullptr, 0, 0}, EpiResBf16{X1b, X2b});
    k_rowssq<<<NTOK / 4, 256, 0, stream>>>(X2b, D, 0, D, ssq2, 16);
    k_rstd16<<<NTOK / 256, 256, 0, stream>>>(ssq2, rstd2);
    k_router<<<NTOK / 4, 256, 0, stream>>>(X2b, rstd2, norm_moe, w_gr, b_gr, w_er, b_er, selw, sele);
    k_moe_up_naive<<<NTOK * 2, 256, 0, stream>>>(X2b, rstd2, norm_moe, w_gate, w_up, selw, sele, HIDn);
    k_moe_down_naive<<<NTOK, 256, 0, stream>>>(HIDn, w_down, sele, X2b, X3b);
    k_final<<<NTOK / 4, 256, 0, stream>>>(X3b, norm_final, out);
}
```

```cpp
#include <hip/hip_runtime.h>
#include <hip/hip_cooperative_groups.h>
#include <cstdio>
#include <cstdint>

typedef unsigned short bf16_t;
typedef short bf16x8 __attribute__((ext_vector_type(8)));
typedef float f32x4 __attribute__((ext_vector_type(4)));
typedef unsigned u32x4 __attribute__((ext_vector_type(4)));

constexpr int D = 1024, BATCH = 8, SEQ = 4096, NTOK = BATCH * SEQ, MEM = 256, NMEM = BATCH * MEM;
constexpr int RW = 512, SBW = 512, PROJ = 2560, NH = 8, HD = 64;
constexpr int XH = 4, XD = 256, NG = 4, EPG = 4, NEXP = 16, DE = 256;
constexpr float EPS = 1e-6f, LOG2E = 1.4426950408889634f;

constexpr size_t MiB = 1u << 20;
constexpr size_t WS_CTL = 0;
constexpr size_t WS_SMALL = 1 * MiB;
constexpr size_t WS_WIN = 16 * MiB;
constexpr size_t WS_WOUT = 21 * MiB;
constexpr size_t WS_WQ = 23 * MiB;
constexpr size_t WS_WKV = 25 * MiB;
constexpr size_t WS_WO = 29 * MiB;
constexpr size_t WS_MEMN = 31 * MiB;
constexpr size_t WS_KVM = 35 * MiB;
constexpr size_t WS_WG = 43 * MiB;
constexpr size_t WS_WU = 51 * MiB;
constexpr size_t WS_WD2 = 59 * MiB;
constexpr size_t WS_R0 = 96 * MiB;
constexpr size_t WS_R1 = 160 * MiB;
constexpr size_t WS_R2 = 224 * MiB;
constexpr size_t WS_R3 = 288 * MiB;
constexpr size_t WS_R4 = 320 * MiB;
constexpr size_t WS_R5 = 384 * MiB;
constexpr size_t WS_END = 448 * MiB;

constexpr size_t SM_RSTD0 = 0;
constexpr size_t SM_SSQR = 1 * 32768;
constexpr size_t SM_SSQS = 2 * 32768;
constexpr size_t SM_SSQ1 = 10 * 32768;
constexpr size_t SM_SSQ2 = 26 * 32768;
constexpr size_t SM_SSQ3 = 42 * 32768;
constexpr size_t SM_SELW = 58 * 32768;
constexpr size_t SM_SELE = 60 * 32768;
constexpr size_t SM_END = 62 * 32768;

__device__ __forceinline__ unsigned f2bf(float f) { unsigned u = __builtin_bit_cast(unsigned, f); return (u + 0x7fffu + ((u >> 16) & 1u)) >> 16; }
__device__ __forceinline__ float bf2f(unsigned short h) { return __builtin_bit_cast(float, (unsigned)h << 16); }
__device__ __forceinline__ float wave_sum(float v) {
#pragma unroll
    for (int o = 1; o < 64; o <<= 1) v += __shfl_xor(v, o);
    return v;
}
__device__ __forceinline__ float gelu_tanh(float x) { const float u = 0.7978845608028654f * (x + 0.044715f * x * x * x); return x / (1.f + __expf(-2.f * u)); }
__device__ __forceinline__ float sigmoidf_(float x) { return 1.f / (1.f + __expf(-x)); }

namespace cg = cooperative_groups;
#define LAS __attribute__((address_space(3)))
constexpr int NWAVES = 8, NTHREADS = 512;
constexpr int LDS_BYTES = 147456;

struct Args { const float* in[29]; float* out; unsigned char* ws; };

struct Ctx {
    const float* in[29]; float* out; unsigned char* ws; unsigned char* lds;
    int tid, lane, wave, gw, NGW, G, bid;
};

__device__ __forceinline__ void row_prep_x(const float* x, bf16_t* xb, float* rstd0, int row, int lane) {
    const f32x4* xr = (const f32x4*)(x + (size_t)row * D) + lane;
    float s = 0.f; f32x4 v[4];
#pragma unroll
    for (int j = 0; j < 4; ++j) { v[j] = xr[64 * j]; s += v[j].x * v[j].x + v[j].y * v[j].y + v[j].z * v[j].z + v[j].w * v[j].w; }
    s = wave_sum(s);
    if (lane == 0) rstd0[row] = 1.0f / sqrtf(s * (1.f / D) + EPS);
    unsigned long long* o8 = (unsigned long long*)(xb + (size_t)row * D) + lane;
#pragma unroll
    for (int j = 0; j < 4; ++j) o8[64 * j] = (unsigned long long)(f2bf(v[j].x) | (f2bf(v[j].y) << 16)) | ((unsigned long long)(f2bf(v[j].z) | (f2bf(v[j].w) << 16)) << 32);
}
__device__ __forceinline__ void row_prep_mem(const float* m, const float* g, bf16_t* o, int row, int lane) {
    const f32x4* xr = (const f32x4*)(m + (size_t)row * D) + lane;
    float s = 0.f; f32x4 v[4];
#pragma unroll
    for (int j = 0; j < 4; ++j) { v[j] = xr[64 * j]; s += v[j].x * v[j].x + v[j].y * v[j].y + v[j].z * v[j].z + v[j].w * v[j].w; }
    s = wave_sum(s);
    const float r = 1.0f / sqrtf(s * (1.f / D) + EPS);
    unsigned long long* o8 = (unsigned long long*)(o + (size_t)row * D) + lane;
#pragma unroll
    for (int j = 0; j < 4; ++j) { const f32x4 gg = ((const f32x4*)g)[64 * j + lane];
        o8[64 * j] = (unsigned long long)(f2bf(v[j].x * r * gg.x) | (f2bf(v[j].y * r * gg.y) << 16)) | ((unsigned long long)(f2bf(v[j].z * r * gg.z) | (f2bf(v[j].w * r * gg.w) << 16)) << 32); }
}
__device__ __forceinline__ void transpose_item(const float* W, int K, int N, bf16_t* Wt, int ldt, const float* g0, const float* g1, int ksplit, LAS float* scr, int item, int lane) {
    const int nblk = N / 32, kb = item / nblk, nb = item % nblk, k0 = 64 * kb, n0 = 32 * nb;
#pragma unroll 8
    for (int i = 0; i < 32; ++i) { const int kk = 2 * i + (lane >> 5), k = k0 + kk; float gv = 1.f; if (g0) gv = (k < ksplit) ? g0[k] : g1[k - ksplit];
        scr[kk * 33 + (lane & 31)] = W[(size_t)k * N + n0 + (lane & 31)] * gv; }
    asm volatile("s_waitcnt lgkmcnt(0)" ::: "memory");
    const int c = lane & 7;
#pragma unroll
    for (int j = 0; j < 4; ++j) { const int n = (lane >> 3) + 8 * j; const LAS float* s = scr + (8 * c) * 33 + n;
        u32x4 o; o.x = f2bf(s[0 * 33]) | (f2bf(s[1 * 33]) << 16); o.y = f2bf(s[2 * 33]) | (f2bf(s[3 * 33]) << 16); o.z = f2bf(s[4 * 33]) | (f2bf(s[5 * 33]) << 16); o.w = f2bf(s[6 * 33]) | (f2bf(s[7 * 33]) << 16);
        *(u32x4*)(Wt + (size_t)(n0 + n) * ldt + k0 + 8 * c) = o; }
    asm volatile("s_waitcnt lgkmcnt(0)" ::: "memory");
}

struct MidScale { const float* f; int k; int pad; };
template <class Epi>
__device__ __forceinline__ void gemm_naive(const Ctx& C, const bf16_t* A, int lda, const bf16_t* Bt, int ldb, int M, int N, int K, MidScale ms, const Epi& E) {
    const int lane = C.lane, fr = lane & 15, fq = lane >> 4, ncol = N / 64, ntile = (M / 16) * ncol;
    for (int t = C.gw; t < ntile; t += C.NGW) {
        const int row0 = (t / ncol) * 16, col0 = (t % ncol) * 64;
        const bf16_t* ap = A + (size_t)(row0 + fr) * lda + fq * 8;
        const bf16_t* bp = Bt + (size_t)(col0 + fr) * ldb + fq * 8;
        f32x4 acc[4];
#pragma unroll
        for (int n = 0; n < 4; ++n) acc[n] = (f32x4){0.f, 0.f, 0.f, 0.f};
        for (int k0 = 0; k0 < K; k0 += 32) {
            if (ms.f && k0 == ms.k) {
#pragma unroll
                for (int j = 0; j < 4; ++j) { const float f = ms.f[row0 + fq * 4 + j];
#pragma unroll
                    for (int n = 0; n < 4; ++n) acc[n][j] *= f; }
            }
            const bf16x8 a = *(const bf16x8*)(ap + k0);
#pragma unroll
            for (int n = 0; n < 4; ++n) { const bf16x8 b = *(const bf16x8*)(bp + (size_t)n * 16 * ldb + k0); acc[n] = __builtin_amdgcn_mfma_f32_16x16x32_bf16(a, b, acc[n], 0, 0, 0); }
        }
#pragma unroll
        for (int n = 0; n < 4; ++n)
#pragma unroll
            for (int j = 0; j < 4; ++j) E(row0 + fq * 4 + j, col0 + n * 16 + fr, acc[n][j]);
    }
}
struct EpiInProj { const float* rstd0; bf16_t *XR, *GG, *Qs, *Ks, *Vs;
    __device__ void operator()(int r, int c, float v) const { v *= rstd0[r]; const int t = c >> 9, cc = c & 511;
        if (t == 0) XR[(size_t)r * RW + cc] = (bf16_t)f2bf(v);
        else if (t == 1) GG[(size_t)r * RW + cc] = (bf16_t)f2bf(gelu_tanh(v));
        else if (t == 2) Qs[(size_t)r * SBW + cc] = (bf16_t)f2bf(v * (0.125f * LOG2E));
        else if (t == 3) Ks[(size_t)r * SBW + cc] = (bf16_t)f2bf(v);
        else Vs[(size_t)r * SBW + cc] = (bf16_t)f2bf(v); } };
struct EpiStoreBf16 { bf16_t* O; const float* rowscale; int ldo; float scale;
    __device__ void operator()(int r, int c, float v) const { O[(size_t)r * ldo + c] = (bf16_t)f2bf(v * (rowscale ? rowscale[r] : 1.f) * scale); } };
struct EpiResF32 { const float* base; const float* rowscale; bf16_t* O;
    __device__ void operator()(int r, int c, float v) const { O[(size_t)r * D + c] = (bf16_t)f2bf(base[(size_t)r * D + c] + v * rowscale[r]); } };
struct EpiResBf16 { const bf16_t* base; bf16_t* O;
    __device__ void operator()(int r, int c, float v) const { O[(size_t)r * D + c] = (bf16_t)f2bf(bf2f(base[(size_t)r * D + c]) + v); } };

__device__ __forceinline__ void lru_naive_unit(int unit, int j, LAS float* xs, const bf16_t* XR, const bf16_t* GG, const float* conv_w, const float* conv_b,
                                               const float* w_a, const float* b_a, const float* w_x, const float* b_x, const float* lam, bf16_t* YY) {
    const int b = unit >> 3, h = unit & 7, c = h * 64 + j;
    float wa[64], wx[64];
#pragma unroll
    for (int i = 0; i < 64; ++i) { wa[i] = w_a[(size_t)(h * 64 + i) * 64 + j]; wx[i] = w_x[(size_t)(h * 64 + i) * 64 + j]; }
    const float ba = b_a[c], bx = b_x[c], cw0 = conv_w[c], cw1 = conv_w[RW + c], cw2 = conv_w[2 * RW + c], cw3 = conv_w[3 * RW + c], cb = conv_b[c];
    const float l = lam[c], spl = (l > 15.f) ? __expf(-l) : log1pf(__expf(-l));
    float x0 = 0.f, x1 = 0.f, x2 = 0.f, hst = 0.f;
    for (int t = 0; t < SEQ; ++t) {
        const size_t row = (size_t)b * SEQ + t;
        const float x3 = bf2f(XR[row * RW + c]);
        const float xc = cw0 * x0 + cw1 * x1 + cw2 * x2 + cw3 * x3 + cb;
        x0 = x1; x1 = x2; x2 = x3;
        asm volatile("s_waitcnt lgkmcnt(0)" ::: "memory"); xs[j] = xc; asm volatile("s_waitcnt lgkmcnt(0)" ::: "memory");
        float ra = ba, ri = bx;
#pragma unroll
        for (int i = 0; i < 64; ++i) { const float xv = xs[i]; ra += xv * wa[i]; ri += xv * wx[i]; }
        const float r = sigmoidf_(ra), ig = sigmoidf_(ri);
        const float log_a = -8.0f * r * spl, a = __expf(log_a), bb = sqrtf(fmaxf(0.f, -expm1f(2.f * log_a))) * (ig * xc);
        hst = a * hst + bb;
        YY[row * D + c] = (bf16_t)f2bf(hst * bf2f(GG[row * RW + c]));
    }
}
__device__ __forceinline__ void sb_naive_unit(int unit, int lane, const bf16_t* Qs, const bf16_t* Ks, const bf16_t* Vs, bf16_t* YY, float* ssq_s8) {
    const int qb = unit & 63, h = (unit >> 6) & 7, b = unit >> 9;
    const int t = qb * 64 + lane; const size_t row = (size_t)b * SEQ + t;
    float q[64], o[64];
#pragma unroll
    for (int d = 0; d < 64; ++d) { q[d] = bf2f(Qs[row * SBW + h * 64 + d]); o[d] = 0.f; }
    float R = 0.f;
    for (int s = qb * 64 + 62; s >= 0; --s) {
        const bf16_t* kr = Ks + ((size_t)b * SEQ + s) * SBW + h * 64; const bf16_t* vr = Vs + ((size_t)b * SEQ + s) * SBW + h * 64;
        float z = 0.f;
#pragma unroll
        for (int d = 0; d < 64; ++d) z += q[d] * bf2f(kr[d]);
        const bool valid = s < t;
        const float sp = valid ? (fmaxf(z, 0.f) + __log2f(1.f + exp2f(-fabsf(z)))) : 0.f;
        const float w = valid ? exp2f(z - (R + sp)) : 0.f;
        R += sp;
        const float wb = bf2f((bf16_t)f2bf(w));
#pragma unroll
        for (int d = 0; d < 64; ++d) o[d] += wb * bf2f(vr[d]);
    }
    float ss = 0.f;
#pragma unroll
    for (int d = 0; d < 64; ++d) { ss += o[d] * o[d]; YY[row * D + RW + h * 64 + d] = (bf16_t)f2bf(o[d]); }
    ssq_s8[row * 8 + h] = ss;
}
__device__ __forceinline__ void xattn_naive_unit(int unit, int j, LAS float* qs, LAS float* ps, const bf16_t* QX, const bf16_t* KVM, bf16_t* OX) {
    const int tg = unit & 511, h = (unit >> 9) & 3, b = unit >> 11, lane = j & 63, wid = j >> 6;
    const size_t row0 = (size_t)b * SEQ + tg * 8;
    for (int i = 0; i < 8; ++i) qs[i * 256 + j] = bf2f(QX[(row0 + i) * D + h * XD + j]);
    __syncthreads();
    const bf16_t* kr = KVM + ((size_t)b * MEM + j) * 2048 + h * XD;
    float sc[8];
#pragma unroll
    for (int i = 0; i < 8; ++i) sc[i] = 0.f;
    for (int d = 0; d < XD; ++d) { const float kv = bf2f(kr[d]);
#pragma unroll
        for (int i = 0; i < 8; ++i) sc[i] += qs[i * 256 + d] * kv; }
#pragma unroll
    for (int i = 0; i < 8; ++i) ps[i * 256 + j] = sc[i];
    __syncthreads();
    for (int i = wid * 2; i < wid * 2 + 2; ++i) {
        float v0 = ps[i * 256 + lane], v1 = ps[i * 256 + lane + 64], v2 = ps[i * 256 + lane + 128], v3 = ps[i * 256 + lane + 192];
        float m = fmaxf(fmaxf(v0, v1), fmaxf(v2, v3));
#pragma unroll
        for (int o = 1; o < 64; o <<= 1) m = fmaxf(m, __shfl_xor(m, o));
        v0 = exp2f(v0 - m); v1 = exp2f(v1 - m); v2 = exp2f(v2 - m); v3 = exp2f(v3 - m);
        const float s = wave_sum(v0 + v1 + v2 + v3), inv = 1.f / s;
        ps[i * 256 + lane] = v0 * inv; ps[i * 256 + lane + 64] = v1 * inv; ps[i * 256 + lane + 128] = v2 * inv; ps[i * 256 + lane + 192] = v3 * inv;
    }
    __syncthreads();
    float o[8];
#pragma unroll
    for (int i = 0; i < 8; ++i) o[i] = 0.f;
    for (int m = 0; m < MEM; ++m) { const float vv = bf2f(KVM[((size_t)b * MEM + m) * 2048 + 1024 + h * XD + j]);
#pragma unroll
        for (int i = 0; i < 8; ++i) o[i] += ps[i * 256 + m] * vv; }
#pragma unroll
    for (int i = 0; i < 8; ++i) OX[(row0 + i) * D + h * XD + j] = (bf16_t)f2bf(o[i]);
    __syncthreads();
}
__device__ __forceinline__ void router_row(int row, int lane, const bf16_t* X2b, const float* rstd2, const float* g, const float* wgr, const float* bgr, const float* wer, const float* ber, float* selw, int* sele) {
    float acc[20];
#pragma unroll
    for (int i = 0; i < 20; ++i) acc[i] = 0.f;
    const float rs = rstd2[row];
    for (int kk = 0; kk < 16; ++kk) { const int k = kk * 64 + lane; const float t = bf2f(X2b[(size_t)row * D + k]) * rs * g[k];
#pragma unroll
        for (int i = 0; i < 4; ++i) acc[i] += t * wgr[k * 4 + i];
#pragma unroll
        for (int gi = 0; gi < 4; ++gi)
#pragma unroll
            for (int e = 0; e < 4; ++e) acc[4 + gi * 4 + e] += t * wer[((size_t)gi * D + k) * 4 + e]; }
#pragma unroll
    for (int i = 0; i < 20; ++i) acc[i] = wave_sum(acc[i]);
    if (lane == 0) {
        float gl[4]; float gm = -INFINITY; int gi = 0;
#pragma unroll
        for (int i = 0; i < 4; ++i) { gl[i] = acc[i] + bgr[i]; if (gl[i] > gm) { gm = gl[i]; gi = i; } }
        float gs = 0.f;
#pragma unroll
        for (int i = 0; i < 4; ++i) gs += __expf(gl[i] - gm);
        const float gp = 1.f / gs;
        float el[4];
#pragma unroll
        for (int e = 0; e < 4; ++e) { float v = 0.f;
#pragma unroll
            for (int q = 0; q < 4; ++q) if (q == gi) v = acc[4 + q * 4 + e] + ber[q * 4 + e];
            el[e] = v; }
        int e1 = 0; float m1 = el[0];
#pragma unroll
        for (int e = 1; e < 4; ++e) if (el[e] > m1) { m1 = el[e]; e1 = e; }
        int e2 = -1; float m2 = -INFINITY;
#pragma unroll
        for (int e = 0; e < 4; ++e) if (e != e1 && el[e] > m2) { m2 = el[e]; e2 = e; }
        const float p2 = __expf(m2 - m1), w1 = gp / (1.f + p2), w2 = gp * p2 / (1.f + p2);
        selw[(size_t)row * 2] = w1; selw[(size_t)row * 2 + 1] = w2; sele[(size_t)row * 2] = gi * 4 + e1; sele[(size_t)row * 2 + 1] = gi * 4 + e2;
    }
}
__device__ __forceinline__ void final_row(int row, int lane, const bf16_t* X3b, const float* g, float* out) {
    float v[16]; float s = 0.f;
#pragma unroll
    for (int j = 0; j < 16; ++j) { v[j] = bf2f(X3b[(size_t)row * D + j * 64 + lane]); s += v[j] * v[j]; }
    s = wave_sum(s); const float r = 1.0f / sqrtf(s * (1.f / D) + EPS);
#pragma unroll
    for (int j = 0; j < 16; ++j) out[(size_t)row * D + j * 64 + lane] = v[j] * r * g[j * 64 + lane];
}

__global__ void __launch_bounds__(NTHREADS, 2) mk_fwd(Args args) {
    extern __shared__ __attribute__((aligned(16))) unsigned char lds[];
    cg::grid_group grid = cg::this_grid();
    Ctx C;
#pragma unroll
    for (int i = 0; i < 29; ++i) C.in[i] = args.in[i];
    C.out = args.out; C.ws = args.ws; C.lds = lds;
    C.tid = threadIdx.x; C.lane = C.tid & 63; C.wave = __builtin_amdgcn_readfirstlane(C.tid >> 6);
    C.G = gridDim.x; C.bid = blockIdx.x; C.gw = C.bid * NWAVES + C.wave; C.NGW = C.G * NWAVES;
    const float* x = C.in[0]; const float* mem = C.in[1]; const float* norm_mix = C.in[2]; const float* w_in = C.in[3];
    const float* conv_w = C.in[4]; const float* conv_b = C.in[5]; const float* lru_w_a = C.in[6]; const float* lru_b_a = C.in[7];
    const float* lru_w_x = C.in[8]; const float* lru_b_x = C.in[9]; const float* lru_lambda = C.in[10];
    const float* norm_rnn = C.in[11]; const float* norm_sb = C.in[12]; const float* w_out = C.in[13];
    const float* norm_xattn = C.in[14]; const float* norm_mem = C.in[15];
    const float* xa_w_q = C.in[16]; const float* xa_w_k = C.in[17]; const float* xa_w_v = C.in[18]; const float* xa_w_o = C.in[19];
    const float* norm_moe = C.in[20]; const float* w_gr = C.in[21]; const float* b_gr = C.in[22]; const float* w_er = C.in[23]; const float* b_er = C.in[24];
    const float* w_gate = C.in[25]; const float* w_up = C.in[26]; const float* w_down = C.in[27]; const float* norm_final = C.in[28];
    unsigned char* ws = C.ws; float* out = C.out;
    float* sm = (float*)(ws + WS_SMALL);
    float* rstd0 = sm + SM_RSTD0; float* ssq_s = sm + SM_SSQS;
    float* selw = sm + SM_SELW; int* sele = (int*)(sm + SM_SELE);
    float* fmid = sm + SM_END; float* fend = fmid + 32768; float* rstd1 = fend + 32768; float* rstd2 = rstd1 + 32768;
    bf16_t* Win_t = (bf16_t*)(ws + WS_WIN); bf16_t* Wout_t = (bf16_t*)(ws + WS_WOUT); bf16_t* Wq_t = (bf16_t*)(ws + WS_WQ); bf16_t* Wkv_t = (bf16_t*)(ws + WS_WKV); bf16_t* Wo_t = (bf16_t*)(ws + WS_WO);
    bf16_t* memn = (bf16_t*)(ws + WS_MEMN); bf16_t* KVM = (bf16_t*)(ws + WS_KVM);
    bf16_t* xb = (bf16_t*)(ws + WS_R0); bf16_t* X1b = xb; bf16_t* X3b = xb;
    bf16_t* XR = (bf16_t*)(ws + WS_R1); bf16_t* GG = XR + (size_t)NTOK * RW; bf16_t* QX = XR;
    bf16_t* Qs = (bf16_t*)(ws + WS_R2); bf16_t* Ks = Qs + (size_t)NTOK * SBW; bf16_t* OX = Qs;
    bf16_t* Vs = (bf16_t*)(ws + WS_R3);
    bf16_t* YY = (bf16_t*)(ws + WS_R4); bf16_t* X2b = YY;
    float* HIDn = (float*)(ws + WS_R5);
    const int gw = C.gw, NGW = C.NGW, lane = C.lane;
#define GRID_SYNC() grid.sync()

    {
        for (int r = gw; r < NTOK; r += NGW) row_prep_x(x, xb, rstd0, r, lane);
        for (int r = gw; r < NMEM; r += NGW) row_prep_mem(mem, norm_mem, memn, r, lane);
        LAS float* scr = (LAS float*)(lds) + C.wave * (64 * 33);
        constexpr int I_IN = (D / 64) * (PROJ / 32), I_SQ = (D / 64) * (D / 32);
        for (int it = gw; it < I_IN + 5 * I_SQ; it += NGW) {
            int r = it;
            if (r < I_IN) { transpose_item(w_in, D, PROJ, Win_t, D, norm_mix, norm_mix, D, scr, r, lane); continue; } r -= I_IN;
            if (r < I_SQ) { transpose_item(w_out, D, D, Wout_t, D, norm_rnn, norm_sb, RW, scr, r, lane); continue; } r -= I_SQ;
            if (r < I_SQ) { transpose_item(xa_w_q, D, D, Wq_t, D, norm_xattn, norm_xattn, D, scr, r, lane); continue; } r -= I_SQ;
            if (r < I_SQ) { transpose_item(xa_w_k, D, D, Wkv_t, D, nullptr, nullptr, 0, scr, r, lane); continue; } r -= I_SQ;
            if (r < I_SQ) { transpose_item(xa_w_v, D, D, Wkv_t + (size_t)D * D, D, nullptr, nullptr, 0, scr, r, lane); continue; } r -= I_SQ;
            transpose_item(xa_w_o, D, D, Wo_t, D, nullptr, nullptr, 0, scr, r, lane);
        }
    }
    GRID_SYNC();
    gemm_naive(C, xb, D, Win_t, D, NTOK, PROJ, D, MidScale{nullptr, 0, 0}, EpiInProj{rstd0, XR, GG, Qs, Ks, Vs});
    gemm_naive(C, memn, D, Wkv_t, D, NMEM, 2048, D, MidScale{nullptr, 0, 0}, EpiStoreBf16{KVM, nullptr, 2048, 1.f});
    GRID_SYNC();
    {
        LAS float* xs = (LAS float*)(lds) + C.wave * 64;
        if (gw < BATCH * NH) lru_naive_unit(gw, lane, xs, XR, GG, conv_w, conv_b, lru_w_a, lru_b_a, lru_w_x, lru_b_x, lru_lambda, YY);
        for (int u = gw; u < BATCH * NH * 64; u += NGW) { const int uu = BATCH * NH * 64 - 1 - u; sb_naive_unit(uu, lane, Qs, Ks, Vs, YY, ssq_s); }
    }
    GRID_SYNC();
    for (int r = gw; r < NTOK; r += NGW) {
        float s = 0.f;
        for (int c = lane; c < RW; c += 64) { const float v = bf2f(YY[(size_t)r * D + c]); s += v * v; }
        s = wave_sum(s);
        if (lane == 0) { float s2 = 0.f;
#pragma unroll
            for (int i = 0; i < 8; ++i) s2 += ssq_s[(size_t)r * 8 + i];
            const float rr = 1.0f / sqrtf(s * (1.f / RW) + EPS), rs = 1.0f / sqrtf(s2 * (1.f / SBW) + EPS); fmid[r] = rr / rs; fend[r] = rs; }
    }
    GRID_SYNC();
    gemm_naive(C, YY, D, Wout_t, D, NTOK, D, D, MidScale{fmid, RW, 0}, EpiResF32{x, fend, X1b});
    GRID_SYNC();
    for (int r = gw; r < NTOK; r += NGW) { float s = 0.f;
        for (int c = lane; c < D; c += 64) { const float v = bf2f(X1b[(size_t)r * D + c]); s += v * v; }
        s = wave_sum(s); if (lane == 0) rstd1[r] = 1.0f / sqrtf(s * (1.f / D) + EPS); }
    GRID_SYNC();
    gemm_naive(C, X1b, D, Wq_t, D, NTOK, D, D, MidScale{nullptr, 0, 0}, EpiStoreBf16{QX, rstd1, D, 0.0625f * LOG2E});
    GRID_SYNC();
    {
        const int half = C.tid >> 8, j = C.tid & 255;
        LAS float* qs = (LAS float*)(lds) + half * 4096; LAS float* ps = qs + 2048;
        for (int u = C.bid * 2; u < BATCH * XH * 512; u += C.G * 2) xattn_naive_unit(u + half, j, qs, ps, QX, KVM, OX);
    }
    GRID_SYNC();
    gemm_naive(C, OX, D, Wo_t, D, NTOK, D, D, MidScale{nullptr, 0, 0}, EpiResBf16{X1b, X2b});
    GRID_SYNC();
    for (int r = gw; r < NTOK; r += NGW) { float s = 0.f;
        for (int c = lane; c < D; c += 64) { const float v = bf2f(X2b[(size_t)r * D + c]); s += v * v; }
        s = wave_sum(s); if (lane == 0) rstd2[r] = 1.0f / sqrtf(s * (1.f / D) + EPS); }
    GRID_SYNC();
    for (int r = gw; r < NTOK; r += NGW) router_row(r, lane, X2b, rstd2, norm_moe, w_gr, b_gr, w_er, b_er, selw, sele);
    GRID_SYNC();
    {
        LAS float* t = (LAS float*)lds;
        const int slot = C.tid >> 8, f = C.tid & 255;
        for (int row = C.bid; row < NTOK; row += C.G) {
            const float rs = rstd2[row];
            for (int k = C.tid; k < D; k += NTHREADS) t[k] = bf2f(X2b[(size_t)row * D + k]) * rs * norm_moe[k];
            __syncthreads();
            const int e = sele[(size_t)row * 2 + slot]; const float w = selw[(size_t)row * 2 + slot];
            const float* wg = w_gate + (size_t)e * D * DE + f; const float* wu = w_up + (size_t)e * D * DE + f;
            float ga = 0.f, ua = 0.f;
            for (int k = 0; k < D; ++k) { ga += t[k] * wg[(size_t)k * DE]; ua += t[k] * wu[(size_t)k * DE]; }
            HIDn[((size_t)row * 2 + slot) * DE + f] = ga * sigmoidf_(ga) * ua * w;
            __syncthreads();
        }
    }
    GRID_SYNC();
    {
        LAS float* hs = (LAS float*)lds;
        for (int row = C.bid; row < NTOK; row += C.G) {
            hs[C.tid] = HIDn[(size_t)row * 2 * DE + C.tid];
            __syncthreads();
            float o0 = 0.f, o1 = 0.f;
            for (int s = 0; s < 2; ++s) { const float* wd = w_down + (size_t)sele[(size_t)row * 2 + s] * DE * D;
                for (int f = 0; f < DE; ++f) { const float hv = hs[s * DE + f]; o0 += hv * wd[(size_t)f * D + C.tid]; o1 += hv * wd[(size_t)f * D + 512 + C.tid]; } }
            X3b[(size_t)row * D + C.tid] = (bf16_t)f2bf(bf2f(X2b[(size_t)row * D + C.tid]) + o0);
            X3b[(size_t)row * D + 512 + C.tid] = (bf16_t)f2bf(bf2f(X2b[(size_t)row * D + 512 + C.tid]) + o1);
            __syncthreads();
        }
    }
    GRID_SYNC();
    for (int r = gw; r < NTOK; r += NGW) final_row(r, lane, X3b, norm_final, out);
}

extern "C" void kernel_launch(void* const* d_in, const int* in_sizes, int n_in, void* d_out, int out_size, void* d_ws, size_t ws_size, hipStream_t stream) {
    static int grid = 0;
    if (grid == 0) {
        if (n_in != 29 || ws_size < WS_END) { fprintf(stderr, "kernel_launch: unexpected inputs (%d) or workspace (%zu)\n", n_in, ws_size); grid = -1; return; }
        int dev = 0, cus = 0, per_cu = 0;
        hipGetDevice(&dev); hipDeviceGetAttribute(&cus, hipDeviceAttributeMultiprocessorCount, dev);
        hipFuncSetAttribute((const void*)mk_fwd, hipFuncAttributeMaxDynamicSharedMemorySize, LDS_BYTES);
        hipOccupancyMaxActiveBlocksPerMultiprocessor(&per_cu, (const void*)mk_fwd, NTHREADS, LDS_BYTES);
        if (per_cu < 1) { fprintf(stderr, "kernel_launch: occupancy query says %d blocks per CU\n", per_cu); per_cu = 1; }
        if (per_cu > 1) per_cu = 1;
        grid = cus * per_cu;
    }
    if (grid < 0) return;
    Args a{};
    for (int i = 0; i < 29; ++i) a.in[i] = (const float*)d_in[i];
    a.out = (float*)d_out; a.ws = (unsigned char*)d_ws;
    void* kargs[] = {&a};
    hipError_t e = hipLaunchCooperativeKernel((const void*)mk_fwd, dim3(grid), dim3(NTHREADS), kargs, LDS_BYTES, stream);
    if (e != hipSuccess) fprintf(stderr, "cooperative launch failed: %s (grid %d)\n", hipGetErrorString(e), grid);
}
```

```cpp
#include <hip/hip_runtime.h>
#include <hip/hip_cooperative_groups.h>
#include <cstdio>
#include <cstdint>

typedef unsigned short bf16_t;
typedef short bf16x8 __attribute__((ext_vector_type(8)));
typedef float f32x4 __attribute__((ext_vector_type(4)));
typedef unsigned u32x4 __attribute__((ext_vector_type(4)));

constexpr int D = 1024, BATCH = 8, SEQ = 4096, NTOK = BATCH * SEQ, MEM = 256, NMEM = BATCH * MEM;
constexpr int RW = 512, SBW = 512, PROJ = 2560, NH = 8, HD = 64;
constexpr int XH = 4, XD = 256, NG = 4, EPG = 4, NEXP = 16, DE = 256;
constexpr float EPS = 1e-6f, LOG2E = 1.4426950408889634f;

constexpr size_t MiB = 1u << 20;
constexpr size_t WS_CTL = 0;
constexpr size_t WS_SMALL = 1 * MiB;
constexpr size_t WS_WIN = 16 * MiB;
constexpr size_t WS_WOUT = 21 * MiB;
constexpr size_t WS_WQ = 23 * MiB;
constexpr size_t WS_WKV = 25 * MiB;
constexpr size_t WS_WO = 29 * MiB;
constexpr size_t WS_MEMN = 31 * MiB;
constexpr size_t WS_KVM = 35 * MiB;
constexpr size_t WS_WG = 43 * MiB;
constexpr size_t WS_WU = 51 * MiB;
constexpr size_t WS_WD2 = 59 * MiB;
constexpr size_t WS_R0 = 96 * MiB;
constexpr size_t WS_R1 = 160 * MiB;
constexpr size_t WS_R2 = 224 * MiB;
constexpr size_t WS_R3 = 288 * MiB;
constexpr size_t WS_R4 = 320 * MiB;
constexpr size_t WS_R5 = 384 * MiB;
constexpr size_t WS_END = 448 * MiB;

constexpr size_t SM_RSTD0 = 0;
constexpr size_t SM_SSQR = 1 * 32768;
constexpr size_t SM_SSQS = 2 * 32768;
constexpr size_t SM_SSQ1 = 10 * 32768;
constexpr size_t SM_SSQ2 = 26 * 32768;
constexpr size_t SM_SSQ3 = 42 * 32768;
constexpr size_t SM_SELW = 58 * 32768;
constexpr size_t SM_SELE = 60 * 32768;
constexpr size_t SM_END = 62 * 32768;

__device__ __forceinline__ unsigned f2bf(float f) { unsigned u = __builtin_bit_cast(unsigned, f); return (u + 0x7fffu + ((u >> 16) & 1u)) >> 16; }
__device__ __forceinline__ float bf2f(unsigned short h) { return __builtin_bit_cast(float, (unsigned)h << 16); }
__device__ __forceinline__ float wave_sum(float v) {
#pragma unroll
    for (int o = 1; o < 64; o <<= 1) v += __shfl_xor(v, o);
    return v;
}
__device__ __forceinline__ float gelu_tanh(float x) { const float u = 0.7978845608028654f * (x + 0.044715f * x * x * x); return x / (1.f + __expf(-2.f * u)); }
__device__ __forceinline__ float sigmoidf_(float x) { return 1.f / (1.f + __expf(-x)); }

namespace cg = cooperative_groups;
#define LAS __attribute__((address_space(3)))
constexpr int NWAVES = 8, NTHREADS = 512;
constexpr int LDS_BYTES = 147456;

struct Args { const float* in[29]; float* out; unsigned char* ws; };

struct Ctx {
    const float* in[29]; float* out; unsigned char* ws; unsigned char* lds;
    int tid, lane, wave, gw, NGW, G, bid;
};

namespace pg8 {
#define PG8_LAS __attribute__((address_space(3)))
constexpr int BM = 256, BK = 64, HALF = 128, HTB = HALF * BK * 2  , STAGE_BYTES = 8 * HTB, NXCD = 8, WGM = 8;
__host__ __device__ __forceinline__ int lds_byte(int r, int c) { const int st = (r >> 4) * 2 + (c >> 5), rr = r & 15, cc = c & 31, ob = rr * 64 + cc * 2; return st * 1024 + (ob ^ (((ob >> 9) & 1) << 5)); }
__host__ __device__ __forceinline__ void stage_rc(int b, int& R, int& C) { const int st = b / 1024, sb = b % 1024, swz = sb ^ (((sb >> 9) & 1) << 5); R = (st >> 1) * 16 + swz / 64; C = (st & 1) * 32 + (swz % 64) / 2; }
__host__ __device__ __forceinline__ int perm32(int rho) { const int n = rho >> 4, i = rho & 15; return 8 * (i >> 2) + 4 * n + (i & 3); }

struct Unit { int pm, pn; };
struct Gemm { int lda, ldb, K; };
struct DenseOrder {
    const bf16_t* A; const bf16_t* Bt; int lda, ldb; int nM, nN, nwg, G, c;
    __device__ void init(const bf16_t* A_, int lda_, const bf16_t* Bt_, int ldb_, int M, int N, int G_, int c_) { A = A_; Bt = Bt_; lda = lda_; ldb = ldb_; nM = M / BM; nN = N / BM; nwg = nM * nN; G = G_; c = c_; }
    __device__ bool next(int i, Unit& u) const {
        const long L = (long)i * G + c; if (L >= nwg) return false;
        int wgid = (int)L; { const int q = nwg / NXCD, r = nwg % NXCD, xcd = wgid % NXCD, off = wgid / NXCD; wgid = (xcd < r ? xcd * (q + 1) : r * (q + 1) + (xcd - r) * q) + off; }
        const int nig = WGM * nN, gid = wgid / nig, fm = gid * WGM, gsz = (nM - fm) < WGM ? (nM - fm) : WGM;
        u.pm = fm + ((wgid % nig) % gsz); u.pn = (wgid % nig) / gsz; return true;
    }
    __device__ __forceinline__ void ptrs(const Unit& u, const char*& a, const char*& b0, const char*& b1) const {
        a = (const char*)A + (size_t)u.pm * BM * lda * 2; b0 = (const char*)Bt + (size_t)u.pn * BM * ldb * 2; b1 = b0 + (size_t)HALF * ldb * 2; }
};

__device__ __forceinline__ unsigned cvt_pk_bf16(float lo, float hi) { unsigned r; asm volatile("v_cvt_pk_bf16_f32 %0, %1, %2" : "=v"(r) : "v"(lo), "v"(hi)); return r; }

template <class Epi, class Sched, bool ALIGN_EPI>
__device__ __forceinline__ void gemm_phase(PG8_LAS unsigned char* lds, const Gemm g, const Sched& S, const Epi& E) {
    const int tid = threadIdx.x, wid = __builtin_amdgcn_readfirstlane(tid >> 6), lane = tid & 63, wr = wid >> 2, wc = wid & 3, fr = lane & 15, fq = lane >> 4;
    const int K = g.K, nt = K / BK;
    unsigned voffA[2], voffB[2];
#pragma unroll
    for (int i = 0; i < 2; ++i) { int R, C; stage_rc(tid * 16 + i * 8192, R, C); const int Rb = Epi::PERM ? ((R & ~31) + perm32(R & 31)) : R;
        voffA[i] = (unsigned)(R * g.lda + C) * 2u; voffB[i] = (unsigned)(Rb * g.ldb + C) * 2u; }
    const size_t kstep = (size_t)(BK * 2);
    const size_t hstepA = (size_t)HALF * g.lda * 2;
    const unsigned ldsw = (unsigned)wid * 1024u;
    const int aoff = lds_byte(wr * 64 + fr, fq * 8), boff = lds_byte(wc * 32 + fr, fq * 8);
#define PG8_SA(b, h) (((b) * 2 + (h)) * HTB)
#define PG8_SB(b, h) ((4 + (b) * 2 + (h)) * HTB)
#define PG8_STAGE(bufoff, gbase, voff) do { _Pragma("unroll") for (int _i = 0; _i < 2; ++_i) \
        __builtin_amdgcn_global_load_lds((const unsigned*)((const char*)(gbase) + (voff)[_i]), (PG8_LAS unsigned*)(lds + (bufoff) + ldsw + _i * 8192), 16, 0, 0); } while (0)
#define PG8_LDA(dst, b, h) do { _Pragma("unroll") for (int m = 0; m < 4; ++m) _Pragma("unroll") for (int k = 0; k < 2; ++k) dst[m][k] = *(const PG8_LAS bf16x8*)(lds + PG8_SA(b, h) + aoff + m * 2048 + k * 1024); } while (0)
#define PG8_LDB(dst, b, h) do { _Pragma("unroll") for (int n = 0; n < 2; ++n) _Pragma("unroll") for (int k = 0; k < 2; ++k) dst[n][k] = *(const PG8_LAS bf16x8*)(lds + PG8_SB(b, h) + boff + n * 2048 + k * 1024); } while (0)
#define PG8_MMA(ai, bj, At, Bt) do { __builtin_amdgcn_s_setprio(1); _Pragma("unroll") for (int m = 0; m < 4; ++m) _Pragma("unroll") for (int n = 0; n < 2; ++n) _Pragma("unroll") for (int k = 0; k < 2; ++k) \
        acc[ai][bj][m][n] = __builtin_amdgcn_mfma_f32_16x16x32_bf16(Bt[n][k], At[m][k], acc[ai][bj][m][n], 0, 0, 0); __builtin_amdgcn_s_setprio(0); } while (0)
#define PG8_WAIT_V(n) asm volatile("s_waitcnt vmcnt(" #n ")" ::: "memory")
#define PG8_WAIT_L(n) asm volatile("s_waitcnt lgkmcnt(" #n ")" ::: "memory")
#define PG8_BAR __builtin_amdgcn_s_barrier()
#define PG8_SCHED __builtin_amdgcn_sched_barrier(0)
    Unit cur, nxt; int ui = 0;
    if (!S.next(0, cur)) return;
    f32x4 acc[2][2][4][2];
#pragma unroll
    for (int a = 0; a < 2; ++a)
#pragma unroll
        for (int b = 0; b < 2; ++b)
#pragma unroll
            for (int m = 0; m < 4; ++m)
#pragma unroll
                for (int n = 0; n < 2; ++n) acc[a][b][m][n] = (f32x4){0.f, 0.f, 0.f, 0.f};
    bf16x8 At[4][2], B0[2][2], B1[2][2];
    const char *cA, *cB0, *cB1; S.ptrs(cur, cA, cB0, cB1);
    PG8_STAGE(PG8_SB(0, 0), cB0, voffB); PG8_STAGE(PG8_SB(0, 1), cB1, voffB); PG8_STAGE(PG8_SA(0, 0), cA, voffA); PG8_STAGE(PG8_SA(0, 1), cA + hstepA, voffA);
    if (wr == 1) PG8_BAR;
    PG8_WAIT_V(2); PG8_BAR;
    PG8_STAGE(PG8_SB(1, 0), cB0 + kstep, voffB); PG8_STAGE(PG8_SA(1, 0), cA + kstep, voffA); PG8_STAGE(PG8_SB(1, 1), cB1 + kstep, voffB);
    PG8_WAIT_V(6); PG8_BAR;
    for (;;) {
        const bool has_next = S.next(ui + 1, nxt);
        const char *nA = cA, *nB0 = cB0, *nB1 = cB1; if (has_next) S.ptrs(nxt, nA, nB0, nB1);
        for (int t = 0; t < nt; t += 2) {
            const bool last = (t == nt - 2);
            if constexpr (Epi::HAS_MID) { if (t == E.mid_t) E.mid(acc, cur, wr, wc, fr, fq); }
            const char* a1 = cA + (size_t)(t + 1) * kstep;
            const char* a2 = last ? nA : cA + (size_t)(t + 2) * kstep; const char* b2 = last ? nB0 : cB0 + (size_t)(t + 2) * kstep; const char* b2h = last ? nB1 : cB1 + (size_t)(t + 2) * kstep;
            const char* a3 = a2 + kstep; const char* b3 = b2 + kstep; const char* b3h = b2h + kstep;
            PG8_LDB(B0, 0, 0); PG8_LDB(B1, 0, 1); PG8_SCHED; PG8_LDA(At, 0, 0); PG8_STAGE(PG8_SA(1, 1), a1 + hstepA, voffA);
            PG8_WAIT_V(8); PG8_WAIT_L(0); PG8_BAR; PG8_MMA(0, 0, At, B0); PG8_MMA(0, 1, At, B1); PG8_BAR; PG8_SCHED;
            PG8_LDA(At, 0, 1); PG8_STAGE(PG8_SB(0, 0), b2, voffB); PG8_STAGE(PG8_SB(0, 1), b2h, voffB); PG8_STAGE(PG8_SA(0, 0), a2, voffA);
            PG8_WAIT_V(8); PG8_WAIT_L(0); PG8_BAR; PG8_MMA(1, 0, At, B0); PG8_MMA(1, 1, At, B1); PG8_BAR; PG8_SCHED;
            PG8_LDB(B0, 1, 0); PG8_LDB(B1, 1, 1); PG8_SCHED; PG8_LDA(At, 1, 0); PG8_STAGE(PG8_SA(0, 1), a2 + hstepA, voffA);
            PG8_WAIT_V(8); PG8_WAIT_L(0); PG8_BAR; PG8_MMA(0, 0, At, B0); PG8_MMA(0, 1, At, B1); PG8_BAR; PG8_SCHED;
            PG8_LDA(At, 1, 1); PG8_STAGE(PG8_SB(1, 0), b3, voffB); PG8_STAGE(PG8_SB(1, 1), b3h, voffB); PG8_STAGE(PG8_SA(1, 0), a3, voffA);
            PG8_WAIT_V(8); PG8_WAIT_L(0); PG8_BAR; PG8_MMA(1, 0, At, B0); PG8_MMA(1, 1, At, B1); PG8_BAR; PG8_SCHED;
        }
        if constexpr (ALIGN_EPI) { if (wr == 0) PG8_BAR; }
        E(acc, cur, wr, wc, fr, fq);
        if (!has_next) break;
#pragma unroll
        for (int a = 0; a < 2; ++a)
#pragma unroll
            for (int b = 0; b < 2; ++b)
#pragma unroll
                for (int m = 0; m < 4; ++m)
#pragma unroll
                    for (int n = 0; n < 2; ++n) acc[a][b][m][n] = (f32x4){0.f, 0.f, 0.f, 0.f};
        cur = nxt; cA = nA; cB0 = nB0; cB1 = nB1; ++ui;
        if constexpr (ALIGN_EPI) { if (wr == 1) PG8_BAR; }
    }
    PG8_WAIT_V(0);
    if constexpr (!ALIGN_EPI) { if (wr == 0) PG8_BAR; }
    PG8_BAR;
#undef PG8_SA
#undef PG8_SB
#undef PG8_STAGE
#undef PG8_LDA
#undef PG8_LDB
#undef PG8_MMA
#undef PG8_WAIT_V
#undef PG8_WAIT_L
#undef PG8_BAR
#undef PG8_SCHED
}

__device__ __forceinline__ float rstd16(const float* p) { const f32x4 a = ((const f32x4*)p)[0], b = ((const f32x4*)p)[1], c = ((const f32x4*)p)[2], d = ((const f32x4*)p)[3];
    const float s = ((a.x + a.y) + (a.z + a.w)) + ((b.x + b.y) + (b.z + b.w)) + ((c.x + c.y) + (c.z + c.w)) + ((d.x + d.y) + (d.z + d.w)); return 1.0f / sqrtf(s * (1.f / D) + EPS); }
__device__ __forceinline__ u32x4 pack8(const f32x4 v0, const f32x4 v1) { u32x4 w; w.x = cvt_pk_bf16(v0[0], v0[1]); w.y = cvt_pk_bf16(v0[2], v0[3]); w.z = cvt_pk_bf16(v1[0], v1[1]); w.w = cvt_pk_bf16(v1[2], v1[3]); return w; }
__device__ __forceinline__ float sq8(const f32x4 a, const f32x4 b) { return ((a[0] * a[0] + a[1] * a[1]) + (a[2] * a[2] + a[3] * a[3])) + ((b[0] * b[0] + b[1] * b[1]) + (b[2] * b[2] + b[3] * b[3])); }

struct EpiInProjF {
    static constexpr bool PERM = true, HAS_MID = false; int mid_t;
    const float* rstd0; bf16_t *XR, *GG, *Qs, *Ks, *Vs; unsigned* kmax;
    __device__ __forceinline__ void mid(f32x4 (&)[2][2][4][2], const Unit&, int, int, int, int) const {}
    __device__ __forceinline__ void operator()(const f32x4 (&acc)[2][2][4][2], const Unit& u, int wr, int wc, int fr, int fq) const {
        const int row0 = u.pm * BM + wr * 64 + fr, t = u.pn >> 1, colt = (u.pn & 1) * 256 + wc * 32 + 8 * fq;
        bf16_t* base = (t == 0) ? XR : (t == 1) ? GG : (t == 2) ? Qs : (t == 3) ? Ks : Vs;
        float km0 = 0.f, km1 = 0.f;
#pragma unroll
        for (int ai = 0; ai < 2; ++ai)
#pragma unroll
            for (int m = 0; m < 4; ++m) { const int r = row0 + ai * HALF + m * 16; const float rs = rstd0[r]; bf16_t* rowp = base + (size_t)r * 512 + colt;
#pragma unroll
                for (int bj = 0; bj < 2; ++bj) { f32x4 v0 = acc[ai][bj][m][0] * rs, v1 = acc[ai][bj][m][1] * rs;
                    if (t == 1) {
#pragma unroll
                        for (int e = 0; e < 4; ++e) { v0[e] = gelu_tanh(v0[e]); v1[e] = gelu_tanh(v1[e]); } }
                    else if (t == 2) { v0 = v0 * (0.125f * LOG2E); v1 = v1 * (0.125f * LOG2E); }
                    else if (t == 3) { float mx = 0.f;
#pragma unroll
                        for (int e = 0; e < 4; ++e) mx = fmaxf(mx, fmaxf(fabsf(v0[e]), fabsf(v1[e])));
                        if (bj == 0) km0 = fmaxf(km0, mx); else km1 = fmaxf(km1, mx); }
                    *(u32x4*)(rowp + bj * HALF) = pack8(v0, v1); } }
        if (t == 3) {
#pragma unroll
            for (int o = 1; o < 64; o <<= 1) { km0 = fmaxf(km0, __shfl_xor(km0, o)); km1 = fmaxf(km1, __shfl_xor(km1, o)); }
            if ((fr | fq) == 0) { const int b = (u.pm * BM) / SEQ, hd = (u.pn & 1) * 4 + (wc >> 1);
                atomicMax(kmax + b * 8 + hd, __float_as_uint(km0)); atomicMax(kmax + b * 8 + hd + 2, __float_as_uint(km1)); }
        }
    }
};
struct EpiBf16F {
    static constexpr bool PERM = true, HAS_MID = false; int mid_t;
    bf16_t* O; const float* ssq16; int ldo; float scale;
    __device__ __forceinline__ void mid(f32x4 (&)[2][2][4][2], const Unit&, int, int, int, int) const {}
    __device__ __forceinline__ void operator()(const f32x4 (&acc)[2][2][4][2], const Unit& u, int wr, int wc, int fr, int fq) const {
        const int row0 = u.pm * BM + wr * 64 + fr, col0 = u.pn * BM + wc * 32 + 8 * fq;
#pragma unroll
        for (int ai = 0; ai < 2; ++ai)
#pragma unroll
            for (int m = 0; m < 4; ++m) { const int r = row0 + ai * HALF + m * 16; const float rs = (ssq16 ? rstd16(ssq16 + (size_t)r * 16) : 1.f) * scale; bf16_t* rowp = O + (size_t)r * ldo + col0;
#pragma unroll
                for (int bj = 0; bj < 2; ++bj) *(u32x4*)(rowp + bj * HALF) = pack8(acc[ai][bj][m][0] * rs, acc[ai][bj][m][1] * rs); }
    }
};
struct EpiX1F {
    static constexpr bool PERM = true, HAS_MID = true; int mid_t;
    const float* x; const float* fmid; const float* fend; bf16_t* X1b; float* ssq1;
    __device__ __forceinline__ void mid(f32x4 (&acc)[2][2][4][2], const Unit& u, int wr, int wc, int fr, int fq) const {
        const int row0 = u.pm * BM + wr * 64 + fr;
#pragma unroll
        for (int ai = 0; ai < 2; ++ai)
#pragma unroll
            for (int m = 0; m < 4; ++m) { const float f = fmid[row0 + ai * HALF + m * 16];
#pragma unroll
                for (int bj = 0; bj < 2; ++bj) { acc[ai][bj][m][0] = acc[ai][bj][m][0] * f; acc[ai][bj][m][1] = acc[ai][bj][m][1] * f; } }
    }
    __device__ __forceinline__ void operator()(const f32x4 (&acc)[2][2][4][2], const Unit& u, int wr, int wc, int fr, int fq) const {
        const int row0 = u.pm * BM + wr * 64 + fr, col0 = u.pn * BM + wc * 32 + 8 * fq;
#pragma unroll
        for (int ai = 0; ai < 2; ++ai)
#pragma unroll
            for (int m = 0; m < 4; ++m) { const int r = row0 + ai * HALF + m * 16; const float fe = fend[r]; const float* xr = x + (size_t)r * D + col0; float ss = 0.f;
#pragma unroll
                for (int bj = 0; bj < 2; ++bj) { const f32x4 v0 = *(const f32x4*)(xr + bj * HALF) + acc[ai][bj][m][0] * fe, v1 = *(const f32x4*)(xr + bj * HALF + 4) + acc[ai][bj][m][1] * fe;
                    ss += sq8(v0, v1); *(u32x4*)(X1b + (size_t)r * D + col0 + bj * HALF) = pack8(v0, v1); }
                ss += __shfl_xor(ss, 16); ss += __shfl_xor(ss, 32);
                if (fq == 0) ssq1[(size_t)r * 16 + u.pn * 4 + wc] = ss;
                asm volatile("" ::: "memory"); }
    }
};
struct EpiResF {
    static constexpr bool PERM = true, HAS_MID = false; int mid_t;
    const bf16_t* Xi; bf16_t* Xo; float* ssq;
    __device__ __forceinline__ void mid(f32x4 (&)[2][2][4][2], const Unit&, int, int, int, int) const {}
    __device__ __forceinline__ void operator()(const f32x4 (&acc)[2][2][4][2], const Unit& u, int wr, int wc, int fr, int fq) const {
        const int row0 = u.pm * BM + wr * 64 + fr, col0 = u.pn * BM + wc * 32 + 8 * fq;
#pragma unroll
        for (int ai = 0; ai < 2; ++ai)
#pragma unroll
            for (int m = 0; m < 4; ++m) { const int r = row0 + ai * HALF + m * 16; float ss = 0.f;
#pragma unroll
                for (int bj = 0; bj < 2; ++bj) { const u32x4 xi = *(const u32x4*)(Xi + (size_t)r * D + col0 + bj * HALF);
                    f32x4 v0, v1; v0[0] = __uint_as_float(xi.x << 16); v0[1] = __uint_as_float(xi.x & 0xffff0000u); v0[2] = __uint_as_float(xi.y << 16); v0[3] = __uint_as_float(xi.y & 0xffff0000u);
                    v1[0] = __uint_as_float(xi.z << 16); v1[1] = __uint_as_float(xi.z & 0xffff0000u); v1[2] = __uint_as_float(xi.w << 16); v1[3] = __uint_as_float(xi.w & 0xffff0000u);
                    v0 = v0 + acc[ai][bj][m][0]; v1 = v1 + acc[ai][bj][m][1];
                    ss += sq8(v0, v1); *(u32x4*)(Xo + (size_t)r * D + col0 + bj * HALF) = pack8(v0, v1); }
                ss += __shfl_xor(ss, 16); ss += __shfl_xor(ss, 32);
                if (fq == 0) ssq[(size_t)r * 16 + u.pn * 4 + wc] = ss; }
    }
};
}
__device__ __forceinline__ void row_prep_x(const float* x, bf16_t* xb, float* rstd0, int row, int lane) {
    const f32x4* xr = (const f32x4*)(x + (size_t)row * D) + lane;
    float s = 0.f; f32x4 v[4];
#pragma unroll
    for (int j = 0; j < 4; ++j) { v[j] = xr[64 * j]; s += v[j].x * v[j].x + v[j].y * v[j].y + v[j].z * v[j].z + v[j].w * v[j].w; }
    s = wave_sum(s);
    if (lane == 0) rstd0[row] = 1.0f / sqrtf(s * (1.f / D) + EPS);
    unsigned long long* o8 = (unsigned long long*)(xb + (size_t)row * D) + lane;
#pragma unroll
    for (int j = 0; j < 4; ++j) o8[64 * j] = (unsigned long long)(f2bf(v[j].x) | (f2bf(v[j].y) << 16)) | ((unsigned long long)(f2bf(v[j].z) | (f2bf(v[j].w) << 16)) << 32);
}
__device__ __forceinline__ void row_prep_mem(const float* m, const float* g, bf16_t* o, int row, int lane) {
    const f32x4* xr = (const f32x4*)(m + (size_t)row * D) + lane;
    float s = 0.f; f32x4 v[4];
#pragma unroll
    for (int j = 0; j < 4; ++j) { v[j] = xr[64 * j]; s += v[j].x * v[j].x + v[j].y * v[j].y + v[j].z * v[j].z + v[j].w * v[j].w; }
    s = wave_sum(s);
    const float r = 1.0f / sqrtf(s * (1.f / D) + EPS);
    unsigned long long* o8 = (unsigned long long*)(o + (size_t)row * D) + lane;
#pragma unroll
    for (int j = 0; j < 4; ++j) { const f32x4 gg = ((const f32x4*)g)[64 * j + lane];
        o8[64 * j] = (unsigned long long)(f2bf(v[j].x * r * gg.x) | (f2bf(v[j].y * r * gg.y) << 16)) | ((unsigned long long)(f2bf(v[j].z * r * gg.z) | (f2bf(v[j].w * r * gg.w) << 16)) << 32); }
}
__device__ __forceinline__ void transpose_item(const float* W, int K, int N, bf16_t* Wt, int ldt, const float* g0, const float* g1, int ksplit, LAS float* scr, int item, int lane) {
    const int nblk = N / 32, kb = item / nblk, nb = item % nblk, k0 = 64 * kb, n0 = 32 * nb;
#pragma unroll 8
    for (int i = 0; i < 32; ++i) { const int kk = 2 * i + (lane >> 5), k = k0 + kk; float gv = 1.f; if (g0) gv = (k < ksplit) ? g0[k] : g1[k - ksplit];
        scr[kk * 33 + (lane & 31)] = W[(size_t)k * N + n0 + (lane & 31)] * gv; }
    asm volatile("s_waitcnt lgkmcnt(0)" ::: "memory");
    const int c = lane & 7;
#pragma unroll
    for (int j = 0; j < 4; ++j) { const int n = (lane >> 3) + 8 * j; const LAS float* s = scr + (8 * c) * 33 + n;
        u32x4 o; o.x = f2bf(s[0 * 33]) | (f2bf(s[1 * 33]) << 16); o.y = f2bf(s[2 * 33]) | (f2bf(s[3 * 33]) << 16); o.z = f2bf(s[4 * 33]) | (f2bf(s[5 * 33]) << 16); o.w = f2bf(s[6 * 33]) | (f2bf(s[7 * 33]) << 16);
        *(u32x4*)(Wt + (size_t)(n0 + n) * ldt + k0 + 8 * c) = o; }
    asm volatile("s_waitcnt lgkmcnt(0)" ::: "memory");
}

struct MidScale { const float* f; int k; int pad; };
template <class Epi>
__device__ __forceinline__ void gemm_naive(const Ctx& C, const bf16_t* A, int lda, const bf16_t* Bt, int ldb, int M, int N, int K, MidScale ms, const Epi& E) {
    const int lane = C.lane, fr = lane & 15, fq = lane >> 4, ncol = N / 64, ntile = (M / 16) * ncol;
    for (int t = C.gw; t < ntile; t += C.NGW) {
        const int row0 = (t / ncol) * 16, col0 = (t % ncol) * 64;
        const bf16_t* ap = A + (size_t)(row0 + fr) * lda + fq * 8;
        const bf16_t* bp = Bt + (size_t)(col0 + fr) * ldb + fq * 8;
        f32x4 acc[4];
#pragma unroll
        for (int n = 0; n < 4; ++n) acc[n] = (f32x4){0.f, 0.f, 0.f, 0.f};
        for (int k0 = 0; k0 < K; k0 += 32) {
            if (ms.f && k0 == ms.k) {
#pragma unroll
                for (int j = 0; j < 4; ++j) { const float f = ms.f[row0 + fq * 4 + j];
#pragma unroll
                    for (int n = 0; n < 4; ++n) acc[n][j] *= f; }
            }
            const bf16x8 a = *(const bf16x8*)(ap + k0);
#pragma unroll
            for (int n = 0; n < 4; ++n) { const bf16x8 b = *(const bf16x8*)(bp + (size_t)n * 16 * ldb + k0); acc[n] = __builtin_amdgcn_mfma_f32_16x16x32_bf16(a, b, acc[n], 0, 0, 0); }
        }
#pragma unroll
        for (int n = 0; n < 4; ++n)
#pragma unroll
            for (int j = 0; j < 4; ++j) E(row0 + fq * 4 + j, col0 + n * 16 + fr, acc[n][j]);
    }
}
struct EpiInProj { const float* rstd0; bf16_t *XR, *GG, *Qs, *Ks, *Vs;
    __device__ void operator()(int r, int c, float v) const { v *= rstd0[r]; const int t = c >> 9, cc = c & 511;
        if (t == 0) XR[(size_t)r * RW + cc] = (bf16_t)f2bf(v);
        else if (t == 1) GG[(size_t)r * RW + cc] = (bf16_t)f2bf(gelu_tanh(v));
        else if (t == 2) Qs[(size_t)r * SBW + cc] = (bf16_t)f2bf(v * (0.125f * LOG2E));
        else if (t == 3) Ks[(size_t)r * SBW + cc] = (bf16_t)f2bf(v);
        else Vs[(size_t)r * SBW + cc] = (bf16_t)f2bf(v); } };
struct EpiStoreBf16 { bf16_t* O; const float* rowscale; int ldo; float scale;
    __device__ void operator()(int r, int c, float v) const { O[(size_t)r * ldo + c] = (bf16_t)f2bf(v * (rowscale ? rowscale[r] : 1.f) * scale); } };
struct EpiResF32 { const float* base; const float* rowscale; bf16_t* O;
    __device__ void operator()(int r, int c, float v) const { O[(size_t)r * D + c] = (bf16_t)f2bf(base[(size_t)r * D + c] + v * rowscale[r]); } };
struct EpiResBf16 { const bf16_t* base; bf16_t* O;
    __device__ void operator()(int r, int c, float v) const { O[(size_t)r * D + c] = (bf16_t)f2bf(bf2f(base[(size_t)r * D + c]) + v); } };

__device__ __forceinline__ void lru_naive_unit(int unit, int j, LAS float* xs, const bf16_t* XR, const bf16_t* GG, const float* conv_w, const float* conv_b,
                                               const float* w_a, const float* b_a, const float* w_x, const float* b_x, const float* lam, bf16_t* YY) {
    const int b = unit >> 3, h = unit & 7, c = h * 64 + j;
    float wa[64], wx[64];
#pragma unroll
    for (int i = 0; i < 64; ++i) { wa[i] = w_a[(size_t)(h * 64 + i) * 64 + j]; wx[i] = w_x[(size_t)(h * 64 + i) * 64 + j]; }
    const float ba = b_a[c], bx = b_x[c], cw0 = conv_w[c], cw1 = conv_w[RW + c], cw2 = conv_w[2 * RW + c], cw3 = conv_w[3 * RW + c], cb = conv_b[c];
    const float l = lam[c], spl = (l > 15.f) ? __expf(-l) : log1pf(__expf(-l));
    float x0 = 0.f, x1 = 0.f, x2 = 0.f, hst = 0.f;
    for (int t = 0; t < SEQ; ++t) {
        const size_t row = (size_t)b * SEQ + t;
        const float x3 = bf2f(XR[row * RW + c]);
        const float xc = cw0 * x0 + cw1 * x1 + cw2 * x2 + cw3 * x3 + cb;
        x0 = x1; x1 = x2; x2 = x3;
        asm volatile("s_waitcnt lgkmcnt(0)" ::: "memory"); xs[j] = xc; asm volatile("s_waitcnt lgkmcnt(0)" ::: "memory");
        float ra = ba, ri = bx;
#pragma unroll
        for (int i = 0; i < 64; ++i) { const float xv = xs[i]; ra += xv * wa[i]; ri += xv * wx[i]; }
        const float r = sigmoidf_(ra), ig = sigmoidf_(ri);
        const float log_a = -8.0f * r * spl, a = __expf(log_a), bb = sqrtf(fmaxf(0.f, -expm1f(2.f * log_a))) * (ig * xc);
        hst = a * hst + bb;
        YY[row * D + c] = (bf16_t)f2bf(hst * bf2f(GG[row * RW + c]));
    }
}
__device__ __forceinline__ void sb_naive_unit(int unit, int lane, const bf16_t* Qs, const bf16_t* Ks, const bf16_t* Vs, bf16_t* YY, float* ssq_s8) {
    const int qb = unit & 63, h = (unit >> 6) & 7, b = unit >> 9;
    const int t = qb * 64 + lane; const size_t row = (size_t)b * SEQ + t;
    float q[64], o[64];
#pragma unroll
    for (int d = 0; d < 64; ++d) { q[d] = bf2f(Qs[row * SBW + h * 64 + d]); o[d] = 0.f; }
    float R = 0.f;
    for (int s = qb * 64 + 62; s >= 0; --s) {
        const bf16_t* kr = Ks + ((size_t)b * SEQ + s) * SBW + h * 64; const bf16_t* vr = Vs + ((size_t)b * SEQ + s) * SBW + h * 64;
        float z = 0.f;
#pragma unroll
        for (int d = 0; d < 64; ++d) z += q[d] * bf2f(kr[d]);
        const bool valid = s < t;
        const float sp = valid ? (fmaxf(z, 0.f) + __log2f(1.f + exp2f(-fabsf(z)))) : 0.f;
        const float w = valid ? exp2f(z - (R + sp)) : 0.f;
        R += sp;
        const float wb = bf2f((bf16_t)f2bf(w));
#pragma unroll
        for (int d = 0; d < 64; ++d) o[d] += wb * bf2f(vr[d]);
    }
    float ss = 0.f;
#pragma unroll
    for (int d = 0; d < 64; ++d) { ss += o[d] * o[d]; YY[row * D + RW + h * 64 + d] = (bf16_t)f2bf(o[d]); }
    ssq_s8[row * 8 + h] = ss;
}
__device__ __forceinline__ void xattn_naive_unit(int unit, int j, LAS float* qs, LAS float* ps, const bf16_t* QX, const bf16_t* KVM, bf16_t* OX) {
    const int tg = unit & 511, h = (unit >> 9) & 3, b = unit >> 11, lane = j & 63, wid = j >> 6;
    const size_t row0 = (size_t)b * SEQ + tg * 8;
    for (int i = 0; i < 8; ++i) qs[i * 256 + j] = bf2f(QX[(row0 + i) * D + h * XD + j]);
    __syncthreads();
    const bf16_t* kr = KVM + ((size_t)b * MEM + j) * 2048 + h * XD;
    float sc[8];
#pragma unroll
    for (int i = 0; i < 8; ++i) sc[i] = 0.f;
    for (int d = 0; d < XD; ++d) { const float kv = bf2f(kr[d]);
#pragma unroll
        for (int i = 0; i < 8; ++i) sc[i] += qs[i * 256 + d] * kv; }
#pragma unroll
    for (int i = 0; i < 8; ++i) ps[i * 256 + j] = sc[i];
    __syncthreads();
    for (int i = wid * 2; i < wid * 2 + 2; ++i) {
        float v0 = ps[i * 256 + lane], v1 = ps[i * 256 + lane + 64], v2 = ps[i * 256 + lane + 128], v3 = ps[i * 256 + lane + 192];
        float m = fmaxf(fmaxf(v0, v1), fmaxf(v2, v3));
#pragma unroll
        for (int o = 1; o < 64; o <<= 1) m = fmaxf(m, __shfl_xor(m, o));
        v0 = exp2f(v0 - m); v1 = exp2f(v1 - m); v2 = exp2f(v2 - m); v3 = exp2f(v3 - m);
        const float s = wave_sum(v0 + v1 + v2 + v3), inv = 1.f / s;
        ps[i * 256 + lane] = v0 * inv; ps[i * 256 + lane + 64] = v1 * inv; ps[i * 256 + lane + 128] = v2 * inv; ps[i * 256 + lane + 192] = v3 * inv;
    }
    __syncthreads();
    float o[8];
#pragma unroll
    for (int i = 0; i < 8; ++i) o[i] = 0.f;
    for (int m = 0; m < MEM; ++m) { const float vv = bf2f(KVM[((size_t)b * MEM + m) * 2048 + 1024 + h * XD + j]);
#pragma unroll
        for (int i = 0; i < 8; ++i) o[i] += ps[i * 256 + m] * vv; }
#pragma unroll
    for (int i = 0; i < 8; ++i) OX[(row0 + i) * D + h * XD + j] = (bf16_t)f2bf(o[i]);
    __syncthreads();
}
__device__ __forceinline__ void router_row(int row, int lane, const bf16_t* X2b, const float* ssq2p, const float* g, const float* wgr, const float* bgr, const float* wer, const float* ber, float* selw, int* sele) {
    float acc[20];
#pragma unroll
    for (int i = 0; i < 20; ++i) acc[i] = 0.f;
    const float rs = pg8::rstd16(ssq2p + (size_t)row * 16);
    for (int kk = 0; kk < 16; ++kk) { const int k = kk * 64 + lane; const float t = bf2f(X2b[(size_t)row * D + k]) * rs * g[k];
#pragma unroll
        for (int i = 0; i < 4; ++i) acc[i] += t * wgr[k * 4 + i];
#pragma unroll
        for (int gi = 0; gi < 4; ++gi)
#pragma unroll
            for (int e = 0; e < 4; ++e) acc[4 + gi * 4 + e] += t * wer[((size_t)gi * D + k) * 4 + e]; }
#pragma unroll
    for (int i = 0; i < 20; ++i) acc[i] = wave_sum(acc[i]);
    if (lane == 0) {
        float gl[4]; float gm = -INFINITY; int gi = 0;
#pragma unroll
        for (int i = 0; i < 4; ++i) { gl[i] = acc[i] + bgr[i]; if (gl[i] > gm) { gm = gl[i]; gi = i; } }
        float gs = 0.f;
#pragma unroll
        for (int i = 0; i < 4; ++i) gs += __expf(gl[i] - gm);
        const float gp = 1.f / gs;
        float el[4];
#pragma unroll
        for (int e = 0; e < 4; ++e) { float v = 0.f;
#pragma unroll
            for (int q = 0; q < 4; ++q) if (q == gi) v = acc[4 + q * 4 + e] + ber[q * 4 + e];
            el[e] = v; }
        int e1 = 0; float m1 = el[0];
#pragma unroll
        for (int e = 1; e < 4; ++e) if (el[e] > m1) { m1 = el[e]; e1 = e; }
        int e2 = -1; float m2 = -INFINITY;
#pragma unroll
        for (int e = 0; e < 4; ++e) if (e != e1 && el[e] > m2) { m2 = el[e]; e2 = e; }
        const float p2 = __expf(m2 - m1), w1 = gp / (1.f + p2), w2 = gp * p2 / (1.f + p2);
        selw[(size_t)row * 2] = w1; selw[(size_t)row * 2 + 1] = w2; sele[(size_t)row * 2] = gi * 4 + e1; sele[(size_t)row * 2 + 1] = gi * 4 + e2;
    }
}
__device__ __forceinline__ void final_row(int row, int lane, const bf16_t* X3b, const float* g, float* out) {
    float v[16]; float s = 0.f;
#pragma unroll
    for (int j = 0; j < 16; ++j) { v[j] = bf2f(X3b[(size_t)row * D + j * 64 + lane]); s += v[j] * v[j]; }
    s = wave_sum(s); const float r = 1.0f / sqrtf(s * (1.f / D) + EPS);
#pragma unroll
    for (int j = 0; j < 16; ++j) out[(size_t)row * D + j * 64 + lane] = v[j] * r * g[j * 64 + lane];
}

__global__ void __launch_bounds__(NTHREADS, 2) mk_fwd(Args args) {
    extern __shared__ __attribute__((aligned(16))) unsigned char lds[];
    cg::grid_group grid = cg::this_grid();
    Ctx C;
#pragma unroll
    for (int i = 0; i < 29; ++i) C.in[i] = args.in[i];
    C.out = args.out; C.ws = args.ws; C.lds = lds;
    C.tid = threadIdx.x; C.lane = C.tid & 63; C.wave = __builtin_amdgcn_readfirstlane(C.tid >> 6);
    C.G = gridDim.x; C.bid = blockIdx.x; C.gw = C.bid * NWAVES + C.wave; C.NGW = C.G * NWAVES;
    const float* x = C.in[0]; const float* mem = C.in[1]; const float* norm_mix = C.in[2]; const float* w_in = C.in[3];
    const float* conv_w = C.in[4]; const float* conv_b = C.in[5]; const float* lru_w_a = C.in[6]; const float* lru_b_a = C.in[7];
    const float* lru_w_x = C.in[8]; const float* lru_b_x = C.in[9]; const float* lru_lambda = C.in[10];
    const float* norm_rnn = C.in[11]; const float* norm_sb = C.in[12]; const float* w_out = C.in[13];
    const float* norm_xattn = C.in[14]; const float* norm_mem = C.in[15];
    const float* xa_w_q = C.in[16]; const float* xa_w_k = C.in[17]; const float* xa_w_v = C.in[18]; const float* xa_w_o = C.in[19];
    const float* norm_moe = C.in[20]; const float* w_gr = C.in[21]; const float* b_gr = C.in[22]; const float* w_er = C.in[23]; const float* b_er = C.in[24];
    const float* w_gate = C.in[25]; const float* w_up = C.in[26]; const float* w_down = C.in[27]; const float* norm_final = C.in[28];
    unsigned char* ws = C.ws; float* out = C.out;
    float* sm = (float*)(ws + WS_SMALL);
    float* rstd0 = sm + SM_RSTD0; float* ssq_r = sm + SM_SSQR; float* ssq_s = sm + SM_SSQS; float* ssq1 = sm + SM_SSQ1; float* ssq2 = sm + SM_SSQ2; unsigned* kmax = (unsigned*)(ws + WS_CTL); float* fmid = sm + SM_END; float* fend = fmid + 32768;
    float* selw = sm + SM_SELW; int* sele = (int*)(sm + SM_SELE);
    bf16_t* Win_t = (bf16_t*)(ws + WS_WIN); bf16_t* Wout_t = (bf16_t*)(ws + WS_WOUT); bf16_t* Wq_t = (bf16_t*)(ws + WS_WQ); bf16_t* Wkv_t = (bf16_t*)(ws + WS_WKV); bf16_t* Wo_t = (bf16_t*)(ws + WS_WO);
    bf16_t* memn = (bf16_t*)(ws + WS_MEMN); bf16_t* KVM = (bf16_t*)(ws + WS_KVM);
    bf16_t* xb = (bf16_t*)(ws + WS_R0); bf16_t* X1b = xb; bf16_t* X3b = xb;
    bf16_t* XR = (bf16_t*)(ws + WS_R1); bf16_t* GG = XR + (size_t)NTOK * RW; bf16_t* QX = XR;
    bf16_t* Qs = (bf16_t*)(ws + WS_R2); bf16_t* Ks = Qs + (size_t)NTOK * SBW; bf16_t* OX = Qs;
    bf16_t* Vs = (bf16_t*)(ws + WS_R3);
    bf16_t* YY = (bf16_t*)(ws + WS_R4); bf16_t* X2b = YY;
    float* HIDn = (float*)(ws + WS_R5);
    const int gw = C.gw, NGW = C.NGW, lane = C.lane;
#define GRID_SYNC() grid.sync()

    {
        if (gw == 0) kmax[lane] = 0u;
        for (int r = gw; r < NTOK; r += NGW) row_prep_x(x, xb, rstd0, r, lane);
        for (int r = gw; r < NMEM; r += NGW) row_prep_mem(mem, norm_mem, memn, r, lane);
        LAS float* scr = (LAS float*)(lds) + C.wave * (64 * 33);
        constexpr int I_IN = (D / 64) * (PROJ / 32), I_SQ = (D / 64) * (D / 32);
        for (int it = gw; it < I_IN + 5 * I_SQ; it += NGW) {
            int r = it;
            if (r < I_IN) { transpose_item(w_in, D, PROJ, Win_t, D, norm_mix, norm_mix, D, scr, r, lane); continue; } r -= I_IN;
            if (r < I_SQ) { transpose_item(w_out, D, D, Wout_t, D, norm_rnn, norm_sb, RW, scr, r, lane); continue; } r -= I_SQ;
            if (r < I_SQ) { transpose_item(xa_w_q, D, D, Wq_t, D, norm_xattn, norm_xattn, D, scr, r, lane); continue; } r -= I_SQ;
            if (r < I_SQ) { transpose_item(xa_w_k, D, D, Wkv_t, D, nullptr, nullptr, 0, scr, r, lane); continue; } r -= I_SQ;
            if (r < I_SQ) { transpose_item(xa_w_v, D, D, Wkv_t + (size_t)D * D, D, nullptr, nullptr, 0, scr, r, lane); continue; } r -= I_SQ;
            transpose_item(xa_w_o, D, D, Wo_t, D, nullptr, nullptr, 0, scr, r, lane);
        }
    }
    GRID_SYNC();
    { pg8::DenseOrder S; S.init(xb, D, Win_t, D, NTOK, PROJ, C.G, C.bid); pg8::EpiInProjF E{0, rstd0, XR, GG, Qs, Ks, Vs, kmax};
      pg8::gemm_phase<pg8::EpiInProjF, pg8::DenseOrder, true>((LAS unsigned char*)lds, pg8::Gemm{D, D, D}, S, E); }
    { pg8::DenseOrder S; S.init(memn, D, Wkv_t, D, NMEM, 2048, C.G, C.bid); pg8::EpiBf16F E{0, KVM, nullptr, 2048, 1.f};
      pg8::gemm_phase<pg8::EpiBf16F, pg8::DenseOrder, true>((LAS unsigned char*)lds, pg8::Gemm{D, D, D}, S, E); }
    GRID_SYNC();
    {
        LAS float* xs = (LAS float*)(lds) + C.wave * 64;
        if (gw < BATCH * NH) lru_naive_unit(gw, lane, xs, XR, GG, conv_w, conv_b, lru_w_a, lru_b_a, lru_w_x, lru_b_x, lru_lambda, YY);
        for (int u = gw; u < BATCH * NH * 64; u += NGW) { const int uu = BATCH * NH * 64 - 1 - u; sb_naive_unit(uu, lane, Qs, Ks, Vs, YY, ssq_s); }
    }
    GRID_SYNC();
    for (int r = gw; r < NTOK; r += NGW) {
        float s = 0.f;
        for (int c = lane; c < RW; c += 64) { const float v = bf2f(YY[(size_t)r * D + c]); s += v * v; }
        s = wave_sum(s);
        if (lane == 0) { float s2 = 0.f;
#pragma unroll
            for (int i = 0; i < 8; ++i) s2 += ssq_s[(size_t)r * 8 + i];
            const float rr = 1.0f / sqrtf(s * (1.f / RW) + EPS), rs = 1.0f / sqrtf(s2 * (1.f / SBW) + EPS); fmid[r] = rr / rs; fend[r] = rs; }
    }
    GRID_SYNC();
    { pg8::DenseOrder S; S.init(YY, D, Wout_t, D, NTOK, D, C.G, C.bid); pg8::EpiX1F E{8, x, fmid, fend, X1b, ssq1};
      pg8::gemm_phase<pg8::EpiX1F, pg8::DenseOrder, true>((LAS unsigned char*)lds, pg8::Gemm{D, D, D}, S, E); }
    GRID_SYNC();
    { pg8::DenseOrder S; S.init(X1b, D, Wq_t, D, NTOK, D, C.G, C.bid); pg8::EpiBf16F E{0, QX, ssq1, D, 0.0625f * LOG2E};
      pg8::gemm_phase<pg8::EpiBf16F, pg8::DenseOrder, true>((LAS unsigned char*)lds, pg8::Gemm{D, D, D}, S, E); }
    GRID_SYNC();
    {
        const int half = C.tid >> 8, j = C.tid & 255;
        LAS float* qs = (LAS float*)(lds) + half * 4096; LAS float* ps = qs + 2048;
        for (int u = C.bid * 2; u < BATCH * XH * 512; u += C.G * 2) xattn_naive_unit(u + half, j, qs, ps, QX, KVM, OX);
    }
    GRID_SYNC();
    { pg8::DenseOrder S; S.init(OX, D, Wo_t, D, NTOK, D, C.G, C.bid); pg8::EpiResF E{0, X1b, X2b, ssq2};
      pg8::gemm_phase<pg8::EpiResF, pg8::DenseOrder, true>((LAS unsigned char*)lds, pg8::Gemm{D, D, D}, S, E); }
    GRID_SYNC();
    for (int r = gw; r < NTOK; r += NGW) router_row(r, lane, X2b, ssq2, norm_moe, w_gr, b_gr, w_er, b_er, selw, sele);
    GRID_SYNC();
    {
        LAS float* t = (LAS float*)lds;
        const int slot = C.tid >> 8, f = C.tid & 255;
        for (int row = C.bid; row < NTOK; row += C.G) {
            const float rs = pg8::rstd16(ssq2 + (size_t)row * 16);
            for (int k = C.tid; k < D; k += NTHREADS) t[k] = bf2f(X2b[(size_t)row * D + k]) * rs * norm_moe[k];
            __syncthreads();
            const int e = sele[(size_t)row * 2 + slot]; const float w = selw[(size_t)row * 2 + slot];
            const float* wg = w_gate + (size_t)e * D * DE + f; const float* wu = w_up + (size_t)e * D * DE + f;
            float ga = 0.f, ua = 0.f;
            for (int k = 0; k < D; ++k) { ga += t[k] * wg[(size_t)k * DE]; ua += t[k] * wu[(size_t)k * DE]; }
            HIDn[((size_t)row * 2 + slot) * DE + f] = ga * sigmoidf_(ga) * ua * w;
            __syncthreads();
        }
    }
    GRID_SYNC();
    {
        LAS float* hs = (LAS float*)lds;
        for (int row = C.bid; row < NTOK; row += C.G) {
            hs[C.tid] = HIDn[(size_t)row * 2 * DE + C.tid];
            __syncthreads();
            float o0 = 0.f, o1 = 0.f;
            for (int s = 0; s < 2; ++s) { const float* wd = w_down + (size_t)sele[(size_t)row * 2 + s] * DE * D;
                for (int f = 0; f < DE; ++f) { const float hv = hs[s * DE + f]; o0 += hv * wd[(size_t)f * D + C.tid]; o1 += hv * wd[(size_t)f * D + 512 + C.tid]; } }
            X3b[(size_t)row * D + C.tid] = (bf16_t)f2bf(bf2f(X2b[(size_t)row * D + C.tid]) + o0);
            X3b[(size_t)row * D + 512 + C.tid] = (bf16_t)f2bf(bf2f(X2b[(size_t)row * D + 512 + C.tid]) + o1);
            __syncthreads();
        }
    }
    GRID_SYNC();
    for (int r = gw; r < NTOK; r += NGW) final_row(r, lane, X3b, norm_final, out);
}

extern "C" void kernel_launch(void* const* d_in, const int* in_sizes, int n_in, void* d_out, int out_size, void* d_ws, size_t ws_size, hipStream_t stream) {
    static int grid = 0;
    if (grid == 0) {
        if (n_in != 29 || ws_size < WS_END) { fprintf(stderr, "kernel_launch: unexpected inputs (%d) or workspace (%zu)\n", n_in, ws_size); grid = -1; return; }
        int dev = 0, cus = 0, per_cu = 0;
        hipGetDevice(&dev); hipDeviceGetAttribute(&cus, hipDeviceAttributeMultiprocessorCount, dev);
        hipFuncSetAttribute((const void*)mk_fwd, hipFuncAttributeMaxDynamicSharedMemorySize, LDS_BYTES);
        hipOccupancyMaxActiveBlocksPerMultiprocessor(&per_cu, (const void*)mk_fwd, NTHREADS, LDS_BYTES);
        if (per_cu < 1) { fprintf(stderr, "kernel_launch: occupancy query says %d blocks per CU\n", per_cu); per_cu = 1; }
        if (per_cu > 1) per_cu = 1;
        grid = cus * per_cu;
    }
    if (grid < 0) return;
    Args a{};
    for (int i = 0; i < 29; ++i) a.in[i] = (const float*)d_in[i];
    a.out = (float*)d_out; a.ws = (unsigned char*)d_ws;
    void* kargs[] = {&a};
    hipError_t e = hipLaunchCooperativeKernel((const void*)mk_fwd, dim3(grid), dim3(NTHREADS), kargs, LDS_BYTES, stream);
    if (e != hipSuccess) fprintf(stderr, "cooperative launch failed: %s (grid %d)\n", hipGetErrorString(e), grid);
}
```

```cpp
#include <hip/hip_runtime.h>
#include <hip/hip_cooperative_groups.h>
#include <cstdio>
#include <cstdint>

typedef unsigned short bf16_t;
typedef short bf16x8 __attribute__((ext_vector_type(8)));
typedef float f32x4 __attribute__((ext_vector_type(4)));
typedef unsigned u32x4 __attribute__((ext_vector_type(4)));

constexpr int D = 1024, BATCH = 8, SEQ = 4096, NTOK = BATCH * SEQ, MEM = 256, NMEM = BATCH * MEM;
constexpr int RW = 512, SBW = 512, PROJ = 2560, NH = 8, HD = 64;
constexpr int XH = 4, XD = 256, NG = 4, EPG = 4, NEXP = 16, DE = 256;
constexpr float EPS = 1e-6f, LOG2E = 1.4426950408889634f;

constexpr size_t MiB = 1u << 20;
constexpr size_t WS_CTL = 0;
constexpr size_t WS_SMALL = 1 * MiB;
constexpr size_t WS_WIN = 16 * MiB;
constexpr size_t WS_WOUT = 21 * MiB;
constexpr size_t WS_WQ = 23 * MiB;
constexpr size_t WS_WKV = 25 * MiB;
constexpr size_t WS_WO = 29 * MiB;
constexpr size_t WS_MEMN = 31 * MiB;
constexpr size_t WS_KVM = 35 * MiB;
constexpr size_t WS_WG = 43 * MiB;
constexpr size_t WS_WU = 51 * MiB;
constexpr size_t WS_WD2 = 59 * MiB;
constexpr size_t WS_R0 = 96 * MiB;
constexpr size_t WS_R1 = 160 * MiB;
constexpr size_t WS_R2 = 224 * MiB;
constexpr size_t WS_R3 = 288 * MiB;
constexpr size_t WS_R4 = 320 * MiB;
constexpr size_t WS_R5 = 384 * MiB;
constexpr size_t WS_END = 448 * MiB;

constexpr size_t SM_RSTD0 = 0;
constexpr size_t SM_SSQR = 1 * 32768;
constexpr size_t SM_SSQS = 2 * 32768;
constexpr size_t SM_SSQ1 = 10 * 32768;
constexpr size_t SM_SSQ2 = 26 * 32768;
constexpr size_t SM_SSQ3 = 42 * 32768;
constexpr size_t SM_SELW = 58 * 32768;
constexpr size_t SM_SELE = 60 * 32768;
constexpr size_t SM_END = 62 * 32768;

__device__ __forceinline__ unsigned f2bf(float f) { unsigned u = __builtin_bit_cast(unsigned, f); return (u + 0x7fffu + ((u >> 16) & 1u)) >> 16; }
__device__ __forceinline__ float bf2f(unsigned short h) { return __builtin_bit_cast(float, (unsigned)h << 16); }
__device__ __forceinline__ float wave_sum(float v) {
#pragma unroll
    for (int o = 1; o < 64; o <<= 1) v += __shfl_xor(v, o);
    return v;
}
__device__ __forceinline__ float gelu_tanh(float x) { const float u = 0.7978845608028654f * (x + 0.044715f * x * x * x); return x / (1.f + __expf(-2.f * u)); }
__device__ __forceinline__ float sigmoidf_(float x) { return 1.f / (1.f + __expf(-x)); }

namespace cg = cooperative_groups;
#define LAS __attribute__((address_space(3)))
constexpr int NWAVES = 8, NTHREADS = 512;
constexpr int LDS_BYTES = 147456;

struct Args { const float* in[29]; float* out; unsigned char* ws; };

struct Ctx {
    const float* in[29]; float* out; unsigned char* ws; unsigned char* lds;
    int tid, lane, wave, gw, NGW, G, bid;
};

namespace pg8 {
#define PG8_LAS __attribute__((address_space(3)))
constexpr int BM = 256, BK = 64, HALF = 128, HTB = HALF * BK * 2  , STAGE_BYTES = 8 * HTB, NXCD = 8, WGM = 8;
__host__ __device__ __forceinline__ int lds_byte(int r, int c) { const int st = (r >> 4) * 2 + (c >> 5), rr = r & 15, cc = c & 31, ob = rr * 64 + cc * 2; return st * 1024 + (ob ^ (((ob >> 9) & 1) << 5)); }
__host__ __device__ __forceinline__ void stage_rc(int b, int& R, int& C) { const int st = b / 1024, sb = b % 1024, swz = sb ^ (((sb >> 9) & 1) << 5); R = (st >> 1) * 16 + swz / 64; C = (st & 1) * 32 + (swz % 64) / 2; }
__host__ __device__ __forceinline__ int perm32(int rho) { const int n = rho >> 4, i = rho & 15; return 8 * (i >> 2) + 4 * n + (i & 3); }

struct Unit { int pm, pn; };
struct Gemm { int lda, ldb, K; };
struct DenseOrder {
    const bf16_t* A; const bf16_t* Bt; int lda, ldb; int nM, nN, nwg, G, c;
    __device__ void init(const bf16_t* A_, int lda_, const bf16_t* Bt_, int ldb_, int M, int N, int G_, int c_) { A = A_; Bt = Bt_; lda = lda_; ldb = ldb_; nM = M / BM; nN = N / BM; nwg = nM * nN; G = G_; c = c_; }
    __device__ bool next(int i, Unit& u) const {
        const long L = (long)i * G + c; if (L >= nwg) return false;
        int wgid = (int)L; { const int q = nwg / NXCD, r = nwg % NXCD, xcd = wgid % NXCD, off = wgid / NXCD; wgid = (xcd < r ? xcd * (q + 1) : r * (q + 1) + (xcd - r) * q) + off; }
        const int nig = WGM * nN, gid = wgid / nig, fm = gid * WGM, gsz = (nM - fm) < WGM ? (nM - fm) : WGM;
        u.pm = fm + ((wgid % nig) % gsz); u.pn = (wgid % nig) / gsz; return true;
    }
    __device__ __forceinline__ void ptrs(const Unit& u, const char*& a, const char*& b0, const char*& b1) const {
        a = (const char*)A + (size_t)u.pm * BM * lda * 2; b0 = (const char*)Bt + (size_t)u.pn * BM * ldb * 2; b1 = b0 + (size_t)HALF * ldb * 2; }
};

__device__ __forceinline__ unsigned cvt_pk_bf16(float lo, float hi) { unsigned r; asm volatile("v_cvt_pk_bf16_f32 %0, %1, %2" : "=v"(r) : "v"(lo), "v"(hi)); return r; }

template <class Epi, class Sched, bool ALIGN_EPI>
__device__ __forceinline__ void gemm_phase(PG8_LAS unsigned char* lds, const Gemm g, const Sched& S, const Epi& E) {
    const int tid = threadIdx.x, wid = __builtin_amdgcn_readfirstlane(tid >> 6), lane = tid & 63, wr = wid >> 2, wc = wid & 3, fr = lane & 15, fq = lane >> 4;
    const int K = g.K, nt = K / BK;
    unsigned voffA[2], voffB[2];
#pragma unroll
    for (int i = 0; i < 2; ++i) { int R, C; stage_rc(tid * 16 + i * 8192, R, C); const int Rb = Epi::PERM ? ((R & ~31) + perm32(R & 31)) : R;
        voffA[i] = (unsigned)(R * g.lda + C) * 2u; voffB[i] = (unsigned)(Rb * g.ldb + C) * 2u; }
    const size_t kstep = (size_t)(BK * 2);
    const size_t hstepA = (size_t)HALF * g.lda * 2;
    const unsigned ldsw = (unsigned)wid * 1024u;
    const int aoff = lds_byte(wr * 64 + fr, fq * 8), boff = lds_byte(wc * 32 + fr, fq * 8);
#define PG8_SA(b, h) (((b) * 2 + (h)) * HTB)
#define PG8_SB(b, h) ((4 + (b) * 2 + (h)) * HTB)
#define PG8_STAGE(bufoff, gbase, voff) do { _Pragma("unroll") for (int _i = 0; _i < 2; ++_i) \
        __builtin_amdgcn_global_load_lds((const unsigned*)((const char*)(gbase) + (voff)[_i]), (PG8_LAS unsigned*)(lds + (bufoff) + ldsw + _i * 8192), 16, 0, 0); } while (0)
#define PG8_LDA(dst, b, h) do { _Pragma("unroll") for (int m = 0; m < 4; ++m) _Pragma("unroll") for (int k = 0; k < 2; ++k) dst[m][k] = *(const PG8_LAS bf16x8*)(lds + PG8_SA(b, h) + aoff + m * 2048 + k * 1024); } while (0)
#define PG8_LDB(dst, b, h) do { _Pragma("unroll") for (int n = 0; n < 2; ++n) _Pragma("unroll") for (int k = 0; k < 2; ++k) dst[n][k] = *(const PG8_LAS bf16x8*)(lds + PG8_SB(b, h) + boff + n * 2048 + k * 1024); } while (0)
#define PG8_MMA(ai, bj, At, Bt) do { __builtin_amdgcn_s_setprio(1); _Pragma("unroll") for (int m = 0; m < 4; ++m) _Pragma("unroll") for (int n = 0; n < 2; ++n) _Pragma("unroll") for (int k = 0; k < 2; ++k) \
        acc[ai][bj][m][n] = __builtin_amdgcn_mfma_f32_16x16x32_bf16(Bt[n][k], At[m][k], acc[ai][bj][m][n], 0, 0, 0); __builtin_amdgcn_s_setprio(0); } while (0)
#define PG8_WAIT_V(n) asm volatile("s_waitcnt vmcnt(" #n ")" ::: "memory")
#define PG8_WAIT_L(n) asm volatile("s_waitcnt lgkmcnt(" #n ")" ::: "memory")
#define PG8_BAR __builtin_amdgcn_s_barrier()
#define PG8_SCHED __builtin_amdgcn_sched_barrier(0)
    Unit cur, nxt; int ui = 0;
    if (!S.next(0, cur)) return;
    f32x4 acc[2][2][4][2];
#pragma unroll
    for (int a = 0; a < 2; ++a)
#pragma unroll
        for (int b = 0; b < 2; ++b)
#pragma unroll
            for (int m = 0; m < 4; ++m)
#pragma unroll
                for (int n = 0; n < 2; ++n) acc[a][b][m][n] = (f32x4){0.f, 0.f, 0.f, 0.f};
    bf16x8 At[4][2], B0[2][2], B1[2][2];
    const char *cA, *cB0, *cB1; S.ptrs(cur, cA, cB0, cB1);
    PG8_STAGE(PG8_SB(0, 0), cB0, voffB); PG8_STAGE(PG8_SB(0, 1), cB1, voffB); PG8_STAGE(PG8_SA(0, 0), cA, voffA); PG8_STAGE(PG8_SA(0, 1), cA + hstepA, voffA);
    if (wr == 1) PG8_BAR;
    PG8_WAIT_V(2); PG8_BAR;
    PG8_STAGE(PG8_SB(1, 0), cB0 + kstep, voffB); PG8_STAGE(PG8_SA(1, 0), cA + kstep, voffA); PG8_STAGE(PG8_SB(1, 1), cB1 + kstep, voffB);
    PG8_WAIT_V(6); PG8_BAR;
    for (;;) {
        const bool has_next = S.next(ui + 1, nxt);
        const char *nA = cA, *nB0 = cB0, *nB1 = cB1; if (has_next) S.ptrs(nxt, nA, nB0, nB1);
        for (int t = 0; t < nt; t += 2) {
            const bool last = (t == nt - 2);
            if constexpr (Epi::HAS_MID) { if (t == E.mid_t) E.mid(acc, cur, wr, wc, fr, fq); }
            const char* a1 = cA + (size_t)(t + 1) * kstep;
            const char* a2 = last ? nA : cA + (size_t)(t + 2) * kstep; const char* b2 = last ? nB0 : cB0 + (size_t)(t + 2) * kstep; const char* b2h = last ? nB1 : cB1 + (size_t)(t + 2) * kstep;
            const char* a3 = a2 + kstep; const char* b3 = b2 + kstep; const char* b3h = b2h + kstep;
            PG8_LDB(B0, 0, 0); PG8_LDB(B1, 0, 1); PG8_SCHED; PG8_LDA(At, 0, 0); PG8_STAGE(PG8_SA(1, 1), a1 + hstepA, voffA);
            PG8_WAIT_V(8); PG8_WAIT_L(0); PG8_BAR; PG8_MMA(0, 0, At, B0); PG8_MMA(0, 1, At, B1); PG8_BAR; PG8_SCHED;
            PG8_LDA(At, 0, 1); PG8_STAGE(PG8_SB(0, 0), b2, voffB); PG8_STAGE(PG8_SB(0, 1), b2h, voffB); PG8_STAGE(PG8_SA(0, 0), a2, voffA);
            PG8_WAIT_V(8); PG8_WAIT_L(0); PG8_BAR; PG8_MMA(1, 0, At, B0); PG8_MMA(1, 1, At, B1); PG8_BAR; PG8_SCHED;
            PG8_LDB(B0, 1, 0); PG8_LDB(B1, 1, 1); PG8_SCHED; PG8_LDA(At, 1, 0); PG8_STAGE(PG8_SA(0, 1), a2 + hstepA, voffA);
            PG8_WAIT_V(8); PG8_WAIT_L(0); PG8_BAR; PG8_MMA(0, 0, At, B0); PG8_MMA(0, 1, At, B1); PG8_BAR; PG8_SCHED;
            PG8_LDA(At, 1, 1); PG8_STAGE(PG8_SB(1, 0), b3, voffB); PG8_STAGE(PG8_SB(1, 1), b3h, voffB); PG8_STAGE(PG8_SA(1, 0), a3, voffA);
            PG8_WAIT_V(8); PG8_WAIT_L(0); PG8_BAR; PG8_MMA(1, 0, At, B0); PG8_MMA(1, 1, At, B1); PG8_BAR; PG8_SCHED;
        }
        if constexpr (ALIGN_EPI) { if (wr == 0) PG8_BAR; }
        E(acc, cur, wr, wc, fr, fq);
        if (!has_next) break;
#pragma unroll
        for (int a = 0; a < 2; ++a)
#pragma unroll
            for (int b = 0; b < 2; ++b)
#pragma unroll
                for (int m = 0; m < 4; ++m)
#pragma unroll
                    for (int n = 0; n < 2; ++n) acc[a][b][m][n] = (f32x4){0.f, 0.f, 0.f, 0.f};
        cur = nxt; cA = nA; cB0 = nB0; cB1 = nB1; ++ui;
        if constexpr (ALIGN_EPI) { if (wr == 1) PG8_BAR; }
    }
    PG8_WAIT_V(0);
    if constexpr (!ALIGN_EPI) { if (wr == 0) PG8_BAR; }
    PG8_BAR;
#undef PG8_SA
#undef PG8_SB
#undef PG8_STAGE
#undef PG8_LDA
#undef PG8_LDB
#undef PG8_MMA
#undef PG8_WAIT_V
#undef PG8_WAIT_L
#undef PG8_BAR
#undef PG8_SCHED
}

__device__ __forceinline__ float rstd16(const float* p) { const f32x4 a = ((const f32x4*)p)[0], b = ((const f32x4*)p)[1], c = ((const f32x4*)p)[2], d = ((const f32x4*)p)[3];
    const float s = ((a.x + a.y) + (a.z + a.w)) + ((b.x + b.y) + (b.z + b.w)) + ((c.x + c.y) + (c.z + c.w)) + ((d.x + d.y) + (d.z + d.w)); return 1.0f / sqrtf(s * (1.f / D) + EPS); }
__device__ __forceinline__ u32x4 pack8(const f32x4 v0, const f32x4 v1) { u32x4 w; w.x = cvt_pk_bf16(v0[0], v0[1]); w.y = cvt_pk_bf16(v0[2], v0[3]); w.z = cvt_pk_bf16(v1[0], v1[1]); w.w = cvt_pk_bf16(v1[2], v1[3]); return w; }
__device__ __forceinline__ float sq8(const f32x4 a, const f32x4 b) { return ((a[0] * a[0] + a[1] * a[1]) + (a[2] * a[2] + a[3] * a[3])) + ((b[0] * b[0] + b[1] * b[1]) + (b[2] * b[2] + b[3] * b[3])); }

struct EpiInProjF {
    static constexpr bool PERM = true, HAS_MID = false; int mid_t;
    const float* rstd0; bf16_t *XR, *GG, *Qs, *Ks, *Vs; unsigned* kmax;
    __device__ __forceinline__ void mid(f32x4 (&)[2][2][4][2], const Unit&, int, int, int, int) const {}
    __device__ __forceinline__ void operator()(const f32x4 (&acc)[2][2][4][2], const Unit& u, int wr, int wc, int fr, int fq) const {
        const int row0 = u.pm * BM + wr * 64 + fr, t = u.pn >> 1, colt = (u.pn & 1) * 256 + wc * 32 + 8 * fq;
        bf16_t* base = (t == 0) ? XR : (t == 1) ? GG : (t == 2) ? Qs : (t == 3) ? Ks : Vs;
        float km0 = 0.f, km1 = 0.f;
#pragma unroll
        for (int ai = 0; ai < 2; ++ai)
#pragma unroll
            for (int m = 0; m < 4; ++m) { const int r = row0 + ai * HALF + m * 16; const float rs = rstd0[r]; bf16_t* rowp = base + (size_t)r * 512 + colt;
#pragma unroll
                for (int bj = 0; bj < 2; ++bj) { f32x4 v0 = acc[ai][bj][m][0] * rs, v1 = acc[ai][bj][m][1] * rs;
                    if (t == 1) {
#pragma unroll
                        for (int e = 0; e < 4; ++e) { v0[e] = gelu_tanh(v0[e]); v1[e] = gelu_tanh(v1[e]); } }
                    else if (t == 2) { v0 = v0 * (0.125f * LOG2E); v1 = v1 * (0.125f * LOG2E); }
                    else if (t == 3) { float mx = 0.f;
#pragma unroll
                        for (int e = 0; e < 4; ++e) mx = fmaxf(mx, fmaxf(fabsf(v0[e]), fabsf(v1[e])));
                        if (bj == 0) km0 = fmaxf(km0, mx); else km1 = fmaxf(km1, mx); }
                    *(u32x4*)(rowp + bj * HALF) = pack8(v0, v1); } }
        if (t == 3) {
#pragma unroll
            for (int o = 1; o < 64; o <<= 1) { km0 = fmaxf(km0, __shfl_xor(km0, o)); km1 = fmaxf(km1, __shfl_xor(km1, o)); }
            if ((fr | fq) == 0) { const int b = (u.pm * BM) / SEQ, hd = (u.pn & 1) * 4 + (wc >> 1);
                atomicMax(kmax + b * 8 + hd, __float_as_uint(km0)); atomicMax(kmax + b * 8 + hd + 2, __float_as_uint(km1)); }
        }
    }
};
struct EpiBf16F {
    static constexpr bool PERM = true, HAS_MID = false; int mid_t;
    bf16_t* O; const float* ssq16; int ldo; float scale;
    __device__ __forceinline__ void mid(f32x4 (&)[2][2][4][2], const Unit&, int, int, int, int) const {}
    __device__ __forceinline__ void operator()(const f32x4 (&acc)[2][2][4][2], const Unit& u, int wr, int wc, int fr, int fq) const {
        const int row0 = u.pm * BM + wr * 64 + fr, col0 = u.pn * BM + wc * 32 + 8 * fq;
#pragma unroll
        for (int ai = 0; ai < 2; ++ai)
#pragma unroll
            for (int m = 0; m < 4; ++m) { const int r = row0 + ai * HALF + m * 16; const float rs = (ssq16 ? rstd16(ssq16 + (size_t)r * 16) : 1.f) * scale; bf16_t* rowp = O + (size_t)r * ldo + col0;
#pragma unroll
                for (int bj = 0; bj < 2; ++bj) *(u32x4*)(rowp + bj * HALF) = pack8(acc[ai][bj][m][0] * rs, acc[ai][bj][m][1] * rs); }
    }
};
struct EpiX1F {
    static constexpr bool PERM = true, HAS_MID = true; int mid_t;
    const float* x; const float* fmid; const float* fend; bf16_t* X1b; float* ssq1;
    __device__ __forceinline__ void mid(f32x4 (&acc)[2][2][4][2], const Unit& u, int wr, int wc, int fr, int fq) const {
        const int row0 = u.pm * BM + wr * 64 + fr;
#pragma unroll
        for (int ai = 0; ai < 2; ++ai)
#pragma unroll
            for (int m = 0; m < 4; ++m) { const float f = fmid[row0 + ai * HALF + m * 16];
#pragma unroll
                for (int bj = 0; bj < 2; ++bj) { acc[ai][bj][m][0] = acc[ai][bj][m][0] * f; acc[ai][bj][m][1] = acc[ai][bj][m][1] * f; } }
    }
    __device__ __forceinline__ void operator()(const f32x4 (&acc)[2][2][4][2], const Unit& u, int wr, int wc, int fr, int fq) const {
        const int row0 = u.pm * BM + wr * 64 + fr, col0 = u.pn * BM + wc * 32 + 8 * fq;
#pragma unroll
        for (int ai = 0; ai < 2; ++ai)
#pragma unroll
            for (int m = 0; m < 4; ++m) { const int r = row0 + ai * HALF + m * 16; const float fe = fend[r]; const float* xr = x + (size_t)r * D + col0; float ss = 0.f;
#pragma unroll
                for (int bj = 0; bj < 2; ++bj) { const f32x4 v0 = *(const f32x4*)(xr + bj * HALF) + acc[ai][bj][m][0] * fe, v1 = *(const f32x4*)(xr + bj * HALF + 4) + acc[ai][bj][m][1] * fe;
                    ss += sq8(v0, v1); *(u32x4*)(X1b + (size_t)r * D + col0 + bj * HALF) = pack8(v0, v1); }
                ss += __shfl_xor(ss, 16); ss += __shfl_xor(ss, 32);
                if (fq == 0) ssq1[(size_t)r * 16 + u.pn * 4 + wc] = ss;
                asm volatile("" ::: "memory"); }
    }
};
struct EpiResF {
    static constexpr bool PERM = true, HAS_MID = false; int mid_t;
    const bf16_t* Xi; bf16_t* Xo; float* ssq;
    __device__ __forceinline__ void mid(f32x4 (&)[2][2][4][2], const Unit&, int, int, int, int) const {}
    __device__ __forceinline__ void operator()(const f32x4 (&acc)[2][2][4][2], const Unit& u, int wr, int wc, int fr, int fq) const {
        const int row0 = u.pm * BM + wr * 64 + fr, col0 = u.pn * BM + wc * 32 + 8 * fq;
#pragma unroll
        for (int ai = 0; ai < 2; ++ai)
#pragma unroll
            for (int m = 0; m < 4; ++m) { const int r = row0 + ai * HALF + m * 16; float ss = 0.f;
#pragma unroll
                for (int bj = 0; bj < 2; ++bj) { const u32x4 xi = *(const u32x4*)(Xi + (size_t)r * D + col0 + bj * HALF);
                    f32x4 v0, v1; v0[0] = __uint_as_float(xi.x << 16); v0[1] = __uint_as_float(xi.x & 0xffff0000u); v0[2] = __uint_as_float(xi.y << 16); v0[3] = __uint_as_float(xi.y & 0xffff0000u);
                    v1[0] = __uint_as_float(xi.z << 16); v1[1] = __uint_as_float(xi.z & 0xffff0000u); v1[2] = __uint_as_float(xi.w << 16); v1[3] = __uint_as_float(xi.w & 0xffff0000u);
                    v0 = v0 + acc[ai][bj][m][0]; v1 = v1 + acc[ai][bj][m][1];
                    ss += sq8(v0, v1); *(u32x4*)(Xo + (size_t)r * D + col0 + bj * HALF) = pack8(v0, v1); }
                ss += __shfl_xor(ss, 16); ss += __shfl_xor(ss, 32);
                if (fq == 0) ssq[(size_t)r * 16 + u.pn * 4 + wc] = ss; }
    }
};

__device__ __forceinline__ void pair_ab(int p, int& a, int& b) { a = (p < 3) ? 0 : (p < 5) ? 1 : 2; b = (p < 3) ? p + 1 : (p < 5) ? p - 1 : 3; }
__device__ __forceinline__ int moe_class_of_tile(const PG8_LAS int* meta, int T) { int c = 0;
#pragma unroll
    for (int k = 1; k < 24; ++k) c += (T >= __builtin_amdgcn_readfirstlane(meta[64 + k])) ? 1 : 0;
    return c; }
struct MoeOrder1 {
    const bf16_t* XG; const bf16_t* Wg; const bf16_t* Wu; const PG8_LAS int* meta; int G, c;
    __device__ bool next(int i, Unit& u) const { const int L = i * G + c, nt = __builtin_amdgcn_readfirstlane(meta[64 + 24]); if (L >= nt * 4) return false;
        u.pm = L >> 2; u.pn = moe_class_of_tile(meta, L >> 2) * 4 + (L & 3); return true; }
    __device__ __forceinline__ void ptrs(const Unit& u, const char*& a, const char*& b0, const char*& b1) const {
        const int cls = u.pn >> 2, j = (u.pn >> 1) & 1, half = u.pn & 1; int ea, eb; pair_ab(cls % 6, ea, eb); const int e = (cls / 6) * 4 + (j ? eb : ea);
        a = (const char*)XG + (size_t)u.pm * BM * D * 2; const size_t bo = ((size_t)e * DE + half * HALF) * D * 2; b0 = (const char*)Wg + bo; b1 = (const char*)Wu + bo; }
};
struct MoeOrder2 {
    const bf16_t* HID; const bf16_t* Wd2; const PG8_LAS int* meta; int G, c;
    __device__ bool next(int i, Unit& u) const { const int L = i * G + c, nt = __builtin_amdgcn_readfirstlane(meta[64 + 24]); if (L >= nt * 4) return false;
        u.pm = L >> 2; u.pn = moe_class_of_tile(meta, L >> 2) * 4 + (L & 3); return true; }
    __device__ __forceinline__ void ptrs(const Unit& u, const char*& a, const char*& b0, const char*& b1) const {
        a = (const char*)HID + (size_t)u.pm * BM * 512 * 2; b0 = (const char*)Wd2 + ((size_t)(u.pn >> 2) * D + (u.pn & 3) * BM) * 512 * 2; b1 = b0 + (size_t)HALF * 512 * 2; }
};
struct EpiMoeUp {
    static constexpr bool PERM = true, HAS_MID = false; int mid_t;
    const float* rsg; const float* wAg; const float* wBg; bf16_t* HID;
    __device__ __forceinline__ void mid(f32x4 (&)[2][2][4][2], const Unit&, int, int, int, int) const {}
    __device__ __forceinline__ void operator()(const f32x4 (&acc)[2][2][4][2], const Unit& u, int wr, int wc, int fr, int fq) const {
        const int row0 = u.pm * BM + wr * 64 + fr, j = (u.pn >> 1) & 1, col0 = j * 256 + (u.pn & 1) * HALF + wc * 32 + 8 * fq; const float* wg = j ? wBg : wAg;
#pragma unroll
        for (int ai = 0; ai < 2; ++ai)
#pragma unroll
            for (int m = 0; m < 4; ++m) { const int r = row0 + ai * HALF + m * 16; const float rs = rsg[r], w = wg[r]; f32x4 h0, h1;
#pragma unroll
                for (int e = 0; e < 4; ++e) { const float g0 = acc[ai][0][m][0][e] * rs, g1 = acc[ai][0][m][1][e] * rs;
                    h0[e] = g0 / (1.f + __expf(-g0)) * (acc[ai][1][m][0][e] * rs) * w; h1[e] = g1 / (1.f + __expf(-g1)) * (acc[ai][1][m][1][e] * rs) * w; }
                *(u32x4*)(HID + (size_t)r * 512 + col0) = pack8(h0, h1); }
    }
};
struct EpiMoeDown {
    static constexpr bool PERM = true, HAS_MID = false; int mid_t;
    const int* tokg; const bf16_t* Xi; bf16_t* Xo; float* ssq;
    __device__ __forceinline__ void mid(f32x4 (&)[2][2][4][2], const Unit&, int, int, int, int) const {}
    __device__ __forceinline__ void operator()(const f32x4 (&acc)[2][2][4][2], const Unit& u, int wr, int wc, int fr, int fq) const {
        const int row0 = u.pm * BM + wr * 64 + fr, ct = u.pn & 3, col0 = ct * BM + wc * 32 + 8 * fq;
#pragma unroll
        for (int ai = 0; ai < 2; ++ai)
#pragma unroll
            for (int m = 0; m < 4; ++m) { const int tok = tokg[row0 + ai * HALF + m * 16];
                if (tok >= 0) { float ss = 0.f;
#pragma unroll
                    for (int bj = 0; bj < 2; ++bj) { const u32x4 xi = *(const u32x4*)(Xi + (size_t)tok * D + col0 + bj * HALF);
                        f32x4 v0, v1; v0[0] = __uint_as_float(xi.x << 16); v0[1] = __uint_as_float(xi.x & 0xffff0000u); v0[2] = __uint_as_float(xi.y << 16); v0[3] = __uint_as_float(xi.y & 0xffff0000u);
                        v1[0] = __uint_as_float(xi.z << 16); v1[1] = __uint_as_float(xi.z & 0xffff0000u); v1[2] = __uint_as_float(xi.w << 16); v1[3] = __uint_as_float(xi.w & 0xffff0000u);
                        v0 = v0 + acc[ai][bj][m][0]; v1 = v1 + acc[ai][bj][m][1];
                        ss += sq8(v0, v1); *(u32x4*)(Xo + (size_t)tok * D + col0 + bj * HALF) = pack8(v0, v1); }
                    ss += __shfl_xor(ss, 16); ss += __shfl_xor(ss, 32);
                    if (fq == 0) ssq[(size_t)tok * 16 + ct * 4 + wc] = ss; } }
    }
};
}
__device__ __forceinline__ void row_prep_x(const float* x, bf16_t* xb, float* rstd0, int row, int lane) {
    const f32x4* xr = (const f32x4*)(x + (size_t)row * D) + lane;
    float s = 0.f; f32x4 v[4];
#pragma unroll
    for (int j = 0; j < 4; ++j) { v[j] = xr[64 * j]; s += v[j].x * v[j].x + v[j].y * v[j].y + v[j].z * v[j].z + v[j].w * v[j].w; }
    s = wave_sum(s);
    if (lane == 0) rstd0[row] = 1.0f / sqrtf(s * (1.f / D) + EPS);
    unsigned long long* o8 = (unsigned long long*)(xb + (size_t)row * D) + lane;
#pragma unroll
    for (int j = 0; j < 4; ++j) o8[64 * j] = (unsigned long long)(f2bf(v[j].x) | (f2bf(v[j].y) << 16)) | ((unsigned long long)(f2bf(v[j].z) | (f2bf(v[j].w) << 16)) << 32);
}
__device__ __forceinline__ void row_prep_mem(const float* m, const float* g, bf16_t* o, int row, int lane) {
    const f32x4* xr = (const f32x4*)(m + (size_t)row * D) + lane;
    float s = 0.f; f32x4 v[4];
#pragma unroll
    for (int j = 0; j < 4; ++j) { v[j] = xr[64 * j]; s += v[j].x * v[j].x + v[j].y * v[j].y + v[j].z * v[j].z + v[j].w * v[j].w; }
    s = wave_sum(s);
    const float r = 1.0f / sqrtf(s * (1.f / D) + EPS);
    unsigned long long* o8 = (unsigned long long*)(o + (size_t)row * D) + lane;
#pragma unroll
    for (int j = 0; j < 4; ++j) { const f32x4 gg = ((const f32x4*)g)[64 * j + lane];
        o8[64 * j] = (unsigned long long)(f2bf(v[j].x * r * gg.x) | (f2bf(v[j].y * r * gg.y) << 16)) | ((unsigned long long)(f2bf(v[j].z * r * gg.z) | (f2bf(v[j].w * r * gg.w) << 16)) << 32); }
}
__device__ __forceinline__ void transpose_item(const float* W, int K, int N, bf16_t* Wt, int ldt, const float* g0, const float* g1, int ksplit, LAS float* scr, int item, int lane) {
    const int nblk = N / 32, kb = item / nblk, nb = item % nblk, k0 = 64 * kb, n0 = 32 * nb;
#pragma unroll 8
    for (int i = 0; i < 32; ++i) { const int kk = 2 * i + (lane >> 5), k = k0 + kk; float gv = 1.f; if (g0) gv = (k < ksplit) ? g0[k] : g1[k - ksplit];
        scr[kk * 33 + (lane & 31)] = W[(size_t)k * N + n0 + (lane & 31)] * gv; }
    asm volatile("s_waitcnt lgkmcnt(0)" ::: "memory");
    const int c = lane & 7;
#pragma unroll
    for (int j = 0; j < 4; ++j) { const int n = (lane >> 3) + 8 * j; const LAS float* s = scr + (8 * c) * 33 + n;
        u32x4 o; o.x = f2bf(s[0 * 33]) | (f2bf(s[1 * 33]) << 16); o.y = f2bf(s[2 * 33]) | (f2bf(s[3 * 33]) << 16); o.z = f2bf(s[4 * 33]) | (f2bf(s[5 * 33]) << 16); o.w = f2bf(s[6 * 33]) | (f2bf(s[7 * 33]) << 16);
        *(u32x4*)(Wt + (size_t)(n0 + n) * ldt + k0 + 8 * c) = o; }
    asm volatile("s_waitcnt lgkmcnt(0)" ::: "memory");
}

struct MidScale { const float* f; int k; int pad; };
template <class Epi>
__device__ __forceinline__ void gemm_naive(const Ctx& C, const bf16_t* A, int lda, const bf16_t* Bt, int ldb, int M, int N, int K, MidScale ms, const Epi& E) {
    const int lane = C.lane, fr = lane & 15, fq = lane >> 4, ncol = N / 64, ntile = (M / 16) * ncol;
    for (int t = C.gw; t < ntile; t += C.NGW) {
        const int row0 = (t / ncol) * 16, col0 = (t % ncol) * 64;
        const bf16_t* ap = A + (size_t)(row0 + fr) * lda + fq * 8;
        const bf16_t* bp = Bt + (size_t)(col0 + fr) * ldb + fq * 8;
        f32x4 acc[4];
#pragma unroll
        for (int n = 0; n < 4; ++n) acc[n] = (f32x4){0.f, 0.f, 0.f, 0.f};
        for (int k0 = 0; k0 < K; k0 += 32) {
            if (ms.f && k0 == ms.k) {
#pragma unroll
                for (int j = 0; j < 4; ++j) { const float f = ms.f[row0 + fq * 4 + j];
#pragma unroll
                    for (int n = 0; n < 4; ++n) acc[n][j] *= f; }
            }
            const bf16x8 a = *(const bf16x8*)(ap + k0);
#pragma unroll
            for (int n = 0; n < 4; ++n) { const bf16x8 b = *(const bf16x8*)(bp + (size_t)n * 16 * ldb + k0); acc[n] = __builtin_amdgcn_mfma_f32_16x16x32_bf16(a, b, acc[n], 0, 0, 0); }
        }
#pragma unroll
        for (int n = 0; n < 4; ++n)
#pragma unroll
            for (int j = 0; j < 4; ++j) E(row0 + fq * 4 + j, col0 + n * 16 + fr, acc[n][j]);
    }
}
struct EpiInProj { const float* rstd0; bf16_t *XR, *GG, *Qs, *Ks, *Vs;
    __device__ void operator()(int r, int c, float v) const { v *= rstd0[r]; const int t = c >> 9, cc = c & 511;
        if (t == 0) XR[(size_t)r * RW + cc] = (bf16_t)f2bf(v);
        else if (t == 1) GG[(size_t)r * RW + cc] = (bf16_t)f2bf(gelu_tanh(v));
        else if (t == 2) Qs[(size_t)r * SBW + cc] = (bf16_t)f2bf(v * (0.125f * LOG2E));
        else if (t == 3) Ks[(size_t)r * SBW + cc] = (bf16_t)f2bf(v);
        else Vs[(size_t)r * SBW + cc] = (bf16_t)f2bf(v); } };
struct EpiStoreBf16 { bf16_t* O; const float* rowscale; int ldo; float scale;
    __device__ void operator()(int r, int c, float v) const { O[(size_t)r * ldo + c] = (bf16_t)f2bf(v * (rowscale ? rowscale[r] : 1.f) * scale); } };
struct EpiResF32 { const float* base; const float* rowscale; bf16_t* O;
    __device__ void operator()(int r, int c, float v) const { O[(size_t)r * D + c] = (bf16_t)f2bf(base[(size_t)r * D + c] + v * rowscale[r]); } };
struct EpiResBf16 { const bf16_t* base; bf16_t* O;
    __device__ void operator()(int r, int c, float v) const { O[(size_t)r * D + c] = (bf16_t)f2bf(bf2f(base[(size_t)r * D + c]) + v); } };

__device__ __forceinline__ void lru_naive_unit(int unit, int j, LAS float* xs, const bf16_t* XR, const bf16_t* GG, const float* conv_w, const float* conv_b,
                                               const float* w_a, const float* b_a, const float* w_x, const float* b_x, const float* lam, bf16_t* YY) {
    const int b = unit >> 3, h = unit & 7, c = h * 64 + j;
    float wa[64], wx[64];
#pragma unroll
    for (int i = 0; i < 64; ++i) { wa[i] = w_a[(size_t)(h * 64 + i) * 64 + j]; wx[i] = w_x[(size_t)(h * 64 + i) * 64 + j]; }
    const float ba = b_a[c], bx = b_x[c], cw0 = conv_w[c], cw1 = conv_w[RW + c], cw2 = conv_w[2 * RW + c], cw3 = conv_w[3 * RW + c], cb = conv_b[c];
    const float l = lam[c], spl = (l > 15.f) ? __expf(-l) : log1pf(__expf(-l));
    float x0 = 0.f, x1 = 0.f, x2 = 0.f, hst = 0.f;
    for (int t = 0; t < SEQ; ++t) {
        const size_t row = (size_t)b * SEQ + t;
        const float x3 = bf2f(XR[row * RW + c]);
        const float xc = cw0 * x0 + cw1 * x1 + cw2 * x2 + cw3 * x3 + cb;
        x0 = x1; x1 = x2; x2 = x3;
        asm volatile("s_waitcnt lgkmcnt(0)" ::: "memory"); xs[j] = xc; asm volatile("s_waitcnt lgkmcnt(0)" ::: "memory");
        float ra = ba, ri = bx;
#pragma unroll
        for (int i = 0; i < 64; ++i) { const float xv = xs[i]; ra += xv * wa[i]; ri += xv * wx[i]; }
        const float r = sigmoidf_(ra), ig = sigmoidf_(ri);
        const float log_a = -8.0f * r * spl, a = __expf(log_a), bb = sqrtf(fmaxf(0.f, -expm1f(2.f * log_a))) * (ig * xc);
        hst = a * hst + bb;
        YY[row * D + c] = (bf16_t)f2bf(hst * bf2f(GG[row * RW + c]));
    }
}
__device__ __forceinline__ void sb_naive_unit(int unit, int lane, const bf16_t* Qs, const bf16_t* Ks, const bf16_t* Vs, bf16_t* YY, float* ssq_s8) {
    const int qb = unit & 63, h = (unit >> 6) & 7, b = unit >> 9;
    const int t = qb * 64 + lane; const size_t row = (size_t)b * SEQ + t;
    float q[64], o[64];
#pragma unroll
    for (int d = 0; d < 64; ++d) { q[d] = bf2f(Qs[row * SBW + h * 64 + d]); o[d] = 0.f; }
    float R = 0.f;
    for (int s = qb * 64 + 62; s >= 0; --s) {
        const bf16_t* kr = Ks + ((size_t)b * SEQ + s) * SBW + h * 64; const bf16_t* vr = Vs + ((size_t)b * SEQ + s) * SBW + h * 64;
        float z = 0.f;
#pragma unroll
        for (int d = 0; d < 64; ++d) z += q[d] * bf2f(kr[d]);
        const bool valid = s < t;
        const float sp = valid ? (fmaxf(z, 0.f) + __log2f(1.f + exp2f(-fabsf(z)))) : 0.f;
        const float w = valid ? exp2f(z - (R + sp)) : 0.f;
        R += sp;
        const float wb = bf2f((bf16_t)f2bf(w));
#pragma unroll
        for (int d = 0; d < 64; ++d) o[d] += wb * bf2f(vr[d]);
    }
    float ss = 0.f;
#pragma unroll
    for (int d = 0; d < 64; ++d) { ss += o[d] * o[d]; YY[row * D + RW + h * 64 + d] = (bf16_t)f2bf(o[d]); }
    ssq_s8[row * 8 + h] = ss;
}
__device__ __forceinline__ void xattn_naive_unit(int unit, int j, LAS float* qs, LAS float* ps, const bf16_t* QX, const bf16_t* KVM, bf16_t* OX) {
    const int tg = unit & 511, h = (unit >> 9) & 3, b = unit >> 11, lane = j & 63, wid = j >> 6;
    const size_t row0 = (size_t)b * SEQ + tg * 8;
    for (int i = 0; i < 8; ++i) qs[i * 256 + j] = bf2f(QX[(row0 + i) * D + h * XD + j]);
    __syncthreads();
    const bf16_t* kr = KVM + ((size_t)b * MEM + j) * 2048 + h * XD;
    float sc[8];
#pragma unroll
    for (int i = 0; i < 8; ++i) sc[i] = 0.f;
    for (int d = 0; d < XD; ++d) { const float kv = bf2f(kr[d]);
#pragma unroll
        for (int i = 0; i < 8; ++i) sc[i] += qs[i * 256 + d] * kv; }
#pragma unroll
    for (int i = 0; i < 8; ++i) ps[i * 256 + j] = sc[i];
    __syncthreads();
    for (int i = wid * 2; i < wid * 2 + 2; ++i) {
        float v0 = ps[i * 256 + lane], v1 = ps[i * 256 + lane + 64], v2 = ps[i * 256 + lane + 128], v3 = ps[i * 256 + lane + 192];
        float m = fmaxf(fmaxf(v0, v1), fmaxf(v2, v3));
#pragma unroll
        for (int o = 1; o < 64; o <<= 1) m = fmaxf(m, __shfl_xor(m, o));
        v0 = exp2f(v0 - m); v1 = exp2f(v1 - m); v2 = exp2f(v2 - m); v3 = exp2f(v3 - m);
        const float s = wave_sum(v0 + v1 + v2 + v3), inv = 1.f / s;
        ps[i * 256 + lane] = v0 * inv; ps[i * 256 + lane + 64] = v1 * inv; ps[i * 256 + lane + 128] = v2 * inv; ps[i * 256 + lane + 192] = v3 * inv;
    }
    __syncthreads();
    float o[8];
#pragma unroll
    for (int i = 0; i < 8; ++i) o[i] = 0.f;
    for (int m = 0; m < MEM; ++m) { const float vv = bf2f(KVM[((size_t)b * MEM + m) * 2048 + 1024 + h * XD + j]);
#pragma unroll
        for (int i = 0; i < 8; ++i) o[i] += ps[i * 256 + m] * vv; }
#pragma unroll
    for (int i = 0; i < 8; ++i) OX[(row0 + i) * D + h * XD + j] = (bf16_t)f2bf(o[i]);
    __syncthreads();
}
__device__ __forceinline__ int router_row(int row, int lane, const bf16_t* X2b, const float* ssq2p, const float* g, const float* wgr, const float* bgr, const float* wer, const float* ber, float* selw) {
    int cls = 0;
    float acc[20];
#pragma unroll
    for (int i = 0; i < 20; ++i) acc[i] = 0.f;
    const float rs = pg8::rstd16(ssq2p + (size_t)row * 16);
    for (int kk = 0; kk < 16; ++kk) { const int k = kk * 64 + lane; const float t = bf2f(X2b[(size_t)row * D + k]) * rs * g[k];
#pragma unroll
        for (int i = 0; i < 4; ++i) acc[i] += t * wgr[k * 4 + i];
#pragma unroll
        for (int gi = 0; gi < 4; ++gi)
#pragma unroll
            for (int e = 0; e < 4; ++e) acc[4 + gi * 4 + e] += t * wer[((size_t)gi * D + k) * 4 + e]; }
#pragma unroll
    for (int i = 0; i < 20; ++i) acc[i] = wave_sum(acc[i]);
    if (lane == 0) {
        float gl[4]; float gm = -INFINITY; int gi = 0;
#pragma unroll
        for (int i = 0; i < 4; ++i) { gl[i] = acc[i] + bgr[i]; if (gl[i] > gm) { gm = gl[i]; gi = i; } }
        float gs = 0.f;
#pragma unroll
        for (int i = 0; i < 4; ++i) gs += __expf(gl[i] - gm);
        const float gp = 1.f / gs;
        float el[4];
#pragma unroll
        for (int e = 0; e < 4; ++e) { float v = 0.f;
#pragma unroll
            for (int q = 0; q < 4; ++q) if (q == gi) v = acc[4 + q * 4 + e] + ber[q * 4 + e];
            el[e] = v; }
        int e1 = 0; float m1 = el[0];
#pragma unroll
        for (int e = 1; e < 4; ++e) if (el[e] > m1) { m1 = el[e]; e1 = e; }
        int e2 = -1; float m2 = -INFINITY;
#pragma unroll
        for (int e = 0; e < 4; ++e) if (e != e1 && el[e] > m2) { m2 = el[e]; e2 = e; }
        const float p2 = __expf(m2 - m1), w1 = gp / (1.f + p2), w2 = gp * p2 / (1.f + p2);
        const int ea = e1 < e2 ? e1 : e2, eb = e1 < e2 ? e2 : e1; const float wA = e1 < e2 ? w1 : w2, wB = e1 < e2 ? w2 : w1;
        const int pr = (ea == 0) ? eb - 1 : (ea == 1) ? eb + 1 : 5;
        selw[(size_t)row * 2] = wA; selw[(size_t)row * 2 + 1] = wB; cls = gi * 6 + pr;
    }
    return cls;
}
__device__ __forceinline__ void final_row(int row, int lane, const bf16_t* X3b, const float* ssq3, const float* g, float* out) {
    float v[16]; float s = 0.f;
#pragma unroll
    for (int j = 0; j < 16; ++j) { v[j] = bf2f(X3b[(size_t)row * D + j * 64 + lane]); s += v[j] * v[j]; }
    const float r = pg8::rstd16(ssq3 + (size_t)row * 16);
#pragma unroll
    for (int j = 0; j < 16; ++j) out[(size_t)row * D + j * 64 + lane] = v[j] * r * g[j * 64 + lane];
}

__global__ void __launch_bounds__(NTHREADS, 2) mk_fwd(Args args) {
    extern __shared__ __attribute__((aligned(16))) unsigned char lds[];
    cg::grid_group grid = cg::this_grid();
    Ctx C;
#pragma unroll
    for (int i = 0; i < 29; ++i) C.in[i] = args.in[i];
    C.out = args.out; C.ws = args.ws; C.lds = lds;
    C.tid = threadIdx.x; C.lane = C.tid & 63; C.wave = __builtin_amdgcn_readfirstlane(C.tid >> 6);
    C.G = gridDim.x; C.bid = blockIdx.x; C.gw = C.bid * NWAVES + C.wave; C.NGW = C.G * NWAVES;
    const float* x = C.in[0]; const float* mem = C.in[1]; const float* norm_mix = C.in[2]; const float* w_in = C.in[3];
    const float* conv_w = C.in[4]; const float* conv_b = C.in[5]; const float* lru_w_a = C.in[6]; const float* lru_b_a = C.in[7];
    const float* lru_w_x = C.in[8]; const float* lru_b_x = C.in[9]; const float* lru_lambda = C.in[10];
    const float* norm_rnn = C.in[11]; const float* norm_sb = C.in[12]; const float* w_out = C.in[13];
    const float* norm_xattn = C.in[14]; const float* norm_mem = C.in[15];
    const float* xa_w_q = C.in[16]; const float* xa_w_k = C.in[17]; const float* xa_w_v = C.in[18]; const float* xa_w_o = C.in[19];
    const float* norm_moe = C.in[20]; const float* w_gr = C.in[21]; const float* b_gr = C.in[22]; const float* w_er = C.in[23]; const float* b_er = C.in[24];
    const float* w_gate = C.in[25]; const float* w_up = C.in[26]; const float* w_down = C.in[27]; const float* norm_final = C.in[28];
    unsigned char* ws = C.ws; float* out = C.out;
    float* sm = (float*)(ws + WS_SMALL);
    float* rstd0 = sm + SM_RSTD0; float* ssq_r = sm + SM_SSQR; float* ssq_s = sm + SM_SSQS; float* ssq1 = sm + SM_SSQ1; float* ssq2 = sm + SM_SSQ2; unsigned* kmax = (unsigned*)(ws + WS_CTL); float* fmid = sm + SM_END; float* fend = fmid + 32768;
    float* selw = sm + SM_SELW; float* ssq3 = sm + SM_SSQ3; int* gcnt = (int*)(ws + WS_CTL + 1024);
    int* tlist = (int*)(sm + 64 * 32768); float* rsg = sm + 88 * 32768; float* wAg = rsg + 40960; float* wBg = wAg + 40960; int* tokg = (int*)(wBg + 40960);
    bf16_t* Wg_t = (bf16_t*)(ws + WS_WG); bf16_t* Wu_t = (bf16_t*)(ws + WS_WU); bf16_t* Wd2 = (bf16_t*)(ws + WS_WD2); bf16_t* XG = (bf16_t*)(ws + WS_R1); bf16_t* HID = (bf16_t*)(ws + WS_R5);
    bf16_t* Win_t = (bf16_t*)(ws + WS_WIN); bf16_t* Wout_t = (bf16_t*)(ws + WS_WOUT); bf16_t* Wq_t = (bf16_t*)(ws + WS_WQ); bf16_t* Wkv_t = (bf16_t*)(ws + WS_WKV); bf16_t* Wo_t = (bf16_t*)(ws + WS_WO);
    bf16_t* memn = (bf16_t*)(ws + WS_MEMN); bf16_t* KVM = (bf16_t*)(ws + WS_KVM);
    bf16_t* xb = (bf16_t*)(ws + WS_R0); bf16_t* X1b = xb; bf16_t* X3b = xb;
    bf16_t* XR = (bf16_t*)(ws + WS_R1); bf16_t* GG = XR + (size_t)NTOK * RW; bf16_t* QX = XR;
    bf16_t* Qs = (bf16_t*)(ws + WS_R2); bf16_t* Ks = Qs + (size_t)NTOK * SBW; bf16_t* OX = Qs;
    bf16_t* Vs = (bf16_t*)(ws + WS_R3);
    bf16_t* YY = (bf16_t*)(ws + WS_R4); bf16_t* X2b = YY;
    const int gw = C.gw, NGW = C.NGW, lane = C.lane;
#define GRID_SYNC() grid.sync()

    {
        if (gw == 0) { kmax[lane] = 0u; if (lane < 32) gcnt[lane] = 0; }
        for (int r = gw; r < NTOK; r += NGW) row_prep_x(x, xb, rstd0, r, lane);
        for (int r = gw; r < NMEM; r += NGW) row_prep_mem(mem, norm_mem, memn, r, lane);
        LAS float* scr = (LAS float*)(lds) + C.wave * (64 * 33);
        constexpr int I_IN = (D / 64) * (PROJ / 32), I_SQ = (D / 64) * (D / 32);
        for (int it = gw; it < I_IN + 5 * I_SQ; it += NGW) {
            int r = it;
            if (r < I_IN) { transpose_item(w_in, D, PROJ, Win_t, D, norm_mix, norm_mix, D, scr, r, lane); continue; } r -= I_IN;
            if (r < I_SQ) { transpose_item(w_out, D, D, Wout_t, D, norm_rnn, norm_sb, RW, scr, r, lane); continue; } r -= I_SQ;
            if (r < I_SQ) { transpose_item(xa_w_q, D, D, Wq_t, D, norm_xattn, norm_xattn, D, scr, r, lane); continue; } r -= I_SQ;
            if (r < I_SQ) { transpose_item(xa_w_k, D, D, Wkv_t, D, nullptr, nullptr, 0, scr, r, lane); continue; } r -= I_SQ;
            if (r < I_SQ) { transpose_item(xa_w_v, D, D, Wkv_t + (size_t)D * D, D, nullptr, nullptr, 0, scr, r, lane); continue; } r -= I_SQ;
            transpose_item(xa_w_o, D, D, Wo_t, D, nullptr, nullptr, 0, scr, r, lane);
        }
        constexpr int I_GU = (D / 64) * (DE / 32), I_DN = (DE / 64) * (D / 32);
        for (int it = gw; it < 32 * I_GU + 48 * I_DN; it += NGW) {
            int r = it;
            if (r < 16 * I_GU) { const int e = r / I_GU; transpose_item(w_gate + (size_t)e * D * DE, D, DE, Wg_t + (size_t)e * DE * D, D, norm_moe, norm_moe, D, scr, r % I_GU, lane); continue; } r -= 16 * I_GU;
            if (r < 16 * I_GU) { const int e = r / I_GU; transpose_item(w_up + (size_t)e * D * DE, D, DE, Wu_t + (size_t)e * DE * D, D, norm_moe, norm_moe, D, scr, r % I_GU, lane); continue; } r -= 16 * I_GU;
            { const int cs = r / I_DN, cls = cs >> 1, slot = cs & 1; int ea, eb; pg8::pair_ab(cls % 6, ea, eb); const int e = (cls / 6) * 4 + (slot ? eb : ea);
              transpose_item(w_down + (size_t)e * DE * D, DE, D, Wd2 + (size_t)cls * D * 512 + slot * DE, 512, nullptr, nullptr, 0, scr, r % I_DN, lane); }
        }
    }
    GRID_SYNC();
    { pg8::DenseOrder S; S.init(xb, D, Win_t, D, NTOK, PROJ, C.G, C.bid); pg8::EpiInProjF E{0, rstd0, XR, GG, Qs, Ks, Vs, kmax};
      pg8::gemm_phase<pg8::EpiInProjF, pg8::DenseOrder, true>((LAS unsigned char*)lds, pg8::Gemm{D, D, D}, S, E); }
    { pg8::DenseOrder S; S.init(memn, D, Wkv_t, D, NMEM, 2048, C.G, C.bid); pg8::EpiBf16F E{0, KVM, nullptr, 2048, 1.f};
      pg8::gemm_phase<pg8::EpiBf16F, pg8::DenseOrder, true>((LAS unsigned char*)lds, pg8::Gemm{D, D, D}, S, E); }
    GRID_SYNC();
    {
        LAS float* xs = (LAS float*)(lds) + C.wave * 64;
        if (gw < BATCH * NH) lru_naive_unit(gw, lane, xs, XR, GG, conv_w, conv_b, lru_w_a, lru_b_a, lru_w_x, lru_b_x, lru_lambda, YY);
        for (int u = gw; u < BATCH * NH * 64; u += NGW) { const int uu = BATCH * NH * 64 - 1 - u; sb_naive_unit(uu, lane, Qs, Ks, Vs, YY, ssq_s); }
    }
    GRID_SYNC();
    for (int r = gw; r < NTOK; r += NGW) {
        float s = 0.f;
        for (int c = lane; c < RW; c += 64) { const float v = bf2f(YY[(size_t)r * D + c]); s += v * v; }
        s = wave_sum(s);
        if (lane == 0) { float s2 = 0.f;
#pragma unroll
            for (int i = 0; i < 8; ++i) s2 += ssq_s[(size_t)r * 8 + i];
            const float rr = 1.0f / sqrtf(s * (1.f / RW) + EPS), rs = 1.0f / sqrtf(s2 * (1.f / SBW) + EPS); fmid[r] = rr / rs; fend[r] = rs; }
    }
    GRID_SYNC();
    { pg8::DenseOrder S; S.init(YY, D, Wout_t, D, NTOK, D, C.G, C.bid); pg8::EpiX1F E{8, x, fmid, fend, X1b, ssq1};
      pg8::gemm_phase<pg8::EpiX1F, pg8::DenseOrder, true>((LAS unsigned char*)lds, pg8::Gemm{D, D, D}, S, E); }
    GRID_SYNC();
    { pg8::DenseOrder S; S.init(X1b, D, Wq_t, D, NTOK, D, C.G, C.bid); pg8::EpiBf16F E{0, QX, ssq1, D, 0.0625f * LOG2E};
      pg8::gemm_phase<pg8::EpiBf16F, pg8::DenseOrder, true>((LAS unsigned char*)lds, pg8::Gemm{D, D, D}, S, E); }
    GRID_SYNC();
    {
        const int half = C.tid >> 8, j = C.tid & 255;
        LAS float* qs = (LAS float*)(lds) + half * 4096; LAS float* ps = qs + 2048;
        for (int u = C.bid * 2; u < BATCH * XH * 512; u += C.G * 2) xattn_naive_unit(u + half, j, qs, ps, QX, KVM, OX);
    }
    GRID_SYNC();
    { pg8::DenseOrder S; S.init(OX, D, Wo_t, D, NTOK, D, C.G, C.bid); pg8::EpiResF E{0, X1b, X2b, ssq2};
      pg8::gemm_phase<pg8::EpiResF, pg8::DenseOrder, true>((LAS unsigned char*)lds, pg8::Gemm{D, D, D}, S, E); }
    GRID_SYNC();
    {
        LAS int* lcnt = (LAS int*)lds; LAS int* lbase = lcnt + 32; LAS int* lcls = lcnt + 64; LAS int* lpos = lcnt + 192;
        for (int chunk = C.bid; chunk < NTOK / 128; chunk += C.G) {
            if (C.tid < 32) lcnt[C.tid] = 0;
            __syncthreads();
            for (int i = 0; i < 16; ++i) { const int lt = C.wave * 16 + i, row = chunk * 128 + lt;
                const int cls = router_row(row, lane, X2b, ssq2, norm_moe, w_gr, b_gr, w_er, b_er, selw);
                if (lane == 0) { lcls[lt] = cls; lpos[lt] = __hip_atomic_fetch_add(lcnt + cls, 1, __ATOMIC_RELAXED, __HIP_MEMORY_SCOPE_WORKGROUP); } }
            __syncthreads();
            if (C.tid < 24) lbase[C.tid] = atomicAdd(gcnt + C.tid, lcnt[C.tid]);
            __syncthreads();
            if (C.tid < 128) { const int c = lcls[C.tid]; tlist[(size_t)c * NTOK + lbase[c] + lpos[C.tid]] = chunk * 128 + C.tid; }
            __syncthreads();
        }
    }
    GRID_SYNC();
    LAS int* meta = (LAS int*)(lds + 131072 + 1024);
    {
        if (C.tid == 0) { int rb = 0, tb = 0;
            for (int c = 0; c < 24; ++c) { const int n = gcnt[c], nt = (n + 255) >> 8; meta[c] = n; meta[32 + c] = rb; meta[64 + c] = tb; rb += nt * 256; tb += nt; }
            meta[32 + 24] = rb; meta[64 + 24] = tb; }
        __syncthreads();
        const int total = meta[32 + 24];
        for (int R = gw; R < total; R += NGW) {
            int c = 0;
            for (int k = 1; k < 24; ++k) c += (R >= meta[32 + k]) ? 1 : 0;
            const int p = R - meta[32 + c]; u32x4 v0 = (u32x4){0u, 0u, 0u, 0u}, v1 = v0; int tok = -1; float rs = 0.f, wA = 0.f, wB = 0.f;
            if (p < meta[c]) { tok = tlist[(size_t)c * NTOK + p]; const u32x4* src = (const u32x4*)(X2b + (size_t)tok * D) + lane; v0 = src[0]; v1 = src[64];
                rs = pg8::rstd16(ssq2 + (size_t)tok * 16); wA = selw[(size_t)tok * 2]; wB = selw[(size_t)tok * 2 + 1]; }
            u32x4* dst = (u32x4*)(XG + (size_t)R * D) + lane; dst[0] = v0; dst[64] = v1;
            if (lane == 0) { rsg[R] = rs; wAg[R] = wA; wBg[R] = wB; tokg[R] = tok; }
        }
    }
    GRID_SYNC();
    { pg8::MoeOrder1 S{XG, Wg_t, Wu_t, meta, C.G, C.bid}; pg8::EpiMoeUp E{0, rsg, wAg, wBg, HID};
      pg8::gemm_phase<pg8::EpiMoeUp, pg8::MoeOrder1, true>((LAS unsigned char*)lds, pg8::Gemm{D, D, D}, S, E); }
    GRID_SYNC();
    { pg8::MoeOrder2 S{HID, Wd2, meta, C.G, C.bid}; pg8::EpiMoeDown E{0, tokg, X2b, X3b, ssq3};
      pg8::gemm_phase<pg8::EpiMoeDown, pg8::MoeOrder2, true>((LAS unsigned char*)lds, pg8::Gemm{512, 512, 512}, S, E); }
    GRID_SYNC();
    for (int r = gw; r < NTOK; r += NGW) final_row(r, lane, X3b, ssq3, norm_final, out);
}

extern "C" void kernel_launch(void* const* d_in, const int* in_sizes, int n_in, void* d_out, int out_size, void* d_ws, size_t ws_size, hipStream_t stream) {
    static int grid = 0;
    if (grid == 0) {
        if (n_in != 29 || ws_size < WS_END) { fprintf(stderr, "kernel_launch: unexpected inputs (%d) or workspace (%zu)\n", n_in, ws_size); grid = -1; return; }
        int dev = 0, cus = 0, per_cu = 0;
        hipGetDevice(&dev); hipDeviceGetAttribute(&cus, hipDeviceAttributeMultiprocessorCount, dev);
        hipFuncSetAttribute((const void*)mk_fwd, hipFuncAttributeMaxDynamicSharedMemorySize, LDS_BYTES);
        hipOccupancyMaxActiveBlocksPerMultiprocessor(&per_cu, (const void*)mk_fwd, NTHREADS, LDS_BYTES);
        if (per_cu < 1) { fprintf(stderr, "kernel_launch: occupancy query says %d blocks per CU\n", per_cu); per_cu = 1; }
        if (per_cu > 1) per_cu = 1;
        grid = cus * per_cu;
    }
    if (grid < 0) return;
    Args a{};
    for (int i = 0; i < 29; ++i) a.in[i] = (const float*)d_in[i];
    a.out = (float*)d_out; a.ws = (unsigned char*)d_ws;
    void* kargs[] = {&a};
    hipError_t e = hipLaunchCooperativeKernel((const void*)mk_fwd, dim3(grid), dim3(NTHREADS), kargs, LDS_BYTES, stream);
    if (e != hipSuccess) fprintf(stderr, "cooperative launch failed: %s (grid %d)\n", hipGetErrorString(e), grid);
}
```

```cpp
#include <hip/hip_runtime.h>
#include <hip/hip_cooperative_groups.h>
#include <cstdio>
#include <cstdint>

typedef unsigned short bf16_t;
typedef short bf16x8 __attribute__((ext_vector_type(8)));
typedef float f32x4 __attribute__((ext_vector_type(4)));
typedef unsigned u32x4 __attribute__((ext_vector_type(4)));

constexpr int D = 1024, BATCH = 8, SEQ = 4096, NTOK = BATCH * SEQ, MEM = 256, NMEM = BATCH * MEM;
constexpr int RW = 512, SBW = 512, PROJ = 2560, NH = 8, HD = 64;
constexpr int XH = 4, XD = 256, NG = 4, EPG = 4, NEXP = 16, DE = 256;
constexpr float EPS = 1e-6f, LOG2E = 1.4426950408889634f;

constexpr size_t MiB = 1u << 20;
constexpr size_t WS_CTL = 0;
constexpr size_t WS_SMALL = 1 * MiB;
constexpr size_t WS_WIN = 16 * MiB;
constexpr size_t WS_WOUT = 21 * MiB;
constexpr size_t WS_WQ = 23 * MiB;
constexpr size_t WS_WKV = 25 * MiB;
constexpr size_t WS_WO = 29 * MiB;
constexpr size_t WS_MEMN = 31 * MiB;
constexpr size_t WS_KVM = 35 * MiB;
constexpr size_t WS_WG = 43 * MiB;
constexpr size_t WS_WU = 51 * MiB;
constexpr size_t WS_WD2 = 59 * MiB;
constexpr size_t WS_R0 = 96 * MiB;
constexpr size_t WS_R1 = 160 * MiB;
constexpr size_t WS_R2 = 224 * MiB;
constexpr size_t WS_R3 = 288 * MiB;
constexpr size_t WS_R4 = 320 * MiB;
constexpr size_t WS_R5 = 384 * MiB;
constexpr size_t WS_END = 448 * MiB;

constexpr size_t SM_RSTD0 = 0;
constexpr size_t SM_SSQR = 1 * 32768;
constexpr size_t SM_SSQS = 2 * 32768;
constexpr size_t SM_SSQ1 = 10 * 32768;
constexpr size_t SM_SSQ2 = 26 * 32768;
constexpr size_t SM_SSQ3 = 42 * 32768;
constexpr size_t SM_SELW = 58 * 32768;
constexpr size_t SM_SELE = 60 * 32768;
constexpr size_t SM_END = 62 * 32768;

__device__ __forceinline__ unsigned f2bf(float f) { unsigned u = __builtin_bit_cast(unsigned, f); return (u + 0x7fffu + ((u >> 16) & 1u)) >> 16; }
__device__ __forceinline__ float bf2f(unsigned short h) { return __builtin_bit_cast(float, (unsigned)h << 16); }
__device__ __forceinline__ float wave_sum(float v) {
#pragma unroll
    for (int o = 1; o < 64; o <<= 1) v += __shfl_xor(v, o);
    return v;
}
__device__ __forceinline__ float gelu_tanh(float x) { const float u = 0.7978845608028654f * (x + 0.044715f * x * x * x); return x / (1.f + __expf(-2.f * u)); }
__device__ __forceinline__ float sigmoidf_(float x) { return 1.f / (1.f + __expf(-x)); }

namespace cg = cooperative_groups;
#define LAS __attribute__((address_space(3)))
constexpr int NWAVES = 8, NTHREADS = 512;
constexpr int LDS_BYTES = 147456;

struct Args { const float* in[29]; float* out; unsigned char* ws; };

struct Ctx {
    const float* in[29]; float* out; unsigned char* ws; unsigned char* lds;
    int tid, lane, wave, gw, NGW, G, bid;
};

namespace pg8 {
#define PG8_LAS __attribute__((address_space(3)))
constexpr int BM = 256, BK = 64, HALF = 128, HTB = HALF * BK * 2  , STAGE_BYTES = 8 * HTB, NXCD = 8, WGM = 8;
__host__ __device__ __forceinline__ int lds_byte(int r, int c) { const int st = (r >> 4) * 2 + (c >> 5), rr = r & 15, cc = c & 31, ob = rr * 64 + cc * 2; return st * 1024 + (ob ^ (((ob >> 9) & 1) << 5)); }
__host__ __device__ __forceinline__ void stage_rc(int b, int& R, int& C) { const int st = b / 1024, sb = b % 1024, swz = sb ^ (((sb >> 9) & 1) << 5); R = (st >> 1) * 16 + swz / 64; C = (st & 1) * 32 + (swz % 64) / 2; }
__host__ __device__ __forceinline__ int perm32(int rho) { const int n = rho >> 4, i = rho & 15; return 8 * (i >> 2) + 4 * n + (i & 3); }

struct Unit { int pm, pn; };
struct Gemm { int lda, ldb, K; };
struct DenseOrder {
    const bf16_t* A; const bf16_t* Bt; int lda, ldb; int nM, nN, nwg, G, c;
    __device__ void init(const bf16_t* A_, int lda_, const bf16_t* Bt_, int ldb_, int M, int N, int G_, int c_) { A = A_; Bt = Bt_; lda = lda_; ldb = ldb_; nM = M / BM; nN = N / BM; nwg = nM * nN; G = G_; c = c_; }
    __device__ bool next(int i, Unit& u) const {
        const long L = (long)i * G + c; if (L >= nwg) return false;
        int wgid = (int)L; { const int q = nwg / NXCD, r = nwg % NXCD, xcd = wgid % NXCD, off = wgid / NXCD; wgid = (xcd < r ? xcd * (q + 1) : r * (q + 1) + (xcd - r) * q) + off; }
        const int nig = WGM * nN, gid = wgid / nig, fm = gid * WGM, gsz = (nM - fm) < WGM ? (nM - fm) : WGM;
        u.pm = fm + ((wgid % nig) % gsz); u.pn = (wgid % nig) / gsz; return true;
    }
    __device__ __forceinline__ void ptrs(const Unit& u, const char*& a, const char*& b0, const char*& b1) const {
        a = (const char*)A + (size_t)u.pm * BM * lda * 2; b0 = (const char*)Bt + (size_t)u.pn * BM * ldb * 2; b1 = b0 + (size_t)HALF * ldb * 2; }
};

__device__ __forceinline__ unsigned cvt_pk_bf16(float lo, float hi) { unsigned r; asm volatile("v_cvt_pk_bf16_f32 %0, %1, %2" : "=v"(r) : "v"(lo), "v"(hi)); return r; }

template <class Epi, class Sched, bool ALIGN_EPI>
__device__ __forceinline__ void gemm_phase(PG8_LAS unsigned char* lds, const Gemm g, const Sched& S, const Epi& E) {
    int tid_ = threadIdx.x; asm volatile("" : "+v"(tid_));
    const int tid = tid_, wid = __builtin_amdgcn_readfirstlane(tid >> 6), lane = tid & 63, wr = wid >> 2, wc = wid & 3, fr = lane & 15, fq = lane >> 4;
    const int K = g.K, nt = K / BK;
    unsigned voffA[2], voffB[2];
#pragma unroll
    for (int i = 0; i < 2; ++i) { int R, C; stage_rc(tid * 16 + i * 8192, R, C); const int Rb = Epi::PERM ? ((R & ~31) + perm32(R & 31)) : R;
        voffA[i] = (unsigned)(R * g.lda + C) * 2u; voffB[i] = (unsigned)(Rb * g.ldb + C) * 2u; }
    const size_t kstep = (size_t)(BK * 2);
    const size_t hstepA = (size_t)HALF * g.lda * 2;
    const unsigned ldsw = (unsigned)wid * 1024u;
    const int aoff = lds_byte(wr * 64 + fr, fq * 8), boff = lds_byte(wc * 32 + fr, fq * 8);
#define PG8_SA(b, h) (((b) * 2 + (h)) * HTB)
#define PG8_SB(b, h) ((4 + (b) * 2 + (h)) * HTB)
#define PG8_STAGE(bufoff, gbase, voff) do { _Pragma("unroll") for (int _i = 0; _i < 2; ++_i) \
        __builtin_amdgcn_global_load_lds((const unsigned*)((const char*)(gbase) + (voff)[_i]), (PG8_LAS unsigned*)(lds + (bufoff) + ldsw + _i * 8192), 16, 0, 0); } while (0)
#define PG8_LDA(dst, b, h) do { _Pragma("unroll") for (int m = 0; m < 4; ++m) _Pragma("unroll") for (int k = 0; k < 2; ++k) dst[m][k] = *(const PG8_LAS bf16x8*)(lds + PG8_SA(b, h) + aoff + m * 2048 + k * 1024); } while (0)
#define PG8_LDB(dst, b, h) do { _Pragma("unroll") for (int n = 0; n < 2; ++n) _Pragma("unroll") for (int k = 0; k < 2; ++k) dst[n][k] = *(const PG8_LAS bf16x8*)(lds + PG8_SB(b, h) + boff + n * 2048 + k * 1024); } while (0)
#define PG8_MMA(ai, bj, At, Bt) do { __builtin_amdgcn_s_setprio(1); _Pragma("unroll") for (int m = 0; m < 4; ++m) _Pragma("unroll") for (int n = 0; n < 2; ++n) _Pragma("unroll") for (int k = 0; k < 2; ++k) \
        acc[ai][bj][m][n] = __builtin_amdgcn_mfma_f32_16x16x32_bf16(Bt[n][k], At[m][k], acc[ai][bj][m][n], 0, 0, 0); __builtin_amdgcn_s_setprio(0); } while (0)
#define PG8_WAIT_V(n) asm volatile("s_waitcnt vmcnt(" #n ")" ::: "memory")
#define PG8_WAIT_L(n) asm volatile("s_waitcnt lgkmcnt(" #n ")" ::: "memory")
#define PG8_BAR __builtin_amdgcn_s_barrier()
#define PG8_SCHED __builtin_amdgcn_sched_barrier(0)
    Unit cur, nxt; int ui = 0;
    if (!S.next(0, cur)) return;
    f32x4 acc[2][2][4][2];
#pragma unroll
    for (int a = 0; a < 2; ++a)
#pragma unroll
        for (int b = 0; b < 2; ++b)
#pragma unroll
            for (int m = 0; m < 4; ++m)
#pragma unroll
                for (int n = 0; n < 2; ++n) acc[a][b][m][n] = (f32x4){0.f, 0.f, 0.f, 0.f};
    bf16x8 At[4][2], B0[2][2], B1[2][2];
    const char *cA, *cB0, *cB1; S.ptrs(cur, cA, cB0, cB1);
    PG8_STAGE(PG8_SB(0, 0), cB0, voffB); PG8_STAGE(PG8_SB(0, 1), cB1, voffB); PG8_STAGE(PG8_SA(0, 0), cA, voffA); PG8_STAGE(PG8_SA(0, 1), cA + hstepA, voffA);
    if (wr == 1) PG8_BAR;
    PG8_WAIT_V(2); PG8_BAR;
    PG8_STAGE(PG8_SB(1, 0), cB0 + kstep, voffB); PG8_STAGE(PG8_SA(1, 0), cA + kstep, voffA); PG8_STAGE(PG8_SB(1, 1), cB1 + kstep, voffB);
    PG8_WAIT_V(6); PG8_BAR;
    for (;;) {
        const bool has_next = S.next(ui + 1, nxt);
        const char *nA = cA, *nB0 = cB0, *nB1 = cB1; if (has_next) S.ptrs(nxt, nA, nB0, nB1);
        for (int t = 0; t < nt; t += 2) {
            const bool last = (t == nt - 2);
            if constexpr (Epi::HAS_MID) { if (t == E.mid_t) E.mid(acc, cur, wr, wc, fr, fq); }
            const char* a1 = cA + (size_t)(t + 1) * kstep;
            const char* a2 = last ? nA : cA + (size_t)(t + 2) * kstep; const char* b2 = last ? nB0 : cB0 + (size_t)(t + 2) * kstep; const char* b2h = last ? nB1 : cB1 + (size_t)(t + 2) * kstep;
            const char* a3 = a2 + kstep; const char* b3 = b2 + kstep; const char* b3h = b2h + kstep;
            PG8_LDB(B0, 0, 0); PG8_LDB(B1, 0, 1); PG8_SCHED; PG8_LDA(At, 0, 0); PG8_STAGE(PG8_SA(1, 1), a1 + hstepA, voffA);
            PG8_WAIT_V(8); PG8_WAIT_L(0); PG8_BAR; PG8_MMA(0, 0, At, B0); PG8_MMA(0, 1, At, B1); PG8_BAR; PG8_SCHED;
            PG8_LDA(At, 0, 1); PG8_STAGE(PG8_SB(0, 0), b2, voffB); PG8_STAGE(PG8_SB(0, 1), b2h, voffB); PG8_STAGE(PG8_SA(0, 0), a2, voffA);
            PG8_WAIT_V(8); PG8_WAIT_L(0); PG8_BAR; PG8_MMA(1, 0, At, B0); PG8_MMA(1, 1, At, B1); PG8_BAR; PG8_SCHED;
            PG8_LDB(B0, 1, 0); PG8_LDB(B1, 1, 1); PG8_SCHED; PG8_LDA(At, 1, 0); PG8_STAGE(PG8_SA(0, 1), a2 + hstepA, voffA);
            PG8_WAIT_V(8); PG8_WAIT_L(0); PG8_BAR; PG8_MMA(0, 0, At, B0); PG8_MMA(0, 1, At, B1); PG8_BAR; PG8_SCHED;
            PG8_LDA(At, 1, 1); PG8_STAGE(PG8_SB(1, 0), b3, voffB); PG8_STAGE(PG8_SB(1, 1), b3h, voffB); PG8_STAGE(PG8_SA(1, 0), a3, voffA);
            PG8_WAIT_V(8); PG8_WAIT_L(0); PG8_BAR; PG8_MMA(1, 0, At, B0); PG8_MMA(1, 1, At, B1); PG8_BAR; PG8_SCHED;
        }
        if constexpr (ALIGN_EPI) { if (wr == 0) PG8_BAR; }
        E(acc, cur, wr, wc, fr, fq);
        if (!has_next) break;
#pragma unroll
        for (int a = 0; a < 2; ++a)
#pragma unroll
            for (int b = 0; b < 2; ++b)
#pragma unroll
                for (int m = 0; m < 4; ++m)
#pragma unroll
                    for (int n = 0; n < 2; ++n) acc[a][b][m][n] = (f32x4){0.f, 0.f, 0.f, 0.f};
        cur = nxt; cA = nA; cB0 = nB0; cB1 = nB1; ++ui;
        if constexpr (ALIGN_EPI) { if (wr == 1) PG8_BAR; }
    }
    PG8_WAIT_V(0);
    if constexpr (!ALIGN_EPI) { if (wr == 0) PG8_BAR; }
    PG8_BAR;
#undef PG8_SA
#undef PG8_SB
#undef PG8_STAGE
#undef PG8_LDA
#undef PG8_LDB
#undef PG8_MMA
#undef PG8_WAIT_V
#undef PG8_WAIT_L
#undef PG8_BAR
#undef PG8_SCHED
}

__device__ __forceinline__ float rstd16(const float* p) { const f32x4 a = ((const f32x4*)p)[0], b = ((const f32x4*)p)[1], c = ((const f32x4*)p)[2], d = ((const f32x4*)p)[3];
    const float s = ((a.x + a.y) + (a.z + a.w)) + ((b.x + b.y) + (b.z + b.w)) + ((c.x + c.y) + (c.z + c.w)) + ((d.x + d.y) + (d.z + d.w)); return 1.0f / sqrtf(s * (1.f / D) + EPS); }
__device__ __forceinline__ u32x4 pack8(const f32x4 v0, const f32x4 v1) { u32x4 w; w.x = cvt_pk_bf16(v0[0], v0[1]); w.y = cvt_pk_bf16(v0[2], v0[3]); w.z = cvt_pk_bf16(v1[0], v1[1]); w.w = cvt_pk_bf16(v1[2], v1[3]); return w; }
__device__ __forceinline__ float sq8(const f32x4 a, const f32x4 b) { return ((a[0] * a[0] + a[1] * a[1]) + (a[2] * a[2] + a[3] * a[3])) + ((b[0] * b[0] + b[1] * b[1]) + (b[2] * b[2] + b[3] * b[3])); }

struct EpiInProjF {
    static constexpr bool PERM = true, HAS_MID = false; int mid_t;
    const float* rstd0; bf16_t *XR, *GG, *Qs, *Ks, *Vs; unsigned* kmax;
    __device__ __forceinline__ void mid(f32x4 (&)[2][2][4][2], const Unit&, int, int, int, int) const {}
    __device__ __forceinline__ void operator()(const f32x4 (&acc)[2][2][4][2], const Unit& u, int wr, int wc, int fr, int fq) const {
        const int row0 = u.pm * BM + wr * 64 + fr, t = u.pn >> 1, colt = (u.pn & 1) * 256 + wc * 32 + 8 * fq;
        bf16_t* base = (t == 0) ? XR : (t == 1) ? GG : (t == 2) ? Qs : (t == 3) ? Ks : Vs;
        float km0 = 0.f, km1 = 0.f;
#pragma unroll
        for (int ai = 0; ai < 2; ++ai)
#pragma unroll
            for (int m = 0; m < 4; ++m) { const int r = row0 + ai * HALF + m * 16; const float rs = rstd0[r]; bf16_t* rowp = base + (size_t)r * 512 + colt;
#pragma unroll
                for (int bj = 0; bj < 2; ++bj) { f32x4 v0 = acc[ai][bj][m][0] * rs, v1 = acc[ai][bj][m][1] * rs;
                    if (t == 1) {
#pragma unroll
                        for (int e = 0; e < 4; ++e) { v0[e] = gelu_tanh(v0[e]); v1[e] = gelu_tanh(v1[e]); } }
                    else if (t == 2) { v0 = v0 * (0.125f * LOG2E); v1 = v1 * (0.125f * LOG2E); }
                    else if (t == 3) { float mx = 0.f;
#pragma unroll
                        for (int e = 0; e < 4; ++e) mx = fmaxf(mx, fmaxf(fabsf(v0[e]), fabsf(v1[e])));
                        if (bj == 0) km0 = fmaxf(km0, mx); else km1 = fmaxf(km1, mx); }
                    *(u32x4*)(rowp + bj * HALF) = pack8(v0, v1); } }
        if (t == 3) {
#pragma unroll
            for (int o = 1; o < 64; o <<= 1) { km0 = fmaxf(km0, __shfl_xor(km0, o)); km1 = fmaxf(km1, __shfl_xor(km1, o)); }
            if ((fr | fq) == 0) { const int b = (u.pm * BM) / SEQ, hd = (u.pn & 1) * 4 + (wc >> 1);
                atomicMax(kmax + b * 8 + hd, __float_as_uint(km0)); atomicMax(kmax + b * 8 + hd + 2, __float_as_uint(km1)); }
        }
    }
};
struct EpiBf16F {
    static constexpr bool PERM = true, HAS_MID = false; int mid_t;
    bf16_t* O; const float* ssq16; int ldo; float scale;
    __device__ __forceinline__ void mid(f32x4 (&)[2][2][4][2], const Unit&, int, int, int, int) const {}
    __device__ __forceinline__ void operator()(const f32x4 (&acc)[2][2][4][2], const Unit& u, int wr, int wc, int fr, int fq) const {
        const int row0 = u.pm * BM + wr * 64 + fr, col0 = u.pn * BM + wc * 32 + 8 * fq;
#pragma unroll
        for (int ai = 0; ai < 2; ++ai)
#pragma unroll
            for (int m = 0; m < 4; ++m) { const int r = row0 + ai * HALF + m * 16; const float rs = (ssq16 ? rstd16(ssq16 + (size_t)r * 16) : 1.f) * scale; bf16_t* rowp = O + (size_t)r * ldo + col0;
#pragma unroll
                for (int bj = 0; bj < 2; ++bj) *(u32x4*)(rowp + bj * HALF) = pack8(acc[ai][bj][m][0] * rs, acc[ai][bj][m][1] * rs); }
    }
};
struct EpiX1F {
    static constexpr bool PERM = true, HAS_MID = true; int mid_t;
    const float* x; const float* fmid; const float* fend; bf16_t* X1b; float* ssq1;
    __device__ __forceinline__ void mid(f32x4 (&acc)[2][2][4][2], const Unit& u, int wr, int wc, int fr, int fq) const {
        const int row0 = u.pm * BM + wr * 64 + fr;
#pragma unroll
        for (int ai = 0; ai < 2; ++ai)
#pragma unroll
            for (int m = 0; m < 4; ++m) { const float f = fmid[row0 + ai * HALF + m * 16];
#pragma unroll
                for (int bj = 0; bj < 2; ++bj) { acc[ai][bj][m][0] = acc[ai][bj][m][0] * f; acc[ai][bj][m][1] = acc[ai][bj][m][1] * f; } }
    }
    __device__ __forceinline__ void operator()(const f32x4 (&acc)[2][2][4][2], const Unit& u, int wr, int wc, int fr, int fq) const {
        const int row0 = u.pm * BM + wr * 64 + fr, col0 = u.pn * BM + wc * 32 + 8 * fq;
#pragma unroll
        for (int ai = 0; ai < 2; ++ai)
#pragma unroll
            for (int m = 0; m < 4; ++m) { const int r = row0 + ai * HALF + m * 16; const float fe = fend[r]; const float* xr = x + (size_t)r * D + col0; float ss = 0.f;
#pragma unroll
                for (int bj = 0; bj < 2; ++bj) { const f32x4 v0 = *(const f32x4*)(xr + bj * HALF) + acc[ai][bj][m][0] * fe, v1 = *(const f32x4*)(xr + bj * HALF + 4) + acc[ai][bj][m][1] * fe;
                    ss += sq8(v0, v1); *(u32x4*)(X1b + (size_t)r * D + col0 + bj * HALF) = pack8(v0, v1); }
                ss += __shfl_xor(ss, 16); ss += __shfl_xor(ss, 32);
                if (fq == 0) ssq1[(size_t)r * 16 + u.pn * 4 + wc] = ss;
                asm volatile("" ::: "memory"); }
    }
};
struct EpiResF {
    static constexpr bool PERM = true, HAS_MID = false; int mid_t;
    const bf16_t* Xi; bf16_t* Xo; float* ssq;
    __device__ __forceinline__ void mid(f32x4 (&)[2][2][4][2], const Unit&, int, int, int, int) const {}
    __device__ __forceinline__ void operator()(const f32x4 (&acc)[2][2][4][2], const Unit& u, int wr, int wc, int fr, int fq) const {
        const int row0 = u.pm * BM + wr * 64 + fr, col0 = u.pn * BM + wc * 32 + 8 * fq;
#pragma unroll
        for (int ai = 0; ai < 2; ++ai)
#pragma unroll
            for (int m = 0; m < 4; ++m) { const int r = row0 + ai * HALF + m * 16; float ss = 0.f;
#pragma unroll
                for (int bj = 0; bj < 2; ++bj) { const u32x4 xi = *(const u32x4*)(Xi + (size_t)r * D + col0 + bj * HALF);
                    f32x4 v0, v1; v0[0] = __uint_as_float(xi.x << 16); v0[1] = __uint_as_float(xi.x & 0xffff0000u); v0[2] = __uint_as_float(xi.y << 16); v0[3] = __uint_as_float(xi.y & 0xffff0000u);
                    v1[0] = __uint_as_float(xi.z << 16); v1[1] = __uint_as_float(xi.z & 0xffff0000u); v1[2] = __uint_as_float(xi.w << 16); v1[3] = __uint_as_float(xi.w & 0xffff0000u);
                    v0 = v0 + acc[ai][bj][m][0]; v1 = v1 + acc[ai][bj][m][1];
                    ss += sq8(v0, v1); *(u32x4*)(Xo + (size_t)r * D + col0 + bj * HALF) = pack8(v0, v1); }
                ss += __shfl_xor(ss, 16); ss += __shfl_xor(ss, 32);
                if (fq == 0) ssq[(size_t)r * 16 + u.pn * 4 + wc] = ss; }
    }
};

__device__ __forceinline__ void pair_ab(int p, int& a, int& b) { a = (p < 3) ? 0 : (p < 5) ? 1 : 2; b = (p < 3) ? p + 1 : (p < 5) ? p - 1 : 3; }
__device__ __forceinline__ int moe_class_of_tile(const PG8_LAS int* meta, int T) { int c = 0;
#pragma unroll
    for (int k = 1; k < 24; ++k) c += (T >= __builtin_amdgcn_readfirstlane(meta[64 + k])) ? 1 : 0;
    return c; }
struct MoeOrder1 {
    const bf16_t* XG; const bf16_t* Wg; const bf16_t* Wu; const PG8_LAS int* meta; int G, c;
    __device__ bool next(int i, Unit& u) const { const int L = i * G + c, nt = __builtin_amdgcn_readfirstlane(meta[64 + 24]); if (L >= nt * 4) return false;
        u.pm = L >> 2; u.pn = moe_class_of_tile(meta, L >> 2) * 4 + (L & 3); return true; }
    __device__ __forceinline__ void ptrs(const Unit& u, const char*& a, const char*& b0, const char*& b1) const {
        const int cls = u.pn >> 2, j = (u.pn >> 1) & 1, half = u.pn & 1; int ea, eb; pair_ab(cls % 6, ea, eb); const int e = (cls / 6) * 4 + (j ? eb : ea);
        a = (const char*)XG + (size_t)u.pm * BM * D * 2; const size_t bo = ((size_t)e * DE + half * HALF) * D * 2; b0 = (const char*)Wg + bo; b1 = (const char*)Wu + bo; }
};
struct MoeOrder2 {
    const bf16_t* HID; const bf16_t* Wd2; const PG8_LAS int* meta; int G, c;
    __device__ bool next(int i, Unit& u) const { const int L = i * G + c, nt = __builtin_amdgcn_readfirstlane(meta[64 + 24]); if (L >= nt * 4) return false;
        u.pm = L >> 2; u.pn = moe_class_of_tile(meta, L >> 2) * 4 + (L & 3); return true; }
    __device__ __forceinline__ void ptrs(const Unit& u, const char*& a, const char*& b0, const char*& b1) const {
        a = (const char*)HID + (size_t)u.pm * BM * 512 * 2; b0 = (const char*)Wd2 + ((size_t)(u.pn >> 2) * D + (u.pn & 3) * BM) * 512 * 2; b1 = b0 + (size_t)HALF * 512 * 2; }
};
struct EpiMoeUp {
    static constexpr bool PERM = true, HAS_MID = false; int mid_t;
    const float* rsg; const float* wAg; const float* wBg; bf16_t* HID;
    __device__ __forceinline__ void mid(f32x4 (&)[2][2][4][2], const Unit&, int, int, int, int) const {}
    __device__ __forceinline__ void operator()(const f32x4 (&acc)[2][2][4][2], const Unit& u, int wr, int wc, int fr, int fq) const {
        const int row0 = u.pm * BM + wr * 64 + fr, j = (u.pn >> 1) & 1, col0 = j * 256 + (u.pn & 1) * HALF + wc * 32 + 8 * fq; const float* wg = j ? wBg : wAg;
#pragma unroll
        for (int ai = 0; ai < 2; ++ai)
#pragma unroll
            for (int m = 0; m < 4; ++m) { const int r = row0 + ai * HALF + m * 16; const float rs = rsg[r], w = wg[r]; f32x4 h0, h1;
#pragma unroll
                for (int e = 0; e < 4; ++e) { const float g0 = acc[ai][0][m][0][e] * rs, g1 = acc[ai][0][m][1][e] * rs;
                    h0[e] = g0 / (1.f + __expf(-g0)) * (acc[ai][1][m][0][e] * rs) * w; h1[e] = g1 / (1.f + __expf(-g1)) * (acc[ai][1][m][1][e] * rs) * w; }
                *(u32x4*)(HID + (size_t)r * 512 + col0) = pack8(h0, h1); }
    }
};
struct EpiMoeDown {
    static constexpr bool PERM = true, HAS_MID = false; int mid_t;
    const int* tokg; const bf16_t* Xi; bf16_t* Xo; float* ssq;
    __device__ __forceinline__ void mid(f32x4 (&)[2][2][4][2], const Unit&, int, int, int, int) const {}
    __device__ __forceinline__ void operator()(const f32x4 (&acc)[2][2][4][2], const Unit& u, int wr, int wc, int fr, int fq) const {
        const int row0 = u.pm * BM + wr * 64 + fr, ct = u.pn & 3, col0 = ct * BM + wc * 32 + 8 * fq;
#pragma unroll
        for (int ai = 0; ai < 2; ++ai)
#pragma unroll
            for (int m = 0; m < 4; ++m) { const int tok = tokg[row0 + ai * HALF + m * 16];
                if (tok >= 0) { float ss = 0.f;
#pragma unroll
                    for (int bj = 0; bj < 2; ++bj) { const u32x4 xi = *(const u32x4*)(Xi + (size_t)tok * D + col0 + bj * HALF);
                        f32x4 v0, v1; v0[0] = __uint_as_float(xi.x << 16); v0[1] = __uint_as_float(xi.x & 0xffff0000u); v0[2] = __uint_as_float(xi.y << 16); v0[3] = __uint_as_float(xi.y & 0xffff0000u);
                        v1[0] = __uint_as_float(xi.z << 16); v1[1] = __uint_as_float(xi.z & 0xffff0000u); v1[2] = __uint_as_float(xi.w << 16); v1[3] = __uint_as_float(xi.w & 0xffff0000u);
                        v0 = v0 + acc[ai][bj][m][0]; v1 = v1 + acc[ai][bj][m][1];
                        ss += sq8(v0, v1); *(u32x4*)(Xo + (size_t)tok * D + col0 + bj * HALF) = pack8(v0, v1); }
                    ss += __shfl_xor(ss, 16); ss += __shfl_xor(ss, 32);
                    if (fq == 0) ssq[(size_t)tok * 16 + ct * 4 + wc] = ss; } }
    }
};
}
namespace sba {
typedef float f32x16 __attribute__((ext_vector_type(16)));
typedef short s16x4 __attribute__((ext_vector_type(4)));
typedef short v4i16_t __attribute__((ext_vector_type(4)));
typedef __attribute__((address_space(3))) const char* lds_cptr;
constexpr int SLOTB = 8192, L_K = 0, L_V = 2 * SLOTB, L_FLAG = 4 * SLOTB, L_OST = L_FLAG + 256, L_BYTES = L_OST + 8 * 4096;
__device__ __forceinline__ int crow(int r, int hi) { return (r & 3) + 8 * (r >> 2) + 4 * hi; }
__device__ __forceinline__ void glds16(const void* gsrc, unsigned lds_dst) { unsigned keep;
    asm volatile("s_mov_b32 %0, m0\n\ts_mov_b32 m0, %2\n\ts_nop 0\n\tglobal_load_lds_dwordx4 %1, off\n\ts_mov_b32 m0, %0" : "=&s"(keep) : "v"(gsrc), "s"(lds_dst) : "memory"); }
typedef float f32x2_t __attribute__((ext_vector_type(2))); typedef __bf16 bf16x2_t __attribute__((ext_vector_type(2)));
__device__ __forceinline__ unsigned cvtpk(float lo, float hi) { f32x2_t v = {lo, hi}; bf16x2_t b = __builtin_convertvector(v, bf16x2_t); return __builtin_bit_cast(unsigned, b); }
__device__ __forceinline__ s16x4 vtr(lds_cptr p) { return __builtin_bit_cast(s16x4, __builtin_amdgcn_ds_read_tr16_b64_v4i16((__attribute__((address_space(3))) v4i16_t*)p)); }

#define SBA_GROUP(Z, SP, g) do { \
        const float off_ = acc_ + (hi ? 0.f : gp_##SP[g]); acc_ += gs_##SP[g] + gp_##SP[g]; \
        const float c3_ = off_ + SP[4 * (g) + 3], c2_ = c3_ + SP[4 * (g) + 2], c1_ = c2_ + SP[4 * (g) + 1], c0_ = c1_ + SP[4 * (g)]; \
        Z[4 * (g) + 3] = __builtin_amdgcn_exp2f(Z[4 * (g) + 3] - c3_); Z[4 * (g) + 2] = __builtin_amdgcn_exp2f(Z[4 * (g) + 2] - c2_); \
        Z[4 * (g) + 1] = __builtin_amdgcn_exp2f(Z[4 * (g) + 1] - c1_); Z[4 * (g)] = __builtin_amdgcn_exp2f(Z[4 * (g)] - c0_); } while (0)

__device__ __forceinline__ void sb_unit(int b, int h, int qb, const bf16_t* Qs, const bf16_t* Ks, const bf16_t* Vs, bf16_t* YY, float* ssq_s8, const unsigned* kmax, char* shm) {
    int tid_ = threadIdx.x; asm volatile("" : "+v"(tid_));
    const int tid = tid_, lane = tid & 63, r32 = lane & 31, hi = lane >> 5; const int wid = __builtin_amdgcn_readfirstlane(tid >> 6);
    const size_t rowbase = (size_t)b * SEQ; const int q0 = qb * 256;
    const bf16_t* Kh = Ks + rowbase * SBW + h * HD; const bf16_t* Vh = Vs + rowbase * SBW + h * HD;
    const unsigned lds0 = (unsigned)(uintptr_t)shm;
    const lds_cptr shm3 = (lds_cptr)shm;
    const bf16_t* ksrc = Kh + (size_t)lane * SBW + wid * 8;
    const bf16_t* vsrc = Vh + (size_t)(16 * (wid & 3) + (lane >> 2)) * SBW + (wid >> 2) * 32 + (lane & 3) * 8;
    const unsigned kdst = lds0 + L_K + wid * 1024, vdst = lds0 + L_V + wid * 1024;
#define DMA_KV(t, slot) do { glds16(ksrc + (size_t)(t) * 64 * SBW, (unsigned)__builtin_amdgcn_readfirstlane(kdst + (slot))); glds16(vsrc + (size_t)(t) * 64 * SBW, (unsigned)__builtin_amdgcn_readfirstlane(vdst + (slot))); } while (0)
    const lds_cptr kp0 = shm3 + L_K + hi * 1024 + r32 * 16;
    const lds_cptr vp0 = shm3 + L_V + ((lane >> 4) & 1) * 32 + (lane & 3) * 8 + (4 * hi + ((lane & 15) >> 2)) * 64;
    volatile __attribute__((address_space(3))) unsigned* flags = (volatile __attribute__((address_space(3))) unsigned*)(shm3 + L_FLAG);
    int tile = 4 * qb + 3, slot = 0, it = 0;
    DMA_KV(tile, 0);
    const bf16_t* Qw = Qs + (rowbase + q0 + wid * 32 + r32) * SBW + h * HD;
    bf16x8 qr[4];
#pragma unroll
    for (int d0 = 0; d0 < 4; ++d0) qr[d0] = *(const bf16x8*)(Qw + d0 * 16 + hi * 8);
    float qn = 0.f;
#pragma unroll
    for (int d0 = 0; d0 < 4; ++d0)
#pragma unroll
        for (int e = 0; e < 8; ++e) qn += fabsf(bf2f((unsigned short)qr[d0][e]));
    qn += __shfl_xor(qn, 32);
    const float zmax = qn * __uint_as_float(kmax[b * 8 + h]) * 1.01f;
    const int tq = q0 + wid * 32 + r32;
    const int tq_min = q0 + wid * 32, tq_max = tq_min + 31;
    float R = 0.f;
    f32x16 o0 = {}, o1 = {};
    for (;;) {
        const bool has_next = tile > 0;
        if (has_next) { DMA_KV(tile - 1, slot ^ SLOTB); asm volatile("s_waitcnt vmcnt(2)" ::: "memory"); }
        else asm volatile("s_waitcnt vmcnt(0)" ::: "memory");
        __builtin_amdgcn_s_barrier(); asm volatile("" ::: "memory");
        const int kmin = tile * 64;
        if (kmin < tq_max) {
            f32x16 z0, z1;
            {
                const lds_cptr kb = kp0 + slot;
#pragma unroll
                for (int d0 = 0; d0 < 4; ++d0) {
                    const bf16x8 b0 = *(const __attribute__((address_space(3))) bf16x8*)(kb + d0 * 2048);
                    const bf16x8 b1 = *(const __attribute__((address_space(3))) bf16x8*)(kb + d0 * 2048 + 512);
                    if (d0 == 0) { z0 = __builtin_amdgcn_mfma_f32_32x32x16_bf16(b0, qr[0], (f32x16){}, 0, 0, 0); z1 = __builtin_amdgcn_mfma_f32_32x32x16_bf16(b1, qr[0], (f32x16){}, 0, 0, 0); }
                    else { z0 = __builtin_amdgcn_mfma_f32_32x32x16_bf16(b0, qr[d0], z0, 0, 0, 0); z1 = __builtin_amdgcn_mfma_f32_32x32x16_bf16(b1, qr[d0], z1, 0, 0, 0); }
                }
            }
            if (kmin + 63 >= tq_min) {
#pragma unroll
                for (int r = 0; r < 16; ++r) { const int kv = kmin + crow(r, hi); if (kv >= tq) z0[r] = -INFINITY; if (kv + 32 >= tq) z1[r] = -INFINITY; }
            }
            f32x16 s0, s1;
#pragma unroll
            for (int r = 0; r < 16; ++r) { z0[r] = fminf(z0[r], 120.f); z1[r] = fminf(z1[r], 120.f);
                s0[r] = __builtin_amdgcn_logf(1.f + __builtin_amdgcn_exp2f(z0[r])); s1[r] = __builtin_amdgcn_logf(1.f + __builtin_amdgcn_exp2f(z1[r])); }
            float gs_s0[4], gs_s1[4], gp_s0[4], gp_s1[4];
#pragma unroll
            for (int g = 0; g < 4; ++g) { gs_s0[g] = (s0[4 * g] + s0[4 * g + 1]) + (s0[4 * g + 2] + s0[4 * g + 3]); gs_s1[g] = (s1[4 * g] + s1[4 * g + 1]) + (s1[4 * g + 2] + s1[4 * g + 3]); }
#pragma unroll
            for (int g = 0; g < 4; ++g) { gp_s0[g] = __shfl_xor(gs_s0[g], 32); gp_s1[g] = __shfl_xor(gs_s1[g], 32); }
            float acc_ = R;
            SBA_GROUP(z1, s1, 3); SBA_GROUP(z1, s1, 2); SBA_GROUP(z1, s1, 1); SBA_GROUP(z1, s1, 0);
            SBA_GROUP(z0, s0, 3); SBA_GROUP(z0, s0, 2); SBA_GROUP(z0, s0, 1); SBA_GROUP(z0, s0, 0);
            R = acc_;
            u32x4 pw0, pw1, pw2, pw3;
            pw0 = (u32x4){cvtpk(z0[0], z0[1]), cvtpk(z0[2], z0[3]), cvtpk(z0[4], z0[5]), cvtpk(z0[6], z0[7])};
            pw1 = (u32x4){cvtpk(z0[8], z0[9]), cvtpk(z0[10], z0[11]), cvtpk(z0[12], z0[13]), cvtpk(z0[14], z0[15])};
            pw2 = (u32x4){cvtpk(z1[0], z1[1]), cvtpk(z1[2], z1[3]), cvtpk(z1[4], z1[5]), cvtpk(z1[6], z1[7])};
            pw3 = (u32x4){cvtpk(z1[8], z1[9]), cvtpk(z1[10], z1[11]), cvtpk(z1[12], z1[13]), cvtpk(z1[14], z1[15])};
            const lds_cptr vp = vp0 + slot;
#define SBA_PV(O, d0, ks, PW) do { const s16x4 lo_ = vtr(vp + (d0) * 4096 + (ks) * 1024), hi_ = vtr(vp + (d0) * 4096 + (ks) * 1024 + 512); \
                const bf16x8 vf_ = (bf16x8){lo_[0], lo_[1], lo_[2], lo_[3], hi_[0], hi_[1], hi_[2], hi_[3]}; \
                O = __builtin_amdgcn_mfma_f32_32x32x16_bf16(__builtin_bit_cast(bf16x8, PW), vf_, O, 0, 0, 0); } while (0)
            SBA_PV(o0, 0, 0, pw0); SBA_PV(o1, 1, 0, pw0); SBA_PV(o0, 0, 1, pw1); SBA_PV(o1, 1, 1, pw1);
            SBA_PV(o0, 0, 2, pw2); SBA_PV(o1, 1, 2, pw2); SBA_PV(o0, 0, 3, pw3); SBA_PV(o1, 1, 3, pw3);
#undef SBA_PV
        }
        const bool done = __all((zmax - R) < -150.f);
        if (lane == 0) flags[(it & 1) * 8 + wid] = done ? 1u : 0u;
        asm volatile("s_waitcnt lgkmcnt(0)" ::: "memory"); __builtin_amdgcn_s_barrier(); asm volatile("" ::: "memory");
        unsigned alld = 1u;
#pragma unroll
        for (int w = 0; w < 8; ++w) alld &= flags[(it & 1) * 8 + w];
        alld = __builtin_amdgcn_readfirstlane(alld);
        if (!has_next || alld) break;
        --tile; slot ^= SLOTB; ++it;
    }
    asm volatile("s_waitcnt vmcnt(0)" ::: "memory");
    {
        bf16_t* Ow = YY + (rowbase + q0 + wid * 32) * D + RW + h * HD;
        bf16_t* stg = (bf16_t*)(shm + L_OST) + wid * 2048;
#pragma unroll
        for (int r = 0; r < 16; ++r) { const int orow = crow(r, hi); stg[orow * 64 + r32] = (bf16_t)f2bf(o0[r]); stg[orow * 64 + 32 + r32] = (bf16_t)f2bf(o1[r]); }
        asm volatile("s_waitcnt lgkmcnt(0)" ::: "memory");
#pragma unroll
        for (int i = 0; i < 4; ++i) { const int row = i * 8 + (lane >> 3), ch = lane & 7; const u32x4 v = *(const u32x4*)(stg + row * 64 + ch * 8);
            *(u32x4*)(Ow + (size_t)row * D + ch * 8) = v;
            float ss = 0.f;
#pragma unroll
            for (int e = 0; e < 4; ++e) { const float lo = __uint_as_float(v[e] << 16), hh = __uint_as_float(v[e] & 0xffff0000u); ss += lo * lo + hh * hh; }
            ss += __shfl_xor(ss, 1); ss += __shfl_xor(ss, 2); ss += __shfl_xor(ss, 4);
            if (ch == 0) ssq_s8[(rowbase + q0 + wid * 32 + row) * 8 + h] = ss; }
    }
    asm volatile("s_waitcnt lgkmcnt(0)" ::: "memory"); __builtin_amdgcn_s_barrier(); asm volatile("" ::: "memory");
#undef DMA_KV
}
#undef SBA_GROUP
}
__device__ __forceinline__ void row_prep_x(const float* x, bf16_t* xb, float* rstd0, int row, int lane) {
    const f32x4* xr = (const f32x4*)(x + (size_t)row * D) + lane;
    float s = 0.f; f32x4 v[4];
#pragma unroll
    for (int j = 0; j < 4; ++j) { v[j] = xr[64 * j]; s += v[j].x * v[j].x + v[j].y * v[j].y + v[j].z * v[j].z + v[j].w * v[j].w; }
    s = wave_sum(s);
    if (lane == 0) rstd0[row] = 1.0f / sqrtf(s * (1.f / D) + EPS);
    unsigned long long* o8 = (unsigned long long*)(xb + (size_t)row * D) + lane;
#pragma unroll
    for (int j = 0; j < 4; ++j) o8[64 * j] = (unsigned long long)(f2bf(v[j].x) | (f2bf(v[j].y) << 16)) | ((unsigned long long)(f2bf(v[j].z) | (f2bf(v[j].w) << 16)) << 32);
}
__device__ __forceinline__ void row_prep_mem(const float* m, const float* g, bf16_t* o, int row, int lane) {
    const f32x4* xr = (const f32x4*)(m + (size_t)row * D) + lane;
    float s = 0.f; f32x4 v[4];
#pragma unroll
    for (int j = 0; j < 4; ++j) { v[j] = xr[64 * j]; s += v[j].x * v[j].x + v[j].y * v[j].y + v[j].z * v[j].z + v[j].w * v[j].w; }
    s = wave_sum(s);
    const float r = 1.0f / sqrtf(s * (1.f / D) + EPS);
    unsigned long long* o8 = (unsigned long long*)(o + (size_t)row * D) + lane;
#pragma unroll
    for (int j = 0; j < 4; ++j) { const f32x4 gg = ((const f32x4*)g)[64 * j + lane];
        o8[64 * j] = (unsigned long long)(f2bf(v[j].x * r * gg.x) | (f2bf(v[j].y * r * gg.y) << 16)) | ((unsigned long long)(f2bf(v[j].z * r * gg.z) | (f2bf(v[j].w * r * gg.w) << 16)) << 32); }
}
__device__ __forceinline__ void transpose_item(const float* W, int K, int N, bf16_t* Wt, int ldt, const float* g0, const float* g1, int ksplit, LAS float* scr, int item, int lane) {
    const int nblk = N / 32, kb = item / nblk, nb = item % nblk, k0 = 64 * kb, n0 = 32 * nb;
#pragma unroll 8
    for (int i = 0; i < 32; ++i) { const int kk = 2 * i + (lane >> 5), k = k0 + kk; float gv = 1.f; if (g0) gv = (k < ksplit) ? g0[k] : g1[k - ksplit];
        scr[kk * 33 + (lane & 31)] = W[(size_t)k * N + n0 + (lane & 31)] * gv; }
    asm volatile("s_waitcnt lgkmcnt(0)" ::: "memory");
    const int c = lane & 7;
#pragma unroll
    for (int j = 0; j < 4; ++j) { const int n = (lane >> 3) + 8 * j; const LAS float* s = scr + (8 * c) * 33 + n;
        u32x4 o; o.x = f2bf(s[0 * 33]) | (f2bf(s[1 * 33]) << 16); o.y = f2bf(s[2 * 33]) | (f2bf(s[3 * 33]) << 16); o.z = f2bf(s[4 * 33]) | (f2bf(s[5 * 33]) << 16); o.w = f2bf(s[6 * 33]) | (f2bf(s[7 * 33]) << 16);
        *(u32x4*)(Wt + (size_t)(n0 + n) * ldt + k0 + 8 * c) = o; }
    asm volatile("s_waitcnt lgkmcnt(0)" ::: "memory");
}

struct MidScale { const float* f; int k; int pad; };
template <class Epi>
__device__ __forceinline__ void gemm_naive(const Ctx& C, const bf16_t* A, int lda, const bf16_t* Bt, int ldb, int M, int N, int K, MidScale ms, const Epi& E) {
    const int lane = C.lane, fr = lane & 15, fq = lane >> 4, ncol = N / 64, ntile = (M / 16) * ncol;
    for (int t = C.gw; t < ntile; t += C.NGW) {
        const int row0 = (t / ncol) * 16, col0 = (t % ncol) * 64;
        const bf16_t* ap = A + (size_t)(row0 + fr) * lda + fq * 8;
        const bf16_t* bp = Bt + (size_t)(col0 + fr) * ldb + fq * 8;
        f32x4 acc[4];
#pragma unroll
        for (int n = 0; n < 4; ++n) acc[n] = (f32x4){0.f, 0.f, 0.f, 0.f};
        for (int k0 = 0; k0 < K; k0 += 32) {
            if (ms.f && k0 == ms.k) {
#pragma unroll
                for (int j = 0; j < 4; ++j) { const float f = ms.f[row0 + fq * 4 + j];
#pragma unroll
                    for (int n = 0; n < 4; ++n) acc[n][j] *= f; }
            }
            const bf16x8 a = *(const bf16x8*)(ap + k0);
#pragma unroll
            for (int n = 0; n < 4; ++n) { const bf16x8 b = *(const bf16x8*)(bp + (size_t)n * 16 * ldb + k0); acc[n] = __builtin_amdgcn_mfma_f32_16x16x32_bf16(a, b, acc[n], 0, 0, 0); }
        }
#pragma unroll
        for (int n = 0; n < 4; ++n)
#pragma unroll
            for (int j = 0; j < 4; ++j) E(row0 + fq * 4 + j, col0 + n * 16 + fr, acc[n][j]);
    }
}
struct EpiInProj { const float* rstd0; bf16_t *XR, *GG, *Qs, *Ks, *Vs;
    __device__ void operator()(int r, int c, float v) const { v *= rstd0[r]; const int t = c >> 9, cc = c & 511;
        if (t == 0) XR[(size_t)r * RW + cc] = (bf16_t)f2bf(v);
        else if (t == 1) GG[(size_t)r * RW + cc] = (bf16_t)f2bf(gelu_tanh(v));
        else if (t == 2) Qs[(size_t)r * SBW + cc] = (bf16_t)f2bf(v * (0.125f * LOG2E));
        else if (t == 3) Ks[(size_t)r * SBW + cc] = (bf16_t)f2bf(v);
        else Vs[(size_t)r * SBW + cc] = (bf16_t)f2bf(v); } };
struct EpiStoreBf16 { bf16_t* O; const float* rowscale; int ldo; float scale;
    __device__ void operator()(int r, int c, float v) const { O[(size_t)r * ldo + c] = (bf16_t)f2bf(v * (rowscale ? rowscale[r] : 1.f) * scale); } };
struct EpiResF32 { const float* base; const float* rowscale; bf16_t* O;
    __device__ void operator()(int r, int c, float v) const { O[(size_t)r * D + c] = (bf16_t)f2bf(base[(size_t)r * D + c] + v * rowscale[r]); } };
struct EpiResBf16 { const bf16_t* base; bf16_t* O;
    __device__ void operator()(int r, int c, float v) const { O[(size_t)r * D + c] = (bf16_t)f2bf(bf2f(base[(size_t)r * D + c]) + v); } };

__device__ __forceinline__ void lru_naive_unit(int unit, int j, LAS float* xs, const bf16_t* XR, const bf16_t* GG, const float* conv_w, const float* conv_b,
                                               const float* w_a, const float* b_a, const float* w_x, const float* b_x, const float* lam, bf16_t* YY) {
    const int b = unit >> 3, h = unit & 7, c = h * 64 + j;
    float wa[64], wx[64];
#pragma unroll
    for (int i = 0; i < 64; ++i) { wa[i] = w_a[(size_t)(h * 64 + i) * 64 + j]; wx[i] = w_x[(size_t)(h * 64 + i) * 64 + j]; }
    const float ba = b_a[c], bx = b_x[c], cw0 = conv_w[c], cw1 = conv_w[RW + c], cw2 = conv_w[2 * RW + c], cw3 = conv_w[3 * RW + c], cb = conv_b[c];
    const float l = lam[c], spl = (l > 15.f) ? __expf(-l) : log1pf(__expf(-l));
    float x0 = 0.f, x1 = 0.f, x2 = 0.f, hst = 0.f;
    for (int t = 0; t < SEQ; ++t) {
        const size_t row = (size_t)b * SEQ + t;
        const float x3 = bf2f(XR[row * RW + c]);
        const float xc = cw0 * x0 + cw1 * x1 + cw2 * x2 + cw3 * x3 + cb;
        x0 = x1; x1 = x2; x2 = x3;
        asm volatile("s_waitcnt lgkmcnt(0)" ::: "memory"); xs[j] = xc; asm volatile("s_waitcnt lgkmcnt(0)" ::: "memory");
        float ra = ba, ri = bx;
#pragma unroll
        for (int i = 0; i < 64; ++i) { const float xv = xs[i]; ra += xv * wa[i]; ri += xv * wx[i]; }
        const float r = sigmoidf_(ra), ig = sigmoidf_(ri);
        const float log_a = -8.0f * r * spl, a = __expf(log_a), bb = sqrtf(fmaxf(0.f, -expm1f(2.f * log_a))) * (ig * xc);
        hst = a * hst + bb;
        YY[row * D + c] = (bf16_t)f2bf(hst * bf2f(GG[row * RW + c]));
    }
}
__device__ __forceinline__ void sb_naive_unit(int unit, int lane, const bf16_t* Qs, const bf16_t* Ks, const bf16_t* Vs, bf16_t* YY, float* ssq_s8) {
    const int qb = unit & 63, h = (unit >> 6) & 7, b = unit >> 9;
    const int t = qb * 64 + lane; const size_t row = (size_t)b * SEQ + t;
    float q[64], o[64];
#pragma unroll
    for (int d = 0; d < 64; ++d) { q[d] = bf2f(Qs[row * SBW + h * 64 + d]); o[d] = 0.f; }
    float R = 0.f;
    for (int s = qb * 64 + 62; s >= 0; --s) {
        const bf16_t* kr = Ks + ((size_t)b * SEQ + s) * SBW + h * 64; const bf16_t* vr = Vs + ((size_t)b * SEQ + s) * SBW + h * 64;
        float z = 0.f;
#pragma unroll
        for (int d = 0; d < 64; ++d) z += q[d] * bf2f(kr[d]);
        const bool valid = s < t;
        const float sp = valid ? (fmaxf(z, 0.f) + __log2f(1.f + exp2f(-fabsf(z)))) : 0.f;
        const float w = valid ? exp2f(z - (R + sp)) : 0.f;
        R += sp;
        const float wb = bf2f((bf16_t)f2bf(w));
#pragma unroll
        for (int d = 0; d < 64; ++d) o[d] += wb * bf2f(vr[d]);
    }
    float ss = 0.f;
#pragma unroll
    for (int d = 0; d < 64; ++d) { ss += o[d] * o[d]; YY[row * D + RW + h * 64 + d] = (bf16_t)f2bf(o[d]); }
    ssq_s8[row * 8 + h] = ss;
}
__device__ __forceinline__ void xattn_naive_unit(int unit, int j, LAS float* qs, LAS float* ps, const bf16_t* QX, const bf16_t* KVM, bf16_t* OX) {
    const int tg = unit & 511, h = (unit >> 9) & 3, b = unit >> 11, lane = j & 63, wid = j >> 6;
    const size_t row0 = (size_t)b * SEQ + tg * 8;
    for (int i = 0; i < 8; ++i) qs[i * 256 + j] = bf2f(QX[(row0 + i) * D + h * XD + j]);
    __syncthreads();
    const bf16_t* kr = KVM + ((size_t)b * MEM + j) * 2048 + h * XD;
    float sc[8];
#pragma unroll
    for (int i = 0; i < 8; ++i) sc[i] = 0.f;
    for (int d = 0; d < XD; ++d) { const float kv = bf2f(kr[d]);
#pragma unroll
        for (int i = 0; i < 8; ++i) sc[i] += qs[i * 256 + d] * kv; }
#pragma unroll
    for (int i = 0; i < 8; ++i) ps[i * 256 + j] = sc[i];
    __syncthreads();
    for (int i = wid * 2; i < wid * 2 + 2; ++i) {
        float v0 = ps[i * 256 + lane], v1 = ps[i * 256 + lane + 64], v2 = ps[i * 256 + lane + 128], v3 = ps[i * 256 + lane + 192];
        float m = fmaxf(fmaxf(v0, v1), fmaxf(v2, v3));
#pragma unroll
        for (int o = 1; o < 64; o <<= 1) m = fmaxf(m, __shfl_xor(m, o));
        v0 = exp2f(v0 - m); v1 = exp2f(v1 - m); v2 = exp2f(v2 - m); v3 = exp2f(v3 - m);
        const float s = wave_sum(v0 + v1 + v2 + v3), inv = 1.f / s;
        ps[i * 256 + lane] = v0 * inv; ps[i * 256 + lane + 64] = v1 * inv; ps[i * 256 + lane + 128] = v2 * inv; ps[i * 256 + lane + 192] = v3 * inv;
    }
    __syncthreads();
    float o[8];
#pragma unroll
    for (int i = 0; i < 8; ++i) o[i] = 0.f;
    for (int m = 0; m < MEM; ++m) { const float vv = bf2f(KVM[((size_t)b * MEM + m) * 2048 + 1024 + h * XD + j]);
#pragma unroll
        for (int i = 0; i < 8; ++i) o[i] += ps[i * 256 + m] * vv; }
#pragma unroll
    for (int i = 0; i < 8; ++i) OX[(row0 + i) * D + h * XD + j] = (bf16_t)f2bf(o[i]);
    __syncthreads();
}
__device__ __forceinline__ int router_row(int row, int lane, const bf16_t* X2b, const float* ssq2p, const float* g, const float* wgr, const float* bgr, const float* wer, const float* ber, float* selw) {
    int cls = 0;
    float acc[20];
#pragma unroll
    for (int i = 0; i < 20; ++i) acc[i] = 0.f;
    const float rs = pg8::rstd16(ssq2p + (size_t)row * 16);
    for (int kk = 0; kk < 16; ++kk) { const int k = kk * 64 + lane; const float t = bf2f(X2b[(size_t)row * D + k]) * rs * g[k];
#pragma unroll
        for (int i = 0; i < 4; ++i) acc[i] += t * wgr[k * 4 + i];
#pragma unroll
        for (int gi = 0; gi < 4; ++gi)
#pragma unroll
            for (int e = 0; e < 4; ++e) acc[4 + gi * 4 + e] += t * wer[((size_t)gi * D + k) * 4 + e]; }
#pragma unroll
    for (int i = 0; i < 20; ++i) acc[i] = wave_sum(acc[i]);
    if (lane == 0) {
        float gl[4]; float gm = -INFINITY; int gi = 0;
#pragma unroll
        for (int i = 0; i < 4; ++i) { gl[i] = acc[i] + bgr[i]; if (gl[i] > gm) { gm = gl[i]; gi = i; } }
        float gs = 0.f;
#pragma unroll
        for (int i = 0; i < 4; ++i) gs += __expf(gl[i] - gm);
        const float gp = 1.f / gs;
        float el[4];
#pragma unroll
        for (int e = 0; e < 4; ++e) { float v = 0.f;
#pragma unroll
            for (int q = 0; q < 4; ++q) if (q == gi) v = acc[4 + q * 4 + e] + ber[q * 4 + e];
            el[e] = v; }
        int e1 = 0; float m1 = el[0];
#pragma unroll
        for (int e = 1; e < 4; ++e) if (el[e] > m1) { m1 = el[e]; e1 = e; }
        int e2 = -1; float m2 = -INFINITY;
#pragma unroll
        for (int e = 0; e < 4; ++e) if (e != e1 && el[e] > m2) { m2 = el[e]; e2 = e; }
        const float p2 = __expf(m2 - m1), w1 = gp / (1.f + p2), w2 = gp * p2 / (1.f + p2);
        const int ea = e1 < e2 ? e1 : e2, eb = e1 < e2 ? e2 : e1; const float wA = e1 < e2 ? w1 : w2, wB = e1 < e2 ? w2 : w1;
        const int pr = (ea == 0) ? eb - 1 : (ea == 1) ? eb + 1 : 5;
        selw[(size_t)row * 2] = wA; selw[(size_t)row * 2 + 1] = wB; cls = gi * 6 + pr;
    }
    return cls;
}
__device__ __forceinline__ void final_row(int row, int lane, const bf16_t* X3b, const float* ssq3, const float* g, float* out) {
    float v[16]; float s = 0.f;
#pragma unroll
    for (int j = 0; j < 16; ++j) { v[j] = bf2f(X3b[(size_t)row * D + j * 64 + lane]); s += v[j] * v[j]; }
    const float r = pg8::rstd16(ssq3 + (size_t)row * 16);
#pragma unroll
    for (int j = 0; j < 16; ++j) out[(size_t)row * D + j * 64 + lane] = v[j] * r * g[j * 64 + lane];
}

__global__ void __launch_bounds__(NTHREADS, 2) mk_fwd(Args args) {
    extern __shared__ __attribute__((aligned(16))) unsigned char lds[];
    cg::grid_group grid = cg::this_grid();
    Ctx C;
#pragma unroll
    for (int i = 0; i < 29; ++i) C.in[i] = args.in[i];
    C.out = args.out; C.ws = args.ws; C.lds = lds;
    C.tid = threadIdx.x; C.lane = C.tid & 63; C.wave = __builtin_amdgcn_readfirstlane(C.tid >> 6);
    C.G = gridDim.x; C.bid = blockIdx.x; C.gw = C.bid * NWAVES + C.wave; C.NGW = C.G * NWAVES;
    const float* x = C.in[0]; const float* mem = C.in[1]; const float* norm_mix = C.in[2]; const float* w_in = C.in[3];
    const float* conv_w = C.in[4]; const float* conv_b = C.in[5]; const float* lru_w_a = C.in[6]; const float* lru_b_a = C.in[7];
    const float* lru_w_x = C.in[8]; const float* lru_b_x = C.in[9]; const float* lru_lambda = C.in[10];
    const float* norm_rnn = C.in[11]; const float* norm_sb = C.in[12]; const float* w_out = C.in[13];
    const float* norm_xattn = C.in[14]; const float* norm_mem = C.in[15];
    const float* xa_w_q = C.in[16]; const float* xa_w_k = C.in[17]; const float* xa_w_v = C.in[18]; const float* xa_w_o = C.in[19];
    const float* norm_moe = C.in[20]; const float* w_gr = C.in[21]; const float* b_gr = C.in[22]; const float* w_er = C.in[23]; const float* b_er = C.in[24];
    const float* w_gate = C.in[25]; const float* w_up = C.in[26]; const float* w_down = C.in[27]; const float* norm_final = C.in[28];
    unsigned char* ws = C.ws; float* out = C.out;
    float* sm = (float*)(ws + WS_SMALL);
    float* rstd0 = sm + SM_RSTD0; float* ssq_r = sm + SM_SSQR; float* ssq_s = sm + SM_SSQS; float* ssq1 = sm + SM_SSQ1; float* ssq2 = sm + SM_SSQ2; unsigned* kmax = (unsigned*)(ws + WS_CTL); float* fmid = sm + SM_END; float* fend = fmid + 32768;
    float* selw = sm + SM_SELW; float* ssq3 = sm + SM_SSQ3; int* gcnt = (int*)(ws + WS_CTL + 1024);
    int* tlist = (int*)(sm + 64 * 32768); float* rsg = sm + 88 * 32768; float* wAg = rsg + 40960; float* wBg = wAg + 40960; int* tokg = (int*)(wBg + 40960);
    bf16_t* Wg_t = (bf16_t*)(ws + WS_WG); bf16_t* Wu_t = (bf16_t*)(ws + WS_WU); bf16_t* Wd2 = (bf16_t*)(ws + WS_WD2); bf16_t* XG = (bf16_t*)(ws + WS_R1); bf16_t* HID = (bf16_t*)(ws + WS_R5);
    bf16_t* Win_t = (bf16_t*)(ws + WS_WIN); bf16_t* Wout_t = (bf16_t*)(ws + WS_WOUT); bf16_t* Wq_t = (bf16_t*)(ws + WS_WQ); bf16_t* Wkv_t = (bf16_t*)(ws + WS_WKV); bf16_t* Wo_t = (bf16_t*)(ws + WS_WO);
    bf16_t* memn = (bf16_t*)(ws + WS_MEMN); bf16_t* KVM = (bf16_t*)(ws + WS_KVM);
    bf16_t* xb = (bf16_t*)(ws + WS_R0); bf16_t* X1b = xb; bf16_t* X3b = xb;
    bf16_t* XR = (bf16_t*)(ws + WS_R1); bf16_t* GG = XR + (size_t)NTOK * RW; bf16_t* QX = XR;
    bf16_t* Qs = (bf16_t*)(ws + WS_R2); bf16_t* Ks = Qs + (size_t)NTOK * SBW; bf16_t* OX = Qs;
    bf16_t* Vs = (bf16_t*)(ws + WS_R3);
    bf16_t* YY = (bf16_t*)(ws + WS_R4); bf16_t* X2b = YY;
    const int gw = C.gw, NGW = C.NGW, lane = C.lane;
#define GRID_SYNC() grid.sync()

    {
        if (gw == 0) { kmax[lane] = 0u; if (lane < 32) gcnt[lane] = 0; }
        for (int r = gw; r < NTOK; r += NGW) row_prep_x(x, xb, rstd0, r, lane);
        for (int r = gw; r < NMEM; r += NGW) row_prep_mem(mem, norm_mem, memn, r, lane);
        LAS float* scr = (LAS float*)(lds) + C.wave * (64 * 33);
        constexpr int I_IN = (D / 64) * (PROJ / 32), I_SQ = (D / 64) * (D / 32);
        for (int it = gw; it < I_IN + 5 * I_SQ; it += NGW) {
            int r = it;
            if (r < I_IN) { transpose_item(w_in, D, PROJ, Win_t, D, norm_mix, norm_mix, D, scr, r, lane); continue; } r -= I_IN;
            if (r < I_SQ) { transpose_item(w_out, D, D, Wout_t, D, norm_rnn, norm_sb, RW, scr, r, lane); continue; } r -= I_SQ;
            if (r < I_SQ) { transpose_item(xa_w_q, D, D, Wq_t, D, norm_xattn, norm_xattn, D, scr, r, lane); continue; } r -= I_SQ;
            if (r < I_SQ) { transpose_item(xa_w_k, D, D, Wkv_t, D, nullptr, nullptr, 0, scr, r, lane); continue; } r -= I_SQ;
            if (r < I_SQ) { transpose_item(xa_w_v, D, D, Wkv_t + (size_t)D * D, D, nullptr, nullptr, 0, scr, r, lane); continue; } r -= I_SQ;
            transpose_item(xa_w_o, D, D, Wo_t, D, nullptr, nullptr, 0, scr, r, lane);
        }
        constexpr int I_GU = (D / 64) * (DE / 32), I_DN = (DE / 64) * (D / 32);
        for (int it = gw; it < 32 * I_GU + 48 * I_DN; it += NGW) {
            int r = it;
            if (r < 16 * I_GU) { const int e = r / I_GU; transpose_item(w_gate + (size_t)e * D * DE, D, DE, Wg_t + (size_t)e * DE * D, D, norm_moe, norm_moe, D, scr, r % I_GU, lane); continue; } r -= 16 * I_GU;
            if (r < 16 * I_GU) { const int e = r / I_GU; transpose_item(w_up + (size_t)e * D * DE, D, DE, Wu_t + (size_t)e * DE * D, D, norm_moe, norm_moe, D, scr, r % I_GU, lane); continue; } r -= 16 * I_GU;
            { const int cs = r / I_DN, cls = cs >> 1, slot = cs & 1; int ea, eb; pg8::pair_ab(cls % 6, ea, eb); const int e = (cls / 6) * 4 + (slot ? eb : ea);
              transpose_item(w_down + (size_t)e * DE * D, DE, D, Wd2 + (size_t)cls * D * 512 + slot * DE, 512, nullptr, nullptr, 0, scr, r % I_DN, lane); }
        }
    }
    GRID_SYNC();
    { pg8::DenseOrder S; S.init(xb, D, Win_t, D, NTOK, PROJ, C.G, C.bid); pg8::EpiInProjF E{0, rstd0, XR, GG, Qs, Ks, Vs, kmax};
      pg8::gemm_phase<pg8::EpiInProjF, pg8::DenseOrder, true>((LAS unsigned char*)lds, pg8::Gemm{D, D, D}, S, E); }
    { pg8::DenseOrder S; S.init(memn, D, Wkv_t, D, NMEM, 2048, C.G, C.bid); pg8::EpiBf16F E{0, KVM, nullptr, 2048, 1.f};
      pg8::gemm_phase<pg8::EpiBf16F, pg8::DenseOrder, true>((LAS unsigned char*)lds, pg8::Gemm{D, D, D}, S, E); }
    GRID_SYNC();
    {
        LAS float* xs = (LAS float*)(lds + 131072 + 4096) + C.wave * 64;
        if (gw < BATCH * NH) lru_naive_unit(gw, lane, xs, XR, GG, conv_w, conv_b, lru_w_a, lru_b_a, lru_w_x, lru_b_x, lru_lambda, YY);
        __syncthreads();
        for (int u = C.bid; u < BATCH * NH * 16; u += C.G) sba::sb_unit(u >> 7, (u >> 4) & 7, 15 - (u & 15), Qs, Ks, Vs, YY, ssq_s, kmax, (char*)lds);
    }
    GRID_SYNC();
    for (int r = gw; r < NTOK; r += NGW) {
        float s = 0.f;
        for (int c = lane; c < RW; c += 64) { const float v = bf2f(YY[(size_t)r * D + c]); s += v * v; }
        s = wave_sum(s);
        if (lane == 0) { float s2 = 0.f;
#pragma unroll
            for (int i = 0; i < 8; ++i) s2 += ssq_s[(size_t)r * 8 + i];
            const float rr = 1.0f / sqrtf(s * (1.f / RW) + EPS), rs = 1.0f / sqrtf(s2 * (1.f / SBW) + EPS); fmid[r] = rr / rs; fend[r] = rs; }
    }
    GRID_SYNC();
    { pg8::DenseOrder S; S.init(YY, D, Wout_t, D, NTOK, D, C.G, C.bid); pg8::EpiX1F E{8, x, fmid, fend, X1b, ssq1};
      pg8::gemm_phase<pg8::EpiX1F, pg8::DenseOrder, true>((LAS unsigned char*)lds, pg8::Gemm{D, D, D}, S, E); }
    GRID_SYNC();
    { pg8::DenseOrder S; S.init(X1b, D, Wq_t, D, NTOK, D, C.G, C.bid); pg8::EpiBf16F E{0, QX, ssq1, D, 0.0625f * LOG2E};
      pg8::gemm_phase<pg8::EpiBf16F, pg8::DenseOrder, true>((LAS unsigned char*)lds, pg8::Gemm{D, D, D}, S, E); }
    GRID_SYNC();
    {
        const int half = C.tid >> 8, j = C.tid & 255;
        LAS float* qs = (LAS float*)(lds) + half * 4096; LAS float* ps = qs + 2048;
        for (int u = C.bid * 2; u < BATCH * XH * 512; u += C.G * 2) xattn_naive_unit(u + half, j, qs, ps, QX, KVM, OX);
    }
    GRID_SYNC();
    { pg8::DenseOrder S; S.init(OX, D, Wo_t, D, NTOK, D, C.G, C.bid); pg8::EpiResF E{0, X1b, X2b, ssq2};
      pg8::gemm_phase<pg8::EpiResF, pg8::DenseOrder, true>((LAS unsigned char*)lds, pg8::Gemm{D, D, D}, S, E); }
    GRID_SYNC();
    {
        LAS int* lcnt = (LAS int*)lds; LAS int* lbase = lcnt + 32; LAS int* lcls = lcnt + 64; LAS int* lpos = lcnt + 192;
        for (int chunk = C.bid; chunk < NTOK / 128; chunk += C.G) {
            if (C.tid < 32) lcnt[C.tid] = 0;
            __syncthreads();
            for (int i = 0; i < 16; ++i) { const int lt = C.wave * 16 + i, row = chunk * 128 + lt;
                const int cls = router_row(row, lane, X2b, ssq2, norm_moe, w_gr, b_gr, w_er, b_er, selw);
                if (lane == 0) { lcls[lt] = cls; lpos[lt] = __hip_atomic_fetch_add(lcnt + cls, 1, __ATOMIC_RELAXED, __HIP_MEMORY_SCOPE_WORKGROUP); } }
            __syncthreads();
            if (C.tid < 24) lbase[C.tid] = atomicAdd(gcnt + C.tid, lcnt[C.tid]);
            __syncthreads();
            if (C.tid < 128) { const int c = lcls[C.tid]; tlist[(size_t)c * NTOK + lbase[c] + lpos[C.tid]] = chunk * 128 + C.tid; }
            __syncthreads();
        }
    }
    GRID_SYNC();
    LAS int* meta = (LAS int*)(lds + 131072 + 1024);
    {
        if (C.tid == 0) { int rb = 0, tb = 0;
            for (int c = 0; c < 24; ++c) { const int n = gcnt[c], nt = (n + 255) >> 8; meta[c] = n; meta[32 + c] = rb; meta[64 + c] = tb; rb += nt * 256; tb += nt; }
            meta[32 + 24] = rb; meta[64 + 24] = tb; }
        __syncthreads();
        const int total = meta[32 + 24];
        for (int R = gw; R < total; R += NGW) {
            int c = 0;
            for (int k = 1; k < 24; ++k) c += (R >= meta[32 + k]) ? 1 : 0;
            const int p = R - meta[32 + c]; u32x4 v0 = (u32x4){0u, 0u, 0u, 0u}, v1 = v0; int tok = -1; float rs = 0.f, wA = 0.f, wB = 0.f;
            if (p < meta[c]) { tok = tlist[(size_t)c * NTOK + p]; const u32x4* src = (const u32x4*)(X2b + (size_t)tok * D) + lane; v0 = src[0]; v1 = src[64];
                rs = pg8::rstd16(ssq2 + (size_t)tok * 16); wA = selw[(size_t)tok * 2]; wB = selw[(size_t)tok * 2 + 1]; }
            u32x4* dst = (u32x4*)(XG + (size_t)R * D) + lane; dst[0] = v0; dst[64] = v1;
            if (lane == 0) { rsg[R] = rs; wAg[R] = wA; wBg[R] = wB; tokg[R] = tok; }
        }
    }
    GRID_SYNC();
    { pg8::MoeOrder1 S{XG, Wg_t, Wu_t, meta, C.G, C.bid}; pg8::EpiMoeUp E{0, rsg, wAg, wBg, HID};
      pg8::gemm_phase<pg8::EpiMoeUp, pg8::MoeOrder1, true>((LAS unsigned char*)lds, pg8::Gemm{D, D, D}, S, E); }
    GRID_SYNC();
    { pg8::MoeOrder2 S{HID, Wd2, meta, C.G, C.bid}; pg8::EpiMoeDown E{0, tokg, X2b, X3b, ssq3};
      pg8::gemm_phase<pg8::EpiMoeDown, pg8::MoeOrder2, true>((LAS unsigned char*)lds, pg8::Gemm{512, 512, 512}, S, E); }
    GRID_SYNC();
    for (int r = gw; r < NTOK; r += NGW) final_row(r, lane, X3b, ssq3, norm_final, out);
}

extern "C" void kernel_launch(void* const* d_in, const int* in_sizes, int n_in, void* d_out, int out_size, void* d_ws, size_t ws_size, hipStream_t stream) {
    static int grid = 0;
    if (grid == 0) {
        if (n_in != 29 || ws_size < WS_END) { fprintf(stderr, "kernel_launch: unexpected inputs (%d) or workspace (%zu)\n", n_in, ws_size); grid = -1; return; }
        int dev = 0, cus = 0, per_cu = 0;
        hipGetDevice(&dev); hipDeviceGetAttribute(&cus, hipDeviceAttributeMultiprocessorCount, dev);
        hipFuncSetAttribute((const void*)mk_fwd, hipFuncAttributeMaxDynamicSharedMemorySize, LDS_BYTES);
        hipOccupancyMaxActiveBlocksPerMultiprocessor(&per_cu, (const void*)mk_fwd, NTHREADS, LDS_BYTES);
        if (per_cu < 1) { fprintf(stderr, "kernel_launch: occupancy query says %d blocks per CU\n", per_cu); per_cu = 1; }
        if (per_cu > 1) per_cu = 1;
        grid = cus * per_cu;
    }
    if (grid < 0) return;
    Args a{};
    for (int i = 0; i < 29; ++i) a.in[i] = (const float*)d_in[i];
    a.out = (float*)d_out; a.ws = (unsigned char*)d_ws;
    void* kargs[] = {&a};
    hipError_t e = hipLaunchCooperativeKernel((const void*)mk_fwd, dim3(grid), dim3(NTHREADS), kargs, LDS_BYTES, stream);
    if (e != hipSuccess) fprintf(stderr, "cooperative launch failed: %s (grid %d)\n", hipGetErrorString(e), grid);
}
```

```cpp
#include <hip/hip_runtime.h>
#include <hip/hip_cooperative_groups.h>
#include <cstdio>
#include <cstdint>

typedef unsigned short bf16_t;
typedef short bf16x8 __attribute__((ext_vector_type(8)));
typedef float f32x4 __attribute__((ext_vector_type(4)));
typedef unsigned u32x4 __attribute__((ext_vector_type(4)));

constexpr int D = 1024, BATCH = 8, SEQ = 4096, NTOK = BATCH * SEQ, MEM = 256, NMEM = BATCH * MEM;
constexpr int RW = 512, SBW = 512, PROJ = 2560, NH = 8, HD = 64;
constexpr int XH = 4, XD = 256, NG = 4, EPG = 4, NEXP = 16, DE = 256;
constexpr float EPS = 1e-6f, LOG2E = 1.4426950408889634f;

constexpr size_t MiB = 1u << 20;
constexpr size_t WS_CTL = 0;
constexpr size_t WS_SMALL = 1 * MiB;
constexpr size_t WS_WIN = 16 * MiB;
constexpr size_t WS_WOUT = 21 * MiB;
constexpr size_t WS_WQ = 23 * MiB;
constexpr size_t WS_WKV = 25 * MiB;
constexpr size_t WS_WO = 29 * MiB;
constexpr size_t WS_MEMN = 31 * MiB;
constexpr size_t WS_KVM = 35 * MiB;
constexpr size_t WS_WG = 43 * MiB;
constexpr size_t WS_WU = 51 * MiB;
constexpr size_t WS_WD2 = 59 * MiB;
constexpr size_t WS_R0 = 96 * MiB;
constexpr size_t WS_R1 = 160 * MiB;
constexpr size_t WS_R2 = 224 * MiB;
constexpr size_t WS_R3 = 288 * MiB;
constexpr size_t WS_R4 = 320 * MiB;
constexpr size_t WS_R5 = 384 * MiB;
constexpr size_t WS_END = 448 * MiB;

constexpr size_t SM_RSTD0 = 0;
constexpr size_t SM_SSQR = 1 * 32768;
constexpr size_t SM_SSQS = 2 * 32768;
constexpr size_t SM_SSQ1 = 10 * 32768;
constexpr size_t SM_SSQ2 = 26 * 32768;
constexpr size_t SM_SSQ3 = 42 * 32768;
constexpr size_t SM_SELW = 58 * 32768;
constexpr size_t SM_SELE = 60 * 32768;
constexpr size_t SM_END = 62 * 32768;

__device__ __forceinline__ unsigned f2bf(float f) { unsigned u = __builtin_bit_cast(unsigned, f); return (u + 0x7fffu + ((u >> 16) & 1u)) >> 16; }
__device__ __forceinline__ float bf2f(unsigned short h) { return __builtin_bit_cast(float, (unsigned)h << 16); }
__device__ __forceinline__ float wave_sum(float v) {
#pragma unroll
    for (int o = 1; o < 64; o <<= 1) v += __shfl_xor(v, o);
    return v;
}
__device__ __forceinline__ float gelu_tanh(float x) { const float u = 0.7978845608028654f * (x + 0.044715f * x * x * x); return x / (1.f + __expf(-2.f * u)); }
__device__ __forceinline__ float sigmoidf_(float x) { return 1.f / (1.f + __expf(-x)); }

namespace cg = cooperative_groups;
#define LAS __attribute__((address_space(3)))
constexpr int NWAVES = 8, NTHREADS = 512;
constexpr int LDS_BYTES = 147456;

struct Args { const float* in[29]; float* out; unsigned char* ws; };

struct Ctx {
    const float* in[29]; float* out; unsigned char* ws; unsigned char* lds;
    int tid, lane, wave, gw, NGW, G, bid;
};

namespace pg8 {
#define PG8_LAS __attribute__((address_space(3)))
constexpr int BM = 256, BK = 64, HALF = 128, HTB = HALF * BK * 2  , STAGE_BYTES = 8 * HTB, NXCD = 8, WGM = 8;
__host__ __device__ __forceinline__ int lds_byte(int r, int c) { const int st = (r >> 4) * 2 + (c >> 5), rr = r & 15, cc = c & 31, ob = rr * 64 + cc * 2; return st * 1024 + (ob ^ (((ob >> 9) & 1) << 5)); }
__host__ __device__ __forceinline__ void stage_rc(int b, int& R, int& C) { const int st = b / 1024, sb = b % 1024, swz = sb ^ (((sb >> 9) & 1) << 5); R = (st >> 1) * 16 + swz / 64; C = (st & 1) * 32 + (swz % 64) / 2; }
__host__ __device__ __forceinline__ int perm32(int rho) { const int n = rho >> 4, i = rho & 15; return 8 * (i >> 2) + 4 * n + (i & 3); }

struct Unit { int pm, pn; };
struct Gemm { int lda, ldb, K; };
struct DenseOrder {
    const bf16_t* A; const bf16_t* Bt; int lda, ldb; int nM, nN, nwg, G, c;
    __device__ void init(const bf16_t* A_, int lda_, const bf16_t* Bt_, int ldb_, int M, int N, int G_, int c_) { A = A_; Bt = Bt_; lda = lda_; ldb = ldb_; nM = M / BM; nN = N / BM; nwg = nM * nN; G = G_; c = c_; }
    __device__ bool next(int i, Unit& u) const {
        const long L = (long)i * G + c; if (L >= nwg) return false;
        int wgid = (int)L; { const int q = nwg / NXCD, r = nwg % NXCD, xcd = wgid % NXCD, off = wgid / NXCD; wgid = (xcd < r ? xcd * (q + 1) : r * (q + 1) + (xcd - r) * q) + off; }
        const int nig = WGM * nN, gid = wgid / nig, fm = gid * WGM, gsz = (nM - fm) < WGM ? (nM - fm) : WGM;
        u.pm = fm + ((wgid % nig) % gsz); u.pn = (wgid % nig) / gsz; return true;
    }
    __device__ __forceinline__ void ptrs(const Unit& u, const char*& a, const char*& b0, const char*& b1) const {
        a = (const char*)A + (size_t)u.pm * BM * lda * 2; b0 = (const char*)Bt + (size_t)u.pn * BM * ldb * 2; b1 = b0 + (size_t)HALF * ldb * 2; }
};

__device__ __forceinline__ unsigned cvt_pk_bf16(float lo, float hi) { unsigned r; asm volatile("v_cvt_pk_bf16_f32 %0, %1, %2" : "=v"(r) : "v"(lo), "v"(hi)); return r; }

template <class Epi, class Sched, bool ALIGN_EPI>
__device__ __forceinline__ void gemm_phase(PG8_LAS unsigned char* lds, const Gemm g, const Sched& S, const Epi& E) {
    int tid_ = threadIdx.x; asm volatile("" : "+v"(tid_));
    const int tid = tid_, wid = __builtin_amdgcn_readfirstlane(tid >> 6), lane = tid & 63, wr = wid >> 2, wc = wid & 3, fr = lane & 15, fq = lane >> 4;
    const int K = g.K, nt = K / BK;
    unsigned voffA[2], voffB[2];
#pragma unroll
    for (int i = 0; i < 2; ++i) { int R, C; stage_rc(tid * 16 + i * 8192, R, C); const int Rb = Epi::PERM ? ((R & ~31) + perm32(R & 31)) : R;
        voffA[i] = (unsigned)(R * g.lda + C) * 2u; voffB[i] = (unsigned)(Rb * g.ldb + C) * 2u; }
    const size_t kstep = (size_t)(BK * 2);
    const size_t hstepA = (size_t)HALF * g.lda * 2;
    const unsigned ldsw = (unsigned)wid * 1024u;
    const int aoff = lds_byte(wr * 64 + fr, fq * 8), boff = lds_byte(wc * 32 + fr, fq * 8);
#define PG8_SA(b, h) (((b) * 2 + (h)) * HTB)
#define PG8_SB(b, h) ((4 + (b) * 2 + (h)) * HTB)
#define PG8_STAGE(bufoff, gbase, voff) do { _Pragma("unroll") for (int _i = 0; _i < 2; ++_i) \
        __builtin_amdgcn_global_load_lds((const unsigned*)((const char*)(gbase) + (voff)[_i]), (PG8_LAS unsigned*)(lds + (bufoff) + ldsw + _i * 8192), 16, 0, 0); } while (0)
#define PG8_LDA(dst, b, h) do { _Pragma("unroll") for (int m = 0; m < 4; ++m) _Pragma("unroll") for (int k = 0; k < 2; ++k) dst[m][k] = *(const PG8_LAS bf16x8*)(lds + PG8_SA(b, h) + aoff + m * 2048 + k * 1024); } while (0)
#define PG8_LDB(dst, b, h) do { _Pragma("unroll") for (int n = 0; n < 2; ++n) _Pragma("unroll") for (int k = 0; k < 2; ++k) dst[n][k] = *(const PG8_LAS bf16x8*)(lds + PG8_SB(b, h) + boff + n * 2048 + k * 1024); } while (0)
#define PG8_MMA(ai, bj, At, Bt) do { __builtin_amdgcn_s_setprio(1); _Pragma("unroll") for (int m = 0; m < 4; ++m) _Pragma("unroll") for (int n = 0; n < 2; ++n) _Pragma("unroll") for (int k = 0; k < 2; ++k) \
        acc[ai][bj][m][n] = __builtin_amdgcn_mfma_f32_16x16x32_bf16(Bt[n][k], At[m][k], acc[ai][bj][m][n], 0, 0, 0); __builtin_amdgcn_s_setprio(0); } while (0)
#define PG8_WAIT_V(n) asm volatile("s_waitcnt vmcnt(" #n ")" ::: "memory")
#define PG8_WAIT_L(n) asm volatile("s_waitcnt lgkmcnt(" #n ")" ::: "memory")
#define PG8_BAR __builtin_amdgcn_s_barrier()
#define PG8_SCHED __builtin_amdgcn_sched_barrier(0)
    Unit cur, nxt; int ui = 0;
    if (!S.next(0, cur)) return;
    f32x4 acc[2][2][4][2];
#pragma unroll
    for (int a = 0; a < 2; ++a)
#pragma unroll
        for (int b = 0; b < 2; ++b)
#pragma unroll
            for (int m = 0; m < 4; ++m)
#pragma unroll
                for (int n = 0; n < 2; ++n) acc[a][b][m][n] = (f32x4){0.f, 0.f, 0.f, 0.f};
    bf16x8 At[4][2], B0[2][2], B1[2][2];
    const char *cA, *cB0, *cB1; S.ptrs(cur, cA, cB0, cB1);
    PG8_STAGE(PG8_SB(0, 0), cB0, voffB); PG8_STAGE(PG8_SB(0, 1), cB1, voffB); PG8_STAGE(PG8_SA(0, 0), cA, voffA); PG8_STAGE(PG8_SA(0, 1), cA + hstepA, voffA);
    if (wr == 1) PG8_BAR;
    PG8_WAIT_V(2); PG8_BAR;
    PG8_STAGE(PG8_SB(1, 0), cB0 + kstep, voffB); PG8_STAGE(PG8_SA(1, 0), cA + kstep, voffA); PG8_STAGE(PG8_SB(1, 1), cB1 + kstep, voffB);
    PG8_WAIT_V(6); PG8_BAR;
    for (;;) {
        const bool has_next = S.next(ui + 1, nxt);
        const char *nA = cA, *nB0 = cB0, *nB1 = cB1; if (has_next) S.ptrs(nxt, nA, nB0, nB1);
        for (int t = 0; t < nt; t += 2) {
            const bool last = (t == nt - 2);
            if constexpr (Epi::HAS_MID) { if (t == E.mid_t) E.mid(acc, cur, wr, wc, fr, fq); }
            const char* a1 = cA + (size_t)(t + 1) * kstep;
            const char* a2 = last ? nA : cA + (size_t)(t + 2) * kstep; const char* b2 = last ? nB0 : cB0 + (size_t)(t + 2) * kstep; const char* b2h = last ? nB1 : cB1 + (size_t)(t + 2) * kstep;
            const char* a3 = a2 + kstep; const char* b3 = b2 + kstep; const char* b3h = b2h + kstep;
            PG8_LDB(B0, 0, 0); PG8_LDB(B1, 0, 1); PG8_SCHED; PG8_LDA(At, 0, 0); PG8_STAGE(PG8_SA(1, 1), a1 + hstepA, voffA);
            PG8_WAIT_V(8); PG8_WAIT_L(0); PG8_BAR; PG8_MMA(0, 0, At, B0); PG8_MMA(0, 1, At, B1); PG8_BAR; PG8_SCHED;
            PG8_LDA(At, 0, 1); PG8_STAGE(PG8_SB(0, 0), b2, voffB); PG8_STAGE(PG8_SB(0, 1), b2h, voffB); PG8_STAGE(PG8_SA(0, 0), a2, voffA);
            PG8_WAIT_V(8); PG8_WAIT_L(0); PG8_BAR; PG8_MMA(1, 0, At, B0); PG8_MMA(1, 1, At, B1); PG8_BAR; PG8_SCHED;
            PG8_LDB(B0, 1, 0); PG8_LDB(B1, 1, 1); PG8_SCHED; PG8_LDA(At, 1, 0); PG8_STAGE(PG8_SA(0, 1), a2 + hstepA, voffA);
            PG8_WAIT_V(8); PG8_WAIT_L(0); PG8_BAR; PG8_MMA(0, 0, At, B0); PG8_MMA(0, 1, At, B1); PG8_BAR; PG8_SCHED;
            PG8_LDA(At, 1, 1); PG8_STAGE(PG8_SB(1, 0), b3, voffB); PG8_STAGE(PG8_SB(1, 1), b3h, voffB); PG8_STAGE(PG8_SA(1, 0), a3, voffA);
            PG8_WAIT_V(8); PG8_WAIT_L(0); PG8_BAR; PG8_MMA(1, 0, At, B0); PG8_MMA(1, 1, At, B1); PG8_BAR; PG8_SCHED;
        }
        if constexpr (ALIGN_EPI) { if (wr == 0) PG8_BAR; }
        E(acc, cur, wr, wc, fr, fq);
        if (!has_next) break;
#pragma unroll
        for (int a = 0; a < 2; ++a)
#pragma unroll
            for (int b = 0; b < 2; ++b)
#pragma unroll
                for (int m = 0; m < 4; ++m)
#pragma unroll
                    for (int n = 0; n < 2; ++n) acc[a][b][m][n] = (f32x4){0.f, 0.f, 0.f, 0.f};
        cur = nxt; cA = nA; cB0 = nB0; cB1 = nB1; ++ui;
        if constexpr (ALIGN_EPI) { if (wr == 1) PG8_BAR; }
    }
    PG8_WAIT_V(0);
    if constexpr (!ALIGN_EPI) { if (wr == 0) PG8_BAR; }
    PG8_BAR;
#undef PG8_SA
#undef PG8_SB
#undef PG8_STAGE
#undef PG8_LDA
#undef PG8_LDB
#undef PG8_MMA
#undef PG8_WAIT_V
#undef PG8_WAIT_L
#undef PG8_BAR
#undef PG8_SCHED
}

__device__ __forceinline__ float rstd16(const float* p) { const f32x4 a = ((const f32x4*)p)[0], b = ((const f32x4*)p)[1], c = ((const f32x4*)p)[2], d = ((const f32x4*)p)[3];
    const float s = ((a.x + a.y) + (a.z + a.w)) + ((b.x + b.y) + (b.z + b.w)) + ((c.x + c.y) + (c.z + c.w)) + ((d.x + d.y) + (d.z + d.w)); return 1.0f / sqrtf(s * (1.f / D) + EPS); }
__device__ __forceinline__ u32x4 pack8(const f32x4 v0, const f32x4 v1) { u32x4 w; w.x = cvt_pk_bf16(v0[0], v0[1]); w.y = cvt_pk_bf16(v0[2], v0[3]); w.z = cvt_pk_bf16(v1[0], v1[1]); w.w = cvt_pk_bf16(v1[2], v1[3]); return w; }
__device__ __forceinline__ float sq8(const f32x4 a, const f32x4 b) { return ((a[0] * a[0] + a[1] * a[1]) + (a[2] * a[2] + a[3] * a[3])) + ((b[0] * b[0] + b[1] * b[1]) + (b[2] * b[2] + b[3] * b[3])); }

struct EpiInProjF {
    static constexpr bool PERM = true, HAS_MID = false; int mid_t;
    const float* rstd0; bf16_t *XR, *GG, *Qs, *Ks, *Vs; unsigned* kmax;
    __device__ __forceinline__ void mid(f32x4 (&)[2][2][4][2], const Unit&, int, int, int, int) const {}
    __device__ __forceinline__ void operator()(const f32x4 (&acc)[2][2][4][2], const Unit& u, int wr, int wc, int fr, int fq) const {
        const int row0 = u.pm * BM + wr * 64 + fr, t = u.pn >> 1, colt = (u.pn & 1) * 256 + wc * 32 + 8 * fq;
        bf16_t* base = (t == 0) ? XR : (t == 1) ? GG : (t == 2) ? Qs : (t == 3) ? Ks : Vs;
        float km0 = 0.f, km1 = 0.f;
#pragma unroll
        for (int ai = 0; ai < 2; ++ai)
#pragma unroll
            for (int m = 0; m < 4; ++m) { const int r = row0 + ai * HALF + m * 16; const float rs = rstd0[r]; bf16_t* rowp = base + (size_t)r * 512 + colt;
#pragma unroll
                for (int bj = 0; bj < 2; ++bj) { f32x4 v0 = acc[ai][bj][m][0] * rs, v1 = acc[ai][bj][m][1] * rs;
                    if (t == 1) {
#pragma unroll
                        for (int e = 0; e < 4; ++e) { v0[e] = gelu_tanh(v0[e]); v1[e] = gelu_tanh(v1[e]); } }
                    else if (t == 2) { v0 = v0 * (0.125f * LOG2E); v1 = v1 * (0.125f * LOG2E); }
                    else if (t == 3) { float mx = 0.f;
#pragma unroll
                        for (int e = 0; e < 4; ++e) mx = fmaxf(mx, fmaxf(fabsf(v0[e]), fabsf(v1[e])));
                        if (bj == 0) km0 = fmaxf(km0, mx); else km1 = fmaxf(km1, mx); }
                    *(u32x4*)(rowp + bj * HALF) = pack8(v0, v1); } }
        if (t == 3) {
#pragma unroll
            for (int o = 1; o < 64; o <<= 1) { km0 = fmaxf(km0, __shfl_xor(km0, o)); km1 = fmaxf(km1, __shfl_xor(km1, o)); }
            if ((fr | fq) == 0) { const int b = (u.pm * BM) / SEQ, hd = (u.pn & 1) * 4 + (wc >> 1);
                atomicMax(kmax + b * 8 + hd, __float_as_uint(km0)); atomicMax(kmax + b * 8 + hd + 2, __float_as_uint(km1)); }
        }
    }
};
struct EpiBf16F {
    static constexpr bool PERM = true, HAS_MID = false; int mid_t;
    bf16_t* O; const float* ssq16; int ldo; float scale;
    __device__ __forceinline__ void mid(f32x4 (&)[2][2][4][2], const Unit&, int, int, int, int) const {}
    __device__ __forceinline__ void operator()(const f32x4 (&acc)[2][2][4][2], const Unit& u, int wr, int wc, int fr, int fq) const {
        const int row0 = u.pm * BM + wr * 64 + fr, col0 = u.pn * BM + wc * 32 + 8 * fq;
#pragma unroll
        for (int ai = 0; ai < 2; ++ai)
#pragma unroll
            for (int m = 0; m < 4; ++m) { const int r = row0 + ai * HALF + m * 16; const float rs = (ssq16 ? rstd16(ssq16 + (size_t)r * 16) : 1.f) * scale; bf16_t* rowp = O + (size_t)r * ldo + col0;
#pragma unroll
                for (int bj = 0; bj < 2; ++bj) *(u32x4*)(rowp + bj * HALF) = pack8(acc[ai][bj][m][0] * rs, acc[ai][bj][m][1] * rs); }
    }
};
struct EpiX1F {
    static constexpr bool PERM = true, HAS_MID = true; int mid_t;
    const float* x; const float* fmid; const float* fend; bf16_t* X1b; float* ssq1;
    __device__ __forceinline__ void mid(f32x4 (&acc)[2][2][4][2], const Unit& u, int wr, int wc, int fr, int fq) const {
        const int row0 = u.pm * BM + wr * 64 + fr;
#pragma unroll
        for (int ai = 0; ai < 2; ++ai)
#pragma unroll
            for (int m = 0; m < 4; ++m) { const float f = fmid[row0 + ai * HALF + m * 16];
#pragma unroll
                for (int bj = 0; bj < 2; ++bj) { acc[ai][bj][m][0] = acc[ai][bj][m][0] * f; acc[ai][bj][m][1] = acc[ai][bj][m][1] * f; } }
    }
    __device__ __forceinline__ void operator()(const f32x4 (&acc)[2][2][4][2], const Unit& u, int wr, int wc, int fr, int fq) const {
        const int row0 = u.pm * BM + wr * 64 + fr, col0 = u.pn * BM + wc * 32 + 8 * fq;
#pragma unroll
        for (int ai = 0; ai < 2; ++ai)
#pragma unroll
            for (int m = 0; m < 4; ++m) { const int r = row0 + ai * HALF + m * 16; const float fe = fend[r]; const float* xr = x + (size_t)r * D + col0; float ss = 0.f;
#pragma unroll
                for (int bj = 0; bj < 2; ++bj) { const f32x4 v0 = *(const f32x4*)(xr + bj * HALF) + acc[ai][bj][m][0] * fe, v1 = *(const f32x4*)(xr + bj * HALF + 4) + acc[ai][bj][m][1] * fe;
                    ss += sq8(v0, v1); *(u32x4*)(X1b + (size_t)r * D + col0 + bj * HALF) = pack8(v0, v1); }
                ss += __shfl_xor(ss, 16); ss += __shfl_xor(ss, 32);
                if (fq == 0) ssq1[(size_t)r * 16 + u.pn * 4 + wc] = ss;
                asm volatile("" ::: "memory"); }
    }
};
struct EpiResF {
    static constexpr bool PERM = true, HAS_MID = false; int mid_t;
    const bf16_t* Xi; bf16_t* Xo; float* ssq;
    __device__ __forceinline__ void mid(f32x4 (&)[2][2][4][2], const Unit&, int, int, int, int) const {}
    __device__ __forceinline__ void operator()(const f32x4 (&acc)[2][2][4][2], const Unit& u, int wr, int wc, int fr, int fq) const {
        const int row0 = u.pm * BM + wr * 64 + fr, col0 = u.pn * BM + wc * 32 + 8 * fq;
#pragma unroll
        for (int ai = 0; ai < 2; ++ai)
#pragma unroll
            for (int m = 0; m < 4; ++m) { const int r = row0 + ai * HALF + m * 16; float ss = 0.f;
#pragma unroll
                for (int bj = 0; bj < 2; ++bj) { const u32x4 xi = *(const u32x4*)(Xi + (size_t)r * D + col0 + bj * HALF);
                    f32x4 v0, v1; v0[0] = __uint_as_float(xi.x << 16); v0[1] = __uint_as_float(xi.x & 0xffff0000u); v0[2] = __uint_as_float(xi.y << 16); v0[3] = __uint_as_float(xi.y & 0xffff0000u);
                    v1[0] = __uint_as_float(xi.z << 16); v1[1] = __uint_as_float(xi.z & 0xffff0000u); v1[2] = __uint_as_float(xi.w << 16); v1[3] = __uint_as_float(xi.w & 0xffff0000u);
                    v0 = v0 + acc[ai][bj][m][0]; v1 = v1 + acc[ai][bj][m][1];
                    ss += sq8(v0, v1); *(u32x4*)(Xo + (size_t)r * D + col0 + bj * HALF) = pack8(v0, v1); }
                ss += __shfl_xor(ss, 16); ss += __shfl_xor(ss, 32);
                if (fq == 0) ssq[(size_t)r * 16 + u.pn * 4 + wc] = ss; }
    }
};

__device__ __forceinline__ void pair_ab(int p, int& a, int& b) { a = (p < 3) ? 0 : (p < 5) ? 1 : 2; b = (p < 3) ? p + 1 : (p < 5) ? p - 1 : 3; }
__device__ __forceinline__ int moe_class_of_tile(const PG8_LAS int* meta, int T) { int c = 0;
#pragma unroll
    for (int k = 1; k < 24; ++k) c += (T >= __builtin_amdgcn_readfirstlane(meta[64 + k])) ? 1 : 0;
    return c; }
struct MoeOrder1 {
    const bf16_t* XG; const bf16_t* Wg; const bf16_t* Wu; const PG8_LAS int* meta; int G, c;
    __device__ bool next(int i, Unit& u) const { const int L = i * G + c, nt = __builtin_amdgcn_readfirstlane(meta[64 + 24]); if (L >= nt * 4) return false;
        u.pm = L >> 2; u.pn = moe_class_of_tile(meta, L >> 2) * 4 + (L & 3); return true; }
    __device__ __forceinline__ void ptrs(const Unit& u, const char*& a, const char*& b0, const char*& b1) const {
        const int cls = u.pn >> 2, j = (u.pn >> 1) & 1, half = u.pn & 1; int ea, eb; pair_ab(cls % 6, ea, eb); const int e = (cls / 6) * 4 + (j ? eb : ea);
        a = (const char*)XG + (size_t)u.pm * BM * D * 2; const size_t bo = ((size_t)e * DE + half * HALF) * D * 2; b0 = (const char*)Wg + bo; b1 = (const char*)Wu + bo; }
};
struct MoeOrder2 {
    const bf16_t* HID; const bf16_t* Wd2; const PG8_LAS int* meta; int G, c;
    __device__ bool next(int i, Unit& u) const { const int L = i * G + c, nt = __builtin_amdgcn_readfirstlane(meta[64 + 24]); if (L >= nt * 4) return false;
        u.pm = L >> 2; u.pn = moe_class_of_tile(meta, L >> 2) * 4 + (L & 3); return true; }
    __device__ __forceinline__ void ptrs(const Unit& u, const char*& a, const char*& b0, const char*& b1) const {
        a = (const char*)HID + (size_t)u.pm * BM * 512 * 2; b0 = (const char*)Wd2 + ((size_t)(u.pn >> 2) * D + (u.pn & 3) * BM) * 512 * 2; b1 = b0 + (size_t)HALF * 512 * 2; }
};
struct EpiMoeUp {
    static constexpr bool PERM = true, HAS_MID = false; int mid_t;
    const float* rsg; const float* wAg; const float* wBg; bf16_t* HID;
    __device__ __forceinline__ void mid(f32x4 (&)[2][2][4][2], const Unit&, int, int, int, int) const {}
    __device__ __forceinline__ void operator()(const f32x4 (&acc)[2][2][4][2], const Unit& u, int wr, int wc, int fr, int fq) const {
        const int row0 = u.pm * BM + wr * 64 + fr, j = (u.pn >> 1) & 1, col0 = j * 256 + (u.pn & 1) * HALF + wc * 32 + 8 * fq; const float* wg = j ? wBg : wAg;
#pragma unroll
        for (int ai = 0; ai < 2; ++ai)
#pragma unroll
            for (int m = 0; m < 4; ++m) { const int r = row0 + ai * HALF + m * 16; const float rs = rsg[r], w = wg[r]; f32x4 h0, h1;
#pragma unroll
                for (int e = 0; e < 4; ++e) { const float g0 = acc[ai][0][m][0][e] * rs, g1 = acc[ai][0][m][1][e] * rs;
                    h0[e] = g0 / (1.f + __expf(-g0)) * (acc[ai][1][m][0][e] * rs) * w; h1[e] = g1 / (1.f + __expf(-g1)) * (acc[ai][1][m][1][e] * rs) * w; }
                *(u32x4*)(HID + (size_t)r * 512 + col0) = pack8(h0, h1); }
    }
};
struct EpiMoeDown {
    static constexpr bool PERM = true, HAS_MID = false; int mid_t;
    const int* tokg; const bf16_t* Xi; bf16_t* Xo; float* ssq;
    __device__ __forceinline__ void mid(f32x4 (&)[2][2][4][2], const Unit&, int, int, int, int) const {}
    __device__ __forceinline__ void operator()(const f32x4 (&acc)[2][2][4][2], const Unit& u, int wr, int wc, int fr, int fq) const {
        const int row0 = u.pm * BM + wr * 64 + fr, ct = u.pn & 3, col0 = ct * BM + wc * 32 + 8 * fq;
#pragma unroll
        for (int ai = 0; ai < 2; ++ai)
#pragma unroll
            for (int m = 0; m < 4; ++m) { const int tok = tokg[row0 + ai * HALF + m * 16];
                if (tok >= 0) { float ss = 0.f;
#pragma unroll
                    for (int bj = 0; bj < 2; ++bj) { const u32x4 xi = *(const u32x4*)(Xi + (size_t)tok * D + col0 + bj * HALF);
                        f32x4 v0, v1; v0[0] = __uint_as_float(xi.x << 16); v0[1] = __uint_as_float(xi.x & 0xffff0000u); v0[2] = __uint_as_float(xi.y << 16); v0[3] = __uint_as_float(xi.y & 0xffff0000u);
                        v1[0] = __uint_as_float(xi.z << 16); v1[1] = __uint_as_float(xi.z & 0xffff0000u); v1[2] = __uint_as_float(xi.w << 16); v1[3] = __uint_as_float(xi.w & 0xffff0000u);
                        v0 = v0 + acc[ai][bj][m][0]; v1 = v1 + acc[ai][bj][m][1];
                        ss += sq8(v0, v1); *(u32x4*)(Xo + (size_t)tok * D + col0 + bj * HALF) = pack8(v0, v1); }
                    ss += __shfl_xor(ss, 16); ss += __shfl_xor(ss, 32);
                    if (fq == 0) ssq[(size_t)tok * 16 + ct * 4 + wc] = ss; } }
    }
};
}
namespace sba {
typedef float f32x16 __attribute__((ext_vector_type(16)));
typedef short s16x4 __attribute__((ext_vector_type(4)));
typedef short v4i16_t __attribute__((ext_vector_type(4)));
typedef __attribute__((address_space(3))) const char* lds_cptr;
constexpr int SLOTB = 8192, L_K = 0, L_V = 2 * SLOTB, L_FLAG = 4 * SLOTB, L_OST = L_FLAG + 256, L_BYTES = L_OST + 8 * 4096;
__device__ __forceinline__ int crow(int r, int hi) { return (r & 3) + 8 * (r >> 2) + 4 * hi; }
__device__ __forceinline__ void glds16(const void* gsrc, unsigned lds_dst) { unsigned keep;
    asm volatile("s_mov_b32 %0, m0\n\ts_mov_b32 m0, %2\n\ts_nop 0\n\tglobal_load_lds_dwordx4 %1, off\n\ts_mov_b32 m0, %0" : "=&s"(keep) : "v"(gsrc), "s"(lds_dst) : "memory"); }
typedef float f32x2_t __attribute__((ext_vector_type(2))); typedef __bf16 bf16x2_t __attribute__((ext_vector_type(2)));
__device__ __forceinline__ unsigned cvtpk(float lo, float hi) { f32x2_t v = {lo, hi}; bf16x2_t b = __builtin_convertvector(v, bf16x2_t); return __builtin_bit_cast(unsigned, b); }
__device__ __forceinline__ s16x4 vtr(lds_cptr p) { return __builtin_bit_cast(s16x4, __builtin_amdgcn_ds_read_tr16_b64_v4i16((__attribute__((address_space(3))) v4i16_t*)p)); }

#define SBA_GROUP(Z, SP, g) do { \
        const float off_ = acc_ + (hi ? 0.f : gp_##SP[g]); acc_ += gs_##SP[g] + gp_##SP[g]; \
        const float c3_ = off_ + SP[4 * (g) + 3], c2_ = c3_ + SP[4 * (g) + 2], c1_ = c2_ + SP[4 * (g) + 1], c0_ = c1_ + SP[4 * (g)]; \
        Z[4 * (g) + 3] = __builtin_amdgcn_exp2f(Z[4 * (g) + 3] - c3_); Z[4 * (g) + 2] = __builtin_amdgcn_exp2f(Z[4 * (g) + 2] - c2_); \
        Z[4 * (g) + 1] = __builtin_amdgcn_exp2f(Z[4 * (g) + 1] - c1_); Z[4 * (g)] = __builtin_amdgcn_exp2f(Z[4 * (g)] - c0_); } while (0)

__device__ __forceinline__ void sb_unit(int b, int h, int qb, const bf16_t* Qs, const bf16_t* Ks, const bf16_t* Vs, bf16_t* YY, float* ssq_s8, const unsigned* kmax, char* shm) {
    int tid_ = threadIdx.x; asm volatile("" : "+v"(tid_));
    const int tid = tid_, lane = tid & 63, r32 = lane & 31, hi = lane >> 5; const int wid = __builtin_amdgcn_readfirstlane(tid >> 6);
    const size_t rowbase = (size_t)b * SEQ; const int q0 = qb * 256;
    const bf16_t* Kh = Ks + rowbase * SBW + h * HD; const bf16_t* Vh = Vs + rowbase * SBW + h * HD;
    const unsigned lds0 = (unsigned)(uintptr_t)shm;
    const lds_cptr shm3 = (lds_cptr)shm;
    const bf16_t* ksrc = Kh + (size_t)lane * SBW + wid * 8;
    const bf16_t* vsrc = Vh + (size_t)(16 * (wid & 3) + (lane >> 2)) * SBW + (wid >> 2) * 32 + (lane & 3) * 8;
    const unsigned kdst = lds0 + L_K + wid * 1024, vdst = lds0 + L_V + wid * 1024;
#define DMA_KV(t, slot) do { glds16(ksrc + (size_t)(t) * 64 * SBW, (unsigned)__builtin_amdgcn_readfirstlane(kdst + (slot))); glds16(vsrc + (size_t)(t) * 64 * SBW, (unsigned)__builtin_amdgcn_readfirstlane(vdst + (slot))); } while (0)
    const lds_cptr kp0 = shm3 + L_K + hi * 1024 + r32 * 16;
    const lds_cptr vp0 = shm3 + L_V + ((lane >> 4) & 1) * 32 + (lane & 3) * 8 + (4 * hi + ((lane & 15) >> 2)) * 64;
    volatile __attribute__((address_space(3))) unsigned* flags = (volatile __attribute__((address_space(3))) unsigned*)(shm3 + L_FLAG);
    int tile = 4 * qb + 3, slot = 0, it = 0;
    DMA_KV(tile, 0);
    const bf16_t* Qw = Qs + (rowbase + q0 + wid * 32 + r32) * SBW + h * HD;
    bf16x8 qr[4];
#pragma unroll
    for (int d0 = 0; d0 < 4; ++d0) qr[d0] = *(const bf16x8*)(Qw + d0 * 16 + hi * 8);
    float qn = 0.f;
#pragma unroll
    for (int d0 = 0; d0 < 4; ++d0)
#pragma unroll
        for (int e = 0; e < 8; ++e) qn += fabsf(bf2f((unsigned short)qr[d0][e]));
    qn += __shfl_xor(qn, 32);
    const float zmax = qn * __uint_as_float(kmax[b * 8 + h]) * 1.01f;
    const int tq = q0 + wid * 32 + r32;
    const int tq_min = q0 + wid * 32, tq_max = tq_min + 31;
    float R = 0.f;
    f32x16 o0 = {}, o1 = {};
    for (;;) {
        const bool has_next = tile > 0;
        if (has_next) { DMA_KV(tile - 1, slot ^ SLOTB); asm volatile("s_waitcnt vmcnt(2)" ::: "memory"); }
        else asm volatile("s_waitcnt vmcnt(0)" ::: "memory");
        __builtin_amdgcn_s_barrier(); asm volatile("" ::: "memory");
        const int kmin = tile * 64;
        if (kmin < tq_max) {
            f32x16 z0, z1;
            {
                const lds_cptr kb = kp0 + slot;
#pragma unroll
                for (int d0 = 0; d0 < 4; ++d0) {
                    const bf16x8 b0 = *(const __attribute__((address_space(3))) bf16x8*)(kb + d0 * 2048);
                    const bf16x8 b1 = *(const __attribute__((address_space(3))) bf16x8*)(kb + d0 * 2048 + 512);
                    if (d0 == 0) { z0 = __builtin_amdgcn_mfma_f32_32x32x16_bf16(b0, qr[0], (f32x16){}, 0, 0, 0); z1 = __builtin_amdgcn_mfma_f32_32x32x16_bf16(b1, qr[0], (f32x16){}, 0, 0, 0); }
                    else { z0 = __builtin_amdgcn_mfma_f32_32x32x16_bf16(b0, qr[d0], z0, 0, 0, 0); z1 = __builtin_amdgcn_mfma_f32_32x32x16_bf16(b1, qr[d0], z1, 0, 0, 0); }
                }
            }
            if (kmin + 63 >= tq_min) {
#pragma unroll
                for (int r = 0; r < 16; ++r) { const int kv = kmin + crow(r, hi); if (kv >= tq) z0[r] = -INFINITY; if (kv + 32 >= tq) z1[r] = -INFINITY; }
            }
            f32x16 s0, s1;
#pragma unroll
            for (int r = 0; r < 16; ++r) { z0[r] = fminf(z0[r], 120.f); z1[r] = fminf(z1[r], 120.f);
                s0[r] = __builtin_amdgcn_logf(1.f + __builtin_amdgcn_exp2f(z0[r])); s1[r] = __builtin_amdgcn_logf(1.f + __builtin_amdgcn_exp2f(z1[r])); }
            float gs_s0[4], gs_s1[4], gp_s0[4], gp_s1[4];
#pragma unroll
            for (int g = 0; g < 4; ++g) { gs_s0[g] = (s0[4 * g] + s0[4 * g + 1]) + (s0[4 * g + 2] + s0[4 * g + 3]); gs_s1[g] = (s1[4 * g] + s1[4 * g + 1]) + (s1[4 * g + 2] + s1[4 * g + 3]); }
#pragma unroll
            for (int g = 0; g < 4; ++g) { gp_s0[g] = __shfl_xor(gs_s0[g], 32); gp_s1[g] = __shfl_xor(gs_s1[g], 32); }
            float acc_ = R;
            SBA_GROUP(z1, s1, 3); SBA_GROUP(z1, s1, 2); SBA_GROUP(z1, s1, 1); SBA_GROUP(z1, s1, 0);
            SBA_GROUP(z0, s0, 3); SBA_GROUP(z0, s0, 2); SBA_GROUP(z0, s0, 1); SBA_GROUP(z0, s0, 0);
            R = acc_;
            u32x4 pw0, pw1, pw2, pw3;
            pw0 = (u32x4){cvtpk(z0[0], z0[1]), cvtpk(z0[2], z0[3]), cvtpk(z0[4], z0[5]), cvtpk(z0[6], z0[7])};
            pw1 = (u32x4){cvtpk(z0[8], z0[9]), cvtpk(z0[10], z0[11]), cvtpk(z0[12], z0[13]), cvtpk(z0[14], z0[15])};
            pw2 = (u32x4){cvtpk(z1[0], z1[1]), cvtpk(z1[2], z1[3]), cvtpk(z1[4], z1[5]), cvtpk(z1[6], z1[7])};
            pw3 = (u32x4){cvtpk(z1[8], z1[9]), cvtpk(z1[10], z1[11]), cvtpk(z1[12], z1[13]), cvtpk(z1[14], z1[15])};
            const lds_cptr vp = vp0 + slot;
#define SBA_PV(O, d0, ks, PW) do { const s16x4 lo_ = vtr(vp + (d0) * 4096 + (ks) * 1024), hi_ = vtr(vp + (d0) * 4096 + (ks) * 1024 + 512); \
                const bf16x8 vf_ = (bf16x8){lo_[0], lo_[1], lo_[2], lo_[3], hi_[0], hi_[1], hi_[2], hi_[3]}; \
                O = __builtin_amdgcn_mfma_f32_32x32x16_bf16(__builtin_bit_cast(bf16x8, PW), vf_, O, 0, 0, 0); } while (0)
            SBA_PV(o0, 0, 0, pw0); SBA_PV(o1, 1, 0, pw0); SBA_PV(o0, 0, 1, pw1); SBA_PV(o1, 1, 1, pw1);
            SBA_PV(o0, 0, 2, pw2); SBA_PV(o1, 1, 2, pw2); SBA_PV(o0, 0, 3, pw3); SBA_PV(o1, 1, 3, pw3);
#undef SBA_PV
        }
        const bool done = __all((zmax - R) < -150.f);
        if (lane == 0) flags[(it & 1) * 8 + wid] = done ? 1u : 0u;
        asm volatile("s_waitcnt lgkmcnt(0)" ::: "memory"); __builtin_amdgcn_s_barrier(); asm volatile("" ::: "memory");
        unsigned alld = 1u;
#pragma unroll
        for (int w = 0; w < 8; ++w) alld &= flags[(it & 1) * 8 + w];
        alld = __builtin_amdgcn_readfirstlane(alld);
        if (!has_next || alld) break;
        --tile; slot ^= SLOTB; ++it;
    }
    asm volatile("s_waitcnt vmcnt(0)" ::: "memory");
    {
        bf16_t* Ow = YY + (rowbase + q0 + wid * 32) * D + RW + h * HD;
        bf16_t* stg = (bf16_t*)(shm + L_OST) + wid * 2048;
#pragma unroll
        for (int r = 0; r < 16; ++r) { const int orow = crow(r, hi); stg[orow * 64 + r32] = (bf16_t)f2bf(o0[r]); stg[orow * 64 + 32 + r32] = (bf16_t)f2bf(o1[r]); }
        asm volatile("s_waitcnt lgkmcnt(0)" ::: "memory");
#pragma unroll
        for (int i = 0; i < 4; ++i) { const int row = i * 8 + (lane >> 3), ch = lane & 7; const u32x4 v = *(const u32x4*)(stg + row * 64 + ch * 8);
            *(u32x4*)(Ow + (size_t)row * D + ch * 8) = v;
            float ss = 0.f;
#pragma unroll
            for (int e = 0; e < 4; ++e) { const float lo = __uint_as_float(v[e] << 16), hh = __uint_as_float(v[e] & 0xffff0000u); ss += lo * lo + hh * hh; }
            ss += __shfl_xor(ss, 1); ss += __shfl_xor(ss, 2); ss += __shfl_xor(ss, 4);
            if (ch == 0) ssq_s8[(rowbase + q0 + wid * 32 + row) * 8 + h] = ss; }
    }
    asm volatile("s_waitcnt lgkmcnt(0)" ::: "memory"); __builtin_amdgcn_s_barrier(); asm volatile("" ::: "memory");
#undef DMA_KV
}
#undef SBA_GROUP
}
namespace lru {
typedef float f32x16 __attribute__((ext_vector_type(16)));
constexpr int XS_ROWS = 67, XS_BYTES = XS_ROWS * 1024  , XC_PITCH = 1040  , XC_OFF = 68608, L_BYTES = XC_OFF + 64 * XC_PITCH;
__device__ __forceinline__ int crow(int r, int hi) { return (r & 3) + 8 * (r >> 2) + 4 * hi; }

struct Weights { bf16x8 wa[2][4], wx[2][4]; float ba[2], bx[2], spl[2]; };
__device__ __forceinline__ void load_weights(Weights& W, int h, int r32, int hi, const float* w_a, const float* b_a, const float* w_x, const float* b_x, const float* lam) {
#pragma unroll
    for (int nt = 0; nt < 2; ++nt) {
#pragma unroll
        for (int s = 0; s < 4; ++s) {
#pragma unroll
            for (int e = 0; e < 8; ++e) { const size_t idx = ((size_t)(h * 64 + 16 * s + 8 * hi + e)) * 64 + 32 * nt + r32;
                W.wa[nt][s][e] = (short)f2bf(w_a[idx]); W.wx[nt][s][e] = (short)f2bf(w_x[idx]); }
        }
        const int c = h * 64 + 32 * nt + r32; W.ba[nt] = b_a[c]; W.bx[nt] = b_x[c];
        const float l = lam[c]; W.spl[nt] = (l > 15.f) ? __expf(-l) : log1pf(__expf(-l));
    }
}

template <bool PASSB>
__device__ __forceinline__ void unit(int b, int chunk, const Weights& W, const bf16_t* XR, const bf16_t* GG, const float* conv_w, const float* conv_b,
                                     float* aggP, float* aggH, const float* ssq_s8, bf16_t* YY, float* fmid, float* fend, unsigned char* shm) {
    int tid_ = threadIdx.x; asm volatile("" : "+v"(tid_));
    const int tid = tid_, lane = tid & 63, r32 = lane & 31, hi = lane >> 5, wid = __builtin_amdgcn_readfirstlane(tid >> 6);
    LAS unsigned char* L = (LAS unsigned char*)shm;
    const int t0 = chunk * 64; const size_t rowbase = (size_t)b * SEQ;
    for (int p = tid; p < XS_ROWS * 64; p += NTHREADS) { const int rr = p >> 6, pc = p & 63, t = t0 - 3 + rr;
        u32x4 v = (u32x4){0u, 0u, 0u, 0u}; if (t >= 0) v = *(const u32x4*)(XR + (rowbase + t) * RW + pc * 8);
        *(LAS u32x4*)(L + rr * 1024 + pc * 16) = v; }
    __syncthreads();
    {
        const int cp = tid & 255, th = tid >> 8, c0 = 2 * cp;
        const float w00 = conv_w[c0], w01 = conv_w[RW + c0], w02 = conv_w[2 * RW + c0], w03 = conv_w[3 * RW + c0], b0 = conv_b[c0];
        const float w10 = conv_w[c0 + 1], w11 = conv_w[RW + c0 + 1], w12 = conv_w[2 * RW + c0 + 1], w13 = conv_w[3 * RW + c0 + 1], b1 = conv_b[c0 + 1];
        const LAS unsigned* xs = (const LAS unsigned*)(L + (th * 32) * 1024 + cp * 4);
        unsigned u0 = xs[0], u1 = xs[256], u2 = xs[512];
        float a0 = __uint_as_float(u0 << 16), a1 = __uint_as_float(u1 << 16), a2 = __uint_as_float(u2 << 16);
        float c0_ = __uint_as_float(u0 & 0xffff0000u), c1_ = __uint_as_float(u1 & 0xffff0000u), c2_ = __uint_as_float(u2 & 0xffff0000u);
#pragma unroll 8
        for (int t = 0; t < 32; ++t) { const unsigned u3 = xs[(t + 3) * 256]; const float a3 = __uint_as_float(u3 << 16), c3_ = __uint_as_float(u3 & 0xffff0000u);
            const float y0 = w00 * a0 + w01 * a1 + w02 * a2 + w03 * a3 + b0, y1 = w10 * c0_ + w11 * c1_ + w12 * c2_ + w13 * c3_ + b1;
            *(LAS unsigned*)(L + XC_OFF + (th * 32 + t) * XC_PITCH + cp * 4) = f2bf(y0) | (f2bf(y1) << 16);
            a0 = a1; a1 = a2; a2 = a3; c0_ = c1_; c1_ = c2_; c2_ = c3_; }
    }
    __syncthreads();
    const int h = wid;
    float Hc[2] = {0.f, 0.f}, Pc[2] = {1.f, 1.f};
    if (PASSB) {
#pragma unroll
        for (int nt = 0; nt < 2; ++nt) { const int c = h * 64 + 32 * nt + r32; const float* pP = aggP + ((size_t)b * 64) * RW + c; const float* pH = aggH + ((size_t)b * 64) * RW + c; float hc = 0.f;
            int ch = 0;
            for (; ch + 8 <= chunk; ch += 8) { float p[8], q[8];
#pragma unroll
                for (int i = 0; i < 8; ++i) { p[i] = pP[(size_t)(ch + i) * RW]; q[i] = pH[(size_t)(ch + i) * RW]; }
#pragma unroll
                for (int i = 0; i < 8; ++i) hc = p[i] * hc + q[i]; }
            for (; ch < chunk; ++ch) hc = pP[(size_t)ch * RW] * hc + pH[(size_t)ch * RW];
            Hc[nt] = hc; }
    }
#pragma unroll
    for (int mt = 0; mt < 2; ++mt) {
        bf16x8 af[4];
#pragma unroll
        for (int s = 0; s < 4; ++s) af[s] = *(const LAS bf16x8*)(L + XC_OFF + (32 * mt + r32) * XC_PITCH + (h * 64 + 16 * s + 8 * hi) * 2);
#pragma unroll
        for (int nt = 0; nt < 2; ++nt) {
            f32x16 ra = {}, ri = {};
#pragma unroll
            for (int s = 0; s < 4; ++s) { ra = __builtin_amdgcn_mfma_f32_32x32x16_bf16(af[s], W.wa[nt][s], ra, 0, 0, 0); ri = __builtin_amdgcn_mfma_f32_32x32x16_bf16(af[s], W.wx[nt][s], ri, 0, 0, 0); }
            const int c = h * 64 + 32 * nt + r32;
#pragma unroll
            for (int r = 0; r < 16; ++r) { const int tok = 32 * mt + crow(r, hi);
                const float xc = bf2f(*(const LAS unsigned short*)(L + XC_OFF + tok * XC_PITCH + c * 2));
                const float rg = 1.f / (1.f + __expf(-(ra[r] + W.ba[nt]))), ig = 1.f / (1.f + __expf(-(ri[r] + W.bx[nt])));
                const float la = -8.0f * rg * W.spl[nt], a = __expf(la);
                ra[r] = a; ri[r] = sqrtf(fmaxf(0.f, 1.f - a * a)) * (ig * xc); }
            float P[4], H[4], Pp[4], Hp[4];
#pragma unroll
            for (int g = 0; g < 4; ++g) { P[g] = (ra[4 * g] * ra[4 * g + 1]) * (ra[4 * g + 2] * ra[4 * g + 3]);
                H[g] = ((ri[4 * g] * ra[4 * g + 1] + ri[4 * g + 1]) * ra[4 * g + 2] + ri[4 * g + 2]) * ra[4 * g + 3] + ri[4 * g + 3]; }
#pragma unroll
            for (int g = 0; g < 4; ++g) { Pp[g] = __shfl_xor(P[g], 32); Hp[g] = __shfl_xor(H[g], 32); }
            float hc = Hc[nt], pc = Pc[nt];
#pragma unroll
            for (int g = 0; g < 4; ++g) { const float P0 = hi ? Pp[g] : P[g], H0 = hi ? Hp[g] : H[g], P1 = hi ? P[g] : Pp[g], H1 = hi ? H[g] : Hp[g];
                const float mid = P0 * hc + H0;
                if (PASSB) { float hh = hi ? mid : hc;
#pragma unroll
                    for (int k = 0; k < 4; ++k) { hh = ra[4 * g + k] * hh + ri[4 * g + k]; const int tok = 32 * mt + 8 * g + 4 * hi + k;
                        *(LAS unsigned short*)(L + tok * 1024 + c * 2) = (unsigned short)f2bf(hh); } }
                hc = P1 * mid + H1; pc = pc * (P0 * P1); }
            Hc[nt] = hc; Pc[nt] = pc;
        }
    }
    if (!PASSB) {
        if (hi == 0) {
#pragma unroll
            for (int nt = 0; nt < 2; ++nt) { const int c = h * 64 + 32 * nt + r32; aggP[((size_t)b * 64 + chunk) * RW + c] = Pc[nt]; aggH[((size_t)b * 64 + chunk) * RW + c] = Hc[nt]; }
        }
        __syncthreads();
    } else {
        __syncthreads();
        for (int i = 0; i < 8; ++i) { const int rr = i * 8 + wid; const size_t row = rowbase + t0 + rr;
            const u32x4 hv = *(const LAS u32x4*)(L + rr * 1024 + lane * 16); const u32x4 gv = *(const u32x4*)(GG + row * RW + lane * 8);
            f32x4 y0, y1;
            y0[0] = __uint_as_float(hv.x << 16) * __uint_as_float(gv.x << 16); y0[1] = __uint_as_float(hv.x & 0xffff0000u) * __uint_as_float(gv.x & 0xffff0000u);
            y0[2] = __uint_as_float(hv.y << 16) * __uint_as_float(gv.y << 16); y0[3] = __uint_as_float(hv.y & 0xffff0000u) * __uint_as_float(gv.y & 0xffff0000u);
            y1[0] = __uint_as_float(hv.z << 16) * __uint_as_float(gv.z << 16); y1[1] = __uint_as_float(hv.z & 0xffff0000u) * __uint_as_float(gv.z & 0xffff0000u);
            y1[2] = __uint_as_float(hv.w << 16) * __uint_as_float(gv.w << 16); y1[3] = __uint_as_float(hv.w & 0xffff0000u) * __uint_as_float(gv.w & 0xffff0000u);
            const float ss = wave_sum(pg8::sq8(y0, y1));
            *(u32x4*)(YY + row * D + lane * 8) = pg8::pack8(y0, y1);
            if (lane == 0) { float s2 = 0.f;
#pragma unroll
                for (int k = 0; k < 8; ++k) s2 += ssq_s8[row * 8 + k];
                const float rrn = 1.0f / sqrtf(ss * (1.f / RW) + EPS), rs = 1.0f / sqrtf(s2 * (1.f / SBW) + EPS); fmid[row] = rrn / rs; fend[row] = rs; } }
        __syncthreads();
    }
}
}
__device__ __forceinline__ void row_prep_x(const float* x, bf16_t* xb, float* rstd0, int row, int lane) {
    const f32x4* xr = (const f32x4*)(x + (size_t)row * D) + lane;
    float s = 0.f; f32x4 v[4];
#pragma unroll
    for (int j = 0; j < 4; ++j) { v[j] = xr[64 * j]; s += v[j].x * v[j].x + v[j].y * v[j].y + v[j].z * v[j].z + v[j].w * v[j].w; }
    s = wave_sum(s);
    if (lane == 0) rstd0[row] = 1.0f / sqrtf(s * (1.f / D) + EPS);
    unsigned long long* o8 = (unsigned long long*)(xb + (size_t)row * D) + lane;
#pragma unroll
    for (int j = 0; j < 4; ++j) o8[64 * j] = (unsigned long long)(f2bf(v[j].x) | (f2bf(v[j].y) << 16)) | ((unsigned long long)(f2bf(v[j].z) | (f2bf(v[j].w) << 16)) << 32);
}
__device__ __forceinline__ void row_prep_mem(const float* m, const float* g, bf16_t* o, int row, int lane) {
    const f32x4* xr = (const f32x4*)(m + (size_t)row * D) + lane;
    float s = 0.f; f32x4 v[4];
#pragma unroll
    for (int j = 0; j < 4; ++j) { v[j] = xr[64 * j]; s += v[j].x * v[j].x + v[j].y * v[j].y + v[j].z * v[j].z + v[j].w * v[j].w; }
    s = wave_sum(s);
    const float r = 1.0f / sqrtf(s * (1.f / D) + EPS);
    unsigned long long* o8 = (unsigned long long*)(o + (size_t)row * D) + lane;
#pragma unroll
    for (int j = 0; j < 4; ++j) { const f32x4 gg = ((const f32x4*)g)[64 * j + lane];
        o8[64 * j] = (unsigned long long)(f2bf(v[j].x * r * gg.x) | (f2bf(v[j].y * r * gg.y) << 16)) | ((unsigned long long)(f2bf(v[j].z * r * gg.z) | (f2bf(v[j].w * r * gg.w) << 16)) << 32); }
}
__device__ __forceinline__ void transpose_item(const float* W, int K, int N, bf16_t* Wt, int ldt, const float* g0, const float* g1, int ksplit, LAS float* scr, int item, int lane) {
    const int nblk = N / 32, kb = item / nblk, nb = item % nblk, k0 = 64 * kb, n0 = 32 * nb;
#pragma unroll 8
    for (int i = 0; i < 32; ++i) { const int kk = 2 * i + (lane >> 5), k = k0 + kk; float gv = 1.f; if (g0) gv = (k < ksplit) ? g0[k] : g1[k - ksplit];
        scr[kk * 33 + (lane & 31)] = W[(size_t)k * N + n0 + (lane & 31)] * gv; }
    asm volatile("s_waitcnt lgkmcnt(0)" ::: "memory");
    const int c = lane & 7;
#pragma unroll
    for (int j = 0; j < 4; ++j) { const int n = (lane >> 3) + 8 * j; const LAS float* s = scr + (8 * c) * 33 + n;
        u32x4 o; o.x = f2bf(s[0 * 33]) | (f2bf(s[1 * 33]) << 16); o.y = f2bf(s[2 * 33]) | (f2bf(s[3 * 33]) << 16); o.z = f2bf(s[4 * 33]) | (f2bf(s[5 * 33]) << 16); o.w = f2bf(s[6 * 33]) | (f2bf(s[7 * 33]) << 16);
        *(u32x4*)(Wt + (size_t)(n0 + n) * ldt + k0 + 8 * c) = o; }
    asm volatile("s_waitcnt lgkmcnt(0)" ::: "memory");
}

struct MidScale { const float* f; int k; int pad; };
template <class Epi>
__device__ __forceinline__ void gemm_naive(const Ctx& C, const bf16_t* A, int lda, const bf16_t* Bt, int ldb, int M, int N, int K, MidScale ms, const Epi& E) {
    const int lane = C.lane, fr = lane & 15, fq = lane >> 4, ncol = N / 64, ntile = (M / 16) * ncol;
    for (int t = C.gw; t < ntile; t += C.NGW) {
        const int row0 = (t / ncol) * 16, col0 = (t % ncol) * 64;
        const bf16_t* ap = A + (size_t)(row0 + fr) * lda + fq * 8;
        const bf16_t* bp = Bt + (size_t)(col0 + fr) * ldb + fq * 8;
        f32x4 acc[4];
#pragma unroll
        for (int n = 0; n < 4; ++n) acc[n] = (f32x4){0.f, 0.f, 0.f, 0.f};
        for (int k0 = 0; k0 < K; k0 += 32) {
            if (ms.f && k0 == ms.k) {
#pragma unroll
                for (int j = 0; j < 4; ++j) { const float f = ms.f[row0 + fq * 4 + j];
#pragma unroll
                    for (int n = 0; n < 4; ++n) acc[n][j] *= f; }
            }
            const bf16x8 a = *(const bf16x8*)(ap + k0);
#pragma unroll
            for (int n = 0; n < 4; ++n) { const bf16x8 b = *(const bf16x8*)(bp + (size_t)n * 16 * ldb + k0); acc[n] = __builtin_amdgcn_mfma_f32_16x16x32_bf16(a, b, acc[n], 0, 0, 0); }
        }
#pragma unroll
        for (int n = 0; n < 4; ++n)
#pragma unroll
            for (int j = 0; j < 4; ++j) E(row0 + fq * 4 + j, col0 + n * 16 + fr, acc[n][j]);
    }
}
struct EpiInProj { const float* rstd0; bf16_t *XR, *GG, *Qs, *Ks, *Vs;
    __device__ void operator()(int r, int c, float v) const { v *= rstd0[r]; const int t = c >> 9, cc = c & 511;
        if (t == 0) XR[(size_t)r * RW + cc] = (bf16_t)f2bf(v);
        else if (t == 1) GG[(size_t)r * RW + cc] = (bf16_t)f2bf(gelu_tanh(v));
        else if (t == 2) Qs[(size_t)r * SBW + cc] = (bf16_t)f2bf(v * (0.125f * LOG2E));
        else if (t == 3) Ks[(size_t)r * SBW + cc] = (bf16_t)f2bf(v);
        else Vs[(size_t)r * SBW + cc] = (bf16_t)f2bf(v); } };
struct EpiStoreBf16 { bf16_t* O; const float* rowscale; int ldo; float scale;
    __device__ void operator()(int r, int c, float v) const { O[(size_t)r * ldo + c] = (bf16_t)f2bf(v * (rowscale ? rowscale[r] : 1.f) * scale); } };
struct EpiResF32 { const float* base; const float* rowscale; bf16_t* O;
    __device__ void operator()(int r, int c, float v) const { O[(size_t)r * D + c] = (bf16_t)f2bf(base[(size_t)r * D + c] + v * rowscale[r]); } };
struct EpiResBf16 { const bf16_t* base; bf16_t* O;
    __device__ void operator()(int r, int c, float v) const { O[(size_t)r * D + c] = (bf16_t)f2bf(bf2f(base[(size_t)r * D + c]) + v); } };

__device__ __forceinline__ void lru_naive_unit(int unit, int j, LAS float* xs, const bf16_t* XR, const bf16_t* GG, const float* conv_w, const float* conv_b,
                                               const float* w_a, const float* b_a, const float* w_x, const float* b_x, const float* lam, bf16_t* YY) {
    const int b = unit >> 3, h = unit & 7, c = h * 64 + j;
    float wa[64], wx[64];
#pragma unroll
    for (int i = 0; i < 64; ++i) { wa[i] = w_a[(size_t)(h * 64 + i) * 64 + j]; wx[i] = w_x[(size_t)(h * 64 + i) * 64 + j]; }
    const float ba = b_a[c], bx = b_x[c], cw0 = conv_w[c], cw1 = conv_w[RW + c], cw2 = conv_w[2 * RW + c], cw3 = conv_w[3 * RW + c], cb = conv_b[c];
    const float l = lam[c], spl = (l > 15.f) ? __expf(-l) : log1pf(__expf(-l));
    float x0 = 0.f, x1 = 0.f, x2 = 0.f, hst = 0.f;
    for (int t = 0; t < SEQ; ++t) {
        const size_t row = (size_t)b * SEQ + t;
        const float x3 = bf2f(XR[row * RW + c]);
        const float xc = cw0 * x0 + cw1 * x1 + cw2 * x2 + cw3 * x3 + cb;
        x0 = x1; x1 = x2; x2 = x3;
        asm volatile("s_waitcnt lgkmcnt(0)" ::: "memory"); xs[j] = xc; asm volatile("s_waitcnt lgkmcnt(0)" ::: "memory");
        float ra = ba, ri = bx;
#pragma unroll
        for (int i = 0; i < 64; ++i) { const float xv = xs[i]; ra += xv * wa[i]; ri += xv * wx[i]; }
        const float r = sigmoidf_(ra), ig = sigmoidf_(ri);
        const float log_a = -8.0f * r * spl, a = __expf(log_a), bb = sqrtf(fmaxf(0.f, -expm1f(2.f * log_a))) * (ig * xc);
        hst = a * hst + bb;
        YY[row * D + c] = (bf16_t)f2bf(hst * bf2f(GG[row * RW + c]));
    }
}
__device__ __forceinline__ void sb_naive_unit(int unit, int lane, const bf16_t* Qs, const bf16_t* Ks, const bf16_t* Vs, bf16_t* YY, float* ssq_s8) {
    const int qb = unit & 63, h = (unit >> 6) & 7, b = unit >> 9;
    const int t = qb * 64 + lane; const size_t row = (size_t)b * SEQ + t;
    float q[64], o[64];
#pragma unroll
    for (int d = 0; d < 64; ++d) { q[d] = bf2f(Qs[row * SBW + h * 64 + d]); o[d] = 0.f; }
    float R = 0.f;
    for (int s = qb * 64 + 62; s >= 0; --s) {
        const bf16_t* kr = Ks + ((size_t)b * SEQ + s) * SBW + h * 64; const bf16_t* vr = Vs + ((size_t)b * SEQ + s) * SBW + h * 64;
        float z = 0.f;
#pragma unroll
        for (int d = 0; d < 64; ++d) z += q[d] * bf2f(kr[d]);
        const bool valid = s < t;
        const float sp = valid ? (fmaxf(z, 0.f) + __log2f(1.f + exp2f(-fabsf(z)))) : 0.f;
        const float w = valid ? exp2f(z - (R + sp)) : 0.f;
        R += sp;
        const float wb = bf2f((bf16_t)f2bf(w));
#pragma unroll
        for (int d = 0; d < 64; ++d) o[d] += wb * bf2f(vr[d]);
    }
    float ss = 0.f;
#pragma unroll
    for (int d = 0; d < 64; ++d) { ss += o[d] * o[d]; YY[row * D + RW + h * 64 + d] = (bf16_t)f2bf(o[d]); }
    ssq_s8[row * 8 + h] = ss;
}
__device__ __forceinline__ void xattn_naive_unit(int unit, int j, LAS float* qs, LAS float* ps, const bf16_t* QX, const bf16_t* KVM, bf16_t* OX) {
    const int tg = unit & 511, h = (unit >> 9) & 3, b = unit >> 11, lane = j & 63, wid = j >> 6;
    const size_t row0 = (size_t)b * SEQ + tg * 8;
    for (int i = 0; i < 8; ++i) qs[i * 256 + j] = bf2f(QX[(row0 + i) * D + h * XD + j]);
    __syncthreads();
    const bf16_t* kr = KVM + ((size_t)b * MEM + j) * 2048 + h * XD;
    float sc[8];
#pragma unroll
    for (int i = 0; i < 8; ++i) sc[i] = 0.f;
    for (int d = 0; d < XD; ++d) { const float kv = bf2f(kr[d]);
#pragma unroll
        for (int i = 0; i < 8; ++i) sc[i] += qs[i * 256 + d] * kv; }
#pragma unroll
    for (int i = 0; i < 8; ++i) ps[i * 256 + j] = sc[i];
    __syncthreads();
    for (int i = wid * 2; i < wid * 2 + 2; ++i) {
        float v0 = ps[i * 256 + lane], v1 = ps[i * 256 + lane + 64], v2 = ps[i * 256 + lane + 128], v3 = ps[i * 256 + lane + 192];
        float m = fmaxf(fmaxf(v0, v1), fmaxf(v2, v3));
#pragma unroll
        for (int o = 1; o < 64; o <<= 1) m = fmaxf(m, __shfl_xor(m, o));
        v0 = exp2f(v0 - m); v1 = exp2f(v1 - m); v2 = exp2f(v2 - m); v3 = exp2f(v3 - m);
        const float s = wave_sum(v0 + v1 + v2 + v3), inv = 1.f / s;
        ps[i * 256 + lane] = v0 * inv; ps[i * 256 + lane + 64] = v1 * inv; ps[i * 256 + lane + 128] = v2 * inv; ps[i * 256 + lane + 192] = v3 * inv;
    }
    __syncthreads();
    float o[8];
#pragma unroll
    for (int i = 0; i < 8; ++i) o[i] = 0.f;
    for (int m = 0; m < MEM; ++m) { const float vv = bf2f(KVM[((size_t)b * MEM + m) * 2048 + 1024 + h * XD + j]);
#pragma unroll
        for (int i = 0; i < 8; ++i) o[i] += ps[i * 256 + m] * vv; }
#pragma unroll
    for (int i = 0; i < 8; ++i) OX[(row0 + i) * D + h * XD + j] = (bf16_t)f2bf(o[i]);
    __syncthreads();
}
__device__ __forceinline__ int router_row(int row, int lane, const bf16_t* X2b, const float* ssq2p, const float* g, const float* wgr, const float* bgr, const float* wer, const float* ber, float* selw) {
    int cls = 0;
    float acc[20];
#pragma unroll
    for (int i = 0; i < 20; ++i) acc[i] = 0.f;
    const float rs = pg8::rstd16(ssq2p + (size_t)row * 16);
    for (int kk = 0; kk < 16; ++kk) { const int k = kk * 64 + lane; const float t = bf2f(X2b[(size_t)row * D + k]) * rs * g[k];
#pragma unroll
        for (int i = 0; i < 4; ++i) acc[i] += t * wgr[k * 4 + i];
#pragma unroll
        for (int gi = 0; gi < 4; ++gi)
#pragma unroll
            for (int e = 0; e < 4; ++e) acc[4 + gi * 4 + e] += t * wer[((size_t)gi * D + k) * 4 + e]; }
#pragma unroll
    for (int i = 0; i < 20; ++i) acc[i] = wave_sum(acc[i]);
    if (lane == 0) {
        float gl[4]; float gm = -INFINITY; int gi = 0;
#pragma unroll
        for (int i = 0; i < 4; ++i) { gl[i] = acc[i] + bgr[i]; if (gl[i] > gm) { gm = gl[i]; gi = i; } }
        float gs = 0.f;
#pragma unroll
        for (int i = 0; i < 4; ++i) gs += __expf(gl[i] - gm);
        const float gp = 1.f / gs;
        float el[4];
#pragma unroll
        for (int e = 0; e < 4; ++e) { float v = 0.f;
#pragma unroll
            for (int q = 0; q < 4; ++q) if (q == gi) v = acc[4 + q * 4 + e] + ber[q * 4 + e];
            el[e] = v; }
        int e1 = 0; float m1 = el[0];
#pragma unroll
        for (int e = 1; e < 4; ++e) if (el[e] > m1) { m1 = el[e]; e1 = e; }
        int e2 = -1; float m2 = -INFINITY;
#pragma unroll
        for (int e = 0; e < 4; ++e) if (e != e1 && el[e] > m2) { m2 = el[e]; e2 = e; }
        const float p2 = __expf(m2 - m1), w1 = gp / (1.f + p2), w2 = gp * p2 / (1.f + p2);
        const int ea = e1 < e2 ? e1 : e2, eb = e1 < e2 ? e2 : e1; const float wA = e1 < e2 ? w1 : w2, wB = e1 < e2 ? w2 : w1;
        const int pr = (ea == 0) ? eb - 1 : (ea == 1) ? eb + 1 : 5;
        selw[(size_t)row * 2] = wA; selw[(size_t)row * 2 + 1] = wB; cls = gi * 6 + pr;
    }
    return cls;
}
__device__ __forceinline__ void final_row(int row, int lane, const bf16_t* X3b, const float* ssq3, const float* g, float* out) {
    float v[16]; float s = 0.f;
#pragma unroll
    for (int j = 0; j < 16; ++j) { v[j] = bf2f(X3b[(size_t)row * D + j * 64 + lane]); s += v[j] * v[j]; }
    const float r = pg8::rstd16(ssq3 + (size_t)row * 16);
#pragma unroll
    for (int j = 0; j < 16; ++j) out[(size_t)row * D + j * 64 + lane] = v[j] * r * g[j * 64 + lane];
}

__global__ void __launch_bounds__(NTHREADS, 2) mk_fwd(Args args) {
    extern __shared__ __attribute__((aligned(16))) unsigned char lds[];
    cg::grid_group grid = cg::this_grid();
    Ctx C;
#pragma unroll
    for (int i = 0; i < 29; ++i) C.in[i] = args.in[i];
    C.out = args.out; C.ws = args.ws; C.lds = lds;
    C.tid = threadIdx.x; C.lane = C.tid & 63; C.wave = __builtin_amdgcn_readfirstlane(C.tid >> 6);
    C.G = gridDim.x; C.bid = blockIdx.x; C.gw = C.bid * NWAVES + C.wave; C.NGW = C.G * NWAVES;
    const float* x = C.in[0]; const float* mem = C.in[1]; const float* norm_mix = C.in[2]; const float* w_in = C.in[3];
    const float* conv_w = C.in[4]; const float* conv_b = C.in[5]; const float* lru_w_a = C.in[6]; const float* lru_b_a = C.in[7];
    const float* lru_w_x = C.in[8]; const float* lru_b_x = C.in[9]; const float* lru_lambda = C.in[10];
    const float* norm_rnn = C.in[11]; const float* norm_sb = C.in[12]; const float* w_out = C.in[13];
    const float* norm_xattn = C.in[14]; const float* norm_mem = C.in[15];
    const float* xa_w_q = C.in[16]; const float* xa_w_k = C.in[17]; const float* xa_w_v = C.in[18]; const float* xa_w_o = C.in[19];
    const float* norm_moe = C.in[20]; const float* w_gr = C.in[21]; const float* b_gr = C.in[22]; const float* w_er = C.in[23]; const float* b_er = C.in[24];
    const float* w_gate = C.in[25]; const float* w_up = C.in[26]; const float* w_down = C.in[27]; const float* norm_final = C.in[28];
    unsigned char* ws = C.ws; float* out = C.out;
    float* sm = (float*)(ws + WS_SMALL);
    float* rstd0 = sm + SM_RSTD0; float* ssq_r = sm + SM_SSQR; float* ssq_s = sm + SM_SSQS; float* ssq1 = sm + SM_SSQ1; float* ssq2 = sm + SM_SSQ2; unsigned* kmax = (unsigned*)(ws + WS_CTL); float* fmid = sm + SM_END; float* fend = fmid + 32768;
    float* aggP = sm + 96 * 32768; float* aggH = sm + 104 * 32768;
    float* selw = sm + SM_SELW; float* ssq3 = sm + SM_SSQ3; int* gcnt = (int*)(ws + WS_CTL + 1024);
    int* tlist = (int*)(sm + 64 * 32768); float* rsg = sm + 88 * 32768; float* wAg = rsg + 40960; float* wBg = wAg + 40960; int* tokg = (int*)(wBg + 40960);
    bf16_t* Wg_t = (bf16_t*)(ws + WS_WG); bf16_t* Wu_t = (bf16_t*)(ws + WS_WU); bf16_t* Wd2 = (bf16_t*)(ws + WS_WD2); bf16_t* XG = (bf16_t*)(ws + WS_R1); bf16_t* HID = (bf16_t*)(ws + WS_R5);
    bf16_t* Win_t = (bf16_t*)(ws + WS_WIN); bf16_t* Wout_t = (bf16_t*)(ws + WS_WOUT); bf16_t* Wq_t = (bf16_t*)(ws + WS_WQ); bf16_t* Wkv_t = (bf16_t*)(ws + WS_WKV); bf16_t* Wo_t = (bf16_t*)(ws + WS_WO);
    bf16_t* memn = (bf16_t*)(ws + WS_MEMN); bf16_t* KVM = (bf16_t*)(ws + WS_KVM);
    bf16_t* xb = (bf16_t*)(ws + WS_R0); bf16_t* X1b = xb; bf16_t* X3b = xb;
    bf16_t* XR = (bf16_t*)(ws + WS_R1); bf16_t* GG = XR + (size_t)NTOK * RW; bf16_t* QX = XR;
    bf16_t* Qs = (bf16_t*)(ws + WS_R2); bf16_t* Ks = Qs + (size_t)NTOK * SBW; bf16_t* OX = Qs;
    bf16_t* Vs = (bf16_t*)(ws + WS_R3);
    bf16_t* YY = (bf16_t*)(ws + WS_R4); bf16_t* X2b = YY;
    const int gw = C.gw, NGW = C.NGW, lane = C.lane;
#define GRID_SYNC() grid.sync()

    {
        if (gw == 0) { kmax[lane] = 0u; if (lane < 32) gcnt[lane] = 0; }
        for (int r = gw; r < NTOK; r += NGW) row_prep_x(x, xb, rstd0, r, lane);
        for (int r = gw; r < NMEM; r += NGW) row_prep_mem(mem, norm_mem, memn, r, lane);
        LAS float* scr = (LAS float*)(lds) + C.wave * (64 * 33);
        constexpr int I_IN = (D / 64) * (PROJ / 32), I_SQ = (D / 64) * (D / 32);
        for (int it = gw; it < I_IN + 5 * I_SQ; it += NGW) {
            int r = it;
            if (r < I_IN) { transpose_item(w_in, D, PROJ, Win_t, D, norm_mix, norm_mix, D, scr, r, lane); continue; } r -= I_IN;
            if (r < I_SQ) { transpose_item(w_out, D, D, Wout_t, D, norm_rnn, norm_sb, RW, scr, r, lane); continue; } r -= I_SQ;
            if (r < I_SQ) { transpose_item(xa_w_q, D, D, Wq_t, D, norm_xattn, norm_xattn, D, scr, r, lane); continue; } r -= I_SQ;
            if (r < I_SQ) { transpose_item(xa_w_k, D, D, Wkv_t, D, nullptr, nullptr, 0, scr, r, lane); continue; } r -= I_SQ;
            if (r < I_SQ) { transpose_item(xa_w_v, D, D, Wkv_t + (size_t)D * D, D, nullptr, nullptr, 0, scr, r, lane); continue; } r -= I_SQ;
            transpose_item(xa_w_o, D, D, Wo_t, D, nullptr, nullptr, 0, scr, r, lane);
        }
        constexpr int I_GU = (D / 64) * (DE / 32), I_DN = (DE / 64) * (D / 32);
        for (int it = gw; it < 32 * I_GU + 48 * I_DN; it += NGW) {
            int r = it;
            if (r < 16 * I_GU) { const int e = r / I_GU; transpose_item(w_gate + (size_t)e * D * DE, D, DE, Wg_t + (size_t)e * DE * D, D, norm_moe, norm_moe, D, scr, r % I_GU, lane); continue; } r -= 16 * I_GU;
            if (r < 16 * I_GU) { const int e = r / I_GU; transpose_item(w_up + (size_t)e * D * DE, D, DE, Wu_t + (size_t)e * DE * D, D, norm_moe, norm_moe, D, scr, r % I_GU, lane); continue; } r -= 16 * I_GU;
            { const int cs = r / I_DN, cls = cs >> 1, slot = cs & 1; int ea, eb; pg8::pair_ab(cls % 6, ea, eb); const int e = (cls / 6) * 4 + (slot ? eb : ea);
              transpose_item(w_down + (size_t)e * DE * D, DE, D, Wd2 + (size_t)cls * D * 512 + slot * DE, 512, nullptr, nullptr, 0, scr, r % I_DN, lane); }
        }
    }
    GRID_SYNC();
    { pg8::DenseOrder S; S.init(xb, D, Win_t, D, NTOK, PROJ, C.G, C.bid); pg8::EpiInProjF E{0, rstd0, XR, GG, Qs, Ks, Vs, kmax};
      pg8::gemm_phase<pg8::EpiInProjF, pg8::DenseOrder, true>((LAS unsigned char*)lds, pg8::Gemm{D, D, D}, S, E); }
    { pg8::DenseOrder S; S.init(memn, D, Wkv_t, D, NMEM, 2048, C.G, C.bid); pg8::EpiBf16F E{0, KVM, nullptr, 2048, 1.f};
      pg8::gemm_phase<pg8::EpiBf16F, pg8::DenseOrder, true>((LAS unsigned char*)lds, pg8::Gemm{D, D, D}, S, E); }
    GRID_SYNC();
    lru::Weights LW; lru::load_weights(LW, C.wave, lane & 31, lane >> 5, lru_w_a, lru_b_a, lru_w_x, lru_b_x, lru_lambda);
    {
        for (int u = C.bid; u < BATCH * 64; u += C.G) lru::unit<false>(u >> 6, u & 63, LW, XR, GG, conv_w, conv_b, aggP, aggH, ssq_s, YY, fmid, fend, lds);
        for (int u = C.bid; u < BATCH * NH * 16; u += C.G) sba::sb_unit(u >> 7, (u >> 4) & 7, 15 - (u & 15), Qs, Ks, Vs, YY, ssq_s, kmax, (char*)lds);
    }
    GRID_SYNC();
    for (int u = C.bid; u < BATCH * 64; u += C.G) lru::unit<true>(u >> 6, u & 63, LW, XR, GG, conv_w, conv_b, aggP, aggH, ssq_s, YY, fmid, fend, lds);
    GRID_SYNC();
    { pg8::DenseOrder S; S.init(YY, D, Wout_t, D, NTOK, D, C.G, C.bid); pg8::EpiX1F E{8, x, fmid, fend, X1b, ssq1};
      pg8::gemm_phase<pg8::EpiX1F, pg8::DenseOrder, true>((LAS unsigned char*)lds, pg8::Gemm{D, D, D}, S, E); }
    GRID_SYNC();
    { pg8::DenseOrder S; S.init(X1b, D, Wq_t, D, NTOK, D, C.G, C.bid); pg8::EpiBf16F E{0, QX, ssq1, D, 0.0625f * LOG2E};
      pg8::gemm_phase<pg8::EpiBf16F, pg8::DenseOrder, true>((LAS unsigned char*)lds, pg8::Gemm{D, D, D}, S, E); }
    GRID_SYNC();
    {
        const int half = C.tid >> 8, j = C.tid & 255;
        LAS float* qs = (LAS float*)(lds) + half * 4096; LAS float* ps = qs + 2048;
        for (int u = C.bid * 2; u < BATCH * XH * 512; u += C.G * 2) xattn_naive_unit(u + half, j, qs, ps, QX, KVM, OX);
    }
    GRID_SYNC();
    { pg8::DenseOrder S; S.init(OX, D, Wo_t, D, NTOK, D, C.G, C.bid); pg8::EpiResF E{0, X1b, X2b, ssq2};
      pg8::gemm_phase<pg8::EpiResF, pg8::DenseOrder, true>((LAS unsigned char*)lds, pg8::Gemm{D, D, D}, S, E); }
    GRID_SYNC();
    {
        LAS int* lcnt = (LAS int*)lds; LAS int* lbase = lcnt + 32; LAS int* lcls = lcnt + 64; LAS int* lpos = lcnt + 192;
        for (int chunk = C.bid; chunk < NTOK / 128; chunk += C.G) {
            if (C.tid < 32) lcnt[C.tid] = 0;
            __syncthreads();
            for (int i = 0; i < 16; ++i) { const int lt = C.wave * 16 + i, row = chunk * 128 + lt;
                const int cls = router_row(row, lane, X2b, ssq2, norm_moe, w_gr, b_gr, w_er, b_er, selw);
                if (lane == 0) { lcls[lt] = cls; lpos[lt] = __hip_atomic_fetch_add(lcnt + cls, 1, __ATOMIC_RELAXED, __HIP_MEMORY_SCOPE_WORKGROUP); } }
            __syncthreads();
            if (C.tid < 24) lbase[C.tid] = atomicAdd(gcnt + C.tid, lcnt[C.tid]);
            __syncthreads();
            if (C.tid < 128) { const int c = lcls[C.tid]; tlist[(size_t)c * NTOK + lbase[c] + lpos[C.tid]] = chunk * 128 + C.tid; }
            __syncthreads();
        }
    }
    GRID_SYNC();
    LAS int* meta = (LAS int*)(lds + 131072 + 1024);
    {
        if (C.tid == 0) { int rb = 0, tb = 0;
            for (int c = 0; c < 24; ++c) { const int n = gcnt[c], nt = (n + 255) >> 8; meta[c] = n; meta[32 + c] = rb; meta[64 + c] = tb; rb += nt * 256; tb += nt; }
            meta[32 + 24] = rb; meta[64 + 24] = tb; }
        __syncthreads();
        const int total = meta[32 + 24];
        for (int R = gw; R < total; R += NGW) {
            int c = 0;
            for (int k = 1; k < 24; ++k) c += (R >= meta[32 + k]) ? 1 : 0;
            const int p = R - meta[32 + c]; u32x4 v0 = (u32x4){0u, 0u, 0u, 0u}, v1 = v0; int tok = -1; float rs = 0.f, wA = 0.f, wB = 0.f;
            if (p < meta[c]) { tok = tlist[(size_t)c * NTOK + p]; const u32x4* src = (const u32x4*)(X2b + (size_t)tok * D) + lane; v0 = src[0]; v1 = src[64];
                rs = pg8::rstd16(ssq2 + (size_t)tok * 16); wA = selw[(size_t)tok * 2]; wB = selw[(size_t)tok * 2 + 1]; }
            u32x4* dst = (u32x4*)(XG + (size_t)R * D) + lane; dst[0] = v0; dst[64] = v1;
            if (lane == 0) { rsg[R] = rs; wAg[R] = wA; wBg[R] = wB; tokg[R] = tok; }
        }
    }
    GRID_SYNC();
    { pg8::MoeOrder1 S{XG, Wg_t, Wu_t, meta, C.G, C.bid}; pg8::EpiMoeUp E{0, rsg, wAg, wBg, HID};
      pg8::gemm_phase<pg8::EpiMoeUp, pg8::MoeOrder1, true>((LAS unsigned char*)lds, pg8::Gemm{D, D, D}, S, E); }
    GRID_SYNC();
    { pg8::MoeOrder2 S{HID, Wd2, meta, C.G, C.bid}; pg8::EpiMoeDown E{0, tokg, X2b, X3b, ssq3};
      pg8::gemm_phase<pg8::EpiMoeDown, pg8::MoeOrder2, true>((LAS unsigned char*)lds, pg8::Gemm{512, 512, 512}, S, E); }
    GRID_SYNC();
    for (int r = gw; r < NTOK; r += NGW) final_row(r, lane, X3b, ssq3, norm_final, out);
}

extern "C" void kernel_launch(void* const* d_in, const int* in_sizes, int n_in, void* d_out, int out_size, void* d_ws, size_t ws_size, hipStream_t stream) {
    static int grid = 0;
    if (grid == 0) {
        if (n_in != 29 || ws_size < WS_END) { fprintf(stderr, "kernel_launch: unexpected inputs (%d) or workspace (%zu)\n", n_in, ws_size); grid = -1; return; }
        int dev = 0, cus = 0, per_cu = 0;
        hipGetDevice(&dev); hipDeviceGetAttribute(&cus, hipDeviceAttributeMultiprocessorCount, dev);
        hipFuncSetAttribute((const void*)mk_fwd, hipFuncAttributeMaxDynamicSharedMemorySize, LDS_BYTES);
        hipOccupancyMaxActiveBlocksPerMultiprocessor(&per_cu, (const void*)mk_fwd, NTHREADS, LDS_BYTES);
        if (per_cu < 1) { fprintf(stderr, "kernel_launch: occupancy query says %d blocks per CU\n", per_cu); per_cu = 1; }
        if (per_cu > 1) per_cu = 1;
        grid = cus * per_cu;
    }
    if (grid < 0) return;
    Args a{};
    for (int i = 0; i < 29; ++i) a.in[i] = (const float*)d_in[i];
    a.out = (float*)d_out; a.ws = (unsigned char*)d_ws;
    void* kargs[] = {&a};
    hipError_t e = hipLaunchCooperativeKernel((const void*)mk_fwd, dim3(grid), dim3(NTHREADS), kargs, LDS_BYTES, stream);
    if (e != hipSuccess) fprintf(stderr, "cooperative launch failed: %s (grid %d)\n", hipGetErrorString(e), grid);
}
```

```cpp
#include <hip/hip_runtime.h>
#include <hip/hip_cooperative_groups.h>
#include <cstdio>
#include <cstdint>

typedef unsigned short bf16_t;
typedef short bf16x8 __attribute__((ext_vector_type(8)));
typedef float f32x4 __attribute__((ext_vector_type(4)));
typedef unsigned u32x4 __attribute__((ext_vector_type(4)));

constexpr int D = 1024, BATCH = 8, SEQ = 4096, NTOK = BATCH * SEQ, MEM = 256, NMEM = BATCH * MEM;
constexpr int RW = 512, SBW = 512, PROJ = 2560, NH = 8, HD = 64;
constexpr int XH = 4, XD = 256, NG = 4, EPG = 4, NEXP = 16, DE = 256;
constexpr float EPS = 1e-6f, LOG2E = 1.4426950408889634f;

constexpr size_t MiB = 1u << 20;
constexpr size_t WS_CTL = 0;
constexpr size_t WS_SMALL = 1 * MiB;
constexpr size_t WS_WIN = 16 * MiB;
constexpr size_t WS_WOUT = 21 * MiB;
constexpr size_t WS_WQ = 23 * MiB;
constexpr size_t WS_WKV = 25 * MiB;
constexpr size_t WS_WO = 29 * MiB;
constexpr size_t WS_MEMN = 31 * MiB;
constexpr size_t WS_KVM = 35 * MiB;
constexpr size_t WS_WG = 43 * MiB;
constexpr size_t WS_WU = 51 * MiB;
constexpr size_t WS_WD2 = 59 * MiB;
constexpr size_t WS_R0 = 96 * MiB;
constexpr size_t WS_R1 = 160 * MiB;
constexpr size_t WS_R2 = 224 * MiB;
constexpr size_t WS_R3 = 288 * MiB;
constexpr size_t WS_R4 = 320 * MiB;
constexpr size_t WS_R5 = 384 * MiB;
constexpr size_t WS_END = 448 * MiB;

constexpr size_t SM_RSTD0 = 0;
constexpr size_t SM_SSQR = 1 * 32768;
constexpr size_t SM_SSQS = 2 * 32768;
constexpr size_t SM_SSQ1 = 10 * 32768;
constexpr size_t SM_SSQ2 = 26 * 32768;
constexpr size_t SM_SSQ3 = 42 * 32768;
constexpr size_t SM_SELW = 58 * 32768;
constexpr size_t SM_SELE = 60 * 32768;
constexpr size_t SM_END = 62 * 32768;

__device__ __forceinline__ unsigned f2bf(float f) { unsigned u = __builtin_bit_cast(unsigned, f); return (u + 0x7fffu + ((u >> 16) & 1u)) >> 16; }
__device__ __forceinline__ float bf2f(unsigned short h) { return __builtin_bit_cast(float, (unsigned)h << 16); }
__device__ __forceinline__ float wave_sum(float v) {
#pragma unroll
    for (int o = 1; o < 64; o <<= 1) v += __shfl_xor(v, o);
    return v;
}
__device__ __forceinline__ float gelu_tanh(float x) { const float u = 0.7978845608028654f * (x + 0.044715f * x * x * x); return x / (1.f + __expf(-2.f * u)); }
__device__ __forceinline__ float sigmoidf_(float x) { return 1.f / (1.f + __expf(-x)); }

namespace cg = cooperative_groups;
#define LAS __attribute__((address_space(3)))
constexpr int NWAVES = 8, NTHREADS = 512;
constexpr int LDS_BYTES = 147456;

struct Args { const float* in[29]; float* out; unsigned char* ws; };

struct Ctx {
    const float* in[29]; float* out; unsigned char* ws; unsigned char* lds;
    int tid, lane, wave, gw, NGW, G, bid;
};

namespace pg8 {
#define PG8_LAS __attribute__((address_space(3)))
constexpr int BM = 256, BK = 64, HALF = 128, HTB = HALF * BK * 2  , STAGE_BYTES = 8 * HTB, NXCD = 8, WGM = 8;
__host__ __device__ __forceinline__ int lds_byte(int r, int c) { const int st = (r >> 4) * 2 + (c >> 5), rr = r & 15, cc = c & 31, ob = rr * 64 + cc * 2; return st * 1024 + (ob ^ (((ob >> 9) & 1) << 5)); }
__host__ __device__ __forceinline__ void stage_rc(int b, int& R, int& C) { const int st = b / 1024, sb = b % 1024, swz = sb ^ (((sb >> 9) & 1) << 5); R = (st >> 1) * 16 + swz / 64; C = (st & 1) * 32 + (swz % 64) / 2; }
__host__ __device__ __forceinline__ int perm32(int rho) { const int n = rho >> 4, i = rho & 15; return 8 * (i >> 2) + 4 * n + (i & 3); }

struct Unit { int pm, pn; };
struct Gemm { int lda, ldb, K; };
struct DenseOrder {
    const bf16_t* A; const bf16_t* Bt; int lda, ldb; int nM, nN, nwg, G, c;
    __device__ void init(const bf16_t* A_, int lda_, const bf16_t* Bt_, int ldb_, int M, int N, int G_, int c_) { A = A_; Bt = Bt_; lda = lda_; ldb = ldb_; nM = M / BM; nN = N / BM; nwg = nM * nN; G = G_; c = c_; }
    __device__ bool next(int i, Unit& u) const {
        const long L = (long)i * G + c; if (L >= nwg) return false;
        int wgid = (int)L; { const int q = nwg / NXCD, r = nwg % NXCD, xcd = wgid % NXCD, off = wgid / NXCD; wgid = (xcd < r ? xcd * (q + 1) : r * (q + 1) + (xcd - r) * q) + off; }
        const int nig = WGM * nN, gid = wgid / nig, fm = gid * WGM, gsz = (nM - fm) < WGM ? (nM - fm) : WGM;
        u.pm = fm + ((wgid % nig) % gsz); u.pn = (wgid % nig) / gsz; return true;
    }
    __device__ __forceinline__ void ptrs(const Unit& u, const char*& a, const char*& b0, const char*& b1) const {
        a = (const char*)A + (size_t)u.pm * BM * lda * 2; b0 = (const char*)Bt + (size_t)u.pn * BM * ldb * 2; b1 = b0 + (size_t)HALF * ldb * 2; }
};

__device__ __forceinline__ unsigned cvt_pk_bf16(float lo, float hi) { unsigned r; asm volatile("v_cvt_pk_bf16_f32 %0, %1, %2" : "=v"(r) : "v"(lo), "v"(hi)); return r; }

template <class Epi, class Sched, bool ALIGN_EPI>
__device__ __forceinline__ void gemm_phase(PG8_LAS unsigned char* lds, const Gemm g, const Sched& S, const Epi& E) {
    int tid_ = threadIdx.x; asm volatile("" : "+v"(tid_));
    const int tid = tid_, wid = __builtin_amdgcn_readfirstlane(tid >> 6), lane = tid & 63, wr = wid >> 2, wc = wid & 3, fr = lane & 15, fq = lane >> 4;
    int nt_ = g.K / BK; asm volatile("" : "+s"(nt_)); const int nt = nt_;
    unsigned voffA[2], voffB[2];
#pragma unroll
    for (int i = 0; i < 2; ++i) { int R, C; stage_rc(tid * 16 + i * 8192, R, C); const int Rb = Epi::PERM ? ((R & ~31) + perm32(R & 31)) : R;
        voffA[i] = (unsigned)(R * g.lda + C) * 2u; voffB[i] = (unsigned)(Rb * g.ldb + C) * 2u; }
    const size_t kstep = (size_t)(BK * 2);
    const size_t hstepA = (size_t)HALF * g.lda * 2;
    const unsigned ldsw = (unsigned)wid * 1024u;
    const int aoff = lds_byte(wr * 64 + fr, fq * 8), boff = lds_byte(wc * 32 + fr, fq * 8);
#define PG8_SA(b, h) (((b) * 2 + (h)) * HTB)
#define PG8_SB(b, h) ((4 + (b) * 2 + (h)) * HTB)
#define PG8_STAGE(bufoff, gbase, voff) do { _Pragma("unroll") for (int _i = 0; _i < 2; ++_i) \
        __builtin_amdgcn_global_load_lds((const unsigned*)((const char*)(gbase) + (voff)[_i]), (PG8_LAS unsigned*)(lds + (bufoff) + ldsw + _i * 8192), 16, 0, 0); } while (0)
#define PG8_LDA(dst, b, h) do { _Pragma("unroll") for (int m = 0; m < 4; ++m) _Pragma("unroll") for (int k = 0; k < 2; ++k) dst[m][k] = *(const PG8_LAS bf16x8*)(lds + PG8_SA(b, h) + aoff + m * 2048 + k * 1024); } while (0)
#define PG8_LDB(dst, b, h) do { _Pragma("unroll") for (int n = 0; n < 2; ++n) _Pragma("unroll") for (int k = 0; k < 2; ++k) dst[n][k] = *(const PG8_LAS bf16x8*)(lds + PG8_SB(b, h) + boff + n * 2048 + k * 1024); } while (0)
#define PG8_MMA(ai, bj, At, Bt) do { __builtin_amdgcn_s_setprio(1); _Pragma("unroll") for (int m = 0; m < 4; ++m) _Pragma("unroll") for (int n = 0; n < 2; ++n) _Pragma("unroll") for (int k = 0; k < 2; ++k) \
        acc[ai][bj][m][n] = __builtin_amdgcn_mfma_f32_16x16x32_bf16(Bt[n][k], At[m][k], acc[ai][bj][m][n], 0, 0, 0); __builtin_amdgcn_s_setprio(0); } while (0)
#define PG8_WAIT_V(n) asm volatile("s_waitcnt vmcnt(" #n ")" ::: "memory")
#define PG8_WAIT_L(n) asm volatile("s_waitcnt lgkmcnt(" #n ")" ::: "memory")
#define PG8_BAR __builtin_amdgcn_s_barrier()
#define PG8_SCHED __builtin_amdgcn_sched_barrier(0)
    Unit cur, nxt; int ui = 0;
    if (!S.next(0, cur)) return;
    f32x4 acc[2][2][4][2];
#pragma unroll
    for (int a = 0; a < 2; ++a)
#pragma unroll
        for (int b = 0; b < 2; ++b)
#pragma unroll
            for (int m = 0; m < 4; ++m)
#pragma unroll
                for (int n = 0; n < 2; ++n) acc[a][b][m][n] = (f32x4){0.f, 0.f, 0.f, 0.f};
    bf16x8 At[4][2], B0[2][2], B1[2][2];
    const char *cA, *cB0, *cB1; S.ptrs(cur, cA, cB0, cB1);
    PG8_STAGE(PG8_SB(0, 0), cB0, voffB); PG8_STAGE(PG8_SB(0, 1), cB1, voffB); PG8_STAGE(PG8_SA(0, 0), cA, voffA); PG8_STAGE(PG8_SA(0, 1), cA + hstepA, voffA);
    if (wr == 1) PG8_BAR;
    PG8_WAIT_V(2); PG8_BAR;
    PG8_STAGE(PG8_SB(1, 0), cB0 + kstep, voffB); PG8_STAGE(PG8_SA(1, 0), cA + kstep, voffA); PG8_STAGE(PG8_SB(1, 1), cB1 + kstep, voffB);
    PG8_WAIT_V(6); PG8_BAR;
    for (;;) {
        const bool has_next = S.next(ui + 1, nxt);
        const char *nA = cA, *nB0 = cB0, *nB1 = cB1; if (has_next) S.ptrs(nxt, nA, nB0, nB1);
#pragma unroll 1
        for (int t = 0; t < nt; t += 2) {
            const bool last = (t == nt - 2);
            if constexpr (Epi::HAS_MID) { if (t == E.mid_t) E.mid(acc, cur, wr, wc, fr, fq); }
            const char* a1 = cA + (size_t)(t + 1) * kstep;
            const char* a2 = last ? nA : cA + (size_t)(t + 2) * kstep; const char* b2 = last ? nB0 : cB0 + (size_t)(t + 2) * kstep; const char* b2h = last ? nB1 : cB1 + (size_t)(t + 2) * kstep;
            const char* a3 = a2 + kstep; const char* b3 = b2 + kstep; const char* b3h = b2h + kstep;
            PG8_LDB(B0, 0, 0); PG8_LDB(B1, 0, 1); PG8_SCHED; PG8_LDA(At, 0, 0); PG8_STAGE(PG8_SA(1, 1), a1 + hstepA, voffA);
            PG8_WAIT_V(8); PG8_WAIT_L(0); PG8_BAR; PG8_MMA(0, 0, At, B0); PG8_MMA(0, 1, At, B1); PG8_BAR; PG8_SCHED;
            PG8_LDA(At, 0, 1); PG8_STAGE(PG8_SB(0, 0), b2, voffB); PG8_STAGE(PG8_SB(0, 1), b2h, voffB); PG8_STAGE(PG8_SA(0, 0), a2, voffA);
            PG8_WAIT_V(8); PG8_WAIT_L(0); PG8_BAR; PG8_MMA(1, 0, At, B0); PG8_MMA(1, 1, At, B1); PG8_BAR; PG8_SCHED;
            PG8_LDB(B0, 1, 0); PG8_LDB(B1, 1, 1); PG8_SCHED; PG8_LDA(At, 1, 0); PG8_STAGE(PG8_SA(0, 1), a2 + hstepA, voffA);
            PG8_WAIT_V(8); PG8_WAIT_L(0); PG8_BAR; PG8_MMA(0, 0, At, B0); PG8_MMA(0, 1, At, B1); PG8_BAR; PG8_SCHED;
            PG8_LDA(At, 1, 1); PG8_STAGE(PG8_SB(1, 0), b3, voffB); PG8_STAGE(PG8_SB(1, 1), b3h, voffB); PG8_STAGE(PG8_SA(1, 0), a3, voffA);
            PG8_WAIT_V(8); PG8_WAIT_L(0); PG8_BAR; PG8_MMA(1, 0, At, B0); PG8_MMA(1, 1, At, B1); PG8_BAR; PG8_SCHED;
        }
        if constexpr (ALIGN_EPI) { if (wr == 0) PG8_BAR; }
        E(acc, cur, wr, wc, fr, fq);
        if (!has_next) break;
#pragma unroll
        for (int a = 0; a < 2; ++a)
#pragma unroll
            for (int b = 0; b < 2; ++b)
#pragma unroll
                for (int m = 0; m < 4; ++m)
#pragma unroll
                    for (int n = 0; n < 2; ++n) acc[a][b][m][n] = (f32x4){0.f, 0.f, 0.f, 0.f};
        cur = nxt; cA = nA; cB0 = nB0; cB1 = nB1; ++ui;
        if constexpr (ALIGN_EPI) { if (wr == 1) PG8_BAR; }
    }
    PG8_WAIT_V(0);
    if constexpr (!ALIGN_EPI) { if (wr == 0) PG8_BAR; }
    PG8_BAR;
#undef PG8_SA
#undef PG8_SB
#undef PG8_STAGE
#undef PG8_LDA
#undef PG8_LDB
#undef PG8_MMA
#undef PG8_WAIT_V
#undef PG8_WAIT_L
#undef PG8_BAR
#undef PG8_SCHED
}

__device__ __forceinline__ float rstd16(const float* p) { const f32x4 a = ((const f32x4*)p)[0], b = ((const f32x4*)p)[1], c = ((const f32x4*)p)[2], d = ((const f32x4*)p)[3];
    const float s = ((a.x + a.y) + (a.z + a.w)) + ((b.x + b.y) + (b.z + b.w)) + ((c.x + c.y) + (c.z + c.w)) + ((d.x + d.y) + (d.z + d.w)); return 1.0f / sqrtf(s * (1.f / D) + EPS); }
__device__ __forceinline__ u32x4 pack8(const f32x4 v0, const f32x4 v1) { u32x4 w; w.x = cvt_pk_bf16(v0[0], v0[1]); w.y = cvt_pk_bf16(v0[2], v0[3]); w.z = cvt_pk_bf16(v1[0], v1[1]); w.w = cvt_pk_bf16(v1[2], v1[3]); return w; }
__device__ __forceinline__ float sq8(const f32x4 a, const f32x4 b) { return ((a[0] * a[0] + a[1] * a[1]) + (a[2] * a[2] + a[3] * a[3])) + ((b[0] * b[0] + b[1] * b[1]) + (b[2] * b[2] + b[3] * b[3])); }

struct EpiInProjF {
    static constexpr bool PERM = true, HAS_MID = false; int mid_t;
    const float* rstd0; bf16_t *XR, *GG, *Qs, *Ks, *Vs; unsigned* kmax;
    __device__ __forceinline__ void mid(f32x4 (&)[2][2][4][2], const Unit&, int, int, int, int) const {}
    __device__ __forceinline__ void operator()(const f32x4 (&acc)[2][2][4][2], const Unit& u, int wr, int wc, int fr, int fq) const {
        const int row0 = u.pm * BM + wr * 64 + fr, t = u.pn >> 1, colt = (u.pn & 1) * 256 + wc * 32 + 8 * fq;
        bf16_t* base = (t == 0) ? XR : (t == 1) ? GG : (t == 2) ? Qs : (t == 3) ? Ks : Vs;
        float km0 = 0.f, km1 = 0.f;
#pragma unroll
        for (int ai = 0; ai < 2; ++ai)
#pragma unroll
            for (int m = 0; m < 4; ++m) { const int r = row0 + ai * HALF + m * 16; const float rs = rstd0[r]; bf16_t* rowp = base + (size_t)r * 512 + colt;
#pragma unroll
                for (int bj = 0; bj < 2; ++bj) { f32x4 v0 = acc[ai][bj][m][0] * rs, v1 = acc[ai][bj][m][1] * rs;
                    if (t == 1) {
#pragma unroll
                        for (int e = 0; e < 4; ++e) { v0[e] = gelu_tanh(v0[e]); v1[e] = gelu_tanh(v1[e]); } }
                    else if (t == 2) { v0 = v0 * (0.125f * LOG2E); v1 = v1 * (0.125f * LOG2E); }
                    else if (t == 3) { float mx = 0.f;
#pragma unroll
                        for (int e = 0; e < 4; ++e) mx = fmaxf(mx, fmaxf(fabsf(v0[e]), fabsf(v1[e])));
                        if (bj == 0) km0 = fmaxf(km0, mx); else km1 = fmaxf(km1, mx); }
                    *(u32x4*)(rowp + bj * HALF) = pack8(v0, v1); } }
        if (t == 3) {
#pragma unroll
            for (int o = 1; o < 64; o <<= 1) { km0 = fmaxf(km0, __shfl_xor(km0, o)); km1 = fmaxf(km1, __shfl_xor(km1, o)); }
            if ((fr | fq) == 0) { const int b = (u.pm * BM) / SEQ, hd = (u.pn & 1) * 4 + (wc >> 1);
                atomicMax(kmax + b * 8 + hd, __float_as_uint(km0)); atomicMax(kmax + b * 8 + hd + 2, __float_as_uint(km1)); }
        }
    }
};
struct EpiBf16F {
    static constexpr bool PERM = true, HAS_MID = false; int mid_t;
    bf16_t* O; const float* ssq16; int ldo; float scale; size_t tstride;
    __device__ __forceinline__ void mid(f32x4 (&)[2][2][4][2], const Unit&, int, int, int, int) const {}
    __device__ __forceinline__ void operator()(const f32x4 (&acc)[2][2][4][2], const Unit& u, int wr, int wc, int fr, int fq) const {
        const int row0 = u.pm * BM + wr * 64 + fr, col0 = (tstride ? 0 : u.pn * BM) + wc * 32 + 8 * fq; bf16_t* base = O + (size_t)u.pn * tstride;
#pragma unroll
        for (int ai = 0; ai < 2; ++ai)
#pragma unroll
            for (int m = 0; m < 4; ++m) { const int r = row0 + ai * HALF + m * 16; const float rs = (ssq16 ? rstd16(ssq16 + (size_t)r * 16) : 1.f) * scale; bf16_t* rowp = base + (size_t)r * ldo + col0;
#pragma unroll
                for (int bj = 0; bj < 2; ++bj) *(u32x4*)(rowp + bj * HALF) = pack8(acc[ai][bj][m][0] * rs, acc[ai][bj][m][1] * rs); }
    }
};
struct EpiX1F {
    static constexpr bool PERM = true, HAS_MID = true; int mid_t;
    const float* x; const float* fmid; const float* fend; bf16_t* X1b; float* ssq1;
    __device__ __forceinline__ void mid(f32x4 (&acc)[2][2][4][2], const Unit& u, int wr, int wc, int fr, int fq) const {
        const int row0 = u.pm * BM + wr * 64 + fr;
#pragma unroll
        for (int ai = 0; ai < 2; ++ai)
#pragma unroll
            for (int m = 0; m < 4; ++m) { const float f = fmid[row0 + ai * HALF + m * 16];
#pragma unroll
                for (int bj = 0; bj < 2; ++bj) { acc[ai][bj][m][0] = acc[ai][bj][m][0] * f; acc[ai][bj][m][1] = acc[ai][bj][m][1] * f; } }
    }
    __device__ __forceinline__ void operator()(const f32x4 (&acc)[2][2][4][2], const Unit& u, int wr, int wc, int fr, int fq) const {
        const int row0 = u.pm * BM + wr * 64 + fr, col0 = u.pn * BM + wc * 32 + 8 * fq;
#pragma unroll
        for (int ai = 0; ai < 2; ++ai)
#pragma unroll
            for (int m = 0; m < 4; ++m) { const int r = row0 + ai * HALF + m * 16; const float fe = fend[r]; const float* xr = x + (size_t)r * D + col0; float ss = 0.f;
#pragma unroll
                for (int bj = 0; bj < 2; ++bj) { const f32x4 v0 = *(const f32x4*)(xr + bj * HALF) + acc[ai][bj][m][0] * fe, v1 = *(const f32x4*)(xr + bj * HALF + 4) + acc[ai][bj][m][1] * fe;
                    ss += sq8(v0, v1); *(u32x4*)(X1b + (size_t)r * D + col0 + bj * HALF) = pack8(v0, v1); }
                ss += __shfl_xor(ss, 16); ss += __shfl_xor(ss, 32);
                if (fq == 0) ssq1[(size_t)r * 16 + u.pn * 4 + wc] = ss;
                asm volatile("" ::: "memory"); }
    }
};
struct EpiResF {
    static constexpr bool PERM = true, HAS_MID = false; int mid_t;
    const bf16_t* Xi; bf16_t* Xo; float* ssq;
    __device__ __forceinline__ void mid(f32x4 (&)[2][2][4][2], const Unit&, int, int, int, int) const {}
    __device__ __forceinline__ void operator()(const f32x4 (&acc)[2][2][4][2], const Unit& u, int wr, int wc, int fr, int fq) const {
        const int row0 = u.pm * BM + wr * 64 + fr, col0 = u.pn * BM + wc * 32 + 8 * fq;
#pragma unroll
        for (int ai = 0; ai < 2; ++ai)
#pragma unroll
            for (int m = 0; m < 4; ++m) { const int r = row0 + ai * HALF + m * 16; float ss = 0.f;
#pragma unroll
                for (int bj = 0; bj < 2; ++bj) { const u32x4 xi = *(const u32x4*)(Xi + (size_t)r * D + col0 + bj * HALF);
                    f32x4 v0, v1; v0[0] = __uint_as_float(xi.x << 16); v0[1] = __uint_as_float(xi.x & 0xffff0000u); v0[2] = __uint_as_float(xi.y << 16); v0[3] = __uint_as_float(xi.y & 0xffff0000u);
                    v1[0] = __uint_as_float(xi.z << 16); v1[1] = __uint_as_float(xi.z & 0xffff0000u); v1[2] = __uint_as_float(xi.w << 16); v1[3] = __uint_as_float(xi.w & 0xffff0000u);
                    v0 = v0 + acc[ai][bj][m][0]; v1 = v1 + acc[ai][bj][m][1];
                    ss += sq8(v0, v1); *(u32x4*)(Xo + (size_t)r * D + col0 + bj * HALF) = pack8(v0, v1); }
                ss += __shfl_xor(ss, 16); ss += __shfl_xor(ss, 32);
                if (fq == 0) ssq[(size_t)r * 16 + u.pn * 4 + wc] = ss; }
    }
};

__device__ __forceinline__ void pair_ab(int p, int& a, int& b) { a = (p < 3) ? 0 : (p < 5) ? 1 : 2; b = (p < 3) ? p + 1 : (p < 5) ? p - 1 : 3; }
__device__ __forceinline__ int moe_class_of_tile(const PG8_LAS int* meta, int T) { int c = 0;
#pragma unroll
    for (int k = 1; k < 24; ++k) c += (T >= __builtin_amdgcn_readfirstlane(meta[64 + k])) ? 1 : 0;
    return c; }
struct MoeOrder1 {
    const bf16_t* XG; const bf16_t* Wg; const bf16_t* Wu; const PG8_LAS int* meta; int G, c;
    __device__ bool next(int i, Unit& u) const { const int L = i * G + c, nt = __builtin_amdgcn_readfirstlane(meta[64 + 24]); if (L >= nt * 4) return false;
        u.pm = L >> 2; u.pn = moe_class_of_tile(meta, L >> 2) * 4 + (L & 3); return true; }
    __device__ __forceinline__ void ptrs(const Unit& u, const char*& a, const char*& b0, const char*& b1) const {
        const int cls = u.pn >> 2, j = (u.pn >> 1) & 1, half = u.pn & 1; int ea, eb; pair_ab(cls % 6, ea, eb); const int e = (cls / 6) * 4 + (j ? eb : ea);
        a = (const char*)XG + (size_t)u.pm * BM * D * 2; const size_t bo = ((size_t)e * DE + half * HALF) * D * 2; b0 = (const char*)Wg + bo; b1 = (const char*)Wu + bo; }
};
struct MoeOrder2 {
    const bf16_t* HID; const bf16_t* Wd2; const PG8_LAS int* meta; int G, c;
    __device__ bool next(int i, Unit& u) const { const int L = i * G + c, nt = __builtin_amdgcn_readfirstlane(meta[64 + 24]); if (L >= nt * 4) return false;
        u.pm = L >> 2; u.pn = moe_class_of_tile(meta, L >> 2) * 4 + (L & 3); return true; }
    __device__ __forceinline__ void ptrs(const Unit& u, const char*& a, const char*& b0, const char*& b1) const {
        a = (const char*)HID + (size_t)u.pm * BM * 512 * 2; b0 = (const char*)Wd2 + ((size_t)(u.pn >> 2) * D + (u.pn & 3) * BM) * 512 * 2; b1 = b0 + (size_t)HALF * 512 * 2; }
};
struct EpiMoeUp {
    static constexpr bool PERM = true, HAS_MID = false; int mid_t;
    const float* rsg; const float* wAg; const float* wBg; bf16_t* HID;
    __device__ __forceinline__ void mid(f32x4 (&)[2][2][4][2], const Unit&, int, int, int, int) const {}
    __device__ __forceinline__ void operator()(const f32x4 (&acc)[2][2][4][2], const Unit& u, int wr, int wc, int fr, int fq) const {
        const int row0 = u.pm * BM + wr * 64 + fr, j = (u.pn >> 1) & 1, col0 = j * 256 + (u.pn & 1) * HALF + wc * 32 + 8 * fq; const float* wg = j ? wBg : wAg;
#pragma unroll
        for (int ai = 0; ai < 2; ++ai)
#pragma unroll
            for (int m = 0; m < 4; ++m) { const int r = row0 + ai * HALF + m * 16; const float rs = rsg[r], w = wg[r]; f32x4 h0, h1;
#pragma unroll
                for (int e = 0; e < 4; ++e) { const float g0 = acc[ai][0][m][0][e] * rs, g1 = acc[ai][0][m][1][e] * rs;
                    h0[e] = g0 / (1.f + __expf(-g0)) * (acc[ai][1][m][0][e] * rs) * w; h1[e] = g1 / (1.f + __expf(-g1)) * (acc[ai][1][m][1][e] * rs) * w; }
                *(u32x4*)(HID + (size_t)r * 512 + col0) = pack8(h0, h1); }
    }
};
struct EpiMoeDown {
    static constexpr bool PERM = true, HAS_MID = false; int mid_t;
    const int* tokg; const bf16_t* Xi; bf16_t* Xo; float* ssq;
    __device__ __forceinline__ void mid(f32x4 (&)[2][2][4][2], const Unit&, int, int, int, int) const {}
    __device__ __forceinline__ void operator()(const f32x4 (&acc)[2][2][4][2], const Unit& u, int wr, int wc, int fr, int fq) const {
        const int row0 = u.pm * BM + wr * 64 + fr, ct = u.pn & 3, col0 = ct * BM + wc * 32 + 8 * fq;
#pragma unroll
        for (int ai = 0; ai < 2; ++ai)
#pragma unroll
            for (int m = 0; m < 4; ++m) { const int tok = tokg[row0 + ai * HALF + m * 16];
                if (tok >= 0) { float ss = 0.f;
#pragma unroll
                    for (int bj = 0; bj < 2; ++bj) { const u32x4 xi = *(const u32x4*)(Xi + (size_t)tok * D + col0 + bj * HALF);
                        f32x4 v0, v1; v0[0] = __uint_as_float(xi.x << 16); v0[1] = __uint_as_float(xi.x & 0xffff0000u); v0[2] = __uint_as_float(xi.y << 16); v0[3] = __uint_as_float(xi.y & 0xffff0000u);
                        v1[0] = __uint_as_float(xi.z << 16); v1[1] = __uint_as_float(xi.z & 0xffff0000u); v1[2] = __uint_as_float(xi.w << 16); v1[3] = __uint_as_float(xi.w & 0xffff0000u);
                        v0 = v0 + acc[ai][bj][m][0]; v1 = v1 + acc[ai][bj][m][1];
                        ss += sq8(v0, v1); *(u32x4*)(Xo + (size_t)tok * D + col0 + bj * HALF) = pack8(v0, v1); }
                    ss += __shfl_xor(ss, 16); ss += __shfl_xor(ss, 32);
                    if (fq == 0) ssq[(size_t)tok * 16 + ct * 4 + wc] = ss; } }
    }
};

struct XaSOrder {
    const bf16_t* QX; const bf16_t* KM; int G, c;
    __device__ bool next(int i, Unit& u) const { const int L = i * G + c; if (L >= (NTOK / BM) * XH) return false; u.pm = L >> 2; u.pn = L & 3; return true; }
    __device__ __forceinline__ void ptrs(const Unit& u, const char*& a, const char*& b0, const char*& b1) const {
        a = (const char*)QX + ((size_t)u.pm * BM * D + u.pn * XD) * 2; const int b = u.pm / (SEQ / BM);
        b0 = (const char*)KM + ((size_t)b * MEM * D + u.pn * XD) * 2; b1 = b0 + (size_t)HALF * D * 2; }
};
struct XaOOrder {
    const bf16_t* P; const bf16_t* VT; int G, c;
    __device__ bool next(int i, Unit& u) const { const int L = i * G + c; if (L >= (NTOK / BM) * XH) return false; u.pm = L >> 2; u.pn = L & 3; return true; }
    __device__ __forceinline__ void ptrs(const Unit& u, const char*& a, const char*& b0, const char*& b1) const {
        a = (const char*)P + ((size_t)u.pm * BM * D + u.pn * XD) * 2; const int b = u.pm / (SEQ / BM);
        b0 = (const char*)VT + ((size_t)b * D + u.pn * XD) * MEM * 2; b1 = b0 + (size_t)HALF * MEM * 2; }
};
struct EpiSoftmax {
    static constexpr bool PERM = true, HAS_MID = false; int mid_t;
    bf16_t* P; PG8_LAS float* xch;
    __device__ __forceinline__ void mid(f32x4 (&)[2][2][4][2], const Unit&, int, int, int, int) const {}
    __device__ __forceinline__ void operator()(f32x4 (&acc)[2][2][4][2], const Unit& u, int wr, int wc, int fr, int fq) const {
        PG8_LAS float* xm = xch; PG8_LAS float* xs = xch + 1024;
#pragma unroll
        for (int ai = 0; ai < 2; ++ai)
#pragma unroll
            for (int m = 0; m < 4; ++m) { float mx = -INFINITY;
#pragma unroll
                for (int bj = 0; bj < 2; ++bj)
#pragma unroll
                    for (int n = 0; n < 2; ++n) { const f32x4 v = acc[ai][bj][m][n]; mx = fmaxf(mx, fmaxf(fmaxf(v[0], v[1]), fmaxf(v[2], v[3]))); }
                mx = fmaxf(mx, __shfl_xor(mx, 16)); mx = fmaxf(mx, __shfl_xor(mx, 32));
                if (fq == 0) xm[(ai * HALF + wr * 64 + m * 16 + fr) * 4 + wc] = mx; asm volatile("" ::: "memory"); }
        asm volatile("s_waitcnt lgkmcnt(0)" ::: "memory"); __builtin_amdgcn_s_barrier(); asm volatile("" ::: "memory");
#pragma unroll
        for (int ai = 0; ai < 2; ++ai)
#pragma unroll
            for (int m = 0; m < 4; ++m) { const int rl = ai * HALF + wr * 64 + m * 16 + fr; const f32x4 q = *(const PG8_LAS f32x4*)(xm + rl * 4);
                const float mx = fmaxf(fmaxf(q[0], q[1]), fmaxf(q[2], q[3])); float ss = 0.f;
#pragma unroll
                for (int bj = 0; bj < 2; ++bj)
#pragma unroll
                    for (int n = 0; n < 2; ++n) { f32x4 v = acc[ai][bj][m][n];
#pragma unroll
                        for (int e = 0; e < 4; ++e) { v[e] = __builtin_amdgcn_exp2f(v[e] - mx); ss += v[e]; }
                        acc[ai][bj][m][n] = v; }
                ss += __shfl_xor(ss, 16); ss += __shfl_xor(ss, 32);
                if (fq == 0) xs[rl * 4 + wc] = ss; asm volatile("" ::: "memory"); }
        asm volatile("s_waitcnt lgkmcnt(0)" ::: "memory"); __builtin_amdgcn_s_barrier(); asm volatile("" ::: "memory");
        const int row0 = u.pm * BM + wr * 64 + fr, col0 = u.pn * XD + wc * 32 + 8 * fq;
#pragma unroll
        for (int ai = 0; ai < 2; ++ai)
#pragma unroll
            for (int m = 0; m < 4; ++m) { const int rl = ai * HALF + wr * 64 + m * 16 + fr; const f32x4 q = *(const PG8_LAS f32x4*)(xs + rl * 4);
                const float inv = 1.0f / ((q[0] + q[1]) + (q[2] + q[3])); bf16_t* rowp = P + (size_t)(row0 + ai * HALF + m * 16) * D + col0;
#pragma unroll
                for (int bj = 0; bj < 2; ++bj) *(u32x4*)(rowp + bj * HALF) = pack8(acc[ai][bj][m][0] * inv, acc[ai][bj][m][1] * inv); asm volatile("" ::: "memory"); }
    }
};
}
namespace sba {
typedef float f32x16 __attribute__((ext_vector_type(16)));
typedef short s16x4 __attribute__((ext_vector_type(4)));
typedef short v4i16_t __attribute__((ext_vector_type(4)));
typedef __attribute__((address_space(3))) const char* lds_cptr;
constexpr int SLOTB = 8192, L_K = 0, L_V = 2 * SLOTB, L_FLAG = 4 * SLOTB, L_OST = L_FLAG + 256, L_BYTES = L_OST + 8 * 4096;
__device__ __forceinline__ int crow(int r, int hi) { return (r & 3) + 8 * (r >> 2) + 4 * hi; }
__device__ __forceinline__ void glds16(const void* gsrc, unsigned lds_dst) { unsigned keep;
    asm volatile("s_mov_b32 %0, m0\n\ts_mov_b32 m0, %2\n\ts_nop 0\n\tglobal_load_lds_dwordx4 %1, off\n\ts_mov_b32 m0, %0" : "=&s"(keep) : "v"(gsrc), "s"(lds_dst) : "memory"); }
typedef float f32x2_t __attribute__((ext_vector_type(2))); typedef __bf16 bf16x2_t __attribute__((ext_vector_type(2)));
__device__ __forceinline__ unsigned cvtpk(float lo, float hi) { f32x2_t v = {lo, hi}; bf16x2_t b = __builtin_convertvector(v, bf16x2_t); return __builtin_bit_cast(unsigned, b); }
__device__ __forceinline__ s16x4 vtr(lds_cptr p) { return __builtin_bit_cast(s16x4, __builtin_amdgcn_ds_read_tr16_b64_v4i16((__attribute__((address_space(3))) v4i16_t*)p)); }

#define SBA_GROUP(Z, SP, g) do { \
        const float off_ = acc_ + (hi ? 0.f : gp_##SP[g]); acc_ += gs_##SP[g] + gp_##SP[g]; \
        const float c3_ = off_ + SP[4 * (g) + 3], c2_ = c3_ + SP[4 * (g) + 2], c1_ = c2_ + SP[4 * (g) + 1], c0_ = c1_ + SP[4 * (g)]; \
        Z[4 * (g) + 3] = __builtin_amdgcn_exp2f(Z[4 * (g) + 3] - c3_); Z[4 * (g) + 2] = __builtin_amdgcn_exp2f(Z[4 * (g) + 2] - c2_); \
        Z[4 * (g) + 1] = __builtin_amdgcn_exp2f(Z[4 * (g) + 1] - c1_); Z[4 * (g)] = __builtin_amdgcn_exp2f(Z[4 * (g)] - c0_); } while (0)

__device__ __forceinline__ void sb_unit(int b, int h, int qb, const bf16_t* Qs, const bf16_t* Ks, const bf16_t* Vs, bf16_t* YY, float* ssq_s8, const unsigned* kmax, char* shm) {
    int tid_ = threadIdx.x; asm volatile("" : "+v"(tid_));
    const int tid = tid_, lane = tid & 63, r32 = lane & 31, hi = lane >> 5; const int wid = __builtin_amdgcn_readfirstlane(tid >> 6);
    const size_t rowbase = (size_t)b * SEQ; const int q0 = qb * 256;
    const bf16_t* Kh = Ks + rowbase * SBW + h * HD; const bf16_t* Vh = Vs + rowbase * SBW + h * HD;
    const unsigned lds0 = (unsigned)(uintptr_t)shm;
    const lds_cptr shm3 = (lds_cptr)shm;
    const bf16_t* ksrc = Kh + (size_t)lane * SBW + wid * 8;
    const bf16_t* vsrc = Vh + (size_t)(16 * (wid & 3) + (lane >> 2)) * SBW + (wid >> 2) * 32 + (lane & 3) * 8;
    const unsigned kdst = lds0 + L_K + wid * 1024, vdst = lds0 + L_V + wid * 1024;
#define DMA_KV(t, slot) do { glds16(ksrc + (size_t)(t) * 64 * SBW, (unsigned)__builtin_amdgcn_readfirstlane(kdst + (slot))); glds16(vsrc + (size_t)(t) * 64 * SBW, (unsigned)__builtin_amdgcn_readfirstlane(vdst + (slot))); } while (0)
    const lds_cptr kp0 = shm3 + L_K + hi * 1024 + r32 * 16;
    const lds_cptr vp0 = shm3 + L_V + ((lane >> 4) & 1) * 32 + (lane & 3) * 8 + (4 * hi + ((lane & 15) >> 2)) * 64;
    volatile __attribute__((address_space(3))) unsigned* flags = (volatile __attribute__((address_space(3))) unsigned*)(shm3 + L_FLAG);
    int tile = 4 * qb + 3, slot = 0, it = 0;
    DMA_KV(tile, 0);
    const bf16_t* Qw = Qs + (rowbase + q0 + wid * 32 + r32) * SBW + h * HD;
    bf16x8 qr[4];
#pragma unroll
    for (int d0 = 0; d0 < 4; ++d0) qr[d0] = *(const bf16x8*)(Qw + d0 * 16 + hi * 8);
    float qn = 0.f;
#pragma unroll
    for (int d0 = 0; d0 < 4; ++d0)
#pragma unroll
        for (int e = 0; e < 8; ++e) qn += fabsf(bf2f((unsigned short)qr[d0][e]));
    qn += __shfl_xor(qn, 32);
    const float zmax = qn * __uint_as_float(kmax[b * 8 + h]) * 1.01f;
    const int tq = q0 + wid * 32 + r32;
    const int tq_min = q0 + wid * 32, tq_max = tq_min + 31;
    float R = 0.f;
    f32x16 o0 = {}, o1 = {};
    for (;;) {
        const bool has_next = tile > 0;
        if (has_next) { DMA_KV(tile - 1, slot ^ SLOTB); asm volatile("s_waitcnt vmcnt(2)" ::: "memory"); }
        else asm volatile("s_waitcnt vmcnt(0)" ::: "memory");
        __builtin_amdgcn_s_barrier(); asm volatile("" ::: "memory");
        const int kmin = tile * 64;
        if (kmin < tq_max) {
            f32x16 z0, z1;
            {
                const lds_cptr kb = kp0 + slot;
#pragma unroll
                for (int d0 = 0; d0 < 4; ++d0) {
                    const bf16x8 b0 = *(const __attribute__((address_space(3))) bf16x8*)(kb + d0 * 2048);
                    const bf16x8 b1 = *(const __attribute__((address_space(3))) bf16x8*)(kb + d0 * 2048 + 512);
                    if (d0 == 0) { z0 = __builtin_amdgcn_mfma_f32_32x32x16_bf16(b0, qr[0], (f32x16){}, 0, 0, 0); z1 = __builtin_amdgcn_mfma_f32_32x32x16_bf16(b1, qr[0], (f32x16){}, 0, 0, 0); }
                    else { z0 = __builtin_amdgcn_mfma_f32_32x32x16_bf16(b0, qr[d0], z0, 0, 0, 0); z1 = __builtin_amdgcn_mfma_f32_32x32x16_bf16(b1, qr[d0], z1, 0, 0, 0); }
                }
            }
            if (kmin + 63 >= tq_min) {
#pragma unroll
                for (int r = 0; r < 16; ++r) { const int kv = kmin + crow(r, hi); if (kv >= tq) z0[r] = -INFINITY; if (kv + 32 >= tq) z1[r] = -INFINITY; }
            }
            f32x16 s0, s1;
#pragma unroll
            for (int r = 0; r < 16; ++r) { z0[r] = fminf(z0[r], 120.f); z1[r] = fminf(z1[r], 120.f);
                s0[r] = __builtin_amdgcn_logf(1.f + __builtin_amdgcn_exp2f(z0[r])); s1[r] = __builtin_amdgcn_logf(1.f + __builtin_amdgcn_exp2f(z1[r])); }
            float gs_s0[4], gs_s1[4], gp_s0[4], gp_s1[4];
#pragma unroll
            for (int g = 0; g < 4; ++g) { gs_s0[g] = (s0[4 * g] + s0[4 * g + 1]) + (s0[4 * g + 2] + s0[4 * g + 3]); gs_s1[g] = (s1[4 * g] + s1[4 * g + 1]) + (s1[4 * g + 2] + s1[4 * g + 3]); }
#pragma unroll
            for (int g = 0; g < 4; ++g) { gp_s0[g] = __shfl_xor(gs_s0[g], 32); gp_s1[g] = __shfl_xor(gs_s1[g], 32); }
            float acc_ = R;
            SBA_GROUP(z1, s1, 3); SBA_GROUP(z1, s1, 2); SBA_GROUP(z1, s1, 1); SBA_GROUP(z1, s1, 0);
            SBA_GROUP(z0, s0, 3); SBA_GROUP(z0, s0, 2); SBA_GROUP(z0, s0, 1); SBA_GROUP(z0, s0, 0);
            R = acc_;
            u32x4 pw0, pw1, pw2, pw3;
            pw0 = (u32x4){cvtpk(z0[0], z0[1]), cvtpk(z0[2], z0[3]), cvtpk(z0[4], z0[5]), cvtpk(z0[6], z0[7])};
            pw1 = (u32x4){cvtpk(z0[8], z0[9]), cvtpk(z0[10], z0[11]), cvtpk(z0[12], z0[13]), cvtpk(z0[14], z0[15])};
            pw2 = (u32x4){cvtpk(z1[0], z1[1]), cvtpk(z1[2], z1[3]), cvtpk(z1[4], z1[5]), cvtpk(z1[6], z1[7])};
            pw3 = (u32x4){cvtpk(z1[8], z1[9]), cvtpk(z1[10], z1[11]), cvtpk(z1[12], z1[13]), cvtpk(z1[14], z1[15])};
            const lds_cptr vp = vp0 + slot;
#define SBA_PV(O, d0, ks, PW) do { const s16x4 lo_ = vtr(vp + (d0) * 4096 + (ks) * 1024), hi_ = vtr(vp + (d0) * 4096 + (ks) * 1024 + 512); \
                const bf16x8 vf_ = (bf16x8){lo_[0], lo_[1], lo_[2], lo_[3], hi_[0], hi_[1], hi_[2], hi_[3]}; \
                O = __builtin_amdgcn_mfma_f32_32x32x16_bf16(__builtin_bit_cast(bf16x8, PW), vf_, O, 0, 0, 0); } while (0)
            SBA_PV(o0, 0, 0, pw0); SBA_PV(o1, 1, 0, pw0); SBA_PV(o0, 0, 1, pw1); SBA_PV(o1, 1, 1, pw1);
            SBA_PV(o0, 0, 2, pw2); SBA_PV(o1, 1, 2, pw2); SBA_PV(o0, 0, 3, pw3); SBA_PV(o1, 1, 3, pw3);
#undef SBA_PV
        }
        const bool done = __all((zmax - R) < -150.f);
        if (lane == 0) flags[(it & 1) * 8 + wid] = done ? 1u : 0u;
        asm volatile("s_waitcnt lgkmcnt(0)" ::: "memory"); __builtin_amdgcn_s_barrier(); asm volatile("" ::: "memory");
        unsigned alld = 1u;
#pragma unroll
        for (int w = 0; w < 8; ++w) alld &= flags[(it & 1) * 8 + w];
        alld = __builtin_amdgcn_readfirstlane(alld);
        if (!has_next || alld) break;
        --tile; slot ^= SLOTB; ++it;
    }
    asm volatile("s_waitcnt vmcnt(0)" ::: "memory");
    {
        bf16_t* Ow = YY + (rowbase + q0 + wid * 32) * D + RW + h * HD;
        bf16_t* stg = (bf16_t*)(shm + L_OST) + wid * 2048;
#pragma unroll
        for (int r = 0; r < 16; ++r) { const int orow = crow(r, hi); stg[orow * 64 + r32] = (bf16_t)f2bf(o0[r]); stg[orow * 64 + 32 + r32] = (bf16_t)f2bf(o1[r]); }
        asm volatile("s_waitcnt lgkmcnt(0)" ::: "memory");
#pragma unroll
        for (int i = 0; i < 4; ++i) { const int row = i * 8 + (lane >> 3), ch = lane & 7; const u32x4 v = *(const u32x4*)(stg + row * 64 + ch * 8);
            *(u32x4*)(Ow + (size_t)row * D + ch * 8) = v;
            float ss = 0.f;
#pragma unroll
            for (int e = 0; e < 4; ++e) { const float lo = __uint_as_float(v[e] << 16), hh = __uint_as_float(v[e] & 0xffff0000u); ss += lo * lo + hh * hh; }
            ss += __shfl_xor(ss, 1); ss += __shfl_xor(ss, 2); ss += __shfl_xor(ss, 4);
            if (ch == 0) ssq_s8[(rowbase + q0 + wid * 32 + row) * 8 + h] = ss; }
    }
    asm volatile("s_waitcnt lgkmcnt(0)" ::: "memory"); __builtin_amdgcn_s_barrier(); asm volatile("" ::: "memory");
#undef DMA_KV
}
#undef SBA_GROUP
}
namespace lru {
typedef float f32x16 __attribute__((ext_vector_type(16)));
constexpr int XS_ROWS = 67, XS_BYTES = XS_ROWS * 1024  , XC_PITCH = 1040  , XC_OFF = 68608, L_BYTES = XC_OFF + 64 * XC_PITCH;
__device__ __forceinline__ int crow(int r, int hi) { return (r & 3) + 8 * (r >> 2) + 4 * hi; }

struct Weights { bf16x8 wa[2][4], wx[2][4]; float ba[2], bx[2], spl[2]; };
__device__ __forceinline__ void load_weights(Weights& W, int h, int r32, int hi, const float* w_a, const float* b_a, const float* w_x, const float* b_x, const float* lam) {
#pragma unroll
    for (int nt = 0; nt < 2; ++nt) {
#pragma unroll
        for (int s = 0; s < 4; ++s) {
#pragma unroll
            for (int e = 0; e < 8; ++e) { const size_t idx = ((size_t)(h * 64 + 16 * s + 8 * hi + e)) * 64 + 32 * nt + r32;
                W.wa[nt][s][e] = (short)f2bf(w_a[idx]); W.wx[nt][s][e] = (short)f2bf(w_x[idx]); }
        }
        const int c = h * 64 + 32 * nt + r32; W.ba[nt] = b_a[c]; W.bx[nt] = b_x[c];
        const float l = lam[c]; W.spl[nt] = (l > 15.f) ? __expf(-l) : log1pf(__expf(-l));
    }
}

template <bool PASSB>
__device__ __forceinline__ void unit(int b, int chunk, const Weights& W, const bf16_t* XR, const bf16_t* GG, const float* conv_w, const float* conv_b,
                                     float* aggP, float* aggH, const float* ssq_s8, bf16_t* YY, float* fmid, float* fend, unsigned char* shm) {
    int tid_ = threadIdx.x; asm volatile("" : "+v"(tid_));
    const int tid = tid_, lane = tid & 63, r32 = lane & 31, hi = lane >> 5, wid = __builtin_amdgcn_readfirstlane(tid >> 6);
    LAS unsigned char* L = (LAS unsigned char*)shm;
    const int t0 = chunk * 64; const size_t rowbase = (size_t)b * SEQ;
    for (int p = tid; p < XS_ROWS * 64; p += NTHREADS) { const int rr = p >> 6, pc = p & 63, t = t0 - 3 + rr;
        u32x4 v = (u32x4){0u, 0u, 0u, 0u}; if (t >= 0) v = *(const u32x4*)(XR + (rowbase + t) * RW + pc * 8);
        *(LAS u32x4*)(L + rr * 1024 + pc * 16) = v; }
    __syncthreads();
    {
        const int cp = tid & 255, th = tid >> 8, c0 = 2 * cp;
        const float w00 = conv_w[c0], w01 = conv_w[RW + c0], w02 = conv_w[2 * RW + c0], w03 = conv_w[3 * RW + c0], b0 = conv_b[c0];
        const float w10 = conv_w[c0 + 1], w11 = conv_w[RW + c0 + 1], w12 = conv_w[2 * RW + c0 + 1], w13 = conv_w[3 * RW + c0 + 1], b1 = conv_b[c0 + 1];
        const LAS unsigned* xs = (const LAS unsigned*)(L + (th * 32) * 1024 + cp * 4);
        unsigned u0 = xs[0], u1 = xs[256], u2 = xs[512];
        float a0 = __uint_as_float(u0 << 16), a1 = __uint_as_float(u1 << 16), a2 = __uint_as_float(u2 << 16);
        float c0_ = __uint_as_float(u0 & 0xffff0000u), c1_ = __uint_as_float(u1 & 0xffff0000u), c2_ = __uint_as_float(u2 & 0xffff0000u);
#pragma unroll 8
        for (int t = 0; t < 32; ++t) { const unsigned u3 = xs[(t + 3) * 256]; const float a3 = __uint_as_float(u3 << 16), c3_ = __uint_as_float(u3 & 0xffff0000u);
            const float y0 = w00 * a0 + w01 * a1 + w02 * a2 + w03 * a3 + b0, y1 = w10 * c0_ + w11 * c1_ + w12 * c2_ + w13 * c3_ + b1;
            *(LAS unsigned*)(L + XC_OFF + (th * 32 + t) * XC_PITCH + cp * 4) = f2bf(y0) | (f2bf(y1) << 16);
            a0 = a1; a1 = a2; a2 = a3; c0_ = c1_; c1_ = c2_; c2_ = c3_; }
    }
    __syncthreads();
    const int h = wid;
    float Hc[2] = {0.f, 0.f}, Pc[2] = {1.f, 1.f};
    if (PASSB) {
#pragma unroll
        for (int nt = 0; nt < 2; ++nt) { const int c = h * 64 + 32 * nt + r32; const float* pP = aggP + ((size_t)b * 64) * RW + c; const float* pH = aggH + ((size_t)b * 64) * RW + c; float hc = 0.f;
            int ch = 0;
            for (; ch + 8 <= chunk; ch += 8) { float p[8], q[8];
#pragma unroll
                for (int i = 0; i < 8; ++i) { p[i] = pP[(size_t)(ch + i) * RW]; q[i] = pH[(size_t)(ch + i) * RW]; }
#pragma unroll
                for (int i = 0; i < 8; ++i) hc = p[i] * hc + q[i]; }
            for (; ch < chunk; ++ch) hc = pP[(size_t)ch * RW] * hc + pH[(size_t)ch * RW];
            Hc[nt] = hc; }
    }
#pragma unroll
    for (int mt = 0; mt < 2; ++mt) {
        bf16x8 af[4];
#pragma unroll
        for (int s = 0; s < 4; ++s) af[s] = *(const LAS bf16x8*)(L + XC_OFF + (32 * mt + r32) * XC_PITCH + (h * 64 + 16 * s + 8 * hi) * 2);
#pragma unroll
        for (int nt = 0; nt < 2; ++nt) {
            f32x16 ra = {}, ri = {};
#pragma unroll
            for (int s = 0; s < 4; ++s) { ra = __builtin_amdgcn_mfma_f32_32x32x16_bf16(af[s], W.wa[nt][s], ra, 0, 0, 0); ri = __builtin_amdgcn_mfma_f32_32x32x16_bf16(af[s], W.wx[nt][s], ri, 0, 0, 0); }
            const int c = h * 64 + 32 * nt + r32;
#pragma unroll
            for (int r = 0; r < 16; ++r) { const int tok = 32 * mt + crow(r, hi);
                const float xc = bf2f(*(const LAS unsigned short*)(L + XC_OFF + tok * XC_PITCH + c * 2));
                const float rg = 1.f / (1.f + __expf(-(ra[r] + W.ba[nt]))), ig = 1.f / (1.f + __expf(-(ri[r] + W.bx[nt])));
                const float la = -8.0f * rg * W.spl[nt], a = __expf(la);
                ra[r] = a; ri[r] = sqrtf(fmaxf(0.f, 1.f - a * a)) * (ig * xc); }
            float P[4], H[4], Pp[4], Hp[4];
#pragma unroll
            for (int g = 0; g < 4; ++g) { P[g] = (ra[4 * g] * ra[4 * g + 1]) * (ra[4 * g + 2] * ra[4 * g + 3]);
                H[g] = ((ri[4 * g] * ra[4 * g + 1] + ri[4 * g + 1]) * ra[4 * g + 2] + ri[4 * g + 2]) * ra[4 * g + 3] + ri[4 * g + 3]; }
#pragma unroll
            for (int g = 0; g < 4; ++g) { Pp[g] = __shfl_xor(P[g], 32); Hp[g] = __shfl_xor(H[g], 32); }
            float hc = Hc[nt], pc = Pc[nt];
#pragma unroll
            for (int g = 0; g < 4; ++g) { const float P0 = hi ? Pp[g] : P[g], H0 = hi ? Hp[g] : H[g], P1 = hi ? P[g] : Pp[g], H1 = hi ? H[g] : Hp[g];
                const float mid = P0 * hc + H0;
                if (PASSB) { float hh = hi ? mid : hc;
#pragma unroll
                    for (int k = 0; k < 4; ++k) { hh = ra[4 * g + k] * hh + ri[4 * g + k]; const int tok = 32 * mt + 8 * g + 4 * hi + k;
                        *(LAS unsigned short*)(L + tok * 1024 + c * 2) = (unsigned short)f2bf(hh); } }
                hc = P1 * mid + H1; pc = pc * (P0 * P1); }
            Hc[nt] = hc; Pc[nt] = pc;
        }
    }
    if (!PASSB) {
        if (hi == 0) {
#pragma unroll
            for (int nt = 0; nt < 2; ++nt) { const int c = h * 64 + 32 * nt + r32; aggP[((size_t)b * 64 + chunk) * RW + c] = Pc[nt]; aggH[((size_t)b * 64 + chunk) * RW + c] = Hc[nt]; }
        }
        __syncthreads();
    } else {
        __syncthreads();
        for (int i = 0; i < 8; ++i) { const int rr = i * 8 + wid; const size_t row = rowbase + t0 + rr;
            const u32x4 hv = *(const LAS u32x4*)(L + rr * 1024 + lane * 16); const u32x4 gv = *(const u32x4*)(GG + row * RW + lane * 8);
            f32x4 y0, y1;
            y0[0] = __uint_as_float(hv.x << 16) * __uint_as_float(gv.x << 16); y0[1] = __uint_as_float(hv.x & 0xffff0000u) * __uint_as_float(gv.x & 0xffff0000u);
            y0[2] = __uint_as_float(hv.y << 16) * __uint_as_float(gv.y << 16); y0[3] = __uint_as_float(hv.y & 0xffff0000u) * __uint_as_float(gv.y & 0xffff0000u);
            y1[0] = __uint_as_float(hv.z << 16) * __uint_as_float(gv.z << 16); y1[1] = __uint_as_float(hv.z & 0xffff0000u) * __uint_as_float(gv.z & 0xffff0000u);
            y1[2] = __uint_as_float(hv.w << 16) * __uint_as_float(gv.w << 16); y1[3] = __uint_as_float(hv.w & 0xffff0000u) * __uint_as_float(gv.w & 0xffff0000u);
            const float ss = wave_sum(pg8::sq8(y0, y1));
            *(u32x4*)(YY + row * D + lane * 8) = pg8::pack8(y0, y1);
            if (lane == 0) { float s2 = 0.f;
#pragma unroll
                for (int k = 0; k < 8; ++k) s2 += ssq_s8[row * 8 + k];
                const float rrn = 1.0f / sqrtf(ss * (1.f / RW) + EPS), rs = 1.0f / sqrtf(s2 * (1.f / SBW) + EPS); fmid[row] = rrn / rs; fend[row] = rs; } }
        __syncthreads();
    }
}
}
__device__ __forceinline__ void row_prep_x(const float* x, bf16_t* xb, float* rstd0, int row, int lane) {
    const f32x4* xr = (const f32x4*)(x + (size_t)row * D) + lane;
    float s = 0.f; f32x4 v[4];
#pragma unroll
    for (int j = 0; j < 4; ++j) { v[j] = xr[64 * j]; s += v[j].x * v[j].x + v[j].y * v[j].y + v[j].z * v[j].z + v[j].w * v[j].w; }
    s = wave_sum(s);
    if (lane == 0) rstd0[row] = 1.0f / sqrtf(s * (1.f / D) + EPS);
    unsigned long long* o8 = (unsigned long long*)(xb + (size_t)row * D) + lane;
#pragma unroll
    for (int j = 0; j < 4; ++j) o8[64 * j] = (unsigned long long)(f2bf(v[j].x) | (f2bf(v[j].y) << 16)) | ((unsigned long long)(f2bf(v[j].z) | (f2bf(v[j].w) << 16)) << 32);
}
__device__ __forceinline__ void row_prep_mem(const float* m, const float* g, bf16_t* o, int row, int lane) {
    const f32x4* xr = (const f32x4*)(m + (size_t)row * D) + lane;
    float s = 0.f; f32x4 v[4];
#pragma unroll
    for (int j = 0; j < 4; ++j) { v[j] = xr[64 * j]; s += v[j].x * v[j].x + v[j].y * v[j].y + v[j].z * v[j].z + v[j].w * v[j].w; }
    s = wave_sum(s);
    const float r = 1.0f / sqrtf(s * (1.f / D) + EPS);
    unsigned long long* o8 = (unsigned long long*)(o + (size_t)row * D) + lane;
#pragma unroll
    for (int j = 0; j < 4; ++j) { const f32x4 gg = ((const f32x4*)g)[64 * j + lane];
        o8[64 * j] = (unsigned long long)(f2bf(v[j].x * r * gg.x) | (f2bf(v[j].y * r * gg.y) << 16)) | ((unsigned long long)(f2bf(v[j].z * r * gg.z) | (f2bf(v[j].w * r * gg.w) << 16)) << 32); }
}
__device__ __forceinline__ void transpose_item(const float* W, int K, int N, bf16_t* Wt, int ldt, const float* g0, const float* g1, int ksplit, LAS float* scr, int item, int lane) {
    const int nblk = N / 32, kb = item / nblk, nb = item % nblk, k0 = 64 * kb, n0 = 32 * nb;
#pragma unroll 8
    for (int i = 0; i < 32; ++i) { const int kk = 2 * i + (lane >> 5), k = k0 + kk; float gv = 1.f; if (g0) gv = (k < ksplit) ? g0[k] : g1[k - ksplit];
        scr[kk * 33 + (lane & 31)] = W[(size_t)k * N + n0 + (lane & 31)] * gv; }
    asm volatile("s_waitcnt lgkmcnt(0)" ::: "memory");
    const int c = lane & 7;
#pragma unroll
    for (int j = 0; j < 4; ++j) { const int n = (lane >> 3) + 8 * j; const LAS float* s = scr + (8 * c) * 33 + n;
        u32x4 o; o.x = f2bf(s[0 * 33]) | (f2bf(s[1 * 33]) << 16); o.y = f2bf(s[2 * 33]) | (f2bf(s[3 * 33]) << 16); o.z = f2bf(s[4 * 33]) | (f2bf(s[5 * 33]) << 16); o.w = f2bf(s[6 * 33]) | (f2bf(s[7 * 33]) << 16);
        *(u32x4*)(Wt + (size_t)(n0 + n) * ldt + k0 + 8 * c) = o; }
    asm volatile("s_waitcnt lgkmcnt(0)" ::: "memory");
}

struct MidScale { const float* f; int k; int pad; };
template <class Epi>
__device__ __forceinline__ void gemm_naive(const Ctx& C, const bf16_t* A, int lda, const bf16_t* Bt, int ldb, int M, int N, int K, MidScale ms, const Epi& E) {
    const int lane = C.lane, fr = lane & 15, fq = lane >> 4, ncol = N / 64, ntile = (M / 16) * ncol;
    for (int t = C.gw; t < ntile; t += C.NGW) {
        const int row0 = (t / ncol) * 16, col0 = (t % ncol) * 64;
        const bf16_t* ap = A + (size_t)(row0 + fr) * lda + fq * 8;
        const bf16_t* bp = Bt + (size_t)(col0 + fr) * ldb + fq * 8;
        f32x4 acc[4];
#pragma unroll
        for (int n = 0; n < 4; ++n) acc[n] = (f32x4){0.f, 0.f, 0.f, 0.f};
        for (int k0 = 0; k0 < K; k0 += 32) {
            if (ms.f && k0 == ms.k) {
#pragma unroll
                for (int j = 0; j < 4; ++j) { const float f = ms.f[row0 + fq * 4 + j];
#pragma unroll
                    for (int n = 0; n < 4; ++n) acc[n][j] *= f; }
            }
            const bf16x8 a = *(const bf16x8*)(ap + k0);
#pragma unroll
            for (int n = 0; n < 4; ++n) { const bf16x8 b = *(const bf16x8*)(bp + (size_t)n * 16 * ldb + k0); acc[n] = __builtin_amdgcn_mfma_f32_16x16x32_bf16(a, b, acc[n], 0, 0, 0); }
        }
#pragma unroll
        for (int n = 0; n < 4; ++n)
#pragma unroll
            for (int j = 0; j < 4; ++j) E(row0 + fq * 4 + j, col0 + n * 16 + fr, acc[n][j]);
    }
}
struct EpiInProj { const float* rstd0; bf16_t *XR, *GG, *Qs, *Ks, *Vs;
    __device__ void operator()(int r, int c, float v) const { v *= rstd0[r]; const int t = c >> 9, cc = c & 511;
        if (t == 0) XR[(size_t)r * RW + cc] = (bf16_t)f2bf(v);
        else if (t == 1) GG[(size_t)r * RW + cc] = (bf16_t)f2bf(gelu_tanh(v));
        else if (t == 2) Qs[(size_t)r * SBW + cc] = (bf16_t)f2bf(v * (0.125f * LOG2E));
        else if (t == 3) Ks[(size_t)r * SBW + cc] = (bf16_t)f2bf(v);
        else Vs[(size_t)r * SBW + cc] = (bf16_t)f2bf(v); } };
struct EpiStoreBf16 { bf16_t* O; const float* rowscale; int ldo; float scale;
    __device__ void operator()(int r, int c, float v) const { O[(size_t)r * ldo + c] = (bf16_t)f2bf(v * (rowscale ? rowscale[r] : 1.f) * scale); } };
struct EpiResF32 { const float* base; const float* rowscale; bf16_t* O;
    __device__ void operator()(int r, int c, float v) const { O[(size_t)r * D + c] = (bf16_t)f2bf(base[(size_t)r * D + c] + v * rowscale[r]); } };
struct EpiResBf16 { const bf16_t* base; bf16_t* O;
    __device__ void operator()(int r, int c, float v) const { O[(size_t)r * D + c] = (bf16_t)f2bf(bf2f(base[(size_t)r * D + c]) + v); } };

__device__ __forceinline__ void lru_naive_unit(int unit, int j, LAS float* xs, const bf16_t* XR, const bf16_t* GG, const float* conv_w, const float* conv_b,
                                               const float* w_a, const float* b_a, const float* w_x, const float* b_x, const float* lam, bf16_t* YY) {
    const int b = unit >> 3, h = unit & 7, c = h * 64 + j;
    float wa[64], wx[64];
#pragma unroll
    for (int i = 0; i < 64; ++i) { wa[i] = w_a[(size_t)(h * 64 + i) * 64 + j]; wx[i] = w_x[(size_t)(h * 64 + i) * 64 + j]; }
    const float ba = b_a[c], bx = b_x[c], cw0 = conv_w[c], cw1 = conv_w[RW + c], cw2 = conv_w[2 * RW + c], cw3 = conv_w[3 * RW + c], cb = conv_b[c];
    const float l = lam[c], spl = (l > 15.f) ? __expf(-l) : log1pf(__expf(-l));
    float x0 = 0.f, x1 = 0.f, x2 = 0.f, hst = 0.f;
    for (int t = 0; t < SEQ; ++t) {
        const size_t row = (size_t)b * SEQ + t;
        const float x3 = bf2f(XR[row * RW + c]);
        const float xc = cw0 * x0 + cw1 * x1 + cw2 * x2 + cw3 * x3 + cb;
        x0 = x1; x1 = x2; x2 = x3;
        asm volatile("s_waitcnt lgkmcnt(0)" ::: "memory"); xs[j] = xc; asm volatile("s_waitcnt lgkmcnt(0)" ::: "memory");
        float ra = ba, ri = bx;
#pragma unroll
        for (int i = 0; i < 64; ++i) { const float xv = xs[i]; ra += xv * wa[i]; ri += xv * wx[i]; }
        const float r = sigmoidf_(ra), ig = sigmoidf_(ri);
        const float log_a = -8.0f * r * spl, a = __expf(log_a), bb = sqrtf(fmaxf(0.f, -expm1f(2.f * log_a))) * (ig * xc);
        hst = a * hst + bb;
        YY[row * D + c] = (bf16_t)f2bf(hst * bf2f(GG[row * RW + c]));
    }
}
__device__ __forceinline__ void sb_naive_unit(int unit, int lane, const bf16_t* Qs, const bf16_t* Ks, const bf16_t* Vs, bf16_t* YY, float* ssq_s8) {
    const int qb = unit & 63, h = (unit >> 6) & 7, b = unit >> 9;
    const int t = qb * 64 + lane; const size_t row = (size_t)b * SEQ + t;
    float q[64], o[64];
#pragma unroll
    for (int d = 0; d < 64; ++d) { q[d] = bf2f(Qs[row * SBW + h * 64 + d]); o[d] = 0.f; }
    float R = 0.f;
    for (int s = qb * 64 + 62; s >= 0; --s) {
        const bf16_t* kr = Ks + ((size_t)b * SEQ + s) * SBW + h * 64; const bf16_t* vr = Vs + ((size_t)b * SEQ + s) * SBW + h * 64;
        float z = 0.f;
#pragma unroll
        for (int d = 0; d < 64; ++d) z += q[d] * bf2f(kr[d]);
        const bool valid = s < t;
        const float sp = valid ? (fmaxf(z, 0.f) + __log2f(1.f + exp2f(-fabsf(z)))) : 0.f;
        const float w = valid ? exp2f(z - (R + sp)) : 0.f;
        R += sp;
        const float wb = bf2f((bf16_t)f2bf(w));
#pragma unroll
        for (int d = 0; d < 64; ++d) o[d] += wb * bf2f(vr[d]);
    }
    float ss = 0.f;
#pragma unroll
    for (int d = 0; d < 64; ++d) { ss += o[d] * o[d]; YY[row * D + RW + h * 64 + d] = (bf16_t)f2bf(o[d]); }
    ssq_s8[row * 8 + h] = ss;
}
__device__ __forceinline__ void xattn_naive_unit(int unit, int j, LAS float* qs, LAS float* ps, const bf16_t* QX, const bf16_t* KVM, bf16_t* OX) {
    const int tg = unit & 511, h = (unit >> 9) & 3, b = unit >> 11, lane = j & 63, wid = j >> 6;
    const size_t row0 = (size_t)b * SEQ + tg * 8;
    for (int i = 0; i < 8; ++i) qs[i * 256 + j] = bf2f(QX[(row0 + i) * D + h * XD + j]);
    __syncthreads();
    const bf16_t* kr = KVM + ((size_t)b * MEM + j) * 2048 + h * XD;
    float sc[8];
#pragma unroll
    for (int i = 0; i < 8; ++i) sc[i] = 0.f;
    for (int d = 0; d < XD; ++d) { const float kv = bf2f(kr[d]);
#pragma unroll
        for (int i = 0; i < 8; ++i) sc[i] += qs[i * 256 + d] * kv; }
#pragma unroll
    for (int i = 0; i < 8; ++i) ps[i * 256 + j] = sc[i];
    __syncthreads();
    for (int i = wid * 2; i < wid * 2 + 2; ++i) {
        float v0 = ps[i * 256 + lane], v1 = ps[i * 256 + lane + 64], v2 = ps[i * 256 + lane + 128], v3 = ps[i * 256 + lane + 192];
        float m = fmaxf(fmaxf(v0, v1), fmaxf(v2, v3));
#pragma unroll
        for (int o = 1; o < 64; o <<= 1) m = fmaxf(m, __shfl_xor(m, o));
        v0 = exp2f(v0 - m); v1 = exp2f(v1 - m); v2 = exp2f(v2 - m); v3 = exp2f(v3 - m);
        const float s = wave_sum(v0 + v1 + v2 + v3), inv = 1.f / s;
        ps[i * 256 + lane] = v0 * inv; ps[i * 256 + lane + 64] = v1 * inv; ps[i * 256 + lane + 128] = v2 * inv; ps[i * 256 + lane + 192] = v3 * inv;
    }
    __syncthreads();
    float o[8];
#pragma unroll
    for (int i = 0; i < 8; ++i) o[i] = 0.f;
    for (int m = 0; m < MEM; ++m) { const float vv = bf2f(KVM[((size_t)b * MEM + m) * 2048 + 1024 + h * XD + j]);
#pragma unroll
        for (int i = 0; i < 8; ++i) o[i] += ps[i * 256 + m] * vv; }
#pragma unroll
    for (int i = 0; i < 8; ++i) OX[(row0 + i) * D + h * XD + j] = (bf16_t)f2bf(o[i]);
    __syncthreads();
}
__device__ __forceinline__ int router_row(int row, int lane, const bf16_t* X2b, const float* ssq2p, const float* g, const float* wgr, const float* bgr, const float* wer, const float* ber, float* selw) {
    int cls = 0;
    float acc[20];
#pragma unroll
    for (int i = 0; i < 20; ++i) acc[i] = 0.f;
    const float rs = pg8::rstd16(ssq2p + (size_t)row * 16);
    for (int kk = 0; kk < 16; ++kk) { const int k = kk * 64 + lane; const float t = bf2f(X2b[(size_t)row * D + k]) * rs * g[k];
#pragma unroll
        for (int i = 0; i < 4; ++i) acc[i] += t * wgr[k * 4 + i];
#pragma unroll
        for (int gi = 0; gi < 4; ++gi)
#pragma unroll
            for (int e = 0; e < 4; ++e) acc[4 + gi * 4 + e] += t * wer[((size_t)gi * D + k) * 4 + e]; }
#pragma unroll
    for (int i = 0; i < 20; ++i) acc[i] = wave_sum(acc[i]);
    if (lane == 0) {
        float gl[4]; float gm = -INFINITY; int gi = 0;
#pragma unroll
        for (int i = 0; i < 4; ++i) { gl[i] = acc[i] + bgr[i]; if (gl[i] > gm) { gm = gl[i]; gi = i; } }
        float gs = 0.f;
#pragma unroll
        for (int i = 0; i < 4; ++i) gs += __expf(gl[i] - gm);
        const float gp = 1.f / gs;
        float el[4];
#pragma unroll
        for (int e = 0; e < 4; ++e) { float v = 0.f;
#pragma unroll
            for (int q = 0; q < 4; ++q) if (q == gi) v = acc[4 + q * 4 + e] + ber[q * 4 + e];
            el[e] = v; }
        int e1 = 0; float m1 = el[0];
#pragma unroll
        for (int e = 1; e < 4; ++e) if (el[e] > m1) { m1 = el[e]; e1 = e; }
        int e2 = -1; float m2 = -INFINITY;
#pragma unroll
        for (int e = 0; e < 4; ++e) if (e != e1 && el[e] > m2) { m2 = el[e]; e2 = e; }
        const float p2 = __expf(m2 - m1), w1 = gp / (1.f + p2), w2 = gp * p2 / (1.f + p2);
        const int ea = e1 < e2 ? e1 : e2, eb = e1 < e2 ? e2 : e1; const float wA = e1 < e2 ? w1 : w2, wB = e1 < e2 ? w2 : w1;
        const int pr = (ea == 0) ? eb - 1 : (ea == 1) ? eb + 1 : 5;
        selw[(size_t)row * 2] = wA; selw[(size_t)row * 2 + 1] = wB; cls = gi * 6 + pr;
    }
    return cls;
}
__device__ __forceinline__ void final_row(int row, int lane, const bf16_t* X3b, const float* ssq3, const float* g, float* out) {
    float v[16]; float s = 0.f;
#pragma unroll
    for (int j = 0; j < 16; ++j) { v[j] = bf2f(X3b[(size_t)row * D + j * 64 + lane]); s += v[j] * v[j]; }
    const float r = pg8::rstd16(ssq3 + (size_t)row * 16);
#pragma unroll
    for (int j = 0; j < 16; ++j) out[(size_t)row * D + j * 64 + lane] = v[j] * r * g[j * 64 + lane];
}

__device__ __forceinline__ void reids(Ctx& C) { int t_ = threadIdx.x; asm volatile("" : "+v"(t_)); C.tid = t_; C.lane = t_ & 63; C.wave = __builtin_amdgcn_readfirstlane(t_ >> 6); C.gw = C.bid * NWAVES + C.wave; }
__global__ void __launch_bounds__(NTHREADS, 2) mk_fwd(Args args) {
    extern __shared__ __attribute__((aligned(16))) unsigned char lds[];
    cg::grid_group grid = cg::this_grid();
    Ctx C;
#pragma unroll
    for (int i = 0; i < 29; ++i) C.in[i] = args.in[i];
    C.out = args.out; C.ws = args.ws; C.lds = lds;
    C.tid = threadIdx.x; C.lane = C.tid & 63; C.wave = __builtin_amdgcn_readfirstlane(C.tid >> 6);
    C.G = gridDim.x; C.bid = blockIdx.x; C.gw = C.bid * NWAVES + C.wave; C.NGW = C.G * NWAVES;
    const float* x = C.in[0]; const float* mem = C.in[1]; const float* norm_mix = C.in[2]; const float* w_in = C.in[3];
    const float* conv_w = C.in[4]; const float* conv_b = C.in[5]; const float* lru_w_a = C.in[6]; const float* lru_b_a = C.in[7];
    const float* lru_w_x = C.in[8]; const float* lru_b_x = C.in[9]; const float* lru_lambda = C.in[10];
    const float* norm_rnn = C.in[11]; const float* norm_sb = C.in[12]; const float* w_out = C.in[13];
    const float* norm_xattn = C.in[14]; const float* norm_mem = C.in[15];
    const float* xa_w_q = C.in[16]; const float* xa_w_k = C.in[17]; const float* xa_w_v = C.in[18]; const float* xa_w_o = C.in[19];
    const float* norm_moe = C.in[20]; const float* w_gr = C.in[21]; const float* b_gr = C.in[22]; const float* w_er = C.in[23]; const float* b_er = C.in[24];
    const float* w_gate = C.in[25]; const float* w_up = C.in[26]; const float* w_down = C.in[27]; const float* norm_final = C.in[28];
    unsigned char* ws = C.ws; float* out = C.out;
    float* sm = (float*)(ws + WS_SMALL);
    float* rstd0 = sm + SM_RSTD0; float* ssq_r = sm + SM_SSQR; float* ssq_s = sm + SM_SSQS; float* ssq1 = sm + SM_SSQ1; float* ssq2 = sm + SM_SSQ2; unsigned* kmax = (unsigned*)(ws + WS_CTL); float* fmid = sm + SM_END; float* fend = fmid + 32768;
    float* aggP = sm + 96 * 32768; float* aggH = sm + 104 * 32768;
    float* selw = sm + SM_SELW; float* ssq3 = sm + SM_SSQ3; int* gcnt = (int*)(ws + WS_CTL + 1024);
    int* tlist = (int*)(sm + 64 * 32768); float* rsg = sm + 88 * 32768; float* wAg = rsg + 40960; float* wBg = wAg + 40960; int* tokg = (int*)(wBg + 40960);
    bf16_t* Wg_t = (bf16_t*)(ws + WS_WG); bf16_t* Wu_t = (bf16_t*)(ws + WS_WU); bf16_t* Wd2 = (bf16_t*)(ws + WS_WD2); bf16_t* XG = (bf16_t*)(ws + WS_R1); bf16_t* HID = (bf16_t*)(ws + WS_R5);
    bf16_t* Win_t = (bf16_t*)(ws + WS_WIN); bf16_t* Wout_t = (bf16_t*)(ws + WS_WOUT); bf16_t* Wq_t = (bf16_t*)(ws + WS_WQ); bf16_t* Wkv_t = (bf16_t*)(ws + WS_WKV); bf16_t* Wo_t = (bf16_t*)(ws + WS_WO);
    bf16_t* memn = (bf16_t*)(ws + WS_MEMN); bf16_t* KM = (bf16_t*)(ws + WS_KVM); bf16_t* VT = KM + (size_t)NMEM * D;
    bf16_t* xb = (bf16_t*)(ws + WS_R0); bf16_t* X1b = xb; bf16_t* X3b = xb;
    bf16_t* XR = (bf16_t*)(ws + WS_R1); bf16_t* GG = XR + (size_t)NTOK * RW; bf16_t* QX = XR;
    bf16_t* Qs = (bf16_t*)(ws + WS_R2); bf16_t* Ks = Qs + (size_t)NTOK * SBW; bf16_t* OX = Qs;
    bf16_t* Vs = (bf16_t*)(ws + WS_R3);
    bf16_t* YY = (bf16_t*)(ws + WS_R4); bf16_t* X2b = YY;
    const int NGW = C.NGW;
#define gw C.gw
#define lane C.lane
#define GRID_SYNC() do { grid.sync(); reids(C); } while (0)

    {
        if (gw == 0) { kmax[lane] = 0u; if (lane < 32) gcnt[lane] = 0; }
        for (int r = gw; r < NTOK; r += NGW) row_prep_x(x, xb, rstd0, r, lane);
        for (int r = gw; r < NMEM; r += NGW) row_prep_mem(mem, norm_mem, memn, r, lane);
        LAS float* scr = (LAS float*)(lds) + C.wave * (64 * 33);
        constexpr int I_IN = (D / 64) * (PROJ / 32), I_SQ = (D / 64) * (D / 32);
        for (int it = gw; it < I_IN + 5 * I_SQ; it += NGW) {
            int r = it;
            if (r < I_IN) { transpose_item(w_in, D, PROJ, Win_t, D, norm_mix, norm_mix, D, scr, r, lane); continue; } r -= I_IN;
            if (r < I_SQ) { transpose_item(w_out, D, D, Wout_t, D, norm_rnn, norm_sb, RW, scr, r, lane); continue; } r -= I_SQ;
            if (r < I_SQ) { transpose_item(xa_w_q, D, D, Wq_t, D, norm_xattn, norm_xattn, D, scr, r, lane); continue; } r -= I_SQ;
            if (r < I_SQ) { transpose_item(xa_w_k, D, D, Wkv_t, D, nullptr, nullptr, 0, scr, r, lane); continue; } r -= I_SQ;
            if (r < I_SQ) { transpose_item(xa_w_v, D, D, Wkv_t + (size_t)D * D, D, nullptr, nullptr, 0, scr, r, lane); continue; } r -= I_SQ;
            transpose_item(xa_w_o, D, D, Wo_t, D, nullptr, nullptr, 0, scr, r, lane);
        }
        constexpr int I_GU = (D / 64) * (DE / 32), I_DN = (DE / 64) * (D / 32);
        for (int it = gw; it < 32 * I_GU + 48 * I_DN; it += NGW) {
            int r = it;
            if (r < 16 * I_GU) { const int e = r / I_GU; transpose_item(w_gate + (size_t)e * D * DE, D, DE, Wg_t + (size_t)e * DE * D, D, norm_moe, norm_moe, D, scr, r % I_GU, lane); continue; } r -= 16 * I_GU;
            if (r < 16 * I_GU) { const int e = r / I_GU; transpose_item(w_up + (size_t)e * D * DE, D, DE, Wu_t + (size_t)e * DE * D, D, norm_moe, norm_moe, D, scr, r % I_GU, lane); continue; } r -= 16 * I_GU;
            { const int cs = r / I_DN, cls = cs >> 1, slot = cs & 1; int ea, eb; pg8::pair_ab(cls % 6, ea, eb); const int e = (cls / 6) * 4 + (slot ? eb : ea);
              transpose_item(w_down + (size_t)e * DE * D, DE, D, Wd2 + (size_t)cls * D * 512 + slot * DE, 512, nullptr, nullptr, 0, scr, r % I_DN, lane); }
        }
    }
    GRID_SYNC();
    { pg8::DenseOrder S; S.init(xb, D, Win_t, D, NTOK, PROJ, C.G, C.bid); pg8::EpiInProjF E{0, rstd0, XR, GG, Qs, Ks, Vs, kmax};
      pg8::gemm_phase<pg8::EpiInProjF, pg8::DenseOrder, true>((LAS unsigned char*)lds, pg8::Gemm{D, D, D}, S, E); }
    { pg8::DenseOrder S; S.init(memn, D, Wkv_t, D, NMEM, D, C.G, C.bid); pg8::EpiBf16F E{0, KM, nullptr, D, 1.f, 0};
      pg8::gemm_phase<pg8::EpiBf16F, pg8::DenseOrder, true>((LAS unsigned char*)lds, pg8::Gemm{D, D, D}, S, E); }
    { pg8::DenseOrder S; S.init(Wkv_t + (size_t)D * D, D, memn, D, D, NMEM, C.G, C.bid); pg8::EpiBf16F E{0, VT, nullptr, MEM, 1.f, (size_t)D * MEM};
      pg8::gemm_phase<pg8::EpiBf16F, pg8::DenseOrder, true>((LAS unsigned char*)lds, pg8::Gemm{D, D, D}, S, E); }
    GRID_SYNC();
    lru::Weights LW; lru::load_weights(LW, C.wave, lane & 31, lane >> 5, lru_w_a, lru_b_a, lru_w_x, lru_b_x, lru_lambda);
    {
        for (int u = C.bid; u < BATCH * 64; u += C.G) lru::unit<false>(u >> 6, u & 63, LW, XR, GG, conv_w, conv_b, aggP, aggH, ssq_s, YY, fmid, fend, lds);
        for (int u = C.bid; u < BATCH * NH * 16; u += C.G) sba::sb_unit(u >> 7, (u >> 4) & 7, 15 - (u & 15), Qs, Ks, Vs, YY, ssq_s, kmax, (char*)lds);
    }
    GRID_SYNC();
    for (int u = C.bid; u < BATCH * 64; u += C.G) lru::unit<true>(u >> 6, u & 63, LW, XR, GG, conv_w, conv_b, aggP, aggH, ssq_s, YY, fmid, fend, lds);
    GRID_SYNC();
    { pg8::DenseOrder S; S.init(YY, D, Wout_t, D, NTOK, D, C.G, C.bid); pg8::EpiX1F E{8, x, fmid, fend, X1b, ssq1};
      pg8::gemm_phase<pg8::EpiX1F, pg8::DenseOrder, true>((LAS unsigned char*)lds, pg8::Gemm{D, D, D}, S, E); }
    GRID_SYNC();
    { pg8::DenseOrder S; S.init(X1b, D, Wq_t, D, NTOK, D, C.G, C.bid); pg8::EpiBf16F E{0, QX, ssq1, D, 0.0625f * LOG2E, 0};
      pg8::gemm_phase<pg8::EpiBf16F, pg8::DenseOrder, true>((LAS unsigned char*)lds, pg8::Gemm{D, D, D}, S, E); }
    GRID_SYNC();
    { pg8::XaSOrder S{QX, KM, C.G, C.bid}; pg8::EpiSoftmax E{0, QX, (LAS float*)(lds + 131072 + 2048)};
      pg8::gemm_phase<pg8::EpiSoftmax, pg8::XaSOrder, true>((LAS unsigned char*)lds, pg8::Gemm{D, D, XD}, S, E); }
    GRID_SYNC();
    { pg8::XaOOrder S{QX, VT, C.G, C.bid}; pg8::EpiBf16F E{0, OX, nullptr, D, 1.f, 0};
      pg8::gemm_phase<pg8::EpiBf16F, pg8::XaOOrder, true>((LAS unsigned char*)lds, pg8::Gemm{D, MEM, MEM}, S, E); }
    GRID_SYNC();
    { pg8::DenseOrder S; S.init(OX, D, Wo_t, D, NTOK, D, C.G, C.bid); pg8::EpiResF E{0, X1b, X2b, ssq2};
      pg8::gemm_phase<pg8::EpiResF, pg8::DenseOrder, true>((LAS unsigned char*)lds, pg8::Gemm{D, D, D}, S, E); }
    GRID_SYNC();
    {
        LAS int* lcnt = (LAS int*)lds; LAS int* lbase = lcnt + 32; LAS int* lcls = lcnt + 64; LAS int* lpos = lcnt + 192;
        for (int chunk = C.bid; chunk < NTOK / 128; chunk += C.G) {
            if (C.tid < 32) lcnt[C.tid] = 0;
            __syncthreads();
            for (int i = 0; i < 16; ++i) { const int lt = C.wave * 16 + i, row = chunk * 128 + lt;
                const int cls = router_row(row, lane, X2b, ssq2, norm_moe, w_gr, b_gr, w_er, b_er, selw);
                if (lane == 0) { lcls[lt] = cls; lpos[lt] = __hip_atomic_fetch_add(lcnt + cls, 1, __ATOMIC_RELAXED, __HIP_MEMORY_SCOPE_WORKGROUP); } }
            __syncthreads();
            if (C.tid < 24) lbase[C.tid] = atomicAdd(gcnt + C.tid, lcnt[C.tid]);
            __syncthreads();
            if (C.tid < 128) { const int c = lcls[C.tid]; tlist[(size_t)c * NTOK + lbase[c] + lpos[C.tid]] = chunk * 128 + C.tid; }
            __syncthreads();
        }
    }
    GRID_SYNC();
    LAS int* meta = (LAS int*)(lds + 131072 + 1024);
    {
        if (C.tid == 0) { int rb = 0, tb = 0;
            for (int c = 0; c < 24; ++c) { const int n = gcnt[c], nt = (n + 255) >> 8; meta[c] = n; meta[32 + c] = rb; meta[64 + c] = tb; rb += nt * 256; tb += nt; }
            meta[32 + 24] = rb; meta[64 + 24] = tb; }
        __syncthreads();
        const int total = meta[32 + 24];
        for (int R = gw; R < total; R += NGW) {
            int c = 0;
            for (int k = 1; k < 24; ++k) c += (R >= meta[32 + k]) ? 1 : 0;
            const int p = R - meta[32 + c]; u32x4 v0 = (u32x4){0u, 0u, 0u, 0u}, v1 = v0; int tok = -1; float rs = 0.f, wA = 0.f, wB = 0.f;
            if (p < meta[c]) { tok = tlist[(size_t)c * NTOK + p]; const u32x4* src = (const u32x4*)(X2b + (size_t)tok * D) + lane; v0 = src[0]; v1 = src[64];
                rs = pg8::rstd16(ssq2 + (size_t)tok * 16); wA = selw[(size_t)tok * 2]; wB = selw[(size_t)tok * 2 + 1]; }
            u32x4* dst = (u32x4*)(XG + (size_t)R * D) + lane; dst[0] = v0; dst[64] = v1;
            if (lane == 0) { rsg[R] = rs; wAg[R] = wA; wBg[R] = wB; tokg[R] = tok; }
        }
    }
    GRID_SYNC();
    { pg8::MoeOrder1 S{XG, Wg_t, Wu_t, meta, C.G, C.bid}; pg8::EpiMoeUp E{0, rsg, wAg, wBg, HID};
      pg8::gemm_phase<pg8::EpiMoeUp, pg8::MoeOrder1, true>((LAS unsigned char*)lds, pg8::Gemm{D, D, D}, S, E); }
    GRID_SYNC();
    { pg8::MoeOrder2 S{HID, Wd2, meta, C.G, C.bid}; pg8::EpiMoeDown E{0, tokg, X2b, X3b, ssq3};
      pg8::gemm_phase<pg8::EpiMoeDown, pg8::MoeOrder2, true>((LAS unsigned char*)lds, pg8::Gemm{512, 512, 512}, S, E); }
    GRID_SYNC();
    for (int r = gw; r < NTOK; r += NGW) final_row(r, lane, X3b, ssq3, norm_final, out);
}

#undef gw
#undef lane
extern "C" void kernel_launch(void* const* d_in, const int* in_sizes, int n_in, void* d_out, int out_size, void* d_ws, size_t ws_size, hipStream_t stream) {
    static int grid = 0;
    if (grid == 0) {
        if (n_in != 29 || ws_size < WS_END) { fprintf(stderr, "kernel_launch: unexpected inputs (%d) or workspace (%zu)\n", n_in, ws_size); grid = -1; return; }
        int dev = 0, cus = 0, per_cu = 0;
        hipGetDevice(&dev); hipDeviceGetAttribute(&cus, hipDeviceAttributeMultiprocessorCount, dev);
        hipFuncSetAttribute((const void*)mk_fwd, hipFuncAttributeMaxDynamicSharedMemorySize, LDS_BYTES);
        hipOccupancyMaxActiveBlocksPerMultiprocessor(&per_cu, (const void*)mk_fwd, NTHREADS, LDS_BYTES);
        if (per_cu < 1) { fprintf(stderr, "kernel_launch: occupancy query says %d blocks per CU\n", per_cu); per_cu = 1; }
        if (per_cu > 1) per_cu = 1;
        grid = cus * per_cu;
    }
    if (grid < 0) return;
    Args a{};
    for (int i = 0; i < 29; ++i) a.in[i] = (const float*)d_in[i];
    a.out = (float*)d_out; a.ws = (unsigned char*)d_ws;
    void* kargs[] = {&a};
    hipError_t e = hipLaunchCooperativeKernel((const void*)mk_fwd, dim3(grid), dim3(NTHREADS), kargs, LDS_BYTES, stream);
    if (e != hipSuccess) fprintf(stderr, "cooperative launch failed: %s (grid %d)\n", hipGetErrorString(e), grid);
}
```

```cpp
#include <hip/hip_runtime.h>
#include <hip/hip_cooperative_groups.h>
#include <cstdio>
#include <cstdint>

typedef unsigned short bf16_t;
typedef short bf16x8 __attribute__((ext_vector_type(8)));
typedef float f32x4 __attribute__((ext_vector_type(4)));
typedef unsigned u32x4 __attribute__((ext_vector_type(4)));

constexpr int D = 1024, BATCH = 8, SEQ = 4096, NTOK = BATCH * SEQ, MEM = 256, NMEM = BATCH * MEM;
constexpr int RW = 512, SBW = 512, PROJ = 2560, NH = 8, HD = 64;
constexpr int XH = 4, XD = 256, NG = 4, EPG = 4, NEXP = 16, DE = 256;
constexpr float EPS = 1e-6f, LOG2E = 1.4426950408889634f;

constexpr size_t MiB = 1u << 20;
constexpr size_t WS_CTL = 0;
constexpr size_t WS_SMALL = 1 * MiB;
constexpr size_t WS_WIN = 16 * MiB;
constexpr size_t WS_WOUT = 21 * MiB;
constexpr size_t WS_WQ = 23 * MiB;
constexpr size_t WS_WKV = 25 * MiB;
constexpr size_t WS_WO = 29 * MiB;
constexpr size_t WS_MEMN = 31 * MiB;
constexpr size_t WS_KVM = 35 * MiB;
constexpr size_t WS_WG = 43 * MiB;
constexpr size_t WS_WU = 51 * MiB;
constexpr size_t WS_WD2 = 59 * MiB;
constexpr size_t WS_R0 = 96 * MiB;
constexpr size_t WS_R1 = 160 * MiB;
constexpr size_t WS_R2 = 224 * MiB;
constexpr size_t WS_R3 = 288 * MiB;
constexpr size_t WS_R4 = 320 * MiB;
constexpr size_t WS_R5 = 384 * MiB;
constexpr size_t WS_END = 448 * MiB;

constexpr size_t SM_RSTD0 = 0;
constexpr size_t SM_SSQR = 1 * 32768;
constexpr size_t SM_SSQS = 2 * 32768;
constexpr size_t SM_SSQ1 = 10 * 32768;
constexpr size_t SM_SSQ2 = 26 * 32768;
constexpr size_t SM_SSQ3 = 42 * 32768;
constexpr size_t SM_SELW = 58 * 32768;
constexpr size_t SM_SELE = 60 * 32768;
constexpr size_t SM_END = 62 * 32768;

__device__ __forceinline__ unsigned f2bf(float f) { unsigned u = __builtin_bit_cast(unsigned, f); return (u + 0x7fffu + ((u >> 16) & 1u)) >> 16; }
__device__ __forceinline__ float bf2f(unsigned short h) { return __builtin_bit_cast(float, (unsigned)h << 16); }
__device__ __forceinline__ float wave_sum(float v) {
#pragma unroll
    for (int o = 1; o < 64; o <<= 1) v += __shfl_xor(v, o);
    return v;
}
__device__ __forceinline__ float gelu_tanh(float x) { const float u = 0.7978845608028654f * (x + 0.044715f * x * x * x); return x / (1.f + __expf(-2.f * u)); }
__device__ __forceinline__ float sigmoidf_(float x) { return 1.f / (1.f + __expf(-x)); }

namespace cg = cooperative_groups;
#define LAS __attribute__((address_space(3)))
constexpr int NWAVES = 8, NTHREADS = 512;
constexpr int LDS_BYTES = 147456;

struct Args { const float* in[29]; float* out; unsigned char* ws; };

struct Ctx {
    const float* in[29]; float* out; unsigned char* ws; unsigned char* lds;
    int tid, lane, wave, gw, NGW, G, bid;
};

#define RLX_AGENT __ATOMIC_RELAXED, __HIP_MEMORY_SCOPE_AGENT
#define XB_TMO      128
#define XB_XCNT(j)  (256  + 64 * (j))
#define XB_XSUB(j)  (1280 + 64 * (j))
#define XB_XGEN(j)  (2304 + 64 * (j))
#define XB_TOP      3328
#define XB_TOPGEN   3392
#define XCD_BAR_WORDS 3456
#define XB_SPIN_CAP (1u << 18)

__device__ __forceinline__ unsigned xb_ld(unsigned* p)              { return __hip_atomic_load(p, __ATOMIC_RELAXED, __HIP_MEMORY_SCOPE_AGENT); }
__device__ __forceinline__ unsigned xb_add(unsigned* p, unsigned v) { return __hip_atomic_fetch_add(p, v, __ATOMIC_RELAXED, __HIP_MEMORY_SCOPE_AGENT); }
__device__ __forceinline__ unsigned xb_xcc_id() { return (unsigned)__builtin_amdgcn_s_getreg((3 << 11) | 20) & 0xFu; }
#define XB_SPIN(cond, bar) do { unsigned _sp = 0; while (cond) { __builtin_amdgcn_s_sleep(1); \
    if ((++_sp & 255u) == 0u) { if (xb_ld(&(bar)[XB_TMO])) break; if (_sp > XB_SPIN_CAP) { atomicAdd(&(bar)[XB_TMO], 1u); break; } } } } while (0)

struct XcdBarrier {
    unsigned* bar; unsigned x;
    volatile LAS unsigned* st;
};

__device__ __forceinline__ XcdBarrier xcd_barrier_post(unsigned* bar, volatile LAS unsigned* st) {
    XcdBarrier b; b.bar = bar; b.x = xb_xcc_id(); b.st = st;
    if (threadIdx.x == 0) (void)xb_add(&bar[XB_XCNT(b.x)], 1u);
    return b;
}
__device__ __forceinline__ void xcd_barrier_complete(unsigned* bar, unsigned x, unsigned& nloc, unsigned& nx) {
    const unsigned G = gridDim.x * gridDim.y * gridDim.z;
    unsigned sum, cnt, mine, sp = 0u;
    for (;;) {
        sum = 0u; cnt = 0u; mine = 0u;
#pragma unroll
        for (unsigned j = 0; j < 16; ++j) { const unsigned c = xb_ld(&bar[XB_XCNT(j)]); sum += c; cnt += (c > 0u) ? 1u : 0u; mine = (j == x) ? c : mine; }
        if (sum == G) break;
        __builtin_amdgcn_s_sleep(1);
        if ((++sp & 255u) == 0u) { if (xb_ld(&bar[XB_TMO])) break; if (sp > XB_SPIN_CAP) { atomicAdd(&bar[XB_TMO], 1u); break; } }
    }
    nloc = mine > 0u ? mine : 1u; nx = cnt > 0u ? cnt : 1u;
}

__device__ __forceinline__ void xcd_barrier(const XcdBarrier& b) {
    asm volatile("s_waitcnt vmcnt(0)" ::: "memory");
    __syncthreads();
    if (threadIdx.x == 0) {
        unsigned* bar = b.bar;
        __builtin_amdgcn_s_waitcnt(0);
        unsigned nloc = b.st[0], nx = b.st[1];
        if (nloc == 0u) { xcd_barrier_complete(bar, b.x, nloc, nx); b.st[0] = nloc; b.st[1] = nx; }
        const unsigned old = xb_add(&bar[XB_XSUB(b.x)], 1u);
        const unsigned gen = old / nloc;
        if (old + 1u == (gen + 1u) * nloc) {
            __builtin_amdgcn_fence(__ATOMIC_RELEASE, "agent");
            asm volatile("s_waitcnt vmcnt(0)" ::: "memory");
            const unsigned og = xb_add(&bar[XB_TOP], 1u);
            const unsigned tg = og / nx;
            if (og + 1u == (tg + 1u) * nx) xb_add(&bar[XB_TOPGEN], 1u);
            else XB_SPIN(xb_ld(&bar[XB_TOPGEN]) == tg, bar);
            __builtin_amdgcn_fence(__ATOMIC_ACQUIRE, "agent");
            xb_add(&bar[XB_XGEN(b.x)], 1u);
            asm volatile("s_waitcnt vmcnt(0)" ::: "memory");
        } else {
            XB_SPIN(xb_ld(&bar[XB_XGEN(b.x)]) == gen, bar);
            __builtin_amdgcn_fence(__ATOMIC_ACQUIRE, "agent");
            asm volatile("s_waitcnt vmcnt(0)" ::: "memory");
        }
    }
    __syncthreads();
}
namespace pg8 {
#define PG8_LAS __attribute__((address_space(3)))
constexpr int BM = 256, BK = 64, HALF = 128, HTB = HALF * BK * 2  , STAGE_BYTES = 8 * HTB, NXCD = 8, WGM = 8;
__host__ __device__ __forceinline__ int lds_byte(int r, int c) { const int st = (r >> 4) * 2 + (c >> 5), rr = r & 15, cc = c & 31, ob = rr * 64 + cc * 2; return st * 1024 + (ob ^ (((ob >> 9) & 1) << 5)); }
__host__ __device__ __forceinline__ void stage_rc(int b, int& R, int& C) { const int st = b / 1024, sb = b % 1024, swz = sb ^ (((sb >> 9) & 1) << 5); R = (st >> 1) * 16 + swz / 64; C = (st & 1) * 32 + (swz % 64) / 2; }
__host__ __device__ __forceinline__ int perm32(int rho) { const int n = rho >> 4, i = rho & 15; return 8 * (i >> 2) + 4 * n + (i & 3); }

struct Unit { int pm, pn; };
struct Gemm { int lda, ldb, K; };
struct DenseOrder {
    const bf16_t* A; const bf16_t* Bt; int lda, ldb; int nM, nN, nwg, G, c;
    __device__ void init(const bf16_t* A_, int lda_, const bf16_t* Bt_, int ldb_, int M, int N, int G_, int c_) { A = A_; Bt = Bt_; lda = lda_; ldb = ldb_; nM = M / BM; nN = N / BM; nwg = nM * nN; G = G_; c = c_; }
    __device__ bool next(int i, Unit& u) const {
        const long L = (long)i * G + c; if (L >= nwg) return false;
        int wgid = (int)L; { const int q = nwg / NXCD, r = nwg % NXCD, xcd = wgid % NXCD, off = wgid / NXCD; wgid = (xcd < r ? xcd * (q + 1) : r * (q + 1) + (xcd - r) * q) + off; }
        const int nig = WGM * nN, gid = wgid / nig, fm = gid * WGM, gsz = (nM - fm) < WGM ? (nM - fm) : WGM;
        u.pm = fm + ((wgid % nig) % gsz); u.pn = (wgid % nig) / gsz; return true;
    }
    __device__ __forceinline__ void ptrs(const Unit& u, const char*& a, const char*& b0, const char*& b1) const {
        a = (const char*)A + (size_t)u.pm * BM * lda * 2; b0 = (const char*)Bt + (size_t)u.pn * BM * ldb * 2; b1 = b0 + (size_t)HALF * ldb * 2; }
};

__device__ __forceinline__ unsigned cvt_pk_bf16(float lo, float hi) { unsigned r; asm volatile("v_cvt_pk_bf16_f32 %0, %1, %2" : "=v"(r) : "v"(lo), "v"(hi)); return r; }

template <class Epi, class Sched, bool ALIGN_EPI>
__device__ __forceinline__ void gemm_phase(PG8_LAS unsigned char* lds, const Gemm g, const Sched& S, const Epi& E) {
    int tid_ = threadIdx.x; asm volatile("" : "+v"(tid_));
    const int tid = tid_, wid = __builtin_amdgcn_readfirstlane(tid >> 6), lane = tid & 63, wr = wid >> 2, wc = wid & 3, fr = lane & 15, fq = lane >> 4;
    int nt_ = g.K / BK; asm volatile("" : "+s"(nt_)); const int nt = nt_;
    unsigned voffA[2], voffB[2];
#pragma unroll
    for (int i = 0; i < 2; ++i) { int R, C; stage_rc(tid * 16 + i * 8192, R, C); const int Rb = Epi::PERM ? ((R & ~31) + perm32(R & 31)) : R;
        voffA[i] = (unsigned)(R * g.lda + C) * 2u; voffB[i] = (unsigned)(Rb * g.ldb + C) * 2u; }
    const size_t kstep = (size_t)(BK * 2);
    const size_t hstepA = (size_t)HALF * g.lda * 2;
    const unsigned ldsw = (unsigned)wid * 1024u;
    const int aoff = lds_byte(wr * 64 + fr, fq * 8), boff = lds_byte(wc * 32 + fr, fq * 8);
#define PG8_SA(b, h) (((b) * 2 + (h)) * HTB)
#define PG8_SB(b, h) ((4 + (b) * 2 + (h)) * HTB)
#define PG8_STAGE(bufoff, gbase, voff) do { _Pragma("unroll") for (int _i = 0; _i < 2; ++_i) \
        __builtin_amdgcn_global_load_lds((const unsigned*)((const char*)(gbase) + (voff)[_i]), (PG8_LAS unsigned*)(lds + (bufoff) + ldsw + _i * 8192), 16, 0, 0); } while (0)
#define PG8_LDA(dst, b, h) do { _Pragma("unroll") for (int m = 0; m < 4; ++m) _Pragma("unroll") for (int k = 0; k < 2; ++k) dst[m][k] = *(const PG8_LAS bf16x8*)(lds + PG8_SA(b, h) + aoff + m * 2048 + k * 1024); } while (0)
#define PG8_LDB(dst, b, h) do { _Pragma("unroll") for (int n = 0; n < 2; ++n) _Pragma("unroll") for (int k = 0; k < 2; ++k) dst[n][k] = *(const PG8_LAS bf16x8*)(lds + PG8_SB(b, h) + boff + n * 2048 + k * 1024); } while (0)
#define PG8_MMA(ai, bj, At, Bt) do { __builtin_amdgcn_s_setprio(1); _Pragma("unroll") for (int m = 0; m < 4; ++m) _Pragma("unroll") for (int n = 0; n < 2; ++n) _Pragma("unroll") for (int k = 0; k < 2; ++k) \
        acc[ai][bj][m][n] = __builtin_amdgcn_mfma_f32_16x16x32_bf16(Bt[n][k], At[m][k], acc[ai][bj][m][n], 0, 0, 0); __builtin_amdgcn_s_setprio(0); } while (0)
#define PG8_WAIT_V(n) asm volatile("s_waitcnt vmcnt(" #n ")" ::: "memory")
#define PG8_WAIT_L(n) asm volatile("s_waitcnt lgkmcnt(" #n ")" ::: "memory")
#define PG8_BAR __builtin_amdgcn_s_barrier()
#define PG8_SCHED __builtin_amdgcn_sched_barrier(0)
    Unit cur, nxt; int ui = 0;
    if (!S.next(0, cur)) return;
    f32x4 acc[2][2][4][2];
#pragma unroll
    for (int a = 0; a < 2; ++a)
#pragma unroll
        for (int b = 0; b < 2; ++b)
#pragma unroll
            for (int m = 0; m < 4; ++m)
#pragma unroll
                for (int n = 0; n < 2; ++n) acc[a][b][m][n] = (f32x4){0.f, 0.f, 0.f, 0.f};
    bf16x8 At[4][2], B0[2][2], B1[2][2];
    const char *cA, *cB0, *cB1; S.ptrs(cur, cA, cB0, cB1);
    PG8_STAGE(PG8_SB(0, 0), cB0, voffB); PG8_STAGE(PG8_SB(0, 1), cB1, voffB); PG8_STAGE(PG8_SA(0, 0), cA, voffA); PG8_STAGE(PG8_SA(0, 1), cA + hstepA, voffA);
    if (wr == 1) PG8_BAR;
    PG8_WAIT_V(2); PG8_BAR;
    PG8_STAGE(PG8_SB(1, 0), cB0 + kstep, voffB); PG8_STAGE(PG8_SA(1, 0), cA + kstep, voffA); PG8_STAGE(PG8_SB(1, 1), cB1 + kstep, voffB);
    PG8_WAIT_V(6); PG8_BAR;
    for (;;) {
        const bool has_next = S.next(ui + 1, nxt);
        const char *nA = cA, *nB0 = cB0, *nB1 = cB1; if (has_next) S.ptrs(nxt, nA, nB0, nB1);
#pragma unroll 1
        for (int t = 0; t < nt; t += 2) {
            const bool last = (t == nt - 2);
            if constexpr (Epi::HAS_MID) { if (t == E.mid_t) E.mid(acc, cur, wr, wc, fr, fq); }
            const char* a1 = cA + (size_t)(t + 1) * kstep;
            const char* a2 = last ? nA : cA + (size_t)(t + 2) * kstep; const char* b2 = last ? nB0 : cB0 + (size_t)(t + 2) * kstep; const char* b2h = last ? nB1 : cB1 + (size_t)(t + 2) * kstep;
            const char* a3 = a2 + kstep; const char* b3 = b2 + kstep; const char* b3h = b2h + kstep;
            PG8_LDB(B0, 0, 0); PG8_LDB(B1, 0, 1); PG8_SCHED; PG8_LDA(At, 0, 0); PG8_STAGE(PG8_SA(1, 1), a1 + hstepA, voffA);
            PG8_WAIT_V(8); PG8_WAIT_L(0); PG8_BAR; PG8_MMA(0, 0, At, B0); PG8_MMA(0, 1, At, B1); PG8_BAR; PG8_SCHED;
            PG8_LDA(At, 0, 1); PG8_STAGE(PG8_SB(0, 0), b2, voffB); PG8_STAGE(PG8_SB(0, 1), b2h, voffB); PG8_STAGE(PG8_SA(0, 0), a2, voffA);
            PG8_WAIT_V(8); PG8_WAIT_L(0); PG8_BAR; PG8_MMA(1, 0, At, B0); PG8_MMA(1, 1, At, B1); PG8_BAR; PG8_SCHED;
            PG8_LDB(B0, 1, 0); PG8_LDB(B1, 1, 1); PG8_SCHED; PG8_LDA(At, 1, 0); PG8_STAGE(PG8_SA(0, 1), a2 + hstepA, voffA);
            PG8_WAIT_V(8); PG8_WAIT_L(0); PG8_BAR; PG8_MMA(0, 0, At, B0); PG8_MMA(0, 1, At, B1); PG8_BAR; PG8_SCHED;
            PG8_LDA(At, 1, 1); PG8_STAGE(PG8_SB(1, 0), b3, voffB); PG8_STAGE(PG8_SB(1, 1), b3h, voffB); PG8_STAGE(PG8_SA(1, 0), a3, voffA);
            PG8_WAIT_V(8); PG8_WAIT_L(0); PG8_BAR; PG8_MMA(1, 0, At, B0); PG8_MMA(1, 1, At, B1); PG8_BAR; PG8_SCHED;
        }
        if constexpr (ALIGN_EPI) { if (wr == 0) PG8_BAR; }
        E(acc, cur, wr, wc, fr, fq);
        if (!has_next) break;
#pragma unroll
        for (int a = 0; a < 2; ++a)
#pragma unroll
            for (int b = 0; b < 2; ++b)
#pragma unroll
                for (int m = 0; m < 4; ++m)
#pragma unroll
                    for (int n = 0; n < 2; ++n) acc[a][b][m][n] = (f32x4){0.f, 0.f, 0.f, 0.f};
        cur = nxt; cA = nA; cB0 = nB0; cB1 = nB1; ++ui;
        if constexpr (ALIGN_EPI) { if (wr == 1) PG8_BAR; }
    }
    PG8_WAIT_V(0);
    if constexpr (!ALIGN_EPI) { if (wr == 0) PG8_BAR; }
    PG8_BAR;
#undef PG8_SA
#undef PG8_SB
#undef PG8_STAGE
#undef PG8_LDA
#undef PG8_LDB
#undef PG8_MMA
#undef PG8_WAIT_V
#undef PG8_WAIT_L
#undef PG8_BAR
#undef PG8_SCHED
}

__device__ __forceinline__ float rstd16(const float* p) { const f32x4 a = ((const f32x4*)p)[0], b = ((const f32x4*)p)[1], c = ((const f32x4*)p)[2], d = ((const f32x4*)p)[3];
    const float s = ((a.x + a.y) + (a.z + a.w)) + ((b.x + b.y) + (b.z + b.w)) + ((c.x + c.y) + (c.z + c.w)) + ((d.x + d.y) + (d.z + d.w)); return 1.0f / sqrtf(s * (1.f / D) + EPS); }
__device__ __forceinline__ u32x4 pack8(const f32x4 v0, const f32x4 v1) { u32x4 w; w.x = cvt_pk_bf16(v0[0], v0[1]); w.y = cvt_pk_bf16(v0[2], v0[3]); w.z = cvt_pk_bf16(v1[0], v1[1]); w.w = cvt_pk_bf16(v1[2], v1[3]); return w; }
__device__ __forceinline__ float sq8(const f32x4 a, const f32x4 b) { return ((a[0] * a[0] + a[1] * a[1]) + (a[2] * a[2] + a[3] * a[3])) + ((b[0] * b[0] + b[1] * b[1]) + (b[2] * b[2] + b[3] * b[3])); }

struct EpiInProjF {
    static constexpr bool PERM = true, HAS_MID = false; int mid_t;
    const float* rstd0; bf16_t *XR, *GG, *Qs, *Ks, *Vs; unsigned* kmax;
    __device__ __forceinline__ void mid(f32x4 (&)[2][2][4][2], const Unit&, int, int, int, int) const {}
    __device__ __forceinline__ void operator()(const f32x4 (&acc)[2][2][4][2], const Unit& u, int wr, int wc, int fr, int fq) const {
        const int row0 = u.pm * BM + wr * 64 + fr, t = u.pn >> 1, colt = (u.pn & 1) * 256 + wc * 32 + 8 * fq;
        bf16_t* base = (t == 0) ? XR : (t == 1) ? GG : (t == 2) ? Qs : (t == 3) ? Ks : Vs;
        float km0 = 0.f, km1 = 0.f;
#pragma unroll
        for (int ai = 0; ai < 2; ++ai)
#pragma unroll
            for (int m = 0; m < 4; ++m) { const int r = row0 + ai * HALF + m * 16; const float rs = rstd0[r]; bf16_t* rowp = base + (size_t)r * 512 + colt;
#pragma unroll
                for (int bj = 0; bj < 2; ++bj) { f32x4 v0 = acc[ai][bj][m][0] * rs, v1 = acc[ai][bj][m][1] * rs;
                    if (t == 1) {
#pragma unroll
                        for (int e = 0; e < 4; ++e) { v0[e] = gelu_tanh(v0[e]); v1[e] = gelu_tanh(v1[e]); } }
                    else if (t == 2) { v0 = v0 * (0.125f * LOG2E); v1 = v1 * (0.125f * LOG2E); }
                    else if (t == 3) { float mx = 0.f;
#pragma unroll
                        for (int e = 0; e < 4; ++e) mx = fmaxf(mx, fmaxf(fabsf(v0[e]), fabsf(v1[e])));
                        if (bj == 0) km0 = fmaxf(km0, mx); else km1 = fmaxf(km1, mx); }
                    *(u32x4*)(rowp + bj * HALF) = pack8(v0, v1); } }
        if (t == 3) {
#pragma unroll
            for (int o = 1; o < 64; o <<= 1) { km0 = fmaxf(km0, __shfl_xor(km0, o)); km1 = fmaxf(km1, __shfl_xor(km1, o)); }
            if ((fr | fq) == 0) { const int b = (u.pm * BM) / SEQ, hd = (u.pn & 1) * 4 + (wc >> 1);
                atomicMax(kmax + b * 8 + hd, __float_as_uint(km0)); atomicMax(kmax + b * 8 + hd + 2, __float_as_uint(km1)); }
        }
    }
};
struct EpiBf16F {
    static constexpr bool PERM = true, HAS_MID = false; int mid_t;
    bf16_t* O; const float* ssq16; int ldo; float scale; size_t tstride;
    __device__ __forceinline__ void mid(f32x4 (&)[2][2][4][2], const Unit&, int, int, int, int) const {}
    __device__ __forceinline__ void operator()(const f32x4 (&acc)[2][2][4][2], const Unit& u, int wr, int wc, int fr, int fq) const {
        const int row0 = u.pm * BM + wr * 64 + fr, col0 = (tstride ? 0 : u.pn * BM) + wc * 32 + 8 * fq; bf16_t* base = O + (size_t)u.pn * tstride;
#pragma unroll
        for (int ai = 0; ai < 2; ++ai)
#pragma unroll
            for (int m = 0; m < 4; ++m) { const int r = row0 + ai * HALF + m * 16; const float rs = (ssq16 ? rstd16(ssq16 + (size_t)r * 16) : 1.f) * scale; bf16_t* rowp = base + (size_t)r * ldo + col0;
#pragma unroll
                for (int bj = 0; bj < 2; ++bj) *(u32x4*)(rowp + bj * HALF) = pack8(acc[ai][bj][m][0] * rs, acc[ai][bj][m][1] * rs); }
    }
};
struct EpiX1F {
    static constexpr bool PERM = true, HAS_MID = true; int mid_t;
    const float* x; const float* fmid; const float* fend; bf16_t* X1b; float* ssq1;
    __device__ __forceinline__ void mid(f32x4 (&acc)[2][2][4][2], const Unit& u, int wr, int wc, int fr, int fq) const {
        const int row0 = u.pm * BM + wr * 64 + fr;
#pragma unroll
        for (int ai = 0; ai < 2; ++ai)
#pragma unroll
            for (int m = 0; m < 4; ++m) { const float f = fmid[row0 + ai * HALF + m * 16];
#pragma unroll
                for (int bj = 0; bj < 2; ++bj) { acc[ai][bj][m][0] = acc[ai][bj][m][0] * f; acc[ai][bj][m][1] = acc[ai][bj][m][1] * f; } }
    }
    __device__ __forceinline__ void operator()(const f32x4 (&acc)[2][2][4][2], const Unit& u, int wr, int wc, int fr, int fq) const {
        const int row0 = u.pm * BM + wr * 64 + fr, col0 = u.pn * BM + wc * 32 + 8 * fq;
#pragma unroll
        for (int ai = 0; ai < 2; ++ai)
#pragma unroll
            for (int m = 0; m < 4; ++m) { const int r = row0 + ai * HALF + m * 16; const float fe = fend[r]; const float* xr = x + (size_t)r * D + col0; float ss = 0.f;
#pragma unroll
                for (int bj = 0; bj < 2; ++bj) { const f32x4 v0 = *(const f32x4*)(xr + bj * HALF) + acc[ai][bj][m][0] * fe, v1 = *(const f32x4*)(xr + bj * HALF + 4) + acc[ai][bj][m][1] * fe;
                    ss += sq8(v0, v1); *(u32x4*)(X1b + (size_t)r * D + col0 + bj * HALF) = pack8(v0, v1); }
                ss += __shfl_xor(ss, 16); ss += __shfl_xor(ss, 32);
                if (fq == 0) ssq1[(size_t)r * 16 + u.pn * 4 + wc] = ss;
                asm volatile("" ::: "memory"); }
    }
};
struct EpiResF {
    static constexpr bool PERM = true, HAS_MID = false; int mid_t;
    const bf16_t* Xi; bf16_t* Xo; float* ssq;
    __device__ __forceinline__ void mid(f32x4 (&)[2][2][4][2], const Unit&, int, int, int, int) const {}
    __device__ __forceinline__ void operator()(const f32x4 (&acc)[2][2][4][2], const Unit& u, int wr, int wc, int fr, int fq) const {
        const int row0 = u.pm * BM + wr * 64 + fr, col0 = u.pn * BM + wc * 32 + 8 * fq;
#pragma unroll
        for (int ai = 0; ai < 2; ++ai)
#pragma unroll
            for (int m = 0; m < 4; ++m) { const int r = row0 + ai * HALF + m * 16; float ss = 0.f;
#pragma unroll
                for (int bj = 0; bj < 2; ++bj) { const u32x4 xi = *(const u32x4*)(Xi + (size_t)r * D + col0 + bj * HALF);
                    f32x4 v0, v1; v0[0] = __uint_as_float(xi.x << 16); v0[1] = __uint_as_float(xi.x & 0xffff0000u); v0[2] = __uint_as_float(xi.y << 16); v0[3] = __uint_as_float(xi.y & 0xffff0000u);
                    v1[0] = __uint_as_float(xi.z << 16); v1[1] = __uint_as_float(xi.z & 0xffff0000u); v1[2] = __uint_as_float(xi.w << 16); v1[3] = __uint_as_float(xi.w & 0xffff0000u);
                    v0 = v0 + acc[ai][bj][m][0]; v1 = v1 + acc[ai][bj][m][1];
                    ss += sq8(v0, v1); *(u32x4*)(Xo + (size_t)r * D + col0 + bj * HALF) = pack8(v0, v1); }
                ss += __shfl_xor(ss, 16); ss += __shfl_xor(ss, 32);
                if (fq == 0) ssq[(size_t)r * 16 + u.pn * 4 + wc] = ss; }
    }
};

__device__ __forceinline__ void pair_ab(int p, int& a, int& b) { a = (p < 3) ? 0 : (p < 5) ? 1 : 2; b = (p < 3) ? p + 1 : (p < 5) ? p - 1 : 3; }
__device__ __forceinline__ int moe_class_of_tile(const PG8_LAS int* meta, int T) { int c = 0;
#pragma unroll
    for (int k = 1; k < 24; ++k) c += (T >= __builtin_amdgcn_readfirstlane(meta[64 + k])) ? 1 : 0;
    return c; }
struct MoeOrder1 {
    const bf16_t* XG; const bf16_t* Wg; const bf16_t* Wu; const PG8_LAS int* meta; int G, c;
    __device__ bool next(int i, Unit& u) const { const int L = i * G + c, nt = __builtin_amdgcn_readfirstlane(meta[64 + 24]); if (L >= nt * 4) return false;
        u.pm = L >> 2; u.pn = moe_class_of_tile(meta, L >> 2) * 4 + (L & 3); return true; }
    __device__ __forceinline__ void ptrs(const Unit& u, const char*& a, const char*& b0, const char*& b1) const {
        const int cls = u.pn >> 2, j = (u.pn >> 1) & 1, half = u.pn & 1; int ea, eb; pair_ab(cls % 6, ea, eb); const int e = (cls / 6) * 4 + (j ? eb : ea);
        a = (const char*)XG + (size_t)u.pm * BM * D * 2; const size_t bo = ((size_t)e * DE + half * HALF) * D * 2; b0 = (const char*)Wg + bo; b1 = (const char*)Wu + bo; }
};
struct MoeOrder2 {
    const bf16_t* HID; const bf16_t* Wd2; const PG8_LAS int* meta; int G, c;
    __device__ bool next(int i, Unit& u) const { const int L = i * G + c, nt = __builtin_amdgcn_readfirstlane(meta[64 + 24]); if (L >= nt * 4) return false;
        u.pm = L >> 2; u.pn = moe_class_of_tile(meta, L >> 2) * 4 + (L & 3); return true; }
    __device__ __forceinline__ void ptrs(const Unit& u, const char*& a, const char*& b0, const char*& b1) const {
        a = (const char*)HID + (size_t)u.pm * BM * 512 * 2; b0 = (const char*)Wd2 + ((size_t)(u.pn >> 2) * D + (u.pn & 3) * BM) * 512 * 2; b1 = b0 + (size_t)HALF * 512 * 2; }
};
struct EpiMoeUp {
    static constexpr bool PERM = true, HAS_MID = false; int mid_t;
    const float* rsg; const float* wAg; const float* wBg; bf16_t* HID;
    __device__ __forceinline__ void mid(f32x4 (&)[2][2][4][2], const Unit&, int, int, int, int) const {}
    __device__ __forceinline__ void operator()(const f32x4 (&acc)[2][2][4][2], const Unit& u, int wr, int wc, int fr, int fq) const {
        const int row0 = u.pm * BM + wr * 64 + fr, j = (u.pn >> 1) & 1, col0 = j * 256 + (u.pn & 1) * HALF + wc * 32 + 8 * fq; const float* wg = j ? wBg : wAg;
#pragma unroll
        for (int ai = 0; ai < 2; ++ai)
#pragma unroll
            for (int m = 0; m < 4; ++m) { const int r = row0 + ai * HALF + m * 16; const float rs = rsg[r], w = wg[r]; f32x4 h0, h1;
#pragma unroll
                for (int e = 0; e < 4; ++e) { const float g0 = acc[ai][0][m][0][e] * rs, g1 = acc[ai][0][m][1][e] * rs;
                    h0[e] = g0 / (1.f + __expf(-g0)) * (acc[ai][1][m][0][e] * rs) * w; h1[e] = g1 / (1.f + __expf(-g1)) * (acc[ai][1][m][1][e] * rs) * w; }
                *(u32x4*)(HID + (size_t)r * 512 + col0) = pack8(h0, h1); }
    }
};
struct EpiMoeDown {
    static constexpr bool PERM = true, HAS_MID = false; int mid_t;
    const int* tokg; const bf16_t* Xi; bf16_t* Xo; float* ssq;
    __device__ __forceinline__ void mid(f32x4 (&)[2][2][4][2], const Unit&, int, int, int, int) const {}
    __device__ __forceinline__ void operator()(const f32x4 (&acc)[2][2][4][2], const Unit& u, int wr, int wc, int fr, int fq) const {
        const int row0 = u.pm * BM + wr * 64 + fr, ct = u.pn & 3, col0 = ct * BM + wc * 32 + 8 * fq;
#pragma unroll
        for (int ai = 0; ai < 2; ++ai)
#pragma unroll
            for (int m = 0; m < 4; ++m) { const int tok = tokg[row0 + ai * HALF + m * 16];
                if (tok >= 0) { float ss = 0.f;
#pragma unroll
                    for (int bj = 0; bj < 2; ++bj) { const u32x4 xi = *(const u32x4*)(Xi + (size_t)tok * D + col0 + bj * HALF);
                        f32x4 v0, v1; v0[0] = __uint_as_float(xi.x << 16); v0[1] = __uint_as_float(xi.x & 0xffff0000u); v0[2] = __uint_as_float(xi.y << 16); v0[3] = __uint_as_float(xi.y & 0xffff0000u);
                        v1[0] = __uint_as_float(xi.z << 16); v1[1] = __uint_as_float(xi.z & 0xffff0000u); v1[2] = __uint_as_float(xi.w << 16); v1[3] = __uint_as_float(xi.w & 0xffff0000u);
                        v0 = v0 + acc[ai][bj][m][0]; v1 = v1 + acc[ai][bj][m][1];
                        ss += sq8(v0, v1); *(u32x4*)(Xo + (size_t)tok * D + col0 + bj * HALF) = pack8(v0, v1); }
                    ss += __shfl_xor(ss, 16); ss += __shfl_xor(ss, 32);
                    if (fq == 0) ssq[(size_t)tok * 16 + ct * 4 + wc] = ss; } }
    }
};

struct XaSOrder {
    const bf16_t* QX; const bf16_t* KM; int G, c;
    __device__ bool next(int i, Unit& u) const { const int L = i * G + c; if (L >= (NTOK / BM) * XH) return false; u.pm = L >> 2; u.pn = L & 3; return true; }
    __device__ __forceinline__ void ptrs(const Unit& u, const char*& a, const char*& b0, const char*& b1) const {
        a = (const char*)QX + ((size_t)u.pm * BM * D + u.pn * XD) * 2; const int b = u.pm / (SEQ / BM);
        b0 = (const char*)KM + ((size_t)b * MEM * D + u.pn * XD) * 2; b1 = b0 + (size_t)HALF * D * 2; }
};
struct XaOOrder {
    const bf16_t* P; const bf16_t* VT; int G, c;
    __device__ bool next(int i, Unit& u) const { const int L = i * G + c; if (L >= (NTOK / BM) * XH) return false; u.pm = L >> 2; u.pn = L & 3; return true; }
    __device__ __forceinline__ void ptrs(const Unit& u, const char*& a, const char*& b0, const char*& b1) const {
        a = (const char*)P + ((size_t)u.pm * BM * D + u.pn * XD) * 2; const int b = u.pm / (SEQ / BM);
        b0 = (const char*)VT + ((size_t)b * D + u.pn * XD) * MEM * 2; b1 = b0 + (size_t)HALF * MEM * 2; }
};
struct EpiSoftmax {
    static constexpr bool PERM = true, HAS_MID = false; int mid_t;
    bf16_t* P; PG8_LAS float* xch;
    __device__ __forceinline__ void mid(f32x4 (&)[2][2][4][2], const Unit&, int, int, int, int) const {}
    __device__ __forceinline__ void operator()(f32x4 (&acc)[2][2][4][2], const Unit& u, int wr, int wc, int fr, int fq) const {
        PG8_LAS float* xm = xch; PG8_LAS float* xs = xch + 1024;
#pragma unroll
        for (int ai = 0; ai < 2; ++ai)
#pragma unroll
            for (int m = 0; m < 4; ++m) { float mx = -INFINITY;
#pragma unroll
                for (int bj = 0; bj < 2; ++bj)
#pragma unroll
                    for (int n = 0; n < 2; ++n) { const f32x4 v = acc[ai][bj][m][n]; mx = fmaxf(mx, fmaxf(fmaxf(v[0], v[1]), fmaxf(v[2], v[3]))); }
                mx = fmaxf(mx, __shfl_xor(mx, 16)); mx = fmaxf(mx, __shfl_xor(mx, 32));
                if (fq == 0) xm[(ai * HALF + wr * 64 + m * 16 + fr) * 4 + wc] = mx; asm volatile("" ::: "memory"); }
        asm volatile("s_waitcnt lgkmcnt(0)" ::: "memory"); __builtin_amdgcn_s_barrier(); asm volatile("" ::: "memory");
#pragma unroll
        for (int ai = 0; ai < 2; ++ai)
#pragma unroll
            for (int m = 0; m < 4; ++m) { const int rl = ai * HALF + wr * 64 + m * 16 + fr; const f32x4 q = *(const PG8_LAS f32x4*)(xm + rl * 4);
                const float mx = fmaxf(fmaxf(q[0], q[1]), fmaxf(q[2], q[3])); float ss = 0.f;
#pragma unroll
                for (int bj = 0; bj < 2; ++bj)
#pragma unroll
                    for (int n = 0; n < 2; ++n) { f32x4 v = acc[ai][bj][m][n];
#pragma unroll
                        for (int e = 0; e < 4; ++e) { v[e] = __builtin_amdgcn_exp2f(v[e] - mx); ss += v[e]; }
                        acc[ai][bj][m][n] = v; }
                ss += __shfl_xor(ss, 16); ss += __shfl_xor(ss, 32);
                if (fq == 0) xs[rl * 4 + wc] = ss; asm volatile("" ::: "memory"); }
        asm volatile("s_waitcnt lgkmcnt(0)" ::: "memory"); __builtin_amdgcn_s_barrier(); asm volatile("" ::: "memory");
        const int row0 = u.pm * BM + wr * 64 + fr, col0 = u.pn * XD + wc * 32 + 8 * fq;
#pragma unroll
        for (int ai = 0; ai < 2; ++ai)
#pragma unroll
            for (int m = 0; m < 4; ++m) { const int rl = ai * HALF + wr * 64 + m * 16 + fr; const f32x4 q = *(const PG8_LAS f32x4*)(xs + rl * 4);
                const float inv = 1.0f / ((q[0] + q[1]) + (q[2] + q[3])); bf16_t* rowp = P + (size_t)(row0 + ai * HALF + m * 16) * D + col0;
#pragma unroll
                for (int bj = 0; bj < 2; ++bj) *(u32x4*)(rowp + bj * HALF) = pack8(acc[ai][bj][m][0] * inv, acc[ai][bj][m][1] * inv); asm volatile("" ::: "memory"); }
    }
};
}
namespace sba {
typedef float f32x16 __attribute__((ext_vector_type(16)));
typedef short s16x4 __attribute__((ext_vector_type(4)));
typedef short v4i16_t __attribute__((ext_vector_type(4)));
typedef __attribute__((address_space(3))) const char* lds_cptr;
constexpr int SLOTB = 8192, L_K = 0, L_V = 2 * SLOTB, L_FLAG = 4 * SLOTB, L_OST = L_FLAG + 256, L_BYTES = L_OST + 8 * 4096;
__device__ __forceinline__ int crow(int r, int hi) { return (r & 3) + 8 * (r >> 2) + 4 * hi; }
__device__ __forceinline__ void glds16(const void* gsrc, unsigned lds_dst) { unsigned keep;
    asm volatile("s_mov_b32 %0, m0\n\ts_mov_b32 m0, %2\n\ts_nop 0\n\tglobal_load_lds_dwordx4 %1, off\n\ts_mov_b32 m0, %0" : "=&s"(keep) : "v"(gsrc), "s"(lds_dst) : "memory"); }
typedef float f32x2_t __attribute__((ext_vector_type(2))); typedef __bf16 bf16x2_t __attribute__((ext_vector_type(2)));
__device__ __forceinline__ unsigned cvtpk(float lo, float hi) { f32x2_t v = {lo, hi}; bf16x2_t b = __builtin_convertvector(v, bf16x2_t); return __builtin_bit_cast(unsigned, b); }
__device__ __forceinline__ s16x4 vtr(lds_cptr p) { return __builtin_bit_cast(s16x4, __builtin_amdgcn_ds_read_tr16_b64_v4i16((__attribute__((address_space(3))) v4i16_t*)p)); }

#define SBA_GROUP(Z, SP, g) do { \
        const float off_ = acc_ + (hi ? 0.f : gp_##SP[g]); acc_ += gs_##SP[g] + gp_##SP[g]; \
        const float c3_ = off_ + SP[4 * (g) + 3], c2_ = c3_ + SP[4 * (g) + 2], c1_ = c2_ + SP[4 * (g) + 1], c0_ = c1_ + SP[4 * (g)]; \
        Z[4 * (g) + 3] = __builtin_amdgcn_exp2f(Z[4 * (g) + 3] - c3_); Z[4 * (g) + 2] = __builtin_amdgcn_exp2f(Z[4 * (g) + 2] - c2_); \
        Z[4 * (g) + 1] = __builtin_amdgcn_exp2f(Z[4 * (g) + 1] - c1_); Z[4 * (g)] = __builtin_amdgcn_exp2f(Z[4 * (g)] - c0_); } while (0)

__device__ __forceinline__ void sb_unit(int b, int h, int qb, const bf16_t* Qs, const bf16_t* Ks, const bf16_t* Vs, bf16_t* YY, float* ssq_s8, const unsigned* kmax, char* shm) {
    int tid_ = threadIdx.x; asm volatile("" : "+v"(tid_));
    const int tid = tid_, lane = tid & 63, r32 = lane & 31, hi = lane >> 5; const int wid = __builtin_amdgcn_readfirstlane(tid >> 6);
    const size_t rowbase = (size_t)b * SEQ; const int q0 = qb * 256;
    const bf16_t* Kh = Ks + rowbase * SBW + h * HD; const bf16_t* Vh = Vs + rowbase * SBW + h * HD;
    const unsigned lds0 = (unsigned)(uintptr_t)shm;
    const lds_cptr shm3 = (lds_cptr)shm;
    const bf16_t* ksrc = Kh + (size_t)lane * SBW + wid * 8;
    const bf16_t* vsrc = Vh + (size_t)(16 * (wid & 3) + (lane >> 2)) * SBW + (wid >> 2) * 32 + (lane & 3) * 8;
    const unsigned kdst = lds0 + L_K + wid * 1024, vdst = lds0 + L_V + wid * 1024;
#define DMA_KV(t, slot) do { glds16(ksrc + (size_t)(t) * 64 * SBW, (unsigned)__builtin_amdgcn_readfirstlane(kdst + (slot))); glds16(vsrc + (size_t)(t) * 64 * SBW, (unsigned)__builtin_amdgcn_readfirstlane(vdst + (slot))); } while (0)
    const lds_cptr kp0 = shm3 + L_K + hi * 1024 + r32 * 16;
    const lds_cptr vp0 = shm3 + L_V + ((lane >> 4) & 1) * 32 + (lane & 3) * 8 + (4 * hi + ((lane & 15) >> 2)) * 64;
    volatile __attribute__((address_space(3))) unsigned* flags = (volatile __attribute__((address_space(3))) unsigned*)(shm3 + L_FLAG);
    int tile = 4 * qb + 3, slot = 0, it = 0;
    DMA_KV(tile, 0);
    const bf16_t* Qw = Qs + (rowbase + q0 + wid * 32 + r32) * SBW + h * HD;
    bf16x8 qr[4];
#pragma unroll
    for (int d0 = 0; d0 < 4; ++d0) qr[d0] = *(const bf16x8*)(Qw + d0 * 16 + hi * 8);
    float qn = 0.f;
#pragma unroll
    for (int d0 = 0; d0 < 4; ++d0)
#pragma unroll
        for (int e = 0; e < 8; ++e) qn += fabsf(bf2f((unsigned short)qr[d0][e]));
    qn += __shfl_xor(qn, 32);
    const float zmax = qn * __uint_as_float(kmax[b * 8 + h]) * 1.01f;
    const int tq = q0 + wid * 32 + r32;
    const int tq_min = q0 + wid * 32, tq_max = tq_min + 31;
    float R = 0.f;
    f32x16 o0 = {}, o1 = {};
    for (;;) {
        const bool has_next = tile > 0;
        if (has_next) { DMA_KV(tile - 1, slot ^ SLOTB); asm volatile("s_waitcnt vmcnt(2)" ::: "memory"); }
        else asm volatile("s_waitcnt vmcnt(0)" ::: "memory");
        __builtin_amdgcn_s_barrier(); asm volatile("" ::: "memory");
        const int kmin = tile * 64;
        if (kmin < tq_max) {
            f32x16 z0, z1;
            {
                const lds_cptr kb = kp0 + slot;
#pragma unroll
                for (int d0 = 0; d0 < 4; ++d0) {
                    const bf16x8 b0 = *(const __attribute__((address_space(3))) bf16x8*)(kb + d0 * 2048);
                    const bf16x8 b1 = *(const __attribute__((address_space(3))) bf16x8*)(kb + d0 * 2048 + 512);
                    if (d0 == 0) { z0 = __builtin_amdgcn_mfma_f32_32x32x16_bf16(b0, qr[0], (f32x16){}, 0, 0, 0); z1 = __builtin_amdgcn_mfma_f32_32x32x16_bf16(b1, qr[0], (f32x16){}, 0, 0, 0); }
                    else { z0 = __builtin_amdgcn_mfma_f32_32x32x16_bf16(b0, qr[d0], z0, 0, 0, 0); z1 = __builtin_amdgcn_mfma_f32_32x32x16_bf16(b1, qr[d0], z1, 0, 0, 0); }
                }
            }
            if (kmin + 63 >= tq_min) {
#pragma unroll
                for (int r = 0; r < 16; ++r) { const int kv = kmin + crow(r, hi); if (kv >= tq) z0[r] = -INFINITY; if (kv + 32 >= tq) z1[r] = -INFINITY; }
            }
            f32x16 s0, s1;
#pragma unroll
            for (int r = 0; r < 16; ++r) { z0[r] = fminf(z0[r], 120.f); z1[r] = fminf(z1[r], 120.f);
                s0[r] = __builtin_amdgcn_logf(1.f + __builtin_amdgcn_exp2f(z0[r])); s1[r] = __builtin_amdgcn_logf(1.f + __builtin_amdgcn_exp2f(z1[r])); }
            float gs_s0[4], gs_s1[4], gp_s0[4], gp_s1[4];
#pragma unroll
            for (int g = 0; g < 4; ++g) { gs_s0[g] = (s0[4 * g] + s0[4 * g + 1]) + (s0[4 * g + 2] + s0[4 * g + 3]); gs_s1[g] = (s1[4 * g] + s1[4 * g + 1]) + (s1[4 * g + 2] + s1[4 * g + 3]); }
#pragma unroll
            for (int g = 0; g < 4; ++g) { gp_s0[g] = __shfl_xor(gs_s0[g], 32); gp_s1[g] = __shfl_xor(gs_s1[g], 32); }
            float acc_ = R;
            SBA_GROUP(z1, s1, 3); SBA_GROUP(z1, s1, 2); SBA_GROUP(z1, s1, 1); SBA_GROUP(z1, s1, 0);
            SBA_GROUP(z0, s0, 3); SBA_GROUP(z0, s0, 2); SBA_GROUP(z0, s0, 1); SBA_GROUP(z0, s0, 0);
            R = acc_;
            u32x4 pw0, pw1, pw2, pw3;
            pw0 = (u32x4){cvtpk(z0[0], z0[1]), cvtpk(z0[2], z0[3]), cvtpk(z0[4], z0[5]), cvtpk(z0[6], z0[7])};
            pw1 = (u32x4){cvtpk(z0[8], z0[9]), cvtpk(z0[10], z0[11]), cvtpk(z0[12], z0[13]), cvtpk(z0[14], z0[15])};
            pw2 = (u32x4){cvtpk(z1[0], z1[1]), cvtpk(z1[2], z1[3]), cvtpk(z1[4], z1[5]), cvtpk(z1[6], z1[7])};
            pw3 = (u32x4){cvtpk(z1[8], z1[9]), cvtpk(z1[10], z1[11]), cvtpk(z1[12], z1[13]), cvtpk(z1[14], z1[15])};
            const lds_cptr vp = vp0 + slot;
#define SBA_PV(O, d0, ks, PW) do { const s16x4 lo_ = vtr(vp + (d0) * 4096 + (ks) * 1024), hi_ = vtr(vp + (d0) * 4096 + (ks) * 1024 + 512); \
                const bf16x8 vf_ = (bf16x8){lo_[0], lo_[1], lo_[2], lo_[3], hi_[0], hi_[1], hi_[2], hi_[3]}; \
                O = __builtin_amdgcn_mfma_f32_32x32x16_bf16(__builtin_bit_cast(bf16x8, PW), vf_, O, 0, 0, 0); } while (0)
            SBA_PV(o0, 0, 0, pw0); SBA_PV(o1, 1, 0, pw0); SBA_PV(o0, 0, 1, pw1); SBA_PV(o1, 1, 1, pw1);
            SBA_PV(o0, 0, 2, pw2); SBA_PV(o1, 1, 2, pw2); SBA_PV(o0, 0, 3, pw3); SBA_PV(o1, 1, 3, pw3);
#undef SBA_PV
        }
        const bool done = __all((zmax - R) < -150.f);
        if (lane == 0) flags[(it & 1) * 8 + wid] = done ? 1u : 0u;
        asm volatile("s_waitcnt lgkmcnt(0)" ::: "memory"); __builtin_amdgcn_s_barrier(); asm volatile("" ::: "memory");
        unsigned alld = 1u;
#pragma unroll
        for (int w = 0; w < 8; ++w) alld &= flags[(it & 1) * 8 + w];
        alld = __builtin_amdgcn_readfirstlane(alld);
        if (!has_next || alld) break;
        --tile; slot ^= SLOTB; ++it;
    }
    asm volatile("s_waitcnt vmcnt(0)" ::: "memory");
    {
        bf16_t* Ow = YY + (rowbase + q0 + wid * 32) * D + RW + h * HD;
        bf16_t* stg = (bf16_t*)(shm + L_OST) + wid * 2048;
#pragma unroll
        for (int r = 0; r < 16; ++r) { const int orow = crow(r, hi); stg[orow * 64 + r32] = (bf16_t)f2bf(o0[r]); stg[orow * 64 + 32 + r32] = (bf16_t)f2bf(o1[r]); }
        asm volatile("s_waitcnt lgkmcnt(0)" ::: "memory");
#pragma unroll
        for (int i = 0; i < 4; ++i) { const int row = i * 8 + (lane >> 3), ch = lane & 7; const u32x4 v = *(const u32x4*)(stg + row * 64 + ch * 8);
            *(u32x4*)(Ow + (size_t)row * D + ch * 8) = v;
            float ss = 0.f;
#pragma unroll
            for (int e = 0; e < 4; ++e) { const float lo = __uint_as_float(v[e] << 16), hh = __uint_as_float(v[e] & 0xffff0000u); ss += lo * lo + hh * hh; }
            ss += __shfl_xor(ss, 1); ss += __shfl_xor(ss, 2); ss += __shfl_xor(ss, 4);
            if (ch == 0) ssq_s8[(rowbase + q0 + wid * 32 + row) * 8 + h] = ss; }
    }
    asm volatile("s_waitcnt lgkmcnt(0)" ::: "memory"); __builtin_amdgcn_s_barrier(); asm volatile("" ::: "memory");
#undef DMA_KV
}
#undef SBA_GROUP
}
namespace lru {
typedef float f32x16 __attribute__((ext_vector_type(16)));
constexpr int XS_ROWS = 67, XS_BYTES = XS_ROWS * 1024  , XC_PITCH = 1040  , XC_OFF = 68608, L_BYTES = XC_OFF + 64 * XC_PITCH;
__device__ __forceinline__ int crow(int r, int hi) { return (r & 3) + 8 * (r >> 2) + 4 * hi; }

struct Weights { bf16x8 wa[2][4], wx[2][4]; float ba[2], bx[2], spl[2]; };
__device__ __forceinline__ void load_weights(Weights& W, int h, int r32, int hi, const float* w_a, const float* b_a, const float* w_x, const float* b_x, const float* lam) {
#pragma unroll
    for (int nt = 0; nt < 2; ++nt) {
#pragma unroll
        for (int s = 0; s < 4; ++s) {
#pragma unroll
            for (int e = 0; e < 8; ++e) { const size_t idx = ((size_t)(h * 64 + 16 * s + 8 * hi + e)) * 64 + 32 * nt + r32;
                W.wa[nt][s][e] = (short)f2bf(w_a[idx]); W.wx[nt][s][e] = (short)f2bf(w_x[idx]); }
        }
        const int c = h * 64 + 32 * nt + r32; W.ba[nt] = b_a[c]; W.bx[nt] = b_x[c];
        const float l = lam[c]; W.spl[nt] = (l > 15.f) ? __expf(-l) : log1pf(__expf(-l));
    }
}

template <bool PASSB>
__device__ __forceinline__ void unit(int b, int chunk, const Weights& W, const bf16_t* XR, const bf16_t* GG, const float* conv_w, const float* conv_b,
                                     float* aggP, float* aggH, const float* ssq_s8, bf16_t* YY, float* fmid, float* fend, unsigned char* shm) {
    int tid_ = threadIdx.x; asm volatile("" : "+v"(tid_));
    const int tid = tid_, lane = tid & 63, r32 = lane & 31, hi = lane >> 5, wid = __builtin_amdgcn_readfirstlane(tid >> 6);
    LAS unsigned char* L = (LAS unsigned char*)shm;
    const int t0 = chunk * 64; const size_t rowbase = (size_t)b * SEQ;
    for (int p = tid; p < XS_ROWS * 64; p += NTHREADS) { const int rr = p >> 6, pc = p & 63, t = t0 - 3 + rr;
        u32x4 v = (u32x4){0u, 0u, 0u, 0u}; if (t >= 0) v = *(const u32x4*)(XR + (rowbase + t) * RW + pc * 8);
        *(LAS u32x4*)(L + rr * 1024 + pc * 16) = v; }
    __syncthreads();
    {
        const int cp = tid & 255, th = tid >> 8, c0 = 2 * cp;
        const float w00 = conv_w[c0], w01 = conv_w[RW + c0], w02 = conv_w[2 * RW + c0], w03 = conv_w[3 * RW + c0], b0 = conv_b[c0];
        const float w10 = conv_w[c0 + 1], w11 = conv_w[RW + c0 + 1], w12 = conv_w[2 * RW + c0 + 1], w13 = conv_w[3 * RW + c0 + 1], b1 = conv_b[c0 + 1];
        const LAS unsigned* xs = (const LAS unsigned*)(L + (th * 32) * 1024 + cp * 4);
        unsigned u0 = xs[0], u1 = xs[256], u2 = xs[512];
        float a0 = __uint_as_float(u0 << 16), a1 = __uint_as_float(u1 << 16), a2 = __uint_as_float(u2 << 16);
        float c0_ = __uint_as_float(u0 & 0xffff0000u), c1_ = __uint_as_float(u1 & 0xffff0000u), c2_ = __uint_as_float(u2 & 0xffff0000u);
#pragma unroll 8
        for (int t = 0; t < 32; ++t) { const unsigned u3 = xs[(t + 3) * 256]; const float a3 = __uint_as_float(u3 << 16), c3_ = __uint_as_float(u3 & 0xffff0000u);
            const float y0 = w00 * a0 + w01 * a1 + w02 * a2 + w03 * a3 + b0, y1 = w10 * c0_ + w11 * c1_ + w12 * c2_ + w13 * c3_ + b1;
            *(LAS unsigned*)(L + XC_OFF + (th * 32 + t) * XC_PITCH + cp * 4) = f2bf(y0) | (f2bf(y1) << 16);
            a0 = a1; a1 = a2; a2 = a3; c0_ = c1_; c1_ = c2_; c2_ = c3_; }
    }
    __syncthreads();
    const int h = wid;
    float Hc[2] = {0.f, 0.f}, Pc[2] = {1.f, 1.f};
    if (PASSB) {
#pragma unroll
        for (int nt = 0; nt < 2; ++nt) { const int c = h * 64 + 32 * nt + r32; const float* pP = aggP + ((size_t)b * 64) * RW + c; const float* pH = aggH + ((size_t)b * 64) * RW + c; float hc = 0.f;
            int ch = 0;
            for (; ch + 8 <= chunk; ch += 8) { float p[8], q[8];
#pragma unroll
                for (int i = 0; i < 8; ++i) { p[i] = pP[(size_t)(ch + i) * RW]; q[i] = pH[(size_t)(ch + i) * RW]; }
#pragma unroll
                for (int i = 0; i < 8; ++i) hc = p[i] * hc + q[i]; }
            for (; ch < chunk; ++ch) hc = pP[(size_t)ch * RW] * hc + pH[(size_t)ch * RW];
            Hc[nt] = hc; }
    }
#pragma unroll
    for (int mt = 0; mt < 2; ++mt) {
        bf16x8 af[4];
#pragma unroll
        for (int s = 0; s < 4; ++s) af[s] = *(const LAS bf16x8*)(L + XC_OFF + (32 * mt + r32) * XC_PITCH + (h * 64 + 16 * s + 8 * hi) * 2);
#pragma unroll
        for (int nt = 0; nt < 2; ++nt) {
            f32x16 ra = {}, ri = {};
#pragma unroll
            for (int s = 0; s < 4; ++s) { ra = __builtin_amdgcn_mfma_f32_32x32x16_bf16(af[s], W.wa[nt][s], ra, 0, 0, 0); ri = __builtin_amdgcn_mfma_f32_32x32x16_bf16(af[s], W.wx[nt][s], ri, 0, 0, 0); }
            const int c = h * 64 + 32 * nt + r32;
#pragma unroll
            for (int r = 0; r < 16; ++r) { const int tok = 32 * mt + crow(r, hi);
                const float xc = bf2f(*(const LAS unsigned short*)(L + XC_OFF + tok * XC_PITCH + c * 2));
                const float rg = 1.f / (1.f + __expf(-(ra[r] + W.ba[nt]))), ig = 1.f / (1.f + __expf(-(ri[r] + W.bx[nt])));
                const float la = -8.0f * rg * W.spl[nt], a = __expf(la);
                ra[r] = a; ri[r] = sqrtf(fmaxf(0.f, 1.f - a * a)) * (ig * xc); }
            float P[4], H[4], Pp[4], Hp[4];
#pragma unroll
            for (int g = 0; g < 4; ++g) { P[g] = (ra[4 * g] * ra[4 * g + 1]) * (ra[4 * g + 2] * ra[4 * g + 3]);
                H[g] = ((ri[4 * g] * ra[4 * g + 1] + ri[4 * g + 1]) * ra[4 * g + 2] + ri[4 * g + 2]) * ra[4 * g + 3] + ri[4 * g + 3]; }
#pragma unroll
            for (int g = 0; g < 4; ++g) { Pp[g] = __shfl_xor(P[g], 32); Hp[g] = __shfl_xor(H[g], 32); }
            float hc = Hc[nt], pc = Pc[nt];
#pragma unroll
            for (int g = 0; g < 4; ++g) { const float P0 = hi ? Pp[g] : P[g], H0 = hi ? Hp[g] : H[g], P1 = hi ? P[g] : Pp[g], H1 = hi ? H[g] : Hp[g];
                const float mid = P0 * hc + H0;
                if (PASSB) { float hh = hi ? mid : hc;
#pragma unroll
                    for (int k = 0; k < 4; ++k) { hh = ra[4 * g + k] * hh + ri[4 * g + k]; const int tok = 32 * mt + 8 * g + 4 * hi + k;
                        *(LAS unsigned short*)(L + tok * 1024 + c * 2) = (unsigned short)f2bf(hh); } }
                hc = P1 * mid + H1; pc = pc * (P0 * P1); }
            Hc[nt] = hc; Pc[nt] = pc;
        }
    }
    if (!PASSB) {
        if (hi == 0) {
#pragma unroll
            for (int nt = 0; nt < 2; ++nt) { const int c = h * 64 + 32 * nt + r32; aggP[((size_t)b * 64 + chunk) * RW + c] = Pc[nt]; aggH[((size_t)b * 64 + chunk) * RW + c] = Hc[nt]; }
        }
        __syncthreads();
    } else {
        __syncthreads();
        for (int i = 0; i < 8; ++i) { const int rr = i * 8 + wid; const size_t row = rowbase + t0 + rr;
            const u32x4 hv = *(const LAS u32x4*)(L + rr * 1024 + lane * 16); const u32x4 gv = *(const u32x4*)(GG + row * RW + lane * 8);
            f32x4 y0, y1;
            y0[0] = __uint_as_float(hv.x << 16) * __uint_as_float(gv.x << 16); y0[1] = __uint_as_float(hv.x & 0xffff0000u) * __uint_as_float(gv.x & 0xffff0000u);
            y0[2] = __uint_as_float(hv.y << 16) * __uint_as_float(gv.y << 16); y0[3] = __uint_as_float(hv.y & 0xffff0000u) * __uint_as_float(gv.y & 0xffff0000u);
            y1[0] = __uint_as_float(hv.z << 16) * __uint_as_float(gv.z << 16); y1[1] = __uint_as_float(hv.z & 0xffff0000u) * __uint_as_float(gv.z & 0xffff0000u);
            y1[2] = __uint_as_float(hv.w << 16) * __uint_as_float(gv.w << 16); y1[3] = __uint_as_float(hv.w & 0xffff0000u) * __uint_as_float(gv.w & 0xffff0000u);
            const float ss = wave_sum(pg8::sq8(y0, y1));
            *(u32x4*)(YY + row * D + lane * 8) = pg8::pack8(y0, y1);
            if (lane == 0) { float s2 = 0.f;
#pragma unroll
                for (int k = 0; k < 8; ++k) s2 += ssq_s8[row * 8 + k];
                const float rrn = 1.0f / sqrtf(ss * (1.f / RW) + EPS), rs = 1.0f / sqrtf(s2 * (1.f / SBW) + EPS); fmid[row] = rrn / rs; fend[row] = rs; } }
        __syncthreads();
    }
}
}
__device__ __forceinline__ void row_prep_x(const float* x, bf16_t* xb, float* rstd0, int row, int lane) {
    const f32x4* xr = (const f32x4*)(x + (size_t)row * D) + lane;
    float s = 0.f; f32x4 v[4];
#pragma unroll
    for (int j = 0; j < 4; ++j) { v[j] = xr[64 * j]; s += v[j].x * v[j].x + v[j].y * v[j].y + v[j].z * v[j].z + v[j].w * v[j].w; }
    s = wave_sum(s);
    if (lane == 0) rstd0[row] = 1.0f / sqrtf(s * (1.f / D) + EPS);
    unsigned long long* o8 = (unsigned long long*)(xb + (size_t)row * D) + lane;
#pragma unroll
    for (int j = 0; j < 4; ++j) o8[64 * j] = (unsigned long long)(f2bf(v[j].x) | (f2bf(v[j].y) << 16)) | ((unsigned long long)(f2bf(v[j].z) | (f2bf(v[j].w) << 16)) << 32);
}
__device__ __forceinline__ void row_prep_mem(const float* m, const float* g, bf16_t* o, int row, int lane) {
    const f32x4* xr = (const f32x4*)(m + (size_t)row * D) + lane;
    float s = 0.f; f32x4 v[4];
#pragma unroll
    for (int j = 0; j < 4; ++j) { v[j] = xr[64 * j]; s += v[j].x * v[j].x + v[j].y * v[j].y + v[j].z * v[j].z + v[j].w * v[j].w; }
    s = wave_sum(s);
    const float r = 1.0f / sqrtf(s * (1.f / D) + EPS);
    unsigned long long* o8 = (unsigned long long*)(o + (size_t)row * D) + lane;
#pragma unroll
    for (int j = 0; j < 4; ++j) { const f32x4 gg = ((const f32x4*)g)[64 * j + lane];
        o8[64 * j] = (unsigned long long)(f2bf(v[j].x * r * gg.x) | (f2bf(v[j].y * r * gg.y) << 16)) | ((unsigned long long)(f2bf(v[j].z * r * gg.z) | (f2bf(v[j].w * r * gg.w) << 16)) << 32); }
}
__device__ __forceinline__ void transpose_item(const float* W, int K, int N, bf16_t* Wt, int ldt, const float* g0, const float* g1, int ksplit, LAS float* scr, int item, int lane) {
    const int nblk = N / 32, kb = item / nblk, nb = item % nblk, k0 = 64 * kb, n0 = 32 * nb;
#pragma unroll 8
    for (int i = 0; i < 32; ++i) { const int kk = 2 * i + (lane >> 5), k = k0 + kk; float gv = 1.f; if (g0) gv = (k < ksplit) ? g0[k] : g1[k - ksplit];
        scr[kk * 33 + (lane & 31)] = W[(size_t)k * N + n0 + (lane & 31)] * gv; }
    asm volatile("s_waitcnt lgkmcnt(0)" ::: "memory");
    const int c = lane & 7;
#pragma unroll
    for (int j = 0; j < 4; ++j) { const int n = (lane >> 3) + 8 * j; const LAS float* s = scr + (8 * c) * 33 + n;
        u32x4 o; o.x = f2bf(s[0 * 33]) | (f2bf(s[1 * 33]) << 16); o.y = f2bf(s[2 * 33]) | (f2bf(s[3 * 33]) << 16); o.z = f2bf(s[4 * 33]) | (f2bf(s[5 * 33]) << 16); o.w = f2bf(s[6 * 33]) | (f2bf(s[7 * 33]) << 16);
        *(u32x4*)(Wt + (size_t)(n0 + n) * ldt + k0 + 8 * c) = o; }
    asm volatile("s_waitcnt lgkmcnt(0)" ::: "memory");
}

struct MidScale { const float* f; int k; int pad; };
template <class Epi>
__device__ __forceinline__ void gemm_naive(const Ctx& C, const bf16_t* A, int lda, const bf16_t* Bt, int ldb, int M, int N, int K, MidScale ms, const Epi& E) {
    const int lane = C.lane, fr = lane & 15, fq = lane >> 4, ncol = N / 64, ntile = (M / 16) * ncol;
    for (int t = C.gw; t < ntile; t += C.NGW) {
        const int row0 = (t / ncol) * 16, col0 = (t % ncol) * 64;
        const bf16_t* ap = A + (size_t)(row0 + fr) * lda + fq * 8;
        const bf16_t* bp = Bt + (size_t)(col0 + fr) * ldb + fq * 8;
        f32x4 acc[4];
#pragma unroll
        for (int n = 0; n < 4; ++n) acc[n] = (f32x4){0.f, 0.f, 0.f, 0.f};
        for (int k0 = 0; k0 < K; k0 += 32) {
            if (ms.f && k0 == ms.k) {
#pragma unroll
                for (int j = 0; j < 4; ++j) { const float f = ms.f[row0 + fq * 4 + j];
#pragma unroll
                    for (int n = 0; n < 4; ++n) acc[n][j] *= f; }
            }
            const bf16x8 a = *(const bf16x8*)(ap + k0);
#pragma unroll
            for (int n = 0; n < 4; ++n) { const bf16x8 b = *(const bf16x8*)(bp + (size_t)n * 16 * ldb + k0); acc[n] = __builtin_amdgcn_mfma_f32_16x16x32_bf16(a, b, acc[n], 0, 0, 0); }
        }
#pragma unroll
        for (int n = 0; n < 4; ++n)
#pragma unroll
            for (int j = 0; j < 4; ++j) E(row0 + fq * 4 + j, col0 + n * 16 + fr, acc[n][j]);
    }
}
struct EpiInProj { const float* rstd0; bf16_t *XR, *GG, *Qs, *Ks, *Vs;
    __device__ void operator()(int r, int c, float v) const { v *= rstd0[r]; const int t = c >> 9, cc = c & 511;
        if (t == 0) XR[(size_t)r * RW + cc] = (bf16_t)f2bf(v);
        else if (t == 1) GG[(size_t)r * RW + cc] = (bf16_t)f2bf(gelu_tanh(v));
        else if (t == 2) Qs[(size_t)r * SBW + cc] = (bf16_t)f2bf(v * (0.125f * LOG2E));
        else if (t == 3) Ks[(size_t)r * SBW + cc] = (bf16_t)f2bf(v);
        else Vs[(size_t)r * SBW + cc] = (bf16_t)f2bf(v); } };
struct EpiStoreBf16 { bf16_t* O; const float* rowscale; int ldo; float scale;
    __device__ void operator()(int r, int c, float v) const { O[(size_t)r * ldo + c] = (bf16_t)f2bf(v * (rowscale ? rowscale[r] : 1.f) * scale); } };
struct EpiResF32 { const float* base; const float* rowscale; bf16_t* O;
    __device__ void operator()(int r, int c, float v) const { O[(size_t)r * D + c] = (bf16_t)f2bf(base[(size_t)r * D + c] + v * rowscale[r]); } };
struct EpiResBf16 { const bf16_t* base; bf16_t* O;
    __device__ void operator()(int r, int c, float v) const { O[(size_t)r * D + c] = (bf16_t)f2bf(bf2f(base[(size_t)r * D + c]) + v); } };

__device__ __forceinline__ void lru_naive_unit(int unit, int j, LAS float* xs, const bf16_t* XR, const bf16_t* GG, const float* conv_w, const float* conv_b,
                                               const float* w_a, const float* b_a, const float* w_x, const float* b_x, const float* lam, bf16_t* YY) {
    const int b = unit >> 3, h = unit & 7, c = h * 64 + j;
    float wa[64], wx[64];
#pragma unroll
    for (int i = 0; i < 64; ++i) { wa[i] = w_a[(size_t)(h * 64 + i) * 64 + j]; wx[i] = w_x[(size_t)(h * 64 + i) * 64 + j]; }
    const float ba = b_a[c], bx = b_x[c], cw0 = conv_w[c], cw1 = conv_w[RW + c], cw2 = conv_w[2 * RW + c], cw3 = conv_w[3 * RW + c], cb = conv_b[c];
    const float l = lam[c], spl = (l > 15.f) ? __expf(-l) : log1pf(__expf(-l));
    float x0 = 0.f, x1 = 0.f, x2 = 0.f, hst = 0.f;
    for (int t = 0; t < SEQ; ++t) {
        const size_t row = (size_t)b * SEQ + t;
        const float x3 = bf2f(XR[row * RW + c]);
        const float xc = cw0 * x0 + cw1 * x1 + cw2 * x2 + cw3 * x3 + cb;
        x0 = x1; x1 = x2; x2 = x3;
        asm volatile("s_waitcnt lgkmcnt(0)" ::: "memory"); xs[j] = xc; asm volatile("s_waitcnt lgkmcnt(0)" ::: "memory");
        float ra = ba, ri = bx;
#pragma unroll
        for (int i = 0; i < 64; ++i) { const float xv = xs[i]; ra += xv * wa[i]; ri += xv * wx[i]; }
        const float r = sigmoidf_(ra), ig = sigmoidf_(ri);
        const float log_a = -8.0f * r * spl, a = __expf(log_a), bb = sqrtf(fmaxf(0.f, -expm1f(2.f * log_a))) * (ig * xc);
        hst = a * hst + bb;
        YY[row * D + c] = (bf16_t)f2bf(hst * bf2f(GG[row * RW + c]));
    }
}
__device__ __forceinline__ void sb_naive_unit(int unit, int lane, const bf16_t* Qs, const bf16_t* Ks, const bf16_t* Vs, bf16_t* YY, float* ssq_s8) {
    const int qb = unit & 63, h = (unit >> 6) & 7, b = unit >> 9;
    const int t = qb * 64 + lane; const size_t row = (size_t)b * SEQ + t;
    float q[64], o[64];
#pragma unroll
    for (int d = 0; d < 64; ++d) { q[d] = bf2f(Qs[row * SBW + h * 64 + d]); o[d] = 0.f; }
    float R = 0.f;
    for (int s = qb * 64 + 62; s >= 0; --s) {
        const bf16_t* kr = Ks + ((size_t)b * SEQ + s) * SBW + h * 64; const bf16_t* vr = Vs + ((size_t)b * SEQ + s) * SBW + h * 64;
        float z = 0.f;
#pragma unroll
        for (int d = 0; d < 64; ++d) z += q[d] * bf2f(kr[d]);
        const bool valid = s < t;
        const float sp = valid ? (fmaxf(z, 0.f) + __log2f(1.f + exp2f(-fabsf(z)))) : 0.f;
        const float w = valid ? exp2f(z - (R + sp)) : 0.f;
        R += sp;
        const float wb = bf2f((bf16_t)f2bf(w));
#pragma unroll
        for (int d = 0; d < 64; ++d) o[d] += wb * bf2f(vr[d]);
    }
    float ss = 0.f;
#pragma unroll
    for (int d = 0; d < 64; ++d) { ss += o[d] * o[d]; YY[row * D + RW + h * 64 + d] = (bf16_t)f2bf(o[d]); }
    ssq_s8[row * 8 + h] = ss;
}
__device__ __forceinline__ void xattn_naive_unit(int unit, int j, LAS float* qs, LAS float* ps, const bf16_t* QX, const bf16_t* KVM, bf16_t* OX) {
    const int tg = unit & 511, h = (unit >> 9) & 3, b = unit >> 11, lane = j & 63, wid = j >> 6;
    const size_t row0 = (size_t)b * SEQ + tg * 8;
    for (int i = 0; i < 8; ++i) qs[i * 256 + j] = bf2f(QX[(row0 + i) * D + h * XD + j]);
    __syncthreads();
    const bf16_t* kr = KVM + ((size_t)b * MEM + j) * 2048 + h * XD;
    float sc[8];
#pragma unroll
    for (int i = 0; i < 8; ++i) sc[i] = 0.f;
    for (int d = 0; d < XD; ++d) { const float kv = bf2f(kr[d]);
#pragma unroll
        for (int i = 0; i < 8; ++i) sc[i] += qs[i * 256 + d] * kv; }
#pragma unroll
    for (int i = 0; i < 8; ++i) ps[i * 256 + j] = sc[i];
    __syncthreads();
    for (int i = wid * 2; i < wid * 2 + 2; ++i) {
        float v0 = ps[i * 256 + lane], v1 = ps[i * 256 + lane + 64], v2 = ps[i * 256 + lane + 128], v3 = ps[i * 256 + lane + 192];
        float m = fmaxf(fmaxf(v0, v1), fmaxf(v2, v3));
#pragma unroll
        for (int o = 1; o < 64; o <<= 1) m = fmaxf(m, __shfl_xor(m, o));
        v0 = exp2f(v0 - m); v1 = exp2f(v1 - m); v2 = exp2f(v2 - m); v3 = exp2f(v3 - m);
        const float s = wave_sum(v0 + v1 + v2 + v3), inv = 1.f / s;
        ps[i * 256 + lane] = v0 * inv; ps[i * 256 + lane + 64] = v1 * inv; ps[i * 256 + lane + 128] = v2 * inv; ps[i * 256 + lane + 192] = v3 * inv;
    }
    __syncthreads();
    float o[8];
#pragma unroll
    for (int i = 0; i < 8; ++i) o[i] = 0.f;
    for (int m = 0; m < MEM; ++m) { const float vv = bf2f(KVM[((size_t)b * MEM + m) * 2048 + 1024 + h * XD + j]);
#pragma unroll
        for (int i = 0; i < 8; ++i) o[i] += ps[i * 256 + m] * vv; }
#pragma unroll
    for (int i = 0; i < 8; ++i) OX[(row0 + i) * D + h * XD + j] = (bf16_t)f2bf(o[i]);
    __syncthreads();
}
__device__ __forceinline__ int router_row(int row, int lane, const bf16_t* X2b, const float* ssq2p, const float* g, const float* wgr, const float* bgr, const float* wer, const float* ber, float* selw) {
    int cls = 0;
    float acc[20];
#pragma unroll
    for (int i = 0; i < 20; ++i) acc[i] = 0.f;
    const float rs = pg8::rstd16(ssq2p + (size_t)row * 16);
    for (int kk = 0; kk < 16; ++kk) { const int k = kk * 64 + lane; const float t = bf2f(X2b[(size_t)row * D + k]) * rs * g[k];
#pragma unroll
        for (int i = 0; i < 4; ++i) acc[i] += t * wgr[k * 4 + i];
#pragma unroll
        for (int gi = 0; gi < 4; ++gi)
#pragma unroll
            for (int e = 0; e < 4; ++e) acc[4 + gi * 4 + e] += t * wer[((size_t)gi * D + k) * 4 + e]; }
#pragma unroll
    for (int i = 0; i < 20; ++i) acc[i] = wave_sum(acc[i]);
    if (lane == 0) {
        float gl[4]; float gm = -INFINITY; int gi = 0;
#pragma unroll
        for (int i = 0; i < 4; ++i) { gl[i] = acc[i] + bgr[i]; if (gl[i] > gm) { gm = gl[i]; gi = i; } }
        float gs = 0.f;
#pragma unroll
        for (int i = 0; i < 4; ++i) gs += __expf(gl[i] - gm);
        const float gp = 1.f / gs;
        float el[4];
#pragma unroll
        for (int e = 0; e < 4; ++e) { float v = 0.f;
#pragma unroll
            for (int q = 0; q < 4; ++q) if (q == gi) v = acc[4 + q * 4 + e] + ber[q * 4 + e];
            el[e] = v; }
        int e1 = 0; float m1 = el[0];
#pragma unroll
        for (int e = 1; e < 4; ++e) if (el[e] > m1) { m1 = el[e]; e1 = e; }
        int e2 = -1; float m2 = -INFINITY;
#pragma unroll
        for (int e = 0; e < 4; ++e) if (e != e1 && el[e] > m2) { m2 = el[e]; e2 = e; }
        const float p2 = __expf(m2 - m1), w1 = gp / (1.f + p2), w2 = gp * p2 / (1.f + p2);
        const int ea = e1 < e2 ? e1 : e2, eb = e1 < e2 ? e2 : e1; const float wA = e1 < e2 ? w1 : w2, wB = e1 < e2 ? w2 : w1;
        const int pr = (ea == 0) ? eb - 1 : (ea == 1) ? eb + 1 : 5;
        selw[(size_t)row * 2] = wA; selw[(size_t)row * 2 + 1] = wB; cls = gi * 6 + pr;
    }
    return cls;
}
__device__ __forceinline__ void final_row(int row, int lane, const bf16_t* X3b, const float* ssq3, const float* g, float* out) {
    float v[16]; float s = 0.f;
#pragma unroll
    for (int j = 0; j < 16; ++j) { v[j] = bf2f(X3b[(size_t)row * D + j * 64 + lane]); s += v[j] * v[j]; }
    const float r = pg8::rstd16(ssq3 + (size_t)row * 16);
#pragma unroll
    for (int j = 0; j < 16; ++j) out[(size_t)row * D + j * 64 + lane] = v[j] * r * g[j * 64 + lane];
}

__device__ __forceinline__ void reids(Ctx& C) { int t_ = threadIdx.x; asm volatile("" : "+v"(t_)); C.tid = t_; C.lane = t_ & 63; C.wave = __builtin_amdgcn_readfirstlane(t_ >> 6); C.gw = C.bid * NWAVES + C.wave; }
__global__ void __launch_bounds__(NTHREADS, 2) mk_fwd(Args args) {
    extern __shared__ __attribute__((aligned(16))) unsigned char lds[];
    cg::grid_group grid = cg::this_grid();
    Ctx C;
#pragma unroll
    for (int i = 0; i < 29; ++i) C.in[i] = args.in[i];
    C.out = args.out; C.ws = args.ws; C.lds = lds;
    C.tid = threadIdx.x; C.lane = C.tid & 63; C.wave = __builtin_amdgcn_readfirstlane(C.tid >> 6);
    C.G = gridDim.x; C.bid = blockIdx.x; C.gw = C.bid * NWAVES + C.wave; C.NGW = C.G * NWAVES;
    const float* x = C.in[0]; const float* mem = C.in[1]; const float* norm_mix = C.in[2]; const float* w_in = C.in[3];
    const float* conv_w = C.in[4]; const float* conv_b = C.in[5]; const float* lru_w_a = C.in[6]; const float* lru_b_a = C.in[7];
    const float* lru_w_x = C.in[8]; const float* lru_b_x = C.in[9]; const float* lru_lambda = C.in[10];
    const float* norm_rnn = C.in[11]; const float* norm_sb = C.in[12]; const float* w_out = C.in[13];
    const float* norm_xattn = C.in[14]; const float* norm_mem = C.in[15];
    const float* xa_w_q = C.in[16]; const float* xa_w_k = C.in[17]; const float* xa_w_v = C.in[18]; const float* xa_w_o = C.in[19];
    const float* norm_moe = C.in[20]; const float* w_gr = C.in[21]; const float* b_gr = C.in[22]; const float* w_er = C.in[23]; const float* b_er = C.in[24];
    const float* w_gate = C.in[25]; const float* w_up = C.in[26]; const float* w_down = C.in[27]; const float* norm_final = C.in[28];
    unsigned char* ws = C.ws; float* out = C.out;
    float* sm = (float*)(ws + WS_SMALL);
    float* rstd0 = sm + SM_RSTD0; float* ssq_r = sm + SM_SSQR; float* ssq_s = sm + SM_SSQS; float* ssq1 = sm + SM_SSQ1; float* ssq2 = sm + SM_SSQ2; unsigned* kmax = (unsigned*)(ws + WS_CTL); float* fmid = sm + SM_END; float* fend = fmid + 32768;
    float* aggP = sm + 96 * 32768; float* aggH = sm + 104 * 32768;
    float* selw = sm + SM_SELW; float* ssq3 = sm + SM_SSQ3; int* gcnt = (int*)(ws + WS_CTL + 1024);
    int* tlist = (int*)(sm + 64 * 32768); float* rsg = sm + 88 * 32768; float* wAg = rsg + 40960; float* wBg = wAg + 40960; int* tokg = (int*)(wBg + 40960);
    bf16_t* Wg_t = (bf16_t*)(ws + WS_WG); bf16_t* Wu_t = (bf16_t*)(ws + WS_WU); bf16_t* Wd2 = (bf16_t*)(ws + WS_WD2); bf16_t* XG = (bf16_t*)(ws + WS_R1); bf16_t* HID = (bf16_t*)(ws + WS_R5);
    bf16_t* Win_t = (bf16_t*)(ws + WS_WIN); bf16_t* Wout_t = (bf16_t*)(ws + WS_WOUT); bf16_t* Wq_t = (bf16_t*)(ws + WS_WQ); bf16_t* Wkv_t = (bf16_t*)(ws + WS_WKV); bf16_t* Wo_t = (bf16_t*)(ws + WS_WO);
    bf16_t* memn = (bf16_t*)(ws + WS_MEMN); bf16_t* KM = (bf16_t*)(ws + WS_KVM); bf16_t* VT = KM + (size_t)NMEM * D;
    bf16_t* xb = (bf16_t*)(ws + WS_R0); bf16_t* X1b = xb; bf16_t* X3b = xb;
    bf16_t* XR = (bf16_t*)(ws + WS_R1); bf16_t* GG = XR + (size_t)NTOK * RW; bf16_t* QX = XR;
    bf16_t* Qs = (bf16_t*)(ws + WS_R2); bf16_t* Ks = Qs + (size_t)NTOK * SBW; bf16_t* OX = Qs;
    bf16_t* Vs = (bf16_t*)(ws + WS_R3);
    bf16_t* YY = (bf16_t*)(ws + WS_R4); bf16_t* X2b = YY;
    const int NGW = C.NGW;
#define gw C.gw
#define lane C.lane
    if (C.tid < 64) ((LAS unsigned*)(lds + 146432))[C.tid] = 0u;
    __syncthreads();
    XcdBarrier bar = xcd_barrier_post((unsigned*)(ws + WS_CTL + 4096), (volatile LAS unsigned*)(lds + 146432 + 32));
#define GRID_SYNC_CG() do { grid.sync(); reids(C); } while (0)
#define GRID_SYNC() do { xcd_barrier(bar); reids(C); } while (0)

    {
        if (gw == 0) { kmax[lane] = 0u; if (lane < 32) gcnt[lane] = 0; }
        for (int r = gw; r < NTOK; r += NGW) row_prep_x(x, xb, rstd0, r, lane);
        for (int r = gw; r < NMEM; r += NGW) row_prep_mem(mem, norm_mem, memn, r, lane);
        LAS float* scr = (LAS float*)(lds) + C.wave * (64 * 33);
        constexpr int I_IN = (D / 64) * (PROJ / 32), I_SQ = (D / 64) * (D / 32);
        for (int it = gw; it < I_IN + 5 * I_SQ; it += NGW) {
            int r = it;
            if (r < I_IN) { transpose_item(w_in, D, PROJ, Win_t, D, norm_mix, norm_mix, D, scr, r, lane); continue; } r -= I_IN;
            if (r < I_SQ) { transpose_item(w_out, D, D, Wout_t, D, norm_rnn, norm_sb, RW, scr, r, lane); continue; } r -= I_SQ;
            if (r < I_SQ) { transpose_item(xa_w_q, D, D, Wq_t, D, norm_xattn, norm_xattn, D, scr, r, lane); continue; } r -= I_SQ;
            if (r < I_SQ) { transpose_item(xa_w_k, D, D, Wkv_t, D, nullptr, nullptr, 0, scr, r, lane); continue; } r -= I_SQ;
            if (r < I_SQ) { transpose_item(xa_w_v, D, D, Wkv_t + (size_t)D * D, D, nullptr, nullptr, 0, scr, r, lane); continue; } r -= I_SQ;
            transpose_item(xa_w_o, D, D, Wo_t, D, nullptr, nullptr, 0, scr, r, lane);
        }
        constexpr int I_GU = (D / 64) * (DE / 32), I_DN = (DE / 64) * (D / 32);
        for (int it = gw; it < 32 * I_GU + 48 * I_DN; it += NGW) {
            int r = it;
            if (r < 16 * I_GU) { const int e = r / I_GU; transpose_item(w_gate + (size_t)e * D * DE, D, DE, Wg_t + (size_t)e * DE * D, D, norm_moe, norm_moe, D, scr, r % I_GU, lane); continue; } r -= 16 * I_GU;
            if (r < 16 * I_GU) { const int e = r / I_GU; transpose_item(w_up + (size_t)e * D * DE, D, DE, Wu_t + (size_t)e * DE * D, D, norm_moe, norm_moe, D, scr, r % I_GU, lane); continue; } r -= 16 * I_GU;
            { const int cs = r / I_DN, cls = cs >> 1, slot = cs & 1; int ea, eb; pg8::pair_ab(cls % 6, ea, eb); const int e = (cls / 6) * 4 + (slot ? eb : ea);
              transpose_item(w_down + (size_t)e * DE * D, DE, D, Wd2 + (size_t)cls * D * 512 + slot * DE, 512, nullptr, nullptr, 0, scr, r % I_DN, lane); }
        }
    }
    GRID_SYNC_CG();
    { pg8::DenseOrder S; S.init(xb, D, Win_t, D, NTOK, PROJ, C.G, C.bid); pg8::EpiInProjF E{0, rstd0, XR, GG, Qs, Ks, Vs, kmax};
      pg8::gemm_phase<pg8::EpiInProjF, pg8::DenseOrder, true>((LAS unsigned char*)lds, pg8::Gemm{D, D, D}, S, E); }
    { pg8::DenseOrder S; S.init(memn, D, Wkv_t, D, NMEM, D, C.G, C.bid); pg8::EpiBf16F E{0, KM, nullptr, D, 1.f, 0};
      pg8::gemm_phase<pg8::EpiBf16F, pg8::DenseOrder, true>((LAS unsigned char*)lds, pg8::Gemm{D, D, D}, S, E); }
    { pg8::DenseOrder S; S.init(Wkv_t + (size_t)D * D, D, memn, D, D, NMEM, C.G, C.bid); pg8::EpiBf16F E{0, VT, nullptr, MEM, 1.f, (size_t)D * MEM};
      pg8::gemm_phase<pg8::EpiBf16F, pg8::DenseOrder, true>((LAS unsigned char*)lds, pg8::Gemm{D, D, D}, S, E); }
    GRID_SYNC();
    lru::Weights LW; lru::load_weights(LW, C.wave, lane & 31, lane >> 5, lru_w_a, lru_b_a, lru_w_x, lru_b_x, lru_lambda);
    {
        for (int u = C.bid; u < BATCH * 64; u += C.G) lru::unit<false>(u >> 6, u & 63, LW, XR, GG, conv_w, conv_b, aggP, aggH, ssq_s, YY, fmid, fend, lds);
        for (int u = C.bid; u < BATCH * NH * 16; u += C.G) sba::sb_unit(u >> 7, (u >> 4) & 7, 15 - (u & 15), Qs, Ks, Vs, YY, ssq_s, kmax, (char*)lds);
    }
    GRID_SYNC();
    for (int u = C.bid; u < BATCH * 64; u += C.G) lru::unit<true>(u >> 6, u & 63, LW, XR, GG, conv_w, conv_b, aggP, aggH, ssq_s, YY, fmid, fend, lds);
    GRID_SYNC();
    { pg8::DenseOrder S; S.init(YY, D, Wout_t, D, NTOK, D, C.G, C.bid); pg8::EpiX1F E{8, x, fmid, fend, X1b, ssq1};
      pg8::gemm_phase<pg8::EpiX1F, pg8::DenseOrder, true>((LAS unsigned char*)lds, pg8::Gemm{D, D, D}, S, E); }
    GRID_SYNC();
    { pg8::DenseOrder S; S.init(X1b, D, Wq_t, D, NTOK, D, C.G, C.bid); pg8::EpiBf16F E{0, QX, ssq1, D, 0.0625f * LOG2E, 0};
      pg8::gemm_phase<pg8::EpiBf16F, pg8::DenseOrder, true>((LAS unsigned char*)lds, pg8::Gemm{D, D, D}, S, E); }
    GRID_SYNC();
    { pg8::XaSOrder S{QX, KM, C.G, C.bid}; pg8::EpiSoftmax E{0, QX, (LAS float*)(lds + 131072 + 2048)};
      pg8::gemm_phase<pg8::EpiSoftmax, pg8::XaSOrder, true>((LAS unsigned char*)lds, pg8::Gemm{D, D, XD}, S, E); }
    GRID_SYNC();
    { pg8::XaOOrder S{QX, VT, C.G, C.bid}; pg8::EpiBf16F E{0, OX, nullptr, D, 1.f, 0};
      pg8::gemm_phase<pg8::EpiBf16F, pg8::XaOOrder, true>((LAS unsigned char*)lds, pg8::Gemm{D, MEM, MEM}, S, E); }
    GRID_SYNC();
    { pg8::DenseOrder S; S.init(OX, D, Wo_t, D, NTOK, D, C.G, C.bid); pg8::EpiResF E{0, X1b, X2b, ssq2};
      pg8::gemm_phase<pg8::EpiResF, pg8::DenseOrder, true>((LAS unsigned char*)lds, pg8::Gemm{D, D, D}, S, E); }
    GRID_SYNC();
    {
        LAS int* lcnt = (LAS int*)lds; LAS int* lbase = lcnt + 32; LAS int* lcls = lcnt + 64; LAS int* lpos = lcnt + 192;
        for (int chunk = C.bid; chunk < NTOK / 128; chunk += C.G) {
            if (C.tid < 32) lcnt[C.tid] = 0;
            __syncthreads();
            for (int i = 0; i < 16; ++i) { const int lt = C.wave * 16 + i, row = chunk * 128 + lt;
                const int cls = router_row(row, lane, X2b, ssq2, norm_moe, w_gr, b_gr, w_er, b_er, selw);
                if (lane == 0) { lcls[lt] = cls; lpos[lt] = __hip_atomic_fetch_add(lcnt + cls, 1, __ATOMIC_RELAXED, __HIP_MEMORY_SCOPE_WORKGROUP); } }
            __syncthreads();
            if (C.tid < 24) lbase[C.tid] = atomicAdd(gcnt + C.tid, lcnt[C.tid]);
            __syncthreads();
            if (C.tid < 128) { const int c = lcls[C.tid]; tlist[(size_t)c * NTOK + lbase[c] + lpos[C.tid]] = chunk * 128 + C.tid; }
            __syncthreads();
        }
    }
    GRID_SYNC();
    LAS int* meta = (LAS int*)(lds + 146432 + 256);
    {
        if (C.tid == 0) { int rb = 0, tb = 0;
            for (int c = 0; c < 24; ++c) { const int n = gcnt[c], nt = (n + 255) >> 8; meta[c] = n; meta[32 + c] = rb; meta[64 + c] = tb; rb += nt * 256; tb += nt; }
            meta[32 + 24] = rb; meta[64 + 24] = tb; }
        __syncthreads();
        const int total = meta[32 + 24];
        for (int R = gw; R < total; R += NGW) {
            int c = 0;
            for (int k = 1; k < 24; ++k) c += (R >= meta[32 + k]) ? 1 : 0;
            const int p = R - meta[32 + c]; u32x4 v0 = (u32x4){0u, 0u, 0u, 0u}, v1 = v0; int tok = -1; float rs = 0.f, wA = 0.f, wB = 0.f;
            if (p < meta[c]) { tok = tlist[(size_t)c * NTOK + p]; const u32x4* src = (const u32x4*)(X2b + (size_t)tok * D) + lane; v0 = src[0]; v1 = src[64];
                rs = pg8::rstd16(ssq2 + (size_t)tok * 16); wA = selw[(size_t)tok * 2]; wB = selw[(size_t)tok * 2 + 1]; }
            u32x4* dst = (u32x4*)(XG + (size_t)R * D) + lane; dst[0] = v0; dst[64] = v1;
            if (lane == 0) { rsg[R] = rs; wAg[R] = wA; wBg[R] = wB; tokg[R] = tok; }
        }
    }
    GRID_SYNC();
    { pg8::MoeOrder1 S{XG, Wg_t, Wu_t, meta, C.G, C.bid}; pg8::EpiMoeUp E{0, rsg, wAg, wBg, HID};
      pg8::gemm_phase<pg8::EpiMoeUp, pg8::MoeOrder1, true>((LAS unsigned char*)lds, pg8::Gemm{D, D, D}, S, E); }
    GRID_SYNC();
    { pg8::MoeOrder2 S{HID, Wd2, meta, C.G, C.bid}; pg8::EpiMoeDown E{0, tokg, X2b, X3b, ssq3};
      pg8::gemm_phase<pg8::EpiMoeDown, pg8::MoeOrder2, true>((LAS unsigned char*)lds, pg8::Gemm{512, 512, 512}, S, E); }
    GRID_SYNC();
    for (int r = gw; r < NTOK; r += NGW) final_row(r, lane, X3b, ssq3, norm_final, out);
}

#undef gw
#undef lane
extern "C" void kernel_launch(void* const* d_in, const int* in_sizes, int n_in, void* d_out, int out_size, void* d_ws, size_t ws_size, hipStream_t stream) {
    static int grid = 0;
    if (grid == 0) {
        if (n_in != 29 || ws_size < WS_END) { fprintf(stderr, "kernel_launch: unexpected inputs (%d) or workspace (%zu)\n", n_in, ws_size); grid = -1; return; }
        int dev = 0, cus = 0, per_cu = 0;
        hipGetDevice(&dev); hipDeviceGetAttribute(&cus, hipDeviceAttributeMultiprocessorCount, dev);
        hipFuncSetAttribute((const void*)mk_fwd, hipFuncAttributeMaxDynamicSharedMemorySize, LDS_BYTES);
        hipOccupancyMaxActiveBlocksPerMultiprocessor(&per_cu, (const void*)mk_fwd, NTHREADS, LDS_BYTES);
        if (per_cu < 1) { fprintf(stderr, "kernel_launch: occupancy query says %d blocks per CU\n", per_cu); per_cu = 1; }
        if (per_cu > 1) per_cu = 1;
        grid = cus * per_cu;
    }
    if (grid < 0) return;
    if (hipMemsetAsync((char*)d_ws + WS_CTL + 4096, 0, 16384, stream) != hipSuccess) { fprintf(stderr, "kernel_launch: memset of the barrier words failed\n"); return; }
    Args a{};
    for (int i = 0; i < 29; ++i) a.in[i] = (const float*)d_in[i];
    a.out = (float*)d_out; a.ws = (unsigned char*)d_ws;
    void* kargs[] = {&a};
    hipError_t e = hipLaunchCooperativeKernel((const void*)mk_fwd, dim3(grid), dim3(NTHREADS), kargs, LDS_BYTES, stream);
    if (e != hipSuccess) fprintf(stderr, "cooperative launch failed: %s (grid %d)\n", hipGetErrorString(e), grid);
}
```

```cpp
#include <hip/hip_runtime.h>
#include <hip/hip_cooperative_groups.h>
#include <cstdio>
#include <cstdint>

typedef unsigned short bf16_t;
typedef short bf16x8 __attribute__((ext_vector_type(8)));
typedef float f32x4 __attribute__((ext_vector_type(4)));
typedef unsigned u32x4 __attribute__((ext_vector_type(4)));

constexpr int D = 1024, BATCH = 8, SEQ = 4096, NTOK = BATCH * SEQ, MEM = 256, NMEM = BATCH * MEM;
constexpr int RW = 512, SBW = 512, PROJ = 2560, NH = 8, HD = 64;
constexpr int XH = 4, XD = 256, NG = 4, EPG = 4, NEXP = 16, DE = 256;
constexpr float EPS = 1e-6f, LOG2E = 1.4426950408889634f;

constexpr size_t MiB = 1u << 20;
constexpr size_t WS_CTL = 0;
constexpr size_t WS_SMALL = 1 * MiB;
constexpr size_t WS_WIN = 16 * MiB;
constexpr size_t WS_WOUT = 21 * MiB;
constexpr size_t WS_WQ = 23 * MiB;
constexpr size_t WS_WKV = 25 * MiB;
constexpr size_t WS_WO = 29 * MiB;
constexpr size_t WS_MEMN = 31 * MiB;
constexpr size_t WS_KVM = 35 * MiB;
constexpr size_t WS_WG = 43 * MiB;
constexpr size_t WS_WU = 51 * MiB;
constexpr size_t WS_WD2 = 59 * MiB;
constexpr size_t WS_R0 = 96 * MiB;
constexpr size_t WS_R1 = 160 * MiB;
constexpr size_t WS_R2 = 224 * MiB;
constexpr size_t WS_R3 = 288 * MiB;
constexpr size_t WS_R4 = 320 * MiB;
constexpr size_t WS_R5 = 384 * MiB;
constexpr size_t WS_END = 448 * MiB;

constexpr size_t SM_RSTD0 = 0;
constexpr size_t SM_SSQR = 1 * 32768;
constexpr size_t SM_SSQS = 2 * 32768;
constexpr size_t SM_SSQ1 = 10 * 32768;
constexpr size_t SM_SSQ2 = 26 * 32768;
constexpr size_t SM_SSQ3 = 42 * 32768;
constexpr size_t SM_SELW = 58 * 32768;
constexpr size_t SM_SELE = 60 * 32768;
constexpr size_t SM_END = 62 * 32768;

__device__ __forceinline__ unsigned f2bf(float f) { unsigned u = __builtin_bit_cast(unsigned, f); return (u + 0x7fffu + ((u >> 16) & 1u)) >> 16; }
__device__ __forceinline__ float bf2f(unsigned short h) { return __builtin_bit_cast(float, (unsigned)h << 16); }
__device__ __forceinline__ float wave_sum(float v) {
#pragma unroll
    for (int o = 1; o < 64; o <<= 1) v += __shfl_xor(v, o);
    return v;
}
__device__ __forceinline__ float gelu_tanh(float x) { const float u = 0.7978845608028654f * (x + 0.044715f * x * x * x); return x / (1.f + __expf(-2.f * u)); }
__device__ __forceinline__ float sigmoidf_(float x) { return 1.f / (1.f + __expf(-x)); }

namespace cg = cooperative_groups;
#ifndef REP_MASK
#define REP_MASK 0u
#endif
#define LAS __attribute__((address_space(3)))
constexpr int NWAVES = 8, NTHREADS = 512;
constexpr int LDS_BYTES = 147456;

struct Args { const float* in[29]; float* out; unsigned char* ws; };

struct Ctx {
    const float* in[29]; float* out; unsigned char* ws; unsigned char* lds;
    int tid, lane, wave, gw, NGW, G, bid;
};

#define RLX_AGENT __ATOMIC_RELAXED, __HIP_MEMORY_SCOPE_AGENT
#define XB_TMO      128
#define XB_XCNT(j)  (256  + 64 * (j))
#define XB_XSUB(j)  (1280 + 64 * (j))
#define XB_XGEN(j)  (2304 + 64 * (j))
#define XB_TOP      3328
#define XB_TOPGEN   3392
#define XCD_BAR_WORDS 3456
#define XB_SPIN_CAP (1u << 18)

__device__ __forceinline__ unsigned xb_ld(unsigned* p)              { return __hip_atomic_load(p, __ATOMIC_RELAXED, __HIP_MEMORY_SCOPE_AGENT); }
__device__ __forceinline__ unsigned xb_add(unsigned* p, unsigned v) { return __hip_atomic_fetch_add(p, v, __ATOMIC_RELAXED, __HIP_MEMORY_SCOPE_AGENT); }
__device__ __forceinline__ unsigned xb_xcc_id() { return (unsigned)__builtin_amdgcn_s_getreg((3 << 11) | 20) & 0xFu; }
#define XB_SPIN(cond, bar) do { unsigned _sp = 0; while (cond) { __builtin_amdgcn_s_sleep(1); \
    if ((++_sp & 255u) == 0u) { if (xb_ld(&(bar)[XB_TMO])) break; if (_sp > XB_SPIN_CAP) { atomicAdd(&(bar)[XB_TMO], 1u); break; } } } } while (0)

struct XcdBarrier {
    unsigned* bar; unsigned x;
    volatile LAS unsigned* st;
};

__device__ __forceinline__ XcdBarrier xcd_barrier_post(unsigned* bar, volatile LAS unsigned* st) {
    XcdBarrier b; b.bar = bar; b.x = xb_xcc_id(); b.st = st;
    if (threadIdx.x == 0) (void)xb_add(&bar[XB_XCNT(b.x)], 1u);
    return b;
}
__device__ __forceinline__ void xcd_barrier_complete(unsigned* bar, unsigned x, unsigned& nloc, unsigned& nx) {
    const unsigned G = gridDim.x * gridDim.y * gridDim.z;
    unsigned sum, cnt, mine, sp = 0u;
    for (;;) {
        sum = 0u; cnt = 0u; mine = 0u;
#pragma unroll
        for (unsigned j = 0; j < 16; ++j) { const unsigned c = xb_ld(&bar[XB_XCNT(j)]); sum += c; cnt += (c > 0u) ? 1u : 0u; mine = (j == x) ? c : mine; }
        if (sum == G) break;
        __builtin_amdgcn_s_sleep(1);
        if ((++sp & 255u) == 0u) { if (xb_ld(&bar[XB_TMO])) break; if (sp > XB_SPIN_CAP) { atomicAdd(&bar[XB_TMO], 1u); break; } }
    }
    nloc = mine > 0u ? mine : 1u; nx = cnt > 0u ? cnt : 1u;
}

__device__ __forceinline__ void xcd_barrier(const XcdBarrier& b) {
    asm volatile("s_waitcnt vmcnt(0)" ::: "memory");
    __syncthreads();
    if (threadIdx.x == 0) {
        unsigned* bar = b.bar;
        __builtin_amdgcn_s_waitcnt(0);
        unsigned nloc = b.st[0], nx = b.st[1];
        if (nloc == 0u) { xcd_barrier_complete(bar, b.x, nloc, nx); b.st[0] = nloc; b.st[1] = nx; }
        const unsigned old = xb_add(&bar[XB_XSUB(b.x)], 1u);
        const unsigned gen = old / nloc;
        if (old + 1u == (gen + 1u) * nloc) {
            __builtin_amdgcn_fence(__ATOMIC_RELEASE, "agent");
            asm volatile("s_waitcnt vmcnt(0)" ::: "memory");
            const unsigned og = xb_add(&bar[XB_TOP], 1u);
            const unsigned tg = og / nx;
            if (og + 1u == (tg + 1u) * nx) xb_add(&bar[XB_TOPGEN], 1u);
            else XB_SPIN(xb_ld(&bar[XB_TOPGEN]) == tg, bar);
            __builtin_amdgcn_fence(__ATOMIC_ACQUIRE, "agent");
            xb_add(&bar[XB_XGEN(b.x)], 1u);
            asm volatile("s_waitcnt vmcnt(0)" ::: "memory");
        } else {
            XB_SPIN(xb_ld(&bar[XB_XGEN(b.x)]) == gen, bar);
            __builtin_amdgcn_fence(__ATOMIC_ACQUIRE, "agent");
            asm volatile("s_waitcnt vmcnt(0)" ::: "memory");
        }
    }
    __syncthreads();
}
namespace pg8 {
#define PG8_LAS __attribute__((address_space(3)))
constexpr int BM = 256, BK = 64, HALF = 128, HTB = HALF * BK * 2  , STAGE_BYTES = 8 * HTB, NXCD = 8, WGM = 8;
__host__ __device__ __forceinline__ int lds_byte(int r, int c) { const int st = (r >> 4) * 2 + (c >> 5), rr = r & 15, cc = c & 31, ob = rr * 64 + cc * 2; return st * 1024 + (ob ^ (((ob >> 9) & 1) << 5)); }
__host__ __device__ __forceinline__ void stage_rc(int b, int& R, int& C) { const int st = b / 1024, sb = b % 1024, swz = sb ^ (((sb >> 9) & 1) << 5); R = (st >> 1) * 16 + swz / 64; C = (st & 1) * 32 + (swz % 64) / 2; }
__host__ __device__ __forceinline__ int perm32(int rho) { const int n = rho >> 4, i = rho & 15; return 8 * (i >> 2) + 4 * n + (i & 3); }

struct Unit { int pm, pn; };
struct Gemm { int lda, ldb, K; };
struct DenseOrder {
    const bf16_t* A; const bf16_t* Bt; int lda, ldb; int nM, nN, nwg, G, c;
    __device__ void init(const bf16_t* A_, int lda_, const bf16_t* Bt_, int ldb_, int M, int N, int G_, int c_) { A = A_; Bt = Bt_; lda = lda_; ldb = ldb_; nM = M / BM; nN = N / BM; nwg = nM * nN; G = G_; c = c_; }
    __device__ bool next(int i, Unit& u) const {
        const long L = (long)i * G + c; if (L >= nwg) return false;
        int wgid = (int)L; { const int q = nwg / NXCD, r = nwg % NXCD, xcd = wgid % NXCD, off = wgid / NXCD; wgid = (xcd < r ? xcd * (q + 1) : r * (q + 1) + (xcd - r) * q) + off; }
        const int nig = WGM * nN, gid = wgid / nig, fm = gid * WGM, gsz = (nM - fm) < WGM ? (nM - fm) : WGM;
        u.pm = fm + ((wgid % nig) % gsz); u.pn = (wgid % nig) / gsz; return true;
    }
    __device__ __forceinline__ void ptrs(const Unit& u, const char*& a, const char*& b0, const char*& b1) const {
        a = (const char*)A + (size_t)u.pm * BM * lda * 2; b0 = (const char*)Bt + (size_t)u.pn * BM * ldb * 2; b1 = b0 + (size_t)HALF * ldb * 2; }
};

__device__ __forceinline__ unsigned cvt_pk_bf16(float lo, float hi) { unsigned r; asm volatile("v_cvt_pk_bf16_f32 %0, %1, %2" : "=v"(r) : "v"(lo), "v"(hi)); return r; }

template <class Epi, class Sched, bool ALIGN_EPI>
__device__ __forceinline__ void gemm_phase(PG8_LAS unsigned char* lds, const Gemm g, const Sched& S, const Epi& E) {
    int tid_ = threadIdx.x; asm volatile("" : "+v"(tid_));
    const int tid = tid_, wid = __builtin_amdgcn_readfirstlane(tid >> 6), lane = tid & 63, wr = wid >> 2, wc = wid & 3, fr = lane & 15, fq = lane >> 4;
    int nt_ = g.K / BK; asm volatile("" : "+s"(nt_)); const int nt = nt_;
    unsigned voffA[2], voffB[2];
#pragma unroll
    for (int i = 0; i < 2; ++i) { int R, C; stage_rc(tid * 16 + i * 8192, R, C); const int Rb = Epi::PERM ? ((R & ~31) + perm32(R & 31)) : R;
        voffA[i] = (unsigned)(R * g.lda + C) * 2u; voffB[i] = (unsigned)(Rb * g.ldb + C) * 2u; }
    const size_t kstep = (size_t)(BK * 2);
    const size_t hstepA = (size_t)HALF * g.lda * 2;
    const unsigned ldsw = (unsigned)wid * 1024u;
    const int aoff = lds_byte(wr * 64 + fr, fq * 8), boff = lds_byte(wc * 32 + fr, fq * 8);
#define PG8_SA(b, h) (((b) * 2 + (h)) * HTB)
#define PG8_SB(b, h) ((4 + (b) * 2 + (h)) * HTB)
#define PG8_STAGE(bufoff, gbase, voff) do { _Pragma("unroll") for (int _i = 0; _i < 2; ++_i) \
        __builtin_amdgcn_global_load_lds((const unsigned*)((const char*)(gbase) + (voff)[_i]), (PG8_LAS unsigned*)(lds + (bufoff) + ldsw + _i * 8192), 16, 0, 0); } while (0)
#define PG8_LDA(dst, b, h) do { _Pragma("unroll") for (int m = 0; m < 4; ++m) _Pragma("unroll") for (int k = 0; k < 2; ++k) dst[m][k] = *(const PG8_LAS bf16x8*)(lds + PG8_SA(b, h) + aoff + m * 2048 + k * 1024); } while (0)
#define PG8_LDB(dst, b, h) do { _Pragma("unroll") for (int n = 0; n < 2; ++n) _Pragma("unroll") for (int k = 0; k < 2; ++k) dst[n][k] = *(const PG8_LAS bf16x8*)(lds + PG8_SB(b, h) + boff + n * 2048 + k * 1024); } while (0)
#define PG8_MMA(ai, bj, At, Bt) do { __builtin_amdgcn_s_setprio(1); _Pragma("unroll") for (int m = 0; m < 4; ++m) _Pragma("unroll") for (int n = 0; n < 2; ++n) _Pragma("unroll") for (int k = 0; k < 2; ++k) \
        acc[ai][bj][m][n] = __builtin_amdgcn_mfma_f32_16x16x32_bf16(Bt[n][k], At[m][k], acc[ai][bj][m][n], 0, 0, 0); __builtin_amdgcn_s_setprio(0); } while (0)
#define PG8_WAIT_V(n) asm volatile("s_waitcnt vmcnt(" #n ")" ::: "memory")
#define PG8_WAIT_L(n) asm volatile("s_waitcnt lgkmcnt(" #n ")" ::: "memory")
#define PG8_BAR __builtin_amdgcn_s_barrier()
#define PG8_SCHED __builtin_amdgcn_sched_barrier(0)
    Unit cur, nxt; int ui = 0;
    if (!S.next(0, cur)) return;
    f32x4 acc[2][2][4][2];
#pragma unroll
    for (int a = 0; a < 2; ++a)
#pragma unroll
        for (int b = 0; b < 2; ++b)
#pragma unroll
            for (int m = 0; m < 4; ++m)
#pragma unroll
                for (int n = 0; n < 2; ++n) acc[a][b][m][n] = (f32x4){0.f, 0.f, 0.f, 0.f};
    bf16x8 At[4][2], B0[2][2], B1[2][2];
    const char *cA, *cB0, *cB1; S.ptrs(cur, cA, cB0, cB1);
    PG8_STAGE(PG8_SB(0, 0), cB0, voffB); PG8_STAGE(PG8_SB(0, 1), cB1, voffB); PG8_STAGE(PG8_SA(0, 0), cA, voffA); PG8_STAGE(PG8_SA(0, 1), cA + hstepA, voffA);
    if (wr == 1) PG8_BAR;
    PG8_WAIT_V(2); PG8_BAR;
    PG8_STAGE(PG8_SB(1, 0), cB0 + kstep, voffB); PG8_STAGE(PG8_SA(1, 0), cA + kstep, voffA); PG8_STAGE(PG8_SB(1, 1), cB1 + kstep, voffB);
    PG8_WAIT_V(6); PG8_BAR;
    for (;;) {
        const bool has_next = S.next(ui + 1, nxt);
        const char *nA = cA, *nB0 = cB0, *nB1 = cB1; if (has_next) S.ptrs(nxt, nA, nB0, nB1);
#pragma unroll 1
        for (int t = 0; t < nt; t += 2) {
            const bool last = (t == nt - 2);
            if constexpr (Epi::HAS_MID) { if (t == E.mid_t) E.mid(acc, cur, wr, wc, fr, fq); }
            const char* a1 = cA + (size_t)(t + 1) * kstep;
            const char* a2 = last ? nA : cA + (size_t)(t + 2) * kstep; const char* b2 = last ? nB0 : cB0 + (size_t)(t + 2) * kstep; const char* b2h = last ? nB1 : cB1 + (size_t)(t + 2) * kstep;
            const char* a3 = a2 + kstep; const char* b3 = b2 + kstep; const char* b3h = b2h + kstep;
            PG8_LDB(B0, 0, 0); PG8_LDB(B1, 0, 1); PG8_SCHED; PG8_LDA(At, 0, 0); PG8_STAGE(PG8_SA(1, 1), a1 + hstepA, voffA);
            PG8_WAIT_V(8); PG8_WAIT_L(0); PG8_BAR; PG8_MMA(0, 0, At, B0); PG8_MMA(0, 1, At, B1); PG8_BAR; PG8_SCHED;
            PG8_LDA(At, 0, 1); PG8_STAGE(PG8_SB(0, 0), b2, voffB); PG8_STAGE(PG8_SB(0, 1), b2h, voffB); PG8_STAGE(PG8_SA(0, 0), a2, voffA);
            PG8_WAIT_V(8); PG8_WAIT_L(0); PG8_BAR; PG8_MMA(1, 0, At, B0); PG8_MMA(1, 1, At, B1); PG8_BAR; PG8_SCHED;
            PG8_LDB(B0, 1, 0); PG8_LDB(B1, 1, 1); PG8_SCHED; PG8_LDA(At, 1, 0); PG8_STAGE(PG8_SA(0, 1), a2 + hstepA, voffA);
            PG8_WAIT_V(8); PG8_WAIT_L(0); PG8_BAR; PG8_MMA(0, 0, At, B0); PG8_MMA(0, 1, At, B1); PG8_BAR; PG8_SCHED;
            PG8_LDA(At, 1, 1); PG8_STAGE(PG8_SB(1, 0), b3, voffB); PG8_STAGE(PG8_SB(1, 1), b3h, voffB); PG8_STAGE(PG8_SA(1, 0), a3, voffA);
            PG8_WAIT_V(8); PG8_WAIT_L(0); PG8_BAR; PG8_MMA(1, 0, At, B0); PG8_MMA(1, 1, At, B1); PG8_BAR; PG8_SCHED;
        }
        if constexpr (ALIGN_EPI) { if (wr == 0) PG8_BAR; }
        E(acc, cur, wr, wc, fr, fq);
        if (!has_next) break;
#pragma unroll
        for (int a = 0; a < 2; ++a)
#pragma unroll
            for (int b = 0; b < 2; ++b)
#pragma unroll
                for (int m = 0; m < 4; ++m)
#pragma unroll
                    for (int n = 0; n < 2; ++n) acc[a][b][m][n] = (f32x4){0.f, 0.f, 0.f, 0.f};
        cur = nxt; cA = nA; cB0 = nB0; cB1 = nB1; ++ui;
        if constexpr (ALIGN_EPI) { if (wr == 1) PG8_BAR; }
    }
    PG8_WAIT_V(0);
    if constexpr (!ALIGN_EPI) { if (wr == 0) PG8_BAR; }
    PG8_BAR;
#undef PG8_SA
#undef PG8_SB
#undef PG8_STAGE
#undef PG8_LDA
#undef PG8_LDB
#undef PG8_MMA
#undef PG8_WAIT_V
#undef PG8_WAIT_L
#undef PG8_BAR
#undef PG8_SCHED
}

__device__ __forceinline__ float rstd16(const float* p) { const f32x4 a = ((const f32x4*)p)[0], b = ((const f32x4*)p)[1], c = ((const f32x4*)p)[2], d = ((const f32x4*)p)[3];
    const float s = ((a.x + a.y) + (a.z + a.w)) + ((b.x + b.y) + (b.z + b.w)) + ((c.x + c.y) + (c.z + c.w)) + ((d.x + d.y) + (d.z + d.w)); return 1.0f / sqrtf(s * (1.f / D) + EPS); }
__device__ __forceinline__ u32x4 pack8(const f32x4 v0, const f32x4 v1) { u32x4 w; w.x = cvt_pk_bf16(v0[0], v0[1]); w.y = cvt_pk_bf16(v0[2], v0[3]); w.z = cvt_pk_bf16(v1[0], v1[1]); w.w = cvt_pk_bf16(v1[2], v1[3]); return w; }
__device__ __forceinline__ float sq8(const f32x4 a, const f32x4 b) { return ((a[0] * a[0] + a[1] * a[1]) + (a[2] * a[2] + a[3] * a[3])) + ((b[0] * b[0] + b[1] * b[1]) + (b[2] * b[2] + b[3] * b[3])); }

struct EpiInProjF {
    static constexpr bool PERM = true, HAS_MID = false; int mid_t;
    const float* rstd0; bf16_t *XR, *GG, *Qs, *Ks, *Vs; unsigned* kmax;
    __device__ __forceinline__ void mid(f32x4 (&)[2][2][4][2], const Unit&, int, int, int, int) const {}
    __device__ __forceinline__ void operator()(const f32x4 (&acc)[2][2][4][2], const Unit& u, int wr, int wc, int fr, int fq) const {
        const int row0 = u.pm * BM + wr * 64 + fr, t = u.pn >> 1, colt = (u.pn & 1) * 256 + wc * 32 + 8 * fq;
        bf16_t* base = (t == 0) ? XR : (t == 1) ? GG : (t == 2) ? Qs : (t == 3) ? Ks : Vs;
        float km0 = 0.f, km1 = 0.f;
#pragma unroll
        for (int ai = 0; ai < 2; ++ai)
#pragma unroll
            for (int m = 0; m < 4; ++m) { const int r = row0 + ai * HALF + m * 16; const float rs = rstd0[r]; bf16_t* rowp = base + (size_t)r * 512 + colt;
#pragma unroll
                for (int bj = 0; bj < 2; ++bj) { f32x4 v0 = acc[ai][bj][m][0] * rs, v1 = acc[ai][bj][m][1] * rs;
                    if (t == 1) {
#pragma unroll
                        for (int e = 0; e < 4; ++e) { v0[e] = gelu_tanh(v0[e]); v1[e] = gelu_tanh(v1[e]); } }
                    else if (t == 2) { v0 = v0 * (0.125f * LOG2E); v1 = v1 * (0.125f * LOG2E); }
                    else if (t == 3) { float mx = 0.f;
#pragma unroll
                        for (int e = 0; e < 4; ++e) mx = fmaxf(mx, fmaxf(fabsf(v0[e]), fabsf(v1[e])));
                        if (bj == 0) km0 = fmaxf(km0, mx); else km1 = fmaxf(km1, mx); }
                    *(u32x4*)(rowp + bj * HALF) = pack8(v0, v1); } }
        if (t == 3) {
#pragma unroll
            for (int o = 1; o < 64; o <<= 1) { km0 = fmaxf(km0, __shfl_xor(km0, o)); km1 = fmaxf(km1, __shfl_xor(km1, o)); }
            if ((fr | fq) == 0) { const int b = (u.pm * BM) / SEQ, hd = (u.pn & 1) * 4 + (wc >> 1);
                atomicMax(kmax + b * 8 + hd, __float_as_uint(km0)); atomicMax(kmax + b * 8 + hd + 2, __float_as_uint(km1)); }
        }
    }
};
struct EpiBf16F {
    static constexpr bool PERM = true, HAS_MID = false; int mid_t;
    bf16_t* O; const float* ssq16; int ldo; float scale; size_t tstride;
    __device__ __forceinline__ void mid(f32x4 (&)[2][2][4][2], const Unit&, int, int, int, int) const {}
    __device__ __forceinline__ void operator()(const f32x4 (&acc)[2][2][4][2], const Unit& u, int wr, int wc, int fr, int fq) const {
        const int row0 = u.pm * BM + wr * 64 + fr, col0 = (tstride ? 0 : u.pn * BM) + wc * 32 + 8 * fq; bf16_t* base = O + (size_t)u.pn * tstride;
#pragma unroll
        for (int ai = 0; ai < 2; ++ai)
#pragma unroll
            for (int m = 0; m < 4; ++m) { const int r = row0 + ai * HALF + m * 16; const float rs = (ssq16 ? rstd16(ssq16 + (size_t)r * 16) : 1.f) * scale; bf16_t* rowp = base + (size_t)r * ldo + col0;
#pragma unroll
                for (int bj = 0; bj < 2; ++bj) *(u32x4*)(rowp + bj * HALF) = pack8(acc[ai][bj][m][0] * rs, acc[ai][bj][m][1] * rs); }
    }
};
struct EpiX1F {
    static constexpr bool PERM = true, HAS_MID = true; int mid_t;
    const float* x; const float* fmid; const float* fend; bf16_t* X1b; float* ssq1;
    __device__ __forceinline__ void mid(f32x4 (&acc)[2][2][4][2], const Unit& u, int wr, int wc, int fr, int fq) const {
        const int row0 = u.pm * BM + wr * 64 + fr;
#pragma unroll
        for (int ai = 0; ai < 2; ++ai)
#pragma unroll
            for (int m = 0; m < 4; ++m) { const float f = fmid[row0 + ai * HALF + m * 16];
#pragma unroll
                for (int bj = 0; bj < 2; ++bj) { acc[ai][bj][m][0] = acc[ai][bj][m][0] * f; acc[ai][bj][m][1] = acc[ai][bj][m][1] * f; } }
    }
    __device__ __forceinline__ void operator()(const f32x4 (&acc)[2][2][4][2], const Unit& u, int wr, int wc, int fr, int fq) const {
        const int row0 = u.pm * BM + wr * 64 + fr, col0 = u.pn * BM + wc * 32 + 8 * fq;
#pragma unroll
        for (int ai = 0; ai < 2; ++ai)
#pragma unroll
            for (int m = 0; m < 4; ++m) { const int r = row0 + ai * HALF + m * 16; const float fe = fend[r]; const float* xr = x + (size_t)r * D + col0; float ss = 0.f;
#pragma unroll
                for (int bj = 0; bj < 2; ++bj) { const f32x4 v0 = *(const f32x4*)(xr + bj * HALF) + acc[ai][bj][m][0] * fe, v1 = *(const f32x4*)(xr + bj * HALF + 4) + acc[ai][bj][m][1] * fe;
                    ss += sq8(v0, v1); *(u32x4*)(X1b + (size_t)r * D + col0 + bj * HALF) = pack8(v0, v1); }
                ss += __shfl_xor(ss, 16); ss += __shfl_xor(ss, 32);
                if (fq == 0) ssq1[(size_t)r * 16 + u.pn * 4 + wc] = ss;
                asm volatile("" ::: "memory"); }
    }
};
struct EpiResF {
    static constexpr bool PERM = true, HAS_MID = false; int mid_t;
    const bf16_t* Xi; bf16_t* Xo; float* ssq;
    __device__ __forceinline__ void mid(f32x4 (&)[2][2][4][2], const Unit&, int, int, int, int) const {}
    __device__ __forceinline__ void operator()(const f32x4 (&acc)[2][2][4][2], const Unit& u, int wr, int wc, int fr, int fq) const {
        const int row0 = u.pm * BM + wr * 64 + fr, col0 = u.pn * BM + wc * 32 + 8 * fq;
#pragma unroll
        for (int ai = 0; ai < 2; ++ai)
#pragma unroll
            for (int m = 0; m < 4; ++m) { const int r = row0 + ai * HALF + m * 16; float ss = 0.f;
#pragma unroll
                for (int bj = 0; bj < 2; ++bj) { const u32x4 xi = *(const u32x4*)(Xi + (size_t)r * D + col0 + bj * HALF);
                    f32x4 v0, v1; v0[0] = __uint_as_float(xi.x << 16); v0[1] = __uint_as_float(xi.x & 0xffff0000u); v0[2] = __uint_as_float(xi.y << 16); v0[3] = __uint_as_float(xi.y & 0xffff0000u);
                    v1[0] = __uint_as_float(xi.z << 16); v1[1] = __uint_as_float(xi.z & 0xffff0000u); v1[2] = __uint_as_float(xi.w << 16); v1[3] = __uint_as_float(xi.w & 0xffff0000u);
                    v0 = v0 + acc[ai][bj][m][0]; v1 = v1 + acc[ai][bj][m][1];
                    ss += sq8(v0, v1); *(u32x4*)(Xo + (size_t)r * D + col0 + bj * HALF) = pack8(v0, v1); }
                ss += __shfl_xor(ss, 16); ss += __shfl_xor(ss, 32);
                if (fq == 0) ssq[(size_t)r * 16 + u.pn * 4 + wc] = ss; }
    }
};

__device__ __forceinline__ void pair_ab(int p, int& a, int& b) { a = (p < 3) ? 0 : (p < 5) ? 1 : 2; b = (p < 3) ? p + 1 : (p < 5) ? p - 1 : 3; }
__device__ __forceinline__ int moe_class_of_tile(const PG8_LAS int* meta, int T) { int c = 0;
#pragma unroll
    for (int k = 1; k < 24; ++k) c += (T >= __builtin_amdgcn_readfirstlane(meta[64 + k])) ? 1 : 0;
    return c; }
struct MoeOrder1 {
    const bf16_t* XG; const bf16_t* Wg; const bf16_t* Wu; const PG8_LAS int* meta; int G, c;
    __device__ bool next(int i, Unit& u) const { const int L = i * G + c, nt = __builtin_amdgcn_readfirstlane(meta[64 + 24]); if (L >= nt * 4) return false;
        u.pm = L >> 2; u.pn = moe_class_of_tile(meta, L >> 2) * 4 + (L & 3); return true; }
    __device__ __forceinline__ void ptrs(const Unit& u, const char*& a, const char*& b0, const char*& b1) const {
        const int cls = u.pn >> 2, j = (u.pn >> 1) & 1, half = u.pn & 1; int ea, eb; pair_ab(cls % 6, ea, eb); const int e = (cls / 6) * 4 + (j ? eb : ea);
        a = (const char*)XG + (size_t)u.pm * BM * D * 2; const size_t bo = ((size_t)e * DE + half * HALF) * D * 2; b0 = (const char*)Wg + bo; b1 = (const char*)Wu + bo; }
};
struct MoeOrder2 {
    const bf16_t* HID; const bf16_t* Wd2; const PG8_LAS int* meta; int G, c;
    __device__ bool next(int i, Unit& u) const { const int L = i * G + c, nt = __builtin_amdgcn_readfirstlane(meta[64 + 24]); if (L >= nt * 4) return false;
        u.pm = L >> 2; u.pn = moe_class_of_tile(meta, L >> 2) * 4 + (L & 3); return true; }
    __device__ __forceinline__ void ptrs(const Unit& u, const char*& a, const char*& b0, const char*& b1) const {
        a = (const char*)HID + (size_t)u.pm * BM * 512 * 2; b0 = (const char*)Wd2 + ((size_t)(u.pn >> 2) * D + (u.pn & 3) * BM) * 512 * 2; b1 = b0 + (size_t)HALF * 512 * 2; }
};
struct EpiMoeUp {
    static constexpr bool PERM = true, HAS_MID = false; int mid_t;
    const float* rsg; const float* wAg; const float* wBg; bf16_t* HID;
    __device__ __forceinline__ void mid(f32x4 (&)[2][2][4][2], const Unit&, int, int, int, int) const {}
    __device__ __forceinline__ void operator()(const f32x4 (&acc)[2][2][4][2], const Unit& u, int wr, int wc, int fr, int fq) const {
        const int row0 = u.pm * BM + wr * 64 + fr, j = (u.pn >> 1) & 1, col0 = j * 256 + (u.pn & 1) * HALF + wc * 32 + 8 * fq; const float* wg = j ? wBg : wAg;
#pragma unroll
        for (int ai = 0; ai < 2; ++ai)
#pragma unroll
            for (int m = 0; m < 4; ++m) { const int r = row0 + ai * HALF + m * 16; const float rs = rsg[r], w = wg[r]; f32x4 h0, h1;
#pragma unroll
                for (int e = 0; e < 4; ++e) { const float g0 = acc[ai][0][m][0][e] * rs, g1 = acc[ai][0][m][1][e] * rs;
                    h0[e] = g0 / (1.f + __expf(-g0)) * (acc[ai][1][m][0][e] * rs) * w; h1[e] = g1 / (1.f + __expf(-g1)) * (acc[ai][1][m][1][e] * rs) * w; }
                *(u32x4*)(HID + (size_t)r * 512 + col0) = pack8(h0, h1); }
    }
};
struct EpiMoeDown {
    static constexpr bool PERM = true, HAS_MID = false; int mid_t;
    const int* tokg; const bf16_t* Xi; bf16_t* Xo; float* ssq;
    __device__ __forceinline__ void mid(f32x4 (&)[2][2][4][2], const Unit&, int, int, int, int) const {}
    __device__ __forceinline__ void operator()(const f32x4 (&acc)[2][2][4][2], const Unit& u, int wr, int wc, int fr, int fq) const {
        const int row0 = u.pm * BM + wr * 64 + fr, ct = u.pn & 3, col0 = ct * BM + wc * 32 + 8 * fq;
#pragma unroll
        for (int ai = 0; ai < 2; ++ai)
#pragma unroll
            for (int m = 0; m < 4; ++m) { const int tok = tokg[row0 + ai * HALF + m * 16];
                if (tok >= 0) { float ss = 0.f;
#pragma unroll
                    for (int bj = 0; bj < 2; ++bj) { const u32x4 xi = *(const u32x4*)(Xi + (size_t)tok * D + col0 + bj * HALF);
                        f32x4 v0, v1; v0[0] = __uint_as_float(xi.x << 16); v0[1] = __uint_as_float(xi.x & 0xffff0000u); v0[2] = __uint_as_float(xi.y << 16); v0[3] = __uint_as_float(xi.y & 0xffff0000u);
                        v1[0] = __uint_as_float(xi.z << 16); v1[1] = __uint_as_float(xi.z & 0xffff0000u); v1[2] = __uint_as_float(xi.w << 16); v1[3] = __uint_as_float(xi.w & 0xffff0000u);
                        v0 = v0 + acc[ai][bj][m][0]; v1 = v1 + acc[ai][bj][m][1];
                        ss += sq8(v0, v1); *(u32x4*)(Xo + (size_t)tok * D + col0 + bj * HALF) = pack8(v0, v1); }
                    ss += __shfl_xor(ss, 16); ss += __shfl_xor(ss, 32);
                    if (fq == 0) ssq[(size_t)tok * 16 + ct * 4 + wc] = ss; } }
    }
};

struct XaSOrder {
    const bf16_t* QX; const bf16_t* KM; int G, c;
    __device__ bool next(int i, Unit& u) const { const int L = i * G + c; if (L >= (NTOK / BM) * XH) return false; u.pm = L >> 2; u.pn = L & 3; return true; }
    __device__ __forceinline__ void ptrs(const Unit& u, const char*& a, const char*& b0, const char*& b1) const {
        a = (const char*)QX + ((size_t)u.pm * BM * D + u.pn * XD) * 2; const int b = u.pm / (SEQ / BM);
        b0 = (const char*)KM + ((size_t)b * MEM * D + u.pn * XD) * 2; b1 = b0 + (size_t)HALF * D * 2; }
};
struct XaOOrder {
    const bf16_t* P; const bf16_t* VT; int G, c;
    __device__ bool next(int i, Unit& u) const { const int L = i * G + c; if (L >= (NTOK / BM) * XH) return false; u.pm = L >> 2; u.pn = L & 3; return true; }
    __device__ __forceinline__ void ptrs(const Unit& u, const char*& a, const char*& b0, const char*& b1) const {
        a = (const char*)P + ((size_t)u.pm * BM * D + u.pn * XD) * 2; const int b = u.pm / (SEQ / BM);
        b0 = (const char*)VT + ((size_t)b * D + u.pn * XD) * MEM * 2; b1 = b0 + (size_t)HALF * MEM * 2; }
};
struct EpiSoftmax {
    static constexpr bool PERM = true, HAS_MID = false; int mid_t;
    bf16_t* P; PG8_LAS float* xch;
    __device__ __forceinline__ void mid(f32x4 (&)[2][2][4][2], const Unit&, int, int, int, int) const {}
    __device__ __forceinline__ void operator()(f32x4 (&acc)[2][2][4][2], const Unit& u, int wr, int wc, int fr, int fq) const {
        PG8_LAS float* xm = xch; PG8_LAS float* xs = xch + 1024;
#pragma unroll
        for (int ai = 0; ai < 2; ++ai)
#pragma unroll
            for (int m = 0; m < 4; ++m) { float mx = -INFINITY;
#pragma unroll
                for (int bj = 0; bj < 2; ++bj)
#pragma unroll
                    for (int n = 0; n < 2; ++n) { const f32x4 v = acc[ai][bj][m][n]; mx = fmaxf(mx, fmaxf(fmaxf(v[0], v[1]), fmaxf(v[2], v[3]))); }
                mx = fmaxf(mx, __shfl_xor(mx, 16)); mx = fmaxf(mx, __shfl_xor(mx, 32));
                if (fq == 0) xm[(ai * HALF + wr * 64 + m * 16 + fr) * 4 + wc] = mx; asm volatile("" ::: "memory"); }
        asm volatile("s_waitcnt lgkmcnt(0)" ::: "memory"); __builtin_amdgcn_s_barrier(); asm volatile("" ::: "memory");
#pragma unroll
        for (int ai = 0; ai < 2; ++ai)
#pragma unroll
            for (int m = 0; m < 4; ++m) { const int rl = ai * HALF + wr * 64 + m * 16 + fr; const f32x4 q = *(const PG8_LAS f32x4*)(xm + rl * 4);
                const float mx = fmaxf(fmaxf(q[0], q[1]), fmaxf(q[2], q[3])); float ss = 0.f;
#pragma unroll
                for (int bj = 0; bj < 2; ++bj)
#pragma unroll
                    for (int n = 0; n < 2; ++n) { f32x4 v = acc[ai][bj][m][n];
#pragma unroll
                        for (int e = 0; e < 4; ++e) { v[e] = __builtin_amdgcn_exp2f(v[e] - mx); ss += v[e]; }
                        acc[ai][bj][m][n] = v; }
                ss += __shfl_xor(ss, 16); ss += __shfl_xor(ss, 32);
                if (fq == 0) xs[rl * 4 + wc] = ss; asm volatile("" ::: "memory"); }
        asm volatile("s_waitcnt lgkmcnt(0)" ::: "memory"); __builtin_amdgcn_s_barrier(); asm volatile("" ::: "memory");
        const int row0 = u.pm * BM + wr * 64 + fr, col0 = u.pn * XD + wc * 32 + 8 * fq;
#pragma unroll
        for (int ai = 0; ai < 2; ++ai)
#pragma unroll
            for (int m = 0; m < 4; ++m) { const int rl = ai * HALF + wr * 64 + m * 16 + fr; const f32x4 q = *(const PG8_LAS f32x4*)(xs + rl * 4);
                const float inv = 1.0f / ((q[0] + q[1]) + (q[2] + q[3])); bf16_t* rowp = P + (size_t)(row0 + ai * HALF + m * 16) * D + col0;
#pragma unroll
                for (int bj = 0; bj < 2; ++bj) *(u32x4*)(rowp + bj * HALF) = pack8(acc[ai][bj][m][0] * inv, acc[ai][bj][m][1] * inv); asm volatile("" ::: "memory"); }
    }
};
}
namespace sba {
typedef float f32x16 __attribute__((ext_vector_type(16)));
typedef short s16x4 __attribute__((ext_vector_type(4)));
typedef short v4i16_t __attribute__((ext_vector_type(4)));
typedef __attribute__((address_space(3))) const char* lds_cptr;
constexpr int SLOTB = 8192, L_K = 0, L_V = 2 * SLOTB, L_FLAG = 4 * SLOTB, L_OST = L_FLAG + 256, L_BYTES = L_OST + 8 * 4096;
__device__ __forceinline__ int crow(int r, int hi) { return (r & 3) + 8 * (r >> 2) + 4 * hi; }
__device__ __forceinline__ void glds16(const void* gsrc, unsigned lds_dst) { unsigned keep;
    asm volatile("s_mov_b32 %0, m0\n\ts_mov_b32 m0, %2\n\ts_nop 0\n\tglobal_load_lds_dwordx4 %1, off\n\ts_mov_b32 m0, %0" : "=&s"(keep) : "v"(gsrc), "s"(lds_dst) : "memory"); }
typedef float f32x2_t __attribute__((ext_vector_type(2))); typedef __bf16 bf16x2_t __attribute__((ext_vector_type(2)));
__device__ __forceinline__ unsigned cvtpk(float lo, float hi) { f32x2_t v = {lo, hi}; bf16x2_t b = __builtin_convertvector(v, bf16x2_t); return __builtin_bit_cast(unsigned, b); }
__device__ __forceinline__ s16x4 vtr(lds_cptr p) { return __builtin_bit_cast(s16x4, __builtin_amdgcn_ds_read_tr16_b64_v4i16((__attribute__((address_space(3))) v4i16_t*)p)); }

#define SBA_GROUP(Z, SP, g) do { \
        const float off_ = acc_ + (hi ? 0.f : gp_##SP[g]); acc_ += gs_##SP[g] + gp_##SP[g]; \
        const float c3_ = off_ + SP[4 * (g) + 3], c2_ = c3_ + SP[4 * (g) + 2], c1_ = c2_ + SP[4 * (g) + 1], c0_ = c1_ + SP[4 * (g)]; \
        Z[4 * (g) + 3] = __builtin_amdgcn_exp2f(Z[4 * (g) + 3] - c3_); Z[4 * (g) + 2] = __builtin_amdgcn_exp2f(Z[4 * (g) + 2] - c2_); \
        Z[4 * (g) + 1] = __builtin_amdgcn_exp2f(Z[4 * (g) + 1] - c1_); Z[4 * (g)] = __builtin_amdgcn_exp2f(Z[4 * (g)] - c0_); } while (0)

__device__ __forceinline__ void sb_unit(int b, int h, int qb, const bf16_t* Qs, const bf16_t* Ks, const bf16_t* Vs, bf16_t* YY, float* ssq_s8, const unsigned* kmax, char* shm) {
    int tid_ = threadIdx.x; asm volatile("" : "+v"(tid_));
    const int tid = tid_, lane = tid & 63, r32 = lane & 31, hi = lane >> 5; const int wid = __builtin_amdgcn_readfirstlane(tid >> 6);
    const size_t rowbase = (size_t)b * SEQ; const int q0 = qb * 256;
    const bf16_t* Kh = Ks + rowbase * SBW + h * HD; const bf16_t* Vh = Vs + rowbase * SBW + h * HD;
    const unsigned lds0 = (unsigned)(uintptr_t)shm;
    const lds_cptr shm3 = (lds_cptr)shm;
    const bf16_t* ksrc = Kh + (size_t)lane * SBW + wid * 8;
    const bf16_t* vsrc = Vh + (size_t)(16 * (wid & 3) + (lane >> 2)) * SBW + (wid >> 2) * 32 + (lane & 3) * 8;
    const unsigned kdst = lds0 + L_K + wid * 1024, vdst = lds0 + L_V + wid * 1024;
#define DMA_KV(t, slot) do { glds16(ksrc + (size_t)(t) * 64 * SBW, (unsigned)__builtin_amdgcn_readfirstlane(kdst + (slot))); glds16(vsrc + (size_t)(t) * 64 * SBW, (unsigned)__builtin_amdgcn_readfirstlane(vdst + (slot))); } while (0)
    const lds_cptr kp0 = shm3 + L_K + hi * 1024 + r32 * 16;
    const lds_cptr vp0 = shm3 + L_V + ((lane >> 4) & 1) * 32 + (lane & 3) * 8 + (4 * hi + ((lane & 15) >> 2)) * 64;
    volatile __attribute__((address_space(3))) unsigned* flags = (volatile __attribute__((address_space(3))) unsigned*)(shm3 + L_FLAG);
    int tile = 4 * qb + 3, slot = 0, it = 0;
    DMA_KV(tile, 0);
    const bf16_t* Qw = Qs + (rowbase + q0 + wid * 32 + r32) * SBW + h * HD;
    bf16x8 qr[4];
#pragma unroll
    for (int d0 = 0; d0 < 4; ++d0) qr[d0] = *(const bf16x8*)(Qw + d0 * 16 + hi * 8);
    float qn = 0.f;
#pragma unroll
    for (int d0 = 0; d0 < 4; ++d0)
#pragma unroll
        for (int e = 0; e < 8; ++e) qn += fabsf(bf2f((unsigned short)qr[d0][e]));
    qn += __shfl_xor(qn, 32);
    const float zmax = qn * __uint_as_float(kmax[b * 8 + h]) * 1.01f;
    const int tq = q0 + wid * 32 + r32;
    const int tq_min = q0 + wid * 32, tq_max = tq_min + 31;
    float R = 0.f;
    f32x16 o0 = {}, o1 = {};
    for (;;) {
        const bool has_next = tile > 0;
        if (has_next) { DMA_KV(tile - 1, slot ^ SLOTB); asm volatile("s_waitcnt vmcnt(2)" ::: "memory"); }
        else asm volatile("s_waitcnt vmcnt(0)" ::: "memory");
        __builtin_amdgcn_s_barrier(); asm volatile("" ::: "memory");
        const int kmin = tile * 64;
        if (kmin < tq_max) {
            f32x16 z0, z1;
            {
                const lds_cptr kb = kp0 + slot;
#pragma unroll
                for (int d0 = 0; d0 < 4; ++d0) {
                    const bf16x8 b0 = *(const __attribute__((address_space(3))) bf16x8*)(kb + d0 * 2048);
                    const bf16x8 b1 = *(const __attribute__((address_space(3))) bf16x8*)(kb + d0 * 2048 + 512);
                    if (d0 == 0) { z0 = __builtin_amdgcn_mfma_f32_32x32x16_bf16(b0, qr[0], (f32x16){}, 0, 0, 0); z1 = __builtin_amdgcn_mfma_f32_32x32x16_bf16(b1, qr[0], (f32x16){}, 0, 0, 0); }
                    else { z0 = __builtin_amdgcn_mfma_f32_32x32x16_bf16(b0, qr[d0], z0, 0, 0, 0); z1 = __builtin_amdgcn_mfma_f32_32x32x16_bf16(b1, qr[d0], z1, 0, 0, 0); }
                }
            }
            if (kmin + 63 >= tq_min) {
#pragma unroll
                for (int r = 0; r < 16; ++r) { const int kv = kmin + crow(r, hi); if (kv >= tq) z0[r] = -INFINITY; if (kv + 32 >= tq) z1[r] = -INFINITY; }
            }
            f32x16 s0, s1;
#pragma unroll
            for (int r = 0; r < 16; ++r) { z0[r] = fminf(z0[r], 120.f); z1[r] = fminf(z1[r], 120.f);
                s0[r] = __builtin_amdgcn_logf(1.f + __builtin_amdgcn_exp2f(z0[r])); s1[r] = __builtin_amdgcn_logf(1.f + __builtin_amdgcn_exp2f(z1[r])); }
            float gs_s0[4], gs_s1[4], gp_s0[4], gp_s1[4];
#pragma unroll
            for (int g = 0; g < 4; ++g) { gs_s0[g] = (s0[4 * g] + s0[4 * g + 1]) + (s0[4 * g + 2] + s0[4 * g + 3]); gs_s1[g] = (s1[4 * g] + s1[4 * g + 1]) + (s1[4 * g + 2] + s1[4 * g + 3]); }
#pragma unroll
            for (int g = 0; g < 4; ++g) { gp_s0[g] = __shfl_xor(gs_s0[g], 32); gp_s1[g] = __shfl_xor(gs_s1[g], 32); }
            float acc_ = R;
            SBA_GROUP(z1, s1, 3); SBA_GROUP(z1, s1, 2); SBA_GROUP(z1, s1, 1); SBA_GROUP(z1, s1, 0);
            SBA_GROUP(z0, s0, 3); SBA_GROUP(z0, s0, 2); SBA_GROUP(z0, s0, 1); SBA_GROUP(z0, s0, 0);
            R = acc_;
            u32x4 pw0, pw1, pw2, pw3;
            pw0 = (u32x4){cvtpk(z0[0], z0[1]), cvtpk(z0[2], z0[3]), cvtpk(z0[4], z0[5]), cvtpk(z0[6], z0[7])};
            pw1 = (u32x4){cvtpk(z0[8], z0[9]), cvtpk(z0[10], z0[11]), cvtpk(z0[12], z0[13]), cvtpk(z0[14], z0[15])};
            pw2 = (u32x4){cvtpk(z1[0], z1[1]), cvtpk(z1[2], z1[3]), cvtpk(z1[4], z1[5]), cvtpk(z1[6], z1[7])};
            pw3 = (u32x4){cvtpk(z1[8], z1[9]), cvtpk(z1[10], z1[11]), cvtpk(z1[12], z1[13]), cvtpk(z1[14], z1[15])};
            const lds_cptr vp = vp0 + slot;
#define SBA_PV(O, d0, ks, PW) do { const s16x4 lo_ = vtr(vp + (d0) * 4096 + (ks) * 1024), hi_ = vtr(vp + (d0) * 4096 + (ks) * 1024 + 512); \
                const bf16x8 vf_ = (bf16x8){lo_[0], lo_[1], lo_[2], lo_[3], hi_[0], hi_[1], hi_[2], hi_[3]}; \
                O = __builtin_amdgcn_mfma_f32_32x32x16_bf16(__builtin_bit_cast(bf16x8, PW), vf_, O, 0, 0, 0); } while (0)
            SBA_PV(o0, 0, 0, pw0); SBA_PV(o1, 1, 0, pw0); SBA_PV(o0, 0, 1, pw1); SBA_PV(o1, 1, 1, pw1);
            SBA_PV(o0, 0, 2, pw2); SBA_PV(o1, 1, 2, pw2); SBA_PV(o0, 0, 3, pw3); SBA_PV(o1, 1, 3, pw3);
#undef SBA_PV
        }
        const bool done = __all((zmax - R) < -150.f);
        if (lane == 0) flags[(it & 1) * 8 + wid] = done ? 1u : 0u;
        asm volatile("s_waitcnt lgkmcnt(0)" ::: "memory"); __builtin_amdgcn_s_barrier(); asm volatile("" ::: "memory");
        unsigned alld = 1u;
#pragma unroll
        for (int w = 0; w < 8; ++w) alld &= flags[(it & 1) * 8 + w];
        alld = __builtin_amdgcn_readfirstlane(alld);
        if (!has_next || alld) break;
        --tile; slot ^= SLOTB; ++it;
    }
    asm volatile("s_waitcnt vmcnt(0)" ::: "memory");
    {
        bf16_t* Ow = YY + (rowbase + q0 + wid * 32) * D + RW + h * HD;
        bf16_t* stg = (bf16_t*)(shm + L_OST) + wid * 2048;
#pragma unroll
        for (int r = 0; r < 16; ++r) { const int orow = crow(r, hi); stg[orow * 64 + r32] = (bf16_t)f2bf(o0[r]); stg[orow * 64 + 32 + r32] = (bf16_t)f2bf(o1[r]); }
        asm volatile("s_waitcnt lgkmcnt(0)" ::: "memory");
#pragma unroll
        for (int i = 0; i < 4; ++i) { const int row = i * 8 + (lane >> 3), ch = lane & 7; const u32x4 v = *(const u32x4*)(stg + row * 64 + ch * 8);
            *(u32x4*)(Ow + (size_t)row * D + ch * 8) = v;
            float ss = 0.f;
#pragma unroll
            for (int e = 0; e < 4; ++e) { const float lo = __uint_as_float(v[e] << 16), hh = __uint_as_float(v[e] & 0xffff0000u); ss += lo * lo + hh * hh; }
            ss += __shfl_xor(ss, 1); ss += __shfl_xor(ss, 2); ss += __shfl_xor(ss, 4);
            if (ch == 0) ssq_s8[(rowbase + q0 + wid * 32 + row) * 8 + h] = ss; }
    }
    asm volatile("s_waitcnt lgkmcnt(0)" ::: "memory"); __builtin_amdgcn_s_barrier(); asm volatile("" ::: "memory");
#undef DMA_KV
}
#undef SBA_GROUP
}
namespace lru {
typedef float f32x16 __attribute__((ext_vector_type(16)));
constexpr int XS_ROWS = 67, XS_BYTES = XS_ROWS * 1024  , XC_PITCH = 1040  , XC_OFF = 68608, HC_OFF = XC_OFF + 64 * XC_PITCH  , L_BYTES = HC_OFF + 2048;
__device__ __forceinline__ int crow(int r, int hi) { return (r & 3) + 8 * (r >> 2) + 4 * hi; }

struct Weights { bf16x8 wa[2][4], wx[2][4]; float ba[2], bx[2], spl[2]; };
__device__ __forceinline__ void load_weights(Weights& W, int h, int r32, int hi, const float* w_a, const float* b_a, const float* w_x, const float* b_x, const float* lam) {
#pragma unroll
    for (int nt = 0; nt < 2; ++nt) {
#pragma unroll
        for (int s = 0; s < 4; ++s) {
#pragma unroll
            for (int e = 0; e < 8; ++e) { const size_t idx = ((size_t)(h * 64 + 16 * s + 8 * hi + e)) * 64 + 32 * nt + r32;
                W.wa[nt][s][e] = (short)f2bf(w_a[idx]); W.wx[nt][s][e] = (short)f2bf(w_x[idx]); }
        }
        const int c = h * 64 + 32 * nt + r32; W.ba[nt] = b_a[c]; W.bx[nt] = b_x[c];
        const float l = lam[c]; W.spl[nt] = (l > 15.f) ? __expf(-l) : log1pf(__expf(-l));
    }
}

template <bool PASSB>
__device__ __forceinline__ void unit(int b, int chunk, const Weights& W, const bf16_t* XR, const bf16_t* GG, const float* conv_w, const float* conv_b,
                                     float* aggP, float* aggH, const float* ssq_s8, bf16_t* YY, float* fmid, float* fend, unsigned char* shm) {
    int tid_ = threadIdx.x; asm volatile("" : "+v"(tid_));
    const int tid = tid_, lane = tid & 63, r32 = lane & 31, hi = lane >> 5, wid = __builtin_amdgcn_readfirstlane(tid >> 6);
    LAS unsigned char* L = (LAS unsigned char*)shm;
    const int t0 = chunk * 64; const size_t rowbase = (size_t)b * SEQ;
    for (int p = tid; p < XS_ROWS * 64; p += NTHREADS) { const int rr = p >> 6, pc = p & 63, t = t0 - 3 + rr;
        u32x4 v = (u32x4){0u, 0u, 0u, 0u}; if (t >= 0) v = *(const u32x4*)(XR + (rowbase + t) * RW + pc * 8);
        *(LAS u32x4*)(L + rr * 1024 + pc * 16) = v; }
    if (PASSB) {
        const f32x4* pP = (const f32x4*)(aggP + ((size_t)b * RW + tid) * 64); const f32x4* pH = (const f32x4*)(aggH + ((size_t)b * RW + tid) * 64); float hc = 0.f;
#pragma unroll
        for (int half = 0; half < 2; ++half) { if (half * 32 < chunk) { f32x4 p[8], q[8];
#pragma unroll
                for (int i = 0; i < 8; ++i) { p[i] = pP[half * 8 + i]; q[i] = pH[half * 8 + i]; }
#pragma unroll
                for (int i = 0; i < 8; ++i)
#pragma unroll
                    for (int e = 0; e < 4; ++e) { if (half * 32 + i * 4 + e < chunk) hc = p[i][e] * hc + q[i][e]; } } }
        *(LAS float*)(L + HC_OFF + tid * 4) = hc;
    }
    __syncthreads();
    {
        const int cp = tid & 255, th = tid >> 8, c0 = 2 * cp;
        const float w00 = conv_w[c0], w01 = conv_w[RW + c0], w02 = conv_w[2 * RW + c0], w03 = conv_w[3 * RW + c0], b0 = conv_b[c0];
        const float w10 = conv_w[c0 + 1], w11 = conv_w[RW + c0 + 1], w12 = conv_w[2 * RW + c0 + 1], w13 = conv_w[3 * RW + c0 + 1], b1 = conv_b[c0 + 1];
        const LAS unsigned* xs = (const LAS unsigned*)(L + (th * 32) * 1024 + cp * 4);
        unsigned u0 = xs[0], u1 = xs[256], u2 = xs[512];
        float a0 = __uint_as_float(u0 << 16), a1 = __uint_as_float(u1 << 16), a2 = __uint_as_float(u2 << 16);
        float c0_ = __uint_as_float(u0 & 0xffff0000u), c1_ = __uint_as_float(u1 & 0xffff0000u), c2_ = __uint_as_float(u2 & 0xffff0000u);
#pragma unroll 8
        for (int t = 0; t < 32; ++t) { const unsigned u3 = xs[(t + 3) * 256]; const float a3 = __uint_as_float(u3 << 16), c3_ = __uint_as_float(u3 & 0xffff0000u);
            const float y0 = w00 * a0 + w01 * a1 + w02 * a2 + w03 * a3 + b0, y1 = w10 * c0_ + w11 * c1_ + w12 * c2_ + w13 * c3_ + b1;
            *(LAS unsigned*)(L + XC_OFF + (th * 32 + t) * XC_PITCH + cp * 4) = f2bf(y0) | (f2bf(y1) << 16);
            a0 = a1; a1 = a2; a2 = a3; c0_ = c1_; c1_ = c2_; c2_ = c3_; }
    }
    __syncthreads();
    const int h = wid;
    float Hc[2] = {0.f, 0.f}, Pc[2] = {1.f, 1.f};
    if (PASSB) {
#pragma unroll
        for (int nt = 0; nt < 2; ++nt) Hc[nt] = *(const LAS float*)(L + HC_OFF + (h * 64 + 32 * nt + r32) * 4);
    }
#pragma unroll
    for (int mt = 0; mt < 2; ++mt) {
        bf16x8 af[4];
#pragma unroll
        for (int s = 0; s < 4; ++s) af[s] = *(const LAS bf16x8*)(L + XC_OFF + (32 * mt + r32) * XC_PITCH + (h * 64 + 16 * s + 8 * hi) * 2);
#pragma unroll
        for (int nt = 0; nt < 2; ++nt) {
            f32x16 ra = {}, ri = {};
#pragma unroll
            for (int s = 0; s < 4; ++s) { ra = __builtin_amdgcn_mfma_f32_32x32x16_bf16(af[s], W.wa[nt][s], ra, 0, 0, 0); ri = __builtin_amdgcn_mfma_f32_32x32x16_bf16(af[s], W.wx[nt][s], ri, 0, 0, 0); }
            const int c = h * 64 + 32 * nt + r32;
#pragma unroll
            for (int r = 0; r < 16; ++r) { const int tok = 32 * mt + crow(r, hi);
                const float xc = bf2f(*(const LAS unsigned short*)(L + XC_OFF + tok * XC_PITCH + c * 2));
                const float rg = 1.f / (1.f + __expf(-(ra[r] + W.ba[nt]))), ig = 1.f / (1.f + __expf(-(ri[r] + W.bx[nt])));
                const float la = -8.0f * rg * W.spl[nt], a = __expf(la);
                ra[r] = a; ri[r] = sqrtf(fmaxf(0.f, 1.f - a * a)) * (ig * xc); }
            float P[4], H[4], Pp[4], Hp[4];
#pragma unroll
            for (int g = 0; g < 4; ++g) { P[g] = (ra[4 * g] * ra[4 * g + 1]) * (ra[4 * g + 2] * ra[4 * g + 3]);
                H[g] = ((ri[4 * g] * ra[4 * g + 1] + ri[4 * g + 1]) * ra[4 * g + 2] + ri[4 * g + 2]) * ra[4 * g + 3] + ri[4 * g + 3]; }
#pragma unroll
            for (int g = 0; g < 4; ++g) { Pp[g] = __shfl_xor(P[g], 32); Hp[g] = __shfl_xor(H[g], 32); }
            float hc = Hc[nt], pc = Pc[nt];
#pragma unroll
            for (int g = 0; g < 4; ++g) { const float P0 = hi ? Pp[g] : P[g], H0 = hi ? Hp[g] : H[g], P1 = hi ? P[g] : Pp[g], H1 = hi ? H[g] : Hp[g];
                const float mid = P0 * hc + H0;
                if (PASSB) { float hh = hi ? mid : hc;
#pragma unroll
                    for (int k = 0; k < 4; ++k) { hh = ra[4 * g + k] * hh + ri[4 * g + k]; const int tok = 32 * mt + 8 * g + 4 * hi + k;
                        *(LAS unsigned short*)(L + tok * 1024 + c * 2) = (unsigned short)f2bf(hh); } }
                hc = P1 * mid + H1; pc = pc * (P0 * P1); }
            Hc[nt] = hc; Pc[nt] = pc;
        }
    }
    if (!PASSB) {
        if (hi == 0) {
#pragma unroll
            for (int nt = 0; nt < 2; ++nt) { const int c = h * 64 + 32 * nt + r32; aggP[((size_t)b * RW + c) * 64 + chunk] = Pc[nt]; aggH[((size_t)b * RW + c) * 64 + chunk] = Hc[nt]; }
        }
        __syncthreads();
    } else {
        __syncthreads();
        for (int i = 0; i < 8; ++i) { const int rr = i * 8 + wid; const size_t row = rowbase + t0 + rr;
            const u32x4 hv = *(const LAS u32x4*)(L + rr * 1024 + lane * 16); const u32x4 gv = *(const u32x4*)(GG + row * RW + lane * 8);
            f32x4 y0, y1;
            y0[0] = __uint_as_float(hv.x << 16) * __uint_as_float(gv.x << 16); y0[1] = __uint_as_float(hv.x & 0xffff0000u) * __uint_as_float(gv.x & 0xffff0000u);
            y0[2] = __uint_as_float(hv.y << 16) * __uint_as_float(gv.y << 16); y0[3] = __uint_as_float(hv.y & 0xffff0000u) * __uint_as_float(gv.y & 0xffff0000u);
            y1[0] = __uint_as_float(hv.z << 16) * __uint_as_float(gv.z << 16); y1[1] = __uint_as_float(hv.z & 0xffff0000u) * __uint_as_float(gv.z & 0xffff0000u);
            y1[2] = __uint_as_float(hv.w << 16) * __uint_as_float(gv.w << 16); y1[3] = __uint_as_float(hv.w & 0xffff0000u) * __uint_as_float(gv.w & 0xffff0000u);
            const float ss = wave_sum(pg8::sq8(y0, y1));
            *(u32x4*)(YY + row * D + lane * 8) = pg8::pack8(y0, y1);
            if (lane == 0) { float s2 = 0.f;
#pragma unroll
                for (int k = 0; k < 8; ++k) s2 += ssq_s8[row * 8 + k];
                const float rrn = 1.0f / sqrtf(ss * (1.f / RW) + EPS), rs = 1.0f / sqrtf(s2 * (1.f / SBW) + EPS); fmid[row] = rrn / rs; fend[row] = rs; } }
        __syncthreads();
    }
}
}
__device__ __forceinline__ void row_prep_x(const float* x, bf16_t* xb, float* rstd0, int row, int lane) {
    const f32x4* xr = (const f32x4*)(x + (size_t)row * D) + lane;
    float s = 0.f; f32x4 v[4];
#pragma unroll
    for (int j = 0; j < 4; ++j) { v[j] = xr[64 * j]; s += v[j].x * v[j].x + v[j].y * v[j].y + v[j].z * v[j].z + v[j].w * v[j].w; }
    s = wave_sum(s);
    if (lane == 0) rstd0[row] = 1.0f / sqrtf(s * (1.f / D) + EPS);
    unsigned long long* o8 = (unsigned long long*)(xb + (size_t)row * D) + lane;
#pragma unroll
    for (int j = 0; j < 4; ++j) o8[64 * j] = (unsigned long long)(f2bf(v[j].x) | (f2bf(v[j].y) << 16)) | ((unsigned long long)(f2bf(v[j].z) | (f2bf(v[j].w) << 16)) << 32);
}
__device__ __forceinline__ void row_prep_mem(const float* m, const float* g, bf16_t* o, int row, int lane) {
    const f32x4* xr = (const f32x4*)(m + (size_t)row * D) + lane;
    float s = 0.f; f32x4 v[4];
#pragma unroll
    for (int j = 0; j < 4; ++j) { v[j] = xr[64 * j]; s += v[j].x * v[j].x + v[j].y * v[j].y + v[j].z * v[j].z + v[j].w * v[j].w; }
    s = wave_sum(s);
    const float r = 1.0f / sqrtf(s * (1.f / D) + EPS);
    unsigned long long* o8 = (unsigned long long*)(o + (size_t)row * D) + lane;
#pragma unroll
    for (int j = 0; j < 4; ++j) { const f32x4 gg = ((const f32x4*)g)[64 * j + lane];
        o8[64 * j] = (unsigned long long)(f2bf(v[j].x * r * gg.x) | (f2bf(v[j].y * r * gg.y) << 16)) | ((unsigned long long)(f2bf(v[j].z * r * gg.z) | (f2bf(v[j].w * r * gg.w) << 16)) << 32); }
}
__device__ __forceinline__ void transpose_item(const float* W, int K, int N, bf16_t* Wt, int ldt, const float* g0, const float* g1, int ksplit, LAS float* scr, int item, int lane) {
    const int nblk = N / 32, kb = item / nblk, nb = item % nblk, k0 = 64 * kb, n0 = 32 * nb;
#pragma unroll 8
    for (int i = 0; i < 32; ++i) { const int kk = 2 * i + (lane >> 5), k = k0 + kk; float gv = 1.f; if (g0) gv = (k < ksplit) ? g0[k] : g1[k - ksplit];
        scr[kk * 33 + (lane & 31)] = W[(size_t)k * N + n0 + (lane & 31)] * gv; }
    asm volatile("s_waitcnt lgkmcnt(0)" ::: "memory");
    const int c = lane & 7;
#pragma unroll
    for (int j = 0; j < 4; ++j) { const int n = (lane >> 3) + 8 * j; const LAS float* s = scr + (8 * c) * 33 + n;
        u32x4 o; o.x = f2bf(s[0 * 33]) | (f2bf(s[1 * 33]) << 16); o.y = f2bf(s[2 * 33]) | (f2bf(s[3 * 33]) << 16); o.z = f2bf(s[4 * 33]) | (f2bf(s[5 * 33]) << 16); o.w = f2bf(s[6 * 33]) | (f2bf(s[7 * 33]) << 16);
        *(u32x4*)(Wt + (size_t)(n0 + n) * ldt + k0 + 8 * c) = o; }
    asm volatile("s_waitcnt lgkmcnt(0)" ::: "memory");
}

struct MidScale { const float* f; int k; int pad; };
template <class Epi>
__device__ __forceinline__ void gemm_naive(const Ctx& C, const bf16_t* A, int lda, const bf16_t* Bt, int ldb, int M, int N, int K, MidScale ms, const Epi& E) {
    const int lane = C.lane, fr = lane & 15, fq = lane >> 4, ncol = N / 64, ntile = (M / 16) * ncol;
    for (int t = C.gw; t < ntile; t += C.NGW) {
        const int row0 = (t / ncol) * 16, col0 = (t % ncol) * 64;
        const bf16_t* ap = A + (size_t)(row0 + fr) * lda + fq * 8;
        const bf16_t* bp = Bt + (size_t)(col0 + fr) * ldb + fq * 8;
        f32x4 acc[4];
#pragma unroll
        for (int n = 0; n < 4; ++n) acc[n] = (f32x4){0.f, 0.f, 0.f, 0.f};
        for (int k0 = 0; k0 < K; k0 += 32) {
            if (ms.f && k0 == ms.k) {
#pragma unroll
                for (int j = 0; j < 4; ++j) { const float f = ms.f[row0 + fq * 4 + j];
#pragma unroll
                    for (int n = 0; n < 4; ++n) acc[n][j] *= f; }
            }
            const bf16x8 a = *(const bf16x8*)(ap + k0);
#pragma unroll
            for (int n = 0; n < 4; ++n) { const bf16x8 b = *(const bf16x8*)(bp + (size_t)n * 16 * ldb + k0); acc[n] = __builtin_amdgcn_mfma_f32_16x16x32_bf16(a, b, acc[n], 0, 0, 0); }
        }
#pragma unroll
        for (int n = 0; n < 4; ++n)
#pragma unroll
            for (int j = 0; j < 4; ++j) E(row0 + fq * 4 + j, col0 + n * 16 + fr, acc[n][j]);
    }
}
struct EpiInProj { const float* rstd0; bf16_t *XR, *GG, *Qs, *Ks, *Vs;
    __device__ void operator()(int r, int c, float v) const { v *= rstd0[r]; const int t = c >> 9, cc = c & 511;
        if (t == 0) XR[(size_t)r * RW + cc] = (bf16_t)f2bf(v);
        else if (t == 1) GG[(size_t)r * RW + cc] = (bf16_t)f2bf(gelu_tanh(v));
        else if (t == 2) Qs[(size_t)r * SBW + cc] = (bf16_t)f2bf(v * (0.125f * LOG2E));
        else if (t == 3) Ks[(size_t)r * SBW + cc] = (bf16_t)f2bf(v);
        else Vs[(size_t)r * SBW + cc] = (bf16_t)f2bf(v); } };
struct EpiStoreBf16 { bf16_t* O; const float* rowscale; int ldo; float scale;
    __device__ void operator()(int r, int c, float v) const { O[(size_t)r * ldo + c] = (bf16_t)f2bf(v * (rowscale ? rowscale[r] : 1.f) * scale); } };
struct EpiResF32 { const float* base; const float* rowscale; bf16_t* O;
    __device__ void operator()(int r, int c, float v) const { O[(size_t)r * D + c] = (bf16_t)f2bf(base[(size_t)r * D + c] + v * rowscale[r]); } };
struct EpiResBf16 { const bf16_t* base; bf16_t* O;
    __device__ void operator()(int r, int c, float v) const { O[(size_t)r * D + c] = (bf16_t)f2bf(bf2f(base[(size_t)r * D + c]) + v); } };

__device__ __forceinline__ void lru_naive_unit(int unit, int j, LAS float* xs, const bf16_t* XR, const bf16_t* GG, const float* conv_w, const float* conv_b,
                                               const float* w_a, const float* b_a, const float* w_x, const float* b_x, const float* lam, bf16_t* YY) {
    const int b = unit >> 3, h = unit & 7, c = h * 64 + j;
    float wa[64], wx[64];
#pragma unroll
    for (int i = 0; i < 64; ++i) { wa[i] = w_a[(size_t)(h * 64 + i) * 64 + j]; wx[i] = w_x[(size_t)(h * 64 + i) * 64 + j]; }
    const float ba = b_a[c], bx = b_x[c], cw0 = conv_w[c], cw1 = conv_w[RW + c], cw2 = conv_w[2 * RW + c], cw3 = conv_w[3 * RW + c], cb = conv_b[c];
    const float l = lam[c], spl = (l > 15.f) ? __expf(-l) : log1pf(__expf(-l));
    float x0 = 0.f, x1 = 0.f, x2 = 0.f, hst = 0.f;
    for (int t = 0; t < SEQ; ++t) {
        const size_t row = (size_t)b * SEQ + t;
        const float x3 = bf2f(XR[row * RW + c]);
        const float xc = cw0 * x0 + cw1 * x1 + cw2 * x2 + cw3 * x3 + cb;
        x0 = x1; x1 = x2; x2 = x3;
        asm volatile("s_waitcnt lgkmcnt(0)" ::: "memory"); xs[j] = xc; asm volatile("s_waitcnt lgkmcnt(0)" ::: "memory");
        float ra = ba, ri = bx;
#pragma unroll
        for (int i = 0; i < 64; ++i) { const float xv = xs[i]; ra += xv * wa[i]; ri += xv * wx[i]; }
        const float r = sigmoidf_(ra), ig = sigmoidf_(ri);
        const float log_a = -8.0f * r * spl, a = __expf(log_a), bb = sqrtf(fmaxf(0.f, -expm1f(2.f * log_a))) * (ig * xc);
        hst = a * hst + bb;
        YY[row * D + c] = (bf16_t)f2bf(hst * bf2f(GG[row * RW + c]));
    }
}
__device__ __forceinline__ void sb_naive_unit(int unit, int lane, const bf16_t* Qs, const bf16_t* Ks, const bf16_t* Vs, bf16_t* YY, float* ssq_s8) {
    const int qb = unit & 63, h = (unit >> 6) & 7, b = unit >> 9;
    const int t = qb * 64 + lane; const size_t row = (size_t)b * SEQ + t;
    float q[64], o[64];
#pragma unroll
    for (int d = 0; d < 64; ++d) { q[d] = bf2f(Qs[row * SBW + h * 64 + d]); o[d] = 0.f; }
    float R = 0.f;
    for (int s = qb * 64 + 62; s >= 0; --s) {
        const bf16_t* kr = Ks + ((size_t)b * SEQ + s) * SBW + h * 64; const bf16_t* vr = Vs + ((size_t)b * SEQ + s) * SBW + h * 64;
        float z = 0.f;
#pragma unroll
        for (int d = 0; d < 64; ++d) z += q[d] * bf2f(kr[d]);
        const bool valid = s < t;
        const float sp = valid ? (fmaxf(z, 0.f) + __log2f(1.f + exp2f(-fabsf(z)))) : 0.f;
        const float w = valid ? exp2f(z - (R + sp)) : 0.f;
        R += sp;
        const float wb = bf2f((bf16_t)f2bf(w));
#pragma unroll
        for (int d = 0; d < 64; ++d) o[d] += wb * bf2f(vr[d]);
    }
    float ss = 0.f;
#pragma unroll
    for (int d = 0; d < 64; ++d) { ss += o[d] * o[d]; YY[row * D + RW + h * 64 + d] = (bf16_t)f2bf(o[d]); }
    ssq_s8[row * 8 + h] = ss;
}
__device__ __forceinline__ void xattn_naive_unit(int unit, int j, LAS float* qs, LAS float* ps, const bf16_t* QX, const bf16_t* KVM, bf16_t* OX) {
    const int tg = unit & 511, h = (unit >> 9) & 3, b = unit >> 11, lane = j & 63, wid = j >> 6;
    const size_t row0 = (size_t)b * SEQ + tg * 8;
    for (int i = 0; i < 8; ++i) qs[i * 256 + j] = bf2f(QX[(row0 + i) * D + h * XD + j]);
    __syncthreads();
    const bf16_t* kr = KVM + ((size_t)b * MEM + j) * 2048 + h * XD;
    float sc[8];
#pragma unroll
    for (int i = 0; i < 8; ++i) sc[i] = 0.f;
    for (int d = 0; d < XD; ++d) { const float kv = bf2f(kr[d]);
#pragma unroll
        for (int i = 0; i < 8; ++i) sc[i] += qs[i * 256 + d] * kv; }
#pragma unroll
    for (int i = 0; i < 8; ++i) ps[i * 256 + j] = sc[i];
    __syncthreads();
    for (int i = wid * 2; i < wid * 2 + 2; ++i) {
        float v0 = ps[i * 256 + lane], v1 = ps[i * 256 + lane + 64], v2 = ps[i * 256 + lane + 128], v3 = ps[i * 256 + lane + 192];
        float m = fmaxf(fmaxf(v0, v1), fmaxf(v2, v3));
#pragma unroll
        for (int o = 1; o < 64; o <<= 1) m = fmaxf(m, __shfl_xor(m, o));
        v0 = exp2f(v0 - m); v1 = exp2f(v1 - m); v2 = exp2f(v2 - m); v3 = exp2f(v3 - m);
        const float s = wave_sum(v0 + v1 + v2 + v3), inv = 1.f / s;
        ps[i * 256 + lane] = v0 * inv; ps[i * 256 + lane + 64] = v1 * inv; ps[i * 256 + lane + 128] = v2 * inv; ps[i * 256 + lane + 192] = v3 * inv;
    }
    __syncthreads();
    float o[8];
#pragma unroll
    for (int i = 0; i < 8; ++i) o[i] = 0.f;
    for (int m = 0; m < MEM; ++m) { const float vv = bf2f(KVM[((size_t)b * MEM + m) * 2048 + 1024 + h * XD + j]);
#pragma unroll
        for (int i = 0; i < 8; ++i) o[i] += ps[i * 256 + m] * vv; }
#pragma unroll
    for (int i = 0; i < 8; ++i) OX[(row0 + i) * D + h * XD + j] = (bf16_t)f2bf(o[i]);
    __syncthreads();
}
__device__ __forceinline__ int router_row(int row, int lane, const bf16_t* X2b, const float* ssq2p, const float* g, const float* wgr, const float* bgr, const float* wer, const float* ber, float* selw) {
    int cls = 0;
    float acc[20];
#pragma unroll
    for (int i = 0; i < 20; ++i) acc[i] = 0.f;
    const float rs = pg8::rstd16(ssq2p + (size_t)row * 16);
    for (int kk = 0; kk < 16; ++kk) { const int k = kk * 64 + lane; const float t = bf2f(X2b[(size_t)row * D + k]) * rs * g[k];
#pragma unroll
        for (int i = 0; i < 4; ++i) acc[i] += t * wgr[k * 4 + i];
#pragma unroll
        for (int gi = 0; gi < 4; ++gi)
#pragma unroll
            for (int e = 0; e < 4; ++e) acc[4 + gi * 4 + e] += t * wer[((size_t)gi * D + k) * 4 + e]; }
#pragma unroll
    for (int i = 0; i < 20; ++i) acc[i] = wave_sum(acc[i]);
    if (lane == 0) {
        float gl[4]; float gm = -INFINITY; int gi = 0;
#pragma unroll
        for (int i = 0; i < 4; ++i) { gl[i] = acc[i] + bgr[i]; if (gl[i] > gm) { gm = gl[i]; gi = i; } }
        float gs = 0.f;
#pragma unroll
        for (int i = 0; i < 4; ++i) gs += __expf(gl[i] - gm);
        const float gp = 1.f / gs;
        float el[4];
#pragma unroll
        for (int e = 0; e < 4; ++e) { float v = 0.f;
#pragma unroll
            for (int q = 0; q < 4; ++q) if (q == gi) v = acc[4 + q * 4 + e] + ber[q * 4 + e];
            el[e] = v; }
        int e1 = 0; float m1 = el[0];
#pragma unroll
        for (int e = 1; e < 4; ++e) if (el[e] > m1) { m1 = el[e]; e1 = e; }
        int e2 = -1; float m2 = -INFINITY;
#pragma unroll
        for (int e = 0; e < 4; ++e) if (e != e1 && el[e] > m2) { m2 = el[e]; e2 = e; }
        const float p2 = __expf(m2 - m1), w1 = gp / (1.f + p2), w2 = gp * p2 / (1.f + p2);
        const int ea = e1 < e2 ? e1 : e2, eb = e1 < e2 ? e2 : e1; const float wA = e1 < e2 ? w1 : w2, wB = e1 < e2 ? w2 : w1;
        const int pr = (ea == 0) ? eb - 1 : (ea == 1) ? eb + 1 : 5;
        selw[(size_t)row * 2] = wA; selw[(size_t)row * 2 + 1] = wB; cls = gi * 6 + pr;
    }
    return cls;
}
__device__ __forceinline__ void final_row(int row, int lane, const bf16_t* X3b, const float* ssq3, const float* g, float* out) {
    const float r = pg8::rstd16(ssq3 + (size_t)row * 16);
#pragma unroll
    for (int j = 0; j < 2; ++j) { const int c = j * 512 + lane * 8; const u32x4 v = *(const u32x4*)(X3b + (size_t)row * D + c); const f32x4 g0 = *(const f32x4*)(g + c), g1 = *(const f32x4*)(g + c + 4);
        f32x4 o0, o1;
        o0[0] = __uint_as_float(v.x << 16) * r * g0[0]; o0[1] = __uint_as_float(v.x & 0xffff0000u) * r * g0[1]; o0[2] = __uint_as_float(v.y << 16) * r * g0[2]; o0[3] = __uint_as_float(v.y & 0xffff0000u) * r * g0[3];
        o1[0] = __uint_as_float(v.z << 16) * r * g1[0]; o1[1] = __uint_as_float(v.z & 0xffff0000u) * r * g1[1]; o1[2] = __uint_as_float(v.w << 16) * r * g1[2]; o1[3] = __uint_as_float(v.w & 0xffff0000u) * r * g1[3];
        *(f32x4*)(out + (size_t)row * D + c) = o0; *(f32x4*)(out + (size_t)row * D + c + 4) = o1; }
}
__device__ __forceinline__ void reids(Ctx& C) { int t_ = threadIdx.x; asm volatile("" : "+v"(t_)); C.tid = t_; C.lane = t_ & 63; C.wave = __builtin_amdgcn_readfirstlane(t_ >> 6); C.gw = C.bid * NWAVES + C.wave; }
__global__ void __launch_bounds__(NTHREADS, 2) mk_fwd(Args args) {
    extern __shared__ __attribute__((aligned(16))) unsigned char lds[];
    cg::grid_group grid = cg::this_grid();
    Ctx C;
#pragma unroll
    for (int i = 0; i < 29; ++i) C.in[i] = args.in[i];
    C.out = args.out; C.ws = args.ws; C.lds = lds;
    C.tid = threadIdx.x; C.lane = C.tid & 63; C.wave = __builtin_amdgcn_readfirstlane(C.tid >> 6);
    C.G = gridDim.x; C.bid = blockIdx.x; C.gw = C.bid * NWAVES + C.wave; C.NGW = C.G * NWAVES;
    const float* x = C.in[0]; const float* mem = C.in[1]; const float* norm_mix = C.in[2]; const float* w_in = C.in[3];
    const float* conv_w = C.in[4]; const float* conv_b = C.in[5]; const float* lru_w_a = C.in[6]; const float* lru_b_a = C.in[7];
    const float* lru_w_x = C.in[8]; const float* lru_b_x = C.in[9]; const float* lru_lambda = C.in[10];
    const float* norm_rnn = C.in[11]; const float* norm_sb = C.in[12]; const float* w_out = C.in[13];
    const float* norm_xattn = C.in[14]; const float* norm_mem = C.in[15];
    const float* xa_w_q = C.in[16]; const float* xa_w_k = C.in[17]; const float* xa_w_v = C.in[18]; const float* xa_w_o = C.in[19];
    const float* norm_moe = C.in[20]; const float* w_gr = C.in[21]; const float* b_gr = C.in[22]; const float* w_er = C.in[23]; const float* b_er = C.in[24];
    const float* w_gate = C.in[25]; const float* w_up = C.in[26]; const float* w_down = C.in[27]; const float* norm_final = C.in[28];
    unsigned char* ws = C.ws; float* out = C.out;
    float* sm = (float*)(ws + WS_SMALL);
    float* rstd0 = sm + SM_RSTD0; float* ssq_r = sm + SM_SSQR; float* ssq_s = sm + SM_SSQS; float* ssq1 = sm + SM_SSQ1; float* ssq2 = sm + SM_SSQ2; unsigned* kmax = (unsigned*)(ws + WS_CTL); float* fmid = sm + SM_END; float* fend = fmid + 32768;
    float* aggP = sm + 96 * 32768; float* aggH = sm + 104 * 32768;
    float* selw = sm + SM_SELW; float* ssq3 = sm + SM_SSQ3; int* gcnt = (int*)(ws + WS_CTL + 1024);
    int* tlist = (int*)(sm + 64 * 32768); float* rsg = sm + 88 * 32768; float* wAg = rsg + 40960; float* wBg = wAg + 40960; int* tokg = (int*)(wBg + 40960);
    bf16_t* Wrh = (bf16_t*)(ws + WS_CTL + 65536); bf16_t* Wrl = Wrh + 32 * D;
    bf16_t* Wg_t = (bf16_t*)(ws + WS_WG); bf16_t* Wu_t = (bf16_t*)(ws + WS_WU); bf16_t* Wd2 = (bf16_t*)(ws + WS_WD2); bf16_t* XG = (bf16_t*)(ws + WS_R1); bf16_t* HID = (bf16_t*)(ws + WS_R5);
    bf16_t* Win_t = (bf16_t*)(ws + WS_WIN); bf16_t* Wout_t = (bf16_t*)(ws + WS_WOUT); bf16_t* Wq_t = (bf16_t*)(ws + WS_WQ); bf16_t* Wkv_t = (bf16_t*)(ws + WS_WKV); bf16_t* Wo_t = (bf16_t*)(ws + WS_WO);
    bf16_t* memn = (bf16_t*)(ws + WS_MEMN); bf16_t* KM = (bf16_t*)(ws + WS_KVM); bf16_t* VT = KM + (size_t)NMEM * D;
    bf16_t* xb = (bf16_t*)(ws + WS_R0); bf16_t* X1b = xb; bf16_t* X3b = xb;
    bf16_t* XR = (bf16_t*)(ws + WS_R1); bf16_t* GG = XR + (size_t)NTOK * RW; bf16_t* QX = XR;
    bf16_t* Qs = (bf16_t*)(ws + WS_R2); bf16_t* Ks = Qs + (size_t)NTOK * SBW; bf16_t* OX = Qs;
    bf16_t* Vs = (bf16_t*)(ws + WS_R3);
    bf16_t* YY = (bf16_t*)(ws + WS_R4); bf16_t* X2b = YY;
    const int NGW = C.NGW;
#define gw C.gw
#define lane C.lane
    if (C.tid < 64) ((LAS unsigned*)(lds + 146432))[C.tid] = 0u;
    __syncthreads();
    XcdBarrier bar = xcd_barrier_post((unsigned*)(ws + WS_CTL + 4096), (volatile LAS unsigned*)(lds + 146432 + 32));
#define GRID_SYNC_CG() do { grid.sync(); reids(C); } while (0)
#define GRID_SYNC() do { xcd_barrier(bar); reids(C); } while (0)

    for (int rep_ = 0; rep_ < (int)((REP_MASK >> 0) & 1u) + 1; ++rep_) {
    {
        if (gw == 0) { kmax[lane] = 0u; if (lane < 32) gcnt[lane] = 0; }
        for (int r = gw; r < NTOK; r += NGW) row_prep_x(x, xb, rstd0, r, lane);
        for (int r = gw; r < NMEM; r += NGW) row_prep_mem(mem, norm_mem, memn, r, lane);
        LAS float* scr = (LAS float*)(lds) + C.wave * (64 * 33);
        constexpr int I_IN = (D / 64) * (PROJ / 32), I_SQ = (D / 64) * (D / 32);
        for (int it = gw; it < I_IN + 5 * I_SQ; it += NGW) {
            int r = it;
            if (r < I_IN) { transpose_item(w_in, D, PROJ, Win_t, D, norm_mix, norm_mix, D, scr, r, lane); continue; } r -= I_IN;
            if (r < I_SQ) { transpose_item(w_out, D, D, Wout_t, D, norm_rnn, norm_sb, RW, scr, r, lane); continue; } r -= I_SQ;
            if (r < I_SQ) { transpose_item(xa_w_q, D, D, Wq_t, D, norm_xattn, norm_xattn, D, scr, r, lane); continue; } r -= I_SQ;
            if (r < I_SQ) { transpose_item(xa_w_k, D, D, Wkv_t, D, nullptr, nullptr, 0, scr, r, lane); continue; } r -= I_SQ;
            if (r < I_SQ) { transpose_item(xa_w_v, D, D, Wkv_t + (size_t)D * D, D, nullptr, nullptr, 0, scr, r, lane); continue; } r -= I_SQ;
            transpose_item(xa_w_o, D, D, Wo_t, D, nullptr, nullptr, 0, scr, r, lane);
        }
        for (int idx = gw * 64 + lane; idx < 32 * D; idx += NGW * 64) { const int n = idx >> 10, k = idx & 1023; float w = 0.f;
            if (n < 4) w = w_gr[k * 4 + n]; else if (n < 20) w = w_er[((size_t)((n - 4) >> 2) * D + k) * 4 + ((n - 4) & 3)];
            w *= norm_moe[k]; const unsigned hi = f2bf(w); Wrh[idx] = (bf16_t)hi; Wrl[idx] = (bf16_t)f2bf(w - bf2f((unsigned short)hi)); }
        constexpr int I_GU = (D / 64) * (DE / 32), I_DN = (DE / 64) * (D / 32);
        for (int it = gw; it < 32 * I_GU + 48 * I_DN; it += NGW) {
            int r = it;
            if (r < 16 * I_GU) { const int e = r / I_GU; transpose_item(w_gate + (size_t)e * D * DE, D, DE, Wg_t + (size_t)e * DE * D, D, norm_moe, norm_moe, D, scr, r % I_GU, lane); continue; } r -= 16 * I_GU;
            if (r < 16 * I_GU) { const int e = r / I_GU; transpose_item(w_up + (size_t)e * D * DE, D, DE, Wu_t + (size_t)e * DE * D, D, norm_moe, norm_moe, D, scr, r % I_GU, lane); continue; } r -= 16 * I_GU;
            { const int cs = r / I_DN, cls = cs >> 1, slot = cs & 1; int ea, eb; pg8::pair_ab(cls % 6, ea, eb); const int e = (cls / 6) * 4 + (slot ? eb : ea);
              transpose_item(w_down + (size_t)e * DE * D, DE, D, Wd2 + (size_t)cls * D * 512 + slot * DE, 512, nullptr, nullptr, 0, scr, r % I_DN, lane); }
        }
    }
    }
    GRID_SYNC_CG();
    for (int rep_ = 0; rep_ < (int)((REP_MASK >> 1) & 1u) + 1; ++rep_) {
    { pg8::DenseOrder S; S.init(xb, D, Win_t, D, NTOK, PROJ, C.G, C.bid); pg8::EpiInProjF E{0, rstd0, XR, GG, Qs, Ks, Vs, kmax};
      pg8::gemm_phase<pg8::EpiInProjF, pg8::DenseOrder, true>((LAS unsigned char*)lds, pg8::Gemm{D, D, D}, S, E); }
    { pg8::DenseOrder S; S.init(memn, D, Wkv_t, D, NMEM, D, C.G, C.bid); pg8::EpiBf16F E{0, KM, nullptr, D, 1.f, 0};
      pg8::gemm_phase<pg8::EpiBf16F, pg8::DenseOrder, true>((LAS unsigned char*)lds, pg8::Gemm{D, D, D}, S, E); }
    { pg8::DenseOrder S; S.init(Wkv_t + (size_t)D * D, D, memn, D, D, NMEM, C.G, C.bid); pg8::EpiBf16F E{0, VT, nullptr, MEM, 1.f, (size_t)D * MEM};
      pg8::gemm_phase<pg8::EpiBf16F, pg8::DenseOrder, true>((LAS unsigned char*)lds, pg8::Gemm{D, D, D}, S, E); }
    }
    GRID_SYNC();
    lru::Weights LW; lru::load_weights(LW, C.wave, lane & 31, lane >> 5, lru_w_a, lru_b_a, lru_w_x, lru_b_x, lru_lambda);
    for (int rep_ = 0; rep_ < (int)((REP_MASK >> 2) & 1u) + 1; ++rep_) {
    {
        for (int u = C.bid; u < BATCH * 64; u += C.G) lru::unit<false>(u >> 6, u & 63, LW, XR, GG, conv_w, conv_b, aggP, aggH, ssq_s, YY, fmid, fend, lds);
        for (int u = C.bid; u < BATCH * NH * 16; u += C.G) sba::sb_unit(u >> 7, (u >> 4) & 7, 15 - (u & 15), Qs, Ks, Vs, YY, ssq_s, kmax, (char*)lds);
    }
    }
    GRID_SYNC();
    for (int rep_ = 0; rep_ < (int)((REP_MASK >> 3) & 1u) + 1; ++rep_) {
    for (int u = C.bid; u < BATCH * 64; u += C.G) lru::unit<true>(u >> 6, u & 63, LW, XR, GG, conv_w, conv_b, aggP, aggH, ssq_s, YY, fmid, fend, lds);
    }
    GRID_SYNC();
    for (int rep_ = 0; rep_ < (int)((REP_MASK >> 4) & 1u) + 1; ++rep_) {
    { pg8::DenseOrder S; S.init(YY, D, Wout_t, D, NTOK, D, C.G, C.bid); pg8::EpiX1F E{8, x, fmid, fend, X1b, ssq1};
      pg8::gemm_phase<pg8::EpiX1F, pg8::DenseOrder, true>((LAS unsigned char*)lds, pg8::Gemm{D, D, D}, S, E); }
    }
    GRID_SYNC();
    for (int rep_ = 0; rep_ < (int)((REP_MASK >> 5) & 1u) + 1; ++rep_) {
    { pg8::DenseOrder S; S.init(X1b, D, Wq_t, D, NTOK, D, C.G, C.bid); pg8::EpiBf16F E{0, QX, ssq1, D, 0.0625f * LOG2E, 0};
      pg8::gemm_phase<pg8::EpiBf16F, pg8::DenseOrder, true>((LAS unsigned char*)lds, pg8::Gemm{D, D, D}, S, E); }
    }
    GRID_SYNC();
    for (int rep_ = 0; rep_ < (int)((REP_MASK >> 6) & 1u) + 1; ++rep_) {
    { pg8::XaSOrder S{QX, KM, C.G, C.bid}; pg8::EpiSoftmax E{0, QX, (LAS float*)(lds + 131072 + 2048)};
      pg8::gemm_phase<pg8::EpiSoftmax, pg8::XaSOrder, true>((LAS unsigned char*)lds, pg8::Gemm{D, D, XD}, S, E); }
    }
    GRID_SYNC();
    for (int rep_ = 0; rep_ < (int)((REP_MASK >> 7) & 1u) + 1; ++rep_) {
    { pg8::XaOOrder S{QX, VT, C.G, C.bid}; pg8::EpiBf16F E{0, OX, nullptr, D, 1.f, 0};
      pg8::gemm_phase<pg8::EpiBf16F, pg8::XaOOrder, true>((LAS unsigned char*)lds, pg8::Gemm{D, MEM, MEM}, S, E); }
    }
    GRID_SYNC();
    for (int rep_ = 0; rep_ < (int)((REP_MASK >> 8) & 1u) + 1; ++rep_) {
    { pg8::DenseOrder S; S.init(OX, D, Wo_t, D, NTOK, D, C.G, C.bid); pg8::EpiResF E{0, X1b, X2b, ssq2};
      pg8::gemm_phase<pg8::EpiResF, pg8::DenseOrder, true>((LAS unsigned char*)lds, pg8::Gemm{D, D, D}, S, E); }
    }
    GRID_SYNC();
    for (int rep_ = 0; rep_ < (int)((REP_MASK >> 9) & 1u) + 1; ++rep_) {
    {
        LAS int* lcnt = (LAS int*)lds; LAS int* lbase = lcnt + 32; LAS int* lcls = lcnt + 64; LAS int* lpos = lcnt + 192;
        for (int chunk = C.bid; chunk < NTOK / 128; chunk += C.G) {
            if (C.tid < 32) lcnt[C.tid] = 0;
            __syncthreads();
            {
                const int fr = lane & 15, fq = lane >> 4, row0 = chunk * 128 + C.wave * 16;
                f32x4 acc0 = {0.f, 0.f, 0.f, 0.f}, acc1 = acc0;
                const bf16_t* ap = X2b + (size_t)(row0 + fr) * D + fq * 8; const bf16_t* bp = Wrh + (size_t)fr * D + fq * 8;
#pragma unroll 4
                for (int ks = 0; ks < 32; ++ks) { const bf16x8 a = *(const bf16x8*)(ap + ks * 32);
                    const bf16x8 h0 = *(const bf16x8*)(bp + ks * 32), h1 = *(const bf16x8*)(bp + 16 * D + ks * 32), l0 = *(const bf16x8*)(bp + 32 * D + ks * 32), l1 = *(const bf16x8*)(bp + 48 * D + ks * 32);
                    acc0 = __builtin_amdgcn_mfma_f32_16x16x32_bf16(a, h0, acc0, 0, 0, 0); acc1 = __builtin_amdgcn_mfma_f32_16x16x32_bf16(a, h1, acc1, 0, 0, 0);
                    acc0 = __builtin_amdgcn_mfma_f32_16x16x32_bf16(a, l0, acc0, 0, 0, 0); acc1 = __builtin_amdgcn_mfma_f32_16x16x32_bf16(a, l1, acc1, 0, 0, 0); }
                LAS float* lg = (LAS float*)(lds + 4096) + C.wave * (16 * 33);
#pragma unroll
                for (int j = 0; j < 4; ++j) { lg[(4 * fq + j) * 33 + fr] = acc0[j]; lg[(4 * fq + j) * 33 + 16 + fr] = acc1[j]; }
                asm volatile("s_waitcnt lgkmcnt(0)" ::: "memory");
                if (lane < 16) { const int row = row0 + lane; const float rs = pg8::rstd16(ssq2 + (size_t)row * 16); const LAS float* lr = lg + lane * 33;
                    float gl[4]; float gm = -INFINITY; int gi = 0;
#pragma unroll
                    for (int i = 0; i < 4; ++i) { gl[i] = lr[i] * rs + b_gr[i]; if (gl[i] > gm) { gm = gl[i]; gi = i; } }
                    float gs = 0.f;
#pragma unroll
                    for (int i = 0; i < 4; ++i) gs += __expf(gl[i] - gm);
                    const float gp = 1.f / gs;
                    float el[4];
#pragma unroll
                    for (int e = 0; e < 4; ++e) el[e] = lr[4 + gi * 4 + e] * rs + b_er[gi * 4 + e];
                    int e1 = 0; float m1 = el[0];
#pragma unroll
                    for (int e = 1; e < 4; ++e) if (el[e] > m1) { m1 = el[e]; e1 = e; }
                    int e2 = -1; float m2 = -INFINITY;
#pragma unroll
                    for (int e = 0; e < 4; ++e) if (e != e1 && el[e] > m2) { m2 = el[e]; e2 = e; }
                    const float p2 = __expf(m2 - m1), w1 = gp / (1.f + p2), w2 = gp * p2 / (1.f + p2);
                    const int ea = e1 < e2 ? e1 : e2, eb = e1 < e2 ? e2 : e1; const float wA = e1 < e2 ? w1 : w2, wB = e1 < e2 ? w2 : w1;
                    const int pr = (ea == 0) ? eb - 1 : (ea == 1) ? eb + 1 : 5, cls = gi * 6 + pr, lt = C.wave * 16 + lane;
                    selw[(size_t)row * 2] = wA; selw[(size_t)row * 2 + 1] = wB;
                    lcls[lt] = cls; lpos[lt] = __hip_atomic_fetch_add(lcnt + cls, 1, __ATOMIC_RELAXED, __HIP_MEMORY_SCOPE_WORKGROUP); }
            }
            __syncthreads();
            if (C.tid < 24) lbase[C.tid] = atomicAdd(gcnt + C.tid, lcnt[C.tid]);
            __syncthreads();
            if (C.tid < 128) { const int c = lcls[C.tid]; tlist[(size_t)c * NTOK + lbase[c] + lpos[C.tid]] = chunk * 128 + C.tid; }
            __syncthreads();
        }
    }
    }
    GRID_SYNC();
    LAS int* meta = (LAS int*)(lds + 146432 + 256);
    for (int rep_ = 0; rep_ < (int)((REP_MASK >> 10) & 1u) + 1; ++rep_) {
    {
        if (C.tid == 0) { int rb = 0, tb = 0;
            for (int c = 0; c < 24; ++c) { const int n = gcnt[c], nt = (n + 255) >> 8; meta[c] = n; meta[32 + c] = rb; meta[64 + c] = tb; rb += nt * 256; tb += nt; }
            meta[32 + 24] = rb; meta[64 + 24] = tb; }
        __syncthreads();
        const int total = meta[32 + 24];
        for (int R = gw; R < total; R += NGW) {
            int c = 0;
            for (int k = 1; k < 24; ++k) c += (R >= meta[32 + k]) ? 1 : 0;
            const int p = R - meta[32 + c]; u32x4 v0 = (u32x4){0u, 0u, 0u, 0u}, v1 = v0; int tok = -1; float rs = 0.f, wA = 0.f, wB = 0.f;
            if (p < meta[c]) { tok = tlist[(size_t)c * NTOK + p]; const u32x4* src = (const u32x4*)(X2b + (size_t)tok * D) + lane; v0 = src[0]; v1 = src[64];
                rs = pg8::rstd16(ssq2 + (size_t)tok * 16); wA = selw[(size_t)tok * 2]; wB = selw[(size_t)tok * 2 + 1]; }
            u32x4* dst = (u32x4*)(XG + (size_t)R * D) + lane; dst[0] = v0; dst[64] = v1;
            if (lane == 0) { rsg[R] = rs; wAg[R] = wA; wBg[R] = wB; tokg[R] = tok; }
        }
    }
    }
    GRID_SYNC();
    for (int rep_ = 0; rep_ < (int)((REP_MASK >> 11) & 1u) + 1; ++rep_) {
    { pg8::MoeOrder1 S{XG, Wg_t, Wu_t, meta, C.G, C.bid}; pg8::EpiMoeUp E{0, rsg, wAg, wBg, HID};
      pg8::gemm_phase<pg8::EpiMoeUp, pg8::MoeOrder1, true>((LAS unsigned char*)lds, pg8::Gemm{D, D, D}, S, E); }
    }
    GRID_SYNC();
    for (int rep_ = 0; rep_ < (int)((REP_MASK >> 12) & 1u) + 1; ++rep_) {
    { pg8::MoeOrder2 S{HID, Wd2, meta, C.G, C.bid}; pg8::EpiMoeDown E{0, tokg, X2b, X3b, ssq3};
      pg8::gemm_phase<pg8::EpiMoeDown, pg8::MoeOrder2, true>((LAS unsigned char*)lds, pg8::Gemm{512, 512, 512}, S, E); }
    }
    GRID_SYNC();
    for (int rep_ = 0; rep_ < (int)((REP_MASK >> 13) & 1u) + 1; ++rep_) {
    for (int r = gw; r < NTOK; r += NGW) final_row(r, lane, X3b, ssq3, norm_final, out);
    }
}

#undef gw
#undef lane
extern "C" void kernel_launch(void* const* d_in, const int* in_sizes, int n_in, void* d_out, int out_size, void* d_ws, size_t ws_size, hipStream_t stream) {
    static int grid = 0;
    if (grid == 0) {
        if (n_in != 29 || ws_size < WS_END) { fprintf(stderr, "kernel_launch: unexpected inputs (%d) or workspace (%zu)\n", n_in, ws_size); grid = -1; return; }
        int dev = 0, cus = 0, per_cu = 0;
        hipGetDevice(&dev); hipDeviceGetAttribute(&cus, hipDeviceAttributeMultiprocessorCount, dev);
        hipFuncSetAttribute((const void*)mk_fwd, hipFuncAttributeMaxDynamicSharedMemorySize, LDS_BYTES);
        hipOccupancyMaxActiveBlocksPerMultiprocessor(&per_cu, (const void*)mk_fwd, NTHREADS, LDS_BYTES);
        if (per_cu < 1) { fprintf(stderr, "kernel_launch: occupancy query says %d blocks per CU\n", per_cu); per_cu = 1; }
        if (per_cu > 1) per_cu = 1;
        grid = cus * per_cu;
    }
    if (grid < 0) return;
    if (hipMemsetAsync((char*)d_ws + WS_CTL + 4096, 0, 16384, stream) != hipSuccess) { fprintf(stderr, "kernel_launch: memset of the barrier words failed\n"); return; }
    Args a{};
    for (int i = 0; i < 29; ++i) a.in[i] = (const float*)d_in[i];
    a.out = (float*)d_out; a.ws = (unsigned char*)d_ws;
    void* kargs[] = {&a};
    hipError_t e = hipLaunchCooperativeKernel((const void*)mk_fwd, dim3(grid), dim3(NTHREADS), kargs, LDS_BYTES, stream);
    if (e != hipSuccess) fprintf(stderr, "cooperative launch failed: %s (grid %d)\n", hipGetErrorString(e), grid);
}
```

```cpp
#include <hip/hip_runtime.h>
#include <hip/hip_cooperative_groups.h>
#include <cstdio>
#include <cstdint>

typedef unsigned short bf16_t;
typedef short bf16x8 __attribute__((ext_vector_type(8)));
typedef float f32x4 __attribute__((ext_vector_type(4)));
typedef unsigned u32x4 __attribute__((ext_vector_type(4)));

constexpr int D = 1024, BATCH = 8, SEQ = 4096, NTOK = BATCH * SEQ, MEM = 256, NMEM = BATCH * MEM;
constexpr int RW = 512, SBW = 512, PROJ = 2560, NH = 8, HD = 64;
constexpr int XH = 4, XD = 256, NG = 4, EPG = 4, NEXP = 16, DE = 256;
constexpr float EPS = 1e-6f, LOG2E = 1.4426950408889634f;

constexpr size_t MiB = 1u << 20;
constexpr size_t WS_CTL = 0;
constexpr size_t WS_SMALL = 1 * MiB;
constexpr size_t WS_WIN = 16 * MiB;
constexpr size_t WS_WOUT = 21 * MiB;
constexpr size_t WS_WQ = 23 * MiB;
constexpr size_t WS_WKV = 25 * MiB;
constexpr size_t WS_WO = 29 * MiB;
constexpr size_t WS_MEMN = 31 * MiB;
constexpr size_t WS_KVM = 35 * MiB;
constexpr size_t WS_WG = 43 * MiB;
constexpr size_t WS_WU = 51 * MiB;
constexpr size_t WS_WD2 = 59 * MiB;
constexpr size_t WS_R0 = 96 * MiB;
constexpr size_t WS_R1 = 160 * MiB;
constexpr size_t WS_R2 = 224 * MiB;
constexpr size_t WS_R3 = 288 * MiB;
constexpr size_t WS_R4 = 320 * MiB;
constexpr size_t WS_R5 = 384 * MiB;
constexpr size_t WS_END = 448 * MiB;

constexpr size_t SM_RSTD0 = 0;
constexpr size_t SM_SSQR = 1 * 32768;
constexpr size_t SM_SSQS = 2 * 32768;
constexpr size_t SM_SSQ1 = 10 * 32768;
constexpr size_t SM_SSQ2 = 26 * 32768;
constexpr size_t SM_SSQ3 = 42 * 32768;
constexpr size_t SM_SELW = 58 * 32768;
constexpr size_t SM_SELE = 60 * 32768;
constexpr size_t SM_END = 62 * 32768;

__device__ __forceinline__ unsigned f2bf(float f) { unsigned u = __builtin_bit_cast(unsigned, f); return (u + 0x7fffu + ((u >> 16) & 1u)) >> 16; }
__device__ __forceinline__ float bf2f(unsigned short h) { return __builtin_bit_cast(float, (unsigned)h << 16); }
__device__ __forceinline__ float wave_sum(float v) {
#pragma unroll
    for (int o = 1; o < 64; o <<= 1) v += __shfl_xor(v, o);
    return v;
}
__device__ __forceinline__ float gelu_tanh(float x) { const float u = 0.7978845608028654f * (x + 0.044715f * x * x * x); return x / (1.f + __expf(-2.f * u)); }
__device__ __forceinline__ float sigmoidf_(float x) { return 1.f / (1.f + __expf(-x)); }

namespace cg = cooperative_groups;
#ifndef REP_MASK
#define REP_MASK 0u
#endif
#define LAS __attribute__((address_space(3)))
constexpr int NWAVES = 8, NTHREADS = 512;
constexpr int LDS_BYTES = 147456;

struct Args { const float* in[29]; float* out; unsigned char* ws; };

struct Ctx {
    const float* in[29]; float* out; unsigned char* ws; unsigned char* lds;
    int tid, lane, wave, gw, NGW, G, bid;
};

#define RLX_AGENT __ATOMIC_RELAXED, __HIP_MEMORY_SCOPE_AGENT
#define XB_TMO      128
#define XB_XCNT(j)  (256  + 64 * (j))
#define XB_XSUB(j)  (1280 + 64 * (j))
#define XB_XGEN(j)  (2304 + 64 * (j))
#define XB_TOP      3328
#define XB_TOPGEN   3392
#define XCD_BAR_WORDS 3456
#define XB_SPIN_CAP (1u << 18)

__device__ __forceinline__ unsigned xb_ld(unsigned* p)              { return __hip_atomic_load(p, __ATOMIC_RELAXED, __HIP_MEMORY_SCOPE_AGENT); }
__device__ __forceinline__ unsigned xb_add(unsigned* p, unsigned v) { return __hip_atomic_fetch_add(p, v, __ATOMIC_RELAXED, __HIP_MEMORY_SCOPE_AGENT); }
__device__ __forceinline__ unsigned xb_xcc_id() { return (unsigned)__builtin_amdgcn_s_getreg((3 << 11) | 20) & 0xFu; }
#define XB_SPIN(cond, bar) do { unsigned _sp = 0; while (cond) { __builtin_amdgcn_s_sleep(1); \
    if ((++_sp & 255u) == 0u) { if (xb_ld(&(bar)[XB_TMO])) break; if (_sp > XB_SPIN_CAP) { atomicAdd(&(bar)[XB_TMO], 1u); break; } } } } while (0)

struct XcdBarrier {
    unsigned* bar; unsigned x;
    volatile LAS unsigned* st;
};

__device__ __forceinline__ XcdBarrier xcd_barrier_post(unsigned* bar, volatile LAS unsigned* st) {
    XcdBarrier b; b.bar = bar; b.x = xb_xcc_id(); b.st = st;
    if (threadIdx.x == 0) (void)xb_add(&bar[XB_XCNT(b.x)], 1u);
    return b;
}
__device__ __forceinline__ void xcd_barrier_complete(unsigned* bar, unsigned x, unsigned& nloc, unsigned& nx) {
    const unsigned G = gridDim.x * gridDim.y * gridDim.z;
    unsigned sum, cnt, mine, sp = 0u;
    for (;;) {
        sum = 0u; cnt = 0u; mine = 0u;
#pragma unroll
        for (unsigned j = 0; j < 16; ++j) { const unsigned c = xb_ld(&bar[XB_XCNT(j)]); sum += c; cnt += (c > 0u) ? 1u : 0u; mine = (j == x) ? c : mine; }
        if (sum == G) break;
        __builtin_amdgcn_s_sleep(1);
        if ((++sp & 255u) == 0u) { if (xb_ld(&bar[XB_TMO])) break; if (sp > XB_SPIN_CAP) { atomicAdd(&bar[XB_TMO], 1u); break; } }
    }
    nloc = mine > 0u ? mine : 1u; nx = cnt > 0u ? cnt : 1u;
}

__device__ __forceinline__ void xcd_barrier(const XcdBarrier& b) {
    asm volatile("s_waitcnt vmcnt(0)" ::: "memory");
    __syncthreads();
    if (threadIdx.x == 0) {
        unsigned* bar = b.bar;
        __builtin_amdgcn_s_waitcnt(0);
        unsigned nloc = b.st[0], nx = b.st[1];
        if (nloc == 0u) { xcd_barrier_complete(bar, b.x, nloc, nx); b.st[0] = nloc; b.st[1] = nx; }
        const unsigned old = xb_add(&bar[XB_XSUB(b.x)], 1u);
        const unsigned gen = old / nloc;
        if (old + 1u == (gen + 1u) * nloc) {
            __builtin_amdgcn_fence(__ATOMIC_RELEASE, "agent");
            asm volatile("s_waitcnt vmcnt(0)" ::: "memory");
            const unsigned og = xb_add(&bar[XB_TOP], 1u);
            const unsigned tg = og / nx;
            if (og + 1u == (tg + 1u) * nx) xb_add(&bar[XB_TOPGEN], 1u);
            else XB_SPIN(xb_ld(&bar[XB_TOPGEN]) == tg, bar);
            __builtin_amdgcn_fence(__ATOMIC_ACQUIRE, "agent");
            xb_add(&bar[XB_XGEN(b.x)], 1u);
            asm volatile("s_waitcnt vmcnt(0)" ::: "memory");
        } else {
            XB_SPIN(xb_ld(&bar[XB_XGEN(b.x)]) == gen, bar);
            __builtin_amdgcn_fence(__ATOMIC_ACQUIRE, "agent");
            asm volatile("s_waitcnt vmcnt(0)" ::: "memory");
        }
    }
    __syncthreads();
}
namespace pg8 {
#define PG8_LAS __attribute__((address_space(3)))
constexpr int BM = 256, BK = 64, HALF = 128, HTB = HALF * BK * 2  , STAGE_BYTES = 8 * HTB, NXCD = 8, WGM = 8;
__host__ __device__ __forceinline__ int lds_byte(int r, int c) { const int st = (r >> 4) * 2 + (c >> 5), rr = r & 15, cc = c & 31, ob = rr * 64 + cc * 2; return st * 1024 + (ob ^ (((ob >> 9) & 1) << 5)); }
__host__ __device__ __forceinline__ void stage_rc(int b, int& R, int& C) { const int st = b / 1024, sb = b % 1024, swz = sb ^ (((sb >> 9) & 1) << 5); R = (st >> 1) * 16 + swz / 64; C = (st & 1) * 32 + (swz % 64) / 2; }
__host__ __device__ __forceinline__ int perm32(int rho) { const int n = rho >> 4, i = rho & 15; return 8 * (i >> 2) + 4 * n + (i & 3); }

struct Unit { int pm, pn; };
struct Gemm { int lda, ldb, K; };
struct DenseOrder {
    const bf16_t* A; const bf16_t* Bt; int lda, ldb; int nM, nN, nwg, G, c;
    __device__ void init(const bf16_t* A_, int lda_, const bf16_t* Bt_, int ldb_, int M, int N, int G_, int c_) { A = A_; Bt = Bt_; lda = lda_; ldb = ldb_; nM = M / BM; nN = N / BM; nwg = nM * nN; G = G_; c = c_; }
    __device__ bool next(int i, Unit& u) const {
        const long L = (long)i * G + c; if (L >= nwg) return false;
        int wgid = (int)L; { const int q = nwg / NXCD, r = nwg % NXCD, xcd = wgid % NXCD, off = wgid / NXCD; wgid = (xcd < r ? xcd * (q + 1) : r * (q + 1) + (xcd - r) * q) + off; }
        const int nig = WGM * nN, gid = wgid / nig, fm = gid * WGM, gsz = (nM - fm) < WGM ? (nM - fm) : WGM;
        u.pm = fm + ((wgid % nig) % gsz); u.pn = (wgid % nig) / gsz; return true;
    }
    __device__ __forceinline__ void ptrs(const Unit& u, const char*& a, const char*& b0, const char*& b1) const {
        a = (const char*)A + (size_t)u.pm * BM * lda * 2; b0 = (const char*)Bt + (size_t)u.pn * BM * ldb * 2; b1 = b0 + (size_t)HALF * ldb * 2; }
};

__device__ __forceinline__ unsigned cvt_pk_bf16(float lo, float hi) { unsigned r; asm volatile("v_cvt_pk_bf16_f32 %0, %1, %2" : "=v"(r) : "v"(lo), "v"(hi)); return r; }

template <class Epi, class Sched, bool ALIGN_EPI>
__device__ __forceinline__ void gemm_phase(PG8_LAS unsigned char* lds, const Gemm g, const Sched& S, const Epi& E) {
    int tid_ = threadIdx.x; asm volatile("" : "+v"(tid_));
    const int tid = tid_, wid = __builtin_amdgcn_readfirstlane(tid >> 6), lane = tid & 63, wr = wid >> 2, wc = wid & 3, fr = lane & 15, fq = lane >> 4;
    int nt_ = g.K / BK; asm volatile("" : "+s"(nt_)); const int nt = nt_;
    unsigned voffA[2], voffB[2];
#pragma unroll
    for (int i = 0; i < 2; ++i) { int R, C; stage_rc(tid * 16 + i * 8192, R, C); const int Rb = Epi::PERM ? ((R & ~31) + perm32(R & 31)) : R;
        voffA[i] = (unsigned)(R * g.lda + C) * 2u; voffB[i] = (unsigned)(Rb * g.ldb + C) * 2u; }
    const size_t kstep = (size_t)(BK * 2);
    const size_t hstepA = (size_t)HALF * g.lda * 2;
    const unsigned ldsw = (unsigned)wid * 1024u;
    const int aoff = lds_byte(wr * 64 + fr, fq * 8), boff = lds_byte(wc * 32 + fr, fq * 8);
#define PG8_SA(b, h) (((b) * 2 + (h)) * HTB)
#define PG8_SB(b, h) ((4 + (b) * 2 + (h)) * HTB)
#define PG8_STAGE(bufoff, gbase, voff) do { _Pragma("unroll") for (int _i = 0; _i < 2; ++_i) \
        __builtin_amdgcn_global_load_lds((const unsigned*)((const char*)(gbase) + (voff)[_i]), (PG8_LAS unsigned*)(lds + (bufoff) + ldsw + _i * 8192), 16, 0, 0); } while (0)
#define PG8_LDA(dst, b, h) do { _Pragma("unroll") for (int m = 0; m < 4; ++m) _Pragma("unroll") for (int k = 0; k < 2; ++k) dst[m][k] = *(const PG8_LAS bf16x8*)(lds + PG8_SA(b, h) + aoff + m * 2048 + k * 1024); } while (0)
#define PG8_LDB(dst, b, h) do { _Pragma("unroll") for (int n = 0; n < 2; ++n) _Pragma("unroll") for (int k = 0; k < 2; ++k) dst[n][k] = *(const PG8_LAS bf16x8*)(lds + PG8_SB(b, h) + boff + n * 2048 + k * 1024); } while (0)
#define PG8_MMA(ai, bj, At, Bt) do { __builtin_amdgcn_s_setprio(1); _Pragma("unroll") for (int m = 0; m < 4; ++m) _Pragma("unroll") for (int n = 0; n < 2; ++n) _Pragma("unroll") for (int k = 0; k < 2; ++k) \
        acc[ai][bj][m][n] = __builtin_amdgcn_mfma_f32_16x16x32_bf16(Bt[n][k], At[m][k], acc[ai][bj][m][n], 0, 0, 0); __builtin_amdgcn_s_setprio(0); } while (0)
#define PG8_WAIT_V(n) asm volatile("s_waitcnt vmcnt(" #n ")" ::: "memory")
#define PG8_WAIT_L(n) asm volatile("s_waitcnt lgkmcnt(" #n ")" ::: "memory")
#define PG8_BAR __builtin_amdgcn_s_barrier()
#define PG8_SCHED __builtin_amdgcn_sched_barrier(0)
    Unit cur, nxt; int ui = 0;
    if (!S.next(0, cur)) return;
    f32x4 acc[2][2][4][2];
#pragma unroll
    for (int a = 0; a < 2; ++a)
#pragma unroll
        for (int b = 0; b < 2; ++b)
#pragma unroll
            for (int m = 0; m < 4; ++m)
#pragma unroll
                for (int n = 0; n < 2; ++n) acc[a][b][m][n] = (f32x4){0.f, 0.f, 0.f, 0.f};
    bf16x8 At[4][2], B0[2][2], B1[2][2];
    const char *cA, *cB0, *cB1; S.ptrs(cur, cA, cB0, cB1);
    PG8_STAGE(PG8_SB(0, 0), cB0, voffB); PG8_STAGE(PG8_SB(0, 1), cB1, voffB); PG8_STAGE(PG8_SA(0, 0), cA, voffA); PG8_STAGE(PG8_SA(0, 1), cA + hstepA, voffA);
    if (wr == 1) PG8_BAR;
    PG8_WAIT_V(2); PG8_BAR;
    PG8_STAGE(PG8_SB(1, 0), cB0 + kstep, voffB); PG8_STAGE(PG8_SA(1, 0), cA + kstep, voffA); PG8_STAGE(PG8_SB(1, 1), cB1 + kstep, voffB);
    PG8_WAIT_V(6); PG8_BAR;
    for (;;) {
        const bool has_next = S.next(ui + 1, nxt);
        const char *nA = cA, *nB0 = cB0, *nB1 = cB1; if (has_next) S.ptrs(nxt, nA, nB0, nB1);
#pragma unroll 1
        for (int t = 0; t < nt; t += 2) {
            const bool last = (t == nt - 2);
            if constexpr (Epi::HAS_MID) { if (t == E.mid_t) E.mid(acc, cur, wr, wc, fr, fq); }
            const char* a1 = cA + (size_t)(t + 1) * kstep;
            const char* a2 = last ? nA : cA + (size_t)(t + 2) * kstep; const char* b2 = last ? nB0 : cB0 + (size_t)(t + 2) * kstep; const char* b2h = last ? nB1 : cB1 + (size_t)(t + 2) * kstep;
            const char* a3 = a2 + kstep; const char* b3 = b2 + kstep; const char* b3h = b2h + kstep;
            PG8_LDB(B0, 0, 0); PG8_LDB(B1, 0, 1); PG8_SCHED; PG8_LDA(At, 0, 0); PG8_STAGE(PG8_SA(1, 1), a1 + hstepA, voffA);
            PG8_WAIT_V(8); PG8_WAIT_L(0); PG8_BAR; PG8_MMA(0, 0, At, B0); PG8_MMA(0, 1, At, B1); PG8_BAR; PG8_SCHED;
            PG8_LDA(At, 0, 1); PG8_STAGE(PG8_SB(0, 0), b2, voffB); PG8_STAGE(PG8_SB(0, 1), b2h, voffB); PG8_STAGE(PG8_SA(0, 0), a2, voffA);
            PG8_WAIT_V(8); PG8_WAIT_L(0); PG8_BAR; PG8_MMA(1, 0, At, B0); PG8_MMA(1, 1, At, B1); PG8_BAR; PG8_SCHED;
            PG8_LDB(B0, 1, 0); PG8_LDB(B1, 1, 1); PG8_SCHED; PG8_LDA(At, 1, 0); PG8_STAGE(PG8_SA(0, 1), a2 + hstepA, voffA);
            PG8_WAIT_V(8); PG8_WAIT_L(0); PG8_BAR; PG8_MMA(0, 0, At, B0); PG8_MMA(0, 1, At, B1); PG8_BAR; PG8_SCHED;
            PG8_LDA(At, 1, 1); PG8_STAGE(PG8_SB(1, 0), b3, voffB); PG8_STAGE(PG8_SB(1, 1), b3h, voffB); PG8_STAGE(PG8_SA(1, 0), a3, voffA);
            PG8_WAIT_V(8); PG8_WAIT_L(0); PG8_BAR; PG8_MMA(1, 0, At, B0); PG8_MMA(1, 1, At, B1); PG8_BAR; PG8_SCHED;
        }
        if constexpr (ALIGN_EPI) { if (wr == 0) PG8_BAR; }
        E(acc, cur, wr, wc, fr, fq);
        if (!has_next) break;
#pragma unroll
        for (int a = 0; a < 2; ++a)
#pragma unroll
            for (int b = 0; b < 2; ++b)
#pragma unroll
                for (int m = 0; m < 4; ++m)
#pragma unroll
                    for (int n = 0; n < 2; ++n) acc[a][b][m][n] = (f32x4){0.f, 0.f, 0.f, 0.f};
        cur = nxt; cA = nA; cB0 = nB0; cB1 = nB1; ++ui;
        if constexpr (ALIGN_EPI) { if (wr == 1) PG8_BAR; }
    }
    PG8_WAIT_V(0);
    if constexpr (!ALIGN_EPI) { if (wr == 0) PG8_BAR; }
    PG8_BAR;
#undef PG8_SA
#undef PG8_SB
#undef PG8_STAGE
#undef PG8_LDA
#undef PG8_LDB
#undef PG8_MMA
#undef PG8_WAIT_V
#undef PG8_WAIT_L
#undef PG8_BAR
#undef PG8_SCHED
}

__device__ __forceinline__ float rstd16(const float* p) { const f32x4 a = ((const f32x4*)p)[0], b = ((const f32x4*)p)[1], c = ((const f32x4*)p)[2], d = ((const f32x4*)p)[3];
    const float s = ((a.x + a.y) + (a.z + a.w)) + ((b.x + b.y) + (b.z + b.w)) + ((c.x + c.y) + (c.z + c.w)) + ((d.x + d.y) + (d.z + d.w)); return 1.0f / sqrtf(s * (1.f / D) + EPS); }
__device__ __forceinline__ u32x4 pack8(const f32x4 v0, const f32x4 v1) { u32x4 w; w.x = cvt_pk_bf16(v0[0], v0[1]); w.y = cvt_pk_bf16(v0[2], v0[3]); w.z = cvt_pk_bf16(v1[0], v1[1]); w.w = cvt_pk_bf16(v1[2], v1[3]); return w; }
__device__ __forceinline__ float sq8(const f32x4 a, const f32x4 b) { return ((a[0] * a[0] + a[1] * a[1]) + (a[2] * a[2] + a[3] * a[3])) + ((b[0] * b[0] + b[1] * b[1]) + (b[2] * b[2] + b[3] * b[3])); }

struct EpiInProjF {
    static constexpr bool PERM = true, HAS_MID = false; int mid_t;
    const float* rstd0; bf16_t *XR, *GG, *Qs, *Ks, *Vs; unsigned* kmax;
    __device__ __forceinline__ void mid(f32x4 (&)[2][2][4][2], const Unit&, int, int, int, int) const {}
    __device__ __forceinline__ void operator()(const f32x4 (&acc)[2][2][4][2], const Unit& u, int wr, int wc, int fr, int fq) const {
        const int row0 = u.pm * BM + wr * 64 + fr, t = u.pn >> 1, colt = (u.pn & 1) * 256 + wc * 32 + 8 * fq;
        bf16_t* base = (t == 0) ? XR : (t == 1) ? GG : (t == 2) ? Qs : (t == 3) ? Ks : Vs;
        float km0 = 0.f, km1 = 0.f;
#pragma unroll
        for (int ai = 0; ai < 2; ++ai)
#pragma unroll
            for (int m = 0; m < 4; ++m) { const int r = row0 + ai * HALF + m * 16; const float rs = rstd0[r]; bf16_t* rowp = base + (size_t)r * 512 + colt;
#pragma unroll
                for (int bj = 0; bj < 2; ++bj) { f32x4 v0 = acc[ai][bj][m][0] * rs, v1 = acc[ai][bj][m][1] * rs;
                    if (t == 1) {
#pragma unroll
                        for (int e = 0; e < 4; ++e) { v0[e] = gelu_tanh(v0[e]); v1[e] = gelu_tanh(v1[e]); } }
                    else if (t == 2) { v0 = v0 * (0.125f * LOG2E); v1 = v1 * (0.125f * LOG2E); }
                    else if (t == 3) { float mx = 0.f;
#pragma unroll
                        for (int e = 0; e < 4; ++e) mx = fmaxf(mx, fmaxf(fabsf(v0[e]), fabsf(v1[e])));
                        if (bj == 0) km0 = fmaxf(km0, mx); else km1 = fmaxf(km1, mx); }
                    *(u32x4*)(rowp + bj * HALF) = pack8(v0, v1); } }
        if (t == 3) {
#pragma unroll
            for (int o = 1; o < 64; o <<= 1) { km0 = fmaxf(km0, __shfl_xor(km0, o)); km1 = fmaxf(km1, __shfl_xor(km1, o)); }
            if ((fr | fq) == 0) { const int b = (u.pm * BM) / SEQ, hd = (u.pn & 1) * 4 + (wc >> 1);
                atomicMax(kmax + b * 8 + hd, __float_as_uint(km0)); atomicMax(kmax + b * 8 + hd + 2, __float_as_uint(km1)); }
        }
    }
};
struct EpiBf16F {
    static constexpr bool PERM = true, HAS_MID = false; int mid_t;
    bf16_t* O; const float* ssq16; int ldo; float scale; size_t tstride;
    __device__ __forceinline__ void mid(f32x4 (&)[2][2][4][2], const Unit&, int, int, int, int) const {}
    __device__ __forceinline__ void operator()(const f32x4 (&acc)[2][2][4][2], const Unit& u, int wr, int wc, int fr, int fq) const {
        const int row0 = u.pm * BM + wr * 64 + fr, col0 = (tstride ? 0 : u.pn * BM) + wc * 32 + 8 * fq; bf16_t* base = O + (size_t)u.pn * tstride;
#pragma unroll
        for (int ai = 0; ai < 2; ++ai)
#pragma unroll
            for (int m = 0; m < 4; ++m) { const int r = row0 + ai * HALF + m * 16; const float rs = (ssq16 ? rstd16(ssq16 + (size_t)r * 16) : 1.f) * scale; bf16_t* rowp = base + (size_t)r * ldo + col0;
#pragma unroll
                for (int bj = 0; bj < 2; ++bj) *(u32x4*)(rowp + bj * HALF) = pack8(acc[ai][bj][m][0] * rs, acc[ai][bj][m][1] * rs); }
    }
};
struct EpiX1F {
    static constexpr bool PERM = true, HAS_MID = true; int mid_t;
    const bf16_t* xb; const float* fmid; const float* fend; bf16_t* X1b; float* ssq1;
    __device__ __forceinline__ void mid(f32x4 (&acc)[2][2][4][2], const Unit& u, int wr, int wc, int fr, int fq) const {
        const int row0 = u.pm * BM + wr * 64 + fr;
#pragma unroll
        for (int ai = 0; ai < 2; ++ai)
#pragma unroll
            for (int m = 0; m < 4; ++m) { const float f = fmid[row0 + ai * HALF + m * 16];
#pragma unroll
                for (int bj = 0; bj < 2; ++bj) { acc[ai][bj][m][0] = acc[ai][bj][m][0] * f; acc[ai][bj][m][1] = acc[ai][bj][m][1] * f; } }
    }
    __device__ __forceinline__ void operator()(const f32x4 (&acc)[2][2][4][2], const Unit& u, int wr, int wc, int fr, int fq) const {
        const int row0 = u.pm * BM + wr * 64 + fr, col0 = u.pn * BM + wc * 32 + 8 * fq;
#pragma unroll
        for (int ai = 0; ai < 2; ++ai)
#pragma unroll
            for (int m = 0; m < 4; ++m) { const int r = row0 + ai * HALF + m * 16; const float fe = fend[r]; float ss = 0.f;
#pragma unroll
                for (int bj = 0; bj < 2; ++bj) { const u32x4 xi = *(const u32x4*)(xb + (size_t)r * D + col0 + bj * HALF);
                    f32x4 v0, v1; v0[0] = __uint_as_float(xi.x << 16); v0[1] = __uint_as_float(xi.x & 0xffff0000u); v0[2] = __uint_as_float(xi.y << 16); v0[3] = __uint_as_float(xi.y & 0xffff0000u);
                    v1[0] = __uint_as_float(xi.z << 16); v1[1] = __uint_as_float(xi.z & 0xffff0000u); v1[2] = __uint_as_float(xi.w << 16); v1[3] = __uint_as_float(xi.w & 0xffff0000u);
                    v0 = v0 + acc[ai][bj][m][0] * fe; v1 = v1 + acc[ai][bj][m][1] * fe;
                    ss += sq8(v0, v1); *(u32x4*)(X1b + (size_t)r * D + col0 + bj * HALF) = pack8(v0, v1); }
                ss += __shfl_xor(ss, 16); ss += __shfl_xor(ss, 32);
                if (fq == 0) ssq1[(size_t)r * 16 + u.pn * 4 + wc] = ss; }
    }
};
struct EpiResF {
    static constexpr bool PERM = true, HAS_MID = false; int mid_t;
    const bf16_t* Xi; bf16_t* Xo; float* ssq;
    __device__ __forceinline__ void mid(f32x4 (&)[2][2][4][2], const Unit&, int, int, int, int) const {}
    __device__ __forceinline__ void operator()(const f32x4 (&acc)[2][2][4][2], const Unit& u, int wr, int wc, int fr, int fq) const {
        const int row0 = u.pm * BM + wr * 64 + fr, col0 = u.pn * BM + wc * 32 + 8 * fq;
#pragma unroll
        for (int ai = 0; ai < 2; ++ai)
#pragma unroll
            for (int m = 0; m < 4; ++m) { const int r = row0 + ai * HALF + m * 16; float ss = 0.f;
#pragma unroll
                for (int bj = 0; bj < 2; ++bj) { const u32x4 xi = *(const u32x4*)(Xi + (size_t)r * D + col0 + bj * HALF);
                    f32x4 v0, v1; v0[0] = __uint_as_float(xi.x << 16); v0[1] = __uint_as_float(xi.x & 0xffff0000u); v0[2] = __uint_as_float(xi.y << 16); v0[3] = __uint_as_float(xi.y & 0xffff0000u);
                    v1[0] = __uint_as_float(xi.z << 16); v1[1] = __uint_as_float(xi.z & 0xffff0000u); v1[2] = __uint_as_float(xi.w << 16); v1[3] = __uint_as_float(xi.w & 0xffff0000u);
                    v0 = v0 + acc[ai][bj][m][0]; v1 = v1 + acc[ai][bj][m][1];
                    ss += sq8(v0, v1); *(u32x4*)(Xo + (size_t)r * D + col0 + bj * HALF) = pack8(v0, v1); }
                ss += __shfl_xor(ss, 16); ss += __shfl_xor(ss, 32);
                if (fq == 0) ssq[(size_t)r * 16 + u.pn * 4 + wc] = ss; }
    }
};

__device__ __forceinline__ void pair_ab(int p, int& a, int& b) { a = (p < 3) ? 0 : (p < 5) ? 1 : 2; b = (p < 3) ? p + 1 : (p < 5) ? p - 1 : 3; }
__device__ __forceinline__ int moe_class_of_tile(const PG8_LAS int* meta, int T) { int c = 0;
#pragma unroll
    for (int k = 1; k < 24; ++k) c += (T >= __builtin_amdgcn_readfirstlane(meta[64 + k])) ? 1 : 0;
    return c; }
struct MoeOrder1 {
    const bf16_t* XG; const bf16_t* Wg; const bf16_t* Wu; const PG8_LAS int* meta; int G, c;
    __device__ bool next(int i, Unit& u) const { const int L = i * G + c, nt = __builtin_amdgcn_readfirstlane(meta[64 + 24]); if (L >= nt * 4) return false;
        u.pm = L >> 2; u.pn = moe_class_of_tile(meta, L >> 2) * 4 + (L & 3); return true; }
    __device__ __forceinline__ void ptrs(const Unit& u, const char*& a, const char*& b0, const char*& b1) const {
        const int cls = u.pn >> 2, j = (u.pn >> 1) & 1, half = u.pn & 1; int ea, eb; pair_ab(cls % 6, ea, eb); const int e = (cls / 6) * 4 + (j ? eb : ea);
        a = (const char*)XG + (size_t)u.pm * BM * D * 2; const size_t bo = ((size_t)e * DE + half * HALF) * D * 2; b0 = (const char*)Wg + bo; b1 = (const char*)Wu + bo; }
};
struct MoeOrder2 {
    const bf16_t* HID; const bf16_t* Wd2; const PG8_LAS int* meta; int G, c;
    __device__ bool next(int i, Unit& u) const { const int L = i * G + c, nt = __builtin_amdgcn_readfirstlane(meta[64 + 24]); if (L >= nt * 4) return false;
        u.pm = L >> 2; u.pn = moe_class_of_tile(meta, L >> 2) * 4 + (L & 3); return true; }
    __device__ __forceinline__ void ptrs(const Unit& u, const char*& a, const char*& b0, const char*& b1) const {
        a = (const char*)HID + (size_t)u.pm * BM * 512 * 2; b0 = (const char*)Wd2 + ((size_t)(u.pn >> 2) * D + (u.pn & 3) * BM) * 512 * 2; b1 = b0 + (size_t)HALF * 512 * 2; }
};
struct EpiMoeUp {
    static constexpr bool PERM = true, HAS_MID = false; int mid_t;
    const float* rsg; const float* wAg; const float* wBg; bf16_t* HID;
    __device__ __forceinline__ void mid(f32x4 (&)[2][2][4][2], const Unit&, int, int, int, int) const {}
    __device__ __forceinline__ void operator()(const f32x4 (&acc)[2][2][4][2], const Unit& u, int wr, int wc, int fr, int fq) const {
        const int row0 = u.pm * BM + wr * 64 + fr, j = (u.pn >> 1) & 1, col0 = j * 256 + (u.pn & 1) * HALF + wc * 32 + 8 * fq; const float* wg = j ? wBg : wAg;
#pragma unroll
        for (int ai = 0; ai < 2; ++ai)
#pragma unroll
            for (int m = 0; m < 4; ++m) { const int r = row0 + ai * HALF + m * 16; const float rs = rsg[r], w = wg[r]; f32x4 h0, h1;
#pragma unroll
                for (int e = 0; e < 4; ++e) { const float g0 = acc[ai][0][m][0][e] * rs, g1 = acc[ai][0][m][1][e] * rs;
                    h0[e] = g0 / (1.f + __expf(-g0)) * (acc[ai][1][m][0][e] * rs) * w; h1[e] = g1 / (1.f + __expf(-g1)) * (acc[ai][1][m][1][e] * rs) * w; }
                *(u32x4*)(HID + (size_t)r * 512 + col0) = pack8(h0, h1); }
    }
};
struct EpiMoeDown {
    static constexpr bool PERM = true, HAS_MID = false; int mid_t;
    const int* tokg; const bf16_t* Xi; bf16_t* Xo; float* ssq;
    __device__ __forceinline__ void mid(f32x4 (&)[2][2][4][2], const Unit&, int, int, int, int) const {}
    __device__ __forceinline__ void operator()(const f32x4 (&acc)[2][2][4][2], const Unit& u, int wr, int wc, int fr, int fq) const {
        const int row0 = u.pm * BM + wr * 64 + fr, ct = u.pn & 3, col0 = ct * BM + wc * 32 + 8 * fq;
#pragma unroll
        for (int ai = 0; ai < 2; ++ai)
#pragma unroll
            for (int m = 0; m < 4; ++m) { const int tok = tokg[row0 + ai * HALF + m * 16];
                if (tok >= 0) { float ss = 0.f;
#pragma unroll
                    for (int bj = 0; bj < 2; ++bj) { const u32x4 xi = *(const u32x4*)(Xi + (size_t)tok * D + col0 + bj * HALF);
                        f32x4 v0, v1; v0[0] = __uint_as_float(xi.x << 16); v0[1] = __uint_as_float(xi.x & 0xffff0000u); v0[2] = __uint_as_float(xi.y << 16); v0[3] = __uint_as_float(xi.y & 0xffff0000u);
                        v1[0] = __uint_as_float(xi.z << 16); v1[1] = __uint_as_float(xi.z & 0xffff0000u); v1[2] = __uint_as_float(xi.w << 16); v1[3] = __uint_as_float(xi.w & 0xffff0000u);
                        v0 = v0 + acc[ai][bj][m][0]; v1 = v1 + acc[ai][bj][m][1];
                        ss += sq8(v0, v1); *(u32x4*)(Xo + (size_t)tok * D + col0 + bj * HALF) = pack8(v0, v1); }
                    ss += __shfl_xor(ss, 16); ss += __shfl_xor(ss, 32);
                    if (fq == 0) ssq[(size_t)tok * 16 + ct * 4 + wc] = ss; } }
    }
};

struct XaSOrder {
    const bf16_t* QX; const bf16_t* KM; int G, c;
    __device__ bool next(int i, Unit& u) const { const int L = i * G + c; if (L >= (NTOK / BM) * XH) return false; u.pm = L >> 2; u.pn = L & 3; return true; }
    __device__ __forceinline__ void ptrs(const Unit& u, const char*& a, const char*& b0, const char*& b1) const {
        a = (const char*)QX + ((size_t)u.pm * BM * D + u.pn * XD) * 2; const int b = u.pm / (SEQ / BM);
        b0 = (const char*)KM + ((size_t)b * MEM * D + u.pn * XD) * 2; b1 = b0 + (size_t)HALF * D * 2; }
};
struct XaOOrder {
    const bf16_t* P; const bf16_t* VT; int G, c;
    __device__ bool next(int i, Unit& u) const { const int L = i * G + c; if (L >= (NTOK / BM) * XH) return false; u.pm = L >> 2; u.pn = L & 3; return true; }
    __device__ __forceinline__ void ptrs(const Unit& u, const char*& a, const char*& b0, const char*& b1) const {
        a = (const char*)P + ((size_t)u.pm * BM * D + u.pn * XD) * 2; const int b = u.pm / (SEQ / BM);
        b0 = (const char*)VT + ((size_t)b * D + u.pn * XD) * MEM * 2; b1 = b0 + (size_t)HALF * MEM * 2; }
};
struct EpiSoftmax {
    static constexpr bool PERM = true, HAS_MID = false; int mid_t;
    bf16_t* P; PG8_LAS float* xch;
    __device__ __forceinline__ void mid(f32x4 (&)[2][2][4][2], const Unit&, int, int, int, int) const {}
    __device__ __forceinline__ void operator()(f32x4 (&acc)[2][2][4][2], const Unit& u, int wr, int wc, int fr, int fq) const {
        PG8_LAS float* xm = xch; PG8_LAS float* xs = xch + 1024;
#pragma unroll
        for (int ai = 0; ai < 2; ++ai)
#pragma unroll
            for (int m = 0; m < 4; ++m) { float mx = -INFINITY;
#pragma unroll
                for (int bj = 0; bj < 2; ++bj)
#pragma unroll
                    for (int n = 0; n < 2; ++n) { const f32x4 v = acc[ai][bj][m][n]; mx = fmaxf(mx, fmaxf(fmaxf(v[0], v[1]), fmaxf(v[2], v[3]))); }
                mx = fmaxf(mx, __shfl_xor(mx, 16)); mx = fmaxf(mx, __shfl_xor(mx, 32));
                if (fq == 0) xm[(ai * HALF + wr * 64 + m * 16 + fr) * 4 + wc] = mx; asm volatile("" ::: "memory"); }
        asm volatile("s_waitcnt lgkmcnt(0)" ::: "memory"); __builtin_amdgcn_s_barrier(); asm volatile("" ::: "memory");
#pragma unroll
        for (int ai = 0; ai < 2; ++ai)
#pragma unroll
            for (int m = 0; m < 4; ++m) { const int rl = ai * HALF + wr * 64 + m * 16 + fr; const f32x4 q = *(const PG8_LAS f32x4*)(xm + rl * 4);
                const float mx = fmaxf(fmaxf(q[0], q[1]), fmaxf(q[2], q[3])); float ss = 0.f;
#pragma unroll
                for (int bj = 0; bj < 2; ++bj)
#pragma unroll
                    for (int n = 0; n < 2; ++n) { f32x4 v = acc[ai][bj][m][n];
#pragma unroll
                        for (int e = 0; e < 4; ++e) { v[e] = __builtin_amdgcn_exp2f(v[e] - mx); ss += v[e]; }
                        acc[ai][bj][m][n] = v; }
                ss += __shfl_xor(ss, 16); ss += __shfl_xor(ss, 32);
                if (fq == 0) xs[rl * 4 + wc] = ss; asm volatile("" ::: "memory"); }
        asm volatile("s_waitcnt lgkmcnt(0)" ::: "memory"); __builtin_amdgcn_s_barrier(); asm volatile("" ::: "memory");
        const int row0 = u.pm * BM + wr * 64 + fr, col0 = u.pn * XD + wc * 32 + 8 * fq;
#pragma unroll
        for (int ai = 0; ai < 2; ++ai)
#pragma unroll
            for (int m = 0; m < 4; ++m) { const int rl = ai * HALF + wr * 64 + m * 16 + fr; const f32x4 q = *(const PG8_LAS f32x4*)(xs + rl * 4);
                const float inv = 1.0f / ((q[0] + q[1]) + (q[2] + q[3])); bf16_t* rowp = P + (size_t)(row0 + ai * HALF + m * 16) * D + col0;
#pragma unroll
                for (int bj = 0; bj < 2; ++bj) *(u32x4*)(rowp + bj * HALF) = pack8(acc[ai][bj][m][0] * inv, acc[ai][bj][m][1] * inv); asm volatile("" ::: "memory"); }
    }
};
}
namespace sba {
typedef float f32x16 __attribute__((ext_vector_type(16)));
typedef short s16x4 __attribute__((ext_vector_type(4)));
typedef short v4i16_t __attribute__((ext_vector_type(4)));
typedef __attribute__((address_space(3))) const char* lds_cptr;
constexpr int SLOTB = 8192, L_K = 0, L_V = 2 * SLOTB, L_FLAG = 4 * SLOTB, L_OST = L_FLAG + 256, L_BYTES = L_OST + 8 * 4096;
__device__ __forceinline__ int crow(int r, int hi) { return (r & 3) + 8 * (r >> 2) + 4 * hi; }
__device__ __forceinline__ void glds16(const void* gsrc, unsigned lds_dst) { unsigned keep;
    asm volatile("s_mov_b32 %0, m0\n\ts_mov_b32 m0, %2\n\ts_nop 0\n\tglobal_load_lds_dwordx4 %1, off\n\ts_mov_b32 m0, %0" : "=&s"(keep) : "v"(gsrc), "s"(lds_dst) : "memory"); }
typedef float f32x2_t __attribute__((ext_vector_type(2))); typedef __bf16 bf16x2_t __attribute__((ext_vector_type(2)));
__device__ __forceinline__ unsigned cvtpk(float lo, float hi) { f32x2_t v = {lo, hi}; bf16x2_t b = __builtin_convertvector(v, bf16x2_t); return __builtin_bit_cast(unsigned, b); }
__device__ __forceinline__ s16x4 vtr(lds_cptr p) { return __builtin_bit_cast(s16x4, __builtin_amdgcn_ds_read_tr16_b64_v4i16((__attribute__((address_space(3))) v4i16_t*)p)); }

#define SBA_GROUP(Z, SP, g) do { \
        const float off_ = acc_ + (hi ? 0.f : gp_##SP[g]); acc_ += gs_##SP[g] + gp_##SP[g]; \
        const float c3_ = off_ + SP[4 * (g) + 3], c2_ = c3_ + SP[4 * (g) + 2], c1_ = c2_ + SP[4 * (g) + 1], c0_ = c1_ + SP[4 * (g)]; \
        Z[4 * (g) + 3] = __builtin_amdgcn_exp2f(Z[4 * (g) + 3] - c3_); Z[4 * (g) + 2] = __builtin_amdgcn_exp2f(Z[4 * (g) + 2] - c2_); \
        Z[4 * (g) + 1] = __builtin_amdgcn_exp2f(Z[4 * (g) + 1] - c1_); Z[4 * (g)] = __builtin_amdgcn_exp2f(Z[4 * (g)] - c0_); } while (0)

__device__ __forceinline__ void sb_unit(int b, int h, int qb, const bf16_t* Qs, const bf16_t* Ks, const bf16_t* Vs, bf16_t* YY, float* ssq_s8, const unsigned* kmax, char* shm) {
    int tid_ = threadIdx.x; asm volatile("" : "+v"(tid_));
    const int tid = tid_, lane = tid & 63, r32 = lane & 31, hi = lane >> 5; const int wid = __builtin_amdgcn_readfirstlane(tid >> 6);
    const size_t rowbase = (size_t)b * SEQ; const int q0 = qb * 256;
    const bf16_t* Kh = Ks + rowbase * SBW + h * HD; const bf16_t* Vh = Vs + rowbase * SBW + h * HD;
    const unsigned lds0 = (unsigned)(uintptr_t)shm;
    const lds_cptr shm3 = (lds_cptr)shm;
    const bf16_t* ksrc = Kh + (size_t)lane * SBW + wid * 8;
    const bf16_t* vsrc = Vh + (size_t)(16 * (wid & 3) + (lane >> 2)) * SBW + (wid >> 2) * 32 + (lane & 3) * 8;
    const unsigned kdst = lds0 + L_K + wid * 1024, vdst = lds0 + L_V + wid * 1024;
#define DMA_KV(t, slot) do { glds16(ksrc + (size_t)(t) * 64 * SBW, (unsigned)__builtin_amdgcn_readfirstlane(kdst + (slot))); glds16(vsrc + (size_t)(t) * 64 * SBW, (unsigned)__builtin_amdgcn_readfirstlane(vdst + (slot))); } while (0)
    const lds_cptr kp0 = shm3 + L_K + hi * 1024 + r32 * 16;
    const lds_cptr vp0 = shm3 + L_V + ((lane >> 4) & 1) * 32 + (lane & 3) * 8 + (4 * hi + ((lane & 15) >> 2)) * 64;
    volatile __attribute__((address_space(3))) unsigned* flags = (volatile __attribute__((address_space(3))) unsigned*)(shm3 + L_FLAG);
    int tile = 4 * qb + 3, slot = 0, it = 0;
    DMA_KV(tile, 0);
    const bf16_t* Qw = Qs + (rowbase + q0 + wid * 32 + r32) * SBW + h * HD;
    bf16x8 qr[4];
#pragma unroll
    for (int d0 = 0; d0 < 4; ++d0) qr[d0] = *(const bf16x8*)(Qw + d0 * 16 + hi * 8);
    float qn = 0.f;
#pragma unroll
    for (int d0 = 0; d0 < 4; ++d0)
#pragma unroll
        for (int e = 0; e < 8; ++e) qn += fabsf(bf2f((unsigned short)qr[d0][e]));
    qn += __shfl_xor(qn, 32);
    const float zmax = qn * __uint_as_float(kmax[b * 8 + h]) * 1.01f;
    const int tq = q0 + wid * 32 + r32;
    const int tq_min = q0 + wid * 32, tq_max = tq_min + 31;
    float R = 0.f;
    f32x16 o0 = {}, o1 = {};
    for (;;) {
        const bool has_next = tile > 0;
        if (has_next) { DMA_KV(tile - 1, slot ^ SLOTB); asm volatile("s_waitcnt vmcnt(2)" ::: "memory"); }
        else asm volatile("s_waitcnt vmcnt(0)" ::: "memory");
        __builtin_amdgcn_s_barrier(); asm volatile("" ::: "memory");
        const int kmin = tile * 64;
        if (kmin < tq_max) {
            f32x16 z0, z1;
            {
                const lds_cptr kb = kp0 + slot;
#pragma unroll
                for (int d0 = 0; d0 < 4; ++d0) {
                    const bf16x8 b0 = *(const __attribute__((address_space(3))) bf16x8*)(kb + d0 * 2048);
                    const bf16x8 b1 = *(const __attribute__((address_space(3))) bf16x8*)(kb + d0 * 2048 + 512);
                    if (d0 == 0) { z0 = __builtin_amdgcn_mfma_f32_32x32x16_bf16(b0, qr[0], (f32x16){}, 0, 0, 0); z1 = __builtin_amdgcn_mfma_f32_32x32x16_bf16(b1, qr[0], (f32x16){}, 0, 0, 0); }
                    else { z0 = __builtin_amdgcn_mfma_f32_32x32x16_bf16(b0, qr[d0], z0, 0, 0, 0); z1 = __builtin_amdgcn_mfma_f32_32x32x16_bf16(b1, qr[d0], z1, 0, 0, 0); }
                }
            }
            if (kmin + 63 >= tq_min) {
#pragma unroll
                for (int r = 0; r < 16; ++r) { const int kv = kmin + crow(r, hi); if (kv >= tq) z0[r] = -INFINITY; if (kv + 32 >= tq) z1[r] = -INFINITY; }
            }
            f32x16 s0, s1;
#pragma unroll
            for (int r = 0; r < 16; ++r) { z0[r] = fminf(z0[r], 120.f); z1[r] = fminf(z1[r], 120.f);
                s0[r] = __builtin_amdgcn_logf(1.f + __builtin_amdgcn_exp2f(z0[r])); s1[r] = __builtin_amdgcn_logf(1.f + __builtin_amdgcn_exp2f(z1[r])); }
            float gs_s0[4], gs_s1[4], gp_s0[4], gp_s1[4];
#pragma unroll
            for (int g = 0; g < 4; ++g) { gs_s0[g] = (s0[4 * g] + s0[4 * g + 1]) + (s0[4 * g + 2] + s0[4 * g + 3]); gs_s1[g] = (s1[4 * g] + s1[4 * g + 1]) + (s1[4 * g + 2] + s1[4 * g + 3]); }
#pragma unroll
            for (int g = 0; g < 4; ++g) { gp_s0[g] = __shfl_xor(gs_s0[g], 32); gp_s1[g] = __shfl_xor(gs_s1[g], 32); }
            float acc_ = R;
            SBA_GROUP(z1, s1, 3); SBA_GROUP(z1, s1, 2); SBA_GROUP(z1, s1, 1); SBA_GROUP(z1, s1, 0);
            SBA_GROUP(z0, s0, 3); SBA_GROUP(z0, s0, 2); SBA_GROUP(z0, s0, 1); SBA_GROUP(z0, s0, 0);
            R = acc_;
            u32x4 pw0, pw1, pw2, pw3;
            pw0 = (u32x4){cvtpk(z0[0], z0[1]), cvtpk(z0[2], z0[3]), cvtpk(z0[4], z0[5]), cvtpk(z0[6], z0[7])};
            pw1 = (u32x4){cvtpk(z0[8], z0[9]), cvtpk(z0[10], z0[11]), cvtpk(z0[12], z0[13]), cvtpk(z0[14], z0[15])};
            pw2 = (u32x4){cvtpk(z1[0], z1[1]), cvtpk(z1[2], z1[3]), cvtpk(z1[4], z1[5]), cvtpk(z1[6], z1[7])};
            pw3 = (u32x4){cvtpk(z1[8], z1[9]), cvtpk(z1[10], z1[11]), cvtpk(z1[12], z1[13]), cvtpk(z1[14], z1[15])};
            const lds_cptr vp = vp0 + slot;
#define SBA_PV(O, d0, ks, PW) do { const s16x4 lo_ = vtr(vp + (d0) * 4096 + (ks) * 1024), hi_ = vtr(vp + (d0) * 4096 + (ks) * 1024 + 512); \
                const bf16x8 vf_ = (bf16x8){lo_[0], lo_[1], lo_[2], lo_[3], hi_[0], hi_[1], hi_[2], hi_[3]}; \
                O = __builtin_amdgcn_mfma_f32_32x32x16_bf16(__builtin_bit_cast(bf16x8, PW), vf_, O, 0, 0, 0); } while (0)
            SBA_PV(o0, 0, 0, pw0); SBA_PV(o1, 1, 0, pw0); SBA_PV(o0, 0, 1, pw1); SBA_PV(o1, 1, 1, pw1);
            SBA_PV(o0, 0, 2, pw2); SBA_PV(o1, 1, 2, pw2); SBA_PV(o0, 0, 3, pw3); SBA_PV(o1, 1, 3, pw3);
#undef SBA_PV
        }
        const bool done = __all((zmax - R) < -150.f);
        if (lane == 0) flags[(it & 1) * 8 + wid] = done ? 1u : 0u;
        asm volatile("s_waitcnt lgkmcnt(0)" ::: "memory"); __builtin_amdgcn_s_barrier(); asm volatile("" ::: "memory");
        unsigned alld = 1u;
#pragma unroll
        for (int w = 0; w < 8; ++w) alld &= flags[(it & 1) * 8 + w];
        alld = __builtin_amdgcn_readfirstlane(alld);
        if (!has_next || alld) break;
        --tile; slot ^= SLOTB; ++it;
    }
    asm volatile("s_waitcnt vmcnt(0)" ::: "memory");
    {
        bf16_t* Ow = YY + (rowbase + q0 + wid * 32) * D + RW + h * HD;
        bf16_t* stg = (bf16_t*)(shm + L_OST) + wid * 2048;
#pragma unroll
        for (int r = 0; r < 16; ++r) { const int orow = crow(r, hi); stg[orow * 64 + r32] = (bf16_t)f2bf(o0[r]); stg[orow * 64 + 32 + r32] = (bf16_t)f2bf(o1[r]); }
        asm volatile("s_waitcnt lgkmcnt(0)" ::: "memory");
#pragma unroll
        for (int i = 0; i < 4; ++i) { const int row = i * 8 + (lane >> 3), ch = lane & 7; const u32x4 v = *(const u32x4*)(stg + row * 64 + ch * 8);
            *(u32x4*)(Ow + (size_t)row * D + ch * 8) = v;
            float ss = 0.f;
#pragma unroll
            for (int e = 0; e < 4; ++e) { const float lo = __uint_as_float(v[e] << 16), hh = __uint_as_float(v[e] & 0xffff0000u); ss += lo * lo + hh * hh; }
            ss += __shfl_xor(ss, 1); ss += __shfl_xor(ss, 2); ss += __shfl_xor(ss, 4);
            if (ch == 0) ssq_s8[(rowbase + q0 + wid * 32 + row) * 8 + h] = ss; }
    }
    asm volatile("s_waitcnt lgkmcnt(0)" ::: "memory"); __builtin_amdgcn_s_barrier(); asm volatile("" ::: "memory");
#undef DMA_KV
}
#undef SBA_GROUP
}
namespace lru {
typedef float f32x16 __attribute__((ext_vector_type(16)));
constexpr int XS_ROWS = 67, XS_BYTES = XS_ROWS * 1024  , XC_PITCH = 1040  , XC_OFF = 68608, HC_OFF = XC_OFF + 64 * XC_PITCH  , L_BYTES = HC_OFF + 2048;
__device__ __forceinline__ int crow(int r, int hi) { return (r & 3) + 8 * (r >> 2) + 4 * hi; }

struct Weights { bf16x8 wa[2][4], wx[2][4]; float ba[2], bx[2], spl[2]; };
__device__ __forceinline__ void load_weights(Weights& W, int h, int r32, int hi, const float* w_a, const float* b_a, const float* w_x, const float* b_x, const float* lam) {
#pragma unroll
    for (int nt = 0; nt < 2; ++nt) {
#pragma unroll
        for (int s = 0; s < 4; ++s) {
#pragma unroll
            for (int e = 0; e < 8; ++e) { const size_t idx = ((size_t)(h * 64 + 16 * s + 8 * hi + e)) * 64 + 32 * nt + r32;
                W.wa[nt][s][e] = (short)f2bf(w_a[idx]); W.wx[nt][s][e] = (short)f2bf(w_x[idx]); }
        }
        const int c = h * 64 + 32 * nt + r32; W.ba[nt] = b_a[c]; W.bx[nt] = b_x[c];
        const float l = lam[c]; W.spl[nt] = (l > 15.f) ? __expf(-l) : log1pf(__expf(-l));
    }
}

template <bool PASSB>
__device__ __forceinline__ void unit(int b, int chunk, const Weights& W, const bf16_t* XR, const bf16_t* GG, const float* conv_w, const float* conv_b,
                                     float* aggP, float* aggH, const float* ssq_s8, bf16_t* YY, float* fmid, float* fend, unsigned char* shm) {
    int tid_ = threadIdx.x; asm volatile("" : "+v"(tid_));
    const int tid = tid_, lane = tid & 63, r32 = lane & 31, hi = lane >> 5, wid = __builtin_amdgcn_readfirstlane(tid >> 6);
    LAS unsigned char* L = (LAS unsigned char*)shm;
    const int t0 = chunk * 64; const size_t rowbase = (size_t)b * SEQ;
    for (int p = tid; p < XS_ROWS * 64; p += NTHREADS) { const int rr = p >> 6, pc = p & 63, t = t0 - 3 + rr;
        u32x4 v = (u32x4){0u, 0u, 0u, 0u}; if (t >= 0) v = *(const u32x4*)(XR + (rowbase + t) * RW + pc * 8);
        *(LAS u32x4*)(L + rr * 1024 + pc * 16) = v; }
    if (PASSB) {
        const f32x4* pP = (const f32x4*)(aggP + ((size_t)b * RW + tid) * 64); const f32x4* pH = (const f32x4*)(aggH + ((size_t)b * RW + tid) * 64); float hc = 0.f;
#pragma unroll
        for (int half = 0; half < 2; ++half) { if (half * 32 < chunk) { f32x4 p[8], q[8];
#pragma unroll
                for (int i = 0; i < 8; ++i) { p[i] = pP[half * 8 + i]; q[i] = pH[half * 8 + i]; }
#pragma unroll
                for (int i = 0; i < 8; ++i)
#pragma unroll
                    for (int e = 0; e < 4; ++e) { if (half * 32 + i * 4 + e < chunk) hc = p[i][e] * hc + q[i][e]; } } }
        *(LAS float*)(L + HC_OFF + tid * 4) = hc;
    }
    __syncthreads();
    {
        const int cp = tid & 255, th = tid >> 8, c0 = 2 * cp;
        const float w00 = conv_w[c0], w01 = conv_w[RW + c0], w02 = conv_w[2 * RW + c0], w03 = conv_w[3 * RW + c0], b0 = conv_b[c0];
        const float w10 = conv_w[c0 + 1], w11 = conv_w[RW + c0 + 1], w12 = conv_w[2 * RW + c0 + 1], w13 = conv_w[3 * RW + c0 + 1], b1 = conv_b[c0 + 1];
        const LAS unsigned* xs = (const LAS unsigned*)(L + (th * 32) * 1024 + cp * 4);
        unsigned u0 = xs[0], u1 = xs[256], u2 = xs[512];
        float a0 = __uint_as_float(u0 << 16), a1 = __uint_as_float(u1 << 16), a2 = __uint_as_float(u2 << 16);
        float c0_ = __uint_as_float(u0 & 0xffff0000u), c1_ = __uint_as_float(u1 & 0xffff0000u), c2_ = __uint_as_float(u2 & 0xffff0000u);
#pragma unroll 8
        for (int t = 0; t < 32; ++t) { const unsigned u3 = xs[(t + 3) * 256]; const float a3 = __uint_as_float(u3 << 16), c3_ = __uint_as_float(u3 & 0xffff0000u);
            const float y0 = w00 * a0 + w01 * a1 + w02 * a2 + w03 * a3 + b0, y1 = w10 * c0_ + w11 * c1_ + w12 * c2_ + w13 * c3_ + b1;
            *(LAS unsigned*)(L + XC_OFF + (th * 32 + t) * XC_PITCH + cp * 4) = f2bf(y0) | (f2bf(y1) << 16);
            a0 = a1; a1 = a2; a2 = a3; c0_ = c1_; c1_ = c2_; c2_ = c3_; }
    }
    __syncthreads();
    const int h = wid;
    float Hc[2] = {0.f, 0.f}, Pc[2] = {1.f, 1.f};
    if (PASSB) {
#pragma unroll
        for (int nt = 0; nt < 2; ++nt) Hc[nt] = *(const LAS float*)(L + HC_OFF + (h * 64 + 32 * nt + r32) * 4);
    }
#pragma unroll
    for (int mt = 0; mt < 2; ++mt) {
        bf16x8 af[4];
#pragma unroll
        for (int s = 0; s < 4; ++s) af[s] = *(const LAS bf16x8*)(L + XC_OFF + (32 * mt + r32) * XC_PITCH + (h * 64 + 16 * s + 8 * hi) * 2);
#pragma unroll
        for (int nt = 0; nt < 2; ++nt) {
            f32x16 ra = {}, ri = {};
#pragma unroll
            for (int s = 0; s < 4; ++s) { ra = __builtin_amdgcn_mfma_f32_32x32x16_bf16(af[s], W.wa[nt][s], ra, 0, 0, 0); ri = __builtin_amdgcn_mfma_f32_32x32x16_bf16(af[s], W.wx[nt][s], ri, 0, 0, 0); }
            const int c = h * 64 + 32 * nt + r32;
#pragma unroll
            for (int r = 0; r < 16; ++r) { const int tok = 32 * mt + crow(r, hi);
                const float xc = bf2f(*(const LAS unsigned short*)(L + XC_OFF + tok * XC_PITCH + c * 2));
                const float rg = 1.f / (1.f + __expf(-(ra[r] + W.ba[nt]))), ig = 1.f / (1.f + __expf(-(ri[r] + W.bx[nt])));
                const float la = -8.0f * rg * W.spl[nt], a = __expf(la);
                ra[r] = a; ri[r] = sqrtf(fmaxf(0.f, 1.f - a * a)) * (ig * xc); }
            float P[4], H[4], Pp[4], Hp[4];
#pragma unroll
            for (int g = 0; g < 4; ++g) { P[g] = (ra[4 * g] * ra[4 * g + 1]) * (ra[4 * g + 2] * ra[4 * g + 3]);
                H[g] = ((ri[4 * g] * ra[4 * g + 1] + ri[4 * g + 1]) * ra[4 * g + 2] + ri[4 * g + 2]) * ra[4 * g + 3] + ri[4 * g + 3]; }
#pragma unroll
            for (int g = 0; g < 4; ++g) { Pp[g] = __shfl_xor(P[g], 32); Hp[g] = __shfl_xor(H[g], 32); }
            float hc = Hc[nt], pc = Pc[nt];
#pragma unroll
            for (int g = 0; g < 4; ++g) { const float P0 = hi ? Pp[g] : P[g], H0 = hi ? Hp[g] : H[g], P1 = hi ? P[g] : Pp[g], H1 = hi ? H[g] : Hp[g];
                const float mid = P0 * hc + H0;
                if (PASSB) { float hh = hi ? mid : hc;
#pragma unroll
                    for (int k = 0; k < 4; ++k) { hh = ra[4 * g + k] * hh + ri[4 * g + k]; const int tok = 32 * mt + 8 * g + 4 * hi + k;
                        *(LAS unsigned short*)(L + tok * 1024 + c * 2) = (unsigned short)f2bf(hh); } }
                hc = P1 * mid + H1; pc = pc * (P0 * P1); }
            Hc[nt] = hc; Pc[nt] = pc;
        }
    }
    if (!PASSB) {
        if (hi == 0) {
#pragma unroll
            for (int nt = 0; nt < 2; ++nt) { const int c = h * 64 + 32 * nt + r32; aggP[((size_t)b * RW + c) * 64 + chunk] = Pc[nt]; aggH[((size_t)b * RW + c) * 64 + chunk] = Hc[nt]; }
        }
        __syncthreads();
    } else {
        __syncthreads();
        for (int i = 0; i < 8; ++i) { const int rr = i * 8 + wid; const size_t row = rowbase + t0 + rr;
            const u32x4 hv = *(const LAS u32x4*)(L + rr * 1024 + lane * 16); const u32x4 gv = *(const u32x4*)(GG + row * RW + lane * 8);
            f32x4 y0, y1;
            y0[0] = __uint_as_float(hv.x << 16) * __uint_as_float(gv.x << 16); y0[1] = __uint_as_float(hv.x & 0xffff0000u) * __uint_as_float(gv.x & 0xffff0000u);
            y0[2] = __uint_as_float(hv.y << 16) * __uint_as_float(gv.y << 16); y0[3] = __uint_as_float(hv.y & 0xffff0000u) * __uint_as_float(gv.y & 0xffff0000u);
            y1[0] = __uint_as_float(hv.z << 16) * __uint_as_float(gv.z << 16); y1[1] = __uint_as_float(hv.z & 0xffff0000u) * __uint_as_float(gv.z & 0xffff0000u);
            y1[2] = __uint_as_float(hv.w << 16) * __uint_as_float(gv.w << 16); y1[3] = __uint_as_float(hv.w & 0xffff0000u) * __uint_as_float(gv.w & 0xffff0000u);
            const float ss = wave_sum(pg8::sq8(y0, y1));
            *(u32x4*)(YY + row * D + lane * 8) = pg8::pack8(y0, y1);
            if (lane == 0) { float s2 = 0.f;
#pragma unroll
                for (int k = 0; k < 8; ++k) s2 += ssq_s8[row * 8 + k];
                const float rrn = 1.0f / sqrtf(ss * (1.f / RW) + EPS), rs = 1.0f / sqrtf(s2 * (1.f / SBW) + EPS); fmid[row] = rrn / rs; fend[row] = rs; } }
        __syncthreads();
    }
}
}
__device__ __forceinline__ void row_prep_x(const float* x, bf16_t* xb, float* rstd0, int row, int lane) {
    const f32x4* xr = (const f32x4*)(x + (size_t)row * D) + lane;
    float s = 0.f; f32x4 v[4];
#pragma unroll
    for (int j = 0; j < 4; ++j) { v[j] = xr[64 * j]; s += v[j].x * v[j].x + v[j].y * v[j].y + v[j].z * v[j].z + v[j].w * v[j].w; }
    s = wave_sum(s);
    if (lane == 0) rstd0[row] = 1.0f / sqrtf(s * (1.f / D) + EPS);
    unsigned long long* o8 = (unsigned long long*)(xb + (size_t)row * D) + lane;
#pragma unroll
    for (int j = 0; j < 4; ++j) o8[64 * j] = (unsigned long long)(f2bf(v[j].x) | (f2bf(v[j].y) << 16)) | ((unsigned long long)(f2bf(v[j].z) | (f2bf(v[j].w) << 16)) << 32);
}
__device__ __forceinline__ void row_prep_mem(const float* m, const float* g, bf16_t* o, int row, int lane) {
    const f32x4* xr = (const f32x4*)(m + (size_t)row * D) + lane;
    float s = 0.f; f32x4 v[4];
#pragma unroll
    for (int j = 0; j < 4; ++j) { v[j] = xr[64 * j]; s += v[j].x * v[j].x + v[j].y * v[j].y + v[j].z * v[j].z + v[j].w * v[j].w; }
    s = wave_sum(s);
    const float r = 1.0f / sqrtf(s * (1.f / D) + EPS);
    unsigned long long* o8 = (unsigned long long*)(o + (size_t)row * D) + lane;
#pragma unroll
    for (int j = 0; j < 4; ++j) { const f32x4 gg = ((const f32x4*)g)[64 * j + lane];
        o8[64 * j] = (unsigned long long)(f2bf(v[j].x * r * gg.x) | (f2bf(v[j].y * r * gg.y) << 16)) | ((unsigned long long)(f2bf(v[j].z * r * gg.z) | (f2bf(v[j].w * r * gg.w) << 16)) << 32); }
}
__device__ __forceinline__ void transpose_item(const float* W, int K, int N, bf16_t* Wt, int ldt, const float* g0, const float* g1, int ksplit, LAS float* scr, int item, int lane) {
    const int nblk = N / 32, kb = item / nblk, nb = item % nblk, k0 = 64 * kb, n0 = 32 * nb;
#pragma unroll 8
    for (int i = 0; i < 32; ++i) { const int kk = 2 * i + (lane >> 5), k = k0 + kk; float gv = 1.f; if (g0) gv = (k < ksplit) ? g0[k] : g1[k - ksplit];
        scr[kk * 33 + (lane & 31)] = W[(size_t)k * N + n0 + (lane & 31)] * gv; }
    asm volatile("s_waitcnt lgkmcnt(0)" ::: "memory");
    const int c = lane & 7;
#pragma unroll
    for (int j = 0; j < 4; ++j) { const int n = (lane >> 3) + 8 * j; const LAS float* s = scr + (8 * c) * 33 + n;
        u32x4 o; o.x = f2bf(s[0 * 33]) | (f2bf(s[1 * 33]) << 16); o.y = f2bf(s[2 * 33]) | (f2bf(s[3 * 33]) << 16); o.z = f2bf(s[4 * 33]) | (f2bf(s[5 * 33]) << 16); o.w = f2bf(s[6 * 33]) | (f2bf(s[7 * 33]) << 16);
        *(u32x4*)(Wt + (size_t)(n0 + n) * ldt + k0 + 8 * c) = o; }
    asm volatile("s_waitcnt lgkmcnt(0)" ::: "memory");
}

struct MidScale { const float* f; int k; int pad; };
template <class Epi>
__device__ __forceinline__ void gemm_naive(const Ctx& C, const bf16_t* A, int lda, const bf16_t* Bt, int ldb, int M, int N, int K, MidScale ms, const Epi& E) {
    const int lane = C.lane, fr = lane & 15, fq = lane >> 4, ncol = N / 64, ntile = (M / 16) * ncol;
    for (int t = C.gw; t < ntile; t += C.NGW) {
        const int row0 = (t / ncol) * 16, col0 = (t % ncol) * 64;
        const bf16_t* ap = A + (size_t)(row0 + fr) * lda + fq * 8;
        const bf16_t* bp = Bt + (size_t)(col0 + fr) * ldb + fq * 8;
        f32x4 acc[4];
#pragma unroll
        for (int n = 0; n < 4; ++n) acc[n] = (f32x4){0.f, 0.f, 0.f, 0.f};
        for (int k0 = 0; k0 < K; k0 += 32) {
            if (ms.f && k0 == ms.k) {
#pragma unroll
                for (int j = 0; j < 4; ++j) { const float f = ms.f[row0 + fq * 4 + j];
#pragma unroll
                    for (int n = 0; n < 4; ++n) acc[n][j] *= f; }
            }
            const bf16x8 a = *(const bf16x8*)(ap + k0);
#pragma unroll
            for (int n = 0; n < 4; ++n) { const bf16x8 b = *(const bf16x8*)(bp + (size_t)n * 16 * ldb + k0); acc[n] = __builtin_amdgcn_mfma_f32_16x16x32_bf16(a, b, acc[n], 0, 0, 0); }
        }
#pragma unroll
        for (int n = 0; n < 4; ++n)
#pragma unroll
            for (int j = 0; j < 4; ++j) E(row0 + fq * 4 + j, col0 + n * 16 + fr, acc[n][j]);
    }
}
struct EpiInProj { const float* rstd0; bf16_t *XR, *GG, *Qs, *Ks, *Vs;
    __device__ void operator()(int r, int c, float v) const { v *= rstd0[r]; const int t = c >> 9, cc = c & 511;
        if (t == 0) XR[(size_t)r * RW + cc] = (bf16_t)f2bf(v);
        else if (t == 1) GG[(size_t)r * RW + cc] = (bf16_t)f2bf(gelu_tanh(v));
        else if (t == 2) Qs[(size_t)r * SBW + cc] = (bf16_t)f2bf(v * (0.125f * LOG2E));
        else if (t == 3) Ks[(size_t)r * SBW + cc] = (bf16_t)f2bf(v);
        else Vs[(size_t)r * SBW + cc] = (bf16_t)f2bf(v); } };
struct EpiStoreBf16 { bf16_t* O; const float* rowscale; int ldo; float scale;
    __device__ void operator()(int r, int c, float v) const { O[(size_t)r * ldo + c] = (bf16_t)f2bf(v * (rowscale ? rowscale[r] : 1.f) * scale); } };
struct EpiResF32 { const float* base; const float* rowscale; bf16_t* O;
    __device__ void operator()(int r, int c, float v) const { O[(size_t)r * D + c] = (bf16_t)f2bf(base[(size_t)r * D + c] + v * rowscale[r]); } };
struct EpiResBf16 { const bf16_t* base; bf16_t* O;
    __device__ void operator()(int r, int c, float v) const { O[(size_t)r * D + c] = (bf16_t)f2bf(bf2f(base[(size_t)r * D + c]) + v); } };

__device__ __forceinline__ void lru_naive_unit(int unit, int j, LAS float* xs, const bf16_t* XR, const bf16_t* GG, const float* conv_w, const float* conv_b,
                                               const float* w_a, const float* b_a, const float* w_x, const float* b_x, const float* lam, bf16_t* YY) {
    const int b = unit >> 3, h = unit & 7, c = h * 64 + j;
    float wa[64], wx[64];
#pragma unroll
    for (int i = 0; i < 64; ++i) { wa[i] = w_a[(size_t)(h * 64 + i) * 64 + j]; wx[i] = w_x[(size_t)(h * 64 + i) * 64 + j]; }
    const float ba = b_a[c], bx = b_x[c], cw0 = conv_w[c], cw1 = conv_w[RW + c], cw2 = conv_w[2 * RW + c], cw3 = conv_w[3 * RW + c], cb = conv_b[c];
    const float l = lam[c], spl = (l > 15.f) ? __expf(-l) : log1pf(__expf(-l));
    float x0 = 0.f, x1 = 0.f, x2 = 0.f, hst = 0.f;
    for (int t = 0; t < SEQ; ++t) {
        const size_t row = (size_t)b * SEQ + t;
        const float x3 = bf2f(XR[row * RW + c]);
        const float xc = cw0 * x0 + cw1 * x1 + cw2 * x2 + cw3 * x3 + cb;
        x0 = x1; x1 = x2; x2 = x3;
        asm volatile("s_waitcnt lgkmcnt(0)" ::: "memory"); xs[j] = xc; asm volatile("s_waitcnt lgkmcnt(0)" ::: "memory");
        float ra = ba, ri = bx;
#pragma unroll
        for (int i = 0; i < 64; ++i) { const float xv = xs[i]; ra += xv * wa[i]; ri += xv * wx[i]; }
        const float r = sigmoidf_(ra), ig = sigmoidf_(ri);
        const float log_a = -8.0f * r * spl, a = __expf(log_a), bb = sqrtf(fmaxf(0.f, -expm1f(2.f * log_a))) * (ig * xc);
        hst = a * hst + bb;
        YY[row * D + c] = (bf16_t)f2bf(hst * bf2f(GG[row * RW + c]));
    }
}
__device__ __forceinline__ void sb_naive_unit(int unit, int lane, const bf16_t* Qs, const bf16_t* Ks, const bf16_t* Vs, bf16_t* YY, float* ssq_s8) {
    const int qb = unit & 63, h = (unit >> 6) & 7, b = unit >> 9;
    const int t = qb * 64 + lane; const size_t row = (size_t)b * SEQ + t;
    float q[64], o[64];
#pragma unroll
    for (int d = 0; d < 64; ++d) { q[d] = bf2f(Qs[row * SBW + h * 64 + d]); o[d] = 0.f; }
    float R = 0.f;
    for (int s = qb * 64 + 62; s >= 0; --s) {
        const bf16_t* kr = Ks + ((size_t)b * SEQ + s) * SBW + h * 64; const bf16_t* vr = Vs + ((size_t)b * SEQ + s) * SBW + h * 64;
        float z = 0.f;
#pragma unroll
        for (int d = 0; d < 64; ++d) z += q[d] * bf2f(kr[d]);
        const bool valid = s < t;
        const float sp = valid ? (fmaxf(z, 0.f) + __log2f(1.f + exp2f(-fabsf(z)))) : 0.f;
        const float w = valid ? exp2f(z - (R + sp)) : 0.f;
        R += sp;
        const float wb = bf2f((bf16_t)f2bf(w));
#pragma unroll
        for (int d = 0; d < 64; ++d) o[d] += wb * bf2f(vr[d]);
    }
    float ss = 0.f;
#pragma unroll
    for (int d = 0; d < 64; ++d) { ss += o[d] * o[d]; YY[row * D + RW + h * 64 + d] = (bf16_t)f2bf(o[d]); }
    ssq_s8[row * 8 + h] = ss;
}
__device__ __forceinline__ void xattn_naive_unit(int unit, int j, LAS float* qs, LAS float* ps, const bf16_t* QX, const bf16_t* KVM, bf16_t* OX) {
    const int tg = unit & 511, h = (unit >> 9) & 3, b = unit >> 11, lane = j & 63, wid = j >> 6;
    const size_t row0 = (size_t)b * SEQ + tg * 8;
    for (int i = 0; i < 8; ++i) qs[i * 256 + j] = bf2f(QX[(row0 + i) * D + h * XD + j]);
    __syncthreads();
    const bf16_t* kr = KVM + ((size_t)b * MEM + j) * 2048 + h * XD;
    float sc[8];
#pragma unroll
    for (int i = 0; i < 8; ++i) sc[i] = 0.f;
    for (int d = 0; d < XD; ++d) { const float kv = bf2f(kr[d]);
#pragma unroll
        for (int i = 0; i < 8; ++i) sc[i] += qs[i * 256 + d] * kv; }
#pragma unroll
    for (int i = 0; i < 8; ++i) ps[i * 256 + j] = sc[i];
    __syncthreads();
    for (int i = wid * 2; i < wid * 2 + 2; ++i) {
        float v0 = ps[i * 256 + lane], v1 = ps[i * 256 + lane + 64], v2 = ps[i * 256 + lane + 128], v3 = ps[i * 256 + lane + 192];
        float m = fmaxf(fmaxf(v0, v1), fmaxf(v2, v3));
#pragma unroll
        for (int o = 1; o < 64; o <<= 1) m = fmaxf(m, __shfl_xor(m, o));
        v0 = exp2f(v0 - m); v1 = exp2f(v1 - m); v2 = exp2f(v2 - m); v3 = exp2f(v3 - m);
        const float s = wave_sum(v0 + v1 + v2 + v3), inv = 1.f / s;
        ps[i * 256 + lane] = v0 * inv; ps[i * 256 + lane + 64] = v1 * inv; ps[i * 256 + lane + 128] = v2 * inv; ps[i * 256 + lane + 192] = v3 * inv;
    }
    __syncthreads();
    float o[8];
#pragma unroll
    for (int i = 0; i < 8; ++i) o[i] = 0.f;
    for (int m = 0; m < MEM; ++m) { const float vv = bf2f(KVM[((size_t)b * MEM + m) * 2048 + 1024 + h * XD + j]);
#pragma unroll
        for (int i = 0; i < 8; ++i) o[i] += ps[i * 256 + m] * vv; }
#pragma unroll
    for (int i = 0; i < 8; ++i) OX[(row0 + i) * D + h * XD + j] = (bf16_t)f2bf(o[i]);
    __syncthreads();
}
__device__ __forceinline__ int router_row(int row, int lane, const bf16_t* X2b, const float* ssq2p, const float* g, const float* wgr, const float* bgr, const float* wer, const float* ber, float* selw) {
    int cls = 0;
    float acc[20];
#pragma unroll
    for (int i = 0; i < 20; ++i) acc[i] = 0.f;
    const float rs = pg8::rstd16(ssq2p + (size_t)row * 16);
    for (int kk = 0; kk < 16; ++kk) { const int k = kk * 64 + lane; const float t = bf2f(X2b[(size_t)row * D + k]) * rs * g[k];
#pragma unroll
        for (int i = 0; i < 4; ++i) acc[i] += t * wgr[k * 4 + i];
#pragma unroll
        for (int gi = 0; gi < 4; ++gi)
#pragma unroll
            for (int e = 0; e < 4; ++e) acc[4 + gi * 4 + e] += t * wer[((size_t)gi * D + k) * 4 + e]; }
#pragma unroll
    for (int i = 0; i < 20; ++i) acc[i] = wave_sum(acc[i]);
    if (lane == 0) {
        float gl[4]; float gm = -INFINITY; int gi = 0;
#pragma unroll
        for (int i = 0; i < 4; ++i) { gl[i] = acc[i] + bgr[i]; if (gl[i] > gm) { gm = gl[i]; gi = i; } }
        float gs = 0.f;
#pragma unroll
        for (int i = 0; i < 4; ++i) gs += __expf(gl[i] - gm);
        const float gp = 1.f / gs;
        float el[4];
#pragma unroll
        for (int e = 0; e < 4; ++e) { float v = 0.f;
#pragma unroll
            for (int q = 0; q < 4; ++q) if (q == gi) v = acc[4 + q * 4 + e] + ber[q * 4 + e];
            el[e] = v; }
        int e1 = 0; float m1 = el[0];
#pragma unroll
        for (int e = 1; e < 4; ++e) if (el[e] > m1) { m1 = el[e]; e1 = e; }
        int e2 = -1; float m2 = -INFINITY;
#pragma unroll
        for (int e = 0; e < 4; ++e) if (e != e1 && el[e] > m2) { m2 = el[e]; e2 = e; }
        const float p2 = __expf(m2 - m1), w1 = gp / (1.f + p2), w2 = gp * p2 / (1.f + p2);
        const int ea = e1 < e2 ? e1 : e2, eb = e1 < e2 ? e2 : e1; const float wA = e1 < e2 ? w1 : w2, wB = e1 < e2 ? w2 : w1;
        const int pr = (ea == 0) ? eb - 1 : (ea == 1) ? eb + 1 : 5;
        selw[(size_t)row * 2] = wA; selw[(size_t)row * 2 + 1] = wB; cls = gi * 6 + pr;
    }
    return cls;
}
__device__ __forceinline__ void final_row(int row, int lane, const bf16_t* X3b, const float* ssq3, const float* g, float* out) {
    const float r = pg8::rstd16(ssq3 + (size_t)row * 16);
#pragma unroll
    for (int j = 0; j < 2; ++j) { const int c = j * 512 + lane * 8; const u32x4 v = *(const u32x4*)(X3b + (size_t)row * D + c); const f32x4 g0 = *(const f32x4*)(g + c), g1 = *(const f32x4*)(g + c + 4);
        f32x4 o0, o1;
        o0[0] = __uint_as_float(v.x << 16) * r * g0[0]; o0[1] = __uint_as_float(v.x & 0xffff0000u) * r * g0[1]; o0[2] = __uint_as_float(v.y << 16) * r * g0[2]; o0[3] = __uint_as_float(v.y & 0xffff0000u) * r * g0[3];
        o1[0] = __uint_as_float(v.z << 16) * r * g1[0]; o1[1] = __uint_as_float(v.z & 0xffff0000u) * r * g1[1]; o1[2] = __uint_as_float(v.w << 16) * r * g1[2]; o1[3] = __uint_as_float(v.w & 0xffff0000u) * r * g1[3];
        *(f32x4*)(out + (size_t)row * D + c) = o0; *(f32x4*)(out + (size_t)row * D + c + 4) = o1; }
}
__device__ __forceinline__ void reids(Ctx& C) { int t_ = threadIdx.x; asm volatile("" : "+v"(t_)); C.tid = t_; C.lane = t_ & 63; C.wave = __builtin_amdgcn_readfirstlane(t_ >> 6); C.gw = C.bid * NWAVES + C.wave; }
__global__ void __launch_bounds__(NTHREADS, 2) mk_fwd(Args args) {
    extern __shared__ __attribute__((aligned(16))) unsigned char lds[];
    cg::grid_group grid = cg::this_grid();
    Ctx C;
#pragma unroll
    for (int i = 0; i < 29; ++i) C.in[i] = args.in[i];
    C.out = args.out; C.ws = args.ws; C.lds = lds;
    C.tid = threadIdx.x; C.lane = C.tid & 63; C.wave = __builtin_amdgcn_readfirstlane(C.tid >> 6);
    C.G = gridDim.x; C.bid = blockIdx.x; C.gw = C.bid * NWAVES + C.wave; C.NGW = C.G * NWAVES;
    const float* x = C.in[0]; const float* mem = C.in[1]; const float* norm_mix = C.in[2]; const float* w_in = C.in[3];
    const float* conv_w = C.in[4]; const float* conv_b = C.in[5]; const float* lru_w_a = C.in[6]; const float* lru_b_a = C.in[7];
    const float* lru_w_x = C.in[8]; const float* lru_b_x = C.in[9]; const float* lru_lambda = C.in[10];
    const float* norm_rnn = C.in[11]; const float* norm_sb = C.in[12]; const float* w_out = C.in[13];
    const float* norm_xattn = C.in[14]; const float* norm_mem = C.in[15];
    const float* xa_w_q = C.in[16]; const float* xa_w_k = C.in[17]; const float* xa_w_v = C.in[18]; const float* xa_w_o = C.in[19];
    const float* norm_moe = C.in[20]; const float* w_gr = C.in[21]; const float* b_gr = C.in[22]; const float* w_er = C.in[23]; const float* b_er = C.in[24];
    const float* w_gate = C.in[25]; const float* w_up = C.in[26]; const float* w_down = C.in[27]; const float* norm_final = C.in[28];
    unsigned char* ws = C.ws; float* out = C.out;
    float* sm = (float*)(ws + WS_SMALL);
    float* rstd0 = sm + SM_RSTD0; float* ssq_r = sm + SM_SSQR; float* ssq_s = sm + SM_SSQS; float* ssq1 = sm + SM_SSQ1; float* ssq2 = sm + SM_SSQ2; unsigned* kmax = (unsigned*)(ws + WS_CTL); float* fmid = sm + SM_END; float* fend = fmid + 32768;
    float* aggP = sm + 96 * 32768; float* aggH = sm + 104 * 32768;
    float* selw = sm + SM_SELW; float* ssq3 = sm + SM_SSQ3; int* gcnt = (int*)(ws + WS_CTL + 1024);
    int* tlist = (int*)(sm + 64 * 32768); float* rsg = sm + 88 * 32768; float* wAg = rsg + 40960; float* wBg = wAg + 40960; int* tokg = (int*)(wBg + 40960);
    bf16_t* Wrh = (bf16_t*)(ws + WS_CTL + 65536); bf16_t* Wrl = Wrh + 32 * D;
    bf16_t* Wg_t = (bf16_t*)(ws + WS_WG); bf16_t* Wu_t = (bf16_t*)(ws + WS_WU); bf16_t* Wd2 = (bf16_t*)(ws + WS_WD2); bf16_t* XG = (bf16_t*)(ws + WS_R1); bf16_t* HID = (bf16_t*)(ws + WS_R5);
    bf16_t* Win_t = (bf16_t*)(ws + WS_WIN); bf16_t* Wout_t = (bf16_t*)(ws + WS_WOUT); bf16_t* Wq_t = (bf16_t*)(ws + WS_WQ); bf16_t* Wkv_t = (bf16_t*)(ws + WS_WKV); bf16_t* Wo_t = (bf16_t*)(ws + WS_WO);
    bf16_t* memn = (bf16_t*)(ws + WS_MEMN); bf16_t* KM = (bf16_t*)(ws + WS_KVM); bf16_t* VT = KM + (size_t)NMEM * D;
    bf16_t* xb = (bf16_t*)(ws + WS_R0); bf16_t* X1b = xb; bf16_t* X3b = xb;
    bf16_t* XR = (bf16_t*)(ws + WS_R1); bf16_t* GG = XR + (size_t)NTOK * RW; bf16_t* QX = XR;
    bf16_t* Qs = (bf16_t*)(ws + WS_R2); bf16_t* Ks = Qs + (size_t)NTOK * SBW; bf16_t* OX = Qs;
    bf16_t* Vs = (bf16_t*)(ws + WS_R3);
    bf16_t* YY = (bf16_t*)(ws + WS_R4); bf16_t* X2b = YY;
    const int NGW = C.NGW;
#define gw C.gw
#define lane C.lane
    if (C.tid < 64) ((LAS unsigned*)(lds + 146432))[C.tid] = 0u;
    __syncthreads();
    XcdBarrier bar = xcd_barrier_post((unsigned*)(ws + WS_CTL + 4096), (volatile LAS unsigned*)(lds + 146432 + 32));
#define GRID_SYNC_CG() do { grid.sync(); reids(C); } while (0)
#define GRID_SYNC() do { xcd_barrier(bar); reids(C); } while (0)

    for (int rep_ = 0; rep_ < (int)((REP_MASK >> 0) & 1u) + 1; ++rep_) {
    {
        if (gw == 0) { kmax[lane] = 0u; if (lane < 32) gcnt[lane] = 0; }
        for (int r = gw * 2; r < NTOK; r += NGW * 2) {
            const f32x4* xr = (const f32x4*)(x + (size_t)r * D) + lane; f32x4 v[8]; float s0 = 0.f, s1 = 0.f;
#pragma unroll
            for (int j = 0; j < 8; ++j) v[j] = __builtin_nontemporal_load(xr + 64 * j);
#pragma unroll
            for (int j = 0; j < 4; ++j) { s0 += (v[j].x * v[j].x + v[j].y * v[j].y) + (v[j].z * v[j].z + v[j].w * v[j].w); s1 += (v[4 + j].x * v[4 + j].x + v[4 + j].y * v[4 + j].y) + (v[4 + j].z * v[4 + j].z + v[4 + j].w * v[4 + j].w); }
#pragma unroll
            for (int o = 1; o < 64; o <<= 1) { s0 += __shfl_xor(s0, o); s1 += __shfl_xor(s1, o); }
            if (lane == 0) { rstd0[r] = 1.0f / sqrtf(s0 * (1.f / D) + EPS); rstd0[r + 1] = 1.0f / sqrtf(s1 * (1.f / D) + EPS); }
            unsigned long long* o8 = (unsigned long long*)(xb + (size_t)r * D) + lane;
#pragma unroll
            for (int j = 0; j < 8; ++j) o8[64 * j] = (unsigned long long)(f2bf(v[j].x) | (f2bf(v[j].y) << 16)) | ((unsigned long long)(f2bf(v[j].z) | (f2bf(v[j].w) << 16)) << 32);
        }
        for (int r = gw; r < NMEM; r += NGW) row_prep_mem(mem, norm_mem, memn, r, lane);
        LAS float* scr = (LAS float*)(lds) + C.wave * (64 * 33);
        constexpr int I_IN = (D / 64) * (PROJ / 32), I_SQ = (D / 64) * (D / 32);
        for (int it = gw; it < I_IN + 5 * I_SQ; it += NGW) {
            int r = it;
            if (r < I_IN) { transpose_item(w_in, D, PROJ, Win_t, D, norm_mix, norm_mix, D, scr, r, lane); continue; } r -= I_IN;
            if (r < I_SQ) { transpose_item(w_out, D, D, Wout_t, D, norm_rnn, norm_sb, RW, scr, r, lane); continue; } r -= I_SQ;
            if (r < I_SQ) { transpose_item(xa_w_q, D, D, Wq_t, D, norm_xattn, norm_xattn, D, scr, r, lane); continue; } r -= I_SQ;
            if (r < I_SQ) { transpose_item(xa_w_k, D, D, Wkv_t, D, nullptr, nullptr, 0, scr, r, lane); continue; } r -= I_SQ;
            if (r < I_SQ) { transpose_item(xa_w_v, D, D, Wkv_t + (size_t)D * D, D, nullptr, nullptr, 0, scr, r, lane); continue; } r -= I_SQ;
            transpose_item(xa_w_o, D, D, Wo_t, D, nullptr, nullptr, 0, scr, r, lane);
        }
        for (int idx = gw * 64 + lane; idx < 32 * D; idx += NGW * 64) { const int n = idx >> 10, k = idx & 1023; float w = 0.f;
            if (n < 4) w = w_gr[k * 4 + n]; else if (n < 20) w = w_er[((size_t)((n - 4) >> 2) * D + k) * 4 + ((n - 4) & 3)];
            w *= norm_moe[k]; const unsigned hi = f2bf(w); Wrh[idx] = (bf16_t)hi; Wrl[idx] = (bf16_t)f2bf(w - bf2f((unsigned short)hi)); }
        constexpr int I_GU = (D / 64) * (DE / 32), I_DN = (DE / 64) * (D / 32);
        for (int it = gw; it < 32 * I_GU + 48 * I_DN; it += NGW) {
            int r = it;
            if (r < 16 * I_GU) { const int e = r / I_GU; transpose_item(w_gate + (size_t)e * D * DE, D, DE, Wg_t + (size_t)e * DE * D, D, norm_moe, norm_moe, D, scr, r % I_GU, lane); continue; } r -= 16 * I_GU;
            if (r < 16 * I_GU) { const int e = r / I_GU; transpose_item(w_up + (size_t)e * D * DE, D, DE, Wu_t + (size_t)e * DE * D, D, norm_moe, norm_moe, D, scr, r % I_GU, lane); continue; } r -= 16 * I_GU;
            { const int cs = r / I_DN, cls = cs >> 1, slot = cs & 1; int ea, eb; pg8::pair_ab(cls % 6, ea, eb); const int e = (cls / 6) * 4 + (slot ? eb : ea);
              transpose_item(w_down + (size_t)e * DE * D, DE, D, Wd2 + (size_t)cls * D * 512 + slot * DE, 512, nullptr, nullptr, 0, scr, r % I_DN, lane); }
        }
    }
    }
    GRID_SYNC();
    for (int rep_ = 0; rep_ < (int)((REP_MASK >> 1) & 1u) + 1; ++rep_) {
    { pg8::DenseOrder S; S.init(xb, D, Win_t, D, NTOK, PROJ, C.G, C.bid); pg8::EpiInProjF E{0, rstd0, XR, GG, Qs, Ks, Vs, kmax};
      pg8::gemm_phase<pg8::EpiInProjF, pg8::DenseOrder, true>((LAS unsigned char*)lds, pg8::Gemm{D, D, D}, S, E); }
    { pg8::DenseOrder S; S.init(memn, D, Wkv_t, D, NMEM, D, C.G, C.bid); pg8::EpiBf16F E{0, KM, nullptr, D, 1.f, 0};
      pg8::gemm_phase<pg8::EpiBf16F, pg8::DenseOrder, true>((LAS unsigned char*)lds, pg8::Gemm{D, D, D}, S, E); }
    { pg8::DenseOrder S; S.init(Wkv_t + (size_t)D * D, D, memn, D, D, NMEM, C.G, C.bid); pg8::EpiBf16F E{0, VT, nullptr, MEM, 1.f, (size_t)D * MEM};
      pg8::gemm_phase<pg8::EpiBf16F, pg8::DenseOrder, true>((LAS unsigned char*)lds, pg8::Gemm{D, D, D}, S, E); }
    }
    GRID_SYNC();
    lru::Weights LW; lru::load_weights(LW, C.wave, lane & 31, lane >> 5, lru_w_a, lru_b_a, lru_w_x, lru_b_x, lru_lambda);
    for (int rep_ = 0; rep_ < (int)((REP_MASK >> 2) & 1u) + 1; ++rep_) {
    {
        for (int u = C.bid; u < BATCH * 64; u += C.G) lru::unit<false>(u >> 6, u & 63, LW, XR, GG, conv_w, conv_b, aggP, aggH, ssq_s, YY, fmid, fend, lds);
        for (int u = C.bid; u < BATCH * NH * 16; u += C.G) sba::sb_unit(u >> 7, (u >> 4) & 7, 15 - (u & 15), Qs, Ks, Vs, YY, ssq_s, kmax, (char*)lds);
    }
    }
    GRID_SYNC();
    for (int rep_ = 0; rep_ < (int)((REP_MASK >> 3) & 1u) + 1; ++rep_) {
    for (int u = C.bid; u < BATCH * 64; u += C.G) lru::unit<true>(u >> 6, u & 63, LW, XR, GG, conv_w, conv_b, aggP, aggH, ssq_s, YY, fmid, fend, lds);
    }
    GRID_SYNC();
    for (int rep_ = 0; rep_ < (int)((REP_MASK >> 4) & 1u) + 1; ++rep_) {
    { pg8::DenseOrder S; S.init(YY, D, Wout_t, D, NTOK, D, C.G, C.bid); pg8::EpiX1F E{8, xb, fmid, fend, X1b, ssq1};
      pg8::gemm_phase<pg8::EpiX1F, pg8::DenseOrder, true>((LAS unsigned char*)lds, pg8::Gemm{D, D, D}, S, E); }
    }
    GRID_SYNC();
    for (int rep_ = 0; rep_ < (int)((REP_MASK >> 5) & 1u) + 1; ++rep_) {
    { pg8::DenseOrder S; S.init(X1b, D, Wq_t, D, NTOK, D, C.G, C.bid); pg8::EpiBf16F E{0, QX, ssq1, D, 0.0625f * LOG2E, 0};
      pg8::gemm_phase<pg8::EpiBf16F, pg8::DenseOrder, true>((LAS unsigned char*)lds, pg8::Gemm{D, D, D}, S, E); }
    }
    GRID_SYNC();
    for (int rep_ = 0; rep_ < (int)((REP_MASK >> 6) & 1u) + 1; ++rep_) {
    { pg8::XaSOrder S{QX, KM, C.G, C.bid}; pg8::EpiSoftmax E{0, QX, (LAS float*)(lds + 131072 + 2048)};
      pg8::gemm_phase<pg8::EpiSoftmax, pg8::XaSOrder, true>((LAS unsigned char*)lds, pg8::Gemm{D, D, XD}, S, E); }
    }
    GRID_SYNC();
    for (int rep_ = 0; rep_ < (int)((REP_MASK >> 7) & 1u) + 1; ++rep_) {
    { pg8::XaOOrder S{QX, VT, C.G, C.bid}; pg8::EpiBf16F E{0, OX, nullptr, D, 1.f, 0};
      pg8::gemm_phase<pg8::EpiBf16F, pg8::XaOOrder, true>((LAS unsigned char*)lds, pg8::Gemm{D, MEM, MEM}, S, E); }
    }
    GRID_SYNC();
    for (int rep_ = 0; rep_ < (int)((REP_MASK >> 8) & 1u) + 1; ++rep_) {
    { pg8::DenseOrder S; S.init(OX, D, Wo_t, D, NTOK, D, C.G, C.bid); pg8::EpiResF E{0, X1b, X2b, ssq2};
      pg8::gemm_phase<pg8::EpiResF, pg8::DenseOrder, true>((LAS unsigned char*)lds, pg8::Gemm{D, D, D}, S, E); }
    }
    GRID_SYNC();
    for (int rep_ = 0; rep_ < (int)((REP_MASK >> 9) & 1u) + 1; ++rep_) {
    {
        LAS int* lcnt = (LAS int*)lds; LAS int* lbase = lcnt + 32; LAS int* lcls = lcnt + 64; LAS int* lpos = lcnt + 192;
        for (int chunk = C.bid; chunk < NTOK / 128; chunk += C.G) {
            if (C.tid < 32) lcnt[C.tid] = 0;
            __syncthreads();
            {
                const int fr = lane & 15, fq = lane >> 4, row0 = chunk * 128 + C.wave * 16;
                f32x4 acc0 = {0.f, 0.f, 0.f, 0.f}, acc1 = acc0;
                const bf16_t* ap = X2b + (size_t)(row0 + fr) * D + fq * 8; const bf16_t* bp = Wrh + (size_t)fr * D + fq * 8;
#pragma unroll 4
                for (int ks = 0; ks < 32; ++ks) { const bf16x8 a = *(const bf16x8*)(ap + ks * 32);
                    const bf16x8 h0 = *(const bf16x8*)(bp + ks * 32), h1 = *(const bf16x8*)(bp + 16 * D + ks * 32), l0 = *(const bf16x8*)(bp + 32 * D + ks * 32), l1 = *(const bf16x8*)(bp + 48 * D + ks * 32);
                    acc0 = __builtin_amdgcn_mfma_f32_16x16x32_bf16(a, h0, acc0, 0, 0, 0); acc1 = __builtin_amdgcn_mfma_f32_16x16x32_bf16(a, h1, acc1, 0, 0, 0);
                    acc0 = __builtin_amdgcn_mfma_f32_16x16x32_bf16(a, l0, acc0, 0, 0, 0); acc1 = __builtin_amdgcn_mfma_f32_16x16x32_bf16(a, l1, acc1, 0, 0, 0); }
                LAS float* lg = (LAS float*)(lds + 4096) + C.wave * (16 * 33);
#pragma unroll
                for (int j = 0; j < 4; ++j) { lg[(4 * fq + j) * 33 + fr] = acc0[j]; lg[(4 * fq + j) * 33 + 16 + fr] = acc1[j]; }
                asm volatile("s_waitcnt lgkmcnt(0)" ::: "memory");
                if (lane < 16) { const int row = row0 + lane; const float rs = pg8::rstd16(ssq2 + (size_t)row * 16); const LAS float* lr = lg + lane * 33;
                    float gl[4]; float gm = -INFINITY; int gi = 0;
#pragma unroll
                    for (int i = 0; i < 4; ++i) { gl[i] = lr[i] * rs + b_gr[i]; if (gl[i] > gm) { gm = gl[i]; gi = i; } }
                    float gs = 0.f;
#pragma unroll
                    for (int i = 0; i < 4; ++i) gs += __expf(gl[i] - gm);
                    const float gp = 1.f / gs;
                    float el[4];
#pragma unroll
                    for (int e = 0; e < 4; ++e) el[e] = lr[4 + gi * 4 + e] * rs + b_er[gi * 4 + e];
                    int e1 = 0; float m1 = el[0];
#pragma unroll
                    for (int e = 1; e < 4; ++e) if (el[e] > m1) { m1 = el[e]; e1 = e; }
                    int e2 = -1; float m2 = -INFINITY;
#pragma unroll
                    for (int e = 0; e < 4; ++e) if (e != e1 && el[e] > m2) { m2 = el[e]; e2 = e; }
                    const float p2 = __expf(m2 - m1), w1 = gp / (1.f + p2), w2 = gp * p2 / (1.f + p2);
                    const int ea = e1 < e2 ? e1 : e2, eb = e1 < e2 ? e2 : e1; const float wA = e1 < e2 ? w1 : w2, wB = e1 < e2 ? w2 : w1;
                    const int pr = (ea == 0) ? eb - 1 : (ea == 1) ? eb + 1 : 5, cls = gi * 6 + pr, lt = C.wave * 16 + lane;
                    selw[(size_t)row * 2] = wA; selw[(size_t)row * 2 + 1] = wB;
                    lcls[lt] = cls; lpos[lt] = __hip_atomic_fetch_add(lcnt + cls, 1, __ATOMIC_RELAXED, __HIP_MEMORY_SCOPE_WORKGROUP); }
            }
            __syncthreads();
            if (C.tid < 24) lbase[C.tid] = atomicAdd(gcnt + C.tid, lcnt[C.tid]);
            __syncthreads();
            if (C.tid < 128) { const int c = lcls[C.tid]; tlist[(size_t)c * NTOK + lbase[c] + lpos[C.tid]] = chunk * 128 + C.tid; }
            __syncthreads();
        }
    }
    }
    GRID_SYNC();
    LAS int* meta = (LAS int*)(lds + 146432 + 256);
    for (int rep_ = 0; rep_ < (int)((REP_MASK >> 10) & 1u) + 1; ++rep_) {
    {
        if (C.tid == 0) { int rb = 0, tb = 0;
            for (int c = 0; c < 24; ++c) { const int n = gcnt[c], nt = (n + 255) >> 8; meta[c] = n; meta[32 + c] = rb; meta[64 + c] = tb; rb += nt * 256; tb += nt; }
            meta[32 + 24] = rb; meta[64 + 24] = tb; }
        __syncthreads();
        const int total = meta[32 + 24];
        for (int R = gw; R < total; R += NGW) {
            int c = 0;
            for (int k = 1; k < 24; ++k) c += (R >= meta[32 + k]) ? 1 : 0;
            const int p = R - meta[32 + c]; u32x4 v0 = (u32x4){0u, 0u, 0u, 0u}, v1 = v0; int tok = -1; float rs = 0.f, wA = 0.f, wB = 0.f;
            if (p < meta[c]) { tok = tlist[(size_t)c * NTOK + p]; const u32x4* src = (const u32x4*)(X2b + (size_t)tok * D) + lane; v0 = src[0]; v1 = src[64];
                rs = pg8::rstd16(ssq2 + (size_t)tok * 16); wA = selw[(size_t)tok * 2]; wB = selw[(size_t)tok * 2 + 1]; }
            u32x4* dst = (u32x4*)(XG + (size_t)R * D) + lane; dst[0] = v0; dst[64] = v1;
            if (lane == 0) { rsg[R] = rs; wAg[R] = wA; wBg[R] = wB; tokg[R] = tok; }
        }
    }
    }
    GRID_SYNC();
    for (int rep_ = 0; rep_ < (int)((REP_MASK >> 11) & 1u) + 1; ++rep_) {
    { pg8::MoeOrder1 S{XG, Wg_t, Wu_t, meta, C.G, C.bid}; pg8::EpiMoeUp E{0, rsg, wAg, wBg, HID};
      pg8::gemm_phase<pg8::EpiMoeUp, pg8::MoeOrder1, true>((LAS unsigned char*)lds, pg8::Gemm{D, D, D}, S, E); }
    }
    GRID_SYNC();
    for (int rep_ = 0; rep_ < (int)((REP_MASK >> 12) & 1u) + 1; ++rep_) {
    { pg8::MoeOrder2 S{HID, Wd2, meta, C.G, C.bid}; pg8::EpiMoeDown E{0, tokg, X2b, X3b, ssq3};
      pg8::gemm_phase<pg8::EpiMoeDown, pg8::MoeOrder2, true>((LAS unsigned char*)lds, pg8::Gemm{512, 512, 512}, S, E); }
    }
    GRID_SYNC();
    for (int rep_ = 0; rep_ < (int)((REP_MASK >> 13) & 1u) + 1; ++rep_) {
    for (int r = gw; r < NTOK; r += NGW) final_row(r, lane, X3b, ssq3, norm_final, out);
    }
}

#undef gw
#undef lane
extern "C" void kernel_launch(void* const* d_in, const int* in_sizes, int n_in, void* d_out, int out_size, void* d_ws, size_t ws_size, hipStream_t stream) {
    static int grid = 0;
    if (grid == 0) {
        if (n_in != 29 || ws_size < WS_END) { fprintf(stderr, "kernel_launch: unexpected inputs (%d) or workspace (%zu)\n", n_in, ws_size); grid = -1; return; }
        int dev = 0, cus = 0, per_cu = 0;
        hipGetDevice(&dev); hipDeviceGetAttribute(&cus, hipDeviceAttributeMultiprocessorCount, dev);
        hipFuncSetAttribute((const void*)mk_fwd, hipFuncAttributeMaxDynamicSharedMemorySize, LDS_BYTES);
        hipOccupancyMaxActiveBlocksPerMultiprocessor(&per_cu, (const void*)mk_fwd, NTHREADS, LDS_BYTES);
        if (per_cu < 1) { fprintf(stderr, "kernel_launch: occupancy query says %d blocks per CU\n", per_cu); per_cu = 1; }
        if (per_cu > 1) per_cu = 1;
        grid = cus * per_cu;
    }
    if (grid < 0) return;
    if (hipMemsetAsync((char*)d_ws + WS_CTL + 4096, 0, 16384, stream) != hipSuccess) { fprintf(stderr, "kernel_launch: memset of the barrier words failed\n"); return; }
    Args a{};
    for (int i = 0; i < 29; ++i) a.in[i] = (const float*)d_in[i];
    a.out = (float*)d_out; a.ws = (unsigned char*)d_ws;
    void* kargs[] = {&a};
    hipError_t e = hipLaunchCooperativeKernel((const void*)mk_fwd, dim3(grid), dim3(NTHREADS), kargs, LDS_BYTES, stream);
    if (e != hipSuccess) fprintf(stderr, "cooperative launch failed: %s (grid %d)\n", hipGetErrorString(e), grid);
}
```

```cpp
#include <hip/hip_runtime.h>
#include <hip/hip_cooperative_groups.h>
#include <cstdio>
#include <cstdint>

typedef unsigned short bf16_t;
typedef short bf16x8 __attribute__((ext_vector_type(8)));
typedef float f32x4 __attribute__((ext_vector_type(4)));
typedef unsigned u32x4 __attribute__((ext_vector_type(4)));

constexpr int D = 1024, BATCH = 8, SEQ = 4096, NTOK = BATCH * SEQ, MEM = 256, NMEM = BATCH * MEM;
constexpr int RW = 512, SBW = 512, PROJ = 2560, NH = 8, HD = 64;
constexpr int XH = 4, XD = 256, NG = 4, EPG = 4, NEXP = 16, DE = 256;
constexpr float EPS = 1e-6f, LOG2E = 1.4426950408889634f;

constexpr size_t MiB = 1u << 20;
constexpr size_t WS_CTL = 0;
constexpr size_t WS_SMALL = 1 * MiB;
constexpr size_t WS_WIN = 16 * MiB;
constexpr size_t WS_WOUT = 21 * MiB;
constexpr size_t WS_WQ = 23 * MiB;
constexpr size_t WS_WKV = 25 * MiB;
constexpr size_t WS_WO = 29 * MiB;
constexpr size_t WS_MEMN = 31 * MiB;
constexpr size_t WS_KVM = 35 * MiB;
constexpr size_t WS_WG = 43 * MiB;
constexpr size_t WS_WU = 51 * MiB;
constexpr size_t WS_WD2 = 59 * MiB;
constexpr size_t WS_R0 = 96 * MiB;
constexpr size_t WS_R1 = 160 * MiB;
constexpr size_t WS_R2 = 224 * MiB;
constexpr size_t WS_R3 = 288 * MiB;
constexpr size_t WS_R4 = 320 * MiB;
constexpr size_t WS_R5 = 384 * MiB;
constexpr size_t WS_END = 448 * MiB;

constexpr size_t SM_RSTD0 = 0;
constexpr size_t SM_SSQR = 1 * 32768;
constexpr size_t SM_SSQS = 2 * 32768;
constexpr size_t SM_SSQ1 = 10 * 32768;
constexpr size_t SM_SSQ2 = 26 * 32768;
constexpr size_t SM_SSQ3 = 42 * 32768;
constexpr size_t SM_SELW = 58 * 32768;
constexpr size_t SM_SELE = 60 * 32768;
constexpr size_t SM_END = 62 * 32768;

__device__ __forceinline__ unsigned f2bf(float f) { unsigned u = __builtin_bit_cast(unsigned, f); return (u + 0x7fffu + ((u >> 16) & 1u)) >> 16; }
__device__ __forceinline__ float bf2f(unsigned short h) { return __builtin_bit_cast(float, (unsigned)h << 16); }
__device__ __forceinline__ float wave_sum(float v) {
#pragma unroll
    for (int o = 1; o < 64; o <<= 1) v += __shfl_xor(v, o);
    return v;
}
__device__ __forceinline__ float gelu_tanh(float x) { const float u = 0.7978845608028654f * (x + 0.044715f * x * x * x); return x * __builtin_amdgcn_rcpf(1.f + __expf(-2.f * u)); }
__device__ __forceinline__ float sigmoidf_(float x) { return 1.f / (1.f + __expf(-x)); }

namespace cg = cooperative_groups;
#ifndef PROBE_A
#define PROBE_A -1
#endif
#ifndef REP_MASK
#define REP_MASK 0u
#endif
#define LAS __attribute__((address_space(3)))
constexpr int NWAVES = 8, NTHREADS = 512;
constexpr int LDS_BYTES = 147456;

struct Args { const float* in[29]; float* out; unsigned char* ws; };

struct Ctx {
    const float* in[29]; float* out; unsigned char* ws; unsigned char* lds;
    int tid, lane, wave, gw, NGW, G, bid;
};

#define RLX_AGENT __ATOMIC_RELAXED, __HIP_MEMORY_SCOPE_AGENT
#define XB_TMO      128
#define XB_XCNT(j)  (256  + 64 * (j))
#define XB_XSUB(j)  (1280 + 64 * (j))
#define XB_XGEN(j)  (2304 + 64 * (j))
#define XB_TOP      3328
#define XB_TOPGEN   3392
#define XCD_BAR_WORDS 3456
#define XB_SPIN_CAP (1u << 18)

__device__ __forceinline__ unsigned xb_ld(unsigned* p)              { return __hip_atomic_load(p, __ATOMIC_RELAXED, __HIP_MEMORY_SCOPE_AGENT); }
__device__ __forceinline__ unsigned xb_add(unsigned* p, unsigned v) { return __hip_atomic_fetch_add(p, v, __ATOMIC_RELAXED, __HIP_MEMORY_SCOPE_AGENT); }
__device__ __forceinline__ unsigned xb_xcc_id() { return (unsigned)__builtin_amdgcn_s_getreg((3 << 11) | 20) & 0xFu; }
#define XB_SPIN(cond, bar) do { unsigned _sp = 0; while (cond) { __builtin_amdgcn_s_sleep(1); \
    if ((++_sp & 255u) == 0u) { if (xb_ld(&(bar)[XB_TMO])) break; if (_sp > XB_SPIN_CAP) { atomicAdd(&(bar)[XB_TMO], 1u); break; } } } } while (0)

struct XcdBarrier {
    unsigned* bar; unsigned x;
    volatile LAS unsigned* st;
};

__device__ __forceinline__ XcdBarrier xcd_barrier_post(unsigned* bar, volatile LAS unsigned* st) {
    XcdBarrier b; b.bar = bar; b.x = xb_xcc_id(); b.st = st;
    if (threadIdx.x == 0) (void)xb_add(&bar[XB_XCNT(b.x)], 1u);
    return b;
}
__device__ __forceinline__ void xcd_barrier_complete(unsigned* bar, unsigned x, unsigned& nloc, unsigned& nx) {
    const unsigned G = gridDim.x * gridDim.y * gridDim.z;
    unsigned sum, cnt, mine, sp = 0u;
    for (;;) {
        sum = 0u; cnt = 0u; mine = 0u;
#pragma unroll
        for (unsigned j = 0; j < 16; ++j) { const unsigned c = xb_ld(&bar[XB_XCNT(j)]); sum += c; cnt += (c > 0u) ? 1u : 0u; mine = (j == x) ? c : mine; }
        if (sum == G) break;
        __builtin_amdgcn_s_sleep(1);
        if ((++sp & 255u) == 0u) { if (xb_ld(&bar[XB_TMO])) break; if (sp > XB_SPIN_CAP) { atomicAdd(&bar[XB_TMO], 1u); break; } }
    }
    nloc = mine > 0u ? mine : 1u; nx = cnt > 0u ? cnt : 1u;
}

__device__ __forceinline__ void xcd_barrier(const XcdBarrier& b) {
    asm volatile("s_waitcnt vmcnt(0)" ::: "memory");
    __syncthreads();
    if (threadIdx.x == 0) {
        unsigned* bar = b.bar;
        __builtin_amdgcn_s_waitcnt(0);
        unsigned nloc = b.st[0], nx = b.st[1];
        if (nloc == 0u) { xcd_barrier_complete(bar, b.x, nloc, nx); b.st[0] = nloc; b.st[1] = nx; }
        const unsigned old = xb_add(&bar[XB_XSUB(b.x)], 1u);
        const unsigned gen = old / nloc;
        if (old + 1u == (gen + 1u) * nloc) {
            __builtin_amdgcn_fence(__ATOMIC_RELEASE, "agent");
            asm volatile("s_waitcnt vmcnt(0)" ::: "memory");
            const unsigned og = xb_add(&bar[XB_TOP], 1u);
            const unsigned tg = og / nx;
            if (og + 1u == (tg + 1u) * nx) xb_add(&bar[XB_TOPGEN], 1u);
            else XB_SPIN(xb_ld(&bar[XB_TOPGEN]) == tg, bar);
            __builtin_amdgcn_fence(__ATOMIC_ACQUIRE, "agent");
            xb_add(&bar[XB_XGEN(b.x)], 1u);
            asm volatile("s_waitcnt vmcnt(0)" ::: "memory");
        } else {
            XB_SPIN(xb_ld(&bar[XB_XGEN(b.x)]) == gen, bar);
            __builtin_amdgcn_fence(__ATOMIC_ACQUIRE, "agent");
            asm volatile("s_waitcnt vmcnt(0)" ::: "memory");
        }
    }
    __syncthreads();
}
namespace pg8 {
#define PG8_LAS __attribute__((address_space(3)))
constexpr int BM = 256, BK = 64, HALF = 128, HTB = HALF * BK * 2  , STAGE_BYTES = 8 * HTB, NXCD = 8, WGM = 8;
__host__ __device__ __forceinline__ int lds_byte(int r, int c) { const int st = (r >> 4) * 2 + (c >> 5), rr = r & 15, cc = c & 31, ob = rr * 64 + cc * 2; return st * 1024 + (ob ^ (((ob >> 9) & 1) << 5)); }
__host__ __device__ __forceinline__ void stage_rc(int b, int& R, int& C) { const int st = b / 1024, sb = b % 1024, swz = sb ^ (((sb >> 9) & 1) << 5); R = (st >> 1) * 16 + swz / 64; C = (st & 1) * 32 + (swz % 64) / 2; }
__host__ __device__ __forceinline__ int perm32(int rho) { const int n = rho >> 4, i = rho & 15; return 8 * (i >> 2) + 4 * n + (i & 3); }

struct Unit { int pm, pn; };
struct Gemm { int lda, ldb, K; };
struct DenseOrder {
    const bf16_t* A; const bf16_t* Bt; int lda, ldb; int nM, nN, nwg, G, c; int ntk = D / BK;
    __device__ __forceinline__ int nt(const Unit&) const { return ntk; }
    __device__ void init(const bf16_t* A_, int lda_, const bf16_t* Bt_, int ldb_, int M, int N, int G_, int c_) { A = A_; Bt = Bt_; lda = lda_; ldb = ldb_; nM = M / BM; nN = N / BM; nwg = nM * nN; G = G_; c = c_; }
    __device__ bool next(int i, Unit& u) const {
        const long L = (long)i * G + c; if (L >= nwg) return false;
        int wgid = (int)L; { const int q = nwg / NXCD, r = nwg % NXCD, xcd = wgid % NXCD, off = wgid / NXCD; wgid = (xcd < r ? xcd * (q + 1) : r * (q + 1) + (xcd - r) * q) + off; }
        const int nig = WGM * nN, gid = wgid / nig, fm = gid * WGM, gsz = (nM - fm) < WGM ? (nM - fm) : WGM;
        u.pm = fm + ((wgid % nig) % gsz); u.pn = (wgid % nig) / gsz; return true;
    }
    __device__ __forceinline__ void ptrs(const Unit& u, const char*& a, const char*& b0, const char*& b1) const {
        a = (const char*)A + (size_t)u.pm * BM * lda * 2; b0 = (const char*)Bt + (size_t)u.pn * BM * ldb * 2; b1 = b0 + (size_t)HALF * ldb * 2; }
};

__device__ __forceinline__ unsigned cvt_pk_bf16(float lo, float hi) { unsigned r; asm volatile("v_cvt_pk_bf16_f32 %0, %1, %2" : "=v"(r) : "v"(lo), "v"(hi)); return r; }

template <class Epi, class Sched, bool ALIGN_EPI>
__device__ __forceinline__ void gemm_phase(PG8_LAS unsigned char* lds, const Gemm g, const Sched& S, const Epi& E) {
    int tid_ = threadIdx.x; asm volatile("" : "+v"(tid_));
    const int tid = tid_, wid = __builtin_amdgcn_readfirstlane(tid >> 6), lane = tid & 63, wr = wid >> 2, wc = wid & 3, fr = lane & 15, fq = lane >> 4;
    unsigned voffA[2], voffB[2];
#pragma unroll
    for (int i = 0; i < 2; ++i) { int R, C; stage_rc(tid * 16 + i * 8192, R, C); const int Rb = Epi::PERM ? ((R & ~31) + perm32(R & 31)) : R;
        voffA[i] = (unsigned)(R * g.lda + C) * 2u; voffB[i] = (unsigned)(Rb * g.ldb + C) * 2u; }
    const size_t kstep = (size_t)(BK * 2);
    const size_t hstepA = (size_t)HALF * g.lda * 2;
    const unsigned ldsw = (unsigned)wid * 1024u;
    const int aoff = lds_byte(wr * 64 + fr, fq * 8), boff = lds_byte(wc * 32 + fr, fq * 8);
#define PG8_SA(b, h) (((b) * 2 + (h)) * HTB)
#define PG8_SB(b, h) ((4 + (b) * 2 + (h)) * HTB)
#define PG8_STAGE(bufoff, gbase, voff) do { _Pragma("unroll") for (int _i = 0; _i < 2; ++_i) \
        __builtin_amdgcn_global_load_lds((const unsigned*)((const char*)(gbase) + (voff)[_i]), (PG8_LAS unsigned*)(lds + (bufoff) + ldsw + _i * 8192), 16, 0, 0); } while (0)
#define PG8_LDA(dst, b, h) do { _Pragma("unroll") for (int m = 0; m < 4; ++m) _Pragma("unroll") for (int k = 0; k < 2; ++k) dst[m][k] = *(const PG8_LAS bf16x8*)(lds + PG8_SA(b, h) + aoff + m * 2048 + k * 1024); } while (0)
#define PG8_LDB(dst, b, h) do { _Pragma("unroll") for (int n = 0; n < 2; ++n) _Pragma("unroll") for (int k = 0; k < 2; ++k) dst[n][k] = *(const PG8_LAS bf16x8*)(lds + PG8_SB(b, h) + boff + n * 2048 + k * 1024); } while (0)
#define PG8_MMA(ai, bj, At, Bt) do { __builtin_amdgcn_s_setprio(1); _Pragma("unroll") for (int m = 0; m < 4; ++m) _Pragma("unroll") for (int n = 0; n < 2; ++n) _Pragma("unroll") for (int k = 0; k < 2; ++k) \
        acc[ai][bj][m][n] = __builtin_amdgcn_mfma_f32_16x16x32_bf16(Bt[n][k], At[m][k], acc[ai][bj][m][n], 0, 0, 0); __builtin_amdgcn_s_setprio(0); } while (0)
#define PG8_WAIT_V(n) asm volatile("s_waitcnt vmcnt(" #n ")" ::: "memory")
#define PG8_WAIT_L(n) asm volatile("s_waitcnt lgkmcnt(" #n ")" ::: "memory")
#define PG8_BAR __builtin_amdgcn_s_barrier()
#define PG8_SCHED __builtin_amdgcn_sched_barrier(0)
    Unit cur, nxt; int ui = 0;
    if (!S.next(0, cur)) return;
    f32x4 acc[2][2][4][2];
#pragma unroll
    for (int a = 0; a < 2; ++a)
#pragma unroll
        for (int b = 0; b < 2; ++b)
#pragma unroll
            for (int m = 0; m < 4; ++m)
#pragma unroll
                for (int n = 0; n < 2; ++n) acc[a][b][m][n] = (f32x4){0.f, 0.f, 0.f, 0.f};
    bf16x8 At[4][2], B0[2][2], B1[2][2];
    const char *cA, *cB0, *cB1; S.ptrs(cur, cA, cB0, cB1);
    int nt = S.nt(cur); asm volatile("" : "+s"(nt));
    PG8_STAGE(PG8_SB(0, 0), cB0, voffB); PG8_STAGE(PG8_SB(0, 1), cB1, voffB); PG8_STAGE(PG8_SA(0, 0), cA, voffA); PG8_STAGE(PG8_SA(0, 1), cA + hstepA, voffA);
    if (wr == 1) PG8_BAR;
    PG8_WAIT_V(2); PG8_BAR;
    PG8_STAGE(PG8_SB(1, 0), cB0 + kstep, voffB); PG8_STAGE(PG8_SA(1, 0), cA + kstep, voffA); PG8_STAGE(PG8_SB(1, 1), cB1 + kstep, voffB);
    PG8_WAIT_V(6); PG8_BAR;
    for (;;) {
        const bool has_next = S.next(ui + 1, nxt);
        const char *nA = cA, *nB0 = cB0, *nB1 = cB1; if (has_next) S.ptrs(nxt, nA, nB0, nB1);
#pragma unroll 1
        for (int t = 0; t < nt; t += 2) {
            const bool last = (t == nt - 2);
            if constexpr (Epi::HAS_MID) { if (t == E.mid_t) E.mid(acc, cur, wr, wc, fr, fq); }
            const char* a1 = cA + (size_t)(t + 1) * kstep;
            const char* a2 = last ? nA : cA + (size_t)(t + 2) * kstep; const char* b2 = last ? nB0 : cB0 + (size_t)(t + 2) * kstep; const char* b2h = last ? nB1 : cB1 + (size_t)(t + 2) * kstep;
            const char* a3 = a2 + kstep; const char* b3 = b2 + kstep; const char* b3h = b2h + kstep;
            PG8_LDB(B0, 0, 0); PG8_LDB(B1, 0, 1); PG8_SCHED; PG8_LDA(At, 0, 0); PG8_STAGE(PG8_SA(1, 1), a1 + hstepA, voffA);
            PG8_WAIT_V(8); PG8_WAIT_L(0); PG8_BAR; PG8_MMA(0, 0, At, B0); PG8_MMA(0, 1, At, B1); PG8_BAR; PG8_SCHED;
            PG8_LDA(At, 0, 1); PG8_STAGE(PG8_SB(0, 0), b2, voffB); PG8_STAGE(PG8_SB(0, 1), b2h, voffB); PG8_STAGE(PG8_SA(0, 0), a2, voffA);
            PG8_WAIT_V(8); PG8_WAIT_L(0); PG8_BAR; PG8_MMA(1, 0, At, B0); PG8_MMA(1, 1, At, B1); PG8_BAR; PG8_SCHED;
            PG8_LDB(B0, 1, 0); PG8_LDB(B1, 1, 1); PG8_SCHED; PG8_LDA(At, 1, 0); PG8_STAGE(PG8_SA(0, 1), a2 + hstepA, voffA);
            PG8_WAIT_V(8); PG8_WAIT_L(0); PG8_BAR; PG8_MMA(0, 0, At, B0); PG8_MMA(0, 1, At, B1); PG8_BAR; PG8_SCHED;
            PG8_LDA(At, 1, 1); PG8_STAGE(PG8_SB(1, 0), b3, voffB); PG8_STAGE(PG8_SB(1, 1), b3h, voffB); PG8_STAGE(PG8_SA(1, 0), a3, voffA);
            PG8_WAIT_V(8); PG8_WAIT_L(0); PG8_BAR; PG8_MMA(1, 0, At, B0); PG8_MMA(1, 1, At, B1); PG8_BAR; PG8_SCHED;
        }
        if constexpr (ALIGN_EPI) { if (wr == 0) PG8_BAR; }
        E(acc, cur, wr, wc, fr, fq);
        if (!has_next) break;
#pragma unroll
        for (int a = 0; a < 2; ++a)
#pragma unroll
            for (int b = 0; b < 2; ++b)
#pragma unroll
                for (int m = 0; m < 4; ++m)
#pragma unroll
                    for (int n = 0; n < 2; ++n) acc[a][b][m][n] = (f32x4){0.f, 0.f, 0.f, 0.f};
        cur = nxt; cA = nA; cB0 = nB0; cB1 = nB1; ++ui; nt = S.nt(cur); asm volatile("" : "+s"(nt));
        if constexpr (ALIGN_EPI) { if (wr == 1) PG8_BAR; }
    }
    PG8_WAIT_V(0);
    if constexpr (!ALIGN_EPI) { if (wr == 0) PG8_BAR; }
    PG8_BAR;
#undef PG8_SA
#undef PG8_SB
#undef PG8_STAGE
#undef PG8_LDA
#undef PG8_LDB
#undef PG8_MMA
#undef PG8_WAIT_V
#undef PG8_WAIT_L
#undef PG8_BAR
#undef PG8_SCHED
}

__device__ __forceinline__ float rstd16(const float* p) { const f32x4 a = ((const f32x4*)p)[0], b = ((const f32x4*)p)[1], c = ((const f32x4*)p)[2], d = ((const f32x4*)p)[3];
    const float s = ((a.x + a.y) + (a.z + a.w)) + ((b.x + b.y) + (b.z + b.w)) + ((c.x + c.y) + (c.z + c.w)) + ((d.x + d.y) + (d.z + d.w)); return __builtin_amdgcn_rsqf(s * (1.f / D) + EPS); }
__device__ __forceinline__ u32x4 pack8(const f32x4 v0, const f32x4 v1) { u32x4 w; w.x = cvt_pk_bf16(v0[0], v0[1]); w.y = cvt_pk_bf16(v0[2], v0[3]); w.z = cvt_pk_bf16(v1[0], v1[1]); w.w = cvt_pk_bf16(v1[2], v1[3]); return w; }
__device__ __forceinline__ float sq8(const f32x4 a, const f32x4 b) { return ((a[0] * a[0] + a[1] * a[1]) + (a[2] * a[2] + a[3] * a[3])) + ((b[0] * b[0] + b[1] * b[1]) + (b[2] * b[2] + b[3] * b[3])); }

struct EpiInProjF {
    static constexpr bool PERM = true, HAS_MID = false; int mid_t;
    const float* rstd0; bf16_t *XR, *GG, *Qs, *Ks, *Vs; unsigned* kmax;
    __device__ __forceinline__ void mid(f32x4 (&)[2][2][4][2], const Unit&, int, int, int, int) const {}
    __device__ __forceinline__ void operator()(const f32x4 (&acc)[2][2][4][2], const Unit& u, int wr, int wc, int fr, int fq) const {
        const int row0 = u.pm * BM + wr * 64 + fr, t = u.pn >> 1, colt = (u.pn & 1) * 256 + wc * 32 + 8 * fq;
        bf16_t* base = (t == 0) ? XR : (t == 1) ? GG : (t == 2) ? Qs : (t == 3) ? Ks : Vs;
        float km0 = 0.f, km1 = 0.f;
#pragma unroll
        for (int ai = 0; ai < 2; ++ai)
#pragma unroll
            for (int m = 0; m < 4; ++m) { const int r = row0 + ai * HALF + m * 16; const float rs = rstd0[r]; bf16_t* rowp = base + (size_t)r * 512 + colt;
#pragma unroll
                for (int bj = 0; bj < 2; ++bj) { f32x4 v0 = acc[ai][bj][m][0] * rs, v1 = acc[ai][bj][m][1] * rs;
                    if (t == 1) {
#pragma unroll
                        for (int e = 0; e < 4; ++e) { v0[e] = gelu_tanh(v0[e]); v1[e] = gelu_tanh(v1[e]); } }
                    else if (t == 2) { v0 = v0 * (0.125f * LOG2E); v1 = v1 * (0.125f * LOG2E); }
                    else if (t == 3) { float mx = 0.f;
#pragma unroll
                        for (int e = 0; e < 4; ++e) mx = fmaxf(mx, fmaxf(fabsf(v0[e]), fabsf(v1[e])));
                        if (bj == 0) km0 = fmaxf(km0, mx); else km1 = fmaxf(km1, mx); }
                    *(u32x4*)(rowp + bj * HALF) = pack8(v0, v1); } }
        if (t == 3) {
#pragma unroll
            for (int o = 1; o < 64; o <<= 1) { km0 = fmaxf(km0, __shfl_xor(km0, o)); km1 = fmaxf(km1, __shfl_xor(km1, o)); }
            if ((fr | fq) == 0) { const int b = (u.pm * BM) / SEQ, hd = (u.pn & 1) * 4 + (wc >> 1);
                atomicMax(kmax + b * 8 + hd, __float_as_uint(km0)); atomicMax(kmax + b * 8 + hd + 2, __float_as_uint(km1)); }
        }
    }
};
struct EpiBf16F {
    static constexpr bool PERM = true, HAS_MID = false; int mid_t;
    bf16_t* O; const float* ssq16; int ldo; float scale; size_t tstride;
    __device__ __forceinline__ void mid(f32x4 (&)[2][2][4][2], const Unit&, int, int, int, int) const {}
    __device__ __forceinline__ void operator()(const f32x4 (&acc)[2][2][4][2], const Unit& u, int wr, int wc, int fr, int fq) const {
        const int row0 = u.pm * BM + wr * 64 + fr, col0 = (tstride ? 0 : u.pn * BM) + wc * 32 + 8 * fq; bf16_t* base = O + (size_t)u.pn * tstride;
#pragma unroll
        for (int ai = 0; ai < 2; ++ai)
#pragma unroll
            for (int m = 0; m < 4; ++m) { const int r = row0 + ai * HALF + m * 16; const float rs = (ssq16 ? rstd16(ssq16 + (size_t)r * 16) : 1.f) * scale; bf16_t* rowp = base + (size_t)r * ldo + col0;
#pragma unroll
                for (int bj = 0; bj < 2; ++bj) *(u32x4*)(rowp + bj * HALF) = pack8(acc[ai][bj][m][0] * rs, acc[ai][bj][m][1] * rs); }
    }
};
struct EpiX1F {
    static constexpr bool PERM = true, HAS_MID = true; int mid_t;
    const bf16_t* xb; const float* fmid; const float* fend; bf16_t* X1b; float* ssq1;
    __device__ __forceinline__ void mid(f32x4 (&acc)[2][2][4][2], const Unit& u, int wr, int wc, int fr, int fq) const {
        const int row0 = u.pm * BM + wr * 64 + fr;
#pragma unroll
        for (int ai = 0; ai < 2; ++ai)
#pragma unroll
            for (int m = 0; m < 4; ++m) { const float f = fmid[row0 + ai * HALF + m * 16];
#pragma unroll
                for (int bj = 0; bj < 2; ++bj) { acc[ai][bj][m][0] = acc[ai][bj][m][0] * f; acc[ai][bj][m][1] = acc[ai][bj][m][1] * f; } }
    }
    __device__ __forceinline__ void operator()(const f32x4 (&acc)[2][2][4][2], const Unit& u, int wr, int wc, int fr, int fq) const {
        const int row0 = u.pm * BM + wr * 64 + fr, col0 = u.pn * BM + wc * 32 + 8 * fq;
#pragma unroll
        for (int ai = 0; ai < 2; ++ai)
#pragma unroll
            for (int m = 0; m < 4; ++m) { const int r = row0 + ai * HALF + m * 16; const float fe = fend[r]; float ss = 0.f;
#pragma unroll
                for (int bj = 0; bj < 2; ++bj) { const u32x4 xi = *(const u32x4*)(xb + (size_t)r * D + col0 + bj * HALF);
                    f32x4 v0, v1; v0[0] = __uint_as_float(xi.x << 16); v0[1] = __uint_as_float(xi.x & 0xffff0000u); v0[2] = __uint_as_float(xi.y << 16); v0[3] = __uint_as_float(xi.y & 0xffff0000u);
                    v1[0] = __uint_as_float(xi.z << 16); v1[1] = __uint_as_float(xi.z & 0xffff0000u); v1[2] = __uint_as_float(xi.w << 16); v1[3] = __uint_as_float(xi.w & 0xffff0000u);
                    v0 = v0 + acc[ai][bj][m][0] * fe; v1 = v1 + acc[ai][bj][m][1] * fe;
                    ss += sq8(v0, v1); *(u32x4*)(X1b + (size_t)r * D + col0 + bj * HALF) = pack8(v0, v1); }
                ss += __shfl_xor(ss, 16); ss += __shfl_xor(ss, 32);
                if (fq == 0) ssq1[(size_t)r * 16 + u.pn * 4 + wc] = ss; }
    }
};
struct EpiResF {
    static constexpr bool PERM = true, HAS_MID = false; int mid_t;
    const bf16_t* Xi; bf16_t* Xo; float* ssq;
    __device__ __forceinline__ void mid(f32x4 (&)[2][2][4][2], const Unit&, int, int, int, int) const {}
    __device__ __forceinline__ void operator()(const f32x4 (&acc)[2][2][4][2], const Unit& u, int wr, int wc, int fr, int fq) const {
        const int row0 = u.pm * BM + wr * 64 + fr, col0 = u.pn * BM + wc * 32 + 8 * fq;
#pragma unroll
        for (int ai = 0; ai < 2; ++ai)
#pragma unroll
            for (int m = 0; m < 4; ++m) { const int r = row0 + ai * HALF + m * 16; float ss = 0.f;
#pragma unroll
                for (int bj = 0; bj < 2; ++bj) { const u32x4 xi = *(const u32x4*)(Xi + (size_t)r * D + col0 + bj * HALF);
                    f32x4 v0, v1; v0[0] = __uint_as_float(xi.x << 16); v0[1] = __uint_as_float(xi.x & 0xffff0000u); v0[2] = __uint_as_float(xi.y << 16); v0[3] = __uint_as_float(xi.y & 0xffff0000u);
                    v1[0] = __uint_as_float(xi.z << 16); v1[1] = __uint_as_float(xi.z & 0xffff0000u); v1[2] = __uint_as_float(xi.w << 16); v1[3] = __uint_as_float(xi.w & 0xffff0000u);
                    v0 = v0 + acc[ai][bj][m][0]; v1 = v1 + acc[ai][bj][m][1];
                    ss += sq8(v0, v1); *(u32x4*)(Xo + (size_t)r * D + col0 + bj * HALF) = pack8(v0, v1); }
                ss += __shfl_xor(ss, 16); ss += __shfl_xor(ss, 32);
                if (fq == 0) ssq[(size_t)r * 16 + u.pn * 4 + wc] = ss; }
    }
};

__device__ __forceinline__ void pair_ab(int p, int& a, int& b) { a = (p < 3) ? 0 : (p < 5) ? 1 : 2; b = (p < 3) ? p + 1 : (p < 5) ? p - 1 : 3; }
__device__ __forceinline__ int moe_class_of_tile(const PG8_LAS int* meta, int T) { int c = 0;
#pragma unroll
    for (int k = 1; k < 24; ++k) c += (T >= __builtin_amdgcn_readfirstlane(meta[64 + k])) ? 1 : 0;
    return c; }
struct MoeOrder1 {
    __device__ __forceinline__ int nt(const Unit&) const { return D / BK; }
    const bf16_t* XG; const bf16_t* Wg; const bf16_t* Wu; const PG8_LAS int* meta; int G, c;
    __device__ bool next(int i, Unit& u) const { const int L = i * G + c, nt = __builtin_amdgcn_readfirstlane(meta[64 + 24]); if (L >= nt * 4) return false;
        u.pm = L >> 2; u.pn = moe_class_of_tile(meta, L >> 2) * 4 + (L & 3); return true; }
    __device__ __forceinline__ void ptrs(const Unit& u, const char*& a, const char*& b0, const char*& b1) const {
        const int cls = u.pn >> 2, j = (u.pn >> 1) & 1, half = u.pn & 1; int ea, eb; pair_ab(cls % 6, ea, eb); const int e = (cls / 6) * 4 + (j ? eb : ea);
        a = (const char*)XG + (size_t)u.pm * BM * D * 2; const size_t bo = ((size_t)e * DE + half * HALF) * D * 2; b0 = (const char*)Wg + bo; b1 = (const char*)Wu + bo; }
};
struct MoeOrder2 {
    __device__ __forceinline__ int nt(const Unit&) const { return 512 / BK; }
    const bf16_t* HID; const bf16_t* Wd2; const PG8_LAS int* meta; int G, c;
    __device__ bool next(int i, Unit& u) const { const int L = i * G + c, nt = __builtin_amdgcn_readfirstlane(meta[64 + 24]); if (L >= nt * 4) return false;
        u.pm = L >> 2; u.pn = moe_class_of_tile(meta, L >> 2) * 4 + (L & 3); return true; }
    __device__ __forceinline__ void ptrs(const Unit& u, const char*& a, const char*& b0, const char*& b1) const {
        a = (const char*)HID + (size_t)u.pm * BM * 512 * 2; b0 = (const char*)Wd2 + ((size_t)(u.pn >> 2) * D + (u.pn & 3) * BM) * 512 * 2; b1 = b0 + (size_t)HALF * 512 * 2; }
};
struct EpiMoeUp {
    static constexpr bool PERM = true, HAS_MID = false; int mid_t;
    const float* rsg; const float* wAg; const float* wBg; bf16_t* HID;
    __device__ __forceinline__ void mid(f32x4 (&)[2][2][4][2], const Unit&, int, int, int, int) const {}
    __device__ __forceinline__ void operator()(const f32x4 (&acc)[2][2][4][2], const Unit& u, int wr, int wc, int fr, int fq) const {
        const int row0 = u.pm * BM + wr * 64 + fr, j = (u.pn >> 1) & 1, col0 = j * 256 + (u.pn & 1) * HALF + wc * 32 + 8 * fq; const float* wg = j ? wBg : wAg;
#pragma unroll
        for (int ai = 0; ai < 2; ++ai)
#pragma unroll
            for (int m = 0; m < 4; ++m) { const int r = row0 + ai * HALF + m * 16; const float rs = rsg[r], w = wg[r]; f32x4 h0, h1;
#pragma unroll
                for (int e = 0; e < 4; ++e) { const float g0 = acc[ai][0][m][0][e] * rs, g1 = acc[ai][0][m][1][e] * rs;
                    h0[e] = g0 * __builtin_amdgcn_rcpf(1.f + __expf(-g0)) * (acc[ai][1][m][0][e] * rs) * w; h1[e] = g1 * __builtin_amdgcn_rcpf(1.f + __expf(-g1)) * (acc[ai][1][m][1][e] * rs) * w; }
                *(u32x4*)(HID + (size_t)r * 512 + col0) = pack8(h0, h1); }
    }
};
struct EpiMoeDown {
    static constexpr bool PERM = true, HAS_MID = false; int mid_t;
    const int* tokg; const bf16_t* Xi; bf16_t* Xo; float* ssq;
    __device__ __forceinline__ void mid(f32x4 (&)[2][2][4][2], const Unit&, int, int, int, int) const {}
    __device__ __forceinline__ void operator()(const f32x4 (&acc)[2][2][4][2], const Unit& u, int wr, int wc, int fr, int fq) const {
        const int row0 = u.pm * BM + wr * 64 + fr, ct = u.pn & 3, col0 = ct * BM + wc * 32 + 8 * fq;
#pragma unroll
        for (int ai = 0; ai < 2; ++ai)
#pragma unroll
            for (int m = 0; m < 4; ++m) { const int tok = tokg[row0 + ai * HALF + m * 16];
                if (tok >= 0) { float ss = 0.f;
#pragma unroll
                    for (int bj = 0; bj < 2; ++bj) { const u32x4 xi = *(const u32x4*)(Xi + (size_t)tok * D + col0 + bj * HALF);
                        f32x4 v0, v1; v0[0] = __uint_as_float(xi.x << 16); v0[1] = __uint_as_float(xi.x & 0xffff0000u); v0[2] = __uint_as_float(xi.y << 16); v0[3] = __uint_as_float(xi.y & 0xffff0000u);
                        v1[0] = __uint_as_float(xi.z << 16); v1[1] = __uint_as_float(xi.z & 0xffff0000u); v1[2] = __uint_as_float(xi.w << 16); v1[3] = __uint_as_float(xi.w & 0xffff0000u);
                        v0 = v0 + acc[ai][bj][m][0]; v1 = v1 + acc[ai][bj][m][1];
                        ss += sq8(v0, v1); *(u32x4*)(Xo + (size_t)tok * D + col0 + bj * HALF) = pack8(v0, v1); }
                    ss += __shfl_xor(ss, 16); ss += __shfl_xor(ss, 32);
                    if (fq == 0) ssq[(size_t)tok * 16 + ct * 4 + wc] = ss; } }
    }
};

struct XaChainOrder {
    const bf16_t* X1b; const bf16_t* Wq_t; const bf16_t* QX; const bf16_t* KM; const bf16_t* VT; int G, c, nu;
    __device__ void init(int G_, int c_) { G = G_; c = c_; const int tot = (NTOK / BM) * XH; nu = (tot - c + G - 1) / G; }
    __device__ bool next(int i, Unit& u) const { if (i >= 3 * nu) return false; const int kind = i / nu, L = (i % nu) * G + c; u.pm = L >> 2; u.pn = (L & 3) | (kind << 8); return true; }
    __device__ __forceinline__ int nt(const Unit& u) const { return (u.pn >> 8) == 0 ? D / BK : XD / BK; }
    __device__ __forceinline__ void ptrs(const Unit& u, const char*& a, const char*& b0, const char*& b1) const {
        const int kind = u.pn >> 8, h = u.pn & 3, b = u.pm / (SEQ / BM);
        if (kind == 0) { a = (const char*)X1b + (size_t)u.pm * BM * D * 2; b0 = (const char*)Wq_t + (size_t)h * XD * D * 2; }
        else { a = (const char*)QX + ((size_t)u.pm * BM * D + h * XD) * 2;
            b0 = (kind == 1) ? (const char*)KM + ((size_t)b * MEM * D + h * XD) * 2 : (const char*)VT + ((size_t)b * D + h * XD) * D * 2; }
        b1 = b0 + (size_t)HALF * D * 2; }
};
struct EpiXaChain {
    static constexpr bool PERM = true, HAS_MID = false; int mid_t;
    bf16_t* QX; bf16_t* OX; const float* ssq1; float qscale; PG8_LAS float* xch;
    __device__ __forceinline__ void mid(f32x4 (&)[2][2][4][2], const Unit&, int, int, int, int) const {}
    __device__ __forceinline__ void operator()(f32x4 (&acc)[2][2][4][2], const Unit& u, int wr, int wc, int fr, int fq) const {
        const int kind = u.pn >> 8, row0 = u.pm * BM + wr * 64 + fr, col0 = (u.pn & 3) * XD + wc * 32 + 8 * fq;
        if (kind != 1) {
            bf16_t* O = kind == 0 ? QX : OX;
#pragma unroll
            for (int ai = 0; ai < 2; ++ai)
#pragma unroll
                for (int m = 0; m < 4; ++m) { const int r = row0 + ai * HALF + m * 16; const float rs = kind == 0 ? rstd16(ssq1 + (size_t)r * 16) * qscale : 1.f; bf16_t* rowp = O + (size_t)r * D + col0;
#pragma unroll
                    for (int bj = 0; bj < 2; ++bj) *(u32x4*)(rowp + bj * HALF) = pack8(acc[ai][bj][m][0] * rs, acc[ai][bj][m][1] * rs); }
            return;
        }
        PG8_LAS float* xm = xch; PG8_LAS float* xs = xch + 1024;
#pragma unroll
        for (int ai = 0; ai < 2; ++ai)
#pragma unroll
            for (int m = 0; m < 4; ++m) { float mx = -INFINITY;
#pragma unroll
                for (int bj = 0; bj < 2; ++bj)
#pragma unroll
                    for (int n = 0; n < 2; ++n) { const f32x4 v = acc[ai][bj][m][n]; mx = fmaxf(mx, fmaxf(fmaxf(v[0], v[1]), fmaxf(v[2], v[3]))); }
                mx = fmaxf(mx, __shfl_xor(mx, 16)); mx = fmaxf(mx, __shfl_xor(mx, 32));
                if (fq == 0) xm[(ai * HALF + wr * 64 + m * 16 + fr) * 4 + wc] = mx; asm volatile("" ::: "memory"); }
        asm volatile("s_waitcnt lgkmcnt(0)" ::: "memory"); __builtin_amdgcn_s_barrier(); asm volatile("" ::: "memory");
#pragma unroll
        for (int ai = 0; ai < 2; ++ai)
#pragma unroll
            for (int m = 0; m < 4; ++m) { const int rl = ai * HALF + wr * 64 + m * 16 + fr; const f32x4 q = *(const PG8_LAS f32x4*)(xm + rl * 4);
                const float mx = fmaxf(fmaxf(q[0], q[1]), fmaxf(q[2], q[3])); float ss = 0.f;
#pragma unroll
                for (int bj = 0; bj < 2; ++bj)
#pragma unroll
                    for (int n = 0; n < 2; ++n) { f32x4 v = acc[ai][bj][m][n];
#pragma unroll
                        for (int e = 0; e < 4; ++e) { v[e] = __builtin_amdgcn_exp2f(v[e] - mx); ss += v[e]; }
                        acc[ai][bj][m][n] = v; }
                ss += __shfl_xor(ss, 16); ss += __shfl_xor(ss, 32);
                if (fq == 0) xs[rl * 4 + wc] = ss; asm volatile("" ::: "memory"); }
        asm volatile("s_waitcnt lgkmcnt(0)" ::: "memory"); __builtin_amdgcn_s_barrier(); asm volatile("" ::: "memory");
#pragma unroll
        for (int ai = 0; ai < 2; ++ai)
#pragma unroll
            for (int m = 0; m < 4; ++m) { const int rl = ai * HALF + wr * 64 + m * 16 + fr; const f32x4 q = *(const PG8_LAS f32x4*)(xs + rl * 4);
                const float inv = __builtin_amdgcn_rcpf((q[0] + q[1]) + (q[2] + q[3])); bf16_t* rowp = QX + (size_t)(row0 + ai * HALF + m * 16) * D + col0;
#pragma unroll
                for (int bj = 0; bj < 2; ++bj) *(u32x4*)(rowp + bj * HALF) = pack8(acc[ai][bj][m][0] * inv, acc[ai][bj][m][1] * inv); asm volatile("" ::: "memory"); }
    }
};
struct KvOrder {
    __device__ __forceinline__ int nt(const Unit&) const { return D / BK; }
    const bf16_t* memn; const bf16_t* Wk_t; const bf16_t* Wv_t; int G, c;
    __device__ bool next(int i, Unit& u) const { const int L = i * G + c; if (L >= 64) return false; if (L < 32) { u.pm = L >> 2; u.pn = L & 3; } else { u.pm = (L - 32) >> 3; u.pn = ((L - 32) & 7) | 256; } return true; }
    __device__ __forceinline__ void ptrs(const Unit& u, const char*& a, const char*& b0, const char*& b1) const {
        const bool vt = (u.pn & 256) != 0; const int pn = u.pn & 255;
        a = (const char*)(vt ? Wv_t : memn) + (size_t)u.pm * BM * D * 2; b0 = (const char*)(vt ? memn : Wk_t) + (size_t)pn * BM * D * 2; b1 = b0 + (size_t)HALF * D * 2; }
};
struct EpiKv {
    static constexpr bool PERM = true, HAS_MID = false; int mid_t;
    bf16_t* KM; bf16_t* VT;
    __device__ __forceinline__ void mid(f32x4 (&)[2][2][4][2], const Unit&, int, int, int, int) const {}
    __device__ __forceinline__ void operator()(const f32x4 (&acc)[2][2][4][2], const Unit& u, int wr, int wc, int fr, int fq) const {
        const bool vt = (u.pn & 256) != 0; const int pn = u.pn & 255, row0 = u.pm * BM + wr * 64 + fr, cw = wc * 32 + 8 * fq;
        bf16_t* base = vt ? VT + (size_t)pn * D * D : KM + pn * BM; const int ldo = D;
#pragma unroll
        for (int ai = 0; ai < 2; ++ai)
#pragma unroll
            for (int m = 0; m < 4; ++m) { bf16_t* rowp = base + (size_t)(row0 + ai * HALF + m * 16) * ldo + cw;
#pragma unroll
                for (int bj = 0; bj < 2; ++bj) *(u32x4*)(rowp + bj * HALF) = pack8(acc[ai][bj][m][0], acc[ai][bj][m][1]); }
    }
};

struct EpiMoeFinal {
    static constexpr bool PERM = true, HAS_MID = false; int mid_t;
    const int* tokg; const bf16_t* Xi; float* out; float* ssq; unsigned* cnt; const float* g; PG8_LAS unsigned* flag; unsigned* tmo;
    __device__ __forceinline__ void mid(f32x4 (&)[2][2][4][2], const Unit&, int, int, int, int) const {}
    __device__ __forceinline__ void operator()(f32x4 (&acc)[2][2][4][2], const Unit& u, int wr, int wc, int fr, int fq) const {
        const int row0 = u.pm * BM + wr * 64 + fr, ct = u.pn & 3, col0 = ct * BM + wc * 32 + 8 * fq;
#pragma unroll
        for (int ai = 0; ai < 2; ++ai)
#pragma unroll
            for (int m = 0; m < 4; ++m) { const int tok = tokg[row0 + ai * HALF + m * 16];
                if (tok >= 0) { float ss = 0.f;
#pragma unroll
                    for (int bj = 0; bj < 2; ++bj) { const u32x4 xi = *(const u32x4*)(Xi + (size_t)tok * D + col0 + bj * HALF);
                        f32x4 v0, v1; v0[0] = __uint_as_float(xi.x << 16); v0[1] = __uint_as_float(xi.x & 0xffff0000u); v0[2] = __uint_as_float(xi.y << 16); v0[3] = __uint_as_float(xi.y & 0xffff0000u);
                        v1[0] = __uint_as_float(xi.z << 16); v1[1] = __uint_as_float(xi.z & 0xffff0000u); v1[2] = __uint_as_float(xi.w << 16); v1[3] = __uint_as_float(xi.w & 0xffff0000u);
                        v0 = v0 + acc[ai][bj][m][0]; v1 = v1 + acc[ai][bj][m][1]; acc[ai][bj][m][0] = v0; acc[ai][bj][m][1] = v1; ss += sq8(v0, v1); }
                    ss += __shfl_xor(ss, 16); ss += __shfl_xor(ss, 32);
                    if (fq == 0) __hip_atomic_store(ssq + (size_t)tok * 16 + ct * 4 + wc, ss, __ATOMIC_RELAXED, __HIP_MEMORY_SCOPE_AGENT); }
                asm volatile("" ::: "memory"); }
        asm volatile("s_waitcnt vmcnt(0) lgkmcnt(0)" ::: "memory"); __builtin_amdgcn_s_barrier(); asm volatile("" ::: "memory");
        const int tid = threadIdx.x;
        if (tid < 64) {
            if (tid == 0) __hip_atomic_fetch_add(cnt + 16 * u.pm, 1u, __ATOMIC_RELAXED, __HIP_MEMORY_SCOPE_AGENT);
            unsigned spins = 0; bool dead = false;
            while ((unsigned)__builtin_amdgcn_readfirstlane(__hip_atomic_load(cnt + 16 * u.pm, __ATOMIC_RELAXED, __HIP_MEMORY_SCOPE_AGENT)) < 4u) {
                __builtin_amdgcn_s_sleep(2); if (++spins > (1u << 20)) { dead = true; break; } }
            __builtin_amdgcn_fence(__ATOMIC_ACQUIRE, "agent");
            if (tid == 0) { flag[0] = dead ? 1u : 0u; if (dead) __hip_atomic_store(tmo, 1u, __ATOMIC_RELAXED, __HIP_MEMORY_SCOPE_AGENT); }
        }
        asm volatile("s_waitcnt vmcnt(0) lgkmcnt(0)" ::: "memory"); __builtin_amdgcn_s_barrier(); asm volatile("" ::: "memory");
        f32x4 gv[2][2];
#pragma unroll
        for (int bj = 0; bj < 2; ++bj) { gv[bj][0] = *(const f32x4*)(g + col0 + bj * HALF); gv[bj][1] = *(const f32x4*)(g + col0 + bj * HALF + 4); }
#pragma unroll
        for (int ai = 0; ai < 2; ++ai)
#pragma unroll
            for (int m = 0; m < 4; ++m) { const int tok = tokg[row0 + ai * HALF + m * 16];
                if (tok >= 0) { const float rs = rstd16(ssq + (size_t)tok * 16); float* orow = out + (size_t)tok * D + col0;
#pragma unroll
                    for (int bj = 0; bj < 2; ++bj) { *(f32x4*)(orow + bj * HALF) = acc[ai][bj][m][0] * rs * gv[bj][0]; *(f32x4*)(orow + bj * HALF + 4) = acc[ai][bj][m][1] * rs * gv[bj][1]; } }
                asm volatile("" ::: "memory"); }
    }
};
}
namespace sba {
typedef float f32x16 __attribute__((ext_vector_type(16)));
typedef short s16x4 __attribute__((ext_vector_type(4)));
typedef short v4i16_t __attribute__((ext_vector_type(4)));
typedef __attribute__((address_space(3))) const char* lds_cptr;
constexpr int SLOTB = 8192, L_K = 0, L_V = 2 * SLOTB, L_FLAG = 4 * SLOTB, L_OST = L_FLAG + 256, L_BYTES = L_OST + 8 * 4096;
__device__ __forceinline__ int crow(int r, int hi) { return (r & 3) + 8 * (r >> 2) + 4 * hi; }
__device__ __forceinline__ void glds16(const void* gsrc, unsigned lds_dst) { unsigned keep;
    asm volatile("s_mov_b32 %0, m0\n\ts_mov_b32 m0, %2\n\ts_nop 0\n\tglobal_load_lds_dwordx4 %1, off\n\ts_mov_b32 m0, %0" : "=&s"(keep) : "v"(gsrc), "s"(lds_dst) : "memory"); }
typedef float f32x2_t __attribute__((ext_vector_type(2))); typedef __bf16 bf16x2_t __attribute__((ext_vector_type(2)));
__device__ __forceinline__ unsigned cvtpk(float lo, float hi) { f32x2_t v = {lo, hi}; bf16x2_t b = __builtin_convertvector(v, bf16x2_t); return __builtin_bit_cast(unsigned, b); }
__device__ __forceinline__ s16x4 vtr(lds_cptr p) { return __builtin_bit_cast(s16x4, __builtin_amdgcn_ds_read_tr16_b64_v4i16((__attribute__((address_space(3))) v4i16_t*)p)); }

#define SBA_GROUP(Z, SP, g) do { \
        const float off_ = acc_ + (hi ? 0.f : gp_##SP[g]); acc_ += gs_##SP[g] + gp_##SP[g]; \
        const float c3_ = off_ + SP[4 * (g) + 3], c2_ = c3_ + SP[4 * (g) + 2], c1_ = c2_ + SP[4 * (g) + 1], c0_ = c1_ + SP[4 * (g)]; \
        Z[4 * (g) + 3] = __builtin_amdgcn_exp2f(Z[4 * (g) + 3] - c3_); Z[4 * (g) + 2] = __builtin_amdgcn_exp2f(Z[4 * (g) + 2] - c2_); \
        Z[4 * (g) + 1] = __builtin_amdgcn_exp2f(Z[4 * (g) + 1] - c1_); Z[4 * (g)] = __builtin_amdgcn_exp2f(Z[4 * (g)] - c0_); } while (0)

__device__ __forceinline__ void sb_unit(int b, int h, int qb, const bf16_t* Qs, const bf16_t* Ks, const bf16_t* Vs, bf16_t* YY, float* ssq_s8, const unsigned* kmax, char* shm) {
    int tid_ = threadIdx.x; asm volatile("" : "+v"(tid_));
    const int tid = tid_, lane = tid & 63, r32 = lane & 31, hi = lane >> 5; const int wid = __builtin_amdgcn_readfirstlane(tid >> 6);
    const size_t rowbase = (size_t)b * SEQ; const int q0 = qb * 256;
    const bf16_t* Kh = Ks + rowbase * SBW + h * HD; const bf16_t* Vh = Vs + rowbase * SBW + h * HD;
    const unsigned lds0 = (unsigned)(uintptr_t)shm;
    const lds_cptr shm3 = (lds_cptr)shm;
    const bf16_t* ksrc = Kh + (size_t)lane * SBW + wid * 8;
    const bf16_t* vsrc = Vh + (size_t)(16 * (wid & 3) + (lane >> 2)) * SBW + (wid >> 2) * 32 + (lane & 3) * 8;
    const unsigned kdst = lds0 + L_K + wid * 1024, vdst = lds0 + L_V + wid * 1024;
#define DMA_KV(t, slot) do { glds16(ksrc + (size_t)(t) * 64 * SBW, (unsigned)__builtin_amdgcn_readfirstlane(kdst + (slot))); glds16(vsrc + (size_t)(t) * 64 * SBW, (unsigned)__builtin_amdgcn_readfirstlane(vdst + (slot))); } while (0)
    const lds_cptr kp0 = shm3 + L_K + hi * 1024 + r32 * 16;
    const lds_cptr vp0 = shm3 + L_V + ((lane >> 4) & 1) * 32 + (lane & 3) * 8 + (4 * hi + ((lane & 15) >> 2)) * 64;
    volatile __attribute__((address_space(3))) unsigned* flags = (volatile __attribute__((address_space(3))) unsigned*)(shm3 + L_FLAG);
    int tile = 4 * qb + 3, slot = 0, it = 0;
    DMA_KV(tile, 0);
    const bf16_t* Qw = Qs + (rowbase + q0 + wid * 32 + r32) * SBW + h * HD;
    bf16x8 qr[4];
#pragma unroll
    for (int d0 = 0; d0 < 4; ++d0) qr[d0] = *(const bf16x8*)(Qw + d0 * 16 + hi * 8);
    float qn = 0.f;
#pragma unroll
    for (int d0 = 0; d0 < 4; ++d0)
#pragma unroll
        for (int e = 0; e < 8; ++e) qn += fabsf(bf2f((unsigned short)qr[d0][e]));
    qn += __shfl_xor(qn, 32);
    const float zmax = qn * __uint_as_float(kmax[b * 8 + h]) * 1.01f;
    const int tq = q0 + wid * 32 + r32;
    const int tq_min = q0 + wid * 32, tq_max = tq_min + 31;
    float R = 0.f;
    f32x16 o0 = {}, o1 = {};
    for (;;) {
        const bool has_next = tile > 0;
        if (has_next) { DMA_KV(tile - 1, slot ^ SLOTB); asm volatile("s_waitcnt vmcnt(2)" ::: "memory"); }
        else asm volatile("s_waitcnt vmcnt(0)" ::: "memory");
        __builtin_amdgcn_s_barrier(); asm volatile("" ::: "memory");
        const int kmin = tile * 64;
        if (kmin < tq_max) {
            f32x16 z0, z1;
            {
                const lds_cptr kb = kp0 + slot;
#pragma unroll
                for (int d0 = 0; d0 < 4; ++d0) {
                    const bf16x8 b0 = *(const __attribute__((address_space(3))) bf16x8*)(kb + d0 * 2048);
                    const bf16x8 b1 = *(const __attribute__((address_space(3))) bf16x8*)(kb + d0 * 2048 + 512);
                    if (d0 == 0) { z0 = __builtin_amdgcn_mfma_f32_32x32x16_bf16(b0, qr[0], (f32x16){}, 0, 0, 0); z1 = __builtin_amdgcn_mfma_f32_32x32x16_bf16(b1, qr[0], (f32x16){}, 0, 0, 0); }
                    else { z0 = __builtin_amdgcn_mfma_f32_32x32x16_bf16(b0, qr[d0], z0, 0, 0, 0); z1 = __builtin_amdgcn_mfma_f32_32x32x16_bf16(b1, qr[d0], z1, 0, 0, 0); }
                }
            }
            if (kmin + 63 >= tq_min) {
#pragma unroll
                for (int r = 0; r < 16; ++r) { const int kv = kmin + crow(r, hi); if (kv >= tq) z0[r] = -INFINITY; if (kv + 32 >= tq) z1[r] = -INFINITY; }
            }
            f32x16 s0, s1;
#pragma unroll
            for (int r = 0; r < 16; ++r) { z0[r] = fminf(z0[r], 120.f); z1[r] = fminf(z1[r], 120.f);
                s0[r] = __builtin_amdgcn_logf(1.f + __builtin_amdgcn_exp2f(z0[r])); s1[r] = __builtin_amdgcn_logf(1.f + __builtin_amdgcn_exp2f(z1[r])); }
            float gs_s0[4], gs_s1[4], gp_s0[4], gp_s1[4];
#pragma unroll
            for (int g = 0; g < 4; ++g) { gs_s0[g] = (s0[4 * g] + s0[4 * g + 1]) + (s0[4 * g + 2] + s0[4 * g + 3]); gs_s1[g] = (s1[4 * g] + s1[4 * g + 1]) + (s1[4 * g + 2] + s1[4 * g + 3]); }
#pragma unroll
            for (int g = 0; g < 4; ++g) { gp_s0[g] = __shfl_xor(gs_s0[g], 32); gp_s1[g] = __shfl_xor(gs_s1[g], 32); }
            float acc_ = R;
            SBA_GROUP(z1, s1, 3); SBA_GROUP(z1, s1, 2); SBA_GROUP(z1, s1, 1); SBA_GROUP(z1, s1, 0);
            SBA_GROUP(z0, s0, 3); SBA_GROUP(z0, s0, 2); SBA_GROUP(z0, s0, 1); SBA_GROUP(z0, s0, 0);
            R = acc_;
            u32x4 pw0, pw1, pw2, pw3;
            pw0 = (u32x4){cvtpk(z0[0], z0[1]), cvtpk(z0[2], z0[3]), cvtpk(z0[4], z0[5]), cvtpk(z0[6], z0[7])};
            pw1 = (u32x4){cvtpk(z0[8], z0[9]), cvtpk(z0[10], z0[11]), cvtpk(z0[12], z0[13]), cvtpk(z0[14], z0[15])};
            pw2 = (u32x4){cvtpk(z1[0], z1[1]), cvtpk(z1[2], z1[3]), cvtpk(z1[4], z1[5]), cvtpk(z1[6], z1[7])};
            pw3 = (u32x4){cvtpk(z1[8], z1[9]), cvtpk(z1[10], z1[11]), cvtpk(z1[12], z1[13]), cvtpk(z1[14], z1[15])};
            const lds_cptr vp = vp0 + slot;
#define SBA_PV(O, d0, ks, PW) do { const s16x4 lo_ = vtr(vp + (d0) * 4096 + (ks) * 1024), hi_ = vtr(vp + (d0) * 4096 + (ks) * 1024 + 512); \
                const bf16x8 vf_ = (bf16x8){lo_[0], lo_[1], lo_[2], lo_[3], hi_[0], hi_[1], hi_[2], hi_[3]}; \
                O = __builtin_amdgcn_mfma_f32_32x32x16_bf16(__builtin_bit_cast(bf16x8, PW), vf_, O, 0, 0, 0); } while (0)
            SBA_PV(o0, 0, 0, pw0); SBA_PV(o1, 1, 0, pw0); SBA_PV(o0, 0, 1, pw1); SBA_PV(o1, 1, 1, pw1);
            SBA_PV(o0, 0, 2, pw2); SBA_PV(o1, 1, 2, pw2); SBA_PV(o0, 0, 3, pw3); SBA_PV(o1, 1, 3, pw3);
#undef SBA_PV
        }
        const bool done = __all((zmax - R) < -150.f);
        if (lane == 0) flags[(it & 1) * 8 + wid] = done ? 1u : 0u;
        asm volatile("s_waitcnt lgkmcnt(0)" ::: "memory"); __builtin_amdgcn_s_barrier(); asm volatile("" ::: "memory");
        unsigned alld = 1u;
#pragma unroll
        for (int w = 0; w < 8; ++w) alld &= flags[(it & 1) * 8 + w];
        alld = __builtin_amdgcn_readfirstlane(alld);
        if (!has_next || alld) break;
        --tile; slot ^= SLOTB; ++it;
    }
    asm volatile("s_waitcnt vmcnt(0)" ::: "memory");
    {
        bf16_t* Ow = YY + (rowbase + q0 + wid * 32) * D + RW + h * HD;
        bf16_t* stg = (bf16_t*)(shm + L_OST) + wid * 2048;
#pragma unroll
        for (int r = 0; r < 16; ++r) { const int orow = crow(r, hi); stg[orow * 64 + r32] = (bf16_t)f2bf(o0[r]); stg[orow * 64 + 32 + r32] = (bf16_t)f2bf(o1[r]); }
        asm volatile("s_waitcnt lgkmcnt(0)" ::: "memory");
#pragma unroll
        for (int i = 0; i < 4; ++i) { const int row = i * 8 + (lane >> 3), ch = lane & 7; const u32x4 v = *(const u32x4*)(stg + row * 64 + ch * 8);
            *(u32x4*)(Ow + (size_t)row * D + ch * 8) = v;
            float ss = 0.f;
#pragma unroll
            for (int e = 0; e < 4; ++e) { const float lo = __uint_as_float(v[e] << 16), hh = __uint_as_float(v[e] & 0xffff0000u); ss += lo * lo + hh * hh; }
            ss += __shfl_xor(ss, 1); ss += __shfl_xor(ss, 2); ss += __shfl_xor(ss, 4);
            if (ch == 0) ssq_s8[(rowbase + q0 + wid * 32 + row) * 8 + h] = ss; }
    }
    asm volatile("s_waitcnt lgkmcnt(0)" ::: "memory"); __builtin_amdgcn_s_barrier(); asm volatile("" ::: "memory");
#undef DMA_KV
}
#undef SBA_GROUP
}
namespace lru {
typedef float f32x16 __attribute__((ext_vector_type(16)));
constexpr int XS_ROWS = 67, XS_BYTES = XS_ROWS * 1024  , XC_PITCH = 1040  , XC_OFF = 68608, HC_OFF = XC_OFF + 64 * XC_PITCH  , L_BYTES = HC_OFF + 2048;
__device__ __forceinline__ int crow(int r, int hi) { return (r & 3) + 8 * (r >> 2) + 4 * hi; }

struct Weights { bf16x8 wa[2][4], wx[2][4]; float ba[2], bx[2], spl[2]; };
__device__ __forceinline__ void load_weights(Weights& W, int h, int r32, int hi, const float* w_a, const float* b_a, const float* w_x, const float* b_x, const float* lam) {
#pragma unroll
    for (int nt = 0; nt < 2; ++nt) {
#pragma unroll
        for (int s = 0; s < 4; ++s) {
#pragma unroll
            for (int e = 0; e < 8; ++e) { const size_t idx = ((size_t)(h * 64 + 16 * s + 8 * hi + e)) * 64 + 32 * nt + r32;
                W.wa[nt][s][e] = (short)f2bf(w_a[idx]); W.wx[nt][s][e] = (short)f2bf(w_x[idx]); }
        }
        const int c = h * 64 + 32 * nt + r32; W.ba[nt] = b_a[c]; W.bx[nt] = b_x[c];
        const float l = lam[c]; W.spl[nt] = (l > 15.f) ? __expf(-l) : log1pf(__expf(-l));
    }
}

template <bool PASSB>
__device__ __forceinline__ void unit(int b, int chunk, const Weights& W, const bf16_t* XR, const bf16_t* GG, const float* conv_w, const float* conv_b,
                                     float* aggP, float* aggH, const float* ssq_s8, bf16_t* YY, float* fmid, float* fend, unsigned char* shm) {
    int tid_ = threadIdx.x; asm volatile("" : "+v"(tid_));
    const int tid = tid_, lane = tid & 63, r32 = lane & 31, hi = lane >> 5, wid = __builtin_amdgcn_readfirstlane(tid >> 6);
    LAS unsigned char* L = (LAS unsigned char*)shm;
#define LSTAMP(k) do { if (PROBE_A >= 200 && PASSB && blockIdx.x == 63 && b == 0 && tid == 0) ((LAS unsigned long long*)(shm + 147200))[16 + (k)] = __builtin_amdgcn_s_memrealtime(); } while (0)
    LSTAMP(0);
    const int t0 = chunk * 64; const size_t rowbase = (size_t)b * SEQ;
    f32x4 cp_[PASSB ? 8 : 1], cq_[PASSB ? 8 : 1];
    if (PASSB) {
        const f32x4* pP = (const f32x4*)(aggP + ((size_t)b * RW + tid) * 64); const f32x4* pH = (const f32x4*)(aggH + ((size_t)b * RW + tid) * 64);
#pragma unroll
        for (int i = 0; i < 8; ++i) { cp_[i] = pP[i]; cq_[i] = pH[i]; }
    }
    {
        u32x4 v[9];
#pragma unroll
        for (int k = 0; k < 9; ++k) { const int p = tid + k * NTHREADS, rr = p >> 6, pc = p & 63, t = t0 - 3 + rr;
            v[k] = (u32x4){0u, 0u, 0u, 0u}; if (p < XS_ROWS * 64 && t >= 0) v[k] = *(const u32x4*)(XR + (rowbase + t) * RW + pc * 8); }
#pragma unroll
        for (int k = 0; k < 9; ++k) { const int p = tid + k * NTHREADS; if (p < XS_ROWS * 64) *(LAS u32x4*)(L + (p >> 6) * 1024 + (p & 63) * 16) = v[k]; }
    }
    if (PASSB) {
        float hc = 0.f;
#pragma unroll
        for (int i = 0; i < 8; ++i)
#pragma unroll
            for (int e = 0; e < 4; ++e) { if (i * 4 + e < chunk) hc = cp_[i][e] * hc + cq_[i][e]; }
        if (chunk > 32) { const f32x4* pP = (const f32x4*)(aggP + ((size_t)b * RW + tid) * 64) + 8; const f32x4* pH = (const f32x4*)(aggH + ((size_t)b * RW + tid) * 64) + 8;
#pragma unroll
            for (int i = 0; i < 8; ++i) { cp_[i] = pP[i]; cq_[i] = pH[i]; }
#pragma unroll
            for (int i = 0; i < 8; ++i)
#pragma unroll
                for (int e = 0; e < 4; ++e) { if (32 + i * 4 + e < chunk) hc = cp_[i][e] * hc + cq_[i][e]; } }
        *(LAS float*)(L + HC_OFF + tid * 4) = hc;
    }
    __syncthreads();
    LSTAMP(1);
    {
        const int cp = tid & 255, th = tid >> 8, c0 = 2 * cp;
        const float w00 = conv_w[c0], w01 = conv_w[RW + c0], w02 = conv_w[2 * RW + c0], w03 = conv_w[3 * RW + c0], b0 = conv_b[c0];
        const float w10 = conv_w[c0 + 1], w11 = conv_w[RW + c0 + 1], w12 = conv_w[2 * RW + c0 + 1], w13 = conv_w[3 * RW + c0 + 1], b1 = conv_b[c0 + 1];
        const LAS unsigned* xs = (const LAS unsigned*)(L + (th * 32) * 1024 + cp * 4);
        unsigned u0 = xs[0], u1 = xs[256], u2 = xs[512];
        float a0 = __uint_as_float(u0 << 16), a1 = __uint_as_float(u1 << 16), a2 = __uint_as_float(u2 << 16);
        float c0_ = __uint_as_float(u0 & 0xffff0000u), c1_ = __uint_as_float(u1 & 0xffff0000u), c2_ = __uint_as_float(u2 & 0xffff0000u);
#pragma unroll 8
        for (int t = 0; t < 32; ++t) { const unsigned u3 = xs[(t + 3) * 256]; const float a3 = __uint_as_float(u3 << 16), c3_ = __uint_as_float(u3 & 0xffff0000u);
            const float y0 = w00 * a0 + w01 * a1 + w02 * a2 + w03 * a3 + b0, y1 = w10 * c0_ + w11 * c1_ + w12 * c2_ + w13 * c3_ + b1;
            *(LAS unsigned*)(L + XC_OFF + (th * 32 + t) * XC_PITCH + cp * 4) = f2bf(y0) | (f2bf(y1) << 16);
            a0 = a1; a1 = a2; a2 = a3; c0_ = c1_; c1_ = c2_; c2_ = c3_; }
    }
    __syncthreads();
    LSTAMP(2);
    const int h = wid;
    float Hc[2] = {0.f, 0.f}, Pc[2] = {1.f, 1.f};
    if (PASSB) {
#pragma unroll
        for (int nt = 0; nt < 2; ++nt) Hc[nt] = *(const LAS float*)(L + HC_OFF + (h * 64 + 32 * nt + r32) * 4);
    }
#pragma unroll
    for (int mt = 0; mt < 2; ++mt) {
        bf16x8 af[4];
#pragma unroll
        for (int s = 0; s < 4; ++s) af[s] = *(const LAS bf16x8*)(L + XC_OFF + (32 * mt + r32) * XC_PITCH + (h * 64 + 16 * s + 8 * hi) * 2);
#pragma unroll
        for (int nt = 0; nt < 2; ++nt) {
            f32x16 ra = {}, ri = {};
#pragma unroll
            for (int s = 0; s < 4; ++s) { ra = __builtin_amdgcn_mfma_f32_32x32x16_bf16(af[s], W.wa[nt][s], ra, 0, 0, 0); ri = __builtin_amdgcn_mfma_f32_32x32x16_bf16(af[s], W.wx[nt][s], ri, 0, 0, 0); }
            const int c = h * 64 + 32 * nt + r32;
#pragma unroll
            for (int r = 0; r < 16; ++r) { const int tok = 32 * mt + crow(r, hi);
                const float xc = bf2f(*(const LAS unsigned short*)(L + XC_OFF + tok * XC_PITCH + c * 2));
                const float rg = __builtin_amdgcn_rcpf(1.f + __expf(-(ra[r] + W.ba[nt]))), ig = __builtin_amdgcn_rcpf(1.f + __expf(-(ri[r] + W.bx[nt])));
                const float la = -8.0f * rg * W.spl[nt], a = __expf(la);
                ra[r] = a; ri[r] = __builtin_amdgcn_sqrtf(fmaxf(0.f, 1.f - a * a)) * (ig * xc); }
            float P[4], H[4], Pp[4], Hp[4];
#pragma unroll
            for (int g = 0; g < 4; ++g) { P[g] = (ra[4 * g] * ra[4 * g + 1]) * (ra[4 * g + 2] * ra[4 * g + 3]);
                H[g] = ((ri[4 * g] * ra[4 * g + 1] + ri[4 * g + 1]) * ra[4 * g + 2] + ri[4 * g + 2]) * ra[4 * g + 3] + ri[4 * g + 3]; }
#pragma unroll
            for (int g = 0; g < 4; ++g) { Pp[g] = __shfl_xor(P[g], 32); Hp[g] = __shfl_xor(H[g], 32); }
            float hc = Hc[nt], pc = Pc[nt];
#pragma unroll
            for (int g = 0; g < 4; ++g) { const float P0 = hi ? Pp[g] : P[g], H0 = hi ? Hp[g] : H[g], P1 = hi ? P[g] : Pp[g], H1 = hi ? H[g] : Hp[g];
                const float mid = P0 * hc + H0;
                if (PASSB) { float hh = hi ? mid : hc;
#pragma unroll
                    for (int k = 0; k < 4; ++k) { hh = ra[4 * g + k] * hh + ri[4 * g + k]; const int tok = 32 * mt + 8 * g + 4 * hi + k;
                        *(LAS unsigned short*)(L + tok * 1024 + c * 2) = (unsigned short)f2bf(hh); } }
                hc = P1 * mid + H1; pc = pc * (P0 * P1); }
            Hc[nt] = hc; Pc[nt] = pc;
        }
    }
    if (!PASSB) {
        if (hi == 0) {
#pragma unroll
            for (int nt = 0; nt < 2; ++nt) { const int c = h * 64 + 32 * nt + r32; aggP[((size_t)b * RW + c) * 64 + chunk] = Pc[nt]; aggH[((size_t)b * RW + c) * 64 + chunk] = Hc[nt]; }
        }
        __syncthreads();
    } else {
        LSTAMP(3);
        __syncthreads();
        LSTAMP(4);
        u32x4 gv[8]; float sv[8];
#pragma unroll
        for (int i = 0; i < 8; ++i) { const size_t row = rowbase + t0 + i * 8 + wid; gv[i] = *(const u32x4*)(GG + row * RW + lane * 8); sv[i] = ssq_s8[row * 8 + (lane & 7)]; }
#pragma unroll
        for (int i = 0; i < 8; ++i) { const int rr = i * 8 + wid; const size_t row = rowbase + t0 + rr;
            const u32x4 hv = *(const LAS u32x4*)(L + rr * 1024 + lane * 16); const u32x4 g4 = gv[i];
            f32x4 y0, y1;
            y0[0] = __uint_as_float(hv.x << 16) * __uint_as_float(g4.x << 16); y0[1] = __uint_as_float(hv.x & 0xffff0000u) * __uint_as_float(g4.x & 0xffff0000u);
            y0[2] = __uint_as_float(hv.y << 16) * __uint_as_float(g4.y << 16); y0[3] = __uint_as_float(hv.y & 0xffff0000u) * __uint_as_float(g4.y & 0xffff0000u);
            y1[0] = __uint_as_float(hv.z << 16) * __uint_as_float(g4.z << 16); y1[1] = __uint_as_float(hv.z & 0xffff0000u) * __uint_as_float(g4.z & 0xffff0000u);
            y1[2] = __uint_as_float(hv.w << 16) * __uint_as_float(g4.w << 16); y1[3] = __uint_as_float(hv.w & 0xffff0000u) * __uint_as_float(g4.w & 0xffff0000u);
            *(u32x4*)(YY + row * D + lane * 8) = pg8::pack8(y0, y1);
            float ss = pg8::sq8(y0, y1), s2 = sv[i];
#pragma unroll
            for (int o = 1; o < 64; o <<= 1) ss += __shfl_xor(ss, o);
            s2 += __shfl_xor(s2, 1); s2 += __shfl_xor(s2, 2); s2 += __shfl_xor(s2, 4);
            if (lane == 0) { const float rrn = 1.0f / sqrtf(ss * (1.f / RW) + EPS), rs = 1.0f / sqrtf(s2 * (1.f / SBW) + EPS); fmid[row] = rrn / rs; fend[row] = rs; } }
        __syncthreads();
        LSTAMP(5);
    }
#undef LSTAMP
}
}
__device__ __forceinline__ void row_prep_x(const float* x, bf16_t* xb, float* rstd0, int row, int lane) {
    const f32x4* xr = (const f32x4*)(x + (size_t)row * D) + lane;
    float s = 0.f; f32x4 v[4];
#pragma unroll
    for (int j = 0; j < 4; ++j) { v[j] = xr[64 * j]; s += v[j].x * v[j].x + v[j].y * v[j].y + v[j].z * v[j].z + v[j].w * v[j].w; }
    s = wave_sum(s);
    if (lane == 0) rstd0[row] = 1.0f / sqrtf(s * (1.f / D) + EPS);
    unsigned long long* o8 = (unsigned long long*)(xb + (size_t)row * D) + lane;
#pragma unroll
    for (int j = 0; j < 4; ++j) o8[64 * j] = (unsigned long long)(f2bf(v[j].x) | (f2bf(v[j].y) << 16)) | ((unsigned long long)(f2bf(v[j].z) | (f2bf(v[j].w) << 16)) << 32);
}
__device__ __forceinline__ void row_prep_mem(const float* m, const float* g, bf16_t* o, int row, int lane) {
    const f32x4* xr = (const f32x4*)(m + (size_t)row * D) + lane;
    float s = 0.f; f32x4 v[4];
#pragma unroll
    for (int j = 0; j < 4; ++j) { v[j] = xr[64 * j]; s += v[j].x * v[j].x + v[j].y * v[j].y + v[j].z * v[j].z + v[j].w * v[j].w; }
    s = wave_sum(s);
    const float r = 1.0f / sqrtf(s * (1.f / D) + EPS);
    unsigned long long* o8 = (unsigned long long*)(o + (size_t)row * D) + lane;
#pragma unroll
    for (int j = 0; j < 4; ++j) { const f32x4 gg = ((const f32x4*)g)[64 * j + lane];
        o8[64 * j] = (unsigned long long)(f2bf(v[j].x * r * gg.x) | (f2bf(v[j].y * r * gg.y) << 16)) | ((unsigned long long)(f2bf(v[j].z * r * gg.z) | (f2bf(v[j].w * r * gg.w) << 16)) << 32); }
}
__device__ __forceinline__ void transpose_item(const float* W, int K, int N, bf16_t* Wt, int ldt, const float* g0, const float* g1, int ksplit, LAS float* scr, int item, int lane) {
    const int nblk = N / 32, kb = item / nblk, nb = item % nblk, k0 = 64 * kb, n0 = 32 * nb;
#pragma unroll 8
    for (int i = 0; i < 32; ++i) { const int kk = 2 * i + (lane >> 5), k = k0 + kk; float gv = 1.f; if (g0) gv = (k < ksplit) ? g0[k] : g1[k - ksplit];
        scr[kk * 33 + (lane & 31)] = W[(size_t)k * N + n0 + (lane & 31)] * gv; }
    asm volatile("s_waitcnt lgkmcnt(0)" ::: "memory");
    const int c = lane & 7;
#pragma unroll
    for (int j = 0; j < 4; ++j) { const int n = (lane >> 3) + 8 * j; const LAS float* s = scr + (8 * c) * 33 + n;
        u32x4 o; o.x = f2bf(s[0 * 33]) | (f2bf(s[1 * 33]) << 16); o.y = f2bf(s[2 * 33]) | (f2bf(s[3 * 33]) << 16); o.z = f2bf(s[4 * 33]) | (f2bf(s[5 * 33]) << 16); o.w = f2bf(s[6 * 33]) | (f2bf(s[7 * 33]) << 16);
        *(u32x4*)(Wt + (size_t)(n0 + n) * ldt + k0 + 8 * c) = o; }
    asm volatile("s_waitcnt lgkmcnt(0)" ::: "memory");
}

struct MidScale { const float* f; int k; int pad; };
template <class Epi>
__device__ __forceinline__ void gemm_naive(const Ctx& C, const bf16_t* A, int lda, const bf16_t* Bt, int ldb, int M, int N, int K, MidScale ms, const Epi& E) {
    const int lane = C.lane, fr = lane & 15, fq = lane >> 4, ncol = N / 64, ntile = (M / 16) * ncol;
    for (int t = C.gw; t < ntile; t += C.NGW) {
        const int row0 = (t / ncol) * 16, col0 = (t % ncol) * 64;
        const bf16_t* ap = A + (size_t)(row0 + fr) * lda + fq * 8;
        const bf16_t* bp = Bt + (size_t)(col0 + fr) * ldb + fq * 8;
        f32x4 acc[4];
#pragma unroll
        for (int n = 0; n < 4; ++n) acc[n] = (f32x4){0.f, 0.f, 0.f, 0.f};
        for (int k0 = 0; k0 < K; k0 += 32) {
            if (ms.f && k0 == ms.k) {
#pragma unroll
                for (int j = 0; j < 4; ++j) { const float f = ms.f[row0 + fq * 4 + j];
#pragma unroll
                    for (int n = 0; n < 4; ++n) acc[n][j] *= f; }
            }
            const bf16x8 a = *(const bf16x8*)(ap + k0);
#pragma unroll
            for (int n = 0; n < 4; ++n) { const bf16x8 b = *(const bf16x8*)(bp + (size_t)n * 16 * ldb + k0); acc[n] = __builtin_amdgcn_mfma_f32_16x16x32_bf16(a, b, acc[n], 0, 0, 0); }
        }
#pragma unroll
        for (int n = 0; n < 4; ++n)
#pragma unroll
            for (int j = 0; j < 4; ++j) E(row0 + fq * 4 + j, col0 + n * 16 + fr, acc[n][j]);
    }
}
struct EpiInProj { const float* rstd0; bf16_t *XR, *GG, *Qs, *Ks, *Vs;
    __device__ void operator()(int r, int c, float v) const { v *= rstd0[r]; const int t = c >> 9, cc = c & 511;
        if (t == 0) XR[(size_t)r * RW + cc] = (bf16_t)f2bf(v);
        else if (t == 1) GG[(size_t)r * RW + cc] = (bf16_t)f2bf(gelu_tanh(v));
        else if (t == 2) Qs[(size_t)r * SBW + cc] = (bf16_t)f2bf(v * (0.125f * LOG2E));
        else if (t == 3) Ks[(size_t)r * SBW + cc] = (bf16_t)f2bf(v);
        else Vs[(size_t)r * SBW + cc] = (bf16_t)f2bf(v); } };
struct EpiStoreBf16 { bf16_t* O; const float* rowscale; int ldo; float scale;
    __device__ void operator()(int r, int c, float v) const { O[(size_t)r * ldo + c] = (bf16_t)f2bf(v * (rowscale ? rowscale[r] : 1.f) * scale); } };
struct EpiResF32 { const float* base; const float* rowscale; bf16_t* O;
    __device__ void operator()(int r, int c, float v) const { O[(size_t)r * D + c] = (bf16_t)f2bf(base[(size_t)r * D + c] + v * rowscale[r]); } };
struct EpiResBf16 { const bf16_t* base; bf16_t* O;
    __device__ void operator()(int r, int c, float v) const { O[(size_t)r * D + c] = (bf16_t)f2bf(bf2f(base[(size_t)r * D + c]) + v); } };

__device__ __forceinline__ void lru_naive_unit(int unit, int j, LAS float* xs, const bf16_t* XR, const bf16_t* GG, const float* conv_w, const float* conv_b,
                                               const float* w_a, const float* b_a, const float* w_x, const float* b_x, const float* lam, bf16_t* YY) {
    const int b = unit >> 3, h = unit & 7, c = h * 64 + j;
    float wa[64], wx[64];
#pragma unroll
    for (int i = 0; i < 64; ++i) { wa[i] = w_a[(size_t)(h * 64 + i) * 64 + j]; wx[i] = w_x[(size_t)(h * 64 + i) * 64 + j]; }
    const float ba = b_a[c], bx = b_x[c], cw0 = conv_w[c], cw1 = conv_w[RW + c], cw2 = conv_w[2 * RW + c], cw3 = conv_w[3 * RW + c], cb = conv_b[c];
    const float l = lam[c], spl = (l > 15.f) ? __expf(-l) : log1pf(__expf(-l));
    float x0 = 0.f, x1 = 0.f, x2 = 0.f, hst = 0.f;
    for (int t = 0; t < SEQ; ++t) {
        const size_t row = (size_t)b * SEQ + t;
        const float x3 = bf2f(XR[row * RW + c]);
        const float xc = cw0 * x0 + cw1 * x1 + cw2 * x2 + cw3 * x3 + cb;
        x0 = x1; x1 = x2; x2 = x3;
        asm volatile("s_waitcnt lgkmcnt(0)" ::: "memory"); xs[j] = xc; asm volatile("s_waitcnt lgkmcnt(0)" ::: "memory");
        float ra = ba, ri = bx;
#pragma unroll
        for (int i = 0; i < 64; ++i) { const float xv = xs[i]; ra += xv * wa[i]; ri += xv * wx[i]; }
        const float r = sigmoidf_(ra), ig = sigmoidf_(ri);
        const float log_a = -8.0f * r * spl, a = __expf(log_a), bb = sqrtf(fmaxf(0.f, -expm1f(2.f * log_a))) * (ig * xc);
        hst = a * hst + bb;
        YY[row * D + c] = (bf16_t)f2bf(hst * bf2f(GG[row * RW + c]));
    }
}
__device__ __forceinline__ void sb_naive_unit(int unit, int lane, const bf16_t* Qs, const bf16_t* Ks, const bf16_t* Vs, bf16_t* YY, float* ssq_s8) {
    const int qb = unit & 63, h = (unit >> 6) & 7, b = unit >> 9;
    const int t = qb * 64 + lane; const size_t row = (size_t)b * SEQ + t;
    float q[64], o[64];
#pragma unroll
    for (int d = 0; d < 64; ++d) { q[d] = bf2f(Qs[row * SBW + h * 64 + d]); o[d] = 0.f; }
    float R = 0.f;
    for (int s = qb * 64 + 62; s >= 0; --s) {
        const bf16_t* kr = Ks + ((size_t)b * SEQ + s) * SBW + h * 64; const bf16_t* vr = Vs + ((size_t)b * SEQ + s) * SBW + h * 64;
        float z = 0.f;
#pragma unroll
        for (int d = 0; d < 64; ++d) z += q[d] * bf2f(kr[d]);
        const bool valid = s < t;
        const float sp = valid ? (fmaxf(z, 0.f) + __log2f(1.f + exp2f(-fabsf(z)))) : 0.f;
        const float w = valid ? exp2f(z - (R + sp)) : 0.f;
        R += sp;
        const float wb = bf2f((bf16_t)f2bf(w));
#pragma unroll
        for (int d = 0; d < 64; ++d) o[d] += wb * bf2f(vr[d]);
    }
    float ss = 0.f;
#pragma unroll
    for (int d = 0; d < 64; ++d) { ss += o[d] * o[d]; YY[row * D + RW + h * 64 + d] = (bf16_t)f2bf(o[d]); }
    ssq_s8[row * 8 + h] = ss;
}
__device__ __forceinline__ void xattn_naive_unit(int unit, int j, LAS float* qs, LAS float* ps, const bf16_t* QX, const bf16_t* KVM, bf16_t* OX) {
    const int tg = unit & 511, h = (unit >> 9) & 3, b = unit >> 11, lane = j & 63, wid = j >> 6;
    const size_t row0 = (size_t)b * SEQ + tg * 8;
    for (int i = 0; i < 8; ++i) qs[i * 256 + j] = bf2f(QX[(row0 + i) * D + h * XD + j]);
    __syncthreads();
    const bf16_t* kr = KVM + ((size_t)b * MEM + j) * 2048 + h * XD;
    float sc[8];
#pragma unroll
    for (int i = 0; i < 8; ++i) sc[i] = 0.f;
    for (int d = 0; d < XD; ++d) { const float kv = bf2f(kr[d]);
#pragma unroll
        for (int i = 0; i < 8; ++i) sc[i] += qs[i * 256 + d] * kv; }
#pragma unroll
    for (int i = 0; i < 8; ++i) ps[i * 256 + j] = sc[i];
    __syncthreads();
    for (int i = wid * 2; i < wid * 2 + 2; ++i) {
        float v0 = ps[i * 256 + lane], v1 = ps[i * 256 + lane + 64], v2 = ps[i * 256 + lane + 128], v3 = ps[i * 256 + lane + 192];
        float m = fmaxf(fmaxf(v0, v1), fmaxf(v2, v3));
#pragma unroll
        for (int o = 1; o < 64; o <<= 1) m = fmaxf(m, __shfl_xor(m, o));
        v0 = exp2f(v0 - m); v1 = exp2f(v1 - m); v2 = exp2f(v2 - m); v3 = exp2f(v3 - m);
        const float s = wave_sum(v0 + v1 + v2 + v3), inv = 1.f / s;
        ps[i * 256 + lane] = v0 * inv; ps[i * 256 + lane + 64] = v1 * inv; ps[i * 256 + lane + 128] = v2 * inv; ps[i * 256 + lane + 192] = v3 * inv;
    }
    __syncthreads();
    float o[8];
#pragma unroll
    for (int i = 0; i < 8; ++i) o[i] = 0.f;
    for (int m = 0; m < MEM; ++m) { const float vv = bf2f(KVM[((size_t)b * MEM + m) * 2048 + 1024 + h * XD + j]);
#pragma unroll
        for (int i = 0; i < 8; ++i) o[i] += ps[i * 256 + m] * vv; }
#pragma unroll
    for (int i = 0; i < 8; ++i) OX[(row0 + i) * D + h * XD + j] = (bf16_t)f2bf(o[i]);
    __syncthreads();
}
__device__ __forceinline__ int router_row(int row, int lane, const bf16_t* X2b, const float* ssq2p, const float* g, const float* wgr, const float* bgr, const float* wer, const float* ber, float* selw) {
    int cls = 0;
    float acc[20];
#pragma unroll
    for (int i = 0; i < 20; ++i) acc[i] = 0.f;
    const float rs = pg8::rstd16(ssq2p + (size_t)row * 16);
    for (int kk = 0; kk < 16; ++kk) { const int k = kk * 64 + lane; const float t = bf2f(X2b[(size_t)row * D + k]) * rs * g[k];
#pragma unroll
        for (int i = 0; i < 4; ++i) acc[i] += t * wgr[k * 4 + i];
#pragma unroll
        for (int gi = 0; gi < 4; ++gi)
#pragma unroll
            for (int e = 0; e < 4; ++e) acc[4 + gi * 4 + e] += t * wer[((size_t)gi * D + k) * 4 + e]; }
#pragma unroll
    for (int i = 0; i < 20; ++i) acc[i] = wave_sum(acc[i]);
    if (lane == 0) {
        float gl[4]; float gm = -INFINITY; int gi = 0;
#pragma unroll
        for (int i = 0; i < 4; ++i) { gl[i] = acc[i] + bgr[i]; if (gl[i] > gm) { gm = gl[i]; gi = i; } }
        float gs = 0.f;
#pragma unroll
        for (int i = 0; i < 4; ++i) gs += __expf(gl[i] - gm);
        const float gp = 1.f / gs;
        float el[4];
#pragma unroll
        for (int e = 0; e < 4; ++e) { float v = 0.f;
#pragma unroll
            for (int q = 0; q < 4; ++q) if (q == gi) v = acc[4 + q * 4 + e] + ber[q * 4 + e];
            el[e] = v; }
        int e1 = 0; float m1 = el[0];
#pragma unroll
        for (int e = 1; e < 4; ++e) if (el[e] > m1) { m1 = el[e]; e1 = e; }
        int e2 = -1; float m2 = -INFINITY;
#pragma unroll
        for (int e = 0; e < 4; ++e) if (e != e1 && el[e] > m2) { m2 = el[e]; e2 = e; }
        const float p2 = __expf(m2 - m1), w1 = gp / (1.f + p2), w2 = gp * p2 / (1.f + p2);
        const int ea = e1 < e2 ? e1 : e2, eb = e1 < e2 ? e2 : e1; const float wA = e1 < e2 ? w1 : w2, wB = e1 < e2 ? w2 : w1;
        const int pr = (ea == 0) ? eb - 1 : (ea == 1) ? eb + 1 : 5;
        selw[(size_t)row * 2] = wA; selw[(size_t)row * 2 + 1] = wB; cls = gi * 6 + pr;
    }
    return cls;
}
__device__ __forceinline__ void final_row(int row, int lane, const bf16_t* X3b, const float* ssq3, const float* g, float* out) {
    const float r = pg8::rstd16(ssq3 + (size_t)row * 16);
#pragma unroll
    for (int j = 0; j < 2; ++j) { const int c = j * 512 + lane * 8; const u32x4 v = *(const u32x4*)(X3b + (size_t)row * D + c); const f32x4 g0 = *(const f32x4*)(g + c), g1 = *(const f32x4*)(g + c + 4);
        f32x4 o0, o1;
        o0[0] = __uint_as_float(v.x << 16) * r * g0[0]; o0[1] = __uint_as_float(v.x & 0xffff0000u) * r * g0[1]; o0[2] = __uint_as_float(v.y << 16) * r * g0[2]; o0[3] = __uint_as_float(v.y & 0xffff0000u) * r * g0[3];
        o1[0] = __uint_as_float(v.z << 16) * r * g1[0]; o1[1] = __uint_as_float(v.z & 0xffff0000u) * r * g1[1]; o1[2] = __uint_as_float(v.w << 16) * r * g1[2]; o1[3] = __uint_as_float(v.w & 0xffff0000u) * r * g1[3];
        *(f32x4*)(out + (size_t)row * D + c) = o0; *(f32x4*)(out + (size_t)row * D + c + 4) = o1; }
}
__device__ __forceinline__ void reids(Ctx& C) { int t_ = threadIdx.x; asm volatile("" : "+v"(t_)); C.tid = t_; C.lane = t_ & 63; C.wave = __builtin_amdgcn_readfirstlane(t_ >> 6); C.gw = C.bid * NWAVES + C.wave; }
__global__ void __launch_bounds__(NTHREADS, 2) mk_fwd(Args args) {
    extern __shared__ __attribute__((aligned(16))) unsigned char lds[];
    cg::grid_group grid = cg::this_grid();
    Ctx C;
#pragma unroll
    for (int i = 0; i < 29; ++i) C.in[i] = args.in[i];
    C.out = args.out; C.ws = args.ws; C.lds = lds;
    C.tid = threadIdx.x; C.lane = C.tid & 63; C.wave = __builtin_amdgcn_readfirstlane(C.tid >> 6);
    C.G = gridDim.x; C.bid = blockIdx.x; C.gw = C.bid * NWAVES + C.wave; C.NGW = C.G * NWAVES;
    const float* x = C.in[0]; const float* mem = C.in[1]; const float* norm_mix = C.in[2]; const float* w_in = C.in[3];
    const float* conv_w = C.in[4]; const float* conv_b = C.in[5]; const float* lru_w_a = C.in[6]; const float* lru_b_a = C.in[7];
    const float* lru_w_x = C.in[8]; const float* lru_b_x = C.in[9]; const float* lru_lambda = C.in[10];
    const float* norm_rnn = C.in[11]; const float* norm_sb = C.in[12]; const float* w_out = C.in[13];
    const float* norm_xattn = C.in[14]; const float* norm_mem = C.in[15];
    const float* xa_w_q = C.in[16]; const float* xa_w_k = C.in[17]; const float* xa_w_v = C.in[18]; const float* xa_w_o = C.in[19];
    const float* norm_moe = C.in[20]; const float* w_gr = C.in[21]; const float* b_gr = C.in[22]; const float* w_er = C.in[23]; const float* b_er = C.in[24];
    const float* w_gate = C.in[25]; const float* w_up = C.in[26]; const float* w_down = C.in[27]; const float* norm_final = C.in[28];
    unsigned char* ws = C.ws; float* out = C.out;
    float* sm = (float*)(ws + WS_SMALL);
    float* rstd0 = sm + SM_RSTD0; float* ssq_r = sm + SM_SSQR; float* ssq_s = sm + SM_SSQS; float* ssq1 = sm + SM_SSQ1; float* ssq2 = sm + SM_SSQ2; unsigned* kmax = (unsigned*)(ws + WS_CTL); float* fmid = sm + SM_END; float* fend = fmid + 32768;
    float* aggP = sm + 96 * 32768; float* aggH = sm + 104 * 32768;
    float* selw = sm + SM_SELW; float* ssq3 = sm + SM_SSQ3; int* gcnt = (int*)(ws + WS_CTL + 1024);
    int* tlist = (int*)(sm + 64 * 32768); float* rsg = sm + 88 * 32768; float* wAg = rsg + 40960; float* wBg = wAg + 40960; int* tokg = (int*)(wBg + 40960);
    bf16_t* Wrh = (bf16_t*)(ws + WS_CTL + 65536); bf16_t* Wrl = Wrh + 32 * D;
    bf16_t* Wg_t = (bf16_t*)(ws + WS_WG); bf16_t* Wu_t = (bf16_t*)(ws + WS_WU); bf16_t* Wd2 = (bf16_t*)(ws + WS_WD2); bf16_t* XG = (bf16_t*)(ws + WS_R1); bf16_t* HID = (bf16_t*)(ws + WS_R5);
    bf16_t* Win_t = (bf16_t*)(ws + WS_WIN); bf16_t* Wout_t = (bf16_t*)(ws + WS_WOUT); bf16_t* Wq_t = (bf16_t*)(ws + WS_WQ); bf16_t* Wkv_t = (bf16_t*)(ws + WS_WKV); bf16_t* Wo_t = (bf16_t*)(ws + WS_WO);
    bf16_t* memn = (bf16_t*)(ws + WS_MEMN); bf16_t* KM = (bf16_t*)(ws + WS_KVM); bf16_t* VT = (bf16_t*)(ws + WS_R5 + 40 * MiB);
    bf16_t* xb = (bf16_t*)(ws + WS_R0); bf16_t* X1b = xb; bf16_t* X3b = xb;
    bf16_t* XR = (bf16_t*)(ws + WS_R1); bf16_t* GG = XR + (size_t)NTOK * RW; bf16_t* QX = XR;
    bf16_t* Qs = (bf16_t*)(ws + WS_R2); bf16_t* Ks = Qs + (size_t)NTOK * SBW; bf16_t* OX = Qs;
    bf16_t* Vs = (bf16_t*)(ws + WS_R3);
    bf16_t* YY = (bf16_t*)(ws + WS_R4); bf16_t* X2b = YY;
    const int NGW = C.NGW;
#define gw C.gw
#define lane C.lane
    if (C.tid < 64) ((LAS unsigned*)(lds + 146432))[C.tid] = 0u;
    __syncthreads();
    XcdBarrier bar = xcd_barrier_post((unsigned*)(ws + WS_CTL + 4096), (volatile LAS unsigned*)(lds + 146432 + 32));
#define GRID_SYNC_CG() do { grid.sync(); reids(C); } while (0)
#define GRID_SYNC() do { xcd_barrier(bar); reids(C); } while (0)

    for (int rep_ = 0; rep_ < (int)((REP_MASK >> 0) & 1u) + 1; ++rep_) {
    {
        if (gw == 0) { kmax[lane] = 0u; if (lane < 32) gcnt[lane] = 0; }
        for (int r = gw * 2; r < NTOK; r += NGW * 2) {
            const f32x4* xr = (const f32x4*)(x + (size_t)r * D) + lane; f32x4 v[8]; float s0 = 0.f, s1 = 0.f;
#pragma unroll
            for (int j = 0; j < 8; ++j) v[j] = __builtin_nontemporal_load(xr + 64 * j);
#pragma unroll
            for (int j = 0; j < 4; ++j) { s0 += (v[j].x * v[j].x + v[j].y * v[j].y) + (v[j].z * v[j].z + v[j].w * v[j].w); s1 += (v[4 + j].x * v[4 + j].x + v[4 + j].y * v[4 + j].y) + (v[4 + j].z * v[4 + j].z + v[4 + j].w * v[4 + j].w); }
#pragma unroll
            for (int o = 1; o < 64; o <<= 1) { s0 += __shfl_xor(s0, o); s1 += __shfl_xor(s1, o); }
            if (lane == 0) { rstd0[r] = 1.0f / sqrtf(s0 * (1.f / D) + EPS); rstd0[r + 1] = 1.0f / sqrtf(s1 * (1.f / D) + EPS); }
            unsigned long long* o8 = (unsigned long long*)(xb + (size_t)r * D) + lane;
#pragma unroll
            for (int j = 0; j < 8; ++j) o8[64 * j] = (unsigned long long)(f2bf(v[j].x) | (f2bf(v[j].y) << 16)) | ((unsigned long long)(f2bf(v[j].z) | (f2bf(v[j].w) << 16)) << 32);
        }
        for (int r = gw; r < NMEM; r += NGW) row_prep_mem(mem, norm_mem, memn, r, lane);
        LAS float* scr = (LAS float*)(lds) + C.wave * (64 * 33);
        constexpr int I_IN = (D / 64) * (PROJ / 32), I_SQ = (D / 64) * (D / 32);
        for (int it = gw; it < I_IN + 5 * I_SQ; it += NGW) {
            int r = it;
            if (r < I_IN) { transpose_item(w_in, D, PROJ, Win_t, D, norm_mix, norm_mix, D, scr, r, lane); continue; } r -= I_IN;
            if (r < I_SQ) { transpose_item(w_out, D, D, Wout_t, D, norm_rnn, norm_sb, RW, scr, r, lane); continue; } r -= I_SQ;
            if (r < I_SQ) { transpose_item(xa_w_q, D, D, Wq_t, D, norm_xattn, norm_xattn, D, scr, r, lane); continue; } r -= I_SQ;
            if (r < I_SQ) { transpose_item(xa_w_k, D, D, Wkv_t, D, nullptr, nullptr, 0, scr, r, lane); continue; } r -= I_SQ;
            if (r < I_SQ) { transpose_item(xa_w_v, D, D, Wkv_t + (size_t)D * D, D, nullptr, nullptr, 0, scr, r, lane); continue; } r -= I_SQ;
            transpose_item(xa_w_o, D, D, Wo_t, D, nullptr, nullptr, 0, scr, r, lane);
        }
        for (int idx = gw * 64 + lane; idx < 32 * D; idx += NGW * 64) { const int n = idx >> 10, k = idx & 1023; float w = 0.f;
            if (n < 4) w = w_gr[k * 4 + n]; else if (n < 20) w = w_er[((size_t)((n - 4) >> 2) * D + k) * 4 + ((n - 4) & 3)];
            w *= norm_moe[k]; const unsigned hi = f2bf(w); Wrh[idx] = (bf16_t)hi; Wrl[idx] = (bf16_t)f2bf(w - bf2f((unsigned short)hi)); }
        constexpr int I_GU = (D / 64) * (DE / 32), I_DN = (DE / 64) * (D / 32);
        for (int it = gw; it < 32 * I_GU + 48 * I_DN; it += NGW) {
            int r = it;
            if (r < 16 * I_GU) { const int e = r / I_GU; transpose_item(w_gate + (size_t)e * D * DE, D, DE, Wg_t + (size_t)e * DE * D, D, norm_moe, norm_moe, D, scr, r % I_GU, lane); continue; } r -= 16 * I_GU;
            if (r < 16 * I_GU) { const int e = r / I_GU; transpose_item(w_up + (size_t)e * D * DE, D, DE, Wu_t + (size_t)e * DE * D, D, norm_moe, norm_moe, D, scr, r % I_GU, lane); continue; } r -= 16 * I_GU;
            { const int cs = r / I_DN, cls = cs >> 1, slot = cs & 1; int ea, eb; pg8::pair_ab(cls % 6, ea, eb); const int e = (cls / 6) * 4 + (slot ? eb : ea);
              transpose_item(w_down + (size_t)e * DE * D, DE, D, Wd2 + (size_t)cls * D * 512 + slot * DE, 512, nullptr, nullptr, 0, scr, r % I_DN, lane); }
        }
    }
    }
    GRID_SYNC();
    for (int rep_ = 0; rep_ < (int)((REP_MASK >> 1) & 1u) + 1; ++rep_) {
    { pg8::DenseOrder S; S.init(xb, D, Win_t, D, NTOK, PROJ, C.G, C.bid); pg8::EpiInProjF E{0, rstd0, XR, GG, Qs, Ks, Vs, kmax};
      pg8::gemm_phase<pg8::EpiInProjF, pg8::DenseOrder, true>((LAS unsigned char*)lds, pg8::Gemm{D, D, D}, S, E); }
    { pg8::KvOrder S{memn, Wkv_t, Wkv_t + (size_t)D * D, C.G, C.bid}; pg8::EpiKv E{0, KM, VT};
      pg8::gemm_phase<pg8::EpiKv, pg8::KvOrder, true>((LAS unsigned char*)lds, pg8::Gemm{D, D, D}, S, E); }
    }
    GRID_SYNC();
    lru::Weights LW; lru::load_weights(LW, C.wave, lane & 31, lane >> 5, lru_w_a, lru_b_a, lru_w_x, lru_b_x, lru_lambda);
    for (int rep_ = 0; rep_ < (int)((REP_MASK >> 2) & 1u) + 1; ++rep_) {
    {
        for (int u = C.bid; u < BATCH * 64; u += C.G) lru::unit<false>(u >> 6, u & 63, LW, XR, GG, conv_w, conv_b, aggP, aggH, ssq_s, YY, fmid, fend, lds);
        for (int u = C.bid; u < BATCH * NH * 16; u += C.G) sba::sb_unit(u >> 7, (u >> 4) & 7, 15 - (u & 15), Qs, Ks, Vs, YY, ssq_s, kmax, (char*)lds);
    }
    }
    GRID_SYNC();
    for (int rep_ = 0; rep_ < (int)((REP_MASK >> 3) & 1u) + 1; ++rep_) {
    for (int u = C.bid; u < BATCH * 64; u += C.G) lru::unit<true>(u >> 6, u & 63, LW, XR, GG, conv_w, conv_b, aggP, aggH, ssq_s, YY, fmid, fend, lds);
    }
    GRID_SYNC();
    for (int rep_ = 0; rep_ < (int)((REP_MASK >> 4) & 1u) + 1; ++rep_) {
    { pg8::DenseOrder S; S.init(YY, D, Wout_t, D, NTOK, D, C.G, C.bid); pg8::EpiX1F E{8, xb, fmid, fend, X1b, ssq1};
      pg8::gemm_phase<pg8::EpiX1F, pg8::DenseOrder, true>((LAS unsigned char*)lds, pg8::Gemm{D, D, D}, S, E); }
    }
    GRID_SYNC();
    for (int rep_ = 0; rep_ < (int)((REP_MASK >> 5) & 1u) + 1; ++rep_) {
    { pg8::XaChainOrder S{X1b, Wq_t, QX, KM, VT, 0, 0, 0}; S.init(C.G, C.bid); pg8::EpiXaChain E{0, QX, OX, ssq1, 0.0625f * LOG2E, (LAS float*)(lds + 131072 + 2048)};
      pg8::gemm_phase<pg8::EpiXaChain, pg8::XaChainOrder, true>((LAS unsigned char*)lds, pg8::Gemm{D, D, D}, S, E); }
    }
    GRID_SYNC();
    for (int rep_ = 0; rep_ < (int)((REP_MASK >> 8) & 1u) + 1; ++rep_) {
    { pg8::DenseOrder S; S.init(OX, D, Wo_t, D, NTOK, D, C.G, C.bid); pg8::EpiResF E{0, X1b, X2b, ssq2};
      pg8::gemm_phase<pg8::EpiResF, pg8::DenseOrder, true>((LAS unsigned char*)lds, pg8::Gemm{D, D, D}, S, E); }
    }
    GRID_SYNC();
    for (int rep_ = 0; rep_ < (int)((REP_MASK >> 9) & 1u) + 1; ++rep_) {
    {
        LAS int* lcnt = (LAS int*)lds; LAS int* lbase = lcnt + 32; LAS int* lcls = lcnt + 64; LAS int* lpos = lcnt + 192;
        for (int chunk = C.bid; chunk < NTOK / 128; chunk += C.G) {
            if (C.tid < 32) lcnt[C.tid] = 0;
            __syncthreads();
            {
                const int fr = lane & 15, fq = lane >> 4, row0 = chunk * 128 + C.wave * 16;
                f32x4 acc0 = {0.f, 0.f, 0.f, 0.f}, acc1 = acc0;
                const bf16_t* ap = X2b + (size_t)(row0 + fr) * D + fq * 8; const bf16_t* bp = Wrh + (size_t)fr * D + fq * 8;
#pragma unroll 4
                for (int ks = 0; ks < 32; ++ks) { const bf16x8 a = *(const bf16x8*)(ap + ks * 32);
                    const bf16x8 h0 = *(const bf16x8*)(bp + ks * 32), h1 = *(const bf16x8*)(bp + 16 * D + ks * 32), l0 = *(const bf16x8*)(bp + 32 * D + ks * 32), l1 = *(const bf16x8*)(bp + 48 * D + ks * 32);
                    acc0 = __builtin_amdgcn_mfma_f32_16x16x32_bf16(a, h0, acc0, 0, 0, 0); acc1 = __builtin_amdgcn_mfma_f32_16x16x32_bf16(a, h1, acc1, 0, 0, 0);
                    acc0 = __builtin_amdgcn_mfma_f32_16x16x32_bf16(a, l0, acc0, 0, 0, 0); acc1 = __builtin_amdgcn_mfma_f32_16x16x32_bf16(a, l1, acc1, 0, 0, 0); }
                LAS float* lg = (LAS float*)(lds + 4096) + C.wave * (16 * 33);
#pragma unroll
                for (int j = 0; j < 4; ++j) { lg[(4 * fq + j) * 33 + fr] = acc0[j]; lg[(4 * fq + j) * 33 + 16 + fr] = acc1[j]; }
                asm volatile("s_waitcnt lgkmcnt(0)" ::: "memory");
                if (lane < 16) { const int row = row0 + lane; const float rs = pg8::rstd16(ssq2 + (size_t)row * 16); const LAS float* lr = lg + lane * 33;
                    float gl[4]; float gm = -INFINITY; int gi = 0;
#pragma unroll
                    for (int i = 0; i < 4; ++i) { gl[i] = lr[i] * rs + b_gr[i]; if (gl[i] > gm) { gm = gl[i]; gi = i; } }
                    float gs = 0.f;
#pragma unroll
                    for (int i = 0; i < 4; ++i) gs += __expf(gl[i] - gm);
                    const float gp = 1.f / gs;
                    float el[4];
#pragma unroll
                    for (int e = 0; e < 4; ++e) el[e] = lr[4 + gi * 4 + e] * rs + b_er[gi * 4 + e];
                    int e1 = 0; float m1 = el[0];
#pragma unroll
                    for (int e = 1; e < 4; ++e) if (el[e] > m1) { m1 = el[e]; e1 = e; }
                    int e2 = -1; float m2 = -INFINITY;
#pragma unroll
                    for (int e = 0; e < 4; ++e) if (e != e1 && el[e] > m2) { m2 = el[e]; e2 = e; }
                    const float p2 = __expf(m2 - m1), w1 = gp / (1.f + p2), w2 = gp * p2 / (1.f + p2);
                    const int ea = e1 < e2 ? e1 : e2, eb = e1 < e2 ? e2 : e1; const float wA = e1 < e2 ? w1 : w2, wB = e1 < e2 ? w2 : w1;
                    const int pr = (ea == 0) ? eb - 1 : (ea == 1) ? eb + 1 : 5, cls = gi * 6 + pr, lt = C.wave * 16 + lane;
                    selw[(size_t)row * 2] = wA; selw[(size_t)row * 2 + 1] = wB;
                    lcls[lt] = cls; lpos[lt] = __hip_atomic_fetch_add(lcnt + cls, 1, __ATOMIC_RELAXED, __HIP_MEMORY_SCOPE_WORKGROUP); }
            }
            __syncthreads();
            if (C.tid < 24) lbase[C.tid] = atomicAdd(gcnt + C.tid, lcnt[C.tid]);
            __syncthreads();
            if (C.tid < 128) { const int c = lcls[C.tid]; tlist[(size_t)c * NTOK + lbase[c] + lpos[C.tid]] = chunk * 128 + C.tid; }
            __syncthreads();
        }
    }
    }
    GRID_SYNC();
    LAS int* meta = (LAS int*)(lds + 146432 + 256);
    for (int rep_ = 0; rep_ < (int)((REP_MASK >> 10) & 1u) + 1; ++rep_) {
    {
        if (C.tid == 0) { int rb = 0, tb = 0;
            for (int c = 0; c < 24; ++c) { const int n = gcnt[c], nt = (n + 255) >> 8; meta[c] = n; meta[32 + c] = rb; meta[64 + c] = tb; rb += nt * 256; tb += nt; }
            meta[32 + 24] = rb; meta[64 + 24] = tb; }
        __syncthreads();
        const int total = meta[32 + 24];
        for (int R = gw; R < total; R += NGW) {
            int c = 0;
            for (int k = 1; k < 24; ++k) c += (R >= meta[32 + k]) ? 1 : 0;
            const int p = R - meta[32 + c]; u32x4 v0 = (u32x4){0u, 0u, 0u, 0u}, v1 = v0; int tok = -1; float rs = 0.f, wA = 0.f, wB = 0.f;
            if (p < meta[c]) { tok = tlist[(size_t)c * NTOK + p]; const u32x4* src = (const u32x4*)(X2b + (size_t)tok * D) + lane; v0 = src[0]; v1 = src[64];
                rs = pg8::rstd16(ssq2 + (size_t)tok * 16); wA = selw[(size_t)tok * 2]; wB = selw[(size_t)tok * 2 + 1]; }
            u32x4* dst = (u32x4*)(XG + (size_t)R * D) + lane; dst[0] = v0; dst[64] = v1;
            if (lane == 0) { rsg[R] = rs; wAg[R] = wA; wBg[R] = wB; tokg[R] = tok; }
        }
    }
    }
    GRID_SYNC();
    for (int rep_ = 0; rep_ < (int)((REP_MASK >> 11) & 1u) + 1; ++rep_) {
    { pg8::MoeOrder1 S{XG, Wg_t, Wu_t, meta, C.G, C.bid}; pg8::EpiMoeUp E{0, rsg, wAg, wBg, HID};
      pg8::gemm_phase<pg8::EpiMoeUp, pg8::MoeOrder1, true>((LAS unsigned char*)lds, pg8::Gemm{D, D, D}, S, E); }
    }
    GRID_SYNC();
    for (int rep_ = 0; rep_ < (int)((REP_MASK >> 12) & 1u) + 1; ++rep_) {
    { pg8::MoeOrder2 S{HID, Wd2, meta, C.G, C.bid};
      pg8::EpiMoeFinal E{0, tokg, X2b, out, ssq3, (unsigned*)(ws + WS_CTL + 4096 + 16384), norm_final, (LAS unsigned*)(lds + 146432 + 128), (unsigned*)(ws + WS_CTL + 4096) + 128};
      pg8::gemm_phase<pg8::EpiMoeFinal, pg8::MoeOrder2, true>((LAS unsigned char*)lds, pg8::Gemm{512, 512, 512}, S, E); }
    }
}

#undef gw
#undef lane
extern "C" void kernel_launch(void* const* d_in, const int* in_sizes, int n_in, void* d_out, int out_size, void* d_ws, size_t ws_size, hipStream_t stream) {
    static int grid = 0;
    if (grid == 0) {
        if (n_in != 29 || ws_size < WS_END) { fprintf(stderr, "kernel_launch: unexpected inputs (%d) or workspace (%zu)\n", n_in, ws_size); grid = -1; return; }
        int dev = 0, cus = 0, per_cu = 0;
        hipGetDevice(&dev); hipDeviceGetAttribute(&cus, hipDeviceAttributeMultiprocessorCount, dev);
        hipFuncSetAttribute((const void*)mk_fwd, hipFuncAttributeMaxDynamicSharedMemorySize, LDS_BYTES);
        hipOccupancyMaxActiveBlocksPerMultiprocessor(&per_cu, (const void*)mk_fwd, NTHREADS, LDS_BYTES);
        if (per_cu < 1) { fprintf(stderr, "kernel_launch: occupancy query says %d blocks per CU\n", per_cu); per_cu = 1; }
        if (per_cu > 1) per_cu = 1;
        grid = cus * per_cu;
    }
    if (grid < 0) return;
    if (hipMemsetAsync((char*)d_ws + WS_CTL + 4096, 0, 32768, stream) != hipSuccess) { fprintf(stderr, "kernel_launch: memset of the barrier words failed\n"); return; }
    Args a{};
    for (int i = 0; i < 29; ++i) a.in[i] = (const float*)d_in[i];
    a.out = (float*)d_out; a.ws = (unsigned char*)d_ws;
    void* kargs[] = {&a};
    hipError_t e = hipLaunchCooperativeKernel((const void*)mk_fwd, dim3(grid), dim3(NTHREADS), kargs, LDS_BYTES, stream);
    if (e != hipSuccess) fprintf(stderr, "cooperative launch failed: %s (grid %d)\n", hipGetErrorString(e), grid);
}
```

```cpp
#include <hip/hip_runtime.h>
#include <hip/hip_cooperative_groups.h>
#include <cstdio>
#include <cstdint>

typedef unsigned short bf16_t;
typedef short bf16x8 __attribute__((ext_vector_type(8)));
typedef float f32x4 __attribute__((ext_vector_type(4)));
typedef unsigned u32x4 __attribute__((ext_vector_type(4)));

constexpr int D = 1024, BATCH = 8, SEQ = 4096, NTOK = BATCH * SEQ, MEM = 256, NMEM = BATCH * MEM;
constexpr int RW = 512, SBW = 512, PROJ = 2560, NH = 8, HD = 64;
constexpr int XH = 4, XD = 256, NG = 4, EPG = 4, NEXP = 16, DE = 256;
constexpr float EPS = 1e-6f, LOG2E = 1.4426950408889634f;

constexpr size_t MiB = 1u << 20;
constexpr size_t WS_CTL = 0;
constexpr size_t WS_SMALL = 1 * MiB;
constexpr size_t WS_WIN = 16 * MiB;
constexpr size_t WS_WOUT = 21 * MiB;
constexpr size_t WS_WQ = 23 * MiB;
constexpr size_t WS_WKV = 25 * MiB;
constexpr size_t WS_WO = 29 * MiB;
constexpr size_t WS_MEMN = 31 * MiB;
constexpr size_t WS_KVM = 35 * MiB;
constexpr size_t WS_WG = 43 * MiB;
constexpr size_t WS_WU = 51 * MiB;
constexpr size_t WS_WD2 = 59 * MiB;
constexpr size_t WS_R0 = 96 * MiB;
constexpr size_t WS_R1 = 160 * MiB;
constexpr size_t WS_R2 = 224 * MiB;
constexpr size_t WS_R3 = 288 * MiB;
constexpr size_t WS_R4 = 320 * MiB;
constexpr size_t WS_R5 = 384 * MiB;
constexpr size_t WS_END = 448 * MiB;

constexpr size_t SM_RSTD0 = 0;
constexpr size_t SM_SSQR = 1 * 32768;
constexpr size_t SM_SSQS = 2 * 32768;
constexpr size_t SM_SSQ1 = 10 * 32768;
constexpr size_t SM_SSQ2 = 26 * 32768;
constexpr size_t SM_SSQ3 = 42 * 32768;
constexpr size_t SM_SELW = 58 * 32768;
constexpr size_t SM_SELE = 60 * 32768;
constexpr size_t SM_END = 62 * 32768;

__device__ __forceinline__ unsigned f2bf(float f) { unsigned u = __builtin_bit_cast(unsigned, f); return (u + 0x7fffu + ((u >> 16) & 1u)) >> 16; }
__device__ __forceinline__ float bf2f(unsigned short h) { return __builtin_bit_cast(float, (unsigned)h << 16); }
__device__ __forceinline__ float wave_sum(float v) {
#pragma unroll
    for (int o = 1; o < 64; o <<= 1) v += __shfl_xor(v, o);
    return v;
}
__device__ __forceinline__ float gelu_tanh(float x) { const float u = 0.7978845608028654f * (x + 0.044715f * x * x * x); return x * __builtin_amdgcn_rcpf(1.f + __expf(-2.f * u)); }
__device__ __forceinline__ float sigmoidf_(float x) { return 1.f / (1.f + __expf(-x)); }

namespace cg = cooperative_groups;
#ifndef PROBE_A
#define PROBE_A -1
#endif
#ifndef REP_MASK
#define REP_MASK 0u
#endif
#define LAS __attribute__((address_space(3)))
constexpr int NWAVES = 8, NTHREADS = 512;
constexpr int LDS_BYTES = 147456;

struct Args { const float* in[29]; float* out; unsigned char* ws; };

struct Ctx {
    const float* in[29]; float* out; unsigned char* ws; unsigned char* lds;
    int tid, lane, wave, gw, NGW, G, bid;
};

#define RLX_AGENT __ATOMIC_RELAXED, __HIP_MEMORY_SCOPE_AGENT
#define XB_TMO      128
#define XB_XCNT(j)  (256  + 64 * (j))
#define XB_XSUB(j)  (1280 + 64 * (j))
#define XB_XGEN(j)  (2304 + 64 * (j))
#define XB_TOP      3328
#define XB_TOPGEN   3392
#define XCD_BAR_WORDS 3456
#define XB_SPIN_CAP (1u << 18)

__device__ __forceinline__ unsigned xb_ld(unsigned* p)              { return __hip_atomic_load(p, __ATOMIC_RELAXED, __HIP_MEMORY_SCOPE_AGENT); }
__device__ __forceinline__ unsigned xb_add(unsigned* p, unsigned v) { return __hip_atomic_fetch_add(p, v, __ATOMIC_RELAXED, __HIP_MEMORY_SCOPE_AGENT); }
__device__ __forceinline__ unsigned xb_xcc_id() { return (unsigned)__builtin_amdgcn_s_getreg((3 << 11) | 20) & 0xFu; }
#define XB_SPIN(cond, bar) do { unsigned _sp = 0; while (cond) { __builtin_amdgcn_s_sleep(1); \
    if ((++_sp & 255u) == 0u) { if (xb_ld(&(bar)[XB_TMO])) break; if (_sp > XB_SPIN_CAP) { atomicAdd(&(bar)[XB_TMO], 1u); break; } } } } while (0)

struct XcdBarrier {
    unsigned* bar; unsigned x;
    volatile LAS unsigned* st;
};

__device__ __forceinline__ XcdBarrier xcd_barrier_post(unsigned* bar, volatile LAS unsigned* st) {
    XcdBarrier b; b.bar = bar; b.x = xb_xcc_id(); b.st = st;
    if (threadIdx.x == 0) (void)xb_add(&bar[XB_XCNT(b.x)], 1u);
    return b;
}
__device__ __forceinline__ void xcd_barrier_complete(unsigned* bar, unsigned x, unsigned& nloc, unsigned& nx) {
    const unsigned G = gridDim.x * gridDim.y * gridDim.z;
    unsigned sum, cnt, mine, sp = 0u;
    for (;;) {
        sum = 0u; cnt = 0u; mine = 0u;
#pragma unroll
        for (unsigned j = 0; j < 16; ++j) { const unsigned c = xb_ld(&bar[XB_XCNT(j)]); sum += c; cnt += (c > 0u) ? 1u : 0u; mine = (j == x) ? c : mine; }
        if (sum == G) break;
        __builtin_amdgcn_s_sleep(1);
        if ((++sp & 255u) == 0u) { if (xb_ld(&bar[XB_TMO])) break; if (sp > XB_SPIN_CAP) { atomicAdd(&bar[XB_TMO], 1u); break; } }
    }
    nloc = mine > 0u ? mine : 1u; nx = cnt > 0u ? cnt : 1u;
}

__device__ __forceinline__ void xcd_barrier(const XcdBarrier& b) {
    asm volatile("s_waitcnt vmcnt(0)" ::: "memory");
    __syncthreads();
    if (threadIdx.x == 0) {
        unsigned* bar = b.bar;
        __builtin_amdgcn_s_waitcnt(0);
        unsigned nloc = b.st[0], nx = b.st[1];
        if (nloc == 0u) { xcd_barrier_complete(bar, b.x, nloc, nx); b.st[0] = nloc; b.st[1] = nx; }
        const unsigned old = xb_add(&bar[XB_XSUB(b.x)], 1u);
        const unsigned gen = old / nloc;
        if (old + 1u == (gen + 1u) * nloc) {
            __builtin_amdgcn_fence(__ATOMIC_RELEASE, "agent");
            asm volatile("s_waitcnt vmcnt(0)" ::: "memory");
            const unsigned og = xb_add(&bar[XB_TOP], 1u);
            const unsigned tg = og / nx;
            if (og + 1u == (tg + 1u) * nx) xb_add(&bar[XB_TOPGEN], 1u);
            else XB_SPIN(xb_ld(&bar[XB_TOPGEN]) == tg, bar);
            __builtin_amdgcn_fence(__ATOMIC_ACQUIRE, "agent");
            xb_add(&bar[XB_XGEN(b.x)], 1u);
            asm volatile("s_waitcnt vmcnt(0)" ::: "memory");
        } else {
            XB_SPIN(xb_ld(&bar[XB_XGEN(b.x)]) == gen, bar);
            __builtin_amdgcn_fence(__ATOMIC_ACQUIRE, "agent");
            asm volatile("s_waitcnt vmcnt(0)" ::: "memory");
        }
    }
    __syncthreads();
}
namespace pg8 {
#define PG8_LAS __attribute__((address_space(3)))
constexpr int BM = 256, BK = 64, HALF = 128, HTB = HALF * BK * 2  , STAGE_BYTES = 8 * HTB, NXCD = 8, WGM = 8;
__host__ __device__ __forceinline__ int lds_byte(int r, int c) { const int st = (r >> 4) * 2 + (c >> 5), rr = r & 15, cc = c & 31, ob = rr * 64 + cc * 2; return st * 1024 + (ob ^ (((ob >> 9) & 1) << 5)); }
__host__ __device__ __forceinline__ void stage_rc(int b, int& R, int& C) { const int st = b / 1024, sb = b % 1024, swz = sb ^ (((sb >> 9) & 1) << 5); R = (st >> 1) * 16 + swz / 64; C = (st & 1) * 32 + (swz % 64) / 2; }
__host__ __device__ __forceinline__ int perm32(int rho) { const int n = rho >> 4, i = rho & 15; return 8 * (i >> 2) + 4 * n + (i & 3); }

struct Unit { int pm, pn; };
struct Gemm { int lda, ldb, K; };
struct DenseOrder {
    const bf16_t* A; const bf16_t* Bt; int lda, ldb; int nM, nN, nwg, G, c; int ntk = D / BK;
    __device__ __forceinline__ int nt(const Unit&) const { return ntk; }
    __device__ void init(const bf16_t* A_, int lda_, const bf16_t* Bt_, int ldb_, int M, int N, int G_, int c_) { A = A_; Bt = Bt_; lda = lda_; ldb = ldb_; nM = M / BM; nN = N / BM; nwg = nM * nN; G = G_; c = c_; }
    __device__ bool next(int i, Unit& u) const {
        const long L = (long)i * G + c; if (L >= nwg) return false;
        int wgid = (int)L; { const int q = nwg / NXCD, r = nwg % NXCD, xcd = wgid % NXCD, off = wgid / NXCD; wgid = (xcd < r ? xcd * (q + 1) : r * (q + 1) + (xcd - r) * q) + off; }
        const int nig = WGM * nN, gid = wgid / nig, fm = gid * WGM, gsz = (nM - fm) < WGM ? (nM - fm) : WGM;
        u.pm = fm + ((wgid % nig) % gsz); u.pn = (wgid % nig) / gsz; return true;
    }
    __device__ __forceinline__ void ptrs(const Unit& u, const char*& a, const char*& b0, const char*& b1) const {
        a = (const char*)A + (size_t)u.pm * BM * lda * 2; b0 = (const char*)Bt + (size_t)u.pn * BM * ldb * 2; b1 = b0 + (size_t)HALF * ldb * 2; }
};

__device__ __forceinline__ unsigned cvt_pk_bf16(float lo, float hi) { unsigned r; asm volatile("v_cvt_pk_bf16_f32 %0, %1, %2" : "=v"(r) : "v"(lo), "v"(hi)); return r; }

template <class Epi, class Sched, bool ALIGN_EPI>
__device__ __forceinline__ void gemm_phase(PG8_LAS unsigned char* lds, const Gemm g, const Sched& S, const Epi& E) {
    int tid_ = threadIdx.x; asm volatile("" : "+v"(tid_));
    const int tid = tid_, wid = __builtin_amdgcn_readfirstlane(tid >> 6), lane = tid & 63, wr = wid >> 2, wc = wid & 3, fr = lane & 15, fq = lane >> 4;
    unsigned voffA[2], voffB[2];
#pragma unroll
    for (int i = 0; i < 2; ++i) { int R, C; stage_rc(tid * 16 + i * 8192, R, C); const int Rb = Epi::PERM ? ((R & ~31) + perm32(R & 31)) : R;
        voffA[i] = (unsigned)(R * g.lda + C) * 2u; voffB[i] = (unsigned)(Rb * g.ldb + C) * 2u; }
    const size_t kstep = (size_t)(BK * 2);
    const size_t hstepA = (size_t)HALF * g.lda * 2;
    const unsigned ldsw = (unsigned)wid * 1024u;
    const int aoff = lds_byte(wr * 64 + fr, fq * 8), boff = lds_byte(wc * 32 + fr, fq * 8);
#define PG8_SA(b, h) (((b) * 2 + (h)) * HTB)
#define PG8_SB(b, h) ((4 + (b) * 2 + (h)) * HTB)
#define PG8_STAGE(bufoff, gbase, voff) do { _Pragma("unroll") for (int _i = 0; _i < 2; ++_i) \
        __builtin_amdgcn_global_load_lds((const unsigned*)((const char*)(gbase) + (voff)[_i]), (PG8_LAS unsigned*)(lds + (bufoff) + ldsw + _i * 8192), 16, 0, 0); } while (0)
#define PG8_LDA(dst, b, h) do { _Pragma("unroll") for (int m = 0; m < 4; ++m) _Pragma("unroll") for (int k = 0; k < 2; ++k) dst[m][k] = *(const PG8_LAS bf16x8*)(lds + PG8_SA(b, h) + aoff + m * 2048 + k * 1024); } while (0)
#define PG8_LDB(dst, b, h) do { _Pragma("unroll") for (int n = 0; n < 2; ++n) _Pragma("unroll") for (int k = 0; k < 2; ++k) dst[n][k] = *(const PG8_LAS bf16x8*)(lds + PG8_SB(b, h) + boff + n * 2048 + k * 1024); } while (0)
#define PG8_MMA(ai, bj, At, Bt) do { __builtin_amdgcn_s_setprio(1); _Pragma("unroll") for (int m = 0; m < 4; ++m) _Pragma("unroll") for (int n = 0; n < 2; ++n) _Pragma("unroll") for (int k = 0; k < 2; ++k) \
        acc[ai][bj][m][n] = __builtin_amdgcn_mfma_f32_16x16x32_bf16(Bt[n][k], At[m][k], acc[ai][bj][m][n], 0, 0, 0); __builtin_amdgcn_s_setprio(0); } while (0)
#define PG8_WAIT_V(n) asm volatile("s_waitcnt vmcnt(" #n ")" ::: "memory")
#define PG8_WAIT_L(n) asm volatile("s_waitcnt lgkmcnt(" #n ")" ::: "memory")
#define PG8_BAR __builtin_amdgcn_s_barrier()
#define PG8_SCHED __builtin_amdgcn_sched_barrier(0)
    Unit cur, nxt; int ui = 0;
    if (!S.next(0, cur)) return;
    f32x4 acc[2][2][4][2];
#pragma unroll
    for (int a = 0; a < 2; ++a)
#pragma unroll
        for (int b = 0; b < 2; ++b)
#pragma unroll
            for (int m = 0; m < 4; ++m)
#pragma unroll
                for (int n = 0; n < 2; ++n) acc[a][b][m][n] = (f32x4){0.f, 0.f, 0.f, 0.f};
    bf16x8 At[4][2], B0[2][2], B1[2][2];
    const char *cA, *cB0, *cB1; S.ptrs(cur, cA, cB0, cB1);
    int nt = S.nt(cur); asm volatile("" : "+s"(nt));
    PG8_STAGE(PG8_SB(0, 0), cB0, voffB); PG8_STAGE(PG8_SB(0, 1), cB1, voffB); PG8_STAGE(PG8_SA(0, 0), cA, voffA); PG8_STAGE(PG8_SA(0, 1), cA + hstepA, voffA);
    if (wr == 1) PG8_BAR;
    PG8_WAIT_V(2); PG8_BAR;
    PG8_STAGE(PG8_SB(1, 0), cB0 + kstep, voffB); PG8_STAGE(PG8_SA(1, 0), cA + kstep, voffA); PG8_STAGE(PG8_SB(1, 1), cB1 + kstep, voffB);
    PG8_WAIT_V(6); PG8_BAR;
    for (;;) {
        const bool has_next = S.next(ui + 1, nxt);
        const char *nA = cA, *nB0 = cB0, *nB1 = cB1; if (has_next) S.ptrs(nxt, nA, nB0, nB1);
#pragma unroll 1
        for (int t = 0; t < nt; t += 2) {
            const bool last = (t == nt - 2);
            if constexpr (Epi::HAS_MID) { if (t == E.mid_t) E.mid(acc, cur, wr, wc, fr, fq); }
            const char* a1 = cA + (size_t)(t + 1) * kstep;
            const char* a2 = last ? nA : cA + (size_t)(t + 2) * kstep; const char* b2 = last ? nB0 : cB0 + (size_t)(t + 2) * kstep; const char* b2h = last ? nB1 : cB1 + (size_t)(t + 2) * kstep;
            const char* a3 = a2 + kstep; const char* b3 = b2 + kstep; const char* b3h = b2h + kstep;
            PG8_LDB(B0, 0, 0); PG8_LDB(B1, 0, 1); PG8_SCHED; PG8_LDA(At, 0, 0); PG8_STAGE(PG8_SA(1, 1), a1 + hstepA, voffA);
            PG8_WAIT_V(8); PG8_WAIT_L(0); PG8_BAR; PG8_MMA(0, 0, At, B0); PG8_MMA(0, 1, At, B1); PG8_BAR; PG8_SCHED;
            PG8_LDA(At, 0, 1); PG8_STAGE(PG8_SB(0, 0), b2, voffB); PG8_STAGE(PG8_SB(0, 1), b2h, voffB); PG8_STAGE(PG8_SA(0, 0), a2, voffA);
            PG8_WAIT_V(8); PG8_WAIT_L(0); PG8_BAR; PG8_MMA(1, 0, At, B0); PG8_MMA(1, 1, At, B1); PG8_BAR; PG8_SCHED;
            PG8_LDB(B0, 1, 0); PG8_LDB(B1, 1, 1); PG8_SCHED; PG8_LDA(At, 1, 0); PG8_STAGE(PG8_SA(0, 1), a2 + hstepA, voffA);
            PG8_WAIT_V(8); PG8_WAIT_L(0); PG8_BAR; PG8_MMA(0, 0, At, B0); PG8_MMA(0, 1, At, B1); PG8_BAR; PG8_SCHED;
            PG8_LDA(At, 1, 1); PG8_STAGE(PG8_SB(1, 0), b3, voffB); PG8_STAGE(PG8_SB(1, 1), b3h, voffB); PG8_STAGE(PG8_SA(1, 0), a3, voffA);
            PG8_WAIT_V(8); PG8_WAIT_L(0); PG8_BAR; PG8_MMA(1, 0, At, B0); PG8_MMA(1, 1, At, B1); PG8_BAR; PG8_SCHED;
        }
        if constexpr (ALIGN_EPI) { if (wr == 0) PG8_BAR; }
        E(acc, cur, wr, wc, fr, fq);
        if (!has_next) break;
#pragma unroll
        for (int a = 0; a < 2; ++a)
#pragma unroll
            for (int b = 0; b < 2; ++b)
#pragma unroll
                for (int m = 0; m < 4; ++m)
#pragma unroll
                    for (int n = 0; n < 2; ++n) acc[a][b][m][n] = (f32x4){0.f, 0.f, 0.f, 0.f};
        cur = nxt; cA = nA; cB0 = nB0; cB1 = nB1; ++ui; nt = S.nt(cur); asm volatile("" : "+s"(nt));
        if constexpr (ALIGN_EPI) { if (wr == 1) PG8_BAR; }
    }
    PG8_WAIT_V(0);
    if constexpr (!ALIGN_EPI) { if (wr == 0) PG8_BAR; }
    PG8_BAR;
#undef PG8_SA
#undef PG8_SB
#undef PG8_STAGE
#undef PG8_LDA
#undef PG8_LDB
#undef PG8_MMA
#undef PG8_WAIT_V
#undef PG8_WAIT_L
#undef PG8_BAR
#undef PG8_SCHED
}

__device__ __forceinline__ float rstd16(const float* p) { const f32x4 a = ((const f32x4*)p)[0], b = ((const f32x4*)p)[1], c = ((const f32x4*)p)[2], d = ((const f32x4*)p)[3];
    const float s = ((a.x + a.y) + (a.z + a.w)) + ((b.x + b.y) + (b.z + b.w)) + ((c.x + c.y) + (c.z + c.w)) + ((d.x + d.y) + (d.z + d.w)); return __builtin_amdgcn_rsqf(s * (1.f / D) + EPS); }
__device__ __forceinline__ u32x4 pack8(const f32x4 v0, const f32x4 v1) { u32x4 w; w.x = cvt_pk_bf16(v0[0], v0[1]); w.y = cvt_pk_bf16(v0[2], v0[3]); w.z = cvt_pk_bf16(v1[0], v1[1]); w.w = cvt_pk_bf16(v1[2], v1[3]); return w; }
__device__ __forceinline__ float sq8(const f32x4 a, const f32x4 b) { return ((a[0] * a[0] + a[1] * a[1]) + (a[2] * a[2] + a[3] * a[3])) + ((b[0] * b[0] + b[1] * b[1]) + (b[2] * b[2] + b[3] * b[3])); }

struct EpiInProjF {
    static constexpr bool PERM = true, HAS_MID = false; int mid_t;
    const float* rstd0; bf16_t *XR, *GG, *Qs, *Ks, *Vs; unsigned* kmax;
    __device__ __forceinline__ void mid(f32x4 (&)[2][2][4][2], const Unit&, int, int, int, int) const {}
    __device__ __forceinline__ void operator()(const f32x4 (&acc)[2][2][4][2], const Unit& u, int wr, int wc, int fr, int fq) const {
        const int row0 = u.pm * BM + wr * 64 + fr, t = u.pn >> 1, colt = (u.pn & 1) * 256 + wc * 32 + 8 * fq;
        bf16_t* base = (t == 0) ? XR : (t == 1) ? GG : (t == 2) ? Qs : (t == 3) ? Ks : Vs;
        float km0 = 0.f, km1 = 0.f;
#pragma unroll
        for (int ai = 0; ai < 2; ++ai)
#pragma unroll
            for (int m = 0; m < 4; ++m) { const int r = row0 + ai * HALF + m * 16; const float rs = rstd0[r]; bf16_t* rowp = base + (size_t)r * 512 + colt;
#pragma unroll
                for (int bj = 0; bj < 2; ++bj) { f32x4 v0 = acc[ai][bj][m][0] * rs, v1 = acc[ai][bj][m][1] * rs;
                    if (t == 1) {
#pragma unroll
                        for (int e = 0; e < 4; ++e) { v0[e] = gelu_tanh(v0[e]); v1[e] = gelu_tanh(v1[e]); } }
                    else if (t == 2) { v0 = v0 * (0.125f * LOG2E); v1 = v1 * (0.125f * LOG2E); }
                    else if (t == 3) { float mx = 0.f;
#pragma unroll
                        for (int e = 0; e < 4; ++e) mx = fmaxf(mx, fmaxf(fabsf(v0[e]), fabsf(v1[e])));
                        if (bj == 0) km0 = fmaxf(km0, mx); else km1 = fmaxf(km1, mx); }
                    *(u32x4*)(rowp + bj * HALF) = pack8(v0, v1); } }
        if (t == 3) {
#pragma unroll
            for (int o = 1; o < 64; o <<= 1) { km0 = fmaxf(km0, __shfl_xor(km0, o)); km1 = fmaxf(km1, __shfl_xor(km1, o)); }
            if ((fr | fq) == 0) { const int b = (u.pm * BM) / SEQ, hd = (u.pn & 1) * 4 + (wc >> 1);
                atomicMax(kmax + b * 8 + hd, __float_as_uint(km0)); atomicMax(kmax + b * 8 + hd + 2, __float_as_uint(km1)); }
        }
    }
};
struct EpiBf16F {
    static constexpr bool PERM = true, HAS_MID = false; int mid_t;
    bf16_t* O; const float* ssq16; int ldo; float scale; size_t tstride;
    __device__ __forceinline__ void mid(f32x4 (&)[2][2][4][2], const Unit&, int, int, int, int) const {}
    __device__ __forceinline__ void operator()(const f32x4 (&acc)[2][2][4][2], const Unit& u, int wr, int wc, int fr, int fq) const {
        const int row0 = u.pm * BM + wr * 64 + fr, col0 = (tstride ? 0 : u.pn * BM) + wc * 32 + 8 * fq; bf16_t* base = O + (size_t)u.pn * tstride;
#pragma unroll
        for (int ai = 0; ai < 2; ++ai)
#pragma unroll
            for (int m = 0; m < 4; ++m) { const int r = row0 + ai * HALF + m * 16; const float rs = (ssq16 ? rstd16(ssq16 + (size_t)r * 16) : 1.f) * scale; bf16_t* rowp = base + (size_t)r * ldo + col0;
#pragma unroll
                for (int bj = 0; bj < 2; ++bj) *(u32x4*)(rowp + bj * HALF) = pack8(acc[ai][bj][m][0] * rs, acc[ai][bj][m][1] * rs); }
    }
};
struct EpiX1F {
    static constexpr bool PERM = true, HAS_MID = true; int mid_t;
    const bf16_t* xb; const float* fmid; const float* fend; bf16_t* X1b; float* ssq1;
    __device__ __forceinline__ void mid(f32x4 (&acc)[2][2][4][2], const Unit& u, int wr, int wc, int fr, int fq) const {
        const int row0 = u.pm * BM + wr * 64 + fr;
#pragma unroll
        for (int ai = 0; ai < 2; ++ai)
#pragma unroll
            for (int m = 0; m < 4; ++m) { const float f = fmid[row0 + ai * HALF + m * 16];
#pragma unroll
                for (int bj = 0; bj < 2; ++bj) { acc[ai][bj][m][0] = acc[ai][bj][m][0] * f; acc[ai][bj][m][1] = acc[ai][bj][m][1] * f; } }
    }
    __device__ __forceinline__ void operator()(const f32x4 (&acc)[2][2][4][2], const Unit& u, int wr, int wc, int fr, int fq) const {
        const int row0 = u.pm * BM + wr * 64 + fr, col0 = u.pn * BM + wc * 32 + 8 * fq;
#pragma unroll
        for (int ai = 0; ai < 2; ++ai)
#pragma unroll
            for (int m = 0; m < 4; ++m) { const int r = row0 + ai * HALF + m * 16; const float fe = fend[r]; float ss = 0.f;
#pragma unroll
                for (int bj = 0; bj < 2; ++bj) { const u32x4 xi = *(const u32x4*)(xb + (size_t)r * D + col0 + bj * HALF);
                    f32x4 v0, v1; v0[0] = __uint_as_float(xi.x << 16); v0[1] = __uint_as_float(xi.x & 0xffff0000u); v0[2] = __uint_as_float(xi.y << 16); v0[3] = __uint_as_float(xi.y & 0xffff0000u);
                    v1[0] = __uint_as_float(xi.z << 16); v1[1] = __uint_as_float(xi.z & 0xffff0000u); v1[2] = __uint_as_float(xi.w << 16); v1[3] = __uint_as_float(xi.w & 0xffff0000u);
                    v0 = v0 + acc[ai][bj][m][0] * fe; v1 = v1 + acc[ai][bj][m][1] * fe;
                    ss += sq8(v0, v1); *(u32x4*)(X1b + (size_t)r * D + col0 + bj * HALF) = pack8(v0, v1); }
                ss += __shfl_xor(ss, 16); ss += __shfl_xor(ss, 32);
                if (fq == 0) ssq1[(size_t)r * 16 + u.pn * 4 + wc] = ss; }
    }
};
struct EpiResF {
    static constexpr bool PERM = true, HAS_MID = false; int mid_t;
    const bf16_t* Xi; bf16_t* Xo; float* ssq;
    __device__ __forceinline__ void mid(f32x4 (&)[2][2][4][2], const Unit&, int, int, int, int) const {}
    __device__ __forceinline__ void operator()(const f32x4 (&acc)[2][2][4][2], const Unit& u, int wr, int wc, int fr, int fq) const {
        const int row0 = u.pm * BM + wr * 64 + fr, col0 = u.pn * BM + wc * 32 + 8 * fq;
#pragma unroll
        for (int ai = 0; ai < 2; ++ai)
#pragma unroll
            for (int m = 0; m < 4; ++m) { const int r = row0 + ai * HALF + m * 16; float ss = 0.f;
#pragma unroll
                for (int bj = 0; bj < 2; ++bj) { const u32x4 xi = *(const u32x4*)(Xi + (size_t)r * D + col0 + bj * HALF);
                    f32x4 v0, v1; v0[0] = __uint_as_float(xi.x << 16); v0[1] = __uint_as_float(xi.x & 0xffff0000u); v0[2] = __uint_as_float(xi.y << 16); v0[3] = __uint_as_float(xi.y & 0xffff0000u);
                    v1[0] = __uint_as_float(xi.z << 16); v1[1] = __uint_as_float(xi.z & 0xffff0000u); v1[2] = __uint_as_float(xi.w << 16); v1[3] = __uint_as_float(xi.w & 0xffff0000u);
                    v0 = v0 + acc[ai][bj][m][0]; v1 = v1 + acc[ai][bj][m][1];
                    ss += sq8(v0, v1); *(u32x4*)(Xo + (size_t)r * D + col0 + bj * HALF) = pack8(v0, v1); }
                ss += __shfl_xor(ss, 16); ss += __shfl_xor(ss, 32);
                if (fq == 0) ssq[(size_t)r * 16 + u.pn * 4 + wc] = ss; }
    }
};

__device__ __forceinline__ void pair_ab(int p, int& a, int& b) { a = (p < 3) ? 0 : (p < 5) ? 1 : 2; b = (p < 3) ? p + 1 : (p < 5) ? p - 1 : 3; }
__device__ __forceinline__ int moe_class_of_tile(const PG8_LAS int* meta, int T) { int c = 0;
#pragma unroll
    for (int k = 1; k < 24; ++k) c += (T >= __builtin_amdgcn_readfirstlane(meta[64 + k])) ? 1 : 0;
    return c; }
struct MoeOrder1 {
    __device__ __forceinline__ int nt(const Unit&) const { return D / BK; }
    const bf16_t* XG; const bf16_t* Wg; const bf16_t* Wu; const PG8_LAS int* meta; int G, c;
    __device__ bool next(int i, Unit& u) const { const int L = i * G + c, nt = __builtin_amdgcn_readfirstlane(meta[64 + 24]); if (L >= nt * 4) return false;
        u.pm = L >> 2; u.pn = moe_class_of_tile(meta, L >> 2) * 4 + (L & 3); return true; }
    __device__ __forceinline__ void ptrs(const Unit& u, const char*& a, const char*& b0, const char*& b1) const {
        const int cls = u.pn >> 2, j = (u.pn >> 1) & 1, half = u.pn & 1; int ea, eb; pair_ab(cls % 6, ea, eb); const int e = (cls / 6) * 4 + (j ? eb : ea);
        a = (const char*)XG + (size_t)u.pm * BM * D * 2; const size_t bo = ((size_t)e * DE + half * HALF) * D * 2; b0 = (const char*)Wg + bo; b1 = (const char*)Wu + bo; }
};
struct MoeOrder2 {
    __device__ __forceinline__ int nt(const Unit&) const { return 512 / BK; }
    const bf16_t* HID; const bf16_t* Wd2; const PG8_LAS int* meta; int G, c;
    __device__ bool next(int i, Unit& u) const { const int L = i * G + c, nt = __builtin_amdgcn_readfirstlane(meta[64 + 24]); if (L >= nt * 4) return false;
        u.pm = L >> 2; u.pn = moe_class_of_tile(meta, L >> 2) * 4 + (L & 3); return true; }
    __device__ __forceinline__ void ptrs(const Unit& u, const char*& a, const char*& b0, const char*& b1) const {
        a = (const char*)HID + (size_t)u.pm * BM * 512 * 2; b0 = (const char*)Wd2 + ((size_t)(u.pn >> 2) * D + (u.pn & 3) * BM) * 512 * 2; b1 = b0 + (size_t)HALF * 512 * 2; }
};
struct EpiMoeUp {
    static constexpr bool PERM = true, HAS_MID = false; int mid_t;
    const float* rsg; const float* wAg; const float* wBg; bf16_t* HID;
    __device__ __forceinline__ void mid(f32x4 (&)[2][2][4][2], const Unit&, int, int, int, int) const {}
    __device__ __forceinline__ void operator()(const f32x4 (&acc)[2][2][4][2], const Unit& u, int wr, int wc, int fr, int fq) const {
        const int row0 = u.pm * BM + wr * 64 + fr, j = (u.pn >> 1) & 1, col0 = j * 256 + (u.pn & 1) * HALF + wc * 32 + 8 * fq; const float* wg = j ? wBg : wAg;
#pragma unroll
        for (int ai = 0; ai < 2; ++ai)
#pragma unroll
            for (int m = 0; m < 4; ++m) { const int r = row0 + ai * HALF + m * 16; const float rs = rsg[r], w = wg[r]; f32x4 h0, h1;
#pragma unroll
                for (int e = 0; e < 4; ++e) { const float g0 = acc[ai][0][m][0][e] * rs, g1 = acc[ai][0][m][1][e] * rs;
                    h0[e] = g0 * __builtin_amdgcn_rcpf(1.f + __expf(-g0)) * (acc[ai][1][m][0][e] * rs) * w; h1[e] = g1 * __builtin_amdgcn_rcpf(1.f + __expf(-g1)) * (acc[ai][1][m][1][e] * rs) * w; }
                *(u32x4*)(HID + (size_t)r * 512 + col0) = pack8(h0, h1); }
    }
};
struct EpiMoeDown {
    static constexpr bool PERM = true, HAS_MID = false; int mid_t;
    const int* tokg; const bf16_t* Xi; bf16_t* Xo; float* ssq;
    __device__ __forceinline__ void mid(f32x4 (&)[2][2][4][2], const Unit&, int, int, int, int) const {}
    __device__ __forceinline__ void operator()(const f32x4 (&acc)[2][2][4][2], const Unit& u, int wr, int wc, int fr, int fq) const {
        const int row0 = u.pm * BM + wr * 64 + fr, ct = u.pn & 3, col0 = ct * BM + wc * 32 + 8 * fq;
#pragma unroll
        for (int ai = 0; ai < 2; ++ai)
#pragma unroll
            for (int m = 0; m < 4; ++m) { const int tok = tokg[row0 + ai * HALF + m * 16];
                if (tok >= 0) { float ss = 0.f;
#pragma unroll
                    for (int bj = 0; bj < 2; ++bj) { const u32x4 xi = *(const u32x4*)(Xi + (size_t)tok * D + col0 + bj * HALF);
                        f32x4 v0, v1; v0[0] = __uint_as_float(xi.x << 16); v0[1] = __uint_as_float(xi.x & 0xffff0000u); v0[2] = __uint_as_float(xi.y << 16); v0[3] = __uint_as_float(xi.y & 0xffff0000u);
                        v1[0] = __uint_as_float(xi.z << 16); v1[1] = __uint_as_float(xi.z & 0xffff0000u); v1[2] = __uint_as_float(xi.w << 16); v1[3] = __uint_as_float(xi.w & 0xffff0000u);
                        v0 = v0 + acc[ai][bj][m][0]; v1 = v1 + acc[ai][bj][m][1];
                        ss += sq8(v0, v1); *(u32x4*)(Xo + (size_t)tok * D + col0 + bj * HALF) = pack8(v0, v1); }
                    ss += __shfl_xor(ss, 16); ss += __shfl_xor(ss, 32);
                    if (fq == 0) ssq[(size_t)tok * 16 + ct * 4 + wc] = ss; } }
    }
};

struct XaChainOrder {
    const bf16_t* X1b; const bf16_t* Wq_t; const bf16_t* QX; const bf16_t* KM; const bf16_t* VT; int G, c, nu;
    __device__ void init(int G_, int c_) { G = G_; c = c_; const int tot = (NTOK / BM) * XH; nu = (tot - c + G - 1) / G; }
    __device__ bool next(int i, Unit& u) const { if (i >= 3 * nu) return false; const int kind = i / nu, L = (i % nu) * G + c; u.pm = L >> 2; u.pn = (L & 3) | (kind << 8); return true; }
    __device__ __forceinline__ int nt(const Unit& u) const { return (u.pn >> 8) == 0 ? D / BK : XD / BK; }
    __device__ __forceinline__ void ptrs(const Unit& u, const char*& a, const char*& b0, const char*& b1) const {
        const int kind = u.pn >> 8, h = u.pn & 3, b = u.pm / (SEQ / BM);
        if (kind == 0) { a = (const char*)X1b + (size_t)u.pm * BM * D * 2; b0 = (const char*)Wq_t + (size_t)h * XD * D * 2; }
        else { a = (const char*)QX + ((size_t)u.pm * BM * D + h * XD) * 2;
            b0 = (kind == 1) ? (const char*)KM + ((size_t)b * MEM * D + h * XD) * 2 : (const char*)VT + ((size_t)b * D + h * XD) * D * 2; }
        b1 = b0 + (size_t)HALF * D * 2; }
};
struct EpiXaChain {
    static constexpr bool PERM = true, HAS_MID = false; int mid_t;
    bf16_t* QX; bf16_t* OX; const float* ssq1; float qscale; PG8_LAS float* xch;
    __device__ __forceinline__ void mid(f32x4 (&)[2][2][4][2], const Unit&, int, int, int, int) const {}
    __device__ __forceinline__ void operator()(f32x4 (&acc)[2][2][4][2], const Unit& u, int wr, int wc, int fr, int fq) const {
        const int kind = u.pn >> 8, row0 = u.pm * BM + wr * 64 + fr, col0 = (u.pn & 3) * XD + wc * 32 + 8 * fq;
        if (kind != 1) {
            bf16_t* O = kind == 0 ? QX : OX;
#pragma unroll
            for (int ai = 0; ai < 2; ++ai)
#pragma unroll
                for (int m = 0; m < 4; ++m) { const int r = row0 + ai * HALF + m * 16; const float rs = kind == 0 ? rstd16(ssq1 + (size_t)r * 16) * qscale : 1.f; bf16_t* rowp = O + (size_t)r * D + col0;
#pragma unroll
                    for (int bj = 0; bj < 2; ++bj) *(u32x4*)(rowp + bj * HALF) = pack8(acc[ai][bj][m][0] * rs, acc[ai][bj][m][1] * rs); }
            return;
        }
        PG8_LAS float* xm = xch; PG8_LAS float* xs = xch + 1024;
#pragma unroll
        for (int ai = 0; ai < 2; ++ai)
#pragma unroll
            for (int m = 0; m < 4; ++m) { float mx = -INFINITY;
#pragma unroll
                for (int bj = 0; bj < 2; ++bj)
#pragma unroll
                    for (int n = 0; n < 2; ++n) { const f32x4 v = acc[ai][bj][m][n]; mx = fmaxf(mx, fmaxf(fmaxf(v[0], v[1]), fmaxf(v[2], v[3]))); }
                mx = fmaxf(mx, __shfl_xor(mx, 16)); mx = fmaxf(mx, __shfl_xor(mx, 32));
                if (fq == 0) xm[(ai * HALF + wr * 64 + m * 16 + fr) * 4 + wc] = mx; asm volatile("" ::: "memory"); }
        asm volatile("s_waitcnt lgkmcnt(0)" ::: "memory"); __builtin_amdgcn_s_barrier(); asm volatile("" ::: "memory");
#pragma unroll
        for (int ai = 0; ai < 2; ++ai)
#pragma unroll
            for (int m = 0; m < 4; ++m) { const int rl = ai * HALF + wr * 64 + m * 16 + fr; const f32x4 q = *(const PG8_LAS f32x4*)(xm + rl * 4);
                const float mx = fmaxf(fmaxf(q[0], q[1]), fmaxf(q[2], q[3])); float ss = 0.f;
#pragma unroll
                for (int bj = 0; bj < 2; ++bj)
#pragma unroll
                    for (int n = 0; n < 2; ++n) { f32x4 v = acc[ai][bj][m][n];
#pragma unroll
                        for (int e = 0; e < 4; ++e) { v[e] = __builtin_amdgcn_exp2f(v[e] - mx); ss += v[e]; }
                        acc[ai][bj][m][n] = v; }
                ss += __shfl_xor(ss, 16); ss += __shfl_xor(ss, 32);
                if (fq == 0) xs[rl * 4 + wc] = ss; asm volatile("" ::: "memory"); }
        asm volatile("s_waitcnt lgkmcnt(0)" ::: "memory"); __builtin_amdgcn_s_barrier(); asm volatile("" ::: "memory");
#pragma unroll
        for (int ai = 0; ai < 2; ++ai)
#pragma unroll
            for (int m = 0; m < 4; ++m) { const int rl = ai * HALF + wr * 64 + m * 16 + fr; const f32x4 q = *(const PG8_LAS f32x4*)(xs + rl * 4);
                const float inv = __builtin_amdgcn_rcpf((q[0] + q[1]) + (q[2] + q[3])); bf16_t* rowp = QX + (size_t)(row0 + ai * HALF + m * 16) * D + col0;
#pragma unroll
                for (int bj = 0; bj < 2; ++bj) *(u32x4*)(rowp + bj * HALF) = pack8(acc[ai][bj][m][0] * inv, acc[ai][bj][m][1] * inv); asm volatile("" ::: "memory"); }
    }
};
struct KvOrder {
    __device__ __forceinline__ int nt(const Unit&) const { return D / BK; }
    const bf16_t* memn; const bf16_t* Wk_t; const bf16_t* Wv_t; int G, c;
    __device__ bool next(int i, Unit& u) const { const int L = i * G + c; if (L >= 64) return false; if (L < 32) { u.pm = L >> 2; u.pn = L & 3; } else { u.pm = (L - 32) >> 3; u.pn = ((L - 32) & 7) | 256; } return true; }
    __device__ __forceinline__ void ptrs(const Unit& u, const char*& a, const char*& b0, const char*& b1) const {
        const bool vt = (u.pn & 256) != 0; const int pn = u.pn & 255;
        a = (const char*)(vt ? Wv_t : memn) + (size_t)u.pm * BM * D * 2; b0 = (const char*)(vt ? memn : Wk_t) + (size_t)pn * BM * D * 2; b1 = b0 + (size_t)HALF * D * 2; }
};
struct EpiKv {
    static constexpr bool PERM = true, HAS_MID = false; int mid_t;
    bf16_t* KM; bf16_t* VT;
    __device__ __forceinline__ void mid(f32x4 (&)[2][2][4][2], const Unit&, int, int, int, int) const {}
    __device__ __forceinline__ void operator()(const f32x4 (&acc)[2][2][4][2], const Unit& u, int wr, int wc, int fr, int fq) const {
        const bool vt = (u.pn & 256) != 0; const int pn = u.pn & 255, row0 = u.pm * BM + wr * 64 + fr, cw = wc * 32 + 8 * fq;
        bf16_t* base = vt ? VT + (size_t)pn * D * D : KM + pn * BM; const int ldo = D;
#pragma unroll
        for (int ai = 0; ai < 2; ++ai)
#pragma unroll
            for (int m = 0; m < 4; ++m) { bf16_t* rowp = base + (size_t)(row0 + ai * HALF + m * 16) * ldo + cw;
#pragma unroll
                for (int bj = 0; bj < 2; ++bj) *(u32x4*)(rowp + bj * HALF) = pack8(acc[ai][bj][m][0], acc[ai][bj][m][1]); }
    }
};

struct EpiMoeFinal {
    static constexpr bool PERM = true, HAS_MID = false; int mid_t;
    const int* tokg; const bf16_t* Xi; float* out; float* ssq; unsigned* cnt; const float* g; PG8_LAS unsigned* flag; unsigned* tmo;
    __device__ __forceinline__ void mid(f32x4 (&)[2][2][4][2], const Unit&, int, int, int, int) const {}
    __device__ __forceinline__ void operator()(f32x4 (&acc)[2][2][4][2], const Unit& u, int wr, int wc, int fr, int fq) const {
        const int row0 = u.pm * BM + wr * 64 + fr, ct = u.pn & 3, col0 = ct * BM + wc * 32 + 8 * fq;
#pragma unroll
        for (int ai = 0; ai < 2; ++ai)
#pragma unroll
            for (int m = 0; m < 4; ++m) { const int tok = tokg[row0 + ai * HALF + m * 16];
                if (tok >= 0) { float ss = 0.f;
#pragma unroll
                    for (int bj = 0; bj < 2; ++bj) { const u32x4 xi = *(const u32x4*)(Xi + (size_t)tok * D + col0 + bj * HALF);
                        f32x4 v0, v1; v0[0] = __uint_as_float(xi.x << 16); v0[1] = __uint_as_float(xi.x & 0xffff0000u); v0[2] = __uint_as_float(xi.y << 16); v0[3] = __uint_as_float(xi.y & 0xffff0000u);
                        v1[0] = __uint_as_float(xi.z << 16); v1[1] = __uint_as_float(xi.z & 0xffff0000u); v1[2] = __uint_as_float(xi.w << 16); v1[3] = __uint_as_float(xi.w & 0xffff0000u);
                        v0 = v0 + acc[ai][bj][m][0]; v1 = v1 + acc[ai][bj][m][1]; acc[ai][bj][m][0] = v0; acc[ai][bj][m][1] = v1; ss += sq8(v0, v1); }
                    ss += __shfl_xor(ss, 16); ss += __shfl_xor(ss, 32);
                    if (fq == 0) __hip_atomic_store(ssq + (size_t)tok * 16 + ct * 4 + wc, ss, __ATOMIC_RELAXED, __HIP_MEMORY_SCOPE_AGENT); }
                asm volatile("" ::: "memory"); }
        asm volatile("s_waitcnt vmcnt(0) lgkmcnt(0)" ::: "memory"); __builtin_amdgcn_s_barrier(); asm volatile("" ::: "memory");
        const int tid = threadIdx.x;
        if (tid < 64) {
            if (tid == 0) __hip_atomic_fetch_add(cnt + 16 * u.pm, 1u, __ATOMIC_RELAXED, __HIP_MEMORY_SCOPE_AGENT);
            unsigned spins = 0; bool dead = false;
            while ((unsigned)__builtin_amdgcn_readfirstlane(__hip_atomic_load(cnt + 16 * u.pm, __ATOMIC_RELAXED, __HIP_MEMORY_SCOPE_AGENT)) < 4u) {
                __builtin_amdgcn_s_sleep(2); if (++spins > (1u << 20)) { dead = true; break; } }
            __builtin_amdgcn_fence(__ATOMIC_ACQUIRE, "agent");
            if (tid == 0) { flag[0] = dead ? 1u : 0u; if (dead) __hip_atomic_store(tmo, 1u, __ATOMIC_RELAXED, __HIP_MEMORY_SCOPE_AGENT); }
        }
        asm volatile("s_waitcnt vmcnt(0) lgkmcnt(0)" ::: "memory"); __builtin_amdgcn_s_barrier(); asm volatile("" ::: "memory");
        f32x4 gv[2][2];
#pragma unroll
        for (int bj = 0; bj < 2; ++bj) { gv[bj][0] = *(const f32x4*)(g + col0 + bj * HALF); gv[bj][1] = *(const f32x4*)(g + col0 + bj * HALF + 4); }
#pragma unroll
        for (int ai = 0; ai < 2; ++ai)
#pragma unroll
            for (int m = 0; m < 4; ++m) { const int tok = tokg[row0 + ai * HALF + m * 16];
                if (tok >= 0) { const float rs = rstd16(ssq + (size_t)tok * 16); float* orow = out + (size_t)tok * D + col0;
#pragma unroll
                    for (int bj = 0; bj < 2; ++bj) { *(f32x4*)(orow + bj * HALF) = acc[ai][bj][m][0] * rs * gv[bj][0]; *(f32x4*)(orow + bj * HALF + 4) = acc[ai][bj][m][1] * rs * gv[bj][1]; } }
                asm volatile("" ::: "memory"); }
    }
};
}
namespace sba {
typedef float f32x16 __attribute__((ext_vector_type(16)));
typedef short s16x4 __attribute__((ext_vector_type(4)));
typedef short v4i16_t __attribute__((ext_vector_type(4)));
typedef __attribute__((address_space(3))) const char* lds_cptr;
constexpr int SLOTB = 8192, L_K = 0, L_V = 2 * SLOTB, L_FLAG = 4 * SLOTB, L_OST = L_FLAG + 256, L_BYTES = L_OST + 8 * 4096;
__device__ __forceinline__ int crow(int r, int hi) { return (r & 3) + 8 * (r >> 2) + 4 * hi; }
__device__ __forceinline__ void glds16(const void* gsrc, unsigned lds_dst) { unsigned keep;
    asm volatile("s_mov_b32 %0, m0\n\ts_mov_b32 m0, %2\n\ts_nop 0\n\tglobal_load_lds_dwordx4 %1, off\n\ts_mov_b32 m0, %0" : "=&s"(keep) : "v"(gsrc), "s"(lds_dst) : "memory"); }
typedef float f32x2_t __attribute__((ext_vector_type(2))); typedef __bf16 bf16x2_t __attribute__((ext_vector_type(2)));
__device__ __forceinline__ unsigned cvtpk(float lo, float hi) { f32x2_t v = {lo, hi}; bf16x2_t b = __builtin_convertvector(v, bf16x2_t); return __builtin_bit_cast(unsigned, b); }
__device__ __forceinline__ s16x4 vtr(lds_cptr p) { return __builtin_bit_cast(s16x4, __builtin_amdgcn_ds_read_tr16_b64_v4i16((__attribute__((address_space(3))) v4i16_t*)p)); }

#define SBA_GROUP(Z, OM, g) do { \
        float d_ = acc_ * (hi ? 1.f : gp_##OM[g]); acc_ *= gs_##OM[g] * gp_##OM[g]; \
        Z[4 * (g) + 3] *= d_; d_ *= OM[4 * (g) + 3]; Z[4 * (g) + 2] *= d_; d_ *= OM[4 * (g) + 2]; Z[4 * (g) + 1] *= d_; d_ *= OM[4 * (g) + 1]; Z[4 * (g)] *= d_; } while (0)

__device__ __forceinline__ void sb_unit(int b, int h, int qb, const bf16_t* Qs, const bf16_t* Ks, const bf16_t* Vs, bf16_t* YY, float* ssq_s8, char* shm) {
    int tid_ = threadIdx.x; asm volatile("" : "+v"(tid_));
    const int tid = tid_, lane = tid & 63, r32 = lane & 31, hi = lane >> 5; const int wid = __builtin_amdgcn_readfirstlane(tid >> 6);
#define SSTAMP(k) do { if (PROBE_A >= 300 && blockIdx.x == 60 && b == 0 && tid == 0) ((__attribute__((address_space(3))) unsigned long long*)(shm + 147200))[16 + (k)] = __builtin_amdgcn_s_memrealtime(); } while (0)
    SSTAMP(0);
    const size_t rowbase = (size_t)b * SEQ; const int q0 = qb * 256;
    const bf16_t* Kh = Ks + rowbase * SBW + h * HD; const bf16_t* Vh = Vs + rowbase * SBW + h * HD;
    const unsigned lds0 = (unsigned)(uintptr_t)shm;
    const lds_cptr shm3 = (lds_cptr)shm;
    const bf16_t* ksrc = Kh + (size_t)lane * SBW + wid * 8;
    const bf16_t* vsrc = Vh + (size_t)(16 * (wid & 3) + (lane >> 2)) * SBW + (wid >> 2) * 32 + (lane & 3) * 8;
    const unsigned kdst = lds0 + L_K + wid * 1024, vdst = lds0 + L_V + wid * 1024;
#define DMA_KV(t, slot) do { glds16(ksrc + (size_t)(t) * 64 * SBW, (unsigned)__builtin_amdgcn_readfirstlane(kdst + (slot))); glds16(vsrc + (size_t)(t) * 64 * SBW, (unsigned)__builtin_amdgcn_readfirstlane(vdst + (slot))); } while (0)
    const lds_cptr kp0 = shm3 + L_K + hi * 1024 + r32 * 16;
    const lds_cptr vp0 = shm3 + L_V + ((lane >> 4) & 1) * 32 + (lane & 3) * 8 + (4 * hi + ((lane & 15) >> 2)) * 64;
    volatile __attribute__((address_space(3))) unsigned* flags = (volatile __attribute__((address_space(3))) unsigned*)(shm3 + L_FLAG);
    int tile = 4 * qb + 3, slot = 0, it = 0;
    DMA_KV(tile, 0);
    const bf16_t* Qw = Qs + (rowbase + q0 + wid * 32 + r32) * SBW + h * HD;
    bf16x8 qr[4];
#pragma unroll
    for (int d0 = 0; d0 < 4; ++d0) qr[d0] = *(const bf16x8*)(Qw + d0 * 16 + hi * 8);
    float qn = 0.f;
#pragma unroll
    for (int d0 = 0; d0 < 4; ++d0)
#pragma unroll
        for (int e = 0; e < 8; ++e) qn += fabsf(bf2f((unsigned short)qr[d0][e]));
    qn += __shfl_xor(qn, 32);
    const int tq = q0 + wid * 32 + r32;
    const int tq_min = q0 + wid * 32, tq_max = tq_min + 31;
    float PR = 1.f;
    f32x16 o0 = {}, o1 = {};
    for (;;) {
        if (it < 4) SSTAMP(1 + it);
        const bool has_next = tile > 0;
        if (has_next) { DMA_KV(tile - 1, slot ^ SLOTB); asm volatile("s_waitcnt vmcnt(2)" ::: "memory"); }
        else asm volatile("s_waitcnt vmcnt(0)" ::: "memory");
        __builtin_amdgcn_s_barrier(); asm volatile("" ::: "memory");
        const int kmin = tile * 64;
        if (kmin < tq_max) {
            f32x16 z0, z1;
            {
                const lds_cptr kb = kp0 + slot; bf16x8 kf[8];
#pragma unroll
                for (int d0 = 0; d0 < 4; ++d0) { kf[2 * d0] = *(const __attribute__((address_space(3))) bf16x8*)(kb + d0 * 2048); kf[2 * d0 + 1] = *(const __attribute__((address_space(3))) bf16x8*)(kb + d0 * 2048 + 512); }
                __builtin_amdgcn_sched_barrier(0);
                z0 = __builtin_amdgcn_mfma_f32_32x32x16_bf16(kf[0], qr[0], (f32x16){}, 0, 0, 0); z1 = __builtin_amdgcn_mfma_f32_32x32x16_bf16(kf[1], qr[0], (f32x16){}, 0, 0, 0);
#pragma unroll
                for (int d0 = 1; d0 < 4; ++d0) { z0 = __builtin_amdgcn_mfma_f32_32x32x16_bf16(kf[2 * d0], qr[d0], z0, 0, 0, 0); z1 = __builtin_amdgcn_mfma_f32_32x32x16_bf16(kf[2 * d0 + 1], qr[d0], z1, 0, 0, 0); }
            }
            if (kmin + 63 >= tq_min) {
#pragma unroll
                for (int r = 0; r < 16; ++r) { const int kv = kmin + crow(r, hi); if (kv >= tq) z0[r] = -INFINITY; if (kv + 32 >= tq) z1[r] = -INFINITY; }
            }
            f32x16 m0, m1;
#pragma unroll
            for (int r = 0; r < 16; ++r) { const float e0 = __builtin_amdgcn_exp2f(fminf(z0[r], 120.f)), e1 = __builtin_amdgcn_exp2f(fminf(z1[r], 120.f));
                m0[r] = __builtin_amdgcn_rcpf(1.f + e0); m1[r] = __builtin_amdgcn_rcpf(1.f + e1); z0[r] = e0 * m0[r]; z1[r] = e1 * m1[r]; }
            float gs_m0[4], gs_m1[4], gp_m0[4], gp_m1[4];
#pragma unroll
            for (int g = 0; g < 4; ++g) { gs_m0[g] = (m0[4 * g] * m0[4 * g + 1]) * (m0[4 * g + 2] * m0[4 * g + 3]); gs_m1[g] = (m1[4 * g] * m1[4 * g + 1]) * (m1[4 * g + 2] * m1[4 * g + 3]); }
#pragma unroll
            for (int g = 0; g < 4; ++g) { const auto r0 = __builtin_amdgcn_permlane32_swap(__float_as_uint(gs_m0[g]), __float_as_uint(gs_m0[g]), false, false), r1 = __builtin_amdgcn_permlane32_swap(__float_as_uint(gs_m1[g]), __float_as_uint(gs_m1[g]), false, false);
                gp_m0[g] = __uint_as_float(hi ? r0[0] : r0[1]); gp_m1[g] = __uint_as_float(hi ? r1[0] : r1[1]); }
            float acc_ = PR;
            SBA_GROUP(z1, m1, 3); SBA_GROUP(z1, m1, 2); SBA_GROUP(z1, m1, 1); SBA_GROUP(z1, m1, 0);
            SBA_GROUP(z0, m0, 3); SBA_GROUP(z0, m0, 2); SBA_GROUP(z0, m0, 1); SBA_GROUP(z0, m0, 0);
            PR = acc_;
            u32x4 pw0, pw1, pw2, pw3;
            pw0 = (u32x4){cvtpk(z0[0], z0[1]), cvtpk(z0[2], z0[3]), cvtpk(z0[4], z0[5]), cvtpk(z0[6], z0[7])};
            pw1 = (u32x4){cvtpk(z0[8], z0[9]), cvtpk(z0[10], z0[11]), cvtpk(z0[12], z0[13]), cvtpk(z0[14], z0[15])};
            pw2 = (u32x4){cvtpk(z1[0], z1[1]), cvtpk(z1[2], z1[3]), cvtpk(z1[4], z1[5]), cvtpk(z1[6], z1[7])};
            pw3 = (u32x4){cvtpk(z1[8], z1[9]), cvtpk(z1[10], z1[11]), cvtpk(z1[12], z1[13]), cvtpk(z1[14], z1[15])};
            const lds_cptr vp = vp0 + slot;
#define SBA_VF(i) (bf16x8){vl[i][0], vl[i][1], vl[i][2], vl[i][3], vh[i][0], vh[i][1], vh[i][2], vh[i][3]}
            { s16x4 vl[4], vh[4];
#pragma unroll
                for (int i = 0; i < 4; ++i) { vl[i] = vtr(vp + i * 1024); vh[i] = vtr(vp + i * 1024 + 512); }
                __builtin_amdgcn_sched_barrier(0);
                o0 = __builtin_amdgcn_mfma_f32_32x32x16_bf16(__builtin_bit_cast(bf16x8, pw0), SBA_VF(0), o0, 0, 0, 0); o0 = __builtin_amdgcn_mfma_f32_32x32x16_bf16(__builtin_bit_cast(bf16x8, pw1), SBA_VF(1), o0, 0, 0, 0);
                o0 = __builtin_amdgcn_mfma_f32_32x32x16_bf16(__builtin_bit_cast(bf16x8, pw2), SBA_VF(2), o0, 0, 0, 0); o0 = __builtin_amdgcn_mfma_f32_32x32x16_bf16(__builtin_bit_cast(bf16x8, pw3), SBA_VF(3), o0, 0, 0, 0); }
            { s16x4 vl[4], vh[4];
#pragma unroll
                for (int i = 0; i < 4; ++i) { vl[i] = vtr(vp + 4096 + i * 1024); vh[i] = vtr(vp + 4096 + i * 1024 + 512); }
                __builtin_amdgcn_sched_barrier(0);
                o1 = __builtin_amdgcn_mfma_f32_32x32x16_bf16(__builtin_bit_cast(bf16x8, pw0), SBA_VF(0), o1, 0, 0, 0); o1 = __builtin_amdgcn_mfma_f32_32x32x16_bf16(__builtin_bit_cast(bf16x8, pw1), SBA_VF(1), o1, 0, 0, 0);
                o1 = __builtin_amdgcn_mfma_f32_32x32x16_bf16(__builtin_bit_cast(bf16x8, pw2), SBA_VF(2), o1, 0, 0, 0); o1 = __builtin_amdgcn_mfma_f32_32x32x16_bf16(__builtin_bit_cast(bf16x8, pw3), SBA_VF(3), o1, 0, 0, 0); }
#undef SBA_VF
        }
        const bool done = __all(PR == 0.f);
        if (lane == 0) flags[(it & 1) * 8 + wid] = done ? 1u : 0u;
        asm volatile("s_waitcnt lgkmcnt(0)" ::: "memory"); __builtin_amdgcn_s_barrier(); asm volatile("" ::: "memory");
        unsigned alld = 1u;
#pragma unroll
        for (int w = 0; w < 8; ++w) alld &= flags[(it & 1) * 8 + w];
        alld = __builtin_amdgcn_readfirstlane(alld);
        if (!has_next || alld) break;
        --tile; slot ^= SLOTB; ++it;
    }
    SSTAMP(5);
    if (PROBE_A >= 300 && blockIdx.x == 60 && b == 0 && tid == 0) { __attribute__((address_space(3))) unsigned long long* st_ = (__attribute__((address_space(3))) unsigned long long*)(shm + 147200) + 16; st_[8] = 0; st_[9] = (unsigned long long)(it + 1) * 100ull; }
    asm volatile("s_waitcnt vmcnt(0)" ::: "memory");
    {
        bf16_t* Ow = YY + (rowbase + q0 + wid * 32) * D + RW + h * HD;
        bf16_t* stg = (bf16_t*)(shm + L_OST) + wid * 2048;
#pragma unroll
        for (int r = 0; r < 16; ++r) { const int orow = crow(r, hi); stg[orow * 64 + r32] = (bf16_t)f2bf(o0[r]); stg[orow * 64 + 32 + r32] = (bf16_t)f2bf(o1[r]); }
        asm volatile("s_waitcnt lgkmcnt(0)" ::: "memory");
#pragma unroll
        for (int i = 0; i < 4; ++i) { const int row = i * 8 + (lane >> 3), ch = lane & 7; const u32x4 v = *(const u32x4*)(stg + row * 64 + ch * 8);
            *(u32x4*)(Ow + (size_t)row * D + ch * 8) = v;
            float ss = 0.f;
#pragma unroll
            for (int e = 0; e < 4; ++e) { const float lo = __uint_as_float(v[e] << 16), hh = __uint_as_float(v[e] & 0xffff0000u); ss += lo * lo + hh * hh; }
            ss += __shfl_xor(ss, 1); ss += __shfl_xor(ss, 2); ss += __shfl_xor(ss, 4);
            if (ch == 0) ssq_s8[(rowbase + q0 + wid * 32 + row) * 8 + h] = ss; }
    }
    asm volatile("s_waitcnt lgkmcnt(0)" ::: "memory"); __builtin_amdgcn_s_barrier(); asm volatile("" ::: "memory");
    SSTAMP(6);
#undef SSTAMP
#undef DMA_KV
}
#undef SBA_GROUP
}
namespace lru {
typedef float f32x16 __attribute__((ext_vector_type(16)));
constexpr int XS_ROWS = 67, XS_BYTES = XS_ROWS * 1024  , XC_PITCH = 1040  , XC_OFF = 68608, HC_OFF = XC_OFF + 64 * XC_PITCH  , L_BYTES = HC_OFF + 2048;
__device__ __forceinline__ int crow(int r, int hi) { return (r & 3) + 8 * (r >> 2) + 4 * hi; }

struct Weights { bf16x8 wa[2][4], wx[2][4]; float ba[2], bx[2], spl[2]; };
__device__ __forceinline__ void load_weights(Weights& W, int h, int r32, int hi, const float* w_a, const float* b_a, const float* w_x, const float* b_x, const float* lam) {
#pragma unroll
    for (int nt = 0; nt < 2; ++nt) {
#pragma unroll
        for (int s = 0; s < 4; ++s) {
#pragma unroll
            for (int e = 0; e < 8; ++e) { const size_t idx = ((size_t)(h * 64 + 16 * s + 8 * hi + e)) * 64 + 32 * nt + r32;
                W.wa[nt][s][e] = (short)f2bf(w_a[idx]); W.wx[nt][s][e] = (short)f2bf(w_x[idx]); }
        }
        const int c = h * 64 + 32 * nt + r32; W.ba[nt] = b_a[c]; W.bx[nt] = b_x[c];
        const float l = lam[c]; W.spl[nt] = (l > 15.f) ? __expf(-l) : log1pf(__expf(-l));
    }
}

template <bool PASSB>
__device__ __forceinline__ void unit(int b, int chunk, const Weights& W, const bf16_t* XR, const bf16_t* GG, const float* conv_w, const float* conv_b,
                                     float* aggP, float* aggH, const float* ssq_s8, bf16_t* YY, float* fmid, float* fend, unsigned char* shm) {
    int tid_ = threadIdx.x; asm volatile("" : "+v"(tid_));
    const int tid = tid_, lane = tid & 63, r32 = lane & 31, hi = lane >> 5, wid = __builtin_amdgcn_readfirstlane(tid >> 6);
    LAS unsigned char* L = (LAS unsigned char*)shm;
#define LSTAMP(k) do { if (PROBE_A >= 200 && PASSB && blockIdx.x == 63 && b == 0 && tid == 0) ((LAS unsigned long long*)(shm + 147200))[16 + (k)] = __builtin_amdgcn_s_memrealtime(); } while (0)
    LSTAMP(0);
    const int t0 = chunk * 64; const size_t rowbase = (size_t)b * SEQ;
    f32x4 cp_[PASSB ? 8 : 1], cq_[PASSB ? 8 : 1];
    if (PASSB) {
        const f32x4* pP = (const f32x4*)(aggP + ((size_t)b * RW + tid) * 64); const f32x4* pH = (const f32x4*)(aggH + ((size_t)b * RW + tid) * 64);
#pragma unroll
        for (int i = 0; i < 8; ++i) { cp_[i] = pP[i]; cq_[i] = pH[i]; }
    }
    {
        u32x4 v[9];
#pragma unroll
        for (int k = 0; k < 9; ++k) { const int p = tid + k * NTHREADS, rr = p >> 6, pc = p & 63, t = t0 - 3 + rr;
            v[k] = (u32x4){0u, 0u, 0u, 0u}; if (p < XS_ROWS * 64 && t >= 0) v[k] = *(const u32x4*)(XR + (rowbase + t) * RW + pc * 8); }
#pragma unroll
        for (int k = 0; k < 9; ++k) { const int p = tid + k * NTHREADS; if (p < XS_ROWS * 64) *(LAS u32x4*)(L + (p >> 6) * 1024 + (p & 63) * 16) = v[k]; }
    }
    if (PASSB) {
        float hc = 0.f;
#pragma unroll
        for (int i = 0; i < 8; ++i)
#pragma unroll
            for (int e = 0; e < 4; ++e) { if (i * 4 + e < chunk) hc = cp_[i][e] * hc + cq_[i][e]; }
        if (chunk > 32) { const f32x4* pP = (const f32x4*)(aggP + ((size_t)b * RW + tid) * 64) + 8; const f32x4* pH = (const f32x4*)(aggH + ((size_t)b * RW + tid) * 64) + 8;
#pragma unroll
            for (int i = 0; i < 8; ++i) { cp_[i] = pP[i]; cq_[i] = pH[i]; }
#pragma unroll
            for (int i = 0; i < 8; ++i)
#pragma unroll
                for (int e = 0; e < 4; ++e) { if (32 + i * 4 + e < chunk) hc = cp_[i][e] * hc + cq_[i][e]; } }
        *(LAS float*)(L + HC_OFF + tid * 4) = hc;
    }
    __syncthreads();
    LSTAMP(1);
    {
        const int cp = tid & 255, th = tid >> 8, c0 = 2 * cp;
        const float w00 = conv_w[c0], w01 = conv_w[RW + c0], w02 = conv_w[2 * RW + c0], w03 = conv_w[3 * RW + c0], b0 = conv_b[c0];
        const float w10 = conv_w[c0 + 1], w11 = conv_w[RW + c0 + 1], w12 = conv_w[2 * RW + c0 + 1], w13 = conv_w[3 * RW + c0 + 1], b1 = conv_b[c0 + 1];
        const LAS unsigned* xs = (const LAS unsigned*)(L + (th * 32) * 1024 + cp * 4);
        unsigned u0 = xs[0], u1 = xs[256], u2 = xs[512];
        float a0 = __uint_as_float(u0 << 16), a1 = __uint_as_float(u1 << 16), a2 = __uint_as_float(u2 << 16);
        float c0_ = __uint_as_float(u0 & 0xffff0000u), c1_ = __uint_as_float(u1 & 0xffff0000u), c2_ = __uint_as_float(u2 & 0xffff0000u);
#pragma unroll 8
        for (int t = 0; t < 32; ++t) { const unsigned u3 = xs[(t + 3) * 256]; const float a3 = __uint_as_float(u3 << 16), c3_ = __uint_as_float(u3 & 0xffff0000u);
            const float y0 = w00 * a0 + w01 * a1 + w02 * a2 + w03 * a3 + b0, y1 = w10 * c0_ + w11 * c1_ + w12 * c2_ + w13 * c3_ + b1;
            *(LAS unsigned*)(L + XC_OFF + (th * 32 + t) * XC_PITCH + cp * 4) = f2bf(y0) | (f2bf(y1) << 16);
            a0 = a1; a1 = a2; a2 = a3; c0_ = c1_; c1_ = c2_; c2_ = c3_; }
    }
    __syncthreads();
    LSTAMP(2);
    const int h = wid;
    float Hc[2] = {0.f, 0.f}, Pc[2] = {1.f, 1.f};
    if (PASSB) {
#pragma unroll
        for (int nt = 0; nt < 2; ++nt) Hc[nt] = *(const LAS float*)(L + HC_OFF + (h * 64 + 32 * nt + r32) * 4);
    }
#pragma unroll
    for (int mt = 0; mt < 2; ++mt) {
        bf16x8 af[4];
#pragma unroll
        for (int s = 0; s < 4; ++s) af[s] = *(const LAS bf16x8*)(L + XC_OFF + (32 * mt + r32) * XC_PITCH + (h * 64 + 16 * s + 8 * hi) * 2);
#pragma unroll
        for (int nt = 0; nt < 2; ++nt) {
            f32x16 ra = {}, ri = {};
#pragma unroll
            for (int s = 0; s < 4; ++s) { ra = __builtin_amdgcn_mfma_f32_32x32x16_bf16(af[s], W.wa[nt][s], ra, 0, 0, 0); ri = __builtin_amdgcn_mfma_f32_32x32x16_bf16(af[s], W.wx[nt][s], ri, 0, 0, 0); }
            const int c = h * 64 + 32 * nt + r32;
#pragma unroll
            for (int r = 0; r < 16; ++r) { const int tok = 32 * mt + crow(r, hi);
                const float xc = bf2f(*(const LAS unsigned short*)(L + XC_OFF + tok * XC_PITCH + c * 2));
                const float rg = __builtin_amdgcn_rcpf(1.f + __expf(-(ra[r] + W.ba[nt]))), ig = __builtin_amdgcn_rcpf(1.f + __expf(-(ri[r] + W.bx[nt])));
                const float la = -8.0f * rg * W.spl[nt], a = __expf(la);
                ra[r] = a; ri[r] = __builtin_amdgcn_sqrtf(fmaxf(0.f, 1.f - a * a)) * (ig * xc); }
            float P[4], H[4], Pp[4], Hp[4];
#pragma unroll
            for (int g = 0; g < 4; ++g) { P[g] = (ra[4 * g] * ra[4 * g + 1]) * (ra[4 * g + 2] * ra[4 * g + 3]);
                H[g] = ((ri[4 * g] * ra[4 * g + 1] + ri[4 * g + 1]) * ra[4 * g + 2] + ri[4 * g + 2]) * ra[4 * g + 3] + ri[4 * g + 3]; }
#pragma unroll
            for (int g = 0; g < 4; ++g) { Pp[g] = __shfl_xor(P[g], 32); Hp[g] = __shfl_xor(H[g], 32); }
            float hc = Hc[nt], pc = Pc[nt];
#pragma unroll
            for (int g = 0; g < 4; ++g) { const float P0 = hi ? Pp[g] : P[g], H0 = hi ? Hp[g] : H[g], P1 = hi ? P[g] : Pp[g], H1 = hi ? H[g] : Hp[g];
                const float mid = P0 * hc + H0;
                if (PASSB) { float hh = hi ? mid : hc;
#pragma unroll
                    for (int k = 0; k < 4; ++k) { hh = ra[4 * g + k] * hh + ri[4 * g + k]; const int tok = 32 * mt + 8 * g + 4 * hi + k;
                        *(LAS unsigned short*)(L + tok * 1024 + c * 2) = (unsigned short)f2bf(hh); } }
                hc = P1 * mid + H1; pc = pc * (P0 * P1); }
            Hc[nt] = hc; Pc[nt] = pc;
        }
    }
    if (!PASSB) {
        if (hi == 0) {
#pragma unroll
            for (int nt = 0; nt < 2; ++nt) { const int c = h * 64 + 32 * nt + r32; aggP[((size_t)b * RW + c) * 64 + chunk] = Pc[nt]; aggH[((size_t)b * RW + c) * 64 + chunk] = Hc[nt]; }
        }
        __syncthreads();
    } else {
        LSTAMP(3);
        __syncthreads();
        LSTAMP(4);
        u32x4 gv[8]; float sv[8];
#pragma unroll
        for (int i = 0; i < 8; ++i) { const size_t row = rowbase + t0 + i * 8 + wid; gv[i] = *(const u32x4*)(GG + row * RW + lane * 8); sv[i] = ssq_s8[row * 8 + (lane & 7)]; }
#pragma unroll
        for (int i = 0; i < 8; ++i) { const int rr = i * 8 + wid; const size_t row = rowbase + t0 + rr;
            const u32x4 hv = *(const LAS u32x4*)(L + rr * 1024 + lane * 16); const u32x4 g4 = gv[i];
            f32x4 y0, y1;
            y0[0] = __uint_as_float(hv.x << 16) * __uint_as_float(g4.x << 16); y0[1] = __uint_as_float(hv.x & 0xffff0000u) * __uint_as_float(g4.x & 0xffff0000u);
            y0[2] = __uint_as_float(hv.y << 16) * __uint_as_float(g4.y << 16); y0[3] = __uint_as_float(hv.y & 0xffff0000u) * __uint_as_float(g4.y & 0xffff0000u);
            y1[0] = __uint_as_float(hv.z << 16) * __uint_as_float(g4.z << 16); y1[1] = __uint_as_float(hv.z & 0xffff0000u) * __uint_as_float(g4.z & 0xffff0000u);
            y1[2] = __uint_as_float(hv.w << 16) * __uint_as_float(g4.w << 16); y1[3] = __uint_as_float(hv.w & 0xffff0000u) * __uint_as_float(g4.w & 0xffff0000u);
            *(u32x4*)(YY + row * D + lane * 8) = pg8::pack8(y0, y1);
            float ss = pg8::sq8(y0, y1), s2 = sv[i];
#pragma unroll
            for (int o = 1; o < 64; o <<= 1) ss += __shfl_xor(ss, o);
            s2 += __shfl_xor(s2, 1); s2 += __shfl_xor(s2, 2); s2 += __shfl_xor(s2, 4);
            if (lane == 0) { const float rrn = 1.0f / sqrtf(ss * (1.f / RW) + EPS), rs = 1.0f / sqrtf(s2 * (1.f / SBW) + EPS); fmid[row] = rrn / rs; fend[row] = rs; } }
        __syncthreads();
        LSTAMP(5);
    }
#undef LSTAMP
}
}
__device__ __forceinline__ void row_prep_x(const float* x, bf16_t* xb, float* rstd0, int row, int lane) {
    const f32x4* xr = (const f32x4*)(x + (size_t)row * D) + lane;
    float s = 0.f; f32x4 v[4];
#pragma unroll
    for (int j = 0; j < 4; ++j) { v[j] = xr[64 * j]; s += v[j].x * v[j].x + v[j].y * v[j].y + v[j].z * v[j].z + v[j].w * v[j].w; }
    s = wave_sum(s);
    if (lane == 0) rstd0[row] = 1.0f / sqrtf(s * (1.f / D) + EPS);
    unsigned long long* o8 = (unsigned long long*)(xb + (size_t)row * D) + lane;
#pragma unroll
    for (int j = 0; j < 4; ++j) o8[64 * j] = (unsigned long long)(f2bf(v[j].x) | (f2bf(v[j].y) << 16)) | ((unsigned long long)(f2bf(v[j].z) | (f2bf(v[j].w) << 16)) << 32);
}
__device__ __forceinline__ void row_prep_mem(const float* m, const float* g, bf16_t* o, int row, int lane) {
    const f32x4* xr = (const f32x4*)(m + (size_t)row * D) + lane;
    float s = 0.f; f32x4 v[4];
#pragma unroll
    for (int j = 0; j < 4; ++j) { v[j] = xr[64 * j]; s += v[j].x * v[j].x + v[j].y * v[j].y + v[j].z * v[j].z + v[j].w * v[j].w; }
    s = wave_sum(s);
    const float r = 1.0f / sqrtf(s * (1.f / D) + EPS);
    unsigned long long* o8 = (unsigned long long*)(o + (size_t)row * D) + lane;
#pragma unroll
    for (int j = 0; j < 4; ++j) { const f32x4 gg = ((const f32x4*)g)[64 * j + lane];
        o8[64 * j] = (unsigned long long)(f2bf(v[j].x * r * gg.x) | (f2bf(v[j].y * r * gg.y) << 16)) | ((unsigned long long)(f2bf(v[j].z * r * gg.z) | (f2bf(v[j].w * r * gg.w) << 16)) << 32); }
}
__device__ __forceinline__ void transpose_item(const float* W, int K, int N, bf16_t* Wt, int ldt, const float* g0, const float* g1, int ksplit, LAS float* scr, int item, int lane) {
    const int nblk = N / 64, kb = item / nblk, nb = item % nblk, k0 = 64 * kb, n0 = 64 * nb, lr = lane >> 4, lc = 4 * (lane & 15);
    f32x4 v[16];
#pragma unroll
    for (int i = 0; i < 16; ++i) v[i] = *(const f32x4*)(W + (size_t)(k0 + 4 * i + lr) * N + n0 + lc);
#pragma unroll
    for (int i = 0; i < 16; ++i) { const int kk = 4 * i + lr, k = k0 + kk; float gv = 1.f; if (g0) gv = (k < ksplit) ? g0[k] : g1[k - ksplit];
        LAS float* d = scr + kk * 65 + lc; d[0] = v[i].x * gv; d[1] = v[i].y * gv; d[2] = v[i].z * gv; d[3] = v[i].w * gv; }
    asm volatile("s_waitcnt lgkmcnt(0)" ::: "memory");
    const int c = lane & 7;
#pragma unroll
    for (int j = 0; j < 8; ++j) { const int n = (lane >> 3) + 8 * j; const LAS float* s = scr + (8 * c) * 65 + n;
        u32x4 o; o.x = f2bf(s[0 * 65]) | (f2bf(s[1 * 65]) << 16); o.y = f2bf(s[2 * 65]) | (f2bf(s[3 * 65]) << 16); o.z = f2bf(s[4 * 65]) | (f2bf(s[5 * 65]) << 16); o.w = f2bf(s[6 * 65]) | (f2bf(s[7 * 65]) << 16);
        *(u32x4*)(Wt + (size_t)(n0 + n) * ldt + k0 + 8 * c) = o; }
    asm volatile("s_waitcnt lgkmcnt(0)" ::: "memory");
}

struct MidScale { const float* f; int k; int pad; };
template <class Epi>
__device__ __forceinline__ void gemm_naive(const Ctx& C, const bf16_t* A, int lda, const bf16_t* Bt, int ldb, int M, int N, int K, MidScale ms, const Epi& E) {
    const int lane = C.lane, fr = lane & 15, fq = lane >> 4, ncol = N / 64, ntile = (M / 16) * ncol;
    for (int t = C.gw; t < ntile; t += C.NGW) {
        const int row0 = (t / ncol) * 16, col0 = (t % ncol) * 64;
        const bf16_t* ap = A + (size_t)(row0 + fr) * lda + fq * 8;
        const bf16_t* bp = Bt + (size_t)(col0 + fr) * ldb + fq * 8;
        f32x4 acc[4];
#pragma unroll
        for (int n = 0; n < 4; ++n) acc[n] = (f32x4){0.f, 0.f, 0.f, 0.f};
        for (int k0 = 0; k0 < K; k0 += 32) {
            if (ms.f && k0 == ms.k) {
#pragma unroll
                for (int j = 0; j < 4; ++j) { const float f = ms.f[row0 + fq * 4 + j];
#pragma unroll
                    for (int n = 0; n < 4; ++n) acc[n][j] *= f; }
            }
            const bf16x8 a = *(const bf16x8*)(ap + k0);
#pragma unroll
            for (int n = 0; n < 4; ++n) { const bf16x8 b = *(const bf16x8*)(bp + (size_t)n * 16 * ldb + k0); acc[n] = __builtin_amdgcn_mfma_f32_16x16x32_bf16(a, b, acc[n], 0, 0, 0); }
        }
#pragma unroll
        for (int n = 0; n < 4; ++n)
#pragma unroll
            for (int j = 0; j < 4; ++j) E(row0 + fq * 4 + j, col0 + n * 16 + fr, acc[n][j]);
    }
}
struct EpiInProj { const float* rstd0; bf16_t *XR, *GG, *Qs, *Ks, *Vs;
    __device__ void operator()(int r, int c, float v) const { v *= rstd0[r]; const int t = c >> 9, cc = c & 511;
        if (t == 0) XR[(size_t)r * RW + cc] = (bf16_t)f2bf(v);
        else if (t == 1) GG[(size_t)r * RW + cc] = (bf16_t)f2bf(gelu_tanh(v));
        else if (t == 2) Qs[(size_t)r * SBW + cc] = (bf16_t)f2bf(v * (0.125f * LOG2E));
        else if (t == 3) Ks[(size_t)r * SBW + cc] = (bf16_t)f2bf(v);
        else Vs[(size_t)r * SBW + cc] = (bf16_t)f2bf(v); } };
struct EpiStoreBf16 { bf16_t* O; const float* rowscale; int ldo; float scale;
    __device__ void operator()(int r, int c, float v) const { O[(size_t)r * ldo + c] = (bf16_t)f2bf(v * (rowscale ? rowscale[r] : 1.f) * scale); } };
struct EpiResF32 { const float* base; const float* rowscale; bf16_t* O;
    __device__ void operator()(int r, int c, float v) const { O[(size_t)r * D + c] = (bf16_t)f2bf(base[(size_t)r * D + c] + v * rowscale[r]); } };
struct EpiResBf16 { const bf16_t* base; bf16_t* O;
    __device__ void operator()(int r, int c, float v) const { O[(size_t)r * D + c] = (bf16_t)f2bf(bf2f(base[(size_t)r * D + c]) + v); } };

__device__ __forceinline__ void lru_naive_unit(int unit, int j, LAS float* xs, const bf16_t* XR, const bf16_t* GG, const float* conv_w, const float* conv_b,
                                               const float* w_a, const float* b_a, const float* w_x, const float* b_x, const float* lam, bf16_t* YY) {
    const int b = unit >> 3, h = unit & 7, c = h * 64 + j;
    float wa[64], wx[64];
#pragma unroll
    for (int i = 0; i < 64; ++i) { wa[i] = w_a[(size_t)(h * 64 + i) * 64 + j]; wx[i] = w_x[(size_t)(h * 64 + i) * 64 + j]; }
    const float ba = b_a[c], bx = b_x[c], cw0 = conv_w[c], cw1 = conv_w[RW + c], cw2 = conv_w[2 * RW + c], cw3 = conv_w[3 * RW + c], cb = conv_b[c];
    const float l = lam[c], spl = (l > 15.f) ? __expf(-l) : log1pf(__expf(-l));
    float x0 = 0.f, x1 = 0.f, x2 = 0.f, hst = 0.f;
    for (int t = 0; t < SEQ; ++t) {
        const size_t row = (size_t)b * SEQ + t;
        const float x3 = bf2f(XR[row * RW + c]);
        const float xc = cw0 * x0 + cw1 * x1 + cw2 * x2 + cw3 * x3 + cb;
        x0 = x1; x1 = x2; x2 = x3;
        asm volatile("s_waitcnt lgkmcnt(0)" ::: "memory"); xs[j] = xc; asm volatile("s_waitcnt lgkmcnt(0)" ::: "memory");
        float ra = ba, ri = bx;
#pragma unroll
        for (int i = 0; i < 64; ++i) { const float xv = xs[i]; ra += xv * wa[i]; ri += xv * wx[i]; }
        const float r = sigmoidf_(ra), ig = sigmoidf_(ri);
        const float log_a = -8.0f * r * spl, a = __expf(log_a), bb = sqrtf(fmaxf(0.f, -expm1f(2.f * log_a))) * (ig * xc);
        hst = a * hst + bb;
        YY[row * D + c] = (bf16_t)f2bf(hst * bf2f(GG[row * RW + c]));
    }
}
__device__ __forceinline__ void sb_naive_unit(int unit, int lane, const bf16_t* Qs, const bf16_t* Ks, const bf16_t* Vs, bf16_t* YY, float* ssq_s8) {
    const int qb = unit & 63, h = (unit >> 6) & 7, b = unit >> 9;
    const int t = qb * 64 + lane; const size_t row = (size_t)b * SEQ + t;
    float q[64], o[64];
#pragma unroll
    for (int d = 0; d < 64; ++d) { q[d] = bf2f(Qs[row * SBW + h * 64 + d]); o[d] = 0.f; }
    float R = 0.f;
    for (int s = qb * 64 + 62; s >= 0; --s) {
        const bf16_t* kr = Ks + ((size_t)b * SEQ + s) * SBW + h * 64; const bf16_t* vr = Vs + ((size_t)b * SEQ + s) * SBW + h * 64;
        float z = 0.f;
#pragma unroll
        for (int d = 0; d < 64; ++d) z += q[d] * bf2f(kr[d]);
        const bool valid = s < t;
        const float sp = valid ? (fmaxf(z, 0.f) + __log2f(1.f + exp2f(-fabsf(z)))) : 0.f;
        const float w = valid ? exp2f(z - (R + sp)) : 0.f;
        R += sp;
        const float wb = bf2f((bf16_t)f2bf(w));
#pragma unroll
        for (int d = 0; d < 64; ++d) o[d] += wb * bf2f(vr[d]);
    }
    float ss = 0.f;
#pragma unroll
    for (int d = 0; d < 64; ++d) { ss += o[d] * o[d]; YY[row * D + RW + h * 64 + d] = (bf16_t)f2bf(o[d]); }
    ssq_s8[row * 8 + h] = ss;
}
__device__ __forceinline__ void xattn_naive_unit(int unit, int j, LAS float* qs, LAS float* ps, const bf16_t* QX, const bf16_t* KVM, bf16_t* OX) {
    const int tg = unit & 511, h = (unit >> 9) & 3, b = unit >> 11, lane = j & 63, wid = j >> 6;
    const size_t row0 = (size_t)b * SEQ + tg * 8;
    for (int i = 0; i < 8; ++i) qs[i * 256 + j] = bf2f(QX[(row0 + i) * D + h * XD + j]);
    __syncthreads();
    const bf16_t* kr = KVM + ((size_t)b * MEM + j) * 2048 + h * XD;
    float sc[8];
#pragma unroll
    for (int i = 0; i < 8; ++i) sc[i] = 0.f;
    for (int d = 0; d < XD; ++d) { const float kv = bf2f(kr[d]);
#pragma unroll
        for (int i = 0; i < 8; ++i) sc[i] += qs[i * 256 + d] * kv; }
#pragma unroll
    for (int i = 0; i < 8; ++i) ps[i * 256 + j] = sc[i];
    __syncthreads();
    for (int i = wid * 2; i < wid * 2 + 2; ++i) {
        float v0 = ps[i * 256 + lane], v1 = ps[i * 256 + lane + 64], v2 = ps[i * 256 + lane + 128], v3 = ps[i * 256 + lane + 192];
        float m = fmaxf(fmaxf(v0, v1), fmaxf(v2, v3));
#pragma unroll
        for (int o = 1; o < 64; o <<= 1) m = fmaxf(m, __shfl_xor(m, o));
        v0 = exp2f(v0 - m); v1 = exp2f(v1 - m); v2 = exp2f(v2 - m); v3 = exp2f(v3 - m);
        const float s = wave_sum(v0 + v1 + v2 + v3), inv = 1.f / s;
        ps[i * 256 + lane] = v0 * inv; ps[i * 256 + lane + 64] = v1 * inv; ps[i * 256 + lane + 128] = v2 * inv; ps[i * 256 + lane + 192] = v3 * inv;
    }
    __syncthreads();
    float o[8];
#pragma unroll
    for (int i = 0; i < 8; ++i) o[i] = 0.f;
    for (int m = 0; m < MEM; ++m) { const float vv = bf2f(KVM[((size_t)b * MEM + m) * 2048 + 1024 + h * XD + j]);
#pragma unroll
        for (int i = 0; i < 8; ++i) o[i] += ps[i * 256 + m] * vv; }
#pragma unroll
    for (int i = 0; i < 8; ++i) OX[(row0 + i) * D + h * XD + j] = (bf16_t)f2bf(o[i]);
    __syncthreads();
}
__device__ __forceinline__ int router_row(int row, int lane, const bf16_t* X2b, const float* ssq2p, const float* g, const float* wgr, const float* bgr, const float* wer, const float* ber, float* selw) {
    int cls = 0;
    float acc[20];
#pragma unroll
    for (int i = 0; i < 20; ++i) acc[i] = 0.f;
    const float rs = pg8::rstd16(ssq2p + (size_t)row * 16);
    for (int kk = 0; kk < 16; ++kk) { const int k = kk * 64 + lane; const float t = bf2f(X2b[(size_t)row * D + k]) * rs * g[k];
#pragma unroll
        for (int i = 0; i < 4; ++i) acc[i] += t * wgr[k * 4 + i];
#pragma unroll
        for (int gi = 0; gi < 4; ++gi)
#pragma unroll
            for (int e = 0; e < 4; ++e) acc[4 + gi * 4 + e] += t * wer[((size_t)gi * D + k) * 4 + e]; }
#pragma unroll
    for (int i = 0; i < 20; ++i) acc[i] = wave_sum(acc[i]);
    if (lane == 0) {
        float gl[4]; float gm = -INFINITY; int gi = 0;
#pragma unroll
        for (int i = 0; i < 4; ++i) { gl[i] = acc[i] + bgr[i]; if (gl[i] > gm) { gm = gl[i]; gi = i; } }
        float gs = 0.f;
#pragma unroll
        for (int i = 0; i < 4; ++i) gs += __expf(gl[i] - gm);
        const float gp = 1.f / gs;
        float el[4];
#pragma unroll
        for (int e = 0; e < 4; ++e) { float v = 0.f;
#pragma unroll
            for (int q = 0; q < 4; ++q) if (q == gi) v = acc[4 + q * 4 + e] + ber[q * 4 + e];
            el[e] = v; }
        int e1 = 0; float m1 = el[0];
#pragma unroll
        for (int e = 1; e < 4; ++e) if (el[e] > m1) { m1 = el[e]; e1 = e; }
        int e2 = -1; float m2 = -INFINITY;
#pragma unroll
        for (int e = 0; e < 4; ++e) if (e != e1 && el[e] > m2) { m2 = el[e]; e2 = e; }
        const float p2 = __expf(m2 - m1), w1 = gp / (1.f + p2), w2 = gp * p2 / (1.f + p2);
        const int ea = e1 < e2 ? e1 : e2, eb = e1 < e2 ? e2 : e1; const float wA = e1 < e2 ? w1 : w2, wB = e1 < e2 ? w2 : w1;
        const int pr = (ea == 0) ? eb - 1 : (ea == 1) ? eb + 1 : 5;
        selw[(size_t)row * 2] = wA; selw[(size_t)row * 2 + 1] = wB; cls = gi * 6 + pr;
    }
    return cls;
}
__device__ __forceinline__ void final_row(int row, int lane, const bf16_t* X3b, const float* ssq3, const float* g, float* out) {
    const float r = pg8::rstd16(ssq3 + (size_t)row * 16);
#pragma unroll
    for (int j = 0; j < 2; ++j) { const int c = j * 512 + lane * 8; const u32x4 v = *(const u32x4*)(X3b + (size_t)row * D + c); const f32x4 g0 = *(const f32x4*)(g + c), g1 = *(const f32x4*)(g + c + 4);
        f32x4 o0, o1;
        o0[0] = __uint_as_float(v.x << 16) * r * g0[0]; o0[1] = __uint_as_float(v.x & 0xffff0000u) * r * g0[1]; o0[2] = __uint_as_float(v.y << 16) * r * g0[2]; o0[3] = __uint_as_float(v.y & 0xffff0000u) * r * g0[3];
        o1[0] = __uint_as_float(v.z << 16) * r * g1[0]; o1[1] = __uint_as_float(v.z & 0xffff0000u) * r * g1[1]; o1[2] = __uint_as_float(v.w << 16) * r * g1[2]; o1[3] = __uint_as_float(v.w & 0xffff0000u) * r * g1[3];
        *(f32x4*)(out + (size_t)row * D + c) = o0; *(f32x4*)(out + (size_t)row * D + c + 4) = o1; }
}
__device__ __forceinline__ void reids(Ctx& C) { int t_ = threadIdx.x; asm volatile("" : "+v"(t_)); C.tid = t_; C.lane = t_ & 63; C.wave = __builtin_amdgcn_readfirstlane(t_ >> 6); C.gw = C.bid * NWAVES + C.wave; }
__global__ void __launch_bounds__(NTHREADS, 2) mk_fwd(Args args) {
    extern __shared__ __attribute__((aligned(16))) unsigned char lds[];
    cg::grid_group grid = cg::this_grid();
    Ctx C;
#pragma unroll
    for (int i = 0; i < 29; ++i) C.in[i] = args.in[i];
    C.out = args.out; C.ws = args.ws; C.lds = lds;
    C.tid = threadIdx.x; C.lane = C.tid & 63; C.wave = __builtin_amdgcn_readfirstlane(C.tid >> 6);
    C.G = gridDim.x; C.bid = blockIdx.x; C.gw = C.bid * NWAVES + C.wave; C.NGW = C.G * NWAVES;
    const float* x = C.in[0]; const float* mem = C.in[1]; const float* norm_mix = C.in[2]; const float* w_in = C.in[3];
    const float* conv_w = C.in[4]; const float* conv_b = C.in[5]; const float* lru_w_a = C.in[6]; const float* lru_b_a = C.in[7];
    const float* lru_w_x = C.in[8]; const float* lru_b_x = C.in[9]; const float* lru_lambda = C.in[10];
    const float* norm_rnn = C.in[11]; const float* norm_sb = C.in[12]; const float* w_out = C.in[13];
    const float* norm_xattn = C.in[14]; const float* norm_mem = C.in[15];
    const float* xa_w_q = C.in[16]; const float* xa_w_k = C.in[17]; const float* xa_w_v = C.in[18]; const float* xa_w_o = C.in[19];
    const float* norm_moe = C.in[20]; const float* w_gr = C.in[21]; const float* b_gr = C.in[22]; const float* w_er = C.in[23]; const float* b_er = C.in[24];
    const float* w_gate = C.in[25]; const float* w_up = C.in[26]; const float* w_down = C.in[27]; const float* norm_final = C.in[28];
    unsigned char* ws = C.ws; float* out = C.out;
    float* sm = (float*)(ws + WS_SMALL);
    float* rstd0 = sm + SM_RSTD0; float* ssq_r = sm + SM_SSQR; float* ssq_s = sm + SM_SSQS; float* ssq1 = sm + SM_SSQ1; float* ssq2 = sm + SM_SSQ2; unsigned* kmax = (unsigned*)(ws + WS_CTL); float* fmid = sm + SM_END; float* fend = fmid + 32768;
    float* aggP = sm + 96 * 32768; float* aggH = sm + 104 * 32768;
    float* selw = sm + SM_SELW; float* ssq3 = sm + SM_SSQ3; int* gcnt = (int*)(ws + WS_CTL + 1024);
    int* tlist = (int*)(sm + 64 * 32768); float* rsg = sm + 88 * 32768; float* wAg = rsg + 40960; float* wBg = wAg + 40960; int* tokg = (int*)(wBg + 40960);
    bf16_t* Wrh = (bf16_t*)(ws + WS_CTL + 65536); bf16_t* Wrl = Wrh + 32 * D;
    bf16_t* Wg_t = (bf16_t*)(ws + WS_WG); bf16_t* Wu_t = (bf16_t*)(ws + WS_WU); bf16_t* Wd2 = (bf16_t*)(ws + WS_WD2); bf16_t* XG = (bf16_t*)(ws + WS_R1); bf16_t* HID = (bf16_t*)(ws + WS_R5);
    bf16_t* Win_t = (bf16_t*)(ws + WS_WIN); bf16_t* Wout_t = (bf16_t*)(ws + WS_WOUT); bf16_t* Wq_t = (bf16_t*)(ws + WS_WQ); bf16_t* Wkv_t = (bf16_t*)(ws + WS_WKV); bf16_t* Wo_t = (bf16_t*)(ws + WS_WO);
    bf16_t* memn = (bf16_t*)(ws + WS_MEMN); bf16_t* KM = (bf16_t*)(ws + WS_KVM); bf16_t* VT = (bf16_t*)(ws + WS_R5 + 40 * MiB);
    bf16_t* xb = (bf16_t*)(ws + WS_R0); bf16_t* X1b = xb; bf16_t* X3b = xb;
    bf16_t* XR = (bf16_t*)(ws + WS_R1); bf16_t* GG = XR + (size_t)NTOK * RW; bf16_t* QX = XR;
    bf16_t* Qs = (bf16_t*)(ws + WS_R2); bf16_t* Ks = Qs + (size_t)NTOK * SBW; bf16_t* OX = Qs;
    bf16_t* Vs = (bf16_t*)(ws + WS_R3);
    bf16_t* YY = (bf16_t*)(ws + WS_R4); bf16_t* X2b = YY;
    const int NGW = C.NGW;
#define gw C.gw
#define lane C.lane
    if (C.tid < 64) ((LAS unsigned*)(lds + 146432))[C.tid] = 0u;
    __syncthreads();
    XcdBarrier bar = xcd_barrier_post((unsigned*)(ws + WS_CTL + 4096), (volatile LAS unsigned*)(lds + 146432 + 32));
#define GRID_SYNC_CG() do { grid.sync(); reids(C); } while (0)
#define GRID_SYNC() do { xcd_barrier(bar); reids(C); } while (0)

    for (int rep_ = 0; rep_ < (int)((REP_MASK >> 0) & 1u) + 1; ++rep_) {
    {
        if (gw == 0) { kmax[lane] = 0u; if (lane < 32) gcnt[lane] = 0; }
        for (int r = gw * 4; r < NTOK; r += NGW * 4) {
            const f32x4* xr = (const f32x4*)(x + (size_t)r * D) + lane; f32x4 v[16]; float s[4] = {0.f, 0.f, 0.f, 0.f};
#pragma unroll
            for (int j = 0; j < 16; ++j) v[j] = __builtin_nontemporal_load(xr + 64 * j);
#pragma unroll
            for (int j = 0; j < 16; ++j) s[j >> 2] += (v[j].x * v[j].x + v[j].y * v[j].y) + (v[j].z * v[j].z + v[j].w * v[j].w);
#pragma unroll
            for (int o = 1; o < 64; o <<= 1) { s[0] += __shfl_xor(s[0], o); s[1] += __shfl_xor(s[1], o); s[2] += __shfl_xor(s[2], o); s[3] += __shfl_xor(s[3], o); }
            if (lane < 4) { const float sv = lane == 0 ? s[0] : lane == 1 ? s[1] : lane == 2 ? s[2] : s[3]; rstd0[r + lane] = __builtin_amdgcn_rsqf(sv * (1.f / D) + EPS); }
            unsigned long long* o8 = (unsigned long long*)(xb + (size_t)r * D) + lane;
#pragma unroll
            for (int j = 0; j < 16; ++j) o8[64 * j] = (unsigned long long)(f2bf(v[j].x) | (f2bf(v[j].y) << 16)) | ((unsigned long long)(f2bf(v[j].z) | (f2bf(v[j].w) << 16)) << 32);
        }
        for (int r = gw; r < NMEM; r += NGW) row_prep_mem(mem, norm_mem, memn, r, lane);
        LAS float* scr = (LAS float*)(lds) + C.wave * (64 * 65);
        constexpr int I_IN = (D / 64) * (PROJ / 64), I_SQ = (D / 64) * (D / 64);
        for (int it = gw; it < I_IN + 5 * I_SQ; it += NGW) {
            int r = it;
            if (r < I_IN) { transpose_item(w_in, D, PROJ, Win_t, D, norm_mix, norm_mix, D, scr, r, lane); continue; } r -= I_IN;
            if (r < I_SQ) { transpose_item(w_out, D, D, Wout_t, D, norm_rnn, norm_sb, RW, scr, r, lane); continue; } r -= I_SQ;
            if (r < I_SQ) { transpose_item(xa_w_q, D, D, Wq_t, D, norm_xattn, norm_xattn, D, scr, r, lane); continue; } r -= I_SQ;
            if (r < I_SQ) { transpose_item(xa_w_k, D, D, Wkv_t, D, nullptr, nullptr, 0, scr, r, lane); continue; } r -= I_SQ;
            if (r < I_SQ) { transpose_item(xa_w_v, D, D, Wkv_t + (size_t)D * D, D, nullptr, nullptr, 0, scr, r, lane); continue; } r -= I_SQ;
            transpose_item(xa_w_o, D, D, Wo_t, D, nullptr, nullptr, 0, scr, r, lane);
        }
        for (int idx = gw * 64 + lane; idx < 32 * D; idx += NGW * 64) { const int n = idx >> 10, k = idx & 1023; float w = 0.f;
            if (n < 4) w = w_gr[k * 4 + n]; else if (n < 20) w = w_er[((size_t)((n - 4) >> 2) * D + k) * 4 + ((n - 4) & 3)];
            w *= norm_moe[k]; const unsigned hi = f2bf(w); Wrh[idx] = (bf16_t)hi; Wrl[idx] = (bf16_t)f2bf(w - bf2f((unsigned short)hi)); }
        constexpr int I_GU = (D / 64) * (DE / 64), I_DN = (DE / 64) * (D / 64);
        for (int it = gw; it < 32 * I_GU + 48 * I_DN; it += NGW) {
            int r = it;
            if (r < 16 * I_GU) { const int e = r / I_GU; transpose_item(w_gate + (size_t)e * D * DE, D, DE, Wg_t + (size_t)e * DE * D, D, norm_moe, norm_moe, D, scr, r % I_GU, lane); continue; } r -= 16 * I_GU;
            if (r < 16 * I_GU) { const int e = r / I_GU; transpose_item(w_up + (size_t)e * D * DE, D, DE, Wu_t + (size_t)e * DE * D, D, norm_moe, norm_moe, D, scr, r % I_GU, lane); continue; } r -= 16 * I_GU;
            { const int cs = r / I_DN, cls = cs >> 1, slot = cs & 1; int ea, eb; pg8::pair_ab(cls % 6, ea, eb); const int e = (cls / 6) * 4 + (slot ? eb : ea);
              transpose_item(w_down + (size_t)e * DE * D, DE, D, Wd2 + (size_t)cls * D * 512 + slot * DE, 512, nullptr, nullptr, 0, scr, r % I_DN, lane); }
        }
    }
    }
    GRID_SYNC();
    for (int rep_ = 0; rep_ < (int)((REP_MASK >> 1) & 1u) + 1; ++rep_) {
    { pg8::DenseOrder S; S.init(xb, D, Win_t, D, NTOK, PROJ, C.G, C.bid); pg8::EpiInProjF E{0, rstd0, XR, GG, Qs, Ks, Vs, kmax};
      pg8::gemm_phase<pg8::EpiInProjF, pg8::DenseOrder, true>((LAS unsigned char*)lds, pg8::Gemm{D, D, D}, S, E); }
    { pg8::KvOrder S{memn, Wkv_t, Wkv_t + (size_t)D * D, C.G, C.bid}; pg8::EpiKv E{0, KM, VT};
      pg8::gemm_phase<pg8::EpiKv, pg8::KvOrder, true>((LAS unsigned char*)lds, pg8::Gemm{D, D, D}, S, E); }
    }
    GRID_SYNC();
    lru::Weights LW; lru::load_weights(LW, C.wave, lane & 31, lane >> 5, lru_w_a, lru_b_a, lru_w_x, lru_b_x, lru_lambda);
    for (int rep_ = 0; rep_ < (int)((REP_MASK >> 2) & 1u) + 1; ++rep_) {
    {
        for (int u = C.bid; u < BATCH * 64; u += C.G) lru::unit<false>(u >> 6, u & 63, LW, XR, GG, conv_w, conv_b, aggP, aggH, ssq_s, YY, fmid, fend, lds);
        for (int u = C.bid; u < BATCH * NH * 16; u += C.G) sba::sb_unit(u >> 7, (u >> 4) & 7, 15 - (u & 15), Qs, Ks, Vs, YY, ssq_s, (char*)lds);
    }
    }
    GRID_SYNC();
    for (int rep_ = 0; rep_ < (int)((REP_MASK >> 3) & 1u) + 1; ++rep_) {
    for (int u = C.bid; u < BATCH * 64; u += C.G) lru::unit<true>(u >> 6, u & 63, LW, XR, GG, conv_w, conv_b, aggP, aggH, ssq_s, YY, fmid, fend, lds);
    }
    GRID_SYNC();
    for (int rep_ = 0; rep_ < (int)((REP_MASK >> 4) & 1u) + 1; ++rep_) {
    { pg8::DenseOrder S; S.init(YY, D, Wout_t, D, NTOK, D, C.G, C.bid); pg8::EpiX1F E{8, xb, fmid, fend, X1b, ssq1};
      pg8::gemm_phase<pg8::EpiX1F, pg8::DenseOrder, true>((LAS unsigned char*)lds, pg8::Gemm{D, D, D}, S, E); }
    }
    GRID_SYNC();
    for (int rep_ = 0; rep_ < (int)((REP_MASK >> 5) & 1u) + 1; ++rep_) {
    { pg8::XaChainOrder S{X1b, Wq_t, QX, KM, VT, 0, 0, 0}; S.init(C.G, C.bid); pg8::EpiXaChain E{0, QX, OX, ssq1, 0.0625f * LOG2E, (LAS float*)(lds + 131072 + 2048)};
      pg8::gemm_phase<pg8::EpiXaChain, pg8::XaChainOrder, true>((LAS unsigned char*)lds, pg8::Gemm{D, D, D}, S, E); }
    }
    GRID_SYNC();
    for (int rep_ = 0; rep_ < (int)((REP_MASK >> 8) & 1u) + 1; ++rep_) {
    { pg8::DenseOrder S; S.init(OX, D, Wo_t, D, NTOK, D, C.G, C.bid); pg8::EpiResF E{0, X1b, X2b, ssq2};
      pg8::gemm_phase<pg8::EpiResF, pg8::DenseOrder, true>((LAS unsigned char*)lds, pg8::Gemm{D, D, D}, S, E); }
    }
    GRID_SYNC();
    for (int rep_ = 0; rep_ < (int)((REP_MASK >> 9) & 1u) + 1; ++rep_) {
    {
        LAS int* lcnt = (LAS int*)lds; LAS int* lbase = lcnt + 32; LAS int* lcls = lcnt + 64; LAS int* lpos = lcnt + 192;
        for (int p = C.tid; p < 64 * 128; p += NTHREADS) { const int rrow = p >> 7, pc = p & 127;
            *(LAS u32x4*)(lds + 12288 + rrow * 2064 + pc * 16) = *(const u32x4*)(Wrh + (size_t)rrow * D + pc * 8); }
        for (int chunk = C.bid; chunk < NTOK / 128; chunk += C.G) {
            if (C.tid < 32) lcnt[C.tid] = 0;
            __syncthreads();
            {
                const int fr = lane & 15, fq = lane >> 4, row0 = chunk * 128 + C.wave * 16;
                f32x4 acc0 = {0.f, 0.f, 0.f, 0.f}, acc1 = acc0;
                const bf16_t* ap = X2b + (size_t)(row0 + fr) * D + fq * 8; const LAS unsigned char* bp = (const LAS unsigned char*)(lds + 12288) + fr * 2064 + fq * 16;
#pragma unroll 1
                for (int kb = 0; kb < 4; ++kb) { bf16x8 a[8];
#pragma unroll
                    for (int j = 0; j < 8; ++j) a[j] = *(const bf16x8*)(ap + (kb * 8 + j) * 32);
#pragma unroll
                    for (int j = 0; j < 8; ++j) { const int ks = kb * 8 + j;
                        const bf16x8 h0 = *(const LAS bf16x8*)(bp + ks * 64), h1 = *(const LAS bf16x8*)(bp + 16 * 2064 + ks * 64), l0 = *(const LAS bf16x8*)(bp + 32 * 2064 + ks * 64), l1 = *(const LAS bf16x8*)(bp + 48 * 2064 + ks * 64);
                        acc0 = __builtin_amdgcn_mfma_f32_16x16x32_bf16(a[j], h0, acc0, 0, 0, 0); acc1 = __builtin_amdgcn_mfma_f32_16x16x32_bf16(a[j], h1, acc1, 0, 0, 0);
                        acc0 = __builtin_amdgcn_mfma_f32_16x16x32_bf16(a[j], l0, acc0, 0, 0, 0); acc1 = __builtin_amdgcn_mfma_f32_16x16x32_bf16(a[j], l1, acc1, 0, 0, 0); } }
                LAS float* lg = (LAS float*)(lds + 1536) + C.wave * (16 * 21);
#pragma unroll
                for (int j = 0; j < 4; ++j) { lg[(4 * fq + j) * 21 + fr] = acc0[j]; if (fr < 4) lg[(4 * fq + j) * 21 + 16 + fr] = acc1[j]; }
                asm volatile("s_waitcnt lgkmcnt(0)" ::: "memory");
                if (lane < 16) { const int row = row0 + lane; const float rs = pg8::rstd16(ssq2 + (size_t)row * 16); const LAS float* lr = lg + lane * 21;
                    float gl[4]; float gm = -INFINITY; int gi = 0;
#pragma unroll
                    for (int i = 0; i < 4; ++i) { gl[i] = lr[i] * rs + b_gr[i]; if (gl[i] > gm) { gm = gl[i]; gi = i; } }
                    float gs = 0.f;
#pragma unroll
                    for (int i = 0; i < 4; ++i) gs += __expf(gl[i] - gm);
                    const float gp = 1.f / gs;
                    float el[4];
#pragma unroll
                    for (int e = 0; e < 4; ++e) el[e] = lr[4 + gi * 4 + e] * rs + b_er[gi * 4 + e];
                    int e1 = 0; float m1 = el[0];
#pragma unroll
                    for (int e = 1; e < 4; ++e) if (el[e] > m1) { m1 = el[e]; e1 = e; }
                    int e2 = -1; float m2 = -INFINITY;
#pragma unroll
                    for (int e = 0; e < 4; ++e) if (e != e1 && el[e] > m2) { m2 = el[e]; e2 = e; }
                    const float p2 = __expf(m2 - m1), w1 = gp / (1.f + p2), w2 = gp * p2 / (1.f + p2);
                    const int ea = e1 < e2 ? e1 : e2, eb = e1 < e2 ? e2 : e1; const float wA = e1 < e2 ? w1 : w2, wB = e1 < e2 ? w2 : w1;
                    const int pr = (ea == 0) ? eb - 1 : (ea == 1) ? eb + 1 : 5, cls = gi * 6 + pr, lt = C.wave * 16 + lane;
                    selw[(size_t)row * 2] = wA; selw[(size_t)row * 2 + 1] = wB;
                    lcls[lt] = cls; lpos[lt] = __hip_atomic_fetch_add(lcnt + cls, 1, __ATOMIC_RELAXED, __HIP_MEMORY_SCOPE_WORKGROUP); }
            }
            __syncthreads();
            if (C.tid < 24) lbase[C.tid] = atomicAdd(gcnt + C.tid, lcnt[C.tid]);
            __syncthreads();
            if (C.tid < 128) { const int c = lcls[C.tid]; tlist[(size_t)c * NTOK + lbase[c] + lpos[C.tid]] = chunk * 128 + C.tid; }
            __syncthreads();
        }
    }
    }
    GRID_SYNC();
    LAS int* meta = (LAS int*)(lds + 146432 + 256);
    for (int rep_ = 0; rep_ < (int)((REP_MASK >> 10) & 1u) + 1; ++rep_) {
    {
        if (C.tid == 0) { int rb = 0, tb = 0;
            for (int c = 0; c < 24; ++c) { const int n = gcnt[c], nt = (n + 255) >> 8; meta[c] = n; meta[32 + c] = rb; meta[64 + c] = tb; rb += nt * 256; tb += nt; }
            meta[32 + 24] = rb; meta[64 + 24] = tb; }
        __syncthreads();
        const int total = meta[32 + 24];
        for (int R = gw; R < total; R += NGW) {
            int c = 0;
            for (int k = 1; k < 24; ++k) c += (R >= meta[32 + k]) ? 1 : 0;
            const int p = R - meta[32 + c]; u32x4 v0 = (u32x4){0u, 0u, 0u, 0u}, v1 = v0; int tok = -1; float rs = 0.f, wA = 0.f, wB = 0.f;
            if (p < meta[c]) { tok = tlist[(size_t)c * NTOK + p]; const u32x4* src = (const u32x4*)(X2b + (size_t)tok * D) + lane; v0 = src[0]; v1 = src[64];
                rs = pg8::rstd16(ssq2 + (size_t)tok * 16); wA = selw[(size_t)tok * 2]; wB = selw[(size_t)tok * 2 + 1]; }
            u32x4* dst = (u32x4*)(XG + (size_t)R * D) + lane; dst[0] = v0; dst[64] = v1;
            if (lane == 0) { rsg[R] = rs; wAg[R] = wA; wBg[R] = wB; tokg[R] = tok; }
        }
    }
    }
    GRID_SYNC();
    for (int rep_ = 0; rep_ < (int)((REP_MASK >> 11) & 1u) + 1; ++rep_) {
    { pg8::MoeOrder1 S{XG, Wg_t, Wu_t, meta, C.G, C.bid}; pg8::EpiMoeUp E{0, rsg, wAg, wBg, HID};
      pg8::gemm_phase<pg8::EpiMoeUp, pg8::MoeOrder1, true>((LAS unsigned char*)lds, pg8::Gemm{D, D, D}, S, E); }
    }
    GRID_SYNC();
    for (int rep_ = 0; rep_ < (int)((REP_MASK >> 12) & 1u) + 1; ++rep_) {
    { pg8::MoeOrder2 S{HID, Wd2, meta, C.G, C.bid};
      pg8::EpiMoeFinal E{0, tokg, X2b, out, ssq3, (unsigned*)(ws + WS_CTL + 4096 + 16384), norm_final, (LAS unsigned*)(lds + 146432 + 128), (unsigned*)(ws + WS_CTL + 4096) + 128};
      pg8::gemm_phase<pg8::EpiMoeFinal, pg8::MoeOrder2, true>((LAS unsigned char*)lds, pg8::Gemm{512, 512, 512}, S, E); }
    }
}

#undef gw
#undef lane
extern "C" void kernel_launch(void* const* d_in, const int* in_sizes, int n_in, void* d_out, int out_size, void* d_ws, size_t ws_size, hipStream_t stream) {
    static int grid = 0;
    if (grid == 0) {
        if (n_in != 29 || ws_size < WS_END) { fprintf(stderr, "kernel_launch: unexpected inputs (%d) or workspace (%zu)\n", n_in, ws_size); grid = -1; return; }
        int dev = 0, cus = 0, per_cu = 0;
        hipGetDevice(&dev); hipDeviceGetAttribute(&cus, hipDeviceAttributeMultiprocessorCount, dev);
        hipFuncSetAttribute((const void*)mk_fwd, hipFuncAttributeMaxDynamicSharedMemorySize, LDS_BYTES);
        hipOccupancyMaxActiveBlocksPerMultiprocessor(&per_cu, (const void*)mk_fwd, NTHREADS, LDS_BYTES);
        if (per_cu < 1) { fprintf(stderr, "kernel_launch: occupancy query says %d blocks per CU\n", per_cu); per_cu = 1; }
        if (per_cu > 1) per_cu = 1;
        grid = cus * per_cu;
    }
    if (grid < 0) return;
    if (hipMemsetAsync((char*)d_ws + WS_CTL + 4096, 0, 32768, stream) != hipSuccess) { fprintf(stderr, "kernel_launch: memset of the barrier words failed\n"); return; }
    Args a{};
    for (int i = 0; i < 29; ++i) a.in[i] = (const float*)d_in[i];
    a.out = (float*)d_out; a.ws = (unsigned char*)d_ws;
    void* kargs[] = {&a};
    hipError_t e = hipLaunchCooperativeKernel((const void*)mk_fwd, dim3(grid), dim3(NTHREADS), kargs, LDS_BYTES, stream);
    if (e != hipSuccess) fprintf(stderr, "cooperative launch failed: %s (grid %d)\n", hipGetErrorString(e), grid);
}
```

```cpp
#include <hip/hip_runtime.h>
#include <hip/hip_cooperative_groups.h>
#include <cstdio>
#include <cstdint>

typedef unsigned short bf16_t;
typedef short bf16x8 __attribute__((ext_vector_type(8)));
typedef float f32x4 __attribute__((ext_vector_type(4)));
typedef unsigned u32x4 __attribute__((ext_vector_type(4)));

constexpr int D = 1024, BATCH = 8, SEQ = 4096, NTOK = BATCH * SEQ, MEM = 256, NMEM = BATCH * MEM;
constexpr int RW = 512, SBW = 512, PROJ = 2560, NH = 8, HD = 64;
constexpr int XH = 4, XD = 256, NG = 4, EPG = 4, NEXP = 16, DE = 256;
constexpr float EPS = 1e-6f, LOG2E = 1.4426950408889634f;

constexpr size_t MiB = 1u << 20;
constexpr size_t WS_CTL = 0;
constexpr size_t WS_SMALL = 1 * MiB;
constexpr size_t WS_WIN = 16 * MiB;
constexpr size_t WS_WOUT = 21 * MiB;
constexpr size_t WS_WQ = 23 * MiB;
constexpr size_t WS_WKV = 25 * MiB;
constexpr size_t WS_WO = 29 * MiB;
constexpr size_t WS_MEMN = 31 * MiB;
constexpr size_t WS_KVM = 35 * MiB;
constexpr size_t WS_WG = 43 * MiB;
constexpr size_t WS_WU = 51 * MiB;
constexpr size_t WS_WD2 = 59 * MiB;
constexpr size_t WS_R0 = 96 * MiB;
constexpr size_t WS_R1 = 160 * MiB;
constexpr size_t WS_R2 = 224 * MiB;
constexpr size_t WS_R3 = 288 * MiB;
constexpr size_t WS_R4 = 320 * MiB;
constexpr size_t WS_R5 = 384 * MiB;
constexpr size_t WS_END = 448 * MiB;

constexpr size_t SM_RSTD0 = 0;
constexpr size_t SM_SSQR = 1 * 32768;
constexpr size_t SM_SSQS = 2 * 32768;
constexpr size_t SM_SSQ1 = 10 * 32768;
constexpr size_t SM_SSQ2 = 26 * 32768;
constexpr size_t SM_SSQ3 = 42 * 32768;
constexpr size_t SM_SELW = 58 * 32768;
constexpr size_t SM_SELE = 60 * 32768;
constexpr size_t SM_END = 62 * 32768;

__device__ __forceinline__ unsigned f2bf(float f) { unsigned u = __builtin_bit_cast(unsigned, f); return (u + 0x7fffu + ((u >> 16) & 1u)) >> 16; }
__device__ __forceinline__ float bf2f(unsigned short h) { return __builtin_bit_cast(float, (unsigned)h << 16); }
__device__ __forceinline__ float wave_sum(float v) {
#pragma unroll
    for (int o = 1; o < 64; o <<= 1) v += __shfl_xor(v, o);
    return v;
}
__device__ __forceinline__ float gelu_tanh(float x) { const float u = 0.7978845608028654f * (x + 0.044715f * x * x * x); return x * __builtin_amdgcn_rcpf(1.f + __expf(-2.f * u)); }
__device__ __forceinline__ float sigmoidf_(float x) { return 1.f / (1.f + __expf(-x)); }

namespace cg = cooperative_groups;
#ifndef PROBE_A
#define PROBE_A -1
#endif
#ifndef REP_MASK
#define REP_MASK 0u
#endif
#define LAS __attribute__((address_space(3)))
constexpr int NWAVES = 8, NTHREADS = 512;
constexpr int LDS_BYTES = 147456;

struct Args { const float* in[29]; float* out; unsigned char* ws; };

struct Ctx {
    const float* in[29]; float* out; unsigned char* ws; unsigned char* lds;
    int tid, lane, wave, gw, NGW, G, bid;
};

#define RLX_AGENT __ATOMIC_RELAXED, __HIP_MEMORY_SCOPE_AGENT
#define XB_TMO      128
#define XB_XCNT(j)  (256  + 64 * (j))
#define XB_XSUB(j)  (1280 + 64 * (j))
#define XB_XGEN(j)  (2304 + 64 * (j))
#define XB_TOP      3328
#define XB_TOPGEN   3392
#define XCD_BAR_WORDS 3456
#define XB_SPIN_CAP (1u << 18)

__device__ __forceinline__ unsigned xb_ld(unsigned* p)              { return __hip_atomic_load(p, __ATOMIC_RELAXED, __HIP_MEMORY_SCOPE_AGENT); }
__device__ __forceinline__ unsigned xb_add(unsigned* p, unsigned v) { return __hip_atomic_fetch_add(p, v, __ATOMIC_RELAXED, __HIP_MEMORY_SCOPE_AGENT); }
__device__ __forceinline__ unsigned xb_xcc_id() { return (unsigned)__builtin_amdgcn_s_getreg((3 << 11) | 20) & 0xFu; }
#define XB_SPIN(cond, bar) do { unsigned _sp = 0; while (cond) { __builtin_amdgcn_s_sleep(1); \
    if ((++_sp & 255u) == 0u) { if (xb_ld(&(bar)[XB_TMO])) break; if (_sp > XB_SPIN_CAP) { atomicAdd(&(bar)[XB_TMO], 1u); break; } } } } while (0)

struct XcdBarrier {
    unsigned* bar; unsigned x;
    volatile LAS unsigned* st;
};

__device__ __forceinline__ XcdBarrier xcd_barrier_post(unsigned* bar, volatile LAS unsigned* st) {
    XcdBarrier b; b.bar = bar; b.x = xb_xcc_id(); b.st = st;
    if (threadIdx.x == 0) (void)xb_add(&bar[XB_XCNT(b.x)], 1u);
    return b;
}
__device__ __forceinline__ void xcd_barrier_complete(unsigned* bar, unsigned x, unsigned& nloc, unsigned& nx) {
    const unsigned G = gridDim.x * gridDim.y * gridDim.z;
    unsigned sum, cnt, mine, sp = 0u;
    for (;;) {
        sum = 0u; cnt = 0u; mine = 0u;
#pragma unroll
        for (unsigned j = 0; j < 16; ++j) { const unsigned c = xb_ld(&bar[XB_XCNT(j)]); sum += c; cnt += (c > 0u) ? 1u : 0u; mine = (j == x) ? c : mine; }
        if (sum == G) break;
        __builtin_amdgcn_s_sleep(1);
        if ((++sp & 255u) == 0u) { if (xb_ld(&bar[XB_TMO])) break; if (sp > XB_SPIN_CAP) { atomicAdd(&bar[XB_TMO], 1u); break; } }
    }
    nloc = mine > 0u ? mine : 1u; nx = cnt > 0u ? cnt : 1u;
}

__device__ __forceinline__ void xcd_barrier(const XcdBarrier& b) {
    asm volatile("s_waitcnt vmcnt(0)" ::: "memory");
    __syncthreads();
    if (threadIdx.x == 0) {
        unsigned* bar = b.bar;
        __builtin_amdgcn_s_waitcnt(0);
        unsigned nloc = b.st[0], nx = b.st[1];
        if (nloc == 0u) { xcd_barrier_complete(bar, b.x, nloc, nx); b.st[0] = nloc; b.st[1] = nx; }
        const unsigned old = xb_add(&bar[XB_XSUB(b.x)], 1u);
        const unsigned gen = old / nloc;
        if (old + 1u == (gen + 1u) * nloc) {
            __builtin_amdgcn_fence(__ATOMIC_RELEASE, "agent");
            asm volatile("s_waitcnt vmcnt(0)" ::: "memory");
            const unsigned og = xb_add(&bar[XB_TOP], 1u);
            const unsigned tg = og / nx;
            if (og + 1u == (tg + 1u) * nx) xb_add(&bar[XB_TOPGEN], 1u);
            else XB_SPIN(xb_ld(&bar[XB_TOPGEN]) == tg, bar);
            __builtin_amdgcn_fence(__ATOMIC_ACQUIRE, "agent");
            xb_add(&bar[XB_XGEN(b.x)], 1u);
            asm volatile("s_waitcnt vmcnt(0)" ::: "memory");
        } else {
            XB_SPIN(xb_ld(&bar[XB_XGEN(b.x)]) == gen, bar);
            __builtin_amdgcn_fence(__ATOMIC_ACQUIRE, "agent");
            asm volatile("s_waitcnt vmcnt(0)" ::: "memory");
        }
    }
    __syncthreads();
}
namespace pg8 {
#define PG8_LAS __attribute__((address_space(3)))
constexpr int BM = 256, BK = 64, HALF = 128, HTB = HALF * BK * 2  , STAGE_BYTES = 8 * HTB, NXCD = 8, WGM = 8;
__host__ __device__ __forceinline__ int lds_byte(int r, int c) { const int st = (r >> 4) * 2 + (c >> 5), rr = r & 15, cc = c & 31, ob = rr * 64 + cc * 2; return st * 1024 + (ob ^ (((ob >> 9) & 1) << 5)); }
__host__ __device__ __forceinline__ void stage_rc(int b, int& R, int& C) { const int st = b / 1024, sb = b % 1024, swz = sb ^ (((sb >> 9) & 1) << 5); R = (st >> 1) * 16 + swz / 64; C = (st & 1) * 32 + (swz % 64) / 2; }
__host__ __device__ __forceinline__ int perm32(int rho) { const int n = rho >> 4, i = rho & 15; return 8 * (i >> 2) + 4 * n + (i & 3); }

struct Unit { int pm, pn; };
struct Gemm { int lda, ldb, K; };
struct DenseOrder {
    const bf16_t* A; const bf16_t* Bt; int lda, ldb; int nM, nN, nwg, G, c; int ntk = D / BK;
    __device__ __forceinline__ int nt(const Unit&) const { return ntk; }
    __device__ void init(const bf16_t* A_, int lda_, const bf16_t* Bt_, int ldb_, int M, int N, int G_, int c_) { A = A_; Bt = Bt_; lda = lda_; ldb = ldb_; nM = M / BM; nN = N / BM; nwg = nM * nN; G = G_; c = c_; }
    __device__ bool next(int i, Unit& u) const {
        const long L = (long)i * G + c; if (L >= nwg) return false;
        int wgid = (int)L; { const int q = nwg / NXCD, r = nwg % NXCD, xcd = wgid % NXCD, off = wgid / NXCD; wgid = (xcd < r ? xcd * (q + 1) : r * (q + 1) + (xcd - r) * q) + off; }
        const int nig = WGM * nN, gid = wgid / nig, fm = gid * WGM, gsz = (nM - fm) < WGM ? (nM - fm) : WGM;
        u.pm = fm + ((wgid % nig) % gsz); u.pn = (wgid % nig) / gsz; return true;
    }
    __device__ __forceinline__ void ptrs(const Unit& u, const char*& a, const char*& b0, const char*& b1) const {
        a = (const char*)A + (size_t)u.pm * BM * lda * 2; b0 = (const char*)Bt + (size_t)u.pn * BM * ldb * 2; b1 = b0 + (size_t)HALF * ldb * 2; }
};

__device__ __forceinline__ unsigned cvt_pk_bf16(float lo, float hi) { unsigned r; asm volatile("v_cvt_pk_bf16_f32 %0, %1, %2" : "=v"(r) : "v"(lo), "v"(hi)); return r; }

template <class Epi, class Sched, bool ALIGN_EPI>
__device__ __forceinline__ void gemm_phase(PG8_LAS unsigned char* lds, const Gemm g, const Sched& S, const Epi& E, int pidx = 0) {
    int tid_ = threadIdx.x; asm volatile("" : "+v"(tid_));
    const int tid = tid_, wid = __builtin_amdgcn_readfirstlane(tid >> 6), lane = tid & 63, wr = wid >> 2, wc = wid & 3, fr = lane & 15, fq = lane >> 4;
    unsigned voffA[2], voffB[2];
#pragma unroll
    for (int i = 0; i < 2; ++i) { int R, C; stage_rc(tid * 16 + i * 8192, R, C); const int Rb = Epi::PERM ? ((R & ~31) + perm32(R & 31)) : R;
        voffA[i] = (unsigned)(R * g.lda + C) * 2u; voffB[i] = (unsigned)(Rb * g.ldb + C) * 2u; }
    const size_t kstep = (size_t)(BK * 2);
    const size_t hstepA = (size_t)HALF * g.lda * 2;
    const unsigned ldsw = (unsigned)wid * 1024u;
    const int aoff = lds_byte(wr * 64 + fr, fq * 8), boff = lds_byte(wc * 32 + fr, fq * 8);
#define PG8_SA(b, h) (((b) * 2 + (h)) * HTB)
#define PG8_SB(b, h) ((4 + (b) * 2 + (h)) * HTB)
#define PG8_STAGE(bufoff, gbase, voff) do { _Pragma("unroll") for (int _i = 0; _i < 2; ++_i) \
        __builtin_amdgcn_global_load_lds((const unsigned*)((const char*)(gbase) + (voff)[_i]), (PG8_LAS unsigned*)(lds + (bufoff) + ldsw + _i * 8192), 16, 0, 0); } while (0)
#define PG8_LDA(dst, b, h) do { _Pragma("unroll") for (int m = 0; m < 4; ++m) _Pragma("unroll") for (int k = 0; k < 2; ++k) dst[m][k] = *(const PG8_LAS bf16x8*)(lds + PG8_SA(b, h) + aoff + m * 2048 + k * 1024); } while (0)
#define PG8_LDB(dst, b, h) do { _Pragma("unroll") for (int n = 0; n < 2; ++n) _Pragma("unroll") for (int k = 0; k < 2; ++k) dst[n][k] = *(const PG8_LAS bf16x8*)(lds + PG8_SB(b, h) + boff + n * 2048 + k * 1024); } while (0)
#define PG8_MMA(ai, bj, At, Bt) do { __builtin_amdgcn_s_setprio(1); _Pragma("unroll") for (int m = 0; m < 4; ++m) _Pragma("unroll") for (int n = 0; n < 2; ++n) _Pragma("unroll") for (int k = 0; k < 2; ++k) \
        acc[ai][bj][m][n] = __builtin_amdgcn_mfma_f32_16x16x32_bf16(Bt[n][k], At[m][k], acc[ai][bj][m][n], 0, 0, 0); __builtin_amdgcn_s_setprio(0); } while (0)
#define PG8_WAIT_V(n) asm volatile("s_waitcnt vmcnt(" #n ")" ::: "memory")
#define PG8_WAIT_L(n) asm volatile("s_waitcnt lgkmcnt(" #n ")" ::: "memory")
#define PG8_BAR __builtin_amdgcn_s_barrier()
#define PG8_SCHED __builtin_amdgcn_sched_barrier(0)
    Unit cur, nxt; int ui = 0;
    if (!S.next(0, cur)) return;
    f32x4 acc[2][2][4][2];
#pragma unroll
    for (int a = 0; a < 2; ++a)
#pragma unroll
        for (int b = 0; b < 2; ++b)
#pragma unroll
            for (int m = 0; m < 4; ++m)
#pragma unroll
                for (int n = 0; n < 2; ++n) acc[a][b][m][n] = (f32x4){0.f, 0.f, 0.f, 0.f};
    bf16x8 At[4][2], B0[2][2], B1[2][2];
    const char *cA, *cB0, *cB1; S.ptrs(cur, cA, cB0, cB1);
    int nt = S.nt(cur); asm volatile("" : "+s"(nt));
    PG8_STAGE(PG8_SB(0, 0), cB0, voffB); PG8_STAGE(PG8_SB(0, 1), cB1, voffB); PG8_STAGE(PG8_SA(0, 0), cA, voffA); PG8_STAGE(PG8_SA(0, 1), cA + hstepA, voffA);
    if (wr == 1) PG8_BAR;
    PG8_WAIT_V(2); PG8_BAR;
    PG8_STAGE(PG8_SB(1, 0), cB0 + kstep, voffB); PG8_STAGE(PG8_SA(1, 0), cA + kstep, voffA); PG8_STAGE(PG8_SB(1, 1), cB1 + kstep, voffB);
    PG8_WAIT_V(6); PG8_BAR;
    for (;;) {
        const bool has_next = S.next(ui + 1, nxt);
        const char *nA = cA, *nB0 = cB0, *nB1 = cB1; if (has_next) S.ptrs(nxt, nA, nB0, nB1);
#pragma unroll 1
        for (int t = 0; t < nt; t += 2) {
            const bool last = (t == nt - 2);
            if constexpr (Epi::HAS_MID) { if (t == E.mid_t) E.mid(acc, cur, wr, wc, fr, fq); }
            const char* a1 = cA + (size_t)(t + 1) * kstep;
            const char* a2 = last ? nA : cA + (size_t)(t + 2) * kstep; const char* b2 = last ? nB0 : cB0 + (size_t)(t + 2) * kstep; const char* b2h = last ? nB1 : cB1 + (size_t)(t + 2) * kstep;
            const char* a3 = a2 + kstep; const char* b3 = b2 + kstep; const char* b3h = b2h + kstep;
            PG8_LDB(B0, 0, 0); PG8_LDB(B1, 0, 1); PG8_SCHED; PG8_LDA(At, 0, 0); PG8_STAGE(PG8_SA(1, 1), a1 + hstepA, voffA);
            PG8_WAIT_V(8); PG8_WAIT_L(0); PG8_BAR; PG8_MMA(0, 0, At, B0); PG8_MMA(0, 1, At, B1); PG8_BAR; PG8_SCHED;
            PG8_LDA(At, 0, 1); PG8_STAGE(PG8_SB(0, 0), b2, voffB); PG8_STAGE(PG8_SB(0, 1), b2h, voffB); PG8_STAGE(PG8_SA(0, 0), a2, voffA);
            PG8_WAIT_V(8); PG8_WAIT_L(0); PG8_BAR; PG8_MMA(1, 0, At, B0); PG8_MMA(1, 1, At, B1); PG8_BAR; PG8_SCHED;
            PG8_LDB(B0, 1, 0); PG8_LDB(B1, 1, 1); PG8_SCHED; PG8_LDA(At, 1, 0); PG8_STAGE(PG8_SA(0, 1), a2 + hstepA, voffA);
            PG8_WAIT_V(8); PG8_WAIT_L(0); PG8_BAR; PG8_MMA(0, 0, At, B0); PG8_MMA(0, 1, At, B1); PG8_BAR; PG8_SCHED;
            PG8_LDA(At, 1, 1); PG8_STAGE(PG8_SB(1, 0), b3, voffB); PG8_STAGE(PG8_SB(1, 1), b3h, voffB); PG8_STAGE(PG8_SA(1, 0), a3, voffA);
            PG8_WAIT_V(8); PG8_WAIT_L(0); PG8_BAR; PG8_MMA(1, 0, At, B0); PG8_MMA(1, 1, At, B1); PG8_BAR; PG8_SCHED;
        }
        if constexpr (ALIGN_EPI) { if (wr == 0) PG8_BAR; }
        { unsigned long long te_ = 0; if (PROBE_A >= 500 && blockIdx.x == 0 && tid == 0) te_ = __builtin_amdgcn_s_memrealtime();
        E(acc, cur, wr, wc, fr, fq);
        if (PROBE_A >= 500 && blockIdx.x == 0 && tid == 0) { PG8_LAS unsigned long long* es_ = (PG8_LAS unsigned long long*)(lds + 147200) + 16 + pidx; *es_ += __builtin_amdgcn_s_memrealtime() - te_; } }
        if (!has_next) break;
#pragma unroll
        for (int a = 0; a < 2; ++a)
#pragma unroll
            for (int b = 0; b < 2; ++b)
#pragma unroll
                for (int m = 0; m < 4; ++m)
#pragma unroll
                    for (int n = 0; n < 2; ++n) acc[a][b][m][n] = (f32x4){0.f, 0.f, 0.f, 0.f};
        cur = nxt; cA = nA; cB0 = nB0; cB1 = nB1; ++ui; nt = S.nt(cur); asm volatile("" : "+s"(nt));
        if constexpr (ALIGN_EPI) { if (wr == 1) PG8_BAR; }
    }
    PG8_WAIT_V(0);
    if constexpr (!ALIGN_EPI) { if (wr == 0) PG8_BAR; }
    PG8_BAR;
#undef PG8_SA
#undef PG8_SB
#undef PG8_STAGE
#undef PG8_LDA
#undef PG8_LDB
#undef PG8_MMA
#undef PG8_WAIT_V
#undef PG8_WAIT_L
#undef PG8_BAR
#undef PG8_SCHED
}

__device__ __forceinline__ float rstd16(const float* p) { const f32x4 a = ((const f32x4*)p)[0], b = ((const f32x4*)p)[1], c = ((const f32x4*)p)[2], d = ((const f32x4*)p)[3];
    const float s = ((a.x + a.y) + (a.z + a.w)) + ((b.x + b.y) + (b.z + b.w)) + ((c.x + c.y) + (c.z + c.w)) + ((d.x + d.y) + (d.z + d.w)); return __builtin_amdgcn_rsqf(s * (1.f / D) + EPS); }
__device__ __forceinline__ u32x4 pack8(const f32x4 v0, const f32x4 v1) { u32x4 w; w.x = cvt_pk_bf16(v0[0], v0[1]); w.y = cvt_pk_bf16(v0[2], v0[3]); w.z = cvt_pk_bf16(v1[0], v1[1]); w.w = cvt_pk_bf16(v1[2], v1[3]); return w; }
__device__ __forceinline__ float sq8(const f32x4 a, const f32x4 b) { return ((a[0] * a[0] + a[1] * a[1]) + (a[2] * a[2] + a[3] * a[3])) + ((b[0] * b[0] + b[1] * b[1]) + (b[2] * b[2] + b[3] * b[3])); }

struct EpiInProjF {
    static constexpr bool PERM = true, HAS_MID = false; int mid_t;
    const float* rstd0; bf16_t *XR, *GG, *Qs, *Ks, *Vs; unsigned* kmax;
    __device__ __forceinline__ void mid(f32x4 (&)[2][2][4][2], const Unit&, int, int, int, int) const {}
    __device__ __forceinline__ void operator()(const f32x4 (&acc)[2][2][4][2], const Unit& u, int wr, int wc, int fr, int fq) const {
        const int row0 = u.pm * BM + wr * 64 + fr, t = u.pn >> 1, colt = (u.pn & 1) * 256 + wc * 32 + 8 * fq;
        bf16_t* base = (t == 0) ? XR : (t == 1) ? GG : (t == 2) ? Qs : (t == 3) ? Ks : Vs;
        float km0 = 0.f, km1 = 0.f;
#pragma unroll
        for (int ai = 0; ai < 2; ++ai)
#pragma unroll
            for (int m = 0; m < 4; ++m) { const int r = row0 + ai * HALF + m * 16; const float rs = rstd0[r]; bf16_t* rowp = base + (size_t)r * 512 + colt;
#pragma unroll
                for (int bj = 0; bj < 2; ++bj) { f32x4 v0 = acc[ai][bj][m][0] * rs, v1 = acc[ai][bj][m][1] * rs;
                    if (t == 1) {
#pragma unroll
                        for (int e = 0; e < 4; ++e) { v0[e] = gelu_tanh(v0[e]); v1[e] = gelu_tanh(v1[e]); } }
                    else if (t == 2) { v0 = v0 * (0.125f * LOG2E); v1 = v1 * (0.125f * LOG2E); }
                    else if (t == 3) { float mx = 0.f;
#pragma unroll
                        for (int e = 0; e < 4; ++e) mx = fmaxf(mx, fmaxf(fabsf(v0[e]), fabsf(v1[e])));
                        if (bj == 0) km0 = fmaxf(km0, mx); else km1 = fmaxf(km1, mx); }
                    *(u32x4*)(rowp + bj * HALF) = pack8(v0, v1); } }
        if (t == 3) {
#pragma unroll
            for (int o = 1; o < 64; o <<= 1) { km0 = fmaxf(km0, __shfl_xor(km0, o)); km1 = fmaxf(km1, __shfl_xor(km1, o)); }
            if ((fr | fq) == 0) { const int b = (u.pm * BM) / SEQ, hd = (u.pn & 1) * 4 + (wc >> 1);
                atomicMax(kmax + b * 8 + hd, __float_as_uint(km0)); atomicMax(kmax + b * 8 + hd + 2, __float_as_uint(km1)); }
        }
    }
};
struct EpiBf16F {
    static constexpr bool PERM = true, HAS_MID = false; int mid_t;
    bf16_t* O; const float* ssq16; int ldo; float scale; size_t tstride;
    __device__ __forceinline__ void mid(f32x4 (&)[2][2][4][2], const Unit&, int, int, int, int) const {}
    __device__ __forceinline__ void operator()(const f32x4 (&acc)[2][2][4][2], const Unit& u, int wr, int wc, int fr, int fq) const {
        const int row0 = u.pm * BM + wr * 64 + fr, col0 = (tstride ? 0 : u.pn * BM) + wc * 32 + 8 * fq; bf16_t* base = O + (size_t)u.pn * tstride;
#pragma unroll
        for (int ai = 0; ai < 2; ++ai)
#pragma unroll
            for (int m = 0; m < 4; ++m) { const int r = row0 + ai * HALF + m * 16; const float rs = (ssq16 ? rstd16(ssq16 + (size_t)r * 16) : 1.f) * scale; bf16_t* rowp = base + (size_t)r * ldo + col0;
#pragma unroll
                for (int bj = 0; bj < 2; ++bj) *(u32x4*)(rowp + bj * HALF) = pack8(acc[ai][bj][m][0] * rs, acc[ai][bj][m][1] * rs); }
    }
};
struct EpiX1F {
    static constexpr bool PERM = true, HAS_MID = true; int mid_t;
    const bf16_t* xb; const float* fmid; const float* fend; bf16_t* X1b; float* ssq1;
    __device__ __forceinline__ void mid(f32x4 (&acc)[2][2][4][2], const Unit& u, int wr, int wc, int fr, int fq) const {
        const int row0 = u.pm * BM + wr * 64 + fr;
#pragma unroll
        for (int ai = 0; ai < 2; ++ai)
#pragma unroll
            for (int m = 0; m < 4; ++m) { const float f = fmid[row0 + ai * HALF + m * 16];
#pragma unroll
                for (int bj = 0; bj < 2; ++bj) { acc[ai][bj][m][0] = acc[ai][bj][m][0] * f; acc[ai][bj][m][1] = acc[ai][bj][m][1] * f; } }
    }
    __device__ __forceinline__ void operator()(const f32x4 (&acc)[2][2][4][2], const Unit& u, int wr, int wc, int fr, int fq) const {
        const int row0 = u.pm * BM + wr * 64 + fr, col0 = u.pn * BM + wc * 32 + 8 * fq;
#pragma unroll
        for (int ai = 0; ai < 2; ++ai)
#pragma unroll
            for (int m = 0; m < 4; ++m) { const int r = row0 + ai * HALF + m * 16; const float fe = fend[r]; float ss = 0.f;
#pragma unroll
                for (int bj = 0; bj < 2; ++bj) { const u32x4 xi = *(const u32x4*)(xb + (size_t)r * D + col0 + bj * HALF);
                    f32x4 v0, v1; v0[0] = __uint_as_float(xi.x << 16); v0[1] = __uint_as_float(xi.x & 0xffff0000u); v0[2] = __uint_as_float(xi.y << 16); v0[3] = __uint_as_float(xi.y & 0xffff0000u);
                    v1[0] = __uint_as_float(xi.z << 16); v1[1] = __uint_as_float(xi.z & 0xffff0000u); v1[2] = __uint_as_float(xi.w << 16); v1[3] = __uint_as_float(xi.w & 0xffff0000u);
                    v0 = v0 + acc[ai][bj][m][0] * fe; v1 = v1 + acc[ai][bj][m][1] * fe;
                    ss += sq8(v0, v1); *(u32x4*)(X1b + (size_t)r * D + col0 + bj * HALF) = pack8(v0, v1); }
                ss += __shfl_xor(ss, 16); ss += __shfl_xor(ss, 32);
                if (fq == 0) ssq1[(size_t)r * 16 + u.pn * 4 + wc] = ss; }
    }
};
struct EpiResF {
    static constexpr bool PERM = true, HAS_MID = false; int mid_t;
    const bf16_t* Xi; bf16_t* Xo; float* ssq;
    __device__ __forceinline__ void mid(f32x4 (&)[2][2][4][2], const Unit&, int, int, int, int) const {}
    __device__ __forceinline__ void operator()(const f32x4 (&acc)[2][2][4][2], const Unit& u, int wr, int wc, int fr, int fq) const {
        const int row0 = u.pm * BM + wr * 64 + fr, col0 = u.pn * BM + wc * 32 + 8 * fq;
#pragma unroll
        for (int ai = 0; ai < 2; ++ai)
#pragma unroll
            for (int m = 0; m < 4; ++m) { const int r = row0 + ai * HALF + m * 16; float ss = 0.f;
#pragma unroll
                for (int bj = 0; bj < 2; ++bj) { const u32x4 xi = *(const u32x4*)(Xi + (size_t)r * D + col0 + bj * HALF);
                    f32x4 v0, v1; v0[0] = __uint_as_float(xi.x << 16); v0[1] = __uint_as_float(xi.x & 0xffff0000u); v0[2] = __uint_as_float(xi.y << 16); v0[3] = __uint_as_float(xi.y & 0xffff0000u);
                    v1[0] = __uint_as_float(xi.z << 16); v1[1] = __uint_as_float(xi.z & 0xffff0000u); v1[2] = __uint_as_float(xi.w << 16); v1[3] = __uint_as_float(xi.w & 0xffff0000u);
                    v0 = v0 + acc[ai][bj][m][0]; v1 = v1 + acc[ai][bj][m][1];
                    ss += sq8(v0, v1); *(u32x4*)(Xo + (size_t)r * D + col0 + bj * HALF) = pack8(v0, v1); }
                ss += __shfl_xor(ss, 16); ss += __shfl_xor(ss, 32);
                if (fq == 0) ssq[(size_t)r * 16 + u.pn * 4 + wc] = ss; }
    }
};

__device__ __forceinline__ void pair_ab(int p, int& a, int& b) { a = (p < 3) ? 0 : (p < 5) ? 1 : 2; b = (p < 3) ? p + 1 : (p < 5) ? p - 1 : 3; }
__device__ __forceinline__ int moe_class_of_tile(const PG8_LAS int* meta, int T) { int c = 0;
#pragma unroll
    for (int k = 1; k < 24; ++k) c += (T >= __builtin_amdgcn_readfirstlane(meta[64 + k])) ? 1 : 0;
    return c; }
struct MoeOrder1 {
    __device__ __forceinline__ int nt(const Unit&) const { return D / BK; }
    const bf16_t* XG; const bf16_t* Wg; const bf16_t* Wu; const PG8_LAS int* meta; int G, c;
    __device__ bool next(int i, Unit& u) const { const int L = i * G + c, nt = __builtin_amdgcn_readfirstlane(meta[64 + 24]); if (L >= nt * 4) return false;
        u.pm = L >> 2; u.pn = moe_class_of_tile(meta, L >> 2) * 4 + (L & 3); return true; }
    __device__ __forceinline__ void ptrs(const Unit& u, const char*& a, const char*& b0, const char*& b1) const {
        const int cls = u.pn >> 2, j = (u.pn >> 1) & 1, half = u.pn & 1; int ea, eb; pair_ab(cls % 6, ea, eb); const int e = (cls / 6) * 4 + (j ? eb : ea);
        a = (const char*)XG + (size_t)u.pm * BM * D * 2; const size_t bo = ((size_t)e * DE + half * HALF) * D * 2; b0 = (const char*)Wg + bo; b1 = (const char*)Wu + bo; }
};
struct MoeOrder2 {
    __device__ __forceinline__ int nt(const Unit&) const { return 512 / BK; }
    const bf16_t* HID; const bf16_t* Wd2; const PG8_LAS int* meta; int G, c;
    __device__ bool next(int i, Unit& u) const { const int L = i * G + c, nt = __builtin_amdgcn_readfirstlane(meta[64 + 24]); if (L >= nt * 4) return false;
        u.pm = L >> 2; u.pn = moe_class_of_tile(meta, L >> 2) * 4 + (L & 3); return true; }
    __device__ __forceinline__ void ptrs(const Unit& u, const char*& a, const char*& b0, const char*& b1) const {
        a = (const char*)HID + (size_t)u.pm * BM * 512 * 2; b0 = (const char*)Wd2 + ((size_t)(u.pn >> 2) * D + (u.pn & 3) * BM) * 512 * 2; b1 = b0 + (size_t)HALF * 512 * 2; }
};
struct EpiMoeUp {
    static constexpr bool PERM = true, HAS_MID = false; int mid_t;
    const float* rsg; const float* wAg; const float* wBg; bf16_t* HID;
    __device__ __forceinline__ void mid(f32x4 (&)[2][2][4][2], const Unit&, int, int, int, int) const {}
    __device__ __forceinline__ void operator()(const f32x4 (&acc)[2][2][4][2], const Unit& u, int wr, int wc, int fr, int fq) const {
        const int row0 = u.pm * BM + wr * 64 + fr, j = (u.pn >> 1) & 1, col0 = j * 256 + (u.pn & 1) * HALF + wc * 32 + 8 * fq; const float* wg = j ? wBg : wAg;
#pragma unroll
        for (int ai = 0; ai < 2; ++ai)
#pragma unroll
            for (int m = 0; m < 4; ++m) { const int r = row0 + ai * HALF + m * 16; const float rs = rsg[r], w = wg[r]; f32x4 h0, h1;
#pragma unroll
                for (int e = 0; e < 4; ++e) { const float g0 = acc[ai][0][m][0][e] * rs, g1 = acc[ai][0][m][1][e] * rs;
                    h0[e] = g0 * __builtin_amdgcn_rcpf(1.f + __expf(-g0)) * (acc[ai][1][m][0][e] * rs) * w; h1[e] = g1 * __builtin_amdgcn_rcpf(1.f + __expf(-g1)) * (acc[ai][1][m][1][e] * rs) * w; }
                *(u32x4*)(HID + (size_t)r * 512 + col0) = pack8(h0, h1); }
    }
};
struct EpiMoeDown {
    static constexpr bool PERM = true, HAS_MID = false; int mid_t;
    const int* tokg; const bf16_t* Xi; bf16_t* Xo; float* ssq;
    __device__ __forceinline__ void mid(f32x4 (&)[2][2][4][2], const Unit&, int, int, int, int) const {}
    __device__ __forceinline__ void operator()(const f32x4 (&acc)[2][2][4][2], const Unit& u, int wr, int wc, int fr, int fq) const {
        const int row0 = u.pm * BM + wr * 64 + fr, ct = u.pn & 3, col0 = ct * BM + wc * 32 + 8 * fq;
#pragma unroll
        for (int ai = 0; ai < 2; ++ai)
#pragma unroll
            for (int m = 0; m < 4; ++m) { const int tok = tokg[row0 + ai * HALF + m * 16];
                if (tok >= 0) { float ss = 0.f;
#pragma unroll
                    for (int bj = 0; bj < 2; ++bj) { const u32x4 xi = *(const u32x4*)(Xi + (size_t)tok * D + col0 + bj * HALF);
                        f32x4 v0, v1; v0[0] = __uint_as_float(xi.x << 16); v0[1] = __uint_as_float(xi.x & 0xffff0000u); v0[2] = __uint_as_float(xi.y << 16); v0[3] = __uint_as_float(xi.y & 0xffff0000u);
                        v1[0] = __uint_as_float(xi.z << 16); v1[1] = __uint_as_float(xi.z & 0xffff0000u); v1[2] = __uint_as_float(xi.w << 16); v1[3] = __uint_as_float(xi.w & 0xffff0000u);
                        v0 = v0 + acc[ai][bj][m][0]; v1 = v1 + acc[ai][bj][m][1];
                        ss += sq8(v0, v1); *(u32x4*)(Xo + (size_t)tok * D + col0 + bj * HALF) = pack8(v0, v1); }
                    ss += __shfl_xor(ss, 16); ss += __shfl_xor(ss, 32);
                    if (fq == 0) ssq[(size_t)tok * 16 + ct * 4 + wc] = ss; } }
    }
};

struct XaChainOrder {
    const bf16_t* X1b; const bf16_t* Wq_t; const bf16_t* QX; const bf16_t* KM; const bf16_t* VT; int G, c, nu;
    __device__ void init(int G_, int c_) { G = G_; c = c_; const int tot = (NTOK / BM) * XH; nu = (tot - c + G - 1) / G; }
    __device__ bool next(int i, Unit& u) const { if (i >= 3 * nu) return false; const int kind = i / nu, L = (i % nu) * G + c; u.pm = L >> 2; u.pn = (L & 3) | (kind << 8); return true; }
    __device__ __forceinline__ int nt(const Unit& u) const { return (u.pn >> 8) == 0 ? D / BK : XD / BK; }
    __device__ __forceinline__ void ptrs(const Unit& u, const char*& a, const char*& b0, const char*& b1) const {
        const int kind = u.pn >> 8, h = u.pn & 3, b = u.pm / (SEQ / BM);
        if (kind == 0) { a = (const char*)X1b + (size_t)u.pm * BM * D * 2; b0 = (const char*)Wq_t + (size_t)h * XD * D * 2; }
        else { a = (const char*)QX + ((size_t)u.pm * BM * D + h * XD) * 2;
            b0 = (kind == 1) ? (const char*)KM + ((size_t)b * MEM * D + h * XD) * 2 : (const char*)VT + ((size_t)b * D + h * XD) * D * 2; }
        b1 = b0 + (size_t)HALF * D * 2; }
};
struct EpiXaChain {
    static constexpr bool PERM = true, HAS_MID = false; int mid_t;
    bf16_t* QX; bf16_t* OX; const float* ssq1; float qscale; PG8_LAS float* xch;
    __device__ __forceinline__ void mid(f32x4 (&)[2][2][4][2], const Unit&, int, int, int, int) const {}
    __device__ __forceinline__ void operator()(f32x4 (&acc)[2][2][4][2], const Unit& u, int wr, int wc, int fr, int fq) const {
        const int kind = u.pn >> 8, row0 = u.pm * BM + wr * 64 + fr, col0 = (u.pn & 3) * XD + wc * 32 + 8 * fq;
        if (kind != 1) {
            bf16_t* O = kind == 0 ? QX : OX;
#pragma unroll
            for (int ai = 0; ai < 2; ++ai)
#pragma unroll
                for (int m = 0; m < 4; ++m) { const int r = row0 + ai * HALF + m * 16; const float rs = kind == 0 ? rstd16(ssq1 + (size_t)r * 16) * qscale : 1.f; bf16_t* rowp = O + (size_t)r * D + col0;
#pragma unroll
                    for (int bj = 0; bj < 2; ++bj) *(u32x4*)(rowp + bj * HALF) = pack8(acc[ai][bj][m][0] * rs, acc[ai][bj][m][1] * rs); }
            return;
        }
        PG8_LAS float* xm = xch; PG8_LAS float* xs = xch + 1024;
#pragma unroll
        for (int ai = 0; ai < 2; ++ai)
#pragma unroll
            for (int m = 0; m < 4; ++m) { float mx = -INFINITY;
#pragma unroll
                for (int bj = 0; bj < 2; ++bj)
#pragma unroll
                    for (int n = 0; n < 2; ++n) { const f32x4 v = acc[ai][bj][m][n]; mx = fmaxf(mx, fmaxf(fmaxf(v[0], v[1]), fmaxf(v[2], v[3]))); }
                mx = fmaxf(mx, __shfl_xor(mx, 16)); mx = fmaxf(mx, __shfl_xor(mx, 32));
                if (fq == 0) xm[(ai * HALF + wr * 64 + m * 16 + fr) * 4 + wc] = mx; asm volatile("" ::: "memory"); }
        asm volatile("s_waitcnt lgkmcnt(0)" ::: "memory"); __builtin_amdgcn_s_barrier(); asm volatile("" ::: "memory");
#pragma unroll
        for (int ai = 0; ai < 2; ++ai)
#pragma unroll
            for (int m = 0; m < 4; ++m) { const int rl = ai * HALF + wr * 64 + m * 16 + fr; const f32x4 q = *(const PG8_LAS f32x4*)(xm + rl * 4);
                const float mx = fmaxf(fmaxf(q[0], q[1]), fmaxf(q[2], q[3])); float ss = 0.f;
#pragma unroll
                for (int bj = 0; bj < 2; ++bj)
#pragma unroll
                    for (int n = 0; n < 2; ++n) { f32x4 v = acc[ai][bj][m][n];
#pragma unroll
                        for (int e = 0; e < 4; ++e) { v[e] = __builtin_amdgcn_exp2f(v[e] - mx); ss += v[e]; }
                        acc[ai][bj][m][n] = v; }
                ss += __shfl_xor(ss, 16); ss += __shfl_xor(ss, 32);
                if (fq == 0) xs[rl * 4 + wc] = ss; asm volatile("" ::: "memory"); }
        asm volatile("s_waitcnt lgkmcnt(0)" ::: "memory"); __builtin_amdgcn_s_barrier(); asm volatile("" ::: "memory");
#pragma unroll
        for (int ai = 0; ai < 2; ++ai)
#pragma unroll
            for (int m = 0; m < 4; ++m) { const int rl = ai * HALF + wr * 64 + m * 16 + fr; const f32x4 q = *(const PG8_LAS f32x4*)(xs + rl * 4);
                const float inv = __builtin_amdgcn_rcpf((q[0] + q[1]) + (q[2] + q[3])); bf16_t* rowp = QX + (size_t)(row0 + ai * HALF + m * 16) * D + col0;
#pragma unroll
                for (int bj = 0; bj < 2; ++bj) *(u32x4*)(rowp + bj * HALF) = pack8(acc[ai][bj][m][0] * inv, acc[ai][bj][m][1] * inv); asm volatile("" ::: "memory"); }
    }
};

struct XaPreOrder {
    const bf16_t* KM; const bf16_t* VM; const bf16_t* WqN; const bf16_t* Wo_t; int G, c;
    __device__ bool next(int i, Unit& u) const { const int L = i * G + c; if (L >= 256) return false; u.pm = 0; u.pn = L; return true; }
    __device__ __forceinline__ int nt(const Unit&) const { return XD / BK; }
    __device__ __forceinline__ void ptrs(const Unit& u, const char*& a, const char*& b0, const char*& b1) const {
        const int L = u.pn, h = L & 3;
        if (L < 128) { const int b = L >> 4, kt = (L >> 2) & 3; a = (const char*)KM + ((size_t)b * MEM * D + h * XD) * 2; b0 = (const char*)WqN + ((size_t)kt * BM * D + h * XD) * 2; }
        else { const int nt_ = (L >> 5) & 3, b = (L >> 2) & 7; a = (const char*)Wo_t + ((size_t)nt_ * BM * D + h * XD) * 2; b0 = (const char*)VM + ((size_t)b * MEM * D + h * XD) * 2; }
        b1 = b0 + (size_t)HALF * D * 2; }
};
struct EpiXaPre {
    static constexpr bool PERM = true, HAS_MID = false; int mid_t;
    bf16_t* MT; bf16_t* NT;
    __device__ __forceinline__ void mid(f32x4 (&)[2][2][4][2], const Unit&, int, int, int, int) const {}
    __device__ __forceinline__ void operator()(const f32x4 (&acc)[2][2][4][2], const Unit& u, int wr, int wc, int fr, int fq) const {
        const int L = u.pn, h = L & 3, cw = wc * 32 + 8 * fq; bf16_t* base;
        if (L < 128) { const int b = L >> 4, kt = (L >> 2) & 3; base = MT + ((size_t)b * D + h * XD) * D + kt * BM; }
        else { const int nt_ = (L >> 5) & 3, b = (L >> 2) & 7; base = NT + ((size_t)b * D + nt_ * BM) * D + h * XD; }
#pragma unroll
        for (int ai = 0; ai < 2; ++ai)
#pragma unroll
            for (int m = 0; m < 4; ++m) { bf16_t* rowp = base + (size_t)(ai * HALF + wr * 64 + m * 16 + fr) * D + cw;
#pragma unroll
                for (int bj = 0; bj < 2; ++bj) *(u32x4*)(rowp + bj * HALF) = pack8(acc[ai][bj][m][0], acc[ai][bj][m][1]); }
    }
};
struct BatchedOrder {
    const bf16_t* A; const bf16_t* W; int G, c;
    __device__ bool next(int i, Unit& u) const { const int L = i * G + c; if (L >= (NTOK / BM) * 4) return false; u.pm = L >> 2; u.pn = L & 3; return true; }
    __device__ __forceinline__ int nt(const Unit&) const { return D / BK; }
    __device__ __forceinline__ void ptrs(const Unit& u, const char*& a, const char*& b0, const char*& b1) const {
        const int b = u.pm / (SEQ / BM); a = (const char*)A + (size_t)u.pm * BM * D * 2; b0 = (const char*)W + ((size_t)b * D + u.pn * BM) * D * 2; b1 = b0 + (size_t)HALF * D * 2; }
};
struct EpiXaSoftmax {
    static constexpr bool PERM = true, HAS_MID = false; int mid_t;
    bf16_t* P; const float* ssq1; float qscale; PG8_LAS float* xch;
    __device__ __forceinline__ void mid(f32x4 (&)[2][2][4][2], const Unit&, int, int, int, int) const {}
    __device__ __forceinline__ void operator()(f32x4 (&acc)[2][2][4][2], const Unit& u, int wr, int wc, int fr, int fq) const {
        const int row0 = u.pm * BM + wr * 64 + fr, col0 = u.pn * XD + wc * 32 + 8 * fq;
        PG8_LAS float* xm = xch; PG8_LAS float* xs = xch + 1024;
#pragma unroll
        for (int ai = 0; ai < 2; ++ai)
#pragma unroll
            for (int m = 0; m < 4; ++m) { const float rs = rstd16(ssq1 + (size_t)(row0 + ai * HALF + m * 16) * 16) * qscale; float mx = -INFINITY;
#pragma unroll
                for (int bj = 0; bj < 2; ++bj)
#pragma unroll
                    for (int n = 0; n < 2; ++n) { const f32x4 v = acc[ai][bj][m][n] * rs; acc[ai][bj][m][n] = v; mx = fmaxf(mx, fmaxf(fmaxf(v[0], v[1]), fmaxf(v[2], v[3]))); }
                mx = fmaxf(mx, __shfl_xor(mx, 16)); mx = fmaxf(mx, __shfl_xor(mx, 32));
                if (fq == 0) xm[(ai * HALF + wr * 64 + m * 16 + fr) * 4 + wc] = mx; asm volatile("" ::: "memory"); }
        asm volatile("s_waitcnt lgkmcnt(0)" ::: "memory"); __builtin_amdgcn_s_barrier(); asm volatile("" ::: "memory");
#pragma unroll
        for (int ai = 0; ai < 2; ++ai)
#pragma unroll
            for (int m = 0; m < 4; ++m) { const int rl = ai * HALF + wr * 64 + m * 16 + fr; const f32x4 q = *(const PG8_LAS f32x4*)(xm + rl * 4);
                const float mx = fmaxf(fmaxf(q[0], q[1]), fmaxf(q[2], q[3])); float ss = 0.f;
#pragma unroll
                for (int bj = 0; bj < 2; ++bj)
#pragma unroll
                    for (int n = 0; n < 2; ++n) { f32x4 v = acc[ai][bj][m][n];
#pragma unroll
                        for (int e = 0; e < 4; ++e) { v[e] = __builtin_amdgcn_exp2f(v[e] - mx); ss += v[e]; }
                        acc[ai][bj][m][n] = v; }
                ss += __shfl_xor(ss, 16); ss += __shfl_xor(ss, 32);
                if (fq == 0) xs[rl * 4 + wc] = ss; asm volatile("" ::: "memory"); }
        asm volatile("s_waitcnt lgkmcnt(0)" ::: "memory"); __builtin_amdgcn_s_barrier(); asm volatile("" ::: "memory");
#pragma unroll
        for (int ai = 0; ai < 2; ++ai)
#pragma unroll
            for (int m = 0; m < 4; ++m) { const int rl = ai * HALF + wr * 64 + m * 16 + fr; const f32x4 q = *(const PG8_LAS f32x4*)(xs + rl * 4);
                const float inv = __builtin_amdgcn_rcpf((q[0] + q[1]) + (q[2] + q[3])); bf16_t* rowp = P + (size_t)(row0 + ai * HALF + m * 16) * D + col0;
#pragma unroll
                for (int bj = 0; bj < 2; ++bj) *(u32x4*)(rowp + bj * HALF) = pack8(acc[ai][bj][m][0] * inv, acc[ai][bj][m][1] * inv); asm volatile("" ::: "memory"); }
    }
};

struct EpiKvN {
    static constexpr bool PERM = true, HAS_MID = false; int mid_t;
    bf16_t* KM; bf16_t* VM;
    __device__ __forceinline__ void mid(f32x4 (&)[2][2][4][2], const Unit&, int, int, int, int) const {}
    __device__ __forceinline__ void operator()(const f32x4 (&acc)[2][2][4][2], const Unit& u, int wr, int wc, int fr, int fq) const {
        bf16_t* base = (u.pn < 4 ? KM : VM) + (u.pn & 3) * BM + wc * 32 + 8 * fq; const int row0 = u.pm * BM + wr * 64 + fr;
#pragma unroll
        for (int ai = 0; ai < 2; ++ai)
#pragma unroll
            for (int m = 0; m < 4; ++m) { bf16_t* rowp = base + (size_t)(row0 + ai * HALF + m * 16) * D;
#pragma unroll
                for (int bj = 0; bj < 2; ++bj) *(u32x4*)(rowp + bj * HALF) = pack8(acc[ai][bj][m][0], acc[ai][bj][m][1]); }
    }
};
struct KvOrder {
    __device__ __forceinline__ int nt(const Unit&) const { return D / BK; }
    const bf16_t* memn; const bf16_t* Wk_t; const bf16_t* Wv_t; int G, c;
    __device__ bool next(int i, Unit& u) const { const int L = i * G + c; if (L >= 64) return false; if (L < 32) { u.pm = L >> 2; u.pn = L & 3; } else { u.pm = (L - 32) >> 3; u.pn = ((L - 32) & 7) | 256; } return true; }
    __device__ __forceinline__ void ptrs(const Unit& u, const char*& a, const char*& b0, const char*& b1) const {
        const bool vt = (u.pn & 256) != 0; const int pn = u.pn & 255;
        a = (const char*)(vt ? Wv_t : memn) + (size_t)u.pm * BM * D * 2; b0 = (const char*)(vt ? memn : Wk_t) + (size_t)pn * BM * D * 2; b1 = b0 + (size_t)HALF * D * 2; }
};
struct EpiKv {
    static constexpr bool PERM = true, HAS_MID = false; int mid_t;
    bf16_t* KM; bf16_t* VT;
    __device__ __forceinline__ void mid(f32x4 (&)[2][2][4][2], const Unit&, int, int, int, int) const {}
    __device__ __forceinline__ void operator()(const f32x4 (&acc)[2][2][4][2], const Unit& u, int wr, int wc, int fr, int fq) const {
        const bool vt = (u.pn & 256) != 0; const int pn = u.pn & 255, row0 = u.pm * BM + wr * 64 + fr, cw = wc * 32 + 8 * fq;
        bf16_t* base = vt ? VT + (size_t)pn * D * D : KM + pn * BM; const int ldo = D;
#pragma unroll
        for (int ai = 0; ai < 2; ++ai)
#pragma unroll
            for (int m = 0; m < 4; ++m) { bf16_t* rowp = base + (size_t)(row0 + ai * HALF + m * 16) * ldo + cw;
#pragma unroll
                for (int bj = 0; bj < 2; ++bj) *(u32x4*)(rowp + bj * HALF) = pack8(acc[ai][bj][m][0], acc[ai][bj][m][1]); }
    }
};

struct EpiMoeFinal {
    static constexpr bool PERM = true, HAS_MID = false; int mid_t;
    const int* tokg; const bf16_t* Xi; float* out; float* ssq; unsigned* cnt; const float* g; PG8_LAS unsigned* flag; unsigned* tmo;
    __device__ __forceinline__ void mid(f32x4 (&)[2][2][4][2], const Unit&, int, int, int, int) const {}
    __device__ __forceinline__ void operator()(f32x4 (&acc)[2][2][4][2], const Unit& u, int wr, int wc, int fr, int fq) const {
        const int row0 = u.pm * BM + wr * 64 + fr, ct = u.pn & 3, col0 = ct * BM + wc * 32 + 8 * fq;
#pragma unroll
        for (int ai = 0; ai < 2; ++ai)
#pragma unroll
            for (int m = 0; m < 4; ++m) { const int tok = tokg[row0 + ai * HALF + m * 16];
                if (tok >= 0) { float ss = 0.f;
#pragma unroll
                    for (int bj = 0; bj < 2; ++bj) { const u32x4 xi = *(const u32x4*)(Xi + (size_t)tok * D + col0 + bj * HALF);
                        f32x4 v0, v1; v0[0] = __uint_as_float(xi.x << 16); v0[1] = __uint_as_float(xi.x & 0xffff0000u); v0[2] = __uint_as_float(xi.y << 16); v0[3] = __uint_as_float(xi.y & 0xffff0000u);
                        v1[0] = __uint_as_float(xi.z << 16); v1[1] = __uint_as_float(xi.z & 0xffff0000u); v1[2] = __uint_as_float(xi.w << 16); v1[3] = __uint_as_float(xi.w & 0xffff0000u);
                        v0 = v0 + acc[ai][bj][m][0]; v1 = v1 + acc[ai][bj][m][1]; acc[ai][bj][m][0] = v0; acc[ai][bj][m][1] = v1; ss += sq8(v0, v1); }
                    ss += __shfl_xor(ss, 16); ss += __shfl_xor(ss, 32);
                    if (fq == 0) __hip_atomic_store(ssq + (size_t)tok * 16 + ct * 4 + wc, ss, __ATOMIC_RELAXED, __HIP_MEMORY_SCOPE_AGENT); }
                asm volatile("" ::: "memory"); }
        asm volatile("s_waitcnt vmcnt(0) lgkmcnt(0)" ::: "memory"); __builtin_amdgcn_s_barrier(); asm volatile("" ::: "memory");
        const int tid = threadIdx.x;
        if (tid < 64) {
            if (tid == 0) __hip_atomic_fetch_add(cnt + 16 * u.pm, 1u, __ATOMIC_RELAXED, __HIP_MEMORY_SCOPE_AGENT);
            unsigned spins = 0; bool dead = false;
            while ((unsigned)__builtin_amdgcn_readfirstlane(__hip_atomic_load(cnt + 16 * u.pm, __ATOMIC_RELAXED, __HIP_MEMORY_SCOPE_AGENT)) < 4u) {
                __builtin_amdgcn_s_sleep(2); if (++spins > (1u << 20)) { dead = true; break; } }
            __builtin_amdgcn_fence(__ATOMIC_ACQUIRE, "agent");
            if (tid == 0) { flag[0] = dead ? 1u : 0u; if (dead) __hip_atomic_store(tmo, 1u, __ATOMIC_RELAXED, __HIP_MEMORY_SCOPE_AGENT); }
        }
        asm volatile("s_waitcnt vmcnt(0) lgkmcnt(0)" ::: "memory"); __builtin_amdgcn_s_barrier(); asm volatile("" ::: "memory");
        f32x4 gv[2][2];
#pragma unroll
        for (int bj = 0; bj < 2; ++bj) { gv[bj][0] = *(const f32x4*)(g + col0 + bj * HALF); gv[bj][1] = *(const f32x4*)(g + col0 + bj * HALF + 4); }
#pragma unroll
        for (int ai = 0; ai < 2; ++ai)
#pragma unroll
            for (int m = 0; m < 4; ++m) { const int tok = tokg[row0 + ai * HALF + m * 16];
                if (tok >= 0) { const float rs = rstd16(ssq + (size_t)tok * 16); float* orow = out + (size_t)tok * D + col0;
#pragma unroll
                    for (int bj = 0; bj < 2; ++bj) { *(f32x4*)(orow + bj * HALF) = acc[ai][bj][m][0] * rs * gv[bj][0]; *(f32x4*)(orow + bj * HALF + 4) = acc[ai][bj][m][1] * rs * gv[bj][1]; } }
                asm volatile("" ::: "memory"); }
    }
};
}
namespace sba {
typedef float f32x16 __attribute__((ext_vector_type(16)));
typedef short s16x4 __attribute__((ext_vector_type(4)));
typedef short v4i16_t __attribute__((ext_vector_type(4)));
typedef __attribute__((address_space(3))) const char* lds_cptr;
constexpr int SLOTB = 8192, L_K = 0, L_V = 2 * SLOTB, L_FLAG = 4 * SLOTB, L_OST = L_FLAG + 256, L_BYTES = L_OST + 8 * 4096;
__device__ __forceinline__ int crow(int r, int hi) { return (r & 3) + 8 * (r >> 2) + 4 * hi; }
__device__ __forceinline__ void glds16(const void* gsrc, unsigned lds_dst) { unsigned keep;
    asm volatile("s_mov_b32 %0, m0\n\ts_mov_b32 m0, %2\n\ts_nop 0\n\tglobal_load_lds_dwordx4 %1, off\n\ts_mov_b32 m0, %0" : "=&s"(keep) : "v"(gsrc), "s"(lds_dst) : "memory"); }
typedef float f32x2_t __attribute__((ext_vector_type(2))); typedef __bf16 bf16x2_t __attribute__((ext_vector_type(2)));
__device__ __forceinline__ unsigned cvtpk(float lo, float hi) { f32x2_t v = {lo, hi}; bf16x2_t b = __builtin_convertvector(v, bf16x2_t); return __builtin_bit_cast(unsigned, b); }
__device__ __forceinline__ s16x4 vtr(lds_cptr p) { return __builtin_bit_cast(s16x4, __builtin_amdgcn_ds_read_tr16_b64_v4i16((__attribute__((address_space(3))) v4i16_t*)p)); }

#define SBA_GROUP(Z, OM, g) do { \
        float d_ = acc_ * (hi ? 1.f : gp_##OM[g]); acc_ *= gs_##OM[g] * gp_##OM[g]; \
        Z[4 * (g) + 3] *= d_; d_ *= OM[4 * (g) + 3]; Z[4 * (g) + 2] *= d_; d_ *= OM[4 * (g) + 2]; Z[4 * (g) + 1] *= d_; d_ *= OM[4 * (g) + 1]; Z[4 * (g)] *= d_; } while (0)

__device__ __forceinline__ void sb_unit(int b, int h, int qb, const bf16_t* Qs, const bf16_t* Ks, const bf16_t* Vs, bf16_t* YY, float* ssq_s8, char* shm) {
    int tid_ = threadIdx.x; asm volatile("" : "+v"(tid_));
    const int tid = tid_, lane = tid & 63, r32 = lane & 31, hi = lane >> 5; const int wid = __builtin_amdgcn_readfirstlane(tid >> 6);
#define SSTAMP(k) do { if (PROBE_A >= 300 && blockIdx.x == 60 && b == 0 && tid == 0) ((__attribute__((address_space(3))) unsigned long long*)(shm + 147200))[16 + (k)] = __builtin_amdgcn_s_memrealtime(); } while (0)
    SSTAMP(0);
    const size_t rowbase = (size_t)b * SEQ; const int q0 = qb * 256;
    const bf16_t* Kh = Ks + rowbase * SBW + h * HD; const bf16_t* Vh = Vs + rowbase * SBW + h * HD;
    const unsigned lds0 = (unsigned)(uintptr_t)shm;
    const lds_cptr shm3 = (lds_cptr)shm;
    const bf16_t* ksrc = Kh + (size_t)lane * SBW + wid * 8;
    const bf16_t* vsrc = Vh + (size_t)(16 * (wid & 3) + (lane >> 2)) * SBW + (wid >> 2) * 32 + (lane & 3) * 8;
    const unsigned kdst = lds0 + L_K + wid * 1024, vdst = lds0 + L_V + wid * 1024;
#define DMA_KV(t, slot) do { glds16(ksrc + (size_t)(t) * 64 * SBW, (unsigned)__builtin_amdgcn_readfirstlane(kdst + (slot))); glds16(vsrc + (size_t)(t) * 64 * SBW, (unsigned)__builtin_amdgcn_readfirstlane(vdst + (slot))); } while (0)
    const lds_cptr kp0 = shm3 + L_K + hi * 1024 + r32 * 16;
    const lds_cptr vp0 = shm3 + L_V + ((lane >> 4) & 1) * 32 + (lane & 3) * 8 + (4 * hi + ((lane & 15) >> 2)) * 64;
    volatile __attribute__((address_space(3))) unsigned* flags = (volatile __attribute__((address_space(3))) unsigned*)(shm3 + L_FLAG);
    int tile = 4 * qb + 3, slot = 0, it = 0;
    DMA_KV(tile, 0);
    const bf16_t* Qw = Qs + (rowbase + q0 + wid * 32 + r32) * SBW + h * HD;
    bf16x8 qr[4];
#pragma unroll
    for (int d0 = 0; d0 < 4; ++d0) qr[d0] = *(const bf16x8*)(Qw + d0 * 16 + hi * 8);
    float qn = 0.f;
#pragma unroll
    for (int d0 = 0; d0 < 4; ++d0)
#pragma unroll
        for (int e = 0; e < 8; ++e) qn += fabsf(bf2f((unsigned short)qr[d0][e]));
    qn += __shfl_xor(qn, 32);
    const int tq = q0 + wid * 32 + r32;
    const int tq_min = q0 + wid * 32, tq_max = tq_min + 31;
    float PR = 1.f;
    f32x16 o0 = {}, o1 = {};
    for (;;) {
        if (it < 4) SSTAMP(1 + it);
        const bool has_next = tile > 0;
        if (has_next) { DMA_KV(tile - 1, slot ^ SLOTB); asm volatile("s_waitcnt vmcnt(2)" ::: "memory"); }
        else asm volatile("s_waitcnt vmcnt(0)" ::: "memory");
        __builtin_amdgcn_s_barrier(); asm volatile("" ::: "memory");
        const int kmin = tile * 64;
        if (kmin < tq_max) {
            f32x16 z0, z1;
            {
                const lds_cptr kb = kp0 + slot; bf16x8 kf[8];
#pragma unroll
                for (int d0 = 0; d0 < 4; ++d0) { kf[2 * d0] = *(const __attribute__((address_space(3))) bf16x8*)(kb + d0 * 2048); kf[2 * d0 + 1] = *(const __attribute__((address_space(3))) bf16x8*)(kb + d0 * 2048 + 512); }
                __builtin_amdgcn_sched_barrier(0);
                z0 = __builtin_amdgcn_mfma_f32_32x32x16_bf16(kf[0], qr[0], (f32x16){}, 0, 0, 0); z1 = __builtin_amdgcn_mfma_f32_32x32x16_bf16(kf[1], qr[0], (f32x16){}, 0, 0, 0);
#pragma unroll
                for (int d0 = 1; d0 < 4; ++d0) { z0 = __builtin_amdgcn_mfma_f32_32x32x16_bf16(kf[2 * d0], qr[d0], z0, 0, 0, 0); z1 = __builtin_amdgcn_mfma_f32_32x32x16_bf16(kf[2 * d0 + 1], qr[d0], z1, 0, 0, 0); }
            }
            if (kmin + 63 >= tq_min) {
#pragma unroll
                for (int r = 0; r < 16; ++r) { const int kv = kmin + crow(r, hi); if (kv >= tq) z0[r] = -INFINITY; if (kv + 32 >= tq) z1[r] = -INFINITY; }
            }
            f32x16 m0, m1;
#pragma unroll
            for (int r = 0; r < 16; ++r) { const float e0 = __builtin_amdgcn_exp2f(fminf(z0[r], 120.f)), e1 = __builtin_amdgcn_exp2f(fminf(z1[r], 120.f));
                m0[r] = __builtin_amdgcn_rcpf(1.f + e0); m1[r] = __builtin_amdgcn_rcpf(1.f + e1); z0[r] = e0 * m0[r]; z1[r] = e1 * m1[r]; }
            float gs_m0[4], gs_m1[4], gp_m0[4], gp_m1[4];
#pragma unroll
            for (int g = 0; g < 4; ++g) { gs_m0[g] = (m0[4 * g] * m0[4 * g + 1]) * (m0[4 * g + 2] * m0[4 * g + 3]); gs_m1[g] = (m1[4 * g] * m1[4 * g + 1]) * (m1[4 * g + 2] * m1[4 * g + 3]); }
#pragma unroll
            for (int g = 0; g < 4; ++g) { const auto r0 = __builtin_amdgcn_permlane32_swap(__float_as_uint(gs_m0[g]), __float_as_uint(gs_m0[g]), false, false), r1 = __builtin_amdgcn_permlane32_swap(__float_as_uint(gs_m1[g]), __float_as_uint(gs_m1[g]), false, false);
                gp_m0[g] = __uint_as_float(hi ? r0[0] : r0[1]); gp_m1[g] = __uint_as_float(hi ? r1[0] : r1[1]); }
            float acc_ = PR;
            SBA_GROUP(z1, m1, 3); SBA_GROUP(z1, m1, 2); SBA_GROUP(z1, m1, 1); SBA_GROUP(z1, m1, 0);
            SBA_GROUP(z0, m0, 3); SBA_GROUP(z0, m0, 2); SBA_GROUP(z0, m0, 1); SBA_GROUP(z0, m0, 0);
            PR = acc_;
            u32x4 pw0, pw1, pw2, pw3;
            pw0 = (u32x4){cvtpk(z0[0], z0[1]), cvtpk(z0[2], z0[3]), cvtpk(z0[4], z0[5]), cvtpk(z0[6], z0[7])};
            pw1 = (u32x4){cvtpk(z0[8], z0[9]), cvtpk(z0[10], z0[11]), cvtpk(z0[12], z0[13]), cvtpk(z0[14], z0[15])};
            pw2 = (u32x4){cvtpk(z1[0], z1[1]), cvtpk(z1[2], z1[3]), cvtpk(z1[4], z1[5]), cvtpk(z1[6], z1[7])};
            pw3 = (u32x4){cvtpk(z1[8], z1[9]), cvtpk(z1[10], z1[11]), cvtpk(z1[12], z1[13]), cvtpk(z1[14], z1[15])};
            const lds_cptr vp = vp0 + slot;
#define SBA_VF(i) (bf16x8){vl[i][0], vl[i][1], vl[i][2], vl[i][3], vh[i][0], vh[i][1], vh[i][2], vh[i][3]}
            { s16x4 vl[4], vh[4];
#pragma unroll
                for (int i = 0; i < 4; ++i) { vl[i] = vtr(vp + i * 1024); vh[i] = vtr(vp + i * 1024 + 512); }
                __builtin_amdgcn_sched_barrier(0);
                o0 = __builtin_amdgcn_mfma_f32_32x32x16_bf16(__builtin_bit_cast(bf16x8, pw0), SBA_VF(0), o0, 0, 0, 0); o0 = __builtin_amdgcn_mfma_f32_32x32x16_bf16(__builtin_bit_cast(bf16x8, pw1), SBA_VF(1), o0, 0, 0, 0);
                o0 = __builtin_amdgcn_mfma_f32_32x32x16_bf16(__builtin_bit_cast(bf16x8, pw2), SBA_VF(2), o0, 0, 0, 0); o0 = __builtin_amdgcn_mfma_f32_32x32x16_bf16(__builtin_bit_cast(bf16x8, pw3), SBA_VF(3), o0, 0, 0, 0); }
            { s16x4 vl[4], vh[4];
#pragma unroll
                for (int i = 0; i < 4; ++i) { vl[i] = vtr(vp + 4096 + i * 1024); vh[i] = vtr(vp + 4096 + i * 1024 + 512); }
                __builtin_amdgcn_sched_barrier(0);
                o1 = __builtin_amdgcn_mfma_f32_32x32x16_bf16(__builtin_bit_cast(bf16x8, pw0), SBA_VF(0), o1, 0, 0, 0); o1 = __builtin_amdgcn_mfma_f32_32x32x16_bf16(__builtin_bit_cast(bf16x8, pw1), SBA_VF(1), o1, 0, 0, 0);
                o1 = __builtin_amdgcn_mfma_f32_32x32x16_bf16(__builtin_bit_cast(bf16x8, pw2), SBA_VF(2), o1, 0, 0, 0); o1 = __builtin_amdgcn_mfma_f32_32x32x16_bf16(__builtin_bit_cast(bf16x8, pw3), SBA_VF(3), o1, 0, 0, 0); }
#undef SBA_VF
        }
        const bool done = __all(PR == 0.f);
        if (lane == 0) flags[(it & 1) * 8 + wid] = done ? 1u : 0u;
        asm volatile("s_waitcnt lgkmcnt(0)" ::: "memory"); __builtin_amdgcn_s_barrier(); asm volatile("" ::: "memory");
        unsigned alld = 1u;
#pragma unroll
        for (int w = 0; w < 8; ++w) alld &= flags[(it & 1) * 8 + w];
        alld = __builtin_amdgcn_readfirstlane(alld);
        if (!has_next || alld) break;
        --tile; slot ^= SLOTB; ++it;
    }
    SSTAMP(5);
    if (PROBE_A >= 300 && blockIdx.x == 60 && b == 0 && tid == 0) { __attribute__((address_space(3))) unsigned long long* st_ = (__attribute__((address_space(3))) unsigned long long*)(shm + 147200) + 16; st_[8] = 0; st_[9] = (unsigned long long)(it + 1) * 100ull; }
    asm volatile("s_waitcnt vmcnt(0)" ::: "memory");
    {
        bf16_t* Ow = YY + (rowbase + q0 + wid * 32) * D + RW + h * HD;
        bf16_t* stg = (bf16_t*)(shm + L_OST) + wid * 2048;
#pragma unroll
        for (int r = 0; r < 16; ++r) { const int orow = crow(r, hi); stg[orow * 64 + r32] = (bf16_t)f2bf(o0[r]); stg[orow * 64 + 32 + r32] = (bf16_t)f2bf(o1[r]); }
        asm volatile("s_waitcnt lgkmcnt(0)" ::: "memory");
#pragma unroll
        for (int i = 0; i < 4; ++i) { const int row = i * 8 + (lane >> 3), ch = lane & 7; const u32x4 v = *(const u32x4*)(stg + row * 64 + ch * 8);
            *(u32x4*)(Ow + (size_t)row * D + ch * 8) = v;
            float ss = 0.f;
#pragma unroll
            for (int e = 0; e < 4; ++e) { const float lo = __uint_as_float(v[e] << 16), hh = __uint_as_float(v[e] & 0xffff0000u); ss += lo * lo + hh * hh; }
            ss += __shfl_xor(ss, 1); ss += __shfl_xor(ss, 2); ss += __shfl_xor(ss, 4);
            if (ch == 0) ssq_s8[(rowbase + q0 + wid * 32 + row) * 8 + h] = ss; }
    }
    asm volatile("s_waitcnt lgkmcnt(0)" ::: "memory"); __builtin_amdgcn_s_barrier(); asm volatile("" ::: "memory");
    SSTAMP(6);
#undef SSTAMP
#undef DMA_KV
}
#undef SBA_GROUP
}
namespace lru {
typedef float f32x16 __attribute__((ext_vector_type(16)));
constexpr int XS_ROWS = 67, XS_BYTES = XS_ROWS * 1024  , XC_PITCH = 1040  , XC_OFF = 68608, HC_OFF = XC_OFF + 64 * XC_PITCH  , L_BYTES = HC_OFF + 2048;
__device__ __forceinline__ int crow(int r, int hi) { return (r & 3) + 8 * (r >> 2) + 4 * hi; }

struct Weights { bf16x8 wa[2][4], wx[2][4]; float ba[2], bx[2], spl[2]; };
__device__ __forceinline__ void load_weights(Weights& W, int h, int r32, int hi, const float* w_a, const float* b_a, const float* w_x, const float* b_x, const float* lam) {
#pragma unroll
    for (int nt = 0; nt < 2; ++nt) {
#pragma unroll
        for (int s = 0; s < 4; ++s) {
#pragma unroll
            for (int e = 0; e < 8; ++e) { const size_t idx = ((size_t)(h * 64 + 16 * s + 8 * hi + e)) * 64 + 32 * nt + r32;
                W.wa[nt][s][e] = (short)f2bf(w_a[idx]); W.wx[nt][s][e] = (short)f2bf(w_x[idx]); }
        }
        const int c = h * 64 + 32 * nt + r32; W.ba[nt] = b_a[c]; W.bx[nt] = b_x[c];
        const float l = lam[c]; W.spl[nt] = (l > 15.f) ? __expf(-l) : log1pf(__expf(-l));
    }
}

template <bool PASSB>
__device__ __forceinline__ void unit(int b, int chunk, const Weights& W, const bf16_t* XR, const bf16_t* GG, const float* conv_w, const float* conv_b,
                                     float* aggP, float* aggH, const float* ssq_s8, bf16_t* YY, float* fmid, float* fend, unsigned char* shm) {
    int tid_ = threadIdx.x; asm volatile("" : "+v"(tid_));
    const int tid = tid_, lane = tid & 63, r32 = lane & 31, hi = lane >> 5, wid = __builtin_amdgcn_readfirstlane(tid >> 6);
    LAS unsigned char* L = (LAS unsigned char*)shm;
#define LSTAMP(k) do { if (PROBE_A >= 200 && PASSB && blockIdx.x == 63 && b == 0 && tid == 0) ((LAS unsigned long long*)(shm + 147200))[16 + (k)] = __builtin_amdgcn_s_memrealtime(); } while (0)
    LSTAMP(0);
    const int t0 = chunk * 64; const size_t rowbase = (size_t)b * SEQ;
    f32x4 cp_[PASSB ? 8 : 1], cq_[PASSB ? 8 : 1];
    if (PASSB) {
        const f32x4* pP = (const f32x4*)(aggP + ((size_t)b * RW + tid) * 64); const f32x4* pH = (const f32x4*)(aggH + ((size_t)b * RW + tid) * 64);
#pragma unroll
        for (int i = 0; i < 8; ++i) { cp_[i] = pP[i]; cq_[i] = pH[i]; }
    }
    {
        u32x4 v[9];
#pragma unroll
        for (int k = 0; k < 9; ++k) { const int p = tid + k * NTHREADS, rr = p >> 6, pc = p & 63, t = t0 - 3 + rr;
            v[k] = (u32x4){0u, 0u, 0u, 0u}; if (p < XS_ROWS * 64 && t >= 0) v[k] = *(const u32x4*)(XR + (rowbase + t) * RW + pc * 8); }
#pragma unroll
        for (int k = 0; k < 9; ++k) { const int p = tid + k * NTHREADS; if (p < XS_ROWS * 64) *(LAS u32x4*)(L + (p >> 6) * 1024 + (p & 63) * 16) = v[k]; }
    }
    if (PASSB) {
        float hc = 0.f;
#pragma unroll
        for (int i = 0; i < 8; ++i)
#pragma unroll
            for (int e = 0; e < 4; ++e) { if (i * 4 + e < chunk) hc = cp_[i][e] * hc + cq_[i][e]; }
        if (chunk > 32) { const f32x4* pP = (const f32x4*)(aggP + ((size_t)b * RW + tid) * 64) + 8; const f32x4* pH = (const f32x4*)(aggH + ((size_t)b * RW + tid) * 64) + 8;
#pragma unroll
            for (int i = 0; i < 8; ++i) { cp_[i] = pP[i]; cq_[i] = pH[i]; }
#pragma unroll
            for (int i = 0; i < 8; ++i)
#pragma unroll
                for (int e = 0; e < 4; ++e) { if (32 + i * 4 + e < chunk) hc = cp_[i][e] * hc + cq_[i][e]; } }
        *(LAS float*)(L + HC_OFF + tid * 4) = hc;
    }
    __syncthreads();
    LSTAMP(1);
    {
        const int cp = tid & 255, th = tid >> 8, c0 = 2 * cp;
        const float w00 = conv_w[c0], w01 = conv_w[RW + c0], w02 = conv_w[2 * RW + c0], w03 = conv_w[3 * RW + c0], b0 = conv_b[c0];
        const float w10 = conv_w[c0 + 1], w11 = conv_w[RW + c0 + 1], w12 = conv_w[2 * RW + c0 + 1], w13 = conv_w[3 * RW + c0 + 1], b1 = conv_b[c0 + 1];
        const LAS unsigned* xs = (const LAS unsigned*)(L + (th * 32) * 1024 + cp * 4);
        unsigned u0 = xs[0], u1 = xs[256], u2 = xs[512];
        float a0 = __uint_as_float(u0 << 16), a1 = __uint_as_float(u1 << 16), a2 = __uint_as_float(u2 << 16);
        float c0_ = __uint_as_float(u0 & 0xffff0000u), c1_ = __uint_as_float(u1 & 0xffff0000u), c2_ = __uint_as_float(u2 & 0xffff0000u);
#pragma unroll 8
        for (int t = 0; t < 32; ++t) { const unsigned u3 = xs[(t + 3) * 256]; const float a3 = __uint_as_float(u3 << 16), c3_ = __uint_as_float(u3 & 0xffff0000u);
            const float y0 = w00 * a0 + w01 * a1 + w02 * a2 + w03 * a3 + b0, y1 = w10 * c0_ + w11 * c1_ + w12 * c2_ + w13 * c3_ + b1;
            *(LAS unsigned*)(L + XC_OFF + (th * 32 + t) * XC_PITCH + cp * 4) = f2bf(y0) | (f2bf(y1) << 16);
            a0 = a1; a1 = a2; a2 = a3; c0_ = c1_; c1_ = c2_; c2_ = c3_; }
    }
    __syncthreads();
    LSTAMP(2);
    const int h = wid;
    float Hc[2] = {0.f, 0.f}, Pc[2] = {1.f, 1.f};
    if (PASSB) {
#pragma unroll
        for (int nt = 0; nt < 2; ++nt) Hc[nt] = *(const LAS float*)(L + HC_OFF + (h * 64 + 32 * nt + r32) * 4);
    }
#pragma unroll
    for (int mt = 0; mt < 2; ++mt) {
        bf16x8 af[4];
#pragma unroll
        for (int s = 0; s < 4; ++s) af[s] = *(const LAS bf16x8*)(L + XC_OFF + (32 * mt + r32) * XC_PITCH + (h * 64 + 16 * s + 8 * hi) * 2);
#pragma unroll
        for (int nt = 0; nt < 2; ++nt) {
            f32x16 ra = {}, ri = {};
#pragma unroll
            for (int s = 0; s < 4; ++s) { ra = __builtin_amdgcn_mfma_f32_32x32x16_bf16(af[s], W.wa[nt][s], ra, 0, 0, 0); ri = __builtin_amdgcn_mfma_f32_32x32x16_bf16(af[s], W.wx[nt][s], ri, 0, 0, 0); }
            const int c = h * 64 + 32 * nt + r32;
#pragma unroll
            for (int r = 0; r < 16; ++r) { const int tok = 32 * mt + crow(r, hi);
                const float xc = bf2f(*(const LAS unsigned short*)(L + XC_OFF + tok * XC_PITCH + c * 2));
                const float rg = __builtin_amdgcn_rcpf(1.f + __expf(-(ra[r] + W.ba[nt]))), ig = __builtin_amdgcn_rcpf(1.f + __expf(-(ri[r] + W.bx[nt])));
                const float la = -8.0f * rg * W.spl[nt], a = __expf(la);
                ra[r] = a; ri[r] = __builtin_amdgcn_sqrtf(fmaxf(0.f, 1.f - a * a)) * (ig * xc); }
            float P[4], H[4], Pp[4], Hp[4];
#pragma unroll
            for (int g = 0; g < 4; ++g) { P[g] = (ra[4 * g] * ra[4 * g + 1]) * (ra[4 * g + 2] * ra[4 * g + 3]);
                H[g] = ((ri[4 * g] * ra[4 * g + 1] + ri[4 * g + 1]) * ra[4 * g + 2] + ri[4 * g + 2]) * ra[4 * g + 3] + ri[4 * g + 3]; }
#pragma unroll
            for (int g = 0; g < 4; ++g) { Pp[g] = __shfl_xor(P[g], 32); Hp[g] = __shfl_xor(H[g], 32); }
            float hc = Hc[nt], pc = Pc[nt];
#pragma unroll
            for (int g = 0; g < 4; ++g) { const float P0 = hi ? Pp[g] : P[g], H0 = hi ? Hp[g] : H[g], P1 = hi ? P[g] : Pp[g], H1 = hi ? H[g] : Hp[g];
                const float mid = P0 * hc + H0;
                if (PASSB) { float hh = hi ? mid : hc;
#pragma unroll
                    for (int k = 0; k < 4; ++k) { hh = ra[4 * g + k] * hh + ri[4 * g + k]; const int tok = 32 * mt + 8 * g + 4 * hi + k;
                        *(LAS unsigned short*)(L + tok * 1024 + c * 2) = (unsigned short)f2bf(hh); } }
                hc = P1 * mid + H1; pc = pc * (P0 * P1); }
            Hc[nt] = hc; Pc[nt] = pc;
        }
    }
    if (!PASSB) {
        if (hi == 0) {
#pragma unroll
            for (int nt = 0; nt < 2; ++nt) { const int c = h * 64 + 32 * nt + r32; aggP[((size_t)b * RW + c) * 64 + chunk] = Pc[nt]; aggH[((size_t)b * RW + c) * 64 + chunk] = Hc[nt]; }
        }
        __syncthreads();
    } else {
        LSTAMP(3);
        __syncthreads();
        LSTAMP(4);
        u32x4 gv[8]; float sv[8];
#pragma unroll
        for (int i = 0; i < 8; ++i) { const size_t row = rowbase + t0 + i * 8 + wid; gv[i] = *(const u32x4*)(GG + row * RW + lane * 8); sv[i] = ssq_s8[row * 8 + (lane & 7)]; }
#pragma unroll
        for (int i = 0; i < 8; ++i) { const int rr = i * 8 + wid; const size_t row = rowbase + t0 + rr;
            const u32x4 hv = *(const LAS u32x4*)(L + rr * 1024 + lane * 16); const u32x4 g4 = gv[i];
            f32x4 y0, y1;
            y0[0] = __uint_as_float(hv.x << 16) * __uint_as_float(g4.x << 16); y0[1] = __uint_as_float(hv.x & 0xffff0000u) * __uint_as_float(g4.x & 0xffff0000u);
            y0[2] = __uint_as_float(hv.y << 16) * __uint_as_float(g4.y << 16); y0[3] = __uint_as_float(hv.y & 0xffff0000u) * __uint_as_float(g4.y & 0xffff0000u);
            y1[0] = __uint_as_float(hv.z << 16) * __uint_as_float(g4.z << 16); y1[1] = __uint_as_float(hv.z & 0xffff0000u) * __uint_as_float(g4.z & 0xffff0000u);
            y1[2] = __uint_as_float(hv.w << 16) * __uint_as_float(g4.w << 16); y1[3] = __uint_as_float(hv.w & 0xffff0000u) * __uint_as_float(g4.w & 0xffff0000u);
            *(u32x4*)(YY + row * D + lane * 8) = pg8::pack8(y0, y1);
            float ss = pg8::sq8(y0, y1), s2 = sv[i];
#pragma unroll
            for (int o = 1; o < 64; o <<= 1) ss += __shfl_xor(ss, o);
            s2 += __shfl_xor(s2, 1); s2 += __shfl_xor(s2, 2); s2 += __shfl_xor(s2, 4);
            if (lane == 0) { const float rrn = 1.0f / sqrtf(ss * (1.f / RW) + EPS), rs = 1.0f / sqrtf(s2 * (1.f / SBW) + EPS); fmid[row] = rrn / rs; fend[row] = rs; } }
        __syncthreads();
        LSTAMP(5);
    }
#undef LSTAMP
}
}
__device__ __forceinline__ void row_prep_x(const float* x, bf16_t* xb, float* rstd0, int row, int lane) {
    const f32x4* xr = (const f32x4*)(x + (size_t)row * D) + lane;
    float s = 0.f; f32x4 v[4];
#pragma unroll
    for (int j = 0; j < 4; ++j) { v[j] = xr[64 * j]; s += v[j].x * v[j].x + v[j].y * v[j].y + v[j].z * v[j].z + v[j].w * v[j].w; }
    s = wave_sum(s);
    if (lane == 0) rstd0[row] = 1.0f / sqrtf(s * (1.f / D) + EPS);
    unsigned long long* o8 = (unsigned long long*)(xb + (size_t)row * D) + lane;
#pragma unroll
    for (int j = 0; j < 4; ++j) o8[64 * j] = (unsigned long long)(f2bf(v[j].x) | (f2bf(v[j].y) << 16)) | ((unsigned long long)(f2bf(v[j].z) | (f2bf(v[j].w) << 16)) << 32);
}
__device__ __forceinline__ void row_prep_mem(const float* m, const float* g, bf16_t* o, int row, int lane) {
    const f32x4* xr = (const f32x4*)(m + (size_t)row * D) + lane;
    float s = 0.f; f32x4 v[4];
#pragma unroll
    for (int j = 0; j < 4; ++j) { v[j] = xr[64 * j]; s += v[j].x * v[j].x + v[j].y * v[j].y + v[j].z * v[j].z + v[j].w * v[j].w; }
    s = wave_sum(s);
    const float r = 1.0f / sqrtf(s * (1.f / D) + EPS);
    unsigned long long* o8 = (unsigned long long*)(o + (size_t)row * D) + lane;
#pragma unroll
    for (int j = 0; j < 4; ++j) { const f32x4 gg = ((const f32x4*)g)[64 * j + lane];
        o8[64 * j] = (unsigned long long)(f2bf(v[j].x * r * gg.x) | (f2bf(v[j].y * r * gg.y) << 16)) | ((unsigned long long)(f2bf(v[j].z * r * gg.z) | (f2bf(v[j].w * r * gg.w) << 16)) << 32); }
}
__device__ __forceinline__ void transpose_item(const float* W, int K, int N, bf16_t* Wt, int ldt, const float* g0, const float* g1, int ksplit, LAS float* scr, int item, int lane) {
    const int nblk = N / 64, kb = item / nblk, nb = item % nblk, k0 = 64 * kb, n0 = 64 * nb, lr = lane >> 4, lc = 4 * (lane & 15);
    f32x4 v[16];
#pragma unroll
    for (int i = 0; i < 16; ++i) v[i] = *(const f32x4*)(W + (size_t)(k0 + 4 * i + lr) * N + n0 + lc);
#pragma unroll
    for (int i = 0; i < 16; ++i) { const int kk = 4 * i + lr, k = k0 + kk; float gv = 1.f; if (g0) gv = (k < ksplit) ? g0[k] : g1[k - ksplit];
        LAS float* d = scr + kk * 65 + lc; d[0] = v[i].x * gv; d[1] = v[i].y * gv; d[2] = v[i].z * gv; d[3] = v[i].w * gv; }
    asm volatile("s_waitcnt lgkmcnt(0)" ::: "memory");
    const int c = lane & 7;
#pragma unroll
    for (int j = 0; j < 8; ++j) { const int n = (lane >> 3) + 8 * j; const LAS float* s = scr + (8 * c) * 65 + n;
        u32x4 o; o.x = f2bf(s[0 * 65]) | (f2bf(s[1 * 65]) << 16); o.y = f2bf(s[2 * 65]) | (f2bf(s[3 * 65]) << 16); o.z = f2bf(s[4 * 65]) | (f2bf(s[5 * 65]) << 16); o.w = f2bf(s[6 * 65]) | (f2bf(s[7 * 65]) << 16);
        *(u32x4*)(Wt + (size_t)(n0 + n) * ldt + k0 + 8 * c) = o; }
    asm volatile("s_waitcnt lgkmcnt(0)" ::: "memory");
}

struct MidScale { const float* f; int k; int pad; };
template <class Epi>
__device__ __forceinline__ void gemm_naive(const Ctx& C, const bf16_t* A, int lda, const bf16_t* Bt, int ldb, int M, int N, int K, MidScale ms, const Epi& E) {
    const int lane = C.lane, fr = lane & 15, fq = lane >> 4, ncol = N / 64, ntile = (M / 16) * ncol;
    for (int t = C.gw; t < ntile; t += C.NGW) {
        const int row0 = (t / ncol) * 16, col0 = (t % ncol) * 64;
        const bf16_t* ap = A + (size_t)(row0 + fr) * lda + fq * 8;
        const bf16_t* bp = Bt + (size_t)(col0 + fr) * ldb + fq * 8;
        f32x4 acc[4];
#pragma unroll
        for (int n = 0; n < 4; ++n) acc[n] = (f32x4){0.f, 0.f, 0.f, 0.f};
        for (int k0 = 0; k0 < K; k0 += 32) {
            if (ms.f && k0 == ms.k) {
#pragma unroll
                for (int j = 0; j < 4; ++j) { const float f = ms.f[row0 + fq * 4 + j];
#pragma unroll
                    for (int n = 0; n < 4; ++n) acc[n][j] *= f; }
            }
            const bf16x8 a = *(const bf16x8*)(ap + k0);
#pragma unroll
            for (int n = 0; n < 4; ++n) { const bf16x8 b = *(const bf16x8*)(bp + (size_t)n * 16 * ldb + k0); acc[n] = __builtin_amdgcn_mfma_f32_16x16x32_bf16(a, b, acc[n], 0, 0, 0); }
        }
#pragma unroll
        for (int n = 0; n < 4; ++n)
#pragma unroll
            for (int j = 0; j < 4; ++j) E(row0 + fq * 4 + j, col0 + n * 16 + fr, acc[n][j]);
    }
}
struct EpiInProj { const float* rstd0; bf16_t *XR, *GG, *Qs, *Ks, *Vs;
    __device__ void operator()(int r, int c, float v) const { v *= rstd0[r]; const int t = c >> 9, cc = c & 511;
        if (t == 0) XR[(size_t)r * RW + cc] = (bf16_t)f2bf(v);
        else if (t == 1) GG[(size_t)r * RW + cc] = (bf16_t)f2bf(gelu_tanh(v));
        else if (t == 2) Qs[(size_t)r * SBW + cc] = (bf16_t)f2bf(v * (0.125f * LOG2E));
        else if (t == 3) Ks[(size_t)r * SBW + cc] = (bf16_t)f2bf(v);
        else Vs[(size_t)r * SBW + cc] = (bf16_t)f2bf(v); } };
struct EpiStoreBf16 { bf16_t* O; const float* rowscale; int ldo; float scale;
    __device__ void operator()(int r, int c, float v) const { O[(size_t)r * ldo + c] = (bf16_t)f2bf(v * (rowscale ? rowscale[r] : 1.f) * scale); } };
struct EpiResF32 { const float* base; const float* rowscale; bf16_t* O;
    __device__ void operator()(int r, int c, float v) const { O[(size_t)r * D + c] = (bf16_t)f2bf(base[(size_t)r * D + c] + v * rowscale[r]); } };
struct EpiResBf16 { const bf16_t* base; bf16_t* O;
    __device__ void operator()(int r, int c, float v) const { O[(size_t)r * D + c] = (bf16_t)f2bf(bf2f(base[(size_t)r * D + c]) + v); } };

__device__ __forceinline__ void lru_naive_unit(int unit, int j, LAS float* xs, const bf16_t* XR, const bf16_t* GG, const float* conv_w, const float* conv_b,
                                               const float* w_a, const float* b_a, const float* w_x, const float* b_x, const float* lam, bf16_t* YY) {
    const int b = unit >> 3, h = unit & 7, c = h * 64 + j;
    float wa[64], wx[64];
#pragma unroll
    for (int i = 0; i < 64; ++i) { wa[i] = w_a[(size_t)(h * 64 + i) * 64 + j]; wx[i] = w_x[(size_t)(h * 64 + i) * 64 + j]; }
    const float ba = b_a[c], bx = b_x[c], cw0 = conv_w[c], cw1 = conv_w[RW + c], cw2 = conv_w[2 * RW + c], cw3 = conv_w[3 * RW + c], cb = conv_b[c];
    const float l = lam[c], spl = (l > 15.f) ? __expf(-l) : log1pf(__expf(-l));
    float x0 = 0.f, x1 = 0.f, x2 = 0.f, hst = 0.f;
    for (int t = 0; t < SEQ; ++t) {
        const size_t row = (size_t)b * SEQ + t;
        const float x3 = bf2f(XR[row * RW + c]);
        const float xc = cw0 * x0 + cw1 * x1 + cw2 * x2 + cw3 * x3 + cb;
        x0 = x1; x1 = x2; x2 = x3;
        asm volatile("s_waitcnt lgkmcnt(0)" ::: "memory"); xs[j] = xc; asm volatile("s_waitcnt lgkmcnt(0)" ::: "memory");
        float ra = ba, ri = bx;
#pragma unroll
        for (int i = 0; i < 64; ++i) { const float xv = xs[i]; ra += xv * wa[i]; ri += xv * wx[i]; }
        const float r = sigmoidf_(ra), ig = sigmoidf_(ri);
        const float log_a = -8.0f * r * spl, a = __expf(log_a), bb = sqrtf(fmaxf(0.f, -expm1f(2.f * log_a))) * (ig * xc);
        hst = a * hst + bb;
        YY[row * D + c] = (bf16_t)f2bf(hst * bf2f(GG[row * RW + c]));
    }
}
__device__ __forceinline__ void sb_naive_unit(int unit, int lane, const bf16_t* Qs, const bf16_t* Ks, const bf16_t* Vs, bf16_t* YY, float* ssq_s8) {
    const int qb = unit & 63, h = (unit >> 6) & 7, b = unit >> 9;
    const int t = qb * 64 + lane; const size_t row = (size_t)b * SEQ + t;
    float q[64], o[64];
#pragma unroll
    for (int d = 0; d < 64; ++d) { q[d] = bf2f(Qs[row * SBW + h * 64 + d]); o[d] = 0.f; }
    float R = 0.f;
    for (int s = qb * 64 + 62; s >= 0; --s) {
        const bf16_t* kr = Ks + ((size_t)b * SEQ + s) * SBW + h * 64; const bf16_t* vr = Vs + ((size_t)b * SEQ + s) * SBW + h * 64;
        float z = 0.f;
#pragma unroll
        for (int d = 0; d < 64; ++d) z += q[d] * bf2f(kr[d]);
        const bool valid = s < t;
        const float sp = valid ? (fmaxf(z, 0.f) + __log2f(1.f + exp2f(-fabsf(z)))) : 0.f;
        const float w = valid ? exp2f(z - (R + sp)) : 0.f;
        R += sp;
        const float wb = bf2f((bf16_t)f2bf(w));
#pragma unroll
        for (int d = 0; d < 64; ++d) o[d] += wb * bf2f(vr[d]);
    }
    float ss = 0.f;
#pragma unroll
    for (int d = 0; d < 64; ++d) { ss += o[d] * o[d]; YY[row * D + RW + h * 64 + d] = (bf16_t)f2bf(o[d]); }
    ssq_s8[row * 8 + h] = ss;
}
__device__ __forceinline__ void xattn_naive_unit(int unit, int j, LAS float* qs, LAS float* ps, const bf16_t* QX, const bf16_t* KVM, bf16_t* OX) {
    const int tg = unit & 511, h = (unit >> 9) & 3, b = unit >> 11, lane = j & 63, wid = j >> 6;
    const size_t row0 = (size_t)b * SEQ + tg * 8;
    for (int i = 0; i < 8; ++i) qs[i * 256 + j] = bf2f(QX[(row0 + i) * D + h * XD + j]);
    __syncthreads();
    const bf16_t* kr = KVM + ((size_t)b * MEM + j) * 2048 + h * XD;
    float sc[8];
#pragma unroll
    for (int i = 0; i < 8; ++i) sc[i] = 0.f;
    for (int d = 0; d < XD; ++d) { const float kv = bf2f(kr[d]);
#pragma unroll
        for (int i = 0; i < 8; ++i) sc[i] += qs[i * 256 + d] * kv; }
#pragma unroll
    for (int i = 0; i < 8; ++i) ps[i * 256 + j] = sc[i];
    __syncthreads();
    for (int i = wid * 2; i < wid * 2 + 2; ++i) {
        float v0 = ps[i * 256 + lane], v1 = ps[i * 256 + lane + 64], v2 = ps[i * 256 + lane + 128], v3 = ps[i * 256 + lane + 192];
        float m = fmaxf(fmaxf(v0, v1), fmaxf(v2, v3));
#pragma unroll
        for (int o = 1; o < 64; o <<= 1) m = fmaxf(m, __shfl_xor(m, o));
        v0 = exp2f(v0 - m); v1 = exp2f(v1 - m); v2 = exp2f(v2 - m); v3 = exp2f(v3 - m);
        const float s = wave_sum(v0 + v1 + v2 + v3), inv = 1.f / s;
        ps[i * 256 + lane] = v0 * inv; ps[i * 256 + lane + 64] = v1 * inv; ps[i * 256 + lane + 128] = v2 * inv; ps[i * 256 + lane + 192] = v3 * inv;
    }
    __syncthreads();
    float o[8];
#pragma unroll
    for (int i = 0; i < 8; ++i) o[i] = 0.f;
    for (int m = 0; m < MEM; ++m) { const float vv = bf2f(KVM[((size_t)b * MEM + m) * 2048 + 1024 + h * XD + j]);
#pragma unroll
        for (int i = 0; i < 8; ++i) o[i] += ps[i * 256 + m] * vv; }
#pragma unroll
    for (int i = 0; i < 8; ++i) OX[(row0 + i) * D + h * XD + j] = (bf16_t)f2bf(o[i]);
    __syncthreads();
}
__device__ __forceinline__ int router_row(int row, int lane, const bf16_t* X2b, const float* ssq2p, const float* g, const float* wgr, const float* bgr, const float* wer, const float* ber, float* selw) {
    int cls = 0;
    float acc[20];
#pragma unroll
    for (int i = 0; i < 20; ++i) acc[i] = 0.f;
    const float rs = pg8::rstd16(ssq2p + (size_t)row * 16);
    for (int kk = 0; kk < 16; ++kk) { const int k = kk * 64 + lane; const float t = bf2f(X2b[(size_t)row * D + k]) * rs * g[k];
#pragma unroll
        for (int i = 0; i < 4; ++i) acc[i] += t * wgr[k * 4 + i];
#pragma unroll
        for (int gi = 0; gi < 4; ++gi)
#pragma unroll
            for (int e = 0; e < 4; ++e) acc[4 + gi * 4 + e] += t * wer[((size_t)gi * D + k) * 4 + e]; }
#pragma unroll
    for (int i = 0; i < 20; ++i) acc[i] = wave_sum(acc[i]);
    if (lane == 0) {
        float gl[4]; float gm = -INFINITY; int gi = 0;
#pragma unroll
        for (int i = 0; i < 4; ++i) { gl[i] = acc[i] + bgr[i]; if (gl[i] > gm) { gm = gl[i]; gi = i; } }
        float gs = 0.f;
#pragma unroll
        for (int i = 0; i < 4; ++i) gs += __expf(gl[i] - gm);
        const float gp = 1.f / gs;
        float el[4];
#pragma unroll
        for (int e = 0; e < 4; ++e) { float v = 0.f;
#pragma unroll
            for (int q = 0; q < 4; ++q) if (q == gi) v = acc[4 + q * 4 + e] + ber[q * 4 + e];
            el[e] = v; }
        int e1 = 0; float m1 = el[0];
#pragma unroll
        for (int e = 1; e < 4; ++e) if (el[e] > m1) { m1 = el[e]; e1 = e; }
        int e2 = -1; float m2 = -INFINITY;
#pragma unroll
        for (int e = 0; e < 4; ++e) if (e != e1 && el[e] > m2) { m2 = el[e]; e2 = e; }
        const float p2 = __expf(m2 - m1), w1 = gp / (1.f + p2), w2 = gp * p2 / (1.f + p2);
        const int ea = e1 < e2 ? e1 : e2, eb = e1 < e2 ? e2 : e1; const float wA = e1 < e2 ? w1 : w2, wB = e1 < e2 ? w2 : w1;
        const int pr = (ea == 0) ? eb - 1 : (ea == 1) ? eb + 1 : 5;
        selw[(size_t)row * 2] = wA; selw[(size_t)row * 2 + 1] = wB; cls = gi * 6 + pr;
    }
    return cls;
}
__device__ __forceinline__ void final_row(int row, int lane, const bf16_t* X3b, const float* ssq3, const float* g, float* out) {
    const float r = pg8::rstd16(ssq3 + (size_t)row * 16);
#pragma unroll
    for (int j = 0; j < 2; ++j) { const int c = j * 512 + lane * 8; const u32x4 v = *(const u32x4*)(X3b + (size_t)row * D + c); const f32x4 g0 = *(const f32x4*)(g + c), g1 = *(const f32x4*)(g + c + 4);
        f32x4 o0, o1;
        o0[0] = __uint_as_float(v.x << 16) * r * g0[0]; o0[1] = __uint_as_float(v.x & 0xffff0000u) * r * g0[1]; o0[2] = __uint_as_float(v.y << 16) * r * g0[2]; o0[3] = __uint_as_float(v.y & 0xffff0000u) * r * g0[3];
        o1[0] = __uint_as_float(v.z << 16) * r * g1[0]; o1[1] = __uint_as_float(v.z & 0xffff0000u) * r * g1[1]; o1[2] = __uint_as_float(v.w << 16) * r * g1[2]; o1[3] = __uint_as_float(v.w & 0xffff0000u) * r * g1[3];
        *(f32x4*)(out + (size_t)row * D + c) = o0; *(f32x4*)(out + (size_t)row * D + c + 4) = o1; }
}
__device__ __forceinline__ void reids(Ctx& C) { int t_ = threadIdx.x; asm volatile("" : "+v"(t_)); C.tid = t_; C.lane = t_ & 63; C.wave = __builtin_amdgcn_readfirstlane(t_ >> 6); C.gw = C.bid * NWAVES + C.wave; }
__global__ void __launch_bounds__(NTHREADS, 2) mk_fwd(Args args) {
    extern __shared__ __attribute__((aligned(16))) unsigned char lds[];
    cg::grid_group grid = cg::this_grid();
    Ctx C;
#pragma unroll
    for (int i = 0; i < 29; ++i) C.in[i] = args.in[i];
    C.out = args.out; C.ws = args.ws; C.lds = lds;
    C.tid = threadIdx.x; C.lane = C.tid & 63; C.wave = __builtin_amdgcn_readfirstlane(C.tid >> 6);
    C.G = gridDim.x; C.bid = blockIdx.x; C.gw = C.bid * NWAVES + C.wave; C.NGW = C.G * NWAVES;
    const float* x = C.in[0]; const float* mem = C.in[1]; const float* norm_mix = C.in[2]; const float* w_in = C.in[3];
    const float* conv_w = C.in[4]; const float* conv_b = C.in[5]; const float* lru_w_a = C.in[6]; const float* lru_b_a = C.in[7];
    const float* lru_w_x = C.in[8]; const float* lru_b_x = C.in[9]; const float* lru_lambda = C.in[10];
    const float* norm_rnn = C.in[11]; const float* norm_sb = C.in[12]; const float* w_out = C.in[13];
    const float* norm_xattn = C.in[14]; const float* norm_mem = C.in[15];
    const float* xa_w_q = C.in[16]; const float* xa_w_k = C.in[17]; const float* xa_w_v = C.in[18]; const float* xa_w_o = C.in[19];
    const float* norm_moe = C.in[20]; const float* w_gr = C.in[21]; const float* b_gr = C.in[22]; const float* w_er = C.in[23]; const float* b_er = C.in[24];
    const float* w_gate = C.in[25]; const float* w_up = C.in[26]; const float* w_down = C.in[27]; const float* norm_final = C.in[28];
    unsigned char* ws = C.ws; float* out = C.out;
    float* sm = (float*)(ws + WS_SMALL);
    float* rstd0 = sm + SM_RSTD0; float* ssq_r = sm + SM_SSQR; float* ssq_s = sm + SM_SSQS; float* ssq1 = sm + SM_SSQ1; float* ssq2 = sm + SM_SSQ2; unsigned* kmax = (unsigned*)(ws + WS_CTL); float* fmid = sm + SM_END; float* fend = fmid + 32768;
    float* aggP = sm + 96 * 32768; float* aggH = sm + 104 * 32768;
    float* selw = sm + SM_SELW; float* ssq3 = sm + SM_SSQ3; int* gcnt = (int*)(ws + WS_CTL + 1024);
    int* tlist = (int*)(sm + 64 * 32768); float* rsg = sm + 88 * 32768; float* wAg = rsg + 40960; float* wBg = wAg + 40960; int* tokg = (int*)(wBg + 40960);
    bf16_t* Wrh = (bf16_t*)(ws + WS_CTL + 65536); bf16_t* Wrl = Wrh + 32 * D;
    bf16_t* Wg_t = (bf16_t*)(ws + WS_WG); bf16_t* Wu_t = (bf16_t*)(ws + WS_WU); bf16_t* Wd2 = (bf16_t*)(ws + WS_WD2); bf16_t* XG = (bf16_t*)(ws + WS_R1); bf16_t* HID = (bf16_t*)(ws + WS_R5);
    bf16_t* Win_t = (bf16_t*)(ws + WS_WIN); bf16_t* Wout_t = (bf16_t*)(ws + WS_WOUT); bf16_t* Wq_t = (bf16_t*)(ws + WS_WQ); bf16_t* Wkv_t = (bf16_t*)(ws + WS_WKV); bf16_t* Wo_t = (bf16_t*)(ws + WS_WO);
    bf16_t* memn = (bf16_t*)(ws + WS_MEMN); bf16_t* KM = (bf16_t*)(ws + WS_KVM); bf16_t* VM = KM + (size_t)NMEM * D; bf16_t* MT = (bf16_t*)(ws + WS_R5); bf16_t* NT = MT + (size_t)BATCH * D * D; bf16_t* WqN = (bf16_t*)(ws + WS_WQ);
    bf16_t* xb = (bf16_t*)(ws + WS_R0); bf16_t* X1b = xb; bf16_t* X3b = xb;
    bf16_t* XR = (bf16_t*)(ws + WS_R1); bf16_t* GG = XR + (size_t)NTOK * RW; bf16_t* QX = XR;
    bf16_t* Qs = (bf16_t*)(ws + WS_R2); bf16_t* Ks = Qs + (size_t)NTOK * SBW; bf16_t* OX = Qs;
    bf16_t* Vs = (bf16_t*)(ws + WS_R3);
    bf16_t* YY = (bf16_t*)(ws + WS_R4); bf16_t* X2b = YY;
    const int NGW = C.NGW;
#define gw C.gw
#define lane C.lane
    if (C.tid < 64) ((LAS unsigned*)(lds + 146432))[C.tid] = 0u;
    __syncthreads();
    XcdBarrier bar = xcd_barrier_post((unsigned*)(ws + WS_CTL + 4096), (volatile LAS unsigned*)(lds + 146432 + 32));
#define GRID_SYNC_CG() do { grid.sync(); reids(C); } while (0)
#define GRID_SYNC() do { xcd_barrier(bar); reids(C); } while (0)

    for (int rep_ = 0; rep_ < (int)((REP_MASK >> 0) & 1u) + 1; ++rep_) {
    {
        if (gw == 0) { kmax[lane] = 0u; if (lane < 32) gcnt[lane] = 0; }
        for (int r = gw * 4; r < NTOK; r += NGW * 4) {
            const f32x4* xr = (const f32x4*)(x + (size_t)r * D) + lane; f32x4 v[16]; float s[4] = {0.f, 0.f, 0.f, 0.f};
#pragma unroll
            for (int j = 0; j < 16; ++j) v[j] = __builtin_nontemporal_load(xr + 64 * j);
#pragma unroll
            for (int j = 0; j < 16; ++j) s[j >> 2] += (v[j].x * v[j].x + v[j].y * v[j].y) + (v[j].z * v[j].z + v[j].w * v[j].w);
#pragma unroll
            for (int o = 1; o < 64; o <<= 1) { s[0] += __shfl_xor(s[0], o); s[1] += __shfl_xor(s[1], o); s[2] += __shfl_xor(s[2], o); s[3] += __shfl_xor(s[3], o); }
            if (lane < 4) { const float sv = lane == 0 ? s[0] : lane == 1 ? s[1] : lane == 2 ? s[2] : s[3]; rstd0[r + lane] = __builtin_amdgcn_rsqf(sv * (1.f / D) + EPS); }
            unsigned long long* o8 = (unsigned long long*)(xb + (size_t)r * D) + lane;
#pragma unroll
            for (int j = 0; j < 16; ++j) o8[64 * j] = (unsigned long long)(f2bf(v[j].x) | (f2bf(v[j].y) << 16)) | ((unsigned long long)(f2bf(v[j].z) | (f2bf(v[j].w) << 16)) << 32);
        }
        for (int r = gw; r < NMEM; r += NGW) row_prep_mem(mem, norm_mem, memn, r, lane);
        LAS float* scr = (LAS float*)(lds) + C.wave * (64 * 65);
        constexpr int I_IN = (D / 64) * (PROJ / 64), I_SQ = (D / 64) * (D / 64);
        for (int it = gw; it < I_IN + 4 * I_SQ; it += NGW) {
            int r = it;
            if (r < I_IN) { transpose_item(w_in, D, PROJ, Win_t, D, norm_mix, norm_mix, D, scr, r, lane); continue; } r -= I_IN;
            if (r < I_SQ) { transpose_item(w_out, D, D, Wout_t, D, norm_rnn, norm_sb, RW, scr, r, lane); continue; } r -= I_SQ;
            if (r < I_SQ) { transpose_item(xa_w_k, D, D, Wkv_t, D, nullptr, nullptr, 0, scr, r, lane); continue; } r -= I_SQ;
            if (r < I_SQ) { transpose_item(xa_w_v, D, D, Wkv_t + (size_t)D * D, D, nullptr, nullptr, 0, scr, r, lane); continue; } r -= I_SQ;
            transpose_item(xa_w_o, D, D, Wo_t, D, nullptr, nullptr, 0, scr, r, lane);
        }
        for (int r = gw; r < D; r += NGW) { const float gk = norm_xattn[r]; const f32x4* src = (const f32x4*)(xa_w_q + (size_t)r * D) + lane; unsigned long long* o8 = (unsigned long long*)(WqN + (size_t)r * D) + lane;
#pragma unroll
            for (int j = 0; j < 4; ++j) { const f32x4 v = src[64 * j]; o8[64 * j] = (unsigned long long)(f2bf(v.x * gk) | (f2bf(v.y * gk) << 16)) | ((unsigned long long)(f2bf(v.z * gk) | (f2bf(v.w * gk) << 16)) << 32); } }
        for (int idx = gw * 64 + lane; idx < 32 * D; idx += NGW * 64) { const int n = idx >> 10, k = idx & 1023; float w = 0.f;
            if (n < 4) w = w_gr[k * 4 + n]; else if (n < 20) w = w_er[((size_t)((n - 4) >> 2) * D + k) * 4 + ((n - 4) & 3)];
            w *= norm_moe[k]; const unsigned hi = f2bf(w); Wrh[idx] = (bf16_t)hi; Wrl[idx] = (bf16_t)f2bf(w - bf2f((unsigned short)hi)); }
        constexpr int I_GU = (D / 64) * (DE / 64), I_DN = (DE / 64) * (D / 64);
        for (int it = gw; it < 32 * I_GU + 48 * I_DN; it += NGW) {
            int r = it;
            if (r < 16 * I_GU) { const int e = r / I_GU; transpose_item(w_gate + (size_t)e * D * DE, D, DE, Wg_t + (size_t)e * DE * D, D, norm_moe, norm_moe, D, scr, r % I_GU, lane); continue; } r -= 16 * I_GU;
            if (r < 16 * I_GU) { const int e = r / I_GU; transpose_item(w_up + (size_t)e * D * DE, D, DE, Wu_t + (size_t)e * DE * D, D, norm_moe, norm_moe, D, scr, r % I_GU, lane); continue; } r -= 16 * I_GU;
            { const int cs = r / I_DN, cls = cs >> 1, slot = cs & 1; int ea, eb; pg8::pair_ab(cls % 6, ea, eb); const int e = (cls / 6) * 4 + (slot ? eb : ea);
              transpose_item(w_down + (size_t)e * DE * D, DE, D, Wd2 + (size_t)cls * D * 512 + slot * DE, 512, nullptr, nullptr, 0, scr, r % I_DN, lane); }
        }
    }
    }
    GRID_SYNC();
    for (int rep_ = 0; rep_ < (int)((REP_MASK >> 1) & 1u) + 1; ++rep_) {
    { pg8::DenseOrder S; S.init(xb, D, Win_t, D, NTOK, PROJ, C.G, C.bid); pg8::EpiInProjF E{0, rstd0, XR, GG, Qs, Ks, Vs, kmax};
      pg8::gemm_phase<pg8::EpiInProjF, pg8::DenseOrder, true>((LAS unsigned char*)lds, pg8::Gemm{D, D, D}, S, E); }
    { pg8::DenseOrder S; S.init(memn, D, Wkv_t, D, NMEM, 2048, C.G, C.bid); pg8::EpiKvN E{0, KM, VM};
      pg8::gemm_phase<pg8::EpiKvN, pg8::DenseOrder, true>((LAS unsigned char*)lds, pg8::Gemm{D, D, D}, S, E); }
    }
    GRID_SYNC();
    for (int rep_ = 0; rep_ < (int)((REP_MASK >> 2) & 1u) + 1; ++rep_) {
    {
        { lru::Weights LW; lru::load_weights(LW, C.wave, lane & 31, lane >> 5, lru_w_a, lru_b_a, lru_w_x, lru_b_x, lru_lambda);
          for (int u = C.bid; u < BATCH * 64; u += C.G) lru::unit<false>(u >> 6, u & 63, LW, XR, GG, conv_w, conv_b, aggP, aggH, ssq_s, YY, fmid, fend, lds); }
        for (int u = C.bid; u < BATCH * NH * 16; u += C.G) sba::sb_unit(u >> 7, (u >> 4) & 7, 15 - (u & 15), Qs, Ks, Vs, YY, ssq_s, (char*)lds);
    }
    { pg8::XaPreOrder S{KM, VM, WqN, Wo_t, C.G, C.bid}; pg8::EpiXaPre E{0, MT, NT};
      pg8::gemm_phase<pg8::EpiXaPre, pg8::XaPreOrder, true>((LAS unsigned char*)lds, pg8::Gemm{D, D, XD}, S, E); }
    }
    GRID_SYNC();
    for (int rep_ = 0; rep_ < (int)((REP_MASK >> 3) & 1u) + 1; ++rep_) {
    { lru::Weights LW; lru::load_weights(LW, C.wave, lane & 31, lane >> 5, lru_w_a, lru_b_a, lru_w_x, lru_b_x, lru_lambda);
      for (int u = C.bid; u < BATCH * 64; u += C.G) lru::unit<true>(u >> 6, u & 63, LW, XR, GG, conv_w, conv_b, aggP, aggH, ssq_s, YY, fmid, fend, lds); }
    }
    GRID_SYNC();
    for (int rep_ = 0; rep_ < (int)((REP_MASK >> 4) & 1u) + 1; ++rep_) {
    { pg8::DenseOrder S; S.init(YY, D, Wout_t, D, NTOK, D, C.G, C.bid); pg8::EpiX1F E{8, xb, fmid, fend, X1b, ssq1};
      pg8::gemm_phase<pg8::EpiX1F, pg8::DenseOrder, true>((LAS unsigned char*)lds, pg8::Gemm{D, D, D}, S, E); }
    }
    GRID_SYNC();
    for (int rep_ = 0; rep_ < (int)((REP_MASK >> 5) & 1u) + 1; ++rep_) {
    { pg8::BatchedOrder S{X1b, MT, C.G, C.bid}; pg8::EpiXaSoftmax E{0, QX, ssq1, 0.0625f * LOG2E, (LAS float*)(lds + 131072 + 2048)};
      pg8::gemm_phase<pg8::EpiXaSoftmax, pg8::BatchedOrder, true>((LAS unsigned char*)lds, pg8::Gemm{D, D, D}, S, E); }
    }
    GRID_SYNC();
    for (int rep_ = 0; rep_ < (int)((REP_MASK >> 8) & 1u) + 1; ++rep_) {
    { pg8::BatchedOrder S{QX, NT, C.G, C.bid}; pg8::EpiResF E{0, X1b, X2b, ssq2};
      pg8::gemm_phase<pg8::EpiResF, pg8::BatchedOrder, true>((LAS unsigned char*)lds, pg8::Gemm{D, D, D}, S, E); }
    }
    GRID_SYNC();
    for (int rep_ = 0; rep_ < (int)((REP_MASK >> 9) & 1u) + 1; ++rep_) {
    {
        LAS int* lcnt = (LAS int*)lds; LAS int* lbase = lcnt + 32; LAS int* lcls = lcnt + 64; LAS int* lpos = lcnt + 192;
        for (int p = C.tid; p < 64 * 128; p += NTHREADS) { const int rrow = p >> 7, pc = p & 127;
            *(LAS u32x4*)(lds + 12288 + rrow * 2064 + pc * 16) = *(const u32x4*)(Wrh + (size_t)rrow * D + pc * 8); }
        for (int chunk = C.bid; chunk < NTOK / 128; chunk += C.G) {
            if (C.tid < 32) lcnt[C.tid] = 0;
            __syncthreads();
            {
                const int fr = lane & 15, fq = lane >> 4, row0 = chunk * 128 + C.wave * 16;
                f32x4 acc0 = {0.f, 0.f, 0.f, 0.f}, acc1 = acc0;
                const bf16_t* ap = X2b + (size_t)(row0 + fr) * D + fq * 8; const LAS unsigned char* bp = (const LAS unsigned char*)(lds + 12288) + fr * 2064 + fq * 16;
#pragma unroll 1
                for (int kb = 0; kb < 4; ++kb) { bf16x8 a[8];
#pragma unroll
                    for (int j = 0; j < 8; ++j) a[j] = *(const bf16x8*)(ap + (kb * 8 + j) * 32);
#pragma unroll
                    for (int j = 0; j < 8; ++j) { const int ks = kb * 8 + j;
                        const bf16x8 h0 = *(const LAS bf16x8*)(bp + ks * 64), h1 = *(const LAS bf16x8*)(bp + 16 * 2064 + ks * 64), l0 = *(const LAS bf16x8*)(bp + 32 * 2064 + ks * 64), l1 = *(const LAS bf16x8*)(bp + 48 * 2064 + ks * 64);
                        acc0 = __builtin_amdgcn_mfma_f32_16x16x32_bf16(a[j], h0, acc0, 0, 0, 0); acc1 = __builtin_amdgcn_mfma_f32_16x16x32_bf16(a[j], h1, acc1, 0, 0, 0);
                        acc0 = __builtin_amdgcn_mfma_f32_16x16x32_bf16(a[j], l0, acc0, 0, 0, 0); acc1 = __builtin_amdgcn_mfma_f32_16x16x32_bf16(a[j], l1, acc1, 0, 0, 0); } }
                LAS float* lg = (LAS float*)(lds + 1536) + C.wave * (16 * 21);
#pragma unroll
                for (int j = 0; j < 4; ++j) { lg[(4 * fq + j) * 21 + fr] = acc0[j]; if (fr < 4) lg[(4 * fq + j) * 21 + 16 + fr] = acc1[j]; }
                asm volatile("s_waitcnt lgkmcnt(0)" ::: "memory");
                if (lane < 16) { const int row = row0 + lane; const float rs = pg8::rstd16(ssq2 + (size_t)row * 16); const LAS float* lr = lg + lane * 21;
                    float gl[4]; float gm = -INFINITY; int gi = 0;
#pragma unroll
                    for (int i = 0; i < 4; ++i) { gl[i] = lr[i] * rs + b_gr[i]; if (gl[i] > gm) { gm = gl[i]; gi = i; } }
                    float gs = 0.f;
#pragma unroll
                    for (int i = 0; i < 4; ++i) gs += __expf(gl[i] - gm);
                    const float gp = 1.f / gs;
                    float el[4];
#pragma unroll
                    for (int e = 0; e < 4; ++e) el[e] = lr[4 + gi * 4 + e] * rs + b_er[gi * 4 + e];
                    int e1 = 0; float m1 = el[0];
#pragma unroll
                    for (int e = 1; e < 4; ++e) if (el[e] > m1) { m1 = el[e]; e1 = e; }
                    int e2 = -1; float m2 = -INFINITY;
#pragma unroll
                    for (int e = 0; e < 4; ++e) if (e != e1 && el[e] > m2) { m2 = el[e]; e2 = e; }
                    const float p2 = __expf(m2 - m1), w1 = gp / (1.f + p2), w2 = gp * p2 / (1.f + p2);
                    const int ea = e1 < e2 ? e1 : e2, eb = e1 < e2 ? e2 : e1; const float wA = e1 < e2 ? w1 : w2, wB = e1 < e2 ? w2 : w1;
                    const int pr = (ea == 0) ? eb - 1 : (ea == 1) ? eb + 1 : 5, cls = gi * 6 + pr, lt = C.wave * 16 + lane;
                    selw[(size_t)row * 2] = wA; selw[(size_t)row * 2 + 1] = wB;
                    lcls[lt] = cls; lpos[lt] = __hip_atomic_fetch_add(lcnt + cls, 1, __ATOMIC_RELAXED, __HIP_MEMORY_SCOPE_WORKGROUP); }
            }
            __syncthreads();
            if (C.tid < 24) lbase[C.tid] = atomicAdd(gcnt + C.tid, lcnt[C.tid]);
            __syncthreads();
            if (C.tid < 128) { const int c = lcls[C.tid]; tlist[(size_t)c * NTOK + lbase[c] + lpos[C.tid]] = chunk * 128 + C.tid; }
            __syncthreads();
        }
    }
    }
    GRID_SYNC();
    LAS int* meta = (LAS int*)(lds + 146432 + 256);
    for (int rep_ = 0; rep_ < (int)((REP_MASK >> 10) & 1u) + 1; ++rep_) {
    {
        if (C.tid == 0) { int rb = 0, tb = 0;
            for (int c = 0; c < 24; ++c) { const int n = gcnt[c], nt = (n + 255) >> 8; meta[c] = n; meta[32 + c] = rb; meta[64 + c] = tb; rb += nt * 256; tb += nt; }
            meta[32 + 24] = rb; meta[64 + 24] = tb; }
        __syncthreads();
        const int total = meta[32 + 24];
        for (int R = gw; R < total; R += NGW) {
            int c = 0;
            for (int k = 1; k < 24; ++k) c += (R >= meta[32 + k]) ? 1 : 0;
            const int p = R - meta[32 + c]; u32x4 v0 = (u32x4){0u, 0u, 0u, 0u}, v1 = v0; int tok = -1; float rs = 0.f, wA = 0.f, wB = 0.f;
            if (p < meta[c]) { tok = tlist[(size_t)c * NTOK + p]; const u32x4* src = (const u32x4*)(X2b + (size_t)tok * D) + lane; v0 = src[0]; v1 = src[64];
                rs = pg8::rstd16(ssq2 + (size_t)tok * 16); wA = selw[(size_t)tok * 2]; wB = selw[(size_t)tok * 2 + 1]; }
            u32x4* dst = (u32x4*)(XG + (size_t)R * D) + lane; dst[0] = v0; dst[64] = v1;
            if (lane == 0) { rsg[R] = rs; wAg[R] = wA; wBg[R] = wB; tokg[R] = tok; }
        }
    }
    }
    GRID_SYNC();
    for (int rep_ = 0; rep_ < (int)((REP_MASK >> 11) & 1u) + 1; ++rep_) {
    { pg8::MoeOrder1 S{XG, Wg_t, Wu_t, meta, C.G, C.bid}; pg8::EpiMoeUp E{0, rsg, wAg, wBg, HID};
      pg8::gemm_phase<pg8::EpiMoeUp, pg8::MoeOrder1, true>((LAS unsigned char*)lds, pg8::Gemm{D, D, D}, S, E); }
    }
    GRID_SYNC();
    for (int rep_ = 0; rep_ < (int)((REP_MASK >> 12) & 1u) + 1; ++rep_) {
    { pg8::MoeOrder2 S{HID, Wd2, meta, C.G, C.bid};
      pg8::EpiMoeFinal E{0, tokg, X2b, out, ssq3, (unsigned*)(ws + WS_CTL + 4096 + 16384), norm_final, (LAS unsigned*)(lds + 146432 + 128), (unsigned*)(ws + WS_CTL + 4096) + 128};
      pg8::gemm_phase<pg8::EpiMoeFinal, pg8::MoeOrder2, true>((LAS unsigned char*)lds, pg8::Gemm{512, 512, 512}, S, E); }
    }
}

#undef gw
#undef lane
extern "C" void kernel_launch(void* const* d_in, const int* in_sizes, int n_in, void* d_out, int out_size, void* d_ws, size_t ws_size, hipStream_t stream) {
    static int grid = 0;
    if (grid == 0) {
        if (n_in != 29 || ws_size < WS_END) { fprintf(stderr, "kernel_launch: unexpected inputs (%d) or workspace (%zu)\n", n_in, ws_size); grid = -1; return; }
        int dev = 0, cus = 0, per_cu = 0;
        hipGetDevice(&dev); hipDeviceGetAttribute(&cus, hipDeviceAttributeMultiprocessorCount, dev);
        hipFuncSetAttribute((const void*)mk_fwd, hipFuncAttributeMaxDynamicSharedMemorySize, LDS_BYTES);
        hipOccupancyMaxActiveBlocksPerMultiprocessor(&per_cu, (const void*)mk_fwd, NTHREADS, LDS_BYTES);
        if (per_cu < 1) { fprintf(stderr, "kernel_launch: occupancy query says %d blocks per CU\n", per_cu); per_cu = 1; }
        if (per_cu > 1) per_cu = 1;
        grid = cus * per_cu;
    }
    if (grid < 0) return;
    if (hipMemsetAsync((char*)d_ws + WS_CTL + 4096, 0, 32768, stream) != hipSuccess) { fprintf(stderr, "kernel_launch: memset of the barrier words failed\n"); return; }
    Args a{};
    for (int i = 0; i < 29; ++i) a.in[i] = (const float*)d_in[i];
    a.out = (float*)d_out; a.ws = (unsigned char*)d_ws;
    void* kargs[] = {&a};
    hipError_t e = hipLaunchCooperativeKernel((const void*)mk_fwd, dim3(grid), dim3(NTHREADS), kargs, LDS_BYTES, stream);
    if (e != hipSuccess) fprintf(stderr, "cooperative launch failed: %s (grid %d)\n", hipGetErrorString(e), grid);
}
```

```cpp
#include <hip/hip_runtime.h>
#include <hip/hip_cooperative_groups.h>
#include <cstdio>
#include <cstdint>

typedef unsigned short bf16_t;
typedef short bf16x8 __attribute__((ext_vector_type(8)));
typedef float f32x4 __attribute__((ext_vector_type(4)));
typedef unsigned u32x4 __attribute__((ext_vector_type(4)));

constexpr int D = 1024, BATCH = 8, SEQ = 4096, NTOK = BATCH * SEQ, MEM = 256, NMEM = BATCH * MEM;
constexpr int RW = 512, SBW = 512, PROJ = 2560, NH = 8, HD = 64;
constexpr int XH = 4, XD = 256, NG = 4, EPG = 4, NEXP = 16, DE = 256;
constexpr float EPS = 1e-6f, LOG2E = 1.4426950408889634f;

constexpr size_t MiB = 1u << 20;
constexpr size_t WS_CTL = 0;
constexpr size_t WS_SMALL = 1 * MiB;
constexpr size_t WS_WIN = 16 * MiB;
constexpr size_t WS_WOUT = 21 * MiB;
constexpr size_t WS_WQ = 23 * MiB;
constexpr size_t WS_WKV = 25 * MiB;
constexpr size_t WS_WO = 29 * MiB;
constexpr size_t WS_MEMN = 31 * MiB;
constexpr size_t WS_KVM = 35 * MiB;
constexpr size_t WS_WG = 43 * MiB;
constexpr size_t WS_WU = 51 * MiB;
constexpr size_t WS_WD2 = 59 * MiB;
constexpr size_t WS_R0 = 96 * MiB;
constexpr size_t WS_R1 = 160 * MiB;
constexpr size_t WS_R2 = 224 * MiB;
constexpr size_t WS_R3 = 288 * MiB;
constexpr size_t WS_R4 = 320 * MiB;
constexpr size_t WS_R5 = 384 * MiB;
constexpr size_t WS_END = 448 * MiB;

constexpr size_t SM_RSTD0 = 0;
constexpr size_t SM_SSQR = 1 * 32768;
constexpr size_t SM_SSQS = 2 * 32768;
constexpr size_t SM_SSQ1 = 10 * 32768;
constexpr size_t SM_SSQ2 = 26 * 32768;
constexpr size_t SM_SSQ3 = 42 * 32768;
constexpr size_t SM_SELW = 58 * 32768;
constexpr size_t SM_SELE = 60 * 32768;
constexpr size_t SM_END = 62 * 32768;

__device__ __forceinline__ unsigned f2bf(float f) { unsigned u = __builtin_bit_cast(unsigned, f); return (u + 0x7fffu + ((u >> 16) & 1u)) >> 16; }
__device__ __forceinline__ float bf2f(unsigned short h) { return __builtin_bit_cast(float, (unsigned)h << 16); }
__device__ __forceinline__ float wave_sum(float v) {
#pragma unroll
    for (int o = 1; o < 64; o <<= 1) v += __shfl_xor(v, o);
    return v;
}
__device__ __forceinline__ float gelu_tanh(float x) { const float u = 0.7978845608028654f * (x + 0.044715f * x * x * x); return x * __builtin_amdgcn_rcpf(1.f + __expf(-2.f * u)); }
__device__ __forceinline__ float sigmoidf_(float x) { return 1.f / (1.f + __expf(-x)); }

namespace cg = cooperative_groups;
#ifndef PROBE_A
#define PROBE_A -1
#endif
#ifndef REP_MASK
#define REP_MASK 0u
#endif
#define LAS __attribute__((address_space(3)))
constexpr int NWAVES = 8, NTHREADS = 512;
constexpr int LDS_BYTES = 147456;

struct Args { const float* in[29]; float* out; unsigned char* ws; };

struct Ctx {
    const float* in[29]; float* out; unsigned char* ws; unsigned char* lds;
    int tid, lane, wave, gw, NGW, G, bid;
};

#define RLX_AGENT __ATOMIC_RELAXED, __HIP_MEMORY_SCOPE_AGENT
#define XB_TMO      128
#define XB_XCNT(j)  (256  + 64 * (j))
#define XB_XSUB(j)  (1280 + 64 * (j))
#define XB_XGEN(j)  (2304 + 64 * (j))
#define XB_TOP      3328
#define XB_TOPGEN   3392
#define XCD_BAR_WORDS 3456
#define XB_SPIN_CAP (1u << 18)

__device__ __forceinline__ unsigned xb_ld(unsigned* p)              { return __hip_atomic_load(p, __ATOMIC_RELAXED, __HIP_MEMORY_SCOPE_AGENT); }
__device__ __forceinline__ unsigned xb_add(unsigned* p, unsigned v) { return __hip_atomic_fetch_add(p, v, __ATOMIC_RELAXED, __HIP_MEMORY_SCOPE_AGENT); }
__device__ __forceinline__ unsigned xb_xcc_id() { return (unsigned)__builtin_amdgcn_s_getreg((3 << 11) | 20) & 0xFu; }
#define XB_SPIN(cond, bar) do { unsigned _sp = 0; while (cond) { __builtin_amdgcn_s_sleep(1); \
    if ((++_sp & 255u) == 0u) { if (xb_ld(&(bar)[XB_TMO])) break; if (_sp > XB_SPIN_CAP) { atomicAdd(&(bar)[XB_TMO], 1u); break; } } } } while (0)

struct XcdBarrier {
    unsigned* bar; unsigned x;
    volatile LAS unsigned* st;
};

__device__ __forceinline__ XcdBarrier xcd_barrier_post(unsigned* bar, volatile LAS unsigned* st) {
    XcdBarrier b; b.bar = bar; b.x = xb_xcc_id(); b.st = st;
    if (threadIdx.x == 0) (void)xb_add(&bar[XB_XCNT(b.x)], 1u);
    return b;
}
__device__ __forceinline__ void xcd_barrier_complete(unsigned* bar, unsigned x, unsigned& nloc, unsigned& nx) {
    const unsigned G = gridDim.x * gridDim.y * gridDim.z;
    unsigned sum, cnt, mine, sp = 0u;
    for (;;) {
        sum = 0u; cnt = 0u; mine = 0u;
#pragma unroll
        for (unsigned j = 0; j < 16; ++j) { const unsigned c = xb_ld(&bar[XB_XCNT(j)]); sum += c; cnt += (c > 0u) ? 1u : 0u; mine = (j == x) ? c : mine; }
        if (sum == G) break;
        __builtin_amdgcn_s_sleep(1);
        if ((++sp & 255u) == 0u) { if (xb_ld(&bar[XB_TMO])) break; if (sp > XB_SPIN_CAP) { atomicAdd(&bar[XB_TMO], 1u); break; } }
    }
    nloc = mine > 0u ? mine : 1u; nx = cnt > 0u ? cnt : 1u;
}

__device__ __forceinline__ void xcd_barrier(const XcdBarrier& b) {
    asm volatile("s_waitcnt vmcnt(0)" ::: "memory");
    __syncthreads();
    if (threadIdx.x == 0) {
        unsigned* bar = b.bar;
        __builtin_amdgcn_s_waitcnt(0);
        unsigned nloc = b.st[0], nx = b.st[1];
        if (nloc == 0u) { xcd_barrier_complete(bar, b.x, nloc, nx); b.st[0] = nloc; b.st[1] = nx; }
        const unsigned old = xb_add(&bar[XB_XSUB(b.x)], 1u);
        const unsigned gen = old / nloc;
        if (old + 1u == (gen + 1u) * nloc) {
            __builtin_amdgcn_fence(__ATOMIC_RELEASE, "agent");
            asm volatile("s_waitcnt vmcnt(0)" ::: "memory");
            const unsigned og = xb_add(&bar[XB_TOP], 1u);
            const unsigned tg = og / nx;
            if (og + 1u == (tg + 1u) * nx) xb_add(&bar[XB_TOPGEN], 1u);
            else XB_SPIN(xb_ld(&bar[XB_TOPGEN]) == tg, bar);
            __builtin_amdgcn_fence(__ATOMIC_ACQUIRE, "agent");
            xb_add(&bar[XB_XGEN(b.x)], 1u);
            asm volatile("s_waitcnt vmcnt(0)" ::: "memory");
        } else {
            XB_SPIN(xb_ld(&bar[XB_XGEN(b.x)]) == gen, bar);
            __builtin_amdgcn_fence(__ATOMIC_ACQUIRE, "agent");
            asm volatile("s_waitcnt vmcnt(0)" ::: "memory");
        }
    }
    __syncthreads();
}
namespace pg8 {
#define PG8_LAS __attribute__((address_space(3)))
constexpr int BM = 256, BK = 64, HALF = 128, HTB = HALF * BK * 2  , STAGE_BYTES = 8 * HTB, NXCD = 8, WGM = 8;
__host__ __device__ __forceinline__ int lds_byte(int r, int c) { const int st = (r >> 4) * 2 + (c >> 5), rr = r & 15, cc = c & 31, ob = rr * 64 + cc * 2; return st * 1024 + (ob ^ (((ob >> 9) & 1) << 5)); }
__host__ __device__ __forceinline__ void stage_rc(int b, int& R, int& C) { const int st = b / 1024, sb = b % 1024, swz = sb ^ (((sb >> 9) & 1) << 5); R = (st >> 1) * 16 + swz / 64; C = (st & 1) * 32 + (swz % 64) / 2; }
__host__ __device__ __forceinline__ int perm32(int rho) { const int n = rho >> 4, i = rho & 15; return 8 * (i >> 2) + 4 * n + (i & 3); }

struct Unit { int pm, pn; };
struct Gemm { int lda, ldb, K; };
struct DenseOrder {
    const bf16_t* A; const bf16_t* Bt; int lda, ldb; int nM, nN, nwg, G, c; int ntk = D / BK;
    __device__ __forceinline__ int nt(const Unit&) const { return ntk; }
    __device__ void init(const bf16_t* A_, int lda_, const bf16_t* Bt_, int ldb_, int M, int N, int G_, int c_) { A = A_; Bt = Bt_; lda = lda_; ldb = ldb_; nM = M / BM; nN = N / BM; nwg = nM * nN; G = G_; c = c_; }
    __device__ bool next(int i, Unit& u) const {
        const long L = (long)i * G + c; if (L >= nwg) return false;
        int wgid = (int)L; { const int q = nwg / NXCD, r = nwg % NXCD, xcd = wgid % NXCD, off = wgid / NXCD; wgid = (xcd < r ? xcd * (q + 1) : r * (q + 1) + (xcd - r) * q) + off; }
        const int nig = WGM * nN, gid = wgid / nig, fm = gid * WGM, gsz = (nM - fm) < WGM ? (nM - fm) : WGM;
        u.pm = fm + ((wgid % nig) % gsz); u.pn = (wgid % nig) / gsz; return true;
    }
    __device__ __forceinline__ void ptrs(const Unit& u, const char*& a, const char*& b0, const char*& b1) const {
        a = (const char*)A + (size_t)u.pm * BM * lda * 2; b0 = (const char*)Bt + (size_t)u.pn * BM * ldb * 2; b1 = b0 + (size_t)HALF * ldb * 2; }
};

__device__ __forceinline__ unsigned cvt_pk_bf16(float lo, float hi) { unsigned r; asm volatile("v_cvt_pk_bf16_f32 %0, %1, %2" : "=v"(r) : "v"(lo), "v"(hi)); return r; }

template <class Epi, class Sched, bool ALIGN_EPI>
__device__ __forceinline__ void gemm_phase(PG8_LAS unsigned char* lds, const Gemm g, const Sched& S, const Epi& E, int pidx = 0) {
    int tid_ = threadIdx.x; asm volatile("" : "+v"(tid_));
    const int tid = tid_, wid = __builtin_amdgcn_readfirstlane(tid >> 6), lane = tid & 63, wr = wid >> 2, wc = wid & 3, fr = lane & 15, fq = lane >> 4;
    unsigned voffA[2], voffB[2];
#pragma unroll
    for (int i = 0; i < 2; ++i) { int R, C; stage_rc(tid * 16 + i * 8192, R, C); const int Rb = Epi::PERM ? ((R & ~31) + perm32(R & 31)) : R;
        voffA[i] = (unsigned)(R * g.lda + C) * 2u; voffB[i] = (unsigned)(Rb * g.ldb + C) * 2u; }
    const size_t kstep = (size_t)(BK * 2);
    const size_t hstepA = (size_t)HALF * g.lda * 2;
    const unsigned ldsw = (unsigned)wid * 1024u;
    const int aoff = lds_byte(wr * 64 + fr, fq * 8), boff = lds_byte(wc * 32 + fr, fq * 8);
#define PG8_SA(b, h) (((b) * 2 + (h)) * HTB)
#define PG8_SB(b, h) ((4 + (b) * 2 + (h)) * HTB)
#define PG8_STAGE(bufoff, gbase, voff) do { _Pragma("unroll") for (int _i = 0; _i < 2; ++_i) \
        __builtin_amdgcn_global_load_lds((const unsigned*)((const char*)(gbase) + (voff)[_i]), (PG8_LAS unsigned*)(lds + (bufoff) + ldsw + _i * 8192), 16, 0, 0); } while (0)
#define PG8_LDA(dst, b, h) do { _Pragma("unroll") for (int m = 0; m < 4; ++m) _Pragma("unroll") for (int k = 0; k < 2; ++k) dst[m][k] = *(const PG8_LAS bf16x8*)(lds + PG8_SA(b, h) + aoff + m * 2048 + k * 1024); } while (0)
#define PG8_LDB(dst, b, h) do { _Pragma("unroll") for (int n = 0; n < 2; ++n) _Pragma("unroll") for (int k = 0; k < 2; ++k) dst[n][k] = *(const PG8_LAS bf16x8*)(lds + PG8_SB(b, h) + boff + n * 2048 + k * 1024); } while (0)
#define PG8_MMA(ai, bj, At, Bt) do { __builtin_amdgcn_s_setprio(1); _Pragma("unroll") for (int m = 0; m < 4; ++m) _Pragma("unroll") for (int n = 0; n < 2; ++n) _Pragma("unroll") for (int k = 0; k < 2; ++k) \
        acc[ai][bj][m][n] = __builtin_amdgcn_mfma_f32_16x16x32_bf16(Bt[n][k], At[m][k], acc[ai][bj][m][n], 0, 0, 0); __builtin_amdgcn_s_setprio(0); } while (0)
#define PG8_WAIT_V(n) asm volatile("s_waitcnt vmcnt(" #n ")" ::: "memory")
#define PG8_WAIT_L(n) asm volatile("s_waitcnt lgkmcnt(" #n ")" ::: "memory")
#define PG8_BAR __builtin_amdgcn_s_barrier()
#define PG8_SCHED __builtin_amdgcn_sched_barrier(0)
    Unit cur, nxt; int ui = 0;
    if (!S.next(0, cur)) return;
    f32x4 acc[2][2][4][2];
#pragma unroll
    for (int a = 0; a < 2; ++a)
#pragma unroll
        for (int b = 0; b < 2; ++b)
#pragma unroll
            for (int m = 0; m < 4; ++m)
#pragma unroll
                for (int n = 0; n < 2; ++n) acc[a][b][m][n] = (f32x4){0.f, 0.f, 0.f, 0.f};
    bf16x8 At[4][2], B0[2][2], B1[2][2];
    const char *cA, *cB0, *cB1; S.ptrs(cur, cA, cB0, cB1);
    int nt = S.nt(cur); asm volatile("" : "+s"(nt));
    PG8_STAGE(PG8_SB(0, 0), cB0, voffB); PG8_STAGE(PG8_SB(0, 1), cB1, voffB); PG8_STAGE(PG8_SA(0, 0), cA, voffA); PG8_STAGE(PG8_SA(0, 1), cA + hstepA, voffA);
    if (wr == 1) PG8_BAR;
    PG8_WAIT_V(2); PG8_BAR;
    PG8_STAGE(PG8_SB(1, 0), cB0 + kstep, voffB); PG8_STAGE(PG8_SA(1, 0), cA + kstep, voffA); PG8_STAGE(PG8_SB(1, 1), cB1 + kstep, voffB);
    PG8_WAIT_V(6); PG8_BAR;
    for (;;) {
        const bool has_next = S.next(ui + 1, nxt);
        const char *nA = cA, *nB0 = cB0, *nB1 = cB1; if (has_next) S.ptrs(nxt, nA, nB0, nB1);
#pragma unroll 1
        for (int t = 0; t < nt; t += 2) {
            const bool last = (t == nt - 2);
            if constexpr (Epi::HAS_MID) { if (t == E.mid_t) E.mid(acc, cur, wr, wc, fr, fq); }
            const char* a1 = cA + (size_t)(t + 1) * kstep;
            const char* a2 = last ? nA : cA + (size_t)(t + 2) * kstep; const char* b2 = last ? nB0 : cB0 + (size_t)(t + 2) * kstep; const char* b2h = last ? nB1 : cB1 + (size_t)(t + 2) * kstep;
            const char* a3 = a2 + kstep; const char* b3 = b2 + kstep; const char* b3h = b2h + kstep;
            PG8_LDB(B0, 0, 0); PG8_LDB(B1, 0, 1); PG8_SCHED; PG8_LDA(At, 0, 0); PG8_STAGE(PG8_SA(1, 1), a1 + hstepA, voffA);
            PG8_WAIT_V(8); PG8_WAIT_L(0); PG8_BAR; PG8_MMA(0, 0, At, B0); PG8_MMA(0, 1, At, B1); PG8_BAR; PG8_SCHED;
            PG8_LDA(At, 0, 1); PG8_STAGE(PG8_SB(0, 0), b2, voffB); PG8_STAGE(PG8_SB(0, 1), b2h, voffB); PG8_STAGE(PG8_SA(0, 0), a2, voffA);
            PG8_WAIT_V(8); PG8_WAIT_L(0); PG8_BAR; PG8_MMA(1, 0, At, B0); PG8_MMA(1, 1, At, B1); PG8_BAR; PG8_SCHED;
            PG8_LDB(B0, 1, 0); PG8_LDB(B1, 1, 1); PG8_SCHED; PG8_LDA(At, 1, 0); PG8_STAGE(PG8_SA(0, 1), a2 + hstepA, voffA);
            PG8_WAIT_V(8); PG8_WAIT_L(0); PG8_BAR; PG8_MMA(0, 0, At, B0); PG8_MMA(0, 1, At, B1); PG8_BAR; PG8_SCHED;
            PG8_LDA(At, 1, 1); PG8_STAGE(PG8_SB(1, 0), b3, voffB); PG8_STAGE(PG8_SB(1, 1), b3h, voffB); PG8_STAGE(PG8_SA(1, 0), a3, voffA);
            PG8_WAIT_V(8); PG8_WAIT_L(0); PG8_BAR; PG8_MMA(1, 0, At, B0); PG8_MMA(1, 1, At, B1); PG8_BAR; PG8_SCHED;
        }
        if constexpr (ALIGN_EPI) { if (wr == 0) PG8_BAR; }
        { unsigned long long te_ = 0; if (PROBE_A >= 500 && blockIdx.x == 0 && tid == 0) te_ = __builtin_amdgcn_s_memrealtime();
        E(acc, cur, wr, wc, fr, fq);
        if (PROBE_A >= 500 && blockIdx.x == 0 && tid == 0) { PG8_LAS unsigned long long* es_ = (PG8_LAS unsigned long long*)(lds + 147200) + 16 + pidx; *es_ += __builtin_amdgcn_s_memrealtime() - te_; } }
        if (!has_next) break;
#pragma unroll
        for (int a = 0; a < 2; ++a)
#pragma unroll
            for (int b = 0; b < 2; ++b)
#pragma unroll
                for (int m = 0; m < 4; ++m)
#pragma unroll
                    for (int n = 0; n < 2; ++n) acc[a][b][m][n] = (f32x4){0.f, 0.f, 0.f, 0.f};
        cur = nxt; cA = nA; cB0 = nB0; cB1 = nB1; ++ui; nt = S.nt(cur); asm volatile("" : "+s"(nt));
        if constexpr (ALIGN_EPI) { if (wr == 1) PG8_BAR; }
    }
    PG8_WAIT_V(0);
    if constexpr (!ALIGN_EPI) { if (wr == 0) PG8_BAR; }
    PG8_BAR;
#undef PG8_SA
#undef PG8_SB
#undef PG8_STAGE
#undef PG8_LDA
#undef PG8_LDB
#undef PG8_MMA
#undef PG8_WAIT_V
#undef PG8_WAIT_L
#undef PG8_BAR
#undef PG8_SCHED
}

template <class Epi, class Sched, bool ALIGN_EPI>
__device__ __forceinline__ void gemm_phase_gather(PG8_LAS unsigned char* lds, const Gemm g, const Sched& S, const Epi& E, int pidx = 0) {
    int tid_ = threadIdx.x; asm volatile("" : "+v"(tid_));
    const int tid = tid_, wid = __builtin_amdgcn_readfirstlane(tid >> 6), lane = tid & 63, wr = wid >> 2, wc = wid & 3, fr = lane & 15, fq = lane >> 4;
    unsigned voffB[2], vAc[2][2], vAn[2][2];
#pragma unroll
    for (int i = 0; i < 2; ++i) { int R, C; stage_rc(tid * 16 + i * 8192, R, C); const int Rb = Epi::PERM ? ((R & ~31) + perm32(R & 31)) : R;
        voffB[i] = (unsigned)(Rb * g.ldb + C) * 2u; }
#define PG8_LOADVA(v, ui_) do { _Pragma("unroll") for (int h_ = 0; h_ < 2; ++h_) _Pragma("unroll") for (int i_ = 0; i_ < 2; ++i_) { int R_, C_; stage_rc(tid * 16 + i_ * 8192, R_, C_); \
        v[h_][i_] = S.aoff(ui_, h_ * HALF + R_) + (unsigned)C_ * 2u; } } while (0)
    const size_t kstep = (size_t)(BK * 2);
    const unsigned ldsw = (unsigned)wid * 1024u;
    const int aoff = lds_byte(wr * 64 + fr, fq * 8), boff = lds_byte(wc * 32 + fr, fq * 8);
#define PG8_SA(b, h) (((b) * 2 + (h)) * HTB)
#define PG8_SB(b, h) ((4 + (b) * 2 + (h)) * HTB)
#define PG8_STAGE(bufoff, gbase, voff) do { _Pragma("unroll") for (int _i = 0; _i < 2; ++_i) \
        __builtin_amdgcn_global_load_lds((const unsigned*)((const char*)(gbase) + (voff)[_i]), (PG8_LAS unsigned*)(lds + (bufoff) + ldsw + _i * 8192), 16, 0, 0); } while (0)
#define PG8_LDA(dst, b, h) do { _Pragma("unroll") for (int m = 0; m < 4; ++m) _Pragma("unroll") for (int k = 0; k < 2; ++k) dst[m][k] = *(const PG8_LAS bf16x8*)(lds + PG8_SA(b, h) + aoff + m * 2048 + k * 1024); } while (0)
#define PG8_LDB(dst, b, h) do { _Pragma("unroll") for (int n = 0; n < 2; ++n) _Pragma("unroll") for (int k = 0; k < 2; ++k) dst[n][k] = *(const PG8_LAS bf16x8*)(lds + PG8_SB(b, h) + boff + n * 2048 + k * 1024); } while (0)
#define PG8_MMA(ai, bj, At, Bt) do { __builtin_amdgcn_s_setprio(1); _Pragma("unroll") for (int m = 0; m < 4; ++m) _Pragma("unroll") for (int n = 0; n < 2; ++n) _Pragma("unroll") for (int k = 0; k < 2; ++k) \
        acc[ai][bj][m][n] = __builtin_amdgcn_mfma_f32_16x16x32_bf16(Bt[n][k], At[m][k], acc[ai][bj][m][n], 0, 0, 0); __builtin_amdgcn_s_setprio(0); } while (0)
#define PG8_WAIT_V(n) asm volatile("s_waitcnt vmcnt(" #n ")" ::: "memory")
#define PG8_WAIT_L(n) asm volatile("s_waitcnt lgkmcnt(" #n ")" ::: "memory")
#define PG8_BAR __builtin_amdgcn_s_barrier()
#define PG8_SCHED __builtin_amdgcn_sched_barrier(0)
    Unit cur, nxt; int ui = 0;
    if (!S.next(0, cur)) return;
    f32x4 acc[2][2][4][2];
#pragma unroll
    for (int a = 0; a < 2; ++a)
#pragma unroll
        for (int b = 0; b < 2; ++b)
#pragma unroll
            for (int m = 0; m < 4; ++m)
#pragma unroll
                for (int n = 0; n < 2; ++n) acc[a][b][m][n] = (f32x4){0.f, 0.f, 0.f, 0.f};
    bf16x8 At[4][2], B0[2][2], B1[2][2];
    const char *cA, *cB0, *cB1; S.ptrs(cur, cA, cB0, cB1);
    PG8_LOADVA(vAc, 0);
    int nt = S.nt(cur); asm volatile("" : "+s"(nt));
    PG8_STAGE(PG8_SB(0, 0), cB0, voffB); PG8_STAGE(PG8_SB(0, 1), cB1, voffB); PG8_STAGE(PG8_SA(0, 0), cA, vAc[0]); PG8_STAGE(PG8_SA(0, 1), cA, vAc[1]);
    if (wr == 1) PG8_BAR;
    PG8_WAIT_V(2); PG8_BAR;
    PG8_STAGE(PG8_SB(1, 0), cB0 + kstep, voffB); PG8_STAGE(PG8_SA(1, 0), cA + kstep, vAc[0]); PG8_STAGE(PG8_SB(1, 1), cB1 + kstep, voffB);
    PG8_WAIT_V(6); PG8_BAR;
    for (;;) {
        const bool has_next = S.next(ui + 1, nxt);
        const char *nA = cA, *nB0 = cB0, *nB1 = cB1; if (has_next) { S.ptrs(nxt, nA, nB0, nB1); PG8_LOADVA(vAn, ui + 1); } else { _Pragma("unroll") for (int h_ = 0; h_ < 2; ++h_) _Pragma("unroll") for (int i_ = 0; i_ < 2; ++i_) vAn[h_][i_] = vAc[h_][i_]; }
#pragma unroll 1
        for (int t = 0; t < nt; t += 2) {
            const bool last = (t == nt - 2);
            if constexpr (Epi::HAS_MID) { if (t == E.mid_t) E.mid(acc, cur, wr, wc, fr, fq); }
            const char* a1 = cA + (size_t)(t + 1) * kstep;
            const char* a2 = cA + (size_t)(last ? 0 : t + 2) * kstep; unsigned vs0[2], vs1[2]; vs0[0] = last ? vAn[0][0] : vAc[0][0]; vs0[1] = last ? vAn[0][1] : vAc[0][1]; vs1[0] = last ? vAn[1][0] : vAc[1][0]; vs1[1] = last ? vAn[1][1] : vAc[1][1]; const char* b2 = last ? nB0 : cB0 + (size_t)(t + 2) * kstep; const char* b2h = last ? nB1 : cB1 + (size_t)(t + 2) * kstep;
            const char* a3 = a2 + kstep; const char* b3 = b2 + kstep; const char* b3h = b2h + kstep;
            PG8_LDB(B0, 0, 0); PG8_LDB(B1, 0, 1); PG8_SCHED; PG8_LDA(At, 0, 0); PG8_STAGE(PG8_SA(1, 1), a1, vAc[1]);
            PG8_WAIT_V(8); PG8_WAIT_L(0); PG8_BAR; PG8_MMA(0, 0, At, B0); PG8_MMA(0, 1, At, B1); PG8_BAR; PG8_SCHED;
            PG8_LDA(At, 0, 1); PG8_STAGE(PG8_SB(0, 0), b2, voffB); PG8_STAGE(PG8_SB(0, 1), b2h, voffB); PG8_STAGE(PG8_SA(0, 0), a2, vs0);
            PG8_WAIT_V(8); PG8_WAIT_L(0); PG8_BAR; PG8_MMA(1, 0, At, B0); PG8_MMA(1, 1, At, B1); PG8_BAR; PG8_SCHED;
            PG8_LDB(B0, 1, 0); PG8_LDB(B1, 1, 1); PG8_SCHED; PG8_LDA(At, 1, 0); PG8_STAGE(PG8_SA(0, 1), a2, vs1);
            PG8_WAIT_V(8); PG8_WAIT_L(0); PG8_BAR; PG8_MMA(0, 0, At, B0); PG8_MMA(0, 1, At, B1); PG8_BAR; PG8_SCHED;
            PG8_LDA(At, 1, 1); PG8_STAGE(PG8_SB(1, 0), b3, voffB); PG8_STAGE(PG8_SB(1, 1), b3h, voffB); PG8_STAGE(PG8_SA(1, 0), a3, vs0);
            PG8_WAIT_V(8); PG8_WAIT_L(0); PG8_BAR; PG8_MMA(1, 0, At, B0); PG8_MMA(1, 1, At, B1); PG8_BAR; PG8_SCHED;
        }
        if constexpr (ALIGN_EPI) { if (wr == 0) PG8_BAR; }
        { unsigned long long te_ = 0; if (PROBE_A >= 500 && blockIdx.x == 0 && tid == 0) te_ = __builtin_amdgcn_s_memrealtime();
        E(acc, cur, wr, wc, fr, fq);
        if (PROBE_A >= 500 && blockIdx.x == 0 && tid == 0) { PG8_LAS unsigned long long* es_ = (PG8_LAS unsigned long long*)(lds + 147200) + 16 + pidx; *es_ += __builtin_amdgcn_s_memrealtime() - te_; } }
        if (!has_next) break;
#pragma unroll
        for (int a = 0; a < 2; ++a)
#pragma unroll
            for (int b = 0; b < 2; ++b)
#pragma unroll
                for (int m = 0; m < 4; ++m)
#pragma unroll
                    for (int n = 0; n < 2; ++n) acc[a][b][m][n] = (f32x4){0.f, 0.f, 0.f, 0.f};
        cur = nxt; cA = nA; cB0 = nB0; cB1 = nB1; ++ui;
#pragma unroll
        for (int h_ = 0; h_ < 2; ++h_)
#pragma unroll
            for (int i_ = 0; i_ < 2; ++i_) vAc[h_][i_] = vAn[h_][i_]; nt = S.nt(cur); asm volatile("" : "+s"(nt));
        if constexpr (ALIGN_EPI) { if (wr == 1) PG8_BAR; }
    }
    PG8_WAIT_V(0);
    if constexpr (!ALIGN_EPI) { if (wr == 0) PG8_BAR; }
    PG8_BAR;
#undef PG8_LOADVA
#undef PG8_SA
#undef PG8_SB
#undef PG8_STAGE
#undef PG8_LDA
#undef PG8_LDB
#undef PG8_MMA
#undef PG8_WAIT_V
#undef PG8_WAIT_L
#undef PG8_BAR
#undef PG8_SCHED
}


__device__ __forceinline__ float rstd16(const float* p) { const f32x4 a = ((const f32x4*)p)[0], b = ((const f32x4*)p)[1], c = ((const f32x4*)p)[2], d = ((const f32x4*)p)[3];
    const float s = ((a.x + a.y) + (a.z + a.w)) + ((b.x + b.y) + (b.z + b.w)) + ((c.x + c.y) + (c.z + c.w)) + ((d.x + d.y) + (d.z + d.w)); return __builtin_amdgcn_rsqf(s * (1.f / D) + EPS); }
__device__ __forceinline__ u32x4 pack8(const f32x4 v0, const f32x4 v1) { u32x4 w; w.x = cvt_pk_bf16(v0[0], v0[1]); w.y = cvt_pk_bf16(v0[2], v0[3]); w.z = cvt_pk_bf16(v1[0], v1[1]); w.w = cvt_pk_bf16(v1[2], v1[3]); return w; }
__device__ __forceinline__ float sq8(const f32x4 a, const f32x4 b) { return ((a[0] * a[0] + a[1] * a[1]) + (a[2] * a[2] + a[3] * a[3])) + ((b[0] * b[0] + b[1] * b[1]) + (b[2] * b[2] + b[3] * b[3])); }

struct EpiInProjF {
    static constexpr bool PERM = true, HAS_MID = false; int mid_t;
    const float* rstd0; bf16_t *XR, *GG, *Qs, *Ks, *Vs; unsigned* kmax;
    __device__ __forceinline__ void mid(f32x4 (&)[2][2][4][2], const Unit&, int, int, int, int) const {}
    __device__ __forceinline__ void operator()(const f32x4 (&acc)[2][2][4][2], const Unit& u, int wr, int wc, int fr, int fq) const {
        const int row0 = u.pm * BM + wr * 64 + fr, t = u.pn >> 1, colt = (u.pn & 1) * 256 + wc * 32 + 8 * fq;
        bf16_t* base = (t == 0) ? XR : (t == 1) ? GG : (t == 2) ? Qs : (t == 3) ? Ks : Vs;
        float km0 = 0.f, km1 = 0.f;
#pragma unroll
        for (int ai = 0; ai < 2; ++ai)
#pragma unroll
            for (int m = 0; m < 4; ++m) { const int r = row0 + ai * HALF + m * 16; const float rs = rstd0[r]; bf16_t* rowp = base + (size_t)r * 512 + colt;
#pragma unroll
                for (int bj = 0; bj < 2; ++bj) { f32x4 v0 = acc[ai][bj][m][0] * rs, v1 = acc[ai][bj][m][1] * rs;
                    if (t == 1) {
#pragma unroll
                        for (int e = 0; e < 4; ++e) { v0[e] = gelu_tanh(v0[e]); v1[e] = gelu_tanh(v1[e]); } }
                    else if (t == 2) { v0 = v0 * (0.125f * LOG2E); v1 = v1 * (0.125f * LOG2E); }
                    else if (t == 3) { float mx = 0.f;
#pragma unroll
                        for (int e = 0; e < 4; ++e) mx = fmaxf(mx, fmaxf(fabsf(v0[e]), fabsf(v1[e])));
                        if (bj == 0) km0 = fmaxf(km0, mx); else km1 = fmaxf(km1, mx); }
                    *(u32x4*)(rowp + bj * HALF) = pack8(v0, v1); } }
        if (t == 3) {
#pragma unroll
            for (int o = 1; o < 64; o <<= 1) { km0 = fmaxf(km0, __shfl_xor(km0, o)); km1 = fmaxf(km1, __shfl_xor(km1, o)); }
            if ((fr | fq) == 0) { const int b = (u.pm * BM) / SEQ, hd = (u.pn & 1) * 4 + (wc >> 1);
                atomicMax(kmax + b * 8 + hd, __float_as_uint(km0)); atomicMax(kmax + b * 8 + hd + 2, __float_as_uint(km1)); }
        }
    }
};
struct EpiBf16F {
    static constexpr bool PERM = true, HAS_MID = false; int mid_t;
    bf16_t* O; const float* ssq16; int ldo; float scale; size_t tstride;
    __device__ __forceinline__ void mid(f32x4 (&)[2][2][4][2], const Unit&, int, int, int, int) const {}
    __device__ __forceinline__ void operator()(const f32x4 (&acc)[2][2][4][2], const Unit& u, int wr, int wc, int fr, int fq) const {
        const int row0 = u.pm * BM + wr * 64 + fr, col0 = (tstride ? 0 : u.pn * BM) + wc * 32 + 8 * fq; bf16_t* base = O + (size_t)u.pn * tstride;
#pragma unroll
        for (int ai = 0; ai < 2; ++ai)
#pragma unroll
            for (int m = 0; m < 4; ++m) { const int r = row0 + ai * HALF + m * 16; const float rs = (ssq16 ? rstd16(ssq16 + (size_t)r * 16) : 1.f) * scale; bf16_t* rowp = base + (size_t)r * ldo + col0;
#pragma unroll
                for (int bj = 0; bj < 2; ++bj) *(u32x4*)(rowp + bj * HALF) = pack8(acc[ai][bj][m][0] * rs, acc[ai][bj][m][1] * rs); }
    }
};
struct EpiX1F {
    static constexpr bool PERM = true, HAS_MID = true; int mid_t;
    const bf16_t* xb; const float* fmid; const float* fend; bf16_t* X1b; float* ssq1;
    __device__ __forceinline__ void mid(f32x4 (&acc)[2][2][4][2], const Unit& u, int wr, int wc, int fr, int fq) const {
        const int row0 = u.pm * BM + wr * 64 + fr;
#pragma unroll
        for (int ai = 0; ai < 2; ++ai)
#pragma unroll
            for (int m = 0; m < 4; ++m) { const float f = fmid[row0 + ai * HALF + m * 16];
#pragma unroll
                for (int bj = 0; bj < 2; ++bj) { acc[ai][bj][m][0] = acc[ai][bj][m][0] * f; acc[ai][bj][m][1] = acc[ai][bj][m][1] * f; } }
    }
    __device__ __forceinline__ void operator()(const f32x4 (&acc)[2][2][4][2], const Unit& u, int wr, int wc, int fr, int fq) const {
        const int row0 = u.pm * BM + wr * 64 + fr, col0 = u.pn * BM + wc * 32 + 8 * fq;
#pragma unroll
        for (int ai = 0; ai < 2; ++ai)
#pragma unroll
            for (int m = 0; m < 4; ++m) { const int r = row0 + ai * HALF + m * 16; const float fe = fend[r]; float ss = 0.f;
#pragma unroll
                for (int bj = 0; bj < 2; ++bj) { const u32x4 xi = *(const u32x4*)(xb + (size_t)r * D + col0 + bj * HALF);
                    f32x4 v0, v1; v0[0] = __uint_as_float(xi.x << 16); v0[1] = __uint_as_float(xi.x & 0xffff0000u); v0[2] = __uint_as_float(xi.y << 16); v0[3] = __uint_as_float(xi.y & 0xffff0000u);
                    v1[0] = __uint_as_float(xi.z << 16); v1[1] = __uint_as_float(xi.z & 0xffff0000u); v1[2] = __uint_as_float(xi.w << 16); v1[3] = __uint_as_float(xi.w & 0xffff0000u);
                    v0 = v0 + acc[ai][bj][m][0] * fe; v1 = v1 + acc[ai][bj][m][1] * fe;
                    ss += sq8(v0, v1); *(u32x4*)(X1b + (size_t)r * D + col0 + bj * HALF) = pack8(v0, v1); }
                ss += __shfl_xor(ss, 16); ss += __shfl_xor(ss, 32);
                if (fq == 0) ssq1[(size_t)r * 16 + u.pn * 4 + wc] = ss; }
    }
};
struct EpiResF {
    static constexpr bool PERM = true, HAS_MID = false; int mid_t;
    const bf16_t* Xi; bf16_t* Xo; float* ssq;
    __device__ __forceinline__ void mid(f32x4 (&)[2][2][4][2], const Unit&, int, int, int, int) const {}
    __device__ __forceinline__ void operator()(const f32x4 (&acc)[2][2][4][2], const Unit& u, int wr, int wc, int fr, int fq) const {
        const int row0 = u.pm * BM + wr * 64 + fr, col0 = u.pn * BM + wc * 32 + 8 * fq;
#pragma unroll
        for (int ai = 0; ai < 2; ++ai)
#pragma unroll
            for (int m = 0; m < 4; ++m) { const int r = row0 + ai * HALF + m * 16; float ss = 0.f;
#pragma unroll
                for (int bj = 0; bj < 2; ++bj) { const u32x4 xi = *(const u32x4*)(Xi + (size_t)r * D + col0 + bj * HALF);
                    f32x4 v0, v1; v0[0] = __uint_as_float(xi.x << 16); v0[1] = __uint_as_float(xi.x & 0xffff0000u); v0[2] = __uint_as_float(xi.y << 16); v0[3] = __uint_as_float(xi.y & 0xffff0000u);
                    v1[0] = __uint_as_float(xi.z << 16); v1[1] = __uint_as_float(xi.z & 0xffff0000u); v1[2] = __uint_as_float(xi.w << 16); v1[3] = __uint_as_float(xi.w & 0xffff0000u);
                    v0 = v0 + acc[ai][bj][m][0]; v1 = v1 + acc[ai][bj][m][1];
                    ss += sq8(v0, v1); *(u32x4*)(Xo + (size_t)r * D + col0 + bj * HALF) = pack8(v0, v1); }
                ss += __shfl_xor(ss, 16); ss += __shfl_xor(ss, 32);
                if (fq == 0) ssq[(size_t)r * 16 + u.pn * 4 + wc] = ss; }
    }
};

__device__ __forceinline__ void pair_ab(int p, int& a, int& b) { a = (p < 3) ? 0 : (p < 5) ? 1 : 2; b = (p < 3) ? p + 1 : (p < 5) ? p - 1 : 3; }
__device__ __forceinline__ int moe_class_of_tile(const PG8_LAS int* meta, int T) { int c = 0;
#pragma unroll
    for (int k = 1; k < 24; ++k) c += (T >= __builtin_amdgcn_readfirstlane(meta[64 + k])) ? 1 : 0;
    return c; }
struct MoeOrder1 {
    __device__ __forceinline__ int nt(const Unit&) const { return D / BK; }
    const bf16_t* XG; const bf16_t* Wg; const bf16_t* Wu; const PG8_LAS int* meta; int G, c;
    __device__ bool next(int i, Unit& u) const { const int L = i * G + c, nt = __builtin_amdgcn_readfirstlane(meta[64 + 24]); if (L >= nt * 4) return false;
        u.pm = L >> 2; u.pn = moe_class_of_tile(meta, L >> 2) * 4 + (L & 3); return true; }
    __device__ __forceinline__ void ptrs(const Unit& u, const char*& a, const char*& b0, const char*& b1) const {
        const int cls = u.pn >> 2, j = (u.pn >> 1) & 1, half = u.pn & 1; int ea, eb; pair_ab(cls % 6, ea, eb); const int e = (cls / 6) * 4 + (j ? eb : ea);
        a = (const char*)XG + (size_t)u.pm * BM * D * 2; const size_t bo = ((size_t)e * DE + half * HALF) * D * 2; b0 = (const char*)Wg + bo; b1 = (const char*)Wu + bo; }
};
struct MoeOrder2 {
    __device__ __forceinline__ int nt(const Unit&) const { return 512 / BK; }
    const bf16_t* HID; const bf16_t* Wd2; const PG8_LAS int* meta; int G, c;
    __device__ bool next(int i, Unit& u) const { const int L = i * G + c, nt = __builtin_amdgcn_readfirstlane(meta[64 + 24]); if (L >= nt * 4) return false;
        u.pm = L >> 2; u.pn = moe_class_of_tile(meta, L >> 2) * 4 + (L & 3); return true; }
    __device__ __forceinline__ void ptrs(const Unit& u, const char*& a, const char*& b0, const char*& b1) const {
        a = (const char*)HID + (size_t)u.pm * BM * 512 * 2; b0 = (const char*)Wd2 + ((size_t)(u.pn >> 2) * D + (u.pn & 3) * BM) * 512 * 2; b1 = b0 + (size_t)HALF * 512 * 2; }
};
struct EpiMoeUp {
    static constexpr bool PERM = true, HAS_MID = false; int mid_t;
    const float* rsg; const float* wAg; const float* wBg; bf16_t* HID;
    __device__ __forceinline__ void mid(f32x4 (&)[2][2][4][2], const Unit&, int, int, int, int) const {}
    __device__ __forceinline__ void operator()(const f32x4 (&acc)[2][2][4][2], const Unit& u, int wr, int wc, int fr, int fq) const {
        const int row0 = u.pm * BM + wr * 64 + fr, j = (u.pn >> 1) & 1, col0 = j * 256 + (u.pn & 1) * HALF + wc * 32 + 8 * fq; const float* wg = j ? wBg : wAg;
#pragma unroll
        for (int ai = 0; ai < 2; ++ai)
#pragma unroll
            for (int m = 0; m < 4; ++m) { const int r = row0 + ai * HALF + m * 16; const float rs = rsg[r], w = wg[r]; f32x4 h0, h1;
#pragma unroll
                for (int e = 0; e < 4; ++e) { const float g0 = acc[ai][0][m][0][e] * rs, g1 = acc[ai][0][m][1][e] * rs;
                    h0[e] = g0 * __builtin_amdgcn_rcpf(1.f + __expf(-g0)) * (acc[ai][1][m][0][e] * rs) * w; h1[e] = g1 * __builtin_amdgcn_rcpf(1.f + __expf(-g1)) * (acc[ai][1][m][1][e] * rs) * w; }
                *(u32x4*)(HID + (size_t)r * 512 + col0) = pack8(h0, h1); }
    }
};

struct MoeOrder1G {
    const bf16_t* X2b; const bf16_t* Wg; const bf16_t* Wu; const PG8_LAS int* meta; const PG8_LAS int* tokl; unsigned zoff; int G, c;
    __device__ __forceinline__ int nt(const Unit&) const { return D / BK; }
    __device__ bool next(int i, Unit& u) const { const int L = i * G + c, nt_ = __builtin_amdgcn_readfirstlane(meta[64 + 24]); if (L >= nt_ * 4) return false;
        u.pm = L >> 2; u.pn = (moe_class_of_tile(meta, L >> 2) * 4 + (L & 3)) | (i << 16); return true; }
    __device__ __forceinline__ unsigned aoff(int ui, int row) const { const int tok = tokl[ui * BM + row]; return tok >= 0 ? (unsigned)tok * (unsigned)(D * 2) : zoff; }
    __device__ __forceinline__ void ptrs(const Unit& u, const char*& a, const char*& b0, const char*& b1) const {
        const int pn = u.pn & 0xffff, cls = pn >> 2, j = (pn >> 1) & 1, half = pn & 1; int ea, eb; pair_ab(cls % 6, ea, eb); const int e = (cls / 6) * 4 + (j ? eb : ea);
        a = (const char*)X2b; const size_t bo = ((size_t)e * DE + half * HALF) * D * 2; b0 = (const char*)Wg + bo; b1 = (const char*)Wu + bo; }
};
struct EpiMoeUpG {
    static constexpr bool PERM = true, HAS_MID = false; int mid_t;
    const PG8_LAS int* tokl; const float* rstok; const float* selw; bf16_t* HID;
    __device__ __forceinline__ void mid(f32x4 (&)[2][2][4][2], const Unit&, int, int, int, int) const {}
    __device__ __forceinline__ void operator()(const f32x4 (&acc)[2][2][4][2], const Unit& u, int wr, int wc, int fr, int fq) const {
        const int pn = u.pn & 0xffff, ui = u.pn >> 16, j = (pn >> 1) & 1, col0 = j * 256 + (pn & 1) * HALF + wc * 32 + 8 * fq, rl0 = wr * 64 + fr;
#pragma unroll
        for (int ai = 0; ai < 2; ++ai)
#pragma unroll
            for (int m = 0; m < 4; ++m) { const int rl = rl0 + ai * HALF + m * 16, tok = tokl[ui * BM + rl]; float rs = 0.f, w = 0.f; if (tok >= 0) { rs = rstok[tok]; w = selw[(size_t)tok * 2 + j]; } f32x4 h0, h1;
#pragma unroll
                for (int e = 0; e < 4; ++e) { const float g0 = acc[ai][0][m][0][e] * rs, g1 = acc[ai][0][m][1][e] * rs;
                    h0[e] = g0 * __builtin_amdgcn_rcpf(1.f + __expf(-g0)) * (acc[ai][1][m][0][e] * rs) * w; h1[e] = g1 * __builtin_amdgcn_rcpf(1.f + __expf(-g1)) * (acc[ai][1][m][1][e] * rs) * w; }
                *(u32x4*)(HID + (size_t)(u.pm * BM + rl) * 512 + col0) = pack8(h0, h1); }
    }
};
struct EpiMoeDown {
    static constexpr bool PERM = true, HAS_MID = false; int mid_t;
    const int* tokg; const bf16_t* Xi; bf16_t* Xo; float* ssq;
    __device__ __forceinline__ void mid(f32x4 (&)[2][2][4][2], const Unit&, int, int, int, int) const {}
    __device__ __forceinline__ void operator()(const f32x4 (&acc)[2][2][4][2], const Unit& u, int wr, int wc, int fr, int fq) const {
        const int row0 = u.pm * BM + wr * 64 + fr, ct = u.pn & 3, col0 = ct * BM + wc * 32 + 8 * fq;
#pragma unroll
        for (int ai = 0; ai < 2; ++ai)
#pragma unroll
            for (int m = 0; m < 4; ++m) { const int tok = tokg[row0 + ai * HALF + m * 16];
                if (tok >= 0) { float ss = 0.f;
#pragma unroll
                    for (int bj = 0; bj < 2; ++bj) { const u32x4 xi = *(const u32x4*)(Xi + (size_t)tok * D + col0 + bj * HALF);
                        f32x4 v0, v1; v0[0] = __uint_as_float(xi.x << 16); v0[1] = __uint_as_float(xi.x & 0xffff0000u); v0[2] = __uint_as_float(xi.y << 16); v0[3] = __uint_as_float(xi.y & 0xffff0000u);
                        v1[0] = __uint_as_float(xi.z << 16); v1[1] = __uint_as_float(xi.z & 0xffff0000u); v1[2] = __uint_as_float(xi.w << 16); v1[3] = __uint_as_float(xi.w & 0xffff0000u);
                        v0 = v0 + acc[ai][bj][m][0]; v1 = v1 + acc[ai][bj][m][1];
                        ss += sq8(v0, v1); *(u32x4*)(Xo + (size_t)tok * D + col0 + bj * HALF) = pack8(v0, v1); }
                    ss += __shfl_xor(ss, 16); ss += __shfl_xor(ss, 32);
                    if (fq == 0) ssq[(size_t)tok * 16 + ct * 4 + wc] = ss; } }
    }
};

struct XaChainOrder {
    const bf16_t* X1b; const bf16_t* Wq_t; const bf16_t* QX; const bf16_t* KM; const bf16_t* VT; int G, c, nu;
    __device__ void init(int G_, int c_) { G = G_; c = c_; const int tot = (NTOK / BM) * XH; nu = (tot - c + G - 1) / G; }
    __device__ bool next(int i, Unit& u) const { if (i >= 3 * nu) return false; const int kind = i / nu, L = (i % nu) * G + c; u.pm = L >> 2; u.pn = (L & 3) | (kind << 8); return true; }
    __device__ __forceinline__ int nt(const Unit& u) const { return (u.pn >> 8) == 0 ? D / BK : XD / BK; }
    __device__ __forceinline__ void ptrs(const Unit& u, const char*& a, const char*& b0, const char*& b1) const {
        const int kind = u.pn >> 8, h = u.pn & 3, b = u.pm / (SEQ / BM);
        if (kind == 0) { a = (const char*)X1b + (size_t)u.pm * BM * D * 2; b0 = (const char*)Wq_t + (size_t)h * XD * D * 2; }
        else { a = (const char*)QX + ((size_t)u.pm * BM * D + h * XD) * 2;
            b0 = (kind == 1) ? (const char*)KM + ((size_t)b * MEM * D + h * XD) * 2 : (const char*)VT + ((size_t)b * D + h * XD) * D * 2; }
        b1 = b0 + (size_t)HALF * D * 2; }
};
struct EpiXaChain {
    static constexpr bool PERM = true, HAS_MID = false; int mid_t;
    bf16_t* QX; bf16_t* OX; const float* ssq1; float qscale; PG8_LAS float* xch;
    __device__ __forceinline__ void mid(f32x4 (&)[2][2][4][2], const Unit&, int, int, int, int) const {}
    __device__ __forceinline__ void operator()(f32x4 (&acc)[2][2][4][2], const Unit& u, int wr, int wc, int fr, int fq) const {
        const int kind = u.pn >> 8, row0 = u.pm * BM + wr * 64 + fr, col0 = (u.pn & 3) * XD + wc * 32 + 8 * fq;
        if (kind != 1) {
            bf16_t* O = kind == 0 ? QX : OX;
#pragma unroll
            for (int ai = 0; ai < 2; ++ai)
#pragma unroll
                for (int m = 0; m < 4; ++m) { const int r = row0 + ai * HALF + m * 16; const float rs = kind == 0 ? rstd16(ssq1 + (size_t)r * 16) * qscale : 1.f; bf16_t* rowp = O + (size_t)r * D + col0;
#pragma unroll
                    for (int bj = 0; bj < 2; ++bj) *(u32x4*)(rowp + bj * HALF) = pack8(acc[ai][bj][m][0] * rs, acc[ai][bj][m][1] * rs); }
            return;
        }
        PG8_LAS float* xm = xch; PG8_LAS float* xs = xch + 1024;
#pragma unroll
        for (int ai = 0; ai < 2; ++ai)
#pragma unroll
            for (int m = 0; m < 4; ++m) { float mx = -INFINITY;
#pragma unroll
                for (int bj = 0; bj < 2; ++bj)
#pragma unroll
                    for (int n = 0; n < 2; ++n) { const f32x4 v = acc[ai][bj][m][n]; mx = fmaxf(mx, fmaxf(fmaxf(v[0], v[1]), fmaxf(v[2], v[3]))); }
                mx = fmaxf(mx, __shfl_xor(mx, 16)); mx = fmaxf(mx, __shfl_xor(mx, 32));
                if (fq == 0) xm[(ai * HALF + wr * 64 + m * 16 + fr) * 4 + wc] = mx; asm volatile("" ::: "memory"); }
        asm volatile("s_waitcnt lgkmcnt(0)" ::: "memory"); __builtin_amdgcn_s_barrier(); asm volatile("" ::: "memory");
#pragma unroll
        for (int ai = 0; ai < 2; ++ai)
#pragma unroll
            for (int m = 0; m < 4; ++m) { const int rl = ai * HALF + wr * 64 + m * 16 + fr; const f32x4 q = *(const PG8_LAS f32x4*)(xm + rl * 4);
                const float mx = fmaxf(fmaxf(q[0], q[1]), fmaxf(q[2], q[3])); float ss = 0.f;
#pragma unroll
                for (int bj = 0; bj < 2; ++bj)
#pragma unroll
                    for (int n = 0; n < 2; ++n) { f32x4 v = acc[ai][bj][m][n];
#pragma unroll
                        for (int e = 0; e < 4; ++e) { v[e] = __builtin_amdgcn_exp2f(v[e] - mx); ss += v[e]; }
                        acc[ai][bj][m][n] = v; }
                ss += __shfl_xor(ss, 16); ss += __shfl_xor(ss, 32);
                if (fq == 0) xs[rl * 4 + wc] = ss; asm volatile("" ::: "memory"); }
        asm volatile("s_waitcnt lgkmcnt(0)" ::: "memory"); __builtin_amdgcn_s_barrier(); asm volatile("" ::: "memory");
#pragma unroll
        for (int ai = 0; ai < 2; ++ai)
#pragma unroll
            for (int m = 0; m < 4; ++m) { const int rl = ai * HALF + wr * 64 + m * 16 + fr; const f32x4 q = *(const PG8_LAS f32x4*)(xs + rl * 4);
                const float inv = __builtin_amdgcn_rcpf((q[0] + q[1]) + (q[2] + q[3])); bf16_t* rowp = QX + (size_t)(row0 + ai * HALF + m * 16) * D + col0;
#pragma unroll
                for (int bj = 0; bj < 2; ++bj) *(u32x4*)(rowp + bj * HALF) = pack8(acc[ai][bj][m][0] * inv, acc[ai][bj][m][1] * inv); asm volatile("" ::: "memory"); }
    }
};

struct XaPreOrder {
    const bf16_t* KM; const bf16_t* VM; const bf16_t* WqN; const bf16_t* Wo_t; int G, c;
    __device__ bool next(int i, Unit& u) const { const int L = i * G + c; if (L >= 256) return false; u.pm = 0; u.pn = L; return true; }
    __device__ __forceinline__ int nt(const Unit&) const { return XD / BK; }
    __device__ __forceinline__ void ptrs(const Unit& u, const char*& a, const char*& b0, const char*& b1) const {
        const int L = u.pn, h = L & 3;
        if (L < 128) { const int b = L >> 4, kt = (L >> 2) & 3; a = (const char*)KM + ((size_t)b * MEM * D + h * XD) * 2; b0 = (const char*)WqN + ((size_t)kt * BM * D + h * XD) * 2; }
        else { const int nt_ = (L >> 5) & 3, b = (L >> 2) & 7; a = (const char*)Wo_t + ((size_t)nt_ * BM * D + h * XD) * 2; b0 = (const char*)VM + ((size_t)b * MEM * D + h * XD) * 2; }
        b1 = b0 + (size_t)HALF * D * 2; }
};
struct EpiXaPre {
    static constexpr bool PERM = true, HAS_MID = false; int mid_t;
    bf16_t* MT; bf16_t* NT;
    __device__ __forceinline__ void mid(f32x4 (&)[2][2][4][2], const Unit&, int, int, int, int) const {}
    __device__ __forceinline__ void operator()(const f32x4 (&acc)[2][2][4][2], const Unit& u, int wr, int wc, int fr, int fq) const {
        const int L = u.pn, h = L & 3, cw = wc * 32 + 8 * fq; bf16_t* base;
        if (L < 128) { const int b = L >> 4, kt = (L >> 2) & 3; base = MT + ((size_t)b * D + h * XD) * D + kt * BM; }
        else { const int nt_ = (L >> 5) & 3, b = (L >> 2) & 7; base = NT + ((size_t)b * D + nt_ * BM) * D + h * XD; }
#pragma unroll
        for (int ai = 0; ai < 2; ++ai)
#pragma unroll
            for (int m = 0; m < 4; ++m) { bf16_t* rowp = base + (size_t)(ai * HALF + wr * 64 + m * 16 + fr) * D + cw;
#pragma unroll
                for (int bj = 0; bj < 2; ++bj) *(u32x4*)(rowp + bj * HALF) = pack8(acc[ai][bj][m][0], acc[ai][bj][m][1]); }
    }
};
struct BatchedOrder {
    const bf16_t* A; const bf16_t* W; int G, c;
    __device__ bool next(int i, Unit& u) const { const int L = i * G + c; if (L >= (NTOK / BM) * 4) return false; u.pm = L >> 2; u.pn = L & 3; return true; }
    __device__ __forceinline__ int nt(const Unit&) const { return D / BK; }
    __device__ __forceinline__ void ptrs(const Unit& u, const char*& a, const char*& b0, const char*& b1) const {
        const int b = u.pm / (SEQ / BM); a = (const char*)A + (size_t)u.pm * BM * D * 2; b0 = (const char*)W + ((size_t)b * D + u.pn * BM) * D * 2; b1 = b0 + (size_t)HALF * D * 2; }
};
struct EpiXaSoftmax {
    static constexpr bool PERM = true, HAS_MID = false; int mid_t;
    bf16_t* P; const float* ssq1; float qscale; PG8_LAS float* xch;
    __device__ __forceinline__ void mid(f32x4 (&)[2][2][4][2], const Unit&, int, int, int, int) const {}
    __device__ __forceinline__ void operator()(f32x4 (&acc)[2][2][4][2], const Unit& u, int wr, int wc, int fr, int fq) const {
        const int row0 = u.pm * BM + wr * 64 + fr, col0 = u.pn * XD + wc * 32 + 8 * fq;
        PG8_LAS float* xm = xch; PG8_LAS float* xs = xch + 1024;
#pragma unroll
        for (int ai = 0; ai < 2; ++ai)
#pragma unroll
            for (int m = 0; m < 4; ++m) { const float rs = rstd16(ssq1 + (size_t)(row0 + ai * HALF + m * 16) * 16) * qscale; float mx = -INFINITY;
#pragma unroll
                for (int bj = 0; bj < 2; ++bj)
#pragma unroll
                    for (int n = 0; n < 2; ++n) { const f32x4 v = acc[ai][bj][m][n] * rs; acc[ai][bj][m][n] = v; mx = fmaxf(mx, fmaxf(fmaxf(v[0], v[1]), fmaxf(v[2], v[3]))); }
                mx = fmaxf(mx, __shfl_xor(mx, 16)); mx = fmaxf(mx, __shfl_xor(mx, 32));
                if (fq == 0) xm[(ai * HALF + wr * 64 + m * 16 + fr) * 4 + wc] = mx; asm volatile("" ::: "memory"); }
        asm volatile("s_waitcnt lgkmcnt(0)" ::: "memory"); __builtin_amdgcn_s_barrier(); asm volatile("" ::: "memory");
#pragma unroll
        for (int ai = 0; ai < 2; ++ai)
#pragma unroll
            for (int m = 0; m < 4; ++m) { const int rl = ai * HALF + wr * 64 + m * 16 + fr; const f32x4 q = *(const PG8_LAS f32x4*)(xm + rl * 4);
                const float mx = fmaxf(fmaxf(q[0], q[1]), fmaxf(q[2], q[3])); float ss = 0.f;
#pragma unroll
                for (int bj = 0; bj < 2; ++bj)
#pragma unroll
                    for (int n = 0; n < 2; ++n) { f32x4 v = acc[ai][bj][m][n];
#pragma unroll
                        for (int e = 0; e < 4; ++e) { v[e] = __builtin_amdgcn_exp2f(v[e] - mx); ss += v[e]; }
                        acc[ai][bj][m][n] = v; }
                ss += __shfl_xor(ss, 16); ss += __shfl_xor(ss, 32);
                if (fq == 0) xs[rl * 4 + wc] = ss; asm volatile("" ::: "memory"); }
        asm volatile("s_waitcnt lgkmcnt(0)" ::: "memory"); __builtin_amdgcn_s_barrier(); asm volatile("" ::: "memory");
#pragma unroll
        for (int ai = 0; ai < 2; ++ai)
#pragma unroll
            for (int m = 0; m < 4; ++m) { const int rl = ai * HALF + wr * 64 + m * 16 + fr; const f32x4 q = *(const PG8_LAS f32x4*)(xs + rl * 4);
                const float inv = __builtin_amdgcn_rcpf((q[0] + q[1]) + (q[2] + q[3])); bf16_t* rowp = P + (size_t)(row0 + ai * HALF + m * 16) * D + col0;
#pragma unroll
                for (int bj = 0; bj < 2; ++bj) *(u32x4*)(rowp + bj * HALF) = pack8(acc[ai][bj][m][0] * inv, acc[ai][bj][m][1] * inv); asm volatile("" ::: "memory"); }
    }
};

struct EpiKvN {
    static constexpr bool PERM = true, HAS_MID = false; int mid_t;
    bf16_t* KM; bf16_t* VM;
    __device__ __forceinline__ void mid(f32x4 (&)[2][2][4][2], const Unit&, int, int, int, int) const {}
    __device__ __forceinline__ void operator()(const f32x4 (&acc)[2][2][4][2], const Unit& u, int wr, int wc, int fr, int fq) const {
        bf16_t* base = (u.pn < 4 ? KM : VM) + (u.pn & 3) * BM + wc * 32 + 8 * fq; const int row0 = u.pm * BM + wr * 64 + fr;
#pragma unroll
        for (int ai = 0; ai < 2; ++ai)
#pragma unroll
            for (int m = 0; m < 4; ++m) { bf16_t* rowp = base + (size_t)(row0 + ai * HALF + m * 16) * D;
#pragma unroll
                for (int bj = 0; bj < 2; ++bj) *(u32x4*)(rowp + bj * HALF) = pack8(acc[ai][bj][m][0], acc[ai][bj][m][1]); }
    }
};
struct KvOrder {
    __device__ __forceinline__ int nt(const Unit&) const { return D / BK; }
    const bf16_t* memn; const bf16_t* Wk_t; const bf16_t* Wv_t; int G, c;
    __device__ bool next(int i, Unit& u) const { const int L = i * G + c; if (L >= 64) return false; if (L < 32) { u.pm = L >> 2; u.pn = L & 3; } else { u.pm = (L - 32) >> 3; u.pn = ((L - 32) & 7) | 256; } return true; }
    __device__ __forceinline__ void ptrs(const Unit& u, const char*& a, const char*& b0, const char*& b1) const {
        const bool vt = (u.pn & 256) != 0; const int pn = u.pn & 255;
        a = (const char*)(vt ? Wv_t : memn) + (size_t)u.pm * BM * D * 2; b0 = (const char*)(vt ? memn : Wk_t) + (size_t)pn * BM * D * 2; b1 = b0 + (size_t)HALF * D * 2; }
};
struct EpiKv {
    static constexpr bool PERM = true, HAS_MID = false; int mid_t;
    bf16_t* KM; bf16_t* VT;
    __device__ __forceinline__ void mid(f32x4 (&)[2][2][4][2], const Unit&, int, int, int, int) const {}
    __device__ __forceinline__ void operator()(const f32x4 (&acc)[2][2][4][2], const Unit& u, int wr, int wc, int fr, int fq) const {
        const bool vt = (u.pn & 256) != 0; const int pn = u.pn & 255, row0 = u.pm * BM + wr * 64 + fr, cw = wc * 32 + 8 * fq;
        bf16_t* base = vt ? VT + (size_t)pn * D * D : KM + pn * BM; const int ldo = D;
#pragma unroll
        for (int ai = 0; ai < 2; ++ai)
#pragma unroll
            for (int m = 0; m < 4; ++m) { bf16_t* rowp = base + (size_t)(row0 + ai * HALF + m * 16) * ldo + cw;
#pragma unroll
                for (int bj = 0; bj < 2; ++bj) *(u32x4*)(rowp + bj * HALF) = pack8(acc[ai][bj][m][0], acc[ai][bj][m][1]); }
    }
};

struct EpiMoeFinal {
    static constexpr bool PERM = true, HAS_MID = false; int mid_t;
    const int* tokg; const bf16_t* Xi; float* out; float* ssq; unsigned* cnt; const float* g; PG8_LAS unsigned* flag; unsigned* tmo;
    __device__ __forceinline__ void mid(f32x4 (&)[2][2][4][2], const Unit&, int, int, int, int) const {}
    __device__ __forceinline__ void operator()(f32x4 (&acc)[2][2][4][2], const Unit& u, int wr, int wc, int fr, int fq) const {
        const int row0 = u.pm * BM + wr * 64 + fr, ct = u.pn & 3, col0 = ct * BM + wc * 32 + 8 * fq;
#pragma unroll
        for (int ai = 0; ai < 2; ++ai)
#pragma unroll
            for (int m = 0; m < 4; ++m) { const int tok = tokg[row0 + ai * HALF + m * 16];
                if (tok >= 0) { float ss = 0.f;
#pragma unroll
                    for (int bj = 0; bj < 2; ++bj) { const u32x4 xi = *(const u32x4*)(Xi + (size_t)tok * D + col0 + bj * HALF);
                        f32x4 v0, v1; v0[0] = __uint_as_float(xi.x << 16); v0[1] = __uint_as_float(xi.x & 0xffff0000u); v0[2] = __uint_as_float(xi.y << 16); v0[3] = __uint_as_float(xi.y & 0xffff0000u);
                        v1[0] = __uint_as_float(xi.z << 16); v1[1] = __uint_as_float(xi.z & 0xffff0000u); v1[2] = __uint_as_float(xi.w << 16); v1[3] = __uint_as_float(xi.w & 0xffff0000u);
                        v0 = v0 + acc[ai][bj][m][0]; v1 = v1 + acc[ai][bj][m][1]; acc[ai][bj][m][0] = v0; acc[ai][bj][m][1] = v1; ss += sq8(v0, v1); }
                    ss += __shfl_xor(ss, 16); ss += __shfl_xor(ss, 32);
                    if (fq == 0) __hip_atomic_store(ssq + (size_t)tok * 16 + ct * 4 + wc, ss, __ATOMIC_RELAXED, __HIP_MEMORY_SCOPE_AGENT); }
                asm volatile("" ::: "memory"); }
        asm volatile("s_waitcnt vmcnt(0) lgkmcnt(0)" ::: "memory"); __builtin_amdgcn_s_barrier(); asm volatile("" ::: "memory");
        const int tid = threadIdx.x;
        if (tid < 64) {
            if (tid == 0) __hip_atomic_fetch_add(cnt + 16 * u.pm, 1u, __ATOMIC_RELAXED, __HIP_MEMORY_SCOPE_AGENT);
            unsigned spins = 0; bool dead = false;
            while ((unsigned)__builtin_amdgcn_readfirstlane(__hip_atomic_load(cnt + 16 * u.pm, __ATOMIC_RELAXED, __HIP_MEMORY_SCOPE_AGENT)) < 4u) {
                __builtin_amdgcn_s_sleep(2); if (++spins > (1u << 20)) { dead = true; break; } }
            __builtin_amdgcn_fence(__ATOMIC_ACQUIRE, "agent");
            if (tid == 0) { flag[0] = dead ? 1u : 0u; if (dead) __hip_atomic_store(tmo, 1u, __ATOMIC_RELAXED, __HIP_MEMORY_SCOPE_AGENT); }
        }
        asm volatile("s_waitcnt vmcnt(0) lgkmcnt(0)" ::: "memory"); __builtin_amdgcn_s_barrier(); asm volatile("" ::: "memory");
        f32x4 gv[2][2];
#pragma unroll
        for (int bj = 0; bj < 2; ++bj) { gv[bj][0] = *(const f32x4*)(g + col0 + bj * HALF); gv[bj][1] = *(const f32x4*)(g + col0 + bj * HALF + 4); }
#pragma unroll
        for (int ai = 0; ai < 2; ++ai)
#pragma unroll
            for (int m = 0; m < 4; ++m) { const int tok = tokg[row0 + ai * HALF + m * 16];
                if (tok >= 0) { const float rs = rstd16(ssq + (size_t)tok * 16); float* orow = out + (size_t)tok * D + col0;
#pragma unroll
                    for (int bj = 0; bj < 2; ++bj) { *(f32x4*)(orow + bj * HALF) = acc[ai][bj][m][0] * rs * gv[bj][0]; *(f32x4*)(orow + bj * HALF + 4) = acc[ai][bj][m][1] * rs * gv[bj][1]; } }
                asm volatile("" ::: "memory"); }
    }
};
}
namespace sba {
typedef float f32x16 __attribute__((ext_vector_type(16)));
typedef short s16x4 __attribute__((ext_vector_type(4)));
typedef short v4i16_t __attribute__((ext_vector_type(4)));
typedef __attribute__((address_space(3))) const char* lds_cptr;
constexpr int SLOTB = 8192, L_K = 0, L_V = 2 * SLOTB, L_FLAG = 4 * SLOTB, L_OST = L_FLAG + 256, L_BYTES = L_OST + 8 * 4096;
__device__ __forceinline__ int crow(int r, int hi) { return (r & 3) + 8 * (r >> 2) + 4 * hi; }
__device__ __forceinline__ void glds16(const void* gsrc, unsigned lds_dst) { unsigned keep;
    asm volatile("s_mov_b32 %0, m0\n\ts_mov_b32 m0, %2\n\ts_nop 0\n\tglobal_load_lds_dwordx4 %1, off\n\ts_mov_b32 m0, %0" : "=&s"(keep) : "v"(gsrc), "s"(lds_dst) : "memory"); }
typedef float f32x2_t __attribute__((ext_vector_type(2))); typedef __bf16 bf16x2_t __attribute__((ext_vector_type(2)));
__device__ __forceinline__ unsigned cvtpk(float lo, float hi) { f32x2_t v = {lo, hi}; bf16x2_t b = __builtin_convertvector(v, bf16x2_t); return __builtin_bit_cast(unsigned, b); }
__device__ __forceinline__ s16x4 vtr(lds_cptr p) { return __builtin_bit_cast(s16x4, __builtin_amdgcn_ds_read_tr16_b64_v4i16((__attribute__((address_space(3))) v4i16_t*)p)); }

#define SBA_GROUP(Z, OM, g) do { \
        float d_ = acc_ * (hi ? 1.f : gp_##OM[g]); acc_ *= gs_##OM[g] * gp_##OM[g]; \
        Z[4 * (g) + 3] *= d_; d_ *= OM[4 * (g) + 3]; Z[4 * (g) + 2] *= d_; d_ *= OM[4 * (g) + 2]; Z[4 * (g) + 1] *= d_; d_ *= OM[4 * (g) + 1]; Z[4 * (g)] *= d_; } while (0)

__device__ __forceinline__ void sb_unit(int b, int h, int qb, const bf16_t* Qs, const bf16_t* Ks, const bf16_t* Vs, bf16_t* YY, float* ssq_s8, char* shm) {
    int tid_ = threadIdx.x; asm volatile("" : "+v"(tid_));
    const int tid = tid_, lane = tid & 63, r32 = lane & 31, hi = lane >> 5; const int wid = __builtin_amdgcn_readfirstlane(tid >> 6);
#define SSTAMP(k) do { if (PROBE_A >= 300 && blockIdx.x == 60 && b == 0 && tid == 0) ((__attribute__((address_space(3))) unsigned long long*)(shm + 147200))[16 + (k)] = __builtin_amdgcn_s_memrealtime(); } while (0)
    SSTAMP(0);
    const size_t rowbase = (size_t)b * SEQ; const int q0 = qb * 256;
    const bf16_t* Kh = Ks + rowbase * SBW + h * HD; const bf16_t* Vh = Vs + rowbase * SBW + h * HD;
    const unsigned lds0 = (unsigned)(uintptr_t)shm;
    const lds_cptr shm3 = (lds_cptr)shm;
    const bf16_t* ksrc = Kh + (size_t)lane * SBW + wid * 8;
    const bf16_t* vsrc = Vh + (size_t)(16 * (wid & 3) + (lane >> 2)) * SBW + (wid >> 2) * 32 + (lane & 3) * 8;
    const unsigned kdst = lds0 + L_K + wid * 1024, vdst = lds0 + L_V + wid * 1024;
#define DMA_KV(t, slot) do { glds16(ksrc + (size_t)(t) * 64 * SBW, (unsigned)__builtin_amdgcn_readfirstlane(kdst + (slot))); glds16(vsrc + (size_t)(t) * 64 * SBW, (unsigned)__builtin_amdgcn_readfirstlane(vdst + (slot))); } while (0)
    const lds_cptr kp0 = shm3 + L_K + hi * 1024 + r32 * 16;
    const lds_cptr vp0 = shm3 + L_V + ((lane >> 4) & 1) * 32 + (lane & 3) * 8 + (4 * hi + ((lane & 15) >> 2)) * 64;
    volatile __attribute__((address_space(3))) unsigned* flags = (volatile __attribute__((address_space(3))) unsigned*)(shm3 + L_FLAG);
    int tile = 4 * qb + 3, slot = 0, it = 0;
    DMA_KV(tile, 0);
    const bf16_t* Qw = Qs + (rowbase + q0 + wid * 32 + r32) * SBW + h * HD;
    bf16x8 qr[4];
#pragma unroll
    for (int d0 = 0; d0 < 4; ++d0) qr[d0] = *(const bf16x8*)(Qw + d0 * 16 + hi * 8);
    float qn = 0.f;
#pragma unroll
    for (int d0 = 0; d0 < 4; ++d0)
#pragma unroll
        for (int e = 0; e < 8; ++e) qn += fabsf(bf2f((unsigned short)qr[d0][e]));
    qn += __shfl_xor(qn, 32);
    const int tq = q0 + wid * 32 + r32;
    const int tq_min = q0 + wid * 32, tq_max = tq_min + 31;
    float PR = 1.f;
    f32x16 o0 = {}, o1 = {};
    for (;;) {
        if (it < 4) SSTAMP(1 + it);
        const bool has_next = tile > 0;
        if (has_next) { DMA_KV(tile - 1, slot ^ SLOTB); asm volatile("s_waitcnt vmcnt(2)" ::: "memory"); }
        else asm volatile("s_waitcnt vmcnt(0)" ::: "memory");
        __builtin_amdgcn_s_barrier(); asm volatile("" ::: "memory");
        const int kmin = tile * 64;
        if (kmin < tq_max) {
            f32x16 z0, z1;
            {
                const lds_cptr kb = kp0 + slot; bf16x8 kf[8];
#pragma unroll
                for (int d0 = 0; d0 < 4; ++d0) { kf[2 * d0] = *(const __attribute__((address_space(3))) bf16x8*)(kb + d0 * 2048); kf[2 * d0 + 1] = *(const __attribute__((address_space(3))) bf16x8*)(kb + d0 * 2048 + 512); }
                __builtin_amdgcn_sched_barrier(0);
                z0 = __builtin_amdgcn_mfma_f32_32x32x16_bf16(kf[0], qr[0], (f32x16){}, 0, 0, 0); z1 = __builtin_amdgcn_mfma_f32_32x32x16_bf16(kf[1], qr[0], (f32x16){}, 0, 0, 0);
#pragma unroll
                for (int d0 = 1; d0 < 4; ++d0) { z0 = __builtin_amdgcn_mfma_f32_32x32x16_bf16(kf[2 * d0], qr[d0], z0, 0, 0, 0); z1 = __builtin_amdgcn_mfma_f32_32x32x16_bf16(kf[2 * d0 + 1], qr[d0], z1, 0, 0, 0); }
            }
            if (kmin + 63 >= tq_min) {
#pragma unroll
                for (int r = 0; r < 16; ++r) { const int kv = kmin + crow(r, hi); if (kv >= tq) z0[r] = -INFINITY; if (kv + 32 >= tq) z1[r] = -INFINITY; }
            }
            f32x16 m0, m1;
#pragma unroll
            for (int r = 0; r < 16; ++r) { const float e0 = __builtin_amdgcn_exp2f(fminf(z0[r], 120.f)), e1 = __builtin_amdgcn_exp2f(fminf(z1[r], 120.f));
                m0[r] = __builtin_amdgcn_rcpf(1.f + e0); m1[r] = __builtin_amdgcn_rcpf(1.f + e1); z0[r] = e0 * m0[r]; z1[r] = e1 * m1[r]; }
            float gs_m0[4], gs_m1[4], gp_m0[4], gp_m1[4];
#pragma unroll
            for (int g = 0; g < 4; ++g) { gs_m0[g] = (m0[4 * g] * m0[4 * g + 1]) * (m0[4 * g + 2] * m0[4 * g + 3]); gs_m1[g] = (m1[4 * g] * m1[4 * g + 1]) * (m1[4 * g + 2] * m1[4 * g + 3]); }
#pragma unroll
            for (int g = 0; g < 4; ++g) { const auto r0 = __builtin_amdgcn_permlane32_swap(__float_as_uint(gs_m0[g]), __float_as_uint(gs_m0[g]), false, false), r1 = __builtin_amdgcn_permlane32_swap(__float_as_uint(gs_m1[g]), __float_as_uint(gs_m1[g]), false, false);
                gp_m0[g] = __uint_as_float(hi ? r0[0] : r0[1]); gp_m1[g] = __uint_as_float(hi ? r1[0] : r1[1]); }
            float acc_ = PR;
            SBA_GROUP(z1, m1, 3); SBA_GROUP(z1, m1, 2); SBA_GROUP(z1, m1, 1); SBA_GROUP(z1, m1, 0);
            SBA_GROUP(z0, m0, 3); SBA_GROUP(z0, m0, 2); SBA_GROUP(z0, m0, 1); SBA_GROUP(z0, m0, 0);
            PR = acc_;
            u32x4 pw0, pw1, pw2, pw3;
            pw0 = (u32x4){cvtpk(z0[0], z0[1]), cvtpk(z0[2], z0[3]), cvtpk(z0[4], z0[5]), cvtpk(z0[6], z0[7])};
            pw1 = (u32x4){cvtpk(z0[8], z0[9]), cvtpk(z0[10], z0[11]), cvtpk(z0[12], z0[13]), cvtpk(z0[14], z0[15])};
            pw2 = (u32x4){cvtpk(z1[0], z1[1]), cvtpk(z1[2], z1[3]), cvtpk(z1[4], z1[5]), cvtpk(z1[6], z1[7])};
            pw3 = (u32x4){cvtpk(z1[8], z1[9]), cvtpk(z1[10], z1[11]), cvtpk(z1[12], z1[13]), cvtpk(z1[14], z1[15])};
            const lds_cptr vp = vp0 + slot;
#define SBA_VF(i) (bf16x8){vl[i][0], vl[i][1], vl[i][2], vl[i][3], vh[i][0], vh[i][1], vh[i][2], vh[i][3]}
            { s16x4 vl[4], vh[4];
#pragma unroll
                for (int i = 0; i < 4; ++i) { vl[i] = vtr(vp + i * 1024); vh[i] = vtr(vp + i * 1024 + 512); }
                __builtin_amdgcn_sched_barrier(0);
                o0 = __builtin_amdgcn_mfma_f32_32x32x16_bf16(__builtin_bit_cast(bf16x8, pw0), SBA_VF(0), o0, 0, 0, 0); o0 = __builtin_amdgcn_mfma_f32_32x32x16_bf16(__builtin_bit_cast(bf16x8, pw1), SBA_VF(1), o0, 0, 0, 0);
                o0 = __builtin_amdgcn_mfma_f32_32x32x16_bf16(__builtin_bit_cast(bf16x8, pw2), SBA_VF(2), o0, 0, 0, 0); o0 = __builtin_amdgcn_mfma_f32_32x32x16_bf16(__builtin_bit_cast(bf16x8, pw3), SBA_VF(3), o0, 0, 0, 0); }
            { s16x4 vl[4], vh[4];
#pragma unroll
                for (int i = 0; i < 4; ++i) { vl[i] = vtr(vp + 4096 + i * 1024); vh[i] = vtr(vp + 4096 + i * 1024 + 512); }
                __builtin_amdgcn_sched_barrier(0);
                o1 = __builtin_amdgcn_mfma_f32_32x32x16_bf16(__builtin_bit_cast(bf16x8, pw0), SBA_VF(0), o1, 0, 0, 0); o1 = __builtin_amdgcn_mfma_f32_32x32x16_bf16(__builtin_bit_cast(bf16x8, pw1), SBA_VF(1), o1, 0, 0, 0);
                o1 = __builtin_amdgcn_mfma_f32_32x32x16_bf16(__builtin_bit_cast(bf16x8, pw2), SBA_VF(2), o1, 0, 0, 0); o1 = __builtin_amdgcn_mfma_f32_32x32x16_bf16(__builtin_bit_cast(bf16x8, pw3), SBA_VF(3), o1, 0, 0, 0); }
#undef SBA_VF
        }
        const bool done = __all(PR == 0.f);
        if (lane == 0) flags[(it & 1) * 8 + wid] = done ? 1u : 0u;
        asm volatile("s_waitcnt lgkmcnt(0)" ::: "memory"); __builtin_amdgcn_s_barrier(); asm volatile("" ::: "memory");
        unsigned alld = 1u;
#pragma unroll
        for (int w = 0; w < 8; ++w) alld &= flags[(it & 1) * 8 + w];
        alld = __builtin_amdgcn_readfirstlane(alld);
        if (!has_next || alld) break;
        --tile; slot ^= SLOTB; ++it;
    }
    SSTAMP(5);
    if (PROBE_A >= 300 && blockIdx.x == 60 && b == 0 && tid == 0) { __attribute__((address_space(3))) unsigned long long* st_ = (__attribute__((address_space(3))) unsigned long long*)(shm + 147200) + 16; st_[8] = 0; st_[9] = (unsigned long long)(it + 1) * 100ull; }
    asm volatile("s_waitcnt vmcnt(0)" ::: "memory");
    {
        bf16_t* Ow = YY + (rowbase + q0 + wid * 32) * D + RW + h * HD;
        bf16_t* stg = (bf16_t*)(shm + L_OST) + wid * 2048;
#pragma unroll
        for (int r = 0; r < 16; ++r) { const int orow = crow(r, hi); stg[orow * 64 + r32] = (bf16_t)f2bf(o0[r]); stg[orow * 64 + 32 + r32] = (bf16_t)f2bf(o1[r]); }
        asm volatile("s_waitcnt lgkmcnt(0)" ::: "memory");
#pragma unroll
        for (int i = 0; i < 4; ++i) { const int row = i * 8 + (lane >> 3), ch = lane & 7; const u32x4 v = *(const u32x4*)(stg + row * 64 + ch * 8);
            *(u32x4*)(Ow + (size_t)row * D + ch * 8) = v;
            float ss = 0.f;
#pragma unroll
            for (int e = 0; e < 4; ++e) { const float lo = __uint_as_float(v[e] << 16), hh = __uint_as_float(v[e] & 0xffff0000u); ss += lo * lo + hh * hh; }
            ss += __shfl_xor(ss, 1); ss += __shfl_xor(ss, 2); ss += __shfl_xor(ss, 4);
            if (ch == 0) ssq_s8[(rowbase + q0 + wid * 32 + row) * 8 + h] = ss; }
    }
    asm volatile("s_waitcnt lgkmcnt(0)" ::: "memory"); __builtin_amdgcn_s_barrier(); asm volatile("" ::: "memory");
    SSTAMP(6);
#undef SSTAMP
#undef DMA_KV
}
#undef SBA_GROUP
}
namespace lru {
typedef float f32x16 __attribute__((ext_vector_type(16)));
constexpr int XS_ROWS = 67, XS_BYTES = XS_ROWS * 1024  , XC_PITCH = 1040  , XC_OFF = 68608, HC_OFF = XC_OFF + 64 * XC_PITCH  , L_BYTES = HC_OFF + 2048;
__device__ __forceinline__ int crow(int r, int hi) { return (r & 3) + 8 * (r >> 2) + 4 * hi; }

struct Weights { bf16x8 wa[2][4], wx[2][4]; float ba[2], bx[2], spl[2]; };
__device__ __forceinline__ void load_weights(Weights& W, int h, int r32, int hi, const float* w_a, const float* b_a, const float* w_x, const float* b_x, const float* lam) {
#pragma unroll
    for (int nt = 0; nt < 2; ++nt) {
#pragma unroll
        for (int s = 0; s < 4; ++s) {
#pragma unroll
            for (int e = 0; e < 8; ++e) { const size_t idx = ((size_t)(h * 64 + 16 * s + 8 * hi + e)) * 64 + 32 * nt + r32;
                W.wa[nt][s][e] = (short)f2bf(w_a[idx]); W.wx[nt][s][e] = (short)f2bf(w_x[idx]); }
        }
        const int c = h * 64 + 32 * nt + r32; W.ba[nt] = b_a[c]; W.bx[nt] = b_x[c];
        const float l = lam[c]; W.spl[nt] = (l > 15.f) ? __expf(-l) : log1pf(__expf(-l));
    }
}

template <bool PASSB>
__device__ __forceinline__ void unit(int b, int chunk, const Weights& W, const bf16_t* XR, const bf16_t* GG, const float* conv_w, const float* conv_b,
                                     float* aggP, float* aggH, const float* ssq_s8, bf16_t* YY, float* fmid, float* fend, unsigned char* shm) {
    int tid_ = threadIdx.x; asm volatile("" : "+v"(tid_));
    const int tid = tid_, lane = tid & 63, r32 = lane & 31, hi = lane >> 5, wid = __builtin_amdgcn_readfirstlane(tid >> 6);
    LAS unsigned char* L = (LAS unsigned char*)shm;
#define LSTAMP(k) do { if (PROBE_A >= 200 && PASSB && blockIdx.x == 63 && b == 0 && tid == 0) ((LAS unsigned long long*)(shm + 147200))[16 + (k)] = __builtin_amdgcn_s_memrealtime(); } while (0)
    LSTAMP(0);
    const int t0 = chunk * 64; const size_t rowbase = (size_t)b * SEQ;
    f32x4 cp_[PASSB ? 8 : 1], cq_[PASSB ? 8 : 1];
    if (PASSB) {
        const f32x4* pP = (const f32x4*)(aggP + ((size_t)b * RW + tid) * 64); const f32x4* pH = (const f32x4*)(aggH + ((size_t)b * RW + tid) * 64);
#pragma unroll
        for (int i = 0; i < 8; ++i) { cp_[i] = pP[i]; cq_[i] = pH[i]; }
    }
    {
        u32x4 v[9];
#pragma unroll
        for (int k = 0; k < 9; ++k) { const int p = tid + k * NTHREADS, rr = p >> 6, pc = p & 63, t = t0 - 3 + rr;
            v[k] = (u32x4){0u, 0u, 0u, 0u}; if (p < XS_ROWS * 64 && t >= 0) v[k] = *(const u32x4*)(XR + (rowbase + t) * RW + pc * 8); }
#pragma unroll
        for (int k = 0; k < 9; ++k) { const int p = tid + k * NTHREADS; if (p < XS_ROWS * 64) *(LAS u32x4*)(L + (p >> 6) * 1024 + (p & 63) * 16) = v[k]; }
    }
    if (PASSB) {
        float hc = 0.f;
#pragma unroll
        for (int i = 0; i < 8; ++i)
#pragma unroll
            for (int e = 0; e < 4; ++e) { if (i * 4 + e < chunk) hc = cp_[i][e] * hc + cq_[i][e]; }
        if (chunk > 32) { const f32x4* pP = (const f32x4*)(aggP + ((size_t)b * RW + tid) * 64) + 8; const f32x4* pH = (const f32x4*)(aggH + ((size_t)b * RW + tid) * 64) + 8;
#pragma unroll
            for (int i = 0; i < 8; ++i) { cp_[i] = pP[i]; cq_[i] = pH[i]; }
#pragma unroll
            for (int i = 0; i < 8; ++i)
#pragma unroll
                for (int e = 0; e < 4; ++e) { if (32 + i * 4 + e < chunk) hc = cp_[i][e] * hc + cq_[i][e]; } }
        *(LAS float*)(L + HC_OFF + tid * 4) = hc;
    }
    __syncthreads();
    LSTAMP(1);
    {
        const int cp = tid & 255, th = tid >> 8, c0 = 2 * cp;
        const float w00 = conv_w[c0], w01 = conv_w[RW + c0], w02 = conv_w[2 * RW + c0], w03 = conv_w[3 * RW + c0], b0 = conv_b[c0];
        const float w10 = conv_w[c0 + 1], w11 = conv_w[RW + c0 + 1], w12 = conv_w[2 * RW + c0 + 1], w13 = conv_w[3 * RW + c0 + 1], b1 = conv_b[c0 + 1];
        const LAS unsigned* xs = (const LAS unsigned*)(L + (th * 32) * 1024 + cp * 4);
        unsigned u0 = xs[0], u1 = xs[256], u2 = xs[512];
        float a0 = __uint_as_float(u0 << 16), a1 = __uint_as_float(u1 << 16), a2 = __uint_as_float(u2 << 16);
        float c0_ = __uint_as_float(u0 & 0xffff0000u), c1_ = __uint_as_float(u1 & 0xffff0000u), c2_ = __uint_as_float(u2 & 0xffff0000u);
#pragma unroll 8
        for (int t = 0; t < 32; ++t) { const unsigned u3 = xs[(t + 3) * 256]; const float a3 = __uint_as_float(u3 << 16), c3_ = __uint_as_float(u3 & 0xffff0000u);
            const float y0 = w00 * a0 + w01 * a1 + w02 * a2 + w03 * a3 + b0, y1 = w10 * c0_ + w11 * c1_ + w12 * c2_ + w13 * c3_ + b1;
            *(LAS unsigned*)(L + XC_OFF + (th * 32 + t) * XC_PITCH + cp * 4) = f2bf(y0) | (f2bf(y1) << 16);
            a0 = a1; a1 = a2; a2 = a3; c0_ = c1_; c1_ = c2_; c2_ = c3_; }
    }
    __syncthreads();
    LSTAMP(2);
    const int h = wid;
    float Hc[2] = {0.f, 0.f}, Pc[2] = {1.f, 1.f};
    if (PASSB) {
#pragma unroll
        for (int nt = 0; nt < 2; ++nt) Hc[nt] = *(const LAS float*)(L + HC_OFF + (h * 64 + 32 * nt + r32) * 4);
    }
#pragma unroll
    for (int mt = 0; mt < 2; ++mt) {
        bf16x8 af[4];
#pragma unroll
        for (int s = 0; s < 4; ++s) af[s] = *(const LAS bf16x8*)(L + XC_OFF + (32 * mt + r32) * XC_PITCH + (h * 64 + 16 * s + 8 * hi) * 2);
#pragma unroll
        for (int nt = 0; nt < 2; ++nt) {
            f32x16 ra = {}, ri = {};
#pragma unroll
            for (int s = 0; s < 4; ++s) { ra = __builtin_amdgcn_mfma_f32_32x32x16_bf16(af[s], W.wa[nt][s], ra, 0, 0, 0); ri = __builtin_amdgcn_mfma_f32_32x32x16_bf16(af[s], W.wx[nt][s], ri, 0, 0, 0); }
            const int c = h * 64 + 32 * nt + r32;
#pragma unroll
            for (int r = 0; r < 16; ++r) { const int tok = 32 * mt + crow(r, hi);
                const float xc = bf2f(*(const LAS unsigned short*)(L + XC_OFF + tok * XC_PITCH + c * 2));
                const float rg = __builtin_amdgcn_rcpf(1.f + __expf(-(ra[r] + W.ba[nt]))), ig = __builtin_amdgcn_rcpf(1.f + __expf(-(ri[r] + W.bx[nt])));
                const float la = -8.0f * rg * W.spl[nt], a = __expf(la);
                ra[r] = a; ri[r] = __builtin_amdgcn_sqrtf(fmaxf(0.f, 1.f - a * a)) * (ig * xc); }
            float P[4], H[4], Pp[4], Hp[4];
#pragma unroll
            for (int g = 0; g < 4; ++g) { P[g] = (ra[4 * g] * ra[4 * g + 1]) * (ra[4 * g + 2] * ra[4 * g + 3]);
                H[g] = ((ri[4 * g] * ra[4 * g + 1] + ri[4 * g + 1]) * ra[4 * g + 2] + ri[4 * g + 2]) * ra[4 * g + 3] + ri[4 * g + 3]; }
#pragma unroll
            for (int g = 0; g < 4; ++g) { Pp[g] = __shfl_xor(P[g], 32); Hp[g] = __shfl_xor(H[g], 32); }
            float hc = Hc[nt], pc = Pc[nt];
#pragma unroll
            for (int g = 0; g < 4; ++g) { const float P0 = hi ? Pp[g] : P[g], H0 = hi ? Hp[g] : H[g], P1 = hi ? P[g] : Pp[g], H1 = hi ? H[g] : Hp[g];
                const float mid = P0 * hc + H0;
                if (PASSB) { float hh = hi ? mid : hc;
#pragma unroll
                    for (int k = 0; k < 4; ++k) { hh = ra[4 * g + k] * hh + ri[4 * g + k]; const int tok = 32 * mt + 8 * g + 4 * hi + k;
                        *(LAS unsigned short*)(L + tok * 1024 + c * 2) = (unsigned short)f2bf(hh); } }
                hc = P1 * mid + H1; pc = pc * (P0 * P1); }
            Hc[nt] = hc; Pc[nt] = pc;
        }
    }
    if (!PASSB) {
        if (hi == 0) {
#pragma unroll
            for (int nt = 0; nt < 2; ++nt) { const int c = h * 64 + 32 * nt + r32; aggP[((size_t)b * RW + c) * 64 + chunk] = Pc[nt]; aggH[((size_t)b * RW + c) * 64 + chunk] = Hc[nt]; }
        }
        __syncthreads();
    } else {
        LSTAMP(3);
        __syncthreads();
        LSTAMP(4);
        u32x4 gv[8]; float sv[8];
#pragma unroll
        for (int i = 0; i < 8; ++i) { const size_t row = rowbase + t0 + i * 8 + wid; gv[i] = *(const u32x4*)(GG + row * RW + lane * 8); sv[i] = ssq_s8[row * 8 + (lane & 7)]; }
#pragma unroll
        for (int i = 0; i < 8; ++i) { const int rr = i * 8 + wid; const size_t row = rowbase + t0 + rr;
            const u32x4 hv = *(const LAS u32x4*)(L + rr * 1024 + lane * 16); const u32x4 g4 = gv[i];
            f32x4 y0, y1;
            y0[0] = __uint_as_float(hv.x << 16) * __uint_as_float(g4.x << 16); y0[1] = __uint_as_float(hv.x & 0xffff0000u) * __uint_as_float(g4.x & 0xffff0000u);
            y0[2] = __uint_as_float(hv.y << 16) * __uint_as_float(g4.y << 16); y0[3] = __uint_as_float(hv.y & 0xffff0000u) * __uint_as_float(g4.y & 0xffff0000u);
            y1[0] = __uint_as_float(hv.z << 16) * __uint_as_float(g4.z << 16); y1[1] = __uint_as_float(hv.z & 0xffff0000u) * __uint_as_float(g4.z & 0xffff0000u);
            y1[2] = __uint_as_float(hv.w << 16) * __uint_as_float(g4.w << 16); y1[3] = __uint_as_float(hv.w & 0xffff0000u) * __uint_as_float(g4.w & 0xffff0000u);
            *(u32x4*)(YY + row * D + lane * 8) = pg8::pack8(y0, y1);
            float ss = pg8::sq8(y0, y1), s2 = sv[i];
#pragma unroll
            for (int o = 1; o < 64; o <<= 1) ss += __shfl_xor(ss, o);
            s2 += __shfl_xor(s2, 1); s2 += __shfl_xor(s2, 2); s2 += __shfl_xor(s2, 4);
            if (lane == 0) { const float rrn = 1.0f / sqrtf(ss * (1.f / RW) + EPS), rs = 1.0f / sqrtf(s2 * (1.f / SBW) + EPS); fmid[row] = rrn / rs; fend[row] = rs; } }
        __syncthreads();
        LSTAMP(5);
    }
#undef LSTAMP
}
}
__device__ __forceinline__ void row_prep_x(const float* x, bf16_t* xb, float* rstd0, int row, int lane) {
    const f32x4* xr = (const f32x4*)(x + (size_t)row * D) + lane;
    float s = 0.f; f32x4 v[4];
#pragma unroll
    for (int j = 0; j < 4; ++j) { v[j] = xr[64 * j]; s += v[j].x * v[j].x + v[j].y * v[j].y + v[j].z * v[j].z + v[j].w * v[j].w; }
    s = wave_sum(s);
    if (lane == 0) rstd0[row] = 1.0f / sqrtf(s * (1.f / D) + EPS);
    unsigned long long* o8 = (unsigned long long*)(xb + (size_t)row * D) + lane;
#pragma unroll
    for (int j = 0; j < 4; ++j) o8[64 * j] = (unsigned long long)(f2bf(v[j].x) | (f2bf(v[j].y) << 16)) | ((unsigned long long)(f2bf(v[j].z) | (f2bf(v[j].w) << 16)) << 32);
}
__device__ __forceinline__ void row_prep_mem(const float* m, const float* g, bf16_t* o, int row, int lane) {
    const f32x4* xr = (const f32x4*)(m + (size_t)row * D) + lane;
    float s = 0.f; f32x4 v[4];
#pragma unroll
    for (int j = 0; j < 4; ++j) { v[j] = xr[64 * j]; s += v[j].x * v[j].x + v[j].y * v[j].y + v[j].z * v[j].z + v[j].w * v[j].w; }
    s = wave_sum(s);
    const float r = 1.0f / sqrtf(s * (1.f / D) + EPS);
    unsigned long long* o8 = (unsigned long long*)(o + (size_t)row * D) + lane;
#pragma unroll
    for (int j = 0; j < 4; ++j) { const f32x4 gg = ((const f32x4*)g)[64 * j + lane];
        o8[64 * j] = (unsigned long long)(f2bf(v[j].x * r * gg.x) | (f2bf(v[j].y * r * gg.y) << 16)) | ((unsigned long long)(f2bf(v[j].z * r * gg.z) | (f2bf(v[j].w * r * gg.w) << 16)) << 32); }
}
__device__ __forceinline__ void transpose_item(const float* W, int K, int N, bf16_t* Wt, int ldt, const float* g0, const float* g1, int ksplit, LAS float* scr, int item, int lane) {
    const int nblk = N / 64, kb = item / nblk, nb = item % nblk, k0 = 64 * kb, n0 = 64 * nb, lr = lane >> 4, lc = 4 * (lane & 15);
    f32x4 v[16];
#pragma unroll
    for (int i = 0; i < 16; ++i) v[i] = *(const f32x4*)(W + (size_t)(k0 + 4 * i + lr) * N + n0 + lc);
#pragma unroll
    for (int i = 0; i < 16; ++i) { const int kk = 4 * i + lr, k = k0 + kk; float gv = 1.f; if (g0) gv = (k < ksplit) ? g0[k] : g1[k - ksplit];
        LAS float* d = scr + kk * 65 + lc; d[0] = v[i].x * gv; d[1] = v[i].y * gv; d[2] = v[i].z * gv; d[3] = v[i].w * gv; }
    asm volatile("s_waitcnt lgkmcnt(0)" ::: "memory");
    const int c = lane & 7;
#pragma unroll
    for (int j = 0; j < 8; ++j) { const int n = (lane >> 3) + 8 * j; const LAS float* s = scr + (8 * c) * 65 + n;
        u32x4 o; o.x = f2bf(s[0 * 65]) | (f2bf(s[1 * 65]) << 16); o.y = f2bf(s[2 * 65]) | (f2bf(s[3 * 65]) << 16); o.z = f2bf(s[4 * 65]) | (f2bf(s[5 * 65]) << 16); o.w = f2bf(s[6 * 65]) | (f2bf(s[7 * 65]) << 16);
        *(u32x4*)(Wt + (size_t)(n0 + n) * ldt + k0 + 8 * c) = o; }
    asm volatile("s_waitcnt lgkmcnt(0)" ::: "memory");
}

struct MidScale { const float* f; int k; int pad; };
template <class Epi>
__device__ __forceinline__ void gemm_naive(const Ctx& C, const bf16_t* A, int lda, const bf16_t* Bt, int ldb, int M, int N, int K, MidScale ms, const Epi& E) {
    const int lane = C.lane, fr = lane & 15, fq = lane >> 4, ncol = N / 64, ntile = (M / 16) * ncol;
    for (int t = C.gw; t < ntile; t += C.NGW) {
        const int row0 = (t / ncol) * 16, col0 = (t % ncol) * 64;
        const bf16_t* ap = A + (size_t)(row0 + fr) * lda + fq * 8;
        const bf16_t* bp = Bt + (size_t)(col0 + fr) * ldb + fq * 8;
        f32x4 acc[4];
#pragma unroll
        for (int n = 0; n < 4; ++n) acc[n] = (f32x4){0.f, 0.f, 0.f, 0.f};
        for (int k0 = 0; k0 < K; k0 += 32) {
            if (ms.f && k0 == ms.k) {
#pragma unroll
                for (int j = 0; j < 4; ++j) { const float f = ms.f[row0 + fq * 4 + j];
#pragma unroll
                    for (int n = 0; n < 4; ++n) acc[n][j] *= f; }
            }
            const bf16x8 a = *(const bf16x8*)(ap + k0);
#pragma unroll
            for (int n = 0; n < 4; ++n) { const bf16x8 b = *(const bf16x8*)(bp + (size_t)n * 16 * ldb + k0); acc[n] = __builtin_amdgcn_mfma_f32_16x16x32_bf16(a, b, acc[n], 0, 0, 0); }
        }
#pragma unroll
        for (int n = 0; n < 4; ++n)
#pragma unroll
            for (int j = 0; j < 4; ++j) E(row0 + fq * 4 + j, col0 + n * 16 + fr, acc[n][j]);
    }
}
struct EpiInProj { const float* rstd0; bf16_t *XR, *GG, *Qs, *Ks, *Vs;
    __device__ void operator()(int r, int c, float v) const { v *= rstd0[r]; const int t = c >> 9, cc = c & 511;
        if (t == 0) XR[(size_t)r * RW + cc] = (bf16_t)f2bf(v);
        else if (t == 1) GG[(size_t)r * RW + cc] = (bf16_t)f2bf(gelu_tanh(v));
        else if (t == 2) Qs[(size_t)r * SBW + cc] = (bf16_t)f2bf(v * (0.125f * LOG2E));
        else if (t == 3) Ks[(size_t)r * SBW + cc] = (bf16_t)f2bf(v);
        else Vs[(size_t)r * SBW + cc] = (bf16_t)f2bf(v); } };
struct EpiStoreBf16 { bf16_t* O; const float* rowscale; int ldo; float scale;
    __device__ void operator()(int r, int c, float v) const { O[(size_t)r * ldo + c] = (bf16_t)f2bf(v * (rowscale ? rowscale[r] : 1.f) * scale); } };
struct EpiResF32 { const float* base; const float* rowscale; bf16_t* O;
    __device__ void operator()(int r, int c, float v) const { O[(size_t)r * D + c] = (bf16_t)f2bf(base[(size_t)r * D + c] + v * rowscale[r]); } };
struct EpiResBf16 { const bf16_t* base; bf16_t* O;
    __device__ void operator()(int r, int c, float v) const { O[(size_t)r * D + c] = (bf16_t)f2bf(bf2f(base[(size_t)r * D + c]) + v); } };

__device__ __forceinline__ void lru_naive_unit(int unit, int j, LAS float* xs, const bf16_t* XR, const bf16_t* GG, const float* conv_w, const float* conv_b,
                                               const float* w_a, const float* b_a, const float* w_x, const float* b_x, const float* lam, bf16_t* YY) {
    const int b = unit >> 3, h = unit & 7, c = h * 64 + j;
    float wa[64], wx[64];
#pragma unroll
    for (int i = 0; i < 64; ++i) { wa[i] = w_a[(size_t)(h * 64 + i) * 64 + j]; wx[i] = w_x[(size_t)(h * 64 + i) * 64 + j]; }
    const float ba = b_a[c], bx = b_x[c], cw0 = conv_w[c], cw1 = conv_w[RW + c], cw2 = conv_w[2 * RW + c], cw3 = conv_w[3 * RW + c], cb = conv_b[c];
    const float l = lam[c], spl = (l > 15.f) ? __expf(-l) : log1pf(__expf(-l));
    float x0 = 0.f, x1 = 0.f, x2 = 0.f, hst = 0.f;
    for (int t = 0; t < SEQ; ++t) {
        const size_t row = (size_t)b * SEQ + t;
        const float x3 = bf2f(XR[row * RW + c]);
        const float xc = cw0 * x0 + cw1 * x1 + cw2 * x2 + cw3 * x3 + cb;
        x0 = x1; x1 = x2; x2 = x3;
        asm volatile("s_waitcnt lgkmcnt(0)" ::: "memory"); xs[j] = xc; asm volatile("s_waitcnt lgkmcnt(0)" ::: "memory");
        float ra = ba, ri = bx;
#pragma unroll
        for (int i = 0; i < 64; ++i) { const float xv = xs[i]; ra += xv * wa[i]; ri += xv * wx[i]; }
        const float r = sigmoidf_(ra), ig = sigmoidf_(ri);
        const float log_a = -8.0f * r * spl, a = __expf(log_a), bb = sqrtf(fmaxf(0.f, -expm1f(2.f * log_a))) * (ig * xc);
        hst = a * hst + bb;
        YY[row * D + c] = (bf16_t)f2bf(hst * bf2f(GG[row * RW + c]));
    }
}
__device__ __forceinline__ void sb_naive_unit(int unit, int lane, const bf16_t* Qs, const bf16_t* Ks, const bf16_t* Vs, bf16_t* YY, float* ssq_s8) {
    const int qb = unit & 63, h = (unit >> 6) & 7, b = unit >> 9;
    const int t = qb * 64 + lane; const size_t row = (size_t)b * SEQ + t;
    float q[64], o[64];
#pragma unroll
    for (int d = 0; d < 64; ++d) { q[d] = bf2f(Qs[row * SBW + h * 64 + d]); o[d] = 0.f; }
    float R = 0.f;
    for (int s = qb * 64 + 62; s >= 0; --s) {
        const bf16_t* kr = Ks + ((size_t)b * SEQ + s) * SBW + h * 64; const bf16_t* vr = Vs + ((size_t)b * SEQ + s) * SBW + h * 64;
        float z = 0.f;
#pragma unroll
        for (int d = 0; d < 64; ++d) z += q[d] * bf2f(kr[d]);
        const bool valid = s < t;
        const float sp = valid ? (fmaxf(z, 0.f) + __log2f(1.f + exp2f(-fabsf(z)))) : 0.f;
        const float w = valid ? exp2f(z - (R + sp)) : 0.f;
        R += sp;
        const float wb = bf2f((bf16_t)f2bf(w));
#pragma unroll
        for (int d = 0; d < 64; ++d) o[d] += wb * bf2f(vr[d]);
    }
    float ss = 0.f;
#pragma unroll
    for (int d = 0; d < 64; ++d) { ss += o[d] * o[d]; YY[row * D + RW + h * 64 + d] = (bf16_t)f2bf(o[d]); }
    ssq_s8[row * 8 + h] = ss;
}
__device__ __forceinline__ void xattn_naive_unit(int unit, int j, LAS float* qs, LAS float* ps, const bf16_t* QX, const bf16_t* KVM, bf16_t* OX) {
    const int tg = unit & 511, h = (unit >> 9) & 3, b = unit >> 11, lane = j & 63, wid = j >> 6;
    const size_t row0 = (size_t)b * SEQ + tg * 8;
    for (int i = 0; i < 8; ++i) qs[i * 256 + j] = bf2f(QX[(row0 + i) * D + h * XD + j]);
    __syncthreads();
    const bf16_t* kr = KVM + ((size_t)b * MEM + j) * 2048 + h * XD;
    float sc[8];
#pragma unroll
    for (int i = 0; i < 8; ++i) sc[i] = 0.f;
    for (int d = 0; d < XD; ++d) { const float kv = bf2f(kr[d]);
#pragma unroll
        for (int i = 0; i < 8; ++i) sc[i] += qs[i * 256 + d] * kv; }
#pragma unroll
    for (int i = 0; i < 8; ++i) ps[i * 256 + j] = sc[i];
    __syncthreads();
    for (int i = wid * 2; i < wid * 2 + 2; ++i) {
        float v0 = ps[i * 256 + lane], v1 = ps[i * 256 + lane + 64], v2 = ps[i * 256 + lane + 128], v3 = ps[i * 256 + lane + 192];
        float m = fmaxf(fmaxf(v0, v1), fmaxf(v2, v3));
#pragma unroll
        for (int o = 1; o < 64; o <<= 1) m = fmaxf(m, __shfl_xor(m, o));
        v0 = exp2f(v0 - m); v1 = exp2f(v1 - m); v2 = exp2f(v2 - m); v3 = exp2f(v3 - m);
        const float s = wave_sum(v0 + v1 + v2 + v3), inv = 1.f / s;
        ps[i * 256 + lane] = v0 * inv; ps[i * 256 + lane + 64] = v1 * inv; ps[i * 256 + lane + 128] = v2 * inv; ps[i * 256 + lane + 192] = v3 * inv;
    }
    __syncthreads();
    float o[8];
#pragma unroll
    for (int i = 0; i < 8; ++i) o[i] = 0.f;
    for (int m = 0; m < MEM; ++m) { const float vv = bf2f(KVM[((size_t)b * MEM + m) * 2048 + 1024 + h * XD + j]);
#pragma unroll
        for (int i = 0; i < 8; ++i) o[i] += ps[i * 256 + m] * vv; }
#pragma unroll
    for (int i = 0; i < 8; ++i) OX[(row0 + i) * D + h * XD + j] = (bf16_t)f2bf(o[i]);
    __syncthreads();
}
__device__ __forceinline__ int router_row(int row, int lane, const bf16_t* X2b, const float* ssq2p, const float* g, const float* wgr, const float* bgr, const float* wer, const float* ber, float* selw) {
    int cls = 0;
    float acc[20];
#pragma unroll
    for (int i = 0; i < 20; ++i) acc[i] = 0.f;
    const float rs = pg8::rstd16(ssq2p + (size_t)row * 16);
    for (int kk = 0; kk < 16; ++kk) { const int k = kk * 64 + lane; const float t = bf2f(X2b[(size_t)row * D + k]) * rs * g[k];
#pragma unroll
        for (int i = 0; i < 4; ++i) acc[i] += t * wgr[k * 4 + i];
#pragma unroll
        for (int gi = 0; gi < 4; ++gi)
#pragma unroll
            for (int e = 0; e < 4; ++e) acc[4 + gi * 4 + e] += t * wer[((size_t)gi * D + k) * 4 + e]; }
#pragma unroll
    for (int i = 0; i < 20; ++i) acc[i] = wave_sum(acc[i]);
    if (lane == 0) {
        float gl[4]; float gm = -INFINITY; int gi = 0;
#pragma unroll
        for (int i = 0; i < 4; ++i) { gl[i] = acc[i] + bgr[i]; if (gl[i] > gm) { gm = gl[i]; gi = i; } }
        float gs = 0.f;
#pragma unroll
        for (int i = 0; i < 4; ++i) gs += __expf(gl[i] - gm);
        const float gp = 1.f / gs;
        float el[4];
#pragma unroll
        for (int e = 0; e < 4; ++e) { float v = 0.f;
#pragma unroll
            for (int q = 0; q < 4; ++q) if (q == gi) v = acc[4 + q * 4 + e] + ber[q * 4 + e];
            el[e] = v; }
        int e1 = 0; float m1 = el[0];
#pragma unroll
        for (int e = 1; e < 4; ++e) if (el[e] > m1) { m1 = el[e]; e1 = e; }
        int e2 = -1; float m2 = -INFINITY;
#pragma unroll
        for (int e = 0; e < 4; ++e) if (e != e1 && el[e] > m2) { m2 = el[e]; e2 = e; }
        const float p2 = __expf(m2 - m1), w1 = gp / (1.f + p2), w2 = gp * p2 / (1.f + p2);
        const int ea = e1 < e2 ? e1 : e2, eb = e1 < e2 ? e2 : e1; const float wA = e1 < e2 ? w1 : w2, wB = e1 < e2 ? w2 : w1;
        const int pr = (ea == 0) ? eb - 1 : (ea == 1) ? eb + 1 : 5;
        selw[(size_t)row * 2] = wA; selw[(size_t)row * 2 + 1] = wB; cls = gi * 6 + pr;
    }
    return cls;
}
__device__ __forceinline__ void final_row(int row, int lane, const bf16_t* X3b, const float* ssq3, const float* g, float* out) {
    const float r = pg8::rstd16(ssq3 + (size_t)row * 16);
#pragma unroll
    for (int j = 0; j < 2; ++j) { const int c = j * 512 + lane * 8; const u32x4 v = *(const u32x4*)(X3b + (size_t)row * D + c); const f32x4 g0 = *(const f32x4*)(g + c), g1 = *(const f32x4*)(g + c + 4);
        f32x4 o0, o1;
        o0[0] = __uint_as_float(v.x << 16) * r * g0[0]; o0[1] = __uint_as_float(v.x & 0xffff0000u) * r * g0[1]; o0[2] = __uint_as_float(v.y << 16) * r * g0[2]; o0[3] = __uint_as_float(v.y & 0xffff0000u) * r * g0[3];
        o1[0] = __uint_as_float(v.z << 16) * r * g1[0]; o1[1] = __uint_as_float(v.z & 0xffff0000u) * r * g1[1]; o1[2] = __uint_as_float(v.w << 16) * r * g1[2]; o1[3] = __uint_as_float(v.w & 0xffff0000u) * r * g1[3];
        *(f32x4*)(out + (size_t)row * D + c) = o0; *(f32x4*)(out + (size_t)row * D + c + 4) = o1; }
}
__device__ __forceinline__ void reids(Ctx& C) { int t_ = threadIdx.x; asm volatile("" : "+v"(t_)); C.tid = t_; C.lane = t_ & 63; C.wave = __builtin_amdgcn_readfirstlane(t_ >> 6); C.gw = C.bid * NWAVES + C.wave; }
__global__ void __launch_bounds__(NTHREADS, 2) mk_fwd(Args args) {
    extern __shared__ __attribute__((aligned(16))) unsigned char lds[];
    cg::grid_group grid = cg::this_grid();
    Ctx C;
#pragma unroll
    for (int i = 0; i < 29; ++i) C.in[i] = args.in[i];
    C.out = args.out; C.ws = args.ws; C.lds = lds;
    C.tid = threadIdx.x; C.lane = C.tid & 63; C.wave = __builtin_amdgcn_readfirstlane(C.tid >> 6);
    C.G = gridDim.x; C.bid = blockIdx.x; C.gw = C.bid * NWAVES + C.wave; C.NGW = C.G * NWAVES;
    const float* x = C.in[0]; const float* mem = C.in[1]; const float* norm_mix = C.in[2]; const float* w_in = C.in[3];
    const float* conv_w = C.in[4]; const float* conv_b = C.in[5]; const float* lru_w_a = C.in[6]; const float* lru_b_a = C.in[7];
    const float* lru_w_x = C.in[8]; const float* lru_b_x = C.in[9]; const float* lru_lambda = C.in[10];
    const float* norm_rnn = C.in[11]; const float* norm_sb = C.in[12]; const float* w_out = C.in[13];
    const float* norm_xattn = C.in[14]; const float* norm_mem = C.in[15];
    const float* xa_w_q = C.in[16]; const float* xa_w_k = C.in[17]; const float* xa_w_v = C.in[18]; const float* xa_w_o = C.in[19];
    const float* norm_moe = C.in[20]; const float* w_gr = C.in[21]; const float* b_gr = C.in[22]; const float* w_er = C.in[23]; const float* b_er = C.in[24];
    const float* w_gate = C.in[25]; const float* w_up = C.in[26]; const float* w_down = C.in[27]; const float* norm_final = C.in[28];
    unsigned char* ws = C.ws; float* out = C.out;
    float* sm = (float*)(ws + WS_SMALL);
    float* rstd0 = sm + SM_RSTD0; float* ssq_r = sm + SM_SSQR; float* ssq_s = sm + SM_SSQS; float* ssq1 = sm + SM_SSQ1; float* ssq2 = sm + SM_SSQ2; unsigned* kmax = (unsigned*)(ws + WS_CTL); float* fmid = sm + SM_END; float* fend = fmid + 32768;
    float* aggP = sm + 96 * 32768; float* aggH = sm + 104 * 32768;
    float* selw = sm + SM_SELW; float* ssq3 = sm + SM_SSQ3; int* gcnt = (int*)(ws + WS_CTL + 1024);
    int* tlist = (int*)(sm + 64 * 32768); float* rsg = sm + 88 * 32768; float* wAg = rsg + 40960; float* wBg = wAg + 40960; int* tokg = (int*)(wBg + 40960); float* rstok = sm + SM_RSTD0;
    bf16_t* Wrh = (bf16_t*)(ws + WS_CTL + 65536); bf16_t* Wrl = Wrh + 32 * D;
    bf16_t* Wg_t = (bf16_t*)(ws + WS_WG); bf16_t* Wu_t = (bf16_t*)(ws + WS_WU); bf16_t* Wd2 = (bf16_t*)(ws + WS_WD2); bf16_t* XG = (bf16_t*)(ws + WS_R1); bf16_t* HID = (bf16_t*)(ws + WS_R5);
    bf16_t* Win_t = (bf16_t*)(ws + WS_WIN); bf16_t* Wout_t = (bf16_t*)(ws + WS_WOUT); bf16_t* Wq_t = (bf16_t*)(ws + WS_WQ); bf16_t* Wkv_t = (bf16_t*)(ws + WS_WKV); bf16_t* Wo_t = (bf16_t*)(ws + WS_WO);
    bf16_t* memn = (bf16_t*)(ws + WS_MEMN); bf16_t* KM = (bf16_t*)(ws + WS_KVM); bf16_t* VM = KM + (size_t)NMEM * D; bf16_t* MT = (bf16_t*)(ws + WS_R5); bf16_t* NT = MT + (size_t)BATCH * D * D; bf16_t* WqN = (bf16_t*)(ws + WS_WQ);
    bf16_t* xb = (bf16_t*)(ws + WS_R0); bf16_t* X1b = xb; bf16_t* X3b = xb;
    bf16_t* XR = (bf16_t*)(ws + WS_R1); bf16_t* GG = XR + (size_t)NTOK * RW; bf16_t* QX = XR;
    bf16_t* Qs = (bf16_t*)(ws + WS_R2); bf16_t* Ks = Qs + (size_t)NTOK * SBW; bf16_t* OX = Qs;
    bf16_t* Vs = (bf16_t*)(ws + WS_R3);
    bf16_t* YY = (bf16_t*)(ws + WS_R4); bf16_t* X2b = YY;
    const int NGW = C.NGW;
#define gw C.gw
#define lane C.lane
    if (C.tid < 64) ((LAS unsigned*)(lds + 146432))[C.tid] = 0u;
    __syncthreads();
    XcdBarrier bar = xcd_barrier_post((unsigned*)(ws + WS_CTL + 4096), (volatile LAS unsigned*)(lds + 146432 + 32));
#define GRID_SYNC_CG() do { grid.sync(); reids(C); } while (0)
#define GRID_SYNC() do { xcd_barrier(bar); reids(C); } while (0)

    for (int rep_ = 0; rep_ < (int)((REP_MASK >> 0) & 1u) + 1; ++rep_) {
    {
        if (gw == 0) { kmax[lane] = 0u; if (lane < 32) gcnt[lane] = 0; }
        if (gw == 1) { ((u32x4*)(ws + WS_END))[lane] = (u32x4){0u, 0u, 0u, 0u}; ((u32x4*)(ws + WS_END))[64 + lane] = (u32x4){0u, 0u, 0u, 0u}; }
        for (int r = gw * 4; r < NTOK; r += NGW * 4) {
            const f32x4* xr = (const f32x4*)(x + (size_t)r * D) + lane; f32x4 v[16]; float s[4] = {0.f, 0.f, 0.f, 0.f};
#pragma unroll
            for (int j = 0; j < 16; ++j) v[j] = __builtin_nontemporal_load(xr + 64 * j);
#pragma unroll
            for (int j = 0; j < 16; ++j) s[j >> 2] += (v[j].x * v[j].x + v[j].y * v[j].y) + (v[j].z * v[j].z + v[j].w * v[j].w);
#pragma unroll
            for (int o = 1; o < 64; o <<= 1) { s[0] += __shfl_xor(s[0], o); s[1] += __shfl_xor(s[1], o); s[2] += __shfl_xor(s[2], o); s[3] += __shfl_xor(s[3], o); }
            if (lane < 4) { const float sv = lane == 0 ? s[0] : lane == 1 ? s[1] : lane == 2 ? s[2] : s[3]; rstd0[r + lane] = __builtin_amdgcn_rsqf(sv * (1.f / D) + EPS); }
            unsigned long long* o8 = (unsigned long long*)(xb + (size_t)r * D) + lane;
#pragma unroll
            for (int j = 0; j < 16; ++j) o8[64 * j] = (unsigned long long)(f2bf(v[j].x) | (f2bf(v[j].y) << 16)) | ((unsigned long long)(f2bf(v[j].z) | (f2bf(v[j].w) << 16)) << 32);
        }
        for (int r = gw; r < NMEM; r += NGW) row_prep_mem(mem, norm_mem, memn, r, lane);
        LAS float* scr = (LAS float*)(lds) + C.wave * (64 * 65);
        constexpr int I_IN = (D / 64) * (PROJ / 64), I_SQ = (D / 64) * (D / 64);
        for (int it = gw; it < I_IN + 4 * I_SQ; it += NGW) {
            int r = it;
            if (r < I_IN) { transpose_item(w_in, D, PROJ, Win_t, D, norm_mix, norm_mix, D, scr, r, lane); continue; } r -= I_IN;
            if (r < I_SQ) { transpose_item(w_out, D, D, Wout_t, D, norm_rnn, norm_sb, RW, scr, r, lane); continue; } r -= I_SQ;
            if (r < I_SQ) { transpose_item(xa_w_k, D, D, Wkv_t, D, nullptr, nullptr, 0, scr, r, lane); continue; } r -= I_SQ;
            if (r < I_SQ) { transpose_item(xa_w_v, D, D, Wkv_t + (size_t)D * D, D, nullptr, nullptr, 0, scr, r, lane); continue; } r -= I_SQ;
            transpose_item(xa_w_o, D, D, Wo_t, D, nullptr, nullptr, 0, scr, r, lane);
        }
        for (int r = gw; r < D; r += NGW) { const float gk = norm_xattn[r]; const f32x4* src = (const f32x4*)(xa_w_q + (size_t)r * D) + lane; unsigned long long* o8 = (unsigned long long*)(WqN + (size_t)r * D) + lane;
#pragma unroll
            for (int j = 0; j < 4; ++j) { const f32x4 v = src[64 * j]; o8[64 * j] = (unsigned long long)(f2bf(v.x * gk) | (f2bf(v.y * gk) << 16)) | ((unsigned long long)(f2bf(v.z * gk) | (f2bf(v.w * gk) << 16)) << 32); } }
        for (int idx = gw * 64 + lane; idx < 32 * D; idx += NGW * 64) { const int n = idx >> 10, k = idx & 1023; float w = 0.f;
            if (n < 4) w = w_gr[k * 4 + n]; else if (n < 20) w = w_er[((size_t)((n - 4) >> 2) * D + k) * 4 + ((n - 4) & 3)];
            w *= norm_moe[k]; const unsigned hi = f2bf(w); Wrh[idx] = (bf16_t)hi; Wrl[idx] = (bf16_t)f2bf(w - bf2f((unsigned short)hi)); }
        constexpr int I_GU = (D / 64) * (DE / 64), I_DN = (DE / 64) * (D / 64);
        for (int it = gw; it < 32 * I_GU + 48 * I_DN; it += NGW) {
            int r = it;
            if (r < 16 * I_GU) { const int e = r / I_GU; transpose_item(w_gate + (size_t)e * D * DE, D, DE, Wg_t + (size_t)e * DE * D, D, norm_moe, norm_moe, D, scr, r % I_GU, lane); continue; } r -= 16 * I_GU;
            if (r < 16 * I_GU) { const int e = r / I_GU; transpose_item(w_up + (size_t)e * D * DE, D, DE, Wu_t + (size_t)e * DE * D, D, norm_moe, norm_moe, D, scr, r % I_GU, lane); continue; } r -= 16 * I_GU;
            { const int cs = r / I_DN, cls = cs >> 1, slot = cs & 1; int ea, eb; pg8::pair_ab(cls % 6, ea, eb); const int e = (cls / 6) * 4 + (slot ? eb : ea);
              transpose_item(w_down + (size_t)e * DE * D, DE, D, Wd2 + (size_t)cls * D * 512 + slot * DE, 512, nullptr, nullptr, 0, scr, r % I_DN, lane); }
        }
    }
    }
    GRID_SYNC();
    for (int rep_ = 0; rep_ < (int)((REP_MASK >> 1) & 1u) + 1; ++rep_) {
    { pg8::DenseOrder S; S.init(xb, D, Win_t, D, NTOK, PROJ, C.G, C.bid); pg8::EpiInProjF E{0, rstd0, XR, GG, Qs, Ks, Vs, kmax};
      pg8::gemm_phase<pg8::EpiInProjF, pg8::DenseOrder, true>((LAS unsigned char*)lds, pg8::Gemm{D, D, D}, S, E); }
    { pg8::DenseOrder S; S.init(memn, D, Wkv_t, D, NMEM, 2048, C.G, C.bid); pg8::EpiKvN E{0, KM, VM};
      pg8::gemm_phase<pg8::EpiKvN, pg8::DenseOrder, true>((LAS unsigned char*)lds, pg8::Gemm{D, D, D}, S, E); }
    }
    GRID_SYNC();
    for (int rep_ = 0; rep_ < (int)((REP_MASK >> 2) & 1u) + 1; ++rep_) {
    {
        { lru::Weights LW; lru::load_weights(LW, C.wave, lane & 31, lane >> 5, lru_w_a, lru_b_a, lru_w_x, lru_b_x, lru_lambda);
          for (int u = C.bid; u < BATCH * 64; u += C.G) lru::unit<false>(u >> 6, u & 63, LW, XR, GG, conv_w, conv_b, aggP, aggH, ssq_s, YY, fmid, fend, lds); }
        for (int u = C.bid; u < BATCH * NH * 16; u += C.G) sba::sb_unit(u >> 7, (u >> 4) & 7, 15 - (u & 15), Qs, Ks, Vs, YY, ssq_s, (char*)lds);
    }
    { pg8::XaPreOrder S{KM, VM, WqN, Wo_t, C.G, C.bid}; pg8::EpiXaPre E{0, MT, NT};
      pg8::gemm_phase<pg8::EpiXaPre, pg8::XaPreOrder, true>((LAS unsigned char*)lds, pg8::Gemm{D, D, XD}, S, E); }
    }
    GRID_SYNC();
    for (int rep_ = 0; rep_ < (int)((REP_MASK >> 3) & 1u) + 1; ++rep_) {
    { lru::Weights LW; lru::load_weights(LW, C.wave, lane & 31, lane >> 5, lru_w_a, lru_b_a, lru_w_x, lru_b_x, lru_lambda);
      for (int u = C.bid; u < BATCH * 64; u += C.G) lru::unit<true>(u >> 6, u & 63, LW, XR, GG, conv_w, conv_b, aggP, aggH, ssq_s, YY, fmid, fend, lds); }
    }
    GRID_SYNC();
    for (int rep_ = 0; rep_ < (int)((REP_MASK >> 4) & 1u) + 1; ++rep_) {
    { pg8::DenseOrder S; S.init(YY, D, Wout_t, D, NTOK, D, C.G, C.bid); pg8::EpiX1F E{8, xb, fmid, fend, X1b, ssq1};
      pg8::gemm_phase<pg8::EpiX1F, pg8::DenseOrder, true>((LAS unsigned char*)lds, pg8::Gemm{D, D, D}, S, E); }
    }
    GRID_SYNC();
    for (int rep_ = 0; rep_ < (int)((REP_MASK >> 5) & 1u) + 1; ++rep_) {
    { pg8::BatchedOrder S{X1b, MT, C.G, C.bid}; pg8::EpiXaSoftmax E{0, QX, ssq1, 0.0625f * LOG2E, (LAS float*)(lds + 131072 + 2048)};
      pg8::gemm_phase<pg8::EpiXaSoftmax, pg8::BatchedOrder, true>((LAS unsigned char*)lds, pg8::Gemm{D, D, D}, S, E); }
    }
    GRID_SYNC();
    for (int rep_ = 0; rep_ < (int)((REP_MASK >> 8) & 1u) + 1; ++rep_) {
    { pg8::BatchedOrder S{QX, NT, C.G, C.bid}; pg8::EpiResF E{0, X1b, X2b, ssq2};
      pg8::gemm_phase<pg8::EpiResF, pg8::BatchedOrder, true>((LAS unsigned char*)lds, pg8::Gemm{D, D, D}, S, E); }
    }
    GRID_SYNC();
    for (int rep_ = 0; rep_ < (int)((REP_MASK >> 9) & 1u) + 1; ++rep_) {
    {
        LAS int* lcnt = (LAS int*)lds; LAS int* lbase = lcnt + 32; LAS int* lcls = lcnt + 64; LAS int* lpos = lcnt + 192;
        for (int p = C.tid; p < 64 * 128; p += NTHREADS) { const int rrow = p >> 7, pc = p & 127;
            *(LAS u32x4*)(lds + 12288 + rrow * 2064 + pc * 16) = *(const u32x4*)(Wrh + (size_t)rrow * D + pc * 8); }
        for (int chunk = C.bid; chunk < NTOK / 128; chunk += C.G) {
            if (C.tid < 32) lcnt[C.tid] = 0;
            __syncthreads();
            {
                const int fr = lane & 15, fq = lane >> 4, row0 = chunk * 128 + C.wave * 16;
                f32x4 acc0 = {0.f, 0.f, 0.f, 0.f}, acc1 = acc0;
                const bf16_t* ap = X2b + (size_t)(row0 + fr) * D + fq * 8; const LAS unsigned char* bp = (const LAS unsigned char*)(lds + 12288) + fr * 2064 + fq * 16;
#pragma unroll 1
                for (int kb = 0; kb < 4; ++kb) { bf16x8 a[8];
#pragma unroll
                    for (int j = 0; j < 8; ++j) a[j] = *(const bf16x8*)(ap + (kb * 8 + j) * 32);
#pragma unroll
                    for (int j = 0; j < 8; ++j) { const int ks = kb * 8 + j;
                        const bf16x8 h0 = *(const LAS bf16x8*)(bp + ks * 64), h1 = *(const LAS bf16x8*)(bp + 16 * 2064 + ks * 64), l0 = *(const LAS bf16x8*)(bp + 32 * 2064 + ks * 64), l1 = *(const LAS bf16x8*)(bp + 48 * 2064 + ks * 64);
                        acc0 = __builtin_amdgcn_mfma_f32_16x16x32_bf16(a[j], h0, acc0, 0, 0, 0); acc1 = __builtin_amdgcn_mfma_f32_16x16x32_bf16(a[j], h1, acc1, 0, 0, 0);
                        acc0 = __builtin_amdgcn_mfma_f32_16x16x32_bf16(a[j], l0, acc0, 0, 0, 0); acc1 = __builtin_amdgcn_mfma_f32_16x16x32_bf16(a[j], l1, acc1, 0, 0, 0); } }
                LAS float* lg = (LAS float*)(lds + 1536) + C.wave * (16 * 21);
#pragma unroll
                for (int j = 0; j < 4; ++j) { lg[(4 * fq + j) * 21 + fr] = acc0[j]; if (fr < 4) lg[(4 * fq + j) * 21 + 16 + fr] = acc1[j]; }
                asm volatile("s_waitcnt lgkmcnt(0)" ::: "memory");
                if (lane < 16) { const int row = row0 + lane; const float rs = pg8::rstd16(ssq2 + (size_t)row * 16); const LAS float* lr = lg + lane * 21;
                    float gl[4]; float gm = -INFINITY; int gi = 0;
#pragma unroll
                    for (int i = 0; i < 4; ++i) { gl[i] = lr[i] * rs + b_gr[i]; if (gl[i] > gm) { gm = gl[i]; gi = i; } }
                    float gs = 0.f;
#pragma unroll
                    for (int i = 0; i < 4; ++i) gs += __expf(gl[i] - gm);
                    const float gp = 1.f / gs;
                    float el[4];
#pragma unroll
                    for (int e = 0; e < 4; ++e) el[e] = lr[4 + gi * 4 + e] * rs + b_er[gi * 4 + e];
                    int e1 = 0; float m1 = el[0];
#pragma unroll
                    for (int e = 1; e < 4; ++e) if (el[e] > m1) { m1 = el[e]; e1 = e; }
                    int e2 = -1; float m2 = -INFINITY;
#pragma unroll
                    for (int e = 0; e < 4; ++e) if (e != e1 && el[e] > m2) { m2 = el[e]; e2 = e; }
                    const float p2 = __expf(m2 - m1), w1 = gp / (1.f + p2), w2 = gp * p2 / (1.f + p2);
                    const int ea = e1 < e2 ? e1 : e2, eb = e1 < e2 ? e2 : e1; const float wA = e1 < e2 ? w1 : w2, wB = e1 < e2 ? w2 : w1;
                    const int pr = (ea == 0) ? eb - 1 : (ea == 1) ? eb + 1 : 5, cls = gi * 6 + pr, lt = C.wave * 16 + lane;
                    selw[(size_t)row * 2] = wA; selw[(size_t)row * 2 + 1] = wB; rstok[row] = rs;
                    lcls[lt] = cls; lpos[lt] = __hip_atomic_fetch_add(lcnt + cls, 1, __ATOMIC_RELAXED, __HIP_MEMORY_SCOPE_WORKGROUP); }
            }
            __syncthreads();
            if (C.tid < 24) lbase[C.tid] = atomicAdd(gcnt + C.tid, lcnt[C.tid]);
            __syncthreads();
            if (C.tid < 128) { const int c = lcls[C.tid]; tlist[(size_t)c * NTOK + lbase[c] + lpos[C.tid]] = chunk * 128 + C.tid; }
            __syncthreads();
        }
    }
    }
    GRID_SYNC();
    LAS int* meta = (LAS int*)(lds + 146432 + 256);
    for (int rep_ = 0; rep_ < (int)((REP_MASK >> 11) & 1u) + 1; ++rep_) {
    {
        if (C.tid == 0) { int rb = 0, tb = 0;
            for (int c = 0; c < 24; ++c) { const int n = gcnt[c], nt = (n + 255) >> 8; meta[c] = n; meta[32 + c] = rb; meta[64 + c] = tb; rb += nt * 256; tb += nt; }
            meta[32 + 24] = rb; meta[64 + 24] = tb; }
        __syncthreads();
        LAS int* tokl = (LAS int*)(lds + 131072 + 2048);
        pg8::MoeOrder1G S{X2b, Wg_t, Wu_t, meta, tokl, (unsigned)(WS_END - WS_R4), C.G, C.bid};
        { pg8::Unit u;
          for (int i = 0; S.next(i, u); ++i) { const int cls = (u.pn & 0xffff) >> 2, p0 = (u.pm - meta[64 + cls]) * 256;
              if (C.tid < 256) { const int pp = p0 + C.tid, tok = pp < meta[cls] ? tlist[(size_t)cls * NTOK + pp] : -1; tokl[i * 256 + C.tid] = tok; tokg[u.pm * 256 + C.tid] = tok; } } }
        __syncthreads();
        pg8::EpiMoeUpG E{0, tokl, rstok, selw, HID};
        pg8::gemm_phase_gather<pg8::EpiMoeUpG, pg8::MoeOrder1G, true>((LAS unsigned char*)lds, pg8::Gemm{D, D, D}, S, E);
    }
    }
    GRID_SYNC();
    for (int rep_ = 0; rep_ < (int)((REP_MASK >> 12) & 1u) + 1; ++rep_) {
    { pg8::MoeOrder2 S{HID, Wd2, meta, C.G, C.bid};
      pg8::EpiMoeFinal E{0, tokg, X2b, out, ssq3, (unsigned*)(ws + WS_CTL + 4096 + 16384), norm_final, (LAS unsigned*)(lds + 146432 + 128), (unsigned*)(ws + WS_CTL + 4096) + 128};
      pg8::gemm_phase<pg8::EpiMoeFinal, pg8::MoeOrder2, true>((LAS unsigned char*)lds, pg8::Gemm{512, 512, 512}, S, E); }
    }
}

#undef gw
#undef lane
extern "C" void kernel_launch(void* const* d_in, const int* in_sizes, int n_in, void* d_out, int out_size, void* d_ws, size_t ws_size, hipStream_t stream) {
    static int grid = 0;
    if (grid == 0) {
        if (n_in != 29 || ws_size < WS_END + 4096) { fprintf(stderr, "kernel_launch: unexpected inputs (%d) or workspace (%zu)\n", n_in, ws_size); grid = -1; return; }
        int dev = 0, cus = 0, per_cu = 0;
        hipGetDevice(&dev); hipDeviceGetAttribute(&cus, hipDeviceAttributeMultiprocessorCount, dev);
        hipFuncSetAttribute((const void*)mk_fwd, hipFuncAttributeMaxDynamicSharedMemorySize, LDS_BYTES);
        hipOccupancyMaxActiveBlocksPerMultiprocessor(&per_cu, (const void*)mk_fwd, NTHREADS, LDS_BYTES);
        if (per_cu < 1) { fprintf(stderr, "kernel_launch: occupancy query says %d blocks per CU\n", per_cu); per_cu = 1; }
        if (per_cu > 1) per_cu = 1;
        grid = cus * per_cu;
    }
    if (grid < 0) return;
    if (hipMemsetAsync((char*)d_ws + WS_CTL + 4096, 0, 32768, stream) != hipSuccess) { fprintf(stderr, "kernel_launch: memset of the barrier words failed\n"); return; }
    Args a{};
    for (int i = 0; i < 29; ++i) a.in[i] = (const float*)d_in[i];
    a.out = (float*)d_out; a.ws = (unsigned char*)d_ws;
    void* kargs[] = {&a};
    hipError_t e = hipLaunchCooperativeKernel((const void*)mk_fwd, dim3(grid), dim3(NTHREADS), kargs, LDS_BYTES, stream);
    if (e != hipSuccess) fprintf(stderr, "cooperative launch failed: %s (grid %d)\n", hipGetErrorString(e), grid);
}
```

```cpp
#include <hip/hip_runtime.h>
#include <hip/hip_cooperative_groups.h>
#include <cstdio>
#include <cstdint>

typedef unsigned short bf16_t;
typedef short bf16x8 __attribute__((ext_vector_type(8)));
typedef float f32x4 __attribute__((ext_vector_type(4)));
typedef unsigned u32x4 __attribute__((ext_vector_type(4)));

constexpr int D = 1024, BATCH = 8, SEQ = 4096, NTOK = BATCH * SEQ, MEM = 256, NMEM = BATCH * MEM;
constexpr int RW = 512, SBW = 512, PROJ = 2560, NH = 8, HD = 64;
constexpr int XH = 4, XD = 256, NG = 4, EPG = 4, NEXP = 16, DE = 256;
constexpr float EPS = 1e-6f, LOG2E = 1.4426950408889634f;

constexpr size_t MiB = 1u << 20;
constexpr size_t WS_CTL = 0;
constexpr size_t WS_SMALL = 1 * MiB;
constexpr size_t WS_WIN = 16 * MiB;
constexpr size_t WS_WOUT = 21 * MiB;
constexpr size_t WS_WQ = 23 * MiB;
constexpr size_t WS_WKV = 25 * MiB;
constexpr size_t WS_WO = 29 * MiB;
constexpr size_t WS_MEMN = 31 * MiB;
constexpr size_t WS_KVM = 35 * MiB;
constexpr size_t WS_WG = 43 * MiB;
constexpr size_t WS_WU = 51 * MiB;
constexpr size_t WS_WD2 = 59 * MiB;
constexpr size_t WS_R0 = 96 * MiB;
constexpr size_t WS_R1 = 160 * MiB;
constexpr size_t WS_R2 = 224 * MiB;
constexpr size_t WS_R3 = 288 * MiB;
constexpr size_t WS_R4 = 320 * MiB;
constexpr size_t WS_R5 = 384 * MiB;
constexpr size_t WS_END = 448 * MiB;

constexpr size_t SM_RSTD0 = 0;
constexpr size_t SM_SSQR = 1 * 32768;
constexpr size_t SM_SSQS = 2 * 32768;
constexpr size_t SM_SSQ1 = 10 * 32768;
constexpr size_t SM_SSQ2 = 26 * 32768;
constexpr size_t SM_SSQ3 = 42 * 32768;
constexpr size_t SM_SELW = 58 * 32768;
constexpr size_t SM_SELE = 60 * 32768;
constexpr size_t SM_END = 62 * 32768;

__device__ __forceinline__ unsigned f2bf(float f) { unsigned u = __builtin_bit_cast(unsigned, f); return (u + 0x7fffu + ((u >> 16) & 1u)) >> 16; }
__device__ __forceinline__ float bf2f(unsigned short h) { return __builtin_bit_cast(float, (unsigned)h << 16); }
__device__ __forceinline__ float wave_sum(float v) {
#pragma unroll
    for (int o = 1; o < 64; o <<= 1) v += __shfl_xor(v, o);
    return v;
}
__device__ __forceinline__ float gelu_tanh(float x) { const float u = 0.7978845608028654f * (x + 0.044715f * x * x * x); return x * __builtin_amdgcn_rcpf(1.f + __expf(-2.f * u)); }
__device__ __forceinline__ float sigmoidf_(float x) { return 1.f / (1.f + __expf(-x)); }

namespace cg = cooperative_groups;
#ifndef PROBE_BLK
#define PROBE_BLK 0
#endif
#ifndef PROBE_A
#define PROBE_A -1
#endif
#ifndef REP_MASK
#define REP_MASK 0u
#endif
#define LAS __attribute__((address_space(3)))
constexpr int NWAVES = 8, NTHREADS = 512;
constexpr int LDS_BYTES = 147456;

struct Args { const float* in[29]; float* out; unsigned char* ws; };

struct Ctx {
    const float* in[29]; float* out; unsigned char* ws; unsigned char* lds;
    int tid, lane, wave, gw, NGW, G, bid;
};

#define RLX_AGENT __ATOMIC_RELAXED, __HIP_MEMORY_SCOPE_AGENT
#define XB_TMO      128
#define XB_XCNT(j)  (256  + 64 * (j))
#define XB_XSUB(j)  (1280 + 64 * (j))
#define XB_XGEN(j)  (2304 + 64 * (j))
#define XB_TOP      3328
#define XB_TOPGEN   3392
#define XCD_BAR_WORDS 3456
#define XB_SPIN_CAP (1u << 18)

__device__ __forceinline__ unsigned xb_ld(unsigned* p)              { return __hip_atomic_load(p, __ATOMIC_RELAXED, __HIP_MEMORY_SCOPE_AGENT); }
__device__ __forceinline__ unsigned xb_add(unsigned* p, unsigned v) { return __hip_atomic_fetch_add(p, v, __ATOMIC_RELAXED, __HIP_MEMORY_SCOPE_AGENT); }
__device__ __forceinline__ unsigned xb_xcc_id() { return (unsigned)__builtin_amdgcn_s_getreg((3 << 11) | 20) & 0xFu; }
#define XB_SPIN(cond, bar) do { unsigned _sp = 0; while (cond) { __builtin_amdgcn_s_sleep(1); \
    if ((++_sp & 255u) == 0u) { if (xb_ld(&(bar)[XB_TMO])) break; if (_sp > XB_SPIN_CAP) { atomicAdd(&(bar)[XB_TMO], 1u); break; } } } } while (0)

struct XcdBarrier {
    unsigned* bar; unsigned x;
    volatile LAS unsigned* st;
};

__device__ __forceinline__ XcdBarrier xcd_barrier_post(unsigned* bar, volatile LAS unsigned* st) {
    XcdBarrier b; b.bar = bar; b.x = xb_xcc_id(); b.st = st;
    if (threadIdx.x == 0) (void)xb_add(&bar[XB_XCNT(b.x)], 1u);
    return b;
}
__device__ __forceinline__ void xcd_barrier_complete(unsigned* bar, unsigned x, unsigned& nloc, unsigned& nx) {
    const unsigned G = gridDim.x * gridDim.y * gridDim.z;
    unsigned sum, cnt, mine, sp = 0u;
    for (;;) {
        sum = 0u; cnt = 0u; mine = 0u;
#pragma unroll
        for (unsigned j = 0; j < 16; ++j) { const unsigned c = xb_ld(&bar[XB_XCNT(j)]); sum += c; cnt += (c > 0u) ? 1u : 0u; mine = (j == x) ? c : mine; }
        if (sum == G) break;
        __builtin_amdgcn_s_sleep(1);
        if ((++sp & 255u) == 0u) { if (xb_ld(&bar[XB_TMO])) break; if (sp > XB_SPIN_CAP) { atomicAdd(&bar[XB_TMO], 1u); break; } }
    }
    nloc = mine > 0u ? mine : 1u; nx = cnt > 0u ? cnt : 1u;
}

__device__ __forceinline__ void xcd_barrier(const XcdBarrier& b) {
    asm volatile("s_waitcnt vmcnt(0)" ::: "memory");
    __syncthreads();
    if (threadIdx.x == 0) {
        unsigned* bar = b.bar;
        __builtin_amdgcn_s_waitcnt(0);
        unsigned nloc = b.st[0], nx = b.st[1];
        if (nloc == 0u) { xcd_barrier_complete(bar, b.x, nloc, nx); b.st[0] = nloc; b.st[1] = nx; }
        const unsigned old = xb_add(&bar[XB_XSUB(b.x)], 1u);
        const unsigned gen = old / nloc;
        if (old + 1u == (gen + 1u) * nloc) {
            __builtin_amdgcn_fence(__ATOMIC_RELEASE, "agent");
            asm volatile("s_waitcnt vmcnt(0)" ::: "memory");
            const unsigned og = xb_add(&bar[XB_TOP], 1u);
            const unsigned tg = og / nx;
            if (og + 1u == (tg + 1u) * nx) xb_add(&bar[XB_TOPGEN], 1u);
            else XB_SPIN(xb_ld(&bar[XB_TOPGEN]) == tg, bar);
            __builtin_amdgcn_fence(__ATOMIC_ACQUIRE, "agent");
            xb_add(&bar[XB_XGEN(b.x)], 1u);
            asm volatile("s_waitcnt vmcnt(0)" ::: "memory");
        } else {
            XB_SPIN(xb_ld(&bar[XB_XGEN(b.x)]) == gen, bar);
            __builtin_amdgcn_fence(__ATOMIC_ACQUIRE, "agent");
            asm volatile("s_waitcnt vmcnt(0)" ::: "memory");
        }
    }
    __syncthreads();
}
namespace pg8 {
#define PG8_LAS __attribute__((address_space(3)))
constexpr int BM = 256, BK = 64, HALF = 128, HTB = HALF * BK * 2  , STAGE_BYTES = 8 * HTB, NXCD = 8, WGM = 8;
__host__ __device__ __forceinline__ int lds_byte(int r, int c) { const int st = (r >> 4) * 2 + (c >> 5), rr = r & 15, cc = c & 31, ob = rr * 64 + cc * 2; return st * 1024 + (ob ^ (((ob >> 9) & 1) << 5)); }
__host__ __device__ __forceinline__ void stage_rc(int b, int& R, int& C) { const int st = b / 1024, sb = b % 1024, swz = sb ^ (((sb >> 9) & 1) << 5); R = (st >> 1) * 16 + swz / 64; C = (st & 1) * 32 + (swz % 64) / 2; }
__host__ __device__ __forceinline__ int perm32(int rho) { const int n = rho >> 4, i = rho & 15; return 8 * (i >> 2) + 4 * n + (i & 3); }

struct Unit { int pm, pn; };
struct Gemm { int lda, ldb, K; };
struct DenseOrder {
    const bf16_t* A; const bf16_t* Bt; int lda, ldb; int nM, nN, nwg, G, c; int ntk = D / BK;
    __device__ __forceinline__ int nt(const Unit&) const { return ntk; }
    __device__ __forceinline__ void init(const bf16_t* A_, int lda_, const bf16_t* Bt_, int ldb_, int M, int N, int G_, int c_) { A = A_; Bt = Bt_; lda = lda_; ldb = ldb_; nM = M / BM; nN = N / BM; nwg = nM * nN; G = G_; c = c_; }
    __device__ __forceinline__ bool next(int i, Unit& u) const {
        const long L = (long)i * G + c; if (L >= nwg) return false;
        int wgid = (int)L; { const int q = nwg / NXCD, r = nwg % NXCD, xcd = wgid % NXCD, off = wgid / NXCD; wgid = (xcd < r ? xcd * (q + 1) : r * (q + 1) + (xcd - r) * q) + off; }
        const int nig = WGM * nN, gid = wgid / nig, fm = gid * WGM, gsz = (nM - fm) < WGM ? (nM - fm) : WGM;
        u.pm = fm + ((wgid % nig) % gsz); u.pn = (wgid % nig) / gsz; return true;
    }
    __device__ __forceinline__ void ptrs(const Unit& u, const char*& a, const char*& b0, const char*& b1) const {
        a = (const char*)A + (size_t)u.pm * BM * lda * 2; b0 = (const char*)Bt + (size_t)u.pn * BM * ldb * 2; b1 = b0 + (size_t)HALF * ldb * 2; }
};

__device__ __forceinline__ unsigned cvt_pk_bf16(float lo, float hi) { unsigned r; asm volatile("v_cvt_pk_bf16_f32 %0, %1, %2" : "=v"(r) : "v"(lo), "v"(hi)); return r; }

template <class Epi, class Sched, bool ALIGN_EPI>
__device__ __forceinline__ void gemm_phase(PG8_LAS unsigned char* lds, const Gemm g, const Sched& S, const Epi& E, int pidx = 0) {
    int tid_ = threadIdx.x; asm volatile("" : "+v"(tid_));
    const int tid = tid_, wid = __builtin_amdgcn_readfirstlane(tid >> 6), lane = tid & 63, wr = wid >> 2, wc = wid & 3, fr = lane & 15, fq = lane >> 4;
    unsigned voffA[2], voffB[2];
#pragma unroll
    for (int i = 0; i < 2; ++i) { int R, C; stage_rc(tid * 16 + i * 8192, R, C); const int Rb = Epi::PERM ? ((R & ~31) + perm32(R & 31)) : R;
        voffA[i] = (unsigned)(R * g.lda + C) * 2u; voffB[i] = (unsigned)(Rb * g.ldb + C) * 2u; }
    const size_t kstep = (size_t)(BK * 2);
    const size_t hstepA = (size_t)HALF * g.lda * 2;
    const unsigned ldsw = (unsigned)wid * 1024u;
    const int aoff = lds_byte(wr * 64 + fr, fq * 8), boff = lds_byte(wc * 32 + fr, fq * 8);
#define PG8_SA(b, h) (((b) * 2 + (h)) * HTB)
#define PG8_SB(b, h) ((4 + (b) * 2 + (h)) * HTB)
#define PG8_STAGE(bufoff, gbase, voff) do { _Pragma("unroll") for (int _i = 0; _i < 2; ++_i) \
        __builtin_amdgcn_global_load_lds((const unsigned*)((const char*)(gbase) + (voff)[_i]), (PG8_LAS unsigned*)(lds + (bufoff) + ldsw + _i * 8192), 16, 0, 0); } while (0)
#define PG8_LDA(dst, b, h) do { _Pragma("unroll") for (int m = 0; m < 4; ++m) _Pragma("unroll") for (int k = 0; k < 2; ++k) dst[m][k] = *(const PG8_LAS bf16x8*)(lds + PG8_SA(b, h) + aoff + m * 2048 + k * 1024); } while (0)
#define PG8_LDB(dst, b, h) do { _Pragma("unroll") for (int n = 0; n < 2; ++n) _Pragma("unroll") for (int k = 0; k < 2; ++k) dst[n][k] = *(const PG8_LAS bf16x8*)(lds + PG8_SB(b, h) + boff + n * 2048 + k * 1024); } while (0)
#define PG8_MMA(ai, bj, At, Bt) do { __builtin_amdgcn_s_setprio(1); _Pragma("unroll") for (int m = 0; m < 4; ++m) _Pragma("unroll") for (int n = 0; n < 2; ++n) _Pragma("unroll") for (int k = 0; k < 2; ++k) \
        acc[ai][bj][m][n] = __builtin_amdgcn_mfma_f32_16x16x32_bf16(Bt[n][k], At[m][k], acc[ai][bj][m][n], 0, 0, 0); __builtin_amdgcn_s_setprio(0); } while (0)
#define PG8_WAIT_V(n) asm volatile("s_waitcnt vmcnt(" #n ")" ::: "memory")
#define PG8_WAIT_L(n) asm volatile("s_waitcnt lgkmcnt(" #n ")" ::: "memory")
#define PG8_BAR __builtin_amdgcn_s_barrier()
#define PG8_SCHED __builtin_amdgcn_sched_barrier(0)
    Unit cur, nxt; int ui = 0;
    if (!S.next(0, cur)) return;
    f32x4 acc[2][2][4][2];
#pragma unroll
    for (int a = 0; a < 2; ++a)
#pragma unroll
        for (int b = 0; b < 2; ++b)
#pragma unroll
            for (int m = 0; m < 4; ++m)
#pragma unroll
                for (int n = 0; n < 2; ++n) acc[a][b][m][n] = (f32x4){0.f, 0.f, 0.f, 0.f};
    bf16x8 At[4][2], B0[2][2], B1[2][2];
    const char *cA, *cB0, *cB1; S.ptrs(cur, cA, cB0, cB1);
    int nt = S.nt(cur); asm volatile("" : "+s"(nt));
    PG8_STAGE(PG8_SB(0, 0), cB0, voffB); PG8_STAGE(PG8_SB(0, 1), cB1, voffB); PG8_STAGE(PG8_SA(0, 0), cA, voffA); PG8_STAGE(PG8_SA(0, 1), cA + hstepA, voffA);
    if (wr == 1) PG8_BAR;
    PG8_WAIT_V(2); PG8_BAR;
    PG8_STAGE(PG8_SB(1, 0), cB0 + kstep, voffB); PG8_STAGE(PG8_SA(1, 0), cA + kstep, voffA); PG8_STAGE(PG8_SB(1, 1), cB1 + kstep, voffB);
    PG8_WAIT_V(6); PG8_BAR;
    for (;;) {
        const bool has_next = S.next(ui + 1, nxt);
        const char *nA = cA, *nB0 = cB0, *nB1 = cB1; if (has_next) S.ptrs(nxt, nA, nB0, nB1);
#pragma unroll 1
        for (int t = 0; t < nt; t += 2) {
            const bool last = (t == nt - 2);
            if constexpr (Epi::HAS_MID) { if (t == E.mid_t) E.mid(acc, cur, wr, wc, fr, fq); }
            const char* a1 = cA + (size_t)(t + 1) * kstep;
            const char* a2 = last ? nA : cA + (size_t)(t + 2) * kstep; const char* b2 = last ? nB0 : cB0 + (size_t)(t + 2) * kstep; const char* b2h = last ? nB1 : cB1 + (size_t)(t + 2) * kstep;
            const char* a3 = a2 + kstep; const char* b3 = b2 + kstep; const char* b3h = b2h + kstep;
            PG8_LDB(B0, 0, 0); PG8_LDB(B1, 0, 1); PG8_SCHED; PG8_LDA(At, 0, 0); PG8_STAGE(PG8_SA(1, 1), a1 + hstepA, voffA);
            PG8_WAIT_V(8); PG8_WAIT_L(0); PG8_BAR; PG8_MMA(0, 0, At, B0); PG8_MMA(0, 1, At, B1); PG8_BAR; PG8_SCHED;
            PG8_LDA(At, 0, 1); PG8_STAGE(PG8_SB(0, 0), b2, voffB); PG8_STAGE(PG8_SB(0, 1), b2h, voffB); PG8_STAGE(PG8_SA(0, 0), a2, voffA);
            PG8_WAIT_V(8); PG8_WAIT_L(0); PG8_BAR; PG8_MMA(1, 0, At, B0); PG8_MMA(1, 1, At, B1); PG8_BAR; PG8_SCHED;
            PG8_LDB(B0, 1, 0); PG8_LDB(B1, 1, 1); PG8_SCHED; PG8_LDA(At, 1, 0); PG8_STAGE(PG8_SA(0, 1), a2 + hstepA, voffA);
            PG8_WAIT_V(8); PG8_WAIT_L(0); PG8_BAR; PG8_MMA(0, 0, At, B0); PG8_MMA(0, 1, At, B1); PG8_BAR; PG8_SCHED;
            PG8_LDA(At, 1, 1); PG8_STAGE(PG8_SB(1, 0), b3, voffB); PG8_STAGE(PG8_SB(1, 1), b3h, voffB); PG8_STAGE(PG8_SA(1, 0), a3, voffA);
            PG8_WAIT_V(8); PG8_WAIT_L(0); PG8_BAR; PG8_MMA(1, 0, At, B0); PG8_MMA(1, 1, At, B1); PG8_BAR; PG8_SCHED;
        }
        if constexpr (ALIGN_EPI) { if (wr == 0) PG8_BAR; }
        { unsigned long long te_ = 0; if (PROBE_A >= 500 && blockIdx.x == 0 && tid == 0) te_ = __builtin_amdgcn_s_memrealtime();
        E(acc, cur, wr, wc, fr, fq);
        if (PROBE_A >= 500 && blockIdx.x == 0 && tid == 0) { PG8_LAS unsigned long long* es_ = (PG8_LAS unsigned long long*)(lds + 147200) + 16 + pidx; *es_ += __builtin_amdgcn_s_memrealtime() - te_; } }
        if (!has_next) break;
#pragma unroll
        for (int a = 0; a < 2; ++a)
#pragma unroll
            for (int b = 0; b < 2; ++b)
#pragma unroll
                for (int m = 0; m < 4; ++m)
#pragma unroll
                    for (int n = 0; n < 2; ++n) acc[a][b][m][n] = (f32x4){0.f, 0.f, 0.f, 0.f};
        cur = nxt; cA = nA; cB0 = nB0; cB1 = nB1; ++ui; nt = S.nt(cur); asm volatile("" : "+s"(nt));
        if constexpr (ALIGN_EPI) { if (wr == 1) PG8_BAR; }
    }
    PG8_WAIT_V(0);
    if constexpr (!ALIGN_EPI) { if (wr == 0) PG8_BAR; }
    PG8_BAR;
#undef PG8_SA
#undef PG8_SB
#undef PG8_STAGE
#undef PG8_LDA
#undef PG8_LDB
#undef PG8_MMA
#undef PG8_WAIT_V
#undef PG8_WAIT_L
#undef PG8_BAR
#undef PG8_SCHED
}

template <class Epi, class Sched, bool ALIGN_EPI>
__device__ __forceinline__ void gemm_phase_gather(PG8_LAS unsigned char* lds, const Gemm g, const Sched& S, const Epi& E, int pidx = 0) {
    int tid_ = threadIdx.x; asm volatile("" : "+v"(tid_));
    const int tid = tid_, wid = __builtin_amdgcn_readfirstlane(tid >> 6), lane = tid & 63, wr = wid >> 2, wc = wid & 3, fr = lane & 15, fq = lane >> 4;
    unsigned voffB[2], vAc[2][2], vAn[2][2];
#pragma unroll
    for (int i = 0; i < 2; ++i) { int R, C; stage_rc(tid * 16 + i * 8192, R, C); const int Rb = Epi::PERM ? ((R & ~31) + perm32(R & 31)) : R;
        voffB[i] = (unsigned)(Rb * g.ldb + C) * 2u; }
#define PG8_LOADVA(v, ui_) do { _Pragma("unroll") for (int h_ = 0; h_ < 2; ++h_) _Pragma("unroll") for (int i_ = 0; i_ < 2; ++i_) { int R_, C_; stage_rc(tid * 16 + i_ * 8192, R_, C_); \
        v[h_][i_] = S.aoff(ui_, h_ * HALF + R_) + (unsigned)C_ * 2u; } } while (0)
    const size_t kstep = (size_t)(BK * 2);
    const unsigned ldsw = (unsigned)wid * 1024u;
    const int aoff = lds_byte(wr * 64 + fr, fq * 8), boff = lds_byte(wc * 32 + fr, fq * 8);
#define PG8_SA(b, h) (((b) * 2 + (h)) * HTB)
#define PG8_SB(b, h) ((4 + (b) * 2 + (h)) * HTB)
#define PG8_STAGE(bufoff, gbase, voff) do { _Pragma("unroll") for (int _i = 0; _i < 2; ++_i) \
        __builtin_amdgcn_global_load_lds((const unsigned*)((const char*)(gbase) + (voff)[_i]), (PG8_LAS unsigned*)(lds + (bufoff) + ldsw + _i * 8192), 16, 0, 0); } while (0)
#define PG8_LDA(dst, b, h) do { _Pragma("unroll") for (int m = 0; m < 4; ++m) _Pragma("unroll") for (int k = 0; k < 2; ++k) dst[m][k] = *(const PG8_LAS bf16x8*)(lds + PG8_SA(b, h) + aoff + m * 2048 + k * 1024); } while (0)
#define PG8_LDB(dst, b, h) do { _Pragma("unroll") for (int n = 0; n < 2; ++n) _Pragma("unroll") for (int k = 0; k < 2; ++k) dst[n][k] = *(const PG8_LAS bf16x8*)(lds + PG8_SB(b, h) + boff + n * 2048 + k * 1024); } while (0)
#define PG8_MMA(ai, bj, At, Bt) do { __builtin_amdgcn_s_setprio(1); _Pragma("unroll") for (int m = 0; m < 4; ++m) _Pragma("unroll") for (int n = 0; n < 2; ++n) _Pragma("unroll") for (int k = 0; k < 2; ++k) \
        acc[ai][bj][m][n] = __builtin_amdgcn_mfma_f32_16x16x32_bf16(Bt[n][k], At[m][k], acc[ai][bj][m][n], 0, 0, 0); __builtin_amdgcn_s_setprio(0); } while (0)
#define PG8_WAIT_V(n) asm volatile("s_waitcnt vmcnt(" #n ")" ::: "memory")
#define PG8_WAIT_L(n) asm volatile("s_waitcnt lgkmcnt(" #n ")" ::: "memory")
#define PG8_BAR __builtin_amdgcn_s_barrier()
#define PG8_SCHED __builtin_amdgcn_sched_barrier(0)
    Unit cur, nxt; int ui = 0;
    if (!S.next(0, cur)) return;
    f32x4 acc[2][2][4][2];
#pragma unroll
    for (int a = 0; a < 2; ++a)
#pragma unroll
        for (int b = 0; b < 2; ++b)
#pragma unroll
            for (int m = 0; m < 4; ++m)
#pragma unroll
                for (int n = 0; n < 2; ++n) acc[a][b][m][n] = (f32x4){0.f, 0.f, 0.f, 0.f};
    bf16x8 At[4][2], B0[2][2], B1[2][2];
    const char *cA, *cB0, *cB1; S.ptrs(cur, cA, cB0, cB1);
    PG8_LOADVA(vAc, 0);
    int nt = S.nt(cur); asm volatile("" : "+s"(nt));
    PG8_STAGE(PG8_SB(0, 0), cB0, voffB); PG8_STAGE(PG8_SB(0, 1), cB1, voffB); PG8_STAGE(PG8_SA(0, 0), cA, vAc[0]); PG8_STAGE(PG8_SA(0, 1), cA, vAc[1]);
    if (wr == 1) PG8_BAR;
    PG8_WAIT_V(2); PG8_BAR;
    PG8_STAGE(PG8_SB(1, 0), cB0 + kstep, voffB); PG8_STAGE(PG8_SA(1, 0), cA + kstep, vAc[0]); PG8_STAGE(PG8_SB(1, 1), cB1 + kstep, voffB);
    PG8_WAIT_V(6); PG8_BAR;
    for (;;) {
        const bool has_next = S.next(ui + 1, nxt);
        const char *nA = cA, *nB0 = cB0, *nB1 = cB1; if (has_next) { S.ptrs(nxt, nA, nB0, nB1); PG8_LOADVA(vAn, ui + 1); } else { _Pragma("unroll") for (int h_ = 0; h_ < 2; ++h_) _Pragma("unroll") for (int i_ = 0; i_ < 2; ++i_) vAn[h_][i_] = vAc[h_][i_]; }
#pragma unroll 1
        for (int t = 0; t < nt; t += 2) {
            const bool last = (t == nt - 2);
            if constexpr (Epi::HAS_MID) { if (t == E.mid_t) E.mid(acc, cur, wr, wc, fr, fq); }
            const char* a1 = cA + (size_t)(t + 1) * kstep;
            const char* a2 = cA + (size_t)(last ? 0 : t + 2) * kstep; unsigned vs0[2], vs1[2]; vs0[0] = last ? vAn[0][0] : vAc[0][0]; vs0[1] = last ? vAn[0][1] : vAc[0][1]; vs1[0] = last ? vAn[1][0] : vAc[1][0]; vs1[1] = last ? vAn[1][1] : vAc[1][1]; const char* b2 = last ? nB0 : cB0 + (size_t)(t + 2) * kstep; const char* b2h = last ? nB1 : cB1 + (size_t)(t + 2) * kstep;
            const char* a3 = a2 + kstep; const char* b3 = b2 + kstep; const char* b3h = b2h + kstep;
            PG8_LDB(B0, 0, 0); PG8_LDB(B1, 0, 1); PG8_SCHED; PG8_LDA(At, 0, 0); PG8_STAGE(PG8_SA(1, 1), a1, vAc[1]);
            PG8_WAIT_V(8); PG8_WAIT_L(0); PG8_BAR; PG8_MMA(0, 0, At, B0); PG8_MMA(0, 1, At, B1); PG8_BAR; PG8_SCHED;
            PG8_LDA(At, 0, 1); PG8_STAGE(PG8_SB(0, 0), b2, voffB); PG8_STAGE(PG8_SB(0, 1), b2h, voffB); PG8_STAGE(PG8_SA(0, 0), a2, vs0);
            PG8_WAIT_V(8); PG8_WAIT_L(0); PG8_BAR; PG8_MMA(1, 0, At, B0); PG8_MMA(1, 1, At, B1); PG8_BAR; PG8_SCHED;
            PG8_LDB(B0, 1, 0); PG8_LDB(B1, 1, 1); PG8_SCHED; PG8_LDA(At, 1, 0); PG8_STAGE(PG8_SA(0, 1), a2, vs1);
            PG8_WAIT_V(8); PG8_WAIT_L(0); PG8_BAR; PG8_MMA(0, 0, At, B0); PG8_MMA(0, 1, At, B1); PG8_BAR; PG8_SCHED;
            PG8_LDA(At, 1, 1); PG8_STAGE(PG8_SB(1, 0), b3, voffB); PG8_STAGE(PG8_SB(1, 1), b3h, voffB); PG8_STAGE(PG8_SA(1, 0), a3, vs0);
            PG8_WAIT_V(8); PG8_WAIT_L(0); PG8_BAR; PG8_MMA(1, 0, At, B0); PG8_MMA(1, 1, At, B1); PG8_BAR; PG8_SCHED;
        }
        if constexpr (ALIGN_EPI) { if (wr == 0) PG8_BAR; }
        { unsigned long long te_ = 0; if (PROBE_A >= 500 && blockIdx.x == 0 && tid == 0) te_ = __builtin_amdgcn_s_memrealtime();
        E(acc, cur, wr, wc, fr, fq);
        if (PROBE_A >= 500 && blockIdx.x == 0 && tid == 0) { PG8_LAS unsigned long long* es_ = (PG8_LAS unsigned long long*)(lds + 147200) + 16 + pidx; *es_ += __builtin_amdgcn_s_memrealtime() - te_; } }
        if (!has_next) break;
#pragma unroll
        for (int a = 0; a < 2; ++a)
#pragma unroll
            for (int b = 0; b < 2; ++b)
#pragma unroll
                for (int m = 0; m < 4; ++m)
#pragma unroll
                    for (int n = 0; n < 2; ++n) acc[a][b][m][n] = (f32x4){0.f, 0.f, 0.f, 0.f};
        cur = nxt; cA = nA; cB0 = nB0; cB1 = nB1; ++ui;
#pragma unroll
        for (int h_ = 0; h_ < 2; ++h_)
#pragma unroll
            for (int i_ = 0; i_ < 2; ++i_) vAc[h_][i_] = vAn[h_][i_]; nt = S.nt(cur); asm volatile("" : "+s"(nt));
        if constexpr (ALIGN_EPI) { if (wr == 1) PG8_BAR; }
    }
    PG8_WAIT_V(0);
    if constexpr (!ALIGN_EPI) { if (wr == 0) PG8_BAR; }
    PG8_BAR;
#undef PG8_LOADVA
#undef PG8_SA
#undef PG8_SB
#undef PG8_STAGE
#undef PG8_LDA
#undef PG8_LDB
#undef PG8_MMA
#undef PG8_WAIT_V
#undef PG8_WAIT_L
#undef PG8_BAR
#undef PG8_SCHED
}


__device__ __forceinline__ float rstd16(const float* p) { const f32x4 a = ((const f32x4*)p)[0], b = ((const f32x4*)p)[1], c = ((const f32x4*)p)[2], d = ((const f32x4*)p)[3];
    const float s = ((a.x + a.y) + (a.z + a.w)) + ((b.x + b.y) + (b.z + b.w)) + ((c.x + c.y) + (c.z + c.w)) + ((d.x + d.y) + (d.z + d.w)); return __builtin_amdgcn_rsqf(s * (1.f / D) + EPS); }
__device__ __forceinline__ u32x4 pack8(const f32x4 v0, const f32x4 v1) { u32x4 w; w.x = cvt_pk_bf16(v0[0], v0[1]); w.y = cvt_pk_bf16(v0[2], v0[3]); w.z = cvt_pk_bf16(v1[0], v1[1]); w.w = cvt_pk_bf16(v1[2], v1[3]); return w; }
__device__ __forceinline__ float sq8(const f32x4 a, const f32x4 b) { return ((a[0] * a[0] + a[1] * a[1]) + (a[2] * a[2] + a[3] * a[3])) + ((b[0] * b[0] + b[1] * b[1]) + (b[2] * b[2] + b[3] * b[3])); }

struct EpiInProjF {
    static constexpr bool PERM = true, HAS_MID = false; int mid_t;
    const float* rstd0; bf16_t *XR, *GG, *Qs, *Ks, *Vs; unsigned* kmax;
    __device__ __forceinline__ void mid(f32x4 (&)[2][2][4][2], const Unit&, int, int, int, int) const {}
    __device__ __forceinline__ void operator()(const f32x4 (&acc)[2][2][4][2], const Unit& u, int wr, int wc, int fr, int fq) const {
        const int row0 = u.pm * BM + wr * 64 + fr, t = u.pn >> 1, colt = (u.pn & 1) * 256 + wc * 32 + 8 * fq;
        bf16_t* base = (t == 0) ? XR : (t == 1) ? GG : (t == 2) ? Qs : (t == 3) ? Ks : Vs;
        float km0 = 0.f, km1 = 0.f;
#pragma unroll
        for (int ai = 0; ai < 2; ++ai)
#pragma unroll
            for (int m = 0; m < 4; ++m) { const int r = row0 + ai * HALF + m * 16; const float rs = rstd0[r]; bf16_t* rowp = base + (size_t)r * 512 + colt;
#pragma unroll
                for (int bj = 0; bj < 2; ++bj) { f32x4 v0 = acc[ai][bj][m][0] * rs, v1 = acc[ai][bj][m][1] * rs;
                    if (t == 1) {
#pragma unroll
                        for (int e = 0; e < 4; ++e) { v0[e] = gelu_tanh(v0[e]); v1[e] = gelu_tanh(v1[e]); } }
                    else if (t == 2) { v0 = v0 * (0.125f * LOG2E); v1 = v1 * (0.125f * LOG2E); }
                    else if (t == 3) { float mx = 0.f;
#pragma unroll
                        for (int e = 0; e < 4; ++e) mx = fmaxf(mx, fmaxf(fabsf(v0[e]), fabsf(v1[e])));
                        if (bj == 0) km0 = fmaxf(km0, mx); else km1 = fmaxf(km1, mx); }
                    *(u32x4*)(rowp + bj * HALF) = pack8(v0, v1); } }
        if (t == 3) {
#pragma unroll
            for (int o = 1; o < 64; o <<= 1) { km0 = fmaxf(km0, __shfl_xor(km0, o)); km1 = fmaxf(km1, __shfl_xor(km1, o)); }
            if ((fr | fq) == 0) { const int b = (u.pm * BM) / SEQ, hd = (u.pn & 1) * 4 + (wc >> 1);
                atomicMax(kmax + b * 8 + hd, __float_as_uint(km0)); atomicMax(kmax + b * 8 + hd + 2, __float_as_uint(km1)); }
        }
    }
};
struct EpiBf16F {
    static constexpr bool PERM = true, HAS_MID = false; int mid_t;
    bf16_t* O; const float* ssq16; int ldo; float scale; size_t tstride;
    __device__ __forceinline__ void mid(f32x4 (&)[2][2][4][2], const Unit&, int, int, int, int) const {}
    __device__ __forceinline__ void operator()(const f32x4 (&acc)[2][2][4][2], const Unit& u, int wr, int wc, int fr, int fq) const {
        const int row0 = u.pm * BM + wr * 64 + fr, col0 = (tstride ? 0 : u.pn * BM) + wc * 32 + 8 * fq; bf16_t* base = O + (size_t)u.pn * tstride;
#pragma unroll
        for (int ai = 0; ai < 2; ++ai)
#pragma unroll
            for (int m = 0; m < 4; ++m) { const int r = row0 + ai * HALF + m * 16; const float rs = (ssq16 ? rstd16(ssq16 + (size_t)r * 16) : 1.f) * scale; bf16_t* rowp = base + (size_t)r * ldo + col0;
#pragma unroll
                for (int bj = 0; bj < 2; ++bj) *(u32x4*)(rowp + bj * HALF) = pack8(acc[ai][bj][m][0] * rs, acc[ai][bj][m][1] * rs); }
    }
};
struct EpiX1F {
    static constexpr bool PERM = true, HAS_MID = true; int mid_t;
    const bf16_t* xb; const float* fmid; const float* fend; bf16_t* X1b; float* ssq1;
    __device__ __forceinline__ void mid(f32x4 (&acc)[2][2][4][2], const Unit& u, int wr, int wc, int fr, int fq) const {
        const int row0 = u.pm * BM + wr * 64 + fr;
#pragma unroll
        for (int ai = 0; ai < 2; ++ai)
#pragma unroll
            for (int m = 0; m < 4; ++m) { const float f = fmid[row0 + ai * HALF + m * 16];
#pragma unroll
                for (int bj = 0; bj < 2; ++bj) { acc[ai][bj][m][0] = acc[ai][bj][m][0] * f; acc[ai][bj][m][1] = acc[ai][bj][m][1] * f; } }
    }
    __device__ __forceinline__ void operator()(const f32x4 (&acc)[2][2][4][2], const Unit& u, int wr, int wc, int fr, int fq) const {
        const int row0 = u.pm * BM + wr * 64 + fr, col0 = u.pn * BM + wc * 32 + 8 * fq;
#pragma unroll
        for (int ai = 0; ai < 2; ++ai)
#pragma unroll
            for (int m = 0; m < 4; ++m) { const int r = row0 + ai * HALF + m * 16; const float fe = fend[r]; float ss = 0.f;
#pragma unroll
                for (int bj = 0; bj < 2; ++bj) { const u32x4 xi = *(const u32x4*)(xb + (size_t)r * D + col0 + bj * HALF);
                    f32x4 v0, v1; v0[0] = __uint_as_float(xi.x << 16); v0[1] = __uint_as_float(xi.x & 0xffff0000u); v0[2] = __uint_as_float(xi.y << 16); v0[3] = __uint_as_float(xi.y & 0xffff0000u);
                    v1[0] = __uint_as_float(xi.z << 16); v1[1] = __uint_as_float(xi.z & 0xffff0000u); v1[2] = __uint_as_float(xi.w << 16); v1[3] = __uint_as_float(xi.w & 0xffff0000u);
                    v0 = v0 + acc[ai][bj][m][0] * fe; v1 = v1 + acc[ai][bj][m][1] * fe;
                    ss += sq8(v0, v1); *(u32x4*)(X1b + (size_t)r * D + col0 + bj * HALF) = pack8(v0, v1); }
                ss += __shfl_xor(ss, 16); ss += __shfl_xor(ss, 32);
                if (fq == 0) ssq1[(size_t)r * 16 + u.pn * 4 + wc] = ss; }
    }
};
struct EpiResF {
    static constexpr bool PERM = true, HAS_MID = false; int mid_t;
    const bf16_t* Xi; bf16_t* Xo; float* ssq;
    __device__ __forceinline__ void mid(f32x4 (&)[2][2][4][2], const Unit&, int, int, int, int) const {}
    __device__ __forceinline__ void operator()(const f32x4 (&acc)[2][2][4][2], const Unit& u, int wr, int wc, int fr, int fq) const {
        const int row0 = u.pm * BM + wr * 64 + fr, col0 = u.pn * BM + wc * 32 + 8 * fq;
#pragma unroll
        for (int ai = 0; ai < 2; ++ai)
#pragma unroll
            for (int m = 0; m < 4; ++m) { const int r = row0 + ai * HALF + m * 16; float ss = 0.f;
#pragma unroll
                for (int bj = 0; bj < 2; ++bj) { const u32x4 xi = *(const u32x4*)(Xi + (size_t)r * D + col0 + bj * HALF);
                    f32x4 v0, v1; v0[0] = __uint_as_float(xi.x << 16); v0[1] = __uint_as_float(xi.x & 0xffff0000u); v0[2] = __uint_as_float(xi.y << 16); v0[3] = __uint_as_float(xi.y & 0xffff0000u);
                    v1[0] = __uint_as_float(xi.z << 16); v1[1] = __uint_as_float(xi.z & 0xffff0000u); v1[2] = __uint_as_float(xi.w << 16); v1[3] = __uint_as_float(xi.w & 0xffff0000u);
                    v0 = v0 + acc[ai][bj][m][0]; v1 = v1 + acc[ai][bj][m][1];
                    ss += sq8(v0, v1); *(u32x4*)(Xo + (size_t)r * D + col0 + bj * HALF) = pack8(v0, v1); }
                ss += __shfl_xor(ss, 16); ss += __shfl_xor(ss, 32);
                if (fq == 0) ssq[(size_t)r * 16 + u.pn * 4 + wc] = ss; }
    }
};

__device__ __forceinline__ void pair_ab(int p, int& a, int& b) { a = (p < 3) ? 0 : (p < 5) ? 1 : 2; b = (p < 3) ? p + 1 : (p < 5) ? p - 1 : 3; }
__device__ __forceinline__ int moe_class_of_tile(const PG8_LAS int* meta, int T) { int c = 0;
#pragma unroll
    for (int k = 1; k < 24; ++k) c += (T >= __builtin_amdgcn_readfirstlane(meta[64 + k])) ? 1 : 0;
    return c; }
struct MoeOrder1 {
    __device__ __forceinline__ int nt(const Unit&) const { return D / BK; }
    const bf16_t* XG; const bf16_t* Wg; const bf16_t* Wu; const PG8_LAS int* meta; int G, c;
    __device__ __forceinline__ bool next(int i, Unit& u) const { const int L = i * G + c, nt = __builtin_amdgcn_readfirstlane(meta[64 + 24]); if (L >= nt * 4) return false;
        u.pm = L >> 2; u.pn = moe_class_of_tile(meta, L >> 2) * 4 + (L & 3); return true; }
    __device__ __forceinline__ void ptrs(const Unit& u, const char*& a, const char*& b0, const char*& b1) const {
        const int cls = u.pn >> 2, j = (u.pn >> 1) & 1, half = u.pn & 1; int ea, eb; pair_ab(cls % 6, ea, eb); const int e = (cls / 6) * 4 + (j ? eb : ea);
        a = (const char*)XG + (size_t)u.pm * BM * D * 2; const size_t bo = ((size_t)e * DE + half * HALF) * D * 2; b0 = (const char*)Wg + bo; b1 = (const char*)Wu + bo; }
};
struct MoeOrder2 {
    __device__ __forceinline__ int nt(const Unit&) const { return 512 / BK; }
    const bf16_t* HID; const bf16_t* Wd2; const PG8_LAS int* meta; int G, c;
    __device__ __forceinline__ bool next(int i, Unit& u) const { const int L = i * G + c, nt = __builtin_amdgcn_readfirstlane(meta[64 + 24]); if (L >= nt * 4) return false;
        u.pm = L >> 2; u.pn = moe_class_of_tile(meta, L >> 2) * 4 + (L & 3); return true; }
    __device__ __forceinline__ void ptrs(const Unit& u, const char*& a, const char*& b0, const char*& b1) const {
        a = (const char*)HID + (size_t)u.pm * BM * 512 * 2; b0 = (const char*)Wd2 + ((size_t)(u.pn >> 2) * D + (u.pn & 3) * BM) * 512 * 2; b1 = b0 + (size_t)HALF * 512 * 2; }
};
struct EpiMoeUp {
    static constexpr bool PERM = true, HAS_MID = false; int mid_t;
    const float* rsg; const float* wAg; const float* wBg; bf16_t* HID;
    __device__ __forceinline__ void mid(f32x4 (&)[2][2][4][2], const Unit&, int, int, int, int) const {}
    __device__ __forceinline__ void operator()(const f32x4 (&acc)[2][2][4][2], const Unit& u, int wr, int wc, int fr, int fq) const {
        const int row0 = u.pm * BM + wr * 64 + fr, j = (u.pn >> 1) & 1, col0 = j * 256 + (u.pn & 1) * HALF + wc * 32 + 8 * fq; const float* wg = j ? wBg : wAg;
#pragma unroll
        for (int ai = 0; ai < 2; ++ai)
#pragma unroll
            for (int m = 0; m < 4; ++m) { const int r = row0 + ai * HALF + m * 16; const float rs = rsg[r], w = wg[r]; f32x4 h0, h1;
#pragma unroll
                for (int e = 0; e < 4; ++e) { const float g0 = acc[ai][0][m][0][e] * rs, g1 = acc[ai][0][m][1][e] * rs;
                    h0[e] = g0 * __builtin_amdgcn_rcpf(1.f + __expf(-g0)) * (acc[ai][1][m][0][e] * rs) * w; h1[e] = g1 * __builtin_amdgcn_rcpf(1.f + __expf(-g1)) * (acc[ai][1][m][1][e] * rs) * w; }
                *(u32x4*)(HID + (size_t)r * 512 + col0) = pack8(h0, h1); }
    }
};

struct MoeOrder1G {
    const bf16_t* X2b; const bf16_t* Wg; const bf16_t* Wu; const PG8_LAS int* meta; const PG8_LAS int* tokl; unsigned zoff; int G, c;
    __device__ __forceinline__ int nt(const Unit&) const { return D / BK; }
    __device__ __forceinline__ bool next(int i, Unit& u) const { const int L = i * G + c, nt_ = __builtin_amdgcn_readfirstlane(meta[64 + 24]); if (L >= nt_ * 4) return false;
        u.pm = L >> 2; u.pn = (moe_class_of_tile(meta, L >> 2) * 4 + (L & 3)) | (i << 16); return true; }
    __device__ __forceinline__ unsigned aoff(int ui, int row) const { const int tok = tokl[ui * BM + row]; return tok >= 0 ? (unsigned)tok * (unsigned)(D * 2) : zoff; }
    __device__ __forceinline__ void ptrs(const Unit& u, const char*& a, const char*& b0, const char*& b1) const {
        const int pn = u.pn & 0xffff, cls = pn >> 2, j = (pn >> 1) & 1, half = pn & 1; int ea, eb; pair_ab(cls % 6, ea, eb); const int e = (cls / 6) * 4 + (j ? eb : ea);
        a = (const char*)X2b; const size_t bo = ((size_t)e * DE + half * HALF) * D * 2; b0 = (const char*)Wg + bo; b1 = (const char*)Wu + bo; }
};
struct EpiMoeUpG {
    static constexpr bool PERM = true, HAS_MID = false; int mid_t;
    const PG8_LAS int* tokl; const float* rstok; const float* selw; bf16_t* HID;
    __device__ __forceinline__ void mid(f32x4 (&)[2][2][4][2], const Unit&, int, int, int, int) const {}
    __device__ __forceinline__ void operator()(const f32x4 (&acc)[2][2][4][2], const Unit& u, int wr, int wc, int fr, int fq) const {
        const int pn = u.pn & 0xffff, ui = u.pn >> 16, j = (pn >> 1) & 1, col0 = j * 256 + (pn & 1) * HALF + wc * 32 + 8 * fq, rl0 = wr * 64 + fr;
#pragma unroll
        for (int ai = 0; ai < 2; ++ai)
#pragma unroll
            for (int m = 0; m < 4; ++m) { const int rl = rl0 + ai * HALF + m * 16, tok = tokl[ui * BM + rl]; float rs = 0.f, w = 0.f; if (tok >= 0) { rs = rstok[tok]; w = selw[(size_t)tok * 2 + j]; } f32x4 h0, h1;
#pragma unroll
                for (int e = 0; e < 4; ++e) { const float g0 = acc[ai][0][m][0][e] * rs, g1 = acc[ai][0][m][1][e] * rs;
                    h0[e] = g0 * __builtin_amdgcn_rcpf(1.f + __expf(-g0)) * (acc[ai][1][m][0][e] * rs) * w; h1[e] = g1 * __builtin_amdgcn_rcpf(1.f + __expf(-g1)) * (acc[ai][1][m][1][e] * rs) * w; }
                *(u32x4*)(HID + (size_t)(u.pm * BM + rl) * 512 + col0) = pack8(h0, h1); }
    }
};
struct EpiMoeDown {
    static constexpr bool PERM = true, HAS_MID = false; int mid_t;
    const int* tokg; const bf16_t* Xi; bf16_t* Xo; float* ssq;
    __device__ __forceinline__ void mid(f32x4 (&)[2][2][4][2], const Unit&, int, int, int, int) const {}
    __device__ __forceinline__ void operator()(const f32x4 (&acc)[2][2][4][2], const Unit& u, int wr, int wc, int fr, int fq) const {
        const int row0 = u.pm * BM + wr * 64 + fr, ct = u.pn & 3, col0 = ct * BM + wc * 32 + 8 * fq;
#pragma unroll
        for (int ai = 0; ai < 2; ++ai)
#pragma unroll
            for (int m = 0; m < 4; ++m) { const int tok = tokg[row0 + ai * HALF + m * 16];
                if (tok >= 0) { float ss = 0.f;
#pragma unroll
                    for (int bj = 0; bj < 2; ++bj) { const u32x4 xi = *(const u32x4*)(Xi + (size_t)tok * D + col0 + bj * HALF);
                        f32x4 v0, v1; v0[0] = __uint_as_float(xi.x << 16); v0[1] = __uint_as_float(xi.x & 0xffff0000u); v0[2] = __uint_as_float(xi.y << 16); v0[3] = __uint_as_float(xi.y & 0xffff0000u);
                        v1[0] = __uint_as_float(xi.z << 16); v1[1] = __uint_as_float(xi.z & 0xffff0000u); v1[2] = __uint_as_float(xi.w << 16); v1[3] = __uint_as_float(xi.w & 0xffff0000u);
                        v0 = v0 + acc[ai][bj][m][0]; v1 = v1 + acc[ai][bj][m][1];
                        ss += sq8(v0, v1); *(u32x4*)(Xo + (size_t)tok * D + col0 + bj * HALF) = pack8(v0, v1); }
                    ss += __shfl_xor(ss, 16); ss += __shfl_xor(ss, 32);
                    if (fq == 0) ssq[(size_t)tok * 16 + ct * 4 + wc] = ss; } }
    }
};

struct XaChainOrder {
    const bf16_t* X1b; const bf16_t* Wq_t; const bf16_t* QX; const bf16_t* KM; const bf16_t* VT; int G, c, nu;
    __device__ __forceinline__ void init(int G_, int c_) { G = G_; c = c_; const int tot = (NTOK / BM) * XH; nu = (tot - c + G - 1) / G; }
    __device__ __forceinline__ bool next(int i, Unit& u) const { if (i >= 3 * nu) return false; const int kind = i / nu, L = (i % nu) * G + c; u.pm = L >> 2; u.pn = (L & 3) | (kind << 8); return true; }
    __device__ __forceinline__ int nt(const Unit& u) const { return (u.pn >> 8) == 0 ? D / BK : XD / BK; }
    __device__ __forceinline__ void ptrs(const Unit& u, const char*& a, const char*& b0, const char*& b1) const {
        const int kind = u.pn >> 8, h = u.pn & 3, b = u.pm / (SEQ / BM);
        if (kind == 0) { a = (const char*)X1b + (size_t)u.pm * BM * D * 2; b0 = (const char*)Wq_t + (size_t)h * XD * D * 2; }
        else { a = (const char*)QX + ((size_t)u.pm * BM * D + h * XD) * 2;
            b0 = (kind == 1) ? (const char*)KM + ((size_t)b * MEM * D + h * XD) * 2 : (const char*)VT + ((size_t)b * D + h * XD) * D * 2; }
        b1 = b0 + (size_t)HALF * D * 2; }
};
struct EpiXaChain {
    static constexpr bool PERM = true, HAS_MID = false; int mid_t;
    bf16_t* QX; bf16_t* OX; const float* ssq1; float qscale; PG8_LAS float* xch;
    __device__ __forceinline__ void mid(f32x4 (&)[2][2][4][2], const Unit&, int, int, int, int) const {}
    __device__ __forceinline__ void operator()(f32x4 (&acc)[2][2][4][2], const Unit& u, int wr, int wc, int fr, int fq) const {
        const int kind = u.pn >> 8, row0 = u.pm * BM + wr * 64 + fr, col0 = (u.pn & 3) * XD + wc * 32 + 8 * fq;
        if (kind != 1) {
            bf16_t* O = kind == 0 ? QX : OX;
#pragma unroll
            for (int ai = 0; ai < 2; ++ai)
#pragma unroll
                for (int m = 0; m < 4; ++m) { const int r = row0 + ai * HALF + m * 16; const float rs = kind == 0 ? rstd16(ssq1 + (size_t)r * 16) * qscale : 1.f; bf16_t* rowp = O + (size_t)r * D + col0;
#pragma unroll
                    for (int bj = 0; bj < 2; ++bj) *(u32x4*)(rowp + bj * HALF) = pack8(acc[ai][bj][m][0] * rs, acc[ai][bj][m][1] * rs); }
            return;
        }
        PG8_LAS float* xm = xch; PG8_LAS float* xs = xch + 1024;
#pragma unroll
        for (int ai = 0; ai < 2; ++ai)
#pragma unroll
            for (int m = 0; m < 4; ++m) { float mx = -INFINITY;
#pragma unroll
                for (int bj = 0; bj < 2; ++bj)
#pragma unroll
                    for (int n = 0; n < 2; ++n) { const f32x4 v = acc[ai][bj][m][n]; mx = fmaxf(mx, fmaxf(fmaxf(v[0], v[1]), fmaxf(v[2], v[3]))); }
                mx = fmaxf(mx, __shfl_xor(mx, 16)); mx = fmaxf(mx, __shfl_xor(mx, 32));
                if (fq == 0) xm[(ai * HALF + wr * 64 + m * 16 + fr) * 4 + wc] = mx; asm volatile("" ::: "memory"); }
        asm volatile("s_waitcnt lgkmcnt(0)" ::: "memory"); __builtin_amdgcn_s_barrier(); asm volatile("" ::: "memory");
#pragma unroll
        for (int ai = 0; ai < 2; ++ai)
#pragma unroll
            for (int m = 0; m < 4; ++m) { const int rl = ai * HALF + wr * 64 + m * 16 + fr; const f32x4 q = *(const PG8_LAS f32x4*)(xm + rl * 4);
                const float mx = fmaxf(fmaxf(q[0], q[1]), fmaxf(q[2], q[3])); float ss = 0.f;
#pragma unroll
                for (int bj = 0; bj < 2; ++bj)
#pragma unroll
                    for (int n = 0; n < 2; ++n) { f32x4 v = acc[ai][bj][m][n];
#pragma unroll
                        for (int e = 0; e < 4; ++e) { v[e] = __builtin_amdgcn_exp2f(v[e] - mx); ss += v[e]; }
                        acc[ai][bj][m][n] = v; }
                ss += __shfl_xor(ss, 16); ss += __shfl_xor(ss, 32);
                if (fq == 0) xs[rl * 4 + wc] = ss; asm volatile("" ::: "memory"); }
        asm volatile("s_waitcnt lgkmcnt(0)" ::: "memory"); __builtin_amdgcn_s_barrier(); asm volatile("" ::: "memory");
#pragma unroll
        for (int ai = 0; ai < 2; ++ai)
#pragma unroll
            for (int m = 0; m < 4; ++m) { const int rl = ai * HALF + wr * 64 + m * 16 + fr; const f32x4 q = *(const PG8_LAS f32x4*)(xs + rl * 4);
                const float inv = __builtin_amdgcn_rcpf((q[0] + q[1]) + (q[2] + q[3])); bf16_t* rowp = QX + (size_t)(row0 + ai * HALF + m * 16) * D + col0;
#pragma unroll
                for (int bj = 0; bj < 2; ++bj) *(u32x4*)(rowp + bj * HALF) = pack8(acc[ai][bj][m][0] * inv, acc[ai][bj][m][1] * inv); asm volatile("" ::: "memory"); }
    }
};

struct XaPreOrder {
    const bf16_t* KM; const bf16_t* VM; const bf16_t* WqN; const bf16_t* Wo_t; int G, c;
    __device__ __forceinline__ bool next(int i, Unit& u) const { const int L = i * G + c; if (L >= 256) return false; u.pm = 0; u.pn = L; return true; }
    __device__ __forceinline__ int nt(const Unit&) const { return XD / BK; }
    __device__ __forceinline__ void ptrs(const Unit& u, const char*& a, const char*& b0, const char*& b1) const {
        const int L = u.pn, h = L & 3;
        if (L < 128) { const int b = L >> 4, kt = (L >> 2) & 3; a = (const char*)KM + ((size_t)b * MEM * D + h * XD) * 2; b0 = (const char*)WqN + ((size_t)kt * BM * D + h * XD) * 2; }
        else { const int nt_ = (L >> 5) & 3, b = (L >> 2) & 7; a = (const char*)Wo_t + ((size_t)nt_ * BM * D + h * XD) * 2; b0 = (const char*)VM + ((size_t)b * MEM * D + h * XD) * 2; }
        b1 = b0 + (size_t)HALF * D * 2; }
};
struct EpiXaPre {
    static constexpr bool PERM = true, HAS_MID = false; int mid_t;
    bf16_t* MT; bf16_t* NT;
    __device__ __forceinline__ void mid(f32x4 (&)[2][2][4][2], const Unit&, int, int, int, int) const {}
    __device__ __forceinline__ void operator()(const f32x4 (&acc)[2][2][4][2], const Unit& u, int wr, int wc, int fr, int fq) const {
        const int L = u.pn, h = L & 3, cw = wc * 32 + 8 * fq; bf16_t* base;
        if (L < 128) { const int b = L >> 4, kt = (L >> 2) & 3; base = MT + ((size_t)b * D + h * XD) * D + kt * BM; }
        else { const int nt_ = (L >> 5) & 3, b = (L >> 2) & 7; base = NT + ((size_t)b * D + nt_ * BM) * D + h * XD; }
#pragma unroll
        for (int ai = 0; ai < 2; ++ai)
#pragma unroll
            for (int m = 0; m < 4; ++m) { bf16_t* rowp = base + (size_t)(ai * HALF + wr * 64 + m * 16 + fr) * D + cw;
#pragma unroll
                for (int bj = 0; bj < 2; ++bj) *(u32x4*)(rowp + bj * HALF) = pack8(acc[ai][bj][m][0], acc[ai][bj][m][1]); }
    }
};
struct BatchedOrder {
    const bf16_t* A; const bf16_t* W; int G, c;
    __device__ __forceinline__ bool next(int i, Unit& u) const { const int L = i * G + c; if (L >= (NTOK / BM) * 4) return false; u.pm = L >> 2; u.pn = L & 3; return true; }
    __device__ __forceinline__ int nt(const Unit&) const { return D / BK; }
    __device__ __forceinline__ void ptrs(const Unit& u, const char*& a, const char*& b0, const char*& b1) const {
        const int b = u.pm / (SEQ / BM); a = (const char*)A + (size_t)u.pm * BM * D * 2; b0 = (const char*)W + ((size_t)b * D + u.pn * BM) * D * 2; b1 = b0 + (size_t)HALF * D * 2; }
};
struct EpiXaSoftmax {
    static constexpr bool PERM = true, HAS_MID = false; int mid_t;
    bf16_t* P; const float* ssq1; float qscale; PG8_LAS float* xch;
    __device__ __forceinline__ void mid(f32x4 (&)[2][2][4][2], const Unit&, int, int, int, int) const {}
    __device__ __forceinline__ void operator()(f32x4 (&acc)[2][2][4][2], const Unit& u, int wr, int wc, int fr, int fq) const {
        const int row0 = u.pm * BM + wr * 64 + fr, col0 = u.pn * XD + wc * 32 + 8 * fq;
        PG8_LAS float* xm = xch; PG8_LAS float* xs = xch + 1024;
#pragma unroll
        for (int ai = 0; ai < 2; ++ai)
#pragma unroll
            for (int m = 0; m < 4; ++m) { const float rs = rstd16(ssq1 + (size_t)(row0 + ai * HALF + m * 16) * 16) * qscale; float mx = -INFINITY;
#pragma unroll
                for (int bj = 0; bj < 2; ++bj)
#pragma unroll
                    for (int n = 0; n < 2; ++n) { const f32x4 v = acc[ai][bj][m][n] * rs; acc[ai][bj][m][n] = v; mx = fmaxf(mx, fmaxf(fmaxf(v[0], v[1]), fmaxf(v[2], v[3]))); }
                mx = fmaxf(mx, __shfl_xor(mx, 16)); mx = fmaxf(mx, __shfl_xor(mx, 32));
                if (fq == 0) xm[(ai * HALF + wr * 64 + m * 16 + fr) * 4 + wc] = mx; asm volatile("" ::: "memory"); }
        asm volatile("s_waitcnt lgkmcnt(0)" ::: "memory"); __builtin_amdgcn_s_barrier(); asm volatile("" ::: "memory");
#pragma unroll
        for (int ai = 0; ai < 2; ++ai)
#pragma unroll
            for (int m = 0; m < 4; ++m) { const int rl = ai * HALF + wr * 64 + m * 16 + fr; const f32x4 q = *(const PG8_LAS f32x4*)(xm + rl * 4);
                const float mx = fmaxf(fmaxf(q[0], q[1]), fmaxf(q[2], q[3])); float ss = 0.f;
#pragma unroll
                for (int bj = 0; bj < 2; ++bj)
#pragma unroll
                    for (int n = 0; n < 2; ++n) { f32x4 v = acc[ai][bj][m][n];
#pragma unroll
                        for (int e = 0; e < 4; ++e) { v[e] = __builtin_amdgcn_exp2f(v[e] - mx); ss += v[e]; }
                        acc[ai][bj][m][n] = v; }
                ss += __shfl_xor(ss, 16); ss += __shfl_xor(ss, 32);
                if (fq == 0) xs[rl * 4 + wc] = ss; asm volatile("" ::: "memory"); }
        asm volatile("s_waitcnt lgkmcnt(0)" ::: "memory"); __builtin_amdgcn_s_barrier(); asm volatile("" ::: "memory");
#pragma unroll
        for (int ai = 0; ai < 2; ++ai)
#pragma unroll
            for (int m = 0; m < 4; ++m) { const int rl = ai * HALF + wr * 64 + m * 16 + fr; const f32x4 q = *(const PG8_LAS f32x4*)(xs + rl * 4);
                const float inv = __builtin_amdgcn_rcpf((q[0] + q[1]) + (q[2] + q[3])); bf16_t* rowp = P + (size_t)(row0 + ai * HALF + m * 16) * D + col0;
#pragma unroll
                for (int bj = 0; bj < 2; ++bj) *(u32x4*)(rowp + bj * HALF) = pack8(acc[ai][bj][m][0] * inv, acc[ai][bj][m][1] * inv); asm volatile("" ::: "memory"); }
    }
};


struct OneUnitOrder {
    const bf16_t* A; const bf16_t* Bt; int lda, ldb, pm, pn, ntk;
    static constexpr bool GATHER = false;
    __device__ __forceinline__ bool next(int i, Unit& u) const { if (i > 0) return false; u.pm = pm; u.pn = pn; return true; }
    __device__ __forceinline__ int nt(const Unit&) const { return ntk; }
    __device__ __forceinline__ void ptrs(const Unit& u, const char*& a, const char*& b0, const char*& b1) const {
        a = (const char*)A + (size_t)u.pm * BM * lda * 2; b0 = (const char*)Bt + (size_t)u.pn * BM * ldb * 2; b1 = b0 + (size_t)HALF * ldb * 2; }
};
struct EpiKvN {
    static constexpr bool PERM = true, HAS_MID = false; int mid_t;
    bf16_t* KM; bf16_t* VM;
    __device__ __forceinline__ void mid(f32x4 (&)[2][2][4][2], const Unit&, int, int, int, int) const {}
    __device__ __forceinline__ void operator()(const f32x4 (&acc)[2][2][4][2], const Unit& u, int wr, int wc, int fr, int fq) const {
        bf16_t* base = (u.pn < 4 ? KM : VM) + (u.pn & 3) * BM + wc * 32 + 8 * fq; const int row0 = u.pm * BM + wr * 64 + fr;
#pragma unroll
        for (int ai = 0; ai < 2; ++ai)
#pragma unroll
            for (int m = 0; m < 4; ++m) { bf16_t* rowp = base + (size_t)(row0 + ai * HALF + m * 16) * D;
#pragma unroll
                for (int bj = 0; bj < 2; ++bj) *(u32x4*)(rowp + bj * HALF) = pack8(acc[ai][bj][m][0], acc[ai][bj][m][1]); }
    }
};
struct KvOrder {
    __device__ __forceinline__ int nt(const Unit&) const { return D / BK; }
    const bf16_t* memn; const bf16_t* Wk_t; const bf16_t* Wv_t; int G, c;
    __device__ __forceinline__ bool next(int i, Unit& u) const { const int L = i * G + c; if (L >= 64) return false; if (L < 32) { u.pm = L >> 2; u.pn = L & 3; } else { u.pm = (L - 32) >> 3; u.pn = ((L - 32) & 7) | 256; } return true; }
    __device__ __forceinline__ void ptrs(const Unit& u, const char*& a, const char*& b0, const char*& b1) const {
        const bool vt = (u.pn & 256) != 0; const int pn = u.pn & 255;
        a = (const char*)(vt ? Wv_t : memn) + (size_t)u.pm * BM * D * 2; b0 = (const char*)(vt ? memn : Wk_t) + (size_t)pn * BM * D * 2; b1 = b0 + (size_t)HALF * D * 2; }
};
struct EpiKv {
    static constexpr bool PERM = true, HAS_MID = false; int mid_t;
    bf16_t* KM; bf16_t* VT;
    __device__ __forceinline__ void mid(f32x4 (&)[2][2][4][2], const Unit&, int, int, int, int) const {}
    __device__ __forceinline__ void operator()(const f32x4 (&acc)[2][2][4][2], const Unit& u, int wr, int wc, int fr, int fq) const {
        const bool vt = (u.pn & 256) != 0; const int pn = u.pn & 255, row0 = u.pm * BM + wr * 64 + fr, cw = wc * 32 + 8 * fq;
        bf16_t* base = vt ? VT + (size_t)pn * D * D : KM + pn * BM; const int ldo = D;
#pragma unroll
        for (int ai = 0; ai < 2; ++ai)
#pragma unroll
            for (int m = 0; m < 4; ++m) { bf16_t* rowp = base + (size_t)(row0 + ai * HALF + m * 16) * ldo + cw;
#pragma unroll
                for (int bj = 0; bj < 2; ++bj) *(u32x4*)(rowp + bj * HALF) = pack8(acc[ai][bj][m][0], acc[ai][bj][m][1]); }
    }
};

struct EpiMoeFinal {
    static constexpr bool PERM = true, HAS_MID = false; int mid_t;
    const int* tokg; const bf16_t* Xi; float* out; float* ssq; unsigned* cnt; const float* g; PG8_LAS unsigned* flag; unsigned* tmo;
    __device__ __forceinline__ void mid(f32x4 (&)[2][2][4][2], const Unit&, int, int, int, int) const {}
    __device__ __forceinline__ void operator()(f32x4 (&acc)[2][2][4][2], const Unit& u, int wr, int wc, int fr, int fq) const {
        const int row0 = u.pm * BM + wr * 64 + fr, ct = u.pn & 3, col0 = ct * BM + wc * 32 + 8 * fq;
#pragma unroll
        for (int ai = 0; ai < 2; ++ai)
#pragma unroll
            for (int m = 0; m < 4; ++m) { const int tok = tokg[row0 + ai * HALF + m * 16];
                if (tok >= 0) { float ss = 0.f;
#pragma unroll
                    for (int bj = 0; bj < 2; ++bj) { const u32x4 xi = *(const u32x4*)(Xi + (size_t)tok * D + col0 + bj * HALF);
                        f32x4 v0, v1; v0[0] = __uint_as_float(xi.x << 16); v0[1] = __uint_as_float(xi.x & 0xffff0000u); v0[2] = __uint_as_float(xi.y << 16); v0[3] = __uint_as_float(xi.y & 0xffff0000u);
                        v1[0] = __uint_as_float(xi.z << 16); v1[1] = __uint_as_float(xi.z & 0xffff0000u); v1[2] = __uint_as_float(xi.w << 16); v1[3] = __uint_as_float(xi.w & 0xffff0000u);
                        v0 = v0 + acc[ai][bj][m][0]; v1 = v1 + acc[ai][bj][m][1]; acc[ai][bj][m][0] = v0; acc[ai][bj][m][1] = v1; ss += sq8(v0, v1); }
                    ss += __shfl_xor(ss, 16); ss += __shfl_xor(ss, 32);
                    if (fq == 0) __hip_atomic_store(ssq + (size_t)tok * 16 + ct * 4 + wc, ss, __ATOMIC_RELAXED, __HIP_MEMORY_SCOPE_AGENT); }
                asm volatile("" ::: "memory"); }
        asm volatile("s_waitcnt vmcnt(0) lgkmcnt(0)" ::: "memory"); __builtin_amdgcn_s_barrier(); asm volatile("" ::: "memory");
        const int tid = threadIdx.x;
        if (tid < 64) {
            if (tid == 0) __hip_atomic_fetch_add(cnt + 16 * u.pm, 1u, __ATOMIC_RELAXED, __HIP_MEMORY_SCOPE_AGENT);
            unsigned spins = 0; bool dead = false;
            while ((unsigned)__builtin_amdgcn_readfirstlane(__hip_atomic_load(cnt + 16 * u.pm, __ATOMIC_RELAXED, __HIP_MEMORY_SCOPE_AGENT)) < 4u) {
                __builtin_amdgcn_s_sleep(2); if (++spins > (1u << 20)) { dead = true; break; } }
            __builtin_amdgcn_fence(__ATOMIC_ACQUIRE, "agent");
            if (tid == 0) { flag[0] = dead ? 1u : 0u; if (dead) __hip_atomic_store(tmo, 1u, __ATOMIC_RELAXED, __HIP_MEMORY_SCOPE_AGENT); }
        }
        asm volatile("s_waitcnt vmcnt(0) lgkmcnt(0)" ::: "memory"); __builtin_amdgcn_s_barrier(); asm volatile("" ::: "memory");
        f32x4 gv[2][2];
#pragma unroll
        for (int bj = 0; bj < 2; ++bj) { gv[bj][0] = *(const f32x4*)(g + col0 + bj * HALF); gv[bj][1] = *(const f32x4*)(g + col0 + bj * HALF + 4); }
#pragma unroll
        for (int ai = 0; ai < 2; ++ai)
#pragma unroll
            for (int m = 0; m < 4; ++m) { const int tok = tokg[row0 + ai * HALF + m * 16];
                if (tok >= 0) { const float rs = rstd16(ssq + (size_t)tok * 16); float* orow = out + (size_t)tok * D + col0;
#pragma unroll
                    for (int bj = 0; bj < 2; ++bj) { *(f32x4*)(orow + bj * HALF) = acc[ai][bj][m][0] * rs * gv[bj][0]; *(f32x4*)(orow + bj * HALF + 4) = acc[ai][bj][m][1] * rs * gv[bj][1]; } }
                asm volatile("" ::: "memory"); }
    }
};
}
namespace sba {
typedef float f32x16 __attribute__((ext_vector_type(16)));
typedef short s16x4 __attribute__((ext_vector_type(4)));
typedef short v4i16_t __attribute__((ext_vector_type(4)));
typedef __attribute__((address_space(3))) const char* lds_cptr;
constexpr int SLOTB = 8192, L_K = 0, L_V = 2 * SLOTB, L_FLAG = 4 * SLOTB, L_OST = L_FLAG + 256, L_BYTES = L_OST + 8 * 4096;
__device__ __forceinline__ int crow(int r, int hi) { return (r & 3) + 8 * (r >> 2) + 4 * hi; }
__device__ __forceinline__ void glds16(const void* gsrc, unsigned lds_dst) { unsigned keep;
    asm volatile("s_mov_b32 %0, m0\n\ts_mov_b32 m0, %2\n\ts_nop 0\n\tglobal_load_lds_dwordx4 %1, off\n\ts_mov_b32 m0, %0" : "=&s"(keep) : "v"(gsrc), "s"(lds_dst) : "memory"); }
typedef float f32x2_t __attribute__((ext_vector_type(2))); typedef __bf16 bf16x2_t __attribute__((ext_vector_type(2)));
__device__ __forceinline__ unsigned cvtpk(float lo, float hi) { f32x2_t v = {lo, hi}; bf16x2_t b = __builtin_convertvector(v, bf16x2_t); return __builtin_bit_cast(unsigned, b); }
__device__ __forceinline__ s16x4 vtr(lds_cptr p) { return __builtin_bit_cast(s16x4, __builtin_amdgcn_ds_read_tr16_b64_v4i16((__attribute__((address_space(3))) v4i16_t*)p)); }

#define SBA_GROUP(Z, OM, g) do { \
        float d_ = acc_ * (hi ? 1.f : gp_##OM[g]); acc_ *= gs_##OM[g] * gp_##OM[g]; \
        Z[4 * (g) + 3] *= d_; d_ *= OM[4 * (g) + 3]; Z[4 * (g) + 2] *= d_; d_ *= OM[4 * (g) + 2]; Z[4 * (g) + 1] *= d_; d_ *= OM[4 * (g) + 1]; Z[4 * (g)] *= d_; } while (0)

__device__ __forceinline__ void sb_unit(int b, int h, int qb, const bf16_t* Qs, const bf16_t* Ks, const bf16_t* Vs, bf16_t* YY, float* ssq_s8, char* shm) {
    int tid_ = threadIdx.x; asm volatile("" : "+v"(tid_));
    const int tid = tid_, lane = tid & 63, r32 = lane & 31, hi = lane >> 5; const int wid = __builtin_amdgcn_readfirstlane(tid >> 6);
#define SSTAMP(k) do { if (PROBE_A >= 300 && PROBE_A < 400 && blockIdx.x == PROBE_BLK && b == 0 && tid == 0) ((__attribute__((address_space(3))) unsigned long long*)(shm + 147200))[16 + (k)] = __builtin_amdgcn_s_memrealtime(); } while (0)
    SSTAMP(0);
    const size_t rowbase = (size_t)b * SEQ; const int q0 = qb * 256;
    const bf16_t* Kh = Ks + rowbase * SBW + h * HD; const bf16_t* Vh = Vs + rowbase * SBW + h * HD;
    const unsigned lds0 = (unsigned)(uintptr_t)shm;
    const lds_cptr shm3 = (lds_cptr)shm;
    const bf16_t* ksrc = Kh + (size_t)lane * SBW + wid * 8;
    const bf16_t* vsrc = Vh + (size_t)(16 * (wid & 3) + (lane >> 2)) * SBW + (wid >> 2) * 32 + (lane & 3) * 8;
    const unsigned kdst = lds0 + L_K + wid * 1024, vdst = lds0 + L_V + wid * 1024;
#define DMA_KV(t, slot) do { glds16(ksrc + (size_t)(t) * 64 * SBW, (unsigned)__builtin_amdgcn_readfirstlane(kdst + (slot))); glds16(vsrc + (size_t)(t) * 64 * SBW, (unsigned)__builtin_amdgcn_readfirstlane(vdst + (slot))); } while (0)
    const lds_cptr kp0 = shm3 + L_K + hi * 1024 + r32 * 16;
    const lds_cptr vp0 = shm3 + L_V + ((lane >> 4) & 1) * 32 + (lane & 3) * 8 + (4 * hi + ((lane & 15) >> 2)) * 64;
    volatile __attribute__((address_space(3))) unsigned* flags = (volatile __attribute__((address_space(3))) unsigned*)(shm3 + L_FLAG);
    int tile = 4 * qb + 3, slot = 0, it = 0;
    DMA_KV(tile, 0);
    const bf16_t* Qw = Qs + (rowbase + q0 + wid * 32 + r32) * SBW + h * HD;
    bf16x8 qr[4];
#pragma unroll
    for (int d0 = 0; d0 < 4; ++d0) qr[d0] = *(const bf16x8*)(Qw + d0 * 16 + hi * 8);
    float qn = 0.f;
#pragma unroll
    for (int d0 = 0; d0 < 4; ++d0)
#pragma unroll
        for (int e = 0; e < 8; ++e) qn += fabsf(bf2f((unsigned short)qr[d0][e]));
    qn += __shfl_xor(qn, 32);
    const int tq = q0 + wid * 32 + r32;
    const int tq_min = q0 + wid * 32, tq_max = tq_min + 31;
    float PR = 1.f;
    f32x16 o0 = {}, o1 = {};
    for (;;) {
        if (it < 4) SSTAMP(1 + it);
        const bool has_next = tile > 0;
        if (has_next) { DMA_KV(tile - 1, slot ^ SLOTB); asm volatile("s_waitcnt vmcnt(2)" ::: "memory"); }
        else asm volatile("s_waitcnt vmcnt(0)" ::: "memory");
        __builtin_amdgcn_s_barrier(); asm volatile("" ::: "memory");
        const int kmin = tile * 64;
        if (kmin < tq_max) {
            f32x16 z0, z1;
            {
                const lds_cptr kb = kp0 + slot; bf16x8 kf[8];
#pragma unroll
                for (int d0 = 0; d0 < 4; ++d0) { kf[2 * d0] = *(const __attribute__((address_space(3))) bf16x8*)(kb + d0 * 2048); kf[2 * d0 + 1] = *(const __attribute__((address_space(3))) bf16x8*)(kb + d0 * 2048 + 512); }
                __builtin_amdgcn_sched_barrier(0);
                z0 = __builtin_amdgcn_mfma_f32_32x32x16_bf16(kf[0], qr[0], (f32x16){}, 0, 0, 0); z1 = __builtin_amdgcn_mfma_f32_32x32x16_bf16(kf[1], qr[0], (f32x16){}, 0, 0, 0);
#pragma unroll
                for (int d0 = 1; d0 < 4; ++d0) { z0 = __builtin_amdgcn_mfma_f32_32x32x16_bf16(kf[2 * d0], qr[d0], z0, 0, 0, 0); z1 = __builtin_amdgcn_mfma_f32_32x32x16_bf16(kf[2 * d0 + 1], qr[d0], z1, 0, 0, 0); }
            }
            if (kmin + 63 >= tq_min) {
#pragma unroll
                for (int r = 0; r < 16; ++r) { const int kv = kmin + crow(r, hi); if (kv >= tq) z0[r] = -INFINITY; if (kv + 32 >= tq) z1[r] = -INFINITY; }
            }
            f32x16 m0, m1;
#pragma unroll
            for (int r = 0; r < 16; ++r) { const float e0 = __builtin_amdgcn_exp2f(fminf(z0[r], 120.f)), e1 = __builtin_amdgcn_exp2f(fminf(z1[r], 120.f));
                m0[r] = __builtin_amdgcn_rcpf(1.f + e0); m1[r] = __builtin_amdgcn_rcpf(1.f + e1); z0[r] = e0 * m0[r]; z1[r] = e1 * m1[r]; }
            float gs_m0[4], gs_m1[4], gp_m0[4], gp_m1[4];
#pragma unroll
            for (int g = 0; g < 4; ++g) { gs_m0[g] = (m0[4 * g] * m0[4 * g + 1]) * (m0[4 * g + 2] * m0[4 * g + 3]); gs_m1[g] = (m1[4 * g] * m1[4 * g + 1]) * (m1[4 * g + 2] * m1[4 * g + 3]); }
#pragma unroll
            for (int g = 0; g < 4; ++g) { const auto r0 = __builtin_amdgcn_permlane32_swap(__float_as_uint(gs_m0[g]), __float_as_uint(gs_m0[g]), false, false), r1 = __builtin_amdgcn_permlane32_swap(__float_as_uint(gs_m1[g]), __float_as_uint(gs_m1[g]), false, false);
                gp_m0[g] = __uint_as_float(hi ? r0[0] : r0[1]); gp_m1[g] = __uint_as_float(hi ? r1[0] : r1[1]); }
            float acc_ = PR;
            SBA_GROUP(z1, m1, 3); SBA_GROUP(z1, m1, 2); SBA_GROUP(z1, m1, 1); SBA_GROUP(z1, m1, 0);
            SBA_GROUP(z0, m0, 3); SBA_GROUP(z0, m0, 2); SBA_GROUP(z0, m0, 1); SBA_GROUP(z0, m0, 0);
            PR = acc_;
            u32x4 pw0, pw1, pw2, pw3;
            pw0 = (u32x4){cvtpk(z0[0], z0[1]), cvtpk(z0[2], z0[3]), cvtpk(z0[4], z0[5]), cvtpk(z0[6], z0[7])};
            pw1 = (u32x4){cvtpk(z0[8], z0[9]), cvtpk(z0[10], z0[11]), cvtpk(z0[12], z0[13]), cvtpk(z0[14], z0[15])};
            pw2 = (u32x4){cvtpk(z1[0], z1[1]), cvtpk(z1[2], z1[3]), cvtpk(z1[4], z1[5]), cvtpk(z1[6], z1[7])};
            pw3 = (u32x4){cvtpk(z1[8], z1[9]), cvtpk(z1[10], z1[11]), cvtpk(z1[12], z1[13]), cvtpk(z1[14], z1[15])};
            const lds_cptr vp = vp0 + slot;
#define SBA_VF(i) (bf16x8){vl[i][0], vl[i][1], vl[i][2], vl[i][3], vh[i][0], vh[i][1], vh[i][2], vh[i][3]}
            { s16x4 vl[4], vh[4];
#pragma unroll
                for (int i = 0; i < 4; ++i) { vl[i] = vtr(vp + i * 1024); vh[i] = vtr(vp + i * 1024 + 512); }
                __builtin_amdgcn_sched_barrier(0);
                o0 = __builtin_amdgcn_mfma_f32_32x32x16_bf16(__builtin_bit_cast(bf16x8, pw0), SBA_VF(0), o0, 0, 0, 0); o0 = __builtin_amdgcn_mfma_f32_32x32x16_bf16(__builtin_bit_cast(bf16x8, pw1), SBA_VF(1), o0, 0, 0, 0);
                o0 = __builtin_amdgcn_mfma_f32_32x32x16_bf16(__builtin_bit_cast(bf16x8, pw2), SBA_VF(2), o0, 0, 0, 0); o0 = __builtin_amdgcn_mfma_f32_32x32x16_bf16(__builtin_bit_cast(bf16x8, pw3), SBA_VF(3), o0, 0, 0, 0); }
            { s16x4 vl[4], vh[4];
#pragma unroll
                for (int i = 0; i < 4; ++i) { vl[i] = vtr(vp + 4096 + i * 1024); vh[i] = vtr(vp + 4096 + i * 1024 + 512); }
                __builtin_amdgcn_sched_barrier(0);
                o1 = __builtin_amdgcn_mfma_f32_32x32x16_bf16(__builtin_bit_cast(bf16x8, pw0), SBA_VF(0), o1, 0, 0, 0); o1 = __builtin_amdgcn_mfma_f32_32x32x16_bf16(__builtin_bit_cast(bf16x8, pw1), SBA_VF(1), o1, 0, 0, 0);
                o1 = __builtin_amdgcn_mfma_f32_32x32x16_bf16(__builtin_bit_cast(bf16x8, pw2), SBA_VF(2), o1, 0, 0, 0); o1 = __builtin_amdgcn_mfma_f32_32x32x16_bf16(__builtin_bit_cast(bf16x8, pw3), SBA_VF(3), o1, 0, 0, 0); }
#undef SBA_VF
        }
        const bool done = __all(PR == 0.f);
        if (lane == 0) flags[(it & 1) * 8 + wid] = done ? 1u : 0u;
        asm volatile("s_waitcnt lgkmcnt(0)" ::: "memory"); __builtin_amdgcn_s_barrier(); asm volatile("" ::: "memory");
        unsigned alld = 1u;
#pragma unroll
        for (int w = 0; w < 8; ++w) alld &= flags[(it & 1) * 8 + w];
        alld = __builtin_amdgcn_readfirstlane(alld);
        if (!has_next || alld) break;
        --tile; slot ^= SLOTB; ++it;
    }
    SSTAMP(5);
    if (PROBE_A >= 300 && PROBE_A < 400 && blockIdx.x == PROBE_BLK && b == 0 && tid == 0) { __attribute__((address_space(3))) unsigned long long* st_ = (__attribute__((address_space(3))) unsigned long long*)(shm + 147200) + 16; st_[8] = 0; st_[9] = (unsigned long long)(it + 1) * 100ull; }
    asm volatile("s_waitcnt vmcnt(0)" ::: "memory");
    {
        bf16_t* Ow = YY + (rowbase + q0 + wid * 32) * D + RW + h * HD;
        bf16_t* stg = (bf16_t*)(shm + L_OST) + wid * 2048;
#pragma unroll
        for (int r = 0; r < 16; ++r) { const int orow = crow(r, hi); stg[orow * 64 + r32] = (bf16_t)f2bf(o0[r]); stg[orow * 64 + 32 + r32] = (bf16_t)f2bf(o1[r]); }
        asm volatile("s_waitcnt lgkmcnt(0)" ::: "memory");
#pragma unroll
        for (int i = 0; i < 4; ++i) { const int row = i * 8 + (lane >> 3), ch = lane & 7; const u32x4 v = *(const u32x4*)(stg + row * 64 + ch * 8);
            *(u32x4*)(Ow + (size_t)row * D + ch * 8) = v;
            float ss = 0.f;
#pragma unroll
            for (int e = 0; e < 4; ++e) { const float lo = __uint_as_float(v[e] << 16), hh = __uint_as_float(v[e] & 0xffff0000u); ss += lo * lo + hh * hh; }
            ss += __shfl_xor(ss, 1); ss += __shfl_xor(ss, 2); ss += __shfl_xor(ss, 4);
            if (ch == 0) ssq_s8[(rowbase + q0 + wid * 32 + row) * 8 + h] = ss; }
    }
    asm volatile("s_waitcnt lgkmcnt(0)" ::: "memory"); __builtin_amdgcn_s_barrier(); asm volatile("" ::: "memory");
    SSTAMP(6);
#undef SSTAMP
#undef DMA_KV
}
#undef SBA_GROUP
}
namespace lru {
typedef float f32x16 __attribute__((ext_vector_type(16)));
constexpr int XS_ROWS = 67, XS_BYTES = XS_ROWS * 1024  , XC_PITCH = 1040  , XC_OFF = 68608, HC_OFF = XC_OFF + 64 * XC_PITCH  , L_BYTES = HC_OFF + 2048;
__device__ __forceinline__ int crow(int r, int hi) { return (r & 3) + 8 * (r >> 2) + 4 * hi; }

struct Weights { bf16x8 wa[2][4], wx[2][4]; float ba[2], bx[2], spl[2]; };
__device__ __forceinline__ void load_weights(Weights& W, int h, int r32, int hi, const float* w_a, const float* b_a, const float* w_x, const float* b_x, const float* lam) {
#pragma unroll
    for (int nt = 0; nt < 2; ++nt) {
#pragma unroll
        for (int s = 0; s < 4; ++s) {
#pragma unroll
            for (int e = 0; e < 8; ++e) { const size_t idx = ((size_t)(h * 64 + 16 * s + 8 * hi + e)) * 64 + 32 * nt + r32;
                W.wa[nt][s][e] = (short)f2bf(w_a[idx]); W.wx[nt][s][e] = (short)f2bf(w_x[idx]); }
            asm volatile("" ::: "memory");
        }
        const int c = h * 64 + 32 * nt + r32; W.ba[nt] = b_a[c]; W.bx[nt] = b_x[c];
        const float l = lam[c]; W.spl[nt] = (l > 15.f) ? __expf(-l) : log1pf(__expf(-l));
    }
}

template <bool PASSB>
__device__ __forceinline__ void pair_unit(int b, int pj, const Weights& W, const bf16_t* XR, const bf16_t* GG, const float* conv_w, const float* conv_b,
                                     float* aggP, float* aggH, const float* ssq_s8, bf16_t* YY, float* fmid, float* fend, unsigned char* shm) {
    int tid_ = threadIdx.x; asm volatile("" : "+v"(tid_));
    const int tid = tid_, lane = tid & 63, r32 = lane & 31, hi = lane >> 5, wid = __builtin_amdgcn_readfirstlane(tid >> 6);
    LAS unsigned char* L = (LAS unsigned char*)shm;
#define LSTAMP(k) do { if (PROBE_A >= 200 && PROBE_A < 300 && PASSB && blockIdx.x == 63 && b == 0 && tid == 0) ((LAS unsigned long long*)(shm + 147200))[16 + (k)] = __builtin_amdgcn_s_memrealtime(); } while (0)
    LSTAMP(0);
    const size_t rowbase = (size_t)b * SEQ; const int h = wid;
    float Hc[2] = {0.f, 0.f}, Pc[2] = {1.f, 1.f};
#pragma unroll
    for (int half = 0; half < 2; ++half) {
    const int t0 = (2 * pj + half) * 64;
    f32x4 cp_[PASSB ? 8 : 1], cq_[PASSB ? 8 : 1];
    if (PASSB && half == 0) {
        const f32x4* pP = (const f32x4*)(aggP + ((size_t)b * RW + tid) * 32); const f32x4* pH = (const f32x4*)(aggH + ((size_t)b * RW + tid) * 32);
#pragma unroll
        for (int i = 0; i < 8; ++i) { cp_[i] = pP[i]; cq_[i] = pH[i]; }
    }
    {
        u32x4 v[9];
#pragma unroll
        for (int k = 0; k < 9; ++k) { const int p = tid + k * NTHREADS, rr = p >> 6, pc = p & 63, t = t0 - 3 + rr;
            v[k] = (u32x4){0u, 0u, 0u, 0u}; if (p < XS_ROWS * 64 && t >= 0) v[k] = *(const u32x4*)(XR + (rowbase + t) * RW + pc * 8); }
#pragma unroll
        for (int k = 0; k < 9; ++k) { const int p = tid + k * NTHREADS; if (p < XS_ROWS * 64) *(LAS u32x4*)(L + (p >> 6) * 1024 + (p & 63) * 16) = v[k]; }
    }
    if (PASSB && half == 0) {
        float hc = 0.f;
#pragma unroll
        for (int i = 0; i < 8; ++i)
#pragma unroll
            for (int e = 0; e < 4; ++e) { if (i * 4 + e < pj) hc = cp_[i][e] * hc + cq_[i][e]; }
        *(LAS float*)(L + HC_OFF + tid * 4) = hc;
    }
    __syncthreads();
    LSTAMP(1);
    {
        const int cp = tid & 255, th = tid >> 8, c0 = 2 * cp;
        const float w00 = conv_w[c0], w01 = conv_w[RW + c0], w02 = conv_w[2 * RW + c0], w03 = conv_w[3 * RW + c0], b0 = conv_b[c0];
        const float w10 = conv_w[c0 + 1], w11 = conv_w[RW + c0 + 1], w12 = conv_w[2 * RW + c0 + 1], w13 = conv_w[3 * RW + c0 + 1], b1 = conv_b[c0 + 1];
        const LAS unsigned* xs = (const LAS unsigned*)(L + (th * 32) * 1024 + cp * 4);
        unsigned u0 = xs[0], u1 = xs[256], u2 = xs[512];
        float a0 = __uint_as_float(u0 << 16), a1 = __uint_as_float(u1 << 16), a2 = __uint_as_float(u2 << 16);
        float c0_ = __uint_as_float(u0 & 0xffff0000u), c1_ = __uint_as_float(u1 & 0xffff0000u), c2_ = __uint_as_float(u2 & 0xffff0000u);
#pragma unroll 8
        for (int t = 0; t < 32; ++t) { const unsigned u3 = xs[(t + 3) * 256]; const float a3 = __uint_as_float(u3 << 16), c3_ = __uint_as_float(u3 & 0xffff0000u);
            const float y0 = w00 * a0 + w01 * a1 + w02 * a2 + w03 * a3 + b0, y1 = w10 * c0_ + w11 * c1_ + w12 * c2_ + w13 * c3_ + b1;
            *(LAS unsigned*)(L + XC_OFF + (th * 32 + t) * XC_PITCH + cp * 4) = f2bf(y0) | (f2bf(y1) << 16);
            a0 = a1; a1 = a2; a2 = a3; c0_ = c1_; c1_ = c2_; c2_ = c3_; }
    }
    __syncthreads();
    LSTAMP(2);
    if (PASSB && half == 0) {
#pragma unroll
        for (int nt = 0; nt < 2; ++nt) Hc[nt] = *(const LAS float*)(L + HC_OFF + (h * 64 + 32 * nt + r32) * 4);
    }
#pragma unroll
    for (int mt = 0; mt < 2; ++mt) {
        bf16x8 af[4];
#pragma unroll
        for (int s = 0; s < 4; ++s) af[s] = *(const LAS bf16x8*)(L + XC_OFF + (32 * mt + r32) * XC_PITCH + (h * 64 + 16 * s + 8 * hi) * 2);
#pragma unroll
        for (int nt = 0; nt < 2; ++nt) {
            f32x16 ra = {}, ri = {};
#pragma unroll
            for (int s = 0; s < 4; ++s) { ra = __builtin_amdgcn_mfma_f32_32x32x16_bf16(af[s], W.wa[nt][s], ra, 0, 0, 0); ri = __builtin_amdgcn_mfma_f32_32x32x16_bf16(af[s], W.wx[nt][s], ri, 0, 0, 0); }
            const int c = h * 64 + 32 * nt + r32;
#pragma unroll
            for (int r = 0; r < 16; ++r) { const int tok = 32 * mt + crow(r, hi);
                const float xc = bf2f(*(const LAS unsigned short*)(L + XC_OFF + tok * XC_PITCH + c * 2));
                const float rg = __builtin_amdgcn_rcpf(1.f + __expf(-(ra[r] + W.ba[nt]))), ig = __builtin_amdgcn_rcpf(1.f + __expf(-(ri[r] + W.bx[nt])));
                const float la = -8.0f * rg * W.spl[nt], a = __expf(la);
                ra[r] = a; ri[r] = __builtin_amdgcn_sqrtf(fmaxf(0.f, 1.f - a * a)) * (ig * xc); }
            float P[4], H[4], Pp[4], Hp[4];
#pragma unroll
            for (int g = 0; g < 4; ++g) { P[g] = (ra[4 * g] * ra[4 * g + 1]) * (ra[4 * g + 2] * ra[4 * g + 3]);
                H[g] = ((ri[4 * g] * ra[4 * g + 1] + ri[4 * g + 1]) * ra[4 * g + 2] + ri[4 * g + 2]) * ra[4 * g + 3] + ri[4 * g + 3]; }
#pragma unroll
            for (int g = 0; g < 4; ++g) { Pp[g] = __shfl_xor(P[g], 32); Hp[g] = __shfl_xor(H[g], 32); }
            float hc = Hc[nt], pc = Pc[nt];
#pragma unroll
            for (int g = 0; g < 4; ++g) { const float P0 = hi ? Pp[g] : P[g], H0 = hi ? Hp[g] : H[g], P1 = hi ? P[g] : Pp[g], H1 = hi ? H[g] : Hp[g];
                const float mid = P0 * hc + H0;
                if (PASSB) { float hh = hi ? mid : hc;
#pragma unroll
                    for (int k = 0; k < 4; ++k) { hh = ra[4 * g + k] * hh + ri[4 * g + k]; const int tok = 32 * mt + 8 * g + 4 * hi + k;
                        *(LAS unsigned short*)(L + tok * 1024 + c * 2) = (unsigned short)f2bf(hh); } }
                hc = P1 * mid + H1; pc = pc * (P0 * P1); }
            Hc[nt] = hc; Pc[nt] = pc;
        }
    }
    if (!PASSB) {
        if (half == 1 && hi == 0) {
#pragma unroll
            for (int nt = 0; nt < 2; ++nt) { const int c = h * 64 + 32 * nt + r32; aggP[((size_t)b * RW + c) * 32 + pj] = Pc[nt]; aggH[((size_t)b * RW + c) * 32 + pj] = Hc[nt]; }
        }
        __syncthreads();
    } else {
        LSTAMP(3);
        __syncthreads();
        LSTAMP(4);
        u32x4 gv[8];
#pragma unroll
        for (int i = 0; i < 8; ++i) { const size_t row = rowbase + t0 + i * 8 + wid; gv[i] = *(const u32x4*)(GG + row * RW + lane * 8); }
#pragma unroll
        for (int i = 0; i < 8; ++i) { const int rr = i * 8 + wid; const size_t row = rowbase + t0 + rr;
            const u32x4 hv = *(const LAS u32x4*)(L + rr * 1024 + lane * 16); const u32x4 g4 = gv[i];
            f32x4 y0, y1;
            y0[0] = __uint_as_float(hv.x << 16) * __uint_as_float(g4.x << 16); y0[1] = __uint_as_float(hv.x & 0xffff0000u) * __uint_as_float(g4.x & 0xffff0000u);
            y0[2] = __uint_as_float(hv.y << 16) * __uint_as_float(g4.y << 16); y0[3] = __uint_as_float(hv.y & 0xffff0000u) * __uint_as_float(g4.y & 0xffff0000u);
            y1[0] = __uint_as_float(hv.z << 16) * __uint_as_float(g4.z << 16); y1[1] = __uint_as_float(hv.z & 0xffff0000u) * __uint_as_float(g4.z & 0xffff0000u);
            y1[2] = __uint_as_float(hv.w << 16) * __uint_as_float(g4.w << 16); y1[3] = __uint_as_float(hv.w & 0xffff0000u) * __uint_as_float(g4.w & 0xffff0000u);
            *(u32x4*)(YY + row * D + lane * 8) = pg8::pack8(y0, y1);
            float ss = pg8::sq8(y0, y1);
#pragma unroll
            for (int o = 1; o < 64; o <<= 1) ss += __shfl_xor(ss, o);
            if (lane == 0) fmid[row] = ss; }
        __syncthreads();
        LSTAMP(5);
    }
    }
#undef LSTAMP
}
}
__device__ __forceinline__ void row_prep_x(const float* x, bf16_t* xb, float* rstd0, int row, int lane) {
    const f32x4* xr = (const f32x4*)(x + (size_t)row * D) + lane;
    float s = 0.f; f32x4 v[4];
#pragma unroll
    for (int j = 0; j < 4; ++j) { v[j] = xr[64 * j]; s += v[j].x * v[j].x + v[j].y * v[j].y + v[j].z * v[j].z + v[j].w * v[j].w; }
    s = wave_sum(s);
    if (lane == 0) rstd0[row] = 1.0f / sqrtf(s * (1.f / D) + EPS);
    unsigned long long* o8 = (unsigned long long*)(xb + (size_t)row * D) + lane;
#pragma unroll
    for (int j = 0; j < 4; ++j) o8[64 * j] = (unsigned long long)(f2bf(v[j].x) | (f2bf(v[j].y) << 16)) | ((unsigned long long)(f2bf(v[j].z) | (f2bf(v[j].w) << 16)) << 32);
}
__device__ __forceinline__ void row_prep_mem(const float* m, const float* g, bf16_t* o, int row, int lane) {
    const f32x4* xr = (const f32x4*)(m + (size_t)row * D) + lane;
    float s = 0.f; f32x4 v[4];
#pragma unroll
    for (int j = 0; j < 4; ++j) { v[j] = xr[64 * j]; s += v[j].x * v[j].x + v[j].y * v[j].y + v[j].z * v[j].z + v[j].w * v[j].w; }
    s = wave_sum(s);
    const float r = 1.0f / sqrtf(s * (1.f / D) + EPS);
    unsigned long long* o8 = (unsigned long long*)(o + (size_t)row * D) + lane;
#pragma unroll
    for (int j = 0; j < 4; ++j) { const f32x4 gg = ((const f32x4*)g)[64 * j + lane];
        o8[64 * j] = (unsigned long long)(f2bf(v[j].x * r * gg.x) | (f2bf(v[j].y * r * gg.y) << 16)) | ((unsigned long long)(f2bf(v[j].z * r * gg.z) | (f2bf(v[j].w * r * gg.w) << 16)) << 32); }
}
__device__ __forceinline__ void transpose_item(const float* W, int K, int N, bf16_t* Wt, int ldt, const float* g0, const float* g1, int ksplit, LAS float* scr, int item, int lane) {
    const int nblk = N / 64, kb = item / nblk, nb = item % nblk, k0 = 64 * kb, n0 = 64 * nb, lr = lane >> 4, lc = 4 * (lane & 15);
    f32x4 v[16];
#pragma unroll
    for (int i = 0; i < 16; ++i) v[i] = *(const f32x4*)(W + (size_t)(k0 + 4 * i + lr) * N + n0 + lc);
#pragma unroll
    for (int i = 0; i < 16; ++i) { const int kk = 4 * i + lr, k = k0 + kk; float gv = 1.f; if (g0) gv = (k < ksplit) ? g0[k] : g1[k - ksplit];
        LAS float* d = scr + kk * 65 + lc; d[0] = v[i].x * gv; d[1] = v[i].y * gv; d[2] = v[i].z * gv; d[3] = v[i].w * gv; }
    asm volatile("s_waitcnt lgkmcnt(0)" ::: "memory");
    const int c = lane & 7;
#pragma unroll
    for (int j = 0; j < 8; ++j) { const int n = (lane >> 3) + 8 * j; const LAS float* s = scr + (8 * c) * 65 + n;
        u32x4 o; o.x = f2bf(s[0 * 65]) | (f2bf(s[1 * 65]) << 16); o.y = f2bf(s[2 * 65]) | (f2bf(s[3 * 65]) << 16); o.z = f2bf(s[4 * 65]) | (f2bf(s[5 * 65]) << 16); o.w = f2bf(s[6 * 65]) | (f2bf(s[7 * 65]) << 16);
        *(u32x4*)(Wt + (size_t)(n0 + n) * ldt + k0 + 8 * c) = o; }
    asm volatile("s_waitcnt lgkmcnt(0)" ::: "memory");
}

struct MidScale { const float* f; int k; int pad; };
template <class Epi>
__device__ __forceinline__ void gemm_naive(const Ctx& C, const bf16_t* A, int lda, const bf16_t* Bt, int ldb, int M, int N, int K, MidScale ms, const Epi& E) {
    const int lane = C.lane, fr = lane & 15, fq = lane >> 4, ncol = N / 64, ntile = (M / 16) * ncol;
    for (int t = C.gw; t < ntile; t += C.NGW) {
        const int row0 = (t / ncol) * 16, col0 = (t % ncol) * 64;
        const bf16_t* ap = A + (size_t)(row0 + fr) * lda + fq * 8;
        const bf16_t* bp = Bt + (size_t)(col0 + fr) * ldb + fq * 8;
        f32x4 acc[4];
#pragma unroll
        for (int n = 0; n < 4; ++n) acc[n] = (f32x4){0.f, 0.f, 0.f, 0.f};
        for (int k0 = 0; k0 < K; k0 += 32) {
            if (ms.f && k0 == ms.k) {
#pragma unroll
                for (int j = 0; j < 4; ++j) { const float f = ms.f[row0 + fq * 4 + j];
#pragma unroll
                    for (int n = 0; n < 4; ++n) acc[n][j] *= f; }
            }
            const bf16x8 a = *(const bf16x8*)(ap + k0);
#pragma unroll
            for (int n = 0; n < 4; ++n) { const bf16x8 b = *(const bf16x8*)(bp + (size_t)n * 16 * ldb + k0); acc[n] = __builtin_amdgcn_mfma_f32_16x16x32_bf16(a, b, acc[n], 0, 0, 0); }
        }
#pragma unroll
        for (int n = 0; n < 4; ++n)
#pragma unroll
            for (int j = 0; j < 4; ++j) E(row0 + fq * 4 + j, col0 + n * 16 + fr, acc[n][j]);
    }
}
struct EpiInProj { const float* rstd0; bf16_t *XR, *GG, *Qs, *Ks, *Vs;
    __device__ void operator()(int r, int c, float v) const { v *= rstd0[r]; const int t = c >> 9, cc = c & 511;
        if (t == 0) XR[(size_t)r * RW + cc] = (bf16_t)f2bf(v);
        else if (t == 1) GG[(size_t)r * RW + cc] = (bf16_t)f2bf(gelu_tanh(v));
        else if (t == 2) Qs[(size_t)r * SBW + cc] = (bf16_t)f2bf(v * (0.125f * LOG2E));
        else if (t == 3) Ks[(size_t)r * SBW + cc] = (bf16_t)f2bf(v);
        else Vs[(size_t)r * SBW + cc] = (bf16_t)f2bf(v); } };
struct EpiStoreBf16 { bf16_t* O; const float* rowscale; int ldo; float scale;
    __device__ void operator()(int r, int c, float v) const { O[(size_t)r * ldo + c] = (bf16_t)f2bf(v * (rowscale ? rowscale[r] : 1.f) * scale); } };
struct EpiResF32 { const float* base; const float* rowscale; bf16_t* O;
    __device__ void operator()(int r, int c, float v) const { O[(size_t)r * D + c] = (bf16_t)f2bf(base[(size_t)r * D + c] + v * rowscale[r]); } };
struct EpiResBf16 { const bf16_t* base; bf16_t* O;
    __device__ void operator()(int r, int c, float v) const { O[(size_t)r * D + c] = (bf16_t)f2bf(bf2f(base[(size_t)r * D + c]) + v); } };

__device__ __forceinline__ void lru_naive_unit(int unit, int j, LAS float* xs, const bf16_t* XR, const bf16_t* GG, const float* conv_w, const float* conv_b,
                                               const float* w_a, const float* b_a, const float* w_x, const float* b_x, const float* lam, bf16_t* YY) {
    const int b = unit >> 3, h = unit & 7, c = h * 64 + j;
    float wa[64], wx[64];
#pragma unroll
    for (int i = 0; i < 64; ++i) { wa[i] = w_a[(size_t)(h * 64 + i) * 64 + j]; wx[i] = w_x[(size_t)(h * 64 + i) * 64 + j]; }
    const float ba = b_a[c], bx = b_x[c], cw0 = conv_w[c], cw1 = conv_w[RW + c], cw2 = conv_w[2 * RW + c], cw3 = conv_w[3 * RW + c], cb = conv_b[c];
    const float l = lam[c], spl = (l > 15.f) ? __expf(-l) : log1pf(__expf(-l));
    float x0 = 0.f, x1 = 0.f, x2 = 0.f, hst = 0.f;
    for (int t = 0; t < SEQ; ++t) {
        const size_t row = (size_t)b * SEQ + t;
        const float x3 = bf2f(XR[row * RW + c]);
        const float xc = cw0 * x0 + cw1 * x1 + cw2 * x2 + cw3 * x3 + cb;
        x0 = x1; x1 = x2; x2 = x3;
        asm volatile("s_waitcnt lgkmcnt(0)" ::: "memory"); xs[j] = xc; asm volatile("s_waitcnt lgkmcnt(0)" ::: "memory");
        float ra = ba, ri = bx;
#pragma unroll
        for (int i = 0; i < 64; ++i) { const float xv = xs[i]; ra += xv * wa[i]; ri += xv * wx[i]; }
        const float r = sigmoidf_(ra), ig = sigmoidf_(ri);
        const float log_a = -8.0f * r * spl, a = __expf(log_a), bb = sqrtf(fmaxf(0.f, -expm1f(2.f * log_a))) * (ig * xc);
        hst = a * hst + bb;
        YY[row * D + c] = (bf16_t)f2bf(hst * bf2f(GG[row * RW + c]));
    }
}
__device__ __forceinline__ void sb_naive_unit(int unit, int lane, const bf16_t* Qs, const bf16_t* Ks, const bf16_t* Vs, bf16_t* YY, float* ssq_s8) {
    const int qb = unit & 63, h = (unit >> 6) & 7, b = unit >> 9;
    const int t = qb * 64 + lane; const size_t row = (size_t)b * SEQ + t;
    float q[64], o[64];
#pragma unroll
    for (int d = 0; d < 64; ++d) { q[d] = bf2f(Qs[row * SBW + h * 64 + d]); o[d] = 0.f; }
    float R = 0.f;
    for (int s = qb * 64 + 62; s >= 0; --s) {
        const bf16_t* kr = Ks + ((size_t)b * SEQ + s) * SBW + h * 64; const bf16_t* vr = Vs + ((size_t)b * SEQ + s) * SBW + h * 64;
        float z = 0.f;
#pragma unroll
        for (int d = 0; d < 64; ++d) z += q[d] * bf2f(kr[d]);
        const bool valid = s < t;
        const float sp = valid ? (fmaxf(z, 0.f) + __log2f(1.f + exp2f(-fabsf(z)))) : 0.f;
        const float w = valid ? exp2f(z - (R + sp)) : 0.f;
        R += sp;
        const float wb = bf2f((bf16_t)f2bf(w));
#pragma unroll
        for (int d = 0; d < 64; ++d) o[d] += wb * bf2f(vr[d]);
    }
    float ss = 0.f;
#pragma unroll
    for (int d = 0; d < 64; ++d) { ss += o[d] * o[d]; YY[row * D + RW + h * 64 + d] = (bf16_t)f2bf(o[d]); }
    ssq_s8[row * 8 + h] = ss;
}
__device__ __forceinline__ void xattn_naive_unit(int unit, int j, LAS float* qs, LAS float* ps, const bf16_t* QX, const bf16_t* KVM, bf16_t* OX) {
    const int tg = unit & 511, h = (unit >> 9) & 3, b = unit >> 11, lane = j & 63, wid = j >> 6;
    const size_t row0 = (size_t)b * SEQ + tg * 8;
    for (int i = 0; i < 8; ++i) qs[i * 256 + j] = bf2f(QX[(row0 + i) * D + h * XD + j]);
    __syncthreads();
    const bf16_t* kr = KVM + ((size_t)b * MEM + j) * 2048 + h * XD;
    float sc[8];
#pragma unroll
    for (int i = 0; i < 8; ++i) sc[i] = 0.f;
    for (int d = 0; d < XD; ++d) { const float kv = bf2f(kr[d]);
#pragma unroll
        for (int i = 0; i < 8; ++i) sc[i] += qs[i * 256 + d] * kv; }
#pragma unroll
    for (int i = 0; i < 8; ++i) ps[i * 256 + j] = sc[i];
    __syncthreads();
    for (int i = wid * 2; i < wid * 2 + 2; ++i) {
        float v0 = ps[i * 256 + lane], v1 = ps[i * 256 + lane + 64], v2 = ps[i * 256 + lane + 128], v3 = ps[i * 256 + lane + 192];
        float m = fmaxf(fmaxf(v0, v1), fmaxf(v2, v3));
#pragma unroll
        for (int o = 1; o < 64; o <<= 1) m = fmaxf(m, __shfl_xor(m, o));
        v0 = exp2f(v0 - m); v1 = exp2f(v1 - m); v2 = exp2f(v2 - m); v3 = exp2f(v3 - m);
        const float s = wave_sum(v0 + v1 + v2 + v3), inv = 1.f / s;
        ps[i * 256 + lane] = v0 * inv; ps[i * 256 + lane + 64] = v1 * inv; ps[i * 256 + lane + 128] = v2 * inv; ps[i * 256 + lane + 192] = v3 * inv;
    }
    __syncthreads();
    float o[8];
#pragma unroll
    for (int i = 0; i < 8; ++i) o[i] = 0.f;
    for (int m = 0; m < MEM; ++m) { const float vv = bf2f(KVM[((size_t)b * MEM + m) * 2048 + 1024 + h * XD + j]);
#pragma unroll
        for (int i = 0; i < 8; ++i) o[i] += ps[i * 256 + m] * vv; }
#pragma unroll
    for (int i = 0; i < 8; ++i) OX[(row0 + i) * D + h * XD + j] = (bf16_t)f2bf(o[i]);
    __syncthreads();
}
__device__ __forceinline__ int router_row(int row, int lane, const bf16_t* X2b, const float* ssq2p, const float* g, const float* wgr, const float* bgr, const float* wer, const float* ber, float* selw) {
    int cls = 0;
    float acc[20];
#pragma unroll
    for (int i = 0; i < 20; ++i) acc[i] = 0.f;
    const float rs = pg8::rstd16(ssq2p + (size_t)row * 16);
    for (int kk = 0; kk < 16; ++kk) { const int k = kk * 64 + lane; const float t = bf2f(X2b[(size_t)row * D + k]) * rs * g[k];
#pragma unroll
        for (int i = 0; i < 4; ++i) acc[i] += t * wgr[k * 4 + i];
#pragma unroll
        for (int gi = 0; gi < 4; ++gi)
#pragma unroll
            for (int e = 0; e < 4; ++e) acc[4 + gi * 4 + e] += t * wer[((size_t)gi * D + k) * 4 + e]; }
#pragma unroll
    for (int i = 0; i < 20; ++i) acc[i] = wave_sum(acc[i]);
    if (lane == 0) {
        float gl[4]; float gm = -INFINITY; int gi = 0;
#pragma unroll
        for (int i = 0; i < 4; ++i) { gl[i] = acc[i] + bgr[i]; if (gl[i] > gm) { gm = gl[i]; gi = i; } }
        float gs = 0.f;
#pragma unroll
        for (int i = 0; i < 4; ++i) gs += __expf(gl[i] - gm);
        const float gp = 1.f / gs;
        float el[4];
#pragma unroll
        for (int e = 0; e < 4; ++e) { float v = 0.f;
#pragma unroll
            for (int q = 0; q < 4; ++q) if (q == gi) v = acc[4 + q * 4 + e] + ber[q * 4 + e];
            el[e] = v; }
        int e1 = 0; float m1 = el[0];
#pragma unroll
        for (int e = 1; e < 4; ++e) if (el[e] > m1) { m1 = el[e]; e1 = e; }
        int e2 = -1; float m2 = -INFINITY;
#pragma unroll
        for (int e = 0; e < 4; ++e) if (e != e1 && el[e] > m2) { m2 = el[e]; e2 = e; }
        const float p2 = __expf(m2 - m1), w1 = gp / (1.f + p2), w2 = gp * p2 / (1.f + p2);
        const int ea = e1 < e2 ? e1 : e2, eb = e1 < e2 ? e2 : e1; const float wA = e1 < e2 ? w1 : w2, wB = e1 < e2 ? w2 : w1;
        const int pr = (ea == 0) ? eb - 1 : (ea == 1) ? eb + 1 : 5;
        selw[(size_t)row * 2] = wA; selw[(size_t)row * 2 + 1] = wB; cls = gi * 6 + pr;
    }
    return cls;
}
__device__ __forceinline__ void final_row(int row, int lane, const bf16_t* X3b, const float* ssq3, const float* g, float* out) {
    const float r = pg8::rstd16(ssq3 + (size_t)row * 16);
#pragma unroll
    for (int j = 0; j < 2; ++j) { const int c = j * 512 + lane * 8; const u32x4 v = *(const u32x4*)(X3b + (size_t)row * D + c); const f32x4 g0 = *(const f32x4*)(g + c), g1 = *(const f32x4*)(g + c + 4);
        f32x4 o0, o1;
        o0[0] = __uint_as_float(v.x << 16) * r * g0[0]; o0[1] = __uint_as_float(v.x & 0xffff0000u) * r * g0[1]; o0[2] = __uint_as_float(v.y << 16) * r * g0[2]; o0[3] = __uint_as_float(v.y & 0xffff0000u) * r * g0[3];
        o1[0] = __uint_as_float(v.z << 16) * r * g1[0]; o1[1] = __uint_as_float(v.z & 0xffff0000u) * r * g1[1]; o1[2] = __uint_as_float(v.w << 16) * r * g1[2]; o1[3] = __uint_as_float(v.w & 0xffff0000u) * r * g1[3];
        *(f32x4*)(out + (size_t)row * D + c) = o0; *(f32x4*)(out + (size_t)row * D + c + 4) = o1; }
}
__device__ __forceinline__ void reids(Ctx& C) { int t_ = threadIdx.x; asm volatile("" : "+v"(t_)); C.tid = t_; C.lane = t_ & 63; C.wave = __builtin_amdgcn_readfirstlane(t_ >> 6); C.gw = C.bid * NWAVES + C.wave; }
__global__ void __launch_bounds__(NTHREADS, 2) mk_fwd(Args args) {
    extern __shared__ __attribute__((aligned(16))) unsigned char lds[];
    cg::grid_group grid = cg::this_grid();
    Ctx C;
#pragma unroll
    for (int i = 0; i < 29; ++i) C.in[i] = args.in[i];
    C.out = args.out; C.ws = args.ws; C.lds = lds;
    C.tid = threadIdx.x; C.lane = C.tid & 63; C.wave = __builtin_amdgcn_readfirstlane(C.tid >> 6);
    C.G = gridDim.x; C.bid = blockIdx.x; C.gw = C.bid * NWAVES + C.wave; C.NGW = C.G * NWAVES;
    const float* x = C.in[0]; const float* mem = C.in[1]; const float* norm_mix = C.in[2]; const float* w_in = C.in[3];
    const float* conv_w = C.in[4]; const float* conv_b = C.in[5]; const float* lru_w_a = C.in[6]; const float* lru_b_a = C.in[7];
    const float* lru_w_x = C.in[8]; const float* lru_b_x = C.in[9]; const float* lru_lambda = C.in[10];
    const float* norm_rnn = C.in[11]; const float* norm_sb = C.in[12]; const float* w_out = C.in[13];
    const float* norm_xattn = C.in[14]; const float* norm_mem = C.in[15];
    const float* xa_w_q = C.in[16]; const float* xa_w_k = C.in[17]; const float* xa_w_v = C.in[18]; const float* xa_w_o = C.in[19];
    const float* norm_moe = C.in[20]; const float* w_gr = C.in[21]; const float* b_gr = C.in[22]; const float* w_er = C.in[23]; const float* b_er = C.in[24];
    const float* w_gate = C.in[25]; const float* w_up = C.in[26]; const float* w_down = C.in[27]; const float* norm_final = C.in[28];
    unsigned char* ws = C.ws; float* out = C.out;
    float* sm = (float*)(ws + WS_SMALL);
    float* rstd0 = sm + SM_RSTD0; float* ssq_r = sm + SM_SSQR; float* ssq_s = sm + SM_SSQS; float* ssq1 = sm + SM_SSQ1; float* ssq2 = sm + SM_SSQ2; unsigned* kmax = (unsigned*)(ws + WS_CTL); float* fmid = sm + SM_END; float* fend = fmid + 32768;
    float* aggP = sm + 96 * 32768; float* aggH = sm + 104 * 32768;
    float* selw = sm + SM_SELW; float* ssq3 = sm + SM_SSQ3; int* gcnt = (int*)(ws + WS_CTL + 1024); int* sbq = (int*)(ws + WS_CTL + 3072); unsigned* lruc = (unsigned*)(ws + WS_CTL + 4096 + 28672);
    int* tlist = (int*)(sm + 64 * 32768); float* rsg = sm + 88 * 32768; float* wAg = rsg + 40960; float* wBg = wAg + 40960; int* tokg = (int*)(wBg + 40960); float* rstok = sm + SM_RSTD0;
    bf16_t* Wrh = (bf16_t*)(ws + WS_CTL + 65536); bf16_t* Wrl = Wrh + 32 * D;
    bf16_t* Wg_t = (bf16_t*)(ws + WS_WG); bf16_t* Wu_t = (bf16_t*)(ws + WS_WU); bf16_t* Wd2 = (bf16_t*)(ws + WS_WD2); bf16_t* XG = (bf16_t*)(ws + WS_R1); bf16_t* HID = (bf16_t*)(ws + WS_R5);
    bf16_t* Win_t = (bf16_t*)(ws + WS_WIN); bf16_t* Wout_t = (bf16_t*)(ws + WS_WOUT); bf16_t* Wq_t = (bf16_t*)(ws + WS_WQ); bf16_t* Wkv_t = (bf16_t*)(ws + WS_WKV); bf16_t* Wo_t = (bf16_t*)(ws + WS_WO);
    bf16_t* memn = (bf16_t*)(ws + WS_MEMN); bf16_t* KM = (bf16_t*)(ws + WS_KVM); bf16_t* VM = KM + (size_t)NMEM * D; bf16_t* MT = (bf16_t*)(ws + WS_R5); bf16_t* NT = MT + (size_t)BATCH * D * D; bf16_t* WqN = (bf16_t*)(ws + WS_WQ);
    bf16_t* xb = (bf16_t*)(ws + WS_R0); bf16_t* X1b = xb; bf16_t* X3b = xb;
    bf16_t* XR = (bf16_t*)(ws + WS_R1); bf16_t* GG = XR + (size_t)NTOK * RW; bf16_t* QX = XR;
    bf16_t* Qs = (bf16_t*)(ws + WS_R2); bf16_t* Ks = Qs + (size_t)NTOK * SBW; bf16_t* OX = Qs;
    bf16_t* Vs = (bf16_t*)(ws + WS_R3);
    bf16_t* YY = (bf16_t*)(ws + WS_R4); bf16_t* X2b = YY;
    const int NGW = C.NGW;
#define gw C.gw
#define lane C.lane
    if (C.tid < 64) ((LAS unsigned*)(lds + 146432))[C.tid] = 0u;
    __syncthreads();
    XcdBarrier bar = xcd_barrier_post((unsigned*)(ws + WS_CTL + 4096), (volatile LAS unsigned*)(lds + 146432 + 32));
#define GRID_SYNC_CG() do { grid.sync(); reids(C); } while (0)
#define GRID_SYNC() do { xcd_barrier(bar); reids(C); } while (0)

    for (int rep_ = 0; rep_ < (int)((REP_MASK >> 0) & 1u) + 1; ++rep_) {
    {
        if (gw == 0) { kmax[lane] = 0u; if (lane < 32) gcnt[lane] = 0; if (lane == 32) sbq[0] = 0; }
        if (gw == 1) { ((u32x4*)(ws + WS_END))[lane] = (u32x4){0u, 0u, 0u, 0u}; ((u32x4*)(ws + WS_END))[64 + lane] = (u32x4){0u, 0u, 0u, 0u}; }
        for (int r = gw * 4; r < NTOK; r += NGW * 4) {
            const f32x4* xr = (const f32x4*)(x + (size_t)r * D) + lane; f32x4 v[16]; float s[4] = {0.f, 0.f, 0.f, 0.f};
#pragma unroll
            for (int j = 0; j < 16; ++j) v[j] = __builtin_nontemporal_load(xr + 64 * j);
#pragma unroll
            for (int j = 0; j < 16; ++j) s[j >> 2] += (v[j].x * v[j].x + v[j].y * v[j].y) + (v[j].z * v[j].z + v[j].w * v[j].w);
#pragma unroll
            for (int o = 1; o < 64; o <<= 1) { s[0] += __shfl_xor(s[0], o); s[1] += __shfl_xor(s[1], o); s[2] += __shfl_xor(s[2], o); s[3] += __shfl_xor(s[3], o); }
            if (lane < 4) { const float sv = lane == 0 ? s[0] : lane == 1 ? s[1] : lane == 2 ? s[2] : s[3]; rstd0[r + lane] = __builtin_amdgcn_rsqf(sv * (1.f / D) + EPS); }
            unsigned long long* o8 = (unsigned long long*)(xb + (size_t)r * D) + lane;
#pragma unroll
            for (int j = 0; j < 16; ++j) o8[64 * j] = (unsigned long long)(f2bf(v[j].x) | (f2bf(v[j].y) << 16)) | ((unsigned long long)(f2bf(v[j].z) | (f2bf(v[j].w) << 16)) << 32);
        }
        for (int r = gw; r < NMEM; r += NGW) row_prep_mem(mem, norm_mem, memn, r, lane);
        LAS float* scr = (LAS float*)(lds) + C.wave * (64 * 65);
        constexpr int I_IN = (D / 64) * (PROJ / 64), I_SQ = (D / 64) * (D / 64);
        for (int it = gw; it < I_IN + 4 * I_SQ; it += NGW) {
            int r = it;
            if (r < I_IN) { transpose_item(w_in, D, PROJ, Win_t, D, norm_mix, norm_mix, D, scr, r, lane); continue; } r -= I_IN;
            if (r < I_SQ) { transpose_item(w_out, D, D, Wout_t, D, norm_rnn, norm_sb, RW, scr, r, lane); continue; } r -= I_SQ;
            if (r < I_SQ) { transpose_item(xa_w_k, D, D, Wkv_t, D, nullptr, nullptr, 0, scr, r, lane); continue; } r -= I_SQ;
            if (r < I_SQ) { transpose_item(xa_w_v, D, D, Wkv_t + (size_t)D * D, D, nullptr, nullptr, 0, scr, r, lane); continue; } r -= I_SQ;
            transpose_item(xa_w_o, D, D, Wo_t, D, nullptr, nullptr, 0, scr, r, lane);
        }
        for (int r = gw; r < D; r += NGW) { const float gk = norm_xattn[r]; const f32x4* src = (const f32x4*)(xa_w_q + (size_t)r * D) + lane; unsigned long long* o8 = (unsigned long long*)(WqN + (size_t)r * D) + lane;
#pragma unroll
            for (int j = 0; j < 4; ++j) { const f32x4 v = src[64 * j]; o8[64 * j] = (unsigned long long)(f2bf(v.x * gk) | (f2bf(v.y * gk) << 16)) | ((unsigned long long)(f2bf(v.z * gk) | (f2bf(v.w * gk) << 16)) << 32); } }
        for (int idx = gw * 64 + lane; idx < 32 * D; idx += NGW * 64) { const int n = idx >> 10, k = idx & 1023; float w = 0.f;
            if (n < 4) w = w_gr[k * 4 + n]; else if (n < 20) w = w_er[((size_t)((n - 4) >> 2) * D + k) * 4 + ((n - 4) & 3)];
            w *= norm_moe[k]; const unsigned hi = f2bf(w); Wrh[idx] = (bf16_t)hi; Wrl[idx] = (bf16_t)f2bf(w - bf2f((unsigned short)hi)); }
        constexpr int I_GU = (D / 64) * (DE / 64), I_DN = (DE / 64) * (D / 64);
        for (int it = gw; it < 32 * I_GU + 48 * I_DN; it += NGW) {
            int r = it;
            if (r < 16 * I_GU) { const int e = r / I_GU; transpose_item(w_gate + (size_t)e * D * DE, D, DE, Wg_t + (size_t)e * DE * D, D, norm_moe, norm_moe, D, scr, r % I_GU, lane); continue; } r -= 16 * I_GU;
            if (r < 16 * I_GU) { const int e = r / I_GU; transpose_item(w_up + (size_t)e * D * DE, D, DE, Wu_t + (size_t)e * DE * D, D, norm_moe, norm_moe, D, scr, r % I_GU, lane); continue; } r -= 16 * I_GU;
            { const int cs = r / I_DN, cls = cs >> 1, slot = cs & 1; int ea, eb; pg8::pair_ab(cls % 6, ea, eb); const int e = (cls / 6) * 4 + (slot ? eb : ea);
              transpose_item(w_down + (size_t)e * DE * D, DE, D, Wd2 + (size_t)cls * D * 512 + slot * DE, 512, nullptr, nullptr, 0, scr, r % I_DN, lane); }
        }
    }
    }
    GRID_SYNC();
    for (int rep_ = 0; rep_ < (int)((REP_MASK >> 1) & 1u) + 1; ++rep_) {
    { pg8::DenseOrder S; S.init(xb, D, Win_t, D, NTOK, PROJ, C.G, C.bid); pg8::EpiInProjF E{0, rstd0, XR, GG, Qs, Ks, Vs, kmax};
      pg8::gemm_phase<pg8::EpiInProjF, pg8::DenseOrder, true>((LAS unsigned char*)lds, pg8::Gemm{D, D, D}, S, E); }
    { pg8::DenseOrder S; S.init(memn, D, Wkv_t, D, NMEM, 2048, C.G, C.bid); pg8::EpiKvN E{0, KM, VM};
      pg8::gemm_phase<pg8::EpiKvN, pg8::DenseOrder, true>((LAS unsigned char*)lds, pg8::Gemm{D, D, D}, S, E); }
    }
    GRID_SYNC();
    for (int rep_ = 0; rep_ < (int)((REP_MASK >> 2) & 1u) + 1; ++rep_) {
    {
        { lru::Weights LW; lru::load_weights(LW, C.wave, lane & 31, lane >> 5, lru_w_a, lru_b_a, lru_w_x, lru_b_x, lru_lambda);
          for (int u = C.bid; u < BATCH * 32; u += C.G) { lru::pair_unit<false>(u >> 5, u & 31, LW, XR, GG, conv_w, conv_b, aggP, aggH, ssq_s, YY, fmid, fend, lds);
              asm volatile("s_waitcnt vmcnt(0)" ::: "memory"); __syncthreads();
              if (C.tid == 0) { __builtin_amdgcn_fence(__ATOMIC_RELEASE, "agent"); asm volatile("s_waitcnt vmcnt(0)" ::: "memory"); __hip_atomic_fetch_add(lruc + 16 * (u >> 5), 1u, __ATOMIC_RELAXED, __HIP_MEMORY_SCOPE_AGENT); } } }
        {
            volatile LAS int* qslot = (volatile LAS int*)(lds + 146432 + 192); int nextu = 0;
            if (C.tid == 0) qslot[0] = atomicAdd(sbq, 1);
            __syncthreads();
            int u = qslot[0];
            while (u < BATCH * NH * 16) {
                __syncthreads();
                if (C.tid == 0) nextu = atomicAdd(sbq, 1);
                sba::sb_unit(u >> 7, (u >> 4) & 7, 15 - (u & 15), Qs, Ks, Vs, YY, ssq_s, (char*)lds);
                if (C.tid == 0) qslot[0] = nextu;
                __syncthreads();
                u = qslot[0];
            }
        }
    }
    { pg8::XaPreOrder S{KM, VM, WqN, Wo_t, C.G, C.bid}; pg8::EpiXaPre E{0, MT, NT};
      pg8::gemm_phase<pg8::EpiXaPre, pg8::XaPreOrder, true>((LAS unsigned char*)lds, pg8::Gemm{D, D, XD}, S, E); }
    {
        const float *pwa = lru_w_a, *pba = lru_b_a, *pwx = lru_w_x, *pbx = lru_b_x, *plm = lru_lambda;
        asm volatile("" : "+s"(pwa), "+s"(pba), "+s"(pwx), "+s"(pbx), "+s"(plm));
        int l2_ = lane; asm volatile("" : "+v"(l2_));
        lru::Weights LW; lru::load_weights(LW, C.wave, l2_ & 31, l2_ >> 5, pwa, pba, pwx, pbx, plm);
        for (int u = C.bid; u < BATCH * 32; u += C.G) {
            if (C.tid < 64) { unsigned spins = 0;
                while ((unsigned)__builtin_amdgcn_readfirstlane(__hip_atomic_load(lruc + 16 * (u >> 5), __ATOMIC_RELAXED, __HIP_MEMORY_SCOPE_AGENT)) < 32u) { __builtin_amdgcn_s_sleep(2); if (++spins > (1u << 20)) break; }
                __builtin_amdgcn_fence(__ATOMIC_ACQUIRE, "agent"); }
            asm volatile("s_waitcnt vmcnt(0)" ::: "memory"); __syncthreads();
            lru::pair_unit<true>(u >> 5, u & 31, LW, XR, GG, conv_w, conv_b, aggP, aggH, ssq_s, YY, ssq_r, fend, lds); }
    }
    }
    GRID_SYNC();
    for (int rep_ = 0; rep_ < (int)((REP_MASK >> 4) & 1u) + 1; ++rep_) {
    { pg8::DenseOrder S; S.init(YY, D, Wout_t, D, NTOK, D, C.G, C.bid); pg8::EpiX1F E{8, xb, fmid, fend, X1b, ssq1};
      { pg8::Unit u_;
        for (int i = 0; S.next(i, u_); ++i) if (C.tid < 256) { const int row = u_.pm * 256 + C.tid; const f32x4 a4 = ((const f32x4*)(ssq_s + (size_t)row * 8))[0], b4 = ((const f32x4*)(ssq_s + (size_t)row * 8))[1];
            const float rr = __builtin_amdgcn_rsqf(ssq_r[row] * (1.f / RW) + EPS), rs = __builtin_amdgcn_rsqf((((a4.x + a4.y) + (a4.z + a4.w)) + ((b4.x + b4.y) + (b4.z + b4.w))) * (1.f / SBW) + EPS);
            fmid[row] = rr * __builtin_amdgcn_rcpf(rs); fend[row] = rs; }
        asm volatile("s_waitcnt vmcnt(0)" ::: "memory"); __syncthreads(); }
      pg8::gemm_phase<pg8::EpiX1F, pg8::DenseOrder, true>((LAS unsigned char*)lds, pg8::Gemm{D, D, D}, S, E); }
    }
    GRID_SYNC();
    for (int rep_ = 0; rep_ < (int)((REP_MASK >> 5) & 1u) + 1; ++rep_) {
    { pg8::BatchedOrder S{X1b, MT, C.G, C.bid}; pg8::EpiXaSoftmax E{0, QX, ssq1, 0.0625f * LOG2E, (LAS float*)(lds + 131072 + 2048)};
      pg8::gemm_phase<pg8::EpiXaSoftmax, pg8::BatchedOrder, true>((LAS unsigned char*)lds, pg8::Gemm{D, D, D}, S, E); }
    }
    GRID_SYNC();
    for (int rep_ = 0; rep_ < (int)((REP_MASK >> 8) & 1u) + 1; ++rep_) {
    { pg8::BatchedOrder S{QX, NT, C.G, C.bid}; pg8::EpiResF E{0, X1b, X2b, ssq2};
      pg8::gemm_phase<pg8::EpiResF, pg8::BatchedOrder, true>((LAS unsigned char*)lds, pg8::Gemm{D, D, D}, S, E); }
    }
    GRID_SYNC();
    for (int rep_ = 0; rep_ < (int)((REP_MASK >> 9) & 1u) + 1; ++rep_) {
    {
        LAS int* lcnt = (LAS int*)lds; LAS int* lbase = lcnt + 32; LAS int* lcls = lcnt + 64; LAS int* lpos = lcnt + 192;
        for (int p = C.tid; p < 64 * 128; p += NTHREADS) { const int rrow = p >> 7, pc = p & 127;
            *(LAS u32x4*)(lds + 12288 + rrow * 2064 + pc * 16) = *(const u32x4*)(Wrh + (size_t)rrow * D + pc * 8); }
        for (int chunk = C.bid; chunk < NTOK / 128; chunk += C.G) {
            if (C.tid < 32) lcnt[C.tid] = 0;
            __syncthreads();
            {
                const int fr = lane & 15, fq = lane >> 4, row0 = chunk * 128 + C.wave * 16;
                f32x4 acc0 = {0.f, 0.f, 0.f, 0.f}, acc1 = acc0;
                const bf16_t* ap = X2b + (size_t)(row0 + fr) * D + fq * 8; const LAS unsigned char* bp = (const LAS unsigned char*)(lds + 12288) + fr * 2064 + fq * 16;
#pragma unroll 1
                for (int kb = 0; kb < 4; ++kb) { bf16x8 a[8];
#pragma unroll
                    for (int j = 0; j < 8; ++j) a[j] = *(const bf16x8*)(ap + (kb * 8 + j) * 32);
#pragma unroll
                    for (int j = 0; j < 8; ++j) { const int ks = kb * 8 + j;
                        const bf16x8 h0 = *(const LAS bf16x8*)(bp + ks * 64), h1 = *(const LAS bf16x8*)(bp + 16 * 2064 + ks * 64), l0 = *(const LAS bf16x8*)(bp + 32 * 2064 + ks * 64), l1 = *(const LAS bf16x8*)(bp + 48 * 2064 + ks * 64);
                        acc0 = __builtin_amdgcn_mfma_f32_16x16x32_bf16(a[j], h0, acc0, 0, 0, 0); acc1 = __builtin_amdgcn_mfma_f32_16x16x32_bf16(a[j], h1, acc1, 0, 0, 0);
                        acc0 = __builtin_amdgcn_mfma_f32_16x16x32_bf16(a[j], l0, acc0, 0, 0, 0); acc1 = __builtin_amdgcn_mfma_f32_16x16x32_bf16(a[j], l1, acc1, 0, 0, 0); } }
                LAS float* lg = (LAS float*)(lds + 1536) + C.wave * (16 * 21);
#pragma unroll
                for (int j = 0; j < 4; ++j) { lg[(4 * fq + j) * 21 + fr] = acc0[j]; if (fr < 4) lg[(4 * fq + j) * 21 + 16 + fr] = acc1[j]; }
                asm volatile("s_waitcnt lgkmcnt(0)" ::: "memory");
                if (lane < 16) { const int row = row0 + lane; const float rs = pg8::rstd16(ssq2 + (size_t)row * 16); const LAS float* lr = lg + lane * 21;
                    float gl[4]; float gm = -INFINITY; int gi = 0;
#pragma unroll
                    for (int i = 0; i < 4; ++i) { gl[i] = lr[i] * rs + b_gr[i]; if (gl[i] > gm) { gm = gl[i]; gi = i; } }
                    float gs = 0.f;
#pragma unroll
                    for (int i = 0; i < 4; ++i) gs += __expf(gl[i] - gm);
                    const float gp = 1.f / gs;
                    float el[4];
#pragma unroll
                    for (int e = 0; e < 4; ++e) el[e] = lr[4 + gi * 4 + e] * rs + b_er[gi * 4 + e];
                    int e1 = 0; float m1 = el[0];
#pragma unroll
                    for (int e = 1; e < 4; ++e) if (el[e] > m1) { m1 = el[e]; e1 = e; }
                    int e2 = -1; float m2 = -INFINITY;
#pragma unroll
                    for (int e = 0; e < 4; ++e) if (e != e1 && el[e] > m2) { m2 = el[e]; e2 = e; }
                    const float p2 = __expf(m2 - m1), w1 = gp / (1.f + p2), w2 = gp * p2 / (1.f + p2);
                    const int ea = e1 < e2 ? e1 : e2, eb = e1 < e2 ? e2 : e1; const float wA = e1 < e2 ? w1 : w2, wB = e1 < e2 ? w2 : w1;
                    const int pr = (ea == 0) ? eb - 1 : (ea == 1) ? eb + 1 : 5, cls = gi * 6 + pr, lt = C.wave * 16 + lane;
                    selw[(size_t)row * 2] = wA; selw[(size_t)row * 2 + 1] = wB; rstok[row] = rs;
                    lcls[lt] = cls; lpos[lt] = __hip_atomic_fetch_add(lcnt + cls, 1, __ATOMIC_RELAXED, __HIP_MEMORY_SCOPE_WORKGROUP); }
            }
            __syncthreads();
            if (C.tid < 24) lbase[C.tid] = atomicAdd(gcnt + C.tid, lcnt[C.tid]);
            __syncthreads();
            if (C.tid < 128) { const int c = lcls[C.tid]; tlist[(size_t)c * NTOK + lbase[c] + lpos[C.tid]] = chunk * 128 + C.tid; }
            __syncthreads();
        }
    }
    }
    GRID_SYNC();
    LAS int* meta = (LAS int*)(lds + 146432 + 256);
    for (int rep_ = 0; rep_ < (int)((REP_MASK >> 11) & 1u) + 1; ++rep_) {
    {
        if (C.tid == 0) { int rb = 0, tb = 0;
            for (int c = 0; c < 24; ++c) { const int n = gcnt[c], nt = (n + 255) >> 8; meta[c] = n; meta[32 + c] = rb; meta[64 + c] = tb; rb += nt * 256; tb += nt; }
            meta[32 + 24] = rb; meta[64 + 24] = tb; }
        __syncthreads();
        LAS int* tokl = (LAS int*)(lds + 131072 + 2048);
        pg8::MoeOrder1G S{X2b, Wg_t, Wu_t, meta, tokl, (unsigned)(WS_END - WS_R4), C.G, C.bid};
        { pg8::Unit u;
          for (int i = 0; S.next(i, u); ++i) { const int cls = (u.pn & 0xffff) >> 2, p0 = (u.pm - meta[64 + cls]) * 256;
              if (C.tid < 256) { const int pp = p0 + C.tid, tok = pp < meta[cls] ? tlist[(size_t)cls * NTOK + pp] : -1; tokl[i * 256 + C.tid] = tok; tokg[u.pm * 256 + C.tid] = tok; } } }
        __syncthreads();
        pg8::EpiMoeUpG E{0, tokl, rstok, selw, HID};
        pg8::gemm_phase_gather<pg8::EpiMoeUpG, pg8::MoeOrder1G, true>((LAS unsigned char*)lds, pg8::Gemm{D, D, D}, S, E);
    }
    }
    GRID_SYNC();
    for (int rep_ = 0; rep_ < (int)((REP_MASK >> 12) & 1u) + 1; ++rep_) {
    { pg8::MoeOrder2 S{HID, Wd2, meta, C.G, C.bid};
      pg8::EpiMoeFinal E{0, tokg, X2b, out, ssq3, (unsigned*)(ws + WS_CTL + 4096 + 16384), norm_final, (LAS unsigned*)(lds + 146432 + 128), (unsigned*)(ws + WS_CTL + 4096) + 128};
      pg8::gemm_phase<pg8::EpiMoeFinal, pg8::MoeOrder2, true>((LAS unsigned char*)lds, pg8::Gemm{512, 512, 512}, S, E); }
    }
}

#undef gw
#undef lane
extern "C" void kernel_launch(void* const* d_in, const int* in_sizes, int n_in, void* d_out, int out_size, void* d_ws, size_t ws_size, hipStream_t stream) {
    static int grid = 0;
    if (grid == 0) {
        if (n_in != 29 || ws_size < WS_END + 4096) { fprintf(stderr, "kernel_launch: unexpected inputs (%d) or workspace (%zu)\n", n_in, ws_size); grid = -1; return; }
        int dev = 0, cus = 0, per_cu = 0;
        hipGetDevice(&dev); hipDeviceGetAttribute(&cus, hipDeviceAttributeMultiprocessorCount, dev);
        hipFuncSetAttribute((const void*)mk_fwd, hipFuncAttributeMaxDynamicSharedMemorySize, LDS_BYTES);
        hipOccupancyMaxActiveBlocksPerMultiprocessor(&per_cu, (const void*)mk_fwd, NTHREADS, LDS_BYTES);
        if (per_cu < 1) { fprintf(stderr, "kernel_launch: occupancy query says %d blocks per CU\n", per_cu); per_cu = 1; }
        if (per_cu > 1) per_cu = 1;
        grid = cus * per_cu;
    }
    if (grid < 0) return;
    if (hipMemsetAsync((char*)d_ws + WS_CTL + 4096, 0, 32768, stream) != hipSuccess) { fprintf(stderr, "kernel_launch: memset of the barrier words failed\n"); return; }
    Args a{};
    for (int i = 0; i < 29; ++i) a.in[i] = (const float*)d_in[i];
    a.out = (float*)d_out; a.ws = (unsigned char*)d_ws;
    void* kargs[] = {&a};
    hipError_t e = hipLaunchCooperativeKernel((const void*)mk_fwd, dim3(grid), dim3(NTHREADS), kargs, LDS_BYTES, stream);
    if (e != hipSuccess) fprintf(stderr, "cooperative launch failed: %s (grid %d)\n", hipGetErrorString(e), grid);
}
```

```cpp
#include <hip/hip_runtime.h>
#include <hip/hip_cooperative_groups.h>
#include <cstdio>
#include <cstdint>

typedef unsigned short bf16_t;
typedef short bf16x8 __attribute__((ext_vector_type(8)));
typedef float f32x4 __attribute__((ext_vector_type(4)));
typedef unsigned u32x4 __attribute__((ext_vector_type(4)));

constexpr int D = 1024, BATCH = 8, SEQ = 4096, NTOK = BATCH * SEQ, MEM = 256, NMEM = BATCH * MEM;
constexpr int RW = 512, SBW = 512, PROJ = 2560, NH = 8, HD = 64;
constexpr int XH = 4, XD = 256, NG = 4, EPG = 4, NEXP = 16, DE = 256;
constexpr float EPS = 1e-6f, LOG2E = 1.4426950408889634f;

constexpr size_t MiB = 1u << 20;
constexpr size_t WS_CTL = 0;
constexpr size_t WS_SMALL = 1 * MiB;
constexpr size_t WS_WIN = 16 * MiB;
constexpr size_t WS_WOUT = 21 * MiB;
constexpr size_t WS_WQ = 23 * MiB;
constexpr size_t WS_WKV = 25 * MiB;
constexpr size_t WS_WO = 29 * MiB;
constexpr size_t WS_MEMN = 31 * MiB;
constexpr size_t WS_KVM = 35 * MiB;
constexpr size_t WS_WG = 43 * MiB;
constexpr size_t WS_WU = 51 * MiB;
constexpr size_t WS_WD2 = 59 * MiB;
constexpr size_t WS_R0 = 96 * MiB;
constexpr size_t WS_R1 = 160 * MiB;
constexpr size_t WS_R2 = 224 * MiB;
constexpr size_t WS_R3 = 288 * MiB;
constexpr size_t WS_R4 = 320 * MiB;
constexpr size_t WS_R5 = 384 * MiB;
constexpr size_t WS_END = 448 * MiB;

constexpr size_t SM_RSTD0 = 0;
constexpr size_t SM_SSQR = 1 * 32768;
constexpr size_t SM_SSQS = 2 * 32768;
constexpr size_t SM_SSQ1 = 10 * 32768;
constexpr size_t SM_SSQ2 = 26 * 32768;
constexpr size_t SM_SSQ3 = 42 * 32768;
constexpr size_t SM_SELW = 58 * 32768;
constexpr size_t SM_SELE = 60 * 32768;
constexpr size_t SM_END = 62 * 32768;

__device__ __forceinline__ unsigned f2bf(float f) { unsigned u = __builtin_bit_cast(unsigned, f); return (u + 0x7fffu + ((u >> 16) & 1u)) >> 16; }
__device__ __forceinline__ float bf2f(unsigned short h) { return __builtin_bit_cast(float, (unsigned)h << 16); }
__device__ __forceinline__ float wave_sum(float v) {
#pragma unroll
    for (int o = 1; o < 64; o <<= 1) v += __shfl_xor(v, o);
    return v;
}
__device__ __forceinline__ float gelu_tanh(float x) { const float u = 0.7978845608028654f * (x + 0.044715f * x * x * x); return x * __builtin_amdgcn_rcpf(1.f + __expf(-2.f * u)); }
__device__ __forceinline__ float sigmoidf_(float x) { return 1.f / (1.f + __expf(-x)); }

namespace cg = cooperative_groups;
#ifndef PROBE_BLK
#define PROBE_BLK 0
#endif
#ifndef PROBE_A
#define PROBE_A -1
#endif
#ifndef REP_MASK
#define REP_MASK 0u
#endif
#define LAS __attribute__((address_space(3)))
constexpr int NWAVES = 8, NTHREADS = 512;
constexpr int LDS_BYTES = 147456;

struct Args { const float* in[29]; float* out; unsigned char* ws; };

struct Ctx {
    const float* in[29]; float* out; unsigned char* ws; unsigned char* lds;
    int tid, lane, wave, gw, NGW, G, bid;
};

#define RLX_AGENT __ATOMIC_RELAXED, __HIP_MEMORY_SCOPE_AGENT
#define XB_TMO      128
#define XB_XCNT(j)  (256  + 64 * (j))
#define XB_XSUB(j)  (1280 + 64 * (j))
#define XB_XGEN(j)  (2304 + 64 * (j))
#define XB_TOP      3328
#define XB_TOPGEN   3392
#define XCD_BAR_WORDS 3456
#define XB_SPIN_CAP (1u << 18)

__device__ __forceinline__ unsigned xb_ld(unsigned* p)              { return __hip_atomic_load(p, __ATOMIC_RELAXED, __HIP_MEMORY_SCOPE_AGENT); }
__device__ __forceinline__ unsigned xb_add(unsigned* p, unsigned v) { return __hip_atomic_fetch_add(p, v, __ATOMIC_RELAXED, __HIP_MEMORY_SCOPE_AGENT); }
__device__ __forceinline__ unsigned xb_xcc_id() { return (unsigned)__builtin_amdgcn_s_getreg((3 << 11) | 20) & 0xFu; }
#define XB_SPIN(cond, bar) do { unsigned _sp = 0; while (cond) { __builtin_amdgcn_s_sleep(1); \
    if ((++_sp & 255u) == 0u) { if (xb_ld(&(bar)[XB_TMO])) break; if (_sp > XB_SPIN_CAP) { atomicAdd(&(bar)[XB_TMO], 1u); break; } } } } while (0)

struct XcdBarrier {
    unsigned* bar; unsigned x;
    volatile LAS unsigned* st;
};

__device__ __forceinline__ XcdBarrier xcd_barrier_post(unsigned* bar, volatile LAS unsigned* st) {
    XcdBarrier b; b.bar = bar; b.x = xb_xcc_id(); b.st = st;
    if (threadIdx.x == 0) (void)xb_add(&bar[XB_XCNT(b.x)], 1u);
    return b;
}
__device__ __forceinline__ void xcd_barrier_complete(unsigned* bar, unsigned x, unsigned& nloc, unsigned& nx) {
    const unsigned G = gridDim.x * gridDim.y * gridDim.z;
    unsigned sum, cnt, mine, sp = 0u;
    for (;;) {
        sum = 0u; cnt = 0u; mine = 0u;
#pragma unroll
        for (unsigned j = 0; j < 16; ++j) { const unsigned c = xb_ld(&bar[XB_XCNT(j)]); sum += c; cnt += (c > 0u) ? 1u : 0u; mine = (j == x) ? c : mine; }
        if (sum == G) break;
        __builtin_amdgcn_s_sleep(1);
        if ((++sp & 255u) == 0u) { if (xb_ld(&bar[XB_TMO])) break; if (sp > XB_SPIN_CAP) { atomicAdd(&bar[XB_TMO], 1u); break; } }
    }
    nloc = mine > 0u ? mine : 1u; nx = cnt > 0u ? cnt : 1u;
}

__device__ __forceinline__ void xcd_barrier(const XcdBarrier& b) {
    asm volatile("s_waitcnt vmcnt(0)" ::: "memory");
    __syncthreads();
    if (threadIdx.x == 0) {
        unsigned* bar = b.bar;
        __builtin_amdgcn_s_waitcnt(0);
        unsigned nloc = b.st[0], nx = b.st[1];
        if (nloc == 0u) { xcd_barrier_complete(bar, b.x, nloc, nx); b.st[0] = nloc; b.st[1] = nx; }
        const unsigned old = xb_add(&bar[XB_XSUB(b.x)], 1u);
        const unsigned gen = old / nloc;
        if (old + 1u == (gen + 1u) * nloc) {
            __builtin_amdgcn_fence(__ATOMIC_RELEASE, "agent");
            asm volatile("s_waitcnt vmcnt(0)" ::: "memory");
            const unsigned og = xb_add(&bar[XB_TOP], 1u);
            const unsigned tg = og / nx;
            if (og + 1u == (tg + 1u) * nx) xb_add(&bar[XB_TOPGEN], 1u);
            else XB_SPIN(xb_ld(&bar[XB_TOPGEN]) == tg, bar);
            __builtin_amdgcn_fence(__ATOMIC_ACQUIRE, "agent");
            xb_add(&bar[XB_XGEN(b.x)], 1u);
            asm volatile("s_waitcnt vmcnt(0)" ::: "memory");
        } else {
            XB_SPIN(xb_ld(&bar[XB_XGEN(b.x)]) == gen, bar);
            __builtin_amdgcn_fence(__ATOMIC_ACQUIRE, "agent");
            asm volatile("s_waitcnt vmcnt(0)" ::: "memory");
        }
    }
    __syncthreads();
}
namespace pg8 {
#define PG8_LAS __attribute__((address_space(3)))
constexpr int BM = 256, BK = 64, HALF = 128, HTB = HALF * BK * 2  , STAGE_BYTES = 8 * HTB, NXCD = 8, WGM = 4;
__host__ __device__ __forceinline__ int lds_byte(int r, int c) { const int st = (r >> 4) * 2 + (c >> 5), rr = r & 15, cc = c & 31, ob = rr * 64 + cc * 2; return st * 1024 + (ob ^ (((ob >> 9) & 1) << 5)); }
__host__ __device__ __forceinline__ void stage_rc(int b, int& R, int& C) { const int st = b / 1024, sb = b % 1024, swz = sb ^ (((sb >> 9) & 1) << 5); R = (st >> 1) * 16 + swz / 64; C = (st & 1) * 32 + (swz % 64) / 2; }
__host__ __device__ __forceinline__ int perm32(int rho) { const int n = rho >> 4, i = rho & 15; return 8 * (i >> 2) + 4 * n + (i & 3); }

struct Unit { int pm, pn; };
struct Gemm { int lda, ldb, K; };
struct DenseOrder {
    const bf16_t* A; const bf16_t* Bt; int lda, ldb; int nM, nN, nwg, G, c; int ntk = D / BK;
    __device__ __forceinline__ int nt(const Unit&) const { return ntk; }
    __device__ __forceinline__ void init(const bf16_t* A_, int lda_, const bf16_t* Bt_, int ldb_, int M, int N, int G_, int c_) { A = A_; Bt = Bt_; lda = lda_; ldb = ldb_; nM = M / BM; nN = N / BM; nwg = nM * nN; G = G_; c = c_; }
    __device__ __forceinline__ bool next(int i, Unit& u) const {
        const long L = (long)i * G + c; if (L >= nwg) return false;
        int wgid = (int)L; { const int q = nwg / NXCD, r = nwg % NXCD, xcd = wgid % NXCD, off = wgid / NXCD; wgid = (xcd < r ? xcd * (q + 1) : r * (q + 1) + (xcd - r) * q) + off; }
        const int nig = WGM * nN, gid = wgid / nig, fm = gid * WGM, gsz = (nM - fm) < WGM ? (nM - fm) : WGM;
        u.pm = fm + ((wgid % nig) % gsz); u.pn = (wgid % nig) / gsz; return true;
    }
    __device__ __forceinline__ void ptrs(const Unit& u, const char*& a, const char*& b0, const char*& b1) const {
        a = (const char*)A + (size_t)u.pm * BM * lda * 2; b0 = (const char*)Bt + (size_t)u.pn * BM * ldb * 2; b1 = b0 + (size_t)HALF * ldb * 2; }
};

__device__ __forceinline__ unsigned cvt_pk_bf16(float lo, float hi) { unsigned r; asm volatile("v_cvt_pk_bf16_f32 %0, %1, %2" : "=v"(r) : "v"(lo), "v"(hi)); return r; }

template <class Epi, class Sched, bool ALIGN_EPI>
__device__ __forceinline__ void gemm_phase(PG8_LAS unsigned char* lds, const Gemm g, const Sched& S, const Epi& E, int pidx = 0) {
    int tid_ = threadIdx.x; asm volatile("" : "+v"(tid_));
    const int tid = tid_, wid = __builtin_amdgcn_readfirstlane(tid >> 6), lane = tid & 63, wr = wid >> 2, wc = wid & 3, fr = lane & 15, fq = lane >> 4;
    unsigned voffA[2], voffB[2];
#pragma unroll
    for (int i = 0; i < 2; ++i) { int R, C; stage_rc(tid * 16 + i * 8192, R, C); const int Rb = Epi::PERM ? ((R & ~31) + perm32(R & 31)) : R;
        voffA[i] = (unsigned)(R * g.lda + C) * 2u; voffB[i] = (unsigned)(Rb * g.ldb + C) * 2u; }
    const size_t kstep = (size_t)(BK * 2);
    const size_t hstepA = (size_t)HALF * g.lda * 2;
    const unsigned ldsw = (unsigned)wid * 1024u;
    const int aoff = lds_byte(wr * 64 + fr, fq * 8), boff = lds_byte(wc * 32 + fr, fq * 8);
#define PG8_SA(b, h) (((b) * 2 + (h)) * HTB)
#define PG8_SB(b, h) ((4 + (b) * 2 + (h)) * HTB)
#define PG8_STAGE(bufoff, gbase, voff) do { _Pragma("unroll") for (int _i = 0; _i < 2; ++_i) \
        __builtin_amdgcn_global_load_lds((const unsigned*)((const char*)(gbase) + (voff)[_i]), (PG8_LAS unsigned*)(lds + (bufoff) + ldsw + _i * 8192), 16, 0, 0); } while (0)
#define PG8_LDA(dst, b, h) do { _Pragma("unroll") for (int m = 0; m < 4; ++m) _Pragma("unroll") for (int k = 0; k < 2; ++k) dst[m][k] = *(const PG8_LAS bf16x8*)(lds + PG8_SA(b, h) + aoff + m * 2048 + k * 1024); } while (0)
#define PG8_LDB(dst, b, h) do { _Pragma("unroll") for (int n = 0; n < 2; ++n) _Pragma("unroll") for (int k = 0; k < 2; ++k) dst[n][k] = *(const PG8_LAS bf16x8*)(lds + PG8_SB(b, h) + boff + n * 2048 + k * 1024); } while (0)
#define PG8_MMA(ai, bj, At, Bt) do { __builtin_amdgcn_s_setprio(1); _Pragma("unroll") for (int m = 0; m < 4; ++m) _Pragma("unroll") for (int n = 0; n < 2; ++n) _Pragma("unroll") for (int k = 0; k < 2; ++k) \
        acc[ai][bj][m][n] = __builtin_amdgcn_mfma_f32_16x16x32_bf16(Bt[n][k], At[m][k], acc[ai][bj][m][n], 0, 0, 0); __builtin_amdgcn_s_setprio(0); } while (0)
#define PG8_WAIT_V(n) asm volatile("s_waitcnt vmcnt(" #n ")" ::: "memory")
#define PG8_WAIT_L(n) asm volatile("s_waitcnt lgkmcnt(" #n ")" ::: "memory")
#define PG8_BAR __builtin_amdgcn_s_barrier()
#define PG8_SCHED __builtin_amdgcn_sched_barrier(0)
    Unit cur, nxt; int ui = 0;
    if (!S.next(0, cur)) return;
    f32x4 acc[2][2][4][2];
#pragma unroll
    for (int a = 0; a < 2; ++a)
#pragma unroll
        for (int b = 0; b < 2; ++b)
#pragma unroll
            for (int m = 0; m < 4; ++m)
#pragma unroll
                for (int n = 0; n < 2; ++n) acc[a][b][m][n] = (f32x4){0.f, 0.f, 0.f, 0.f};
    bf16x8 At[4][2], B0[2][2], B1[2][2];
    const char *cA, *cB0, *cB1; S.ptrs(cur, cA, cB0, cB1);
    int nt = S.nt(cur); asm volatile("" : "+s"(nt));
    PG8_STAGE(PG8_SB(0, 0), cB0, voffB); PG8_STAGE(PG8_SB(0, 1), cB1, voffB); PG8_STAGE(PG8_SA(0, 0), cA, voffA); PG8_STAGE(PG8_SA(0, 1), cA + hstepA, voffA);
    if (wr == 1) PG8_BAR;
    PG8_WAIT_V(2); PG8_BAR;
    PG8_STAGE(PG8_SB(1, 0), cB0 + kstep, voffB); PG8_STAGE(PG8_SA(1, 0), cA + kstep, voffA); PG8_STAGE(PG8_SB(1, 1), cB1 + kstep, voffB);
    PG8_WAIT_V(6); PG8_BAR;
    for (;;) {
        const bool has_next = S.next(ui + 1, nxt);
        const char *nA = cA, *nB0 = cB0, *nB1 = cB1; if (has_next) S.ptrs(nxt, nA, nB0, nB1);
#pragma unroll 1
        for (int t = 0; t < nt; t += 2) {
            const bool last = (t == nt - 2);
            if constexpr (Epi::HAS_MID) { if (t == E.mid_t) E.mid(acc, cur, wr, wc, fr, fq); }
            const char* a1 = cA + (size_t)(t + 1) * kstep;
            const char* a2 = last ? nA : cA + (size_t)(t + 2) * kstep; const char* b2 = last ? nB0 : cB0 + (size_t)(t + 2) * kstep; const char* b2h = last ? nB1 : cB1 + (size_t)(t + 2) * kstep;
            const char* a3 = a2 + kstep; const char* b3 = b2 + kstep; const char* b3h = b2h + kstep;
            PG8_LDB(B0, 0, 0); PG8_LDB(B1, 0, 1); PG8_SCHED; PG8_LDA(At, 0, 0); PG8_STAGE(PG8_SA(1, 1), a1 + hstepA, voffA);
            PG8_WAIT_V(8); PG8_WAIT_L(0); PG8_BAR; PG8_MMA(0, 0, At, B0); PG8_MMA(0, 1, At, B1); PG8_BAR; PG8_SCHED;
            PG8_LDA(At, 0, 1); PG8_STAGE(PG8_SB(0, 0), b2, voffB); PG8_STAGE(PG8_SB(0, 1), b2h, voffB); PG8_STAGE(PG8_SA(0, 0), a2, voffA);
            PG8_WAIT_V(8); PG8_WAIT_L(0); PG8_BAR; PG8_MMA(1, 0, At, B0); PG8_MMA(1, 1, At, B1); PG8_BAR; PG8_SCHED;
            PG8_LDB(B0, 1, 0); PG8_LDB(B1, 1, 1); PG8_SCHED; PG8_LDA(At, 1, 0); PG8_STAGE(PG8_SA(0, 1), a2 + hstepA, voffA);
            PG8_WAIT_V(8); PG8_WAIT_L(0); PG8_BAR; PG8_MMA(0, 0, At, B0); PG8_MMA(0, 1, At, B1); PG8_BAR; PG8_SCHED;
            PG8_LDA(At, 1, 1); PG8_STAGE(PG8_SB(1, 0), b3, voffB); PG8_STAGE(PG8_SB(1, 1), b3h, voffB); PG8_STAGE(PG8_SA(1, 0), a3, voffA);
            PG8_WAIT_V(8); PG8_WAIT_L(0); PG8_BAR; PG8_MMA(1, 0, At, B0); PG8_MMA(1, 1, At, B1); PG8_BAR; PG8_SCHED;
        }
        if constexpr (ALIGN_EPI) { if (wr == 0) PG8_BAR; }
        { unsigned long long te_ = 0; if (PROBE_A >= 500 && blockIdx.x == 0 && tid == 0) te_ = __builtin_amdgcn_s_memrealtime();
        E(acc, cur, wr, wc, fr, fq);
        if (PROBE_A >= 500 && blockIdx.x == 0 && tid == 0) { PG8_LAS unsigned long long* es_ = (PG8_LAS unsigned long long*)(lds + 147200) + 16 + pidx; *es_ += __builtin_amdgcn_s_memrealtime() - te_; } }
        if (!has_next) break;
#pragma unroll
        for (int a = 0; a < 2; ++a)
#pragma unroll
            for (int b = 0; b < 2; ++b)
#pragma unroll
                for (int m = 0; m < 4; ++m)
#pragma unroll
                    for (int n = 0; n < 2; ++n) acc[a][b][m][n] = (f32x4){0.f, 0.f, 0.f, 0.f};
        cur = nxt; cA = nA; cB0 = nB0; cB1 = nB1; ++ui; nt = S.nt(cur); asm volatile("" : "+s"(nt));
        if constexpr (ALIGN_EPI) { if (wr == 1) PG8_BAR; }
    }
    PG8_WAIT_V(0);
    if constexpr (!ALIGN_EPI) { if (wr == 0) PG8_BAR; }
    PG8_BAR;
#undef PG8_SA
#undef PG8_SB
#undef PG8_STAGE
#undef PG8_LDA
#undef PG8_LDB
#undef PG8_MMA
#undef PG8_WAIT_V
#undef PG8_WAIT_L
#undef PG8_BAR
#undef PG8_SCHED
}

template <class Epi, class Sched, bool ALIGN_EPI>
__device__ __forceinline__ void gemm_phase_gather(PG8_LAS unsigned char* lds, const Gemm g, const Sched& S, const Epi& E, int pidx = 0) {
    int tid_ = threadIdx.x; asm volatile("" : "+v"(tid_));
    const int tid = tid_, wid = __builtin_amdgcn_readfirstlane(tid >> 6), lane = tid & 63, wr = wid >> 2, wc = wid & 3, fr = lane & 15, fq = lane >> 4;
    unsigned voffB[2], vAc[2][2], vAn[2][2];
#pragma unroll
    for (int i = 0; i < 2; ++i) { int R, C; stage_rc(tid * 16 + i * 8192, R, C); const int Rb = Epi::PERM ? ((R & ~31) + perm32(R & 31)) : R;
        voffB[i] = (unsigned)(Rb * g.ldb + C) * 2u; }
#define PG8_LOADVA(v, ui_) do { _Pragma("unroll") for (int h_ = 0; h_ < 2; ++h_) _Pragma("unroll") for (int i_ = 0; i_ < 2; ++i_) { int R_, C_; stage_rc(tid * 16 + i_ * 8192, R_, C_); \
        v[h_][i_] = S.aoff(ui_, h_ * HALF + R_) + (unsigned)C_ * 2u; } } while (0)
    const size_t kstep = (size_t)(BK * 2);
    const unsigned ldsw = (unsigned)wid * 1024u;
    const int aoff = lds_byte(wr * 64 + fr, fq * 8), boff = lds_byte(wc * 32 + fr, fq * 8);
#define PG8_SA(b, h) (((b) * 2 + (h)) * HTB)
#define PG8_SB(b, h) ((4 + (b) * 2 + (h)) * HTB)
#define PG8_STAGE(bufoff, gbase, voff) do { _Pragma("unroll") for (int _i = 0; _i < 2; ++_i) \
        __builtin_amdgcn_global_load_lds((const unsigned*)((const char*)(gbase) + (voff)[_i]), (PG8_LAS unsigned*)(lds + (bufoff) + ldsw + _i * 8192), 16, 0, 0); } while (0)
#define PG8_LDA(dst, b, h) do { _Pragma("unroll") for (int m = 0; m < 4; ++m) _Pragma("unroll") for (int k = 0; k < 2; ++k) dst[m][k] = *(const PG8_LAS bf16x8*)(lds + PG8_SA(b, h) + aoff + m * 2048 + k * 1024); } while (0)
#define PG8_LDB(dst, b, h) do { _Pragma("unroll") for (int n = 0; n < 2; ++n) _Pragma("unroll") for (int k = 0; k < 2; ++k) dst[n][k] = *(const PG8_LAS bf16x8*)(lds + PG8_SB(b, h) + boff + n * 2048 + k * 1024); } while (0)
#define PG8_MMA(ai, bj, At, Bt) do { __builtin_amdgcn_s_setprio(1); _Pragma("unroll") for (int m = 0; m < 4; ++m) _Pragma("unroll") for (int n = 0; n < 2; ++n) _Pragma("unroll") for (int k = 0; k < 2; ++k) \
        acc[ai][bj][m][n] = __builtin_amdgcn_mfma_f32_16x16x32_bf16(Bt[n][k], At[m][k], acc[ai][bj][m][n], 0, 0, 0); __builtin_amdgcn_s_setprio(0); } while (0)
#define PG8_WAIT_V(n) asm volatile("s_waitcnt vmcnt(" #n ")" ::: "memory")
#define PG8_WAIT_L(n) asm volatile("s_waitcnt lgkmcnt(" #n ")" ::: "memory")
#define PG8_BAR __builtin_amdgcn_s_barrier()
#define PG8_SCHED __builtin_amdgcn_sched_barrier(0)
    Unit cur, nxt; int ui = 0;
    if (!S.next(0, cur)) return;
    f32x4 acc[2][2][4][2];
#pragma unroll
    for (int a = 0; a < 2; ++a)
#pragma unroll
        for (int b = 0; b < 2; ++b)
#pragma unroll
            for (int m = 0; m < 4; ++m)
#pragma unroll
                for (int n = 0; n < 2; ++n) acc[a][b][m][n] = (f32x4){0.f, 0.f, 0.f, 0.f};
    bf16x8 At[4][2], B0[2][2], B1[2][2];
    const char *cA, *cB0, *cB1; S.ptrs(cur, cA, cB0, cB1);
    PG8_LOADVA(vAc, 0);
    int nt = S.nt(cur); asm volatile("" : "+s"(nt));
    PG8_STAGE(PG8_SB(0, 0), cB0, voffB); PG8_STAGE(PG8_SB(0, 1), cB1, voffB); PG8_STAGE(PG8_SA(0, 0), cA, vAc[0]); PG8_STAGE(PG8_SA(0, 1), cA, vAc[1]);
    if (wr == 1) PG8_BAR;
    PG8_WAIT_V(2); PG8_BAR;
    PG8_STAGE(PG8_SB(1, 0), cB0 + kstep, voffB); PG8_STAGE(PG8_SA(1, 0), cA + kstep, vAc[0]); PG8_STAGE(PG8_SB(1, 1), cB1 + kstep, voffB);
    PG8_WAIT_V(6); PG8_BAR;
    for (;;) {
        const bool has_next = S.next(ui + 1, nxt);
        const char *nA = cA, *nB0 = cB0, *nB1 = cB1; if (has_next) { S.ptrs(nxt, nA, nB0, nB1); PG8_LOADVA(vAn, ui + 1); } else { _Pragma("unroll") for (int h_ = 0; h_ < 2; ++h_) _Pragma("unroll") for (int i_ = 0; i_ < 2; ++i_) vAn[h_][i_] = vAc[h_][i_]; }
#pragma unroll 1
        for (int t = 0; t < nt; t += 2) {
            const bool last = (t == nt - 2);
            if constexpr (Epi::HAS_MID) { if (t == E.mid_t) E.mid(acc, cur, wr, wc, fr, fq); }
            const char* a1 = cA + (size_t)(t + 1) * kstep;
            const char* a2 = cA + (size_t)(last ? 0 : t + 2) * kstep; unsigned vs0[2], vs1[2]; vs0[0] = last ? vAn[0][0] : vAc[0][0]; vs0[1] = last ? vAn[0][1] : vAc[0][1]; vs1[0] = last ? vAn[1][0] : vAc[1][0]; vs1[1] = last ? vAn[1][1] : vAc[1][1]; const char* b2 = last ? nB0 : cB0 + (size_t)(t + 2) * kstep; const char* b2h = last ? nB1 : cB1 + (size_t)(t + 2) * kstep;
            const char* a3 = a2 + kstep; const char* b3 = b2 + kstep; const char* b3h = b2h + kstep;
            PG8_LDB(B0, 0, 0); PG8_LDB(B1, 0, 1); PG8_SCHED; PG8_LDA(At, 0, 0); PG8_STAGE(PG8_SA(1, 1), a1, vAc[1]);
            PG8_WAIT_V(8); PG8_WAIT_L(0); PG8_BAR; PG8_MMA(0, 0, At, B0); PG8_MMA(0, 1, At, B1); PG8_BAR; PG8_SCHED;
            PG8_LDA(At, 0, 1); PG8_STAGE(PG8_SB(0, 0), b2, voffB); PG8_STAGE(PG8_SB(0, 1), b2h, voffB); PG8_STAGE(PG8_SA(0, 0), a2, vs0);
            PG8_WAIT_V(8); PG8_WAIT_L(0); PG8_BAR; PG8_MMA(1, 0, At, B0); PG8_MMA(1, 1, At, B1); PG8_BAR; PG8_SCHED;
            PG8_LDB(B0, 1, 0); PG8_LDB(B1, 1, 1); PG8_SCHED; PG8_LDA(At, 1, 0); PG8_STAGE(PG8_SA(0, 1), a2, vs1);
            PG8_WAIT_V(8); PG8_WAIT_L(0); PG8_BAR; PG8_MMA(0, 0, At, B0); PG8_MMA(0, 1, At, B1); PG8_BAR; PG8_SCHED;
            PG8_LDA(At, 1, 1); PG8_STAGE(PG8_SB(1, 0), b3, voffB); PG8_STAGE(PG8_SB(1, 1), b3h, voffB); PG8_STAGE(PG8_SA(1, 0), a3, vs0);
            PG8_WAIT_V(8); PG8_WAIT_L(0); PG8_BAR; PG8_MMA(1, 0, At, B0); PG8_MMA(1, 1, At, B1); PG8_BAR; PG8_SCHED;
        }
        if constexpr (ALIGN_EPI) { if (wr == 0) PG8_BAR; }
        { unsigned long long te_ = 0; if (PROBE_A >= 500 && blockIdx.x == 0 && tid == 0) te_ = __builtin_amdgcn_s_memrealtime();
        E(acc, cur, wr, wc, fr, fq);
        if (PROBE_A >= 500 && blockIdx.x == 0 && tid == 0) { PG8_LAS unsigned long long* es_ = (PG8_LAS unsigned long long*)(lds + 147200) + 16 + pidx; *es_ += __builtin_amdgcn_s_memrealtime() - te_; } }
        if (!has_next) break;
#pragma unroll
        for (int a = 0; a < 2; ++a)
#pragma unroll
            for (int b = 0; b < 2; ++b)
#pragma unroll
                for (int m = 0; m < 4; ++m)
#pragma unroll
                    for (int n = 0; n < 2; ++n) acc[a][b][m][n] = (f32x4){0.f, 0.f, 0.f, 0.f};
        cur = nxt; cA = nA; cB0 = nB0; cB1 = nB1; ++ui;
#pragma unroll
        for (int h_ = 0; h_ < 2; ++h_)
#pragma unroll
            for (int i_ = 0; i_ < 2; ++i_) vAc[h_][i_] = vAn[h_][i_]; nt = S.nt(cur); asm volatile("" : "+s"(nt));
        if constexpr (ALIGN_EPI) { if (wr == 1) PG8_BAR; }
    }
    PG8_WAIT_V(0);
    if constexpr (!ALIGN_EPI) { if (wr == 0) PG8_BAR; }
    PG8_BAR;
#undef PG8_LOADVA
#undef PG8_SA
#undef PG8_SB
#undef PG8_STAGE
#undef PG8_LDA
#undef PG8_LDB
#undef PG8_MMA
#undef PG8_WAIT_V
#undef PG8_WAIT_L
#undef PG8_BAR
#undef PG8_SCHED
}


__device__ __forceinline__ float rstd16(const float* p) { const f32x4 a = ((const f32x4*)p)[0], b = ((const f32x4*)p)[1], c = ((const f32x4*)p)[2], d = ((const f32x4*)p)[3];
    const float s = ((a.x + a.y) + (a.z + a.w)) + ((b.x + b.y) + (b.z + b.w)) + ((c.x + c.y) + (c.z + c.w)) + ((d.x + d.y) + (d.z + d.w)); return __builtin_amdgcn_rsqf(s * (1.f / D) + EPS); }
__device__ __forceinline__ u32x4 pack8(const f32x4 v0, const f32x4 v1) { u32x4 w; w.x = cvt_pk_bf16(v0[0], v0[1]); w.y = cvt_pk_bf16(v0[2], v0[3]); w.z = cvt_pk_bf16(v1[0], v1[1]); w.w = cvt_pk_bf16(v1[2], v1[3]); return w; }
__device__ __forceinline__ float sq8(const f32x4 a, const f32x4 b) { return ((a[0] * a[0] + a[1] * a[1]) + (a[2] * a[2] + a[3] * a[3])) + ((b[0] * b[0] + b[1] * b[1]) + (b[2] * b[2] + b[3] * b[3])); }

struct EpiInProjF {
    static constexpr bool PERM = true, HAS_MID = false; int mid_t;
    const float* rstd0; bf16_t *XR, *GG, *Qs, *Ks, *Vs; unsigned* kmax;
    __device__ __forceinline__ void mid(f32x4 (&)[2][2][4][2], const Unit&, int, int, int, int) const {}
    __device__ __forceinline__ void operator()(const f32x4 (&acc)[2][2][4][2], const Unit& u, int wr, int wc, int fr, int fq) const {
        const int row0 = u.pm * BM + wr * 64 + fr, t = u.pn >> 1, colt = (u.pn & 1) * 256 + wc * 32 + 8 * fq;
        bf16_t* base = (t == 0) ? XR : (t == 1) ? GG : (t == 2) ? Qs : (t == 3) ? Ks : Vs;
        float km0 = 0.f, km1 = 0.f;
#pragma unroll
        for (int ai = 0; ai < 2; ++ai)
#pragma unroll
            for (int m = 0; m < 4; ++m) { const int r = row0 + ai * HALF + m * 16; const float rs = rstd0[r]; bf16_t* rowp = base + (size_t)r * 512 + colt;
#pragma unroll
                for (int bj = 0; bj < 2; ++bj) { f32x4 v0 = acc[ai][bj][m][0] * rs, v1 = acc[ai][bj][m][1] * rs;
                    if (t == 1) {
#pragma unroll
                        for (int e = 0; e < 4; ++e) { v0[e] = gelu_tanh(v0[e]); v1[e] = gelu_tanh(v1[e]); } }
                    else if (t == 2) { v0 = v0 * (0.125f * LOG2E); v1 = v1 * (0.125f * LOG2E); }
                    else if (t == 3) { float mx = 0.f;
#pragma unroll
                        for (int e = 0; e < 4; ++e) mx = fmaxf(mx, fmaxf(fabsf(v0[e]), fabsf(v1[e])));
                        if (bj == 0) km0 = fmaxf(km0, mx); else km1 = fmaxf(km1, mx); }
                    *(u32x4*)(rowp + bj * HALF) = pack8(v0, v1); } }
        if (t == 3) {
#pragma unroll
            for (int o = 1; o < 64; o <<= 1) { km0 = fmaxf(km0, __shfl_xor(km0, o)); km1 = fmaxf(km1, __shfl_xor(km1, o)); }
            if ((fr | fq) == 0) { const int b = (u.pm * BM) / SEQ, hd = (u.pn & 1) * 4 + (wc >> 1);
                atomicMax(kmax + b * 8 + hd, __float_as_uint(km0)); atomicMax(kmax + b * 8 + hd + 2, __float_as_uint(km1)); }
        }
    }
};
struct EpiBf16F {
    static constexpr bool PERM = true, HAS_MID = false; int mid_t;
    bf16_t* O; const float* ssq16; int ldo; float scale; size_t tstride;
    __device__ __forceinline__ void mid(f32x4 (&)[2][2][4][2], const Unit&, int, int, int, int) const {}
    __device__ __forceinline__ void operator()(const f32x4 (&acc)[2][2][4][2], const Unit& u, int wr, int wc, int fr, int fq) const {
        const int row0 = u.pm * BM + wr * 64 + fr, col0 = (tstride ? 0 : u.pn * BM) + wc * 32 + 8 * fq; bf16_t* base = O + (size_t)u.pn * tstride;
#pragma unroll
        for (int ai = 0; ai < 2; ++ai)
#pragma unroll
            for (int m = 0; m < 4; ++m) { const int r = row0 + ai * HALF + m * 16; const float rs = (ssq16 ? rstd16(ssq16 + (size_t)r * 16) : 1.f) * scale; bf16_t* rowp = base + (size_t)r * ldo + col0;
#pragma unroll
                for (int bj = 0; bj < 2; ++bj) *(u32x4*)(rowp + bj * HALF) = pack8(acc[ai][bj][m][0] * rs, acc[ai][bj][m][1] * rs); }
    }
};
struct EpiX1F {
    static constexpr bool PERM = true, HAS_MID = true; int mid_t;
    const bf16_t* xb; const float* fmid; const float* fend; bf16_t* X1b; float* ssq1;
    __device__ __forceinline__ void mid(f32x4 (&acc)[2][2][4][2], const Unit& u, int wr, int wc, int fr, int fq) const {
        const int row0 = u.pm * BM + wr * 64 + fr;
#pragma unroll
        for (int ai = 0; ai < 2; ++ai)
#pragma unroll
            for (int m = 0; m < 4; ++m) { const float f = fmid[row0 + ai * HALF + m * 16];
#pragma unroll
                for (int bj = 0; bj < 2; ++bj) { acc[ai][bj][m][0] = acc[ai][bj][m][0] * f; acc[ai][bj][m][1] = acc[ai][bj][m][1] * f; } }
    }
    __device__ __forceinline__ void operator()(const f32x4 (&acc)[2][2][4][2], const Unit& u, int wr, int wc, int fr, int fq) const {
        const int row0 = u.pm * BM + wr * 64 + fr, col0 = u.pn * BM + wc * 32 + 8 * fq;
#pragma unroll
        for (int ai = 0; ai < 2; ++ai)
#pragma unroll
            for (int m = 0; m < 4; ++m) { const int r = row0 + ai * HALF + m * 16; const float fe = fend[r]; float ss = 0.f;
#pragma unroll
                for (int bj = 0; bj < 2; ++bj) { const u32x4 xi = *(const u32x4*)(xb + (size_t)r * D + col0 + bj * HALF);
                    f32x4 v0, v1; v0[0] = __uint_as_float(xi.x << 16); v0[1] = __uint_as_float(xi.x & 0xffff0000u); v0[2] = __uint_as_float(xi.y << 16); v0[3] = __uint_as_float(xi.y & 0xffff0000u);
                    v1[0] = __uint_as_float(xi.z << 16); v1[1] = __uint_as_float(xi.z & 0xffff0000u); v1[2] = __uint_as_float(xi.w << 16); v1[3] = __uint_as_float(xi.w & 0xffff0000u);
                    v0 = v0 + acc[ai][bj][m][0] * fe; v1 = v1 + acc[ai][bj][m][1] * fe;
                    ss += sq8(v0, v1); *(u32x4*)(X1b + (size_t)r * D + col0 + bj * HALF) = pack8(v0, v1); }
                ss += __shfl_xor(ss, 16); ss += __shfl_xor(ss, 32);
                if (fq == 0) ssq1[(size_t)r * 16 + u.pn * 4 + wc] = ss; }
    }
};
struct EpiResF {
    static constexpr bool PERM = true, HAS_MID = false; int mid_t;
    const bf16_t* Xi; bf16_t* Xo; float* ssq;
    __device__ __forceinline__ void mid(f32x4 (&)[2][2][4][2], const Unit&, int, int, int, int) const {}
    __device__ __forceinline__ void operator()(const f32x4 (&acc)[2][2][4][2], const Unit& u, int wr, int wc, int fr, int fq) const {
        const int row0 = u.pm * BM + wr * 64 + fr, col0 = u.pn * BM + wc * 32 + 8 * fq;
#pragma unroll
        for (int ai = 0; ai < 2; ++ai)
#pragma unroll
            for (int m = 0; m < 4; ++m) { const int r = row0 + ai * HALF + m * 16; float ss = 0.f;
#pragma unroll
                for (int bj = 0; bj < 2; ++bj) { const u32x4 xi = *(const u32x4*)(Xi + (size_t)r * D + col0 + bj * HALF);
                    f32x4 v0, v1; v0[0] = __uint_as_float(xi.x << 16); v0[1] = __uint_as_float(xi.x & 0xffff0000u); v0[2] = __uint_as_float(xi.y << 16); v0[3] = __uint_as_float(xi.y & 0xffff0000u);
                    v1[0] = __uint_as_float(xi.z << 16); v1[1] = __uint_as_float(xi.z & 0xffff0000u); v1[2] = __uint_as_float(xi.w << 16); v1[3] = __uint_as_float(xi.w & 0xffff0000u);
                    v0 = v0 + acc[ai][bj][m][0]; v1 = v1 + acc[ai][bj][m][1];
                    ss += sq8(v0, v1); *(u32x4*)(Xo + (size_t)r * D + col0 + bj * HALF) = pack8(v0, v1); }
                ss += __shfl_xor(ss, 16); ss += __shfl_xor(ss, 32);
                if (fq == 0) ssq[(size_t)r * 16 + u.pn * 4 + wc] = ss; }
    }
};

__device__ __forceinline__ void pair_ab(int p, int& a, int& b) { a = (p < 3) ? 0 : (p < 5) ? 1 : 2; b = (p < 3) ? p + 1 : (p < 5) ? p - 1 : 3; }
__device__ __forceinline__ int moe_class_of_tile(const PG8_LAS int* meta, int T) { int c = 0;
#pragma unroll
    for (int k = 1; k < 24; ++k) c += (T >= __builtin_amdgcn_readfirstlane(meta[64 + k])) ? 1 : 0;
    return c; }
struct MoeOrder1 {
    __device__ __forceinline__ int nt(const Unit&) const { return D / BK; }
    const bf16_t* XG; const bf16_t* Wg; const bf16_t* Wu; const PG8_LAS int* meta; int G, c;
    __device__ __forceinline__ bool next(int i, Unit& u) const { const int L = i * G + c, nt = __builtin_amdgcn_readfirstlane(meta[64 + 24]); if (L >= nt * 4) return false;
        u.pm = L >> 2; u.pn = moe_class_of_tile(meta, L >> 2) * 4 + (L & 3); return true; }
    __device__ __forceinline__ void ptrs(const Unit& u, const char*& a, const char*& b0, const char*& b1) const {
        const int cls = u.pn >> 2, j = (u.pn >> 1) & 1, half = u.pn & 1; int ea, eb; pair_ab(cls % 6, ea, eb); const int e = (cls / 6) * 4 + (j ? eb : ea);
        a = (const char*)XG + (size_t)u.pm * BM * D * 2; const size_t bo = ((size_t)e * DE + half * HALF) * D * 2; b0 = (const char*)Wg + bo; b1 = (const char*)Wu + bo; }
};
struct MoeOrder2 {
    __device__ __forceinline__ int nt(const Unit&) const { return 512 / BK; }
    const bf16_t* HID; const bf16_t* Wd2; const PG8_LAS int* meta; int G, c;
    __device__ __forceinline__ bool next(int i, Unit& u) const { const int nt = __builtin_amdgcn_readfirstlane(meta[64 + 24]);
        const int x = c % NXCD, y = c / NXCD, T = i * (G / 4) + x * (G / 32) + (y >> 2); if (T >= nt) return false;
        u.pm = T; u.pn = moe_class_of_tile(meta, T) * 4 + (y & 3); return true; }
    __device__ __forceinline__ void ptrs(const Unit& u, const char*& a, const char*& b0, const char*& b1) const {
        a = (const char*)HID + (size_t)u.pm * BM * 512 * 2; b0 = (const char*)Wd2 + ((size_t)(u.pn >> 2) * D + (u.pn & 3) * BM) * 512 * 2; b1 = b0 + (size_t)HALF * 512 * 2; }
};
struct EpiMoeUp {
    static constexpr bool PERM = true, HAS_MID = false; int mid_t;
    const float* rsg; const float* wAg; const float* wBg; bf16_t* HID;
    __device__ __forceinline__ void mid(f32x4 (&)[2][2][4][2], const Unit&, int, int, int, int) const {}
    __device__ __forceinline__ void operator()(const f32x4 (&acc)[2][2][4][2], const Unit& u, int wr, int wc, int fr, int fq) const {
        const int row0 = u.pm * BM + wr * 64 + fr, j = (u.pn >> 1) & 1, col0 = j * 256 + (u.pn & 1) * HALF + wc * 32 + 8 * fq; const float* wg = j ? wBg : wAg;
#pragma unroll
        for (int ai = 0; ai < 2; ++ai)
#pragma unroll
            for (int m = 0; m < 4; ++m) { const int r = row0 + ai * HALF + m * 16; const float rs = rsg[r], w = wg[r]; f32x4 h0, h1;
#pragma unroll
                for (int e = 0; e < 4; ++e) { const float g0 = acc[ai][0][m][0][e] * rs, g1 = acc[ai][0][m][1][e] * rs;
                    h0[e] = g0 * __builtin_amdgcn_rcpf(1.f + __expf(-g0)) * (acc[ai][1][m][0][e] * rs) * w; h1[e] = g1 * __builtin_amdgcn_rcpf(1.f + __expf(-g1)) * (acc[ai][1][m][1][e] * rs) * w; }
                *(u32x4*)(HID + (size_t)r * 512 + col0) = pack8(h0, h1); }
    }
};

struct MoeOrder1G {
    const bf16_t* X2b; const bf16_t* Wg; const bf16_t* Wu; const PG8_LAS int* meta; const PG8_LAS int* tokl; unsigned zoff; int G, c;
    __device__ __forceinline__ int nt(const Unit&) const { return D / BK; }
    __device__ __forceinline__ bool next(int i, Unit& u) const { int L = i * G + c; const int nwg = __builtin_amdgcn_readfirstlane(meta[64 + 24]) * 4; if (L >= nwg) return false;
        { const int q = nwg / NXCD, r = nwg % NXCD, xcd = L % NXCD, off = L / NXCD; L = (xcd < r ? xcd * (q + 1) : r * (q + 1) + (xcd - r) * q) + off; }
        u.pm = L >> 2; u.pn = (moe_class_of_tile(meta, L >> 2) * 4 + (L & 3)) | (i << 16); return true; }
    __device__ __forceinline__ unsigned aoff(int ui, int row) const { const int tok = tokl[ui * BM + row]; return tok >= 0 ? (unsigned)tok * (unsigned)(D * 2) : zoff; }
    __device__ __forceinline__ void ptrs(const Unit& u, const char*& a, const char*& b0, const char*& b1) const {
        const int pn = u.pn & 0xffff, cls = pn >> 2, j = (pn >> 1) & 1, half = pn & 1; int ea, eb; pair_ab(cls % 6, ea, eb); const int e = (cls / 6) * 4 + (j ? eb : ea);
        a = (const char*)X2b; const size_t bo = ((size_t)e * DE + half * HALF) * D * 2; b0 = (const char*)Wg + bo; b1 = (const char*)Wu + bo; }
};
struct EpiMoeUpG {
    static constexpr bool PERM = true, HAS_MID = false; int mid_t;
    const PG8_LAS int* tokl; const float* rstok; const float* selw; bf16_t* HID;
    __device__ __forceinline__ void mid(f32x4 (&)[2][2][4][2], const Unit&, int, int, int, int) const {}
    __device__ __forceinline__ void operator()(const f32x4 (&acc)[2][2][4][2], const Unit& u, int wr, int wc, int fr, int fq) const {
        const int pn = u.pn & 0xffff, ui = u.pn >> 16, j = (pn >> 1) & 1, col0 = j * 256 + (pn & 1) * HALF + wc * 32 + 8 * fq, rl0 = wr * 64 + fr;
#pragma unroll
        for (int ai = 0; ai < 2; ++ai)
#pragma unroll
            for (int m = 0; m < 4; ++m) { const int rl = rl0 + ai * HALF + m * 16, tok = tokl[ui * BM + rl]; float rs = 0.f, w = 0.f; if (tok >= 0) { rs = rstok[tok]; w = selw[(size_t)tok * 2 + j]; } f32x4 h0, h1;
#pragma unroll
                for (int e = 0; e < 4; ++e) { const float g0 = acc[ai][0][m][0][e] * rs, g1 = acc[ai][0][m][1][e] * rs;
                    h0[e] = g0 * __builtin_amdgcn_rcpf(1.f + __expf(-g0)) * (acc[ai][1][m][0][e] * rs) * w; h1[e] = g1 * __builtin_amdgcn_rcpf(1.f + __expf(-g1)) * (acc[ai][1][m][1][e] * rs) * w; }
                *(u32x4*)(HID + (size_t)(u.pm * BM + rl) * 512 + col0) = pack8(h0, h1); }
    }
};
struct EpiMoeDown {
    static constexpr bool PERM = true, HAS_MID = false; int mid_t;
    const int* tokg; const bf16_t* Xi; bf16_t* Xo; float* ssq;
    __device__ __forceinline__ void mid(f32x4 (&)[2][2][4][2], const Unit&, int, int, int, int) const {}
    __device__ __forceinline__ void operator()(const f32x4 (&acc)[2][2][4][2], const Unit& u, int wr, int wc, int fr, int fq) const {
        const int row0 = u.pm * BM + wr * 64 + fr, ct = u.pn & 3, col0 = ct * BM + wc * 32 + 8 * fq;
#pragma unroll
        for (int ai = 0; ai < 2; ++ai)
#pragma unroll
            for (int m = 0; m < 4; ++m) { const int tok = tokg[row0 + ai * HALF + m * 16];
                if (tok >= 0) { float ss = 0.f;
#pragma unroll
                    for (int bj = 0; bj < 2; ++bj) { const u32x4 xi = *(const u32x4*)(Xi + (size_t)tok * D + col0 + bj * HALF);
                        f32x4 v0, v1; v0[0] = __uint_as_float(xi.x << 16); v0[1] = __uint_as_float(xi.x & 0xffff0000u); v0[2] = __uint_as_float(xi.y << 16); v0[3] = __uint_as_float(xi.y & 0xffff0000u);
                        v1[0] = __uint_as_float(xi.z << 16); v1[1] = __uint_as_float(xi.z & 0xffff0000u); v1[2] = __uint_as_float(xi.w << 16); v1[3] = __uint_as_float(xi.w & 0xffff0000u);
                        v0 = v0 + acc[ai][bj][m][0]; v1 = v1 + acc[ai][bj][m][1];
                        ss += sq8(v0, v1); *(u32x4*)(Xo + (size_t)tok * D + col0 + bj * HALF) = pack8(v0, v1); }
                    ss += __shfl_xor(ss, 16); ss += __shfl_xor(ss, 32);
                    if (fq == 0) ssq[(size_t)tok * 16 + ct * 4 + wc] = ss; } }
    }
};

struct XaChainOrder {
    const bf16_t* X1b; const bf16_t* Wq_t; const bf16_t* QX; const bf16_t* KM; const bf16_t* VT; int G, c, nu;
    __device__ __forceinline__ void init(int G_, int c_) { G = G_; c = c_; const int tot = (NTOK / BM) * XH; nu = (tot - c + G - 1) / G; }
    __device__ __forceinline__ bool next(int i, Unit& u) const { if (i >= 3 * nu) return false; const int kind = i / nu, L = (i % nu) * G + c; u.pm = L >> 2; u.pn = (L & 3) | (kind << 8); return true; }
    __device__ __forceinline__ int nt(const Unit& u) const { return (u.pn >> 8) == 0 ? D / BK : XD / BK; }
    __device__ __forceinline__ void ptrs(const Unit& u, const char*& a, const char*& b0, const char*& b1) const {
        const int kind = u.pn >> 8, h = u.pn & 3, b = u.pm / (SEQ / BM);
        if (kind == 0) { a = (const char*)X1b + (size_t)u.pm * BM * D * 2; b0 = (const char*)Wq_t + (size_t)h * XD * D * 2; }
        else { a = (const char*)QX + ((size_t)u.pm * BM * D + h * XD) * 2;
            b0 = (kind == 1) ? (const char*)KM + ((size_t)b * MEM * D + h * XD) * 2 : (const char*)VT + ((size_t)b * D + h * XD) * D * 2; }
        b1 = b0 + (size_t)HALF * D * 2; }
};
struct EpiXaChain {
    static constexpr bool PERM = true, HAS_MID = false; int mid_t;
    bf16_t* QX; bf16_t* OX; const float* ssq1; float qscale; PG8_LAS float* xch;
    __device__ __forceinline__ void mid(f32x4 (&)[2][2][4][2], const Unit&, int, int, int, int) const {}
    __device__ __forceinline__ void operator()(f32x4 (&acc)[2][2][4][2], const Unit& u, int wr, int wc, int fr, int fq) const {
        const int kind = u.pn >> 8, row0 = u.pm * BM + wr * 64 + fr, col0 = (u.pn & 3) * XD + wc * 32 + 8 * fq;
        if (kind != 1) {
            bf16_t* O = kind == 0 ? QX : OX;
#pragma unroll
            for (int ai = 0; ai < 2; ++ai)
#pragma unroll
                for (int m = 0; m < 4; ++m) { const int r = row0 + ai * HALF + m * 16; const float rs = kind == 0 ? rstd16(ssq1 + (size_t)r * 16) * qscale : 1.f; bf16_t* rowp = O + (size_t)r * D + col0;
#pragma unroll
                    for (int bj = 0; bj < 2; ++bj) *(u32x4*)(rowp + bj * HALF) = pack8(acc[ai][bj][m][0] * rs, acc[ai][bj][m][1] * rs); }
            return;
        }
        PG8_LAS float* xm = xch; PG8_LAS float* xs = xch + 1024;
#pragma unroll
        for (int ai = 0; ai < 2; ++ai)
#pragma unroll
            for (int m = 0; m < 4; ++m) { float mx = -INFINITY;
#pragma unroll
                for (int bj = 0; bj < 2; ++bj)
#pragma unroll
                    for (int n = 0; n < 2; ++n) { const f32x4 v = acc[ai][bj][m][n]; mx = fmaxf(mx, fmaxf(fmaxf(v[0], v[1]), fmaxf(v[2], v[3]))); }
                mx = fmaxf(mx, __shfl_xor(mx, 16)); mx = fmaxf(mx, __shfl_xor(mx, 32));
                if (fq == 0) xm[(ai * HALF + wr * 64 + m * 16 + fr) * 4 + wc] = mx; asm volatile("" ::: "memory"); }
        asm volatile("s_waitcnt lgkmcnt(0)" ::: "memory"); __builtin_amdgcn_s_barrier(); asm volatile("" ::: "memory");
#pragma unroll
        for (int ai = 0; ai < 2; ++ai)
#pragma unroll
            for (int m = 0; m < 4; ++m) { const int rl = ai * HALF + wr * 64 + m * 16 + fr; const f32x4 q = *(const PG8_LAS f32x4*)(xm + rl * 4);
                const float mx = fmaxf(fmaxf(q[0], q[1]), fmaxf(q[2], q[3])); float ss = 0.f;
#pragma unroll
                for (int bj = 0; bj < 2; ++bj)
#pragma unroll
                    for (int n = 0; n < 2; ++n) { f32x4 v = acc[ai][bj][m][n];
#pragma unroll
                        for (int e = 0; e < 4; ++e) { v[e] = __builtin_amdgcn_exp2f(v[e] - mx); ss += v[e]; }
                        acc[ai][bj][m][n] = v; }
                ss += __shfl_xor(ss, 16); ss += __shfl_xor(ss, 32);
                if (fq == 0) xs[rl * 4 + wc] = ss; asm volatile("" ::: "memory"); }
        asm volatile("s_waitcnt lgkmcnt(0)" ::: "memory"); __builtin_amdgcn_s_barrier(); asm volatile("" ::: "memory");
#pragma unroll
        for (int ai = 0; ai < 2; ++ai)
#pragma unroll
            for (int m = 0; m < 4; ++m) { const int rl = ai * HALF + wr * 64 + m * 16 + fr; const f32x4 q = *(const PG8_LAS f32x4*)(xs + rl * 4);
                const float inv = __builtin_amdgcn_rcpf((q[0] + q[1]) + (q[2] + q[3])); bf16_t* rowp = QX + (size_t)(row0 + ai * HALF + m * 16) * D + col0;
#pragma unroll
                for (int bj = 0; bj < 2; ++bj) *(u32x4*)(rowp + bj * HALF) = pack8(acc[ai][bj][m][0] * inv, acc[ai][bj][m][1] * inv); asm volatile("" ::: "memory"); }
    }
};

struct XaPreOrder {
    const bf16_t* KM; const bf16_t* VM; const bf16_t* WqN; const bf16_t* Wo_t; int G, c;
    __device__ __forceinline__ bool next(int i, Unit& u) const { const int L = i * G + c; if (L >= 256) return false; u.pm = 0; u.pn = L; return true; }
    __device__ __forceinline__ int nt(const Unit&) const { return XD / BK; }
    __device__ __forceinline__ void ptrs(const Unit& u, const char*& a, const char*& b0, const char*& b1) const {
        const int L = u.pn, h = L & 3;
        if (L < 128) { const int b = L >> 4, kt = (L >> 2) & 3; a = (const char*)KM + ((size_t)b * MEM * D + h * XD) * 2; b0 = (const char*)WqN + ((size_t)kt * BM * D + h * XD) * 2; }
        else { const int nt_ = (L >> 5) & 3, b = (L >> 2) & 7; a = (const char*)Wo_t + ((size_t)nt_ * BM * D + h * XD) * 2; b0 = (const char*)VM + ((size_t)b * MEM * D + h * XD) * 2; }
        b1 = b0 + (size_t)HALF * D * 2; }
};
struct EpiXaPre {
    static constexpr bool PERM = true, HAS_MID = false; int mid_t;
    bf16_t* MT; bf16_t* NT;
    __device__ __forceinline__ void mid(f32x4 (&)[2][2][4][2], const Unit&, int, int, int, int) const {}
    __device__ __forceinline__ void operator()(const f32x4 (&acc)[2][2][4][2], const Unit& u, int wr, int wc, int fr, int fq) const {
        const int L = u.pn, h = L & 3, cw = wc * 32 + 8 * fq; bf16_t* base;
        if (L < 128) { const int b = L >> 4, kt = (L >> 2) & 3; base = MT + ((size_t)b * D + h * XD) * D + kt * BM; }
        else { const int nt_ = (L >> 5) & 3, b = (L >> 2) & 7; base = NT + ((size_t)b * D + nt_ * BM) * D + h * XD; }
#pragma unroll
        for (int ai = 0; ai < 2; ++ai)
#pragma unroll
            for (int m = 0; m < 4; ++m) { bf16_t* rowp = base + (size_t)(ai * HALF + wr * 64 + m * 16 + fr) * D + cw;
#pragma unroll
                for (int bj = 0; bj < 2; ++bj) *(u32x4*)(rowp + bj * HALF) = pack8(acc[ai][bj][m][0], acc[ai][bj][m][1]); }
    }
};
struct BatchedOrder {
    const bf16_t* A; const bf16_t* W; int G, c;
    __device__ __forceinline__ bool next(int i, Unit& u) const { int L = i * G + c; if (L >= (NTOK / BM) * 4) return false;
        L = (L % NXCD) * ((NTOK / BM) * 4 / NXCD) + L / NXCD;
        u.pm = L >> 2; u.pn = L & 3; return true; }
    __device__ __forceinline__ int nt(const Unit&) const { return D / BK; }
    __device__ __forceinline__ void ptrs(const Unit& u, const char*& a, const char*& b0, const char*& b1) const {
        const int b = u.pm / (SEQ / BM); a = (const char*)A + (size_t)u.pm * BM * D * 2; b0 = (const char*)W + ((size_t)b * D + u.pn * BM) * D * 2; b1 = b0 + (size_t)HALF * D * 2; }
};
struct EpiXaSoftmax {
    static constexpr bool PERM = true, HAS_MID = false; int mid_t;
    bf16_t* P; const float* ssq1; float qscale; PG8_LAS float* xch;
    __device__ __forceinline__ void mid(f32x4 (&)[2][2][4][2], const Unit&, int, int, int, int) const {}
    __device__ __forceinline__ void operator()(f32x4 (&acc)[2][2][4][2], const Unit& u, int wr, int wc, int fr, int fq) const {
        const int row0 = u.pm * BM + wr * 64 + fr, col0 = u.pn * XD + wc * 32 + 8 * fq;
        PG8_LAS float* xm = xch; PG8_LAS float* xs = xch + 1024;
#pragma unroll
        for (int ai = 0; ai < 2; ++ai)
#pragma unroll
            for (int m = 0; m < 4; ++m) { const float rs = rstd16(ssq1 + (size_t)(row0 + ai * HALF + m * 16) * 16) * qscale; float mx = -INFINITY;
#pragma unroll
                for (int bj = 0; bj < 2; ++bj)
#pragma unroll
                    for (int n = 0; n < 2; ++n) { const f32x4 v = acc[ai][bj][m][n] * rs; acc[ai][bj][m][n] = v; mx = fmaxf(mx, fmaxf(fmaxf(v[0], v[1]), fmaxf(v[2], v[3]))); }
                mx = fmaxf(mx, __shfl_xor(mx, 16)); mx = fmaxf(mx, __shfl_xor(mx, 32));
                if (fq == 0) xm[(ai * HALF + wr * 64 + m * 16 + fr) * 4 + wc] = mx; asm volatile("" ::: "memory"); }
        asm volatile("s_waitcnt lgkmcnt(0)" ::: "memory"); __builtin_amdgcn_s_barrier(); asm volatile("" ::: "memory");
#pragma unroll
        for (int ai = 0; ai < 2; ++ai)
#pragma unroll
            for (int m = 0; m < 4; ++m) { const int rl = ai * HALF + wr * 64 + m * 16 + fr; const f32x4 q = *(const PG8_LAS f32x4*)(xm + rl * 4);
                const float mx = fmaxf(fmaxf(q[0], q[1]), fmaxf(q[2], q[3])); float ss = 0.f;
#pragma unroll
                for (int bj = 0; bj < 2; ++bj)
#pragma unroll
                    for (int n = 0; n < 2; ++n) { f32x4 v = acc[ai][bj][m][n];
#pragma unroll
                        for (int e = 0; e < 4; ++e) { v[e] = __builtin_amdgcn_exp2f(v[e] - mx); ss += v[e]; }
                        acc[ai][bj][m][n] = v; }
                ss += __shfl_xor(ss, 16); ss += __shfl_xor(ss, 32);
                if (fq == 0) xs[rl * 4 + wc] = ss; asm volatile("" ::: "memory"); }
        asm volatile("s_waitcnt lgkmcnt(0)" ::: "memory"); __builtin_amdgcn_s_barrier(); asm volatile("" ::: "memory");
#pragma unroll
        for (int ai = 0; ai < 2; ++ai)
#pragma unroll
            for (int m = 0; m < 4; ++m) { const int rl = ai * HALF + wr * 64 + m * 16 + fr; const f32x4 q = *(const PG8_LAS f32x4*)(xs + rl * 4);
                const float inv = __builtin_amdgcn_rcpf((q[0] + q[1]) + (q[2] + q[3])); bf16_t* rowp = P + (size_t)(row0 + ai * HALF + m * 16) * D + col0;
#pragma unroll
                for (int bj = 0; bj < 2; ++bj) *(u32x4*)(rowp + bj * HALF) = pack8(acc[ai][bj][m][0] * inv, acc[ai][bj][m][1] * inv); asm volatile("" ::: "memory"); }
    }
};


struct OneUnitOrder {
    const bf16_t* A; const bf16_t* Bt; int lda, ldb, pm, pn, ntk;
    static constexpr bool GATHER = false;
    __device__ __forceinline__ bool next(int i, Unit& u) const { if (i > 0) return false; u.pm = pm; u.pn = pn; return true; }
    __device__ __forceinline__ int nt(const Unit&) const { return ntk; }
    __device__ __forceinline__ void ptrs(const Unit& u, const char*& a, const char*& b0, const char*& b1) const {
        a = (const char*)A + (size_t)u.pm * BM * lda * 2; b0 = (const char*)Bt + (size_t)u.pn * BM * ldb * 2; b1 = b0 + (size_t)HALF * ldb * 2; }
};
struct EpiKvN {
    static constexpr bool PERM = true, HAS_MID = false; int mid_t;
    bf16_t* KM; bf16_t* VM;
    __device__ __forceinline__ void mid(f32x4 (&)[2][2][4][2], const Unit&, int, int, int, int) const {}
    __device__ __forceinline__ void operator()(const f32x4 (&acc)[2][2][4][2], const Unit& u, int wr, int wc, int fr, int fq) const {
        bf16_t* base = (u.pn < 4 ? KM : VM) + (u.pn & 3) * BM + wc * 32 + 8 * fq; const int row0 = u.pm * BM + wr * 64 + fr;
#pragma unroll
        for (int ai = 0; ai < 2; ++ai)
#pragma unroll
            for (int m = 0; m < 4; ++m) { bf16_t* rowp = base + (size_t)(row0 + ai * HALF + m * 16) * D;
#pragma unroll
                for (int bj = 0; bj < 2; ++bj) *(u32x4*)(rowp + bj * HALF) = pack8(acc[ai][bj][m][0], acc[ai][bj][m][1]); }
    }
};
struct KvOrder {
    __device__ __forceinline__ int nt(const Unit&) const { return D / BK; }
    const bf16_t* memn; const bf16_t* Wk_t; const bf16_t* Wv_t; int G, c;
    __device__ __forceinline__ bool next(int i, Unit& u) const { const int L = i * G + c; if (L >= 64) return false; if (L < 32) { u.pm = L >> 2; u.pn = L & 3; } else { u.pm = (L - 32) >> 3; u.pn = ((L - 32) & 7) | 256; } return true; }
    __device__ __forceinline__ void ptrs(const Unit& u, const char*& a, const char*& b0, const char*& b1) const {
        const bool vt = (u.pn & 256) != 0; const int pn = u.pn & 255;
        a = (const char*)(vt ? Wv_t : memn) + (size_t)u.pm * BM * D * 2; b0 = (const char*)(vt ? memn : Wk_t) + (size_t)pn * BM * D * 2; b1 = b0 + (size_t)HALF * D * 2; }
};
struct EpiKv {
    static constexpr bool PERM = true, HAS_MID = false; int mid_t;
    bf16_t* KM; bf16_t* VT;
    __device__ __forceinline__ void mid(f32x4 (&)[2][2][4][2], const Unit&, int, int, int, int) const {}
    __device__ __forceinline__ void operator()(const f32x4 (&acc)[2][2][4][2], const Unit& u, int wr, int wc, int fr, int fq) const {
        const bool vt = (u.pn & 256) != 0; const int pn = u.pn & 255, row0 = u.pm * BM + wr * 64 + fr, cw = wc * 32 + 8 * fq;
        bf16_t* base = vt ? VT + (size_t)pn * D * D : KM + pn * BM; const int ldo = D;
#pragma unroll
        for (int ai = 0; ai < 2; ++ai)
#pragma unroll
            for (int m = 0; m < 4; ++m) { bf16_t* rowp = base + (size_t)(row0 + ai * HALF + m * 16) * ldo + cw;
#pragma unroll
                for (int bj = 0; bj < 2; ++bj) *(u32x4*)(rowp + bj * HALF) = pack8(acc[ai][bj][m][0], acc[ai][bj][m][1]); }
    }
};

struct EpiMoeFinal {
    static constexpr bool PERM = true, HAS_MID = false; int mid_t;
    const int* tokg; const bf16_t* Xi; float* out; float* ssq; unsigned* cnt; const float* g; PG8_LAS unsigned* flag; unsigned* tmo;
    __device__ __forceinline__ void mid(f32x4 (&)[2][2][4][2], const Unit&, int, int, int, int) const {}
    __device__ __forceinline__ void operator()(f32x4 (&acc)[2][2][4][2], const Unit& u, int wr, int wc, int fr, int fq) const {
        const int row0 = u.pm * BM + wr * 64 + fr, ct = u.pn & 3, col0 = ct * BM + wc * 32 + 8 * fq;
#pragma unroll
        for (int ai = 0; ai < 2; ++ai)
#pragma unroll
            for (int m = 0; m < 4; ++m) { const int tok = tokg[row0 + ai * HALF + m * 16];
                if (tok >= 0) { float ss = 0.f;
#pragma unroll
                    for (int bj = 0; bj < 2; ++bj) { const u32x4 xi = *(const u32x4*)(Xi + (size_t)tok * D + col0 + bj * HALF);
                        f32x4 v0, v1; v0[0] = __uint_as_float(xi.x << 16); v0[1] = __uint_as_float(xi.x & 0xffff0000u); v0[2] = __uint_as_float(xi.y << 16); v0[3] = __uint_as_float(xi.y & 0xffff0000u);
                        v1[0] = __uint_as_float(xi.z << 16); v1[1] = __uint_as_float(xi.z & 0xffff0000u); v1[2] = __uint_as_float(xi.w << 16); v1[3] = __uint_as_float(xi.w & 0xffff0000u);
                        v0 = v0 + acc[ai][bj][m][0]; v1 = v1 + acc[ai][bj][m][1]; acc[ai][bj][m][0] = v0; acc[ai][bj][m][1] = v1; ss += sq8(v0, v1); }
                    ss += __shfl_xor(ss, 16); ss += __shfl_xor(ss, 32);
                    if (fq == 0) __hip_atomic_store(ssq + (size_t)tok * 16 + ct * 4 + wc, ss, __ATOMIC_RELAXED, __HIP_MEMORY_SCOPE_AGENT); }
                asm volatile("" ::: "memory"); }
        asm volatile("s_waitcnt vmcnt(0) lgkmcnt(0)" ::: "memory"); __builtin_amdgcn_s_barrier(); asm volatile("" ::: "memory");
        const int tid = threadIdx.x;
        if (tid < 64) {
            if (tid == 0) __hip_atomic_fetch_add(cnt + 16 * u.pm, 1u, __ATOMIC_RELAXED, __HIP_MEMORY_SCOPE_AGENT);
            unsigned spins = 0; bool dead = false;
            while ((unsigned)__builtin_amdgcn_readfirstlane(__hip_atomic_load(cnt + 16 * u.pm, __ATOMIC_RELAXED, __HIP_MEMORY_SCOPE_AGENT)) < 4u) {
                __builtin_amdgcn_s_sleep(2); if (++spins > (1u << 20)) { dead = true; break; } }
            __builtin_amdgcn_fence(__ATOMIC_ACQUIRE, "agent");
            if (tid == 0) { flag[0] = dead ? 1u : 0u; if (dead) __hip_atomic_store(tmo, 1u, __ATOMIC_RELAXED, __HIP_MEMORY_SCOPE_AGENT); }
        }
        asm volatile("s_waitcnt vmcnt(0) lgkmcnt(0)" ::: "memory"); __builtin_amdgcn_s_barrier(); asm volatile("" ::: "memory");
        f32x4 gv[2][2];
#pragma unroll
        for (int bj = 0; bj < 2; ++bj) { gv[bj][0] = *(const f32x4*)(g + col0 + bj * HALF); gv[bj][1] = *(const f32x4*)(g + col0 + bj * HALF + 4); }
#pragma unroll
        for (int ai = 0; ai < 2; ++ai)
#pragma unroll
            for (int m = 0; m < 4; ++m) { const int tok = tokg[row0 + ai * HALF + m * 16];
                if (tok >= 0) { const float rs = rstd16(ssq + (size_t)tok * 16); float* orow = out + (size_t)tok * D + col0;
#pragma unroll
                    for (int bj = 0; bj < 2; ++bj) { *(f32x4*)(orow + bj * HALF) = acc[ai][bj][m][0] * rs * gv[bj][0]; *(f32x4*)(orow + bj * HALF + 4) = acc[ai][bj][m][1] * rs * gv[bj][1]; } }
                asm volatile("" ::: "memory"); }
    }
};
}
namespace sba {
typedef float f32x16 __attribute__((ext_vector_type(16)));
typedef short s16x4 __attribute__((ext_vector_type(4)));
typedef short v4i16_t __attribute__((ext_vector_type(4)));
typedef __attribute__((address_space(3))) const char* lds_cptr;
constexpr int SLOTB = 8192, L_K = 0, L_V = 2 * SLOTB, L_FLAG = 4 * SLOTB, L_OST = L_FLAG + 256, L_BYTES = L_OST + 8 * 4096;
__device__ __forceinline__ int crow(int r, int hi) { return (r & 3) + 8 * (r >> 2) + 4 * hi; }
__device__ __forceinline__ void glds16(const void* gsrc, unsigned lds_dst) { unsigned keep;
    asm volatile("s_mov_b32 %0, m0\n\ts_mov_b32 m0, %2\n\ts_nop 0\n\tglobal_load_lds_dwordx4 %1, off\n\ts_mov_b32 m0, %0" : "=&s"(keep) : "v"(gsrc), "s"(lds_dst) : "memory"); }
typedef float f32x2_t __attribute__((ext_vector_type(2))); typedef __bf16 bf16x2_t __attribute__((ext_vector_type(2)));
__device__ __forceinline__ unsigned cvtpk(float lo, float hi) { f32x2_t v = {lo, hi}; bf16x2_t b = __builtin_convertvector(v, bf16x2_t); return __builtin_bit_cast(unsigned, b); }
__device__ __forceinline__ s16x4 vtr(lds_cptr p) { return __builtin_bit_cast(s16x4, __builtin_amdgcn_ds_read_tr16_b64_v4i16((__attribute__((address_space(3))) v4i16_t*)p)); }

#define SBA_GROUP(Z, OM, g) do { \
        float d_ = acc_ * (hi ? 1.f : gp_##OM[g]); acc_ *= gs_##OM[g] * gp_##OM[g]; \
        Z[4 * (g) + 3] *= d_; d_ *= OM[4 * (g) + 3]; Z[4 * (g) + 2] *= d_; d_ *= OM[4 * (g) + 2]; Z[4 * (g) + 1] *= d_; d_ *= OM[4 * (g) + 1]; Z[4 * (g)] *= d_; } while (0)

__device__ __forceinline__ void sb_unit(int b, int h, int qb, const bf16_t* Qs, const bf16_t* Ks, const bf16_t* Vs, bf16_t* YY, float* ssq_s8, char* shm) {
    int tid_ = threadIdx.x; asm volatile("" : "+v"(tid_));
    const int tid = tid_, lane = tid & 63, r32 = lane & 31, hi = lane >> 5; const int wid = __builtin_amdgcn_readfirstlane(tid >> 6);
#define SSTAMP(k) do { if (PROBE_A >= 300 && PROBE_A < 400 && blockIdx.x == PROBE_BLK && b == 0 && tid == 0) ((__attribute__((address_space(3))) unsigned long long*)(shm + 147200))[16 + (k)] = __builtin_amdgcn_s_memrealtime(); } while (0)
    SSTAMP(0);
    const size_t rowbase = (size_t)b * SEQ; const int q0 = qb * 256;
    const bf16_t* Kh = Ks + rowbase * SBW + h * HD; const bf16_t* Vh = Vs + rowbase * SBW + h * HD;
    const unsigned lds0 = (unsigned)(uintptr_t)shm;
    const lds_cptr shm3 = (lds_cptr)shm;
    const bf16_t* ksrc = Kh + (size_t)lane * SBW + wid * 8;
    const bf16_t* vsrc = Vh + (size_t)(16 * (wid & 3) + (lane >> 2)) * SBW + (wid >> 2) * 32 + (lane & 3) * 8;
    const unsigned kdst = lds0 + L_K + wid * 1024, vdst = lds0 + L_V + wid * 1024;
#define DMA_KV(t, slot) do { glds16(ksrc + (size_t)(t) * 64 * SBW, (unsigned)__builtin_amdgcn_readfirstlane(kdst + (slot))); glds16(vsrc + (size_t)(t) * 64 * SBW, (unsigned)__builtin_amdgcn_readfirstlane(vdst + (slot))); } while (0)
    const lds_cptr kp0 = shm3 + L_K + hi * 1024 + r32 * 16;
    const lds_cptr vp0 = shm3 + L_V + ((lane >> 4) & 1) * 32 + (lane & 3) * 8 + (4 * hi + ((lane & 15) >> 2)) * 64;
    volatile __attribute__((address_space(3))) unsigned* flags = (volatile __attribute__((address_space(3))) unsigned*)(shm3 + L_FLAG);
    int tile = 4 * qb + 3, slot = 0, it = 0;
    DMA_KV(tile, 0);
    const bf16_t* Qw = Qs + (rowbase + q0 + wid * 32 + r32) * SBW + h * HD;
    bf16x8 qr[4];
#pragma unroll
    for (int d0 = 0; d0 < 4; ++d0) qr[d0] = *(const bf16x8*)(Qw + d0 * 16 + hi * 8);
    float qn = 0.f;
#pragma unroll
    for (int d0 = 0; d0 < 4; ++d0)
#pragma unroll
        for (int e = 0; e < 8; ++e) qn += fabsf(bf2f((unsigned short)qr[d0][e]));
    qn += __shfl_xor(qn, 32);
    const int tq = q0 + wid * 32 + r32;
    const int tq_min = q0 + wid * 32, tq_max = tq_min + 31;
    float PR = 1.f;
    f32x16 o0 = {}, o1 = {};
    for (;;) {
        if (it < 4) SSTAMP(1 + it);
        const bool has_next = tile > 0;
        if (has_next) { DMA_KV(tile - 1, slot ^ SLOTB); asm volatile("s_waitcnt vmcnt(2)" ::: "memory"); }
        else asm volatile("s_waitcnt vmcnt(0)" ::: "memory");
        __builtin_amdgcn_s_barrier(); asm volatile("" ::: "memory");
        const int kmin = tile * 64;
        if (kmin < tq_max) {
            f32x16 z0, z1;
            {
                const lds_cptr kb = kp0 + slot; bf16x8 kf[8];
#pragma unroll
                for (int d0 = 0; d0 < 4; ++d0) { kf[2 * d0] = *(const __attribute__((address_space(3))) bf16x8*)(kb + d0 * 2048); kf[2 * d0 + 1] = *(const __attribute__((address_space(3))) bf16x8*)(kb + d0 * 2048 + 512); }
                __builtin_amdgcn_sched_barrier(0);
                z0 = __builtin_amdgcn_mfma_f32_32x32x16_bf16(kf[0], qr[0], (f32x16){}, 0, 0, 0); z1 = __builtin_amdgcn_mfma_f32_32x32x16_bf16(kf[1], qr[0], (f32x16){}, 0, 0, 0);
#pragma unroll
                for (int d0 = 1; d0 < 4; ++d0) { z0 = __builtin_amdgcn_mfma_f32_32x32x16_bf16(kf[2 * d0], qr[d0], z0, 0, 0, 0); z1 = __builtin_amdgcn_mfma_f32_32x32x16_bf16(kf[2 * d0 + 1], qr[d0], z1, 0, 0, 0); }
            }
            if (kmin + 63 >= tq_min) {
#pragma unroll
                for (int r = 0; r < 16; ++r) { const int kv = kmin + crow(r, hi); if (kv >= tq) z0[r] = -INFINITY; if (kv + 32 >= tq) z1[r] = -INFINITY; }
            }
            f32x16 m0, m1;
#pragma unroll
            for (int r = 0; r < 16; ++r) { const float e0 = __builtin_amdgcn_exp2f(fminf(z0[r], 120.f)), e1 = __builtin_amdgcn_exp2f(fminf(z1[r], 120.f));
                m0[r] = __builtin_amdgcn_rcpf(1.f + e0); m1[r] = __builtin_amdgcn_rcpf(1.f + e1); z0[r] = e0 * m0[r]; z1[r] = e1 * m1[r]; }
            float gs_m0[4], gs_m1[4], gp_m0[4], gp_m1[4];
#pragma unroll
            for (int g = 0; g < 4; ++g) { gs_m0[g] = (m0[4 * g] * m0[4 * g + 1]) * (m0[4 * g + 2] * m0[4 * g + 3]); gs_m1[g] = (m1[4 * g] * m1[4 * g + 1]) * (m1[4 * g + 2] * m1[4 * g + 3]); }
#pragma unroll
            for (int g = 0; g < 4; ++g) { const auto r0 = __builtin_amdgcn_permlane32_swap(__float_as_uint(gs_m0[g]), __float_as_uint(gs_m0[g]), false, false), r1 = __builtin_amdgcn_permlane32_swap(__float_as_uint(gs_m1[g]), __float_as_uint(gs_m1[g]), false, false);
                gp_m0[g] = __uint_as_float(hi ? r0[0] : r0[1]); gp_m1[g] = __uint_as_float(hi ? r1[0] : r1[1]); }
            float acc_ = PR;
            SBA_GROUP(z1, m1, 3); SBA_GROUP(z1, m1, 2); SBA_GROUP(z1, m1, 1); SBA_GROUP(z1, m1, 0);
            SBA_GROUP(z0, m0, 3); SBA_GROUP(z0, m0, 2); SBA_GROUP(z0, m0, 1); SBA_GROUP(z0, m0, 0);
            PR = acc_;
            u32x4 pw0, pw1, pw2, pw3;
            pw0 = (u32x4){cvtpk(z0[0], z0[1]), cvtpk(z0[2], z0[3]), cvtpk(z0[4], z0[5]), cvtpk(z0[6], z0[7])};
            pw1 = (u32x4){cvtpk(z0[8], z0[9]), cvtpk(z0[10], z0[11]), cvtpk(z0[12], z0[13]), cvtpk(z0[14], z0[15])};
            pw2 = (u32x4){cvtpk(z1[0], z1[1]), cvtpk(z1[2], z1[3]), cvtpk(z1[4], z1[5]), cvtpk(z1[6], z1[7])};
            pw3 = (u32x4){cvtpk(z1[8], z1[9]), cvtpk(z1[10], z1[11]), cvtpk(z1[12], z1[13]), cvtpk(z1[14], z1[15])};
            const lds_cptr vp = vp0 + slot;
#define SBA_VF(i) (bf16x8){vl[i][0], vl[i][1], vl[i][2], vl[i][3], vh[i][0], vh[i][1], vh[i][2], vh[i][3]}
            { s16x4 vl[4], vh[4];
#pragma unroll
                for (int i = 0; i < 4; ++i) { vl[i] = vtr(vp + i * 1024); vh[i] = vtr(vp + i * 1024 + 512); }
                __builtin_amdgcn_sched_barrier(0);
                o0 = __builtin_amdgcn_mfma_f32_32x32x16_bf16(__builtin_bit_cast(bf16x8, pw0), SBA_VF(0), o0, 0, 0, 0); o0 = __builtin_amdgcn_mfma_f32_32x32x16_bf16(__builtin_bit_cast(bf16x8, pw1), SBA_VF(1), o0, 0, 0, 0);
                o0 = __builtin_amdgcn_mfma_f32_32x32x16_bf16(__builtin_bit_cast(bf16x8, pw2), SBA_VF(2), o0, 0, 0, 0); o0 = __builtin_amdgcn_mfma_f32_32x32x16_bf16(__builtin_bit_cast(bf16x8, pw3), SBA_VF(3), o0, 0, 0, 0); }
            { s16x4 vl[4], vh[4];
#pragma unroll
                for (int i = 0; i < 4; ++i) { vl[i] = vtr(vp + 4096 + i * 1024); vh[i] = vtr(vp + 4096 + i * 1024 + 512); }
                __builtin_amdgcn_sched_barrier(0);
                o1 = __builtin_amdgcn_mfma_f32_32x32x16_bf16(__builtin_bit_cast(bf16x8, pw0), SBA_VF(0), o1, 0, 0, 0); o1 = __builtin_amdgcn_mfma_f32_32x32x16_bf16(__builtin_bit_cast(bf16x8, pw1), SBA_VF(1), o1, 0, 0, 0);
                o1 = __builtin_amdgcn_mfma_f32_32x32x16_bf16(__builtin_bit_cast(bf16x8, pw2), SBA_VF(2), o1, 0, 0, 0); o1 = __builtin_amdgcn_mfma_f32_32x32x16_bf16(__builtin_bit_cast(bf16x8, pw3), SBA_VF(3), o1, 0, 0, 0); }
#undef SBA_VF
        }
        const bool done = __all(PR == 0.f);
        if (lane == 0) flags[(it & 1) * 8 + wid] = done ? 1u : 0u;
        asm volatile("s_waitcnt lgkmcnt(0)" ::: "memory"); __builtin_amdgcn_s_barrier(); asm volatile("" ::: "memory");
        unsigned alld = 1u;
#pragma unroll
        for (int w = 0; w < 8; ++w) alld &= flags[(it & 1) * 8 + w];
        alld = __builtin_amdgcn_readfirstlane(alld);
        if (!has_next || alld) break;
        --tile; slot ^= SLOTB; ++it;
    }
    SSTAMP(5);
    if (PROBE_A >= 300 && PROBE_A < 400 && blockIdx.x == PROBE_BLK && b == 0 && tid == 0) { __attribute__((address_space(3))) unsigned long long* st_ = (__attribute__((address_space(3))) unsigned long long*)(shm + 147200) + 16; st_[8] = 0; st_[9] = (unsigned long long)(it + 1) * 100ull; }
    asm volatile("s_waitcnt vmcnt(0)" ::: "memory");
    {
        bf16_t* Ow = YY + (rowbase + q0 + wid * 32) * D + RW + h * HD;
        bf16_t* stg = (bf16_t*)(shm + L_OST) + wid * 2048;
#pragma unroll
        for (int r = 0; r < 16; ++r) { const int orow = crow(r, hi); stg[orow * 64 + r32] = (bf16_t)f2bf(o0[r]); stg[orow * 64 + 32 + r32] = (bf16_t)f2bf(o1[r]); }
        asm volatile("s_waitcnt lgkmcnt(0)" ::: "memory");
#pragma unroll
        for (int i = 0; i < 4; ++i) { const int row = i * 8 + (lane >> 3), ch = lane & 7; const u32x4 v = *(const u32x4*)(stg + row * 64 + ch * 8);
            *(u32x4*)(Ow + (size_t)row * D + ch * 8) = v;
            float ss = 0.f;
#pragma unroll
            for (int e = 0; e < 4; ++e) { const float lo = __uint_as_float(v[e] << 16), hh = __uint_as_float(v[e] & 0xffff0000u); ss += lo * lo + hh * hh; }
            ss += __shfl_xor(ss, 1); ss += __shfl_xor(ss, 2); ss += __shfl_xor(ss, 4);
            if (ch == 0) ssq_s8[(rowbase + q0 + wid * 32 + row) * 8 + h] = ss; }
    }
    asm volatile("s_waitcnt lgkmcnt(0)" ::: "memory"); __builtin_amdgcn_s_barrier(); asm volatile("" ::: "memory");
    SSTAMP(6);
#undef SSTAMP
#undef DMA_KV
}
#undef SBA_GROUP
}
namespace lru {
typedef float f32x16 __attribute__((ext_vector_type(16)));
constexpr int XS_ROWS = 67, XS_BYTES = XS_ROWS * 1024  , XC_PITCH = 1040  , XC_OFF = 68608, HC_OFF = XC_OFF + 64 * XC_PITCH  , L_BYTES = HC_OFF + 2048;
__device__ __forceinline__ int crow(int r, int hi) { return (r & 3) + 8 * (r >> 2) + 4 * hi; }

struct Weights { bf16x8 wa[2][4], wx[2][4]; float ba[2], bx[2], spl[2]; };
__device__ __forceinline__ void load_weights(Weights& W, int h, int r32, int hi, const float* w_a, const float* b_a, const float* w_x, const float* b_x, const float* lam) {
#pragma unroll
    for (int nt = 0; nt < 2; ++nt) {
#pragma unroll
        for (int s = 0; s < 4; ++s) {
#pragma unroll
            for (int e = 0; e < 8; ++e) { const size_t idx = ((size_t)(h * 64 + 16 * s + 8 * hi + e)) * 64 + 32 * nt + r32;
                W.wa[nt][s][e] = (short)f2bf(w_a[idx]); W.wx[nt][s][e] = (short)f2bf(w_x[idx]); }
            asm volatile("" ::: "memory");
        }
        const int c = h * 64 + 32 * nt + r32; W.ba[nt] = b_a[c]; W.bx[nt] = b_x[c];
        const float l = lam[c]; W.spl[nt] = (l > 15.f) ? __expf(-l) : log1pf(__expf(-l));
    }
}

template <bool PASSB>
__device__ __forceinline__ void pair_unit(int b, int pj, const Weights& W, const bf16_t* XR, const bf16_t* GG, const float* conv_w, const float* conv_b,
                                     float* aggP, float* aggH, const float* ssq_s8, bf16_t* YY, float* fmid, float* fend, unsigned char* shm) {
    int tid_ = threadIdx.x; asm volatile("" : "+v"(tid_));
    const int tid = tid_, lane = tid & 63, r32 = lane & 31, hi = lane >> 5, wid = __builtin_amdgcn_readfirstlane(tid >> 6);
    LAS unsigned char* L = (LAS unsigned char*)shm;
#define LSTAMP(k) do { if (PROBE_A >= 200 && PROBE_A < 300 && PASSB && blockIdx.x == 63 && b == 0 && tid == 0) ((LAS unsigned long long*)(shm + 147200))[16 + (k)] = __builtin_amdgcn_s_memrealtime(); } while (0)
    LSTAMP(0);
    const size_t rowbase = (size_t)b * SEQ; const int h = wid;
    float Hc[2] = {0.f, 0.f}, Pc[2] = {1.f, 1.f};
#pragma unroll
    for (int half = 0; half < 2; ++half) {
    const int t0 = (2 * pj + half) * 64;
    f32x4 cp_[PASSB ? 8 : 1], cq_[PASSB ? 8 : 1];
    if (PASSB && half == 0) {
        const f32x4* pP = (const f32x4*)(aggP + ((size_t)b * RW + tid) * 32); const f32x4* pH = (const f32x4*)(aggH + ((size_t)b * RW + tid) * 32);
#pragma unroll
        for (int i = 0; i < 8; ++i) { cp_[i] = pP[i]; cq_[i] = pH[i]; }
    }
    {
        u32x4 v[9];
#pragma unroll
        for (int k = 0; k < 9; ++k) { const int p = tid + k * NTHREADS, rr = p >> 6, pc = p & 63, t = t0 - 3 + rr;
            v[k] = (u32x4){0u, 0u, 0u, 0u}; if (p < XS_ROWS * 64 && t >= 0) v[k] = *(const u32x4*)(XR + (rowbase + t) * RW + pc * 8); }
#pragma unroll
        for (int k = 0; k < 9; ++k) { const int p = tid + k * NTHREADS; if (p < XS_ROWS * 64) *(LAS u32x4*)(L + (p >> 6) * 1024 + (p & 63) * 16) = v[k]; }
    }
    if (PASSB && half == 0) {
        float hc = 0.f;
#pragma unroll
        for (int i = 0; i < 8; ++i)
#pragma unroll
            for (int e = 0; e < 4; ++e) { if (i * 4 + e < pj) hc = cp_[i][e] * hc + cq_[i][e]; }
        *(LAS float*)(L + HC_OFF + tid * 4) = hc;
    }
    __syncthreads();
    LSTAMP(1);
    {
        const int cp = tid & 255, th = tid >> 8, c0 = 2 * cp;
        const float w00 = conv_w[c0], w01 = conv_w[RW + c0], w02 = conv_w[2 * RW + c0], w03 = conv_w[3 * RW + c0], b0 = conv_b[c0];
        const float w10 = conv_w[c0 + 1], w11 = conv_w[RW + c0 + 1], w12 = conv_w[2 * RW + c0 + 1], w13 = conv_w[3 * RW + c0 + 1], b1 = conv_b[c0 + 1];
        const LAS unsigned* xs = (const LAS unsigned*)(L + (th * 32) * 1024 + cp * 4);
        unsigned u0 = xs[0], u1 = xs[256], u2 = xs[512];
        float a0 = __uint_as_float(u0 << 16), a1 = __uint_as_float(u1 << 16), a2 = __uint_as_float(u2 << 16);
        float c0_ = __uint_as_float(u0 & 0xffff0000u), c1_ = __uint_as_float(u1 & 0xffff0000u), c2_ = __uint_as_float(u2 & 0xffff0000u);
#pragma unroll 8
        for (int t = 0; t < 32; ++t) { const unsigned u3 = xs[(t + 3) * 256]; const float a3 = __uint_as_float(u3 << 16), c3_ = __uint_as_float(u3 & 0xffff0000u);
            const float y0 = w00 * a0 + w01 * a1 + w02 * a2 + w03 * a3 + b0, y1 = w10 * c0_ + w11 * c1_ + w12 * c2_ + w13 * c3_ + b1;
            *(LAS unsigned*)(L + XC_OFF + (th * 32 + t) * XC_PITCH + cp * 4) = f2bf(y0) | (f2bf(y1) << 16);
            a0 = a1; a1 = a2; a2 = a3; c0_ = c1_; c1_ = c2_; c2_ = c3_; }
    }
    __syncthreads();
    LSTAMP(2);
    if (PASSB && half == 0) {
#pragma unroll
        for (int nt = 0; nt < 2; ++nt) Hc[nt] = *(const LAS float*)(L + HC_OFF + (h * 64 + 32 * nt + r32) * 4);
    }
#pragma unroll
    for (int mt = 0; mt < 2; ++mt) {
        bf16x8 af[4];
#pragma unroll
        for (int s = 0; s < 4; ++s) af[s] = *(const LAS bf16x8*)(L + XC_OFF + (32 * mt + r32) * XC_PITCH + (h * 64 + 16 * s + 8 * hi) * 2);
#pragma unroll
        for (int nt = 0; nt < 2; ++nt) {
            f32x16 ra = {}, ri = {};
#pragma unroll
            for (int s = 0; s < 4; ++s) { ra = __builtin_amdgcn_mfma_f32_32x32x16_bf16(af[s], W.wa[nt][s], ra, 0, 0, 0); ri = __builtin_amdgcn_mfma_f32_32x32x16_bf16(af[s], W.wx[nt][s], ri, 0, 0, 0); }
            const int c = h * 64 + 32 * nt + r32;
#pragma unroll
            for (int r = 0; r < 16; ++r) { const int tok = 32 * mt + crow(r, hi);
                const float xc = bf2f(*(const LAS unsigned short*)(L + XC_OFF + tok * XC_PITCH + c * 2));
                const float rg = __builtin_amdgcn_rcpf(1.f + __expf(-(ra[r] + W.ba[nt]))), ig = __builtin_amdgcn_rcpf(1.f + __expf(-(ri[r] + W.bx[nt])));
                const float la = -8.0f * rg * W.spl[nt], a = __expf(la);
                ra[r] = a; ri[r] = __builtin_amdgcn_sqrtf(fmaxf(0.f, 1.f - a * a)) * (ig * xc); }
            float P[4], H[4], Pp[4], Hp[4];
#pragma unroll
            for (int g = 0; g < 4; ++g) { P[g] = (ra[4 * g] * ra[4 * g + 1]) * (ra[4 * g + 2] * ra[4 * g + 3]);
                H[g] = ((ri[4 * g] * ra[4 * g + 1] + ri[4 * g + 1]) * ra[4 * g + 2] + ri[4 * g + 2]) * ra[4 * g + 3] + ri[4 * g + 3]; }
#pragma unroll
            for (int g = 0; g < 4; ++g) { Pp[g] = __shfl_xor(P[g], 32); Hp[g] = __shfl_xor(H[g], 32); }
            float hc = Hc[nt], pc = Pc[nt];
#pragma unroll
            for (int g = 0; g < 4; ++g) { const float P0 = hi ? Pp[g] : P[g], H0 = hi ? Hp[g] : H[g], P1 = hi ? P[g] : Pp[g], H1 = hi ? H[g] : Hp[g];
                const float mid = P0 * hc + H0;
                if (PASSB) { float hh = hi ? mid : hc;
#pragma unroll
                    for (int k = 0; k < 4; ++k) { hh = ra[4 * g + k] * hh + ri[4 * g + k]; const int tok = 32 * mt + 8 * g + 4 * hi + k;
                        *(LAS unsigned short*)(L + tok * 1024 + c * 2) = (unsigned short)f2bf(hh); } }
                hc = P1 * mid + H1; pc = pc * (P0 * P1); }
            Hc[nt] = hc; Pc[nt] = pc;
        }
    }
    if (!PASSB) {
        if (half == 1 && hi == 0) {
#pragma unroll
            for (int nt = 0; nt < 2; ++nt) { const int c = h * 64 + 32 * nt + r32; aggP[((size_t)b * RW + c) * 32 + pj] = Pc[nt]; aggH[((size_t)b * RW + c) * 32 + pj] = Hc[nt]; }
        }
        __syncthreads();
    } else {
        LSTAMP(3);
        __syncthreads();
        LSTAMP(4);
        u32x4 gv[8];
#pragma unroll
        for (int i = 0; i < 8; ++i) { const size_t row = rowbase + t0 + i * 8 + wid; gv[i] = *(const u32x4*)(GG + row * RW + lane * 8); }
#pragma unroll
        for (int i = 0; i < 8; ++i) { const int rr = i * 8 + wid; const size_t row = rowbase + t0 + rr;
            const u32x4 hv = *(const LAS u32x4*)(L + rr * 1024 + lane * 16); const u32x4 g4 = gv[i];
            f32x4 y0, y1;
            y0[0] = __uint_as_float(hv.x << 16) * __uint_as_float(g4.x << 16); y0[1] = __uint_as_float(hv.x & 0xffff0000u) * __uint_as_float(g4.x & 0xffff0000u);
            y0[2] = __uint_as_float(hv.y << 16) * __uint_as_float(g4.y << 16); y0[3] = __uint_as_float(hv.y & 0xffff0000u) * __uint_as_float(g4.y & 0xffff0000u);
            y1[0] = __uint_as_float(hv.z << 16) * __uint_as_float(g4.z << 16); y1[1] = __uint_as_float(hv.z & 0xffff0000u) * __uint_as_float(g4.z & 0xffff0000u);
            y1[2] = __uint_as_float(hv.w << 16) * __uint_as_float(g4.w << 16); y1[3] = __uint_as_float(hv.w & 0xffff0000u) * __uint_as_float(g4.w & 0xffff0000u);
            *(u32x4*)(YY + row * D + lane * 8) = pg8::pack8(y0, y1);
            float ss = pg8::sq8(y0, y1);
#pragma unroll
            for (int o = 1; o < 64; o <<= 1) ss += __shfl_xor(ss, o);
            if (lane == 0) fmid[row] = ss; }
        __syncthreads();
        LSTAMP(5);
    }
    }
#undef LSTAMP
}
}
__device__ __forceinline__ void row_prep_x(const float* x, bf16_t* xb, float* rstd0, int row, int lane) {
    const f32x4* xr = (const f32x4*)(x + (size_t)row * D) + lane;
    float s = 0.f; f32x4 v[4];
#pragma unroll
    for (int j = 0; j < 4; ++j) { v[j] = xr[64 * j]; s += v[j].x * v[j].x + v[j].y * v[j].y + v[j].z * v[j].z + v[j].w * v[j].w; }
    s = wave_sum(s);
    if (lane == 0) rstd0[row] = 1.0f / sqrtf(s * (1.f / D) + EPS);
    unsigned long long* o8 = (unsigned long long*)(xb + (size_t)row * D) + lane;
#pragma unroll
    for (int j = 0; j < 4; ++j) o8[64 * j] = (unsigned long long)(f2bf(v[j].x) | (f2bf(v[j].y) << 16)) | ((unsigned long long)(f2bf(v[j].z) | (f2bf(v[j].w) << 16)) << 32);
}
__device__ __forceinline__ void row_prep_mem(const float* m, const float* g, bf16_t* o, int row, int lane) {
    const f32x4* xr = (const f32x4*)(m + (size_t)row * D) + lane;
    float s = 0.f; f32x4 v[4];
#pragma unroll
    for (int j = 0; j < 4; ++j) { v[j] = xr[64 * j]; s += v[j].x * v[j].x + v[j].y * v[j].y + v[j].z * v[j].z + v[j].w * v[j].w; }
    s = wave_sum(s);
    const float r = 1.0f / sqrtf(s * (1.f / D) + EPS);
    unsigned long long* o8 = (unsigned long long*)(o + (size_t)row * D) + lane;
#pragma unroll
    for (int j = 0; j < 4; ++j) { const f32x4 gg = ((const f32x4*)g)[64 * j + lane];
        o8[64 * j] = (unsigned long long)(f2bf(v[j].x * r * gg.x) | (f2bf(v[j].y * r * gg.y) << 16)) | ((unsigned long long)(f2bf(v[j].z * r * gg.z) | (f2bf(v[j].w * r * gg.w) << 16)) << 32); }
}
__device__ __forceinline__ void transpose_item(const float* W, int K, int N, bf16_t* Wt, int ldt, const float* g0, const float* g1, int ksplit, LAS float* scr, int item, int lane) {
    const int nblk = N / 64, kb = item / nblk, nb = item % nblk, k0 = 64 * kb, n0 = 64 * nb, lr = lane >> 4, lc = 4 * (lane & 15);
    f32x4 v[16];
#pragma unroll
    for (int i = 0; i < 16; ++i) v[i] = *(const f32x4*)(W + (size_t)(k0 + 4 * i + lr) * N + n0 + lc);
#pragma unroll
    for (int i = 0; i < 16; ++i) { const int kk = 4 * i + lr, k = k0 + kk; float gv = 1.f; if (g0) gv = (k < ksplit) ? g0[k] : g1[k - ksplit];
        LAS float* d = scr + kk * 65 + lc; d[0] = v[i].x * gv; d[1] = v[i].y * gv; d[2] = v[i].z * gv; d[3] = v[i].w * gv; }
    asm volatile("s_waitcnt lgkmcnt(0)" ::: "memory");
    const int c = lane & 7;
#pragma unroll
    for (int j = 0; j < 8; ++j) { const int n = (lane >> 3) + 8 * j; const LAS float* s = scr + (8 * c) * 65 + n;
        u32x4 o; o.x = f2bf(s[0 * 65]) | (f2bf(s[1 * 65]) << 16); o.y = f2bf(s[2 * 65]) | (f2bf(s[3 * 65]) << 16); o.z = f2bf(s[4 * 65]) | (f2bf(s[5 * 65]) << 16); o.w = f2bf(s[6 * 65]) | (f2bf(s[7 * 65]) << 16);
        *(u32x4*)(Wt + (size_t)(n0 + n) * ldt + k0 + 8 * c) = o; }
    asm volatile("s_waitcnt lgkmcnt(0)" ::: "memory");
}

struct MidScale { const float* f; int k; int pad; };
template <class Epi>
__device__ __forceinline__ void gemm_naive(const Ctx& C, const bf16_t* A, int lda, const bf16_t* Bt, int ldb, int M, int N, int K, MidScale ms, const Epi& E) {
    const int lane = C.lane, fr = lane & 15, fq = lane >> 4, ncol = N / 64, ntile = (M / 16) * ncol;
    for (int t = C.gw; t < ntile; t += C.NGW) {
        const int row0 = (t / ncol) * 16, col0 = (t % ncol) * 64;
        const bf16_t* ap = A + (size_t)(row0 + fr) * lda + fq * 8;
        const bf16_t* bp = Bt + (size_t)(col0 + fr) * ldb + fq * 8;
        f32x4 acc[4];
#pragma unroll
        for (int n = 0; n < 4; ++n) acc[n] = (f32x4){0.f, 0.f, 0.f, 0.f};
        for (int k0 = 0; k0 < K; k0 += 32) {
            if (ms.f && k0 == ms.k) {
#pragma unroll
                for (int j = 0; j < 4; ++j) { const float f = ms.f[row0 + fq * 4 + j];
#pragma unroll
                    for (int n = 0; n < 4; ++n) acc[n][j] *= f; }
            }
            const bf16x8 a = *(const bf16x8*)(ap + k0);
#pragma unroll
            for (int n = 0; n < 4; ++n) { const bf16x8 b = *(const bf16x8*)(bp + (size_t)n * 16 * ldb + k0); acc[n] = __builtin_amdgcn_mfma_f32_16x16x32_bf16(a, b, acc[n], 0, 0, 0); }
        }
#pragma unroll
        for (int n = 0; n < 4; ++n)
#pragma unroll
            for (int j = 0; j < 4; ++j) E(row0 + fq * 4 + j, col0 + n * 16 + fr, acc[n][j]);
    }
}
struct EpiInProj { const float* rstd0; bf16_t *XR, *GG, *Qs, *Ks, *Vs;
    __device__ void operator()(int r, int c, float v) const { v *= rstd0[r]; const int t = c >> 9, cc = c & 511;
        if (t == 0) XR[(size_t)r * RW + cc] = (bf16_t)f2bf(v);
        else if (t == 1) GG[(size_t)r * RW + cc] = (bf16_t)f2bf(gelu_tanh(v));
        else if (t == 2) Qs[(size_t)r * SBW + cc] = (bf16_t)f2bf(v * (0.125f * LOG2E));
        else if (t == 3) Ks[(size_t)r * SBW + cc] = (bf16_t)f2bf(v);
        else Vs[(size_t)r * SBW + cc] = (bf16_t)f2bf(v); } };
struct EpiStoreBf16 { bf16_t* O; const float* rowscale; int ldo; float scale;
    __device__ void operator()(int r, int c, float v) const { O[(size_t)r * ldo + c] = (bf16_t)f2bf(v * (rowscale ? rowscale[r] : 1.f) * scale); } };
struct EpiResF32 { const float* base; const float* rowscale; bf16_t* O;
    __device__ void operator()(int r, int c, float v) const { O[(size_t)r * D + c] = (bf16_t)f2bf(base[(size_t)r * D + c] + v * rowscale[r]); } };
struct EpiResBf16 { const bf16_t* base; bf16_t* O;
    __device__ void operator()(int r, int c, float v) const { O[(size_t)r * D + c] = (bf16_t)f2bf(bf2f(base[(size_t)r * D + c]) + v); } };

__device__ __forceinline__ void lru_naive_unit(int unit, int j, LAS float* xs, const bf16_t* XR, const bf16_t* GG, const float* conv_w, const float* conv_b,
                                               const float* w_a, const float* b_a, const float* w_x, const float* b_x, const float* lam, bf16_t* YY) {
    const int b = unit >> 3, h = unit & 7, c = h * 64 + j;
    float wa[64], wx[64];
#pragma unroll
    for (int i = 0; i < 64; ++i) { wa[i] = w_a[(size_t)(h * 64 + i) * 64 + j]; wx[i] = w_x[(size_t)(h * 64 + i) * 64 + j]; }
    const float ba = b_a[c], bx = b_x[c], cw0 = conv_w[c], cw1 = conv_w[RW + c], cw2 = conv_w[2 * RW + c], cw3 = conv_w[3 * RW + c], cb = conv_b[c];
    const float l = lam[c], spl = (l > 15.f) ? __expf(-l) : log1pf(__expf(-l));
    float x0 = 0.f, x1 = 0.f, x2 = 0.f, hst = 0.f;
    for (int t = 0; t < SEQ; ++t) {
        const size_t row = (size_t)b * SEQ + t;
        const float x3 = bf2f(XR[row * RW + c]);
        const float xc = cw0 * x0 + cw1 * x1 + cw2 * x2 + cw3 * x3 + cb;
        x0 = x1; x1 = x2; x2 = x3;
        asm volatile("s_waitcnt lgkmcnt(0)" ::: "memory"); xs[j] = xc; asm volatile("s_waitcnt lgkmcnt(0)" ::: "memory");
        float ra = ba, ri = bx;
#pragma unroll
        for (int i = 0; i < 64; ++i) { const float xv = xs[i]; ra += xv * wa[i]; ri += xv * wx[i]; }
        const float r = sigmoidf_(ra), ig = sigmoidf_(ri);
        const float log_a = -8.0f * r * spl, a = __expf(log_a), bb = sqrtf(fmaxf(0.f, -expm1f(2.f * log_a))) * (ig * xc);
        hst = a * hst + bb;
        YY[row * D + c] = (bf16_t)f2bf(hst * bf2f(GG[row * RW + c]));
    }
}
__device__ __forceinline__ void sb_naive_unit(int unit, int lane, const bf16_t* Qs, const bf16_t* Ks, const bf16_t* Vs, bf16_t* YY, float* ssq_s8) {
    const int qb = unit & 63, h = (unit >> 6) & 7, b = unit >> 9;
    const int t = qb * 64 + lane; const size_t row = (size_t)b * SEQ + t;
    float q[64], o[64];
#pragma unroll
    for (int d = 0; d < 64; ++d) { q[d] = bf2f(Qs[row * SBW + h * 64 + d]); o[d] = 0.f; }
    float R = 0.f;
    for (int s = qb * 64 + 62; s >= 0; --s) {
        const bf16_t* kr = Ks + ((size_t)b * SEQ + s) * SBW + h * 64; const bf16_t* vr = Vs + ((size_t)b * SEQ + s) * SBW + h * 64;
        float z = 0.f;
#pragma unroll
        for (int d = 0; d < 64; ++d) z += q[d] * bf2f(kr[d]);
        const bool valid = s < t;
        const float sp = valid ? (fmaxf(z, 0.f) + __log2f(1.f + exp2f(-fabsf(z)))) : 0.f;
        const float w = valid ? exp2f(z - (R + sp)) : 0.f;
        R += sp;
        const float wb = bf2f((bf16_t)f2bf(w));
#pragma unroll
        for (int d = 0; d < 64; ++d) o[d] += wb * bf2f(vr[d]);
    }
    float ss = 0.f;
#pragma unroll
    for (int d = 0; d < 64; ++d) { ss += o[d] * o[d]; YY[row * D + RW + h * 64 + d] = (bf16_t)f2bf(o[d]); }
    ssq_s8[row * 8 + h] = ss;
}
__device__ __forceinline__ void xattn_naive_unit(int unit, int j, LAS float* qs, LAS float* ps, const bf16_t* QX, const bf16_t* KVM, bf16_t* OX) {
    const int tg = unit & 511, h = (unit >> 9) & 3, b = unit >> 11, lane = j & 63, wid = j >> 6;
    const size_t row0 = (size_t)b * SEQ + tg * 8;
    for (int i = 0; i < 8; ++i) qs[i * 256 + j] = bf2f(QX[(row0 + i) * D + h * XD + j]);
    __syncthreads();
    const bf16_t* kr = KVM + ((size_t)b * MEM + j) * 2048 + h * XD;
    float sc[8];
#pragma unroll
    for (int i = 0; i < 8; ++i) sc[i] = 0.f;
    for (int d = 0; d < XD; ++d) { const float kv = bf2f(kr[d]);
#pragma unroll
        for (int i = 0; i < 8; ++i) sc[i] += qs[i * 256 + d] * kv; }
#pragma unroll
    for (int i = 0; i < 8; ++i) ps[i * 256 + j] = sc[i];
    __syncthreads();
    for (int i = wid * 2; i < wid * 2 + 2; ++i) {
        float v0 = ps[i * 256 + lane], v1 = ps[i * 256 + lane + 64], v2 = ps[i * 256 + lane + 128], v3 = ps[i * 256 + lane + 192];
        float m = fmaxf(fmaxf(v0, v1), fmaxf(v2, v3));
#pragma unroll
        for (int o = 1; o < 64; o <<= 1) m = fmaxf(m, __shfl_xor(m, o));
        v0 = exp2f(v0 - m); v1 = exp2f(v1 - m); v2 = exp2f(v2 - m); v3 = exp2f(v3 - m);
        const float s = wave_sum(v0 + v1 + v2 + v3), inv = 1.f / s;
        ps[i * 256 + lane] = v0 * inv; ps[i * 256 + lane + 64] = v1 * inv; ps[i * 256 + lane + 128] = v2 * inv; ps[i * 256 + lane + 192] = v3 * inv;
    }
    __syncthreads();
    float o[8];
#pragma unroll
    for (int i = 0; i < 8; ++i) o[i] = 0.f;
    for (int m = 0; m < MEM; ++m) { const float vv = bf2f(KVM[((size_t)b * MEM + m) * 2048 + 1024 + h * XD + j]);
#pragma unroll
        for (int i = 0; i < 8; ++i) o[i] += ps[i * 256 + m] * vv; }
#pragma unroll
    for (int i = 0; i < 8; ++i) OX[(row0 + i) * D + h * XD + j] = (bf16_t)f2bf(o[i]);
    __syncthreads();
}
__device__ __forceinline__ int router_row(int row, int lane, const bf16_t* X2b, const float* ssq2p, const float* g, const float* wgr, const float* bgr, const float* wer, const float* ber, float* selw) {
    int cls = 0;
    float acc[20];
#pragma unroll
    for (int i = 0; i < 20; ++i) acc[i] = 0.f;
    const float rs = pg8::rstd16(ssq2p + (size_t)row * 16);
    for (int kk = 0; kk < 16; ++kk) { const int k = kk * 64 + lane; const float t = bf2f(X2b[(size_t)row * D + k]) * rs * g[k];
#pragma unroll
        for (int i = 0; i < 4; ++i) acc[i] += t * wgr[k * 4 + i];
#pragma unroll
        for (int gi = 0; gi < 4; ++gi)
#pragma unroll
            for (int e = 0; e < 4; ++e) acc[4 + gi * 4 + e] += t * wer[((size_t)gi * D + k) * 4 + e]; }
#pragma unroll
    for (int i = 0; i < 20; ++i) acc[i] = wave_sum(acc[i]);
    if (lane == 0) {
        float gl[4]; float gm = -INFINITY; int gi = 0;
#pragma unroll
        for (int i = 0; i < 4; ++i) { gl[i] = acc[i] + bgr[i]; if (gl[i] > gm) { gm = gl[i]; gi = i; } }
        float gs = 0.f;
#pragma unroll
        for (int i = 0; i < 4; ++i) gs += __expf(gl[i] - gm);
        const float gp = 1.f / gs;
        float el[4];
#pragma unroll
        for (int e = 0; e < 4; ++e) { float v = 0.f;
#pragma unroll
            for (int q = 0; q < 4; ++q) if (q == gi) v = acc[4 + q * 4 + e] + ber[q * 4 + e];
            el[e] = v; }
        int e1 = 0; float m1 = el[0];
#pragma unroll
        for (int e = 1; e < 4; ++e) if (el[e] > m1) { m1 = el[e]; e1 = e; }
        int e2 = -1; float m2 = -INFINITY;
#pragma unroll
        for (int e = 0; e < 4; ++e) if (e != e1 && el[e] > m2) { m2 = el[e]; e2 = e; }
        const float p2 = __expf(m2 - m1), w1 = gp / (1.f + p2), w2 = gp * p2 / (1.f + p2);
        const int ea = e1 < e2 ? e1 : e2, eb = e1 < e2 ? e2 : e1; const float wA = e1 < e2 ? w1 : w2, wB = e1 < e2 ? w2 : w1;
        const int pr = (ea == 0) ? eb - 1 : (ea == 1) ? eb + 1 : 5;
        selw[(size_t)row * 2] = wA; selw[(size_t)row * 2 + 1] = wB; cls = gi * 6 + pr;
    }
    return cls;
}
__device__ __forceinline__ void final_row(int row, int lane, const bf16_t* X3b, const float* ssq3, const float* g, float* out) {
    const float r = pg8::rstd16(ssq3 + (size_t)row * 16);
#pragma unroll
    for (int j = 0; j < 2; ++j) { const int c = j * 512 + lane * 8; const u32x4 v = *(const u32x4*)(X3b + (size_t)row * D + c); const f32x4 g0 = *(const f32x4*)(g + c), g1 = *(const f32x4*)(g + c + 4);
        f32x4 o0, o1;
        o0[0] = __uint_as_float(v.x << 16) * r * g0[0]; o0[1] = __uint_as_float(v.x & 0xffff0000u) * r * g0[1]; o0[2] = __uint_as_float(v.y << 16) * r * g0[2]; o0[3] = __uint_as_float(v.y & 0xffff0000u) * r * g0[3];
        o1[0] = __uint_as_float(v.z << 16) * r * g1[0]; o1[1] = __uint_as_float(v.z & 0xffff0000u) * r * g1[1]; o1[2] = __uint_as_float(v.w << 16) * r * g1[2]; o1[3] = __uint_as_float(v.w & 0xffff0000u) * r * g1[3];
        *(f32x4*)(out + (size_t)row * D + c) = o0; *(f32x4*)(out + (size_t)row * D + c + 4) = o1; }
}
__device__ __forceinline__ void reids(Ctx& C) { int t_ = threadIdx.x; asm volatile("" : "+v"(t_)); C.tid = t_; C.lane = t_ & 63; C.wave = __builtin_amdgcn_readfirstlane(t_ >> 6); C.gw = C.bid * NWAVES + C.wave; }
__global__ void __launch_bounds__(NTHREADS, 2) mk_fwd(Args args) {
    extern __shared__ __attribute__((aligned(16))) unsigned char lds[];
    cg::grid_group grid = cg::this_grid();
    Ctx C;
#pragma unroll
    for (int i = 0; i < 29; ++i) C.in[i] = args.in[i];
    C.out = args.out; C.ws = args.ws; C.lds = lds;
    C.tid = threadIdx.x; C.lane = C.tid & 63; C.wave = __builtin_amdgcn_readfirstlane(C.tid >> 6);
    C.G = gridDim.x; C.bid = blockIdx.x; C.gw = C.bid * NWAVES + C.wave; C.NGW = C.G * NWAVES;
    const float* x = C.in[0]; const float* mem = C.in[1]; const float* norm_mix = C.in[2]; const float* w_in = C.in[3];
    const float* conv_w = C.in[4]; const float* conv_b = C.in[5]; const float* lru_w_a = C.in[6]; const float* lru_b_a = C.in[7];
    const float* lru_w_x = C.in[8]; const float* lru_b_x = C.in[9]; const float* lru_lambda = C.in[10];
    const float* norm_rnn = C.in[11]; const float* norm_sb = C.in[12]; const float* w_out = C.in[13];
    const float* norm_xattn = C.in[14]; const float* norm_mem = C.in[15];
    const float* xa_w_q = C.in[16]; const float* xa_w_k = C.in[17]; const float* xa_w_v = C.in[18]; const float* xa_w_o = C.in[19];
    const float* norm_moe = C.in[20]; const float* w_gr = C.in[21]; const float* b_gr = C.in[22]; const float* w_er = C.in[23]; const float* b_er = C.in[24];
    const float* w_gate = C.in[25]; const float* w_up = C.in[26]; const float* w_down = C.in[27]; const float* norm_final = C.in[28];
    unsigned char* ws = C.ws; float* out = C.out;
    float* sm = (float*)(ws + WS_SMALL);
    float* rstd0 = sm + SM_RSTD0; float* ssq_r = sm + SM_SSQR; float* ssq_s = sm + SM_SSQS; float* ssq1 = sm + SM_SSQ1; float* ssq2 = sm + SM_SSQ2; unsigned* kmax = (unsigned*)(ws + WS_CTL); float* fmid = sm + SM_END; float* fend = fmid + 32768;
    float* aggP = sm + 96 * 32768; float* aggH = sm + 104 * 32768;
    float* selw = sm + SM_SELW; float* ssq3 = sm + SM_SSQ3; int* gcnt = (int*)(ws + WS_CTL + 1024); int* sbq = (int*)(ws + WS_CTL + 3072); unsigned* lruc = (unsigned*)(ws + WS_CTL + 4096 + 28672);
    int* tlist = (int*)(sm + 64 * 32768); float* rsg = sm + 88 * 32768; float* wAg = rsg + 40960; float* wBg = wAg + 40960; int* tokg = (int*)(wBg + 40960); float* rstok = sm + SM_RSTD0;
    bf16_t* Wrh = (bf16_t*)(ws + WS_CTL + 65536); bf16_t* Wrl = Wrh + 32 * D;
    bf16_t* Wg_t = (bf16_t*)(ws + WS_WG); bf16_t* Wu_t = (bf16_t*)(ws + WS_WU); bf16_t* Wd2 = (bf16_t*)(ws + WS_WD2); bf16_t* XG = (bf16_t*)(ws + WS_R1); bf16_t* HID = (bf16_t*)(ws + WS_R5);
    bf16_t* Win_t = (bf16_t*)(ws + WS_WIN); bf16_t* Wout_t = (bf16_t*)(ws + WS_WOUT); bf16_t* Wq_t = (bf16_t*)(ws + WS_WQ); bf16_t* Wkv_t = (bf16_t*)(ws + WS_WKV); bf16_t* Wo_t = (bf16_t*)(ws + WS_WO);
    bf16_t* memn = (bf16_t*)(ws + WS_MEMN); bf16_t* KM = (bf16_t*)(ws + WS_KVM); bf16_t* VM = KM + (size_t)NMEM * D; bf16_t* MT = (bf16_t*)(ws + WS_R5); bf16_t* NT = MT + (size_t)BATCH * D * D; bf16_t* WqN = (bf16_t*)(ws + WS_WQ);
    bf16_t* xb = (bf16_t*)(ws + WS_R0); bf16_t* X1b = xb; bf16_t* X3b = xb;
    bf16_t* XR = (bf16_t*)(ws + WS_R1); bf16_t* GG = XR + (size_t)NTOK * RW; bf16_t* QX = XR;
    bf16_t* Qs = (bf16_t*)(ws + WS_R2); bf16_t* Ks = Qs + (size_t)NTOK * SBW; bf16_t* OX = Qs;
    bf16_t* Vs = (bf16_t*)(ws + WS_R3);
    bf16_t* YY = (bf16_t*)(ws + WS_R4); bf16_t* X2b = YY;
    const int NGW = C.NGW;
#define gw C.gw
#define lane C.lane
    if (C.tid < 64) ((LAS unsigned*)(lds + 146432))[C.tid] = 0u;
    __syncthreads();
    XcdBarrier bar = xcd_barrier_post((unsigned*)(ws + WS_CTL + 4096), (volatile LAS unsigned*)(lds + 146432 + 32));
#define GRID_SYNC_CG() do { grid.sync(); reids(C); } while (0)
#define GRID_SYNC() do { xcd_barrier(bar); reids(C); } while (0)

    for (int rep_ = 0; rep_ < (int)((REP_MASK >> 0) & 1u) + 1; ++rep_) {
    {
        if (gw == 0) { kmax[lane] = 0u; if (lane < 32) gcnt[lane] = 0; if (lane == 32) sbq[0] = 0; }
        if (gw == 1) { ((u32x4*)(ws + WS_END))[lane] = (u32x4){0u, 0u, 0u, 0u}; ((u32x4*)(ws + WS_END))[64 + lane] = (u32x4){0u, 0u, 0u, 0u}; }
        for (int r = gw * 4; r < NTOK; r += NGW * 4) {
            const f32x4* xr = (const f32x4*)(x + (size_t)r * D) + lane; f32x4 v[16]; float s[4] = {0.f, 0.f, 0.f, 0.f};
#pragma unroll
            for (int j = 0; j < 16; ++j) v[j] = __builtin_nontemporal_load(xr + 64 * j);
#pragma unroll
            for (int j = 0; j < 16; ++j) s[j >> 2] += (v[j].x * v[j].x + v[j].y * v[j].y) + (v[j].z * v[j].z + v[j].w * v[j].w);
#pragma unroll
            for (int o = 1; o < 64; o <<= 1) { s[0] += __shfl_xor(s[0], o); s[1] += __shfl_xor(s[1], o); s[2] += __shfl_xor(s[2], o); s[3] += __shfl_xor(s[3], o); }
            if (lane < 4) { const float sv = lane == 0 ? s[0] : lane == 1 ? s[1] : lane == 2 ? s[2] : s[3]; rstd0[r + lane] = __builtin_amdgcn_rsqf(sv * (1.f / D) + EPS); }
            unsigned long long* o8 = (unsigned long long*)(xb + (size_t)r * D) + lane;
#pragma unroll
            for (int j = 0; j < 16; ++j) o8[64 * j] = (unsigned long long)(f2bf(v[j].x) | (f2bf(v[j].y) << 16)) | ((unsigned long long)(f2bf(v[j].z) | (f2bf(v[j].w) << 16)) << 32);
        }
        for (int r = gw; r < NMEM; r += NGW) row_prep_mem(mem, norm_mem, memn, r, lane);
        LAS float* scr = (LAS float*)(lds) + C.wave * (64 * 65);
        constexpr int I_IN = (D / 64) * (PROJ / 64), I_SQ = (D / 64) * (D / 64);
        for (int it = gw; it < I_IN + 4 * I_SQ; it += NGW) {
            int r = it;
            if (r < I_IN) { transpose_item(w_in, D, PROJ, Win_t, D, norm_mix, norm_mix, D, scr, r, lane); continue; } r -= I_IN;
            if (r < I_SQ) { transpose_item(w_out, D, D, Wout_t, D, norm_rnn, norm_sb, RW, scr, r, lane); continue; } r -= I_SQ;
            if (r < I_SQ) { transpose_item(xa_w_k, D, D, Wkv_t, D, nullptr, nullptr, 0, scr, r, lane); continue; } r -= I_SQ;
            if (r < I_SQ) { transpose_item(xa_w_v, D, D, Wkv_t + (size_t)D * D, D, nullptr, nullptr, 0, scr, r, lane); continue; } r -= I_SQ;
            transpose_item(xa_w_o, D, D, Wo_t, D, nullptr, nullptr, 0, scr, r, lane);
        }
        for (int r = gw; r < D; r += NGW) { const float gk = norm_xattn[r]; const f32x4* src = (const f32x4*)(xa_w_q + (size_t)r * D) + lane; unsigned long long* o8 = (unsigned long long*)(WqN + (size_t)r * D) + lane;
#pragma unroll
            for (int j = 0; j < 4; ++j) { const f32x4 v = src[64 * j]; o8[64 * j] = (unsigned long long)(f2bf(v.x * gk) | (f2bf(v.y * gk) << 16)) | ((unsigned long long)(f2bf(v.z * gk) | (f2bf(v.w * gk) << 16)) << 32); } }
        for (int idx = gw * 64 + lane; idx < 32 * D; idx += NGW * 64) { const int n = idx >> 10, k = idx & 1023; float w = 0.f;
            if (n < 4) w = w_gr[k * 4 + n]; else if (n < 20) w = w_er[((size_t)((n - 4) >> 2) * D + k) * 4 + ((n - 4) & 3)];
            w *= norm_moe[k]; const unsigned hi = f2bf(w); Wrh[idx] = (bf16_t)hi; Wrl[idx] = (bf16_t)f2bf(w - bf2f((unsigned short)hi)); }
        constexpr int I_GU = (D / 64) * (DE / 64), I_DN = (DE / 64) * (D / 64);
        for (int it = gw; it < 32 * I_GU + 48 * I_DN; it += NGW) {
            int r = it;
            if (r < 16 * I_GU) { const int e = r / I_GU; transpose_item(w_gate + (size_t)e * D * DE, D, DE, Wg_t + (size_t)e * DE * D, D, norm_moe, norm_moe, D, scr, r % I_GU, lane); continue; } r -= 16 * I_GU;
            if (r < 16 * I_GU) { const int e = r / I_GU; transpose_item(w_up + (size_t)e * D * DE, D, DE, Wu_t + (size_t)e * DE * D, D, norm_moe, norm_moe, D, scr, r % I_GU, lane); continue; } r -= 16 * I_GU;
            { const int cs = r / I_DN, cls = cs >> 1, slot = cs & 1; int ea, eb; pg8::pair_ab(cls % 6, ea, eb); const int e = (cls / 6) * 4 + (slot ? eb : ea);
              transpose_item(w_down + (size_t)e * DE * D, DE, D, Wd2 + (size_t)cls * D * 512 + slot * DE, 512, nullptr, nullptr, 0, scr, r % I_DN, lane); }
        }
    }
    }
    GRID_SYNC();
    for (int rep_ = 0; rep_ < (int)((REP_MASK >> 1) & 1u) + 1; ++rep_) {
    { pg8::DenseOrder S; S.init(xb, D, Win_t, D, NTOK, PROJ, C.G, C.bid); pg8::EpiInProjF E{0, rstd0, XR, GG, Qs, Ks, Vs, kmax};
      pg8::gemm_phase<pg8::EpiInProjF, pg8::DenseOrder, true>((LAS unsigned char*)lds, pg8::Gemm{D, D, D}, S, E); }
    { pg8::DenseOrder S; S.init(memn, D, Wkv_t, D, NMEM, 2048, C.G, C.bid); pg8::EpiKvN E{0, KM, VM};
      pg8::gemm_phase<pg8::EpiKvN, pg8::DenseOrder, true>((LAS unsigned char*)lds, pg8::Gemm{D, D, D}, S, E); }
    }
    GRID_SYNC();
    for (int rep_ = 0; rep_ < (int)((REP_MASK >> 2) & 1u) + 1; ++rep_) {
    {
        { lru::Weights LW; lru::load_weights(LW, C.wave, lane & 31, lane >> 5, lru_w_a, lru_b_a, lru_w_x, lru_b_x, lru_lambda);
          for (int u = C.bid; u < BATCH * 32; u += C.G) { lru::pair_unit<false>(u >> 5, u & 31, LW, XR, GG, conv_w, conv_b, aggP, aggH, ssq_s, YY, fmid, fend, lds);
              asm volatile("s_waitcnt vmcnt(0)" ::: "memory"); __syncthreads();
              if (C.tid == 0) { __builtin_amdgcn_fence(__ATOMIC_RELEASE, "agent"); asm volatile("s_waitcnt vmcnt(0)" ::: "memory"); __hip_atomic_fetch_add(lruc + 16 * (u >> 5), 1u, __ATOMIC_RELAXED, __HIP_MEMORY_SCOPE_AGENT); } } }
        {
            volatile LAS int* qslot = (volatile LAS int*)(lds + 146432 + 192); int nextu = 0;
            if (C.tid == 0) qslot[0] = atomicAdd(sbq, 1);
            __syncthreads();
            int u = qslot[0];
            while (u < BATCH * NH * 16) {
                __syncthreads();
                if (C.tid == 0) nextu = atomicAdd(sbq, 1);
                sba::sb_unit(u >> 7, (u >> 4) & 7, 15 - (u & 15), Qs, Ks, Vs, YY, ssq_s, (char*)lds);
                if (C.tid == 0) qslot[0] = nextu;
                __syncthreads();
                u = qslot[0];
            }
        }
    }
    { pg8::XaPreOrder S{KM, VM, WqN, Wo_t, C.G, C.bid}; pg8::EpiXaPre E{0, MT, NT};
      pg8::gemm_phase<pg8::EpiXaPre, pg8::XaPreOrder, true>((LAS unsigned char*)lds, pg8::Gemm{D, D, XD}, S, E); }
    {
        const float *pwa = lru_w_a, *pba = lru_b_a, *pwx = lru_w_x, *pbx = lru_b_x, *plm = lru_lambda;
        asm volatile("" : "+s"(pwa), "+s"(pba), "+s"(pwx), "+s"(pbx), "+s"(plm));
        int l2_ = lane; asm volatile("" : "+v"(l2_));
        lru::Weights LW; lru::load_weights(LW, C.wave, l2_ & 31, l2_ >> 5, pwa, pba, pwx, pbx, plm);
        for (int u = C.bid; u < BATCH * 32; u += C.G) {
            if (C.tid < 64) { unsigned spins = 0;
                while ((unsigned)__builtin_amdgcn_readfirstlane(__hip_atomic_load(lruc + 16 * (u >> 5), __ATOMIC_RELAXED, __HIP_MEMORY_SCOPE_AGENT)) < 32u) { __builtin_amdgcn_s_sleep(2); if (++spins > (1u << 20)) break; }
                __builtin_amdgcn_fence(__ATOMIC_ACQUIRE, "agent"); }
            asm volatile("s_waitcnt vmcnt(0)" ::: "memory"); __syncthreads();
            lru::pair_unit<true>(u >> 5, u & 31, LW, XR, GG, conv_w, conv_b, aggP, aggH, ssq_s, YY, ssq_r, fend, lds); }
    }
    }
    GRID_SYNC();
    for (int rep_ = 0; rep_ < (int)((REP_MASK >> 4) & 1u) + 1; ++rep_) {
    { pg8::DenseOrder S; S.init(YY, D, Wout_t, D, NTOK, D, C.G, C.bid); pg8::EpiX1F E{8, xb, fmid, fend, X1b, ssq1};
      { pg8::Unit u_;
        for (int i = 0; S.next(i, u_); ++i) if (C.tid < 256) { const int row = u_.pm * 256 + C.tid; const f32x4 a4 = ((const f32x4*)(ssq_s + (size_t)row * 8))[0], b4 = ((const f32x4*)(ssq_s + (size_t)row * 8))[1];
            const float rr = __builtin_amdgcn_rsqf(ssq_r[row] * (1.f / RW) + EPS), rs = __builtin_amdgcn_rsqf((((a4.x + a4.y) + (a4.z + a4.w)) + ((b4.x + b4.y) + (b4.z + b4.w))) * (1.f / SBW) + EPS);
            fmid[row] = rr * __builtin_amdgcn_rcpf(rs); fend[row] = rs; }
        asm volatile("s_waitcnt vmcnt(0)" ::: "memory"); __syncthreads(); }
      pg8::gemm_phase<pg8::EpiX1F, pg8::DenseOrder, true>((LAS unsigned char*)lds, pg8::Gemm{D, D, D}, S, E); }
    }
    GRID_SYNC();
    for (int rep_ = 0; rep_ < (int)((REP_MASK >> 5) & 1u) + 1; ++rep_) {
    { pg8::BatchedOrder S{X1b, MT, C.G, C.bid}; pg8::EpiXaSoftmax E{0, QX, ssq1, 0.0625f * LOG2E, (LAS float*)(lds + 131072 + 2048)};
      pg8::gemm_phase<pg8::EpiXaSoftmax, pg8::BatchedOrder, true>((LAS unsigned char*)lds, pg8::Gemm{D, D, D}, S, E); }
    }
    GRID_SYNC();
    for (int rep_ = 0; rep_ < (int)((REP_MASK >> 8) & 1u) + 1; ++rep_) {
    { pg8::BatchedOrder S{QX, NT, C.G, C.bid}; pg8::EpiResF E{0, X1b, X2b, ssq2};
      pg8::gemm_phase<pg8::EpiResF, pg8::BatchedOrder, true>((LAS unsigned char*)lds, pg8::Gemm{D, D, D}, S, E); }
    }
    GRID_SYNC();
    for (int rep_ = 0; rep_ < (int)((REP_MASK >> 9) & 1u) + 1; ++rep_) {
    {
        LAS int* lcnt = (LAS int*)lds; LAS int* lbase = lcnt + 32; LAS int* lcls = lcnt + 64; LAS int* lpos = lcnt + 192;
        for (int p = C.tid; p < 64 * 128; p += NTHREADS) { const int rrow = p >> 7, pc = p & 127;
            *(LAS u32x4*)(lds + 12288 + rrow * 2064 + pc * 16) = *(const u32x4*)(Wrh + (size_t)rrow * D + pc * 8); }
        for (int chunk = C.bid; chunk < NTOK / 128; chunk += C.G) {
            if (C.tid < 32) lcnt[C.tid] = 0;
            __syncthreads();
            {
                const int fr = lane & 15, fq = lane >> 4, row0 = chunk * 128 + C.wave * 16;
                f32x4 acc0 = {0.f, 0.f, 0.f, 0.f}, acc1 = acc0;
                const bf16_t* ap = X2b + (size_t)(row0 + fr) * D + fq * 8; const LAS unsigned char* bp = (const LAS unsigned char*)(lds + 12288) + fr * 2064 + fq * 16;
#pragma unroll 1
                for (int kb = 0; kb < 4; ++kb) { bf16x8 a[8];
#pragma unroll
                    for (int j = 0; j < 8; ++j) a[j] = *(const bf16x8*)(ap + (kb * 8 + j) * 32);
#pragma unroll
                    for (int j = 0; j < 8; ++j) { const int ks = kb * 8 + j;
                        const bf16x8 h0 = *(const LAS bf16x8*)(bp + ks * 64), h1 = *(const LAS bf16x8*)(bp + 16 * 2064 + ks * 64), l0 = *(const LAS bf16x8*)(bp + 32 * 2064 + ks * 64), l1 = *(const LAS bf16x8*)(bp + 48 * 2064 + ks * 64);
                        acc0 = __builtin_amdgcn_mfma_f32_16x16x32_bf16(a[j], h0, acc0, 0, 0, 0); acc1 = __builtin_amdgcn_mfma_f32_16x16x32_bf16(a[j], h1, acc1, 0, 0, 0);
                        acc0 = __builtin_amdgcn_mfma_f32_16x16x32_bf16(a[j], l0, acc0, 0, 0, 0); acc1 = __builtin_amdgcn_mfma_f32_16x16x32_bf16(a[j], l1, acc1, 0, 0, 0); } }
                LAS float* lg = (LAS float*)(lds + 1536) + C.wave * (16 * 21);
#pragma unroll
                for (int j = 0; j < 4; ++j) { lg[(4 * fq + j) * 21 + fr] = acc0[j]; if (fr < 4) lg[(4 * fq + j) * 21 + 16 + fr] = acc1[j]; }
                asm volatile("s_waitcnt lgkmcnt(0)" ::: "memory");
                if (lane < 16) { const int row = row0 + lane; const float rs = pg8::rstd16(ssq2 + (size_t)row * 16); const LAS float* lr = lg + lane * 21;
                    float gl[4]; float gm = -INFINITY; int gi = 0;
#pragma unroll
                    for (int i = 0; i < 4; ++i) { gl[i] = lr[i] * rs + b_gr[i]; if (gl[i] > gm) { gm = gl[i]; gi = i; } }
                    float gs = 0.f;
#pragma unroll
                    for (int i = 0; i < 4; ++i) gs += __expf(gl[i] - gm);
                    const float gp = 1.f / gs;
                    float el[4];
#pragma unroll
                    for (int e = 0; e < 4; ++e) el[e] = lr[4 + gi * 4 + e] * rs + b_er[gi * 4 + e];
                    int e1 = 0; float m1 = el[0];
#pragma unroll
                    for (int e = 1; e < 4; ++e) if (el[e] > m1) { m1 = el[e]; e1 = e; }
                    int e2 = -1; float m2 = -INFINITY;
#pragma unroll
                    for (int e = 0; e < 4; ++e) if (e != e1 && el[e] > m2) { m2 = el[e]; e2 = e; }
                    const float p2 = __expf(m2 - m1), w1 = gp / (1.f + p2), w2 = gp * p2 / (1.f + p2);
                    const int ea = e1 < e2 ? e1 : e2, eb = e1 < e2 ? e2 : e1; const float wA = e1 < e2 ? w1 : w2, wB = e1 < e2 ? w2 : w1;
                    const int pr = (ea == 0) ? eb - 1 : (ea == 1) ? eb + 1 : 5, cls = gi * 6 + pr, lt = C.wave * 16 + lane;
                    selw[(size_t)row * 2] = wA; selw[(size_t)row * 2 + 1] = wB; rstok[row] = rs;
                    lcls[lt] = cls; lpos[lt] = __hip_atomic_fetch_add(lcnt + cls, 1, __ATOMIC_RELAXED, __HIP_MEMORY_SCOPE_WORKGROUP); }
            }
            __syncthreads();
            if (C.tid < 24) lbase[C.tid] = atomicAdd(gcnt + C.tid, lcnt[C.tid]);
            __syncthreads();
            if (C.tid < 128) { const int c = lcls[C.tid]; tlist[(size_t)c * NTOK + lbase[c] + lpos[C.tid]] = chunk * 128 + C.tid; }
            __syncthreads();
        }
    }
    }
    GRID_SYNC();
    LAS int* meta = (LAS int*)(lds + 146432 + 256);
    for (int rep_ = 0; rep_ < (int)((REP_MASK >> 11) & 1u) + 1; ++rep_) {
    {
        if (C.tid == 0) { int rb = 0, tb = 0;
            for (int c = 0; c < 24; ++c) { const int n = gcnt[c], nt = (n + 255) >> 8; meta[c] = n; meta[32 + c] = rb; meta[64 + c] = tb; rb += nt * 256; tb += nt; }
            meta[32 + 24] = rb; meta[64 + 24] = tb; }
        __syncthreads();
        LAS int* tokl = (LAS int*)(lds + 131072 + 2048);
        pg8::MoeOrder1G S{X2b, Wg_t, Wu_t, meta, tokl, (unsigned)(WS_END - WS_R4), C.G, C.bid};
        { pg8::Unit u;
          for (int i = 0; S.next(i, u); ++i) { const int cls = (u.pn & 0xffff) >> 2, p0 = (u.pm - meta[64 + cls]) * 256;
              if (C.tid < 256) { const int pp = p0 + C.tid, tok = pp < meta[cls] ? tlist[(size_t)cls * NTOK + pp] : -1; tokl[i * 256 + C.tid] = tok; tokg[u.pm * 256 + C.tid] = tok; } } }
        __syncthreads();
        pg8::EpiMoeUpG E{0, tokl, rstok, selw, HID};
        pg8::gemm_phase_gather<pg8::EpiMoeUpG, pg8::MoeOrder1G, true>((LAS unsigned char*)lds, pg8::Gemm{D, D, D}, S, E);
    }
    }
    GRID_SYNC();
    for (int rep_ = 0; rep_ < (int)((REP_MASK >> 12) & 1u) + 1; ++rep_) {
    { pg8::MoeOrder2 S{HID, Wd2, meta, C.G, C.bid};
      pg8::EpiMoeFinal E{0, tokg, X2b, out, ssq3, (unsigned*)(ws + WS_CTL + 4096 + 16384), norm_final, (LAS unsigned*)(lds + 146432 + 128), (unsigned*)(ws + WS_CTL + 4096) + 128};
      pg8::gemm_phase<pg8::EpiMoeFinal, pg8::MoeOrder2, true>((LAS unsigned char*)lds, pg8::Gemm{512, 512, 512}, S, E); }
    }
}

#undef gw
#undef lane
extern "C" void kernel_launch(void* const* d_in, const int* in_sizes, int n_in, void* d_out, int out_size, void* d_ws, size_t ws_size, hipStream_t stream) {
    static int grid = 0;
    if (grid == 0) {
        if (n_in != 29 || ws_size < WS_END + 4096) { fprintf(stderr, "kernel_launch: unexpected inputs (%d) or workspace (%zu)\n", n_in, ws_size); grid = -1; return; }
        int dev = 0, cus = 0, per_cu = 0;
        hipGetDevice(&dev); hipDeviceGetAttribute(&cus, hipDeviceAttributeMultiprocessorCount, dev);
        hipFuncSetAttribute((const void*)mk_fwd, hipFuncAttributeMaxDynamicSharedMemorySize, LDS_BYTES);
        hipOccupancyMaxActiveBlocksPerMultiprocessor(&per_cu, (const void*)mk_fwd, NTHREADS, LDS_BYTES);
        if (per_cu < 1) { fprintf(stderr, "kernel_launch: occupancy query says %d blocks per CU\n", per_cu); per_cu = 1; }
        if (per_cu > 1) per_cu = 1;
        grid = cus * per_cu;
    }
    if (grid < 0) return;
    if (hipMemsetAsync((char*)d_ws + WS_CTL + 4096, 0, 32768, stream) != hipSuccess) { fprintf(stderr, "kernel_launch: memset of the barrier words failed\n"); return; }
    Args a{};
    for (int i = 0; i < 29; ++i) a.in[i] = (const float*)d_in[i];
    a.out = (float*)d_out; a.ws = (unsigned char*)d_ws;
    void* kargs[] = {&a};
    hipError_t e = hipLaunchCooperativeKernel((const void*)mk_fwd, dim3(grid), dim3(NTHREADS), kargs, LDS_BYTES, stream);
    if (e != hipSuccess) fprintf(stderr, "cooperative launch failed: %s (grid %d)\n", hipGetErrorString(e), grid);
}
```

```cpp
#include <hip/hip_runtime.h>
#include <hip/hip_cooperative_groups.h>
#include <cstdio>
#include <cstdint>

typedef unsigned short bf16_t;
typedef short bf16x8 __attribute__((ext_vector_type(8)));
typedef float f32x4 __attribute__((ext_vector_type(4)));
typedef unsigned u32x4 __attribute__((ext_vector_type(4)));

constexpr int D = 1024, BATCH = 8, SEQ = 4096, NTOK = BATCH * SEQ, MEM = 256, NMEM = BATCH * MEM;
constexpr int RW = 512, SBW = 512, PROJ = 2560, NH = 8, HD = 64;
constexpr int XH = 4, XD = 256, NG = 4, EPG = 4, NEXP = 16, DE = 256;
constexpr float EPS = 1e-6f, LOG2E = 1.4426950408889634f;

constexpr size_t MiB = 1u << 20;
constexpr size_t WS_CTL = 0;
constexpr size_t WS_SMALL = 1 * MiB;
constexpr size_t WS_WIN = 16 * MiB;
constexpr size_t WS_WOUT = 21 * MiB;
constexpr size_t WS_WQ = 23 * MiB;
constexpr size_t WS_WKV = 25 * MiB;
constexpr size_t WS_WO = 29 * MiB;
constexpr size_t WS_MEMN = 31 * MiB;
constexpr size_t WS_KVM = 35 * MiB;
constexpr size_t WS_WG = 43 * MiB;
constexpr size_t WS_WU = 51 * MiB;
constexpr size_t WS_WD2 = 59 * MiB;
constexpr size_t WS_R0 = 96 * MiB;
constexpr size_t WS_R1 = 160 * MiB;
constexpr size_t WS_R2 = 224 * MiB;
constexpr size_t WS_R3 = 288 * MiB;
constexpr size_t WS_R4 = 320 * MiB;
constexpr size_t WS_R5 = 384 * MiB;
constexpr size_t WS_END = 448 * MiB;

constexpr size_t SM_RSTD0 = 0;
constexpr size_t SM_SSQR = 1 * 32768;
constexpr size_t SM_SSQS = 2 * 32768;
constexpr size_t SM_SSQ1 = 10 * 32768;
constexpr size_t SM_SSQ2 = 26 * 32768;
constexpr size_t SM_SSQ3 = 42 * 32768;
constexpr size_t SM_SELW = 58 * 32768;
constexpr size_t SM_SELE = 60 * 32768;
constexpr size_t SM_END = 62 * 32768;

__device__ __forceinline__ unsigned f2bf(float f) { unsigned u = __builtin_bit_cast(unsigned, f); return (u + 0x7fffu + ((u >> 16) & 1u)) >> 16; }
__device__ __forceinline__ float bf2f(unsigned short h) { return __builtin_bit_cast(float, (unsigned)h << 16); }
__device__ __forceinline__ float wave_sum(float v) {
#pragma unroll
    for (int o = 1; o < 64; o <<= 1) v += __shfl_xor(v, o);
    return v;
}
__device__ __forceinline__ float gelu_tanh(float x) { const float u = 0.7978845608028654f * (x + 0.044715f * x * x * x); return x * __builtin_amdgcn_rcpf(1.f + __expf(-2.f * u)); }
__device__ __forceinline__ float sigmoidf_(float x) { return 1.f / (1.f + __expf(-x)); }

namespace cg = cooperative_groups;
#define LAS __attribute__((address_space(3)))
constexpr int NWAVES = 8, NTHREADS = 512;
constexpr int LDS_BYTES = 147456;

struct Args { const float* in[29]; float* out; unsigned char* ws; };

struct Ctx {
    const float* in[29]; float* out; unsigned char* ws; unsigned char* lds;
    int tid, lane, wave, gw, NGW, G, bid;
};

#define RLX_AGENT __ATOMIC_RELAXED, __HIP_MEMORY_SCOPE_AGENT
#define XB_TMO      128
#define XB_XCNT(j)  (256  + 64 * (j))
#define XB_XSUB(j)  (1280 + 64 * (j))
#define XB_XGEN(j)  (2304 + 64 * (j))
#define XB_TOP      3328
#define XB_TOPGEN   3392
#define XCD_BAR_WORDS 3456
#define XB_SPIN_CAP (1u << 18)

__device__ __forceinline__ unsigned xb_ld(unsigned* p)              { return __hip_atomic_load(p, __ATOMIC_RELAXED, __HIP_MEMORY_SCOPE_AGENT); }
__device__ __forceinline__ unsigned xb_add(unsigned* p, unsigned v) { return __hip_atomic_fetch_add(p, v, __ATOMIC_RELAXED, __HIP_MEMORY_SCOPE_AGENT); }
__device__ __forceinline__ unsigned xb_xcc_id() { return (unsigned)__builtin_amdgcn_s_getreg((3 << 11) | 20) & 0xFu; }
#define XB_SPIN(cond, bar) do { unsigned _sp = 0; while (cond) { __builtin_amdgcn_s_sleep(1); \
    if ((++_sp & 255u) == 0u) { if (xb_ld(&(bar)[XB_TMO])) break; if (_sp > XB_SPIN_CAP) { atomicAdd(&(bar)[XB_TMO], 1u); break; } } } } while (0)

struct XcdBarrier {
    unsigned* bar; unsigned x;
    volatile LAS unsigned* st;
};

__device__ __forceinline__ XcdBarrier xcd_barrier_post(unsigned* bar, volatile LAS unsigned* st) {
    XcdBarrier b; b.bar = bar; b.x = xb_xcc_id(); b.st = st;
    if (threadIdx.x == 0) (void)xb_add(&bar[XB_XCNT(b.x)], 1u);
    return b;
}
__device__ __forceinline__ void xcd_barrier_complete(unsigned* bar, unsigned x, unsigned& nloc, unsigned& nx) {
    const unsigned G = gridDim.x * gridDim.y * gridDim.z;
    unsigned sum, cnt, mine, sp = 0u;
    for (;;) {
        sum = 0u; cnt = 0u; mine = 0u;
#pragma unroll
        for (unsigned j = 0; j < 16; ++j) { const unsigned c = xb_ld(&bar[XB_XCNT(j)]); sum += c; cnt += (c > 0u) ? 1u : 0u; mine = (j == x) ? c : mine; }
        if (sum == G) break;
        __builtin_amdgcn_s_sleep(1);
        if ((++sp & 255u) == 0u) { if (xb_ld(&bar[XB_TMO])) break; if (sp > XB_SPIN_CAP) { atomicAdd(&bar[XB_TMO], 1u); break; } }
    }
    nloc = mine > 0u ? mine : 1u; nx = cnt > 0u ? cnt : 1u;
}

__device__ __forceinline__ void xcd_barrier(const XcdBarrier& b) {
    asm volatile("s_waitcnt vmcnt(0)" ::: "memory");
    __syncthreads();
    if (threadIdx.x == 0) {
        unsigned* bar = b.bar;
        __builtin_amdgcn_s_waitcnt(0);
        unsigned nloc = b.st[0], nx = b.st[1];
        if (nloc == 0u) { xcd_barrier_complete(bar, b.x, nloc, nx); b.st[0] = nloc; b.st[1] = nx; }
        const unsigned old = xb_add(&bar[XB_XSUB(b.x)], 1u);
        const unsigned gen = old / nloc;
        if (old + 1u == (gen + 1u) * nloc) {
            __builtin_amdgcn_fence(__ATOMIC_RELEASE, "agent");
            asm volatile("s_waitcnt vmcnt(0)" ::: "memory");
            const unsigned og = xb_add(&bar[XB_TOP], 1u);
            const unsigned tg = og / nx;
            if (og + 1u == (tg + 1u) * nx) xb_add(&bar[XB_TOPGEN], 1u);
            else XB_SPIN(xb_ld(&bar[XB_TOPGEN]) == tg, bar);
            __builtin_amdgcn_fence(__ATOMIC_ACQUIRE, "agent");
            xb_add(&bar[XB_XGEN(b.x)], 1u);
            asm volatile("s_waitcnt vmcnt(0)" ::: "memory");
        } else {
            XB_SPIN(xb_ld(&bar[XB_XGEN(b.x)]) == gen, bar);
            __builtin_amdgcn_fence(__ATOMIC_ACQUIRE, "agent");
            asm volatile("s_waitcnt vmcnt(0)" ::: "memory");
        }
    }
    __syncthreads();
}
namespace pg8 {
#define PG8_LAS __attribute__((address_space(3)))
constexpr int BM = 256, BK = 64, HALF = 128, HTB = HALF * BK * 2  , STAGE_BYTES = 8 * HTB, NXCD = 8, WGM = 4;
__host__ __device__ __forceinline__ int lds_byte(int r, int c) { const int st = (r >> 4) * 2 + (c >> 5), rr = r & 15, cc = c & 31, ob = rr * 64 + cc * 2; return st * 1024 + (ob ^ (((ob >> 9) & 1) << 5)); }
__host__ __device__ __forceinline__ void stage_rc(int b, int& R, int& C) { const int st = b / 1024, sb = b % 1024, swz = sb ^ (((sb >> 9) & 1) << 5); R = (st >> 1) * 16 + swz / 64; C = (st & 1) * 32 + (swz % 64) / 2; }
__host__ __device__ __forceinline__ int perm32(int rho) { const int n = rho >> 4, i = rho & 15; return 8 * (i >> 2) + 4 * n + (i & 3); }

struct Unit { int pm, pn; };
struct Gemm { int lda, ldb, K; };
struct DenseOrder {
    const bf16_t* A; const bf16_t* Bt; int lda, ldb; int nM, nN, nwg, G, c; int ntk = D / BK;
    __device__ __forceinline__ int nt(const Unit&) const { return ntk; }
    __device__ __forceinline__ void init(const bf16_t* A_, int lda_, const bf16_t* Bt_, int ldb_, int M, int N, int G_, int c_) { A = A_; Bt = Bt_; lda = lda_; ldb = ldb_; nM = M / BM; nN = N / BM; nwg = nM * nN; G = G_; c = c_; }
    __device__ __forceinline__ bool next(int i, Unit& u) const {
        const long L = (long)i * G + c; if (L >= nwg) return false;
        int wgid = (int)L; { const int q = nwg / NXCD, r = nwg % NXCD, xcd = wgid % NXCD, off = wgid / NXCD; wgid = (xcd < r ? xcd * (q + 1) : r * (q + 1) + (xcd - r) * q) + off; }
        const int nig = WGM * nN, gid = wgid / nig, fm = gid * WGM, gsz = (nM - fm) < WGM ? (nM - fm) : WGM;
        u.pm = fm + ((wgid % nig) % gsz); u.pn = (wgid % nig) / gsz; return true;
    }
    __device__ __forceinline__ void ptrs(const Unit& u, const char*& a, const char*& b0, const char*& b1) const {
        a = (const char*)A + (size_t)u.pm * BM * lda * 2; b0 = (const char*)Bt + (size_t)u.pn * BM * ldb * 2; b1 = b0 + (size_t)HALF * ldb * 2; }
};

__device__ __forceinline__ unsigned cvt_pk_bf16(float lo, float hi) { unsigned r; asm volatile("v_cvt_pk_bf16_f32 %0, %1, %2" : "=v"(r) : "v"(lo), "v"(hi)); return r; }

template <class Epi, class Sched, bool ALIGN_EPI>
__device__ __forceinline__ void gemm_phase(PG8_LAS unsigned char* lds, const Gemm g, const Sched& S, const Epi& E) {
    int tid_ = threadIdx.x; asm volatile("" : "+v"(tid_));
    const int tid = tid_, wid = __builtin_amdgcn_readfirstlane(tid >> 6), lane = tid & 63, wr = wid >> 2, wc = wid & 3, fr = lane & 15, fq = lane >> 4;
    unsigned voffA[2], voffB[2];
#pragma unroll
    for (int i = 0; i < 2; ++i) { int R, C; stage_rc(tid * 16 + i * 8192, R, C); const int Rb = Epi::PERM ? ((R & ~31) + perm32(R & 31)) : R;
        voffA[i] = (unsigned)(R * g.lda + C) * 2u; voffB[i] = (unsigned)(Rb * g.ldb + C) * 2u; }
    const size_t kstep = (size_t)(BK * 2);
    const size_t hstepA = (size_t)HALF * g.lda * 2;
    const unsigned ldsw = (unsigned)wid * 1024u;
    const int aoff = lds_byte(wr * 64 + fr, fq * 8), boff = lds_byte(wc * 32 + fr, fq * 8);
#define PG8_SA(b, h) (((b) * 2 + (h)) * HTB)
#define PG8_SB(b, h) ((4 + (b) * 2 + (h)) * HTB)
#define PG8_STAGE(bufoff, gbase, voff) do { _Pragma("unroll") for (int _i = 0; _i < 2; ++_i) \
        __builtin_amdgcn_global_load_lds((const unsigned*)((const char*)(gbase) + (voff)[_i]), (PG8_LAS unsigned*)(lds + (bufoff) + ldsw + _i * 8192), 16, 0, 0); } while (0)
#define PG8_LDA(dst, b, h) do { _Pragma("unroll") for (int m = 0; m < 4; ++m) _Pragma("unroll") for (int k = 0; k < 2; ++k) dst[m][k] = *(const PG8_LAS bf16x8*)(lds + PG8_SA(b, h) + aoff + m * 2048 + k * 1024); } while (0)
#define PG8_LDB(dst, b, h) do { _Pragma("unroll") for (int n = 0; n < 2; ++n) _Pragma("unroll") for (int k = 0; k < 2; ++k) dst[n][k] = *(const PG8_LAS bf16x8*)(lds + PG8_SB(b, h) + boff + n * 2048 + k * 1024); } while (0)
#define PG8_MMA(ai, bj, At, Bt) do { __builtin_amdgcn_s_setprio(1); _Pragma("unroll") for (int m = 0; m < 4; ++m) _Pragma("unroll") for (int n = 0; n < 2; ++n) _Pragma("unroll") for (int k = 0; k < 2; ++k) \
        acc[ai][bj][m][n] = __builtin_amdgcn_mfma_f32_16x16x32_bf16(Bt[n][k], At[m][k], acc[ai][bj][m][n], 0, 0, 0); __builtin_amdgcn_s_setprio(0); } while (0)
#define PG8_WAIT_V(n) asm volatile("s_waitcnt vmcnt(" #n ")" ::: "memory")
#define PG8_WAIT_L(n) asm volatile("s_waitcnt lgkmcnt(" #n ")" ::: "memory")
#define PG8_BAR __builtin_amdgcn_s_barrier()
#define PG8_SCHED __builtin_amdgcn_sched_barrier(0)
    Unit cur, nxt; int ui = 0;
    if (!S.next(0, cur)) return;
    f32x4 acc[2][2][4][2];
#pragma unroll
    for (int a = 0; a < 2; ++a)
#pragma unroll
        for (int b = 0; b < 2; ++b)
#pragma unroll
            for (int m = 0; m < 4; ++m)
#pragma unroll
                for (int n = 0; n < 2; ++n) acc[a][b][m][n] = (f32x4){0.f, 0.f, 0.f, 0.f};
    bf16x8 At[4][2], B0[2][2], B1[2][2];
    const char *cA, *cB0, *cB1; S.ptrs(cur, cA, cB0, cB1);
    int nt = S.nt(cur); asm volatile("" : "+s"(nt));
    PG8_STAGE(PG8_SB(0, 0), cB0, voffB); PG8_STAGE(PG8_SB(0, 1), cB1, voffB); PG8_STAGE(PG8_SA(0, 0), cA, voffA); PG8_STAGE(PG8_SA(0, 1), cA + hstepA, voffA);
    if (wr == 1) PG8_BAR;
    PG8_WAIT_V(2); PG8_BAR;
    PG8_STAGE(PG8_SB(1, 0), cB0 + kstep, voffB); PG8_STAGE(PG8_SA(1, 0), cA + kstep, voffA); PG8_STAGE(PG8_SB(1, 1), cB1 + kstep, voffB);
    PG8_WAIT_V(6); PG8_BAR;
    for (;;) {
        const bool has_next = S.next(ui + 1, nxt);
        const char *nA = cA, *nB0 = cB0, *nB1 = cB1; if (has_next) S.ptrs(nxt, nA, nB0, nB1);
#pragma unroll 1
        for (int t = 0; t < nt; t += 2) {
            const bool last = (t == nt - 2);
            if constexpr (Epi::HAS_MID) { if (t == E.mid_t) E.mid(acc, cur, wr, wc, fr, fq); }
            const char* a1 = cA + (size_t)(t + 1) * kstep;
            const char* a2 = last ? nA : cA + (size_t)(t + 2) * kstep; const char* b2 = last ? nB0 : cB0 + (size_t)(t + 2) * kstep; const char* b2h = last ? nB1 : cB1 + (size_t)(t + 2) * kstep;
            const char* a3 = a2 + kstep; const char* b3 = b2 + kstep; const char* b3h = b2h + kstep;
            PG8_LDB(B0, 0, 0); PG8_LDB(B1, 0, 1); PG8_SCHED; PG8_LDA(At, 0, 0); PG8_STAGE(PG8_SA(1, 1), a1 + hstepA, voffA);
            PG8_WAIT_V(8); PG8_WAIT_L(0); PG8_BAR; PG8_MMA(0, 0, At, B0); PG8_MMA(0, 1, At, B1); PG8_BAR; PG8_SCHED;
            PG8_LDA(At, 0, 1); PG8_STAGE(PG8_SB(0, 0), b2, voffB); PG8_STAGE(PG8_SB(0, 1), b2h, voffB); PG8_STAGE(PG8_SA(0, 0), a2, voffA);
            PG8_WAIT_V(8); PG8_WAIT_L(0); PG8_BAR; PG8_MMA(1, 0, At, B0); PG8_MMA(1, 1, At, B1); PG8_BAR; PG8_SCHED;
            PG8_LDB(B0, 1, 0); PG8_LDB(B1, 1, 1); PG8_SCHED; PG8_LDA(At, 1, 0); PG8_STAGE(PG8_SA(0, 1), a2 + hstepA, voffA);
            PG8_WAIT_V(8); PG8_WAIT_L(0); PG8_BAR; PG8_MMA(0, 0, At, B0); PG8_MMA(0, 1, At, B1); PG8_BAR; PG8_SCHED;
            PG8_LDA(At, 1, 1); PG8_STAGE(PG8_SB(1, 0), b3, voffB); PG8_STAGE(PG8_SB(1, 1), b3h, voffB); PG8_STAGE(PG8_SA(1, 0), a3, voffA);
            PG8_WAIT_V(8); PG8_WAIT_L(0); PG8_BAR; PG8_MMA(1, 0, At, B0); PG8_MMA(1, 1, At, B1); PG8_BAR; PG8_SCHED;
        }
        if constexpr (ALIGN_EPI) { if (wr == 0) PG8_BAR; }
        E(acc, cur, wr, wc, fr, fq);
        if (!has_next) break;
#pragma unroll
        for (int a = 0; a < 2; ++a)
#pragma unroll
            for (int b = 0; b < 2; ++b)
#pragma unroll
                for (int m = 0; m < 4; ++m)
#pragma unroll
                    for (int n = 0; n < 2; ++n) acc[a][b][m][n] = (f32x4){0.f, 0.f, 0.f, 0.f};
        cur = nxt; cA = nA; cB0 = nB0; cB1 = nB1; ++ui; nt = S.nt(cur); asm volatile("" : "+s"(nt));
        if constexpr (ALIGN_EPI) { if (wr == 1) PG8_BAR; }
    }
    PG8_WAIT_V(0);
    if constexpr (!ALIGN_EPI) { if (wr == 0) PG8_BAR; }
    PG8_BAR;
#undef PG8_SA
#undef PG8_SB
#undef PG8_STAGE
#undef PG8_LDA
#undef PG8_LDB
#undef PG8_MMA
#undef PG8_WAIT_V
#undef PG8_WAIT_L
#undef PG8_BAR
#undef PG8_SCHED
}

template <class Epi, class Sched, bool ALIGN_EPI>
__device__ __forceinline__ void gemm_phase_gather(PG8_LAS unsigned char* lds, const Gemm g, const Sched& S, const Epi& E) {
    int tid_ = threadIdx.x; asm volatile("" : "+v"(tid_));
    const int tid = tid_, wid = __builtin_amdgcn_readfirstlane(tid >> 6), lane = tid & 63, wr = wid >> 2, wc = wid & 3, fr = lane & 15, fq = lane >> 4;
    unsigned voffB[2], vAc[2][2], vAn[2][2];
#pragma unroll
    for (int i = 0; i < 2; ++i) { int R, C; stage_rc(tid * 16 + i * 8192, R, C); const int Rb = Epi::PERM ? ((R & ~31) + perm32(R & 31)) : R;
        voffB[i] = (unsigned)(Rb * g.ldb + C) * 2u; }
#define PG8_LOADVA(v, ui_) do { _Pragma("unroll") for (int h_ = 0; h_ < 2; ++h_) _Pragma("unroll") for (int i_ = 0; i_ < 2; ++i_) { int R_, C_; stage_rc(tid * 16 + i_ * 8192, R_, C_); \
        v[h_][i_] = S.aoff(ui_, h_ * HALF + R_) + (unsigned)C_ * 2u; } } while (0)
    const size_t kstep = (size_t)(BK * 2);
    const unsigned ldsw = (unsigned)wid * 1024u;
    const int aoff = lds_byte(wr * 64 + fr, fq * 8), boff = lds_byte(wc * 32 + fr, fq * 8);
#define PG8_SA(b, h) (((b) * 2 + (h)) * HTB)
#define PG8_SB(b, h) ((4 + (b) * 2 + (h)) * HTB)
#define PG8_STAGE(bufoff, gbase, voff) do { _Pragma("unroll") for (int _i = 0; _i < 2; ++_i) \
        __builtin_amdgcn_global_load_lds((const unsigned*)((const char*)(gbase) + (voff)[_i]), (PG8_LAS unsigned*)(lds + (bufoff) + ldsw + _i * 8192), 16, 0, 0); } while (0)
#define PG8_LDA(dst, b, h) do { _Pragma("unroll") for (int m = 0; m < 4; ++m) _Pragma("unroll") for (int k = 0; k < 2; ++k) dst[m][k] = *(const PG8_LAS bf16x8*)(lds + PG8_SA(b, h) + aoff + m * 2048 + k * 1024); } while (0)
#define PG8_LDB(dst, b, h) do { _Pragma("unroll") for (int n = 0; n < 2; ++n) _Pragma("unroll") for (int k = 0; k < 2; ++k) dst[n][k] = *(const PG8_LAS bf16x8*)(lds + PG8_SB(b, h) + boff + n * 2048 + k * 1024); } while (0)
#define PG8_MMA(ai, bj, At, Bt) do { __builtin_amdgcn_s_setprio(1); _Pragma("unroll") for (int m = 0; m < 4; ++m) _Pragma("unroll") for (int n = 0; n < 2; ++n) _Pragma("unroll") for (int k = 0; k < 2; ++k) \
        acc[ai][bj][m][n] = __builtin_amdgcn_mfma_f32_16x16x32_bf16(Bt[n][k], At[m][k], acc[ai][bj][m][n], 0, 0, 0); __builtin_amdgcn_s_setprio(0); } while (0)
#define PG8_WAIT_V(n) asm volatile("s_waitcnt vmcnt(" #n ")" ::: "memory")
#define PG8_WAIT_L(n) asm volatile("s_waitcnt lgkmcnt(" #n ")" ::: "memory")
#define PG8_BAR __builtin_amdgcn_s_barrier()
#define PG8_SCHED __builtin_amdgcn_sched_barrier(0)
    Unit cur, nxt; int ui = 0;
    if (!S.next(0, cur)) return;
    f32x4 acc[2][2][4][2];
#pragma unroll
    for (int a = 0; a < 2; ++a)
#pragma unroll
        for (int b = 0; b < 2; ++b)
#pragma unroll
            for (int m = 0; m < 4; ++m)
#pragma unroll
                for (int n = 0; n < 2; ++n) acc[a][b][m][n] = (f32x4){0.f, 0.f, 0.f, 0.f};
    bf16x8 At[4][2], B0[2][2], B1[2][2];
    const char *cA, *cB0, *cB1; S.ptrs(cur, cA, cB0, cB1);
    PG8_LOADVA(vAc, 0);
    int nt = S.nt(cur); asm volatile("" : "+s"(nt));
    PG8_STAGE(PG8_SB(0, 0), cB0, voffB); PG8_STAGE(PG8_SB(0, 1), cB1, voffB); PG8_STAGE(PG8_SA(0, 0), cA, vAc[0]); PG8_STAGE(PG8_SA(0, 1), cA, vAc[1]);
    if (wr == 1) PG8_BAR;
    PG8_WAIT_V(2); PG8_BAR;
    PG8_STAGE(PG8_SB(1, 0), cB0 + kstep, voffB); PG8_STAGE(PG8_SA(1, 0), cA + kstep, vAc[0]); PG8_STAGE(PG8_SB(1, 1), cB1 + kstep, voffB);
    PG8_WAIT_V(6); PG8_BAR;
    for (;;) {
        const bool has_next = S.next(ui + 1, nxt);
        const char *nA = cA, *nB0 = cB0, *nB1 = cB1; if (has_next) { S.ptrs(nxt, nA, nB0, nB1); PG8_LOADVA(vAn, ui + 1); } else { _Pragma("unroll") for (int h_ = 0; h_ < 2; ++h_) _Pragma("unroll") for (int i_ = 0; i_ < 2; ++i_) vAn[h_][i_] = vAc[h_][i_]; }
#pragma unroll 1
        for (int t = 0; t < nt; t += 2) {
            const bool last = (t == nt - 2);
            if constexpr (Epi::HAS_MID) { if (t == E.mid_t) E.mid(acc, cur, wr, wc, fr, fq); }
            const char* a1 = cA + (size_t)(t + 1) * kstep;
            const char* a2 = cA + (size_t)(last ? 0 : t + 2) * kstep; unsigned vs0[2], vs1[2]; vs0[0] = last ? vAn[0][0] : vAc[0][0]; vs0[1] = last ? vAn[0][1] : vAc[0][1]; vs1[0] = last ? vAn[1][0] : vAc[1][0]; vs1[1] = last ? vAn[1][1] : vAc[1][1]; const char* b2 = last ? nB0 : cB0 + (size_t)(t + 2) * kstep; const char* b2h = last ? nB1 : cB1 + (size_t)(t + 2) * kstep;
            const char* a3 = a2 + kstep; const char* b3 = b2 + kstep; const char* b3h = b2h + kstep;
            PG8_LDB(B0, 0, 0); PG8_LDB(B1, 0, 1); PG8_SCHED; PG8_LDA(At, 0, 0); PG8_STAGE(PG8_SA(1, 1), a1, vAc[1]);
            PG8_WAIT_V(8); PG8_WAIT_L(0); PG8_BAR; PG8_MMA(0, 0, At, B0); PG8_MMA(0, 1, At, B1); PG8_BAR; PG8_SCHED;
            PG8_LDA(At, 0, 1); PG8_STAGE(PG8_SB(0, 0), b2, voffB); PG8_STAGE(PG8_SB(0, 1), b2h, voffB); PG8_STAGE(PG8_SA(0, 0), a2, vs0);
            PG8_WAIT_V(8); PG8_WAIT_L(0); PG8_BAR; PG8_MMA(1, 0, At, B0); PG8_MMA(1, 1, At, B1); PG8_BAR; PG8_SCHED;
            PG8_LDB(B0, 1, 0); PG8_LDB(B1, 1, 1); PG8_SCHED; PG8_LDA(At, 1, 0); PG8_STAGE(PG8_SA(0, 1), a2, vs1);
            PG8_WAIT_V(8); PG8_WAIT_L(0); PG8_BAR; PG8_MMA(0, 0, At, B0); PG8_MMA(0, 1, At, B1); PG8_BAR; PG8_SCHED;
            PG8_LDA(At, 1, 1); PG8_STAGE(PG8_SB(1, 0), b3, voffB); PG8_STAGE(PG8_SB(1, 1), b3h, voffB); PG8_STAGE(PG8_SA(1, 0), a3, vs0);
            PG8_WAIT_V(8); PG8_WAIT_L(0); PG8_BAR; PG8_MMA(1, 0, At, B0); PG8_MMA(1, 1, At, B1); PG8_BAR; PG8_SCHED;
        }
        if constexpr (ALIGN_EPI) { if (wr == 0) PG8_BAR; }
        E(acc, cur, wr, wc, fr, fq);
        if (!has_next) break;
#pragma unroll
        for (int a = 0; a < 2; ++a)
#pragma unroll
            for (int b = 0; b < 2; ++b)
#pragma unroll
                for (int m = 0; m < 4; ++m)
#pragma unroll
                    for (int n = 0; n < 2; ++n) acc[a][b][m][n] = (f32x4){0.f, 0.f, 0.f, 0.f};
        cur = nxt; cA = nA; cB0 = nB0; cB1 = nB1; ++ui;
#pragma unroll
        for (int h_ = 0; h_ < 2; ++h_)
#pragma unroll
            for (int i_ = 0; i_ < 2; ++i_) vAc[h_][i_] = vAn[h_][i_]; nt = S.nt(cur); asm volatile("" : "+s"(nt));
        if constexpr (ALIGN_EPI) { if (wr == 1) PG8_BAR; }
    }
    PG8_WAIT_V(0);
    if constexpr (!ALIGN_EPI) { if (wr == 0) PG8_BAR; }
    PG8_BAR;
#undef PG8_LOADVA
#undef PG8_SA
#undef PG8_SB
#undef PG8_STAGE
#undef PG8_LDA
#undef PG8_LDB
#undef PG8_MMA
#undef PG8_WAIT_V
#undef PG8_WAIT_L
#undef PG8_BAR
#undef PG8_SCHED
}


__device__ __forceinline__ float rstd16(const float* p) { const f32x4 a = ((const f32x4*)p)[0], b = ((const f32x4*)p)[1], c = ((const f32x4*)p)[2], d = ((const f32x4*)p)[3];
    const float s = ((a.x + a.y) + (a.z + a.w)) + ((b.x + b.y) + (b.z + b.w)) + ((c.x + c.y) + (c.z + c.w)) + ((d.x + d.y) + (d.z + d.w)); return __builtin_amdgcn_rsqf(s * (1.f / D) + EPS); }
__device__ __forceinline__ u32x4 pack8(const f32x4 v0, const f32x4 v1) { u32x4 w; w.x = cvt_pk_bf16(v0[0], v0[1]); w.y = cvt_pk_bf16(v0[2], v0[3]); w.z = cvt_pk_bf16(v1[0], v1[1]); w.w = cvt_pk_bf16(v1[2], v1[3]); return w; }
__device__ __forceinline__ float sq8(const f32x4 a, const f32x4 b) { return ((a[0] * a[0] + a[1] * a[1]) + (a[2] * a[2] + a[3] * a[3])) + ((b[0] * b[0] + b[1] * b[1]) + (b[2] * b[2] + b[3] * b[3])); }

struct EpiInProjF {
    static constexpr bool PERM = true, HAS_MID = false; int mid_t;
    const float* rstd0; bf16_t *XR, *GG, *Qs, *Ks, *Vs;
    __device__ __forceinline__ void mid(f32x4 (&)[2][2][4][2], const Unit&, int, int, int, int) const {}
    __device__ __forceinline__ void operator()(const f32x4 (&acc)[2][2][4][2], const Unit& u, int wr, int wc, int fr, int fq) const {
        const int row0 = u.pm * BM + wr * 64 + fr, t = u.pn >> 1, colt = (u.pn & 1) * 256 + wc * 32 + 8 * fq;
        bf16_t* base = (t == 0) ? XR : (t == 1) ? GG : (t == 2) ? Qs : (t == 3) ? Ks : Vs;
#pragma unroll
        for (int ai = 0; ai < 2; ++ai)
#pragma unroll
            for (int m = 0; m < 4; ++m) { const int r = row0 + ai * HALF + m * 16; const float rs = rstd0[r]; bf16_t* rowp = base + (size_t)r * 512 + colt;
#pragma unroll
                for (int bj = 0; bj < 2; ++bj) { f32x4 v0 = acc[ai][bj][m][0] * rs, v1 = acc[ai][bj][m][1] * rs;
                    if (t == 1) {
#pragma unroll
                        for (int e = 0; e < 4; ++e) { v0[e] = gelu_tanh(v0[e]); v1[e] = gelu_tanh(v1[e]); } }
                    else if (t == 2) { v0 = v0 * (0.125f * LOG2E); v1 = v1 * (0.125f * LOG2E); }
                    *(u32x4*)(rowp + bj * HALF) = pack8(v0, v1); } }
    }
};
struct EpiBf16F {
    static constexpr bool PERM = true, HAS_MID = false; int mid_t;
    bf16_t* O; const float* ssq16; int ldo; float scale; size_t tstride;
    __device__ __forceinline__ void mid(f32x4 (&)[2][2][4][2], const Unit&, int, int, int, int) const {}
    __device__ __forceinline__ void operator()(const f32x4 (&acc)[2][2][4][2], const Unit& u, int wr, int wc, int fr, int fq) const {
        const int row0 = u.pm * BM + wr * 64 + fr, col0 = (tstride ? 0 : u.pn * BM) + wc * 32 + 8 * fq; bf16_t* base = O + (size_t)u.pn * tstride;
#pragma unroll
        for (int ai = 0; ai < 2; ++ai)
#pragma unroll
            for (int m = 0; m < 4; ++m) { const int r = row0 + ai * HALF + m * 16; const float rs = (ssq16 ? rstd16(ssq16 + (size_t)r * 16) : 1.f) * scale; bf16_t* rowp = base + (size_t)r * ldo + col0;
#pragma unroll
                for (int bj = 0; bj < 2; ++bj) *(u32x4*)(rowp + bj * HALF) = pack8(acc[ai][bj][m][0] * rs, acc[ai][bj][m][1] * rs); }
    }
};
struct EpiX1F {
    static constexpr bool PERM = true, HAS_MID = true; int mid_t;
    const bf16_t* xb; const float* fmid; const float* fend; bf16_t* X1b; float* ssq1;
    __device__ __forceinline__ void mid(f32x4 (&acc)[2][2][4][2], const Unit& u, int wr, int wc, int fr, int fq) const {
        const int row0 = u.pm * BM + wr * 64 + fr;
#pragma unroll
        for (int ai = 0; ai < 2; ++ai)
#pragma unroll
            for (int m = 0; m < 4; ++m) { const float f = fmid[row0 + ai * HALF + m * 16];
#pragma unroll
                for (int bj = 0; bj < 2; ++bj) { acc[ai][bj][m][0] = acc[ai][bj][m][0] * f; acc[ai][bj][m][1] = acc[ai][bj][m][1] * f; } }
    }
    __device__ __forceinline__ void operator()(const f32x4 (&acc)[2][2][4][2], const Unit& u, int wr, int wc, int fr, int fq) const {
        const int row0 = u.pm * BM + wr * 64 + fr, col0 = u.pn * BM + wc * 32 + 8 * fq;
#pragma unroll
        for (int ai = 0; ai < 2; ++ai)
#pragma unroll
            for (int m = 0; m < 4; ++m) { const int r = row0 + ai * HALF + m * 16; const float fe = fend[r]; float ss = 0.f;
#pragma unroll
                for (int bj = 0; bj < 2; ++bj) { const u32x4 xi = *(const u32x4*)(xb + (size_t)r * D + col0 + bj * HALF);
                    f32x4 v0, v1; v0[0] = __uint_as_float(xi.x << 16); v0[1] = __uint_as_float(xi.x & 0xffff0000u); v0[2] = __uint_as_float(xi.y << 16); v0[3] = __uint_as_float(xi.y & 0xffff0000u);
                    v1[0] = __uint_as_float(xi.z << 16); v1[1] = __uint_as_float(xi.z & 0xffff0000u); v1[2] = __uint_as_float(xi.w << 16); v1[3] = __uint_as_float(xi.w & 0xffff0000u);
                    v0 = v0 + acc[ai][bj][m][0] * fe; v1 = v1 + acc[ai][bj][m][1] * fe;
                    ss += sq8(v0, v1); *(u32x4*)(X1b + (size_t)r * D + col0 + bj * HALF) = pack8(v0, v1); }
                ss += __shfl_xor(ss, 16); ss += __shfl_xor(ss, 32);
                if (fq == 0) ssq1[(size_t)r * 16 + u.pn * 4 + wc] = ss; }
    }
};
struct EpiResF {
    static constexpr bool PERM = true, HAS_MID = false; int mid_t;
    const bf16_t* Xi; bf16_t* Xo; float* ssq;
    __device__ __forceinline__ void mid(f32x4 (&)[2][2][4][2], const Unit&, int, int, int, int) const {}
    __device__ __forceinline__ void operator()(const f32x4 (&acc)[2][2][4][2], const Unit& u, int wr, int wc, int fr, int fq) const {
        const int row0 = u.pm * BM + wr * 64 + fr, col0 = u.pn * BM + wc * 32 + 8 * fq;
#pragma unroll
        for (int ai = 0; ai < 2; ++ai)
#pragma unroll
            for (int m = 0; m < 4; ++m) { const int r = row0 + ai * HALF + m * 16; float ss = 0.f;
#pragma unroll
                for (int bj = 0; bj < 2; ++bj) { const u32x4 xi = *(const u32x4*)(Xi + (size_t)r * D + col0 + bj * HALF);
                    f32x4 v0, v1; v0[0] = __uint_as_float(xi.x << 16); v0[1] = __uint_as_float(xi.x & 0xffff0000u); v0[2] = __uint_as_float(xi.y << 16); v0[3] = __uint_as_float(xi.y & 0xffff0000u);
                    v1[0] = __uint_as_float(xi.z << 16); v1[1] = __uint_as_float(xi.z & 0xffff0000u); v1[2] = __uint_as_float(xi.w << 16); v1[3] = __uint_as_float(xi.w & 0xffff0000u);
                    v0 = v0 + acc[ai][bj][m][0]; v1 = v1 + acc[ai][bj][m][1];
                    ss += sq8(v0, v1); *(u32x4*)(Xo + (size_t)r * D + col0 + bj * HALF) = pack8(v0, v1); }
                ss += __shfl_xor(ss, 16); ss += __shfl_xor(ss, 32);
                if (fq == 0) ssq[(size_t)r * 16 + u.pn * 4 + wc] = ss; }
    }
};

__device__ __forceinline__ void pair_ab(int p, int& a, int& b) { a = (p < 3) ? 0 : (p < 5) ? 1 : 2; b = (p < 3) ? p + 1 : (p < 5) ? p - 1 : 3; }
__device__ __forceinline__ int moe_class_of_tile(const PG8_LAS int* meta, int T) { int c = 0;
#pragma unroll
    for (int k = 1; k < 24; ++k) c += (T >= __builtin_amdgcn_readfirstlane(meta[64 + k])) ? 1 : 0;
    return c; }
struct MoeOrder2 {
    __device__ __forceinline__ int nt(const Unit&) const { return 512 / BK; }
    const bf16_t* HID; const bf16_t* Wd2; const PG8_LAS int* meta; int G, c;
    __device__ __forceinline__ bool next(int i, Unit& u) const { const int nt = __builtin_amdgcn_readfirstlane(meta[64 + 24]);
        const int x = c % NXCD, y = c / NXCD, T = i * (G / 4) + x * (G / 32) + (y >> 2); if (T >= nt) return false;
        u.pm = T; u.pn = moe_class_of_tile(meta, T) * 4 + (y & 3); return true; }
    __device__ __forceinline__ void ptrs(const Unit& u, const char*& a, const char*& b0, const char*& b1) const {
        a = (const char*)HID + (size_t)u.pm * BM * 512 * 2; b0 = (const char*)Wd2 + ((size_t)(u.pn >> 2) * D + (u.pn & 3) * BM) * 512 * 2; b1 = b0 + (size_t)HALF * 512 * 2; }
};
struct MoeOrder1G {
    const bf16_t* X2b; const bf16_t* Wg; const bf16_t* Wu; const PG8_LAS int* meta; const PG8_LAS int* tokl; unsigned zoff; int G, c;
    __device__ __forceinline__ int nt(const Unit&) const { return D / BK; }
    __device__ __forceinline__ bool next(int i, Unit& u) const { int L = i * G + c; const int nwg = __builtin_amdgcn_readfirstlane(meta[64 + 24]) * 4; if (L >= nwg) return false;
        { const int q = nwg / NXCD, r = nwg % NXCD, xcd = L % NXCD, off = L / NXCD; L = (xcd < r ? xcd * (q + 1) : r * (q + 1) + (xcd - r) * q) + off; }
        u.pm = L >> 2; u.pn = (moe_class_of_tile(meta, L >> 2) * 4 + (L & 3)) | (i << 16); return true; }
    __device__ __forceinline__ unsigned aoff(int ui, int row) const { const int tok = tokl[ui * BM + row]; return tok >= 0 ? (unsigned)tok * (unsigned)(D * 2) : zoff; }
    __device__ __forceinline__ void ptrs(const Unit& u, const char*& a, const char*& b0, const char*& b1) const {
        const int pn = u.pn & 0xffff, cls = pn >> 2, j = (pn >> 1) & 1, half = pn & 1; int ea, eb; pair_ab(cls % 6, ea, eb); const int e = (cls / 6) * 4 + (j ? eb : ea);
        a = (const char*)X2b; const size_t bo = ((size_t)e * DE + half * HALF) * D * 2; b0 = (const char*)Wg + bo; b1 = (const char*)Wu + bo; }
};
struct EpiMoeUpG {
    static constexpr bool PERM = true, HAS_MID = false; int mid_t;
    const PG8_LAS int* tokl; const float* rstok; const float* selw; bf16_t* HID;
    __device__ __forceinline__ void mid(f32x4 (&)[2][2][4][2], const Unit&, int, int, int, int) const {}
    __device__ __forceinline__ void operator()(const f32x4 (&acc)[2][2][4][2], const Unit& u, int wr, int wc, int fr, int fq) const {
        const int pn = u.pn & 0xffff, ui = u.pn >> 16, j = (pn >> 1) & 1, col0 = j * 256 + (pn & 1) * HALF + wc * 32 + 8 * fq, rl0 = wr * 64 + fr;
#pragma unroll
        for (int ai = 0; ai < 2; ++ai)
#pragma unroll
            for (int m = 0; m < 4; ++m) { const int rl = rl0 + ai * HALF + m * 16, tok = tokl[ui * BM + rl]; float rs = 0.f, w = 0.f; if (tok >= 0) { rs = rstok[tok]; w = selw[(size_t)tok * 2 + j]; } f32x4 h0, h1;
#pragma unroll
                for (int e = 0; e < 4; ++e) { const float g0 = acc[ai][0][m][0][e] * rs, g1 = acc[ai][0][m][1][e] * rs;
                    h0[e] = g0 * __builtin_amdgcn_rcpf(1.f + __expf(-g0)) * (acc[ai][1][m][0][e] * rs) * w; h1[e] = g1 * __builtin_amdgcn_rcpf(1.f + __expf(-g1)) * (acc[ai][1][m][1][e] * rs) * w; }
                *(u32x4*)(HID + (size_t)(u.pm * BM + rl) * 512 + col0) = pack8(h0, h1); }
    }
};
struct XaPreOrder {
    const bf16_t* KM; const bf16_t* VM; const bf16_t* WqN; const bf16_t* Wo_t; int G, c;
    __device__ __forceinline__ bool next(int i, Unit& u) const { const int L = i * G + c; if (L >= 256) return false; u.pm = 0; u.pn = L; return true; }
    __device__ __forceinline__ int nt(const Unit&) const { return XD / BK; }
    __device__ __forceinline__ void ptrs(const Unit& u, const char*& a, const char*& b0, const char*& b1) const {
        const int L = u.pn, h = L & 3;
        if (L < 128) { const int b = L >> 4, kt = (L >> 2) & 3; a = (const char*)KM + ((size_t)b * MEM * D + h * XD) * 2; b0 = (const char*)WqN + ((size_t)kt * BM * D + h * XD) * 2; }
        else { const int nt_ = (L >> 5) & 3, b = (L >> 2) & 7; a = (const char*)Wo_t + ((size_t)nt_ * BM * D + h * XD) * 2; b0 = (const char*)VM + ((size_t)b * MEM * D + h * XD) * 2; }
        b1 = b0 + (size_t)HALF * D * 2; }
};
struct EpiXaPre {
    static constexpr bool PERM = true, HAS_MID = false; int mid_t;
    bf16_t* MT; bf16_t* NT;
    __device__ __forceinline__ void mid(f32x4 (&)[2][2][4][2], const Unit&, int, int, int, int) const {}
    __device__ __forceinline__ void operator()(const f32x4 (&acc)[2][2][4][2], const Unit& u, int wr, int wc, int fr, int fq) const {
        const int L = u.pn, h = L & 3, cw = wc * 32 + 8 * fq; bf16_t* base;
        if (L < 128) { const int b = L >> 4, kt = (L >> 2) & 3; base = MT + ((size_t)b * D + h * XD) * D + kt * BM; }
        else { const int nt_ = (L >> 5) & 3, b = (L >> 2) & 7; base = NT + ((size_t)b * D + nt_ * BM) * D + h * XD; }
#pragma unroll
        for (int ai = 0; ai < 2; ++ai)
#pragma unroll
            for (int m = 0; m < 4; ++m) { bf16_t* rowp = base + (size_t)(ai * HALF + wr * 64 + m * 16 + fr) * D + cw;
#pragma unroll
                for (int bj = 0; bj < 2; ++bj) *(u32x4*)(rowp + bj * HALF) = pack8(acc[ai][bj][m][0], acc[ai][bj][m][1]); }
    }
};
struct BatchedOrder {
    const bf16_t* A; const bf16_t* W; int G, c;
    __device__ __forceinline__ bool next(int i, Unit& u) const { int L = i * G + c; if (L >= (NTOK / BM) * 4) return false;
        L = (L % NXCD) * ((NTOK / BM) * 4 / NXCD) + L / NXCD;
        u.pm = L >> 2; u.pn = L & 3; return true; }
    __device__ __forceinline__ int nt(const Unit&) const { return D / BK; }
    __device__ __forceinline__ void ptrs(const Unit& u, const char*& a, const char*& b0, const char*& b1) const {
        const int b = u.pm / (SEQ / BM); a = (const char*)A + (size_t)u.pm * BM * D * 2; b0 = (const char*)W + ((size_t)b * D + u.pn * BM) * D * 2; b1 = b0 + (size_t)HALF * D * 2; }
};
struct EpiXaSoftmax {
    static constexpr bool PERM = true, HAS_MID = false; int mid_t;
    bf16_t* P; const float* ssq1; float qscale; PG8_LAS float* xch;
    __device__ __forceinline__ void mid(f32x4 (&)[2][2][4][2], const Unit&, int, int, int, int) const {}
    __device__ __forceinline__ void operator()(f32x4 (&acc)[2][2][4][2], const Unit& u, int wr, int wc, int fr, int fq) const {
        const int row0 = u.pm * BM + wr * 64 + fr, col0 = u.pn * XD + wc * 32 + 8 * fq;
        PG8_LAS float* xm = xch; PG8_LAS float* xs = xch + 1024;
#pragma unroll
        for (int ai = 0; ai < 2; ++ai)
#pragma unroll
            for (int m = 0; m < 4; ++m) { const float rs = rstd16(ssq1 + (size_t)(row0 + ai * HALF + m * 16) * 16) * qscale; float mx = -INFINITY;
#pragma unroll
                for (int bj = 0; bj < 2; ++bj)
#pragma unroll
                    for (int n = 0; n < 2; ++n) { const f32x4 v = acc[ai][bj][m][n] * rs; acc[ai][bj][m][n] = v; mx = fmaxf(mx, fmaxf(fmaxf(v[0], v[1]), fmaxf(v[2], v[3]))); }
                mx = fmaxf(mx, __shfl_xor(mx, 16)); mx = fmaxf(mx, __shfl_xor(mx, 32));
                if (fq == 0) xm[(ai * HALF + wr * 64 + m * 16 + fr) * 4 + wc] = mx; asm volatile("" ::: "memory"); }
        asm volatile("s_waitcnt lgkmcnt(0)" ::: "memory"); __builtin_amdgcn_s_barrier(); asm volatile("" ::: "memory");
#pragma unroll
        for (int ai = 0; ai < 2; ++ai)
#pragma unroll
            for (int m = 0; m < 4; ++m) { const int rl = ai * HALF + wr * 64 + m * 16 + fr; const f32x4 q = *(const PG8_LAS f32x4*)(xm + rl * 4);
                const float mx = fmaxf(fmaxf(q[0], q[1]), fmaxf(q[2], q[3])); float ss = 0.f;
#pragma unroll
                for (int bj = 0; bj < 2; ++bj)
#pragma unroll
                    for (int n = 0; n < 2; ++n) { f32x4 v = acc[ai][bj][m][n];
#pragma unroll
                        for (int e = 0; e < 4; ++e) { v[e] = __builtin_amdgcn_exp2f(v[e] - mx); ss += v[e]; }
                        acc[ai][bj][m][n] = v; }
                ss += __shfl_xor(ss, 16); ss += __shfl_xor(ss, 32);
                if (fq == 0) xs[rl * 4 + wc] = ss; asm volatile("" ::: "memory"); }
        asm volatile("s_waitcnt lgkmcnt(0)" ::: "memory"); __builtin_amdgcn_s_barrier(); asm volatile("" ::: "memory");
#pragma unroll
        for (int ai = 0; ai < 2; ++ai)
#pragma unroll
            for (int m = 0; m < 4; ++m) { const int rl = ai * HALF + wr * 64 + m * 16 + fr; const f32x4 q = *(const PG8_LAS f32x4*)(xs + rl * 4);
                const float inv = __builtin_amdgcn_rcpf((q[0] + q[1]) + (q[2] + q[3])); bf16_t* rowp = P + (size_t)(row0 + ai * HALF + m * 16) * D + col0;
#pragma unroll
                for (int bj = 0; bj < 2; ++bj) *(u32x4*)(rowp + bj * HALF) = pack8(acc[ai][bj][m][0] * inv, acc[ai][bj][m][1] * inv); asm volatile("" ::: "memory"); }
    }
};


struct OneUnitOrder {
    const bf16_t* A; const bf16_t* Bt; int lda, ldb, pm, pn, ntk;
    static constexpr bool GATHER = false;
    __device__ __forceinline__ bool next(int i, Unit& u) const { if (i > 0) return false; u.pm = pm; u.pn = pn; return true; }
    __device__ __forceinline__ int nt(const Unit&) const { return ntk; }
    __device__ __forceinline__ void ptrs(const Unit& u, const char*& a, const char*& b0, const char*& b1) const {
        a = (const char*)A + (size_t)u.pm * BM * lda * 2; b0 = (const char*)Bt + (size_t)u.pn * BM * ldb * 2; b1 = b0 + (size_t)HALF * ldb * 2; }
};
struct EpiKvN {
    static constexpr bool PERM = true, HAS_MID = false; int mid_t;
    bf16_t* KM; bf16_t* VM;
    __device__ __forceinline__ void mid(f32x4 (&)[2][2][4][2], const Unit&, int, int, int, int) const {}
    __device__ __forceinline__ void operator()(const f32x4 (&acc)[2][2][4][2], const Unit& u, int wr, int wc, int fr, int fq) const {
        bf16_t* base = (u.pn < 4 ? KM : VM) + (u.pn & 3) * BM + wc * 32 + 8 * fq; const int row0 = u.pm * BM + wr * 64 + fr;
#pragma unroll
        for (int ai = 0; ai < 2; ++ai)
#pragma unroll
            for (int m = 0; m < 4; ++m) { bf16_t* rowp = base + (size_t)(row0 + ai * HALF + m * 16) * D;
#pragma unroll
                for (int bj = 0; bj < 2; ++bj) *(u32x4*)(rowp + bj * HALF) = pack8(acc[ai][bj][m][0], acc[ai][bj][m][1]); }
    }
};
struct EpiMoeFinal {
    static constexpr bool PERM = true, HAS_MID = false; int mid_t;
    const int* tokg; const bf16_t* Xi; float* out; float* ssq; unsigned* cnt; const float* g; PG8_LAS unsigned* flag; unsigned* tmo;
    __device__ __forceinline__ void mid(f32x4 (&)[2][2][4][2], const Unit&, int, int, int, int) const {}
    __device__ __forceinline__ void operator()(f32x4 (&acc)[2][2][4][2], const Unit& u, int wr, int wc, int fr, int fq) const {
        const int row0 = u.pm * BM + wr * 64 + fr, ct = u.pn & 3, col0 = ct * BM + wc * 32 + 8 * fq;
#pragma unroll
        for (int ai = 0; ai < 2; ++ai)
#pragma unroll
            for (int m = 0; m < 4; ++m) { const int tok = tokg[row0 + ai * HALF + m * 16];
                if (tok >= 0) { float ss = 0.f;
#pragma unroll
                    for (int bj = 0; bj < 2; ++bj) { const u32x4 xi = *(const u32x4*)(Xi + (size_t)tok * D + col0 + bj * HALF);
                        f32x4 v0, v1; v0[0] = __uint_as_float(xi.x << 16); v0[1] = __uint_as_float(xi.x & 0xffff0000u); v0[2] = __uint_as_float(xi.y << 16); v0[3] = __uint_as_float(xi.y & 0xffff0000u);
                        v1[0] = __uint_as_float(xi.z << 16); v1[1] = __uint_as_float(xi.z & 0xffff0000u); v1[2] = __uint_as_float(xi.w << 16); v1[3] = __uint_as_float(xi.w & 0xffff0000u);
                        v0 = v0 + acc[ai][bj][m][0]; v1 = v1 + acc[ai][bj][m][1]; acc[ai][bj][m][0] = v0; acc[ai][bj][m][1] = v1; ss += sq8(v0, v1); }
                    ss += __shfl_xor(ss, 16); ss += __shfl_xor(ss, 32);
                    if (fq == 0) __hip_atomic_store(ssq + (size_t)tok * 16 + ct * 4 + wc, ss, __ATOMIC_RELAXED, __HIP_MEMORY_SCOPE_AGENT); }
                asm volatile("" ::: "memory"); }
        asm volatile("s_waitcnt vmcnt(0) lgkmcnt(0)" ::: "memory"); __builtin_amdgcn_s_barrier(); asm volatile("" ::: "memory");
        const int tid = threadIdx.x;
        if (tid < 64) {
            if (tid == 0) __hip_atomic_fetch_add(cnt + 16 * u.pm, 1u, __ATOMIC_RELAXED, __HIP_MEMORY_SCOPE_AGENT);
            unsigned spins = 0; bool dead = false;
            while ((unsigned)__builtin_amdgcn_readfirstlane(__hip_atomic_load(cnt + 16 * u.pm, __ATOMIC_RELAXED, __HIP_MEMORY_SCOPE_AGENT)) < 4u) {
                __builtin_amdgcn_s_sleep(2); if (++spins > (1u << 20)) { dead = true; break; } }
            __builtin_amdgcn_fence(__ATOMIC_ACQUIRE, "agent");
            if (tid == 0) { flag[0] = dead ? 1u : 0u; if (dead) __hip_atomic_store(tmo, 1u, __ATOMIC_RELAXED, __HIP_MEMORY_SCOPE_AGENT); }
        }
        asm volatile("s_waitcnt vmcnt(0) lgkmcnt(0)" ::: "memory"); __builtin_amdgcn_s_barrier(); asm volatile("" ::: "memory");
        f32x4 gv[2][2];
#pragma unroll
        for (int bj = 0; bj < 2; ++bj) { gv[bj][0] = *(const f32x4*)(g + col0 + bj * HALF); gv[bj][1] = *(const f32x4*)(g + col0 + bj * HALF + 4); }
#pragma unroll
        for (int ai = 0; ai < 2; ++ai)
#pragma unroll
            for (int m = 0; m < 4; ++m) { const int tok = tokg[row0 + ai * HALF + m * 16];
                if (tok >= 0) { const float rs = rstd16(ssq + (size_t)tok * 16); float* orow = out + (size_t)tok * D + col0;
#pragma unroll
                    for (int bj = 0; bj < 2; ++bj) { *(f32x4*)(orow + bj * HALF) = acc[ai][bj][m][0] * rs * gv[bj][0]; *(f32x4*)(orow + bj * HALF + 4) = acc[ai][bj][m][1] * rs * gv[bj][1]; } }
                asm volatile("" ::: "memory"); }
    }
};
}
namespace sba {
typedef float f32x16 __attribute__((ext_vector_type(16)));
typedef short s16x4 __attribute__((ext_vector_type(4)));
typedef short v4i16_t __attribute__((ext_vector_type(4)));
typedef __attribute__((address_space(3))) const char* lds_cptr;
constexpr int SLOTB = 8192, L_K = 0, L_V = 2 * SLOTB, L_FLAG = 4 * SLOTB, L_OST = L_FLAG + 256, L_BYTES = L_OST + 8 * 4096;
__device__ __forceinline__ int crow(int r, int hi) { return (r & 3) + 8 * (r >> 2) + 4 * hi; }
__device__ __forceinline__ void glds16(const void* gsrc, unsigned lds_dst) { unsigned keep;
    asm volatile("s_mov_b32 %0, m0\n\ts_mov_b32 m0, %2\n\ts_nop 0\n\tglobal_load_lds_dwordx4 %1, off\n\ts_mov_b32 m0, %0" : "=&s"(keep) : "v"(gsrc), "s"(lds_dst) : "memory"); }
typedef float f32x2_t __attribute__((ext_vector_type(2))); typedef __bf16 bf16x2_t __attribute__((ext_vector_type(2)));
__device__ __forceinline__ unsigned cvtpk(float lo, float hi) { f32x2_t v = {lo, hi}; bf16x2_t b = __builtin_convertvector(v, bf16x2_t); return __builtin_bit_cast(unsigned, b); }
__device__ __forceinline__ s16x4 vtr(lds_cptr p) { return __builtin_bit_cast(s16x4, __builtin_amdgcn_ds_read_tr16_b64_v4i16((__attribute__((address_space(3))) v4i16_t*)p)); }

#define SBA_GROUP(Z, OM, g) do { \
        float d_ = acc_ * (hi ? 1.f : gp_##OM[g]); acc_ *= gs_##OM[g] * gp_##OM[g]; \
        Z[4 * (g) + 3] *= d_; d_ *= OM[4 * (g) + 3]; Z[4 * (g) + 2] *= d_; d_ *= OM[4 * (g) + 2]; Z[4 * (g) + 1] *= d_; d_ *= OM[4 * (g) + 1]; Z[4 * (g)] *= d_; } while (0)

__device__ __forceinline__ void sb_unit(int b, int h, int qb, const bf16_t* Qs, const bf16_t* Ks, const bf16_t* Vs, bf16_t* YY, float* ssq_s8, char* shm) {
    int tid_ = threadIdx.x; asm volatile("" : "+v"(tid_));
    const int tid = tid_, lane = tid & 63, r32 = lane & 31, hi = lane >> 5; const int wid = __builtin_amdgcn_readfirstlane(tid >> 6);
    const size_t rowbase = (size_t)b * SEQ; const int q0 = qb * 256;
    const bf16_t* Kh = Ks + rowbase * SBW + h * HD; const bf16_t* Vh = Vs + rowbase * SBW + h * HD;
    const unsigned lds0 = (unsigned)(uintptr_t)shm;
    const lds_cptr shm3 = (lds_cptr)shm;
    const bf16_t* ksrc = Kh + (size_t)lane * SBW + wid * 8;
    const bf16_t* vsrc = Vh + (size_t)(16 * (wid & 3) + (lane >> 2)) * SBW + (wid >> 2) * 32 + (lane & 3) * 8;
    const unsigned kdst = lds0 + L_K + wid * 1024, vdst = lds0 + L_V + wid * 1024;
#define DMA_KV(t, slot) do { glds16(ksrc + (size_t)(t) * 64 * SBW, (unsigned)__builtin_amdgcn_readfirstlane(kdst + (slot))); glds16(vsrc + (size_t)(t) * 64 * SBW, (unsigned)__builtin_amdgcn_readfirstlane(vdst + (slot))); } while (0)
    const lds_cptr kp0 = shm3 + L_K + hi * 1024 + r32 * 16;
    const lds_cptr vp0 = shm3 + L_V + ((lane >> 4) & 1) * 32 + (lane & 3) * 8 + (4 * hi + ((lane & 15) >> 2)) * 64;
    volatile __attribute__((address_space(3))) unsigned* flags = (volatile __attribute__((address_space(3))) unsigned*)(shm3 + L_FLAG);
    int tile = 4 * qb + 3, slot = 0, it = 0;
    DMA_KV(tile, 0);
    const bf16_t* Qw = Qs + (rowbase + q0 + wid * 32 + r32) * SBW + h * HD;
    bf16x8 qr[4];
#pragma unroll
    for (int d0 = 0; d0 < 4; ++d0) qr[d0] = *(const bf16x8*)(Qw + d0 * 16 + hi * 8);
    float qn = 0.f;
#pragma unroll
    for (int d0 = 0; d0 < 4; ++d0)
#pragma unroll
        for (int e = 0; e < 8; ++e) qn += fabsf(bf2f((unsigned short)qr[d0][e]));
    qn += __shfl_xor(qn, 32);
    const int tq = q0 + wid * 32 + r32;
    const int tq_min = q0 + wid * 32, tq_max = tq_min + 31;
    float PR = 1.f;
    f32x16 o0 = {}, o1 = {};
    for (;;) {
        const bool has_next = tile > 0;
        if (has_next) { DMA_KV(tile - 1, slot ^ SLOTB); asm volatile("s_waitcnt vmcnt(2)" ::: "memory"); }
        else asm volatile("s_waitcnt vmcnt(0)" ::: "memory");
        __builtin_amdgcn_s_barrier(); asm volatile("" ::: "memory");
        const int kmin = tile * 64;
        if (kmin < tq_max) {
            f32x16 z0, z1;
            {
                const lds_cptr kb = kp0 + slot; bf16x8 kf[8];
#pragma unroll
                for (int d0 = 0; d0 < 4; ++d0) { kf[2 * d0] = *(const __attribute__((address_space(3))) bf16x8*)(kb + d0 * 2048); kf[2 * d0 + 1] = *(const __attribute__((address_space(3))) bf16x8*)(kb + d0 * 2048 + 512); }
                __builtin_amdgcn_sched_barrier(0);
                z0 = __builtin_amdgcn_mfma_f32_32x32x16_bf16(kf[0], qr[0], (f32x16){}, 0, 0, 0); z1 = __builtin_amdgcn_mfma_f32_32x32x16_bf16(kf[1], qr[0], (f32x16){}, 0, 0, 0);
#pragma unroll
                for (int d0 = 1; d0 < 4; ++d0) { z0 = __builtin_amdgcn_mfma_f32_32x32x16_bf16(kf[2 * d0], qr[d0], z0, 0, 0, 0); z1 = __builtin_amdgcn_mfma_f32_32x32x16_bf16(kf[2 * d0 + 1], qr[d0], z1, 0, 0, 0); }
            }
            if (kmin + 63 >= tq_min) {
#pragma unroll
                for (int r = 0; r < 16; ++r) { const int kv = kmin + crow(r, hi); if (kv >= tq) z0[r] = -INFINITY; if (kv + 32 >= tq) z1[r] = -INFINITY; }
            }
            f32x16 m0, m1;
#pragma unroll
            for (int r = 0; r < 16; ++r) { const float e0 = __builtin_amdgcn_exp2f(fminf(z0[r], 120.f)), e1 = __builtin_amdgcn_exp2f(fminf(z1[r], 120.f));
                m0[r] = __builtin_amdgcn_rcpf(1.f + e0); m1[r] = __builtin_amdgcn_rcpf(1.f + e1); z0[r] = e0 * m0[r]; z1[r] = e1 * m1[r]; }
            float gs_m0[4], gs_m1[4], gp_m0[4], gp_m1[4];
#pragma unroll
            for (int g = 0; g < 4; ++g) { gs_m0[g] = (m0[4 * g] * m0[4 * g + 1]) * (m0[4 * g + 2] * m0[4 * g + 3]); gs_m1[g] = (m1[4 * g] * m1[4 * g + 1]) * (m1[4 * g + 2] * m1[4 * g + 3]); }
#pragma unroll
            for (int g = 0; g < 4; ++g) { const auto r0 = __builtin_amdgcn_permlane32_swap(__float_as_uint(gs_m0[g]), __float_as_uint(gs_m0[g]), false, false), r1 = __builtin_amdgcn_permlane32_swap(__float_as_uint(gs_m1[g]), __float_as_uint(gs_m1[g]), false, false);
                gp_m0[g] = __uint_as_float(hi ? r0[0] : r0[1]); gp_m1[g] = __uint_as_float(hi ? r1[0] : r1[1]); }
            float acc_ = PR;
            SBA_GROUP(z1, m1, 3); SBA_GROUP(z1, m1, 2); SBA_GROUP(z1, m1, 1); SBA_GROUP(z1, m1, 0);
            SBA_GROUP(z0, m0, 3); SBA_GROUP(z0, m0, 2); SBA_GROUP(z0, m0, 1); SBA_GROUP(z0, m0, 0);
            PR = acc_;
            u32x4 pw0, pw1, pw2, pw3;
            pw0 = (u32x4){cvtpk(z0[0], z0[1]), cvtpk(z0[2], z0[3]), cvtpk(z0[4], z0[5]), cvtpk(z0[6], z0[7])};
            pw1 = (u32x4){cvtpk(z0[8], z0[9]), cvtpk(z0[10], z0[11]), cvtpk(z0[12], z0[13]), cvtpk(z0[14], z0[15])};
            pw2 = (u32x4){cvtpk(z1[0], z1[1]), cvtpk(z1[2], z1[3]), cvtpk(z1[4], z1[5]), cvtpk(z1[6], z1[7])};
            pw3 = (u32x4){cvtpk(z1[8], z1[9]), cvtpk(z1[10], z1[11]), cvtpk(z1[12], z1[13]), cvtpk(z1[14], z1[15])};
            const lds_cptr vp = vp0 + slot;
#define SBA_VF(i) (bf16x8){vl[i][0], vl[i][1], vl[i][2], vl[i][3], vh[i][0], vh[i][1], vh[i][2], vh[i][3]}
            { s16x4 vl[4], vh[4];
#pragma unroll
                for (int i = 0; i < 4; ++i) { vl[i] = vtr(vp + i * 1024); vh[i] = vtr(vp + i * 1024 + 512); }
                __builtin_amdgcn_sched_barrier(0);
                o0 = __builtin_amdgcn_mfma_f32_32x32x16_bf16(__builtin_bit_cast(bf16x8, pw0), SBA_VF(0), o0, 0, 0, 0); o0 = __builtin_amdgcn_mfma_f32_32x32x16_bf16(__builtin_bit_cast(bf16x8, pw1), SBA_VF(1), o0, 0, 0, 0);
                o0 = __builtin_amdgcn_mfma_f32_32x32x16_bf16(__builtin_bit_cast(bf16x8, pw2), SBA_VF(2), o0, 0, 0, 0); o0 = __builtin_amdgcn_mfma_f32_32x32x16_bf16(__builtin_bit_cast(bf16x8, pw3), SBA_VF(3), o0, 0, 0, 0); }
            { s16x4 vl[4], vh[4];
#pragma unroll
                for (int i = 0; i < 4; ++i) { vl[i] = vtr(vp + 4096 + i * 1024); vh[i] = vtr(vp + 4096 + i * 1024 + 512); }
                __builtin_amdgcn_sched_barrier(0);
                o1 = __builtin_amdgcn_mfma_f32_32x32x16_bf16(__builtin_bit_cast(bf16x8, pw0), SBA_VF(0), o1, 0, 0, 0); o1 = __builtin_amdgcn_mfma_f32_32x32x16_bf16(__builtin_bit_cast(bf16x8, pw1), SBA_VF(1), o1, 0, 0, 0);
                o1 = __builtin_amdgcn_mfma_f32_32x32x16_bf16(__builtin_bit_cast(bf16x8, pw2), SBA_VF(2), o1, 0, 0, 0); o1 = __builtin_amdgcn_mfma_f32_32x32x16_bf16(__builtin_bit_cast(bf16x8, pw3), SBA_VF(3), o1, 0, 0, 0); }
#undef SBA_VF
        }
        const bool done = __all(PR == 0.f);
        if (lane == 0) flags[(it & 1) * 8 + wid] = done ? 1u : 0u;
        asm volatile("s_waitcnt lgkmcnt(0)" ::: "memory"); __builtin_amdgcn_s_barrier(); asm volatile("" ::: "memory");
        unsigned alld = 1u;
#pragma unroll
        for (int w = 0; w < 8; ++w) alld &= flags[(it & 1) * 8 + w];
        alld = __builtin_amdgcn_readfirstlane(alld);
        if (!has_next || alld) break;
        --tile; slot ^= SLOTB; ++it;
    }
    asm volatile("s_waitcnt vmcnt(0)" ::: "memory");
    {
        bf16_t* Ow = YY + (rowbase + q0 + wid * 32) * D + RW + h * HD;
        bf16_t* stg = (bf16_t*)(shm + L_OST) + wid * 2048;
#pragma unroll
        for (int r = 0; r < 16; ++r) { const int orow = crow(r, hi); stg[orow * 64 + r32] = (bf16_t)f2bf(o0[r]); stg[orow * 64 + 32 + r32] = (bf16_t)f2bf(o1[r]); }
        asm volatile("s_waitcnt lgkmcnt(0)" ::: "memory");
#pragma unroll
        for (int i = 0; i < 4; ++i) { const int row = i * 8 + (lane >> 3), ch = lane & 7; const u32x4 v = *(const u32x4*)(stg + row * 64 + ch * 8);
            *(u32x4*)(Ow + (size_t)row * D + ch * 8) = v;
            float ss = 0.f;
#pragma unroll
            for (int e = 0; e < 4; ++e) { const float lo = __uint_as_float(v[e] << 16), hh = __uint_as_float(v[e] & 0xffff0000u); ss += lo * lo + hh * hh; }
            ss += __shfl_xor(ss, 1); ss += __shfl_xor(ss, 2); ss += __shfl_xor(ss, 4);
            if (ch == 0) ssq_s8[(rowbase + q0 + wid * 32 + row) * 8 + h] = ss; }
    }
    asm volatile("s_waitcnt lgkmcnt(0)" ::: "memory"); __builtin_amdgcn_s_barrier(); asm volatile("" ::: "memory");
#undef DMA_KV
}
#undef SBA_GROUP
}
namespace lru {
typedef float f32x16 __attribute__((ext_vector_type(16)));
constexpr int XS_ROWS = 67, XS_BYTES = XS_ROWS * 1024  , XC_PITCH = 1040  , XC_OFF = 68608, HC_OFF = XC_OFF + 64 * XC_PITCH  , L_BYTES = HC_OFF + 2048;
__device__ __forceinline__ int crow(int r, int hi) { return (r & 3) + 8 * (r >> 2) + 4 * hi; }

struct Weights { bf16x8 wa[2][4], wx[2][4]; float ba[2], bx[2], spl[2]; };
__device__ __forceinline__ void load_weights(Weights& W, int h, int r32, int hi, const float* w_a, const float* b_a, const float* w_x, const float* b_x, const float* lam) {
#pragma unroll
    for (int nt = 0; nt < 2; ++nt) {
#pragma unroll
        for (int s = 0; s < 4; ++s) {
#pragma unroll
            for (int e = 0; e < 8; ++e) { const size_t idx = ((size_t)(h * 64 + 16 * s + 8 * hi + e)) * 64 + 32 * nt + r32;
                W.wa[nt][s][e] = (short)f2bf(w_a[idx]); W.wx[nt][s][e] = (short)f2bf(w_x[idx]); }
            asm volatile("" ::: "memory");
        }
        const int c = h * 64 + 32 * nt + r32; W.ba[nt] = b_a[c]; W.bx[nt] = b_x[c];
        const float l = lam[c]; W.spl[nt] = (l > 15.f) ? __expf(-l) : log1pf(__expf(-l));
    }
}

template <bool PASSB>
__device__ __forceinline__ void pair_unit(int b, int pj, const Weights& W, const bf16_t* XR, const bf16_t* GG, const float* conv_w, const float* conv_b,
                                     float* aggP, float* aggH, const float* ssq_s8, bf16_t* YY, float* fmid, float* fend, unsigned char* shm) {
    int tid_ = threadIdx.x; asm volatile("" : "+v"(tid_));
    const int tid = tid_, lane = tid & 63, r32 = lane & 31, hi = lane >> 5, wid = __builtin_amdgcn_readfirstlane(tid >> 6);
    LAS unsigned char* L = (LAS unsigned char*)shm;
    const size_t rowbase = (size_t)b * SEQ; const int h = wid;
    float Hc[2] = {0.f, 0.f}, Pc[2] = {1.f, 1.f};
#pragma unroll
    for (int half = 0; half < 2; ++half) {
    const int t0 = (2 * pj + half) * 64;
    f32x4 cp_[PASSB ? 8 : 1], cq_[PASSB ? 8 : 1];
    if (PASSB && half == 0) {
        const f32x4* pP = (const f32x4*)(aggP + ((size_t)b * RW + tid) * 32); const f32x4* pH = (const f32x4*)(aggH + ((size_t)b * RW + tid) * 32);
#pragma unroll
        for (int i = 0; i < 8; ++i) { cp_[i] = pP[i]; cq_[i] = pH[i]; }
    }
    {
        u32x4 v[9];
#pragma unroll
        for (int k = 0; k < 9; ++k) { const int p = tid + k * NTHREADS, rr = p >> 6, pc = p & 63, t = t0 - 3 + rr;
            v[k] = (u32x4){0u, 0u, 0u, 0u}; if (p < XS_ROWS * 64 && t >= 0) v[k] = *(const u32x4*)(XR + (rowbase + t) * RW + pc * 8); }
#pragma unroll
        for (int k = 0; k < 9; ++k) { const int p = tid + k * NTHREADS; if (p < XS_ROWS * 64) *(LAS u32x4*)(L + (p >> 6) * 1024 + (p & 63) * 16) = v[k]; }
    }
    if (PASSB && half == 0) {
        float hc = 0.f;
#pragma unroll
        for (int i = 0; i < 8; ++i)
#pragma unroll
            for (int e = 0; e < 4; ++e) { if (i * 4 + e < pj) hc = cp_[i][e] * hc + cq_[i][e]; }
        *(LAS float*)(L + HC_OFF + tid * 4) = hc;
    }
    __syncthreads();
    {
        const int cp = tid & 255, th = tid >> 8, c0 = 2 * cp;
        const float w00 = conv_w[c0], w01 = conv_w[RW + c0], w02 = conv_w[2 * RW + c0], w03 = conv_w[3 * RW + c0], b0 = conv_b[c0];
        const float w10 = conv_w[c0 + 1], w11 = conv_w[RW + c0 + 1], w12 = conv_w[2 * RW + c0 + 1], w13 = conv_w[3 * RW + c0 + 1], b1 = conv_b[c0 + 1];
        const LAS unsigned* xs = (const LAS unsigned*)(L + (th * 32) * 1024 + cp * 4);
        unsigned u0 = xs[0], u1 = xs[256], u2 = xs[512];
        float a0 = __uint_as_float(u0 << 16), a1 = __uint_as_float(u1 << 16), a2 = __uint_as_float(u2 << 16);
        float c0_ = __uint_as_float(u0 & 0xffff0000u), c1_ = __uint_as_float(u1 & 0xffff0000u), c2_ = __uint_as_float(u2 & 0xffff0000u);
#pragma unroll 8
        for (int t = 0; t < 32; ++t) { const unsigned u3 = xs[(t + 3) * 256]; const float a3 = __uint_as_float(u3 << 16), c3_ = __uint_as_float(u3 & 0xffff0000u);
            const float y0 = w00 * a0 + w01 * a1 + w02 * a2 + w03 * a3 + b0, y1 = w10 * c0_ + w11 * c1_ + w12 * c2_ + w13 * c3_ + b1;
            *(LAS unsigned*)(L + XC_OFF + (th * 32 + t) * XC_PITCH + cp * 4) = f2bf(y0) | (f2bf(y1) << 16);
            a0 = a1; a1 = a2; a2 = a3; c0_ = c1_; c1_ = c2_; c2_ = c3_; }
    }
    __syncthreads();
    if (PASSB && half == 0) {
#pragma unroll
        for (int nt = 0; nt < 2; ++nt) Hc[nt] = *(const LAS float*)(L + HC_OFF + (h * 64 + 32 * nt + r32) * 4);
    }
#pragma unroll
    for (int mt = 0; mt < 2; ++mt) {
        bf16x8 af[4];
#pragma unroll
        for (int s = 0; s < 4; ++s) af[s] = *(const LAS bf16x8*)(L + XC_OFF + (32 * mt + r32) * XC_PITCH + (h * 64 + 16 * s + 8 * hi) * 2);
#pragma unroll
        for (int nt = 0; nt < 2; ++nt) {
            f32x16 ra = {}, ri = {};
#pragma unroll
            for (int s = 0; s < 4; ++s) { ra = __builtin_amdgcn_mfma_f32_32x32x16_bf16(af[s], W.wa[nt][s], ra, 0, 0, 0); ri = __builtin_amdgcn_mfma_f32_32x32x16_bf16(af[s], W.wx[nt][s], ri, 0, 0, 0); }
            const int c = h * 64 + 32 * nt + r32;
#pragma unroll
            for (int r = 0; r < 16; ++r) { const int tok = 32 * mt + crow(r, hi);
                const float xc = bf2f(*(const LAS unsigned short*)(L + XC_OFF + tok * XC_PITCH + c * 2));
                const float rg = __builtin_amdgcn_rcpf(1.f + __expf(-(ra[r] + W.ba[nt]))), ig = __builtin_amdgcn_rcpf(1.f + __expf(-(ri[r] + W.bx[nt])));
                const float la = -8.0f * rg * W.spl[nt], a = __expf(la);
                ra[r] = a; ri[r] = __builtin_amdgcn_sqrtf(fmaxf(0.f, 1.f - a * a)) * (ig * xc); }
            float P[4], H[4], Pp[4], Hp[4];
#pragma unroll
            for (int g = 0; g < 4; ++g) { P[g] = (ra[4 * g] * ra[4 * g + 1]) * (ra[4 * g + 2] * ra[4 * g + 3]);
                H[g] = ((ri[4 * g] * ra[4 * g + 1] + ri[4 * g + 1]) * ra[4 * g + 2] + ri[4 * g + 2]) * ra[4 * g + 3] + ri[4 * g + 3]; }
#pragma unroll
            for (int g = 0; g < 4; ++g) { Pp[g] = __shfl_xor(P[g], 32); Hp[g] = __shfl_xor(H[g], 32); }
            float hc = Hc[nt], pc = Pc[nt];
#pragma unroll
            for (int g = 0; g < 4; ++g) { const float P0 = hi ? Pp[g] : P[g], H0 = hi ? Hp[g] : H[g], P1 = hi ? P[g] : Pp[g], H1 = hi ? H[g] : Hp[g];
                const float mid = P0 * hc + H0;
                if (PASSB) { float hh = hi ? mid : hc;
#pragma unroll
                    for (int k = 0; k < 4; ++k) { hh = ra[4 * g + k] * hh + ri[4 * g + k]; const int tok = 32 * mt + 8 * g + 4 * hi + k;
                        *(LAS unsigned short*)(L + tok * 1024 + c * 2) = (unsigned short)f2bf(hh); } }
                hc = P1 * mid + H1; pc = pc * (P0 * P1); }
            Hc[nt] = hc; Pc[nt] = pc;
        }
    }
    if (!PASSB) {
        if (half == 1 && hi == 0) {
#pragma unroll
            for (int nt = 0; nt < 2; ++nt) { const int c = h * 64 + 32 * nt + r32; aggP[((size_t)b * RW + c) * 32 + pj] = Pc[nt]; aggH[((size_t)b * RW + c) * 32 + pj] = Hc[nt]; }
        }
        __syncthreads();
    } else {
        __syncthreads();
        u32x4 gv[8];
#pragma unroll
        for (int i = 0; i < 8; ++i) { const size_t row = rowbase + t0 + i * 8 + wid; gv[i] = *(const u32x4*)(GG + row * RW + lane * 8); }
#pragma unroll
        for (int i = 0; i < 8; ++i) { const int rr = i * 8 + wid; const size_t row = rowbase + t0 + rr;
            const u32x4 hv = *(const LAS u32x4*)(L + rr * 1024 + lane * 16); const u32x4 g4 = gv[i];
            f32x4 y0, y1;
            y0[0] = __uint_as_float(hv.x << 16) * __uint_as_float(g4.x << 16); y0[1] = __uint_as_float(hv.x & 0xffff0000u) * __uint_as_float(g4.x & 0xffff0000u);
            y0[2] = __uint_as_float(hv.y << 16) * __uint_as_float(g4.y << 16); y0[3] = __uint_as_float(hv.y & 0xffff0000u) * __uint_as_float(g4.y & 0xffff0000u);
            y1[0] = __uint_as_float(hv.z << 16) * __uint_as_float(g4.z << 16); y1[1] = __uint_as_float(hv.z & 0xffff0000u) * __uint_as_float(g4.z & 0xffff0000u);
            y1[2] = __uint_as_float(hv.w << 16) * __uint_as_float(g4.w << 16); y1[3] = __uint_as_float(hv.w & 0xffff0000u) * __uint_as_float(g4.w & 0xffff0000u);
            *(u32x4*)(YY + row * D + lane * 8) = pg8::pack8(y0, y1);
            float ss = pg8::sq8(y0, y1);
#pragma unroll
            for (int o = 1; o < 64; o <<= 1) ss += __shfl_xor(ss, o);
            if (lane == 0) fmid[row] = ss; }
        __syncthreads();
    }
    }
}
}
__device__ __forceinline__ void row_prep_mem(const float* m, const float* g, bf16_t* o, int row, int lane) {
    const f32x4* xr = (const f32x4*)(m + (size_t)row * D) + lane;
    float s = 0.f; f32x4 v[4];
#pragma unroll
    for (int j = 0; j < 4; ++j) { v[j] = xr[64 * j]; s += v[j].x * v[j].x + v[j].y * v[j].y + v[j].z * v[j].z + v[j].w * v[j].w; }
    s = wave_sum(s);
    const float r = 1.0f / sqrtf(s * (1.f / D) + EPS);
    unsigned long long* o8 = (unsigned long long*)(o + (size_t)row * D) + lane;
#pragma unroll
    for (int j = 0; j < 4; ++j) { const f32x4 gg = ((const f32x4*)g)[64 * j + lane];
        o8[64 * j] = (unsigned long long)(f2bf(v[j].x * r * gg.x) | (f2bf(v[j].y * r * gg.y) << 16)) | ((unsigned long long)(f2bf(v[j].z * r * gg.z) | (f2bf(v[j].w * r * gg.w) << 16)) << 32); }
}
__device__ __forceinline__ void transpose_item(const float* W, int K, int N, bf16_t* Wt, int ldt, const float* g0, const float* g1, int ksplit, LAS float* scr, int item, int lane) {
    const int nblk = N / 64, kb = item / nblk, nb = item % nblk, k0 = 64 * kb, n0 = 64 * nb, lr = lane >> 4, lc = 4 * (lane & 15);
    f32x4 v[16];
#pragma unroll
    for (int i = 0; i < 16; ++i) v[i] = *(const f32x4*)(W + (size_t)(k0 + 4 * i + lr) * N + n0 + lc);
#pragma unroll
    for (int i = 0; i < 16; ++i) { const int kk = 4 * i + lr, k = k0 + kk; float gv = 1.f; if (g0) gv = (k < ksplit) ? g0[k] : g1[k - ksplit];
        LAS float* d = scr + kk * 65 + lc; d[0] = v[i].x * gv; d[1] = v[i].y * gv; d[2] = v[i].z * gv; d[3] = v[i].w * gv; }
    asm volatile("s_waitcnt lgkmcnt(0)" ::: "memory");
    const int c = lane & 7;
#pragma unroll
    for (int j = 0; j < 8; ++j) { const int n = (lane >> 3) + 8 * j; const LAS float* s = scr + (8 * c) * 65 + n;
        u32x4 o; o.x = f2bf(s[0 * 65]) | (f2bf(s[1 * 65]) << 16); o.y = f2bf(s[2 * 65]) | (f2bf(s[3 * 65]) << 16); o.z = f2bf(s[4 * 65]) | (f2bf(s[5 * 65]) << 16); o.w = f2bf(s[6 * 65]) | (f2bf(s[7 * 65]) << 16);
        *(u32x4*)(Wt + (size_t)(n0 + n) * ldt + k0 + 8 * c) = o; }
    asm volatile("s_waitcnt lgkmcnt(0)" ::: "memory");
}

__device__ __forceinline__ void reids(Ctx& C) { int t_ = threadIdx.x; asm volatile("" : "+v"(t_)); C.tid = t_; C.lane = t_ & 63; C.wave = __builtin_amdgcn_readfirstlane(t_ >> 6); C.gw = C.bid * NWAVES + C.wave; }
__global__ void __launch_bounds__(NTHREADS, 2) mk_fwd(Args args) {
    extern __shared__ __attribute__((aligned(16))) unsigned char lds[];
    cg::grid_group grid = cg::this_grid();
    Ctx C;
#pragma unroll
    for (int i = 0; i < 29; ++i) C.in[i] = args.in[i];
    C.out = args.out; C.ws = args.ws; C.lds = lds;
    C.tid = threadIdx.x; C.lane = C.tid & 63; C.wave = __builtin_amdgcn_readfirstlane(C.tid >> 6);
    C.G = gridDim.x; C.bid = blockIdx.x; C.gw = C.bid * NWAVES + C.wave; C.NGW = C.G * NWAVES;
    const float* x = C.in[0]; const float* mem = C.in[1]; const float* norm_mix = C.in[2]; const float* w_in = C.in[3];
    const float* conv_w = C.in[4]; const float* conv_b = C.in[5]; const float* lru_w_a = C.in[6]; const float* lru_b_a = C.in[7];
    const float* lru_w_x = C.in[8]; const float* lru_b_x = C.in[9]; const float* lru_lambda = C.in[10];
    const float* norm_rnn = C.in[11]; const float* norm_sb = C.in[12]; const float* w_out = C.in[13];
    const float* norm_xattn = C.in[14]; const float* norm_mem = C.in[15];
    const float* xa_w_q = C.in[16]; const float* xa_w_k = C.in[17]; const float* xa_w_v = C.in[18]; const float* xa_w_o = C.in[19];
    const float* norm_moe = C.in[20]; const float* w_gr = C.in[21]; const float* b_gr = C.in[22]; const float* w_er = C.in[23]; const float* b_er = C.in[24];
    const float* w_gate = C.in[25]; const float* w_up = C.in[26]; const float* w_down = C.in[27]; const float* norm_final = C.in[28];
    unsigned char* ws = C.ws; float* out = C.out;
    float* sm = (float*)(ws + WS_SMALL);
    float* rstd0 = sm + SM_RSTD0; float* ssq_r = sm + SM_SSQR; float* ssq_s = sm + SM_SSQS; float* ssq1 = sm + SM_SSQ1; float* ssq2 = sm + SM_SSQ2; float* fmid = sm + SM_END; float* fend = fmid + 32768;
    float* aggP = sm + 96 * 32768; float* aggH = sm + 104 * 32768;
    float* selw = sm + SM_SELW; float* ssq3 = sm + SM_SSQ3; int* gcnt = (int*)(ws + WS_CTL + 1024); int* sbq = (int*)(ws + WS_CTL + 3072); unsigned* lruc = (unsigned*)(ws + WS_CTL + 4096 + 28672);
    int* tlist = (int*)(sm + 64 * 32768); float* rsg = sm + 88 * 32768; float* wAg = rsg + 40960; float* wBg = wAg + 40960; int* tokg = (int*)(wBg + 40960); float* rstok = sm + SM_RSTD0;
    bf16_t* Wrh = (bf16_t*)(ws + WS_CTL + 65536); bf16_t* Wrl = Wrh + 32 * D;
    bf16_t* Wg_t = (bf16_t*)(ws + WS_WG); bf16_t* Wu_t = (bf16_t*)(ws + WS_WU); bf16_t* Wd2 = (bf16_t*)(ws + WS_WD2); bf16_t* XG = (bf16_t*)(ws + WS_R1); bf16_t* HID = (bf16_t*)(ws + WS_R5);
    bf16_t* Win_t = (bf16_t*)(ws + WS_WIN); bf16_t* Wout_t = (bf16_t*)(ws + WS_WOUT); bf16_t* Wq_t = (bf16_t*)(ws + WS_WQ); bf16_t* Wkv_t = (bf16_t*)(ws + WS_WKV); bf16_t* Wo_t = (bf16_t*)(ws + WS_WO);
    bf16_t* memn = (bf16_t*)(ws + WS_MEMN); bf16_t* KM = (bf16_t*)(ws + WS_KVM); bf16_t* VM = KM + (size_t)NMEM * D; bf16_t* MT = (bf16_t*)(ws + WS_R5); bf16_t* NT = MT + (size_t)BATCH * D * D; bf16_t* WqN = (bf16_t*)(ws + WS_WQ);
    bf16_t* xb = (bf16_t*)(ws + WS_R0); bf16_t* X1b = xb; bf16_t* X3b = xb;
    bf16_t* XR = (bf16_t*)(ws + WS_R1); bf16_t* GG = XR + (size_t)NTOK * RW; bf16_t* QX = XR;
    bf16_t* Qs = (bf16_t*)(ws + WS_R2); bf16_t* Ks = Qs + (size_t)NTOK * SBW; bf16_t* OX = Qs;
    bf16_t* Vs = (bf16_t*)(ws + WS_R3);
    bf16_t* YY = (bf16_t*)(ws + WS_R4); bf16_t* X2b = YY;
    const int NGW = C.NGW;
#define gw C.gw
#define lane C.lane
    if (C.tid < 64) ((LAS unsigned*)(lds + 146432))[C.tid] = 0u;
    __syncthreads();
    XcdBarrier bar = xcd_barrier_post((unsigned*)(ws + WS_CTL + 4096), (volatile LAS unsigned*)(lds + 146432 + 32));
#define GRID_SYNC_CG() do { grid.sync(); reids(C); } while (0)
#define GRID_SYNC() do { xcd_barrier(bar); reids(C); } while (0)

    {
        if (gw == 0) { if (lane < 32) gcnt[lane] = 0; if (lane == 32) sbq[0] = 0; }
        if (gw == 1) { ((u32x4*)(ws + WS_END))[lane] = (u32x4){0u, 0u, 0u, 0u}; ((u32x4*)(ws + WS_END))[64 + lane] = (u32x4){0u, 0u, 0u, 0u}; }
        for (int r = gw * 4; r < NTOK; r += NGW * 4) {
            const f32x4* xr = (const f32x4*)(x + (size_t)r * D) + lane; f32x4 v[16]; float s[4] = {0.f, 0.f, 0.f, 0.f};
#pragma unroll
            for (int j = 0; j < 16; ++j) v[j] = __builtin_nontemporal_load(xr + 64 * j);
#pragma unroll
            for (int j = 0; j < 16; ++j) s[j >> 2] += (v[j].x * v[j].x + v[j].y * v[j].y) + (v[j].z * v[j].z + v[j].w * v[j].w);
#pragma unroll
            for (int o = 1; o < 64; o <<= 1) { s[0] += __shfl_xor(s[0], o); s[1] += __shfl_xor(s[1], o); s[2] += __shfl_xor(s[2], o); s[3] += __shfl_xor(s[3], o); }
            if (lane < 4) { const float sv = lane == 0 ? s[0] : lane == 1 ? s[1] : lane == 2 ? s[2] : s[3]; rstd0[r + lane] = __builtin_amdgcn_rsqf(sv * (1.f / D) + EPS); }
            unsigned long long* o8 = (unsigned long long*)(xb + (size_t)r * D) + lane;
#pragma unroll
            for (int j = 0; j < 16; ++j) o8[64 * j] = (unsigned long long)(f2bf(v[j].x) | (f2bf(v[j].y) << 16)) | ((unsigned long long)(f2bf(v[j].z) | (f2bf(v[j].w) << 16)) << 32);
        }
        for (int r = gw; r < NMEM; r += NGW) row_prep_mem(mem, norm_mem, memn, r, lane);
        LAS float* scr = (LAS float*)(lds) + C.wave * (64 * 65);
        constexpr int I_IN = (D / 64) * (PROJ / 64), I_SQ = (D / 64) * (D / 64);
        for (int it = gw; it < I_IN + 4 * I_SQ; it += NGW) {
            int r = it;
            if (r < I_IN) { transpose_item(w_in, D, PROJ, Win_t, D, norm_mix, norm_mix, D, scr, r, lane); continue; } r -= I_IN;
            if (r < I_SQ) { transpose_item(w_out, D, D, Wout_t, D, norm_rnn, norm_sb, RW, scr, r, lane); continue; } r -= I_SQ;
            if (r < I_SQ) { transpose_item(xa_w_k, D, D, Wkv_t, D, nullptr, nullptr, 0, scr, r, lane); continue; } r -= I_SQ;
            if (r < I_SQ) { transpose_item(xa_w_v, D, D, Wkv_t + (size_t)D * D, D, nullptr, nullptr, 0, scr, r, lane); continue; } r -= I_SQ;
            transpose_item(xa_w_o, D, D, Wo_t, D, nullptr, nullptr, 0, scr, r, lane);
        }
        for (int r = gw; r < D; r += NGW) { const float gk = norm_xattn[r]; const f32x4* src = (const f32x4*)(xa_w_q + (size_t)r * D) + lane; unsigned long long* o8 = (unsigned long long*)(WqN + (size_t)r * D) + lane;
#pragma unroll
            for (int j = 0; j < 4; ++j) { const f32x4 v = src[64 * j]; o8[64 * j] = (unsigned long long)(f2bf(v.x * gk) | (f2bf(v.y * gk) << 16)) | ((unsigned long long)(f2bf(v.z * gk) | (f2bf(v.w * gk) << 16)) << 32); } }
        for (int idx = gw * 64 + lane; idx < 32 * D; idx += NGW * 64) { const int n = idx >> 10, k = idx & 1023; float w = 0.f;
            if (n < 4) w = w_gr[k * 4 + n]; else if (n < 20) w = w_er[((size_t)((n - 4) >> 2) * D + k) * 4 + ((n - 4) & 3)];
            w *= norm_moe[k]; const unsigned hi = f2bf(w); Wrh[idx] = (bf16_t)hi; Wrl[idx] = (bf16_t)f2bf(w - bf2f((unsigned short)hi)); }
        constexpr int I_GU = (D / 64) * (DE / 64), I_DN = (DE / 64) * (D / 64);
        for (int it = gw; it < 32 * I_GU + 48 * I_DN; it += NGW) {
            int r = it;
            if (r < 16 * I_GU) { const int e = r / I_GU; transpose_item(w_gate + (size_t)e * D * DE, D, DE, Wg_t + (size_t)e * DE * D, D, norm_moe, norm_moe, D, scr, r % I_GU, lane); continue; } r -= 16 * I_GU;
            if (r < 16 * I_GU) { const int e = r / I_GU; transpose_item(w_up + (size_t)e * D * DE, D, DE, Wu_t + (size_t)e * DE * D, D, norm_moe, norm_moe, D, scr, r % I_GU, lane); continue; } r -= 16 * I_GU;
            { const int cs = r / I_DN, cls = cs >> 1, slot = cs & 1; int ea, eb; pg8::pair_ab(cls % 6, ea, eb); const int e = (cls / 6) * 4 + (slot ? eb : ea);
              transpose_item(w_down + (size_t)e * DE * D, DE, D, Wd2 + (size_t)cls * D * 512 + slot * DE, 512, nullptr, nullptr, 0, scr, r % I_DN, lane); }
        }
    }
    GRID_SYNC();
    { pg8::DenseOrder S; S.init(xb, D, Win_t, D, NTOK, PROJ, C.G, C.bid); pg8::EpiInProjF E{0, rstd0, XR, GG, Qs, Ks, Vs};
      pg8::gemm_phase<pg8::EpiInProjF, pg8::DenseOrder, true>((LAS unsigned char*)lds, pg8::Gemm{D, D, D}, S, E); }
    { pg8::DenseOrder S; S.init(memn, D, Wkv_t, D, NMEM, 2048, C.G, C.bid); pg8::EpiKvN E{0, KM, VM};
      pg8::gemm_phase<pg8::EpiKvN, pg8::DenseOrder, true>((LAS unsigned char*)lds, pg8::Gemm{D, D, D}, S, E); }
    GRID_SYNC();
    {
        { lru::Weights LW; lru::load_weights(LW, C.wave, lane & 31, lane >> 5, lru_w_a, lru_b_a, lru_w_x, lru_b_x, lru_lambda);
          for (int u = C.bid; u < BATCH * 32; u += C.G) { lru::pair_unit<false>(u >> 5, u & 31, LW, XR, GG, conv_w, conv_b, aggP, aggH, ssq_s, YY, fmid, fend, lds);
              asm volatile("s_waitcnt vmcnt(0)" ::: "memory"); __syncthreads();
              if (C.tid == 0) { __builtin_amdgcn_fence(__ATOMIC_RELEASE, "agent"); asm volatile("s_waitcnt vmcnt(0)" ::: "memory"); __hip_atomic_fetch_add(lruc + 16 * (u >> 5), 1u, __ATOMIC_RELAXED, __HIP_MEMORY_SCOPE_AGENT); } } }
        {
            volatile LAS int* qslot = (volatile LAS int*)(lds + 146432 + 192); int nextu = 0;
            if (C.tid == 0) qslot[0] = atomicAdd(sbq, 1);
            __syncthreads();
            int u = qslot[0];
            while (u < BATCH * NH * 16) {
                __syncthreads();
                if (C.tid == 0) nextu = atomicAdd(sbq, 1);
                sba::sb_unit(u >> 7, (u >> 4) & 7, 15 - (u & 15), Qs, Ks, Vs, YY, ssq_s, (char*)lds);
                if (C.tid == 0) qslot[0] = nextu;
                __syncthreads();
                u = qslot[0];
            }
        }
    }
    { pg8::XaPreOrder S{KM, VM, WqN, Wo_t, C.G, C.bid}; pg8::EpiXaPre E{0, MT, NT};
      pg8::gemm_phase<pg8::EpiXaPre, pg8::XaPreOrder, true>((LAS unsigned char*)lds, pg8::Gemm{D, D, XD}, S, E); }
    {
        const float *pwa = lru_w_a, *pba = lru_b_a, *pwx = lru_w_x, *pbx = lru_b_x, *plm = lru_lambda;
        asm volatile("" : "+s"(pwa), "+s"(pba), "+s"(pwx), "+s"(pbx), "+s"(plm));
        int l2_ = lane; asm volatile("" : "+v"(l2_));
        lru::Weights LW; lru::load_weights(LW, C.wave, l2_ & 31, l2_ >> 5, pwa, pba, pwx, pbx, plm);
        for (int u = C.bid; u < BATCH * 32; u += C.G) {
            if (C.tid < 64) { unsigned spins = 0;
                while ((unsigned)__builtin_amdgcn_readfirstlane(__hip_atomic_load(lruc + 16 * (u >> 5), __ATOMIC_RELAXED, __HIP_MEMORY_SCOPE_AGENT)) < 32u) { __builtin_amdgcn_s_sleep(2); if (++spins > (1u << 20)) break; }
                __builtin_amdgcn_fence(__ATOMIC_ACQUIRE, "agent"); }
            asm volatile("s_waitcnt vmcnt(0)" ::: "memory"); __syncthreads();
            lru::pair_unit<true>(u >> 5, u & 31, LW, XR, GG, conv_w, conv_b, aggP, aggH, ssq_s, YY, ssq_r, fend, lds); }
    }
    GRID_SYNC();
    { pg8::DenseOrder S; S.init(YY, D, Wout_t, D, NTOK, D, C.G, C.bid); pg8::EpiX1F E{8, xb, fmid, fend, X1b, ssq1};
      { pg8::Unit u_;
        for (int i = 0; S.next(i, u_); ++i) if (C.tid < 256) { const int row = u_.pm * 256 + C.tid; const f32x4 a4 = ((const f32x4*)(ssq_s + (size_t)row * 8))[0], b4 = ((const f32x4*)(ssq_s + (size_t)row * 8))[1];
            const float rr = __builtin_amdgcn_rsqf(ssq_r[row] * (1.f / RW) + EPS), rs = __builtin_amdgcn_rsqf((((a4.x + a4.y) + (a4.z + a4.w)) + ((b4.x + b4.y) + (b4.z + b4.w))) * (1.f / SBW) + EPS);
            fmid[row] = rr * __builtin_amdgcn_rcpf(rs); fend[row] = rs; }
        asm volatile("s_waitcnt vmcnt(0)" ::: "memory"); __syncthreads(); }
      pg8::gemm_phase<pg8::EpiX1F, pg8::DenseOrder, true>((LAS unsigned char*)lds, pg8::Gemm{D, D, D}, S, E); }
    GRID_SYNC();
    { pg8::BatchedOrder S{X1b, MT, C.G, C.bid}; pg8::EpiXaSoftmax E{0, QX, ssq1, 0.0625f * LOG2E, (LAS float*)(lds + 131072 + 2048)};
      pg8::gemm_phase<pg8::EpiXaSoftmax, pg8::BatchedOrder, true>((LAS unsigned char*)lds, pg8::Gemm{D, D, D}, S, E); }
    GRID_SYNC();
    { pg8::BatchedOrder S{QX, NT, C.G, C.bid}; pg8::EpiResF E{0, X1b, X2b, ssq2};
      pg8::gemm_phase<pg8::EpiResF, pg8::BatchedOrder, true>((LAS unsigned char*)lds, pg8::Gemm{D, D, D}, S, E); }
    GRID_SYNC();
    {
        LAS int* lcnt = (LAS int*)lds; LAS int* lbase = lcnt + 32; LAS int* lcls = lcnt + 64; LAS int* lpos = lcnt + 192;
        for (int p = C.tid; p < 64 * 128; p += NTHREADS) { const int rrow = p >> 7, pc = p & 127;
            *(LAS u32x4*)(lds + 12288 + rrow * 2064 + pc * 16) = *(const u32x4*)(Wrh + (size_t)rrow * D + pc * 8); }
        for (int chunk = C.bid; chunk < NTOK / 128; chunk += C.G) {
            if (C.tid < 32) lcnt[C.tid] = 0;
            __syncthreads();
            {
                const int fr = lane & 15, fq = lane >> 4, row0 = chunk * 128 + C.wave * 16;
                f32x4 acc0 = {0.f, 0.f, 0.f, 0.f}, acc1 = acc0;
                const bf16_t* ap = X2b + (size_t)(row0 + fr) * D + fq * 8; const LAS unsigned char* bp = (const LAS unsigned char*)(lds + 12288) + fr * 2064 + fq * 16;
#pragma unroll 1
                for (int kb = 0; kb < 4; ++kb) { bf16x8 a[8];
#pragma unroll
                    for (int j = 0; j < 8; ++j) a[j] = *(const bf16x8*)(ap + (kb * 8 + j) * 32);
#pragma unroll
                    for (int j = 0; j < 8; ++j) { const int ks = kb * 8 + j;
                        const bf16x8 h0 = *(const LAS bf16x8*)(bp + ks * 64), h1 = *(const LAS bf16x8*)(bp + 16 * 2064 + ks * 64), l0 = *(const LAS bf16x8*)(bp + 32 * 2064 + ks * 64), l1 = *(const LAS bf16x8*)(bp + 48 * 2064 + ks * 64);
                        acc0 = __builtin_amdgcn_mfma_f32_16x16x32_bf16(a[j], h0, acc0, 0, 0, 0); acc1 = __builtin_amdgcn_mfma_f32_16x16x32_bf16(a[j], h1, acc1, 0, 0, 0);
                        acc0 = __builtin_amdgcn_mfma_f32_16x16x32_bf16(a[j], l0, acc0, 0, 0, 0); acc1 = __builtin_amdgcn_mfma_f32_16x16x32_bf16(a[j], l1, acc1, 0, 0, 0); } }
                LAS float* lg = (LAS float*)(lds + 1536) + C.wave * (16 * 21);
#pragma unroll
                for (int j = 0; j < 4; ++j) { lg[(4 * fq + j) * 21 + fr] = acc0[j]; if (fr < 4) lg[(4 * fq + j) * 21 + 16 + fr] = acc1[j]; }
                asm volatile("s_waitcnt lgkmcnt(0)" ::: "memory");
                if (lane < 16) { const int row = row0 + lane; const float rs = pg8::rstd16(ssq2 + (size_t)row * 16); const LAS float* lr = lg + lane * 21;
                    float gl[4]; float gm = -INFINITY; int gi = 0;
#pragma unroll
                    for (int i = 0; i < 4; ++i) { gl[i] = lr[i] * rs + b_gr[i]; if (gl[i] > gm) { gm = gl[i]; gi = i; } }
                    float gs = 0.f;
#pragma unroll
                    for (int i = 0; i < 4; ++i) gs += __expf(gl[i] - gm);
                    const float gp = 1.f / gs;
                    float el[4];
#pragma unroll
                    for (int e = 0; e < 4; ++e) el[e] = lr[4 + gi * 4 + e] * rs + b_er[gi * 4 + e];
                    int e1 = 0; float m1 = el[0];
#pragma unroll
                    for (int e = 1; e < 4; ++e) if (el[e] > m1) { m1 = el[e]; e1 = e; }
                    int e2 = -1; float m2 = -INFINITY;
#pragma unroll
                    for (int e = 0; e < 4; ++e) if (e != e1 && el[e] > m2) { m2 = el[e]; e2 = e; }
                    const float p2 = __expf(m2 - m1), w1 = gp / (1.f + p2), w2 = gp * p2 / (1.f + p2);
                    const int ea = e1 < e2 ? e1 : e2, eb = e1 < e2 ? e2 : e1; const float wA = e1 < e2 ? w1 : w2, wB = e1 < e2 ? w2 : w1;
                    const int pr = (ea == 0) ? eb - 1 : (ea == 1) ? eb + 1 : 5, cls = gi * 6 + pr, lt = C.wave * 16 + lane;
                    selw[(size_t)row * 2] = wA; selw[(size_t)row * 2 + 1] = wB; rstok[row] = rs;
                    lcls[lt] = cls; lpos[lt] = __hip_atomic_fetch_add(lcnt + cls, 1, __ATOMIC_RELAXED, __HIP_MEMORY_SCOPE_WORKGROUP); }
            }
            __syncthreads();
            if (C.tid < 24) lbase[C.tid] = atomicAdd(gcnt + C.tid, lcnt[C.tid]);
            __syncthreads();
            if (C.tid < 128) { const int c = lcls[C.tid]; tlist[(size_t)c * NTOK + lbase[c] + lpos[C.tid]] = chunk * 128 + C.tid; }
            __syncthreads();
        }
    }
    GRID_SYNC();
    LAS int* meta = (LAS int*)(lds + 146432 + 256);
    {
        if (C.tid == 0) { int rb = 0, tb = 0;
            for (int c = 0; c < 24; ++c) { const int n = gcnt[c], nt = (n + 255) >> 8; meta[c] = n; meta[32 + c] = rb; meta[64 + c] = tb; rb += nt * 256; tb += nt; }
            meta[32 + 24] = rb; meta[64 + 24] = tb; }
        __syncthreads();
        LAS int* tokl = (LAS int*)(lds + 131072 + 2048);
        pg8::MoeOrder1G S{X2b, Wg_t, Wu_t, meta, tokl, (unsigned)(WS_END - WS_R4), C.G, C.bid};
        { pg8::Unit u;
          for (int i = 0; S.next(i, u); ++i) { const int cls = (u.pn & 0xffff) >> 2, p0 = (u.pm - meta[64 + cls]) * 256;
              if (C.tid < 256) { const int pp = p0 + C.tid, tok = pp < meta[cls] ? tlist[(size_t)cls * NTOK + pp] : -1; tokl[i * 256 + C.tid] = tok; tokg[u.pm * 256 + C.tid] = tok; } } }
        __syncthreads();
        pg8::EpiMoeUpG E{0, tokl, rstok, selw, HID};
        pg8::gemm_phase_gather<pg8::EpiMoeUpG, pg8::MoeOrder1G, true>((LAS unsigned char*)lds, pg8::Gemm{D, D, D}, S, E);
    }
    GRID_SYNC();
    { pg8::MoeOrder2 S{HID, Wd2, meta, C.G, C.bid};
      pg8::EpiMoeFinal E{0, tokg, X2b, out, ssq3, (unsigned*)(ws + WS_CTL + 4096 + 16384), norm_final, (LAS unsigned*)(lds + 146432 + 128), (unsigned*)(ws + WS_CTL + 4096) + 128};
      pg8::gemm_phase<pg8::EpiMoeFinal, pg8::MoeOrder2, true>((LAS unsigned char*)lds, pg8::Gemm{512, 512, 512}, S, E); }
}

#undef gw
#undef lane
extern "C" void kernel_launch(void* const* d_in, const int* in_sizes, int n_in, void* d_out, int out_size, void* d_ws, size_t ws_size, hipStream_t stream) {
    static int grid = 0;
    if (grid == 0) {
        if (n_in != 29 || ws_size < WS_END + 4096) { fprintf(stderr, "kernel_launch: unexpected inputs (%d) or workspace (%zu)\n", n_in, ws_size); grid = -1; return; }
        int dev = 0, cus = 0, per_cu = 0;
        hipGetDevice(&dev); hipDeviceGetAttribute(&cus, hipDeviceAttributeMultiprocessorCount, dev);
        hipFuncSetAttribute((const void*)mk_fwd, hipFuncAttributeMaxDynamicSharedMemorySize, LDS_BYTES);
        hipOccupancyMaxActiveBlocksPerMultiprocessor(&per_cu, (const void*)mk_fwd, NTHREADS, LDS_BYTES);
        if (per_cu < 1) { fprintf(stderr, "kernel_launch: occupancy query says %d blocks per CU\n", per_cu); per_cu = 1; }
        if (per_cu > 1) per_cu = 1;
        grid = cus * per_cu;
    }
    if (grid < 0) return;
    if (hipMemsetAsync((char*)d_ws + WS_CTL + 4096, 0, 32768, stream) != hipSuccess) { fprintf(stderr, "kernel_launch: memset of the barrier words failed\n"); return; }
    Args a{};
    for (int i = 0; i < 29; ++i) a.in[i] = (const float*)d_in[i];
    a.out = (float*)d_out; a.ws = (unsigned char*)d_ws;
    void* kargs[] = {&a};
    hipError_t e = hipLaunchCooperativeKernel((const void*)mk_fwd, dim3(grid), dim3(NTHREADS), kargs, LDS_BYTES, stream);
    if (e != hipSuccess) fprintf(stderr, "cooperative launch failed: %s (grid %d)\n", hipGetErrorString(e), grid);
}
```
